# Optimizing an MI355X kernel written in HIP

```python
import math
import jax
import jax.numpy as jnp
from jax import lax
import numpy as np

D_MODEL = 1024
BATCH = 1
SEQ = 16384
DEPTH = 2
DEC_BATCH = 32
DEC_SEQ = 1
PAST_LEN = 16384
PAGE_SIZE = 128

HEAD_DIM = 64
ROPE_THETA = 10000.0
N_A_LAYERS = (DEPTH + 1) // 2
N_C_LAYERS = DEPTH // 2
NSA_HEADS = 8
NSA_KV_HEADS = 2
NSA_GROUP = NSA_HEADS // NSA_KV_HEADS
CMP_BLOCK = 32
SEL_BLOCK = 64
CMP_PER_SEL = SEL_BLOCK // CMP_BLOCK
CMP_HIDDEN = 2 * HEAD_DIM
NSA_TOPN = 16
NSA_WINDOW = 512
NSA_QBLOCK = 128
NSA_FORCE = 1.0e4
GDN_HEADS = 8
GDN_CONV = 4
GDN_CHUNK = 64
DIL_HEADS = 16
DIL_GROUPS = ((128, 1), (512, 4), (2048, 16))
DIL_SPAN = 128
DIL_BLOCK = 128
DIL_MAX_WINDOW = 2048
D_FF = 2816
FFN_CONV = 3
DEEPNORM_ALPHA = (2.0 * DEPTH) ** 0.25
DEEPNORM_BETA = (8.0 * DEPTH) ** -0.25
LN_EPS = 1e-5
NORM_EPS = 1e-6
NSA_Q_W = NSA_HEADS * HEAD_DIM
NSA_KV_W = NSA_KV_HEADS * HEAD_DIM
GDN_W = GDN_HEADS * HEAD_DIM
DIL_W = DIL_HEADS * HEAD_DIM
PROJ_A_W = NSA_Q_W + 6 * NSA_KV_W + 3 * NSA_HEADS + 4 * GDN_W + 2 * GDN_HEADS

kernel_name = 'hybrid_nsa_gdn_dilated_convffn_step'


def _split_cols(h, widths):
    parts, start = [], 0
    for w in widths:
        parts.append(h[..., start:start + w])
        start += w
    return parts


def _even_widths():
    return (NSA_Q_W,) + (NSA_KV_W,) * 6 + (3 * NSA_HEADS, 3 * GDN_W, GDN_HEADS, GDN_HEADS, GDN_W)


def _layer_norm(x, g, b):
    xf = x.astype(jnp.float32)
    mu = jnp.mean(xf, axis=-1, keepdims=True)
    var = jnp.mean(jnp.square(xf - mu), axis=-1, keepdims=True)
    return (xf - mu) * lax.rsqrt(var + LN_EPS) * g + b


def _rms_norm(x, w):
    return x * lax.rsqrt(jnp.mean(jnp.square(x), axis=-1, keepdims=True) + NORM_EPS) * w


def _l2_norm(x):
    return x * lax.rsqrt(jnp.sum(jnp.square(x), axis=-1, keepdims=True) + NORM_EPS)


def _rope(x, pos):
    half = HEAD_DIM // 2
    inv_freq = ROPE_THETA ** (-2.0 * jnp.arange(half, dtype=jnp.float32) / HEAD_DIM)
    ang = pos.astype(jnp.float32)[:, None] * inv_freq[None, :]
    cos, sin = jnp.cos(ang)[:, None, :], jnp.sin(ang)[:, None, :]
    xf = x.astype(jnp.float32)
    x1, x2 = xf[..., :half], xf[..., half:]
    return jnp.concatenate([x1 * cos - x2 * sin, x2 * cos + x1 * sin], axis=-1)


def _causal_dwconv(hist, u, w):
    width, s = w.shape[0], u.shape[1]
    ext = jnp.concatenate([hist.astype(u.dtype), u], axis=1)
    out = w[0] * ext[:, :s]
    for j in range(1, width):
        out = out + w[j] * ext[:, j:j + s]
    return out, ext[:, s:]


def _masked_softmax(s, mask):
    s = jnp.where(mask, s, -jnp.inf)
    m = jnp.max(s, axis=-1, keepdims=True)
    m = jnp.where(jnp.isfinite(m), m, 0.0)
    e = jnp.where(mask, jnp.exp(s - m), 0.0)
    den = jnp.sum(e, axis=-1, keepdims=True)
    return e / jnp.where(den > 0.0, den, 1.0)


def _gather_pages(pool, page_table, layer_idx):
    rows = pool[page_table, layer_idx]
    return rows.reshape(rows.shape[0], -1, *rows.shape[3:])


def _nsa_compress(rows, w1, b1, w2, pe):
    b, l, g, dh = rows.shape
    nc = l // CMP_BLOCK
    blk = rows[:, :nc * CMP_BLOCK].astype(jnp.float32).reshape(b, nc, CMP_BLOCK, g, dh) + pe[:, None, :]
    flat = blk.transpose(0, 1, 3, 2, 4).reshape(b, nc, g, CMP_BLOCK * dh)
    return jax.nn.gelu(flat @ w1 + b1) @ w2


def _nsa_compressed_kv(k_rows, v_rows, cw1, cb1, cw2, cpe):
    ck = _nsa_compress(k_rows, cw1[0], cb1[0], cw2[0], cpe[0])
    cv = _nsa_compress(v_rows, cw1[1], cb1[1], cw2[1], cpe[1])
    nc = ck.shape[1]
    ck = _rope(ck, (jnp.arange(nc) + 1) * CMP_BLOCK - 1)
    return ck, cv


def _nsa_attend(q, qpos, ck, cv, sk, sv, wk, wv, wpos):
    b, nq = q.shape[:2]
    scale = HEAD_DIM ** -0.5
    nc, ns = ck.shape[1], sk.shape[2]
    cend = (jnp.arange(nc) + 1) * CMP_BLOCK - 1
    s = jnp.einsum('bqghd,bcgd->bghqc', q, ck) * scale
    p_cmp = _masked_softmax(s, cend[None, :] <= qpos[:, None])
    o_cmp = jnp.einsum('bghqc,bcgd->bqghd', p_cmp, cv)
    imp = jnp.sum(p_cmp, axis=2)
    imp = jnp.pad(imp, ((0, 0), (0, 0), (0, 0), (0, ns * CMP_PER_SEL - nc)))
    imp = imp.reshape(b, NSA_KV_HEADS, nq, ns, CMP_PER_SEL).sum(-1)
    blk = jnp.arange(ns)[None, :]
    cur = (qpos // SEL_BLOCK)[:, None]
    forced = (blk == 0) | (blk == cur) | (blk == cur - 1)
    imp = jnp.where(blk <= cur, jnp.where(forced, NSA_FORCE, imp), -1.0)
    _, idx = lax.top_k(imp, min(NSA_TOPN, ns))
    n = idx.shape[-1]
    pick = jax.vmap(jax.vmap(lambda kb, ix: kb[ix]))
    ksel = pick(sk, idx).reshape(b, NSA_KV_HEADS, nq, n * SEL_BLOCK, HEAD_DIM)
    vsel = pick(sv, idx).reshape(b, NSA_KV_HEADS, nq, n * SEL_BLOCK, HEAD_DIM)
    kpos = (idx[..., None] * SEL_BLOCK + jnp.arange(SEL_BLOCK)).reshape(b, NSA_KV_HEADS, nq, n * SEL_BLOCK)
    s = jnp.einsum('bqghd,bgqkd->bghqk', q, ksel) * scale
    p = _masked_softmax(s, (kpos <= qpos[:, None])[:, :, None])
    o_slc = jnp.einsum('bghqk,bgqkd->bqghd', p, vsel)
    dist = qpos[:, None] - wpos[None, :]
    wmask = (dist >= 0) & (dist <= NSA_WINDOW) & (wpos[None, :] >= 0)
    s = jnp.einsum('bqghd,bkgd->bghqk', q, wk) * scale
    p = _masked_softmax(s, wmask)
    o_win = jnp.einsum('bghqk,bkgd->bqghd', p, wv)
    return o_cmp, o_slc, o_win


def _nsa_prompt(q, kc, vc, ks, vs, kw, vw, cw1, cb1, cw2, cpe):
    b, l = q.shape[:2]
    pos = jnp.arange(l)
    qr = _rope(q, pos).reshape(b, l, NSA_KV_HEADS, NSA_GROUP, HEAD_DIM)
    ck, cv = _nsa_compressed_kv(kc, vc, cw1, cb1, cw2, cpe)
    ksr = _rope(ks, pos)
    vsf = vs.astype(jnp.float32)
    ns = l // SEL_BLOCK
    to_blocks = lambda t: t.reshape(b, ns, SEL_BLOCK, NSA_KV_HEADS, HEAD_DIM).transpose(0, 3, 1, 2, 4)
    sk, sv = to_blocks(ksr), to_blocks(vsf)
    kwr = _rope(kw, pos)
    vwf = vw.astype(jnp.float32)
    pad = ((0, 0), (NSA_WINDOW, 0), (0, 0), (0, 0))
    wk, wv = jnp.pad(kwr, pad), jnp.pad(vwf, pad)
    span = NSA_WINDOW + NSA_QBLOCK

    def block(bi):
        s0 = bi * NSA_QBLOCK
        qpos = s0 + jnp.arange(NSA_QBLOCK)
        wpos = s0 - NSA_WINDOW + jnp.arange(span)
        return _nsa_attend(lax.dynamic_slice_in_dim(qr, s0, NSA_QBLOCK, axis=1), qpos, ck, cv, sk, sv,
                           lax.dynamic_slice_in_dim(wk, s0, span, axis=1),
                           lax.dynamic_slice_in_dim(wv, s0, span, axis=1), wpos)

    o_cmp, o_slc, o_win = lax.map(block, jnp.arange(l // NSA_QBLOCK))
    unblock = lambda o: jnp.moveaxis(o, 0, 1).reshape(b, l, NSA_HEADS, HEAD_DIM)
    keep = min(NSA_WINDOW, l)
    rows_cmp = jnp.stack([kc, vc], axis=2)
    rows_slc = jnp.stack([ksr, vsf], axis=2)
    rows_win = jnp.stack([kwr[:, l - keep:], vwf[:, l - keep:]], axis=2)
    return unblock(o_cmp), unblock(o_slc), unblock(o_win), rows_cmp, rows_slc, rows_win


def _nsa_sample(q, kc, vc, ks, vs, kw, vw, cmp_pool, slc_pool, layer_idx, win_buf, page_table, cw1, cb1, cw2, cpe):
    db, s = q.shape[:2]
    past = page_table.shape[1] * PAGE_SIZE
    l = past + s
    qpos = past + jnp.arange(s)
    qr = _rope(q, qpos).reshape(db, s, NSA_KV_HEADS, NSA_GROUP, HEAD_DIM)
    past_c = _gather_pages(cmp_pool, page_table, layer_idx)
    ck, cv = _nsa_compressed_kv(jnp.concatenate([past_c[:, :, 0], kc], axis=1),
                                jnp.concatenate([past_c[:, :, 1], vc], axis=1), cw1, cb1, cw2, cpe)
    ksr = _rope(ks, qpos)
    vsf = vs.astype(jnp.float32)
    past_s = _gather_pages(slc_pool, page_table, layer_idx)
    ns = -(-l // SEL_BLOCK)
    pad = ((0, 0), (0, ns * SEL_BLOCK - l), (0, 0), (0, 0))
    to_blocks = lambda t: jnp.pad(t.astype(jnp.float32), pad).reshape(
        db, ns, SEL_BLOCK, NSA_KV_HEADS, HEAD_DIM).transpose(0, 3, 1, 2, 4)
    sk = to_blocks(jnp.concatenate([past_s[:, :, 0], ksr], axis=1))
    sv = to_blocks(jnp.concatenate([past_s[:, :, 1], vsf], axis=1))
    kwr = _rope(kw, qpos)
    wb = win_buf.shape[1]
    wk = jnp.concatenate([win_buf[:, :, 0].astype(jnp.float32), kwr], axis=1)
    wv = jnp.concatenate([win_buf[:, :, 1].astype(jnp.float32), vw.astype(jnp.float32)], axis=1)
    wpos = past - wb + jnp.arange(wb + s)
    o_cmp, o_slc, o_win = _nsa_attend(qr, qpos, ck, cv, sk, sv, wk, wv, wpos)
    flat = lambda o: o.reshape(db, s, NSA_HEADS, HEAD_DIM)
    keep = min(NSA_WINDOW, l)
    rows_cmp = jnp.stack([kc, vc], axis=2)
    rows_slc = jnp.stack([ksr, vsf], axis=2)
    rows_win = jnp.stack([wk[:, wb + s - keep:], wv[:, wb + s - keep:]], axis=2)
    return flat(o_cmp), flat(o_slc), flat(o_win), rows_cmp, rows_slc, rows_win


def _gdn_chunked(q, k, v, g, beta, s0):
    b, l, h, dk = q.shape
    dv = v.shape[-1]
    c = GDN_CHUNK
    nch = l // c
    r = lambda a: jnp.moveaxis(a.reshape(b, nch, c, h, *a.shape[3:]), 3, 2)
    q, k, v, g, beta = r(q), r(k), r(v), r(g), r(beta)
    gc = jnp.cumsum(g, axis=-1)
    ii = jnp.arange(c)
    tri = ii[:, None] >= ii[None, :]
    strict = ii[:, None] > ii[None, :]
    diff = gc[..., :, None] - gc[..., None, :]
    gamma = jnp.where(tri, jnp.exp(jnp.where(tri, diff, 0.0)), 0.0)
    kb = k * beta[..., None]
    a_mat = jnp.where(strict, jnp.einsum('bnhik,bnhjk->bnhij', kb, k) * gamma, 0.0)
    eye = jnp.eye(c, dtype=jnp.float32)
    t_inv = lax.linalg.triangular_solve(eye + a_mat, jnp.broadcast_to(eye, a_mat.shape),
                                        left_side=True, lower=True, unit_diagonal=True)
    u = t_inv @ (v * beta[..., None])
    w = t_inv @ (kb * jnp.exp(gc)[..., None])
    qk = jnp.where(tri, jnp.einsum('bnhik,bnhjk->bnhij', q, k) * gamma, 0.0)
    qg = q * jnp.exp(gc)[..., None]
    kd = k * jnp.exp(gc[..., -1:] - gc)[..., None]
    glast = jnp.exp(gc[..., -1])

    def step(state, xs):
        qg_c, kd_c, u_c, w_c, qk_c, gl_c = xs
        v_new = u_c - jnp.einsum('bhck,bhkv->bhcv', w_c, state)
        o = jnp.einsum('bhck,bhkv->bhcv', qg_c, state) + jnp.einsum('bhij,bhjv->bhiv', qk_c, v_new)
        state = state * gl_c[..., None, None] + jnp.einsum('bhck,bhcv->bhkv', kd_c, v_new)
        return state, o

    xs = tuple(jnp.moveaxis(a, 1, 0) for a in (qg, kd, u, w, qk, glast))
    s_fin, o = lax.scan(step, s0, xs)
    o = jnp.moveaxis(jnp.moveaxis(o, 0, 1), 2, 3).reshape(b, l, h, dv)
    return o, s_fin


def _gdn_recurrent(q, k, v, g, beta, s0):
    def step(state, xs):
        q_t, k_t, v_t, g_t, b_t = xs
        state = state * jnp.exp(g_t)[..., None, None]
        v_t = (v_t - jnp.einsum('bhk,bhkv->bhv', k_t, state)) * b_t[..., None]
        state = state + jnp.einsum('bhk,bhv->bhkv', k_t, v_t)
        return state, jnp.einsum('bhk,bhkv->bhv', q_t, state)

    xs = tuple(jnp.moveaxis(a, 1, 0) for a in (q, k, v, g, beta))
    s_fin, o = lax.scan(step, s0, xs)
    return jnp.moveaxis(o, 0, 1), s_fin


def _gdn_mix(qkv, a, bt, z, conv_hist, s0, conv_w, a_log, dt_bias, norm_w, chunked):
    b, s = qkv.shape[:2]
    c, new_hist = _causal_dwconv(conv_hist, qkv, conv_w)
    c = jax.nn.silu(c.astype(jnp.float32))
    q, k, v = [t.reshape(b, s, GDN_HEADS, HEAD_DIM) for t in jnp.split(c, 3, axis=-1)]
    q = _l2_norm(q) * HEAD_DIM ** -0.5
    k = _l2_norm(k)
    beta = jax.nn.sigmoid(bt.astype(jnp.float32))
    g = -jnp.exp(a_log) * jax.nn.softplus(a.astype(jnp.float32) + dt_bias)
    s0 = s0.astype(jnp.float32)
    if chunked:
        o, s_fin = _gdn_chunked(q, k, v, g, beta, s0)
    else:
        o, s_fin = _gdn_recurrent(q, k, v, g, beta, s0)
    o = _rms_norm(o, norm_w) * jax.nn.silu(z.astype(jnp.float32).reshape(b, s, GDN_HEADS, HEAD_DIM))
    return o.reshape(b, s, GDN_W), new_hist, s_fin


def _even_merge(o_cmp, o_slc, o_win, gate, o_gdn, w_out):
    b, s = gate.shape[:2]
    gt = jax.nn.sigmoid(gate.astype(jnp.float32)).reshape(b, s, 3, NSA_HEADS, 1)
    o_nsa = gt[:, :, 0] * o_cmp + gt[:, :, 1] * o_slc + gt[:, :, 2] * o_win
    return jnp.concatenate([o_nsa.reshape(b, s, NSA_Q_W), o_gdn], axis=-1) @ w_out


def _even_prompt(x, w_in, cw1, cb1, cw2, cpe, conv_w, a_log, dt_bias, norm_w, w_out):
    b, l, _ = x.shape
    q, kc, vc, ks, vs, kw, vw, gate, qkv, a, bt, z = _split_cols(x @ w_in, _even_widths())
    heads = lambda t: t.reshape(b, l, -1, HEAD_DIM)
    o_cmp, o_slc, o_win, r_cmp, r_slc, r_win = _nsa_prompt(
        heads(q), heads(kc), heads(vc), heads(ks), heads(vs), heads(kw), heads(vw), cw1, cb1, cw2, cpe)
    hist0 = jnp.zeros((b, GDN_CONV - 1, 3 * GDN_W), qkv.dtype)
    s0 = jnp.zeros((b, GDN_HEADS, HEAD_DIM, HEAD_DIM), jnp.float32)
    o_gdn, conv_hist, s_fin = _gdn_mix(qkv, a, bt, z, hist0, s0, conv_w, a_log, dt_bias, norm_w, True)
    out = _even_merge(o_cmp, o_slc, o_win, gate, o_gdn, w_out)
    return out, r_cmp, r_slc, r_win, conv_hist, s_fin


def _even_sample(x, cmp_pool, slc_pool, layer_idx, win_buf, conv_hist, s0, page_table,
                 w_in, cw1, cb1, cw2, cpe, conv_w, a_log, dt_bias, norm_w, w_out):
    b, s, _ = x.shape
    q, kc, vc, ks, vs, kw, vw, gate, qkv, a, bt, z = _split_cols(x @ w_in, _even_widths())
    heads = lambda t: t.reshape(b, s, -1, HEAD_DIM)
    o_cmp, o_slc, o_win, r_cmp, r_slc, r_win = _nsa_sample(
        heads(q), heads(kc), heads(vc), heads(ks), heads(vs), heads(kw), heads(vw),
        cmp_pool, slc_pool, layer_idx, win_buf, page_table, cw1, cb1, cw2, cpe)
    o_gdn, new_hist, s_fin = _gdn_mix(qkv, a, bt, z, conv_hist, s0, conv_w, a_log, dt_bias, norm_w, False)
    out = _even_merge(o_cmp, o_slc, o_win, gate, o_gdn, w_out)
    return out, r_cmp, r_slc, r_win, new_hist, s_fin


def _dilated_band_stats(q, k, v, d):
    b, l, h, dh = q.shape
    unit = d * DIL_BLOCK
    lp = -(-l // unit) * unit
    nb = lp // unit
    to_sub = lambda a: jnp.pad(a, ((0, 0), (0, lp - l), (0, 0), (0, 0))).reshape(b, nb, DIL_BLOCK, d, h, dh)
    qs, ks, vs = to_sub(q), to_sub(k), to_sub(v)
    prev = lambda a: jnp.concatenate([jnp.zeros_like(a[:, :1]), a[:, :-1]], axis=1)
    kk = jnp.concatenate([prev(ks), ks], axis=2)
    vv = jnp.concatenate([prev(vs), vs], axis=2)
    s = jnp.einsum('bnirhd,bnjrhd->bnrhij', qs, kk) * HEAD_DIM ** -0.5
    i = jnp.arange(DIL_BLOCK)
    j = jnp.arange(2 * DIL_BLOCK) - DIL_BLOCK
    dist = i[:, None] - j[None, :]
    sub_k = jnp.arange(nb)[:, None, None] * DIL_BLOCK + j[None, None, :]
    mask = (dist >= 0)[None] & (dist <= DIL_SPAN)[None] & (sub_k >= 0)
    s = jnp.where(mask[None, :, None, None], s, -jnp.inf)
    m = jnp.max(s, axis=-1)
    e = jnp.exp(s - m[..., None])
    den = jnp.sum(e, axis=-1)
    num = jnp.einsum('bnrhij,bnjrhd->bnrhid', e, vv)
    m = jnp.transpose(m, (0, 1, 4, 2, 3)).reshape(b, lp, h)[:, :l]
    den = jnp.transpose(den, (0, 1, 4, 2, 3)).reshape(b, lp, h)[:, :l]
    num = jnp.transpose(num, (0, 1, 4, 2, 3, 5)).reshape(b, lp, h, dh)[:, :l]
    return m, den, num


def _dilated_gather_stats(q, k_all, v_all, qpos, kpos0, d):
    kp = qpos[:, None] - jnp.arange(DIL_SPAN + 1)[None, :] * d
    idx = kp - kpos0
    valid = idx >= 0
    idxc = jnp.clip(idx, 0)
    kg, vg = k_all[:, idxc], v_all[:, idxc]
    s = jnp.einsum('bshd,bsmhd->bshm', q, kg) * HEAD_DIM ** -0.5
    s = jnp.where(valid[None, :, None, :], s, -jnp.inf)
    m = jnp.max(s, axis=-1)
    e = jnp.exp(s - m[..., None])
    return m, jnp.sum(e, axis=-1), jnp.einsum('bshm,bsmhd->bshd', e, vg)


def _combine_by_denominators(stats):
    m_all = stats[0][0]
    for m, _, _ in stats[1:]:
        m_all = jnp.maximum(m_all, m)
    num, den = None, None
    for m, dn, nm in stats:
        w = jnp.exp(m - m_all)
        num = w[..., None] * nm if num is None else num + w[..., None] * nm
        den = w * dn if den is None else den + w * dn
    return num / den[..., None]


def _dil_prompt(x, w_in, w_out):
    b, l, _ = x.shape
    q, k, v = [t.reshape(b, l, DIL_HEADS, HEAD_DIM) for t in jnp.split(x @ w_in, 3, axis=-1)]
    pos = jnp.arange(l)
    qr, kr, vf = _rope(q, pos), _rope(k, pos), v.astype(jnp.float32)
    o = _combine_by_denominators([_dilated_band_stats(qr, kr, vf, d) for _, d in DIL_GROUPS])
    keep = min(DIL_MAX_WINDOW, l)
    buf = jnp.stack([kr[:, l - keep:], vf[:, l - keep:]], axis=2)
    return o.reshape(b, l, DIL_W) @ w_out, buf


def _dil_sample(x, buf, past, w_in, w_out):
    db, s, _ = x.shape
    q, k, v = [t.reshape(db, s, DIL_HEADS, HEAD_DIM) for t in jnp.split(x @ w_in, 3, axis=-1)]
    qpos = past + jnp.arange(s)
    qr, kr = _rope(q, qpos), _rope(k, qpos)
    wb = buf.shape[1]
    k_all = jnp.concatenate([buf[:, :, 0].astype(jnp.float32), kr], axis=1)
    v_all = jnp.concatenate([buf[:, :, 1].astype(jnp.float32), v.astype(jnp.float32)], axis=1)
    o = _combine_by_denominators(
        [_dilated_gather_stats(qr, k_all, v_all, qpos, past - wb, d) for _, d in DIL_GROUPS])
    keep = min(DIL_MAX_WINDOW, past + s)
    new_buf = jnp.stack([k_all[:, wb + s - keep:], v_all[:, wb + s - keep:]], axis=2)
    return o.reshape(db, s, DIL_W) @ w_out, new_buf


def _conv_ffn(x, hist, w_in, conv_w, conv_b, w_out):
    u = x @ w_in
    c, new_hist = _causal_dwconv(hist, u, conv_w)
    a, g = jnp.split(c + conv_b, 2, axis=-1)
    return (jax.nn.silu(a) * g) @ w_out, new_hist


def setup_inputs(seed: int = 0) -> dict:
    key = jax.random.key(seed)
    keys = iter(jax.random.split(key, 40))

    def nrm(shape, scale):
        return jax.random.normal(next(keys), shape, jnp.float32) * scale

    n_pages = PAST_LEN // PAGE_SIZE
    n_pool = (DEC_BATCH * n_pages * 5) // 4
    win_buf = min(NSA_WINDOW, PAST_LEN)
    dil_buf = min(DIL_MAX_WINDOW, PAST_LEN)
    x_prompt = nrm((BATCH, SEQ, D_MODEL), 1.0)
    x_sample = nrm((DEC_BATCH, DEC_SEQ, D_MODEL), 1.0)
    cache_nsa_cmp_kv = nrm((n_pool, N_A_LAYERS, PAGE_SIZE, 2, NSA_KV_HEADS, HEAD_DIM), 1.0)
    cache_nsa_slc_kv = nrm((n_pool, N_A_LAYERS, PAGE_SIZE, 2, NSA_KV_HEADS, HEAD_DIM), 1.0)
    state_nsa_win_kv = nrm((DEC_BATCH, N_A_LAYERS, win_buf, 2, NSA_KV_HEADS, HEAD_DIM), 1.0)
    state_gdn_conv = nrm((DEC_BATCH, N_A_LAYERS, GDN_CONV - 1, 3 * GDN_W), 1.0)
    state_gdn_S = nrm((DEC_BATCH, N_A_LAYERS, GDN_HEADS, HEAD_DIM, HEAD_DIM), 0.1)
    state_dil_kv = nrm((DEC_BATCH, N_C_LAYERS, dil_buf, 2, DIL_HEADS, HEAD_DIM), 1.0)
    state_ffn_conv = nrm((DEC_BATCH, DEPTH, FFN_CONV - 1, 2 * D_FF), 1.0)
    page_table = jax.random.permutation(next(keys), n_pool)[:DEC_BATCH * n_pages].reshape(
        DEC_BATCH, n_pages).astype(jnp.int32)
    w_in_a = nrm((N_A_LAYERS, D_MODEL, PROJ_A_W), D_MODEL ** -0.5)
    nsa_cmp_w1 = nrm((N_A_LAYERS, 2, CMP_BLOCK * HEAD_DIM, CMP_HIDDEN), (CMP_BLOCK * HEAD_DIM) ** -0.5)
    nsa_cmp_b1 = nrm((N_A_LAYERS, 2, CMP_HIDDEN), 0.02)
    nsa_cmp_w2 = nrm((N_A_LAYERS, 2, CMP_HIDDEN, HEAD_DIM), CMP_HIDDEN ** -0.5)
    nsa_cmp_pe = nrm((N_A_LAYERS, 2, CMP_BLOCK, HEAD_DIM), 0.1)
    gdn_conv_w = nrm((N_A_LAYERS, GDN_CONV, 3 * GDN_W), GDN_CONV ** -0.5)
    gdn_A_log = jnp.log(jax.random.uniform(next(keys), (N_A_LAYERS, GDN_HEADS), jnp.float32, 1.0, 16.0))
    dt = jnp.exp(jax.random.uniform(next(keys), (N_A_LAYERS, GDN_HEADS), jnp.float32,
                                    math.log(1e-3), math.log(1e-1)))
    gdn_dt_bias = dt + jnp.log(-jnp.expm1(-dt))
    gdn_norm_w = 1.0 + nrm((N_A_LAYERS, HEAD_DIM), 0.02)
    w_out_a = nrm((N_A_LAYERS, NSA_Q_W + GDN_W, D_MODEL), (NSA_Q_W + GDN_W) ** -0.5 * DEEPNORM_BETA)
    w_in_c = nrm((N_C_LAYERS, D_MODEL, 3 * DIL_W), D_MODEL ** -0.5)
    w_out_c = nrm((N_C_LAYERS, DIL_W, D_MODEL), DIL_W ** -0.5 * DEEPNORM_BETA)
    ln_mix_g = 1.0 + nrm((DEPTH, D_MODEL), 0.02)
    ln_mix_b = nrm((DEPTH, D_MODEL), 0.02)
    ffn_w_in = nrm((DEPTH, D_MODEL, 2 * D_FF), D_MODEL ** -0.5)
    ffn_conv_w = nrm((DEPTH, FFN_CONV, 2 * D_FF), FFN_CONV ** -0.5)
    ffn_conv_b = nrm((DEPTH, 2 * D_FF), 0.02)
    ffn_w_out = nrm((DEPTH, D_FF, D_MODEL), D_FF ** -0.5 * DEEPNORM_BETA)
    ln_ffn_g = 1.0 + nrm((DEPTH, D_MODEL), 0.02)
    ln_ffn_b = nrm((DEPTH, D_MODEL), 0.02)
    return {'x_prompt': x_prompt, 'x_sample': x_sample,
            'cache_nsa_cmp_kv': cache_nsa_cmp_kv, 'cache_nsa_slc_kv': cache_nsa_slc_kv,
            'state_nsa_win_kv': state_nsa_win_kv, 'state_gdn_conv': state_gdn_conv, 'state_gdn_S': state_gdn_S,
            'state_dil_kv': state_dil_kv, 'state_ffn_conv': state_ffn_conv, 'page_table': page_table,
            'w_in_a': w_in_a, 'nsa_cmp_w1': nsa_cmp_w1, 'nsa_cmp_b1': nsa_cmp_b1, 'nsa_cmp_w2': nsa_cmp_w2,
            'nsa_cmp_pe': nsa_cmp_pe, 'gdn_conv_w': gdn_conv_w, 'gdn_A_log': gdn_A_log, 'gdn_dt_bias': gdn_dt_bias,
            'gdn_norm_w': gdn_norm_w, 'w_out_a': w_out_a, 'w_in_c': w_in_c, 'w_out_c': w_out_c,
            'ln_mix_g': ln_mix_g, 'ln_mix_b': ln_mix_b, 'ffn_w_in': ffn_w_in, 'ffn_conv_w': ffn_conv_w,
            'ffn_conv_b': ffn_conv_b, 'ffn_w_out': ffn_w_out, 'ln_ffn_g': ln_ffn_g, 'ln_ffn_b': ln_ffn_b}


def reference(x_prompt, x_sample, cache_nsa_cmp_kv, cache_nsa_slc_kv, state_nsa_win_kv, state_gdn_conv,
              state_gdn_S, state_dil_kv, state_ffn_conv, page_table, w_in_a, nsa_cmp_w1, nsa_cmp_b1, nsa_cmp_w2,
              nsa_cmp_pe, gdn_conv_w, gdn_A_log, gdn_dt_bias, gdn_norm_w, w_out_a, w_in_c, w_out_c,
              ln_mix_g, ln_mix_b, ffn_w_in, ffn_conv_w, ffn_conv_b, ffn_w_out, ln_ffn_g, ln_ffn_b):
    past = page_table.shape[1] * PAGE_SIZE
    xp, xs = x_prompt, x_sample
    cmp_p, cmp_s, slc_p, slc_s, win_p, win_s = [], [], [], [], [], []
    gconv_p, gconv_s, gstate_p, gstate_s = [], [], [], []
    dil_p, dil_s, ffn_p, ffn_s = [], [], [], []
    for layer in range(DEPTH):
        if layer % 2 == 0:
            la = layer // 2
            wa = (w_in_a[la], nsa_cmp_w1[la], nsa_cmp_b1[la], nsa_cmp_w2[la], nsa_cmp_pe[la],
                  gdn_conv_w[la], gdn_A_log[la], gdn_dt_bias[la], gdn_norm_w[la], w_out_a[la])
            mp, rc, rs, rw, hc, hs_ = _even_prompt(xp, *wa)
            cmp_p.append(rc); slc_p.append(rs); win_p.append(rw); gconv_p.append(hc); gstate_p.append(hs_)
            ms, rc, rs, rw, hc, hs_ = _even_sample(xs, cache_nsa_cmp_kv, cache_nsa_slc_kv, la,
                                                   state_nsa_win_kv[:, la], state_gdn_conv[:, la],
                                                   state_gdn_S[:, la], page_table, *wa)
            cmp_s.append(rc); slc_s.append(rs); win_s.append(rw); gconv_s.append(hc); gstate_s.append(hs_)
        else:
            lc = layer // 2
            mp, bp = _dil_prompt(xp, w_in_c[lc], w_out_c[lc])
            ms, bs = _dil_sample(xs, state_dil_kv[:, lc], past, w_in_c[lc], w_out_c[lc])
            dil_p.append(bp); dil_s.append(bs)
        xp = _layer_norm(DEEPNORM_ALPHA * xp + mp, ln_mix_g[layer], ln_mix_b[layer])
        xs = _layer_norm(DEEPNORM_ALPHA * xs + ms, ln_mix_g[layer], ln_mix_b[layer])
        hist0 = jnp.zeros((xp.shape[0], FFN_CONV - 1, 2 * D_FF), xp.dtype)
        fp, hp = _conv_ffn(xp, hist0, ffn_w_in[layer], ffn_conv_w[layer], ffn_conv_b[layer], ffn_w_out[layer])
        fs, hs = _conv_ffn(xs, state_ffn_conv[:, layer], ffn_w_in[layer], ffn_conv_w[layer], ffn_conv_b[layer],
                           ffn_w_out[layer])
        xp = _layer_norm(DEEPNORM_ALPHA * xp + fp, ln_ffn_g[layer], ln_ffn_b[layer])
        xs = _layer_norm(DEEPNORM_ALPHA * xs + fs, ln_ffn_g[layer], ln_ffn_b[layer])
        ffn_p.append(hp); ffn_s.append(hs)

    def stk(lst):
        return jnp.stack(lst, axis=1)

    return (xp, xs, stk(cmp_p), stk(cmp_s), stk(slc_p), stk(slc_s), stk(win_p), stk(win_s),
            stk(gconv_p), stk(gconv_s), stk(gstate_p), stk(gstate_s), stk(dil_p), stk(dil_s),
            stk(ffn_p), stk(ffn_s))
```

```cpp
#include <hip/hip_runtime.h>
#include <cstdint>
#include <cstdio>
#include <cmath>

namespace pg8 {
#define PG8_LAS __attribute__((address_space(3)))
typedef unsigned short bf16_t;
typedef short bf16x8 __attribute__((ext_vector_type(8)));
typedef float f32x4 __attribute__((ext_vector_type(4)));
typedef unsigned u32x4 __attribute__((ext_vector_type(4)));
constexpr int BM = 256, BK = 64, HALF = 128, HTB = HALF * BK * 2  , STAGE_BYTES = 8 * HTB, NXCD = 8, WGM = 8;

__host__ __device__ __forceinline__ int lds_byte(int r, int c) { const int st = (r >> 4) * 2 + (c >> 5), rr = r & 15, cc = c & 31, ob = rr * 64 + cc * 2; return st * 1024 + (ob ^ (((ob >> 9) & 1) << 5)); }
__host__ __device__ __forceinline__ void stage_rc(int b, int& R, int& C) { const int st = b / 1024, sb = b % 1024, swz = sb ^ (((sb >> 9) & 1) << 5); R = (st >> 1) * 16 + swz / 64; C = (st & 1) * 32 + (swz % 64) / 2; }
__host__ __device__ __forceinline__ int perm32(int rho) { const int n = rho >> 4, i = rho & 15; return 8 * (i >> 2) + 4 * n + (i & 3); }

struct Unit { int pm, pn; };
struct Gemm { const bf16_t* A; const bf16_t* Bt; int M, N, K; };

struct StaticOrder {
    int nM, nN, nwg, G, c;
    __host__ __device__ void init(int M, int N, int G_, int c_) { nM = M / BM; nN = N / BM; nwg = nM * nN; G = G_; c = c_; }
    __host__ __device__ bool next(int i, Unit& u) const {
        const long L = (long)i * G + c; if (L >= nwg) return false;
        int wgid = (int)L; { const int q = nwg / NXCD, r = nwg % NXCD, xcd = wgid % NXCD, off = wgid / NXCD; wgid = (xcd < r ? xcd * (q + 1) : r * (q + 1) + (xcd - r) * q) + off; }
        const int nig = WGM * nN, gid = wgid / nig, fm = gid * WGM, gsz = (nM - fm) < WGM ? (nM - fm) : WGM;
        u.pm = fm + ((wgid % nig) % gsz); u.pn = (wgid % nig) / gsz; return true;
    }
    __device__ __forceinline__ void a_ready(const Unit&) const {}
    __device__ __forceinline__ void done(const Unit&) const {}
};

__device__ __forceinline__ unsigned cvt_pk_bf16(float lo, float hi) { unsigned r; asm volatile("v_cvt_pk_bf16_f32 %0, %1, %2" : "=v"(r) : "v"(lo), "v"(hi)); return r; }
typedef float f32x2 __attribute__((ext_vector_type(2)));
__device__ __forceinline__ f32x2 gelu_pk(f32x2 v) {
    const f32x2 av = __builtin_elementwise_abs(v), d = av * 0.2316418882f + 1.0f;
    f32x2 t; t.x = __builtin_amdgcn_rcpf(d.x); t.y = __builtin_amdgcn_rcpf(d.y);
    f32x2 q = t * 0.5307027145f + (-0.7265760135f); q = q * t + 0.7107068705f; q = q * t + (-0.142248368f); q = q * t + 0.127414796f; q = q * t;
    const f32x2 s = (v * v) * (-0.72134752044f);
    f32x2 e; e.x = __builtin_amdgcn_exp2f(s.x); e.y = __builtin_amdgcn_exp2f(s.y);
    const f32x2 m = v * (q * e), r = v - m;
    f32x2 o; o.x = v.x < 0.f ? m.x : r.x; o.y = v.y < 0.f ? m.y : r.y; return o;
}

template <int ACT  > struct EpiBf16 {
    static constexpr bool PERM = true, AFTER_DRAIN = false; static_assert(ACT == 0 || ACT == 1, "EpiBf16: ACT is 0 (none) or 1 (gelu_pk)");
    bf16_t* O; int ldc; const float* bias; int split_cols; size_t split_stride; float scale0;
    __device__ __forceinline__ void operator()(const f32x4 (&acc)[2][2][4][2], const Unit& u, int wr, int wc, int fr, int fq) const {
        const int row0 = u.pm * BM + wr * 64 + fr; int colt = u.pn * BM; bf16_t* base = O;
        float sc = 1.f; if (split_cols) { const int t = colt / split_cols; base += (size_t)t * split_stride; colt -= t * split_cols; if (t == 0) sc = scale0; }
        const int col0 = colt + wc * 32 + 8 * fq, bcol0 = u.pn * BM + wc * 32 + 8 * fq;
        f32x4 bv[2][2];
#pragma unroll
        for (int bj = 0; bj < 2; ++bj)
#pragma unroll
            for (int n = 0; n < 2; ++n) bv[bj][n] = bias ? *(const f32x4*)(bias + bcol0 + bj * HALF + 4 * n) : (f32x4){0.f, 0.f, 0.f, 0.f};
#pragma unroll
        for (int ai = 0; ai < 2; ++ai)
#pragma unroll
            for (int m = 0; m < 4; ++m) { bf16_t* rowp = base + (size_t)(row0 + ai * HALF + m * 16) * ldc + col0;
#pragma unroll
                for (int bj = 0; bj < 2; ++bj) { f32x4 v0 = acc[ai][bj][m][0] + bv[bj][0], v1 = acc[ai][bj][m][1] + bv[bj][1];
                    if (ACT == 1) { f32x2 a = gelu_pk((f32x2){v0[0], v0[1]}), b = gelu_pk((f32x2){v0[2], v0[3]}), c = gelu_pk((f32x2){v1[0], v1[1]}), d = gelu_pk((f32x2){v1[2], v1[3]});
                        v0 = (f32x4){a.x, a.y, b.x, b.y}; v1 = (f32x4){c.x, c.y, d.x, d.y}; }
                    v0 = v0 * sc; v1 = v1 * sc; u32x4 w; w.x = cvt_pk_bf16(v0[0], v0[1]); w.y = cvt_pk_bf16(v0[2], v0[3]); w.z = cvt_pk_bf16(v1[0], v1[1]); w.w = cvt_pk_bf16(v1[2], v1[3]);
                    *(u32x4*)(rowp + bj * HALF) = w; } }
    }
};

struct EpiF32 {
    static constexpr bool PERM = false, AFTER_DRAIN = false;
    float* O; int ldc; int ncols;
    __device__ __forceinline__ void operator()(const f32x4 (&acc)[2][2][4][2], const Unit& u, int wr, int wc, int fr, int fq) const {
        const int row0 = u.pm * BM + wr * 64 + fr; const int col0 = u.pn * BM + wc * 32 + 4 * fq;
#pragma unroll
        for (int ai = 0; ai < 2; ++ai)
#pragma unroll
            for (int m = 0; m < 4; ++m) { float* rowp = O + (size_t)(row0 + ai * HALF + m * 16) * ldc;
#pragma unroll
                for (int bj = 0; bj < 2; ++bj)
#pragma unroll
                    for (int n = 0; n < 2; ++n) { const int c = col0 + bj * HALF + n * 16; if (c < ncols) *(f32x4*)(rowp + c) = acc[ai][bj][m][n]; } }
    }
};
template <class Epi, class Sched, bool ALIGN_EPI = false, bool SP2 = false>
__device__ __forceinline__ void gemm_phase(PG8_LAS unsigned char* lds, const Gemm g, const Sched& S, const Epi& E) {
    const int tid = threadIdx.x, wid = __builtin_amdgcn_readfirstlane(tid >> 6), lane = tid & 63, wr = wid >> 2, wc = wid & 3, fr = lane & 15, fq = lane >> 4;
    const int K = g.K, nt = K / BK;
    unsigned voffA[2], voffB[2];
#pragma unroll
    for (int i = 0; i < 2; ++i) { int R, C; stage_rc(tid * 16 + i * 8192, R, C); const int Rb = Epi::PERM ? ((R & ~31) + perm32(R & 31)) : R;
        voffA[i] = (unsigned)(R * K + C) * 2u; voffB[i] = (unsigned)(Rb * K + C) * 2u; }
    const size_t kstep = (size_t)(BK * 2);
    const size_t hstep = (size_t)HALF * K * 2;
    const size_t tstep = 2 * hstep;
    const unsigned ldsw = (unsigned)wid * 1024u;
    const int aoff = lds_byte(wr * 64 + fr, fq * 8), boff = lds_byte(wc * 32 + fr, fq * 8);
#define PG8_SA(b, h) (((b) * 2 + (h)) * HTB)
#define PG8_SB(b, h) ((4 + (b) * 2 + (h)) * HTB)
#define PG8_STAGE(bufoff, gbase, voff) do { _Pragma("unroll") for (int _i = 0; _i < 2; ++_i) \
        __builtin_amdgcn_global_load_lds((const unsigned*)((const char*)(gbase) + (voff)[_i]), (PG8_LAS unsigned*)(lds + (bufoff) + ldsw + _i * 8192), 16, 0, 0); } while (0)
#define PG8_LDA(dst, b, h) do { _Pragma("unroll") for (int m = 0; m < 4; ++m) _Pragma("unroll") for (int k = 0; k < 2; ++k) dst[m][k] = *(const PG8_LAS bf16x8*)(lds + PG8_SA(b, h) + aoff + m * 2048 + k * 1024); } while (0)
#define PG8_LDB(dst, b, h) do { _Pragma("unroll") for (int n = 0; n < 2; ++n) _Pragma("unroll") for (int k = 0; k < 2; ++k) dst[n][k] = *(const PG8_LAS bf16x8*)(lds + PG8_SB(b, h) + boff + n * 2048 + k * 1024); } while (0)
#define PG8_MMA(ai, bj, At, Bt) do { __builtin_amdgcn_s_setprio(1); _Pragma("unroll") for (int m = 0; m < 4; ++m) _Pragma("unroll") for (int n = 0; n < 2; ++n) _Pragma("unroll") for (int k = 0; k < 2; ++k) \
        acc[ai][bj][m][n] = __builtin_amdgcn_mfma_f32_16x16x32_bf16(Bt[n][k], At[m][k], acc[ai][bj][m][n], 0, 0, 0); __builtin_amdgcn_s_setprio(0); } while (0)
#define PG8_WAIT_V(n) asm volatile("s_waitcnt vmcnt(" #n ")" ::: "memory")
#define PG8_WAIT_L(n) asm volatile("s_waitcnt lgkmcnt(" #n ")" ::: "memory")
#define PG8_BAR __builtin_amdgcn_s_barrier()
#define PG8_SCHED __builtin_amdgcn_sched_barrier(0)
    Unit cur, nxt; int ui = 0;
    if (!S.next(0, cur)) return;
    f32x4 acc[2][2][4][2];
#pragma unroll
    for (int a = 0; a < 2; ++a)
#pragma unroll
        for (int b = 0; b < 2; ++b)
#pragma unroll
            for (int m = 0; m < 4; ++m)
#pragma unroll
                for (int n = 0; n < 2; ++n) acc[a][b][m][n] = (f32x4){0.f, 0.f, 0.f, 0.f};
    bf16x8 At[4][2], B0[2][2], B1[2][2];
    const char* cA = (const char*)g.A + (size_t)cur.pm * tstep; const char* cB = (const char*)g.Bt + (size_t)cur.pn * tstep;
    S.a_ready(cur);
    if constexpr (SP2) {
        PG8_STAGE(PG8_SB(0, 0), cB, voffB); PG8_STAGE(PG8_SB(0, 1), cB + hstep, voffB); PG8_STAGE(PG8_SA(0, 0), cA, voffA); PG8_STAGE(PG8_SA(0, 1), cA + hstep, voffA);
        if (wr == 1) PG8_BAR;
        PG8_WAIT_V(2); PG8_BAR;
        PG8_STAGE(PG8_SB(1, 0), cB + kstep, voffB); PG8_STAGE(PG8_SA(1, 0), cA + kstep, voffA); PG8_STAGE(PG8_SB(1, 1), cB + hstep + kstep, voffB);
        PG8_WAIT_V(6); PG8_BAR;
    } else {
        PG8_STAGE(PG8_SB(0, 0), cB, voffB); PG8_STAGE(PG8_SA(0, 0), cA, voffA); PG8_STAGE(PG8_SB(0, 1), cB + hstep, voffB); PG8_STAGE(PG8_SA(0, 1), cA + hstep, voffA);
        if (wr == 1) PG8_BAR;
        PG8_WAIT_V(4); PG8_BAR;
        PG8_STAGE(PG8_SB(1, 0), cB + kstep, voffB); PG8_STAGE(PG8_SA(1, 0), cA + kstep, voffA); PG8_STAGE(PG8_SB(1, 1), cB + hstep + kstep, voffB);
        PG8_WAIT_V(6); PG8_BAR;
    }
    for (;;) {
        const bool has_next = S.next(ui + 1, nxt);
        const char* nA = has_next ? (const char*)g.A + (size_t)nxt.pm * tstep : cA; const char* nB = has_next ? (const char*)g.Bt + (size_t)nxt.pn * tstep : cB;
        for (int t = 0; t < nt; t += 2) {
            const bool last = (t == nt - 2);
            const char* a1 = cA + (size_t)(t + 1) * kstep;
            const char* a2 = last ? nA : cA + (size_t)(t + 2) * kstep; const char* b2 = last ? nB : cB + (size_t)(t + 2) * kstep;
            const char* a3 = a2 + kstep; const char* b3 = b2 + kstep;
            if (last && has_next) S.a_ready(nxt);
            if constexpr (SP2) {
            PG8_LDB(B0, 0, 0); PG8_LDB(B1, 0, 1); PG8_SCHED; PG8_LDA(At, 0, 0); PG8_STAGE(PG8_SA(1, 1), a1 + hstep, voffA);
            PG8_WAIT_V(8); PG8_WAIT_L(0); PG8_BAR; PG8_MMA(0, 0, At, B0); PG8_MMA(0, 1, At, B1); PG8_BAR; PG8_SCHED;
            PG8_LDA(At, 0, 1); PG8_STAGE(PG8_SB(0, 0), b2, voffB); PG8_STAGE(PG8_SB(0, 1), b2 + hstep, voffB); PG8_STAGE(PG8_SA(0, 0), a2, voffA);
            PG8_WAIT_V(8); PG8_WAIT_L(0); PG8_BAR; PG8_MMA(1, 0, At, B0); PG8_MMA(1, 1, At, B1); PG8_BAR; PG8_SCHED;
            PG8_LDB(B0, 1, 0); PG8_LDB(B1, 1, 1); PG8_SCHED; PG8_LDA(At, 1, 0); PG8_STAGE(PG8_SA(0, 1), a2 + hstep, voffA);
            PG8_WAIT_V(8); PG8_WAIT_L(0); PG8_BAR; PG8_MMA(0, 0, At, B0); PG8_MMA(0, 1, At, B1); PG8_BAR; PG8_SCHED;
            PG8_LDA(At, 1, 1); PG8_STAGE(PG8_SB(1, 0), b3, voffB); PG8_STAGE(PG8_SB(1, 1), b3 + hstep, voffB); PG8_STAGE(PG8_SA(1, 0), a3, voffA);
            PG8_WAIT_V(8); PG8_WAIT_L(0); PG8_BAR; PG8_MMA(1, 0, At, B0); PG8_MMA(1, 1, At, B1); PG8_BAR; PG8_SCHED;
            } else {
            PG8_LDB(B0, 0, 0); PG8_SCHED; PG8_LDA(At, 0, 0); PG8_STAGE(PG8_SA(1, 1), a1 + hstep, voffA);
            PG8_WAIT_L(8); PG8_BAR; PG8_WAIT_L(0); PG8_MMA(0, 0, At, B0); PG8_BAR; PG8_SCHED;
            PG8_LDB(B1, 0, 1); PG8_STAGE(PG8_SB(0, 0), b2, voffB);
            PG8_BAR; PG8_WAIT_L(0); PG8_MMA(0, 1, At, B1); PG8_BAR;
            PG8_LDA(At, 0, 1); PG8_STAGE(PG8_SA(0, 0), a2, voffA);
            PG8_BAR; PG8_WAIT_L(0); PG8_MMA(1, 0, At, B0); PG8_BAR; PG8_SCHED;
            PG8_STAGE(PG8_SB(0, 1), b2 + hstep, voffB);
            PG8_WAIT_V(6); PG8_BAR; PG8_MMA(1, 1, At, B1); PG8_BAR;
            PG8_LDB(B0, 1, 0); PG8_SCHED; PG8_LDA(At, 1, 0); PG8_STAGE(PG8_SA(0, 1), a2 + hstep, voffA);
            PG8_WAIT_L(8); PG8_BAR; PG8_WAIT_L(0); PG8_MMA(0, 0, At, B0); PG8_BAR; PG8_SCHED;
            PG8_LDB(B1, 1, 1); PG8_STAGE(PG8_SB(1, 0), b3, voffB);
            PG8_BAR; PG8_WAIT_L(0); PG8_MMA(0, 1, At, B1); PG8_BAR;
            PG8_LDA(At, 1, 1); PG8_STAGE(PG8_SA(1, 0), a3, voffA);
            PG8_BAR; PG8_WAIT_L(0); PG8_MMA(1, 0, At, B0); PG8_BAR; PG8_SCHED;
            PG8_STAGE(PG8_SB(1, 1), b3 + hstep, voffB);
            PG8_WAIT_V(6); PG8_BAR; PG8_MMA(1, 1, At, B1); PG8_BAR;
            }
        }
        if constexpr (ALIGN_EPI) { if (wr == 0) PG8_BAR; }
        if constexpr (!Epi::AFTER_DRAIN) { E(acc, cur, wr, wc, fr, fq); S.done(cur); }
        if (!has_next) break;
#pragma unroll
        for (int a = 0; a < 2; ++a)
#pragma unroll
            for (int b = 0; b < 2; ++b)
#pragma unroll
                for (int m = 0; m < 4; ++m)
#pragma unroll
                    for (int n = 0; n < 2; ++n) acc[a][b][m][n] = (f32x4){0.f, 0.f, 0.f, 0.f};
        cur = nxt; cA = nA; cB = nB; ++ui;
        if constexpr (ALIGN_EPI) { if (wr == 1) PG8_BAR; }
    }
    PG8_WAIT_V(0);
    if constexpr (!ALIGN_EPI) { if (wr == 0) PG8_BAR; }
    PG8_BAR;
    if constexpr (Epi::AFTER_DRAIN) { E.fused(acc, cur, wr, wc, fr, fq, lds, wid, lane); S.done(cur); }
#undef PG8_SA
#undef PG8_SB
#undef PG8_STAGE
#undef PG8_LDA
#undef PG8_LDB
#undef PG8_MMA
#undef PG8_WAIT_V
#undef PG8_WAIT_L
#undef PG8_BAR
#undef PG8_SCHED
}
}

#define LAS __attribute__((address_space(3)))
#define XB_TMO      128
#define XB_XCNT(j)  (256  + 64 * (j))
#define XB_XSUB(j)  (1280 + 64 * (j))
#define XB_XGEN(j)  (2304 + 64 * (j))
#define XB_TOP      3328
#define XB_TOPGEN   3392
#define XCD_BAR_WORDS 3456
#define XB_SPIN_CAP (1u << 26)

__device__ __forceinline__ unsigned xb_ld(unsigned* p)              { return __hip_atomic_load(p, __ATOMIC_RELAXED, __HIP_MEMORY_SCOPE_AGENT); }
__device__ __forceinline__ unsigned xb_add(unsigned* p, unsigned v) { return __hip_atomic_fetch_add(p, v, __ATOMIC_RELAXED, __HIP_MEMORY_SCOPE_AGENT); }
__device__ __forceinline__ unsigned xb_xcc_id() { return (unsigned)__builtin_amdgcn_s_getreg((3 << 11) | 20) & 0xFu; }
#define XB_SPIN(cond, bar) do { unsigned _sp = 0; while (cond) { __builtin_amdgcn_s_sleep(1); \
    if ((++_sp & 255u) == 0u) { if (xb_ld(&(bar)[XB_TMO])) break; if (_sp > XB_SPIN_CAP) { atomicAdd(&(bar)[XB_TMO], 1u); break; } } } } while (0)

struct XcdBarrier {
    unsigned* bar; unsigned x;
    volatile LAS unsigned* st;
};

__device__ __forceinline__ XcdBarrier xcd_barrier_post(unsigned* bar, volatile LAS unsigned* st) {
    XcdBarrier b; b.bar = bar; b.x = xb_xcc_id(); b.st = st;
    if (threadIdx.x == 0) (void)xb_add(&bar[XB_XCNT(b.x)], 1u);
    return b;
}
__device__ __forceinline__ void xcd_barrier_complete(unsigned* bar, unsigned x, unsigned& nloc, unsigned& nx) {
    const unsigned G = gridDim.x * gridDim.y * gridDim.z;
    unsigned sum, cnt, mine, sp = 0u;
    for (;;) {
        sum = 0u; cnt = 0u; mine = 0u;
#pragma unroll
        for (unsigned j = 0; j < 16; ++j) { const unsigned c = xb_ld(&bar[XB_XCNT(j)]); sum += c; cnt += (c > 0u) ? 1u : 0u; mine = (j == x) ? c : mine; }
        if (sum == G) break;
        __builtin_amdgcn_s_sleep(1);
        if ((++sp & 255u) == 0u) { if (xb_ld(&bar[XB_TMO])) break; if (sp > XB_SPIN_CAP) { atomicAdd(&bar[XB_TMO], 1u); break; } }
    }
    nloc = mine > 0u ? mine : 1u; nx = cnt > 0u ? cnt : 1u;
}

__device__ __forceinline__ void xcd_barrier(const XcdBarrier& b) {
    asm volatile("s_waitcnt vmcnt(0)" ::: "memory");
    __syncthreads();
    if (threadIdx.x == 0) {
        unsigned* bar = b.bar;
        __builtin_amdgcn_s_waitcnt(0);
        unsigned nloc = b.st[0], nx = b.st[1];
        if (nloc == 0u) { xcd_barrier_complete(bar, b.x, nloc, nx); b.st[0] = nloc; b.st[1] = nx; }
        const unsigned old = xb_add(&bar[XB_XSUB(b.x)], 1u);
        const unsigned gen = old / nloc;
        if (old + 1u == (gen + 1u) * nloc) {
            __builtin_amdgcn_fence(__ATOMIC_RELEASE, "agent");
            asm volatile("s_waitcnt vmcnt(0)" ::: "memory");
            const unsigned og = xb_add(&bar[XB_TOP], 1u);
            const unsigned tg = og / nx;
            if (og + 1u == (tg + 1u) * nx) xb_add(&bar[XB_TOPGEN], 1u);
            else XB_SPIN(xb_ld(&bar[XB_TOPGEN]) == tg, bar);
            __builtin_amdgcn_fence(__ATOMIC_ACQUIRE, "agent");
            xb_add(&bar[XB_XGEN(b.x)], 1u);
            asm volatile("s_waitcnt vmcnt(0)" ::: "memory");
        } else {
            XB_SPIN(xb_ld(&bar[XB_XGEN(b.x)]) == gen, bar);
            __builtin_amdgcn_fence(__ATOMIC_ACQUIRE, "agent");
            asm volatile("s_waitcnt vmcnt(0)" ::: "memory");
        }
    }
    __syncthreads();
}

#ifndef PG8_SP2
#define PG8_SP2 true
#endif
#ifndef PG8_ALIGN
#define PG8_ALIGN true
#endif
#ifndef MK_PER_PHASE
#define MK_PER_PHASE 0
#endif

constexpr int T = 16384, NSMP = 32, TS = T + NSMP, TSP = T + 256, DM = 1024;
constexpr int PA = 3368, PAP = 3584;
constexpr int C_Q = 0, C_KC = 512, C_VC = 640, C_KS = 768, C_VS = 896, C_KW = 1024, C_VW = 1152, C_GATE = 1280,
              C_GQKV = 1304, C_A = 2840, C_BT = 2848, C_Z = 2856;
constexpr int DFF = 2816, DFF2 = 5632;
constexpr float DN_ALPHA = 1.4142135623730951f;
constexpr float LN_EPS = 1e-5f, NORM_EPS = 1e-6f;
constexpr int NPAGES = 128;
constexpr int NWAVES = 8, NTHR = 512;

constexpr size_t O_Y_P = 0;
constexpr size_t O_Y_S = O_Y_P + (size_t)T * DM;
constexpr size_t O_CMP_P = O_Y_S + (size_t)NSMP * DM;
constexpr size_t O_CMP_S = O_CMP_P + (size_t)T * 256;
constexpr size_t O_SLC_P = O_CMP_S + (size_t)NSMP * 256;
constexpr size_t O_SLC_S = O_SLC_P + (size_t)T * 256;
constexpr size_t O_WIN_P = O_SLC_S + (size_t)NSMP * 256;
constexpr size_t O_WIN_S = O_WIN_P + (size_t)512 * 256;
constexpr size_t O_GCONV_P = O_WIN_S + (size_t)NSMP * 512 * 256;
constexpr size_t O_GCONV_S = O_GCONV_P + (size_t)3 * 1536;
constexpr size_t O_GS_P = O_GCONV_S + (size_t)NSMP * 3 * 1536;
constexpr size_t O_GS_S = O_GS_P + (size_t)8 * 64 * 64;
constexpr size_t O_DIL_P = O_GS_S + (size_t)NSMP * 8 * 64 * 64;
constexpr size_t O_DIL_S = O_DIL_P + (size_t)2048 * 2048;
constexpr size_t O_FFN_P = O_DIL_S + (size_t)NSMP * 2048 * 2048;
constexpr size_t O_FFN_S = O_FFN_P + (size_t)2 * 2 * DFF2;
constexpr size_t O_END = O_FFN_S + (size_t)NSMP * 2 * 2 * DFF2;

constexpr int RING_BYTES = 131072;
constexpr int MISC_OFF = RING_BYTES + 320;
constexpr int LDS_BYTES = 147456;

typedef unsigned short bf16;
typedef unsigned v4u __attribute__((ext_vector_type(4)));

__device__ __forceinline__ unsigned f2bf(float f) { unsigned u = __builtin_bit_cast(unsigned, f); return (u + 0x7fffu + ((u >> 16) & 1u)) >> 16; }
__device__ __forceinline__ unsigned pk2(float lo, float hi) { return f2bf(lo) | (f2bf(hi) << 16); }
__device__ __forceinline__ float wave_sum(float v) {
#pragma unroll
    for (int o = 1; o < 64; o <<= 1) v += __shfl_xor(v, o);
    return v;
}
__device__ __forceinline__ float wave_max(float v) {
#pragma unroll
    for (int o = 1; o < 64; o <<= 1) v = fmaxf(v, __shfl_xor(v, o));
    return v;
}
__device__ __forceinline__ void wave_lds_sync() { asm volatile("s_waitcnt lgkmcnt(0)" ::: "memory"); __builtin_amdgcn_wave_barrier(); asm volatile("" ::: "memory"); }
__device__ __forceinline__ float sigmoidf_(float x) { return 1.f / (1.f + expf(-x)); }
__device__ __forceinline__ float siluf_(float x) { return x / (1.f + expf(-x)); }
__device__ __forceinline__ float gelu_tanh(float x) { const float c = 0.7978845608028654f; return 0.5f * x * (1.f + tanhf(c * (x + 0.044715f * x * x * x))); }
__device__ __forceinline__ float softplusf_(float x) { return x > 20.f ? x : log1pf(expf(x)); }

struct KP {
    const float *x_prompt, *x_sample, *cache_cmp, *cache_slc, *st_win, *st_gconv, *st_gS, *st_dil, *st_ffn;
    const int* page_table;
    const float *w_in_a, *cw1, *cb1, *cw2, *cpe, *gconv_w, *gA, *gdt, *gnw, *w_out_a, *w_in_c, *w_out_c, *ln_mix_g, *ln_mix_b,
                *ffn_w_in, *ffn_cw, *ffn_cb, *ffn_w_out, *ln_ffn_g, *ln_ffn_b;
    float* out;
    unsigned* ctl;
    bf16 *WT_A, *WT_OA, *WT_FI0, *WT_FI1, *WT_FO0, *WT_FO1, *WT_CI, *WT_CO;
    float2* ROPE;
    bf16 *ACTB, *MIXB, *HFFB;
    float *BIGF, *MO, *X1, *X2, *X3, *QR, *KS, *VS, *KW, *VW, *CK, *CV, *GQ, *GK, *GV, *OG, *Gg, *Gb, *QD, *KD;
    int ph_lo, ph_hi;
};

struct Fr { unsigned char* lds; int tid, lane, wave, gw, NGW, bid, G; };

__device__ __forceinline__ void transpose_item(const float* W, int K, int N, int NT, bf16* WT, float* scr, int item, int lane) {
    const int nblk = NT / 32, kb = item / nblk, nb = item % nblk, k0 = 64 * kb, n0 = 32 * nb;
#pragma unroll 8
    for (int i = 0; i < 32; ++i) { const int kk = 2 * i + (lane >> 5); const int n = n0 + (lane & 31); scr[kk * 33 + (lane & 31)] = (n < N) ? W[(size_t)(k0 + kk) * N + n] : 0.f; }
    wave_lds_sync();
    const int c = lane & 7;
#pragma unroll
    for (int j = 0; j < 4; ++j) { const int n = (lane >> 3) + 8 * j; const float* s = scr + (8 * c) * 33 + n;
        v4u o; o.x = pk2(s[0 * 33], s[1 * 33]); o.y = pk2(s[2 * 33], s[3 * 33]); o.z = pk2(s[4 * 33], s[5 * 33]); o.w = pk2(s[6 * 33], s[7 * 33]);
        *(v4u*)(WT + (size_t)(n0 + n) * K + k0 + 8 * c) = o; }
    wave_lds_sync();
}
__device__ __forceinline__ void ph_prologue(const KP& p, const Fr& F) {
    float* scr = (float*)(F.lds + F.wave * 16384);
    const int I_A = 16 * (PAP / 32), I_OA = 16 * 32, I_FI = 16 * (DFF2 / 32), I_FO = (DFF / 64) * 32, I_CI = 16 * (3072 / 32), I_CO = 16 * 32;
    const int NITEMS = I_A + I_OA + 2 * I_FI + 2 * I_FO + I_CI + I_CO;
    for (int it = F.gw; it < NITEMS; it += F.NGW) {
        int r = it;
        if (r < I_A) { transpose_item(p.w_in_a, DM, PA, PAP, p.WT_A, scr, r, F.lane); continue; } r -= I_A;
        if (r < I_OA) { transpose_item(p.w_out_a, DM, DM, DM, p.WT_OA, scr, r, F.lane); continue; } r -= I_OA;
        if (r < I_FI) { transpose_item(p.ffn_w_in, DM, DFF2, DFF2, p.WT_FI0, scr, r, F.lane); continue; } r -= I_FI;
        if (r < I_FI) { transpose_item(p.ffn_w_in + (size_t)DM * DFF2, DM, DFF2, DFF2, p.WT_FI1, scr, r, F.lane); continue; } r -= I_FI;
        if (r < I_FO) { transpose_item(p.ffn_w_out, DFF, DM, DM, p.WT_FO0, scr, r, F.lane); continue; } r -= I_FO;
        if (r < I_FO) { transpose_item(p.ffn_w_out + (size_t)DFF * DM, DFF, DM, DM, p.WT_FO1, scr, r, F.lane); continue; } r -= I_FO;
        if (r < I_CI) { transpose_item(p.w_in_c, DM, 3072, 3072, p.WT_CI, scr, r, F.lane); continue; } r -= I_CI;
        transpose_item(p.w_out_c, DM, DM, DM, p.WT_CO, scr, r, F.lane);
    }
    const size_t gt = (size_t)F.bid * NTHR + F.tid, GT = (size_t)F.G * NTHR;
    for (size_t i4 = gt; i4 < (size_t)TSP * (DM / 4); i4 += GT) {
        const int r = (int)(i4 / (DM / 4)), c4 = (int)(i4 % (DM / 4));
        float4 v = make_float4(0.f, 0.f, 0.f, 0.f);
        if (r < T) v = ((const float4*)p.x_prompt)[(size_t)r * (DM / 4) + c4]; else if (r < TS) v = ((const float4*)p.x_sample)[(size_t)(r - T) * (DM / 4) + c4];
        uint2 o; o.x = pk2(v.x, v.y); o.y = pk2(v.z, v.w);
        ((uint2*)p.ACTB)[i4] = o;
    }
    for (size_t idx = gt; idx < (size_t)(T + 1) * 32; idx += GT) {
        const int pos = (int)(idx >> 5), i = (int)(idx & 31);
        const float inv = (float)pow(10000.0, -2.0 * (double)i / 64.0);
        const float ang = (float)pos * inv;
        p.ROPE[idx] = make_float2((float)cos((double)ang), (float)sin((double)ang));
    }
}

__device__ __forceinline__ void ph_gemm_f32(const Fr& F, const bf16* A, const bf16* Bt, int M, int N, int K, float* C, int ldc, int ncols) {
    pg8::Gemm g{A, Bt, M, N, K}; pg8::StaticOrder S; S.init(M, N, F.G, F.bid);
    pg8::EpiF32 E{C, ldc, ncols};
    pg8::gemm_phase<pg8::EpiF32, pg8::StaticOrder, PG8_ALIGN, PG8_SP2>((PG8_LAS unsigned char*)F.lds, g, S, E);
}

__device__ __forceinline__ float rope_val(const float* row, int base, int i, float2 cs) {
    const int ii = i & 31;
    const float x1 = row[base + ii], x2 = row[base + ii + 32];
    return (i < 32) ? (x1 * cs.x - x2 * cs.y) : (x2 * cs.x + x1 * cs.y);
}
__device__ __forceinline__ void ph_nsa_prep(const KP& p, const Fr& F) {
    const float* H0 = p.BIGF; float* out = p.out;
    const size_t gt = (size_t)F.bid * NTHR + F.tid, GT = (size_t)F.G * NTHR;
    const size_t total = (size_t)TS * 1280;
    for (size_t idx = gt; idx < total; idx += GT) {
        const int r = (int)(idx / 1280), c = (int)(idx % 1280);
        const bool smp = r >= T; const int b = r - T; const int pos = smp ? T : r;
        const float* row = H0 + (size_t)r * PA;
        const int i = c & 63;
        const float2 cs = p.ROPE[pos * 32 + (i & 31)];
        if (c < 512) { p.QR[(size_t)r * 512 + c] = rope_val(row, c & ~63, i, cs); continue; }
        const int sec = (c - 512) >> 7; const int gd = (c - 512) & 127; const int base = c & ~63;
        float v;
        if (sec == 2 || sec == 4) v = rope_val(row, base, i, cs); else v = row[c];
        const int kv = sec & 1;
        if (sec < 2) {
            if (!smp) out[O_CMP_P + (size_t)r * 256 + kv * 128 + gd] = v; else out[O_CMP_S + (size_t)b * 256 + kv * 128 + gd] = v;
        } else if (sec < 4) {
            if (!smp) out[O_SLC_P + (size_t)r * 256 + kv * 128 + gd] = v; else out[O_SLC_S + (size_t)b * 256 + kv * 128 + gd] = v;
            if (kv == 0) p.KS[(size_t)r * 128 + gd] = v; else p.VS[(size_t)r * 128 + gd] = v;
        } else {
            if (kv == 0) p.KW[(size_t)r * 128 + gd] = v; else p.VW[(size_t)r * 128 + gd] = v;
            if (!smp) { if (r >= T - 512) out[O_WIN_P + (size_t)(r - (T - 512)) * 256 + kv * 128 + gd] = v; }
            else out[O_WIN_S + ((size_t)b * 512 + 511) * 256 + kv * 128 + gd] = v;
        }
    }
    const size_t tot2 = (size_t)NSMP * 511 * 256;
    for (size_t idx = gt; idx < tot2; idx += GT) {
        const int b = (int)(idx / (511 * 256)); const int rem = (int)(idx % (511 * 256));
        out[O_WIN_S + (size_t)b * 512 * 256 + rem] = p.st_win[(size_t)b * 512 * 256 + 256 + rem];
    }
}

__device__ __forceinline__ void ph_compress(const KP& p, const Fr& F) {
    float* flat = (float*)F.lds;
    float* hid = (float*)(F.lds + 32768);
    float* res = (float*)(F.lds + 32768 + 2048);
    const float* H0 = p.BIGF;
    const int tid = F.tid;
    for (int item = F.bid; item < 33 * 512; item += F.G) {
        const int c = item & 511, s = item >> 9;
        for (int e = tid; e < 8192; e += NTHR) {
            const int kv = e >> 12, g = (e >> 11) & 1, k = e & 2047, i = k >> 6, d = k & 63;
            const int row = c * 32 + i;
            float v;
            if (s == 0) v = H0[(size_t)row * PA + C_KC + kv * 128 + g * 64 + d];
            else { const int b = s - 1; const int page = p.page_table[b * NPAGES + (row >> 7)];
                   v = p.cache_cmp[((((size_t)page * 128 + (row & 127)) * 2 + kv) * 2 + g) * 64 + d]; }
            flat[e] = v + p.cpe[(kv * 32 + i) * 64 + d];
        }
        __syncthreads();
        {
            const int kv = tid >> 8, g = (tid >> 7) & 1, j = tid & 127;
            const float* w = p.cw1 + (size_t)kv * 2048 * 128 + j;
            const float* fl = flat + (kv * 2 + g) * 2048;
            float acc = p.cb1[kv * 128 + j];
            for (int k = 0; k < 2048; ++k) acc += fl[k] * w[(size_t)k * 128];
            hid[(kv * 2 + g) * 128 + j] = gelu_tanh(acc);
        }
        __syncthreads();
        if (tid < 256) {
            const int kv = tid >> 7, g = (tid >> 6) & 1, d = tid & 63;
            const float* w = p.cw2 + (size_t)kv * 128 * 64 + d;
            const float* hh = hid + (kv * 2 + g) * 128;
            float acc = 0.f;
            for (int j = 0; j < 128; ++j) acc += hh[j] * w[j * 64];
            res[(kv * 2 + g) * 64 + d] = acc;
        }
        __syncthreads();
        if (tid < 256) {
            const int kv = tid >> 7, g = (tid >> 6) & 1, d = tid & 63;
            const float* rr = res + (kv * 2 + g) * 64;
            float v = rr[d];
            if (kv == 0) {
                const int pos = (c + 1) * 32 - 1; const float2 cs = p.ROPE[pos * 32 + (d & 31)];
                const float x1 = rr[d & 31], x2 = rr[(d & 31) + 32];
                v = (d < 32) ? (x1 * cs.x - x2 * cs.y) : (x2 * cs.x + x1 * cs.y);
                p.CK[(((size_t)s * 512 + c) * 2 + g) * 64 + d] = v;
            } else p.CV[(((size_t)s * 512 + c) * 2 + g) * 64 + d] = v;
        }
        __syncthreads();
    }
}

__device__ __forceinline__ void ph_gdn_prep(const KP& p, const Fr& F) {
    const float* H0 = p.BIGF; const int lane = F.lane;
    for (int item = F.gw; item < TS * 8; item += F.NGW) {
        const int r = item >> 3, h = item & 7;
        const bool smp = r >= T; const int b = r - T;
        float cv[3];
#pragma unroll
        for (int part = 0; part < 3; ++part) {
            const int ch = part * 512 + h * 64 + lane;
            float acc = 0.f;
#pragma unroll
            for (int j = 0; j < 4; ++j) {
                float u;
                if (!smp) { const int t = r + j - 3; u = (t >= 0) ? H0[(size_t)t * PA + C_GQKV + ch] : 0.f; }
                else { u = (j < 3) ? p.st_gconv[((size_t)b * 3 + j) * 1536 + ch] : H0[(size_t)r * PA + C_GQKV + ch]; }
                acc += p.gconv_w[j * 1536 + ch] * u;
            }
            cv[part] = siluf_(acc);
        }
        const float qn = wave_sum(cv[0] * cv[0]), kn = wave_sum(cv[1] * cv[1]);
        const size_t o = ((size_t)r * 8 + h) * 64 + lane;
        p.GQ[o] = cv[0] * rsqrtf(qn + NORM_EPS) * 0.125f;
        p.GK[o] = cv[1] * rsqrtf(kn + NORM_EPS);
        p.GV[o] = cv[2];
        if (lane == 0) {
            const float av = H0[(size_t)r * PA + C_A + h], bt = H0[(size_t)r * PA + C_BT + h];
            p.Gg[(size_t)r * 8 + h] = -expf(p.gA[h]) * softplusf_(av + p.gdt[h]);
            p.Gb[(size_t)r * 8 + h] = sigmoidf_(bt);
        }
    }
    const size_t gt = (size_t)F.bid * NTHR + F.tid, GT = (size_t)F.G * NTHR;
    for (size_t idx = gt; idx < (size_t)3 * 1536; idx += GT) {
        const int j = (int)(idx / 1536), ch = (int)(idx % 1536);
        p.out[O_GCONV_P + idx] = H0[(size_t)(T - 3 + j) * PA + C_GQKV + ch];
    }
    for (size_t idx = gt; idx < (size_t)NSMP * 3 * 1536; idx += GT) {
        const int b = (int)(idx / (3 * 1536)), j = (int)((idx / 1536) % 3), ch = (int)(idx % 1536);
        p.out[O_GCONV_S + idx] = (j < 2) ? p.st_gconv[((size_t)b * 3 + j + 1) * 1536 + ch] : H0[(size_t)(T + b) * PA + C_GQKV + ch];
    }
}

template <int NH, class KF>
__device__ __forceinline__ void wave_attend(const float* qs, float* sc, int scstride, int nkeys, KF kf, float (&outv)[NH], float (&den)[NH], int lane) {
    float mx[NH];
#pragma unroll
    for (int h = 0; h < NH; ++h) mx[h] = -INFINITY;
    for (int j = lane; j < nkeys; j += 64) {
        const float *kp, *vp; const bool ok = kf(j, kp, vp);
        float s[NH];
#pragma unroll
        for (int h = 0; h < NH; ++h) s[h] = 0.f;
        if (ok) {
            for (int d4 = 0; d4 < 16; ++d4) {
                const float4 kvv = ((const float4*)kp)[d4];
#pragma unroll
                for (int h = 0; h < NH; ++h) { const float* q = qs + h * 64 + d4 * 4; s[h] += kvv.x * q[0] + kvv.y * q[1] + kvv.z * q[2] + kvv.w * q[3]; }
            }
        }
#pragma unroll
        for (int h = 0; h < NH; ++h) { const float v = ok ? s[h] * 0.125f : -INFINITY; sc[h * scstride + j] = v; mx[h] = fmaxf(mx[h], v); }
    }
#pragma unroll
    for (int h = 0; h < NH; ++h) { mx[h] = wave_max(mx[h]); if (!(mx[h] > -INFINITY)) mx[h] = 0.f; }
    float sm[NH];
#pragma unroll
    for (int h = 0; h < NH; ++h) sm[h] = 0.f;
    for (int j = lane; j < nkeys; j += 64) {
#pragma unroll
        for (int h = 0; h < NH; ++h) { const float v = sc[h * scstride + j]; const float pp = (v == -INFINITY) ? 0.f : expf(v - mx[h]); sc[h * scstride + j] = pp; sm[h] += pp; }
    }
#pragma unroll
    for (int h = 0; h < NH; ++h) { sm[h] = wave_sum(sm[h]); den[h] = sm[h] > 0.f ? sm[h] : 1.f; }
    wave_lds_sync();
#pragma unroll
    for (int h = 0; h < NH; ++h) outv[h] = 0.f;
    for (int j = 0; j < nkeys; ++j) {
        const float *kp, *vp; const bool ok = kf(j, kp, vp);
        if (ok) { const float v = vp[lane];
#pragma unroll
            for (int h = 0; h < NH; ++h) outv[h] += sc[h * scstride + j] * v; }
    }
#pragma unroll
    for (int h = 0; h < NH; ++h) outv[h] /= den[h];
    wave_lds_sync();
}

__device__ __forceinline__ void nsa_item(const KP& p, int item, float* wl, int lane) {
    float* qs = wl; float* sc = wl + 256; float* imp = wl + 256 + 4 * 1088; int* sel = (int*)(wl + 256 + 4 * 1088 + 320);
    const float* H0 = p.BIGF;
    const int r = item >> 1, g = item & 1;
    const bool smp = r >= T; const int b = r - T; const int qpos = smp ? T : r;
#pragma unroll
    for (int h = 0; h < 4; ++h) qs[h * 64 + lane] = p.QR[(size_t)r * 512 + (g * 4 + h) * 64 + lane];
    wave_lds_sync();
    float ocmp[4], oslc[4], owin[4], den[4];
    {
        const int s = smp ? 1 + b : 0;
        const float* CKp = p.CK + (size_t)s * 512 * 128; const float* CVp = p.CV + (size_t)s * 512 * 128;
        int nk = (qpos + 1) / 32; if (nk > 512) nk = 512;
        auto kf = [&](int j, const float*& kp, const float*& vp) -> bool { kp = CKp + (j * 2 + g) * 64; vp = CVp + (j * 2 + g) * 64; return true; };
        wave_attend<4>(qs, sc, 1088, nk, kf, ocmp, den, lane);
        for (int blk = lane; blk < 320; blk += 64) {
            float v = 0.f;
#pragma unroll
            for (int h = 0; h < 4; ++h) {
                const int c0 = 2 * blk, c1 = 2 * blk + 1;
                if (c0 < nk) v += sc[h * 1088 + c0] / den[h];
                if (c1 < nk) v += sc[h * 1088 + c1] / den[h];
            }
            imp[blk] = v;
        }
        wave_lds_sync();
    }
    {
        const int cur = qpos >> 6; const int nv = cur + 1;
        if (nv <= 16) { if (lane < 16) sel[lane] = (lane < nv) ? lane : -1; }
        else {
            float val[5];
#pragma unroll
            for (int j = 0; j < 5; ++j) { const int blk = lane + 64 * j; val[j] = (blk >= 1 && blk <= cur - 2) ? imp[blk] : -1.f; }
            if (lane == 0) { sel[0] = 0; sel[1] = cur; sel[2] = cur - 1; }
            for (int n = 3; n < 16; ++n) {
                float bv = -2.f; int bi = 0x7fffffff;
#pragma unroll
                for (int j = 0; j < 5; ++j) if (val[j] > bv) { bv = val[j]; bi = lane + 64 * j; }
#pragma unroll
                for (int o = 1; o < 64; o <<= 1) { const float ov = __shfl_xor(bv, o); const int oi = __shfl_xor(bi, o); if (ov > bv || (ov == bv && oi < bi)) { bv = ov; bi = oi; } }
#pragma unroll
                for (int j = 0; j < 5; ++j) if (lane + 64 * j == bi) val[j] = -3.f;
                if (lane == 0) sel[n] = bi;
            }
        }
        wave_lds_sync();
    }
    {
        auto kf = [&](int j, const float*& kp, const float*& vp) -> bool {
            const int blk = sel[j >> 6]; if (blk < 0) return false;
            const int pos = blk * 64 + (j & 63); if (pos > qpos) return false;
            if (!smp) { kp = p.KS + (size_t)pos * 128 + g * 64; vp = p.VS + (size_t)pos * 128 + g * 64; return true; }
            if (pos == T) { kp = p.KS + (size_t)r * 128 + g * 64; vp = p.VS + (size_t)r * 128 + g * 64; return true; }
            const int page = p.page_table[b * NPAGES + (pos >> 7)];
            const float* base = p.cache_slc + ((size_t)page * 128 + (pos & 127)) * 256;
            kp = base + g * 64; vp = base + 128 + g * 64; return true; };
        wave_attend<4>(qs, sc, 1088, 1024, kf, oslc, den, lane);
    }
    {
        auto kf = [&](int j, const float*& kp, const float*& vp) -> bool {
            if (!smp) { const int pos = qpos - 512 + j; if (pos < 0) return false; kp = p.KW + (size_t)pos * 128 + g * 64; vp = p.VW + (size_t)pos * 128 + g * 64; return true; }
            if (j == 512) { kp = p.KW + (size_t)r * 128 + g * 64; vp = p.VW + (size_t)r * 128 + g * 64; return true; }
            const float* base = p.st_win + ((size_t)b * 512 + j) * 256;
            kp = base + g * 64; vp = base + 128 + g * 64; return true; };
        wave_attend<4>(qs, sc, 1088, 513, kf, owin, den, lane);
    }
    const float* grow = H0 + (size_t)r * PA + C_GATE;
#pragma unroll
    for (int h = 0; h < 4; ++h) {
        const int hh = g * 4 + h;
        const float o = sigmoidf_(grow[hh]) * ocmp[h] + sigmoidf_(grow[8 + hh]) * oslc[h] + sigmoidf_(grow[16 + hh]) * owin[h];
        p.MIXB[(size_t)r * 1024 + hh * 64 + lane] = (bf16)f2bf(o);
    }
    wave_lds_sync();
}

__device__ __forceinline__ void gdn_scan_item(const KP& p, int item, float* wl, int lane) {
    float* kq = wl;
    const int seq = item >> 3, h = item & 7;
    float S[64];
    if (seq == 0) {
#pragma unroll
        for (int i = 0; i < 64; ++i) S[i] = 0.f;
    } else {
#pragma unroll
        for (int i = 0; i < 64; ++i) S[i] = p.st_gS[(((size_t)(seq - 1) * 8 + h) * 64 + i) * 64 + lane];
    }
    const int r0 = seq == 0 ? 0 : T + seq - 1, n = seq == 0 ? T : 1;
    for (int t = 0; t < n; ++t) {
        const int r = r0 + t; const size_t o = ((size_t)r * 8 + h) * 64;
        wave_lds_sync();
        kq[lane] = p.GK[o + lane]; kq[64 + lane] = p.GQ[o + lane];
        wave_lds_sync();
        const float dec = expf(p.Gg[(size_t)r * 8 + h]), bt = p.Gb[(size_t)r * 8 + h];
        float kv = 0.f;
#pragma unroll
        for (int i = 0; i < 64; ++i) { S[i] *= dec; kv += kq[i] * S[i]; }
        const float vn = (p.GV[o + lane] - kv) * bt;
        float ov = 0.f;
#pragma unroll
        for (int i = 0; i < 64; ++i) { S[i] += kq[i] * vn; ov += kq[64 + i] * S[i]; }
        p.OG[o + lane] = ov;
    }
    float* so = (seq == 0) ? p.out + O_GS_P + (size_t)h * 4096 : p.out + O_GS_S + ((size_t)(seq - 1) * 8 + h) * 4096;
#pragma unroll
    for (int i = 0; i < 64; ++i) so[i * 64 + lane] = S[i];
}

__device__ __forceinline__ void ph_mix(const KP& p, const Fr& F) {
    if (F.bid < 33) gdn_scan_item(p, F.bid * 8 + F.wave, (float*)(F.lds + 81920 + F.wave * 512), F.lane);
    if (F.wave < 4) {
        float* wl = (float*)(F.lds + F.wave * 20480);
        for (int item = F.bid * 4 + F.wave; item < TS * 2; item += F.G * 4) nsa_item(p, item, wl, F.lane);
    }
}

__device__ __forceinline__ void ph_gdn_out(const KP& p, const Fr& F) {
    const float* H0 = p.BIGF; const int lane = F.lane;
    for (int item = F.gw; item < TS * 8; item += F.NGW) {
        const int r = item >> 3, h = item & 7;
        const float o = p.OG[((size_t)r * 8 + h) * 64 + lane];
        const float ms = wave_sum(o * o) * (1.f / 64.f);
        const float z = H0[(size_t)r * PA + C_Z + h * 64 + lane];
        p.MIXB[(size_t)r * 1024 + 512 + h * 64 + lane] = (bf16)f2bf(o * rsqrtf(ms + NORM_EPS) * p.gnw[lane] * siluf_(z));
    }
}

__device__ __forceinline__ void ph_ln(const Fr& F, const float* Xp, const float* Xs, const float* Fm, const float* gam, const float* bet, float* outp, float* outs, bf16* ob) {
    const int lane = F.lane;
    for (int r = F.gw; r < TS; r += F.NGW) {
        const float* xr = (r < T) ? Xp + (size_t)r * DM : Xs + (size_t)(r - T) * DM;
        float v[16]; float s = 0.f;
#pragma unroll
        for (int j = 0; j < 16; ++j) { const int c = lane + 64 * j; v[j] = DN_ALPHA * xr[c] + Fm[(size_t)r * DM + c]; s += v[j]; }
        const float mean = wave_sum(s) * (1.f / DM); float q = 0.f;
#pragma unroll
        for (int j = 0; j < 16; ++j) { v[j] -= mean; q += v[j] * v[j]; }
        const float rstd = rsqrtf(wave_sum(q) * (1.f / DM) + LN_EPS);
        float* o = (r < T) ? outp + (size_t)r * DM : outs + (size_t)(r - T) * DM;
#pragma unroll
        for (int j = 0; j < 16; ++j) { const int c = lane + 64 * j; const float y = v[j] * rstd * gam[c] + bet[c]; o[c] = y; if (ob) ob[(size_t)r * DM + c] = (bf16)f2bf(y); }
    }
}

__device__ __forceinline__ void ph_ffn_act(const KP& p, const Fr& F, int layer) {
    const float* U = p.BIGF; const float* cw = p.ffn_cw + (size_t)layer * 3 * DFF2; const float* cb = p.ffn_cb + (size_t)layer * DFF2;
    const size_t gt = (size_t)F.bid * NTHR + F.tid, GT = (size_t)F.G * NTHR;
    const size_t total = (size_t)TS * DFF;
    for (size_t idx = gt; idx < total; idx += GT) {
        const int r = (int)(idx / DFF), j = (int)(idx % DFF);
        const bool smp = r >= T; const int b = r - T;
        float c2[2];
#pragma unroll
        for (int half = 0; half < 2; ++half) {
            const int ch = half * DFF + j;
            float acc = cb[ch];
#pragma unroll
            for (int k = 0; k < 3; ++k) {
                float u;
                if (!smp) { const int t = r + k - 2; u = (t >= 0) ? U[(size_t)t * DFF2 + ch] : 0.f; }
                else u = (k < 2) ? p.st_ffn[(((size_t)b * 2 + layer) * 2 + k) * DFF2 + ch] : U[(size_t)r * DFF2 + ch];
                acc += cw[k * DFF2 + ch] * u;
            }
            c2[half] = acc;
        }
        p.HFFB[idx] = (bf16)f2bf(siluf_(c2[0]) * c2[1]);
    }
    for (size_t idx = gt; idx < (size_t)2 * DFF2; idx += GT) {
        const int k = (int)(idx / DFF2), ch = (int)(idx % DFF2);
        p.out[O_FFN_P + ((size_t)layer * 2 + k) * DFF2 + ch] = U[(size_t)(T - 2 + k) * DFF2 + ch];
    }
    for (size_t idx = gt; idx < (size_t)NSMP * 2 * DFF2; idx += GT) {
        const int b = (int)(idx / (2 * DFF2)), k = (int)((idx / DFF2) % 2), ch = (int)(idx % DFF2);
        p.out[O_FFN_S + (((size_t)b * 2 + layer) * 2 + k) * DFF2 + ch] =
            (k == 0) ? p.st_ffn[(((size_t)b * 2 + layer) * 2 + 1) * DFF2 + ch] : U[(size_t)(T + b) * DFF2 + ch];
    }
}

__device__ __forceinline__ void ph_dil_prep(const KP& p, const Fr& F) {
    const float* H1 = p.BIGF;
    const size_t gt = (size_t)F.bid * NTHR + F.tid, GT = (size_t)F.G * NTHR;
    const size_t total = (size_t)TS * 2048;
    for (size_t idx = gt; idx < total; idx += GT) {
        const int r = (int)(idx >> 11), c = (int)(idx & 2047);
        const bool smp = r >= T; const int pos = smp ? T : r;
        const float* row = H1 + (size_t)r * 3072;
        const int i = c & 63; const float2 cs = p.ROPE[pos * 32 + (i & 31)];
        const float v = rope_val(row, c & ~63, i, cs);
        if (c < 1024) p.QD[(size_t)r * 1024 + c] = v; else p.KD[(size_t)r * 1024 + (c - 1024)] = v;
    }
}
__device__ __forceinline__ void ph_dil_cache(const KP& p, const Fr& F) {
    const float* H1 = p.BIGF;
    const size_t gt = (size_t)F.bid * NTHR + F.tid, GT = (size_t)F.G * NTHR;
    const size_t totp = (size_t)2048 * 2048;
    for (size_t idx = gt; idx < totp; idx += GT) {
        const int i = (int)(idx >> 11), c = (int)(idx & 2047); const int t = T - 2048 + i;
        p.out[O_DIL_P + idx] = (c < 1024) ? p.KD[(size_t)t * 1024 + c] : H1[(size_t)t * 3072 + 2048 + (c - 1024)];
    }
    const size_t tots4 = (size_t)NSMP * 2048 * 512;
    for (size_t idx = gt; idx < tots4; idx += GT) {
        const int b = (int)(idx / (2048 * 512)); const int i = (int)((idx / 512) % 2048); const int c4 = (int)(idx % 512);
        float4 v;
        if (i < 2047) v = ((const float4*)p.st_dil)[((size_t)b * 2048 + i + 1) * 512 + c4];
        else { const int c = c4 * 4; const int r = T + b;
               v = (c < 1024) ? *(const float4*)(p.KD + (size_t)r * 1024 + c) : *(const float4*)(H1 + (size_t)r * 3072 + 2048 + (c - 1024)); }
        ((float4*)(p.out + O_DIL_S))[idx] = v;
    }
}
__device__ __forceinline__ void ph_dil_attn(const KP& p, const Fr& F) {
    const float* H1 = p.BIGF; const int lane = F.lane;
    float* qs = (float*)(F.lds + F.wave * 4096); float* sc = qs + 64;
    for (int item = F.gw; item < TS * 16; item += F.NGW) {
        const int r = item >> 4, h = item & 15;
        const bool smp = r >= T; const int b = r - T; const int qpos = smp ? T : r;
        qs[lane] = p.QD[(size_t)r * 1024 + h * 64 + lane];
        wave_lds_sync();
        auto kf = [&](int j, const float*& kp, const float*& vp) -> bool {
            const int gi = j / 129, m = j - gi * 129; const int dd = gi == 0 ? 1 : (gi == 1 ? 4 : 16);
            const int pos = qpos - m * dd; if (pos < 0) return false;
            if (!smp || pos == T) { const int rr = smp ? r : pos; kp = p.KD + (size_t)rr * 1024 + h * 64; vp = H1 + (size_t)rr * 3072 + 2048 + h * 64; return true; }
            const int bi = pos - (T - 2048);
            const float* base = p.st_dil + ((size_t)b * 2048 + bi) * 2048;
            kp = base + h * 64; vp = base + 1024 + h * 64; return true; };
        float o[1], den[1];
        wave_attend<1>(qs, sc, 448, 387, kf, o, den, lane);
        p.MIXB[(size_t)r * 1024 + h * 64 + lane] = (bf16)f2bf(o[0]);
        wave_lds_sync();
    }
}

constexpr int NPHASE = 20;
__global__ void __launch_bounds__(NTHR, 2) mega(KP p) {
    extern __shared__ __attribute__((aligned(16))) unsigned char lds[];
    Fr F; F.lds = lds; F.tid = threadIdx.x; F.lane = F.tid & 63; F.wave = __builtin_amdgcn_readfirstlane(F.tid >> 6);
    F.bid = blockIdx.x; F.G = gridDim.x; F.gw = F.bid * NWAVES + F.wave; F.NGW = F.G * NWAVES;
    for (int u = F.tid; u < (LDS_BYTES - RING_BYTES) / 4; u += NTHR) ((unsigned*)(lds + RING_BYTES))[u] = 0u;
    __syncthreads();
    XcdBarrier bar; bar.bar = p.ctl + 4096; bar.x = 0; bar.st = nullptr;
    if (!MK_PER_PHASE) bar = xcd_barrier_post(p.ctl + 4096, (volatile LAS unsigned*)(lds + MISC_OFF + 32));
    const int lo = p.ph_lo, hi = p.ph_hi;
#define IN(k) (lo <= (k) && (k) < hi)
#define SEAM(k) do { if (IN(k) && IN((k) + 1)) xcd_barrier(bar); } while (0)

    if (IN(0)) { ph_prologue(p, F); } SEAM(0);
    if (IN(1)) { ph_gemm_f32(F, p.ACTB, p.WT_A, TSP, PAP, DM, p.BIGF, PA, PA); } SEAM(1);
    if (IN(2)) { ph_nsa_prep(p, F); ph_compress(p, F); ph_gdn_prep(p, F); } SEAM(2);
    if (IN(3)) { ph_mix(p, F); } SEAM(3);
    if (IN(4)) { ph_gdn_out(p, F); } SEAM(4);
    if (IN(5)) { ph_gemm_f32(F, p.MIXB, p.WT_OA, TSP, DM, DM, p.MO, DM, DM); } SEAM(5);
    if (IN(6)) { ph_ln(F, p.x_prompt, p.x_sample, p.MO, p.ln_mix_g, p.ln_mix_b, p.X1, p.X1 + (size_t)T * DM, p.ACTB); } SEAM(6);
    if (IN(7)) { ph_gemm_f32(F, p.ACTB, p.WT_FI0, TSP, DFF2, DM, p.BIGF, DFF2, DFF2); } SEAM(7);
    if (IN(8)) { ph_ffn_act(p, F, 0); } SEAM(8);
    if (IN(9)) { ph_gemm_f32(F, p.HFFB, p.WT_FO0, TSP, DM, DFF, p.MO, DM, DM); } SEAM(9);
    if (IN(10)) { ph_ln(F, p.X1, p.X1 + (size_t)T * DM, p.MO, p.ln_ffn_g, p.ln_ffn_b, p.X2, p.X2 + (size_t)T * DM, p.ACTB); } SEAM(10);
    if (IN(11)) { ph_gemm_f32(F, p.ACTB, p.WT_CI, TSP, 3072, DM, p.BIGF, 3072, 3072); } SEAM(11);
    if (IN(12)) { ph_dil_prep(p, F); } SEAM(12);
    if (IN(13)) { ph_dil_cache(p, F); ph_dil_attn(p, F); } SEAM(13);
    if (IN(14)) { ph_gemm_f32(F, p.MIXB, p.WT_CO, TSP, DM, DM, p.MO, DM, DM); } SEAM(14);
    if (IN(15)) { ph_ln(F, p.X2, p.X2 + (size_t)T * DM, p.MO, p.ln_mix_g + DM, p.ln_mix_b + DM, p.X3, p.X3 + (size_t)T * DM, p.ACTB); } SEAM(15);
    if (IN(16)) { ph_gemm_f32(F, p.ACTB, p.WT_FI1, TSP, DFF2, DM, p.BIGF, DFF2, DFF2); } SEAM(16);
    if (IN(17)) { ph_ffn_act(p, F, 1); } SEAM(17);
    if (IN(18)) { ph_gemm_f32(F, p.HFFB, p.WT_FO1, TSP, DM, DFF, p.MO, DM, DM); } SEAM(18);
    if (IN(19)) { ph_ln(F, p.X3, p.X3 + (size_t)T * DM, p.MO, p.ln_ffn_g + DM, p.ln_ffn_b + DM, p.out + O_Y_P, p.out + O_Y_S, nullptr); }
#undef IN
#undef SEAM
}

static inline size_t align_up(size_t x) { return (x + 255) & ~(size_t)255; }

extern "C" void kernel_launch(void* const* d_in, const int* in_sizes, int n_in, void* d_out, int out_size, void* d_ws, size_t ws_size, hipStream_t stream) {
    static int grid = 0;
    if (grid == 0) {
        int dev = 0, cus = 0, per_cu = 0;
        if (hipGetDevice(&dev) != hipSuccess || hipDeviceGetAttribute(&cus, hipDeviceAttributeMultiprocessorCount, dev) != hipSuccess) { fprintf(stderr, "kernel_launch: device query failed\n"); grid = -1; return; }
        if (hipFuncSetAttribute((const void*)mega, hipFuncAttributeMaxDynamicSharedMemorySize, LDS_BYTES) != hipSuccess) { fprintf(stderr, "kernel_launch: hipFuncSetAttribute failed\n"); grid = -1; return; }
        if (hipOccupancyMaxActiveBlocksPerMultiprocessor(&per_cu, (const void*)mega, NTHR, LDS_BYTES) != hipSuccess || per_cu < 1) { fprintf(stderr, "kernel_launch: occupancy query says %d blocks per CU\n", per_cu); }
        (void)hipGetLastError();
        grid = cus;
    }
    if (grid < 0) return;
    if ((size_t)out_size != O_END) fprintf(stderr, "kernel_launch: out_size %d != expected %zu\n", out_size, (size_t)O_END);
    KP p{};
    p.x_prompt = (const float*)d_in[0]; p.x_sample = (const float*)d_in[1]; p.cache_cmp = (const float*)d_in[2]; p.cache_slc = (const float*)d_in[3];
    p.st_win = (const float*)d_in[4]; p.st_gconv = (const float*)d_in[5]; p.st_gS = (const float*)d_in[6]; p.st_dil = (const float*)d_in[7];
    p.st_ffn = (const float*)d_in[8]; p.page_table = (const int*)d_in[9]; p.w_in_a = (const float*)d_in[10]; p.cw1 = (const float*)d_in[11];
    p.cb1 = (const float*)d_in[12]; p.cw2 = (const float*)d_in[13]; p.cpe = (const float*)d_in[14]; p.gconv_w = (const float*)d_in[15];
    p.gA = (const float*)d_in[16]; p.gdt = (const float*)d_in[17]; p.gnw = (const float*)d_in[18]; p.w_out_a = (const float*)d_in[19];
    p.w_in_c = (const float*)d_in[20]; p.w_out_c = (const float*)d_in[21]; p.ln_mix_g = (const float*)d_in[22]; p.ln_mix_b = (const float*)d_in[23];
    p.ffn_w_in = (const float*)d_in[24]; p.ffn_cw = (const float*)d_in[25]; p.ffn_cb = (const float*)d_in[26]; p.ffn_w_out = (const float*)d_in[27];
    p.ln_ffn_g = (const float*)d_in[28]; p.ln_ffn_b = (const float*)d_in[29];
    p.out = (float*)d_out;
    char* ws = (char*)d_ws; size_t off = 0;
    auto alloc = [&](size_t bytes) { void* q = (void*)(ws + off); off = align_up(off + bytes); return q; };
    p.ctl = (unsigned*)alloc(1 << 20);
    p.WT_A = (bf16*)alloc((size_t)PAP * DM * 2); p.WT_OA = (bf16*)alloc((size_t)DM * DM * 2);
    p.WT_FI0 = (bf16*)alloc((size_t)DFF2 * DM * 2); p.WT_FI1 = (bf16*)alloc((size_t)DFF2 * DM * 2);
    p.WT_FO0 = (bf16*)alloc((size_t)DM * DFF * 2); p.WT_FO1 = (bf16*)alloc((size_t)DM * DFF * 2);
    p.WT_CI = (bf16*)alloc((size_t)3072 * DM * 2); p.WT_CO = (bf16*)alloc((size_t)DM * DM * 2);
    p.ROPE = (float2*)alloc((size_t)(T + 1) * 32 * 8);
    p.ACTB = (bf16*)alloc((size_t)TSP * DM * 2); p.MIXB = (bf16*)alloc((size_t)TSP * DM * 2); p.HFFB = (bf16*)alloc((size_t)TSP * DFF * 2);
    p.BIGF = (float*)alloc((size_t)TSP * DFF2 * 4); p.MO = (float*)alloc((size_t)TSP * DM * 4);
    p.X1 = (float*)alloc((size_t)TS * DM * 4); p.X2 = (float*)alloc((size_t)TS * DM * 4); p.X3 = (float*)alloc((size_t)TS * DM * 4);
    p.QR = (float*)alloc((size_t)TS * 512 * 4);
    p.KS = (float*)alloc((size_t)TS * 128 * 4); p.VS = (float*)alloc((size_t)TS * 128 * 4); p.KW = (float*)alloc((size_t)TS * 128 * 4); p.VW = (float*)alloc((size_t)TS * 128 * 4);
    p.CK = (float*)alloc((size_t)33 * 512 * 128 * 4); p.CV = (float*)alloc((size_t)33 * 512 * 128 * 4);
    p.GQ = (float*)alloc((size_t)TS * 512 * 4); p.GK = (float*)alloc((size_t)TS * 512 * 4); p.GV = (float*)alloc((size_t)TS * 512 * 4); p.OG = (float*)alloc((size_t)TS * 512 * 4);
    p.Gg = (float*)alloc((size_t)TS * 8 * 4); p.Gb = (float*)alloc((size_t)TS * 8 * 4);
    p.QD = (float*)alloc((size_t)TS * DM * 4); p.KD = (float*)alloc((size_t)TS * DM * 4);
    if (off > ws_size) { fprintf(stderr, "kernel_launch: workspace too small: need %zu have %zu\n", off, ws_size); return; }
    if (hipMemsetAsync(p.ctl, 0, 1 << 20, stream) != hipSuccess) { fprintf(stderr, "kernel_launch: memset failed\n"); return; }
#if MK_PER_PHASE
    for (int k = 0; k < NPHASE; ++k) { p.ph_lo = k; p.ph_hi = k + 1; hipLaunchKernelGGL(mega, dim3(grid), dim3(NTHR), LDS_BYTES, stream, p); }
#else
    p.ph_lo = 0; p.ph_hi = NPHASE;
    hipLaunchKernelGGL(mega, dim3(grid), dim3(NTHR), LDS_BYTES, stream, p);
#endif
    const hipError_t le = hipPeekAtLastError();
    if (le != hipSuccess) fprintf(stderr, "kernel_launch: launch failed: %s\n", hipGetErrorName(le));
}
```

```cpp
#include <hip/hip_runtime.h>
#include <cstdint>
#include <cstdio>
#include <cmath>

namespace pg8 {
#define PG8_LAS __attribute__((address_space(3)))
typedef unsigned short bf16_t;
typedef short bf16x8 __attribute__((ext_vector_type(8)));
typedef float f32x4 __attribute__((ext_vector_type(4)));
typedef unsigned u32x4 __attribute__((ext_vector_type(4)));
constexpr int BM = 256, BK = 64, HALF = 128, HTB = HALF * BK * 2  , STAGE_BYTES = 8 * HTB, NXCD = 8, WGM = 8;

__host__ __device__ __forceinline__ int lds_byte(int r, int c) { const int st = (r >> 4) * 2 + (c >> 5), rr = r & 15, cc = c & 31, ob = rr * 64 + cc * 2; return st * 1024 + (ob ^ (((ob >> 9) & 1) << 5)); }
__host__ __device__ __forceinline__ void stage_rc(int b, int& R, int& C) { const int st = b / 1024, sb = b % 1024, swz = sb ^ (((sb >> 9) & 1) << 5); R = (st >> 1) * 16 + swz / 64; C = (st & 1) * 32 + (swz % 64) / 2; }
__host__ __device__ __forceinline__ int perm32(int rho) { const int n = rho >> 4, i = rho & 15; return 8 * (i >> 2) + 4 * n + (i & 3); }

struct Unit { int pm, pn; };
struct Gemm { const bf16_t* A; const bf16_t* Bt; int M, N, K; };

struct StaticOrder {
    int nM, nN, nwg, G, c;
    __host__ __device__ void init(int M, int N, int G_, int c_) { nM = M / BM; nN = N / BM; nwg = nM * nN; G = G_; c = c_; }
    __host__ __device__ bool next(int i, Unit& u) const {
        const long L = (long)i * G + c; if (L >= nwg) return false;
        int wgid = (int)L; { const int q = nwg / NXCD, r = nwg % NXCD, xcd = wgid % NXCD, off = wgid / NXCD; wgid = (xcd < r ? xcd * (q + 1) : r * (q + 1) + (xcd - r) * q) + off; }
        const int nig = WGM * nN, gid = wgid / nig, fm = gid * WGM, gsz = (nM - fm) < WGM ? (nM - fm) : WGM;
        u.pm = fm + ((wgid % nig) % gsz); u.pn = (wgid % nig) / gsz; return true;
    }
    __device__ __forceinline__ void a_ready(const Unit&) const {}
    __device__ __forceinline__ void done(const Unit&) const {}
};

typedef __bf16 bf16x2_t __attribute__((ext_vector_type(2)));
typedef float f32x2_t __attribute__((ext_vector_type(2)));
__device__ __forceinline__ unsigned cvt_pk_bf16(float lo, float hi) { const f32x2_t v = {lo, hi}; return __builtin_bit_cast(unsigned, __builtin_convertvector(v, bf16x2_t)); }
typedef float f32x2 __attribute__((ext_vector_type(2)));
__device__ __forceinline__ f32x2 gelu_pk(f32x2 v) {
    const f32x2 av = __builtin_elementwise_abs(v), d = av * 0.2316418882f + 1.0f;
    f32x2 t; t.x = __builtin_amdgcn_rcpf(d.x); t.y = __builtin_amdgcn_rcpf(d.y);
    f32x2 q = t * 0.5307027145f + (-0.7265760135f); q = q * t + 0.7107068705f; q = q * t + (-0.142248368f); q = q * t + 0.127414796f; q = q * t;
    const f32x2 s = (v * v) * (-0.72134752044f);
    f32x2 e; e.x = __builtin_amdgcn_exp2f(s.x); e.y = __builtin_amdgcn_exp2f(s.y);
    const f32x2 m = v * (q * e), r = v - m;
    f32x2 o; o.x = v.x < 0.f ? m.x : r.x; o.y = v.y < 0.f ? m.y : r.y; return o;
}

template <int ACT  > struct EpiBf16 {
    static constexpr bool PERM = true, AFTER_DRAIN = false; static_assert(ACT == 0 || ACT == 1, "EpiBf16: ACT is 0 (none) or 1 (gelu_pk)");
    bf16_t* O; int ldc; const float* bias; int split_cols; size_t split_stride; float scale0;
    __device__ __forceinline__ void operator()(const f32x4 (&acc)[2][2][4][2], const Unit& u, int wr, int wc, int fr, int fq) const {
        const int row0 = u.pm * BM + wr * 64 + fr; int colt = u.pn * BM; bf16_t* base = O;
        float sc = 1.f; if (split_cols) { const int t = colt / split_cols; base += (size_t)t * split_stride; colt -= t * split_cols; if (t == 0) sc = scale0; }
        const int col0 = colt + wc * 32 + 8 * fq, bcol0 = u.pn * BM + wc * 32 + 8 * fq;
        f32x4 bv[2][2];
#pragma unroll
        for (int bj = 0; bj < 2; ++bj)
#pragma unroll
            for (int n = 0; n < 2; ++n) bv[bj][n] = bias ? *(const f32x4*)(bias + bcol0 + bj * HALF + 4 * n) : (f32x4){0.f, 0.f, 0.f, 0.f};
#pragma unroll
        for (int ai = 0; ai < 2; ++ai)
#pragma unroll
            for (int m = 0; m < 4; ++m) { bf16_t* rowp = base + (size_t)(row0 + ai * HALF + m * 16) * ldc + col0;
#pragma unroll
                for (int bj = 0; bj < 2; ++bj) { f32x4 v0 = acc[ai][bj][m][0] + bv[bj][0], v1 = acc[ai][bj][m][1] + bv[bj][1];
                    if (ACT == 1) { f32x2 a = gelu_pk((f32x2){v0[0], v0[1]}), b = gelu_pk((f32x2){v0[2], v0[3]}), c = gelu_pk((f32x2){v1[0], v1[1]}), d = gelu_pk((f32x2){v1[2], v1[3]});
                        v0 = (f32x4){a.x, a.y, b.x, b.y}; v1 = (f32x4){c.x, c.y, d.x, d.y}; }
                    v0 = v0 * sc; v1 = v1 * sc; u32x4 w; w.x = cvt_pk_bf16(v0[0], v0[1]); w.y = cvt_pk_bf16(v0[2], v0[3]); w.z = cvt_pk_bf16(v1[0], v1[1]); w.w = cvt_pk_bf16(v1[2], v1[3]);
                    *(u32x4*)(rowp + bj * HALF) = w; } }
    }
};

struct EpiF32 {
    static constexpr bool PERM = false, AFTER_DRAIN = false;
    float* O; int ldc; int ncols;
    __device__ __forceinline__ void operator()(const f32x4 (&acc)[2][2][4][2], const Unit& u, int wr, int wc, int fr, int fq) const {
        const int row0 = u.pm * BM + wr * 64 + fr; const int col0 = u.pn * BM + wc * 32 + 4 * fq;
#pragma unroll
        for (int ai = 0; ai < 2; ++ai)
#pragma unroll
            for (int m = 0; m < 4; ++m) { float* rowp = O + (size_t)(row0 + ai * HALF + m * 16) * ldc;
#pragma unroll
                for (int bj = 0; bj < 2; ++bj)
#pragma unroll
                    for (int n = 0; n < 2; ++n) { const int c = col0 + bj * HALF + n * 16; if (c < ncols) *(f32x4*)(rowp + c) = acc[ai][bj][m][n]; } }
    }
};
template <class Epi, class Sched, bool ALIGN_EPI = false, bool SP2 = false>
__device__ __forceinline__ void gemm_phase(PG8_LAS unsigned char* lds, const Gemm g, const Sched& S, const Epi& E) {
    const int tid = threadIdx.x, wid = __builtin_amdgcn_readfirstlane(tid >> 6), lane = tid & 63, wr = wid >> 2, wc = wid & 3, fr = lane & 15, fq = lane >> 4;
    const int K = g.K, nt = K / BK;
    unsigned voffA[2], voffB[2];
#pragma unroll
    for (int i = 0; i < 2; ++i) { int R, C; stage_rc(tid * 16 + i * 8192, R, C); const int Rb = Epi::PERM ? ((R & ~31) + perm32(R & 31)) : R;
        voffA[i] = (unsigned)(R * K + C) * 2u; voffB[i] = (unsigned)(Rb * K + C) * 2u; }
    const size_t kstep = (size_t)(BK * 2);
    const size_t hstep = (size_t)HALF * K * 2;
    const size_t tstep = 2 * hstep;
    const unsigned ldsw = (unsigned)wid * 1024u;
    const int aoff = lds_byte(wr * 64 + fr, fq * 8), boff = lds_byte(wc * 32 + fr, fq * 8);
#define PG8_SA(b, h) (((b) * 2 + (h)) * HTB)
#define PG8_SB(b, h) ((4 + (b) * 2 + (h)) * HTB)
#define PG8_STAGE(bufoff, gbase, voff) do { _Pragma("unroll") for (int _i = 0; _i < 2; ++_i) \
        __builtin_amdgcn_global_load_lds((const unsigned*)((const char*)(gbase) + (voff)[_i]), (PG8_LAS unsigned*)(lds + (bufoff) + ldsw + _i * 8192), 16, 0, 0); } while (0)
#define PG8_LDA(dst, b, h) do { _Pragma("unroll") for (int m = 0; m < 4; ++m) _Pragma("unroll") for (int k = 0; k < 2; ++k) dst[m][k] = *(const PG8_LAS bf16x8*)(lds + PG8_SA(b, h) + aoff + m * 2048 + k * 1024); } while (0)
#define PG8_LDB(dst, b, h) do { _Pragma("unroll") for (int n = 0; n < 2; ++n) _Pragma("unroll") for (int k = 0; k < 2; ++k) dst[n][k] = *(const PG8_LAS bf16x8*)(lds + PG8_SB(b, h) + boff + n * 2048 + k * 1024); } while (0)
#define PG8_MMA(ai, bj, At, Bt) do { __builtin_amdgcn_s_setprio(1); _Pragma("unroll") for (int m = 0; m < 4; ++m) _Pragma("unroll") for (int n = 0; n < 2; ++n) _Pragma("unroll") for (int k = 0; k < 2; ++k) \
        acc[ai][bj][m][n] = __builtin_amdgcn_mfma_f32_16x16x32_bf16(Bt[n][k], At[m][k], acc[ai][bj][m][n], 0, 0, 0); __builtin_amdgcn_s_setprio(0); } while (0)
#define PG8_WAIT_V(n) asm volatile("s_waitcnt vmcnt(" #n ")" ::: "memory")
#define PG8_WAIT_L(n) asm volatile("s_waitcnt lgkmcnt(" #n ")" ::: "memory")
#define PG8_BAR __builtin_amdgcn_s_barrier()
#define PG8_SCHED __builtin_amdgcn_sched_barrier(0)
    Unit cur, nxt; int ui = 0;
    if (!S.next(0, cur)) return;
    f32x4 acc[2][2][4][2];
#pragma unroll
    for (int a = 0; a < 2; ++a)
#pragma unroll
        for (int b = 0; b < 2; ++b)
#pragma unroll
            for (int m = 0; m < 4; ++m)
#pragma unroll
                for (int n = 0; n < 2; ++n) acc[a][b][m][n] = (f32x4){0.f, 0.f, 0.f, 0.f};
    bf16x8 At[4][2], B0[2][2], B1[2][2];
    const char* cA = (const char*)g.A + (size_t)cur.pm * tstep; const char* cB = (const char*)g.Bt + (size_t)cur.pn * tstep;
    S.a_ready(cur);
    if constexpr (SP2) {
        PG8_STAGE(PG8_SB(0, 0), cB, voffB); PG8_STAGE(PG8_SB(0, 1), cB + hstep, voffB); PG8_STAGE(PG8_SA(0, 0), cA, voffA); PG8_STAGE(PG8_SA(0, 1), cA + hstep, voffA);
        if (wr == 1) PG8_BAR;
        PG8_WAIT_V(2); PG8_BAR;
        PG8_STAGE(PG8_SB(1, 0), cB + kstep, voffB); PG8_STAGE(PG8_SA(1, 0), cA + kstep, voffA); PG8_STAGE(PG8_SB(1, 1), cB + hstep + kstep, voffB);
        PG8_WAIT_V(6); PG8_BAR;
    } else {
        PG8_STAGE(PG8_SB(0, 0), cB, voffB); PG8_STAGE(PG8_SA(0, 0), cA, voffA); PG8_STAGE(PG8_SB(0, 1), cB + hstep, voffB); PG8_STAGE(PG8_SA(0, 1), cA + hstep, voffA);
        if (wr == 1) PG8_BAR;
        PG8_WAIT_V(4); PG8_BAR;
        PG8_STAGE(PG8_SB(1, 0), cB + kstep, voffB); PG8_STAGE(PG8_SA(1, 0), cA + kstep, voffA); PG8_STAGE(PG8_SB(1, 1), cB + hstep + kstep, voffB);
        PG8_WAIT_V(6); PG8_BAR;
    }
    for (;;) {
        const bool has_next = S.next(ui + 1, nxt);
        const char* nA = has_next ? (const char*)g.A + (size_t)nxt.pm * tstep : cA; const char* nB = has_next ? (const char*)g.Bt + (size_t)nxt.pn * tstep : cB;
        for (int t = 0; t < nt; t += 2) {
            const bool last = (t == nt - 2);
            const char* a1 = cA + (size_t)(t + 1) * kstep;
            const char* a2 = last ? nA : cA + (size_t)(t + 2) * kstep; const char* b2 = last ? nB : cB + (size_t)(t + 2) * kstep;
            const char* a3 = a2 + kstep; const char* b3 = b2 + kstep;
            if (last && has_next) S.a_ready(nxt);
            if constexpr (SP2) {
            PG8_LDB(B0, 0, 0); PG8_LDB(B1, 0, 1); PG8_SCHED; PG8_LDA(At, 0, 0); PG8_STAGE(PG8_SA(1, 1), a1 + hstep, voffA);
            PG8_WAIT_V(8); PG8_WAIT_L(0); PG8_BAR; PG8_MMA(0, 0, At, B0); PG8_MMA(0, 1, At, B1); PG8_BAR; PG8_SCHED;
            PG8_LDA(At, 0, 1); PG8_STAGE(PG8_SB(0, 0), b2, voffB); PG8_STAGE(PG8_SB(0, 1), b2 + hstep, voffB); PG8_STAGE(PG8_SA(0, 0), a2, voffA);
            PG8_WAIT_V(8); PG8_WAIT_L(0); PG8_BAR; PG8_MMA(1, 0, At, B0); PG8_MMA(1, 1, At, B1); PG8_BAR; PG8_SCHED;
            PG8_LDB(B0, 1, 0); PG8_LDB(B1, 1, 1); PG8_SCHED; PG8_LDA(At, 1, 0); PG8_STAGE(PG8_SA(0, 1), a2 + hstep, voffA);
            PG8_WAIT_V(8); PG8_WAIT_L(0); PG8_BAR; PG8_MMA(0, 0, At, B0); PG8_MMA(0, 1, At, B1); PG8_BAR; PG8_SCHED;
            PG8_LDA(At, 1, 1); PG8_STAGE(PG8_SB(1, 0), b3, voffB); PG8_STAGE(PG8_SB(1, 1), b3 + hstep, voffB); PG8_STAGE(PG8_SA(1, 0), a3, voffA);
            PG8_WAIT_V(8); PG8_WAIT_L(0); PG8_BAR; PG8_MMA(1, 0, At, B0); PG8_MMA(1, 1, At, B1); PG8_BAR; PG8_SCHED;
            } else {
            PG8_LDB(B0, 0, 0); PG8_SCHED; PG8_LDA(At, 0, 0); PG8_STAGE(PG8_SA(1, 1), a1 + hstep, voffA);
            PG8_WAIT_L(8); PG8_BAR; PG8_WAIT_L(0); PG8_MMA(0, 0, At, B0); PG8_BAR; PG8_SCHED;
            PG8_LDB(B1, 0, 1); PG8_STAGE(PG8_SB(0, 0), b2, voffB);
            PG8_BAR; PG8_WAIT_L(0); PG8_MMA(0, 1, At, B1); PG8_BAR;
            PG8_LDA(At, 0, 1); PG8_STAGE(PG8_SA(0, 0), a2, voffA);
            PG8_BAR; PG8_WAIT_L(0); PG8_MMA(1, 0, At, B0); PG8_BAR; PG8_SCHED;
            PG8_STAGE(PG8_SB(0, 1), b2 + hstep, voffB);
            PG8_WAIT_V(6); PG8_BAR; PG8_MMA(1, 1, At, B1); PG8_BAR;
            PG8_LDB(B0, 1, 0); PG8_SCHED; PG8_LDA(At, 1, 0); PG8_STAGE(PG8_SA(0, 1), a2 + hstep, voffA);
            PG8_WAIT_L(8); PG8_BAR; PG8_WAIT_L(0); PG8_MMA(0, 0, At, B0); PG8_BAR; PG8_SCHED;
            PG8_LDB(B1, 1, 1); PG8_STAGE(PG8_SB(1, 0), b3, voffB);
            PG8_BAR; PG8_WAIT_L(0); PG8_MMA(0, 1, At, B1); PG8_BAR;
            PG8_LDA(At, 1, 1); PG8_STAGE(PG8_SA(1, 0), a3, voffA);
            PG8_BAR; PG8_WAIT_L(0); PG8_MMA(1, 0, At, B0); PG8_BAR; PG8_SCHED;
            PG8_STAGE(PG8_SB(1, 1), b3 + hstep, voffB);
            PG8_WAIT_V(6); PG8_BAR; PG8_MMA(1, 1, At, B1); PG8_BAR;
            }
        }
        if constexpr (ALIGN_EPI) { if (wr == 0) PG8_BAR; }
        if constexpr (!Epi::AFTER_DRAIN) { E(acc, cur, wr, wc, fr, fq); S.done(cur); }
        if (!has_next) break;
#pragma unroll
        for (int a = 0; a < 2; ++a)
#pragma unroll
            for (int b = 0; b < 2; ++b)
#pragma unroll
                for (int m = 0; m < 4; ++m)
#pragma unroll
                    for (int n = 0; n < 2; ++n) acc[a][b][m][n] = (f32x4){0.f, 0.f, 0.f, 0.f};
        cur = nxt; cA = nA; cB = nB; ++ui;
        if constexpr (ALIGN_EPI) { if (wr == 1) PG8_BAR; }
    }
    PG8_WAIT_V(0);
    if constexpr (!ALIGN_EPI) { if (wr == 0) PG8_BAR; }
    PG8_BAR;
    if constexpr (Epi::AFTER_DRAIN) { E.fused(acc, cur, wr, wc, fr, fq, lds, wid, lane); S.done(cur); }
#undef PG8_SA
#undef PG8_SB
#undef PG8_STAGE
#undef PG8_LDA
#undef PG8_LDB
#undef PG8_MMA
#undef PG8_WAIT_V
#undef PG8_WAIT_L
#undef PG8_BAR
#undef PG8_SCHED
}
}

#define LAS __attribute__((address_space(3)))
#define XB_TMO      128
#define XB_XCNT(j)  (256  + 64 * (j))
#define XB_XSUB(j)  (1280 + 64 * (j))
#define XB_XGEN(j)  (2304 + 64 * (j))
#define XB_TOP      3328
#define XB_TOPGEN   3392
#define XCD_BAR_WORDS 3456
#define XB_SPIN_CAP (1u << 26)

__device__ __forceinline__ unsigned xb_ld(unsigned* p)              { return __hip_atomic_load(p, __ATOMIC_RELAXED, __HIP_MEMORY_SCOPE_AGENT); }
__device__ __forceinline__ unsigned xb_add(unsigned* p, unsigned v) { return __hip_atomic_fetch_add(p, v, __ATOMIC_RELAXED, __HIP_MEMORY_SCOPE_AGENT); }
__device__ __forceinline__ unsigned xb_xcc_id() { return (unsigned)__builtin_amdgcn_s_getreg((3 << 11) | 20) & 0xFu; }
#define XB_SPIN(cond, bar) do { unsigned _sp = 0; while (cond) { __builtin_amdgcn_s_sleep(1); \
    if ((++_sp & 255u) == 0u) { if (xb_ld(&(bar)[XB_TMO])) break; if (_sp > XB_SPIN_CAP) { atomicAdd(&(bar)[XB_TMO], 1u); break; } } } } while (0)

struct XcdBarrier {
    unsigned* bar; unsigned x;
    volatile LAS unsigned* st;
};

__device__ __forceinline__ XcdBarrier xcd_barrier_post(unsigned* bar, volatile LAS unsigned* st) {
    XcdBarrier b; b.bar = bar; b.x = xb_xcc_id(); b.st = st;
    if (threadIdx.x == 0) (void)xb_add(&bar[XB_XCNT(b.x)], 1u);
    return b;
}
__device__ __forceinline__ void xcd_barrier_complete(unsigned* bar, unsigned x, unsigned& nloc, unsigned& nx) {
    const unsigned G = gridDim.x * gridDim.y * gridDim.z;
    unsigned sum, cnt, mine, sp = 0u;
    for (;;) {
        sum = 0u; cnt = 0u; mine = 0u;
#pragma unroll
        for (unsigned j = 0; j < 16; ++j) { const unsigned c = xb_ld(&bar[XB_XCNT(j)]); sum += c; cnt += (c > 0u) ? 1u : 0u; mine = (j == x) ? c : mine; }
        if (sum == G) break;
        __builtin_amdgcn_s_sleep(1);
        if ((++sp & 255u) == 0u) { if (xb_ld(&bar[XB_TMO])) break; if (sp > XB_SPIN_CAP) { atomicAdd(&bar[XB_TMO], 1u); break; } }
    }
    nloc = mine > 0u ? mine : 1u; nx = cnt > 0u ? cnt : 1u;
}

__device__ __forceinline__ void xcd_barrier(const XcdBarrier& b) {
    asm volatile("s_waitcnt vmcnt(0)" ::: "memory");
    __syncthreads();
    if (threadIdx.x == 0) {
        unsigned* bar = b.bar;
        __builtin_amdgcn_s_waitcnt(0);
        unsigned nloc = b.st[0], nx = b.st[1];
        if (nloc == 0u) { xcd_barrier_complete(bar, b.x, nloc, nx); b.st[0] = nloc; b.st[1] = nx; }
        const unsigned old = xb_add(&bar[XB_XSUB(b.x)], 1u);
        const unsigned gen = old / nloc;
        if (old + 1u == (gen + 1u) * nloc) {
            __builtin_amdgcn_fence(__ATOMIC_RELEASE, "agent");
            asm volatile("s_waitcnt vmcnt(0)" ::: "memory");
            const unsigned og = xb_add(&bar[XB_TOP], 1u);
            const unsigned tg = og / nx;
            if (og + 1u == (tg + 1u) * nx) xb_add(&bar[XB_TOPGEN], 1u);
            else XB_SPIN(xb_ld(&bar[XB_TOPGEN]) == tg, bar);
            __builtin_amdgcn_fence(__ATOMIC_ACQUIRE, "agent");
            xb_add(&bar[XB_XGEN(b.x)], 1u);
            asm volatile("s_waitcnt vmcnt(0)" ::: "memory");
        } else {
            XB_SPIN(xb_ld(&bar[XB_XGEN(b.x)]) == gen, bar);
            __builtin_amdgcn_fence(__ATOMIC_ACQUIRE, "agent");
            asm volatile("s_waitcnt vmcnt(0)" ::: "memory");
        }
    }
    __syncthreads();
}

#ifndef PG8_SP2
#define PG8_SP2 true
#endif
#ifndef PG8_ALIGN
#define PG8_ALIGN true
#endif
#ifndef MK_PER_PHASE
#define MK_PER_PHASE 0
#endif

constexpr int T = 16384, NSMP = 32, TS = T + NSMP, TSP = T + 256, DM = 1024;
constexpr int PA = 3368, PAP = 3584;
constexpr int C_Q = 0, C_KC = 512, C_VC = 640, C_KS = 768, C_VS = 896, C_KW = 1024, C_VW = 1152, C_GATE = 1280,
              C_GQKV = 1304, C_A = 2840, C_BT = 2848, C_Z = 2856;
constexpr int DFF = 2816, DFF2 = 5632;
constexpr float DN_ALPHA = 1.4142135623730951f;
constexpr float LN_EPS = 1e-5f, NORM_EPS = 1e-6f;
constexpr int NPAGES = 128;
constexpr int NWAVES = 8, NTHR = 512;

constexpr size_t O_Y_P = 0;
constexpr size_t O_Y_S = O_Y_P + (size_t)T * DM;
constexpr size_t O_CMP_P = O_Y_S + (size_t)NSMP * DM;
constexpr size_t O_CMP_S = O_CMP_P + (size_t)T * 256;
constexpr size_t O_SLC_P = O_CMP_S + (size_t)NSMP * 256;
constexpr size_t O_SLC_S = O_SLC_P + (size_t)T * 256;
constexpr size_t O_WIN_P = O_SLC_S + (size_t)NSMP * 256;
constexpr size_t O_WIN_S = O_WIN_P + (size_t)512 * 256;
constexpr size_t O_GCONV_P = O_WIN_S + (size_t)NSMP * 512 * 256;
constexpr size_t O_GCONV_S = O_GCONV_P + (size_t)3 * 1536;
constexpr size_t O_GS_P = O_GCONV_S + (size_t)NSMP * 3 * 1536;
constexpr size_t O_GS_S = O_GS_P + (size_t)8 * 64 * 64;
constexpr size_t O_DIL_P = O_GS_S + (size_t)NSMP * 8 * 64 * 64;
constexpr size_t O_DIL_S = O_DIL_P + (size_t)2048 * 2048;
constexpr size_t O_FFN_P = O_DIL_S + (size_t)NSMP * 2048 * 2048;
constexpr size_t O_FFN_S = O_FFN_P + (size_t)2 * 2 * DFF2;
constexpr size_t O_END = O_FFN_S + (size_t)NSMP * 2 * 2 * DFF2;

constexpr int RING_BYTES = 131072;
constexpr int FAST_WL = 17408;
constexpr int MISC_OFF = 8 * FAST_WL + 64;
constexpr int LDS_BYTES = 147456;

typedef unsigned short bf16;
typedef unsigned v4u __attribute__((ext_vector_type(4)));

__device__ __forceinline__ unsigned f2bf(float f) { return (unsigned)__builtin_bit_cast(unsigned short, (__bf16)f); }
__device__ __forceinline__ unsigned pk2(float lo, float hi) { return pg8::cvt_pk_bf16(lo, hi); }
__device__ __forceinline__ float wave_sum(float v) {
#pragma unroll
    for (int o = 1; o < 64; o <<= 1) v += __shfl_xor(v, o);
    return v;
}
__device__ __forceinline__ float wave_max(float v) {
#pragma unroll
    for (int o = 1; o < 64; o <<= 1) v = fmaxf(v, __shfl_xor(v, o));
    return v;
}
__device__ __forceinline__ void wave_lds_sync() { asm volatile("s_waitcnt lgkmcnt(0)" ::: "memory"); __builtin_amdgcn_wave_barrier(); asm volatile("" ::: "memory"); }
__device__ __forceinline__ float sigmoidf_(float x) { return 1.f / (1.f + expf(-x)); }
__device__ __forceinline__ float siluf_(float x) { return x / (1.f + expf(-x)); }
__device__ __forceinline__ float gelu_tanh(float x) { const float c = 0.7978845608028654f; return 0.5f * x * (1.f + tanhf(c * (x + 0.044715f * x * x * x))); }
__device__ __forceinline__ float softplusf_(float x) { return x > 20.f ? x : log1pf(expf(x)); }

struct KP {
    const float *x_prompt, *x_sample, *cache_cmp, *cache_slc, *st_win, *st_gconv, *st_gS, *st_dil, *st_ffn;
    const int* page_table;
    const float *w_in_a, *cw1, *cb1, *cw2, *cpe, *gconv_w, *gA, *gdt, *gnw, *w_out_a, *w_in_c, *w_out_c, *ln_mix_g, *ln_mix_b,
                *ffn_w_in, *ffn_cw, *ffn_cb, *ffn_w_out, *ln_ffn_g, *ln_ffn_b;
    float* out;
    unsigned* ctl;
    bf16 *WT_A, *WT_OA, *WT_FI0, *WT_FI1, *WT_FO0, *WT_FO1, *WT_CI, *WT_CO;
    float2* ROPE;
    bf16 *ACTB, *MIXB, *HFFB;
    bf16 *QB, *KSF, *VSF, *KWF, *VWF, *CKF, *CVF;
    bf16 *QDB; bf16* DKF[3]; bf16* DVF[3];
    bf16 *G_WF, *G_KDF, *G_QGF, *G_QKF, *G_SPF, *G_VNF; float *G_UF, *G_GL;
    float *BIGF, *MO, *X1, *X2, *X3, *QR, *KS, *VS, *KW, *VW, *CK, *CV, *GQ, *GK, *GV, *OG, *Gg, *Gb, *QD, *KD;
    int ph_lo, ph_hi;
};

struct Fr { unsigned char* lds; int tid, lane, wave, gw, NGW, bid, G; };

__device__ __forceinline__ void transpose_item(const float* W, int K, int N, int NT, bf16* WT, float* scr, int item, int lane) {
    const int nblk = NT / 32, kb = item / nblk, nb = item % nblk, k0 = 64 * kb, n0 = 32 * nb;
#pragma unroll 8
    for (int i = 0; i < 32; ++i) { const int kk = 2 * i + (lane >> 5); const int n = n0 + (lane & 31); scr[kk * 33 + (lane & 31)] = (n < N) ? W[(size_t)(k0 + kk) * N + n] : 0.f; }
    wave_lds_sync();
    const int c = lane & 7;
#pragma unroll
    for (int j = 0; j < 4; ++j) { const int n = (lane >> 3) + 8 * j; const float* s = scr + (8 * c) * 33 + n;
        v4u o; o.x = pk2(s[0 * 33], s[1 * 33]); o.y = pk2(s[2 * 33], s[3 * 33]); o.z = pk2(s[4 * 33], s[5 * 33]); o.w = pk2(s[6 * 33], s[7 * 33]);
        *(v4u*)(WT + (size_t)(n0 + n) * K + k0 + 8 * c) = o; }
    wave_lds_sync();
}
__device__ __forceinline__ void ph_prologue(const KP& p, const Fr& F) {
    float* scr = (float*)(F.lds + F.wave * 16384);
    const int I_A = 16 * (PAP / 32), I_OA = 16 * 32, I_FI = 16 * (DFF2 / 32), I_FO = (DFF / 64) * 32, I_CI = 16 * (3072 / 32), I_CO = 16 * 32;
    const int NITEMS = I_A + I_OA + 2 * I_FI + 2 * I_FO + I_CI + I_CO;
    for (int it = F.gw; it < NITEMS; it += F.NGW) {
        int r = it;
        if (r < I_A) { transpose_item(p.w_in_a, DM, PA, PAP, p.WT_A, scr, r, F.lane); continue; } r -= I_A;
        if (r < I_OA) { transpose_item(p.w_out_a, DM, DM, DM, p.WT_OA, scr, r, F.lane); continue; } r -= I_OA;
        if (r < I_FI) { transpose_item(p.ffn_w_in, DM, DFF2, DFF2, p.WT_FI0, scr, r, F.lane); continue; } r -= I_FI;
        if (r < I_FI) { transpose_item(p.ffn_w_in + (size_t)DM * DFF2, DM, DFF2, DFF2, p.WT_FI1, scr, r, F.lane); continue; } r -= I_FI;
        if (r < I_FO) { transpose_item(p.ffn_w_out, DFF, DM, DM, p.WT_FO0, scr, r, F.lane); continue; } r -= I_FO;
        if (r < I_FO) { transpose_item(p.ffn_w_out + (size_t)DFF * DM, DFF, DM, DM, p.WT_FO1, scr, r, F.lane); continue; } r -= I_FO;
        if (r < I_CI) { transpose_item(p.w_in_c, DM, 3072, 3072, p.WT_CI, scr, r, F.lane); continue; } r -= I_CI;
        transpose_item(p.w_out_c, DM, DM, DM, p.WT_CO, scr, r, F.lane);
    }
    const size_t gt = (size_t)F.bid * NTHR + F.tid, GT = (size_t)F.G * NTHR;
    for (size_t i4 = gt; i4 < (size_t)TSP * (DM / 4); i4 += GT) {
        const int r = (int)(i4 / (DM / 4)), c4 = (int)(i4 % (DM / 4));
        float4 v = make_float4(0.f, 0.f, 0.f, 0.f);
        if (r < T) v = ((const float4*)p.x_prompt)[(size_t)r * (DM / 4) + c4]; else if (r < TS) v = ((const float4*)p.x_sample)[(size_t)(r - T) * (DM / 4) + c4];
        uint2 o; o.x = pk2(v.x, v.y); o.y = pk2(v.z, v.w);
        ((uint2*)p.ACTB)[i4] = o;
    }
    for (size_t idx = gt; idx < (size_t)(T + 1) * 32; idx += GT) {
        const int pos = (int)(idx >> 5), i = (int)(idx & 31);
        const float inv = (float)pow(10000.0, -2.0 * (double)i / 64.0);
        const float ang = (float)pos * inv;
        p.ROPE[idx] = make_float2((float)cos((double)ang), (float)sin((double)ang));
    }
}

__device__ __forceinline__ void ph_gemm_f32(const Fr& F, const bf16* A, const bf16* Bt, int M, int N, int K, float* C, int ldc, int ncols) {
    pg8::Gemm g{A, Bt, M, N, K}; pg8::StaticOrder S; S.init(M, N, F.G, F.bid);
    pg8::EpiF32 E{C, ldc, ncols};
    pg8::gemm_phase<pg8::EpiF32, pg8::StaticOrder, PG8_ALIGN, PG8_SP2>((PG8_LAS unsigned char*)F.lds, g, S, E);
}

__device__ __forceinline__ float rope_val(const float* row, int base, int i, float2 cs) {
    const int ii = i & 31;
    const float x1 = row[base + ii], x2 = row[base + ii + 32];
    return (i < 32) ? (x1 * cs.x - x2 * cs.y) : (x2 * cs.x + x1 * cs.y);
}
__device__ __forceinline__ void ph_nsa_prep(const KP& p, const Fr& F) {
    const float* H0 = p.BIGF; float* out = p.out;
    const size_t gt = (size_t)F.bid * NTHR + F.tid, GT = (size_t)F.G * NTHR;
    const size_t total = (size_t)TS * 1280;
    for (size_t idx = gt + (size_t)T * 1280; idx < total; idx += GT) {
        const int r = (int)(idx / 1280), c = (int)(idx % 1280);
        const bool smp = r >= T; const int b = r - T; const int pos = smp ? T : r;
        const float* row = H0 + (size_t)r * PA;
        const int i = c & 63;
        const float2 cs = p.ROPE[pos * 32 + (i & 31)];
        if (c < 512) { p.QR[(size_t)r * 512 + c] = rope_val(row, c & ~63, i, cs); continue; }
        const int sec = (c - 512) >> 7; const int gd = (c - 512) & 127; const int base = c & ~63;
        float v;
        if (sec == 2 || sec == 4) v = rope_val(row, base, i, cs); else v = row[c];
        const int kv = sec & 1;
        if (sec < 2) {
            if (!smp) out[O_CMP_P + (size_t)r * 256 + kv * 128 + gd] = v; else out[O_CMP_S + (size_t)b * 256 + kv * 128 + gd] = v;
        } else if (sec < 4) {
            if (!smp) out[O_SLC_P + (size_t)r * 256 + kv * 128 + gd] = v; else out[O_SLC_S + (size_t)b * 256 + kv * 128 + gd] = v;
            if (kv == 0) p.KS[(size_t)r * 128 + gd] = v; else p.VS[(size_t)r * 128 + gd] = v;
        } else {
            if (kv == 0) p.KW[(size_t)r * 128 + gd] = v; else p.VW[(size_t)r * 128 + gd] = v;
            if (!smp) { if (r >= T - 512) out[O_WIN_P + (size_t)(r - (T - 512)) * 256 + kv * 128 + gd] = v; }
            else out[O_WIN_S + ((size_t)b * 512 + 511) * 256 + kv * 128 + gd] = v;
        }
    }
    const size_t tot2 = (size_t)NSMP * 511 * 256;
    for (size_t idx = gt; idx < tot2; idx += GT) {
        const int b = (int)(idx / (511 * 256)); const int rem = (int)(idx % (511 * 256));
        out[O_WIN_S + (size_t)b * 512 * 256 + rem] = p.st_win[(size_t)b * 512 * 256 + 256 + rem];
    }
}

typedef short bf16x8 __attribute__((ext_vector_type(8)));
typedef float f32x4 __attribute__((ext_vector_type(4)));
constexpr float QSCALE = 0.18033688011112042f;
#define MFMA16(a, b, c) __builtin_amdgcn_mfma_f32_16x16x32_bf16((a), (b), (c), 0, 0, 0)

__device__ __forceinline__ size_t kfrag_off(int kt, int ks, int lane) { return ((size_t)(kt * 2 + ks) * 64 + lane) * 8; }
__device__ __forceinline__ size_t vfrag_off(int st, int dt, int lane) { return ((size_t)(st * 4 + dt) * 64 + lane) * 8; }
__device__ __forceinline__ size_t vfrag_elem(int key, int d) {
    const int st = key >> 5, kk = key & 31, tile = kk >> 4, r16 = kk & 15, grp = r16 >> 2, reg = r16 & 3;
    return ((size_t)(st * 4 + (d >> 4)) * 64 + (d & 15) + 16 * grp) * 8 + tile * 4 + reg;
}
__device__ __forceinline__ size_t kfrag_elem(int key, int d) {
    return ((size_t)((key >> 4) * 2 + (d >> 5)) * 64 + (key & 15) + 16 * ((d & 31) >> 3)) * 8 + (d & 7);
}

__device__ __forceinline__ void ph_nsa_prep_fast(const KP& p, const Fr& F) {
    const float* H0 = p.BIGF; float* out = p.out;
    const size_t gt = (size_t)F.bid * NTHR + F.tid, GT = (size_t)F.G * NTHR;
    for (size_t idx = gt; idx < (size_t)T * 160; idx += GT) {
        const int t = (int)(idx / 160), u = (int)(idx % 160);
        const int c0 = u * 8; const float* row = H0 + (size_t)t * PA;
        const float4 a0 = *(const float4*)(row + c0), a1 = *(const float4*)(row + c0 + 4);
        float v[8] = {a0.x, a0.y, a0.z, a0.w, a1.x, a1.y, a1.z, a1.w};
        const int sec = (u < 64) ? -1 : ((u - 64) >> 4);
        const bool roped = (sec == -1 || sec == 2 || sec == 4);
        if (roped) {
            const int d0 = c0 & 63; const int pc = (d0 < 32) ? c0 + 32 : c0 - 32;
            const float4 b0 = *(const float4*)(row + pc), b1 = *(const float4*)(row + pc + 4);
            const float w[8] = {b0.x, b0.y, b0.z, b0.w, b1.x, b1.y, b1.z, b1.w};
#pragma unroll
            for (int j = 0; j < 8; ++j) { const float2 cs = p.ROPE[t * 32 + ((d0 + j) & 31)];
                v[j] = (d0 < 32) ? (v[j] * cs.x - w[j] * cs.y) : (v[j] * cs.x + w[j] * cs.y); }
        }
        if (sec == -1) {
            v4u o; o.x = pk2(v[0] * QSCALE, v[1] * QSCALE); o.y = pk2(v[2] * QSCALE, v[3] * QSCALE); o.z = pk2(v[4] * QSCALE, v[5] * QSCALE); o.w = pk2(v[6] * QSCALE, v[7] * QSCALE);
            *(v4u*)(p.QB + (size_t)t * 512 + c0) = o; continue;
        }
        const int gd = (c0 - 512) & 127, g = gd >> 6, d0 = gd & 63, kv = sec & 1;
        const float4 o0 = make_float4(v[0], v[1], v[2], v[3]), o1 = make_float4(v[4], v[5], v[6], v[7]);
        if (sec < 2) { float* o = out + O_CMP_P + (size_t)t * 256 + kv * 128 + gd; *(float4*)o = o0; *(float4*)(o + 4) = o1; continue; }
        if (sec < 4) { float* o = out + O_SLC_P + (size_t)t * 256 + kv * 128 + gd; *(float4*)o = o0; *(float4*)(o + 4) = o1; }
        else if (t >= T - 512) { float* o = out + O_WIN_P + (size_t)(t - (T - 512)) * 256 + kv * 128 + gd; *(float4*)o = o0; *(float4*)(o + 4) = o1; }
        bf16* KF = (sec < 4) ? p.KSF : p.KWF; bf16* VF = (sec < 4) ? p.VSF : p.VWF;
        if (kv == 0) {
            v4u o; o.x = pk2(v[0], v[1]); o.y = pk2(v[2], v[3]); o.z = pk2(v[4], v[5]); o.w = pk2(v[6], v[7]);
            *(v4u*)(KF + (size_t)g * T * 64 + kfrag_elem(t, d0)) = o;
        } else {
#pragma unroll
            for (int j = 0; j < 8; ++j) VF[(size_t)g * T * 64 + vfrag_elem(t, d0 + j)] = (bf16)f2bf(v[j]);
        }
    }
}

struct AttW { f32x4 o[4]; float m, l; };
__device__ __forceinline__ void attw_init(AttW& a) {
#pragma unroll
    for (int i = 0; i < 4; ++i) a.o[i] = (f32x4){0.f, 0.f, 0.f, 0.f};
    a.m = -INFINITY; a.l = 0.f;
}
__device__ __forceinline__ void qk_step(const bf16x8 (&kf)[2][2], const bf16x8 (&qf)[2], f32x4& s0, f32x4& s1) {
    const f32x4 z = {0.f, 0.f, 0.f, 0.f};
    s0 = MFMA16(kf[0][0], qf[0], z); s0 = MFMA16(kf[0][1], qf[1], s0);
    s1 = MFMA16(kf[1][0], qf[0], z); s1 = MFMA16(kf[1][1], qf[1], s1);
}
__device__ __forceinline__ bf16x8 pack_p(const f32x4& p0, const f32x4& p1) {
    union { v4u u; bf16x8 b; } c;
    c.u.x = pg8::cvt_pk_bf16(p0[0], p0[1]); c.u.y = pg8::cvt_pk_bf16(p0[2], p0[3]); c.u.z = pg8::cvt_pk_bf16(p1[0], p1[1]); c.u.w = pg8::cvt_pk_bf16(p1[2], p1[3]);
    return c.b;
}
__device__ __forceinline__ void att_update(AttW& a, const f32x4& s0, const f32x4& s1, const bf16x8 (&vf)[4]) {
    float mx = fmaxf(fmaxf(fmaxf(s0[0], s0[1]), fmaxf(s0[2], s0[3])), fmaxf(fmaxf(s1[0], s1[1]), fmaxf(s1[2], s1[3])));
    mx = fmaxf(mx, __shfl_xor(mx, 16)); mx = fmaxf(mx, __shfl_xor(mx, 32));
    const float mn = fmaxf(a.m, mx);
    const float ms = (mn == -INFINITY) ? 0.f : mn;
    const float alpha = __builtin_amdgcn_exp2f(a.m - ms);
    f32x4 p0, p1;
#pragma unroll
    for (int i = 0; i < 4; ++i) { p0[i] = __builtin_amdgcn_exp2f(s0[i] - ms); p1[i] = __builtin_amdgcn_exp2f(s1[i] - ms); }
    a.l = a.l * alpha + ((p0[0] + p0[1]) + (p0[2] + p0[3])) + ((p1[0] + p1[1]) + (p1[2] + p1[3]));
    a.m = mn;
    const bf16x8 pf = pack_p(p0, p1);
#pragma unroll
    for (int dt = 0; dt < 4; ++dt) { a.o[dt] = a.o[dt] * alpha; a.o[dt] = MFMA16(vf[dt], pf, a.o[dt]); }
}
__device__ __forceinline__ float grp_sum(float v) { v += __shfl_xor(v, 16); v += __shfl_xor(v, 32); return v; }

__device__ __forceinline__ void nsa_fast_unit(const KP& p, int unit, float* wl, int lane) {
    asm volatile("" : "+v"(lane));
    const int g = unit & 1, t0 = (unit >> 1) * 16;
    const int qi = lane & 15, grp = lane >> 4, t = t0 + qi;
    float* imp = wl; int* sel = (int*)(wl + 4096);
    const float* grow = p.BIGF + (size_t)t * PA + C_GATE + g * 4;
    bf16x8 qf[4][2];
#pragma unroll
    for (int h = 0; h < 4; ++h)
#pragma unroll
        for (int ks = 0; ks < 2; ++ks) qf[h][ks] = *(const bf16x8*)(p.QB + (size_t)t * 512 + (g * 4 + h) * 64 + 32 * ks + 8 * grp);
    AttW st[4];
    {
        const bf16* CKF = p.CKF + (size_t)g * 512 * 64; const bf16* CVF = p.CVF + (size_t)g * 512 * 64;
        const int nmax = (t0 + 16) >> 5; const int nsteps = (nmax + 31) >> 5;
        const int nval = (t + 1) >> 5;
        float m[4], l[4];
#pragma unroll
        for (int h = 0; h < 4; ++h) { m[h] = -INFINITY; l[h] = 0.f; }
        for (int s = 0; s < nsteps; ++s) {
            bf16x8 kf[2][2];
#pragma unroll
            for (int tl = 0; tl < 2; ++tl)
#pragma unroll
                for (int ks = 0; ks < 2; ++ks) kf[tl][ks] = *(const bf16x8*)(CKF + kfrag_off(2 * s + tl, ks, lane));
            const int cb = 32 * s + 4 * grp;
#pragma unroll
            for (int h = 0; h < 4; ++h) {
                f32x4 s0, s1; qk_step(kf, qf[h], s0, s1);
#pragma unroll
                for (int i = 0; i < 4; ++i) { if (cb + i >= nval) s0[i] = -INFINITY; if (cb + 16 + i >= nval) s1[i] = -INFINITY; }
                float mx = fmaxf(fmaxf(fmaxf(s0[0], s0[1]), fmaxf(s0[2], s0[3])), fmaxf(fmaxf(s1[0], s1[1]), fmaxf(s1[2], s1[3])));
                mx = fmaxf(mx, __shfl_xor(mx, 16)); mx = fmaxf(mx, __shfl_xor(mx, 32));
                const float mn = fmaxf(m[h], mx); const float ms = (mn == -INFINITY) ? 0.f : mn;
                float sum = 0.f;
#pragma unroll
                for (int i = 0; i < 4; ++i) sum += __builtin_amdgcn_exp2f(s0[i] - ms) + __builtin_amdgcn_exp2f(s1[i] - ms);
                l[h] = l[h] * __builtin_amdgcn_exp2f(m[h] - ms) + sum; m[h] = mn;
            }
        }
        float il[4];
#pragma unroll
        for (int h = 0; h < 4; ++h) { const float lt = grp_sum(l[h]); il[h] = lt > 0.f ? 1.f / lt : 0.f; if (m[h] == -INFINITY) m[h] = 0.f; attw_init(st[h]); }
        for (int s = 0; s < nsteps; ++s) {
            bf16x8 kf[2][2], vf[4];
#pragma unroll
            for (int tl = 0; tl < 2; ++tl)
#pragma unroll
                for (int ks = 0; ks < 2; ++ks) kf[tl][ks] = *(const bf16x8*)(CKF + kfrag_off(2 * s + tl, ks, lane));
#pragma unroll
            for (int dt = 0; dt < 4; ++dt) vf[dt] = *(const bf16x8*)(CVF + vfrag_off(s, dt, lane));
            const int cb = 32 * s + 4 * grp;
            float i4[4] = {0.f, 0.f, 0.f, 0.f};
#pragma unroll
            for (int h = 0; h < 4; ++h) {
                f32x4 s0, s1; qk_step(kf, qf[h], s0, s1);
                f32x4 p0, p1;
#pragma unroll
                for (int i = 0; i < 4; ++i) {
                    p0[i] = (cb + i < nval) ? __builtin_amdgcn_exp2f(s0[i] - m[h]) * il[h] : 0.f;
                    p1[i] = (cb + 16 + i < nval) ? __builtin_amdgcn_exp2f(s1[i] - m[h]) * il[h] : 0.f; }
                i4[0] += p0[0] + p0[1]; i4[1] += p0[2] + p0[3]; i4[2] += p1[0] + p1[1]; i4[3] += p1[2] + p1[3];
                const bf16x8 pf = pack_p(p0, p1);
#pragma unroll
                for (int dt = 0; dt < 4; ++dt) st[h].o[dt] = MFMA16(vf[dt], pf, st[h].o[dt]);
            }
            *(float2*)(imp + qi * 256 + 16 * s + 2 * grp) = make_float2(i4[0], i4[1]);
            *(float2*)(imp + qi * 256 + 16 * s + 8 + 2 * grp) = make_float2(i4[2], i4[3]);
        }
        wave_lds_sync();
    }
    const int cur = t0 >> 6;
    {
        if (cur + 1 <= 16) {
            for (int idx = lane; idx < 256; idx += 64) sel[idx] = ((idx & 15) <= cur) ? (idx & 15) : -1;
        } else {
            for (int q = 0; q < 16; ++q) {
                unsigned key[4];
#pragma unroll
                for (int j = 0; j < 4; ++j) { const int blk = lane + 64 * j; const float v = imp[q * 256 + blk];
                    key[j] = (blk >= 1 && blk <= cur - 2) ? ((__float_as_uint(v) & 0xFFFFFF00u) | (unsigned)(255 - blk)) : 0u; }
                if (lane == 0) { sel[q * 16 + 0] = 0; sel[q * 16 + 1] = cur; sel[q * 16 + 2] = cur - 1; }
                for (int n = 3; n < 16; ++n) {
                    unsigned best = max(max(key[0], key[1]), max(key[2], key[3]));
#pragma unroll
                    for (int o = 1; o < 64; o <<= 1) best = max(best, (unsigned)__shfl_xor((int)best, o));
                    const int blk = 255 - (int)(best & 255u);
#pragma unroll
                    for (int j = 0; j < 4; ++j) if (lane + 64 * j == blk) key[j] = 0u;
                    if (lane == 0) sel[q * 16 + n] = blk;
                }
            }
        }
        wave_lds_sync();
    }
    float* acc = wl;
    {
#pragma unroll
        for (int h = 0; h < 4; ++h) { const float gs = sigmoidf_(grow[h]);
#pragma unroll
            for (int dt = 0; dt < 4; ++dt) *(f32x4*)(acc + (qi * 4 + h) * 64 + 16 * dt + 4 * grp) = st[h].o[dt] * gs; }
        wave_lds_sync();
    }
    {
        const bf16* KF = p.KWF + (size_t)g * T * 64; const bf16* VF = p.VWF + (size_t)g * T * 64;
        int kstart = t0 - 512; if (kstart < 0) kstart = 0; kstart &= ~31;
        const int nsteps = (t0 + 16 - kstart + 31) >> 5;
#pragma unroll
        for (int h = 0; h < 4; ++h) attw_init(st[h]);
        for (int s = 0; s < nsteps; ++s) {
            const int k0 = kstart + 32 * s;
            bf16x8 kf[2][2], vf[4];
#pragma unroll
            for (int tl = 0; tl < 2; ++tl)
#pragma unroll
                for (int ks = 0; ks < 2; ++ks) kf[tl][ks] = *(const bf16x8*)(KF + kfrag_off((k0 >> 4) + tl, ks, lane));
#pragma unroll
            for (int dt = 0; dt < 4; ++dt) vf[dt] = *(const bf16x8*)(VF + vfrag_off(k0 >> 5, dt, lane));
            const bool need_mask = (k0 + 31 > t0) || (k0 < t0 + 15 - 512);
            const int pb = k0 + 4 * grp;
#pragma unroll
            for (int h = 0; h < 4; ++h) {
                f32x4 s0, s1; qk_step(kf, qf[h], s0, s1);
                if (need_mask) {
#pragma unroll
                    for (int i = 0; i < 4; ++i) { const int p0 = pb + i, p1 = pb + 16 + i;
                        if (p0 > t || p0 < t - 512) s0[i] = -INFINITY; if (p1 > t || p1 < t - 512) s1[i] = -INFINITY; }
                }
                att_update(st[h], s0, s1, vf);
            }
        }
#pragma unroll
        for (int h = 0; h < 4; ++h) { const float lt = grp_sum(st[h].l); const float gs = sigmoidf_(grow[16 + h]) * (lt > 0.f ? 1.f / lt : 0.f);
#pragma unroll
            for (int dt = 0; dt < 4; ++dt) { f32x4* a = (f32x4*)(acc + (qi * 4 + h) * 64 + 16 * dt + 4 * grp); *a = *a + st[h].o[dt] * gs; } }
        wave_lds_sync();
    }
    {
        const bf16* KF = p.KSF + (size_t)g * T * 64; const bf16* VF = p.VSF + (size_t)g * T * 64;
        const int hn = lane & 3;
        for (int q = 0; q < 16; ++q) {
            const int tq = t0 + q;
            bf16x8 qs[2];
#pragma unroll
            for (int ks = 0; ks < 2; ++ks) qs[ks] = *(const bf16x8*)(p.QB + (size_t)tq * 512 + (g * 4 + hn) * 64 + 32 * ks + 8 * grp);
            AttW a; attw_init(a);
            for (int bi = 0; bi < 16; ++bi) {
                const int blk = __builtin_amdgcn_readfirstlane(sel[q * 16 + bi]);
                if (blk < 0) continue;
#pragma unroll
                for (int s2 = 0; s2 < 2; ++s2) {
                    const int k0 = blk * 64 + 32 * s2;
                    if (k0 > tq) continue;
                    bf16x8 kf[2][2], vf[4];
#pragma unroll
                    for (int tl = 0; tl < 2; ++tl)
#pragma unroll
                        for (int ks = 0; ks < 2; ++ks) kf[tl][ks] = *(const bf16x8*)(KF + kfrag_off((k0 >> 4) + tl, ks, lane));
#pragma unroll
                    for (int dt = 0; dt < 4; ++dt) vf[dt] = *(const bf16x8*)(VF + vfrag_off(k0 >> 5, dt, lane));
                    f32x4 s0, s1; qk_step(kf, qs, s0, s1);
                    if (k0 + 31 > tq) {
                        const int pb = k0 + 4 * grp;
#pragma unroll
                        for (int i = 0; i < 4; ++i) { if (pb + i > tq) s0[i] = -INFINITY; if (pb + 16 + i > tq) s1[i] = -INFINITY; }
                    }
                    att_update(a, s0, s1, vf);
                }
            }
            const float lt = grp_sum(a.l);
            if (qi < 4) {
                const float gs = sigmoidf_(p.BIGF[(size_t)tq * PA + C_GATE + 8 + g * 4 + qi]) * (lt > 0.f ? 1.f / lt : 0.f);
#pragma unroll
                for (int dt = 0; dt < 4; ++dt) { f32x4* ap = (f32x4*)(acc + (q * 4 + qi) * 64 + 16 * dt + 4 * grp); *ap = *ap + a.o[dt] * gs; }
            }
        }
        wave_lds_sync();
    }
#pragma unroll 4
    for (int q = 0; q < 16; ++q) {
        const f32x4 v = *(const f32x4*)(acc + q * 256 + 4 * lane);
        uint2 o; o.x = pk2(v[0], v[1]); o.y = pk2(v[2], v[3]);
        *(uint2*)(p.MIXB + (size_t)(t0 + q) * 1024 + g * 256 + 4 * lane) = o;
    }
    wave_lds_sync();
}

__device__ __forceinline__ void ph_compress(const KP& p, const Fr& F) {
    float* flat = (float*)F.lds;
    float* hid = (float*)(F.lds + 32768);
    float* res = (float*)(F.lds + 32768 + 2048);
    const float* H0 = p.BIGF;
    const int tid = F.tid;
    for (int item = F.bid; item < 33 * 512; item += F.G) {
        const int c = item & 511, s = item >> 9;
        for (int e = tid; e < 8192; e += NTHR) {
            const int kv = e >> 12, g = (e >> 11) & 1, k = e & 2047, i = k >> 6, d = k & 63;
            const int row = c * 32 + i;
            float v;
            if (s == 0) v = H0[(size_t)row * PA + C_KC + kv * 128 + g * 64 + d];
            else { const int b = s - 1; const int page = p.page_table[b * NPAGES + (row >> 7)];
                   v = p.cache_cmp[((((size_t)page * 128 + (row & 127)) * 2 + kv) * 2 + g) * 64 + d]; }
            flat[e] = v + p.cpe[(kv * 32 + i) * 64 + d];
        }
        __syncthreads();
        {
            const int kv = tid >> 8, g = (tid >> 7) & 1, j = tid & 127;
            const float* w = p.cw1 + (size_t)kv * 2048 * 128 + j;
            const float* fl = flat + (kv * 2 + g) * 2048;
            float acc = p.cb1[kv * 128 + j];
            for (int k = 0; k < 2048; ++k) acc += fl[k] * w[(size_t)k * 128];
            hid[(kv * 2 + g) * 128 + j] = gelu_tanh(acc);
        }
        __syncthreads();
        if (tid < 256) {
            const int kv = tid >> 7, g = (tid >> 6) & 1, d = tid & 63;
            const float* w = p.cw2 + (size_t)kv * 128 * 64 + d;
            const float* hh = hid + (kv * 2 + g) * 128;
            float acc = 0.f;
            for (int j = 0; j < 128; ++j) acc += hh[j] * w[j * 64];
            res[(kv * 2 + g) * 64 + d] = acc;
        }
        __syncthreads();
        if (tid < 256) {
            const int kv = tid >> 7, g = (tid >> 6) & 1, d = tid & 63;
            const float* rr = res + (kv * 2 + g) * 64;
            float v = rr[d];
            if (kv == 0) {
                const int pos = (c + 1) * 32 - 1; const float2 cs = p.ROPE[pos * 32 + (d & 31)];
                const float x1 = rr[d & 31], x2 = rr[(d & 31) + 32];
                v = (d < 32) ? (x1 * cs.x - x2 * cs.y) : (x2 * cs.x + x1 * cs.y);
                p.CK[(((size_t)s * 512 + c) * 2 + g) * 64 + d] = v;
                if (s == 0) p.CKF[(size_t)g * 512 * 64 + kfrag_elem(c, d)] = (bf16)f2bf(v);
            } else { p.CV[(((size_t)s * 512 + c) * 2 + g) * 64 + d] = v; if (s == 0) p.CVF[(size_t)g * 512 * 64 + vfrag_elem(c, d)] = (bf16)f2bf(v); }
        }
        __syncthreads();
    }
}

__device__ __forceinline__ void ph_gdn_prep(const KP& p, const Fr& F) {
    const float* H0 = p.BIGF; const int lane = F.lane;
    for (int item = F.gw; item < TS * 8; item += F.NGW) {
        const int r = item >> 3, h = item & 7;
        const bool smp = r >= T; const int b = r - T;
        float cv[3];
#pragma unroll
        for (int part = 0; part < 3; ++part) {
            const int ch = part * 512 + h * 64 + lane;
            float acc = 0.f;
#pragma unroll
            for (int j = 0; j < 4; ++j) {
                float u;
                if (!smp) { const int t = r + j - 3; u = (t >= 0) ? H0[(size_t)t * PA + C_GQKV + ch] : 0.f; }
                else { u = (j < 3) ? p.st_gconv[((size_t)b * 3 + j) * 1536 + ch] : H0[(size_t)r * PA + C_GQKV + ch]; }
                acc += p.gconv_w[j * 1536 + ch] * u;
            }
            cv[part] = siluf_(acc);
        }
        const float qn = wave_sum(cv[0] * cv[0]), kn = wave_sum(cv[1] * cv[1]);
        const size_t o = ((size_t)r * 8 + h) * 64 + lane;
        p.GQ[o] = cv[0] * rsqrtf(qn + NORM_EPS) * 0.125f;
        p.GK[o] = cv[1] * rsqrtf(kn + NORM_EPS);
        p.GV[o] = cv[2];
        if (lane == 0) {
            const float av = H0[(size_t)r * PA + C_A + h], bt = H0[(size_t)r * PA + C_BT + h];
            p.Gg[(size_t)r * 8 + h] = -expf(p.gA[h]) * softplusf_(av + p.gdt[h]);
            p.Gb[(size_t)r * 8 + h] = sigmoidf_(bt);
        }
    }
    const size_t gt = (size_t)F.bid * NTHR + F.tid, GT = (size_t)F.G * NTHR;
    for (size_t idx = gt; idx < (size_t)3 * 1536; idx += GT) {
        const int j = (int)(idx / 1536), ch = (int)(idx % 1536);
        p.out[O_GCONV_P + idx] = H0[(size_t)(T - 3 + j) * PA + C_GQKV + ch];
    }
    for (size_t idx = gt; idx < (size_t)NSMP * 3 * 1536; idx += GT) {
        const int b = (int)(idx / (3 * 1536)), j = (int)((idx / 1536) % 3), ch = (int)(idx % 1536);
        p.out[O_GCONV_S + idx] = (j < 2) ? p.st_gconv[((size_t)b * 3 + j + 1) * 1536 + ch] : H0[(size_t)(T + b) * PA + C_GQKV + ch];
    }
}

template <int NH, class KF>
__device__ __forceinline__ void wave_attend(const float* qs, float* sc, int scstride, int nkeys, KF kf, float (&outv)[NH], float (&den)[NH], int lane) {
    float mx[NH];
#pragma unroll
    for (int h = 0; h < NH; ++h) mx[h] = -INFINITY;
    for (int j = lane; j < nkeys; j += 64) {
        const float *kp, *vp; const bool ok = kf(j, kp, vp);
        float s[NH];
#pragma unroll
        for (int h = 0; h < NH; ++h) s[h] = 0.f;
        if (ok) {
            for (int d4 = 0; d4 < 16; ++d4) {
                const float4 kvv = ((const float4*)kp)[d4];
#pragma unroll
                for (int h = 0; h < NH; ++h) { const float* q = qs + h * 64 + d4 * 4; s[h] += kvv.x * q[0] + kvv.y * q[1] + kvv.z * q[2] + kvv.w * q[3]; }
            }
        }
#pragma unroll
        for (int h = 0; h < NH; ++h) { const float v = ok ? s[h] * 0.125f : -INFINITY; sc[h * scstride + j] = v; mx[h] = fmaxf(mx[h], v); }
    }
#pragma unroll
    for (int h = 0; h < NH; ++h) { mx[h] = wave_max(mx[h]); if (!(mx[h] > -INFINITY)) mx[h] = 0.f; }
    float sm[NH];
#pragma unroll
    for (int h = 0; h < NH; ++h) sm[h] = 0.f;
    for (int j = lane; j < nkeys; j += 64) {
#pragma unroll
        for (int h = 0; h < NH; ++h) { const float v = sc[h * scstride + j]; const float pp = (v == -INFINITY) ? 0.f : expf(v - mx[h]); sc[h * scstride + j] = pp; sm[h] += pp; }
    }
#pragma unroll
    for (int h = 0; h < NH; ++h) { sm[h] = wave_sum(sm[h]); den[h] = sm[h] > 0.f ? sm[h] : 1.f; }
    wave_lds_sync();
#pragma unroll
    for (int h = 0; h < NH; ++h) outv[h] = 0.f;
    for (int j = 0; j < nkeys; ++j) {
        const float *kp, *vp; const bool ok = kf(j, kp, vp);
        if (ok) { const float v = vp[lane];
#pragma unroll
            for (int h = 0; h < NH; ++h) outv[h] += sc[h * scstride + j] * v; }
    }
#pragma unroll
    for (int h = 0; h < NH; ++h) outv[h] /= den[h];
    wave_lds_sync();
}

__device__ __forceinline__ void nsa_item(const KP& p, int item, float* wl, int lane) {
    float* qs = wl; float* sc = wl + 256; float* imp = wl + 256 + 4 * 1088; int* sel = (int*)(wl + 256 + 4 * 1088 + 320);
    const float* H0 = p.BIGF;
    const int r = item >> 1, g = item & 1;
    const bool smp = r >= T; const int b = r - T; const int qpos = smp ? T : r;
#pragma unroll
    for (int h = 0; h < 4; ++h) qs[h * 64 + lane] = p.QR[(size_t)r * 512 + (g * 4 + h) * 64 + lane];
    wave_lds_sync();
    float ocmp[4], oslc[4], owin[4], den[4];
    {
        const int s = smp ? 1 + b : 0;
        const float* CKp = p.CK + (size_t)s * 512 * 128; const float* CVp = p.CV + (size_t)s * 512 * 128;
        int nk = (qpos + 1) / 32; if (nk > 512) nk = 512;
        auto kf = [&](int j, const float*& kp, const float*& vp) -> bool { kp = CKp + (j * 2 + g) * 64; vp = CVp + (j * 2 + g) * 64; return true; };
        wave_attend<4>(qs, sc, 1088, nk, kf, ocmp, den, lane);
        for (int blk = lane; blk < 320; blk += 64) {
            float v = 0.f;
#pragma unroll
            for (int h = 0; h < 4; ++h) {
                const int c0 = 2 * blk, c1 = 2 * blk + 1;
                if (c0 < nk) v += sc[h * 1088 + c0] / den[h];
                if (c1 < nk) v += sc[h * 1088 + c1] / den[h];
            }
            imp[blk] = v;
        }
        wave_lds_sync();
    }
    {
        const int cur = qpos >> 6; const int nv = cur + 1;
        if (nv <= 16) { if (lane < 16) sel[lane] = (lane < nv) ? lane : -1; }
        else {
            float val[5];
#pragma unroll
            for (int j = 0; j < 5; ++j) { const int blk = lane + 64 * j; val[j] = (blk >= 1 && blk <= cur - 2) ? imp[blk] : -1.f; }
            if (lane == 0) { sel[0] = 0; sel[1] = cur; sel[2] = cur - 1; }
            for (int n = 3; n < 16; ++n) {
                float bv = -2.f; int bi = 0x7fffffff;
#pragma unroll
                for (int j = 0; j < 5; ++j) if (val[j] > bv) { bv = val[j]; bi = lane + 64 * j; }
#pragma unroll
                for (int o = 1; o < 64; o <<= 1) { const float ov = __shfl_xor(bv, o); const int oi = __shfl_xor(bi, o); if (ov > bv || (ov == bv && oi < bi)) { bv = ov; bi = oi; } }
#pragma unroll
                for (int j = 0; j < 5; ++j) if (lane + 64 * j == bi) val[j] = -3.f;
                if (lane == 0) sel[n] = bi;
            }
        }
        wave_lds_sync();
    }
    {
        auto kf = [&](int j, const float*& kp, const float*& vp) -> bool {
            const int blk = sel[j >> 6]; if (blk < 0) return false;
            const int pos = blk * 64 + (j & 63); if (pos > qpos) return false;
            if (!smp) { kp = p.KS + (size_t)pos * 128 + g * 64; vp = p.VS + (size_t)pos * 128 + g * 64; return true; }
            if (pos == T) { kp = p.KS + (size_t)r * 128 + g * 64; vp = p.VS + (size_t)r * 128 + g * 64; return true; }
            const int page = p.page_table[b * NPAGES + (pos >> 7)];
            const float* base = p.cache_slc + ((size_t)page * 128 + (pos & 127)) * 256;
            kp = base + g * 64; vp = base + 128 + g * 64; return true; };
        wave_attend<4>(qs, sc, 1088, 1024, kf, oslc, den, lane);
    }
    {
        auto kf = [&](int j, const float*& kp, const float*& vp) -> bool {
            if (!smp) { const int pos = qpos - 512 + j; if (pos < 0) return false; kp = p.KW + (size_t)pos * 128 + g * 64; vp = p.VW + (size_t)pos * 128 + g * 64; return true; }
            if (j == 512) { kp = p.KW + (size_t)r * 128 + g * 64; vp = p.VW + (size_t)r * 128 + g * 64; return true; }
            const float* base = p.st_win + ((size_t)b * 512 + j) * 256;
            kp = base + g * 64; vp = base + 128 + g * 64; return true; };
        wave_attend<4>(qs, sc, 1088, 513, kf, owin, den, lane);
    }
    const float* grow = H0 + (size_t)r * PA + C_GATE;
#pragma unroll
    for (int h = 0; h < 4; ++h) {
        const int hh = g * 4 + h;
        const float o = sigmoidf_(grow[hh]) * ocmp[h] + sigmoidf_(grow[8 + hh]) * oslc[h] + sigmoidf_(grow[16 + hh]) * owin[h];
        p.MIXB[(size_t)r * 1024 + hh * 64 + lane] = (bf16)f2bf(o);
    }
    wave_lds_sync();
}

__device__ __forceinline__ void gdn_scan_item(const KP& p, int item, float* wl, int lane) {
    float* kq = wl;
    const int seq = item >> 3, h = item & 7;
    float S[64];
    if (seq == 0) {
#pragma unroll
        for (int i = 0; i < 64; ++i) S[i] = 0.f;
    } else {
#pragma unroll
        for (int i = 0; i < 64; ++i) S[i] = p.st_gS[(((size_t)(seq - 1) * 8 + h) * 64 + i) * 64 + lane];
    }
    const int r0 = seq == 0 ? 0 : T + seq - 1, n = seq == 0 ? T : 1;
    for (int t = 0; t < n; ++t) {
        const int r = r0 + t; const size_t o = ((size_t)r * 8 + h) * 64;
        wave_lds_sync();
        kq[lane] = p.GK[o + lane]; kq[64 + lane] = p.GQ[o + lane];
        wave_lds_sync();
        const float dec = expf(p.Gg[(size_t)r * 8 + h]), bt = p.Gb[(size_t)r * 8 + h];
        float kv = 0.f;
#pragma unroll
        for (int i = 0; i < 64; ++i) { S[i] *= dec; kv += kq[i] * S[i]; }
        const float vn = (p.GV[o + lane] - kv) * bt;
        float ov = 0.f;
#pragma unroll
        for (int i = 0; i < 64; ++i) { S[i] += kq[i] * vn; ov += kq[64 + i] * S[i]; }
        p.OG[o + lane] = ov;
    }
    float* so = (seq == 0) ? p.out + O_GS_P + (size_t)h * 4096 : p.out + O_GS_S + ((size_t)(seq - 1) * 8 + h) * 4096;
#pragma unroll
    for (int i = 0; i < 64; ++i) so[i * 64 + lane] = S[i];
}

constexpr int GDN_WL = 34816;
__device__ __forceinline__ int kperm(int ks, int grp, int j) { return 32 * ks + 16 * (j >> 2) + 4 * grp + (j & 3); }

__device__ __forceinline__ void gdn_chunk_unit(const KP& p, int unit, unsigned char* ldsb, int woff, int lane) {
    asm volatile("" : "+v"(lane), "+s"(woff));
    unsigned char* wlb = ldsb + woff;
    const int n = unit >> 3, h = unit & 7, t0 = 64 * n;
    const int l15 = lane & 15, grp = lane >> 4;
    float* Af = (float*)wlb; bf16* kt = (bf16*)(wlb + 16384); bf16* qt = kt + 64 * 72; bf16* tmp = (bf16*)wlb;
#pragma unroll 8
    for (int i = 0; i < 64; ++i) {
        const size_t o = ((size_t)(t0 + i) * 8 + h) * 64 + lane;
        kt[i * 72 + lane] = (bf16)f2bf(p.GK[o]); qt[i * 72 + lane] = (bf16)f2bf(p.GQ[o]);
    }
    const float gl_ = p.Gg[(size_t)(t0 + lane) * 8 + h], beta = p.Gb[(size_t)(t0 + lane) * 8 + h];
    float gc = gl_;
#pragma unroll
    for (int o = 1; o < 64; o <<= 1) { const float tv = __shfl_up(gc, o); if (lane >= o) gc += tv; }
    const float gclast = __shfl(gc, 63);
#define GPAD(i) ((float*)(kt + (i) * 72 + 64))
    { float* pd = GPAD(lane); pd[0] = gc; pd[1] = beta; pd[2] = expf(gc); pd[3] = expf(gclast - gc); }
    wave_lds_sync();
    bf16* QKF = p.G_QKF + (size_t)unit * 4096;
#pragma unroll
    for (int it = 0; it < 4; ++it) {
        const int i = 16 * it + l15;
        const float gci = GPAD(i)[0], bi = GPAD(i)[1];
        bf16x8 bk[2], bq[2];
#pragma unroll
        for (int ks = 0; ks < 2; ++ks) { bk[ks] = *(const bf16x8*)(kt + i * 72 + 32 * ks + 8 * grp); bq[ks] = *(const bf16x8*)(qt + i * 72 + 32 * ks + 8 * grp); }
#pragma unroll
        for (int jt = 0; jt < 4; ++jt) {
            uint2 qkp = make_uint2(0u, 0u);
            if (jt <= it) {
                bf16x8 ak[2];
#pragma unroll
                for (int ks = 0; ks < 2; ++ks) ak[ks] = *(const bf16x8*)(kt + (16 * jt + l15) * 72 + 32 * ks + 8 * grp);
                f32x4 aa = {0.f, 0.f, 0.f, 0.f}, aq = {0.f, 0.f, 0.f, 0.f};
                aa = MFMA16(ak[0], bk[0], aa); aa = MFMA16(ak[1], bk[1], aa);
                aq = MFMA16(ak[0], bq[0], aq); aq = MFMA16(ak[1], bq[1], aq);
                f32x4 av, qv;
#pragma unroll
                for (int r = 0; r < 4; ++r) {
                    const int j = 16 * jt + 4 * grp + r; const float gcj = GPAD(j)[0];
                    const float e = (j <= i) ? expf(gci - gcj) : 0.f;
                    av[r] = (j < i) ? bi * aa[r] * e : 0.f; qv[r] = aq[r] * e;
                }
                *(f32x4*)(Af + i * 64 + 16 * jt + 4 * grp) = av;
                qkp.x = pk2(qv[0], qv[1]); qkp.y = pk2(qv[2], qv[3]);
            }
            *(uint2*)(QKF + ((size_t)(it * 2 + (jt >> 1)) * 64 + lane) * 8 + (jt & 1) * 4) = qkp;
        }
    }
    wave_lds_sync();
    {
        float* UF = p.G_UF + (size_t)unit * 4096;
        const int vq = lane >> 4;
#pragma unroll
        for (int pass = 0; pass < 2; ++pass) {
            float x[64];
            int goff = 0;
#pragma unroll
            for (int i = 0; i < 64; ++i) {
                const float bi = GPAD(i)[1];
                float acc;
                if (pass == 0) { acc = p.GV[((size_t)t0 * 8 + h) * 64 + lane + goff] * bi; goff += 512; asm volatile("" : "+s"(goff)); }
                else { const float ei = GPAD(i)[2];
                       acc = __uint_as_float((unsigned)kt[i * 72 + lane] << 16) * bi * ei; }
#pragma unroll
                for (int jj = 0; jj < (i + 3) / 4; ++jj) {
                    const float4 a4 = *(const float4*)(Af + i * 64 + 4 * jj);
                    acc -= a4.x * x[4 * jj + 0];
                    if (4 * jj + 1 < i) acc -= a4.y * x[4 * jj + 1];
                    if (4 * jj + 2 < i) acc -= a4.z * x[4 * jj + 2];
                    if (4 * jj + 3 < i) acc -= a4.w * x[4 * jj + 3];
                }
                x[i] = acc;
                if ((i & 3) == 3) asm volatile("" ::: "memory");
            }
            if (pass == 0) {
#pragma unroll
                for (int c4 = 0; c4 < 16; ++c4) {
                    const int mt = c4 >> 2, lp = l15 + 16 * (c4 & 3);
                    *(f32x4*)(UF + ((size_t)(vq * 4 + mt) * 64 + lp) * 4) = (f32x4){x[4 * c4], x[4 * c4 + 1], x[4 * c4 + 2], x[4 * c4 + 3]};
                }
            } else {
                wave_lds_sync();
#pragma unroll
                for (int c = 0; c < 64; ++c) tmp[c * 72 + lane] = (bf16)f2bf(-x[c]);
            }
            asm volatile("" ::: "memory");
        }
    }
    wave_lds_sync();
    {
        bf16* WF = p.G_WF + (size_t)unit * 4096; bf16* QGF = p.G_QGF + (size_t)unit * 4096; bf16* KDF = p.G_KDF + (size_t)unit * 4096;
#pragma unroll
        for (int mt = 0; mt < 4; ++mt) {
            const float egc = GPAD(16 * mt + l15)[2];
#pragma unroll
            for (int ks = 0; ks < 2; ++ks) {
                const int c = 16 * mt + l15, k0 = 32 * ks + 4 * grp;
                const uint2 w0 = *(const uint2*)(tmp + c * 72 + k0), w1 = *(const uint2*)(tmp + c * 72 + k0 + 16);
                v4u wv; wv.x = w0.x; wv.y = w0.y; wv.z = w1.x; wv.w = w1.y;
                *(v4u*)(WF + ((size_t)(mt * 2 + ks) * 64 + lane) * 8) = wv;
                const uint2 q0 = *(const uint2*)(qt + c * 72 + k0), q1 = *(const uint2*)(qt + c * 72 + k0 + 16);
                v4u qv;
                qv.x = pk2(__uint_as_float(q0.x << 16) * egc, __uint_as_float(q0.x & 0xffff0000u) * egc); qv.y = pk2(__uint_as_float(q0.y << 16) * egc, __uint_as_float(q0.y & 0xffff0000u) * egc);
                qv.z = pk2(__uint_as_float(q1.x << 16) * egc, __uint_as_float(q1.x & 0xffff0000u) * egc); qv.w = pk2(__uint_as_float(q1.y << 16) * egc, __uint_as_float(q1.y & 0xffff0000u) * egc);
                *(v4u*)(QGF + ((size_t)(mt * 2 + ks) * 64 + lane) * 8) = qv;
                float kd[8];
#pragma unroll
                for (int j = 0; j < 8; ++j) { const int cc = kperm(ks, grp, j); kd[j] = __uint_as_float((unsigned)kt[cc * 72 + 16 * mt + l15] << 16) * GPAD(cc)[3]; }
                v4u kv; kv.x = pk2(kd[0], kd[1]); kv.y = pk2(kd[2], kd[3]); kv.z = pk2(kd[4], kd[5]); kv.w = pk2(kd[6], kd[7]);
                *(v4u*)(KDF + ((size_t)(mt * 2 + ks) * 64 + lane) * 8) = kv;
            }
        }
        if (lane == 0) p.G_GL[unit] = expf(gclast);
    }
    wave_lds_sync();
#undef GPAD
}

__device__ __forceinline__ void gdn_chain(const KP& p, int h, int vq, int lane) {
    const int l15 = lane & 15, grp = lane >> 4;
    f32x4 S[4];
#pragma unroll
    for (int i = 0; i < 4; ++i) S[i] = (f32x4){0.f, 0.f, 0.f, 0.f};
    bf16x8 wf[4][2], kdf[4][2]; f32x4 uf[4]; float gl;
    auto load = [&](int n, bf16x8 (&W)[4][2], bf16x8 (&K)[4][2], f32x4 (&U)[4], float& G) {
        const int unit = n * 8 + h;
        const bf16* WF = p.G_WF + (size_t)unit * 4096; const bf16* KDF = p.G_KDF + (size_t)unit * 4096; const float* UF = p.G_UF + (size_t)unit * 4096;
#pragma unroll
        for (int mt = 0; mt < 4; ++mt) {
#pragma unroll
            for (int ks = 0; ks < 2; ++ks) { W[mt][ks] = *(const bf16x8*)(WF + ((size_t)(mt * 2 + ks) * 64 + lane) * 8); K[mt][ks] = *(const bf16x8*)(KDF + ((size_t)(mt * 2 + ks) * 64 + lane) * 8); }
            U[mt] = *(const f32x4*)(UF + ((size_t)(vq * 4 + mt) * 64 + lane) * 4);
        }
        G = p.G_GL[unit];
    };
    load(0, wf, kdf, uf, gl);
    for (int n = 0; n < 256; ++n) {
        bf16x8 wn[4][2], kn[4][2]; f32x4 un[4]; float gn;
        const int nn = (n + 1 < 256) ? n + 1 : n;
        load(nn, wn, kn, un, gn);
        const size_t fo = ((size_t)((n * 8 + h) * 4 + vq) * 2) * 512;
        bf16x8 sB[2];
#pragma unroll
        for (int ks = 0; ks < 2; ++ks) { sB[ks] = pack_p(S[2 * ks], S[2 * ks + 1]); *(bf16x8*)(p.G_SPF + fo + ((size_t)ks * 64 + lane) * 8) = sB[ks]; }
        f32x4 v[4];
#pragma unroll
        for (int mt = 0; mt < 4; ++mt) { v[mt] = uf[mt]; v[mt] = MFMA16(wf[mt][0], sB[0], v[mt]); v[mt] = MFMA16(wf[mt][1], sB[1], v[mt]); }
        bf16x8 vB[2];
#pragma unroll
        for (int ks = 0; ks < 2; ++ks) { vB[ks] = pack_p(v[2 * ks], v[2 * ks + 1]); *(bf16x8*)(p.G_VNF + fo + ((size_t)ks * 64 + lane) * 8) = vB[ks]; }
#pragma unroll
        for (int mt = 0; mt < 4; ++mt) { S[mt] = S[mt] * gl; S[mt] = MFMA16(kdf[mt][0], vB[0], S[mt]); S[mt] = MFMA16(kdf[mt][1], vB[1], S[mt]); }
#pragma unroll
        for (int mt = 0; mt < 4; ++mt) {
#pragma unroll
            for (int ks = 0; ks < 2; ++ks) { wf[mt][ks] = wn[mt][ks]; kdf[mt][ks] = kn[mt][ks]; }
            uf[mt] = un[mt];
        }
        gl = gn;
    }
    float* so = p.out + O_GS_P + (size_t)h * 4096;
#pragma unroll
    for (int mt = 0; mt < 4; ++mt)
#pragma unroll
        for (int r = 0; r < 4; ++r) so[(16 * mt + 4 * grp + r) * 64 + 16 * vq + l15] = S[mt][r];
}

__device__ __forceinline__ void gdn_out_unit(const KP& p, int unit, int lane) {
    asm volatile("" : "+v"(lane));
    const int n = unit >> 3, h = unit & 7, t0 = 64 * n; const int l15 = lane & 15, grp = lane >> 4;
    const bf16* QGF = p.G_QGF + (size_t)unit * 4096; const bf16* QKF = p.G_QKF + (size_t)unit * 4096;
    f32x4 o[4][4];
#pragma unroll
    for (int mt = 0; mt < 4; ++mt)
#pragma unroll
        for (int vq = 0; vq < 4; ++vq) o[mt][vq] = (f32x4){0.f, 0.f, 0.f, 0.f};
#pragma unroll
    for (int ks = 0; ks < 2; ++ks) {
        bf16x8 sp[4], vn[4];
#pragma unroll
        for (int vq = 0; vq < 4; ++vq) { const size_t fo = ((size_t)(unit * 4 + vq) * 2 + ks) * 512 + (size_t)lane * 8; sp[vq] = *(const bf16x8*)(p.G_SPF + fo); vn[vq] = *(const bf16x8*)(p.G_VNF + fo); }
#pragma unroll
        for (int mt = 0; mt < 4; ++mt) {
            const bf16x8 qg = *(const bf16x8*)(QGF + ((size_t)(mt * 2 + ks) * 64 + lane) * 8), qk = *(const bf16x8*)(QKF + ((size_t)(mt * 2 + ks) * 64 + lane) * 8);
#pragma unroll
            for (int vq = 0; vq < 4; ++vq) { o[mt][vq] = MFMA16(qg, sp[vq], o[mt][vq]); o[mt][vq] = MFMA16(qk, vn[vq], o[mt][vq]); }
        }
    }
    float nw[4];
#pragma unroll
    for (int vq = 0; vq < 4; ++vq) nw[vq] = p.gnw[16 * vq + l15];
#pragma unroll
    for (int mt = 0; mt < 4; ++mt)
#pragma unroll
        for (int r = 0; r < 4; ++r) {
            float ss = 0.f;
#pragma unroll
            for (int vq = 0; vq < 4; ++vq) ss += o[mt][vq][r] * o[mt][vq][r];
            ss += __shfl_xor(ss, 1); ss += __shfl_xor(ss, 2); ss += __shfl_xor(ss, 4); ss += __shfl_xor(ss, 8);
            const float rs = rsqrtf(ss * (1.f / 64.f) + NORM_EPS);
            const int t = t0 + 16 * mt + 4 * grp + r;
            const float* zr = p.BIGF + (size_t)t * PA + C_Z + h * 64;
#pragma unroll
            for (int vq = 0; vq < 4; ++vq) p.MIXB[(size_t)t * 1024 + 512 + h * 64 + 16 * vq + l15] = (bf16)f2bf(o[mt][vq][r] * rs * nw[vq] * siluf_(zr[16 * vq + l15]));
        }
}

__device__ __forceinline__ void ph_gdn_chunks(const KP& p, const Fr& F) {
    if (F.wave < 4) for (int unit = F.bid * 4 + F.wave; unit < 2048; unit += F.G * 4) gdn_chunk_unit(p, unit, F.lds, F.wave * GDN_WL, F.lane);
}
__device__ __forceinline__ void ph_mix(const KP& p, const Fr& F) {
    if (F.bid < 8) { if (F.wave < 4) gdn_chain(p, F.bid, F.wave, F.lane); return; }
    if (F.bid < 40) gdn_scan_item(p, (F.bid - 7) * 8 + F.wave, (float*)(F.lds + 8 * FAST_WL + 1024 + F.wave * 512), F.lane);
    if (F.bid >= 40 && F.bid < 56) {
        if (F.wave < 4) nsa_item(p, T * 2 + (F.bid - 40) * 4 + F.wave, (float*)(F.lds + F.wave * 20480), F.lane);
    } else {
        const int fr = (F.bid < 40) ? F.bid - 8 : F.bid - 24;
        const int NFW = (F.G - 24) * 8;
        float* wl = (float*)(F.lds + F.wave * FAST_WL);
        for (int unit = fr * 8 + F.wave; unit < 2048; unit += NFW) nsa_fast_unit(p, unit, wl, F.lane);
    }
}

__device__ __forceinline__ void ph_gdn_out(const KP& p, const Fr& F) {
    const float* H0 = p.BIGF; const int lane = F.lane;
    for (int unit = F.gw; unit < 2048; unit += F.NGW) gdn_out_unit(p, unit, lane);
    for (int item = T * 8 + F.gw; item < TS * 8; item += F.NGW) {
        const int r = item >> 3, h = item & 7;
        const float o = p.OG[((size_t)r * 8 + h) * 64 + lane];
        const float ms = wave_sum(o * o) * (1.f / 64.f);
        const float z = H0[(size_t)r * PA + C_Z + h * 64 + lane];
        p.MIXB[(size_t)r * 1024 + 512 + h * 64 + lane] = (bf16)f2bf(o * rsqrtf(ms + NORM_EPS) * p.gnw[lane] * siluf_(z));
    }
}

__device__ __forceinline__ void ph_ln(const Fr& F, const float* Xp, const float* Xs, const float* Fm, const float* gam, const float* bet, float* outp, float* outs, bf16* ob) {
    const int lane = F.lane;
    for (int r = F.gw; r < TS; r += F.NGW) {
        const float* xr = (r < T) ? Xp + (size_t)r * DM : Xs + (size_t)(r - T) * DM;
        float v[16]; float s = 0.f;
#pragma unroll
        for (int j = 0; j < 16; ++j) { const int c = lane + 64 * j; v[j] = DN_ALPHA * xr[c] + Fm[(size_t)r * DM + c]; s += v[j]; }
        const float mean = wave_sum(s) * (1.f / DM); float q = 0.f;
#pragma unroll
        for (int j = 0; j < 16; ++j) { v[j] -= mean; q += v[j] * v[j]; }
        const float rstd = rsqrtf(wave_sum(q) * (1.f / DM) + LN_EPS);
        float* o = (r < T) ? outp + (size_t)r * DM : outs + (size_t)(r - T) * DM;
#pragma unroll
        for (int j = 0; j < 16; ++j) { const int c = lane + 64 * j; const float y = v[j] * rstd * gam[c] + bet[c]; o[c] = y; if (ob) ob[(size_t)r * DM + c] = (bf16)f2bf(y); }
    }
}

__device__ __forceinline__ void ph_ffn_act(const KP& p, const Fr& F, int layer) {
    const float* U = p.BIGF; const float* cw = p.ffn_cw + (size_t)layer * 3 * DFF2; const float* cb = p.ffn_cb + (size_t)layer * DFF2;
    const size_t gt = (size_t)F.bid * NTHR + F.tid, GT = (size_t)F.G * NTHR;
    const size_t total = (size_t)TS * DFF;
    for (size_t idx = gt; idx < total; idx += GT) {
        const int r = (int)(idx / DFF), j = (int)(idx % DFF);
        const bool smp = r >= T; const int b = r - T;
        float c2[2];
#pragma unroll
        for (int half = 0; half < 2; ++half) {
            const int ch = half * DFF + j;
            float acc = cb[ch];
#pragma unroll
            for (int k = 0; k < 3; ++k) {
                float u;
                if (!smp) { const int t = r + k - 2; u = (t >= 0) ? U[(size_t)t * DFF2 + ch] : 0.f; }
                else u = (k < 2) ? p.st_ffn[(((size_t)b * 2 + layer) * 2 + k) * DFF2 + ch] : U[(size_t)r * DFF2 + ch];
                acc += cw[k * DFF2 + ch] * u;
            }
            c2[half] = acc;
        }
        p.HFFB[idx] = (bf16)f2bf(siluf_(c2[0]) * c2[1]);
    }
    for (size_t idx = gt; idx < (size_t)2 * DFF2; idx += GT) {
        const int k = (int)(idx / DFF2), ch = (int)(idx % DFF2);
        p.out[O_FFN_P + ((size_t)layer * 2 + k) * DFF2 + ch] = U[(size_t)(T - 2 + k) * DFF2 + ch];
    }
    for (size_t idx = gt; idx < (size_t)NSMP * 2 * DFF2; idx += GT) {
        const int b = (int)(idx / (2 * DFF2)), k = (int)((idx / DFF2) % 2), ch = (int)(idx % DFF2);
        p.out[O_FFN_S + (((size_t)b * 2 + layer) * 2 + k) * DFF2 + ch] =
            (k == 0) ? p.st_ffn[(((size_t)b * 2 + layer) * 2 + 1) * DFF2 + ch] : U[(size_t)(T + b) * DFF2 + ch];
    }
}

__device__ __forceinline__ void ph_dil_prep(const KP& p, const Fr& F) {
    const float* H1 = p.BIGF;
    const size_t gt = (size_t)F.bid * NTHR + F.tid, GT = (size_t)F.G * NTHR;
    const size_t total = (size_t)TS * 2048;
    for (size_t idx = gt + (size_t)T * 2048; idx < total; idx += GT) {
        const int r = (int)(idx >> 11), c = (int)(idx & 2047);
        const bool smp = r >= T; const int pos = smp ? T : r;
        const float* row = H1 + (size_t)r * 3072;
        const int i = c & 63; const float2 cs = p.ROPE[pos * 32 + (i & 31)];
        const float v = rope_val(row, c & ~63, i, cs);
        if (c < 1024) p.QD[(size_t)r * 1024 + c] = v; else p.KD[(size_t)r * 1024 + (c - 1024)] = v;
    }
}
__device__ __forceinline__ void ph_dil_cache(const KP& p, const Fr& F) {
    const float* H1 = p.BIGF;
    const size_t gt = (size_t)F.bid * NTHR + F.tid, GT = (size_t)F.G * NTHR;
    const size_t tots4 = (size_t)NSMP * 2048 * 512;
    for (size_t idx = gt; idx < tots4; idx += GT) {
        const int b = (int)(idx / (2048 * 512)); const int i = (int)((idx / 512) % 2048); const int c4 = (int)(idx % 512);
        float4 v;
        if (i < 2047) v = ((const float4*)p.st_dil)[((size_t)b * 2048 + i + 1) * 512 + c4];
        else { const int c = c4 * 4; const int r = T + b;
               v = (c < 1024) ? *(const float4*)(p.KD + (size_t)r * 1024 + c) : *(const float4*)(H1 + (size_t)r * 3072 + 2048 + (c - 1024)); }
        ((float4*)(p.out + O_DIL_S))[idx] = v;
    }
}
__device__ __forceinline__ void ph_dil_attn(const KP& p, const Fr& F) {
    const float* H1 = p.BIGF; const int lane = F.lane;
    float* qs = (float*)(F.lds + F.wave * 4096); float* sc = qs + 64;
    for (int item = T * 16 + F.gw; item < TS * 16; item += F.NGW) {
        const int r = item >> 4, h = item & 15;
        const bool smp = r >= T; const int b = r - T; const int qpos = smp ? T : r;
        qs[lane] = p.QD[(size_t)r * 1024 + h * 64 + lane];
        wave_lds_sync();
        auto kf = [&](int j, const float*& kp, const float*& vp) -> bool {
            const int gi = j / 129, m = j - gi * 129; const int dd = gi == 0 ? 1 : (gi == 1 ? 4 : 16);
            const int pos = qpos - m * dd; if (pos < 0) return false;
            if (!smp || pos == T) { const int rr = smp ? r : pos; kp = p.KD + (size_t)rr * 1024 + h * 64; vp = H1 + (size_t)rr * 3072 + 2048 + h * 64; return true; }
            const int bi = pos - (T - 2048);
            const float* base = p.st_dil + ((size_t)b * 2048 + bi) * 2048;
            kp = base + h * 64; vp = base + 1024 + h * 64; return true; };
        float o[1], den[1];
        wave_attend<1>(qs, sc, 448, 387, kf, o, den, lane);
        p.MIXB[(size_t)r * 1024 + h * 64 + lane] = (bf16)f2bf(o[0]);
        wave_lds_sync();
    }
}

__device__ __forceinline__ void ph_dil_prep_fast(const KP& p, const Fr& F) {
    const float* H1 = p.BIGF;
    const size_t gt = (size_t)F.bid * NTHR + F.tid, GT = (size_t)F.G * NTHR;
    for (size_t idx = gt; idx < (size_t)T * 256; idx += GT) {
        const int t = (int)(idx >> 8), u = (int)(idx & 255);
        const int c0 = u * 8; const float* row = H1 + (size_t)t * 3072;
        const float4 a0 = *(const float4*)(row + c0), a1 = *(const float4*)(row + c0 + 4);
        float v[8] = {a0.x, a0.y, a0.z, a0.w, a1.x, a1.y, a1.z, a1.w};
        const int d0 = c0 & 63; const int pc = (d0 < 32) ? c0 + 32 : c0 - 32;
        const float4 b0 = *(const float4*)(row + pc), b1 = *(const float4*)(row + pc + 4);
        const float w[8] = {b0.x, b0.y, b0.z, b0.w, b1.x, b1.y, b1.z, b1.w};
#pragma unroll
        for (int j = 0; j < 8; ++j) { const float2 cs = p.ROPE[t * 32 + ((d0 + j) & 31)];
            v[j] = (d0 < 32) ? (v[j] * cs.x - w[j] * cs.y) : (v[j] * cs.x + w[j] * cs.y); }
        if (u < 128) {
            v4u o; o.x = pk2(v[0] * QSCALE, v[1] * QSCALE); o.y = pk2(v[2] * QSCALE, v[3] * QSCALE); o.z = pk2(v[4] * QSCALE, v[5] * QSCALE); o.w = pk2(v[6] * QSCALE, v[7] * QSCALE);
            *(v4u*)(p.QDB + (size_t)t * 1024 + c0) = o;
        } else {
            const int kc = c0 - 1024, h = kc >> 6;
            v4u o; o.x = pk2(v[0], v[1]); o.y = pk2(v[2], v[3]); o.z = pk2(v[4], v[5]); o.w = pk2(v[6], v[7]);
#pragma unroll
            for (int pass = 0; pass < 3; ++pass) { const int sh = 2 * pass; const int pi = (t & ((1 << sh) - 1)) * (T >> sh) + (t >> sh);
                *(v4u*)(p.DKF[pass] + (size_t)h * T * 64 + kfrag_elem(pi, d0)) = o; }
            if (t >= T - 2048) { float* op = p.out + O_DIL_P + (size_t)(t - (T - 2048)) * 2048 + kc;
                *(float4*)op = make_float4(v[0], v[1], v[2], v[3]); *(float4*)(op + 4) = make_float4(v[4], v[5], v[6], v[7]); }
        }
    }
    for (size_t idx = gt; idx < (size_t)2048 * 256; idx += GT) {
        const int i = (int)(idx >> 8), c4 = (int)(idx & 255);
        *(float4*)(p.out + O_DIL_P + (size_t)i * 2048 + 1024 + c4 * 4) = *(const float4*)(H1 + (size_t)(T - 2048 + i) * 3072 + 2048 + c4 * 4);
    }
    const int lane = F.lane, l15 = lane & 15, grp = lane >> 4;
    for (int unit = F.gw; unit < 3 * 16 * 512; unit += F.NGW) {
        const int st = unit & 511, h = (unit >> 9) & 15, pass = unit >> 13; const int sh = 2 * pass, Td = T >> sh;
        const int pi0 = 32 * st, r = pi0 / Td, s0 = pi0 - r * Td;
        bf16* dst = p.DVF[pass] + (size_t)h * T * 64;
#pragma unroll
        for (int dt = 0; dt < 4; ++dt) {
            float v[8];
#pragma unroll
            for (int j = 0; j < 8; ++j) { const int s = s0 + 16 * (j >> 2) + 4 * grp + (j & 3); const int t = (s << sh) + r;
                v[j] = H1[(size_t)t * 3072 + 2048 + h * 64 + 16 * dt + l15]; }
            v4u o; o.x = pk2(v[0], v[1]); o.y = pk2(v[2], v[3]); o.z = pk2(v[4], v[5]); o.w = pk2(v[6], v[7]);
            *(v4u*)(dst + vfrag_off(st, dt, lane)) = o;
        }
    }
}

__device__ __forceinline__ void dil_unit(const KP& p, int unit, unsigned char* ldsb, int wave, int lane) {
    asm volatile("" : "+v"(lane));
    const int h = unit & 15, P0 = (unit >> 4) * 256;
    const int l15 = lane & 15, grp = lane >> 4;
    float* stO = (float*)ldsb; float* stML = stO + 256 * 64;
    for (int pass = 0; pass < 3; ++pass) {
        const int sh = 2 * pass, Td = T >> sh;
        const bf16* KF = p.DKF[pass] + (size_t)h * T * 64; const bf16* VF = p.DVF[pass] + (size_t)h * T * 64;
        for (int tt = 0; tt < 2; ++tt) {
            const int tl = 2 * wave + tt;
            const int r = tl >> (4 - sh), s0 = (P0 >> sh) + 16 * (tl & ((16 >> sh) - 1));
            const int sq = s0 + l15, tq = (sq << sh) + r, tloc = tq - P0;
            bf16x8 qf[2];
#pragma unroll
            for (int ks = 0; ks < 2; ++ks) qf[ks] = *(const bf16x8*)(p.QDB + (size_t)tq * 1024 + h * 64 + 32 * ks + 8 * grp);
            AttW a;
            if (pass == 0) attw_init(a);
            else {
#pragma unroll
                for (int dt = 0; dt < 4; ++dt) a.o[dt] = *(const f32x4*)(stO + tloc * 64 + 16 * dt + 4 * grp);
                a.m = stML[tloc * 2]; a.l = (grp == 0) ? stML[tloc * 2 + 1] : 0.f;
            }
            int kstart = s0 - 128; if (kstart < 0) kstart = 0; kstart &= ~31;
            const int nsteps = (s0 + 16 - kstart + 31) >> 5;
            const int base = r * Td;
            for (int s = 0; s < nsteps; ++s) {
                const int k0 = kstart + 32 * s;
                bf16x8 kf[2][2], vf[4];
#pragma unroll
                for (int tl2 = 0; tl2 < 2; ++tl2)
#pragma unroll
                    for (int ks = 0; ks < 2; ++ks) kf[tl2][ks] = *(const bf16x8*)(KF + kfrag_off(((base + k0) >> 4) + tl2, ks, lane));
#pragma unroll
                for (int dt = 0; dt < 4; ++dt) vf[dt] = *(const bf16x8*)(VF + vfrag_off((base + k0) >> 5, dt, lane));
                f32x4 s0v, s1v; qk_step(kf, qf, s0v, s1v);
                if ((k0 + 31 > s0) || (k0 < s0 + 15 - 128)) {
                    const int pb = k0 + 4 * grp;
#pragma unroll
                    for (int i = 0; i < 4; ++i) { const int p0 = pb + i, p1 = pb + 16 + i;
                        if (p0 > sq || p0 < sq - 128) s0v[i] = -INFINITY; if (p1 > sq || p1 < sq - 128) s1v[i] = -INFINITY; }
                }
                att_update(a, s0v, s1v, vf);
            }
            const float lt = grp_sum(a.l);
            if (pass < 2) {
#pragma unroll
                for (int dt = 0; dt < 4; ++dt) *(f32x4*)(stO + tloc * 64 + 16 * dt + 4 * grp) = a.o[dt];
                if (grp == 0) { stML[tloc * 2] = a.m; stML[tloc * 2 + 1] = lt; }
            } else {
                const float il = lt > 0.f ? 1.f / lt : 0.f;
#pragma unroll
                for (int dt = 0; dt < 4; ++dt) { uint2 o; o.x = pk2(a.o[dt][0] * il, a.o[dt][1] * il); o.y = pk2(a.o[dt][2] * il, a.o[dt][3] * il);
                    *(uint2*)(p.MIXB + (size_t)tq * 1024 + h * 64 + 16 * dt + 4 * grp) = o; }
            }
        }
        __syncthreads();
    }
}
__device__ __forceinline__ void ph_dil_attn_fast(const KP& p, const Fr& F) {
    for (int unit = F.bid; unit < 64 * 16; unit += F.G) dil_unit(p, unit, F.lds, F.wave, F.lane);
}

constexpr int NPHASE = 21;
__global__ void __launch_bounds__(NTHR, 2) mega(KP p) {
    extern __shared__ __attribute__((aligned(16))) unsigned char lds[];
    Fr F; F.lds = lds; F.tid = threadIdx.x; F.lane = F.tid & 63; F.wave = __builtin_amdgcn_readfirstlane(F.tid >> 6);
    F.bid = blockIdx.x; F.G = gridDim.x; F.gw = F.bid * NWAVES + F.wave; F.NGW = F.G * NWAVES;
    for (int u = F.tid; u < (LDS_BYTES - RING_BYTES) / 4; u += NTHR) ((unsigned*)(lds + RING_BYTES))[u] = 0u;
    __syncthreads();
    XcdBarrier bar; bar.bar = p.ctl + 4096; bar.x = 0; bar.st = nullptr;
    if (!MK_PER_PHASE) bar = xcd_barrier_post(p.ctl + 4096, (volatile LAS unsigned*)(lds + MISC_OFF + 32));
    const int lo = p.ph_lo, hi = p.ph_hi;
#define IN(k) (lo <= (k) && (k) < hi)

    int ph = 0;
#define PHASE(...) do { if (IN(ph)) { __VA_ARGS__ } if (IN(ph) && IN(ph + 1)) xcd_barrier(bar); ++ph; } while (0)
    PHASE(ph_prologue(p, F););
    PHASE(ph_gemm_f32(F, p.ACTB, p.WT_A, TSP, PAP, DM, p.BIGF, PA, PA););
    PHASE(ph_nsa_prep(p, F); ph_nsa_prep_fast(p, F); ph_compress(p, F); ph_gdn_prep(p, F););
    PHASE(ph_gdn_chunks(p, F););
    PHASE(ph_mix(p, F););
    PHASE(ph_gdn_out(p, F););
    PHASE(ph_gemm_f32(F, p.MIXB, p.WT_OA, TSP, DM, DM, p.MO, DM, DM););
    PHASE(ph_ln(F, p.x_prompt, p.x_sample, p.MO, p.ln_mix_g, p.ln_mix_b, p.X1, p.X1 + (size_t)T * DM, p.ACTB););
    PHASE(ph_gemm_f32(F, p.ACTB, p.WT_FI0, TSP, DFF2, DM, p.BIGF, DFF2, DFF2););
    PHASE(ph_ffn_act(p, F, 0););
    PHASE(ph_gemm_f32(F, p.HFFB, p.WT_FO0, TSP, DM, DFF, p.MO, DM, DM););
    PHASE(ph_ln(F, p.X1, p.X1 + (size_t)T * DM, p.MO, p.ln_ffn_g, p.ln_ffn_b, p.X2, p.X2 + (size_t)T * DM, p.ACTB););
    PHASE(ph_gemm_f32(F, p.ACTB, p.WT_CI, TSP, 3072, DM, p.BIGF, 3072, 3072););
    PHASE(ph_dil_prep(p, F); ph_dil_prep_fast(p, F););
    PHASE(ph_dil_cache(p, F); ph_dil_attn(p, F); __syncthreads(); ph_dil_attn_fast(p, F););
    PHASE(ph_gemm_f32(F, p.MIXB, p.WT_CO, TSP, DM, DM, p.MO, DM, DM););
    PHASE(ph_ln(F, p.X2, p.X2 + (size_t)T * DM, p.MO, p.ln_mix_g + DM, p.ln_mix_b + DM, p.X3, p.X3 + (size_t)T * DM, p.ACTB););
    PHASE(ph_gemm_f32(F, p.ACTB, p.WT_FI1, TSP, DFF2, DM, p.BIGF, DFF2, DFF2););
    PHASE(ph_ffn_act(p, F, 1););
    PHASE(ph_gemm_f32(F, p.HFFB, p.WT_FO1, TSP, DM, DFF, p.MO, DM, DM););
    PHASE(ph_ln(F, p.X3, p.X3 + (size_t)T * DM, p.MO, p.ln_ffn_g + DM, p.ln_ffn_b + DM, p.out + O_Y_P, p.out + O_Y_S, nullptr););
#undef PHASE
#undef IN
}

static inline size_t align_up(size_t x) { return (x + 255) & ~(size_t)255; }

extern "C" void kernel_launch(void* const* d_in, const int* in_sizes, int n_in, void* d_out, int out_size, void* d_ws, size_t ws_size, hipStream_t stream) {
    static int grid = 0;
    if (grid == 0) {
        int dev = 0, cus = 0, per_cu = 0;
        if (hipGetDevice(&dev) != hipSuccess || hipDeviceGetAttribute(&cus, hipDeviceAttributeMultiprocessorCount, dev) != hipSuccess) { fprintf(stderr, "kernel_launch: device query failed\n"); grid = -1; return; }
        if (hipFuncSetAttribute((const void*)mega, hipFuncAttributeMaxDynamicSharedMemorySize, LDS_BYTES) != hipSuccess) { fprintf(stderr, "kernel_launch: hipFuncSetAttribute failed\n"); grid = -1; return; }
        if (hipOccupancyMaxActiveBlocksPerMultiprocessor(&per_cu, (const void*)mega, NTHR, LDS_BYTES) != hipSuccess || per_cu < 1) { fprintf(stderr, "kernel_launch: occupancy query says %d blocks per CU\n", per_cu); }
        (void)hipGetLastError();
        grid = cus;
    }
    if (grid < 0) return;
    if ((size_t)out_size != O_END) fprintf(stderr, "kernel_launch: out_size %d != expected %zu\n", out_size, (size_t)O_END);
    KP p{};
    p.x_prompt = (const float*)d_in[0]; p.x_sample = (const float*)d_in[1]; p.cache_cmp = (const float*)d_in[2]; p.cache_slc = (const float*)d_in[3];
    p.st_win = (const float*)d_in[4]; p.st_gconv = (const float*)d_in[5]; p.st_gS = (const float*)d_in[6]; p.st_dil = (const float*)d_in[7];
    p.st_ffn = (const float*)d_in[8]; p.page_table = (const int*)d_in[9]; p.w_in_a = (const float*)d_in[10]; p.cw1 = (const float*)d_in[11];
    p.cb1 = (const float*)d_in[12]; p.cw2 = (const float*)d_in[13]; p.cpe = (const float*)d_in[14]; p.gconv_w = (const float*)d_in[15];
    p.gA = (const float*)d_in[16]; p.gdt = (const float*)d_in[17]; p.gnw = (const float*)d_in[18]; p.w_out_a = (const float*)d_in[19];
    p.w_in_c = (const float*)d_in[20]; p.w_out_c = (const float*)d_in[21]; p.ln_mix_g = (const float*)d_in[22]; p.ln_mix_b = (const float*)d_in[23];
    p.ffn_w_in = (const float*)d_in[24]; p.ffn_cw = (const float*)d_in[25]; p.ffn_cb = (const float*)d_in[26]; p.ffn_w_out = (const float*)d_in[27];
    p.ln_ffn_g = (const float*)d_in[28]; p.ln_ffn_b = (const float*)d_in[29];
    p.out = (float*)d_out;
    char* ws = (char*)d_ws; size_t off = 0;
    auto alloc = [&](size_t bytes) { void* q = (void*)(ws + off); off = align_up(off + bytes); return q; };
    p.ctl = (unsigned*)alloc(1 << 20);
    p.WT_A = (bf16*)alloc((size_t)PAP * DM * 2); p.WT_OA = (bf16*)alloc((size_t)DM * DM * 2);
    p.WT_FI0 = (bf16*)alloc((size_t)DFF2 * DM * 2); p.WT_FI1 = (bf16*)alloc((size_t)DFF2 * DM * 2);
    p.WT_FO0 = (bf16*)alloc((size_t)DM * DFF * 2); p.WT_FO1 = (bf16*)alloc((size_t)DM * DFF * 2);
    p.WT_CI = (bf16*)alloc((size_t)3072 * DM * 2); p.WT_CO = (bf16*)alloc((size_t)DM * DM * 2);
    p.ROPE = (float2*)alloc((size_t)(T + 1) * 32 * 8);
    p.ACTB = (bf16*)alloc((size_t)TSP * DM * 2); p.MIXB = (bf16*)alloc((size_t)TSP * DM * 2); p.HFFB = (bf16*)alloc((size_t)TSP * DFF * 2);
    p.QB = (bf16*)alloc((size_t)T * 512 * 2); p.KSF = (bf16*)alloc((size_t)2 * T * 64 * 2); p.VSF = (bf16*)alloc((size_t)2 * T * 64 * 2);
    p.KWF = (bf16*)alloc((size_t)2 * T * 64 * 2); p.VWF = (bf16*)alloc((size_t)2 * T * 64 * 2); p.CKF = (bf16*)alloc((size_t)2 * 512 * 64 * 2); p.CVF = (bf16*)alloc((size_t)2 * 512 * 64 * 2);
    p.QDB = (bf16*)alloc((size_t)T * 1024 * 2);
    for (int i = 0; i < 3; ++i) { p.DKF[i] = (bf16*)alloc((size_t)T * 1024 * 2); p.DVF[i] = (bf16*)alloc((size_t)T * 1024 * 2); }
    p.G_WF = (bf16*)alloc((size_t)2048 * 4096 * 2); p.G_KDF = (bf16*)alloc((size_t)2048 * 4096 * 2); p.G_QGF = (bf16*)alloc((size_t)2048 * 4096 * 2); p.G_QKF = (bf16*)alloc((size_t)2048 * 4096 * 2);
    p.G_SPF = (bf16*)alloc((size_t)2048 * 4096 * 2); p.G_VNF = (bf16*)alloc((size_t)2048 * 4096 * 2); p.G_UF = (float*)alloc((size_t)2048 * 4096 * 4); p.G_GL = (float*)alloc((size_t)2048 * 4);
    p.BIGF = (float*)alloc((size_t)TSP * DFF2 * 4); p.MO = (float*)alloc((size_t)TSP * DM * 4);
    p.X1 = (float*)alloc((size_t)TS * DM * 4); p.X2 = (float*)alloc((size_t)TS * DM * 4); p.X3 = (float*)alloc((size_t)TS * DM * 4);
    p.QR = (float*)alloc((size_t)TS * 512 * 4);
    p.KS = (float*)alloc((size_t)TS * 128 * 4); p.VS = (float*)alloc((size_t)TS * 128 * 4); p.KW = (float*)alloc((size_t)TS * 128 * 4); p.VW = (float*)alloc((size_t)TS * 128 * 4);
    p.CK = (float*)alloc((size_t)33 * 512 * 128 * 4); p.CV = (float*)alloc((size_t)33 * 512 * 128 * 4);
    p.GQ = (float*)alloc((size_t)TS * 512 * 4); p.GK = (float*)alloc((size_t)TS * 512 * 4); p.GV = (float*)alloc((size_t)TS * 512 * 4); p.OG = (float*)alloc((size_t)TS * 512 * 4);
    p.Gg = (float*)alloc((size_t)TS * 8 * 4); p.Gb = (float*)alloc((size_t)TS * 8 * 4);
    p.QD = (float*)alloc((size_t)TS * DM * 4); p.KD = (float*)alloc((size_t)TS * DM * 4);
    if (off > ws_size) { fprintf(stderr, "kernel_launch: workspace too small: need %zu have %zu\n", off, ws_size); return; }
    if (hipMemsetAsync(p.ctl, 0, 1 << 20, stream) != hipSuccess) { fprintf(stderr, "kernel_launch: memset failed\n"); return; }
#if MK_PER_PHASE
    for (int k = 0; k < NPHASE; ++k) { p.ph_lo = k; p.ph_hi = k + 1; hipLaunchKernelGGL(mega, dim3(grid), dim3(NTHR), LDS_BYTES, stream, p); }
#else
    p.ph_lo = 0; p.ph_hi = NPHASE;
    hipLaunchKernelGGL(mega, dim3(grid), dim3(NTHR), LDS_BYTES, stream, p);
#endif
    const hipError_t le = hipPeekAtLastError();
    if (le != hipSuccess) fprintf(stderr, "kernel_launch: launch failed: %s\n", hipGetErrorName(le));
}
```

```cpp
#include <hip/hip_runtime.h>
#include <cstdint>
#include <cstdio>
#include <cmath>

namespace pg8 {
#define PG8_LAS __attribute__((address_space(3)))
typedef unsigned short bf16_t;
typedef short bf16x8 __attribute__((ext_vector_type(8)));
typedef float f32x4 __attribute__((ext_vector_type(4)));
typedef unsigned u32x4 __attribute__((ext_vector_type(4)));
constexpr int BM = 256, BK = 64, HALF = 128, HTB = HALF * BK * 2  , STAGE_BYTES = 8 * HTB, NXCD = 8, WGM = 8;

__host__ __device__ __forceinline__ int lds_byte(int r, int c) { const int st = (r >> 4) * 2 + (c >> 5), rr = r & 15, cc = c & 31, ob = rr * 64 + cc * 2; return st * 1024 + (ob ^ (((ob >> 9) & 1) << 5)); }
__host__ __device__ __forceinline__ void stage_rc(int b, int& R, int& C) { const int st = b / 1024, sb = b % 1024, swz = sb ^ (((sb >> 9) & 1) << 5); R = (st >> 1) * 16 + swz / 64; C = (st & 1) * 32 + (swz % 64) / 2; }
__host__ __device__ __forceinline__ int perm32(int rho) { const int n = rho >> 4, i = rho & 15; return 8 * (i >> 2) + 4 * n + (i & 3); }

struct Unit { int pm, pn; };
struct Gemm { const bf16_t* A; const bf16_t* Bt; int M, N, K; };

struct StaticOrder {
    int nM, nN, nwg, G, c;
    __host__ __device__ void init(int M, int N, int G_, int c_) { nM = M / BM; nN = N / BM; nwg = nM * nN; G = G_; c = c_; }
    __host__ __device__ bool next(int i, Unit& u) const {
        const long L = (long)i * G + c; if (L >= nwg) return false;
        int wgid = (int)L; { const int q = nwg / NXCD, r = nwg % NXCD, xcd = wgid % NXCD, off = wgid / NXCD; wgid = (xcd < r ? xcd * (q + 1) : r * (q + 1) + (xcd - r) * q) + off; }
        const int nig = WGM * nN, gid = wgid / nig, fm = gid * WGM, gsz = (nM - fm) < WGM ? (nM - fm) : WGM;
        u.pm = fm + ((wgid % nig) % gsz); u.pn = (wgid % nig) / gsz; return true;
    }
    __device__ __forceinline__ void a_ready(const Unit&) const {}
    __device__ __forceinline__ void done(const Unit&) const {}
};

typedef __bf16 bf16x2_t __attribute__((ext_vector_type(2)));
typedef float f32x2_t __attribute__((ext_vector_type(2)));
__device__ __forceinline__ unsigned cvt_pk_bf16(float lo, float hi) { const f32x2_t v = {lo, hi}; return __builtin_bit_cast(unsigned, __builtin_convertvector(v, bf16x2_t)); }
typedef float f32x2 __attribute__((ext_vector_type(2)));
__device__ __forceinline__ f32x2 gelu_pk(f32x2 v) {
    const f32x2 av = __builtin_elementwise_abs(v), d = av * 0.2316418882f + 1.0f;
    f32x2 t; t.x = __builtin_amdgcn_rcpf(d.x); t.y = __builtin_amdgcn_rcpf(d.y);
    f32x2 q = t * 0.5307027145f + (-0.7265760135f); q = q * t + 0.7107068705f; q = q * t + (-0.142248368f); q = q * t + 0.127414796f; q = q * t;
    const f32x2 s = (v * v) * (-0.72134752044f);
    f32x2 e; e.x = __builtin_amdgcn_exp2f(s.x); e.y = __builtin_amdgcn_exp2f(s.y);
    const f32x2 m = v * (q * e), r = v - m;
    f32x2 o; o.x = v.x < 0.f ? m.x : r.x; o.y = v.y < 0.f ? m.y : r.y; return o;
}

template <int ACT  > struct EpiBf16 {
    static constexpr bool PERM = true, AFTER_DRAIN = false; static_assert(ACT == 0 || ACT == 1, "EpiBf16: ACT is 0 (none) or 1 (gelu_pk)");
    bf16_t* O; int ldc; const float* bias; int split_cols; size_t split_stride; float scale0;
    __device__ __forceinline__ void operator()(const f32x4 (&acc)[2][2][4][2], const Unit& u, int wr, int wc, int fr, int fq) const {
        const int row0 = u.pm * BM + wr * 64 + fr; int colt = u.pn * BM; bf16_t* base = O;
        float sc = 1.f; if (split_cols) { const int t = colt / split_cols; base += (size_t)t * split_stride; colt -= t * split_cols; if (t == 0) sc = scale0; }
        const int col0 = colt + wc * 32 + 8 * fq, bcol0 = u.pn * BM + wc * 32 + 8 * fq;
        f32x4 bv[2][2];
#pragma unroll
        for (int bj = 0; bj < 2; ++bj)
#pragma unroll
            for (int n = 0; n < 2; ++n) bv[bj][n] = bias ? *(const f32x4*)(bias + bcol0 + bj * HALF + 4 * n) : (f32x4){0.f, 0.f, 0.f, 0.f};
#pragma unroll
        for (int ai = 0; ai < 2; ++ai)
#pragma unroll
            for (int m = 0; m < 4; ++m) { bf16_t* rowp = base + (size_t)(row0 + ai * HALF + m * 16) * ldc + col0;
#pragma unroll
                for (int bj = 0; bj < 2; ++bj) { f32x4 v0 = acc[ai][bj][m][0] + bv[bj][0], v1 = acc[ai][bj][m][1] + bv[bj][1];
                    if (ACT == 1) { f32x2 a = gelu_pk((f32x2){v0[0], v0[1]}), b = gelu_pk((f32x2){v0[2], v0[3]}), c = gelu_pk((f32x2){v1[0], v1[1]}), d = gelu_pk((f32x2){v1[2], v1[3]});
                        v0 = (f32x4){a.x, a.y, b.x, b.y}; v1 = (f32x4){c.x, c.y, d.x, d.y}; }
                    v0 = v0 * sc; v1 = v1 * sc; u32x4 w; w.x = cvt_pk_bf16(v0[0], v0[1]); w.y = cvt_pk_bf16(v0[2], v0[3]); w.z = cvt_pk_bf16(v1[0], v1[1]); w.w = cvt_pk_bf16(v1[2], v1[3]);
                    *(u32x4*)(rowp + bj * HALF) = w; } }
    }
};

struct EpiF32 {
    static constexpr bool PERM = false, AFTER_DRAIN = false;
    float* O; int ldc; int ncols;
    __device__ __forceinline__ void operator()(const f32x4 (&acc)[2][2][4][2], const Unit& u, int wr, int wc, int fr, int fq) const {
        const int row0 = u.pm * BM + wr * 64 + fr; const int col0 = u.pn * BM + wc * 32 + 4 * fq;
#pragma unroll
        for (int ai = 0; ai < 2; ++ai)
#pragma unroll
            for (int m = 0; m < 4; ++m) { float* rowp = O + (size_t)(row0 + ai * HALF + m * 16) * ldc;
#pragma unroll
                for (int bj = 0; bj < 2; ++bj)
#pragma unroll
                    for (int n = 0; n < 2; ++n) { const int c = col0 + bj * HALF + n * 16; if (c < ncols) *(f32x4*)(rowp + c) = acc[ai][bj][m][n]; } }
    }
};
template <class Epi, class Sched, bool ALIGN_EPI = false, bool SP2 = false>
__device__ __forceinline__ void gemm_phase(PG8_LAS unsigned char* lds, const Gemm g, const Sched& S, const Epi& E) {
    const int tid = threadIdx.x, wid = __builtin_amdgcn_readfirstlane(tid >> 6), lane = tid & 63, wr = wid >> 2, wc = wid & 3, fr = lane & 15, fq = lane >> 4;
    const int K = g.K, nt = K / BK;
    unsigned voffA[2], voffB[2];
#pragma unroll
    for (int i = 0; i < 2; ++i) { int R, C; stage_rc(tid * 16 + i * 8192, R, C); const int Rb = Epi::PERM ? ((R & ~31) + perm32(R & 31)) : R;
        voffA[i] = (unsigned)(R * K + C) * 2u; voffB[i] = (unsigned)(Rb * K + C) * 2u; }
    const size_t kstep = (size_t)(BK * 2);
    const size_t hstep = (size_t)HALF * K * 2;
    const size_t tstep = 2 * hstep;
    const unsigned ldsw = (unsigned)wid * 1024u;
    const int aoff = lds_byte(wr * 64 + fr, fq * 8), boff = lds_byte(wc * 32 + fr, fq * 8);
#define PG8_SA(b, h) (((b) * 2 + (h)) * HTB)
#define PG8_SB(b, h) ((4 + (b) * 2 + (h)) * HTB)
#define PG8_STAGE(bufoff, gbase, voff) do { _Pragma("unroll") for (int _i = 0; _i < 2; ++_i) \
        __builtin_amdgcn_global_load_lds((const unsigned*)((const char*)(gbase) + (voff)[_i]), (PG8_LAS unsigned*)(lds + (bufoff) + ldsw + _i * 8192), 16, 0, 0); } while (0)
#define PG8_LDA(dst, b, h) do { _Pragma("unroll") for (int m = 0; m < 4; ++m) _Pragma("unroll") for (int k = 0; k < 2; ++k) dst[m][k] = *(const PG8_LAS bf16x8*)(lds + PG8_SA(b, h) + aoff + m * 2048 + k * 1024); } while (0)
#define PG8_LDB(dst, b, h) do { _Pragma("unroll") for (int n = 0; n < 2; ++n) _Pragma("unroll") for (int k = 0; k < 2; ++k) dst[n][k] = *(const PG8_LAS bf16x8*)(lds + PG8_SB(b, h) + boff + n * 2048 + k * 1024); } while (0)
#define PG8_MMA(ai, bj, At, Bt) do { __builtin_amdgcn_s_setprio(1); _Pragma("unroll") for (int m = 0; m < 4; ++m) _Pragma("unroll") for (int n = 0; n < 2; ++n) _Pragma("unroll") for (int k = 0; k < 2; ++k) \
        acc[ai][bj][m][n] = __builtin_amdgcn_mfma_f32_16x16x32_bf16(Bt[n][k], At[m][k], acc[ai][bj][m][n], 0, 0, 0); __builtin_amdgcn_s_setprio(0); } while (0)
#define PG8_WAIT_V(n) asm volatile("s_waitcnt vmcnt(" #n ")" ::: "memory")
#define PG8_WAIT_L(n) asm volatile("s_waitcnt lgkmcnt(" #n ")" ::: "memory")
#define PG8_BAR __builtin_amdgcn_s_barrier()
#define PG8_SCHED __builtin_amdgcn_sched_barrier(0)
    Unit cur, nxt; int ui = 0;
    if (!S.next(0, cur)) return;
    f32x4 acc[2][2][4][2];
#pragma unroll
    for (int a = 0; a < 2; ++a)
#pragma unroll
        for (int b = 0; b < 2; ++b)
#pragma unroll
            for (int m = 0; m < 4; ++m)
#pragma unroll
                for (int n = 0; n < 2; ++n) acc[a][b][m][n] = (f32x4){0.f, 0.f, 0.f, 0.f};
    bf16x8 At[4][2], B0[2][2], B1[2][2];
    const char* cA = (const char*)g.A + (size_t)cur.pm * tstep; const char* cB = (const char*)g.Bt + (size_t)cur.pn * tstep;
    S.a_ready(cur);
    if constexpr (SP2) {
        PG8_STAGE(PG8_SB(0, 0), cB, voffB); PG8_STAGE(PG8_SB(0, 1), cB + hstep, voffB); PG8_STAGE(PG8_SA(0, 0), cA, voffA); PG8_STAGE(PG8_SA(0, 1), cA + hstep, voffA);
        if (wr == 1) PG8_BAR;
        PG8_WAIT_V(2); PG8_BAR;
        PG8_STAGE(PG8_SB(1, 0), cB + kstep, voffB); PG8_STAGE(PG8_SA(1, 0), cA + kstep, voffA); PG8_STAGE(PG8_SB(1, 1), cB + hstep + kstep, voffB);
        PG8_WAIT_V(6); PG8_BAR;
    } else {
        PG8_STAGE(PG8_SB(0, 0), cB, voffB); PG8_STAGE(PG8_SA(0, 0), cA, voffA); PG8_STAGE(PG8_SB(0, 1), cB + hstep, voffB); PG8_STAGE(PG8_SA(0, 1), cA + hstep, voffA);
        if (wr == 1) PG8_BAR;
        PG8_WAIT_V(4); PG8_BAR;
        PG8_STAGE(PG8_SB(1, 0), cB + kstep, voffB); PG8_STAGE(PG8_SA(1, 0), cA + kstep, voffA); PG8_STAGE(PG8_SB(1, 1), cB + hstep + kstep, voffB);
        PG8_WAIT_V(6); PG8_BAR;
    }
    for (;;) {
        const bool has_next = S.next(ui + 1, nxt);
        const char* nA = has_next ? (const char*)g.A + (size_t)nxt.pm * tstep : cA; const char* nB = has_next ? (const char*)g.Bt + (size_t)nxt.pn * tstep : cB;
        for (int t = 0; t < nt; t += 2) {
            const bool last = (t == nt - 2);
            const char* a1 = cA + (size_t)(t + 1) * kstep;
            const char* a2 = last ? nA : cA + (size_t)(t + 2) * kstep; const char* b2 = last ? nB : cB + (size_t)(t + 2) * kstep;
            const char* a3 = a2 + kstep; const char* b3 = b2 + kstep;
            if (last && has_next) S.a_ready(nxt);
            if constexpr (SP2) {
            PG8_LDB(B0, 0, 0); PG8_LDB(B1, 0, 1); PG8_SCHED; PG8_LDA(At, 0, 0); PG8_STAGE(PG8_SA(1, 1), a1 + hstep, voffA);
            PG8_WAIT_V(8); PG8_WAIT_L(0); PG8_BAR; PG8_MMA(0, 0, At, B0); PG8_MMA(0, 1, At, B1); PG8_BAR; PG8_SCHED;
            PG8_LDA(At, 0, 1); PG8_STAGE(PG8_SB(0, 0), b2, voffB); PG8_STAGE(PG8_SB(0, 1), b2 + hstep, voffB); PG8_STAGE(PG8_SA(0, 0), a2, voffA);
            PG8_WAIT_V(8); PG8_WAIT_L(0); PG8_BAR; PG8_MMA(1, 0, At, B0); PG8_MMA(1, 1, At, B1); PG8_BAR; PG8_SCHED;
            PG8_LDB(B0, 1, 0); PG8_LDB(B1, 1, 1); PG8_SCHED; PG8_LDA(At, 1, 0); PG8_STAGE(PG8_SA(0, 1), a2 + hstep, voffA);
            PG8_WAIT_V(8); PG8_WAIT_L(0); PG8_BAR; PG8_MMA(0, 0, At, B0); PG8_MMA(0, 1, At, B1); PG8_BAR; PG8_SCHED;
            PG8_LDA(At, 1, 1); PG8_STAGE(PG8_SB(1, 0), b3, voffB); PG8_STAGE(PG8_SB(1, 1), b3 + hstep, voffB); PG8_STAGE(PG8_SA(1, 0), a3, voffA);
            PG8_WAIT_V(8); PG8_WAIT_L(0); PG8_BAR; PG8_MMA(1, 0, At, B0); PG8_MMA(1, 1, At, B1); PG8_BAR; PG8_SCHED;
            } else {
            PG8_LDB(B0, 0, 0); PG8_SCHED; PG8_LDA(At, 0, 0); PG8_STAGE(PG8_SA(1, 1), a1 + hstep, voffA);
            PG8_WAIT_L(8); PG8_BAR; PG8_WAIT_L(0); PG8_MMA(0, 0, At, B0); PG8_BAR; PG8_SCHED;
            PG8_LDB(B1, 0, 1); PG8_STAGE(PG8_SB(0, 0), b2, voffB);
            PG8_BAR; PG8_WAIT_L(0); PG8_MMA(0, 1, At, B1); PG8_BAR;
            PG8_LDA(At, 0, 1); PG8_STAGE(PG8_SA(0, 0), a2, voffA);
            PG8_BAR; PG8_WAIT_L(0); PG8_MMA(1, 0, At, B0); PG8_BAR; PG8_SCHED;
            PG8_STAGE(PG8_SB(0, 1), b2 + hstep, voffB);
            PG8_WAIT_V(6); PG8_BAR; PG8_MMA(1, 1, At, B1); PG8_BAR;
            PG8_LDB(B0, 1, 0); PG8_SCHED; PG8_LDA(At, 1, 0); PG8_STAGE(PG8_SA(0, 1), a2 + hstep, voffA);
            PG8_WAIT_L(8); PG8_BAR; PG8_WAIT_L(0); PG8_MMA(0, 0, At, B0); PG8_BAR; PG8_SCHED;
            PG8_LDB(B1, 1, 1); PG8_STAGE(PG8_SB(1, 0), b3, voffB);
            PG8_BAR; PG8_WAIT_L(0); PG8_MMA(0, 1, At, B1); PG8_BAR;
            PG8_LDA(At, 1, 1); PG8_STAGE(PG8_SA(1, 0), a3, voffA);
            PG8_BAR; PG8_WAIT_L(0); PG8_MMA(1, 0, At, B0); PG8_BAR; PG8_SCHED;
            PG8_STAGE(PG8_SB(1, 1), b3 + hstep, voffB);
            PG8_WAIT_V(6); PG8_BAR; PG8_MMA(1, 1, At, B1); PG8_BAR;
            }
        }
        if constexpr (ALIGN_EPI) { if (wr == 0) PG8_BAR; }
        if constexpr (!Epi::AFTER_DRAIN) { E(acc, cur, wr, wc, fr, fq); S.done(cur); }
        if (!has_next) break;
#pragma unroll
        for (int a = 0; a < 2; ++a)
#pragma unroll
            for (int b = 0; b < 2; ++b)
#pragma unroll
                for (int m = 0; m < 4; ++m)
#pragma unroll
                    for (int n = 0; n < 2; ++n) acc[a][b][m][n] = (f32x4){0.f, 0.f, 0.f, 0.f};
        cur = nxt; cA = nA; cB = nB; ++ui;
        if constexpr (ALIGN_EPI) { if (wr == 1) PG8_BAR; }
    }
    PG8_WAIT_V(0);
    if constexpr (!ALIGN_EPI) { if (wr == 0) PG8_BAR; }
    PG8_BAR;
    if constexpr (Epi::AFTER_DRAIN) { E.fused(acc, cur, wr, wc, fr, fq, lds, wid, lane); S.done(cur); }
#undef PG8_SA
#undef PG8_SB
#undef PG8_STAGE
#undef PG8_LDA
#undef PG8_LDB
#undef PG8_MMA
#undef PG8_WAIT_V
#undef PG8_WAIT_L
#undef PG8_BAR
#undef PG8_SCHED
}
}

#define LAS __attribute__((address_space(3)))
#define XB_TMO      128
#define XB_XCNT(j)  (256  + 64 * (j))
#define XB_XSUB(j)  (1280 + 64 * (j))
#define XB_XGEN(j)  (2304 + 64 * (j))
#define XB_TOP      3328
#define XB_TOPGEN   3392
#define XCD_BAR_WORDS 3456
#define XB_SPIN_CAP (1u << 26)

__device__ __forceinline__ unsigned xb_ld(unsigned* p)              { return __hip_atomic_load(p, __ATOMIC_RELAXED, __HIP_MEMORY_SCOPE_AGENT); }
__device__ __forceinline__ unsigned xb_add(unsigned* p, unsigned v) { return __hip_atomic_fetch_add(p, v, __ATOMIC_RELAXED, __HIP_MEMORY_SCOPE_AGENT); }
__device__ __forceinline__ unsigned xb_xcc_id() { return (unsigned)__builtin_amdgcn_s_getreg((3 << 11) | 20) & 0xFu; }
#define XB_SPIN(cond, bar) do { unsigned _sp = 0; while (cond) { __builtin_amdgcn_s_sleep(1); \
    if ((++_sp & 255u) == 0u) { if (xb_ld(&(bar)[XB_TMO])) break; if (_sp > XB_SPIN_CAP) { atomicAdd(&(bar)[XB_TMO], 1u); break; } } } } while (0)

struct XcdBarrier {
    unsigned* bar; unsigned x;
    volatile LAS unsigned* st;
};

__device__ __forceinline__ XcdBarrier xcd_barrier_post(unsigned* bar, volatile LAS unsigned* st) {
    XcdBarrier b; b.bar = bar; b.x = xb_xcc_id(); b.st = st;
    if (threadIdx.x == 0) (void)xb_add(&bar[XB_XCNT(b.x)], 1u);
    return b;
}
__device__ __forceinline__ void xcd_barrier_complete(unsigned* bar, unsigned x, unsigned& nloc, unsigned& nx) {
    const unsigned G = gridDim.x * gridDim.y * gridDim.z;
    unsigned sum, cnt, mine, sp = 0u;
    for (;;) {
        sum = 0u; cnt = 0u; mine = 0u;
#pragma unroll
        for (unsigned j = 0; j < 16; ++j) { const unsigned c = xb_ld(&bar[XB_XCNT(j)]); sum += c; cnt += (c > 0u) ? 1u : 0u; mine = (j == x) ? c : mine; }
        if (sum == G) break;
        __builtin_amdgcn_s_sleep(1);
        if ((++sp & 255u) == 0u) { if (xb_ld(&bar[XB_TMO])) break; if (sp > XB_SPIN_CAP) { atomicAdd(&bar[XB_TMO], 1u); break; } }
    }
    nloc = mine > 0u ? mine : 1u; nx = cnt > 0u ? cnt : 1u;
}

__device__ __forceinline__ void xcd_barrier(const XcdBarrier& b) {
    asm volatile("s_waitcnt vmcnt(0)" ::: "memory");
    __syncthreads();
    if (threadIdx.x == 0) {
        unsigned* bar = b.bar;
        __builtin_amdgcn_s_waitcnt(0);
        unsigned nloc = b.st[0], nx = b.st[1];
        if (nloc == 0u) { xcd_barrier_complete(bar, b.x, nloc, nx); b.st[0] = nloc; b.st[1] = nx; }
        const unsigned old = xb_add(&bar[XB_XSUB(b.x)], 1u);
        const unsigned gen = old / nloc;
        if (old + 1u == (gen + 1u) * nloc) {
            __builtin_amdgcn_fence(__ATOMIC_RELEASE, "agent");
            asm volatile("s_waitcnt vmcnt(0)" ::: "memory");
            const unsigned og = xb_add(&bar[XB_TOP], 1u);
            const unsigned tg = og / nx;
            if (og + 1u == (tg + 1u) * nx) xb_add(&bar[XB_TOPGEN], 1u);
            else XB_SPIN(xb_ld(&bar[XB_TOPGEN]) == tg, bar);
            __builtin_amdgcn_fence(__ATOMIC_ACQUIRE, "agent");
            xb_add(&bar[XB_XGEN(b.x)], 1u);
            asm volatile("s_waitcnt vmcnt(0)" ::: "memory");
        } else {
            XB_SPIN(xb_ld(&bar[XB_XGEN(b.x)]) == gen, bar);
            __builtin_amdgcn_fence(__ATOMIC_ACQUIRE, "agent");
            asm volatile("s_waitcnt vmcnt(0)" ::: "memory");
        }
    }
    __syncthreads();
}

#ifndef PG8_SP2
#define PG8_SP2 true
#endif
#ifndef PG8_ALIGN
#define PG8_ALIGN true
#endif
#ifndef PROBE_ON
#define PROBE_ON 0
#define PROBE_A 0
#define PROBE_B 1
#endif
#ifndef MK_PER_PHASE
#define MK_PER_PHASE 0
#endif

constexpr int T = 16384, NSMP = 32, TS = T + NSMP, TSP = T + 256, DM = 1024;
constexpr int PA = 3368, PAP = 3584;
constexpr int C_Q = 0, C_KC = 512, C_VC = 640, C_KS = 768, C_VS = 896, C_KW = 1024, C_VW = 1152, C_GATE = 1280,
              C_GQKV = 1304, C_A = 2840, C_BT = 2848, C_Z = 2856;
constexpr int DFF = 2816, DFF2 = 5632;
constexpr float DN_ALPHA = 1.4142135623730951f;
constexpr float LN_EPS = 1e-5f, NORM_EPS = 1e-6f;
constexpr int NPAGES = 128;
constexpr int NWAVES = 8, NTHR = 512;

constexpr size_t O_Y_P = 0;
constexpr size_t O_Y_S = O_Y_P + (size_t)T * DM;
constexpr size_t O_CMP_P = O_Y_S + (size_t)NSMP * DM;
constexpr size_t O_CMP_S = O_CMP_P + (size_t)T * 256;
constexpr size_t O_SLC_P = O_CMP_S + (size_t)NSMP * 256;
constexpr size_t O_SLC_S = O_SLC_P + (size_t)T * 256;
constexpr size_t O_WIN_P = O_SLC_S + (size_t)NSMP * 256;
constexpr size_t O_WIN_S = O_WIN_P + (size_t)512 * 256;
constexpr size_t O_GCONV_P = O_WIN_S + (size_t)NSMP * 512 * 256;
constexpr size_t O_GCONV_S = O_GCONV_P + (size_t)3 * 1536;
constexpr size_t O_GS_P = O_GCONV_S + (size_t)NSMP * 3 * 1536;
constexpr size_t O_GS_S = O_GS_P + (size_t)8 * 64 * 64;
constexpr size_t O_DIL_P = O_GS_S + (size_t)NSMP * 8 * 64 * 64;
constexpr size_t O_DIL_S = O_DIL_P + (size_t)2048 * 2048;
constexpr size_t O_FFN_P = O_DIL_S + (size_t)NSMP * 2048 * 2048;
constexpr size_t O_FFN_S = O_FFN_P + (size_t)2 * 2 * DFF2;
constexpr size_t O_END = O_FFN_S + (size_t)NSMP * 2 * 2 * DFF2;

constexpr int RING_BYTES = 131072;
constexpr int FAST_WL = 17408;
constexpr int MISC_OFF = 8 * FAST_WL + 64;
constexpr int LDS_BYTES = 147456;

typedef unsigned short bf16;
typedef unsigned v4u __attribute__((ext_vector_type(4)));

__device__ __forceinline__ unsigned f2bf(float f) { return (unsigned)__builtin_bit_cast(unsigned short, (__bf16)f); }
__device__ __forceinline__ unsigned pk2(float lo, float hi) { return pg8::cvt_pk_bf16(lo, hi); }
typedef short bf16x8 __attribute__((ext_vector_type(8)));
typedef float f32x4 __attribute__((ext_vector_type(4)));
#define MFMA16(a, b, c) __builtin_amdgcn_mfma_f32_16x16x32_bf16((a), (b), (c), 0, 0, 0)
__device__ __forceinline__ float wave_sum(float v) {
#pragma unroll
    for (int o = 1; o < 64; o <<= 1) v += __shfl_xor(v, o);
    return v;
}
__device__ __forceinline__ float wave_max(float v) {
#pragma unroll
    for (int o = 1; o < 64; o <<= 1) v = fmaxf(v, __shfl_xor(v, o));
    return v;
}
__device__ __forceinline__ void wave_lds_sync() { asm volatile("s_waitcnt lgkmcnt(0)" ::: "memory"); __builtin_amdgcn_wave_barrier(); asm volatile("" ::: "memory"); }
__device__ __forceinline__ float sigmoidf_(float x) { return 1.f / (1.f + expf(-x)); }
__device__ __forceinline__ float siluf_(float x) { return x / (1.f + expf(-x)); }
__device__ __forceinline__ float gelu_tanh(float x) { const float c = 0.7978845608028654f; return 0.5f * x * (1.f + tanhf(c * (x + 0.044715f * x * x * x))); }
__device__ __forceinline__ float softplusf_(float x) { return x > 20.f ? x : log1pf(expf(x)); }

struct KP {
    const float *x_prompt, *x_sample, *cache_cmp, *cache_slc, *st_win, *st_gconv, *st_gS, *st_dil, *st_ffn;
    const int* page_table;
    const float *w_in_a, *cw1, *cb1, *cw2, *cpe, *gconv_w, *gA, *gdt, *gnw, *w_out_a, *w_in_c, *w_out_c, *ln_mix_g, *ln_mix_b,
                *ffn_w_in, *ffn_cw, *ffn_cb, *ffn_w_out, *ln_ffn_g, *ln_ffn_b;
    float* out;
    unsigned* ctl;
    bf16 *WT_A, *WT_OA, *WT_FI0, *WT_FI1, *WT_FO0, *WT_FO1, *WT_CI, *WT_CO;
    float2* ROPE;
    bf16 *ACTB, *MIXB, *HFFB;
    bf16 *QB, *KSF, *VSF, *KWF, *VWF, *CKF, *CVF;
    bf16 *QDB; bf16* DKF[3]; bf16* DVF[3];
    bf16 *AC, *WT_C, *HID, *W2T, *ACP; float* SMIXF; float* NSACC; int* SEL; float* UB;
    bf16 *G_WF, *G_KDF, *G_QGF, *G_QKF, *G_SPF, *G_VNF; float *G_UF, *G_GL;
    float *BIGF, *MO, *X1, *X2, *X3, *QR, *KS, *VS, *KW, *VW, *CK, *CV, *GQ, *GK, *GV, *OG, *Gg, *Gb, *QD, *KD;
    int ph_lo, ph_hi;
};

struct Fr { unsigned char* lds; int tid, lane, wave, gw, NGW, bid, G; };

__device__ __forceinline__ int ffn_row(int u) { const int half = u >= DFF ? 1 : 0, jc = u - half * DFF; return 256 * (jc >> 7) + 128 * half + (jc & 127); }
__device__ __forceinline__ void transpose_item(const float* W, int K, int N, int NT, bf16* WT, float* scr, int item, int lane, int rowmap = 0) {
    const int nblk = NT / 32, kb = item / nblk, nb = item % nblk, k0 = 64 * kb, n0 = 32 * nb;
#pragma unroll 8
    for (int i = 0; i < 32; ++i) { const int kk = 2 * i + (lane >> 5); const int n = n0 + (lane & 31); scr[kk * 33 + (lane & 31)] = (n < N) ? W[(size_t)(k0 + kk) * N + n] : 0.f; }
    wave_lds_sync();
    const int c = lane & 7;
#pragma unroll
    for (int j = 0; j < 4; ++j) { const int n = (lane >> 3) + 8 * j; const float* s = scr + (8 * c) * 33 + n;
        v4u o; o.x = pk2(s[0 * 33], s[1 * 33]); o.y = pk2(s[2 * 33], s[3 * 33]); o.z = pk2(s[4 * 33], s[5 * 33]); o.w = pk2(s[6 * 33], s[7 * 33]);
        const int row = rowmap ? ffn_row(n0 + n) : n0 + n;
        *(v4u*)(WT + (size_t)row * K + k0 + 8 * c) = o; }
    wave_lds_sync();
}
__device__ __forceinline__ void ph_prologue(const KP& p, const Fr& F) {
    float* scr = (float*)(F.lds + F.wave * 16384);
    const int I_A = 16 * (PAP / 32), I_OA = 16 * 32, I_FI = 16 * (DFF2 / 32), I_FO = (DFF / 64) * 32, I_CI = 16 * (3072 / 32), I_CO = 16 * 32;
    const int NITEMS = I_A + I_OA + 2 * I_FI + 2 * I_FO + I_CI + I_CO + 256 + 8;
    for (int it = F.gw; it < NITEMS; it += F.NGW) {
        int r = it;
        if (r < I_A) { transpose_item(p.w_in_a, DM, PA, PAP, p.WT_A, scr, r, F.lane); continue; } r -= I_A;
        if (r < I_OA) { transpose_item(p.w_out_a, DM, DM, DM, p.WT_OA, scr, r, F.lane); continue; } r -= I_OA;
        if (r < I_FI) { transpose_item(p.ffn_w_in, DM, DFF2, DFF2, p.WT_FI0, scr, r, F.lane, 1); continue; } r -= I_FI;
        if (r < I_FI) { transpose_item(p.ffn_w_in + (size_t)DM * DFF2, DM, DFF2, DFF2, p.WT_FI1, scr, r, F.lane, 1); continue; } r -= I_FI;
        if (r < I_FO) { transpose_item(p.ffn_w_out, DFF, DM, DM, p.WT_FO0, scr, r, F.lane); continue; } r -= I_FO;
        if (r < I_FO) { transpose_item(p.ffn_w_out + (size_t)DFF * DM, DFF, DM, DM, p.WT_FO1, scr, r, F.lane); continue; } r -= I_FO;
        if (r < I_CI) { transpose_item(p.w_in_c, DM, 3072, 3072, p.WT_CI, scr, r, F.lane); continue; } r -= I_CI;
        if (r < I_CO) { transpose_item(p.w_out_c, DM, DM, DM, p.WT_CO, scr, r, F.lane); continue; } r -= I_CO;
        if (r < 256) { const int kv = r >> 7; transpose_item(p.cw1 + (size_t)kv * 2048 * 128, 2048, 128, 128, p.WT_C + (size_t)kv * 128 * 2048, scr, r & 127, F.lane); continue; } r -= 256;
        { const int kv = r >> 2; transpose_item(p.cw2 + (size_t)kv * 128 * 64, 128, 64, 64, p.W2T + (size_t)kv * 64 * 128, scr, r & 3, F.lane); }
    }
    const size_t gt = (size_t)F.bid * NTHR + F.tid, GT = (size_t)F.G * NTHR;
    for (size_t i4 = gt; i4 < (size_t)TSP * (DM / 4); i4 += GT) {
        const int r = (int)(i4 / (DM / 4)), c4 = (int)(i4 % (DM / 4));
        float4 v = make_float4(0.f, 0.f, 0.f, 0.f);
        if (r < T) v = ((const float4*)p.x_prompt)[(size_t)r * (DM / 4) + c4]; else if (r < TS) v = ((const float4*)p.x_sample)[(size_t)(r - T) * (DM / 4) + c4];
        uint2 o; o.x = pk2(v.x, v.y); o.y = pk2(v.z, v.w);
        ((uint2*)p.ACTB)[i4] = o;
    }
    for (size_t idx = gt; idx < (size_t)65536 * 256; idx += GT) {
        const int R = (int)(idx >> 8), u = (int)(idx & 255);
        const int kv = (R >> 7) & 1, combo = (R >> 8) * 128 + (R & 127); const int g = combo & 1, c = (combo >> 1) & 511, b = combo >> 10;
        const int i = u >> 3, d0 = (u & 7) * 8, row = c * 32 + i;
        const int page = p.page_table[b * NPAGES + (row >> 7)];
        const float* src = p.cache_cmp + ((((size_t)page * 128 + (row & 127)) * 2 + kv) * 2 + g) * 64 + d0; const float* pe = p.cpe + (kv * 32 + i) * 64 + d0;
        const float4 a0 = *(const float4*)src, a1 = *(const float4*)(src + 4), e0 = *(const float4*)pe, e1 = *(const float4*)(pe + 4);
        v4u o; o.x = pk2(a0.x + e0.x, a0.y + e0.y); o.y = pk2(a0.z + e0.z, a0.w + e0.w); o.z = pk2(a1.x + e1.x, a1.y + e1.y); o.w = pk2(a1.z + e1.z, a1.w + e1.w);
        *(v4u*)(p.AC + (size_t)R * 2048 + u * 8) = o;
    }
    for (size_t idx = gt; idx < (size_t)(T + 1) * 32; idx += GT) {
        const int pos = (int)(idx >> 5), i = (int)(idx & 31);
        const float inv = (float)pow(10000.0, -2.0 * (double)i / 64.0);
        const float ang = (float)pos * inv;
        p.ROPE[idx] = make_float2((float)cos((double)ang), (float)sin((double)ang));
    }
}

__device__ __forceinline__ size_t vfrag_elem(int key, int d);
__device__ __forceinline__ size_t kfrag_elem(int key, int d);
__device__ __forceinline__ bf16x8 pack_p(const f32x4& p0, const f32x4& p1);
template <bool FFNMAP = false>
__device__ __forceinline__ void skinny_gemm(const Fr& F, const bf16* A, const bf16* Bt, int K, int ncols, float* C, int ldc) {
    const int lane = F.lane, l15 = lane & 15, grp = lane >> 4;
    const bf16* a0 = A + (size_t)(T + l15) * K + 8 * grp; const bf16* a1 = a0 + (size_t)16 * K;
    for (int nt = F.gw; nt * 16 < ncols; nt += F.NGW) {
        const bf16* bp = Bt + (size_t)(nt * 16 + l15) * K + 8 * grp;
        f32x4 c0 = {0.f, 0.f, 0.f, 0.f}, c1 = {0.f, 0.f, 0.f, 0.f};
#pragma unroll 4
        for (int k = 0; k < K; k += 32) {
            const bf16x8 b = *(const bf16x8*)(bp + k), x0 = *(const bf16x8*)(a0 + k), x1 = *(const bf16x8*)(a1 + k);
            c0 = MFMA16(x0, b, c0); c1 = MFMA16(x1, b, c1);
        }
        int n = nt * 16 + l15;
        if (FFNMAP) n = ((n >> 7) & 1) * DFF + (n >> 8) * 128 + (n & 127);
        if (n < ncols) {
#pragma unroll
            for (int r = 0; r < 4; ++r) { C[(size_t)(T + 4 * grp + r) * ldc + n] = c0[r]; C[(size_t)(T + 16 + 4 * grp + r) * ldc + n] = c1[r]; }
        }
    }
}
__device__ __forceinline__ void ph_gemm_f32(const Fr& F, const bf16* A, const bf16* Bt, int N, int K, float* C, int ldc, int ncols) {
    skinny_gemm(F, A, Bt, K, ncols, C, ldc);
    pg8::Gemm g{A, Bt, T, N, K}; pg8::StaticOrder S; S.init(T, N, F.G, F.bid);
    pg8::EpiF32 E{C, ldc, ncols};
    pg8::gemm_phase<pg8::EpiF32, pg8::StaticOrder, PG8_ALIGN, PG8_SP2>((PG8_LAS unsigned char*)F.lds, g, S, E);
}
__device__ __forceinline__ float dpp_ror1(float x) { return __int_as_float(__builtin_amdgcn_update_dpp(0, __float_as_int(x), 0x121, 0xf, 0xf, false)); }
__device__ __forceinline__ float dpp_ror2(float x) { return __int_as_float(__builtin_amdgcn_update_dpp(0, __float_as_int(x), 0x122, 0xf, 0xf, false)); }
struct EpiFfn {
    static constexpr bool PERM = true, AFTER_DRAIN = false;
    bf16* H; float* UB; const float* cw; const float* cb;
    __device__ __forceinline__ void operator()(const pg8::f32x4 (&acc)[2][2][4][2], const pg8::Unit& u, int wr, int wc, int fr, int fq) const {
#pragma unroll
        for (int n = 0; n < 2; ++n) {
            const int jc = u.pn * 128 + wc * 32 + 8 * fq + 4 * n;
            pg8::f32x4 w0[2], w1[2], w2[2], bb[2];
#pragma unroll
            for (int bj = 0; bj < 2; ++bj) { const int uc = bj * DFF + jc;
                w0[bj] = *(const pg8::f32x4*)(cw + uc); w1[bj] = *(const pg8::f32x4*)(cw + DFF2 + uc); w2[bj] = *(const pg8::f32x4*)(cw + 2 * DFF2 + uc); bb[bj] = *(const pg8::f32x4*)(cb + uc); }
#pragma unroll
            for (int ai = 0; ai < 2; ++ai) {
                const int sl = u.pm * 4 + ai * 2 + wr;
                pg8::f32x4 pr1[2], pr2[2];
#pragma unroll
                for (int m = 0; m < 4; ++m) {
                    pg8::f32x4 c[2];
#pragma unroll
                    for (int bj = 0; bj < 2; ++bj) {
                        const pg8::f32x4 uu = acc[ai][bj][m][n]; pg8::f32x4 r1, r2;
#pragma unroll
                        for (int e = 0; e < 4; ++e) { r1[e] = dpp_ror1(uu[e]); r2[e] = dpp_ror2(uu[e]); }
                        pg8::f32x4 p1 = r1, p2 = r2;
                        if (m > 0) { if (fr == 0) p1 = pr1[bj]; if (fr < 2) p2 = pr2[bj]; }
                        c[bj] = bb[bj] + w0[bj] * p2 + w1[bj] * p1 + w2[bj] * uu;
                        pr1[bj] = r1; pr2[bj] = r2;
                        const int uc = bj * DFF + jc;
                        if (m == 0 && fr < 2) *(pg8::f32x4*)(UB + ((size_t)sl * 4 + fr) * DFF2 + uc) = uu;
                        if (m == 3 && fr >= 14) *(pg8::f32x4*)(UB + ((size_t)sl * 4 + 2 + (fr - 14)) * DFF2 + uc) = uu;
                    }
                    if (!(m == 0 && fr < 2)) {
                        const int t = u.pm * 256 + ai * 128 + wr * 64 + m * 16 + fr;
                        uint2 o; o.x = pk2(siluf_(c[0][0]) * c[1][0], siluf_(c[0][1]) * c[1][1]); o.y = pk2(siluf_(c[0][2]) * c[1][2], siluf_(c[0][3]) * c[1][3]);
                        *(uint2*)(H + (size_t)t * DFF + jc) = o;
                    }
                }
            }
        }
    }
};
__device__ __forceinline__ void ph_ffn_gemm(const KP& p, const Fr& F, const bf16* Bt, int layer) {
    skinny_gemm<true>(F, p.ACTB, Bt, DM, DFF2, p.BIGF, DFF2);
    pg8::Gemm g{p.ACTB, Bt, T, DFF2, DM}; pg8::StaticOrder S; S.init(T, DFF2, F.G, F.bid);
    EpiFfn E{p.HFFB, p.UB, p.ffn_cw + (size_t)layer * 3 * DFF2, p.ffn_cb + (size_t)layer * DFF2};
    pg8::gemm_phase<EpiFfn, pg8::StaticOrder, PG8_ALIGN, PG8_SP2>((PG8_LAS unsigned char*)F.lds, g, S, E);
}
__device__ __forceinline__ void ph_ffn_fix(const KP& p, const Fr& F, int layer) {
    const float* cw = p.ffn_cw + (size_t)layer * 3 * DFF2; const float* cb = p.ffn_cb + (size_t)layer * DFF2; const float* U = p.BIGF;
    const int gt = F.bid * NTHR + F.tid, GT = F.G * NTHR;
    for (int idx = gt; idx < 512 * DFF; idx += GT) {
        const int rr = idx / DFF, j = idx - rr * DFF; const int sl = rr >> 1, q = rr & 1;
        float c2[2];
#pragma unroll
        for (int half = 0; half < 2; ++half) { const int ch = half * DFF + j;
            const float u0 = p.UB[((size_t)sl * 4 + q) * DFF2 + ch];
            const float um1 = q ? p.UB[((size_t)sl * 4) * DFF2 + ch] : (sl ? p.UB[((size_t)(sl - 1) * 4 + 3) * DFF2 + ch] : 0.f);
            const float um2 = sl ? p.UB[((size_t)(sl - 1) * 4 + 2 + q) * DFF2 + ch] : 0.f;
            c2[half] = cb[ch] + cw[ch] * um2 + cw[DFF2 + ch] * um1 + cw[2 * DFF2 + ch] * u0; }
        p.HFFB[(size_t)(64 * sl + q) * DFF + j] = (bf16)f2bf(siluf_(c2[0]) * c2[1]);
    }
    for (int idx = gt; idx < NSMP * DFF; idx += GT) {
        const int b = idx / DFF, j = idx - b * DFF;
        float c2[2];
#pragma unroll
        for (int half = 0; half < 2; ++half) { const int ch = half * DFF + j;
            const float* hs = p.st_ffn + (((size_t)b * 2 + layer) * 2) * DFF2 + ch;
            c2[half] = cb[ch] + cw[ch] * hs[0] + cw[DFF2 + ch] * hs[DFF2] + cw[2 * DFF2 + ch] * U[(size_t)(T + b) * DFF2 + ch]; }
        p.HFFB[(size_t)(T + b) * DFF + j] = (bf16)f2bf(siluf_(c2[0]) * c2[1]);
    }
    for (int idx = gt; idx < 2 * DFF2; idx += GT) { const int k = idx / DFF2, ch = idx - k * DFF2;
        p.out[O_FFN_P + ((size_t)layer * 2 + k) * DFF2 + ch] = p.UB[((size_t)255 * 4 + 2 + k) * DFF2 + ch]; }
    for (int idx = gt; idx < NSMP * 2 * DFF2; idx += GT) { const int b = idx / (2 * DFF2), k = (idx / DFF2) & 1, ch = idx % DFF2;
        p.out[O_FFN_S + (((size_t)b * 2 + layer) * 2 + k) * DFF2 + ch] = (k == 0) ? p.st_ffn[(((size_t)b * 2 + layer) * 2 + 1) * DFF2 + ch] : U[(size_t)(T + b) * DFF2 + ch]; }
}
struct EpiCmp {
    static constexpr bool PERM = false, AFTER_DRAIN = false;
    bf16* HID; const float* b1;
    __device__ __forceinline__ void operator()(const pg8::f32x4 (&acc)[2][2][4][2], const pg8::Unit& u, int wr, int wc, int fr, int fq) const {
#pragma unroll
        for (int ai = 0; ai < 2; ++ai)
#pragma unroll
            for (int m = 0; m < 4; ++m) { const int combo = u.pm * 128 + wr * 64 + m * 16 + fr;
#pragma unroll
                for (int n = 0; n < 2; ++n) { const int j0 = wc * 32 + n * 16 + 4 * fq; const pg8::f32x4 v = acc[ai][ai][m][n]; const float* bb = b1 + ai * 128 + j0;
                    uint2 o; o.x = pk2(gelu_tanh(v[0] + bb[0]), gelu_tanh(v[1] + bb[1])); o.y = pk2(gelu_tanh(v[2] + bb[2]), gelu_tanh(v[3] + bb[3]));
                    *(uint2*)(HID + ((size_t)combo * 2 + ai) * 128 + j0) = o; } }
    }
};
__device__ __forceinline__ void ph_cmp_gemm(const KP& p, const Fr& F) {
    pg8::Gemm g{p.AC, p.WT_C, 65536, 256, 2048}; pg8::StaticOrder S; S.init(65536, 256, F.G, F.bid);
    EpiCmp E{p.HID, p.cb1};
    pg8::gemm_phase<EpiCmp, pg8::StaticOrder, PG8_ALIGN, PG8_SP2>((PG8_LAS unsigned char*)F.lds, g, S, E);
}
__device__ __forceinline__ void ph_cmp_stage2(const KP& p, const Fr& F) {
    const int lane = F.lane, l15 = lane & 15, grp = lane >> 4;
    for (int tile = F.gw; tile < 4096; tile += F.NGW) {
        const int kv = tile & 1, combo0 = (tile >> 1) * 16;
        const bf16* hid = p.HID + ((size_t)(combo0 + l15) * 2 + kv) * 128 + 8 * grp; const bf16* w2 = p.W2T + (size_t)kv * 64 * 128 + (size_t)l15 * 128 + 8 * grp;
        f32x4 acc[4];
#pragma unroll
        for (int nt = 0; nt < 4; ++nt) acc[nt] = (f32x4){0.f, 0.f, 0.f, 0.f};
#pragma unroll
        for (int ks = 0; ks < 4; ++ks) { const bf16x8 a = *(const bf16x8*)(hid + 32 * ks);
#pragma unroll
            for (int nt = 0; nt < 4; ++nt) acc[nt] = MFMA16(a, *(const bf16x8*)(w2 + (size_t)nt * 16 * 128 + 32 * ks), acc[nt]); }
#pragma unroll
        for (int r = 0; r < 4; ++r) {
            const int combo = combo0 + 4 * grp + r; const int g = combo & 1, c = (combo >> 1) & 511, b = combo >> 10;
            float* dst = ((kv == 0) ? p.CK : p.CV) + (((size_t)(1 + b) * 512 + c) * 2 + g) * 64;
            if (kv == 0) {
                const int pos = (c + 1) * 32 - 1;
#pragma unroll
                for (int nt = 0; nt < 2; ++nt) { const float2 cs = p.ROPE[pos * 32 + 16 * nt + l15]; const float x1 = acc[nt][r], x2 = acc[nt + 2][r];
                    dst[16 * nt + l15] = x1 * cs.x - x2 * cs.y; dst[16 * (nt + 2) + l15] = x2 * cs.x + x1 * cs.y; }
            } else {
#pragma unroll
                for (int nt = 0; nt < 4; ++nt) dst[16 * nt + l15] = acc[nt][r];
            }
        }
    }
}
__device__ __forceinline__ void cmp_prompt_unit(const KP& p, int unit, int lane) {
    asm volatile("" : "+v"(lane));
    const int l15 = lane & 15, grp = lane >> 4;
    const int kv = unit & 1, combo = (unit >> 1) * 16 + l15; const int g = combo & 1, c = combo >> 1;
    const bf16* w1 = p.WT_C + ((size_t)kv * 128 + l15) * 2048 + 8 * grp;
    f32x4 acc[8];
#pragma unroll
    for (int jt = 0; jt < 8; ++jt) acc[jt] = (f32x4){0.f, 0.f, 0.f, 0.f};
    const bf16* fl = p.ACP + ((size_t)kv * 1024 + combo) * 2048 + 8 * grp;
#pragma unroll 4
    for (int ks = 0; ks < 64; ++ks) {
        const bf16x8 fb = *(const bf16x8*)(fl + 32 * ks);
#pragma unroll
        for (int jt = 0; jt < 8; ++jt) acc[jt] = MFMA16(*(const bf16x8*)(w1 + (size_t)jt * 16 * 2048 + 32 * ks), fb, acc[jt]);
    }
    bf16x8 hb[4];
#pragma unroll
    for (int s2 = 0; s2 < 4; ++s2) {
        f32x4 h0, h1;
#pragma unroll
        for (int r = 0; r < 4; ++r) { h0[r] = gelu_tanh(acc[2 * s2][r] + p.cb1[kv * 128 + 32 * s2 + 4 * grp + r]); h1[r] = gelu_tanh(acc[2 * s2 + 1][r] + p.cb1[kv * 128 + 32 * s2 + 16 + 4 * grp + r]); }
        hb[s2] = pack_p(h0, h1);
    }
    f32x4 o[4];
#pragma unroll
    for (int dt = 0; dt < 4; ++dt) {
        o[dt] = (f32x4){0.f, 0.f, 0.f, 0.f};
        const bf16* w2 = p.W2T + (size_t)kv * 64 * 128 + (size_t)(16 * dt + l15) * 128 + 4 * grp;
#pragma unroll
        for (int s2 = 0; s2 < 4; ++s2) { const uint2 x0 = *(const uint2*)(w2 + 32 * s2), x1 = *(const uint2*)(w2 + 32 * s2 + 16);
            union { v4u u; bf16x8 b; } wa; wa.u.x = x0.x; wa.u.y = x0.y; wa.u.z = x1.x; wa.u.w = x1.y;
            o[dt] = MFMA16(wa.b, hb[s2], o[dt]); }
    }
    if (kv == 0) {
        const int pos = (c + 1) * 32 - 1;
#pragma unroll
        for (int dt = 0; dt < 2; ++dt)
#pragma unroll
            for (int r = 0; r < 4; ++r) { const float2 cs = p.ROPE[pos * 32 + 16 * dt + 4 * grp + r]; const float x1 = o[dt][r], x2 = o[dt + 2][r];
                o[dt][r] = x1 * cs.x - x2 * cs.y; o[dt + 2][r] = x2 * cs.x + x1 * cs.y; }
    }
#pragma unroll
    for (int dt = 0; dt < 4; ++dt)
#pragma unroll
        for (int r = 0; r < 4; ++r) { const int d = 16 * dt + 4 * grp + r;
            if (kv == 0) p.CKF[(size_t)g * 512 * 64 + kfrag_elem(c, d)] = (bf16)f2bf(o[dt][r]); else p.CVF[(size_t)g * 512 * 64 + vfrag_elem(c, d)] = (bf16)f2bf(o[dt][r]); }
}
__device__ __forceinline__ void ph_cmp_prompt(const KP& p, const Fr& F) {
    for (int unit = F.gw; unit < 128; unit += F.NGW) cmp_prompt_unit(p, unit, F.lane);
}

__device__ __forceinline__ float rope_val(const float* row, int base, int i, float2 cs) {
    const int ii = i & 31;
    const float x1 = row[base + ii], x2 = row[base + ii + 32];
    return (i < 32) ? (x1 * cs.x - x2 * cs.y) : (x2 * cs.x + x1 * cs.y);
}
__device__ __forceinline__ void ph_nsa_prep(const KP& p, const Fr& F) {
    const float* H0 = p.BIGF; float* out = p.out;
    const size_t gt = (size_t)F.bid * NTHR + F.tid, GT = (size_t)F.G * NTHR;
    const size_t total = (size_t)TS * 1280;
    for (size_t idx = gt + (size_t)T * 1280; idx < total; idx += GT) {
        const int r = (int)(idx / 1280), c = (int)(idx % 1280);
        const bool smp = r >= T; const int b = r - T; const int pos = smp ? T : r;
        const float* row = H0 + (size_t)r * PA;
        const int i = c & 63;
        const float2 cs = p.ROPE[pos * 32 + (i & 31)];
        if (c < 512) { p.QR[(size_t)r * 512 + c] = rope_val(row, c & ~63, i, cs); continue; }
        const int sec = (c - 512) >> 7; const int gd = (c - 512) & 127; const int base = c & ~63;
        float v;
        if (sec == 2 || sec == 4) v = rope_val(row, base, i, cs); else v = row[c];
        const int kv = sec & 1;
        if (sec < 2) {
            if (!smp) out[O_CMP_P + (size_t)r * 256 + kv * 128 + gd] = v; else out[O_CMP_S + (size_t)b * 256 + kv * 128 + gd] = v;
        } else if (sec < 4) {
            if (!smp) out[O_SLC_P + (size_t)r * 256 + kv * 128 + gd] = v; else out[O_SLC_S + (size_t)b * 256 + kv * 128 + gd] = v;
            if (kv == 0) p.KS[(size_t)r * 128 + gd] = v; else p.VS[(size_t)r * 128 + gd] = v;
        } else {
            if (kv == 0) p.KW[(size_t)r * 128 + gd] = v; else p.VW[(size_t)r * 128 + gd] = v;
            if (!smp) { if (r >= T - 512) out[O_WIN_P + (size_t)(r - (T - 512)) * 256 + kv * 128 + gd] = v; }
            else out[O_WIN_S + ((size_t)b * 512 + 511) * 256 + kv * 128 + gd] = v;
        }
    }
    const size_t tot2 = (size_t)NSMP * 511 * 256;
    for (size_t idx = gt; idx < tot2; idx += GT) {
        const int b = (int)(idx / (511 * 256)); const int rem = (int)(idx % (511 * 256));
        out[O_WIN_S + (size_t)b * 512 * 256 + rem] = p.st_win[(size_t)b * 512 * 256 + 256 + rem];
    }
}

constexpr float QSCALE = 0.18033688011112042f;

__device__ __forceinline__ size_t kfrag_off(int kt, int ks, int lane) { return ((size_t)(kt * 2 + ks) * 64 + lane) * 8; }
__device__ __forceinline__ size_t vfrag_off(int st, int dt, int lane) { return ((size_t)(st * 4 + dt) * 64 + lane) * 8; }
__device__ __forceinline__ size_t vfrag_elem(int key, int d) {
    const int st = key >> 5, kk = key & 31, tile = kk >> 4, r16 = kk & 15, grp = r16 >> 2, reg = r16 & 3;
    return ((size_t)(st * 4 + (d >> 4)) * 64 + (d & 15) + 16 * grp) * 8 + tile * 4 + reg;
}
__device__ __forceinline__ size_t kfrag_elem(int key, int d) {
    return ((size_t)((key >> 4) * 2 + (d >> 5)) * 64 + (key & 15) + 16 * ((d & 31) >> 3)) * 8 + (d & 7);
}

__device__ __forceinline__ void ph_nsa_prep_fast(const KP& p, const Fr& F) {
    const float* H0 = p.BIGF; float* out = p.out;
    const size_t gt = (size_t)F.bid * NTHR + F.tid, GT = (size_t)F.G * NTHR;
    for (size_t idx = gt; idx < (size_t)T * 160; idx += GT) {
        const int t = (int)(idx / 160), u = (int)(idx % 160);
        const int c0 = u * 8; const float* row = H0 + (size_t)t * PA;
        const float4 a0 = *(const float4*)(row + c0), a1 = *(const float4*)(row + c0 + 4);
        float v[8] = {a0.x, a0.y, a0.z, a0.w, a1.x, a1.y, a1.z, a1.w};
        const int sec = (u < 64) ? -1 : ((u - 64) >> 4);
        const bool roped = (sec == -1 || sec == 2 || sec == 4);
        if (roped) {
            const int d0 = c0 & 63; const int pc = (d0 < 32) ? c0 + 32 : c0 - 32;
            const float4 b0 = *(const float4*)(row + pc), b1 = *(const float4*)(row + pc + 4);
            const float w[8] = {b0.x, b0.y, b0.z, b0.w, b1.x, b1.y, b1.z, b1.w};
#pragma unroll
            for (int j = 0; j < 8; ++j) { const float2 cs = p.ROPE[t * 32 + ((d0 + j) & 31)];
                v[j] = (d0 < 32) ? (v[j] * cs.x - w[j] * cs.y) : (v[j] * cs.x + w[j] * cs.y); }
        }
        if (sec == -1) {
            v4u o; o.x = pk2(v[0] * QSCALE, v[1] * QSCALE); o.y = pk2(v[2] * QSCALE, v[3] * QSCALE); o.z = pk2(v[4] * QSCALE, v[5] * QSCALE); o.w = pk2(v[6] * QSCALE, v[7] * QSCALE);
            *(v4u*)(p.QB + (size_t)t * 512 + c0) = o; continue;
        }
        const int gd = (c0 - 512) & 127, g = gd >> 6, d0 = gd & 63, kv = sec & 1;
        const float4 o0 = make_float4(v[0], v[1], v[2], v[3]), o1 = make_float4(v[4], v[5], v[6], v[7]);
        if (sec < 2) { float* o = out + O_CMP_P + (size_t)t * 256 + kv * 128 + gd; *(float4*)o = o0; *(float4*)(o + 4) = o1;
            const int i = t & 31; const float* pe = p.cpe + (kv * 32 + i) * 64 + d0; const float4 e0 = *(const float4*)pe, e1 = *(const float4*)(pe + 4);
            v4u w; w.x = pk2(v[0] + e0.x, v[1] + e0.y); w.y = pk2(v[2] + e0.z, v[3] + e0.w); w.z = pk2(v[4] + e1.x, v[5] + e1.y); w.w = pk2(v[6] + e1.z, v[7] + e1.w);
            *(v4u*)(p.ACP + ((size_t)kv * 1024 + (t >> 5) * 2 + g) * 2048 + i * 64 + d0) = w; continue; }
        if (sec < 4) { float* o = out + O_SLC_P + (size_t)t * 256 + kv * 128 + gd; *(float4*)o = o0; *(float4*)(o + 4) = o1; }
        else if (t >= T - 512) { float* o = out + O_WIN_P + (size_t)(t - (T - 512)) * 256 + kv * 128 + gd; *(float4*)o = o0; *(float4*)(o + 4) = o1; }
        bf16* KF = (sec < 4) ? p.KSF : p.KWF; bf16* VF = (sec < 4) ? p.VSF : p.VWF;
        if (kv == 0) {
            v4u o; o.x = pk2(v[0], v[1]); o.y = pk2(v[2], v[3]); o.z = pk2(v[4], v[5]); o.w = pk2(v[6], v[7]);
            *(v4u*)(KF + (size_t)g * T * 64 + kfrag_elem(t, d0)) = o;
        } else {
#pragma unroll
            for (int j = 0; j < 8; ++j) VF[(size_t)g * T * 64 + vfrag_elem(t, d0 + j)] = (bf16)f2bf(v[j]);
        }
    }
}

struct AttW { f32x4 o[4]; float m, l; };
__device__ __forceinline__ void attw_init(AttW& a) {
#pragma unroll
    for (int i = 0; i < 4; ++i) a.o[i] = (f32x4){0.f, 0.f, 0.f, 0.f};
    a.m = -INFINITY; a.l = 0.f;
}
__device__ __forceinline__ void qk_step(const bf16x8 (&kf)[2][2], const bf16x8 (&qf)[2], f32x4& s0, f32x4& s1) {
    const f32x4 z = {0.f, 0.f, 0.f, 0.f};
    s0 = MFMA16(kf[0][0], qf[0], z); s0 = MFMA16(kf[0][1], qf[1], s0);
    s1 = MFMA16(kf[1][0], qf[0], z); s1 = MFMA16(kf[1][1], qf[1], s1);
}
__device__ __forceinline__ bf16x8 pack_p(const f32x4& p0, const f32x4& p1) {
    union { v4u u; bf16x8 b; } c;
    c.u.x = pg8::cvt_pk_bf16(p0[0], p0[1]); c.u.y = pg8::cvt_pk_bf16(p0[2], p0[3]); c.u.z = pg8::cvt_pk_bf16(p1[0], p1[1]); c.u.w = pg8::cvt_pk_bf16(p1[2], p1[3]);
    return c.b;
}
__device__ __forceinline__ void att_update(AttW& a, const f32x4& s0, const f32x4& s1, const bf16x8 (&vf)[4]) {
    float mx = fmaxf(fmaxf(fmaxf(s0[0], s0[1]), fmaxf(s0[2], s0[3])), fmaxf(fmaxf(s1[0], s1[1]), fmaxf(s1[2], s1[3])));
    mx = fmaxf(mx, __shfl_xor(mx, 16)); mx = fmaxf(mx, __shfl_xor(mx, 32));
    const float mn = fmaxf(a.m, mx);
    const float ms = (mn == -INFINITY) ? 0.f : mn;
    const float alpha = __builtin_amdgcn_exp2f(a.m - ms);
    f32x4 p0, p1;
#pragma unroll
    for (int i = 0; i < 4; ++i) { p0[i] = __builtin_amdgcn_exp2f(s0[i] - ms); p1[i] = __builtin_amdgcn_exp2f(s1[i] - ms); }
    a.l = a.l * alpha + ((p0[0] + p0[1]) + (p0[2] + p0[3])) + ((p1[0] + p1[1]) + (p1[2] + p1[3]));
    a.m = mn;
    const bf16x8 pf = pack_p(p0, p1);
#pragma unroll
    for (int dt = 0; dt < 4; ++dt) { a.o[dt] = a.o[dt] * alpha; a.o[dt] = MFMA16(vf[dt], pf, a.o[dt]); }
}
__device__ __forceinline__ float grp_sum(float v) { v += __shfl_xor(v, 16); v += __shfl_xor(v, 32); return v; }

__device__ __forceinline__ void nsa_fast_unit(const KP& p, int unit, float* wl, int lane) {
    asm volatile("" : "+v"(lane));
    const int g = unit & 1, t0 = (unit >> 1) * 16;
    const int qi = lane & 15, grp = lane >> 4, t = t0 + qi;
    float* imp = wl; int* sel = (int*)(wl + 4096);
    const float* grow = p.BIGF + (size_t)t * PA + C_GATE + g * 4;
    bf16x8 qf[4][2];
#pragma unroll
    for (int h = 0; h < 4; ++h)
#pragma unroll
        for (int ks = 0; ks < 2; ++ks) qf[h][ks] = *(const bf16x8*)(p.QB + (size_t)t * 512 + (g * 4 + h) * 64 + 32 * ks + 8 * grp);
    AttW st[4];
    {
        const bf16* CKF = p.CKF + (size_t)g * 512 * 64; const bf16* CVF = p.CVF + (size_t)g * 512 * 64;
        const int nmax = (t0 + 16) >> 5; const int nsteps = (nmax + 31) >> 5;
        const int nval = (t + 1) >> 5;
        float m[4], l[4];
#pragma unroll
        for (int h = 0; h < 4; ++h) { m[h] = -INFINITY; l[h] = 0.f; }
        for (int s = 0; s < nsteps; ++s) {
            bf16x8 kf[2][2];
#pragma unroll
            for (int tl = 0; tl < 2; ++tl)
#pragma unroll
                for (int ks = 0; ks < 2; ++ks) kf[tl][ks] = *(const bf16x8*)(CKF + kfrag_off(2 * s + tl, ks, lane));
            const int cb = 32 * s + 4 * grp;
#pragma unroll
            for (int h = 0; h < 4; ++h) {
                f32x4 s0, s1; qk_step(kf, qf[h], s0, s1);
#pragma unroll
                for (int i = 0; i < 4; ++i) { if (cb + i >= nval) s0[i] = -INFINITY; if (cb + 16 + i >= nval) s1[i] = -INFINITY; }
                float mx = fmaxf(fmaxf(fmaxf(s0[0], s0[1]), fmaxf(s0[2], s0[3])), fmaxf(fmaxf(s1[0], s1[1]), fmaxf(s1[2], s1[3])));
                mx = fmaxf(mx, __shfl_xor(mx, 16)); mx = fmaxf(mx, __shfl_xor(mx, 32));
                const float mn = fmaxf(m[h], mx); const float ms = (mn == -INFINITY) ? 0.f : mn;
                float sum = 0.f;
#pragma unroll
                for (int i = 0; i < 4; ++i) sum += __builtin_amdgcn_exp2f(s0[i] - ms) + __builtin_amdgcn_exp2f(s1[i] - ms);
                l[h] = l[h] * __builtin_amdgcn_exp2f(m[h] - ms) + sum; m[h] = mn;
            }
        }
        float il[4];
#pragma unroll
        for (int h = 0; h < 4; ++h) { const float lt = grp_sum(l[h]); il[h] = lt > 0.f ? 1.f / lt : 0.f; if (m[h] == -INFINITY) m[h] = 0.f; attw_init(st[h]); }
        for (int s = 0; s < nsteps; ++s) {
            bf16x8 kf[2][2], vf[4];
#pragma unroll
            for (int tl = 0; tl < 2; ++tl)
#pragma unroll
                for (int ks = 0; ks < 2; ++ks) kf[tl][ks] = *(const bf16x8*)(CKF + kfrag_off(2 * s + tl, ks, lane));
#pragma unroll
            for (int dt = 0; dt < 4; ++dt) vf[dt] = *(const bf16x8*)(CVF + vfrag_off(s, dt, lane));
            const int cb = 32 * s + 4 * grp;
            float i4[4] = {0.f, 0.f, 0.f, 0.f};
#pragma unroll
            for (int h = 0; h < 4; ++h) {
                f32x4 s0, s1; qk_step(kf, qf[h], s0, s1);
                f32x4 p0, p1;
#pragma unroll
                for (int i = 0; i < 4; ++i) {
                    p0[i] = (cb + i < nval) ? __builtin_amdgcn_exp2f(s0[i] - m[h]) * il[h] : 0.f;
                    p1[i] = (cb + 16 + i < nval) ? __builtin_amdgcn_exp2f(s1[i] - m[h]) * il[h] : 0.f; }
                i4[0] += p0[0] + p0[1]; i4[1] += p0[2] + p0[3]; i4[2] += p1[0] + p1[1]; i4[3] += p1[2] + p1[3];
                const bf16x8 pf = pack_p(p0, p1);
#pragma unroll
                for (int dt = 0; dt < 4; ++dt) st[h].o[dt] = MFMA16(vf[dt], pf, st[h].o[dt]);
            }
            *(float2*)(imp + qi * 256 + 16 * s + 2 * grp) = make_float2(i4[0], i4[1]);
            *(float2*)(imp + qi * 256 + 16 * s + 8 + 2 * grp) = make_float2(i4[2], i4[3]);
        }
        wave_lds_sync();
    }
    const int cur = t0 >> 6;
    {
        if (cur + 1 <= 16) {
            for (int idx = lane; idx < 256; idx += 64) sel[idx] = ((idx & 15) <= cur) ? (idx & 15) : -1;
        } else {
            for (int q = 0; q < 16; ++q) {
                unsigned key[4];
#pragma unroll
                for (int j = 0; j < 4; ++j) { const int blk = lane + 64 * j; const float v = imp[q * 256 + blk];
                    key[j] = (blk >= 1 && blk <= cur - 2) ? ((__float_as_uint(v) & 0xFFFFFF00u) | (unsigned)(255 - blk)) : 0u; }
                if (lane == 0) { sel[q * 16 + 0] = 0; sel[q * 16 + 1] = cur; sel[q * 16 + 2] = cur - 1; }
                for (int n = 3; n < 16; ++n) {
                    unsigned best = max(max(key[0], key[1]), max(key[2], key[3]));
#pragma unroll
                    for (int o = 1; o < 64; o <<= 1) best = max(best, (unsigned)__shfl_xor((int)best, o));
                    const int blk = 255 - (int)(best & 255u);
#pragma unroll
                    for (int j = 0; j < 4; ++j) if (lane + 64 * j == blk) key[j] = 0u;
                    if (lane == 0) sel[q * 16 + n] = blk;
                }
            }
        }
        wave_lds_sync();
    }
    float* acc = wl;
    {
#pragma unroll
        for (int h = 0; h < 4; ++h) { const float gs = sigmoidf_(grow[h]);
#pragma unroll
            for (int dt = 0; dt < 4; ++dt) *(f32x4*)(acc + (qi * 4 + h) * 64 + 16 * dt + 4 * grp) = st[h].o[dt] * gs; }
        wave_lds_sync();
    }
    {
        const bf16* KF = p.KWF + (size_t)g * T * 64; const bf16* VF = p.VWF + (size_t)g * T * 64;
        int kstart = t0 - 512; if (kstart < 0) kstart = 0; kstart &= ~31;
        const int nsteps = (t0 + 16 - kstart + 31) >> 5;
#pragma unroll
        for (int h = 0; h < 4; ++h) attw_init(st[h]);
        for (int s = 0; s < nsteps; ++s) {
            const int k0 = kstart + 32 * s;
            bf16x8 kf[2][2], vf[4];
#pragma unroll
            for (int tl = 0; tl < 2; ++tl)
#pragma unroll
                for (int ks = 0; ks < 2; ++ks) kf[tl][ks] = *(const bf16x8*)(KF + kfrag_off((k0 >> 4) + tl, ks, lane));
#pragma unroll
            for (int dt = 0; dt < 4; ++dt) vf[dt] = *(const bf16x8*)(VF + vfrag_off(k0 >> 5, dt, lane));
            const bool need_mask = (k0 + 31 > t0) || (k0 < t0 + 15 - 512);
            const int pb = k0 + 4 * grp;
#pragma unroll
            for (int h = 0; h < 4; ++h) {
                f32x4 s0, s1; qk_step(kf, qf[h], s0, s1);
                if (need_mask) {
#pragma unroll
                    for (int i = 0; i < 4; ++i) { const int p0 = pb + i, p1 = pb + 16 + i;
                        if (p0 > t || p0 < t - 512) s0[i] = -INFINITY; if (p1 > t || p1 < t - 512) s1[i] = -INFINITY; }
                }
                att_update(st[h], s0, s1, vf);
            }
        }
#pragma unroll
        for (int h = 0; h < 4; ++h) { const float lt = grp_sum(st[h].l); const float gs = sigmoidf_(grow[16 + h]) * (lt > 0.f ? 1.f / lt : 0.f);
#pragma unroll
            for (int dt = 0; dt < 4; ++dt) { f32x4* a = (f32x4*)(acc + (qi * 4 + h) * 64 + 16 * dt + 4 * grp); *a = *a + st[h].o[dt] * gs; } }
        wave_lds_sync();
    }
    *(int4*)(p.SEL + ((size_t)g * T + t0) * 16 + lane * 4) = *(const int4*)(sel + lane * 4);
#pragma unroll 4
    for (int q = 0; q < 16; ++q) *(f32x4*)(p.NSACC + (size_t)(t0 + q) * 512 + g * 256 + 4 * lane) = *(const f32x4*)(acc + q * 256 + 4 * lane);
    wave_lds_sync();
}

__device__ __forceinline__ void nsa_slc_item(const KP& p, int tq, int g, int lane) {
    asm volatile("" : "+v"(lane));
    const int l15 = lane & 15, grp = lane >> 4, hn = lane & 3;
    const bf16* KF = p.KSF + (size_t)g * T * 64; const bf16* VF = p.VSF + (size_t)g * T * 64;
    const int* selp = p.SEL + ((size_t)g * T + tq) * 16;
    int sb[16];
#pragma unroll
    for (int i = 0; i < 16; ++i) sb[i] = __builtin_amdgcn_readfirstlane(selp[i]);
    bf16x8 qs[2];
#pragma unroll
    for (int ks = 0; ks < 2; ++ks) qs[ks] = *(const bf16x8*)(p.QB + (size_t)tq * 512 + (g * 4 + hn) * 64 + 32 * ks + 8 * grp);
    AttW a; attw_init(a);
    bf16x8 kf[2][2][2], vf[2][4];
    auto issue = [&](int i, int buf) {
        const int blk = sb[i >> 1]; int k0 = blk * 64 + 32 * (i & 1); if (blk < 0 || k0 > tq) k0 = 0;
#pragma unroll
        for (int tl = 0; tl < 2; ++tl)
#pragma unroll
            for (int ks = 0; ks < 2; ++ks) kf[buf][tl][ks] = *(const bf16x8*)(KF + kfrag_off((k0 >> 4) + tl, ks, lane));
#pragma unroll
        for (int dt = 0; dt < 4; ++dt) vf[buf][dt] = *(const bf16x8*)(VF + vfrag_off(k0 >> 5, dt, lane));
    };
    issue(0, 0);
#pragma unroll
    for (int i = 0; i < 32; ++i) {
        const int buf = i & 1;
        if (i + 1 < 32) issue(i + 1, buf ^ 1);
        const int blk = sb[i >> 1]; const int k0 = blk * 64 + 32 * (i & 1);
        const bool dead = (blk < 0) || (k0 > tq);
        f32x4 s0, s1; qk_step(kf[buf], qs, s0, s1);
        const int pb = k0 + 4 * grp;
#pragma unroll
        for (int j = 0; j < 4; ++j) { if (dead || pb + j > tq) s0[j] = -INFINITY; if (dead || pb + 16 + j > tq) s1[j] = -INFINITY; }
        att_update(a, s0, s1, vf[buf]);
    }
    const float lt = grp_sum(a.l);
    if (l15 < 4) {
        const float gs = sigmoidf_(p.BIGF[(size_t)tq * PA + C_GATE + 8 + g * 4 + l15]) * (lt > 0.f ? 1.f / lt : 0.f);
#pragma unroll
        for (int dt = 0; dt < 4; ++dt) {
            const size_t o = (size_t)tq * 512 + g * 256 + l15 * 64 + 16 * dt + 4 * grp;
            const f32x4 base = *(const f32x4*)(p.NSACC + o); const f32x4 v = base + a.o[dt] * gs;
            uint2 w; w.x = pk2(v[0], v[1]); w.y = pk2(v[2], v[3]);
            *(uint2*)(p.MIXB + (size_t)tq * 1024 + g * 256 + l15 * 64 + 16 * dt + 4 * grp) = w;
        }
    }
}

__device__ __forceinline__ void ph_compress(const KP& p, const Fr& F) {
    float* flat = (float*)F.lds;
    float* hid = (float*)(F.lds + 32768);
    float* res = (float*)(F.lds + 32768 + 2048);
    const float* H0 = p.BIGF;
    const int tid = F.tid;
    for (int item = F.bid; item < 512; item += F.G) {
        const int c = item & 511, s = item >> 9;
        for (int e = tid; e < 8192; e += NTHR) {
            const int kv = e >> 12, g = (e >> 11) & 1, k = e & 2047, i = k >> 6, d = k & 63;
            const int row = c * 32 + i;
            float v;
            if (s == 0) v = H0[(size_t)row * PA + C_KC + kv * 128 + g * 64 + d];
            else { const int b = s - 1; const int page = p.page_table[b * NPAGES + (row >> 7)];
                   v = p.cache_cmp[((((size_t)page * 128 + (row & 127)) * 2 + kv) * 2 + g) * 64 + d]; }
            flat[e] = v + p.cpe[(kv * 32 + i) * 64 + d];
        }
        __syncthreads();
        {
            const int kv = tid >> 8, g = (tid >> 7) & 1, j = tid & 127;
            const float* w = p.cw1 + (size_t)kv * 2048 * 128 + j;
            const float* fl = flat + (kv * 2 + g) * 2048;
            float acc = p.cb1[kv * 128 + j];
            for (int k = 0; k < 2048; ++k) acc += fl[k] * w[(size_t)k * 128];
            hid[(kv * 2 + g) * 128 + j] = gelu_tanh(acc);
        }
        __syncthreads();
        if (tid < 256) {
            const int kv = tid >> 7, g = (tid >> 6) & 1, d = tid & 63;
            const float* w = p.cw2 + (size_t)kv * 128 * 64 + d;
            const float* hh = hid + (kv * 2 + g) * 128;
            float acc = 0.f;
            for (int j = 0; j < 128; ++j) acc += hh[j] * w[j * 64];
            res[(kv * 2 + g) * 64 + d] = acc;
        }
        __syncthreads();
        if (tid < 256) {
            const int kv = tid >> 7, g = (tid >> 6) & 1, d = tid & 63;
            const float* rr = res + (kv * 2 + g) * 64;
            float v = rr[d];
            if (kv == 0) {
                const int pos = (c + 1) * 32 - 1; const float2 cs = p.ROPE[pos * 32 + (d & 31)];
                const float x1 = rr[d & 31], x2 = rr[(d & 31) + 32];
                v = (d < 32) ? (x1 * cs.x - x2 * cs.y) : (x2 * cs.x + x1 * cs.y);
                p.CK[(((size_t)s * 512 + c) * 2 + g) * 64 + d] = v;
                if (s == 0) p.CKF[(size_t)g * 512 * 64 + kfrag_elem(c, d)] = (bf16)f2bf(v);
            } else { p.CV[(((size_t)s * 512 + c) * 2 + g) * 64 + d] = v; if (s == 0) p.CVF[(size_t)g * 512 * 64 + vfrag_elem(c, d)] = (bf16)f2bf(v); }
        }
        __syncthreads();
    }
}

__device__ __forceinline__ void ph_gdn_prep(const KP& p, const Fr& F) {
    const float* H0 = p.BIGF; const int lane = F.lane;
    for (int item = T * 8 + F.gw; item < TS * 8; item += F.NGW) {
        const int r = item >> 3, h = item & 7;
        const bool smp = r >= T; const int b = r - T;
        float cv[3];
#pragma unroll
        for (int part = 0; part < 3; ++part) {
            const int ch = part * 512 + h * 64 + lane;
            float acc = 0.f;
#pragma unroll
            for (int j = 0; j < 4; ++j) {
                float u;
                if (!smp) { const int t = r + j - 3; u = (t >= 0) ? H0[(size_t)t * PA + C_GQKV + ch] : 0.f; }
                else { u = (j < 3) ? p.st_gconv[((size_t)b * 3 + j) * 1536 + ch] : H0[(size_t)r * PA + C_GQKV + ch]; }
                acc += p.gconv_w[j * 1536 + ch] * u;
            }
            cv[part] = siluf_(acc);
        }
        const float qn = wave_sum(cv[0] * cv[0]), kn = wave_sum(cv[1] * cv[1]);
        const size_t o = ((size_t)r * 8 + h) * 64 + lane;
        p.GQ[o] = cv[0] * rsqrtf(qn + NORM_EPS) * 0.125f;
        p.GK[o] = cv[1] * rsqrtf(kn + NORM_EPS);
        p.GV[o] = cv[2];
        if (lane == 0) {
            const float av = H0[(size_t)r * PA + C_A + h], bt = H0[(size_t)r * PA + C_BT + h];
            p.Gg[(size_t)r * 8 + h] = -expf(p.gA[h]) * softplusf_(av + p.gdt[h]);
            p.Gb[(size_t)r * 8 + h] = sigmoidf_(bt);
        }
    }
    const size_t gt = (size_t)F.bid * NTHR + F.tid, GT = (size_t)F.G * NTHR;
    for (size_t idx = gt; idx < (size_t)3 * 1536; idx += GT) {
        const int j = (int)(idx / 1536), ch = (int)(idx % 1536);
        p.out[O_GCONV_P + idx] = H0[(size_t)(T - 3 + j) * PA + C_GQKV + ch];
    }
    for (size_t idx = gt; idx < (size_t)NSMP * 3 * 1536; idx += GT) {
        const int b = (int)(idx / (3 * 1536)), j = (int)((idx / 1536) % 3), ch = (int)(idx % 1536);
        p.out[O_GCONV_S + idx] = (j < 2) ? p.st_gconv[((size_t)b * 3 + j + 1) * 1536 + ch] : H0[(size_t)(T + b) * PA + C_GQKV + ch];
    }
}

template <int NH, class KF>
__device__ __forceinline__ void wave_attend(const float* qs, float* sc, int scstride, int nkeys, KF kf, float (&outv)[NH], float (&den)[NH], int lane) {
    float mx[NH];
#pragma unroll
    for (int h = 0; h < NH; ++h) mx[h] = -INFINITY;
    for (int j = lane; j < nkeys; j += 64) {
        const float *kp, *vp; const bool ok = kf(j, kp, vp);
        float s[NH];
#pragma unroll
        for (int h = 0; h < NH; ++h) s[h] = 0.f;
        if (ok) {
            for (int d4 = 0; d4 < 16; ++d4) {
                const float4 kvv = ((const float4*)kp)[d4];
#pragma unroll
                for (int h = 0; h < NH; ++h) { const float* q = qs + h * 64 + d4 * 4; s[h] += kvv.x * q[0] + kvv.y * q[1] + kvv.z * q[2] + kvv.w * q[3]; }
            }
        }
#pragma unroll
        for (int h = 0; h < NH; ++h) { const float v = ok ? s[h] * 0.125f : -INFINITY; sc[h * scstride + j] = v; mx[h] = fmaxf(mx[h], v); }
    }
#pragma unroll
    for (int h = 0; h < NH; ++h) { mx[h] = wave_max(mx[h]); if (!(mx[h] > -INFINITY)) mx[h] = 0.f; }
    float sm[NH];
#pragma unroll
    for (int h = 0; h < NH; ++h) sm[h] = 0.f;
    for (int j = lane; j < nkeys; j += 64) {
#pragma unroll
        for (int h = 0; h < NH; ++h) { const float v = sc[h * scstride + j]; const float pp = (v == -INFINITY) ? 0.f : expf(v - mx[h]); sc[h * scstride + j] = pp; sm[h] += pp; }
    }
#pragma unroll
    for (int h = 0; h < NH; ++h) { sm[h] = wave_sum(sm[h]); den[h] = sm[h] > 0.f ? sm[h] : 1.f; }
    wave_lds_sync();
    {
        const int kq = lane >> 4, d4 = lane & 15;
        float4 acc[NH];
#pragma unroll
        for (int h = 0; h < NH; ++h) acc[h] = make_float4(0.f, 0.f, 0.f, 0.f);
        for (int j0 = 0; j0 < nkeys; j0 += 32) {
            float4 v[8];
#pragma unroll
            for (int u = 0; u < 8; ++u) { const int j = j0 + 4 * u + kq; const float *kp, *vp; const bool ok = (j < nkeys) && kf(j, kp, vp);
                v[u] = ok ? *(const float4*)(vp + 4 * d4) : make_float4(0.f, 0.f, 0.f, 0.f); }
#pragma unroll
            for (int u = 0; u < 8; ++u) { const int j = j0 + 4 * u + kq;
#pragma unroll
                for (int h = 0; h < NH; ++h) { const float pp = (j < nkeys) ? sc[h * scstride + j] : 0.f;
                    acc[h].x += pp * v[u].x; acc[h].y += pp * v[u].y; acc[h].z += pp * v[u].z; acc[h].w += pp * v[u].w; } }
        }
#pragma unroll
        for (int h = 0; h < NH; ++h) {
            float4 a = acc[h];
            a.x += __shfl_xor(a.x, 16); a.y += __shfl_xor(a.y, 16); a.z += __shfl_xor(a.z, 16); a.w += __shfl_xor(a.w, 16);
            a.x += __shfl_xor(a.x, 32); a.y += __shfl_xor(a.y, 32); a.z += __shfl_xor(a.z, 32); a.w += __shfl_xor(a.w, 32);
            const float x0 = __shfl(a.x, lane >> 2), x1 = __shfl(a.y, lane >> 2), x2 = __shfl(a.z, lane >> 2), x3 = __shfl(a.w, lane >> 2);
            const int cc = lane & 3; outv[h] = cc == 0 ? x0 : (cc == 1 ? x1 : (cc == 2 ? x2 : x3));
        }
    }
#pragma unroll
    for (int h = 0; h < NH; ++h) outv[h] /= den[h];
    wave_lds_sync();
}

__device__ __forceinline__ void nsa_smp_cs(const KP& p, int b, int g, float* wl, int lane) {
    float* qs = wl; float* sc = wl + 256; float* imp = wl + 256 + 4 * 1088; int* sel = (int*)(wl + 256 + 4 * 1088 + 320); long long* bb = (long long*)(wl + 256 + 4 * 1088 + 320 + 16);
    const int r = T + b; const int qpos = T;
    const float* grow = p.BIGF + (size_t)r * PA + C_GATE;
#pragma unroll
    for (int h = 0; h < 4; ++h) qs[h * 64 + lane] = p.QR[(size_t)r * 512 + (g * 4 + h) * 64 + lane];
    wave_lds_sync();
    float ocmp[4], oslc[4], den[4];
    {
        const float* CKp = p.CK + (size_t)(1 + b) * 512 * 128; const float* CVp = p.CV + (size_t)(1 + b) * 512 * 128;
        auto kf = [&](int j, const float*& kp, const float*& vp) -> bool { kp = CKp + (j * 2 + g) * 64; vp = CVp + (j * 2 + g) * 64; return true; };
        wave_attend<4>(qs, sc, 1088, 512, kf, ocmp, den, lane);
        for (int blk = lane; blk < 320; blk += 64) {
            float v = 0.f;
            if (blk < 256) {
#pragma unroll
                for (int h = 0; h < 4; ++h) v += (sc[h * 1088 + 2 * blk] + sc[h * 1088 + 2 * blk + 1]) / den[h];
            }
            imp[blk] = v;
        }
        wave_lds_sync();
    }
    {
        const int cur = qpos >> 6;
        float val[5];
#pragma unroll
        for (int j = 0; j < 5; ++j) { const int blk = lane + 64 * j; val[j] = (blk >= 1 && blk <= cur - 2) ? imp[blk] : -1.f; }
        if (lane == 0) { sel[0] = 0; sel[1] = cur; sel[2] = cur - 1; }
        for (int n = 3; n < 16; ++n) {
            float bv = -2.f; int bi = 0x7fffffff;
#pragma unroll
            for (int j = 0; j < 5; ++j) if (val[j] > bv) { bv = val[j]; bi = lane + 64 * j; }
#pragma unroll
            for (int o = 1; o < 64; o <<= 1) { const float ov = __shfl_xor(bv, o); const int oi = __shfl_xor(bi, o); if (ov > bv || (ov == bv && oi < bi)) { bv = ov; bi = oi; } }
#pragma unroll
            for (int j = 0; j < 5; ++j) if (lane + 64 * j == bi) val[j] = -3.f;
            if (lane == 0) sel[n] = bi;
        }
        wave_lds_sync();
        if (lane < 16) { const int blk = sel[lane]; long long o = 0;
            if (blk < 256) { const int page = p.page_table[b * NPAGES + (blk >> 1)]; o = ((long long)page * 128 + (blk & 1) * 64) * 256; }
            bb[lane] = o; }
        wave_lds_sync();
    }
    {
        auto kf = [&](int j, const float*& kp, const float*& vp) -> bool {
            const int blk = sel[j >> 6]; const int pos = blk * 64 + (j & 63); if (pos > qpos) return false;
            if (pos == T) { kp = p.KS + (size_t)r * 128 + g * 64; vp = p.VS + (size_t)r * 128 + g * 64; return true; }
            const float* base = p.cache_slc + bb[j >> 6] + (j & 63) * 256;
            kp = base + g * 64; vp = base + 128 + g * 64; return true; };
        wave_attend<4>(qs, sc, 1088, 1024, kf, oslc, den, lane);
    }
#pragma unroll
    for (int h = 0; h < 4; ++h) {
        const int hh = g * 4 + h;
        p.SMIXF[((size_t)b * 3 + 0) * 512 + hh * 64 + lane] = sigmoidf_(grow[hh]) * ocmp[h];
        p.SMIXF[((size_t)b * 3 + 1) * 512 + hh * 64 + lane] = sigmoidf_(grow[8 + hh]) * oslc[h];
    }
    wave_lds_sync();
}
__device__ __forceinline__ void nsa_smp_win(const KP& p, int b, int g, float* wl, int lane) {
    float* qs = wl; float* sc = wl + 256;
    const int r = T + b;
    const float* grow = p.BIGF + (size_t)r * PA + C_GATE;
#pragma unroll
    for (int h = 0; h < 4; ++h) qs[h * 64 + lane] = p.QR[(size_t)r * 512 + (g * 4 + h) * 64 + lane];
    wave_lds_sync();
    float owin[4], den[4];
    auto kf = [&](int j, const float*& kp, const float*& vp) -> bool {
        if (j == 512) { kp = p.KW + (size_t)r * 128 + g * 64; vp = p.VW + (size_t)r * 128 + g * 64; return true; }
        const float* base = p.st_win + ((size_t)b * 512 + j) * 256;
        kp = base + g * 64; vp = base + 128 + g * 64; return true; };
    wave_attend<4>(qs, sc, 528, 513, kf, owin, den, lane);
#pragma unroll
    for (int h = 0; h < 4; ++h) { const int hh = g * 4 + h; p.SMIXF[((size_t)b * 3 + 2) * 512 + hh * 64 + lane] = sigmoidf_(grow[16 + hh]) * owin[h]; }
    wave_lds_sync();
}

__device__ __forceinline__ void gdn_scan_item(const KP& p, int item, float* wl, int lane) {
    asm volatile("" : "+v"(lane));
    float* kq = wl;
    const int b = (item >> 3) - 1, h = item & 7;
    const int r = T + b; const size_t o = ((size_t)r * 8 + h) * 64;
    kq[lane] = p.GK[o + lane]; kq[64 + lane] = p.GQ[o + lane];
    wave_lds_sync();
    const float dec = expf(p.Gg[(size_t)r * 8 + h]), bt = p.Gb[(size_t)r * 8 + h];
    const float* Sp = p.st_gS + ((size_t)b * 8 + h) * 4096 + lane;
    float* so = p.out + O_GS_S + ((size_t)b * 8 + h) * 4096 + lane;
    float S[64]; float kv = 0.f;
#pragma unroll
    for (int i = 0; i < 64; ++i) { S[i] = Sp[i * 64] * dec; kv += kq[i] * S[i]; }
    const float vn = (p.GV[o + lane] - kv) * bt;
    float ov = 0.f;
#pragma unroll
    for (int i = 0; i < 64; ++i) { const float sn = S[i] + kq[i] * vn; ov += kq[64 + i] * sn; so[i * 64] = sn; }
    p.OG[o + lane] = ov;
    wave_lds_sync();
}

constexpr int GDN_WL = 34816;
__device__ __forceinline__ int kperm(int ks, int grp, int j) { return 32 * ks + 16 * (j >> 2) + 4 * grp + (j & 3); }

__device__ __forceinline__ void gdn_chunk_unit(const KP& p, int unit, unsigned char* ldsb, int woff, int lane) {
    asm volatile("" : "+v"(lane), "+s"(woff));
    unsigned char* wlb = ldsb + woff;
    const int n = unit >> 3, h = unit & 7, t0 = 64 * n;
    const int l15 = lane & 15, grp = lane >> 4;
    float* Af = (float*)wlb; bf16* kt = (bf16*)(wlb + 16384); bf16* qt = kt + 64 * 72; bf16* tmp = (bf16*)wlb;
    {
        const float* H0 = p.BIGF;
        float w[3][4], u1[3], u2[3], u3[3];
#pragma unroll
        for (int part = 0; part < 3; ++part) {
            const int ch = part * 512 + h * 64 + lane;
#pragma unroll
            for (int j = 0; j < 4; ++j) w[part][j] = p.gconv_w[j * 1536 + ch];
            u1[part] = (t0 >= 1) ? H0[(size_t)(t0 - 1) * PA + C_GQKV + ch] : 0.f;
            u2[part] = (t0 >= 2) ? H0[(size_t)(t0 - 2) * PA + C_GQKV + ch] : 0.f;
            u3[part] = (t0 >= 3) ? H0[(size_t)(t0 - 3) * PA + C_GQKV + ch] : 0.f;
        }
        int roff = 0;
#pragma unroll 4
        for (int i = 0; i < 64; ++i) {
            float cv[3];
#pragma unroll
            for (int part = 0; part < 3; ++part) {
                const float u0 = H0[(size_t)t0 * PA + C_GQKV + part * 512 + h * 64 + lane + roff];
                cv[part] = siluf_(w[part][0] * u3[part] + w[part][1] * u2[part] + w[part][2] * u1[part] + w[part][3] * u0);
                u3[part] = u2[part]; u2[part] = u1[part]; u1[part] = u0;
            }
            roff += PA; asm volatile("" : "+s"(roff));
            const float qn = wave_sum(cv[0] * cv[0]), kn = wave_sum(cv[1] * cv[1]);
            qt[i * 72 + lane] = (bf16)f2bf(cv[0] * rsqrtf(qn + NORM_EPS) * 0.125f);
            kt[i * 72 + lane] = (bf16)f2bf(cv[1] * rsqrtf(kn + NORM_EPS));
            p.GV[((size_t)(t0 + i) * 8 + h) * 64 + lane] = cv[2];
        }
    }
    const float gl_ = -expf(p.gA[h]) * softplusf_(p.BIGF[(size_t)(t0 + lane) * PA + C_A + h] + p.gdt[h]);
    const float beta = sigmoidf_(p.BIGF[(size_t)(t0 + lane) * PA + C_BT + h]);
    float gc = gl_;
#pragma unroll
    for (int o = 1; o < 64; o <<= 1) { const float tv = __shfl_up(gc, o); if (lane >= o) gc += tv; }
    const float gclast = __shfl(gc, 63);
#define GPAD(i) ((float*)(kt + (i) * 72 + 64))
    { float* pd = GPAD(lane); pd[0] = gc; pd[1] = beta; pd[2] = expf(gc); pd[3] = expf(gclast - gc); }
    wave_lds_sync();
    bf16* QKF = p.G_QKF + (size_t)unit * 4096;
#pragma unroll
    for (int it = 0; it < 4; ++it) {
        const int i = 16 * it + l15;
        const float gci = GPAD(i)[0], bi = GPAD(i)[1];
        bf16x8 bk[2], bq[2];
#pragma unroll
        for (int ks = 0; ks < 2; ++ks) { bk[ks] = *(const bf16x8*)(kt + i * 72 + 32 * ks + 8 * grp); bq[ks] = *(const bf16x8*)(qt + i * 72 + 32 * ks + 8 * grp); }
#pragma unroll
        for (int jt = 0; jt < 4; ++jt) {
            uint2 qkp = make_uint2(0u, 0u);
            if (jt <= it) {
                bf16x8 ak[2];
#pragma unroll
                for (int ks = 0; ks < 2; ++ks) ak[ks] = *(const bf16x8*)(kt + (16 * jt + l15) * 72 + 32 * ks + 8 * grp);
                f32x4 aa = {0.f, 0.f, 0.f, 0.f}, aq = {0.f, 0.f, 0.f, 0.f};
                aa = MFMA16(ak[0], bk[0], aa); aa = MFMA16(ak[1], bk[1], aa);
                aq = MFMA16(ak[0], bq[0], aq); aq = MFMA16(ak[1], bq[1], aq);
                f32x4 av, qv;
#pragma unroll
                for (int r = 0; r < 4; ++r) {
                    const int j = 16 * jt + 4 * grp + r; const float gcj = GPAD(j)[0];
                    const float e = (j <= i) ? expf(gci - gcj) : 0.f;
                    av[r] = (j < i) ? bi * aa[r] * e : 0.f; qv[r] = aq[r] * e;
                }
                *(f32x4*)(Af + i * 64 + 16 * jt + 4 * grp) = av;
                qkp.x = pk2(qv[0], qv[1]); qkp.y = pk2(qv[2], qv[3]);
            }
            *(uint2*)(QKF + ((size_t)(it * 2 + (jt >> 1)) * 64 + lane) * 8 + (jt & 1) * 4) = qkp;
        }
    }
    wave_lds_sync();
    {
        float* UF = p.G_UF + (size_t)unit * 4096;
        const int vq = lane >> 4;
#pragma unroll
        for (int pass = 0; pass < 2; ++pass) {
            float x[64];
            int goff = 0;
#pragma unroll
            for (int i = 0; i < 64; ++i) {
                const float bi = GPAD(i)[1];
                float acc;
                if (pass == 0) { acc = p.GV[((size_t)t0 * 8 + h) * 64 + lane + goff] * bi; goff += 512; asm volatile("" : "+s"(goff)); }
                else { const float ei = GPAD(i)[2];
                       acc = __uint_as_float((unsigned)kt[i * 72 + lane] << 16) * bi * ei; }
#pragma unroll
                for (int jj = 0; jj < (i + 3) / 4; ++jj) {
                    const float4 a4 = *(const float4*)(Af + i * 64 + 4 * jj);
                    acc -= a4.x * x[4 * jj + 0];
                    if (4 * jj + 1 < i) acc -= a4.y * x[4 * jj + 1];
                    if (4 * jj + 2 < i) acc -= a4.z * x[4 * jj + 2];
                    if (4 * jj + 3 < i) acc -= a4.w * x[4 * jj + 3];
                }
                x[i] = acc;
                if ((i & 3) == 3) asm volatile("" ::: "memory");
            }
            if (pass == 0) {
#pragma unroll
                for (int c4 = 0; c4 < 16; ++c4) {
                    const int mt = c4 >> 2, lp = l15 + 16 * (c4 & 3);
                    *(f32x4*)(UF + ((size_t)(vq * 4 + mt) * 64 + lp) * 4) = (f32x4){x[4 * c4], x[4 * c4 + 1], x[4 * c4 + 2], x[4 * c4 + 3]};
                }
            } else {
                wave_lds_sync();
#pragma unroll
                for (int c = 0; c < 64; ++c) tmp[c * 72 + lane] = (bf16)f2bf(-x[c]);
            }
            asm volatile("" ::: "memory");
        }
    }
    wave_lds_sync();
    {
        bf16* WF = p.G_WF + (size_t)unit * 4096; bf16* QGF = p.G_QGF + (size_t)unit * 4096; bf16* KDF = p.G_KDF + (size_t)unit * 4096;
#pragma unroll
        for (int mt = 0; mt < 4; ++mt) {
            const float egc = GPAD(16 * mt + l15)[2];
#pragma unroll
            for (int ks = 0; ks < 2; ++ks) {
                const int c = 16 * mt + l15, k0 = 32 * ks + 4 * grp;
                const uint2 w0 = *(const uint2*)(tmp + c * 72 + k0), w1 = *(const uint2*)(tmp + c * 72 + k0 + 16);
                v4u wv; wv.x = w0.x; wv.y = w0.y; wv.z = w1.x; wv.w = w1.y;
                *(v4u*)(WF + ((size_t)(mt * 2 + ks) * 64 + lane) * 8) = wv;
                const uint2 q0 = *(const uint2*)(qt + c * 72 + k0), q1 = *(const uint2*)(qt + c * 72 + k0 + 16);
                v4u qv;
                qv.x = pk2(__uint_as_float(q0.x << 16) * egc, __uint_as_float(q0.x & 0xffff0000u) * egc); qv.y = pk2(__uint_as_float(q0.y << 16) * egc, __uint_as_float(q0.y & 0xffff0000u) * egc);
                qv.z = pk2(__uint_as_float(q1.x << 16) * egc, __uint_as_float(q1.x & 0xffff0000u) * egc); qv.w = pk2(__uint_as_float(q1.y << 16) * egc, __uint_as_float(q1.y & 0xffff0000u) * egc);
                *(v4u*)(QGF + ((size_t)(mt * 2 + ks) * 64 + lane) * 8) = qv;
                float kd[8];
#pragma unroll
                for (int j = 0; j < 8; ++j) { const int cc = kperm(ks, grp, j); kd[j] = __uint_as_float((unsigned)kt[cc * 72 + 16 * mt + l15] << 16) * GPAD(cc)[3]; }
                v4u kv; kv.x = pk2(kd[0], kd[1]); kv.y = pk2(kd[2], kd[3]); kv.z = pk2(kd[4], kd[5]); kv.w = pk2(kd[6], kd[7]);
                *(v4u*)(KDF + ((size_t)(mt * 2 + ks) * 64 + lane) * 8) = kv;
            }
        }
        if (lane == 0) p.G_GL[unit] = expf(gclast);
    }
    wave_lds_sync();
#undef GPAD
}

__device__ __forceinline__ void gdn_chain(const KP& p, int h, int vq, int lane) {
    const int l15 = lane & 15, grp = lane >> 4;
    f32x4 S[4];
#pragma unroll
    for (int i = 0; i < 4; ++i) S[i] = (f32x4){0.f, 0.f, 0.f, 0.f};
    bf16x8 wf[4][2], kdf[4][2]; f32x4 uf[4]; float gl;
    auto load = [&](int n, bf16x8 (&W)[4][2], bf16x8 (&K)[4][2], f32x4 (&U)[4], float& G) {
        const int unit = n * 8 + h;
        const bf16* WF = p.G_WF + (size_t)unit * 4096; const bf16* KDF = p.G_KDF + (size_t)unit * 4096; const float* UF = p.G_UF + (size_t)unit * 4096;
#pragma unroll
        for (int mt = 0; mt < 4; ++mt) {
#pragma unroll
            for (int ks = 0; ks < 2; ++ks) { W[mt][ks] = *(const bf16x8*)(WF + ((size_t)(mt * 2 + ks) * 64 + lane) * 8); K[mt][ks] = *(const bf16x8*)(KDF + ((size_t)(mt * 2 + ks) * 64 + lane) * 8); }
            U[mt] = *(const f32x4*)(UF + ((size_t)(vq * 4 + mt) * 64 + lane) * 4);
        }
        G = p.G_GL[unit];
    };
    load(0, wf, kdf, uf, gl);
    for (int n = 0; n < 256; ++n) {
        bf16x8 wn[4][2], kn[4][2]; f32x4 un[4]; float gn;
        const int nn = (n + 1 < 256) ? n + 1 : n;
        load(nn, wn, kn, un, gn);
        const size_t fo = ((size_t)((n * 8 + h) * 4 + vq) * 2) * 512;
        bf16x8 sB[2];
#pragma unroll
        for (int ks = 0; ks < 2; ++ks) { sB[ks] = pack_p(S[2 * ks], S[2 * ks + 1]); *(bf16x8*)(p.G_SPF + fo + ((size_t)ks * 64 + lane) * 8) = sB[ks]; }
        f32x4 v[4];
#pragma unroll
        for (int mt = 0; mt < 4; ++mt) { v[mt] = uf[mt]; v[mt] = MFMA16(wf[mt][0], sB[0], v[mt]); v[mt] = MFMA16(wf[mt][1], sB[1], v[mt]); }
        bf16x8 vB[2];
#pragma unroll
        for (int ks = 0; ks < 2; ++ks) { vB[ks] = pack_p(v[2 * ks], v[2 * ks + 1]); *(bf16x8*)(p.G_VNF + fo + ((size_t)ks * 64 + lane) * 8) = vB[ks]; }
#pragma unroll
        for (int mt = 0; mt < 4; ++mt) { S[mt] = S[mt] * gl; S[mt] = MFMA16(kdf[mt][0], vB[0], S[mt]); S[mt] = MFMA16(kdf[mt][1], vB[1], S[mt]); }
#pragma unroll
        for (int mt = 0; mt < 4; ++mt) {
#pragma unroll
            for (int ks = 0; ks < 2; ++ks) { wf[mt][ks] = wn[mt][ks]; kdf[mt][ks] = kn[mt][ks]; }
            uf[mt] = un[mt];
        }
        gl = gn;
    }
    float* so = p.out + O_GS_P + (size_t)h * 4096;
#pragma unroll
    for (int mt = 0; mt < 4; ++mt)
#pragma unroll
        for (int r = 0; r < 4; ++r) so[(16 * mt + 4 * grp + r) * 64 + 16 * vq + l15] = S[mt][r];
}

__device__ __forceinline__ void gdn_out_unit(const KP& p, int unit, int lane) {
    asm volatile("" : "+v"(lane));
    const int n = unit >> 3, h = unit & 7, t0 = 64 * n; const int l15 = lane & 15, grp = lane >> 4;
    const bf16* QGF = p.G_QGF + (size_t)unit * 4096; const bf16* QKF = p.G_QKF + (size_t)unit * 4096;
    f32x4 o[4][4];
#pragma unroll
    for (int mt = 0; mt < 4; ++mt)
#pragma unroll
        for (int vq = 0; vq < 4; ++vq) o[mt][vq] = (f32x4){0.f, 0.f, 0.f, 0.f};
#pragma unroll
    for (int ks = 0; ks < 2; ++ks) {
        bf16x8 sp[4], vn[4];
#pragma unroll
        for (int vq = 0; vq < 4; ++vq) { const size_t fo = ((size_t)(unit * 4 + vq) * 2 + ks) * 512 + (size_t)lane * 8; sp[vq] = *(const bf16x8*)(p.G_SPF + fo); vn[vq] = *(const bf16x8*)(p.G_VNF + fo); }
#pragma unroll
        for (int mt = 0; mt < 4; ++mt) {
            const bf16x8 qg = *(const bf16x8*)(QGF + ((size_t)(mt * 2 + ks) * 64 + lane) * 8), qk = *(const bf16x8*)(QKF + ((size_t)(mt * 2 + ks) * 64 + lane) * 8);
#pragma unroll
            for (int vq = 0; vq < 4; ++vq) { o[mt][vq] = MFMA16(qg, sp[vq], o[mt][vq]); o[mt][vq] = MFMA16(qk, vn[vq], o[mt][vq]); }
        }
    }
    float nw[4];
#pragma unroll
    for (int vq = 0; vq < 4; ++vq) nw[vq] = p.gnw[16 * vq + l15];
#pragma unroll
    for (int mt = 0; mt < 4; ++mt)
#pragma unroll
        for (int r = 0; r < 4; ++r) {
            float ss = 0.f;
#pragma unroll
            for (int vq = 0; vq < 4; ++vq) ss += o[mt][vq][r] * o[mt][vq][r];
            ss += __shfl_xor(ss, 1); ss += __shfl_xor(ss, 2); ss += __shfl_xor(ss, 4); ss += __shfl_xor(ss, 8);
            const float rs = rsqrtf(ss * (1.f / 64.f) + NORM_EPS);
            const int t = t0 + 16 * mt + 4 * grp + r;
            const float* zr = p.BIGF + (size_t)t * PA + C_Z + h * 64;
#pragma unroll
            for (int vq = 0; vq < 4; ++vq) p.MIXB[(size_t)t * 1024 + 512 + h * 64 + 16 * vq + l15] = (bf16)f2bf(o[mt][vq][r] * rs * nw[vq] * siluf_(zr[16 * vq + l15]));
        }
}

__device__ __forceinline__ void ph_gdn_chunks(const KP& p, const Fr& F) {
    if (F.wave < 4) for (int unit = F.bid * 4 + F.wave; unit < 2048; unit += F.G * 4) gdn_chunk_unit(p, unit, F.lds, F.wave * GDN_WL, F.lane);
    else { const int unit = F.bid * 4 + (F.wave - 4); if (unit < 128) cmp_prompt_unit(p, unit, F.lane); }
}
__device__ __forceinline__ void ph_mix_a(const KP& p, const Fr& F) {
    if (F.bid < 32) gdn_scan_item(p, (F.bid + 1) * 8 + F.wave, (float*)(F.lds + 8 * FAST_WL + 1024 + F.wave * 512), F.lane);
    float* wl = (float*)(F.lds + F.wave * FAST_WL);
    for (int unit = F.gw; unit < 2048; unit += F.NGW) nsa_fast_unit(p, unit, wl, F.lane);
}
__device__ __forceinline__ void ph_mix_b(const KP& p, const Fr& F) {
    if (F.bid < 8) { if (F.wave < 4) gdn_chain(p, F.bid, F.wave, F.lane); return; }
    if (F.bid < 24) {
        const int it = (F.bid - 8) * 4 + (F.wave & 3);
        if (F.wave < 4) nsa_smp_cs(p, it >> 1, it & 1, (float*)(F.lds + F.wave * 20480), F.lane);
        else nsa_smp_win(p, it >> 1, it & 1, (float*)(F.lds + 81920 + (F.wave - 4) * 12288), F.lane);
        return;
    }
    const int g = F.bid & 1, fr = (F.bid - 24) >> 1, NW = ((F.G - 24) >> 1) * 8;
    for (int tq = fr * 8 + F.wave; tq < T; tq += NW) nsa_slc_item(p, tq, g, F.lane);
}

__device__ __forceinline__ void ph_gdn_out(const KP& p, const Fr& F) {
    const float* H0 = p.BIGF; const int lane = F.lane;
    for (int unit = F.gw; unit < 2048; unit += F.NGW) gdn_out_unit(p, unit, lane);
    for (int idx = F.bid * NTHR + F.tid; idx < NSMP * 512; idx += F.G * NTHR) { const int b = idx >> 9, c = idx & 511; const float* sp = p.SMIXF + (size_t)b * 3 * 512 + c;
        p.MIXB[(size_t)(T + b) * 1024 + c] = (bf16)f2bf(sp[0] + sp[512] + sp[1024]); }
    for (int item = T * 8 + F.gw; item < TS * 8; item += F.NGW) {
        const int r = item >> 3, h = item & 7;
        const float o = p.OG[((size_t)r * 8 + h) * 64 + lane];
        const float ms = wave_sum(o * o) * (1.f / 64.f);
        const float z = H0[(size_t)r * PA + C_Z + h * 64 + lane];
        p.MIXB[(size_t)r * 1024 + 512 + h * 64 + lane] = (bf16)f2bf(o * rsqrtf(ms + NORM_EPS) * p.gnw[lane] * siluf_(z));
    }
}

__device__ __forceinline__ void ph_ln(const Fr& F, const float* Xp, const float* Xs, const float* Fm, const float* gam, const float* bet, float* outp, float* outs, bf16* ob) {
    const int lane = F.lane;
    for (int r = F.gw; r < TS; r += F.NGW) {
        const float* xr = (r < T) ? Xp + (size_t)r * DM : Xs + (size_t)(r - T) * DM;
        float v[16]; float s = 0.f;
#pragma unroll
        for (int j = 0; j < 16; ++j) { const int c = lane + 64 * j; v[j] = DN_ALPHA * xr[c] + Fm[(size_t)r * DM + c]; s += v[j]; }
        const float mean = wave_sum(s) * (1.f / DM); float q = 0.f;
#pragma unroll
        for (int j = 0; j < 16; ++j) { v[j] -= mean; q += v[j] * v[j]; }
        const float rstd = rsqrtf(wave_sum(q) * (1.f / DM) + LN_EPS);
        float* o = (r < T) ? outp + (size_t)r * DM : outs + (size_t)(r - T) * DM;
#pragma unroll
        for (int j = 0; j < 16; ++j) { const int c = lane + 64 * j; const float y = v[j] * rstd * gam[c] + bet[c]; o[c] = y; if (ob) ob[(size_t)r * DM + c] = (bf16)f2bf(y); }
    }
}

__device__ __forceinline__ void ph_ffn_act(const KP& p, const Fr& F, int layer) {
    const float* U = p.BIGF; const float* cw = p.ffn_cw + (size_t)layer * 3 * DFF2; const float* cb = p.ffn_cb + (size_t)layer * DFF2;
    const size_t gt = (size_t)F.bid * NTHR + F.tid, GT = (size_t)F.G * NTHR;
    const size_t total = (size_t)TS * DFF;
    for (size_t idx = gt; idx < total; idx += GT) {
        const int r = (int)(idx / DFF), j = (int)(idx % DFF);
        const bool smp = r >= T; const int b = r - T;
        float c2[2];
#pragma unroll
        for (int half = 0; half < 2; ++half) {
            const int ch = half * DFF + j;
            float acc = cb[ch];
#pragma unroll
            for (int k = 0; k < 3; ++k) {
                float u;
                if (!smp) { const int t = r + k - 2; u = (t >= 0) ? U[(size_t)t * DFF2 + ch] : 0.f; }
                else u = (k < 2) ? p.st_ffn[(((size_t)b * 2 + layer) * 2 + k) * DFF2 + ch] : U[(size_t)r * DFF2 + ch];
                acc += cw[k * DFF2 + ch] * u;
            }
            c2[half] = acc;
        }
        p.HFFB[idx] = (bf16)f2bf(siluf_(c2[0]) * c2[1]);
    }
    for (size_t idx = gt; idx < (size_t)2 * DFF2; idx += GT) {
        const int k = (int)(idx / DFF2), ch = (int)(idx % DFF2);
        p.out[O_FFN_P + ((size_t)layer * 2 + k) * DFF2 + ch] = U[(size_t)(T - 2 + k) * DFF2 + ch];
    }
    for (size_t idx = gt; idx < (size_t)NSMP * 2 * DFF2; idx += GT) {
        const int b = (int)(idx / (2 * DFF2)), k = (int)((idx / DFF2) % 2), ch = (int)(idx % DFF2);
        p.out[O_FFN_S + (((size_t)b * 2 + layer) * 2 + k) * DFF2 + ch] =
            (k == 0) ? p.st_ffn[(((size_t)b * 2 + layer) * 2 + 1) * DFF2 + ch] : U[(size_t)(T + b) * DFF2 + ch];
    }
}

__device__ __forceinline__ void ph_dil_prep(const KP& p, const Fr& F) {
    const float* H1 = p.BIGF;
    const size_t gt = (size_t)F.bid * NTHR + F.tid, GT = (size_t)F.G * NTHR;
    const size_t total = (size_t)TS * 2048;
    for (size_t idx = gt + (size_t)T * 2048; idx < total; idx += GT) {
        const int r = (int)(idx >> 11), c = (int)(idx & 2047);
        const bool smp = r >= T; const int pos = smp ? T : r;
        const float* row = H1 + (size_t)r * 3072;
        const int i = c & 63; const float2 cs = p.ROPE[pos * 32 + (i & 31)];
        const float v = rope_val(row, c & ~63, i, cs);
        if (c < 1024) p.QD[(size_t)r * 1024 + c] = v; else p.KD[(size_t)r * 1024 + (c - 1024)] = v;
    }
}
__device__ __forceinline__ void ph_dil_cache(const KP& p, const Fr& F) {
    const float* H1 = p.BIGF;
    const size_t gt = (size_t)F.bid * NTHR + F.tid, GT = (size_t)F.G * NTHR;
    const size_t tots4 = (size_t)NSMP * 2048 * 512;
    for (size_t idx = gt; idx < tots4; idx += GT) {
        const int b = (int)(idx / (2048 * 512)); const int i = (int)((idx / 512) % 2048); const int c4 = (int)(idx % 512);
        float4 v;
        if (i < 2047) v = ((const float4*)p.st_dil)[((size_t)b * 2048 + i + 1) * 512 + c4];
        else { const int c = c4 * 4; const int r = T + b;
               v = (c < 1024) ? *(const float4*)(p.KD + (size_t)r * 1024 + c) : *(const float4*)(H1 + (size_t)r * 3072 + 2048 + (c - 1024)); }
        ((float4*)(p.out + O_DIL_S))[idx] = v;
    }
}
__device__ __forceinline__ void ph_dil_attn(const KP& p, const Fr& F) {
    const float* H1 = p.BIGF; const int lane = F.lane;
    float* qs = (float*)(F.lds + F.wave * 4096); float* sc = qs + 64;
    for (int item = T * 16 + F.gw; item < TS * 16; item += F.NGW) {
        const int r = item >> 4, h = item & 15;
        const bool smp = r >= T; const int b = r - T; const int qpos = smp ? T : r;
        qs[lane] = p.QD[(size_t)r * 1024 + h * 64 + lane];
        wave_lds_sync();
        auto kf = [&](int j, const float*& kp, const float*& vp) -> bool {
            const int gi = j / 129, m = j - gi * 129; const int dd = gi == 0 ? 1 : (gi == 1 ? 4 : 16);
            const int pos = qpos - m * dd; if (pos < 0) return false;
            if (!smp || pos == T) { const int rr = smp ? r : pos; kp = p.KD + (size_t)rr * 1024 + h * 64; vp = H1 + (size_t)rr * 3072 + 2048 + h * 64; return true; }
            const int bi = pos - (T - 2048);
            const float* base = p.st_dil + ((size_t)b * 2048 + bi) * 2048;
            kp = base + h * 64; vp = base + 1024 + h * 64; return true; };
        float o[1], den[1];
        wave_attend<1>(qs, sc, 448, 387, kf, o, den, lane);
        p.MIXB[(size_t)r * 1024 + h * 64 + lane] = (bf16)f2bf(o[0]);
        wave_lds_sync();
    }
}

__device__ __forceinline__ void ph_dil_prep_fast(const KP& p, const Fr& F) {
    const float* H1 = p.BIGF;
    const size_t gt = (size_t)F.bid * NTHR + F.tid, GT = (size_t)F.G * NTHR;
    for (size_t idx = gt; idx < (size_t)T * 256; idx += GT) {
        const int t = (int)(idx >> 8), u = (int)(idx & 255);
        const int c0 = u * 8; const float* row = H1 + (size_t)t * 3072;
        const float4 a0 = *(const float4*)(row + c0), a1 = *(const float4*)(row + c0 + 4);
        float v[8] = {a0.x, a0.y, a0.z, a0.w, a1.x, a1.y, a1.z, a1.w};
        const int d0 = c0 & 63; const int pc = (d0 < 32) ? c0 + 32 : c0 - 32;
        const float4 b0 = *(const float4*)(row + pc), b1 = *(const float4*)(row + pc + 4);
        const float w[8] = {b0.x, b0.y, b0.z, b0.w, b1.x, b1.y, b1.z, b1.w};
#pragma unroll
        for (int j = 0; j < 8; ++j) { const float2 cs = p.ROPE[t * 32 + ((d0 + j) & 31)];
            v[j] = (d0 < 32) ? (v[j] * cs.x - w[j] * cs.y) : (v[j] * cs.x + w[j] * cs.y); }
        if (u < 128) {
            v4u o; o.x = pk2(v[0] * QSCALE, v[1] * QSCALE); o.y = pk2(v[2] * QSCALE, v[3] * QSCALE); o.z = pk2(v[4] * QSCALE, v[5] * QSCALE); o.w = pk2(v[6] * QSCALE, v[7] * QSCALE);
            *(v4u*)(p.QDB + (size_t)t * 1024 + c0) = o;
        } else {
            const int kc = c0 - 1024, h = kc >> 6;
            v4u o; o.x = pk2(v[0], v[1]); o.y = pk2(v[2], v[3]); o.z = pk2(v[4], v[5]); o.w = pk2(v[6], v[7]);
#pragma unroll
            for (int pass = 0; pass < 3; ++pass) { const int sh = 2 * pass; const int pi = (t & ((1 << sh) - 1)) * (T >> sh) + (t >> sh);
                *(v4u*)(p.DKF[pass] + (size_t)h * T * 64 + kfrag_elem(pi, d0)) = o; }
            if (t >= T - 2048) { float* op = p.out + O_DIL_P + (size_t)(t - (T - 2048)) * 2048 + kc;
                *(float4*)op = make_float4(v[0], v[1], v[2], v[3]); *(float4*)(op + 4) = make_float4(v[4], v[5], v[6], v[7]); }
        }
    }
    for (size_t idx = gt; idx < (size_t)2048 * 256; idx += GT) {
        const int i = (int)(idx >> 8), c4 = (int)(idx & 255);
        *(float4*)(p.out + O_DIL_P + (size_t)i * 2048 + 1024 + c4 * 4) = *(const float4*)(H1 + (size_t)(T - 2048 + i) * 3072 + 2048 + c4 * 4);
    }
    const int lane = F.lane, l15 = lane & 15, grp = lane >> 4;
    for (int unit = F.gw; unit < 3 * 16 * 512; unit += F.NGW) {
        const int st = unit & 511, h = (unit >> 9) & 15, pass = unit >> 13; const int sh = 2 * pass, Td = T >> sh;
        const int pi0 = 32 * st, r = pi0 / Td, s0 = pi0 - r * Td;
        bf16* dst = p.DVF[pass] + (size_t)h * T * 64;
#pragma unroll
        for (int dt = 0; dt < 4; ++dt) {
            float v[8];
#pragma unroll
            for (int j = 0; j < 8; ++j) { const int s = s0 + 16 * (j >> 2) + 4 * grp + (j & 3); const int t = (s << sh) + r;
                v[j] = H1[(size_t)t * 3072 + 2048 + h * 64 + 16 * dt + l15]; }
            v4u o; o.x = pk2(v[0], v[1]); o.y = pk2(v[2], v[3]); o.z = pk2(v[4], v[5]); o.w = pk2(v[6], v[7]);
            *(v4u*)(dst + vfrag_off(st, dt, lane)) = o;
        }
    }
}

__device__ __forceinline__ void dil_unit(const KP& p, int unit, unsigned char* ldsb, int wave, int lane) {
    asm volatile("" : "+v"(lane));
    const int h = unit & 15, P0 = (unit >> 4) * 256;
    const int l15 = lane & 15, grp = lane >> 4;
    float* stO = (float*)ldsb; float* stML = stO + 256 * 64;
    for (int pass = 0; pass < 3; ++pass) {
        const int sh = 2 * pass, Td = T >> sh;
        const bf16* KF = p.DKF[pass] + (size_t)h * T * 64; const bf16* VF = p.DVF[pass] + (size_t)h * T * 64;
        for (int tt = 0; tt < 2; ++tt) {
            const int tl = 2 * wave + tt;
            const int r = tl >> (4 - sh), s0 = (P0 >> sh) + 16 * (tl & ((16 >> sh) - 1));
            const int sq = s0 + l15, tq = (sq << sh) + r, tloc = tq - P0;
            bf16x8 qf[2];
#pragma unroll
            for (int ks = 0; ks < 2; ++ks) qf[ks] = *(const bf16x8*)(p.QDB + (size_t)tq * 1024 + h * 64 + 32 * ks + 8 * grp);
            AttW a;
            if (pass == 0) attw_init(a);
            else {
#pragma unroll
                for (int dt = 0; dt < 4; ++dt) a.o[dt] = *(const f32x4*)(stO + tloc * 64 + 16 * dt + 4 * grp);
                a.m = stML[tloc * 2]; a.l = (grp == 0) ? stML[tloc * 2 + 1] : 0.f;
            }
            int kstart = s0 - 128; if (kstart < 0) kstart = 0; kstart &= ~31;
            const int nsteps = (s0 + 16 - kstart + 31) >> 5;
            const int base = r * Td;
            bf16x8 kf[2][2][2], vf[2][4];
            auto issue = [&](int s, int buf) {
                const int k0 = kstart + 32 * s;
#pragma unroll
                for (int tl2 = 0; tl2 < 2; ++tl2)
#pragma unroll
                    for (int ks = 0; ks < 2; ++ks) kf[buf][tl2][ks] = *(const bf16x8*)(KF + kfrag_off(((base + k0) >> 4) + tl2, ks, lane));
#pragma unroll
                for (int dt = 0; dt < 4; ++dt) vf[buf][dt] = *(const bf16x8*)(VF + vfrag_off((base + k0) >> 5, dt, lane));
            };
            issue(0, 0);
#pragma unroll
            for (int s = 0; s < 5; ++s) {
                if (s < nsteps) {
                    if (s + 1 < nsteps) issue(s + 1, (s + 1) & 1);
                    const int k0 = kstart + 32 * s;
                    f32x4 s0v, s1v; qk_step(kf[s & 1], qf, s0v, s1v);
                    if ((k0 + 31 > s0) || (k0 < s0 + 15 - 128)) {
                        const int pb = k0 + 4 * grp;
#pragma unroll
                        for (int i = 0; i < 4; ++i) { const int p0 = pb + i, p1 = pb + 16 + i;
                            if (p0 > sq || p0 < sq - 128) s0v[i] = -INFINITY; if (p1 > sq || p1 < sq - 128) s1v[i] = -INFINITY; }
                    }
                    att_update(a, s0v, s1v, vf[s & 1]);
                }
            }
            const float lt = grp_sum(a.l);
            if (pass < 2) {
#pragma unroll
                for (int dt = 0; dt < 4; ++dt) *(f32x4*)(stO + tloc * 64 + 16 * dt + 4 * grp) = a.o[dt];
                if (grp == 0) { stML[tloc * 2] = a.m; stML[tloc * 2 + 1] = lt; }
            } else {
                const float il = lt > 0.f ? 1.f / lt : 0.f;
#pragma unroll
                for (int dt = 0; dt < 4; ++dt) { uint2 o; o.x = pk2(a.o[dt][0] * il, a.o[dt][1] * il); o.y = pk2(a.o[dt][2] * il, a.o[dt][3] * il);
                    *(uint2*)(p.MIXB + (size_t)tq * 1024 + h * 64 + 16 * dt + 4 * grp) = o; }
            }
        }
        __syncthreads();
    }
}
__device__ __forceinline__ void ph_dil_attn_fast(const KP& p, const Fr& F) {
    for (int unit = F.bid; unit < 64 * 16; unit += F.G) dil_unit(p, unit, F.lds, F.wave, F.lane);
}

constexpr int NPHASE = 22;
__global__ void __launch_bounds__(NTHR, 2) mega(KP p) {
    extern __shared__ __attribute__((aligned(16))) unsigned char lds[];
    Fr F; F.lds = lds; F.tid = threadIdx.x; F.lane = 0; F.wave = __builtin_amdgcn_readfirstlane(F.tid >> 6);
    F.bid = blockIdx.x; F.G = gridDim.x; F.gw = F.bid * NWAVES + F.wave; F.NGW = F.G * NWAVES;
    for (int u = F.tid; u < (LDS_BYTES - RING_BYTES) / 4; u += NTHR) ((unsigned*)(lds + RING_BYTES))[u] = 0u;
    __syncthreads();
    XcdBarrier bar; bar.bar = p.ctl + 4096; bar.x = 0; bar.st = nullptr;
    if (!MK_PER_PHASE) bar = xcd_barrier_post(p.ctl + 4096, (volatile LAS unsigned*)(lds + MISC_OFF + 32));
    const int lo = p.ph_lo, hi = p.ph_hi;
#define IN(k) (lo <= (k) && (k) < hi)

    int ph = 0;
#if PROBE_ON
#define PROBE_STAMP(k) do { if (blockIdx.x == 0 && threadIdx.x == 0) ((unsigned long long*)(p.ctl + 65536))[k] = __builtin_amdgcn_s_memrealtime(); } while (0)
#define PROBE_STAMPB(k, blk) do { if (blockIdx.x == (blk) && threadIdx.x == 0) ((unsigned long long*)(p.ctl + 65536))[k] = __builtin_amdgcn_s_memrealtime(); } while (0)
    PROBE_STAMP(0);
#else
#define PROBE_STAMP(k) do { } while (0)
#define PROBE_STAMPB(k, blk) do { } while (0)
#endif
#define PHASE(...) do { { unsigned t_ = threadIdx.x; asm volatile("" : "+v"(t_)); F.lane = (int)(t_ & 63u); } if (IN(ph)) { __VA_ARGS__ } if (IN(ph) && IN(ph + 1)) xcd_barrier(bar); ++ph; PROBE_STAMP(ph); } while (0)
    PHASE(ph_prologue(p, F););
    PHASE(ph_gemm_f32(F, p.ACTB, p.WT_A, PAP, DM, p.BIGF, PA, PA); ph_cmp_gemm(p, F););
    PHASE(ph_nsa_prep(p, F); ph_nsa_prep_fast(p, F); ph_gdn_prep(p, F); ph_cmp_stage2(p, F););
    PHASE(ph_gdn_chunks(p, F););
    PHASE(ph_mix_a(p, F););
    PHASE(ph_mix_b(p, F););
    PHASE(ph_gdn_out(p, F););
    PHASE(ph_gemm_f32(F, p.MIXB, p.WT_OA, DM, DM, p.MO, DM, DM););
    PHASE(ph_ln(F, p.x_prompt, p.x_sample, p.MO, p.ln_mix_g, p.ln_mix_b, p.X1, p.X1 + (size_t)T * DM, p.ACTB););
    PHASE(ph_ffn_gemm(p, F, p.WT_FI0, 0););
    PHASE(ph_ffn_fix(p, F, 0););
    PHASE(ph_gemm_f32(F, p.HFFB, p.WT_FO0, DM, DFF, p.MO, DM, DM););
    PHASE(ph_ln(F, p.X1, p.X1 + (size_t)T * DM, p.MO, p.ln_ffn_g, p.ln_ffn_b, p.X2, p.X2 + (size_t)T * DM, p.ACTB););
    PHASE(ph_gemm_f32(F, p.ACTB, p.WT_CI, 3072, DM, p.BIGF, 3072, 3072););
    PHASE(ph_dil_prep(p, F); ph_dil_prep_fast(p, F););
    PHASE(ph_dil_cache(p, F); ph_dil_attn(p, F); __syncthreads(); ph_dil_attn_fast(p, F););
    PHASE(ph_gemm_f32(F, p.MIXB, p.WT_CO, DM, DM, p.MO, DM, DM););
    PHASE(ph_ln(F, p.X2, p.X2 + (size_t)T * DM, p.MO, p.ln_mix_g + DM, p.ln_mix_b + DM, p.X3, p.X3 + (size_t)T * DM, p.ACTB););
    PHASE(ph_ffn_gemm(p, F, p.WT_FI1, 1););
    PHASE(ph_ffn_fix(p, F, 1););
    PHASE(ph_gemm_f32(F, p.HFFB, p.WT_FO1, DM, DFF, p.MO, DM, DM););
    PHASE(ph_ln(F, p.X3, p.X3 + (size_t)T * DM, p.MO, p.ln_ffn_g + DM, p.ln_ffn_b + DM, p.out + O_Y_P, p.out + O_Y_S, nullptr););
#undef PHASE
#if PROBE_ON
    xcd_barrier(bar);
    if (blockIdx.x == 0) { __syncthreads(); const unsigned long long* pts = (const unsigned long long*)(p.ctl + 65536); const float x = (float)(pts[PROBE_B] - pts[PROBE_A]) * 1e-5f;
        for (int i = threadIdx.x; i < NSMP * DM; i += NTHR) p.out[O_Y_S + i] *= (1.f + x); }
#endif
#undef IN
}

static inline size_t align_up(size_t x) { return (x + 255) & ~(size_t)255; }

extern "C" void kernel_launch(void* const* d_in, const int* in_sizes, int n_in, void* d_out, int out_size, void* d_ws, size_t ws_size, hipStream_t stream) {
    static int grid = 0;
    if (grid == 0) {
        int dev = 0, cus = 0, per_cu = 0;
        if (hipGetDevice(&dev) != hipSuccess || hipDeviceGetAttribute(&cus, hipDeviceAttributeMultiprocessorCount, dev) != hipSuccess) { fprintf(stderr, "kernel_launch: device query failed\n"); grid = -1; return; }
        if (hipFuncSetAttribute((const void*)mega, hipFuncAttributeMaxDynamicSharedMemorySize, LDS_BYTES) != hipSuccess) { fprintf(stderr, "kernel_launch: hipFuncSetAttribute failed\n"); grid = -1; return; }
        if (hipOccupancyMaxActiveBlocksPerMultiprocessor(&per_cu, (const void*)mega, NTHR, LDS_BYTES) != hipSuccess || per_cu < 1) { fprintf(stderr, "kernel_launch: occupancy query says %d blocks per CU\n", per_cu); }
        (void)hipGetLastError();
        grid = cus;
    }
    if (grid < 0) return;
    if ((size_t)out_size != O_END) fprintf(stderr, "kernel_launch: out_size %d != expected %zu\n", out_size, (size_t)O_END);
    KP p{};
    p.x_prompt = (const float*)d_in[0]; p.x_sample = (const float*)d_in[1]; p.cache_cmp = (const float*)d_in[2]; p.cache_slc = (const float*)d_in[3];
    p.st_win = (const float*)d_in[4]; p.st_gconv = (const float*)d_in[5]; p.st_gS = (const float*)d_in[6]; p.st_dil = (const float*)d_in[7];
    p.st_ffn = (const float*)d_in[8]; p.page_table = (const int*)d_in[9]; p.w_in_a = (const float*)d_in[10]; p.cw1 = (const float*)d_in[11];
    p.cb1 = (const float*)d_in[12]; p.cw2 = (const float*)d_in[13]; p.cpe = (const float*)d_in[14]; p.gconv_w = (const float*)d_in[15];
    p.gA = (const float*)d_in[16]; p.gdt = (const float*)d_in[17]; p.gnw = (const float*)d_in[18]; p.w_out_a = (const float*)d_in[19];
    p.w_in_c = (const float*)d_in[20]; p.w_out_c = (const float*)d_in[21]; p.ln_mix_g = (const float*)d_in[22]; p.ln_mix_b = (const float*)d_in[23];
    p.ffn_w_in = (const float*)d_in[24]; p.ffn_cw = (const float*)d_in[25]; p.ffn_cb = (const float*)d_in[26]; p.ffn_w_out = (const float*)d_in[27];
    p.ln_ffn_g = (const float*)d_in[28]; p.ln_ffn_b = (const float*)d_in[29];
    p.out = (float*)d_out;
    char* ws = (char*)d_ws; size_t off = 0;
    auto alloc = [&](size_t bytes) { void* q = (void*)(ws + off); off = align_up(off + bytes); return q; };
    p.ctl = (unsigned*)alloc(1 << 20);
    p.WT_A = (bf16*)alloc((size_t)PAP * DM * 2); p.WT_OA = (bf16*)alloc((size_t)DM * DM * 2);
    p.WT_FI0 = (bf16*)alloc((size_t)DFF2 * DM * 2); p.WT_FI1 = (bf16*)alloc((size_t)DFF2 * DM * 2);
    p.WT_FO0 = (bf16*)alloc((size_t)DM * DFF * 2); p.WT_FO1 = (bf16*)alloc((size_t)DM * DFF * 2);
    p.WT_CI = (bf16*)alloc((size_t)3072 * DM * 2); p.WT_CO = (bf16*)alloc((size_t)DM * DM * 2);
    p.ROPE = (float2*)alloc((size_t)(T + 1) * 32 * 8);
    p.ACTB = (bf16*)alloc((size_t)TSP * DM * 2); p.MIXB = (bf16*)alloc((size_t)TSP * DM * 2); p.HFFB = (bf16*)alloc((size_t)TSP * DFF * 2);
    p.QB = (bf16*)alloc((size_t)T * 512 * 2); p.KSF = (bf16*)alloc((size_t)2 * T * 64 * 2); p.VSF = (bf16*)alloc((size_t)2 * T * 64 * 2);
    p.KWF = (bf16*)alloc((size_t)2 * T * 64 * 2); p.VWF = (bf16*)alloc((size_t)2 * T * 64 * 2); p.CKF = (bf16*)alloc((size_t)2 * 512 * 64 * 2); p.CVF = (bf16*)alloc((size_t)2 * 512 * 64 * 2);
    p.ACP = (bf16*)alloc((size_t)2048 * 2048 * 2);
    p.W2T = (bf16*)alloc((size_t)2 * 64 * 128 * 2);
    p.AC = (bf16*)alloc((size_t)65536 * 2048 * 2); p.WT_C = (bf16*)alloc((size_t)256 * 2048 * 2); p.HID = (bf16*)alloc((size_t)65536 * 128 * 2); p.SMIXF = (float*)alloc((size_t)NSMP * 3 * 512 * 4);
    p.UB = (float*)alloc((size_t)256 * 4 * DFF2 * 4);
    p.NSACC = (float*)alloc((size_t)T * 512 * 4); p.SEL = (int*)alloc((size_t)2 * T * 16 * 4);
    p.QDB = (bf16*)alloc((size_t)T * 1024 * 2);
    for (int i = 0; i < 3; ++i) { p.DKF[i] = (bf16*)alloc((size_t)T * 1024 * 2); p.DVF[i] = (bf16*)alloc((size_t)T * 1024 * 2); }
    p.G_WF = (bf16*)alloc((size_t)2048 * 4096 * 2); p.G_KDF = (bf16*)alloc((size_t)2048 * 4096 * 2); p.G_QGF = (bf16*)alloc((size_t)2048 * 4096 * 2); p.G_QKF = (bf16*)alloc((size_t)2048 * 4096 * 2);
    p.G_SPF = (bf16*)alloc((size_t)2048 * 4096 * 2); p.G_VNF = (bf16*)alloc((size_t)2048 * 4096 * 2); p.G_UF = (float*)alloc((size_t)2048 * 4096 * 4); p.G_GL = (float*)alloc((size_t)2048 * 4);
    p.BIGF = (float*)alloc((size_t)TSP * DFF2 * 4); p.MO = (float*)alloc((size_t)TSP * DM * 4);
    p.X1 = (float*)alloc((size_t)TS * DM * 4); p.X2 = (float*)alloc((size_t)TS * DM * 4); p.X3 = (float*)alloc((size_t)TS * DM * 4);
    p.QR = (float*)alloc((size_t)TS * 512 * 4);
    p.KS = (float*)alloc((size_t)TS * 128 * 4); p.VS = (float*)alloc((size_t)TS * 128 * 4); p.KW = (float*)alloc((size_t)TS * 128 * 4); p.VW = (float*)alloc((size_t)TS * 128 * 4);
    p.CK = (float*)alloc((size_t)33 * 512 * 128 * 4); p.CV = (float*)alloc((size_t)33 * 512 * 128 * 4);
    p.GQ = (float*)alloc((size_t)TS * 512 * 4); p.GK = (float*)alloc((size_t)TS * 512 * 4); p.GV = (float*)alloc((size_t)TS * 512 * 4); p.OG = (float*)alloc((size_t)TS * 512 * 4);
    p.Gg = (float*)alloc((size_t)TS * 8 * 4); p.Gb = (float*)alloc((size_t)TS * 8 * 4);
    p.QD = (float*)alloc((size_t)TS * DM * 4); p.KD = (float*)alloc((size_t)TS * DM * 4);
    if (off > ws_size) { fprintf(stderr, "kernel_launch: workspace too small: need %zu have %zu\n", off, ws_size); return; }
    if (hipMemsetAsync(p.ctl, 0, 1 << 20, stream) != hipSuccess) { fprintf(stderr, "kernel_launch: memset failed\n"); return; }
#if MK_PER_PHASE
    for (int k = 0; k < NPHASE; ++k) { p.ph_lo = k; p.ph_hi = k + 1; hipLaunchKernelGGL(mega, dim3(grid), dim3(NTHR), LDS_BYTES, stream, p); }
#else
    p.ph_lo = 0; p.ph_hi = NPHASE;
    hipLaunchKernelGGL(mega, dim3(grid), dim3(NTHR), LDS_BYTES, stream, p);
#endif
    const hipError_t le = hipPeekAtLastError();
    if (le != hipSuccess) fprintf(stderr, "kernel_launch: launch failed: %s\n", hipGetErrorName(le));
}
```

```cpp
#include <hip/hip_runtime.h>
#include <cstdint>
#include <cstdio>
#include <cmath>

namespace pg8 {
#define PG8_LAS __attribute__((address_space(3)))
typedef unsigned short bf16_t;
typedef short bf16x8 __attribute__((ext_vector_type(8)));
typedef float f32x4 __attribute__((ext_vector_type(4)));
typedef unsigned u32x4 __attribute__((ext_vector_type(4)));
constexpr int BM = 256, BK = 64, HALF = 128, HTB = HALF * BK * 2  , STAGE_BYTES = 8 * HTB, NXCD = 8, WGM = 8;

__host__ __device__ __forceinline__ int lds_byte(int r, int c) { const int st = (r >> 4) * 2 + (c >> 5), rr = r & 15, cc = c & 31, ob = rr * 64 + cc * 2; return st * 1024 + (ob ^ (((ob >> 9) & 1) << 5)); }
__host__ __device__ __forceinline__ void stage_rc(int b, int& R, int& C) { const int st = b / 1024, sb = b % 1024, swz = sb ^ (((sb >> 9) & 1) << 5); R = (st >> 1) * 16 + swz / 64; C = (st & 1) * 32 + (swz % 64) / 2; }
__host__ __device__ __forceinline__ int perm32(int rho) { const int n = rho >> 4, i = rho & 15; return 8 * (i >> 2) + 4 * n + (i & 3); }

struct Unit { int pm, pn; };
struct Gemm { const bf16_t* A; const bf16_t* Bt; int M, N, K; };

struct StaticOrder {
    int nM, nN, nwg, G, c;
    __host__ __device__ void init(int M, int N, int G_, int c_) { nM = M / BM; nN = N / BM; nwg = nM * nN; G = G_; c = c_; }
    __host__ __device__ bool next(int i, Unit& u) const {
        const long L = (long)i * G + c; if (L >= nwg) return false;
        int wgid = (int)L; { const int q = nwg / NXCD, r = nwg % NXCD, xcd = wgid % NXCD, off = wgid / NXCD; wgid = (xcd < r ? xcd * (q + 1) : r * (q + 1) + (xcd - r) * q) + off; }
        const int nig = WGM * nN, gid = wgid / nig, fm = gid * WGM, gsz = (nM - fm) < WGM ? (nM - fm) : WGM;
        u.pm = fm + ((wgid % nig) % gsz); u.pn = (wgid % nig) / gsz; return true;
    }
    __device__ __forceinline__ void a_ready(const Unit&) const {}
    __device__ __forceinline__ void done(const Unit&) const {}
};

typedef __bf16 bf16x2_t __attribute__((ext_vector_type(2)));
typedef float f32x2_t __attribute__((ext_vector_type(2)));
__device__ __forceinline__ unsigned cvt_pk_bf16(float lo, float hi) { const f32x2_t v = {lo, hi}; return __builtin_bit_cast(unsigned, __builtin_convertvector(v, bf16x2_t)); }
typedef float f32x2 __attribute__((ext_vector_type(2)));
__device__ __forceinline__ f32x2 gelu_pk(f32x2 v) {
    const f32x2 av = __builtin_elementwise_abs(v), d = av * 0.2316418882f + 1.0f;
    f32x2 t; t.x = __builtin_amdgcn_rcpf(d.x); t.y = __builtin_amdgcn_rcpf(d.y);
    f32x2 q = t * 0.5307027145f + (-0.7265760135f); q = q * t + 0.7107068705f; q = q * t + (-0.142248368f); q = q * t + 0.127414796f; q = q * t;
    const f32x2 s = (v * v) * (-0.72134752044f);
    f32x2 e; e.x = __builtin_amdgcn_exp2f(s.x); e.y = __builtin_amdgcn_exp2f(s.y);
    const f32x2 m = v * (q * e), r = v - m;
    f32x2 o; o.x = v.x < 0.f ? m.x : r.x; o.y = v.y < 0.f ? m.y : r.y; return o;
}

template <int ACT  > struct EpiBf16 {
    static constexpr bool PERM = true, AFTER_DRAIN = false; static_assert(ACT == 0 || ACT == 1, "EpiBf16: ACT is 0 (none) or 1 (gelu_pk)");
    bf16_t* O; int ldc; const float* bias; int split_cols; size_t split_stride; float scale0;
    __device__ __forceinline__ void operator()(const f32x4 (&acc)[2][2][4][2], const Unit& u, int wr, int wc, int fr, int fq) const {
        const int row0 = u.pm * BM + wr * 64 + fr; int colt = u.pn * BM; bf16_t* base = O;
        float sc = 1.f; if (split_cols) { const int t = colt / split_cols; base += (size_t)t * split_stride; colt -= t * split_cols; if (t == 0) sc = scale0; }
        const int col0 = colt + wc * 32 + 8 * fq, bcol0 = u.pn * BM + wc * 32 + 8 * fq;
        f32x4 bv[2][2];
#pragma unroll
        for (int bj = 0; bj < 2; ++bj)
#pragma unroll
            for (int n = 0; n < 2; ++n) bv[bj][n] = bias ? *(const f32x4*)(bias + bcol0 + bj * HALF + 4 * n) : (f32x4){0.f, 0.f, 0.f, 0.f};
#pragma unroll
        for (int ai = 0; ai < 2; ++ai)
#pragma unroll
            for (int m = 0; m < 4; ++m) { bf16_t* rowp = base + (size_t)(row0 + ai * HALF + m * 16) * ldc + col0;
#pragma unroll
                for (int bj = 0; bj < 2; ++bj) { f32x4 v0 = acc[ai][bj][m][0] + bv[bj][0], v1 = acc[ai][bj][m][1] + bv[bj][1];
                    if (ACT == 1) { f32x2 a = gelu_pk((f32x2){v0[0], v0[1]}), b = gelu_pk((f32x2){v0[2], v0[3]}), c = gelu_pk((f32x2){v1[0], v1[1]}), d = gelu_pk((f32x2){v1[2], v1[3]});
                        v0 = (f32x4){a.x, a.y, b.x, b.y}; v1 = (f32x4){c.x, c.y, d.x, d.y}; }
                    v0 = v0 * sc; v1 = v1 * sc; u32x4 w; w.x = cvt_pk_bf16(v0[0], v0[1]); w.y = cvt_pk_bf16(v0[2], v0[3]); w.z = cvt_pk_bf16(v1[0], v1[1]); w.w = cvt_pk_bf16(v1[2], v1[3]);
                    *(u32x4*)(rowp + bj * HALF) = w; } }
    }
};

struct EpiF32 {
    static constexpr bool PERM = false, AFTER_DRAIN = false;
    float* O; int ldc; int ncols;
    __device__ __forceinline__ void operator()(const f32x4 (&acc)[2][2][4][2], const Unit& u, int wr, int wc, int fr, int fq) const {
        const int row0 = u.pm * BM + wr * 64 + fr; const int col0 = u.pn * BM + wc * 32 + 4 * fq;
#pragma unroll
        for (int ai = 0; ai < 2; ++ai)
#pragma unroll
            for (int m = 0; m < 4; ++m) { float* rowp = O + (size_t)(row0 + ai * HALF + m * 16) * ldc;
#pragma unroll
                for (int bj = 0; bj < 2; ++bj)
#pragma unroll
                    for (int n = 0; n < 2; ++n) { const int c = col0 + bj * HALF + n * 16; if (c < ncols) *(f32x4*)(rowp + c) = acc[ai][bj][m][n]; } }
    }
};
template <class Epi, class Sched, bool ALIGN_EPI = false, bool SP2 = false>
__device__ __forceinline__ void gemm_phase(PG8_LAS unsigned char* lds, const Gemm g, const Sched& S, const Epi& E) {
    const int tid = threadIdx.x, wid = __builtin_amdgcn_readfirstlane(tid >> 6), lane = tid & 63, wr = wid >> 2, wc = wid & 3, fr = lane & 15, fq = lane >> 4;
    const int K = g.K, nt = K / BK;
    unsigned voffA[2], voffB[2];
#pragma unroll
    for (int i = 0; i < 2; ++i) { int R, C; stage_rc(tid * 16 + i * 8192, R, C); const int Rb = Epi::PERM ? ((R & ~31) + perm32(R & 31)) : R;
        voffA[i] = (unsigned)(R * K + C) * 2u; voffB[i] = (unsigned)(Rb * K + C) * 2u; }
    const size_t kstep = (size_t)(BK * 2);
    const size_t hstep = (size_t)HALF * K * 2;
    const size_t tstep = 2 * hstep;
    const unsigned ldsw = (unsigned)wid * 1024u;
    const int aoff = lds_byte(wr * 64 + fr, fq * 8), boff = lds_byte(wc * 32 + fr, fq * 8);
#define PG8_SA(b, h) (((b) * 2 + (h)) * HTB)
#define PG8_SB(b, h) ((4 + (b) * 2 + (h)) * HTB)
#define PG8_STAGE(bufoff, gbase, voff) do { _Pragma("unroll") for (int _i = 0; _i < 2; ++_i) \
        __builtin_amdgcn_global_load_lds((const unsigned*)((const char*)(gbase) + (voff)[_i]), (PG8_LAS unsigned*)(lds + (bufoff) + ldsw + _i * 8192), 16, 0, 0); } while (0)
#define PG8_LDA(dst, b, h) do { _Pragma("unroll") for (int m = 0; m < 4; ++m) _Pragma("unroll") for (int k = 0; k < 2; ++k) dst[m][k] = *(const PG8_LAS bf16x8*)(lds + PG8_SA(b, h) + aoff + m * 2048 + k * 1024); } while (0)
#define PG8_LDB(dst, b, h) do { _Pragma("unroll") for (int n = 0; n < 2; ++n) _Pragma("unroll") for (int k = 0; k < 2; ++k) dst[n][k] = *(const PG8_LAS bf16x8*)(lds + PG8_SB(b, h) + boff + n * 2048 + k * 1024); } while (0)
#define PG8_MMA(ai, bj, At, Bt) do { __builtin_amdgcn_s_setprio(1); _Pragma("unroll") for (int m = 0; m < 4; ++m) _Pragma("unroll") for (int n = 0; n < 2; ++n) _Pragma("unroll") for (int k = 0; k < 2; ++k) \
        acc[ai][bj][m][n] = __builtin_amdgcn_mfma_f32_16x16x32_bf16(Bt[n][k], At[m][k], acc[ai][bj][m][n], 0, 0, 0); __builtin_amdgcn_s_setprio(0); } while (0)
#define PG8_WAIT_V(n) asm volatile("s_waitcnt vmcnt(" #n ")" ::: "memory")
#define PG8_WAIT_L(n) asm volatile("s_waitcnt lgkmcnt(" #n ")" ::: "memory")
#define PG8_BAR __builtin_amdgcn_s_barrier()
#define PG8_SCHED __builtin_amdgcn_sched_barrier(0)
    Unit cur, nxt; int ui = 0;
    if (!S.next(0, cur)) return;
    f32x4 acc[2][2][4][2];
#pragma unroll
    for (int a = 0; a < 2; ++a)
#pragma unroll
        for (int b = 0; b < 2; ++b)
#pragma unroll
            for (int m = 0; m < 4; ++m)
#pragma unroll
                for (int n = 0; n < 2; ++n) acc[a][b][m][n] = (f32x4){0.f, 0.f, 0.f, 0.f};
    bf16x8 At[4][2], B0[2][2], B1[2][2];
    const char* cA = (const char*)g.A + (size_t)cur.pm * tstep; const char* cB = (const char*)g.Bt + (size_t)cur.pn * tstep;
    S.a_ready(cur);
    if constexpr (SP2) {
        PG8_STAGE(PG8_SB(0, 0), cB, voffB); PG8_STAGE(PG8_SB(0, 1), cB + hstep, voffB); PG8_STAGE(PG8_SA(0, 0), cA, voffA); PG8_STAGE(PG8_SA(0, 1), cA + hstep, voffA);
        if (wr == 1) PG8_BAR;
        PG8_WAIT_V(2); PG8_BAR;
        PG8_STAGE(PG8_SB(1, 0), cB + kstep, voffB); PG8_STAGE(PG8_SA(1, 0), cA + kstep, voffA); PG8_STAGE(PG8_SB(1, 1), cB + hstep + kstep, voffB);
        PG8_WAIT_V(6); PG8_BAR;
    } else {
        PG8_STAGE(PG8_SB(0, 0), cB, voffB); PG8_STAGE(PG8_SA(0, 0), cA, voffA); PG8_STAGE(PG8_SB(0, 1), cB + hstep, voffB); PG8_STAGE(PG8_SA(0, 1), cA + hstep, voffA);
        if (wr == 1) PG8_BAR;
        PG8_WAIT_V(4); PG8_BAR;
        PG8_STAGE(PG8_SB(1, 0), cB + kstep, voffB); PG8_STAGE(PG8_SA(1, 0), cA + kstep, voffA); PG8_STAGE(PG8_SB(1, 1), cB + hstep + kstep, voffB);
        PG8_WAIT_V(6); PG8_BAR;
    }
    for (;;) {
        const bool has_next = S.next(ui + 1, nxt);
        const char* nA = has_next ? (const char*)g.A + (size_t)nxt.pm * tstep : cA; const char* nB = has_next ? (const char*)g.Bt + (size_t)nxt.pn * tstep : cB;
        for (int t = 0; t < nt; t += 2) {
            const bool last = (t == nt - 2);
            const char* a1 = cA + (size_t)(t + 1) * kstep;
            const char* a2 = last ? nA : cA + (size_t)(t + 2) * kstep; const char* b2 = last ? nB : cB + (size_t)(t + 2) * kstep;
            const char* a3 = a2 + kstep; const char* b3 = b2 + kstep;
            if (last && has_next) S.a_ready(nxt);
            if constexpr (SP2) {
            PG8_LDB(B0, 0, 0); PG8_LDB(B1, 0, 1); PG8_SCHED; PG8_LDA(At, 0, 0); PG8_STAGE(PG8_SA(1, 1), a1 + hstep, voffA);
            PG8_WAIT_V(8); PG8_WAIT_L(0); PG8_BAR; PG8_MMA(0, 0, At, B0); PG8_MMA(0, 1, At, B1); PG8_BAR; PG8_SCHED;
            PG8_LDA(At, 0, 1); PG8_STAGE(PG8_SB(0, 0), b2, voffB); PG8_STAGE(PG8_SB(0, 1), b2 + hstep, voffB); PG8_STAGE(PG8_SA(0, 0), a2, voffA);
            PG8_WAIT_V(8); PG8_WAIT_L(0); PG8_BAR; PG8_MMA(1, 0, At, B0); PG8_MMA(1, 1, At, B1); PG8_BAR; PG8_SCHED;
            PG8_LDB(B0, 1, 0); PG8_LDB(B1, 1, 1); PG8_SCHED; PG8_LDA(At, 1, 0); PG8_STAGE(PG8_SA(0, 1), a2 + hstep, voffA);
            PG8_WAIT_V(8); PG8_WAIT_L(0); PG8_BAR; PG8_MMA(0, 0, At, B0); PG8_MMA(0, 1, At, B1); PG8_BAR; PG8_SCHED;
            PG8_LDA(At, 1, 1); PG8_STAGE(PG8_SB(1, 0), b3, voffB); PG8_STAGE(PG8_SB(1, 1), b3 + hstep, voffB); PG8_STAGE(PG8_SA(1, 0), a3, voffA);
            PG8_WAIT_V(8); PG8_WAIT_L(0); PG8_BAR; PG8_MMA(1, 0, At, B0); PG8_MMA(1, 1, At, B1); PG8_BAR; PG8_SCHED;
            } else {
            PG8_LDB(B0, 0, 0); PG8_SCHED; PG8_LDA(At, 0, 0); PG8_STAGE(PG8_SA(1, 1), a1 + hstep, voffA);
            PG8_WAIT_L(8); PG8_BAR; PG8_WAIT_L(0); PG8_MMA(0, 0, At, B0); PG8_BAR; PG8_SCHED;
            PG8_LDB(B1, 0, 1); PG8_STAGE(PG8_SB(0, 0), b2, voffB);
            PG8_BAR; PG8_WAIT_L(0); PG8_MMA(0, 1, At, B1); PG8_BAR;
            PG8_LDA(At, 0, 1); PG8_STAGE(PG8_SA(0, 0), a2, voffA);
            PG8_BAR; PG8_WAIT_L(0); PG8_MMA(1, 0, At, B0); PG8_BAR; PG8_SCHED;
            PG8_STAGE(PG8_SB(0, 1), b2 + hstep, voffB);
            PG8_WAIT_V(6); PG8_BAR; PG8_MMA(1, 1, At, B1); PG8_BAR;
            PG8_LDB(B0, 1, 0); PG8_SCHED; PG8_LDA(At, 1, 0); PG8_STAGE(PG8_SA(0, 1), a2 + hstep, voffA);
            PG8_WAIT_L(8); PG8_BAR; PG8_WAIT_L(0); PG8_MMA(0, 0, At, B0); PG8_BAR; PG8_SCHED;
            PG8_LDB(B1, 1, 1); PG8_STAGE(PG8_SB(1, 0), b3, voffB);
            PG8_BAR; PG8_WAIT_L(0); PG8_MMA(0, 1, At, B1); PG8_BAR;
            PG8_LDA(At, 1, 1); PG8_STAGE(PG8_SA(1, 0), a3, voffA);
            PG8_BAR; PG8_WAIT_L(0); PG8_MMA(1, 0, At, B0); PG8_BAR; PG8_SCHED;
            PG8_STAGE(PG8_SB(1, 1), b3 + hstep, voffB);
            PG8_WAIT_V(6); PG8_BAR; PG8_MMA(1, 1, At, B1); PG8_BAR;
            }
        }
        if constexpr (ALIGN_EPI) { if (wr == 0) PG8_BAR; }
        if constexpr (!Epi::AFTER_DRAIN) { E(acc, cur, wr, wc, fr, fq); S.done(cur); }
        if (!has_next) break;
#pragma unroll
        for (int a = 0; a < 2; ++a)
#pragma unroll
            for (int b = 0; b < 2; ++b)
#pragma unroll
                for (int m = 0; m < 4; ++m)
#pragma unroll
                    for (int n = 0; n < 2; ++n) acc[a][b][m][n] = (f32x4){0.f, 0.f, 0.f, 0.f};
        cur = nxt; cA = nA; cB = nB; ++ui;
        if constexpr (ALIGN_EPI) { if (wr == 1) PG8_BAR; }
    }
    PG8_WAIT_V(0);
    if constexpr (!ALIGN_EPI) { if (wr == 0) PG8_BAR; }
    PG8_BAR;
    if constexpr (Epi::AFTER_DRAIN) { E.fused(acc, cur, wr, wc, fr, fq, lds, wid, lane); S.done(cur); }
#undef PG8_SA
#undef PG8_SB
#undef PG8_STAGE
#undef PG8_LDA
#undef PG8_LDB
#undef PG8_MMA
#undef PG8_WAIT_V
#undef PG8_WAIT_L
#undef PG8_BAR
#undef PG8_SCHED
}
}

#define LAS __attribute__((address_space(3)))
#define XB_TMO      128
#define XB_XCNT(j)  (256  + 64 * (j))
#define XB_XSUB(j)  (1280 + 64 * (j))
#define XB_XGEN(j)  (2304 + 64 * (j))
#define XB_TOP      3328
#define XB_TOPGEN   3392
#define XCD_BAR_WORDS 3456
#define XB_SPIN_CAP (1u << 26)

__device__ __forceinline__ unsigned xb_ld(unsigned* p)              { return __hip_atomic_load(p, __ATOMIC_RELAXED, __HIP_MEMORY_SCOPE_AGENT); }
__device__ __forceinline__ unsigned xb_add(unsigned* p, unsigned v) { return __hip_atomic_fetch_add(p, v, __ATOMIC_RELAXED, __HIP_MEMORY_SCOPE_AGENT); }
__device__ __forceinline__ unsigned xb_xcc_id() { return (unsigned)__builtin_amdgcn_s_getreg((3 << 11) | 20) & 0xFu; }
#define XB_SPIN(cond, bar) do { unsigned _sp = 0; while (cond) { __builtin_amdgcn_s_sleep(1); \
    if ((++_sp & 255u) == 0u) { if (xb_ld(&(bar)[XB_TMO])) break; if (_sp > XB_SPIN_CAP) { atomicAdd(&(bar)[XB_TMO], 1u); break; } } } } while (0)

struct XcdBarrier {
    unsigned* bar; unsigned x;
    volatile LAS unsigned* st;
};

__device__ __forceinline__ XcdBarrier xcd_barrier_post(unsigned* bar, volatile LAS unsigned* st) {
    XcdBarrier b; b.bar = bar; b.x = xb_xcc_id(); b.st = st;
    if (threadIdx.x == 0) (void)xb_add(&bar[XB_XCNT(b.x)], 1u);
    return b;
}
__device__ __forceinline__ void xcd_barrier_complete(unsigned* bar, unsigned x, unsigned& nloc, unsigned& nx) {
    const unsigned G = gridDim.x * gridDim.y * gridDim.z;
    unsigned sum, cnt, mine, sp = 0u;
    for (;;) {
        sum = 0u; cnt = 0u; mine = 0u;
#pragma unroll
        for (unsigned j = 0; j < 16; ++j) { const unsigned c = xb_ld(&bar[XB_XCNT(j)]); sum += c; cnt += (c > 0u) ? 1u : 0u; mine = (j == x) ? c : mine; }
        if (sum == G) break;
        __builtin_amdgcn_s_sleep(1);
        if ((++sp & 255u) == 0u) { if (xb_ld(&bar[XB_TMO])) break; if (sp > XB_SPIN_CAP) { atomicAdd(&bar[XB_TMO], 1u); break; } }
    }
    nloc = mine > 0u ? mine : 1u; nx = cnt > 0u ? cnt : 1u;
}

__device__ __forceinline__ void xcd_barrier(const XcdBarrier& b) {
    asm volatile("s_waitcnt vmcnt(0)" ::: "memory");
    __syncthreads();
    if (threadIdx.x == 0) {
        unsigned* bar = b.bar;
        __builtin_amdgcn_s_waitcnt(0);
        unsigned nloc = b.st[0], nx = b.st[1];
        if (nloc == 0u) { xcd_barrier_complete(bar, b.x, nloc, nx); b.st[0] = nloc; b.st[1] = nx; }
        const unsigned old = xb_add(&bar[XB_XSUB(b.x)], 1u);
        const unsigned gen = old / nloc;
        if (old + 1u == (gen + 1u) * nloc) {
            __builtin_amdgcn_fence(__ATOMIC_RELEASE, "agent");
            asm volatile("s_waitcnt vmcnt(0)" ::: "memory");
            const unsigned og = xb_add(&bar[XB_TOP], 1u);
            const unsigned tg = og / nx;
            if (og + 1u == (tg + 1u) * nx) xb_add(&bar[XB_TOPGEN], 1u);
            else XB_SPIN(xb_ld(&bar[XB_TOPGEN]) == tg, bar);
            __builtin_amdgcn_fence(__ATOMIC_ACQUIRE, "agent");
            xb_add(&bar[XB_XGEN(b.x)], 1u);
            asm volatile("s_waitcnt vmcnt(0)" ::: "memory");
        } else {
            XB_SPIN(xb_ld(&bar[XB_XGEN(b.x)]) == gen, bar);
            __builtin_amdgcn_fence(__ATOMIC_ACQUIRE, "agent");
            asm volatile("s_waitcnt vmcnt(0)" ::: "memory");
        }
    }
    __syncthreads();
}

#ifndef PG8_SP2
#define PG8_SP2 true
#endif
#ifndef PG8_ALIGN
#define PG8_ALIGN true
#endif
#ifndef PROBE_ON
#define PROBE_ON 0
#define PROBE_A 0
#define PROBE_B 1
#endif
#ifndef MK_PER_PHASE
#define MK_PER_PHASE 0
#endif

constexpr int T = 16384, NSMP = 32, TS = T + NSMP, TSP = T + 256, DM = 1024;
constexpr int PA = 3368, PAP = 3584;
constexpr int C_Q = 0, C_KC = 512, C_VC = 640, C_KS = 768, C_VS = 896, C_KW = 1024, C_VW = 1152, C_GATE = 1280,
              C_GQKV = 1304, C_A = 2840, C_BT = 2848, C_Z = 2856;
constexpr int DFF = 2816, DFF2 = 5632;
constexpr float DN_ALPHA = 1.4142135623730951f;
constexpr float LN_EPS = 1e-5f, NORM_EPS = 1e-6f;
constexpr int NPAGES = 128;
constexpr int NWAVES = 8, NTHR = 512;

constexpr size_t O_Y_P = 0;
constexpr size_t O_Y_S = O_Y_P + (size_t)T * DM;
constexpr size_t O_CMP_P = O_Y_S + (size_t)NSMP * DM;
constexpr size_t O_CMP_S = O_CMP_P + (size_t)T * 256;
constexpr size_t O_SLC_P = O_CMP_S + (size_t)NSMP * 256;
constexpr size_t O_SLC_S = O_SLC_P + (size_t)T * 256;
constexpr size_t O_WIN_P = O_SLC_S + (size_t)NSMP * 256;
constexpr size_t O_WIN_S = O_WIN_P + (size_t)512 * 256;
constexpr size_t O_GCONV_P = O_WIN_S + (size_t)NSMP * 512 * 256;
constexpr size_t O_GCONV_S = O_GCONV_P + (size_t)3 * 1536;
constexpr size_t O_GS_P = O_GCONV_S + (size_t)NSMP * 3 * 1536;
constexpr size_t O_GS_S = O_GS_P + (size_t)8 * 64 * 64;
constexpr size_t O_DIL_P = O_GS_S + (size_t)NSMP * 8 * 64 * 64;
constexpr size_t O_DIL_S = O_DIL_P + (size_t)2048 * 2048;
constexpr size_t O_FFN_P = O_DIL_S + (size_t)NSMP * 2048 * 2048;
constexpr size_t O_FFN_S = O_FFN_P + (size_t)2 * 2 * DFF2;
constexpr size_t O_END = O_FFN_S + (size_t)NSMP * 2 * 2 * DFF2;

constexpr int RING_BYTES = 131072;
constexpr int FAST_WL = 17408;
constexpr int MISC_OFF = 8 * FAST_WL + 64;
constexpr int LDS_BYTES = 147456;

typedef unsigned short bf16;
typedef unsigned v4u __attribute__((ext_vector_type(4)));

__device__ __forceinline__ unsigned f2bf(float f) { return (unsigned)__builtin_bit_cast(unsigned short, (__bf16)f); }
__device__ __forceinline__ unsigned pk2(float lo, float hi) { return pg8::cvt_pk_bf16(lo, hi); }
typedef short bf16x8 __attribute__((ext_vector_type(8)));
typedef float f32x4 __attribute__((ext_vector_type(4)));
#define MFMA16(a, b, c) __builtin_amdgcn_mfma_f32_16x16x32_bf16((a), (b), (c), 0, 0, 0)
__device__ __forceinline__ float wave_sum(float v) {
#pragma unroll
    for (int o = 1; o < 64; o <<= 1) v += __shfl_xor(v, o);
    return v;
}
__device__ __forceinline__ float wave_max(float v) {
#pragma unroll
    for (int o = 1; o < 64; o <<= 1) v = fmaxf(v, __shfl_xor(v, o));
    return v;
}
__device__ __forceinline__ void wave_lds_sync() { asm volatile("s_waitcnt lgkmcnt(0)" ::: "memory"); __builtin_amdgcn_wave_barrier(); asm volatile("" ::: "memory"); }
__device__ __forceinline__ float sigmoidf_(float x) { return 1.f / (1.f + expf(-x)); }
__device__ __forceinline__ float siluf_(float x) { return x / (1.f + expf(-x)); }
__device__ __forceinline__ float gelu_tanh(float x) { const float c = 0.7978845608028654f; return 0.5f * x * (1.f + tanhf(c * (x + 0.044715f * x * x * x))); }
__device__ __forceinline__ float softplusf_(float x) { return x > 20.f ? x : log1pf(expf(x)); }

struct KP {
    const float *x_prompt, *x_sample, *cache_cmp, *cache_slc, *st_win, *st_gconv, *st_gS, *st_dil, *st_ffn;
    const int* page_table;
    const float *w_in_a, *cw1, *cb1, *cw2, *cpe, *gconv_w, *gA, *gdt, *gnw, *w_out_a, *w_in_c, *w_out_c, *ln_mix_g, *ln_mix_b,
                *ffn_w_in, *ffn_cw, *ffn_cb, *ffn_w_out, *ln_ffn_g, *ln_ffn_b;
    float* out;
    unsigned* ctl;
    bf16 *WT_A, *WT_OA, *WT_FI0, *WT_FI1, *WT_FO0, *WT_FO1, *WT_CI, *WT_CO;
    float2* ROPE;
    bf16 *ACTB, *MIXB, *HFFB;
    bf16 *QB, *KSF, *VSF, *KWF, *VWF, *CKF, *CVF;
    unsigned char *KS8, *VS8;
    bf16 *QDB; bf16* DKF[3]; bf16* DVF[3];
    bf16 *AC, *WT_C, *HID, *W2T, *ACP; float* SMIXF; float* NSACC; int* SEL; float* UB;
    bf16 *G_WF, *G_KDF, *G_QGF, *G_QKF, *G_SPF, *G_VNF; float *G_UF, *G_GL;
    float *BIGF, *MO, *X1, *X2, *X3, *QR, *KS, *VS, *KW, *VW, *CK, *CV, *GQ, *GK, *GV, *OG, *Gg, *Gb, *QD, *KD;
    int ph_lo, ph_hi;
};

struct Fr { unsigned char* lds; int tid, lane, wave, gw, NGW, bid, G; };

__device__ __forceinline__ int ffn_row(int u) { const int half = u >= DFF ? 1 : 0, jc = u - half * DFF; return 256 * (jc >> 7) + 128 * half + (jc & 127); }
__device__ __forceinline__ void transpose_item(const float* W, int K, int N, int NT, bf16* WT, float* scr, int item, int lane, int rowmap = 0) {
    const int nblk = NT / 32, kb = item / nblk, nb = item % nblk, k0 = 64 * kb, n0 = 32 * nb;
#pragma unroll 8
    for (int i = 0; i < 32; ++i) { const int kk = 2 * i + (lane >> 5); const int n = n0 + (lane & 31); scr[kk * 33 + (lane & 31)] = (n < N) ? W[(size_t)(k0 + kk) * N + n] : 0.f; }
    wave_lds_sync();
    const int c = lane & 7;
#pragma unroll
    for (int j = 0; j < 4; ++j) { const int n = (lane >> 3) + 8 * j; const float* s = scr + (8 * c) * 33 + n;
        v4u o; o.x = pk2(s[0 * 33], s[1 * 33]); o.y = pk2(s[2 * 33], s[3 * 33]); o.z = pk2(s[4 * 33], s[5 * 33]); o.w = pk2(s[6 * 33], s[7 * 33]);
        const int row = rowmap ? ffn_row(n0 + n) : n0 + n;
        *(v4u*)(WT + (size_t)row * K + k0 + 8 * c) = o; }
    wave_lds_sync();
}
__device__ __forceinline__ void ph_prologue(const KP& p, const Fr& F) {
    float* scr = (float*)(F.lds + F.wave * 16384);
    const int I_A = 16 * (PAP / 32), I_OA = 16 * 32, I_FI = 16 * (DFF2 / 32), I_FO = (DFF / 64) * 32, I_CI = 16 * (3072 / 32), I_CO = 16 * 32;
    const int NITEMS = I_A + I_OA + 2 * I_FI + 2 * I_FO + I_CI + I_CO + 256 + 8;
    for (int it = F.gw; it < NITEMS; it += F.NGW) {
        int r = it;
        if (r < I_A) { transpose_item(p.w_in_a, DM, PA, PAP, p.WT_A, scr, r, F.lane); continue; } r -= I_A;
        if (r < I_OA) { transpose_item(p.w_out_a, DM, DM, DM, p.WT_OA, scr, r, F.lane); continue; } r -= I_OA;
        if (r < I_FI) { transpose_item(p.ffn_w_in, DM, DFF2, DFF2, p.WT_FI0, scr, r, F.lane, 1); continue; } r -= I_FI;
        if (r < I_FI) { transpose_item(p.ffn_w_in + (size_t)DM * DFF2, DM, DFF2, DFF2, p.WT_FI1, scr, r, F.lane, 1); continue; } r -= I_FI;
        if (r < I_FO) { transpose_item(p.ffn_w_out, DFF, DM, DM, p.WT_FO0, scr, r, F.lane); continue; } r -= I_FO;
        if (r < I_FO) { transpose_item(p.ffn_w_out + (size_t)DFF * DM, DFF, DM, DM, p.WT_FO1, scr, r, F.lane); continue; } r -= I_FO;
        if (r < I_CI) { transpose_item(p.w_in_c, DM, 3072, 3072, p.WT_CI, scr, r, F.lane); continue; } r -= I_CI;
        if (r < I_CO) { transpose_item(p.w_out_c, DM, DM, DM, p.WT_CO, scr, r, F.lane); continue; } r -= I_CO;
        if (r < 256) { const int kv = r >> 7; transpose_item(p.cw1 + (size_t)kv * 2048 * 128, 2048, 128, 128, p.WT_C + (size_t)kv * 128 * 2048, scr, r & 127, F.lane); continue; } r -= 256;
        { const int kv = r >> 2; transpose_item(p.cw2 + (size_t)kv * 128 * 64, 128, 64, 64, p.W2T + (size_t)kv * 64 * 128, scr, r & 3, F.lane); }
    }
    const size_t gt = (size_t)F.bid * NTHR + F.tid, GT = (size_t)F.G * NTHR;
    for (size_t i4 = gt; i4 < (size_t)TSP * (DM / 4); i4 += GT) {
        const int r = (int)(i4 / (DM / 4)), c4 = (int)(i4 % (DM / 4));
        float4 v = make_float4(0.f, 0.f, 0.f, 0.f);
        if (r < T) v = ((const float4*)p.x_prompt)[(size_t)r * (DM / 4) + c4]; else if (r < TS) v = ((const float4*)p.x_sample)[(size_t)(r - T) * (DM / 4) + c4];
        uint2 o; o.x = pk2(v.x, v.y); o.y = pk2(v.z, v.w);
        ((uint2*)p.ACTB)[i4] = o;
    }
    for (size_t idx = gt; idx < (size_t)(T + 1) * 32; idx += GT) {
        const int pos = (int)(idx >> 5), i = (int)(idx & 31);
        const float inv = (float)pow(10000.0, -2.0 * (double)i / 64.0);
        const float ang = (float)pos * inv;
        p.ROPE[idx] = make_float2((float)cos((double)ang), (float)sin((double)ang));
    }
}

__device__ __forceinline__ size_t vfrag_elem(int key, int d);
__device__ __forceinline__ size_t kfrag_elem(int key, int d);
__device__ __forceinline__ bf16x8 pack_p(const f32x4& p0, const f32x4& p1);
template <bool FFNMAP = false>
__device__ __forceinline__ void skinny_gemm(const Fr& F, const bf16* A, const bf16* Bt, int K, int ncols, float* C, int ldc) {
    const int lane = F.lane, l15 = lane & 15, grp = lane >> 4;
    const bf16* a0 = A + (size_t)(T + l15) * K + 8 * grp; const bf16* a1 = a0 + (size_t)16 * K;
    for (int nt = F.gw; nt * 16 < ncols; nt += F.NGW) {
        const bf16* bp = Bt + (size_t)(nt * 16 + l15) * K + 8 * grp;
        f32x4 c0 = {0.f, 0.f, 0.f, 0.f}, c1 = {0.f, 0.f, 0.f, 0.f};
#pragma unroll 4
        for (int k = 0; k < K; k += 32) {
            const bf16x8 b = *(const bf16x8*)(bp + k), x0 = *(const bf16x8*)(a0 + k), x1 = *(const bf16x8*)(a1 + k);
            c0 = MFMA16(x0, b, c0); c1 = MFMA16(x1, b, c1);
        }
        int n = nt * 16 + l15;
        if (FFNMAP) n = ((n >> 7) & 1) * DFF + (n >> 8) * 128 + (n & 127);
        if (n < ncols) {
#pragma unroll
            for (int r = 0; r < 4; ++r) { C[(size_t)(T + 4 * grp + r) * ldc + n] = c0[r]; C[(size_t)(T + 16 + 4 * grp + r) * ldc + n] = c1[r]; }
        }
    }
}
__device__ __forceinline__ void ph_gemm_f32(const Fr& F, const bf16* A, const bf16* Bt, int N, int K, float* C, int ldc, int ncols) {
    skinny_gemm(F, A, Bt, K, ncols, C, ldc);
    pg8::Gemm g{A, Bt, T, N, K}; pg8::StaticOrder S; S.init(T, N, F.G, F.bid);
    pg8::EpiF32 E{C, ldc, ncols};
    pg8::gemm_phase<pg8::EpiF32, pg8::StaticOrder, PG8_ALIGN, PG8_SP2>((PG8_LAS unsigned char*)F.lds, g, S, E);
}
__device__ __forceinline__ float dpp_ror1(float x) { return __int_as_float(__builtin_amdgcn_update_dpp(0, __float_as_int(x), 0x121, 0xf, 0xf, false)); }
__device__ __forceinline__ float dpp_ror2(float x) { return __int_as_float(__builtin_amdgcn_update_dpp(0, __float_as_int(x), 0x122, 0xf, 0xf, false)); }
struct EpiFfn {
    static constexpr bool PERM = true, AFTER_DRAIN = false;
    bf16* H; float* UB; const float* cw; const float* cb;
    __device__ __forceinline__ void operator()(const pg8::f32x4 (&acc)[2][2][4][2], const pg8::Unit& u, int wr, int wc, int fr, int fq) const {
#pragma unroll
        for (int n = 0; n < 2; ++n) {
            const int jc = u.pn * 128 + wc * 32 + 8 * fq + 4 * n;
            pg8::f32x4 w0[2], w1[2], w2[2], bb[2];
#pragma unroll
            for (int bj = 0; bj < 2; ++bj) { const int uc = bj * DFF + jc;
                w0[bj] = *(const pg8::f32x4*)(cw + uc); w1[bj] = *(const pg8::f32x4*)(cw + DFF2 + uc); w2[bj] = *(const pg8::f32x4*)(cw + 2 * DFF2 + uc); bb[bj] = *(const pg8::f32x4*)(cb + uc); }
#pragma unroll
            for (int ai = 0; ai < 2; ++ai) {
                const int sl = u.pm * 4 + ai * 2 + wr;
                pg8::f32x4 pr1[2], pr2[2];
#pragma unroll
                for (int m = 0; m < 4; ++m) {
                    pg8::f32x4 c[2];
#pragma unroll
                    for (int bj = 0; bj < 2; ++bj) {
                        const pg8::f32x4 uu = acc[ai][bj][m][n]; pg8::f32x4 r1, r2;
#pragma unroll
                        for (int e = 0; e < 4; ++e) { r1[e] = dpp_ror1(uu[e]); r2[e] = dpp_ror2(uu[e]); }
                        pg8::f32x4 p1 = r1, p2 = r2;
                        if (m > 0) { if (fr == 0) p1 = pr1[bj]; if (fr < 2) p2 = pr2[bj]; }
                        c[bj] = bb[bj] + w0[bj] * p2 + w1[bj] * p1 + w2[bj] * uu;
                        pr1[bj] = r1; pr2[bj] = r2;
                        const int uc = bj * DFF + jc;
                        if (m == 0 && fr < 2) *(pg8::f32x4*)(UB + ((size_t)sl * 4 + fr) * DFF2 + uc) = uu;
                        if (m == 3 && fr >= 14) *(pg8::f32x4*)(UB + ((size_t)sl * 4 + 2 + (fr - 14)) * DFF2 + uc) = uu;
                    }
                    if (!(m == 0 && fr < 2)) {
                        const int t = u.pm * 256 + ai * 128 + wr * 64 + m * 16 + fr;
                        uint2 o; o.x = pk2(siluf_(c[0][0]) * c[1][0], siluf_(c[0][1]) * c[1][1]); o.y = pk2(siluf_(c[0][2]) * c[1][2], siluf_(c[0][3]) * c[1][3]);
                        *(uint2*)(H + (size_t)t * DFF + jc) = o;
                    }
                }
            }
        }
    }
};
__device__ __forceinline__ void ph_ffn_gemm(const KP& p, const Fr& F, const bf16* Bt, int layer) {
    skinny_gemm<true>(F, p.ACTB, Bt, DM, DFF2, p.BIGF, DFF2);
    pg8::Gemm g{p.ACTB, Bt, T, DFF2, DM}; pg8::StaticOrder S; S.init(T, DFF2, F.G, F.bid);
    EpiFfn E{p.HFFB, p.UB, p.ffn_cw + (size_t)layer * 3 * DFF2, p.ffn_cb + (size_t)layer * DFF2};
    pg8::gemm_phase<EpiFfn, pg8::StaticOrder, PG8_ALIGN, PG8_SP2>((PG8_LAS unsigned char*)F.lds, g, S, E);
}
__device__ __forceinline__ void ph_ffn_fix(const KP& p, const Fr& F, int layer) {
    const float* cw = p.ffn_cw + (size_t)layer * 3 * DFF2; const float* cb = p.ffn_cb + (size_t)layer * DFF2; const float* U = p.BIGF;
    const int gt = F.bid * NTHR + F.tid, GT = F.G * NTHR;
    for (int idx = gt; idx < 512 * DFF; idx += GT) {
        const int rr = idx / DFF, j = idx - rr * DFF; const int sl = rr >> 1, q = rr & 1;
        float c2[2];
#pragma unroll
        for (int half = 0; half < 2; ++half) { const int ch = half * DFF + j;
            const float u0 = p.UB[((size_t)sl * 4 + q) * DFF2 + ch];
            const float um1 = q ? p.UB[((size_t)sl * 4) * DFF2 + ch] : (sl ? p.UB[((size_t)(sl - 1) * 4 + 3) * DFF2 + ch] : 0.f);
            const float um2 = sl ? p.UB[((size_t)(sl - 1) * 4 + 2 + q) * DFF2 + ch] : 0.f;
            c2[half] = cb[ch] + cw[ch] * um2 + cw[DFF2 + ch] * um1 + cw[2 * DFF2 + ch] * u0; }
        p.HFFB[(size_t)(64 * sl + q) * DFF + j] = (bf16)f2bf(siluf_(c2[0]) * c2[1]);
    }
    for (int idx = gt; idx < NSMP * DFF; idx += GT) {
        const int b = idx / DFF, j = idx - b * DFF;
        float c2[2];
#pragma unroll
        for (int half = 0; half < 2; ++half) { const int ch = half * DFF + j;
            const float* hs = p.st_ffn + (((size_t)b * 2 + layer) * 2) * DFF2 + ch;
            c2[half] = cb[ch] + cw[ch] * hs[0] + cw[DFF2 + ch] * hs[DFF2] + cw[2 * DFF2 + ch] * U[(size_t)(T + b) * DFF2 + ch]; }
        p.HFFB[(size_t)(T + b) * DFF + j] = (bf16)f2bf(siluf_(c2[0]) * c2[1]);
    }
    for (int idx = gt; idx < 2 * DFF2; idx += GT) { const int k = idx / DFF2, ch = idx - k * DFF2;
        p.out[O_FFN_P + ((size_t)layer * 2 + k) * DFF2 + ch] = p.UB[((size_t)255 * 4 + 2 + k) * DFF2 + ch]; }
    for (int idx = gt; idx < NSMP * 2 * DFF2; idx += GT) { const int b = idx / (2 * DFF2), k = (idx / DFF2) & 1, ch = idx % DFF2;
        p.out[O_FFN_S + (((size_t)b * 2 + layer) * 2 + k) * DFF2 + ch] = (k == 0) ? p.st_ffn[(((size_t)b * 2 + layer) * 2 + 1) * DFF2 + ch] : U[(size_t)(T + b) * DFF2 + ch]; }
}
struct EpiCmp {
    static constexpr bool PERM = false, AFTER_DRAIN = false;
    bf16* HID; const float* b1;
    __device__ __forceinline__ void operator()(const pg8::f32x4 (&acc)[2][2][4][2], const pg8::Unit& u, int wr, int wc, int fr, int fq) const {
#pragma unroll
        for (int ai = 0; ai < 2; ++ai)
#pragma unroll
            for (int m = 0; m < 4; ++m) { const int combo = u.pm * 128 + wr * 64 + m * 16 + fr;
#pragma unroll
                for (int n = 0; n < 2; ++n) { const int j0 = wc * 32 + n * 16 + 4 * fq; const pg8::f32x4 v = acc[ai][ai][m][n]; const float* bb = b1 + ai * 128 + j0;
                    uint2 o; o.x = pk2(gelu_tanh(v[0] + bb[0]), gelu_tanh(v[1] + bb[1])); o.y = pk2(gelu_tanh(v[2] + bb[2]), gelu_tanh(v[3] + bb[3]));
                    *(uint2*)(HID + ((size_t)combo * 2 + ai) * 128 + j0) = o; } }
    }
};
__device__ __forceinline__ void ph_cmp_gemm(const KP& p, const Fr& F) {
    pg8::Gemm g{p.AC, p.WT_C, 65536, 256, 2048}; pg8::StaticOrder S; S.init(65536, 256, F.G, F.bid);
    EpiCmp E{p.HID, p.cb1};
    pg8::gemm_phase<EpiCmp, pg8::StaticOrder, PG8_ALIGN, PG8_SP2>((PG8_LAS unsigned char*)F.lds, g, S, E);
}
__device__ __forceinline__ void ph_cmp_stage2(const KP& p, const Fr& F) {
    const int lane = F.lane, l15 = lane & 15, grp = lane >> 4;
    for (int tile = F.gw; tile < 4096; tile += F.NGW) {
        const int kv = tile & 1, combo0 = (tile >> 1) * 16;
        const bf16* hid = p.HID + ((size_t)(combo0 + l15) * 2 + kv) * 128 + 8 * grp; const bf16* w2 = p.W2T + (size_t)kv * 64 * 128 + (size_t)l15 * 128 + 8 * grp;
        f32x4 acc[4];
#pragma unroll
        for (int nt = 0; nt < 4; ++nt) acc[nt] = (f32x4){0.f, 0.f, 0.f, 0.f};
#pragma unroll
        for (int ks = 0; ks < 4; ++ks) { const bf16x8 a = *(const bf16x8*)(hid + 32 * ks);
#pragma unroll
            for (int nt = 0; nt < 4; ++nt) acc[nt] = MFMA16(a, *(const bf16x8*)(w2 + (size_t)nt * 16 * 128 + 32 * ks), acc[nt]); }
#pragma unroll
        for (int r = 0; r < 4; ++r) {
            const int combo = combo0 + 4 * grp + r; const int g = combo & 1, c = (combo >> 1) & 511, b = combo >> 10;
            float* dst = ((kv == 0) ? p.CK : p.CV) + (((size_t)(1 + b) * 512 + c) * 2 + g) * 64;
            if (kv == 0) {
                const int pos = (c + 1) * 32 - 1;
#pragma unroll
                for (int nt = 0; nt < 2; ++nt) { const float2 cs = p.ROPE[pos * 32 + 16 * nt + l15]; const float x1 = acc[nt][r], x2 = acc[nt + 2][r];
                    dst[16 * nt + l15] = x1 * cs.x - x2 * cs.y; dst[16 * (nt + 2) + l15] = x2 * cs.x + x1 * cs.y; }
            } else {
#pragma unroll
                for (int nt = 0; nt < 4; ++nt) dst[16 * nt + l15] = acc[nt][r];
            }
        }
    }
}
__device__ __forceinline__ void cmp_prompt_unit(const KP& p, int unit, int lane) {
    asm volatile("" : "+v"(lane));
    const int l15 = lane & 15, grp = lane >> 4;
    const int kv = unit & 1, combo = (unit >> 1) * 16 + l15; const int g = combo & 1, c = combo >> 1;
    const bf16* w1 = p.WT_C + ((size_t)kv * 128 + l15) * 2048 + 8 * grp;
    f32x4 acc[8];
#pragma unroll
    for (int jt = 0; jt < 8; ++jt) acc[jt] = (f32x4){0.f, 0.f, 0.f, 0.f};
    const bf16* fl = p.ACP + ((size_t)kv * 1024 + combo) * 2048 + 8 * grp;
#pragma unroll 4
    for (int ks = 0; ks < 64; ++ks) {
        const bf16x8 fb = *(const bf16x8*)(fl + 32 * ks);
#pragma unroll
        for (int jt = 0; jt < 8; ++jt) acc[jt] = MFMA16(*(const bf16x8*)(w1 + (size_t)jt * 16 * 2048 + 32 * ks), fb, acc[jt]);
    }
    bf16x8 hb[4];
#pragma unroll
    for (int s2 = 0; s2 < 4; ++s2) {
        f32x4 h0, h1;
#pragma unroll
        for (int r = 0; r < 4; ++r) { h0[r] = gelu_tanh(acc[2 * s2][r] + p.cb1[kv * 128 + 32 * s2 + 4 * grp + r]); h1[r] = gelu_tanh(acc[2 * s2 + 1][r] + p.cb1[kv * 128 + 32 * s2 + 16 + 4 * grp + r]); }
        hb[s2] = pack_p(h0, h1);
    }
    f32x4 o[4];
#pragma unroll
    for (int dt = 0; dt < 4; ++dt) {
        o[dt] = (f32x4){0.f, 0.f, 0.f, 0.f};
        const bf16* w2 = p.W2T + (size_t)kv * 64 * 128 + (size_t)(16 * dt + l15) * 128 + 4 * grp;
#pragma unroll
        for (int s2 = 0; s2 < 4; ++s2) { const uint2 x0 = *(const uint2*)(w2 + 32 * s2), x1 = *(const uint2*)(w2 + 32 * s2 + 16);
            union { v4u u; bf16x8 b; } wa; wa.u.x = x0.x; wa.u.y = x0.y; wa.u.z = x1.x; wa.u.w = x1.y;
            o[dt] = MFMA16(wa.b, hb[s2], o[dt]); }
    }
    if (kv == 0) {
        const int pos = (c + 1) * 32 - 1;
#pragma unroll
        for (int dt = 0; dt < 2; ++dt)
#pragma unroll
            for (int r = 0; r < 4; ++r) { const float2 cs = p.ROPE[pos * 32 + 16 * dt + 4 * grp + r]; const float x1 = o[dt][r], x2 = o[dt + 2][r];
                o[dt][r] = x1 * cs.x - x2 * cs.y; o[dt + 2][r] = x2 * cs.x + x1 * cs.y; }
    }
#pragma unroll
    for (int dt = 0; dt < 4; ++dt)
#pragma unroll
        for (int r = 0; r < 4; ++r) { const int d = 16 * dt + 4 * grp + r;
            if (kv == 0) p.CKF[(size_t)g * 512 * 64 + kfrag_elem(c, d)] = (bf16)f2bf(o[dt][r]); else p.CVF[(size_t)g * 512 * 64 + vfrag_elem(c, d)] = (bf16)f2bf(o[dt][r]); }
}
__device__ __forceinline__ void cmp_sample_unit(const KP& p, int unit, int lane) {
    asm volatile("" : "+v"(lane));
    const int l15 = lane & 15, grp = lane >> 4;
    const int b = unit >> 6, kv = (unit >> 5) & 1, cb = unit & 31;
    const bf16* w1 = p.WT_C + ((size_t)kv * 128 + l15) * 2048 + 8 * grp;
    const float* src[2];
#pragma unroll
    for (int cg = 0; cg < 2; ++cg) { const int combo = cb * 32 + 16 * cg + l15; const int g = combo & 1, c = combo >> 1;
        const int page = p.page_table[b * NPAGES + (c >> 2)];
        src[cg] = p.cache_cmp + (((size_t)page * 128 + (c & 3) * 32) * 4 + kv * 2 + g) * 64 + 8 * grp; }
    const float* pe = p.cpe + (size_t)kv * 32 * 64 + 8 * grp;
    f32x4 acc[2][8];
#pragma unroll
    for (int cg = 0; cg < 2; ++cg)
#pragma unroll
        for (int jt = 0; jt < 8; ++jt) acc[cg][jt] = (f32x4){0.f, 0.f, 0.f, 0.f};
#pragma unroll 2
    for (int ks = 0; ks < 64; ++ks) {
        const int i = ks >> 1, dd = 32 * (ks & 1);
        const float4 e0 = *(const float4*)(pe + i * 64 + dd), e1 = *(const float4*)(pe + i * 64 + dd + 4);
        bf16x8 fb[2];
#pragma unroll
        for (int cg = 0; cg < 2; ++cg) { const float4 a0 = *(const float4*)(src[cg] + i * 256 + dd), a1 = *(const float4*)(src[cg] + i * 256 + dd + 4);
            union { v4u u; bf16x8 b; } t; t.u.x = pk2(a0.x + e0.x, a0.y + e0.y); t.u.y = pk2(a0.z + e0.z, a0.w + e0.w); t.u.z = pk2(a1.x + e1.x, a1.y + e1.y); t.u.w = pk2(a1.z + e1.z, a1.w + e1.w); fb[cg] = t.b; }
#pragma unroll
        for (int jt = 0; jt < 8; ++jt) { const bf16x8 wa = *(const bf16x8*)(w1 + (size_t)jt * 16 * 2048 + 32 * ks);
            acc[0][jt] = MFMA16(wa, fb[0], acc[0][jt]); acc[1][jt] = MFMA16(wa, fb[1], acc[1][jt]); }
    }
#pragma unroll
    for (int cg = 0; cg < 2; ++cg) {
        const int combo = cb * 32 + 16 * cg + l15; const int g = combo & 1, c = combo >> 1;
        bf16x8 hb[4];
#pragma unroll
        for (int s2 = 0; s2 < 4; ++s2) { f32x4 h0, h1;
#pragma unroll
            for (int r = 0; r < 4; ++r) { h0[r] = gelu_tanh(acc[cg][2 * s2][r] + p.cb1[kv * 128 + 32 * s2 + 4 * grp + r]); h1[r] = gelu_tanh(acc[cg][2 * s2 + 1][r] + p.cb1[kv * 128 + 32 * s2 + 16 + 4 * grp + r]); }
            hb[s2] = pack_p(h0, h1); }
        f32x4 o[4];
#pragma unroll
        for (int dt = 0; dt < 4; ++dt) {
            o[dt] = (f32x4){0.f, 0.f, 0.f, 0.f};
            const bf16* w2 = p.W2T + (size_t)kv * 64 * 128 + (size_t)(16 * dt + l15) * 128 + 4 * grp;
#pragma unroll
            for (int s2 = 0; s2 < 4; ++s2) { const uint2 x0 = *(const uint2*)(w2 + 32 * s2), x1 = *(const uint2*)(w2 + 32 * s2 + 16);
                union { v4u u; bf16x8 b; } wa; wa.u.x = x0.x; wa.u.y = x0.y; wa.u.z = x1.x; wa.u.w = x1.y;
                o[dt] = MFMA16(wa.b, hb[s2], o[dt]); }
        }
        if (kv == 0) {
            const int pos = (c + 1) * 32 - 1;
#pragma unroll
            for (int dt = 0; dt < 2; ++dt)
#pragma unroll
                for (int r = 0; r < 4; ++r) { const float2 cs = p.ROPE[pos * 32 + 16 * dt + 4 * grp + r]; const float x1 = o[dt][r], x2 = o[dt + 2][r];
                    o[dt][r] = x1 * cs.x - x2 * cs.y; o[dt + 2][r] = x2 * cs.x + x1 * cs.y; }
        }
        float* dst = ((kv == 0) ? p.CK : p.CV) + (((size_t)(1 + b) * 512 + c) * 2 + g) * 64 + 4 * grp;
#pragma unroll
        for (int dt = 0; dt < 4; ++dt) *(f32x4*)(dst + 16 * dt) = o[dt];
    }
}
__device__ __forceinline__ void ph_cmp_samples(const KP& p, const Fr& F) {
    for (int unit = F.gw; unit < 2048; unit += F.NGW) cmp_sample_unit(p, unit, F.lane);
}
__device__ __forceinline__ void ph_cmp_prompt(const KP& p, const Fr& F) {
    for (int unit = F.gw; unit < 128; unit += F.NGW) cmp_prompt_unit(p, unit, F.lane);
}

__device__ __forceinline__ float rope_val(const float* row, int base, int i, float2 cs) {
    const int ii = i & 31;
    const float x1 = row[base + ii], x2 = row[base + ii + 32];
    return (i < 32) ? (x1 * cs.x - x2 * cs.y) : (x2 * cs.x + x1 * cs.y);
}
__device__ __forceinline__ void ph_nsa_prep(const KP& p, const Fr& F) {
    const float* H0 = p.BIGF; float* out = p.out;
    const size_t gt = (size_t)F.bid * NTHR + F.tid, GT = (size_t)F.G * NTHR;
    const size_t total = (size_t)TS * 1280;
    for (size_t idx = gt + (size_t)T * 1280; idx < total; idx += GT) {
        const int r = (int)(idx / 1280), c = (int)(idx % 1280);
        const bool smp = r >= T; const int b = r - T; const int pos = smp ? T : r;
        const float* row = H0 + (size_t)r * PA;
        const int i = c & 63;
        const float2 cs = p.ROPE[pos * 32 + (i & 31)];
        if (c < 512) { p.QR[(size_t)r * 512 + c] = rope_val(row, c & ~63, i, cs); continue; }
        const int sec = (c - 512) >> 7; const int gd = (c - 512) & 127; const int base = c & ~63;
        float v;
        if (sec == 2 || sec == 4) v = rope_val(row, base, i, cs); else v = row[c];
        const int kv = sec & 1;
        if (sec < 2) {
            if (!smp) out[O_CMP_P + (size_t)r * 256 + kv * 128 + gd] = v; else out[O_CMP_S + (size_t)b * 256 + kv * 128 + gd] = v;
        } else if (sec < 4) {
            if (!smp) out[O_SLC_P + (size_t)r * 256 + kv * 128 + gd] = v; else out[O_SLC_S + (size_t)b * 256 + kv * 128 + gd] = v;
            if (kv == 0) p.KS[(size_t)r * 128 + gd] = v; else p.VS[(size_t)r * 128 + gd] = v;
        } else {
            if (kv == 0) p.KW[(size_t)r * 128 + gd] = v; else p.VW[(size_t)r * 128 + gd] = v;
            if (!smp) { if (r >= T - 512) out[O_WIN_P + (size_t)(r - (T - 512)) * 256 + kv * 128 + gd] = v; }
            else out[O_WIN_S + ((size_t)b * 512 + 511) * 256 + kv * 128 + gd] = v;
        }
    }
    const size_t tot2 = (size_t)NSMP * 511 * 256;
    for (size_t idx = gt; idx < tot2; idx += GT) {
        const int b = (int)(idx / (511 * 256)); const int rem = (int)(idx % (511 * 256));
        out[O_WIN_S + (size_t)b * 512 * 256 + rem] = p.st_win[(size_t)b * 512 * 256 + 256 + rem];
    }
}

constexpr float QSCALE = 0.18033688011112042f;

__device__ __forceinline__ size_t kfrag_off(int kt, int ks, int lane) { return ((size_t)(kt * 2 + ks) * 64 + lane) * 8; }
__device__ __forceinline__ size_t vfrag_off(int st, int dt, int lane) { return ((size_t)(st * 4 + dt) * 64 + lane) * 8; }
__device__ __forceinline__ size_t vfrag_elem(int key, int d) {
    const int st = key >> 5, kk = key & 31, tile = kk >> 4, r16 = kk & 15, grp = r16 >> 2, reg = r16 & 3;
    return ((size_t)(st * 4 + (d >> 4)) * 64 + (d & 15) + 16 * grp) * 8 + tile * 4 + reg;
}
__device__ __forceinline__ size_t k8_off(int key, int d) { return ((size_t)(key >> 4) * 64 + (key & 15) + 16 * ((d & 31) >> 3)) * 16 + (d >> 5) * 8 + (d & 7); }
__device__ __forceinline__ size_t v8_off(int key, int d) {
    const int blk = key >> 6, st = (key >> 5) & 1, kk = key & 31, tile = kk >> 4, r16 = kk & 15, grp = r16 >> 2, reg = r16 & 3;
    return ((size_t)(blk * 4 + (d >> 4)) * 64 + (d & 15) + 16 * grp) * 16 + st * 8 + tile * 4 + reg;
}
__device__ __forceinline__ size_t kfrag_elem(int key, int d) {
    return ((size_t)((key >> 4) * 2 + (d >> 5)) * 64 + (key & 15) + 16 * ((d & 31) >> 3)) * 8 + (d & 7);
}

__device__ __forceinline__ void ph_nsa_prep_fast(const KP& p, const Fr& F) {
    const float* H0 = p.BIGF; float* out = p.out;
    const size_t gt = (size_t)F.bid * NTHR + F.tid, GT = (size_t)F.G * NTHR;
    for (size_t idx = gt; idx < (size_t)T * 160; idx += GT) {
        const int t = (int)(idx / 160), u = (int)(idx % 160);
        const int c0 = u * 8; const float* row = H0 + (size_t)t * PA;
        const float4 a0 = *(const float4*)(row + c0), a1 = *(const float4*)(row + c0 + 4);
        float v[8] = {a0.x, a0.y, a0.z, a0.w, a1.x, a1.y, a1.z, a1.w};
        const int sec = (u < 64) ? -1 : ((u - 64) >> 4);
        const bool roped = (sec == -1 || sec == 2 || sec == 4);
        if (roped) {
            const int d0 = c0 & 63; const int pc = (d0 < 32) ? c0 + 32 : c0 - 32;
            const float4 b0 = *(const float4*)(row + pc), b1 = *(const float4*)(row + pc + 4);
            const float w[8] = {b0.x, b0.y, b0.z, b0.w, b1.x, b1.y, b1.z, b1.w};
#pragma unroll
            for (int j = 0; j < 8; ++j) { const float2 cs = p.ROPE[t * 32 + ((d0 + j) & 31)];
                v[j] = (d0 < 32) ? (v[j] * cs.x - w[j] * cs.y) : (v[j] * cs.x + w[j] * cs.y); }
        }
        if (sec == -1) {
            v4u o; o.x = pk2(v[0] * QSCALE, v[1] * QSCALE); o.y = pk2(v[2] * QSCALE, v[3] * QSCALE); o.z = pk2(v[4] * QSCALE, v[5] * QSCALE); o.w = pk2(v[6] * QSCALE, v[7] * QSCALE);
            *(v4u*)(p.QB + (size_t)t * 512 + c0) = o; continue;
        }
        const int gd = (c0 - 512) & 127, g = gd >> 6, d0 = gd & 63, kv = sec & 1;
        const float4 o0 = make_float4(v[0], v[1], v[2], v[3]), o1 = make_float4(v[4], v[5], v[6], v[7]);
        if (sec < 2) { float* o = out + O_CMP_P + (size_t)t * 256 + kv * 128 + gd; *(float4*)o = o0; *(float4*)(o + 4) = o1;
            const int i = t & 31; const float* pe = p.cpe + (kv * 32 + i) * 64 + d0; const float4 e0 = *(const float4*)pe, e1 = *(const float4*)(pe + 4);
            v4u w; w.x = pk2(v[0] + e0.x, v[1] + e0.y); w.y = pk2(v[2] + e0.z, v[3] + e0.w); w.z = pk2(v[4] + e1.x, v[5] + e1.y); w.w = pk2(v[6] + e1.z, v[7] + e1.w);
            *(v4u*)(p.ACP + ((size_t)kv * 1024 + (t >> 5) * 2 + g) * 2048 + i * 64 + d0) = w; continue; }
        if (sec < 4) { float* o = out + O_SLC_P + (size_t)t * 256 + kv * 128 + gd; *(float4*)o = o0; *(float4*)(o + 4) = o1; }
        else if (t >= T - 512) { float* o = out + O_WIN_P + (size_t)(t - (T - 512)) * 256 + kv * 128 + gd; *(float4*)o = o0; *(float4*)(o + 4) = o1; }
        if (sec < 4) {
            if (kv == 0) {
                int w0 = 0, w1 = 0;
                w0 = __builtin_amdgcn_cvt_pk_fp8_f32(v[0], v[1], w0, false); w0 = __builtin_amdgcn_cvt_pk_fp8_f32(v[2], v[3], w0, true);
                w1 = __builtin_amdgcn_cvt_pk_fp8_f32(v[4], v[5], w1, false); w1 = __builtin_amdgcn_cvt_pk_fp8_f32(v[6], v[7], w1, true);
                *(uint2*)(p.KS8 + (size_t)g * T * 64 + k8_off(t, d0)) = make_uint2((unsigned)w0, (unsigned)w1);
            } else {
#pragma unroll
                for (int j = 0; j < 8; ++j) p.VS8[(size_t)g * T * 64 + v8_off(t, d0 + j)] = (unsigned char)(__builtin_amdgcn_cvt_pk_fp8_f32(v[j], 0.f, 0, false) & 0xff);
            }
            continue;
        }
        bf16* KF = p.KWF; bf16* VF = p.VWF;
        if (kv == 0) {
            v4u o; o.x = pk2(v[0], v[1]); o.y = pk2(v[2], v[3]); o.z = pk2(v[4], v[5]); o.w = pk2(v[6], v[7]);
            *(v4u*)(KF + (size_t)g * T * 64 + kfrag_elem(t, d0)) = o;
        } else {
#pragma unroll
            for (int j = 0; j < 8; ++j) VF[(size_t)g * T * 64 + vfrag_elem(t, d0 + j)] = (bf16)f2bf(v[j]);
        }
    }
}

struct AttW { f32x4 o[4]; float m, l; };
__device__ __forceinline__ void attw_init(AttW& a) {
#pragma unroll
    for (int i = 0; i < 4; ++i) a.o[i] = (f32x4){0.f, 0.f, 0.f, 0.f};
    a.m = -INFINITY; a.l = 0.f;
}
__device__ __forceinline__ void qk_step(const bf16x8 (&kf)[2][2], const bf16x8 (&qf)[2], f32x4& s0, f32x4& s1) {
    const f32x4 z = {0.f, 0.f, 0.f, 0.f};
    s0 = MFMA16(kf[0][0], qf[0], z); s0 = MFMA16(kf[0][1], qf[1], s0);
    s1 = MFMA16(kf[1][0], qf[0], z); s1 = MFMA16(kf[1][1], qf[1], s1);
}
__device__ __forceinline__ bf16x8 pack_p(const f32x4& p0, const f32x4& p1) {
    union { v4u u; bf16x8 b; } c;
    c.u.x = pg8::cvt_pk_bf16(p0[0], p0[1]); c.u.y = pg8::cvt_pk_bf16(p0[2], p0[3]); c.u.z = pg8::cvt_pk_bf16(p1[0], p1[1]); c.u.w = pg8::cvt_pk_bf16(p1[2], p1[3]);
    return c.b;
}
__device__ __forceinline__ void att_update(AttW& a, const f32x4& s0, const f32x4& s1, const bf16x8 (&vf)[4]) {
    float mx = fmaxf(fmaxf(fmaxf(s0[0], s0[1]), fmaxf(s0[2], s0[3])), fmaxf(fmaxf(s1[0], s1[1]), fmaxf(s1[2], s1[3])));
    mx = fmaxf(mx, __shfl_xor(mx, 16)); mx = fmaxf(mx, __shfl_xor(mx, 32));
    const float mn = fmaxf(a.m, mx);
    const float ms = (mn == -INFINITY) ? 0.f : mn;
    const float alpha = __builtin_amdgcn_exp2f(a.m - ms);
    f32x4 p0, p1;
#pragma unroll
    for (int i = 0; i < 4; ++i) { p0[i] = __builtin_amdgcn_exp2f(s0[i] - ms); p1[i] = __builtin_amdgcn_exp2f(s1[i] - ms); }
    a.l = a.l * alpha + ((p0[0] + p0[1]) + (p0[2] + p0[3])) + ((p1[0] + p1[1]) + (p1[2] + p1[3]));
    a.m = mn;
    const bf16x8 pf = pack_p(p0, p1);
#pragma unroll
    for (int dt = 0; dt < 4; ++dt) { a.o[dt] = a.o[dt] * alpha; a.o[dt] = MFMA16(vf[dt], pf, a.o[dt]); }
}
__device__ __forceinline__ float grp_sum(float v) { v += __shfl_xor(v, 16); v += __shfl_xor(v, 32); return v; }

__device__ __forceinline__ void nsa_fast_unit(const KP& p, int unit, float* wl, int lane) {
    asm volatile("" : "+v"(lane));
    const int g = unit & 1, t0 = (unit >> 1) * 16;
    const int qi = lane & 15, grp = lane >> 4, t = t0 + qi;
    float* imp = wl; int* sel = (int*)(wl + 4096);
    const float* grow = p.BIGF + (size_t)t * PA + C_GATE + g * 4;
    bf16x8 qf[4][2];
#pragma unroll
    for (int h = 0; h < 4; ++h)
#pragma unroll
        for (int ks = 0; ks < 2; ++ks) qf[h][ks] = *(const bf16x8*)(p.QB + (size_t)t * 512 + (g * 4 + h) * 64 + 32 * ks + 8 * grp);
    AttW st[4];
    {
        const bf16* CKF = p.CKF + (size_t)g * 512 * 64; const bf16* CVF = p.CVF + (size_t)g * 512 * 64;
        const int nmax = (t0 + 16) >> 5; const int nsteps = (nmax + 31) >> 5;
        const int nval = (t + 1) >> 5;
        float m[4], l[4];
#pragma unroll
        for (int h = 0; h < 4; ++h) { m[h] = -INFINITY; l[h] = 0.f; }
        for (int s = 0; s < nsteps; ++s) {
            bf16x8 kf[2][2];
#pragma unroll
            for (int tl = 0; tl < 2; ++tl)
#pragma unroll
                for (int ks = 0; ks < 2; ++ks) kf[tl][ks] = *(const bf16x8*)(CKF + kfrag_off(2 * s + tl, ks, lane));
            const int cb = 32 * s + 4 * grp;
#pragma unroll
            for (int h = 0; h < 4; ++h) {
                f32x4 s0, s1; qk_step(kf, qf[h], s0, s1);
#pragma unroll
                for (int i = 0; i < 4; ++i) { if (cb + i >= nval) s0[i] = -INFINITY; if (cb + 16 + i >= nval) s1[i] = -INFINITY; }
                float mx = fmaxf(fmaxf(fmaxf(s0[0], s0[1]), fmaxf(s0[2], s0[3])), fmaxf(fmaxf(s1[0], s1[1]), fmaxf(s1[2], s1[3])));
                mx = fmaxf(mx, __shfl_xor(mx, 16)); mx = fmaxf(mx, __shfl_xor(mx, 32));
                const float mn = fmaxf(m[h], mx); const float ms = (mn == -INFINITY) ? 0.f : mn;
                float sum = 0.f;
#pragma unroll
                for (int i = 0; i < 4; ++i) sum += __builtin_amdgcn_exp2f(s0[i] - ms) + __builtin_amdgcn_exp2f(s1[i] - ms);
                l[h] = l[h] * __builtin_amdgcn_exp2f(m[h] - ms) + sum; m[h] = mn;
            }
        }
        float il[4];
#pragma unroll
        for (int h = 0; h < 4; ++h) { const float lt = grp_sum(l[h]); il[h] = lt > 0.f ? 1.f / lt : 0.f; if (m[h] == -INFINITY) m[h] = 0.f; attw_init(st[h]); }
        for (int s = 0; s < nsteps; ++s) {
            bf16x8 kf[2][2], vf[4];
#pragma unroll
            for (int tl = 0; tl < 2; ++tl)
#pragma unroll
                for (int ks = 0; ks < 2; ++ks) kf[tl][ks] = *(const bf16x8*)(CKF + kfrag_off(2 * s + tl, ks, lane));
#pragma unroll
            for (int dt = 0; dt < 4; ++dt) vf[dt] = *(const bf16x8*)(CVF + vfrag_off(s, dt, lane));
            const int cb = 32 * s + 4 * grp;
            float i4[4] = {0.f, 0.f, 0.f, 0.f};
#pragma unroll
            for (int h = 0; h < 4; ++h) {
                f32x4 s0, s1; qk_step(kf, qf[h], s0, s1);
                f32x4 p0, p1;
#pragma unroll
                for (int i = 0; i < 4; ++i) {
                    p0[i] = (cb + i < nval) ? __builtin_amdgcn_exp2f(s0[i] - m[h]) * il[h] : 0.f;
                    p1[i] = (cb + 16 + i < nval) ? __builtin_amdgcn_exp2f(s1[i] - m[h]) * il[h] : 0.f; }
                i4[0] += p0[0] + p0[1]; i4[1] += p0[2] + p0[3]; i4[2] += p1[0] + p1[1]; i4[3] += p1[2] + p1[3];
                const bf16x8 pf = pack_p(p0, p1);
#pragma unroll
                for (int dt = 0; dt < 4; ++dt) st[h].o[dt] = MFMA16(vf[dt], pf, st[h].o[dt]);
            }
            *(float2*)(imp + qi * 256 + 16 * s + 2 * grp) = make_float2(i4[0], i4[1]);
            *(float2*)(imp + qi * 256 + 16 * s + 8 + 2 * grp) = make_float2(i4[2], i4[3]);
        }
        wave_lds_sync();
    }
    const int cur = t0 >> 6;
    {
        if (cur + 1 <= 16) {
            for (int idx = lane; idx < 256; idx += 64) sel[idx] = ((idx & 15) <= cur) ? (idx & 15) : -1;
        } else {
            for (int q = 0; q < 16; ++q) {
                unsigned key[4];
#pragma unroll
                for (int j = 0; j < 4; ++j) { const int blk = lane + 64 * j; const float v = imp[q * 256 + blk];
                    key[j] = (blk >= 1 && blk <= cur - 2) ? ((__float_as_uint(v) & 0xFFFFFF00u) | (unsigned)(255 - blk)) : 0u; }
                if (lane == 0) { sel[q * 16 + 0] = 0; sel[q * 16 + 1] = cur; sel[q * 16 + 2] = cur - 1; }
                for (int n = 3; n < 16; ++n) {
                    unsigned best = max(max(key[0], key[1]), max(key[2], key[3]));
#pragma unroll
                    for (int o = 1; o < 64; o <<= 1) best = max(best, (unsigned)__shfl_xor((int)best, o));
                    const int blk = 255 - (int)(best & 255u);
#pragma unroll
                    for (int j = 0; j < 4; ++j) if (lane + 64 * j == blk) key[j] = 0u;
                    if (lane == 0) sel[q * 16 + n] = blk;
                }
            }
        }
        wave_lds_sync();
    }
    float* acc = wl;
    {
#pragma unroll
        for (int h = 0; h < 4; ++h) { const float gs = sigmoidf_(grow[h]);
#pragma unroll
            for (int dt = 0; dt < 4; ++dt) *(f32x4*)(acc + (qi * 4 + h) * 64 + 16 * dt + 4 * grp) = st[h].o[dt] * gs; }
        wave_lds_sync();
    }
    {
        const bf16* KF = p.KWF + (size_t)g * T * 64; const bf16* VF = p.VWF + (size_t)g * T * 64;
        int kstart = t0 - 512; if (kstart < 0) kstart = 0; kstart &= ~31;
        const int nsteps = (t0 + 16 - kstart + 31) >> 5;
#pragma unroll
        for (int h = 0; h < 4; ++h) attw_init(st[h]);
        for (int s = 0; s < nsteps; ++s) {
            const int k0 = kstart + 32 * s;
            bf16x8 kf[2][2], vf[4];
#pragma unroll
            for (int tl = 0; tl < 2; ++tl)
#pragma unroll
                for (int ks = 0; ks < 2; ++ks) kf[tl][ks] = *(const bf16x8*)(KF + kfrag_off((k0 >> 4) + tl, ks, lane));
#pragma unroll
            for (int dt = 0; dt < 4; ++dt) vf[dt] = *(const bf16x8*)(VF + vfrag_off(k0 >> 5, dt, lane));
            const bool need_mask = (k0 + 31 > t0) || (k0 < t0 + 15 - 512);
            const int pb = k0 + 4 * grp;
#pragma unroll
            for (int h = 0; h < 4; ++h) {
                f32x4 s0, s1; qk_step(kf, qf[h], s0, s1);
                if (need_mask) {
#pragma unroll
                    for (int i = 0; i < 4; ++i) { const int p0 = pb + i, p1 = pb + 16 + i;
                        if (p0 > t || p0 < t - 512) s0[i] = -INFINITY; if (p1 > t || p1 < t - 512) s1[i] = -INFINITY; }
                }
                att_update(st[h], s0, s1, vf);
            }
        }
#pragma unroll
        for (int h = 0; h < 4; ++h) { const float lt = grp_sum(st[h].l); const float gs = sigmoidf_(grow[16 + h]) * (lt > 0.f ? 1.f / lt : 0.f);
#pragma unroll
            for (int dt = 0; dt < 4; ++dt) { f32x4* a = (f32x4*)(acc + (qi * 4 + h) * 64 + 16 * dt + 4 * grp); *a = *a + st[h].o[dt] * gs; } }
        wave_lds_sync();
    }
    *(int4*)(p.SEL + ((size_t)g * T + t0) * 16 + lane * 4) = *(const int4*)(sel + lane * 4);
#pragma unroll 4
    for (int q = 0; q < 16; ++q) *(f32x4*)(p.NSACC + (size_t)(t0 + q) * 512 + g * 256 + 4 * lane) = *(const f32x4*)(acc + q * 256 + 4 * lane);
    wave_lds_sync();
}

__device__ __forceinline__ void nsa_slc_item(const KP& p, int tq, int g, int lane) {
    asm volatile("" : "+v"(lane));
    const int l15 = lane & 15, grp = lane >> 4, hn = lane & 3;
    const bf16* KF = p.KSF + (size_t)g * T * 64; const bf16* VF = p.VSF + (size_t)g * T * 64;
    const int* selp = p.SEL + ((size_t)g * T + tq) * 16;
    int sb[16];
#pragma unroll
    for (int i = 0; i < 16; ++i) sb[i] = __builtin_amdgcn_readfirstlane(selp[i]);
    bf16x8 qs[2];
#pragma unroll
    for (int ks = 0; ks < 2; ++ks) qs[ks] = *(const bf16x8*)(p.QB + (size_t)tq * 512 + (g * 4 + hn) * 64 + 32 * ks + 8 * grp);
    AttW a; attw_init(a);
    bf16x8 kf[2][2][2], vf[2][4];
    auto issue = [&](int i, int buf) {
        const int blk = sb[i >> 1]; int k0 = blk * 64 + 32 * (i & 1); if (blk < 0 || k0 > tq) k0 = 0;
#pragma unroll
        for (int tl = 0; tl < 2; ++tl)
#pragma unroll
            for (int ks = 0; ks < 2; ++ks) kf[buf][tl][ks] = *(const bf16x8*)(KF + kfrag_off((k0 >> 4) + tl, ks, lane));
#pragma unroll
        for (int dt = 0; dt < 4; ++dt) vf[buf][dt] = *(const bf16x8*)(VF + vfrag_off(k0 >> 5, dt, lane));
    };
    issue(0, 0);
#pragma unroll
    for (int i = 0; i < 32; ++i) {
        const int buf = i & 1;
        if (i + 1 < 32) issue(i + 1, buf ^ 1);
        const int blk = sb[i >> 1]; const int k0 = blk * 64 + 32 * (i & 1);
        const bool dead = (blk < 0) || (k0 > tq);
        f32x4 s0, s1; qk_step(kf[buf], qs, s0, s1);
        const int pb = k0 + 4 * grp;
#pragma unroll
        for (int j = 0; j < 4; ++j) { if (dead || pb + j > tq) s0[j] = -INFINITY; if (dead || pb + 16 + j > tq) s1[j] = -INFINITY; }
        att_update(a, s0, s1, vf[buf]);
    }
    const float lt = grp_sum(a.l);
    if (l15 < 4) {
        const float gs = sigmoidf_(p.BIGF[(size_t)tq * PA + C_GATE + 8 + g * 4 + l15]) * (lt > 0.f ? 1.f / lt : 0.f);
#pragma unroll
        for (int dt = 0; dt < 4; ++dt) {
            const size_t o = (size_t)tq * 512 + g * 256 + l15 * 64 + 16 * dt + 4 * grp;
            const f32x4 base = *(const f32x4*)(p.NSACC + o); const f32x4 v = base + a.o[dt] * gs;
            uint2 w; w.x = pk2(v[0], v[1]); w.y = pk2(v[2], v[3]);
            *(uint2*)(p.MIXB + (size_t)tq * 1024 + g * 256 + l15 * 64 + 16 * dt + 4 * grp) = w;
        }
    }
}

__device__ __forceinline__ void ph_compress(const KP& p, const Fr& F) {
    float* flat = (float*)F.lds;
    float* hid = (float*)(F.lds + 32768);
    float* res = (float*)(F.lds + 32768 + 2048);
    const float* H0 = p.BIGF;
    const int tid = F.tid;
    for (int item = F.bid; item < 512; item += F.G) {
        const int c = item & 511, s = item >> 9;
        for (int e = tid; e < 8192; e += NTHR) {
            const int kv = e >> 12, g = (e >> 11) & 1, k = e & 2047, i = k >> 6, d = k & 63;
            const int row = c * 32 + i;
            float v;
            if (s == 0) v = H0[(size_t)row * PA + C_KC + kv * 128 + g * 64 + d];
            else { const int b = s - 1; const int page = p.page_table[b * NPAGES + (row >> 7)];
                   v = p.cache_cmp[((((size_t)page * 128 + (row & 127)) * 2 + kv) * 2 + g) * 64 + d]; }
            flat[e] = v + p.cpe[(kv * 32 + i) * 64 + d];
        }
        __syncthreads();
        {
            const int kv = tid >> 8, g = (tid >> 7) & 1, j = tid & 127;
            const float* w = p.cw1 + (size_t)kv * 2048 * 128 + j;
            const float* fl = flat + (kv * 2 + g) * 2048;
            float acc = p.cb1[kv * 128 + j];
            for (int k = 0; k < 2048; ++k) acc += fl[k] * w[(size_t)k * 128];
            hid[(kv * 2 + g) * 128 + j] = gelu_tanh(acc);
        }
        __syncthreads();
        if (tid < 256) {
            const int kv = tid >> 7, g = (tid >> 6) & 1, d = tid & 63;
            const float* w = p.cw2 + (size_t)kv * 128 * 64 + d;
            const float* hh = hid + (kv * 2 + g) * 128;
            float acc = 0.f;
            for (int j = 0; j < 128; ++j) acc += hh[j] * w[j * 64];
            res[(kv * 2 + g) * 64 + d] = acc;
        }
        __syncthreads();
        if (tid < 256) {
            const int kv = tid >> 7, g = (tid >> 6) & 1, d = tid & 63;
            const float* rr = res + (kv * 2 + g) * 64;
            float v = rr[d];
            if (kv == 0) {
                const int pos = (c + 1) * 32 - 1; const float2 cs = p.ROPE[pos * 32 + (d & 31)];
                const float x1 = rr[d & 31], x2 = rr[(d & 31) + 32];
                v = (d < 32) ? (x1 * cs.x - x2 * cs.y) : (x2 * cs.x + x1 * cs.y);
                p.CK[(((size_t)s * 512 + c) * 2 + g) * 64 + d] = v;
                if (s == 0) p.CKF[(size_t)g * 512 * 64 + kfrag_elem(c, d)] = (bf16)f2bf(v);
            } else { p.CV[(((size_t)s * 512 + c) * 2 + g) * 64 + d] = v; if (s == 0) p.CVF[(size_t)g * 512 * 64 + vfrag_elem(c, d)] = (bf16)f2bf(v); }
        }
        __syncthreads();
    }
}

__device__ __forceinline__ void ph_gdn_prep(const KP& p, const Fr& F) {
    const float* H0 = p.BIGF; const int lane = F.lane;
    for (int item = T * 8 + F.gw; item < TS * 8; item += F.NGW) {
        const int r = item >> 3, h = item & 7;
        const bool smp = r >= T; const int b = r - T;
        float cv[3];
#pragma unroll
        for (int part = 0; part < 3; ++part) {
            const int ch = part * 512 + h * 64 + lane;
            float acc = 0.f;
#pragma unroll
            for (int j = 0; j < 4; ++j) {
                float u;
                if (!smp) { const int t = r + j - 3; u = (t >= 0) ? H0[(size_t)t * PA + C_GQKV + ch] : 0.f; }
                else { u = (j < 3) ? p.st_gconv[((size_t)b * 3 + j) * 1536 + ch] : H0[(size_t)r * PA + C_GQKV + ch]; }
                acc += p.gconv_w[j * 1536 + ch] * u;
            }
            cv[part] = siluf_(acc);
        }
        const float qn = wave_sum(cv[0] * cv[0]), kn = wave_sum(cv[1] * cv[1]);
        const size_t o = ((size_t)r * 8 + h) * 64 + lane;
        p.GQ[o] = cv[0] * rsqrtf(qn + NORM_EPS) * 0.125f;
        p.GK[o] = cv[1] * rsqrtf(kn + NORM_EPS);
        p.GV[o] = cv[2];
        if (lane == 0) {
            const float av = H0[(size_t)r * PA + C_A + h], bt = H0[(size_t)r * PA + C_BT + h];
            p.Gg[(size_t)r * 8 + h] = -expf(p.gA[h]) * softplusf_(av + p.gdt[h]);
            p.Gb[(size_t)r * 8 + h] = sigmoidf_(bt);
        }
    }
    const size_t gt = (size_t)F.bid * NTHR + F.tid, GT = (size_t)F.G * NTHR;
    for (size_t idx = gt; idx < (size_t)3 * 1536; idx += GT) {
        const int j = (int)(idx / 1536), ch = (int)(idx % 1536);
        p.out[O_GCONV_P + idx] = H0[(size_t)(T - 3 + j) * PA + C_GQKV + ch];
    }
    for (size_t idx = gt; idx < (size_t)NSMP * 3 * 1536; idx += GT) {
        const int b = (int)(idx / (3 * 1536)), j = (int)((idx / 1536) % 3), ch = (int)(idx % 1536);
        p.out[O_GCONV_S + idx] = (j < 2) ? p.st_gconv[((size_t)b * 3 + j + 1) * 1536 + ch] : H0[(size_t)(T + b) * PA + C_GQKV + ch];
    }
}

template <int NH, class KF>
__device__ __forceinline__ void wave_attend(const float* qs, float* sc, int scstride, int nkeys, KF kf, float (&outv)[NH], float (&den)[NH], int lane) {
    float mx[NH];
#pragma unroll
    for (int h = 0; h < NH; ++h) mx[h] = -INFINITY;
    for (int j = lane; j < nkeys; j += 64) {
        const float *kp, *vp; const bool ok = kf(j, kp, vp);
        float s[NH];
#pragma unroll
        for (int h = 0; h < NH; ++h) s[h] = 0.f;
        if (ok) {
            for (int d4 = 0; d4 < 16; ++d4) {
                const float4 kvv = ((const float4*)kp)[d4];
#pragma unroll
                for (int h = 0; h < NH; ++h) { const float* q = qs + h * 64 + d4 * 4; s[h] += kvv.x * q[0] + kvv.y * q[1] + kvv.z * q[2] + kvv.w * q[3]; }
            }
        }
#pragma unroll
        for (int h = 0; h < NH; ++h) { const float v = ok ? s[h] * 0.125f : -INFINITY; sc[h * scstride + j] = v; mx[h] = fmaxf(mx[h], v); }
    }
#pragma unroll
    for (int h = 0; h < NH; ++h) { mx[h] = wave_max(mx[h]); if (!(mx[h] > -INFINITY)) mx[h] = 0.f; }
    float sm[NH];
#pragma unroll
    for (int h = 0; h < NH; ++h) sm[h] = 0.f;
    for (int j = lane; j < nkeys; j += 64) {
#pragma unroll
        for (int h = 0; h < NH; ++h) { const float v = sc[h * scstride + j]; const float pp = (v == -INFINITY) ? 0.f : expf(v - mx[h]); sc[h * scstride + j] = pp; sm[h] += pp; }
    }
#pragma unroll
    for (int h = 0; h < NH; ++h) { sm[h] = wave_sum(sm[h]); den[h] = sm[h] > 0.f ? sm[h] : 1.f; }
    wave_lds_sync();
    {
        const int kq = lane >> 4, d4 = lane & 15;
        float4 acc[NH];
#pragma unroll
        for (int h = 0; h < NH; ++h) acc[h] = make_float4(0.f, 0.f, 0.f, 0.f);
        for (int j0 = 0; j0 < nkeys; j0 += 32) {
            float4 v[8];
#pragma unroll
            for (int u = 0; u < 8; ++u) { const int j = j0 + 4 * u + kq; const float *kp, *vp; const bool ok = (j < nkeys) && kf(j, kp, vp);
                v[u] = ok ? *(const float4*)(vp + 4 * d4) : make_float4(0.f, 0.f, 0.f, 0.f); }
#pragma unroll
            for (int u = 0; u < 8; ++u) { const int j = j0 + 4 * u + kq;
#pragma unroll
                for (int h = 0; h < NH; ++h) { const float pp = (j < nkeys) ? sc[h * scstride + j] : 0.f;
                    acc[h].x += pp * v[u].x; acc[h].y += pp * v[u].y; acc[h].z += pp * v[u].z; acc[h].w += pp * v[u].w; } }
        }
#pragma unroll
        for (int h = 0; h < NH; ++h) {
            float4 a = acc[h];
            a.x += __shfl_xor(a.x, 16); a.y += __shfl_xor(a.y, 16); a.z += __shfl_xor(a.z, 16); a.w += __shfl_xor(a.w, 16);
            a.x += __shfl_xor(a.x, 32); a.y += __shfl_xor(a.y, 32); a.z += __shfl_xor(a.z, 32); a.w += __shfl_xor(a.w, 32);
            const float x0 = __shfl(a.x, lane >> 2), x1 = __shfl(a.y, lane >> 2), x2 = __shfl(a.z, lane >> 2), x3 = __shfl(a.w, lane >> 2);
            const int cc = lane & 3; outv[h] = cc == 0 ? x0 : (cc == 1 ? x1 : (cc == 2 ? x2 : x3));
        }
    }
#pragma unroll
    for (int h = 0; h < NH; ++h) outv[h] /= den[h];
    wave_lds_sync();
}

__device__ __forceinline__ void nsa_smp_cs(const KP& p, int b, int g, float* wl, int lane) {
    float* qs = wl; float* sc = wl + 256; float* imp = wl + 256 + 4 * 1088; int* sel = (int*)(wl + 256 + 4 * 1088 + 320); long long* bb = (long long*)(wl + 256 + 4 * 1088 + 320 + 16);
    const int r = T + b; const int qpos = T;
    const float* grow = p.BIGF + (size_t)r * PA + C_GATE;
#pragma unroll
    for (int h = 0; h < 4; ++h) qs[h * 64 + lane] = p.QR[(size_t)r * 512 + (g * 4 + h) * 64 + lane];
    wave_lds_sync();
    float ocmp[4], oslc[4], den[4];
    {
        const float* CKp = p.CK + (size_t)(1 + b) * 512 * 128; const float* CVp = p.CV + (size_t)(1 + b) * 512 * 128;
        auto kf = [&](int j, const float*& kp, const float*& vp) -> bool { kp = CKp + (j * 2 + g) * 64; vp = CVp + (j * 2 + g) * 64; return true; };
        wave_attend<4>(qs, sc, 1088, 512, kf, ocmp, den, lane);
        for (int blk = lane; blk < 320; blk += 64) {
            float v = 0.f;
            if (blk < 256) {
#pragma unroll
                for (int h = 0; h < 4; ++h) v += (sc[h * 1088 + 2 * blk] + sc[h * 1088 + 2 * blk + 1]) / den[h];
            }
            imp[blk] = v;
        }
        wave_lds_sync();
    }
    {
        const int cur = qpos >> 6;
        float val[5];
#pragma unroll
        for (int j = 0; j < 5; ++j) { const int blk = lane + 64 * j; val[j] = (blk >= 1 && blk <= cur - 2) ? imp[blk] : -1.f; }
        if (lane == 0) { sel[0] = 0; sel[1] = cur; sel[2] = cur - 1; }
        for (int n = 3; n < 16; ++n) {
            float bv = -2.f; int bi = 0x7fffffff;
#pragma unroll
            for (int j = 0; j < 5; ++j) if (val[j] > bv) { bv = val[j]; bi = lane + 64 * j; }
#pragma unroll
            for (int o = 1; o < 64; o <<= 1) { const float ov = __shfl_xor(bv, o); const int oi = __shfl_xor(bi, o); if (ov > bv || (ov == bv && oi < bi)) { bv = ov; bi = oi; } }
#pragma unroll
            for (int j = 0; j < 5; ++j) if (lane + 64 * j == bi) val[j] = -3.f;
            if (lane == 0) sel[n] = bi;
        }
        wave_lds_sync();
        if (lane < 16) { const int blk = sel[lane]; long long o = 0;
            if (blk < 256) { const int page = p.page_table[b * NPAGES + (blk >> 1)]; o = ((long long)page * 128 + (blk & 1) * 64) * 256; }
            bb[lane] = o; }
        wave_lds_sync();
    }
    {
        auto kf = [&](int j, const float*& kp, const float*& vp) -> bool {
            const int blk = sel[j >> 6]; const int pos = blk * 64 + (j & 63); if (pos > qpos) return false;
            if (pos == T) { kp = p.KS + (size_t)r * 128 + g * 64; vp = p.VS + (size_t)r * 128 + g * 64; return true; }
            const float* base = p.cache_slc + bb[j >> 6] + (j & 63) * 256;
            kp = base + g * 64; vp = base + 128 + g * 64; return true; };
        wave_attend<4>(qs, sc, 1088, 1024, kf, oslc, den, lane);
    }
#pragma unroll
    for (int h = 0; h < 4; ++h) {
        const int hh = g * 4 + h;
        p.SMIXF[((size_t)b * 3 + 0) * 512 + hh * 64 + lane] = sigmoidf_(grow[hh]) * ocmp[h];
        p.SMIXF[((size_t)b * 3 + 1) * 512 + hh * 64 + lane] = sigmoidf_(grow[8 + hh]) * oslc[h];
    }
    wave_lds_sync();
}
__device__ __forceinline__ void nsa_smp_win(const KP& p, int b, int g, float* wl, int lane) {
    float* qs = wl; float* sc = wl + 256;
    const int r = T + b;
    const float* grow = p.BIGF + (size_t)r * PA + C_GATE;
#pragma unroll
    for (int h = 0; h < 4; ++h) qs[h * 64 + lane] = p.QR[(size_t)r * 512 + (g * 4 + h) * 64 + lane];
    wave_lds_sync();
    float owin[4], den[4];
    auto kf = [&](int j, const float*& kp, const float*& vp) -> bool {
        if (j == 512) { kp = p.KW + (size_t)r * 128 + g * 64; vp = p.VW + (size_t)r * 128 + g * 64; return true; }
        const float* base = p.st_win + ((size_t)b * 512 + j) * 256;
        kp = base + g * 64; vp = base + 128 + g * 64; return true; };
    wave_attend<4>(qs, sc, 528, 513, kf, owin, den, lane);
#pragma unroll
    for (int h = 0; h < 4; ++h) { const int hh = g * 4 + h; p.SMIXF[((size_t)b * 3 + 2) * 512 + hh * 64 + lane] = sigmoidf_(grow[16 + hh]) * owin[h]; }
    wave_lds_sync();
}

__device__ __forceinline__ void gdn_scan_item(const KP& p, int item, float* wl, int lane) {
    asm volatile("" : "+v"(lane));
    float* kq = wl;
    const int b = (item >> 3) - 1, h = item & 7;
    const int r = T + b; const size_t o = ((size_t)r * 8 + h) * 64;
    kq[lane] = p.GK[o + lane]; kq[64 + lane] = p.GQ[o + lane];
    wave_lds_sync();
    const float dec = expf(p.Gg[(size_t)r * 8 + h]), bt = p.Gb[(size_t)r * 8 + h];
    const float* Sp = p.st_gS + ((size_t)b * 8 + h) * 4096 + lane;
    float* so = p.out + O_GS_S + ((size_t)b * 8 + h) * 4096 + lane;
    float S[64]; float kv = 0.f;
#pragma unroll
    for (int i = 0; i < 64; ++i) { S[i] = Sp[i * 64] * dec; kv += kq[i] * S[i]; }
    const float vn = (p.GV[o + lane] - kv) * bt;
    float ov = 0.f;
#pragma unroll
    for (int i = 0; i < 64; ++i) { const float sn = S[i] + kq[i] * vn; ov += kq[64 + i] * sn; so[i * 64] = sn; }
    p.OG[o + lane] = ov;
    wave_lds_sync();
}

constexpr int GDN_WL = 34816;
__device__ __forceinline__ int kperm(int ks, int grp, int j) { return 32 * ks + 16 * (j >> 2) + 4 * grp + (j & 3); }

__device__ __forceinline__ void gdn_chunk_unit(const KP& p, int unit, unsigned char* ldsb, int woff, int lane) {
    asm volatile("" : "+v"(lane), "+s"(woff));
    unsigned char* wlb = ldsb + woff;
    const int n = unit >> 3, h = unit & 7, t0 = 64 * n;
    const int l15 = lane & 15, grp = lane >> 4;
    float* Af = (float*)wlb; bf16* kt = (bf16*)(wlb + 16384); bf16* qt = kt + 64 * 72; bf16* tmp = (bf16*)wlb;
    {
        const float* H0 = p.BIGF;
        float w[3][4], u1[3], u2[3], u3[3];
#pragma unroll
        for (int part = 0; part < 3; ++part) {
            const int ch = part * 512 + h * 64 + lane;
#pragma unroll
            for (int j = 0; j < 4; ++j) w[part][j] = p.gconv_w[j * 1536 + ch];
            u1[part] = (t0 >= 1) ? H0[(size_t)(t0 - 1) * PA + C_GQKV + ch] : 0.f;
            u2[part] = (t0 >= 2) ? H0[(size_t)(t0 - 2) * PA + C_GQKV + ch] : 0.f;
            u3[part] = (t0 >= 3) ? H0[(size_t)(t0 - 3) * PA + C_GQKV + ch] : 0.f;
        }
        int roff = 0;
#pragma unroll 4
        for (int i = 0; i < 64; ++i) {
            float cv[3];
#pragma unroll
            for (int part = 0; part < 3; ++part) {
                const float u0 = H0[(size_t)t0 * PA + C_GQKV + part * 512 + h * 64 + lane + roff];
                cv[part] = siluf_(w[part][0] * u3[part] + w[part][1] * u2[part] + w[part][2] * u1[part] + w[part][3] * u0);
                u3[part] = u2[part]; u2[part] = u1[part]; u1[part] = u0;
            }
            roff += PA; asm volatile("" : "+s"(roff));
            const float qn = wave_sum(cv[0] * cv[0]), kn = wave_sum(cv[1] * cv[1]);
            qt[i * 72 + lane] = (bf16)f2bf(cv[0] * rsqrtf(qn + NORM_EPS) * 0.125f);
            kt[i * 72 + lane] = (bf16)f2bf(cv[1] * rsqrtf(kn + NORM_EPS));
            p.GV[((size_t)(t0 + i) * 8 + h) * 64 + lane] = cv[2];
        }
    }
    const float gl_ = -expf(p.gA[h]) * softplusf_(p.BIGF[(size_t)(t0 + lane) * PA + C_A + h] + p.gdt[h]);
    const float beta = sigmoidf_(p.BIGF[(size_t)(t0 + lane) * PA + C_BT + h]);
    float gc = gl_;
#pragma unroll
    for (int o = 1; o < 64; o <<= 1) { const float tv = __shfl_up(gc, o); if (lane >= o) gc += tv; }
    const float gclast = __shfl(gc, 63);
#define GPAD(i) ((float*)(kt + (i) * 72 + 64))
    { float* pd = GPAD(lane); pd[0] = gc; pd[1] = beta; pd[2] = expf(gc); pd[3] = expf(gclast - gc); }
    wave_lds_sync();
    bf16* QKF = p.G_QKF + (size_t)unit * 4096;
#pragma unroll
    for (int it = 0; it < 4; ++it) {
        const int i = 16 * it + l15;
        const float gci = GPAD(i)[0], bi = GPAD(i)[1];
        bf16x8 bk[2], bq[2];
#pragma unroll
        for (int ks = 0; ks < 2; ++ks) { bk[ks] = *(const bf16x8*)(kt + i * 72 + 32 * ks + 8 * grp); bq[ks] = *(const bf16x8*)(qt + i * 72 + 32 * ks + 8 * grp); }
#pragma unroll
        for (int jt = 0; jt < 4; ++jt) {
            uint2 qkp = make_uint2(0u, 0u);
            if (jt <= it) {
                bf16x8 ak[2];
#pragma unroll
                for (int ks = 0; ks < 2; ++ks) ak[ks] = *(const bf16x8*)(kt + (16 * jt + l15) * 72 + 32 * ks + 8 * grp);
                f32x4 aa = {0.f, 0.f, 0.f, 0.f}, aq = {0.f, 0.f, 0.f, 0.f};
                aa = MFMA16(ak[0], bk[0], aa); aa = MFMA16(ak[1], bk[1], aa);
                aq = MFMA16(ak[0], bq[0], aq); aq = MFMA16(ak[1], bq[1], aq);
                f32x4 av, qv;
#pragma unroll
                for (int r = 0; r < 4; ++r) {
                    const int j = 16 * jt + 4 * grp + r; const float gcj = GPAD(j)[0];
                    const float e = (j <= i) ? expf(gci - gcj) : 0.f;
                    av[r] = (j < i) ? bi * aa[r] * e : 0.f; qv[r] = aq[r] * e;
                }
                *(f32x4*)(Af + i * 64 + 16 * jt + 4 * grp) = av;
                qkp.x = pk2(qv[0], qv[1]); qkp.y = pk2(qv[2], qv[3]);
            }
            *(uint2*)(QKF + ((size_t)(it * 2 + (jt >> 1)) * 64 + lane) * 8 + (jt & 1) * 4) = qkp;
        }
    }
    wave_lds_sync();
    {
        float* UF = p.G_UF + (size_t)unit * 4096;
        const int vq = lane >> 4;
#pragma unroll
        for (int pass = 0; pass < 2; ++pass) {
            float x[64];
            int goff = 0;
#pragma unroll
            for (int i = 0; i < 64; ++i) {
                const float bi = GPAD(i)[1];
                float acc;
                if (pass == 0) { acc = p.GV[((size_t)t0 * 8 + h) * 64 + lane + goff] * bi; goff += 512; asm volatile("" : "+s"(goff)); }
                else { const float ei = GPAD(i)[2];
                       acc = __uint_as_float((unsigned)kt[i * 72 + lane] << 16) * bi * ei; }
#pragma unroll
                for (int jj = 0; jj < (i + 3) / 4; ++jj) {
                    const float4 a4 = *(const float4*)(Af + i * 64 + 4 * jj);
                    acc -= a4.x * x[4 * jj + 0];
                    if (4 * jj + 1 < i) acc -= a4.y * x[4 * jj + 1];
                    if (4 * jj + 2 < i) acc -= a4.z * x[4 * jj + 2];
                    if (4 * jj + 3 < i) acc -= a4.w * x[4 * jj + 3];
                }
                x[i] = acc;
                if ((i & 3) == 3) asm volatile("" ::: "memory");
            }
            if (pass == 0) {
#pragma unroll
                for (int c4 = 0; c4 < 16; ++c4) {
                    const int mt = c4 >> 2, lp = l15 + 16 * (c4 & 3);
                    *(f32x4*)(UF + ((size_t)(vq * 4 + mt) * 64 + lp) * 4) = (f32x4){x[4 * c4], x[4 * c4 + 1], x[4 * c4 + 2], x[4 * c4 + 3]};
                }
            } else {
                wave_lds_sync();
#pragma unroll
                for (int c = 0; c < 64; ++c) tmp[c * 72 + lane] = (bf16)f2bf(-x[c]);
            }
            asm volatile("" ::: "memory");
        }
    }
    wave_lds_sync();
    {
        bf16* WF = p.G_WF + (size_t)unit * 4096; bf16* QGF = p.G_QGF + (size_t)unit * 4096; bf16* KDF = p.G_KDF + (size_t)unit * 4096;
#pragma unroll
        for (int mt = 0; mt < 4; ++mt) {
            const float egc = GPAD(16 * mt + l15)[2];
#pragma unroll
            for (int ks = 0; ks < 2; ++ks) {
                const int c = 16 * mt + l15, k0 = 32 * ks + 4 * grp;
                const uint2 w0 = *(const uint2*)(tmp + c * 72 + k0), w1 = *(const uint2*)(tmp + c * 72 + k0 + 16);
                v4u wv; wv.x = w0.x; wv.y = w0.y; wv.z = w1.x; wv.w = w1.y;
                *(v4u*)(WF + ((size_t)(mt * 2 + ks) * 64 + lane) * 8) = wv;
                const uint2 q0 = *(const uint2*)(qt + c * 72 + k0), q1 = *(const uint2*)(qt + c * 72 + k0 + 16);
                v4u qv;
                qv.x = pk2(__uint_as_float(q0.x << 16) * egc, __uint_as_float(q0.x & 0xffff0000u) * egc); qv.y = pk2(__uint_as_float(q0.y << 16) * egc, __uint_as_float(q0.y & 0xffff0000u) * egc);
                qv.z = pk2(__uint_as_float(q1.x << 16) * egc, __uint_as_float(q1.x & 0xffff0000u) * egc); qv.w = pk2(__uint_as_float(q1.y << 16) * egc, __uint_as_float(q1.y & 0xffff0000u) * egc);
                *(v4u*)(QGF + ((size_t)(mt * 2 + ks) * 64 + lane) * 8) = qv;
                float kd[8];
#pragma unroll
                for (int j = 0; j < 8; ++j) { const int cc = kperm(ks, grp, j); kd[j] = __uint_as_float((unsigned)kt[cc * 72 + 16 * mt + l15] << 16) * GPAD(cc)[3]; }
                v4u kv; kv.x = pk2(kd[0], kd[1]); kv.y = pk2(kd[2], kd[3]); kv.z = pk2(kd[4], kd[5]); kv.w = pk2(kd[6], kd[7]);
                *(v4u*)(KDF + ((size_t)(mt * 2 + ks) * 64 + lane) * 8) = kv;
            }
        }
        if (lane == 0) p.G_GL[unit] = expf(gclast);
    }
    wave_lds_sync();
#undef GPAD
}

constexpr int CH_SLOT = 32768;
__device__ __forceinline__ void gdn_chain_wg(const KP& p, int h, int wave, int lane, unsigned char* ldsb) {
    asm volatile("" : "+v"(lane));
    const int l15 = lane & 15, grp = lane >> 4;
    float* GLs = (float*)(ldsb + 4 * CH_SLOT);
    if (wave < 4) GLs[wave * 64 + lane] = p.G_GL[(size_t)(wave * 64 + lane) * 8 + h];
#define CH_BAR() do { asm volatile("s_waitcnt lgkmcnt(0)" ::: "memory"); __builtin_amdgcn_s_barrier(); asm volatile("" ::: "memory"); } while (0)
    if (wave >= 4) {
        const int lw = wave - 4;
        const unsigned char* gb = (lw == 0) ? (const unsigned char*)p.G_WF : (lw == 1) ? (const unsigned char*)p.G_KDF : (const unsigned char*)p.G_UF + (size_t)(lw - 2) * 8192;
        const size_t ustride = (lw < 2) ? 8192 : 16384;
        gb += (size_t)h * ustride + (size_t)lane * 16;
        auto src = [&](int n, int k) -> const v4u* { return (const v4u*)(gb + (size_t)n * 8 * ustride + k * 1024); };
        v4u rs[4][8];
#pragma unroll
        for (int j = 0; j < 4; ++j)
#pragma unroll
            for (int k = 0; k < 8; ++k) rs[j][k] = *src(j, k);
#pragma unroll
        for (int j = 0; j < 2; ++j) {
#pragma unroll
            for (int k = 0; k < 8; ++k) { *(v4u*)(ldsb + j * CH_SLOT + (lw * 512 + k * 64 + lane) * 16) = rs[j][k]; rs[j][k] = *src(4 + j, k); }
        }
        CH_BAR();
        for (int n0 = 0; n0 < 256; n0 += 4) {
#pragma unroll
            for (int j = 0; j < 4; ++j) {
                const int n = n0 + j, st = n + 2;
                if (st < 256) {
                    const int set = (j + 2) & 3;
#pragma unroll
                    for (int k = 0; k < 8; ++k) { *(v4u*)(ldsb + (st & 3) * CH_SLOT + (lw * 512 + k * 64 + lane) * 16) = rs[set][k]; if (st + 4 < 256) rs[set][k] = *src(st + 4, k); }
                }
                CH_BAR();
            }
        }
#undef CH_BAR
        return;
    }
    const int vq = wave;
    f32x4 S[4];
#pragma unroll
    for (int i = 0; i < 4; ++i) S[i] = (f32x4){0.f, 0.f, 0.f, 0.f};
    asm volatile("s_waitcnt lgkmcnt(0)" ::: "memory"); __builtin_amdgcn_s_barrier(); asm volatile("" ::: "memory");
    for (int n = 0; n < 256; ++n) {
        const unsigned char* sl = ldsb + (n & 3) * CH_SLOT;
        bf16x8 wf[4][2], kdf[4][2]; f32x4 uf[4];
#pragma unroll
        for (int mt = 0; mt < 4; ++mt) {
#pragma unroll
            for (int ks = 0; ks < 2; ++ks) { wf[mt][ks] = *(const bf16x8*)(sl + ((mt * 2 + ks) * 64 + lane) * 16); kdf[mt][ks] = *(const bf16x8*)(sl + 8192 + ((mt * 2 + ks) * 64 + lane) * 16); }
            uf[mt] = *(const f32x4*)(sl + 16384 + ((vq * 4 + mt) * 64 + lane) * 16);
        }
        const float gl = GLs[n];
        const size_t fo = ((size_t)((n * 8 + h) * 4 + vq) * 2) * 512;
        bf16x8 sB[2];
#pragma unroll
        for (int ks = 0; ks < 2; ++ks) { sB[ks] = pack_p(S[2 * ks], S[2 * ks + 1]); *(bf16x8*)(p.G_SPF + fo + ((size_t)ks * 64 + lane) * 8) = sB[ks]; }
        f32x4 v[4];
#pragma unroll
        for (int mt = 0; mt < 4; ++mt) { v[mt] = uf[mt]; v[mt] = MFMA16(wf[mt][0], sB[0], v[mt]); v[mt] = MFMA16(wf[mt][1], sB[1], v[mt]); }
        bf16x8 vB[2];
#pragma unroll
        for (int ks = 0; ks < 2; ++ks) { vB[ks] = pack_p(v[2 * ks], v[2 * ks + 1]); *(bf16x8*)(p.G_VNF + fo + ((size_t)ks * 64 + lane) * 8) = vB[ks]; }
#pragma unroll
        for (int mt = 0; mt < 4; ++mt) { S[mt] = S[mt] * gl; S[mt] = MFMA16(kdf[mt][0], vB[0], S[mt]); S[mt] = MFMA16(kdf[mt][1], vB[1], S[mt]); }
        asm volatile("s_waitcnt lgkmcnt(0)" ::: "memory"); __builtin_amdgcn_s_barrier(); asm volatile("" ::: "memory");
    }
    float* so = p.out + O_GS_P + (size_t)h * 4096;
#pragma unroll
    for (int mt = 0; mt < 4; ++mt)
#pragma unroll
        for (int r = 0; r < 4; ++r) so[(16 * mt + 4 * grp + r) * 64 + 16 * vq + l15] = S[mt][r];
}

__device__ __forceinline__ void gdn_out_unit(const KP& p, int unit, int lane) {
    asm volatile("" : "+v"(lane));
    const int n = unit >> 3, h = unit & 7, t0 = 64 * n; const int l15 = lane & 15, grp = lane >> 4;
    const bf16* QGF = p.G_QGF + (size_t)unit * 4096; const bf16* QKF = p.G_QKF + (size_t)unit * 4096;
    f32x4 o[4][4];
#pragma unroll
    for (int mt = 0; mt < 4; ++mt)
#pragma unroll
        for (int vq = 0; vq < 4; ++vq) o[mt][vq] = (f32x4){0.f, 0.f, 0.f, 0.f};
#pragma unroll
    for (int ks = 0; ks < 2; ++ks) {
        bf16x8 sp[4], vn[4];
#pragma unroll
        for (int vq = 0; vq < 4; ++vq) { const size_t fo = ((size_t)(unit * 4 + vq) * 2 + ks) * 512 + (size_t)lane * 8; sp[vq] = *(const bf16x8*)(p.G_SPF + fo); vn[vq] = *(const bf16x8*)(p.G_VNF + fo); }
#pragma unroll
        for (int mt = 0; mt < 4; ++mt) {
            const bf16x8 qg = *(const bf16x8*)(QGF + ((size_t)(mt * 2 + ks) * 64 + lane) * 8), qk = *(const bf16x8*)(QKF + ((size_t)(mt * 2 + ks) * 64 + lane) * 8);
#pragma unroll
            for (int vq = 0; vq < 4; ++vq) { o[mt][vq] = MFMA16(qg, sp[vq], o[mt][vq]); o[mt][vq] = MFMA16(qk, vn[vq], o[mt][vq]); }
        }
    }
    float nw[4];
#pragma unroll
    for (int vq = 0; vq < 4; ++vq) nw[vq] = p.gnw[16 * vq + l15];
#pragma unroll
    for (int mt = 0; mt < 4; ++mt)
#pragma unroll
        for (int r = 0; r < 4; ++r) {
            float ss = 0.f;
#pragma unroll
            for (int vq = 0; vq < 4; ++vq) ss += o[mt][vq][r] * o[mt][vq][r];
            ss += __shfl_xor(ss, 1); ss += __shfl_xor(ss, 2); ss += __shfl_xor(ss, 4); ss += __shfl_xor(ss, 8);
            const float rs = rsqrtf(ss * (1.f / 64.f) + NORM_EPS);
            const int t = t0 + 16 * mt + 4 * grp + r;
            const float* zr = p.BIGF + (size_t)t * PA + C_Z + h * 64;
#pragma unroll
            for (int vq = 0; vq < 4; ++vq) p.MIXB[(size_t)t * 1024 + 512 + h * 64 + 16 * vq + l15] = (bf16)f2bf(o[mt][vq][r] * rs * nw[vq] * siluf_(zr[16 * vq + l15]));
        }
}

#define MFMA8(a, b, c) __builtin_amdgcn_mfma_f32_16x16x32_fp8_fp8((a), (b), (c), 0, 0, 0)
__device__ __forceinline__ long pack_fp8(const f32x4& a, const f32x4& b) {
    int w0 = 0, w1 = 0;
    w0 = __builtin_amdgcn_cvt_pk_fp8_f32(a[0], a[1], w0, false); w0 = __builtin_amdgcn_cvt_pk_fp8_f32(a[2], a[3], w0, true);
    w1 = __builtin_amdgcn_cvt_pk_fp8_f32(b[0], b[1], w1, false); w1 = __builtin_amdgcn_cvt_pk_fp8_f32(b[2], b[3], w1, true);
    return (long)(((unsigned long long)(unsigned)w1 << 32) | (unsigned long long)(unsigned)w0);
}
template <bool GEN>
__device__ __forceinline__ void nsa_slc_item8(const KP& p, int tq, int g, int lane) {
    asm volatile("" : "+v"(lane));
    const int l15 = lane & 15, grp = lane >> 4, hn = lane & 3;
    const unsigned char* KF = p.KS8 + (size_t)g * T * 64; const unsigned char* VF = p.VS8 + (size_t)g * T * 64;
    const int* selp = p.SEL + ((size_t)g * T + tq) * 16;
    int sb[16];
#pragma unroll
    for (int i = 0; i < 16; ++i) sb[i] = __builtin_amdgcn_readfirstlane(selp[i]);
    long qs[2];
#pragma unroll
    for (int ks = 0; ks < 2; ++ks) {
        const bf16x8 qb = *(const bf16x8*)(p.QB + (size_t)tq * 512 + (g * 4 + hn) * 64 + 32 * ks + 8 * grp);
        f32x4 a, b;
#pragma unroll
        for (int j = 0; j < 4; ++j) { a[j] = __uint_as_float((unsigned)(unsigned short)qb[j] << 16) * (1.f / QSCALE); b[j] = __uint_as_float((unsigned)(unsigned short)qb[4 + j] << 16) * (1.f / QSCALE); }
        qs[ks] = pack_fp8(a, b);
    }
    AttW a; attw_init(a);
    long kf[3][4][2], vf[3][2][4];
    auto issue = [&](int bi, int buf) {
        int blk = sb[bi]; if (GEN && (blk < 0 || blk * 64 > tq)) blk = 0;
        typedef long l2_t __attribute__((ext_vector_type(2)));
#pragma unroll
        for (int tl = 0; tl < 4; ++tl) { const l2_t x = *(const l2_t*)(KF + ((size_t)(blk * 4 + tl) * 64 + lane) * 16); kf[buf][tl][0] = x[0]; kf[buf][tl][1] = x[1]; }
#pragma unroll
        for (int dt = 0; dt < 4; ++dt) { const l2_t x = *(const l2_t*)(VF + ((size_t)(blk * 4 + dt) * 64 + lane) * 16); vf[buf][0][dt] = x[0]; vf[buf][1][dt] = x[1]; }
    };
    issue(0, 0); issue(1, 1);
#pragma unroll
    for (int bi = 0; bi < 16; ++bi) {
        const int buf = bi % 3;
        if (bi + 2 < 16) issue(bi + 2, (bi + 2) % 3);
        const int blk = sb[bi]; const int k0 = blk * 64;
        if (GEN && (blk < 0 || k0 > tq)) continue;
        const f32x4 z = {0.f, 0.f, 0.f, 0.f};
        f32x4 sc[4];
#pragma unroll
        for (int tl = 0; tl < 4; ++tl) { sc[tl] = MFMA8(kf[buf][tl][0], qs[0], z); sc[tl] = MFMA8(kf[buf][tl][1], qs[1], sc[tl]); }
        if (GEN ? (k0 + 63 > tq) : (bi == 1)) {
#pragma unroll
            for (int tl = 0; tl < 4; ++tl)
#pragma unroll
                for (int j = 0; j < 4; ++j) if (k0 + 16 * tl + 4 * grp + j > tq) sc[tl][j] = -INFINITY;
        }
        float mx = fmaxf(fmaxf(fmaxf(fmaxf(sc[0][0], sc[0][1]), fmaxf(sc[0][2], sc[0][3])), fmaxf(fmaxf(sc[1][0], sc[1][1]), fmaxf(sc[1][2], sc[1][3]))),
                         fmaxf(fmaxf(fmaxf(sc[2][0], sc[2][1]), fmaxf(sc[2][2], sc[2][3])), fmaxf(fmaxf(sc[3][0], sc[3][1]), fmaxf(sc[3][2], sc[3][3]))));
        mx = fmaxf(mx, __shfl_xor(mx, 16)); mx = fmaxf(mx, __shfl_xor(mx, 32));
        const float mn = fmaxf(a.m, mx * QSCALE);
        const float alpha = __builtin_amdgcn_exp2f(a.m - mn);
        const float mb = 7.f - mn;
        f32x4 pp[4]; float sum = 0.f;
#pragma unroll
        for (int tl = 0; tl < 4; ++tl) {
#pragma unroll
            for (int j = 0; j < 4; ++j) pp[tl][j] = __builtin_amdgcn_exp2f(fmaf(sc[tl][j], QSCALE, mb));
            sum += (pp[tl][0] + pp[tl][1]) + (pp[tl][2] + pp[tl][3]);
        }
        a.l = a.l * alpha + sum; a.m = mn;
        const long pf0 = pack_fp8(pp[0], pp[1]), pf1 = pack_fp8(pp[2], pp[3]);
#pragma unroll
        for (int dt = 0; dt < 4; ++dt) { a.o[dt] = a.o[dt] * alpha; a.o[dt] = MFMA8(vf[buf][0][dt], pf0, a.o[dt]); a.o[dt] = MFMA8(vf[buf][1][dt], pf1, a.o[dt]); }
    }
    const float lt = grp_sum(a.l);
    if (l15 < 4) {
        const float gs = sigmoidf_(p.BIGF[(size_t)tq * PA + C_GATE + 8 + g * 4 + l15]) * (lt > 0.f ? 1.f / lt : 0.f);
#pragma unroll
        for (int dt = 0; dt < 4; ++dt) {
            const size_t o = (size_t)tq * 512 + g * 256 + l15 * 64 + 16 * dt + 4 * grp;
            const f32x4 base = *(const f32x4*)(p.NSACC + o); const f32x4 v = base + a.o[dt] * gs;
            uint2 w; w.x = pk2(v[0], v[1]); w.y = pk2(v[2], v[3]);
            *(uint2*)(p.MIXB + (size_t)tq * 1024 + g * 256 + l15 * 64 + 16 * dt + 4 * grp) = w;
        }
    }
}

__device__ __forceinline__ void ph_gdn_chunks(const KP& p, const Fr& F) {
    if (F.wave < 4) for (int unit = F.bid * 4 + F.wave; unit < 2048; unit += F.G * 4) gdn_chunk_unit(p, unit, F.lds, F.wave * GDN_WL, F.lane);
    else { const int unit = F.bid * 4 + (F.wave - 4); if (unit < 128) cmp_prompt_unit(p, unit, F.lane); }
}
__device__ __forceinline__ void ph_mix_a(const KP& p, const Fr& F) {
    if (F.bid < 32) gdn_scan_item(p, (F.bid + 1) * 8 + F.wave, (float*)(F.lds + 8 * FAST_WL + 1024 + F.wave * 512), F.lane);
    float* wl = (float*)(F.lds + F.wave * FAST_WL);
    for (int unit = F.gw; unit < 2048; unit += F.NGW) nsa_fast_unit(p, unit, wl, F.lane);
}
__device__ __forceinline__ void ph_mix_b(const KP& p, const Fr& F) {
    if (F.bid < 8) { gdn_chain_wg(p, F.bid, F.wave, F.lane, F.lds); return; }
    if (F.bid < 24) {
        const int it = (F.bid - 8) * 4 + (F.wave & 3);
        if (F.wave < 4) nsa_smp_cs(p, it >> 1, it & 1, (float*)(F.lds + F.wave * 20480), F.lane);
        else nsa_smp_win(p, it >> 1, it & 1, (float*)(F.lds + 81920 + (F.wave - 4) * 12288), F.lane);
        return;
    }
    const int g = F.bid & 1, fr = (F.bid - 24) >> 1, NW = ((F.G - 24) >> 1) * 8;
    for (int tq = fr * 8 + F.wave; tq < T; tq += NW) { if (tq >= 1024) nsa_slc_item8<false>(p, tq, g, F.lane); else nsa_slc_item8<true>(p, tq, g, F.lane); }
}

__device__ __forceinline__ void ph_gdn_out(const KP& p, const Fr& F) {
    const float* H0 = p.BIGF; const int lane = F.lane;
    for (int unit = F.gw; unit < 2048; unit += F.NGW) gdn_out_unit(p, unit, lane);
    for (int idx = F.bid * NTHR + F.tid; idx < NSMP * 512; idx += F.G * NTHR) { const int b = idx >> 9, c = idx & 511; const float* sp = p.SMIXF + (size_t)b * 3 * 512 + c;
        p.MIXB[(size_t)(T + b) * 1024 + c] = (bf16)f2bf(sp[0] + sp[512] + sp[1024]); }
    for (int item = T * 8 + F.gw; item < TS * 8; item += F.NGW) {
        const int r = item >> 3, h = item & 7;
        const float o = p.OG[((size_t)r * 8 + h) * 64 + lane];
        const float ms = wave_sum(o * o) * (1.f / 64.f);
        const float z = H0[(size_t)r * PA + C_Z + h * 64 + lane];
        p.MIXB[(size_t)r * 1024 + 512 + h * 64 + lane] = (bf16)f2bf(o * rsqrtf(ms + NORM_EPS) * p.gnw[lane] * siluf_(z));
    }
}

__device__ __forceinline__ void ph_ln(const Fr& F, const float* Xp, const float* Xs, const float* Fm, const float* gam, const float* bet, float* outp, float* outs, bf16* ob) {
    const int lane = F.lane;
    for (int r = F.gw; r < TS; r += F.NGW) {
        const float* xr = (r < T) ? Xp + (size_t)r * DM : Xs + (size_t)(r - T) * DM;
        float v[16]; float s = 0.f;
#pragma unroll
        for (int j = 0; j < 16; ++j) { const int c = lane + 64 * j; v[j] = DN_ALPHA * xr[c] + Fm[(size_t)r * DM + c]; s += v[j]; }
        const float mean = wave_sum(s) * (1.f / DM); float q = 0.f;
#pragma unroll
        for (int j = 0; j < 16; ++j) { v[j] -= mean; q += v[j] * v[j]; }
        const float rstd = rsqrtf(wave_sum(q) * (1.f / DM) + LN_EPS);
        float* o = (r < T) ? outp + (size_t)r * DM : outs + (size_t)(r - T) * DM;
#pragma unroll
        for (int j = 0; j < 16; ++j) { const int c = lane + 64 * j; const float y = v[j] * rstd * gam[c] + bet[c]; o[c] = y; if (ob) ob[(size_t)r * DM + c] = (bf16)f2bf(y); }
    }
}

__device__ __forceinline__ void ph_ffn_act(const KP& p, const Fr& F, int layer) {
    const float* U = p.BIGF; const float* cw = p.ffn_cw + (size_t)layer * 3 * DFF2; const float* cb = p.ffn_cb + (size_t)layer * DFF2;
    const size_t gt = (size_t)F.bid * NTHR + F.tid, GT = (size_t)F.G * NTHR;
    const size_t total = (size_t)TS * DFF;
    for (size_t idx = gt; idx < total; idx += GT) {
        const int r = (int)(idx / DFF), j = (int)(idx % DFF);
        const bool smp = r >= T; const int b = r - T;
        float c2[2];
#pragma unroll
        for (int half = 0; half < 2; ++half) {
            const int ch = half * DFF + j;
            float acc = cb[ch];
#pragma unroll
            for (int k = 0; k < 3; ++k) {
                float u;
                if (!smp) { const int t = r + k - 2; u = (t >= 0) ? U[(size_t)t * DFF2 + ch] : 0.f; }
                else u = (k < 2) ? p.st_ffn[(((size_t)b * 2 + layer) * 2 + k) * DFF2 + ch] : U[(size_t)r * DFF2 + ch];
                acc += cw[k * DFF2 + ch] * u;
            }
            c2[half] = acc;
        }
        p.HFFB[idx] = (bf16)f2bf(siluf_(c2[0]) * c2[1]);
    }
    for (size_t idx = gt; idx < (size_t)2 * DFF2; idx += GT) {
        const int k = (int)(idx / DFF2), ch = (int)(idx % DFF2);
        p.out[O_FFN_P + ((size_t)layer * 2 + k) * DFF2 + ch] = U[(size_t)(T - 2 + k) * DFF2 + ch];
    }
    for (size_t idx = gt; idx < (size_t)NSMP * 2 * DFF2; idx += GT) {
        const int b = (int)(idx / (2 * DFF2)), k = (int)((idx / DFF2) % 2), ch = (int)(idx % DFF2);
        p.out[O_FFN_S + (((size_t)b * 2 + layer) * 2 + k) * DFF2 + ch] =
            (k == 0) ? p.st_ffn[(((size_t)b * 2 + layer) * 2 + 1) * DFF2 + ch] : U[(size_t)(T + b) * DFF2 + ch];
    }
}

__device__ __forceinline__ void ph_dil_prep(const KP& p, const Fr& F) {
    const float* H1 = p.BIGF;
    const size_t gt = (size_t)F.bid * NTHR + F.tid, GT = (size_t)F.G * NTHR;
    const size_t total = (size_t)TS * 2048;
    for (size_t idx = gt + (size_t)T * 2048; idx < total; idx += GT) {
        const int r = (int)(idx >> 11), c = (int)(idx & 2047);
        const bool smp = r >= T; const int pos = smp ? T : r;
        const float* row = H1 + (size_t)r * 3072;
        const int i = c & 63; const float2 cs = p.ROPE[pos * 32 + (i & 31)];
        const float v = rope_val(row, c & ~63, i, cs);
        if (c < 1024) p.QD[(size_t)r * 1024 + c] = v; else p.KD[(size_t)r * 1024 + (c - 1024)] = v;
    }
}
__device__ __forceinline__ void ph_dil_cache(const KP& p, const Fr& F) {
    const float* H1 = p.BIGF;
    const size_t gt = (size_t)F.bid * NTHR + F.tid, GT = (size_t)F.G * NTHR;
    const size_t tots4 = (size_t)NSMP * 2048 * 512;
    for (size_t idx = gt; idx < tots4; idx += GT) {
        const int b = (int)(idx / (2048 * 512)); const int i = (int)((idx / 512) % 2048); const int c4 = (int)(idx % 512);
        float4 v;
        if (i < 2047) v = ((const float4*)p.st_dil)[((size_t)b * 2048 + i + 1) * 512 + c4];
        else { const int c = c4 * 4; const int r = T + b;
               v = (c < 1024) ? *(const float4*)(p.KD + (size_t)r * 1024 + c) : *(const float4*)(H1 + (size_t)r * 3072 + 2048 + (c - 1024)); }
        ((float4*)(p.out + O_DIL_S))[idx] = v;
    }
}
__device__ __forceinline__ void ph_dil_attn(const KP& p, const Fr& F) {
    const float* H1 = p.BIGF; const int lane = F.lane;
    float* qs = (float*)(F.lds + F.wave * 4096); float* sc = qs + 64;
    for (int item = T * 16 + F.gw; item < TS * 16; item += F.NGW) {
        const int r = item >> 4, h = item & 15;
        const bool smp = r >= T; const int b = r - T; const int qpos = smp ? T : r;
        qs[lane] = p.QD[(size_t)r * 1024 + h * 64 + lane];
        wave_lds_sync();
        auto kf = [&](int j, const float*& kp, const float*& vp) -> bool {
            const int gi = j / 129, m = j - gi * 129; const int dd = gi == 0 ? 1 : (gi == 1 ? 4 : 16);
            const int pos = qpos - m * dd; if (pos < 0) return false;
            if (!smp || pos == T) { const int rr = smp ? r : pos; kp = p.KD + (size_t)rr * 1024 + h * 64; vp = H1 + (size_t)rr * 3072 + 2048 + h * 64; return true; }
            const int bi = pos - (T - 2048);
            const float* base = p.st_dil + ((size_t)b * 2048 + bi) * 2048;
            kp = base + h * 64; vp = base + 1024 + h * 64; return true; };
        float o[1], den[1];
        wave_attend<1>(qs, sc, 448, 387, kf, o, den, lane);
        p.MIXB[(size_t)r * 1024 + h * 64 + lane] = (bf16)f2bf(o[0]);
        wave_lds_sync();
    }
}

__device__ __forceinline__ void ph_dil_prep_fast(const KP& p, const Fr& F) {
    const float* H1 = p.BIGF;
    const size_t gt = (size_t)F.bid * NTHR + F.tid, GT = (size_t)F.G * NTHR;
    for (size_t idx = gt; idx < (size_t)T * 256; idx += GT) {
        const int t = (int)(idx >> 8), u = (int)(idx & 255);
        const int c0 = u * 8; const float* row = H1 + (size_t)t * 3072;
        const float4 a0 = *(const float4*)(row + c0), a1 = *(const float4*)(row + c0 + 4);
        float v[8] = {a0.x, a0.y, a0.z, a0.w, a1.x, a1.y, a1.z, a1.w};
        const int d0 = c0 & 63; const int pc = (d0 < 32) ? c0 + 32 : c0 - 32;
        const float4 b0 = *(const float4*)(row + pc), b1 = *(const float4*)(row + pc + 4);
        const float w[8] = {b0.x, b0.y, b0.z, b0.w, b1.x, b1.y, b1.z, b1.w};
#pragma unroll
        for (int j = 0; j < 8; ++j) { const float2 cs = p.ROPE[t * 32 + ((d0 + j) & 31)];
            v[j] = (d0 < 32) ? (v[j] * cs.x - w[j] * cs.y) : (v[j] * cs.x + w[j] * cs.y); }
        if (u < 128) {
            v4u o; o.x = pk2(v[0] * QSCALE, v[1] * QSCALE); o.y = pk2(v[2] * QSCALE, v[3] * QSCALE); o.z = pk2(v[4] * QSCALE, v[5] * QSCALE); o.w = pk2(v[6] * QSCALE, v[7] * QSCALE);
            *(v4u*)(p.QDB + (size_t)t * 1024 + c0) = o;
        } else {
            const int kc = c0 - 1024, h = kc >> 6;
            v4u o; o.x = pk2(v[0], v[1]); o.y = pk2(v[2], v[3]); o.z = pk2(v[4], v[5]); o.w = pk2(v[6], v[7]);
#pragma unroll
            for (int pass = 0; pass < 3; ++pass) { const int sh = 2 * pass; const int pi = (t & ((1 << sh) - 1)) * (T >> sh) + (t >> sh);
                *(v4u*)(p.DKF[pass] + (size_t)h * T * 64 + kfrag_elem(pi, d0)) = o; }
            if (t >= T - 2048) { float* op = p.out + O_DIL_P + (size_t)(t - (T - 2048)) * 2048 + kc;
                *(float4*)op = make_float4(v[0], v[1], v[2], v[3]); *(float4*)(op + 4) = make_float4(v[4], v[5], v[6], v[7]); }
        }
    }
    for (size_t idx = gt; idx < (size_t)2048 * 256; idx += GT) {
        const int i = (int)(idx >> 8), c4 = (int)(idx & 255);
        *(float4*)(p.out + O_DIL_P + (size_t)i * 2048 + 1024 + c4 * 4) = *(const float4*)(H1 + (size_t)(T - 2048 + i) * 3072 + 2048 + c4 * 4);
    }
    const int lane = F.lane, l15 = lane & 15, grp = lane >> 4;
    for (int unit = F.gw; unit < 3 * 16 * 512; unit += F.NGW) {
        const int st = unit & 511, h = (unit >> 9) & 15, pass = unit >> 13; const int sh = 2 * pass, Td = T >> sh;
        const int pi0 = 32 * st, r = pi0 / Td, s0 = pi0 - r * Td;
        bf16* dst = p.DVF[pass] + (size_t)h * T * 64;
#pragma unroll
        for (int dt = 0; dt < 4; ++dt) {
            float v[8];
#pragma unroll
            for (int j = 0; j < 8; ++j) { const int s = s0 + 16 * (j >> 2) + 4 * grp + (j & 3); const int t = (s << sh) + r;
                v[j] = H1[(size_t)t * 3072 + 2048 + h * 64 + 16 * dt + l15]; }
            v4u o; o.x = pk2(v[0], v[1]); o.y = pk2(v[2], v[3]); o.z = pk2(v[4], v[5]); o.w = pk2(v[6], v[7]);
            *(v4u*)(dst + vfrag_off(st, dt, lane)) = o;
        }
    }
}

__device__ __forceinline__ void dil_unit(const KP& p, int unit, unsigned char* ldsb, int wave, int lane) {
    asm volatile("" : "+v"(lane));
    const int h = unit & 15, P0 = (unit >> 4) * 256;
    const int l15 = lane & 15, grp = lane >> 4;
    float* stO = (float*)ldsb; float* stML = stO + 256 * 64;
    for (int pass = 0; pass < 3; ++pass) {
        const int sh = 2 * pass, Td = T >> sh;
        const bf16* KF = p.DKF[pass] + (size_t)h * T * 64; const bf16* VF = p.DVF[pass] + (size_t)h * T * 64;
        for (int tt = 0; tt < 2; ++tt) {
            const int tl = 2 * wave + tt;
            const int r = tl >> (4 - sh), s0 = (P0 >> sh) + 16 * (tl & ((16 >> sh) - 1));
            const int sq = s0 + l15, tq = (sq << sh) + r, tloc = tq - P0;
            bf16x8 qf[2];
#pragma unroll
            for (int ks = 0; ks < 2; ++ks) qf[ks] = *(const bf16x8*)(p.QDB + (size_t)tq * 1024 + h * 64 + 32 * ks + 8 * grp);
            AttW a;
            if (pass == 0) attw_init(a);
            else {
#pragma unroll
                for (int dt = 0; dt < 4; ++dt) a.o[dt] = *(const f32x4*)(stO + tloc * 64 + 16 * dt + 4 * grp);
                a.m = stML[tloc * 2]; a.l = (grp == 0) ? stML[tloc * 2 + 1] : 0.f;
            }
            int kstart = s0 - 128; if (kstart < 0) kstart = 0; kstart &= ~31;
            const int nsteps = (s0 + 16 - kstart + 31) >> 5;
            const int base = r * Td;
            bf16x8 kf[3][2][2], vf[3][4];
            auto issue = [&](int s, int buf) {
                const int k0 = kstart + 32 * s;
#pragma unroll
                for (int tl2 = 0; tl2 < 2; ++tl2)
#pragma unroll
                    for (int ks = 0; ks < 2; ++ks) kf[buf][tl2][ks] = *(const bf16x8*)(KF + kfrag_off(((base + k0) >> 4) + tl2, ks, lane));
#pragma unroll
                for (int dt = 0; dt < 4; ++dt) vf[buf][dt] = *(const bf16x8*)(VF + vfrag_off((base + k0) >> 5, dt, lane));
            };
            issue(0, 0); if (nsteps > 1) issue(1, 1);
#pragma unroll
            for (int s = 0; s < 5; ++s) {
                if (s < nsteps) {
                    if (s + 2 < nsteps) issue(s + 2, (s + 2) % 3);
                    const int k0 = kstart + 32 * s;
                    f32x4 s0v, s1v; qk_step(kf[s % 3], qf, s0v, s1v);
                    if ((k0 + 31 > s0) || (k0 < s0 + 15 - 128)) {
                        const int pb = k0 + 4 * grp;
#pragma unroll
                        for (int i = 0; i < 4; ++i) { const int p0 = pb + i, p1 = pb + 16 + i;
                            if (p0 > sq || p0 < sq - 128) s0v[i] = -INFINITY; if (p1 > sq || p1 < sq - 128) s1v[i] = -INFINITY; }
                    }
                    att_update(a, s0v, s1v, vf[s % 3]);
                }
            }
            const float lt = grp_sum(a.l);
            if (pass < 2) {
#pragma unroll
                for (int dt = 0; dt < 4; ++dt) *(f32x4*)(stO + tloc * 64 + 16 * dt + 4 * grp) = a.o[dt];
                if (grp == 0) { stML[tloc * 2] = a.m; stML[tloc * 2 + 1] = lt; }
            } else {
                const float il = lt > 0.f ? 1.f / lt : 0.f;
#pragma unroll
                for (int dt = 0; dt < 4; ++dt) { uint2 o; o.x = pk2(a.o[dt][0] * il, a.o[dt][1] * il); o.y = pk2(a.o[dt][2] * il, a.o[dt][3] * il);
                    *(uint2*)(p.MIXB + (size_t)tq * 1024 + h * 64 + 16 * dt + 4 * grp) = o; }
            }
        }
        __syncthreads();
    }
}
__device__ __forceinline__ void ph_dil_attn_fast(const KP& p, const Fr& F) {
    for (int unit = F.bid; unit < 64 * 16; unit += F.G) dil_unit(p, unit, F.lds, F.wave, F.lane);
}

constexpr int NPHASE = 22;
__global__ void __launch_bounds__(NTHR, 2) mega(KP p) {
    extern __shared__ __attribute__((aligned(16))) unsigned char lds[];
    Fr F; F.lds = lds; F.tid = threadIdx.x; F.lane = 0; F.wave = __builtin_amdgcn_readfirstlane(F.tid >> 6);
    F.bid = blockIdx.x; F.G = gridDim.x; F.gw = F.bid * NWAVES + F.wave; F.NGW = F.G * NWAVES;
    for (int u = F.tid; u < (LDS_BYTES - RING_BYTES) / 4; u += NTHR) ((unsigned*)(lds + RING_BYTES))[u] = 0u;
    __syncthreads();
    XcdBarrier bar; bar.bar = p.ctl + 4096; bar.x = 0; bar.st = nullptr;
    if (!MK_PER_PHASE) bar = xcd_barrier_post(p.ctl + 4096, (volatile LAS unsigned*)(lds + MISC_OFF + 32));
    const int lo = p.ph_lo, hi = p.ph_hi;
#define IN(k) (lo <= (k) && (k) < hi)

    int ph = 0;
#if PROBE_ON
#define PROBE_STAMP(k) do { if (blockIdx.x == 0 && threadIdx.x == 0) ((unsigned long long*)(p.ctl + 65536))[k] = __builtin_amdgcn_s_memrealtime(); } while (0)
#define PROBE_STAMPB(k, blk) do { if (blockIdx.x == (blk) && threadIdx.x == 0) ((unsigned long long*)(p.ctl + 65536))[k] = __builtin_amdgcn_s_memrealtime(); } while (0)
    PROBE_STAMP(0);
#else
#define PROBE_STAMP(k) do { } while (0)
#define PROBE_STAMPB(k, blk) do { } while (0)
#endif
#define PHASE(...) do { { unsigned t_ = threadIdx.x; asm volatile("" : "+v"(t_)); F.lane = (int)(t_ & 63u); } if (IN(ph)) { __VA_ARGS__ } if (IN(ph) && IN(ph + 1)) xcd_barrier(bar); ++ph; PROBE_STAMP(ph); } while (0)
    PHASE(ph_prologue(p, F););
    PHASE(ph_gemm_f32(F, p.ACTB, p.WT_A, PAP, DM, p.BIGF, PA, PA); ph_cmp_samples(p, F););
    PHASE(ph_nsa_prep(p, F); ph_nsa_prep_fast(p, F); ph_gdn_prep(p, F););
    PHASE(ph_gdn_chunks(p, F););
    PHASE(ph_mix_a(p, F););
    PHASE(ph_mix_b(p, F););
    PHASE(ph_gdn_out(p, F););
    PHASE(ph_gemm_f32(F, p.MIXB, p.WT_OA, DM, DM, p.MO, DM, DM););
    PHASE(ph_ln(F, p.x_prompt, p.x_sample, p.MO, p.ln_mix_g, p.ln_mix_b, p.X1, p.X1 + (size_t)T * DM, p.ACTB););
    PHASE(ph_ffn_gemm(p, F, p.WT_FI0, 0););
    PHASE(ph_ffn_fix(p, F, 0););
    PHASE(ph_gemm_f32(F, p.HFFB, p.WT_FO0, DM, DFF, p.MO, DM, DM););
    PHASE(ph_ln(F, p.X1, p.X1 + (size_t)T * DM, p.MO, p.ln_ffn_g, p.ln_ffn_b, p.X2, p.X2 + (size_t)T * DM, p.ACTB););
    PHASE(ph_gemm_f32(F, p.ACTB, p.WT_CI, 3072, DM, p.BIGF, 3072, 3072););
    PHASE(ph_dil_prep(p, F); ph_dil_prep_fast(p, F););
    PHASE(ph_dil_cache(p, F); ph_dil_attn(p, F); __syncthreads(); ph_dil_attn_fast(p, F););
    PHASE(ph_gemm_f32(F, p.MIXB, p.WT_CO, DM, DM, p.MO, DM, DM););
    PHASE(ph_ln(F, p.X2, p.X2 + (size_t)T * DM, p.MO, p.ln_mix_g + DM, p.ln_mix_b + DM, p.X3, p.X3 + (size_t)T * DM, p.ACTB););
    PHASE(ph_ffn_gemm(p, F, p.WT_FI1, 1););
    PHASE(ph_ffn_fix(p, F, 1););
    PHASE(ph_gemm_f32(F, p.HFFB, p.WT_FO1, DM, DFF, p.MO, DM, DM););
    PHASE(ph_ln(F, p.X3, p.X3 + (size_t)T * DM, p.MO, p.ln_ffn_g + DM, p.ln_ffn_b + DM, p.out + O_Y_P, p.out + O_Y_S, nullptr););
#undef PHASE
#if PROBE_ON
    xcd_barrier(bar);
    if (blockIdx.x == 0) { __syncthreads(); const unsigned long long* pts = (const unsigned long long*)(p.ctl + 65536); const float x = (float)(pts[PROBE_B] - pts[PROBE_A]) * 1e-5f;
        for (int i = threadIdx.x; i < NSMP * DM; i += NTHR) p.out[O_Y_S + i] *= (1.f + x); }
#endif
#undef IN
}

static inline size_t align_up(size_t x) { return (x + 255) & ~(size_t)255; }

extern "C" void kernel_launch(void* const* d_in, const int* in_sizes, int n_in, void* d_out, int out_size, void* d_ws, size_t ws_size, hipStream_t stream) {
    static int grid = 0;
    if (grid == 0) {
        int dev = 0, cus = 0, per_cu = 0;
        if (hipGetDevice(&dev) != hipSuccess || hipDeviceGetAttribute(&cus, hipDeviceAttributeMultiprocessorCount, dev) != hipSuccess) { fprintf(stderr, "kernel_launch: device query failed\n"); grid = -1; return; }
        if (hipFuncSetAttribute((const void*)mega, hipFuncAttributeMaxDynamicSharedMemorySize, LDS_BYTES) != hipSuccess) { fprintf(stderr, "kernel_launch: hipFuncSetAttribute failed\n"); grid = -1; return; }
        if (hipOccupancyMaxActiveBlocksPerMultiprocessor(&per_cu, (const void*)mega, NTHR, LDS_BYTES) != hipSuccess || per_cu < 1) { fprintf(stderr, "kernel_launch: occupancy query says %d blocks per CU\n", per_cu); }
        (void)hipGetLastError();
        grid = cus;
    }
    if (grid < 0) return;
    if ((size_t)out_size != O_END) fprintf(stderr, "kernel_launch: out_size %d != expected %zu\n", out_size, (size_t)O_END);
    KP p{};
    p.x_prompt = (const float*)d_in[0]; p.x_sample = (const float*)d_in[1]; p.cache_cmp = (const float*)d_in[2]; p.cache_slc = (const float*)d_in[3];
    p.st_win = (const float*)d_in[4]; p.st_gconv = (const float*)d_in[5]; p.st_gS = (const float*)d_in[6]; p.st_dil = (const float*)d_in[7];
    p.st_ffn = (const float*)d_in[8]; p.page_table = (const int*)d_in[9]; p.w_in_a = (const float*)d_in[10]; p.cw1 = (const float*)d_in[11];
    p.cb1 = (const float*)d_in[12]; p.cw2 = (const float*)d_in[13]; p.cpe = (const float*)d_in[14]; p.gconv_w = (const float*)d_in[15];
    p.gA = (const float*)d_in[16]; p.gdt = (const float*)d_in[17]; p.gnw = (const float*)d_in[18]; p.w_out_a = (const float*)d_in[19];
    p.w_in_c = (const float*)d_in[20]; p.w_out_c = (const float*)d_in[21]; p.ln_mix_g = (const float*)d_in[22]; p.ln_mix_b = (const float*)d_in[23];
    p.ffn_w_in = (const float*)d_in[24]; p.ffn_cw = (const float*)d_in[25]; p.ffn_cb = (const float*)d_in[26]; p.ffn_w_out = (const float*)d_in[27];
    p.ln_ffn_g = (const float*)d_in[28]; p.ln_ffn_b = (const float*)d_in[29];
    p.out = (float*)d_out;
    char* ws = (char*)d_ws; size_t off = 0;
    auto alloc = [&](size_t bytes) { void* q = (void*)(ws + off); off = align_up(off + bytes); return q; };
    p.ctl = (unsigned*)alloc(1 << 20);
    p.WT_A = (bf16*)alloc((size_t)PAP * DM * 2); p.WT_OA = (bf16*)alloc((size_t)DM * DM * 2);
    p.WT_FI0 = (bf16*)alloc((size_t)DFF2 * DM * 2); p.WT_FI1 = (bf16*)alloc((size_t)DFF2 * DM * 2);
    p.WT_FO0 = (bf16*)alloc((size_t)DM * DFF * 2); p.WT_FO1 = (bf16*)alloc((size_t)DM * DFF * 2);
    p.WT_CI = (bf16*)alloc((size_t)3072 * DM * 2); p.WT_CO = (bf16*)alloc((size_t)DM * DM * 2);
    p.ROPE = (float2*)alloc((size_t)(T + 1) * 32 * 8);
    p.ACTB = (bf16*)alloc((size_t)TSP * DM * 2); p.MIXB = (bf16*)alloc((size_t)TSP * DM * 2); p.HFFB = (bf16*)alloc((size_t)TSP * DFF * 2);
    p.KS8 = (unsigned char*)alloc((size_t)2 * T * 64); p.VS8 = (unsigned char*)alloc((size_t)2 * T * 64);
    p.QB = (bf16*)alloc((size_t)T * 512 * 2); p.KSF = (bf16*)alloc((size_t)2 * T * 64 * 2); p.VSF = (bf16*)alloc((size_t)2 * T * 64 * 2);
    p.KWF = (bf16*)alloc((size_t)2 * T * 64 * 2); p.VWF = (bf16*)alloc((size_t)2 * T * 64 * 2); p.CKF = (bf16*)alloc((size_t)2 * 512 * 64 * 2); p.CVF = (bf16*)alloc((size_t)2 * 512 * 64 * 2);
    p.ACP = (bf16*)alloc((size_t)2048 * 2048 * 2);
    p.W2T = (bf16*)alloc((size_t)2 * 64 * 128 * 2);
    p.AC = nullptr; p.WT_C = (bf16*)alloc((size_t)256 * 2048 * 2); p.HID = nullptr; p.SMIXF = (float*)alloc((size_t)NSMP * 3 * 512 * 4);
    p.UB = (float*)alloc((size_t)256 * 4 * DFF2 * 4);
    p.NSACC = (float*)alloc((size_t)T * 512 * 4); p.SEL = (int*)alloc((size_t)2 * T * 16 * 4);
    p.QDB = (bf16*)alloc((size_t)T * 1024 * 2);
    for (int i = 0; i < 3; ++i) { p.DKF[i] = (bf16*)alloc((size_t)T * 1024 * 2); p.DVF[i] = (bf16*)alloc((size_t)T * 1024 * 2); }
    p.G_WF = (bf16*)alloc((size_t)2048 * 4096 * 2); p.G_KDF = (bf16*)alloc((size_t)2048 * 4096 * 2); p.G_QGF = (bf16*)alloc((size_t)2048 * 4096 * 2); p.G_QKF = (bf16*)alloc((size_t)2048 * 4096 * 2);
    p.G_SPF = (bf16*)alloc((size_t)2048 * 4096 * 2); p.G_VNF = (bf16*)alloc((size_t)2048 * 4096 * 2); p.G_UF = (float*)alloc((size_t)2048 * 4096 * 4); p.G_GL = (float*)alloc((size_t)2048 * 4);
    p.BIGF = (float*)alloc((size_t)TSP * DFF2 * 4); p.MO = (float*)alloc((size_t)TSP * DM * 4);
    p.X1 = (float*)alloc((size_t)TS * DM * 4); p.X2 = (float*)alloc((size_t)TS * DM * 4); p.X3 = (float*)alloc((size_t)TS * DM * 4);
    p.QR = (float*)alloc((size_t)TS * 512 * 4);
    p.KS = (float*)alloc((size_t)TS * 128 * 4); p.VS = (float*)alloc((size_t)TS * 128 * 4); p.KW = (float*)alloc((size_t)TS * 128 * 4); p.VW = (float*)alloc((size_t)TS * 128 * 4);
    p.CK = (float*)alloc((size_t)33 * 512 * 128 * 4); p.CV = (float*)alloc((size_t)33 * 512 * 128 * 4);
    p.GQ = (float*)alloc((size_t)TS * 512 * 4); p.GK = (float*)alloc((size_t)TS * 512 * 4); p.GV = (float*)alloc((size_t)TS * 512 * 4); p.OG = (float*)alloc((size_t)TS * 512 * 4);
    p.Gg = (float*)alloc((size_t)TS * 8 * 4); p.Gb = (float*)alloc((size_t)TS * 8 * 4);
    p.QD = (float*)alloc((size_t)TS * DM * 4); p.KD = (float*)alloc((size_t)TS * DM * 4);
    if (off > ws_size) { fprintf(stderr, "kernel_launch: workspace too small: need %zu have %zu\n", off, ws_size); return; }
    if (hipMemsetAsync(p.ctl, 0, 1 << 20, stream) != hipSuccess) { fprintf(stderr, "kernel_launch: memset failed\n"); return; }
#if MK_PER_PHASE
    for (int k = 0; k < NPHASE; ++k) { p.ph_lo = k; p.ph_hi = k + 1; hipLaunchKernelGGL(mega, dim3(grid), dim3(NTHR), LDS_BYTES, stream, p); }
#else
    p.ph_lo = 0; p.ph_hi = NPHASE;
    hipLaunchKernelGGL(mega, dim3(grid), dim3(NTHR), LDS_BYTES, stream, p);
#endif
    const hipError_t le = hipPeekAtLastError();
    if (le != hipSuccess) fprintf(stderr, "kernel_launch: launch failed: %s\n", hipGetErrorName(le));
}
```

```cpp
#include <hip/hip_runtime.h>
#include <cstdint>
#include <cstdio>
#include <cmath>

namespace pg8 {
#define PG8_LAS __attribute__((address_space(3)))
typedef unsigned short bf16_t;
typedef short bf16x8 __attribute__((ext_vector_type(8)));
typedef float f32x4 __attribute__((ext_vector_type(4)));
typedef unsigned u32x4 __attribute__((ext_vector_type(4)));
constexpr int BM = 256, BK = 64, HALF = 128, HTB = HALF * BK * 2  , STAGE_BYTES = 8 * HTB, NXCD = 8, WGM = 8;

__host__ __device__ __forceinline__ int lds_byte(int r, int c) { const int st = (r >> 4) * 2 + (c >> 5), rr = r & 15, cc = c & 31, ob = rr * 64 + cc * 2; return st * 1024 + (ob ^ (((ob >> 9) & 1) << 5)); }
__host__ __device__ __forceinline__ void stage_rc(int b, int& R, int& C) { const int st = b / 1024, sb = b % 1024, swz = sb ^ (((sb >> 9) & 1) << 5); R = (st >> 1) * 16 + swz / 64; C = (st & 1) * 32 + (swz % 64) / 2; }
__host__ __device__ __forceinline__ int perm32(int rho) { const int n = rho >> 4, i = rho & 15; return 8 * (i >> 2) + 4 * n + (i & 3); }

struct Unit { int pm, pn; };
struct Gemm { const bf16_t* A; const bf16_t* Bt; int M, N, K; };

struct StaticOrder {
    int nM, nN, nwg, G, c;
    __host__ __device__ void init(int M, int N, int G_, int c_) { nM = M / BM; nN = N / BM; nwg = nM * nN; G = G_; c = c_; }
    __host__ __device__ bool next(int i, Unit& u) const {
        const long L = (long)i * G + c; if (L >= nwg) return false;
        int wgid = (int)L; { const int q = nwg / NXCD, r = nwg % NXCD, xcd = wgid % NXCD, off = wgid / NXCD; wgid = (xcd < r ? xcd * (q + 1) : r * (q + 1) + (xcd - r) * q) + off; }
        const int nig = WGM * nN, gid = wgid / nig, fm = gid * WGM, gsz = (nM - fm) < WGM ? (nM - fm) : WGM;
        u.pm = fm + ((wgid % nig) % gsz); u.pn = (wgid % nig) / gsz; return true;
    }
    __device__ __forceinline__ void a_ready(const Unit&) const {}
    __device__ __forceinline__ void done(const Unit&) const {}
};

typedef __bf16 bf16x2_t __attribute__((ext_vector_type(2)));
typedef float f32x2_t __attribute__((ext_vector_type(2)));
__device__ __forceinline__ unsigned cvt_pk_bf16(float lo, float hi) { const f32x2_t v = {lo, hi}; return __builtin_bit_cast(unsigned, __builtin_convertvector(v, bf16x2_t)); }
typedef float f32x2 __attribute__((ext_vector_type(2)));
__device__ __forceinline__ f32x2 gelu_pk(f32x2 v) {
    const f32x2 av = __builtin_elementwise_abs(v), d = av * 0.2316418882f + 1.0f;
    f32x2 t; t.x = __builtin_amdgcn_rcpf(d.x); t.y = __builtin_amdgcn_rcpf(d.y);
    f32x2 q = t * 0.5307027145f + (-0.7265760135f); q = q * t + 0.7107068705f; q = q * t + (-0.142248368f); q = q * t + 0.127414796f; q = q * t;
    const f32x2 s = (v * v) * (-0.72134752044f);
    f32x2 e; e.x = __builtin_amdgcn_exp2f(s.x); e.y = __builtin_amdgcn_exp2f(s.y);
    const f32x2 m = v * (q * e), r = v - m;
    f32x2 o; o.x = v.x < 0.f ? m.x : r.x; o.y = v.y < 0.f ? m.y : r.y; return o;
}

template <int ACT  > struct EpiBf16 {
    static constexpr bool PERM = true, AFTER_DRAIN = false; static_assert(ACT == 0 || ACT == 1, "EpiBf16: ACT is 0 (none) or 1 (gelu_pk)");
    bf16_t* O; int ldc; const float* bias; int split_cols; size_t split_stride; float scale0;
    __device__ __forceinline__ void operator()(const f32x4 (&acc)[2][2][4][2], const Unit& u, int wr, int wc, int fr, int fq) const {
        const int row0 = u.pm * BM + wr * 64 + fr; int colt = u.pn * BM; bf16_t* base = O;
        float sc = 1.f; if (split_cols) { const int t = colt / split_cols; base += (size_t)t * split_stride; colt -= t * split_cols; if (t == 0) sc = scale0; }
        const int col0 = colt + wc * 32 + 8 * fq, bcol0 = u.pn * BM + wc * 32 + 8 * fq;
        f32x4 bv[2][2];
#pragma unroll
        for (int bj = 0; bj < 2; ++bj)
#pragma unroll
            for (int n = 0; n < 2; ++n) bv[bj][n] = bias ? *(const f32x4*)(bias + bcol0 + bj * HALF + 4 * n) : (f32x4){0.f, 0.f, 0.f, 0.f};
#pragma unroll
        for (int ai = 0; ai < 2; ++ai)
#pragma unroll
            for (int m = 0; m < 4; ++m) { bf16_t* rowp = base + (size_t)(row0 + ai * HALF + m * 16) * ldc + col0;
#pragma unroll
                for (int bj = 0; bj < 2; ++bj) { f32x4 v0 = acc[ai][bj][m][0] + bv[bj][0], v1 = acc[ai][bj][m][1] + bv[bj][1];
                    if (ACT == 1) { f32x2 a = gelu_pk((f32x2){v0[0], v0[1]}), b = gelu_pk((f32x2){v0[2], v0[3]}), c = gelu_pk((f32x2){v1[0], v1[1]}), d = gelu_pk((f32x2){v1[2], v1[3]});
                        v0 = (f32x4){a.x, a.y, b.x, b.y}; v1 = (f32x4){c.x, c.y, d.x, d.y}; }
                    v0 = v0 * sc; v1 = v1 * sc; u32x4 w; w.x = cvt_pk_bf16(v0[0], v0[1]); w.y = cvt_pk_bf16(v0[2], v0[3]); w.z = cvt_pk_bf16(v1[0], v1[1]); w.w = cvt_pk_bf16(v1[2], v1[3]);
                    *(u32x4*)(rowp + bj * HALF) = w; } }
    }
};

struct EpiF32 {
    static constexpr bool PERM = false, AFTER_DRAIN = false;
    float* O; int ldc; int ncols;
    __device__ __forceinline__ void operator()(const f32x4 (&acc)[2][2][4][2], const Unit& u, int wr, int wc, int fr, int fq) const {
        const int row0 = u.pm * BM + wr * 64 + fr; const int col0 = u.pn * BM + wc * 32 + 4 * fq;
#pragma unroll
        for (int ai = 0; ai < 2; ++ai)
#pragma unroll
            for (int m = 0; m < 4; ++m) { float* rowp = O + (size_t)(row0 + ai * HALF + m * 16) * ldc;
#pragma unroll
                for (int bj = 0; bj < 2; ++bj)
#pragma unroll
                    for (int n = 0; n < 2; ++n) { const int c = col0 + bj * HALF + n * 16; if (c < ncols) *(f32x4*)(rowp + c) = acc[ai][bj][m][n]; } }
    }
};
template <class Epi, class Sched, bool ALIGN_EPI = false, bool SP2 = false>
__device__ __forceinline__ void gemm_phase(PG8_LAS unsigned char* lds, const Gemm g, const Sched& S, const Epi& E) {
    const int tid = threadIdx.x, wid = __builtin_amdgcn_readfirstlane(tid >> 6), lane = tid & 63, wr = wid >> 2, wc = wid & 3, fr = lane & 15, fq = lane >> 4;
    const int K = g.K, nt = K / BK;
    unsigned voffA[2], voffB[2];
#pragma unroll
    for (int i = 0; i < 2; ++i) { int R, C; stage_rc(tid * 16 + i * 8192, R, C); const int Rb = Epi::PERM ? ((R & ~31) + perm32(R & 31)) : R;
        voffA[i] = (unsigned)(R * K + C) * 2u; voffB[i] = (unsigned)(Rb * K + C) * 2u; }
    const size_t kstep = (size_t)(BK * 2);
    const size_t hstep = (size_t)HALF * K * 2;
    const size_t tstep = 2 * hstep;
    const unsigned ldsw = (unsigned)wid * 1024u;
    const int aoff = lds_byte(wr * 64 + fr, fq * 8), boff = lds_byte(wc * 32 + fr, fq * 8);
#define PG8_SA(b, h) (((b) * 2 + (h)) * HTB)
#define PG8_SB(b, h) ((4 + (b) * 2 + (h)) * HTB)
#define PG8_STAGE(bufoff, gbase, voff) do { _Pragma("unroll") for (int _i = 0; _i < 2; ++_i) \
        __builtin_amdgcn_global_load_lds((const unsigned*)((const char*)(gbase) + (voff)[_i]), (PG8_LAS unsigned*)(lds + (bufoff) + ldsw + _i * 8192), 16, 0, 0); } while (0)
#define PG8_LDA(dst, b, h) do { _Pragma("unroll") for (int m = 0; m < 4; ++m) _Pragma("unroll") for (int k = 0; k < 2; ++k) dst[m][k] = *(const PG8_LAS bf16x8*)(lds + PG8_SA(b, h) + aoff + m * 2048 + k * 1024); } while (0)
#define PG8_LDB(dst, b, h) do { _Pragma("unroll") for (int n = 0; n < 2; ++n) _Pragma("unroll") for (int k = 0; k < 2; ++k) dst[n][k] = *(const PG8_LAS bf16x8*)(lds + PG8_SB(b, h) + boff + n * 2048 + k * 1024); } while (0)
#define PG8_MMA(ai, bj, At, Bt) do { __builtin_amdgcn_s_setprio(1); _Pragma("unroll") for (int m = 0; m < 4; ++m) _Pragma("unroll") for (int n = 0; n < 2; ++n) _Pragma("unroll") for (int k = 0; k < 2; ++k) \
        acc[ai][bj][m][n] = __builtin_amdgcn_mfma_f32_16x16x32_bf16(Bt[n][k], At[m][k], acc[ai][bj][m][n], 0, 0, 0); __builtin_amdgcn_s_setprio(0); } while (0)
#define PG8_WAIT_V(n) asm volatile("s_waitcnt vmcnt(" #n ")" ::: "memory")
#define PG8_WAIT_L(n) asm volatile("s_waitcnt lgkmcnt(" #n ")" ::: "memory")
#define PG8_BAR __builtin_amdgcn_s_barrier()
#define PG8_SCHED __builtin_amdgcn_sched_barrier(0)
    Unit cur, nxt; int ui = 0;
    if (!S.next(0, cur)) return;
    f32x4 acc[2][2][4][2];
#pragma unroll
    for (int a = 0; a < 2; ++a)
#pragma unroll
        for (int b = 0; b < 2; ++b)
#pragma unroll
            for (int m = 0; m < 4; ++m)
#pragma unroll
                for (int n = 0; n < 2; ++n) acc[a][b][m][n] = (f32x4){0.f, 0.f, 0.f, 0.f};
    bf16x8 At[4][2], B0[2][2], B1[2][2];
    const char* cA = (const char*)g.A + (size_t)cur.pm * tstep; const char* cB = (const char*)g.Bt + (size_t)cur.pn * tstep;
    S.a_ready(cur);
    if constexpr (SP2) {
        PG8_STAGE(PG8_SB(0, 0), cB, voffB); PG8_STAGE(PG8_SB(0, 1), cB + hstep, voffB); PG8_STAGE(PG8_SA(0, 0), cA, voffA); PG8_STAGE(PG8_SA(0, 1), cA + hstep, voffA);
        if (wr == 1) PG8_BAR;
        PG8_WAIT_V(2); PG8_BAR;
        PG8_STAGE(PG8_SB(1, 0), cB + kstep, voffB); PG8_STAGE(PG8_SA(1, 0), cA + kstep, voffA); PG8_STAGE(PG8_SB(1, 1), cB + hstep + kstep, voffB);
        PG8_WAIT_V(6); PG8_BAR;
    } else {
        PG8_STAGE(PG8_SB(0, 0), cB, voffB); PG8_STAGE(PG8_SA(0, 0), cA, voffA); PG8_STAGE(PG8_SB(0, 1), cB + hstep, voffB); PG8_STAGE(PG8_SA(0, 1), cA + hstep, voffA);
        if (wr == 1) PG8_BAR;
        PG8_WAIT_V(4); PG8_BAR;
        PG8_STAGE(PG8_SB(1, 0), cB + kstep, voffB); PG8_STAGE(PG8_SA(1, 0), cA + kstep, voffA); PG8_STAGE(PG8_SB(1, 1), cB + hstep + kstep, voffB);
        PG8_WAIT_V(6); PG8_BAR;
    }
    for (;;) {
        const bool has_next = S.next(ui + 1, nxt);
        const char* nA = has_next ? (const char*)g.A + (size_t)nxt.pm * tstep : cA; const char* nB = has_next ? (const char*)g.Bt + (size_t)nxt.pn * tstep : cB;
        for (int t = 0; t < nt; t += 2) {
            const bool last = (t == nt - 2);
            const char* a1 = cA + (size_t)(t + 1) * kstep;
            const char* a2 = last ? nA : cA + (size_t)(t + 2) * kstep; const char* b2 = last ? nB : cB + (size_t)(t + 2) * kstep;
            const char* a3 = a2 + kstep; const char* b3 = b2 + kstep;
            if (last && has_next) S.a_ready(nxt);
            if constexpr (SP2) {
            PG8_LDB(B0, 0, 0); PG8_LDB(B1, 0, 1); PG8_SCHED; PG8_LDA(At, 0, 0); PG8_STAGE(PG8_SA(1, 1), a1 + hstep, voffA);
            PG8_WAIT_V(8); PG8_WAIT_L(0); PG8_BAR; PG8_MMA(0, 0, At, B0); PG8_MMA(0, 1, At, B1); PG8_BAR; PG8_SCHED;
            PG8_LDA(At, 0, 1); PG8_STAGE(PG8_SB(0, 0), b2, voffB); PG8_STAGE(PG8_SB(0, 1), b2 + hstep, voffB); PG8_STAGE(PG8_SA(0, 0), a2, voffA);
            PG8_WAIT_V(8); PG8_WAIT_L(0); PG8_BAR; PG8_MMA(1, 0, At, B0); PG8_MMA(1, 1, At, B1); PG8_BAR; PG8_SCHED;
            PG8_LDB(B0, 1, 0); PG8_LDB(B1, 1, 1); PG8_SCHED; PG8_LDA(At, 1, 0); PG8_STAGE(PG8_SA(0, 1), a2 + hstep, voffA);
            PG8_WAIT_V(8); PG8_WAIT_L(0); PG8_BAR; PG8_MMA(0, 0, At, B0); PG8_MMA(0, 1, At, B1); PG8_BAR; PG8_SCHED;
            PG8_LDA(At, 1, 1); PG8_STAGE(PG8_SB(1, 0), b3, voffB); PG8_STAGE(PG8_SB(1, 1), b3 + hstep, voffB); PG8_STAGE(PG8_SA(1, 0), a3, voffA);
            PG8_WAIT_V(8); PG8_WAIT_L(0); PG8_BAR; PG8_MMA(1, 0, At, B0); PG8_MMA(1, 1, At, B1); PG8_BAR; PG8_SCHED;
            } else {
            PG8_LDB(B0, 0, 0); PG8_SCHED; PG8_LDA(At, 0, 0); PG8_STAGE(PG8_SA(1, 1), a1 + hstep, voffA);
            PG8_WAIT_L(8); PG8_BAR; PG8_WAIT_L(0); PG8_MMA(0, 0, At, B0); PG8_BAR; PG8_SCHED;
            PG8_LDB(B1, 0, 1); PG8_STAGE(PG8_SB(0, 0), b2, voffB);
            PG8_BAR; PG8_WAIT_L(0); PG8_MMA(0, 1, At, B1); PG8_BAR;
            PG8_LDA(At, 0, 1); PG8_STAGE(PG8_SA(0, 0), a2, voffA);
            PG8_BAR; PG8_WAIT_L(0); PG8_MMA(1, 0, At, B0); PG8_BAR; PG8_SCHED;
            PG8_STAGE(PG8_SB(0, 1), b2 + hstep, voffB);
            PG8_WAIT_V(6); PG8_BAR; PG8_MMA(1, 1, At, B1); PG8_BAR;
            PG8_LDB(B0, 1, 0); PG8_SCHED; PG8_LDA(At, 1, 0); PG8_STAGE(PG8_SA(0, 1), a2 + hstep, voffA);
            PG8_WAIT_L(8); PG8_BAR; PG8_WAIT_L(0); PG8_MMA(0, 0, At, B0); PG8_BAR; PG8_SCHED;
            PG8_LDB(B1, 1, 1); PG8_STAGE(PG8_SB(1, 0), b3, voffB);
            PG8_BAR; PG8_WAIT_L(0); PG8_MMA(0, 1, At, B1); PG8_BAR;
            PG8_LDA(At, 1, 1); PG8_STAGE(PG8_SA(1, 0), a3, voffA);
            PG8_BAR; PG8_WAIT_L(0); PG8_MMA(1, 0, At, B0); PG8_BAR; PG8_SCHED;
            PG8_STAGE(PG8_SB(1, 1), b3 + hstep, voffB);
            PG8_WAIT_V(6); PG8_BAR; PG8_MMA(1, 1, At, B1); PG8_BAR;
            }
        }
        if constexpr (ALIGN_EPI) { if (wr == 0) PG8_BAR; }
        if constexpr (!Epi::AFTER_DRAIN) { E(acc, cur, wr, wc, fr, fq); S.done(cur); }
        if (!has_next) break;
#pragma unroll
        for (int a = 0; a < 2; ++a)
#pragma unroll
            for (int b = 0; b < 2; ++b)
#pragma unroll
                for (int m = 0; m < 4; ++m)
#pragma unroll
                    for (int n = 0; n < 2; ++n) acc[a][b][m][n] = (f32x4){0.f, 0.f, 0.f, 0.f};
        cur = nxt; cA = nA; cB = nB; ++ui;
        if constexpr (ALIGN_EPI) { if (wr == 1) PG8_BAR; }
    }
    PG8_WAIT_V(0);
    if constexpr (!ALIGN_EPI) { if (wr == 0) PG8_BAR; }
    PG8_BAR;
    if constexpr (Epi::AFTER_DRAIN) { E.fused(acc, cur, wr, wc, fr, fq, lds, wid, lane); S.done(cur); }
#undef PG8_SA
#undef PG8_SB
#undef PG8_STAGE
#undef PG8_LDA
#undef PG8_LDB
#undef PG8_MMA
#undef PG8_WAIT_V
#undef PG8_WAIT_L
#undef PG8_BAR
#undef PG8_SCHED
}
}

#define LAS __attribute__((address_space(3)))
#define XB_TMO      128
#define XB_XCNT(j)  (256  + 64 * (j))
#define XB_XSUB(j)  (1280 + 64 * (j))
#define XB_XGEN(j)  (2304 + 64 * (j))
#define XB_TOP      3328
#define XB_TOPGEN   3392
#define XCD_BAR_WORDS 3456
#define XB_SPIN_CAP (1u << 26)

__device__ __forceinline__ unsigned xb_ld(unsigned* p)              { return __hip_atomic_load(p, __ATOMIC_RELAXED, __HIP_MEMORY_SCOPE_AGENT); }
__device__ __forceinline__ unsigned xb_add(unsigned* p, unsigned v) { return __hip_atomic_fetch_add(p, v, __ATOMIC_RELAXED, __HIP_MEMORY_SCOPE_AGENT); }
__device__ __forceinline__ unsigned xb_xcc_id() { return (unsigned)__builtin_amdgcn_s_getreg((3 << 11) | 20) & 0xFu; }
#define XB_SPIN(cond, bar) do { unsigned _sp = 0; while (cond) { __builtin_amdgcn_s_sleep(1); \
    if ((++_sp & 255u) == 0u) { if (xb_ld(&(bar)[XB_TMO])) break; if (_sp > XB_SPIN_CAP) { atomicAdd(&(bar)[XB_TMO], 1u); break; } } } } while (0)

struct XcdBarrier {
    unsigned* bar; unsigned x;
    volatile LAS unsigned* st;
};

__device__ __forceinline__ XcdBarrier xcd_barrier_post(unsigned* bar, volatile LAS unsigned* st) {
    XcdBarrier b; b.bar = bar; b.x = xb_xcc_id(); b.st = st;
    if (threadIdx.x == 0) (void)xb_add(&bar[XB_XCNT(b.x)], 1u);
    return b;
}
__device__ __forceinline__ void xcd_barrier_complete(unsigned* bar, unsigned x, unsigned& nloc, unsigned& nx) {
    const unsigned G = gridDim.x * gridDim.y * gridDim.z;
    unsigned sum, cnt, mine, sp = 0u;
    for (;;) {
        sum = 0u; cnt = 0u; mine = 0u;
#pragma unroll
        for (unsigned j = 0; j < 16; ++j) { const unsigned c = xb_ld(&bar[XB_XCNT(j)]); sum += c; cnt += (c > 0u) ? 1u : 0u; mine = (j == x) ? c : mine; }
        if (sum == G) break;
        __builtin_amdgcn_s_sleep(1);
        if ((++sp & 255u) == 0u) { if (xb_ld(&bar[XB_TMO])) break; if (sp > XB_SPIN_CAP) { atomicAdd(&bar[XB_TMO], 1u); break; } }
    }
    nloc = mine > 0u ? mine : 1u; nx = cnt > 0u ? cnt : 1u;
}

__device__ __forceinline__ void xcd_barrier(const XcdBarrier& b) {
    asm volatile("s_waitcnt vmcnt(0)" ::: "memory");
    __syncthreads();
    if (threadIdx.x == 0) {
        unsigned* bar = b.bar;
        __builtin_amdgcn_s_waitcnt(0);
        unsigned nloc = b.st[0], nx = b.st[1];
        if (nloc == 0u) { xcd_barrier_complete(bar, b.x, nloc, nx); b.st[0] = nloc; b.st[1] = nx; }
        const unsigned old = xb_add(&bar[XB_XSUB(b.x)], 1u);
        const unsigned gen = old / nloc;
        if (old + 1u == (gen + 1u) * nloc) {
            __builtin_amdgcn_fence(__ATOMIC_RELEASE, "agent");
            asm volatile("s_waitcnt vmcnt(0)" ::: "memory");
            const unsigned og = xb_add(&bar[XB_TOP], 1u);
            const unsigned tg = og / nx;
            if (og + 1u == (tg + 1u) * nx) xb_add(&bar[XB_TOPGEN], 1u);
            else XB_SPIN(xb_ld(&bar[XB_TOPGEN]) == tg, bar);
            __builtin_amdgcn_fence(__ATOMIC_ACQUIRE, "agent");
            xb_add(&bar[XB_XGEN(b.x)], 1u);
            asm volatile("s_waitcnt vmcnt(0)" ::: "memory");
        } else {
            XB_SPIN(xb_ld(&bar[XB_XGEN(b.x)]) == gen, bar);
            __builtin_amdgcn_fence(__ATOMIC_ACQUIRE, "agent");
            asm volatile("s_waitcnt vmcnt(0)" ::: "memory");
        }
    }
    __syncthreads();
}

#ifndef PG8_SP2
#define PG8_SP2 true
#endif
#ifndef PG8_ALIGN
#define PG8_ALIGN true
#endif
#ifndef PROBE_ON
#define PROBE_ON 0
#define PROBE_A 0
#define PROBE_B 1
#endif
#ifndef MK_PER_PHASE
#define MK_PER_PHASE 0
#endif

constexpr int T = 16384, NSMP = 32, TS = T + NSMP, TSP = T + 256, DM = 1024;
constexpr int PA = 3368, PAP = 3584;
constexpr int C_Q = 0, C_KC = 512, C_VC = 640, C_KS = 768, C_VS = 896, C_KW = 1024, C_VW = 1152, C_GATE = 1280,
              C_GQKV = 1304, C_A = 2840, C_BT = 2848, C_Z = 2856;
constexpr int DFF = 2816, DFF2 = 5632;
constexpr float DN_ALPHA = 1.4142135623730951f;
constexpr float LN_EPS = 1e-5f, NORM_EPS = 1e-6f;
constexpr int NPAGES = 128;
constexpr int NWAVES = 8, NTHR = 512;

constexpr size_t O_Y_P = 0;
constexpr size_t O_Y_S = O_Y_P + (size_t)T * DM;
constexpr size_t O_CMP_P = O_Y_S + (size_t)NSMP * DM;
constexpr size_t O_CMP_S = O_CMP_P + (size_t)T * 256;
constexpr size_t O_SLC_P = O_CMP_S + (size_t)NSMP * 256;
constexpr size_t O_SLC_S = O_SLC_P + (size_t)T * 256;
constexpr size_t O_WIN_P = O_SLC_S + (size_t)NSMP * 256;
constexpr size_t O_WIN_S = O_WIN_P + (size_t)512 * 256;
constexpr size_t O_GCONV_P = O_WIN_S + (size_t)NSMP * 512 * 256;
constexpr size_t O_GCONV_S = O_GCONV_P + (size_t)3 * 1536;
constexpr size_t O_GS_P = O_GCONV_S + (size_t)NSMP * 3 * 1536;
constexpr size_t O_GS_S = O_GS_P + (size_t)8 * 64 * 64;
constexpr size_t O_DIL_P = O_GS_S + (size_t)NSMP * 8 * 64 * 64;
constexpr size_t O_DIL_S = O_DIL_P + (size_t)2048 * 2048;
constexpr size_t O_FFN_P = O_DIL_S + (size_t)NSMP * 2048 * 2048;
constexpr size_t O_FFN_S = O_FFN_P + (size_t)2 * 2 * DFF2;
constexpr size_t O_END = O_FFN_S + (size_t)NSMP * 2 * 2 * DFF2;

constexpr int RING_BYTES = 131072;
constexpr int FAST_WL = 17408;
constexpr int MISC_OFF = 8 * FAST_WL + 64;
constexpr int LDS_BYTES = 147456;

typedef unsigned short bf16;
typedef unsigned v4u __attribute__((ext_vector_type(4)));

__device__ __forceinline__ unsigned f2bf(float f) { return (unsigned)__builtin_bit_cast(unsigned short, (__bf16)f); }
__device__ __forceinline__ unsigned pk2(float lo, float hi) { return pg8::cvt_pk_bf16(lo, hi); }
typedef short bf16x8 __attribute__((ext_vector_type(8)));
typedef float f32x4 __attribute__((ext_vector_type(4)));
#define MFMA16(a, b, c) __builtin_amdgcn_mfma_f32_16x16x32_bf16((a), (b), (c), 0, 0, 0)
__device__ __forceinline__ float wave_sum(float v) {
#pragma unroll
    for (int o = 1; o < 64; o <<= 1) v += __shfl_xor(v, o);
    return v;
}
__device__ __forceinline__ float wave_max(float v) {
#pragma unroll
    for (int o = 1; o < 64; o <<= 1) v = fmaxf(v, __shfl_xor(v, o));
    return v;
}
__device__ __forceinline__ void wave_lds_sync() { asm volatile("s_waitcnt lgkmcnt(0)" ::: "memory"); __builtin_amdgcn_wave_barrier(); asm volatile("" ::: "memory"); }
__device__ __forceinline__ float sigmoidf_(float x) { return 1.f / (1.f + expf(-x)); }
__device__ __forceinline__ float siluf_(float x) { return x / (1.f + expf(-x)); }
__device__ __forceinline__ float gelu_tanh(float x) { const float c = 0.7978845608028654f; return 0.5f * x * (1.f + tanhf(c * (x + 0.044715f * x * x * x))); }
__device__ __forceinline__ float softplusf_(float x) { return x > 20.f ? x : log1pf(expf(x)); }

struct KP {
    const float *x_prompt, *x_sample, *cache_cmp, *cache_slc, *st_win, *st_gconv, *st_gS, *st_dil, *st_ffn;
    const int* page_table;
    const float *w_in_a, *cw1, *cb1, *cw2, *cpe, *gconv_w, *gA, *gdt, *gnw, *w_out_a, *w_in_c, *w_out_c, *ln_mix_g, *ln_mix_b,
                *ffn_w_in, *ffn_cw, *ffn_cb, *ffn_w_out, *ln_ffn_g, *ln_ffn_b;
    float* out;
    unsigned* ctl;
    bf16 *WT_A, *WT_OA, *WT_FI0, *WT_FI1, *WT_FO0, *WT_FO1, *WT_CI, *WT_CO;
    float2* ROPE;
    bf16 *ACTB, *MIXB, *HFFB;
    bf16 *QB, *KSF, *VSF, *KWF, *VWF, *CKF, *CVF;
    unsigned char *KS8, *VS8;
    bf16 *QDB; bf16* DKF[3]; bf16* DVF[3];
    bf16 *AC, *WT_C, *HID, *W2T, *ACP; float* SMIXF; float* NSACC; int* SEL; float* UB;
    bf16 *G_WF, *G_KDF, *G_QGF, *G_QKF, *G_SPF, *G_VNF; float *G_UF, *G_GL;
    float *BIGF, *MO, *X1, *X2, *X3, *QR, *KS, *VS, *KW, *VW, *CK, *CV, *GQ, *GK, *GV, *OG, *Gg, *Gb, *QD, *KD;
    int ph_lo, ph_hi;
};

struct Fr { unsigned char* lds; int tid, lane, wave, gw, NGW, bid, G; };

__device__ __forceinline__ int ffn_row(int u) { const int half = u >= DFF ? 1 : 0, jc = u - half * DFF; return 256 * (jc >> 7) + 128 * half + (jc & 127); }
__device__ __forceinline__ void transpose_item(const float* W, int K, int N, int NT, bf16* WT, float* scr, int item, int lane, int rowmap = 0) {
    const int nblk = NT / 32, kb = item / nblk, nb = item % nblk, k0 = 64 * kb, n0 = 32 * nb;
#pragma unroll 8
    for (int i = 0; i < 32; ++i) { const int kk = 2 * i + (lane >> 5); const int n = n0 + (lane & 31); scr[kk * 33 + (lane & 31)] = (n < N) ? W[(size_t)(k0 + kk) * N + n] : 0.f; }
    wave_lds_sync();
    const int c = lane & 7;
#pragma unroll
    for (int j = 0; j < 4; ++j) { const int n = (lane >> 3) + 8 * j; const float* s = scr + (8 * c) * 33 + n;
        v4u o; o.x = pk2(s[0 * 33], s[1 * 33]); o.y = pk2(s[2 * 33], s[3 * 33]); o.z = pk2(s[4 * 33], s[5 * 33]); o.w = pk2(s[6 * 33], s[7 * 33]);
        const int row = rowmap ? ffn_row(n0 + n) : n0 + n;
        *(v4u*)(WT + (size_t)row * K + k0 + 8 * c) = o; }
    wave_lds_sync();
}
__device__ __forceinline__ void ph_prologue(const KP& p, const Fr& F) {
    float* scr = (float*)(F.lds + F.wave * 16384);
    const int I_A = 16 * (PAP / 32), I_OA = 16 * 32, I_FI = 16 * (DFF2 / 32), I_FO = (DFF / 64) * 32, I_CI = 16 * (3072 / 32), I_CO = 16 * 32;
    const int NITEMS = I_A + I_OA + 2 * I_FI + 2 * I_FO + I_CI + I_CO + 256 + 8;
    for (int it = F.gw; it < NITEMS; it += F.NGW) {
        int r = it;
        if (r < I_A) { transpose_item(p.w_in_a, DM, PA, PAP, p.WT_A, scr, r, F.lane); continue; } r -= I_A;
        if (r < I_OA) { transpose_item(p.w_out_a, DM, DM, DM, p.WT_OA, scr, r, F.lane); continue; } r -= I_OA;
        if (r < I_FI) { transpose_item(p.ffn_w_in, DM, DFF2, DFF2, p.WT_FI0, scr, r, F.lane, 1); continue; } r -= I_FI;
        if (r < I_FI) { transpose_item(p.ffn_w_in + (size_t)DM * DFF2, DM, DFF2, DFF2, p.WT_FI1, scr, r, F.lane, 1); continue; } r -= I_FI;
        if (r < I_FO) { transpose_item(p.ffn_w_out, DFF, DM, DM, p.WT_FO0, scr, r, F.lane); continue; } r -= I_FO;
        if (r < I_FO) { transpose_item(p.ffn_w_out + (size_t)DFF * DM, DFF, DM, DM, p.WT_FO1, scr, r, F.lane); continue; } r -= I_FO;
        if (r < I_CI) { transpose_item(p.w_in_c, DM, 3072, 3072, p.WT_CI, scr, r, F.lane); continue; } r -= I_CI;
        if (r < I_CO) { transpose_item(p.w_out_c, DM, DM, DM, p.WT_CO, scr, r, F.lane); continue; } r -= I_CO;
        if (r < 256) { const int kv = r >> 7; transpose_item(p.cw1 + (size_t)kv * 2048 * 128, 2048, 128, 128, p.WT_C + (size_t)kv * 128 * 2048, scr, r & 127, F.lane); continue; } r -= 256;
        { const int kv = r >> 2; transpose_item(p.cw2 + (size_t)kv * 128 * 64, 128, 64, 64, p.W2T + (size_t)kv * 64 * 128, scr, r & 3, F.lane); }
    }
    const size_t gt = (size_t)F.bid * NTHR + F.tid, GT = (size_t)F.G * NTHR;
    for (size_t i4 = gt; i4 < (size_t)TSP * (DM / 4); i4 += GT) {
        const int r = (int)(i4 / (DM / 4)), c4 = (int)(i4 % (DM / 4));
        float4 v = make_float4(0.f, 0.f, 0.f, 0.f);
        if (r < T) v = ((const float4*)p.x_prompt)[(size_t)r * (DM / 4) + c4]; else if (r < TS) v = ((const float4*)p.x_sample)[(size_t)(r - T) * (DM / 4) + c4];
        uint2 o; o.x = pk2(v.x, v.y); o.y = pk2(v.z, v.w);
        ((uint2*)p.ACTB)[i4] = o;
    }
    for (size_t idx = gt; idx < (size_t)(T + 1) * 32; idx += GT) {
        const int pos = (int)(idx >> 5), i = (int)(idx & 31);
        const float inv = (float)pow(10000.0, -2.0 * (double)i / 64.0);
        const float ang = (float)pos * inv;
        p.ROPE[idx] = make_float2((float)cos((double)ang), (float)sin((double)ang));
    }
}

__device__ __forceinline__ size_t vfrag_elem(int key, int d);
__device__ __forceinline__ size_t kfrag_elem(int key, int d);
__device__ __forceinline__ bf16x8 pack_p(const f32x4& p0, const f32x4& p1);
template <bool FFNMAP = false>
__device__ __forceinline__ void skinny_gemm(const Fr& F, const bf16* A, const bf16* Bt, int K, int ncols, float* C, int ldc) {
    const int lane = F.lane, l15 = lane & 15, grp = lane >> 4;
    const bf16* a0 = A + (size_t)(T + l15) * K + 8 * grp; const bf16* a1 = a0 + (size_t)16 * K;
    for (int nt = F.gw; nt * 16 < ncols; nt += F.NGW) {
        const bf16* bp = Bt + (size_t)(nt * 16 + l15) * K + 8 * grp;
        f32x4 c0 = {0.f, 0.f, 0.f, 0.f}, c1 = {0.f, 0.f, 0.f, 0.f};
#pragma unroll 4
        for (int k = 0; k < K; k += 32) {
            const bf16x8 b = *(const bf16x8*)(bp + k), x0 = *(const bf16x8*)(a0 + k), x1 = *(const bf16x8*)(a1 + k);
            c0 = MFMA16(x0, b, c0); c1 = MFMA16(x1, b, c1);
        }
        int n = nt * 16 + l15;
        if (FFNMAP) n = ((n >> 7) & 1) * DFF + (n >> 8) * 128 + (n & 127);
        if (n < ncols) {
#pragma unroll
            for (int r = 0; r < 4; ++r) { C[(size_t)(T + 4 * grp + r) * ldc + n] = c0[r]; C[(size_t)(T + 16 + 4 * grp + r) * ldc + n] = c1[r]; }
        }
    }
}
__device__ __forceinline__ void ph_gemm_f32(const Fr& F, const bf16* A, const bf16* Bt, int N, int K, float* C, int ldc, int ncols) {
    skinny_gemm(F, A, Bt, K, ncols, C, ldc);
    pg8::Gemm g{A, Bt, T, N, K}; pg8::StaticOrder S; S.init(T, N, F.G, F.bid);
    pg8::EpiF32 E{C, ldc, ncols};
    pg8::gemm_phase<pg8::EpiF32, pg8::StaticOrder, PG8_ALIGN, PG8_SP2>((PG8_LAS unsigned char*)F.lds, g, S, E);
}
__device__ __forceinline__ float dpp_ror1(float x) { return __int_as_float(__builtin_amdgcn_update_dpp(0, __float_as_int(x), 0x121, 0xf, 0xf, false)); }
__device__ __forceinline__ float dpp_ror2(float x) { return __int_as_float(__builtin_amdgcn_update_dpp(0, __float_as_int(x), 0x122, 0xf, 0xf, false)); }
struct EpiFfn {
    static constexpr bool PERM = true, AFTER_DRAIN = false;
    bf16* H; float* UB; const float* cw; const float* cb;
    __device__ __forceinline__ void operator()(const pg8::f32x4 (&acc)[2][2][4][2], const pg8::Unit& u, int wr, int wc, int fr, int fq) const {
#pragma unroll
        for (int n = 0; n < 2; ++n) {
            const int jc = u.pn * 128 + wc * 32 + 8 * fq + 4 * n;
            pg8::f32x4 w0[2], w1[2], w2[2], bb[2];
#pragma unroll
            for (int bj = 0; bj < 2; ++bj) { const int uc = bj * DFF + jc;
                w0[bj] = *(const pg8::f32x4*)(cw + uc); w1[bj] = *(const pg8::f32x4*)(cw + DFF2 + uc); w2[bj] = *(const pg8::f32x4*)(cw + 2 * DFF2 + uc); bb[bj] = *(const pg8::f32x4*)(cb + uc); }
#pragma unroll
            for (int ai = 0; ai < 2; ++ai) {
                const int sl = u.pm * 4 + ai * 2 + wr;
                pg8::f32x4 pr1[2], pr2[2];
#pragma unroll
                for (int m = 0; m < 4; ++m) {
                    pg8::f32x4 c[2];
#pragma unroll
                    for (int bj = 0; bj < 2; ++bj) {
                        const pg8::f32x4 uu = acc[ai][bj][m][n]; pg8::f32x4 r1, r2;
#pragma unroll
                        for (int e = 0; e < 4; ++e) { r1[e] = dpp_ror1(uu[e]); r2[e] = dpp_ror2(uu[e]); }
                        pg8::f32x4 p1 = r1, p2 = r2;
                        if (m > 0) { if (fr == 0) p1 = pr1[bj]; if (fr < 2) p2 = pr2[bj]; }
                        c[bj] = bb[bj] + w0[bj] * p2 + w1[bj] * p1 + w2[bj] * uu;
                        pr1[bj] = r1; pr2[bj] = r2;
                        const int uc = bj * DFF + jc;
                        if (m == 0 && fr < 2) *(pg8::f32x4*)(UB + ((size_t)sl * 4 + fr) * DFF2 + uc) = uu;
                        if (m == 3 && fr >= 14) *(pg8::f32x4*)(UB + ((size_t)sl * 4 + 2 + (fr - 14)) * DFF2 + uc) = uu;
                    }
                    if (!(m == 0 && fr < 2)) {
                        const int t = u.pm * 256 + ai * 128 + wr * 64 + m * 16 + fr;
                        uint2 o; o.x = pk2(siluf_(c[0][0]) * c[1][0], siluf_(c[0][1]) * c[1][1]); o.y = pk2(siluf_(c[0][2]) * c[1][2], siluf_(c[0][3]) * c[1][3]);
                        *(uint2*)(H + (size_t)t * DFF + jc) = o;
                    }
                }
            }
        }
    }
};
__device__ __forceinline__ void ph_ffn_gemm(const KP& p, const Fr& F, const bf16* Bt, int layer) {
    skinny_gemm<true>(F, p.ACTB, Bt, DM, DFF2, p.BIGF, DFF2);
    pg8::Gemm g{p.ACTB, Bt, T, DFF2, DM}; pg8::StaticOrder S; S.init(T, DFF2, F.G, F.bid);
    EpiFfn E{p.HFFB, p.UB, p.ffn_cw + (size_t)layer * 3 * DFF2, p.ffn_cb + (size_t)layer * DFF2};
    pg8::gemm_phase<EpiFfn, pg8::StaticOrder, PG8_ALIGN, PG8_SP2>((PG8_LAS unsigned char*)F.lds, g, S, E);
}
__device__ __forceinline__ void ph_ffn_fix(const KP& p, const Fr& F, int layer) {
    const float* cw = p.ffn_cw + (size_t)layer * 3 * DFF2; const float* cb = p.ffn_cb + (size_t)layer * DFF2; const float* U = p.BIGF;
    const int gt = F.bid * NTHR + F.tid, GT = F.G * NTHR;
    for (int idx = gt; idx < 512 * DFF; idx += GT) {
        const int rr = idx / DFF, j = idx - rr * DFF; const int sl = rr >> 1, q = rr & 1;
        float c2[2];
#pragma unroll
        for (int half = 0; half < 2; ++half) { const int ch = half * DFF + j;
            const float u0 = p.UB[((size_t)sl * 4 + q) * DFF2 + ch];
            const float um1 = q ? p.UB[((size_t)sl * 4) * DFF2 + ch] : (sl ? p.UB[((size_t)(sl - 1) * 4 + 3) * DFF2 + ch] : 0.f);
            const float um2 = sl ? p.UB[((size_t)(sl - 1) * 4 + 2 + q) * DFF2 + ch] : 0.f;
            c2[half] = cb[ch] + cw[ch] * um2 + cw[DFF2 + ch] * um1 + cw[2 * DFF2 + ch] * u0; }
        p.HFFB[(size_t)(64 * sl + q) * DFF + j] = (bf16)f2bf(siluf_(c2[0]) * c2[1]);
    }
    for (int idx = gt; idx < NSMP * DFF; idx += GT) {
        const int b = idx / DFF, j = idx - b * DFF;
        float c2[2];
#pragma unroll
        for (int half = 0; half < 2; ++half) { const int ch = half * DFF + j;
            const float* hs = p.st_ffn + (((size_t)b * 2 + layer) * 2) * DFF2 + ch;
            c2[half] = cb[ch] + cw[ch] * hs[0] + cw[DFF2 + ch] * hs[DFF2] + cw[2 * DFF2 + ch] * U[(size_t)(T + b) * DFF2 + ch]; }
        p.HFFB[(size_t)(T + b) * DFF + j] = (bf16)f2bf(siluf_(c2[0]) * c2[1]);
    }
    for (int idx = gt; idx < 2 * DFF2; idx += GT) { const int k = idx / DFF2, ch = idx - k * DFF2;
        p.out[O_FFN_P + ((size_t)layer * 2 + k) * DFF2 + ch] = p.UB[((size_t)255 * 4 + 2 + k) * DFF2 + ch]; }
    for (int idx = gt; idx < NSMP * 2 * DFF2; idx += GT) { const int b = idx / (2 * DFF2), k = (idx / DFF2) & 1, ch = idx % DFF2;
        p.out[O_FFN_S + (((size_t)b * 2 + layer) * 2 + k) * DFF2 + ch] = (k == 0) ? p.st_ffn[(((size_t)b * 2 + layer) * 2 + 1) * DFF2 + ch] : U[(size_t)(T + b) * DFF2 + ch]; }
}
struct EpiCmp {
    static constexpr bool PERM = false, AFTER_DRAIN = false;
    bf16* HID; const float* b1;
    __device__ __forceinline__ void operator()(const pg8::f32x4 (&acc)[2][2][4][2], const pg8::Unit& u, int wr, int wc, int fr, int fq) const {
#pragma unroll
        for (int ai = 0; ai < 2; ++ai)
#pragma unroll
            for (int m = 0; m < 4; ++m) { const int combo = u.pm * 128 + wr * 64 + m * 16 + fr;
#pragma unroll
                for (int n = 0; n < 2; ++n) { const int j0 = wc * 32 + n * 16 + 4 * fq; const pg8::f32x4 v = acc[ai][ai][m][n]; const float* bb = b1 + ai * 128 + j0;
                    uint2 o; o.x = pk2(gelu_tanh(v[0] + bb[0]), gelu_tanh(v[1] + bb[1])); o.y = pk2(gelu_tanh(v[2] + bb[2]), gelu_tanh(v[3] + bb[3]));
                    *(uint2*)(HID + ((size_t)combo * 2 + ai) * 128 + j0) = o; } }
    }
};
__device__ __forceinline__ void ph_cmp_gemm(const KP& p, const Fr& F) {
    pg8::Gemm g{p.AC, p.WT_C, 65536, 256, 2048}; pg8::StaticOrder S; S.init(65536, 256, F.G, F.bid);
    EpiCmp E{p.HID, p.cb1};
    pg8::gemm_phase<EpiCmp, pg8::StaticOrder, PG8_ALIGN, PG8_SP2>((PG8_LAS unsigned char*)F.lds, g, S, E);
}
__device__ __forceinline__ void ph_cmp_stage2(const KP& p, const Fr& F) {
    const int lane = F.lane, l15 = lane & 15, grp = lane >> 4;
    for (int tile = F.gw; tile < 4096; tile += F.NGW) {
        const int kv = tile & 1, combo0 = (tile >> 1) * 16;
        const bf16* hid = p.HID + ((size_t)(combo0 + l15) * 2 + kv) * 128 + 8 * grp; const bf16* w2 = p.W2T + (size_t)kv * 64 * 128 + (size_t)l15 * 128 + 8 * grp;
        f32x4 acc[4];
#pragma unroll
        for (int nt = 0; nt < 4; ++nt) acc[nt] = (f32x4){0.f, 0.f, 0.f, 0.f};
#pragma unroll
        for (int ks = 0; ks < 4; ++ks) { const bf16x8 a = *(const bf16x8*)(hid + 32 * ks);
#pragma unroll
            for (int nt = 0; nt < 4; ++nt) acc[nt] = MFMA16(a, *(const bf16x8*)(w2 + (size_t)nt * 16 * 128 + 32 * ks), acc[nt]); }
#pragma unroll
        for (int r = 0; r < 4; ++r) {
            const int combo = combo0 + 4 * grp + r; const int g = combo & 1, c = (combo >> 1) & 511, b = combo >> 10;
            float* dst = ((kv == 0) ? p.CK : p.CV) + (((size_t)(1 + b) * 512 + c) * 2 + g) * 64;
            if (kv == 0) {
                const int pos = (c + 1) * 32 - 1;
#pragma unroll
                for (int nt = 0; nt < 2; ++nt) { const float2 cs = p.ROPE[pos * 32 + 16 * nt + l15]; const float x1 = acc[nt][r], x2 = acc[nt + 2][r];
                    dst[16 * nt + l15] = x1 * cs.x - x2 * cs.y; dst[16 * (nt + 2) + l15] = x2 * cs.x + x1 * cs.y; }
            } else {
#pragma unroll
                for (int nt = 0; nt < 4; ++nt) dst[16 * nt + l15] = acc[nt][r];
            }
        }
    }
}
__device__ __forceinline__ void cmp_prompt_unit(const KP& p, int unit, int lane) {
    asm volatile("" : "+v"(lane));
    const int l15 = lane & 15, grp = lane >> 4;
    const int kv = unit & 1, combo = (unit >> 1) * 16 + l15; const int g = combo & 1, c = combo >> 1;
    const bf16* w1 = p.WT_C + ((size_t)kv * 128 + l15) * 2048 + 8 * grp;
    f32x4 acc[8];
#pragma unroll
    for (int jt = 0; jt < 8; ++jt) acc[jt] = (f32x4){0.f, 0.f, 0.f, 0.f};
    const bf16* fl = p.ACP + ((size_t)kv * 1024 + combo) * 2048 + 8 * grp;
#pragma unroll 4
    for (int ks = 0; ks < 64; ++ks) {
        const bf16x8 fb = *(const bf16x8*)(fl + 32 * ks);
#pragma unroll
        for (int jt = 0; jt < 8; ++jt) acc[jt] = MFMA16(*(const bf16x8*)(w1 + (size_t)jt * 16 * 2048 + 32 * ks), fb, acc[jt]);
    }
    bf16x8 hb[4];
#pragma unroll
    for (int s2 = 0; s2 < 4; ++s2) {
        f32x4 h0, h1;
#pragma unroll
        for (int r = 0; r < 4; ++r) { h0[r] = gelu_tanh(acc[2 * s2][r] + p.cb1[kv * 128 + 32 * s2 + 4 * grp + r]); h1[r] = gelu_tanh(acc[2 * s2 + 1][r] + p.cb1[kv * 128 + 32 * s2 + 16 + 4 * grp + r]); }
        hb[s2] = pack_p(h0, h1);
    }
    f32x4 o[4];
#pragma unroll
    for (int dt = 0; dt < 4; ++dt) {
        o[dt] = (f32x4){0.f, 0.f, 0.f, 0.f};
        const bf16* w2 = p.W2T + (size_t)kv * 64 * 128 + (size_t)(16 * dt + l15) * 128 + 4 * grp;
#pragma unroll
        for (int s2 = 0; s2 < 4; ++s2) { const uint2 x0 = *(const uint2*)(w2 + 32 * s2), x1 = *(const uint2*)(w2 + 32 * s2 + 16);
            union { v4u u; bf16x8 b; } wa; wa.u.x = x0.x; wa.u.y = x0.y; wa.u.z = x1.x; wa.u.w = x1.y;
            o[dt] = MFMA16(wa.b, hb[s2], o[dt]); }
    }
    if (kv == 0) {
        const int pos = (c + 1) * 32 - 1;
#pragma unroll
        for (int dt = 0; dt < 2; ++dt)
#pragma unroll
            for (int r = 0; r < 4; ++r) { const float2 cs = p.ROPE[pos * 32 + 16 * dt + 4 * grp + r]; const float x1 = o[dt][r], x2 = o[dt + 2][r];
                o[dt][r] = x1 * cs.x - x2 * cs.y; o[dt + 2][r] = x2 * cs.x + x1 * cs.y; }
    }
#pragma unroll
    for (int dt = 0; dt < 4; ++dt)
#pragma unroll
        for (int r = 0; r < 4; ++r) { const int d = 16 * dt + 4 * grp + r;
            if (kv == 0) p.CKF[(size_t)g * 512 * 64 + kfrag_elem(c, d)] = (bf16)f2bf(o[dt][r]); else p.CVF[(size_t)g * 512 * 64 + vfrag_elem(c, d)] = (bf16)f2bf(o[dt][r]); }
}
__device__ __forceinline__ void cmp_sample_unit(const KP& p, int unit, int lane) {
    asm volatile("" : "+v"(lane));
    const int l15 = lane & 15, grp = lane >> 4;
    const int b = unit >> 6, kv = (unit >> 5) & 1, cb = unit & 31;
    const bf16* w1 = p.WT_C + ((size_t)kv * 128 + l15) * 2048 + 8 * grp;
    const float* src[2];
#pragma unroll
    for (int cg = 0; cg < 2; ++cg) { const int combo = cb * 32 + 16 * cg + l15; const int g = combo & 1, c = combo >> 1;
        const int page = p.page_table[b * NPAGES + (c >> 2)];
        src[cg] = p.cache_cmp + (((size_t)page * 128 + (c & 3) * 32) * 4 + kv * 2 + g) * 64 + 8 * grp; }
    const float* pe = p.cpe + (size_t)kv * 32 * 64 + 8 * grp;
    f32x4 acc[2][8];
#pragma unroll
    for (int cg = 0; cg < 2; ++cg)
#pragma unroll
        for (int jt = 0; jt < 8; ++jt) acc[cg][jt] = (f32x4){0.f, 0.f, 0.f, 0.f};
#pragma unroll 2
    for (int ks = 0; ks < 64; ++ks) {
        const int i = ks >> 1, dd = 32 * (ks & 1);
        const float4 e0 = *(const float4*)(pe + i * 64 + dd), e1 = *(const float4*)(pe + i * 64 + dd + 4);
        bf16x8 fb[2];
#pragma unroll
        for (int cg = 0; cg < 2; ++cg) { const float4 a0 = *(const float4*)(src[cg] + i * 256 + dd), a1 = *(const float4*)(src[cg] + i * 256 + dd + 4);
            union { v4u u; bf16x8 b; } t; t.u.x = pk2(a0.x + e0.x, a0.y + e0.y); t.u.y = pk2(a0.z + e0.z, a0.w + e0.w); t.u.z = pk2(a1.x + e1.x, a1.y + e1.y); t.u.w = pk2(a1.z + e1.z, a1.w + e1.w); fb[cg] = t.b; }
#pragma unroll
        for (int jt = 0; jt < 8; ++jt) { const bf16x8 wa = *(const bf16x8*)(w1 + (size_t)jt * 16 * 2048 + 32 * ks);
            acc[0][jt] = MFMA16(wa, fb[0], acc[0][jt]); acc[1][jt] = MFMA16(wa, fb[1], acc[1][jt]); }
    }
#pragma unroll
    for (int cg = 0; cg < 2; ++cg) {
        const int combo = cb * 32 + 16 * cg + l15; const int g = combo & 1, c = combo >> 1;
        bf16x8 hb[4];
#pragma unroll
        for (int s2 = 0; s2 < 4; ++s2) { f32x4 h0, h1;
#pragma unroll
            for (int r = 0; r < 4; ++r) { h0[r] = gelu_tanh(acc[cg][2 * s2][r] + p.cb1[kv * 128 + 32 * s2 + 4 * grp + r]); h1[r] = gelu_tanh(acc[cg][2 * s2 + 1][r] + p.cb1[kv * 128 + 32 * s2 + 16 + 4 * grp + r]); }
            hb[s2] = pack_p(h0, h1); }
        f32x4 o[4];
#pragma unroll
        for (int dt = 0; dt < 4; ++dt) {
            o[dt] = (f32x4){0.f, 0.f, 0.f, 0.f};
            const bf16* w2 = p.W2T + (size_t)kv * 64 * 128 + (size_t)(16 * dt + l15) * 128 + 4 * grp;
#pragma unroll
            for (int s2 = 0; s2 < 4; ++s2) { const uint2 x0 = *(const uint2*)(w2 + 32 * s2), x1 = *(const uint2*)(w2 + 32 * s2 + 16);
                union { v4u u; bf16x8 b; } wa; wa.u.x = x0.x; wa.u.y = x0.y; wa.u.z = x1.x; wa.u.w = x1.y;
                o[dt] = MFMA16(wa.b, hb[s2], o[dt]); }
        }
        if (kv == 0) {
            const int pos = (c + 1) * 32 - 1;
#pragma unroll
            for (int dt = 0; dt < 2; ++dt)
#pragma unroll
                for (int r = 0; r < 4; ++r) { const float2 cs = p.ROPE[pos * 32 + 16 * dt + 4 * grp + r]; const float x1 = o[dt][r], x2 = o[dt + 2][r];
                    o[dt][r] = x1 * cs.x - x2 * cs.y; o[dt + 2][r] = x2 * cs.x + x1 * cs.y; }
        }
        float* dst = ((kv == 0) ? p.CK : p.CV) + (((size_t)(1 + b) * 512 + c) * 2 + g) * 64 + 4 * grp;
#pragma unroll
        for (int dt = 0; dt < 4; ++dt) *(f32x4*)(dst + 16 * dt) = o[dt];
    }
}
constexpr int W1S_PITCH = 528;
constexpr int W1S_BYTES = 128 * W1S_PITCH;
__device__ __forceinline__ void cmp_sample_wg(const KP& p, int wu, const Fr& F) {
    int lane = F.lane; asm volatile("" : "+v"(lane));
    const int l15 = lane & 15, grp = lane >> 4, tid = F.tid;
    const int b = wu >> 3, kv = (wu >> 2) & 1, q4 = wu & 3;
    const float* src[2];
#pragma unroll
    for (int cg = 0; cg < 2; ++cg) { const int combo = q4 * 256 + F.wave * 32 + 16 * cg + l15; const int g = combo & 1, c = combo >> 1;
        const int page = p.page_table[b * NPAGES + (c >> 2)];
        src[cg] = p.cache_cmp + (((size_t)page * 128 + (c & 3) * 32) * 4 + kv * 2 + g) * 64 + 8 * grp; }
    const float* pe = p.cpe + (size_t)kv * 32 * 64 + 8 * grp;
    const bf16* wg = p.WT_C + (size_t)kv * 128 * 2048;
    f32x4 acc[2][8];
#pragma unroll
    for (int cg = 0; cg < 2; ++cg)
#pragma unroll
        for (int jt = 0; jt < 8; ++jt) acc[cg][jt] = (f32x4){0.f, 0.f, 0.f, 0.f};
    v4u wreg[8];
#pragma unroll
    for (int k = 0; k < 8; ++k) { const int c = tid + 512 * k; wreg[k] = *(const v4u*)(wg + (size_t)(c >> 5) * 2048 + (c & 31) * 8); }
#pragma unroll
    for (int k = 0; k < 8; ++k) { const int c = tid + 512 * k; *(v4u*)(F.lds + (c >> 5) * W1S_PITCH + (c & 31) * 16) = wreg[k]; }
    __syncthreads();
#pragma unroll 1
    for (int sl = 0; sl < 8; ++sl) {
        if (sl + 1 < 8) {
#pragma unroll
            for (int k = 0; k < 8; ++k) { const int c = tid + 512 * k; wreg[k] = *(const v4u*)(wg + (size_t)(c >> 5) * 2048 + (sl + 1) * 256 + (c & 31) * 8); }
        }
        const unsigned char* wl = F.lds + (sl & 1) * W1S_BYTES + l15 * W1S_PITCH + grp * 16;
#pragma unroll 2
        for (int kk = 0; kk < 8; ++kk) {
            const int ks = sl * 8 + kk, i = ks >> 1, dd = 32 * (ks & 1);
            const float4 e0 = *(const float4*)(pe + i * 64 + dd), e1 = *(const float4*)(pe + i * 64 + dd + 4);
            bf16x8 fb[2];
#pragma unroll
            for (int cg = 0; cg < 2; ++cg) { const float4 a0 = *(const float4*)(src[cg] + i * 256 + dd), a1 = *(const float4*)(src[cg] + i * 256 + dd + 4);
                union { v4u u; bf16x8 b; } t; t.u.x = pk2(a0.x + e0.x, a0.y + e0.y); t.u.y = pk2(a0.z + e0.z, a0.w + e0.w); t.u.z = pk2(a1.x + e1.x, a1.y + e1.y); t.u.w = pk2(a1.z + e1.z, a1.w + e1.w); fb[cg] = t.b; }
#pragma unroll
            for (int jt = 0; jt < 8; ++jt) { const bf16x8 wa = *(const bf16x8*)(wl + jt * 16 * W1S_PITCH + kk * 64);
                acc[0][jt] = MFMA16(wa, fb[0], acc[0][jt]); acc[1][jt] = MFMA16(wa, fb[1], acc[1][jt]); }
        }
        if (sl + 1 < 8) {
#pragma unroll
            for (int k = 0; k < 8; ++k) { const int c = tid + 512 * k; *(v4u*)(F.lds + ((sl + 1) & 1) * W1S_BYTES + (c >> 5) * W1S_PITCH + (c & 31) * 16) = wreg[k]; }
        }
        __syncthreads();
    }
#pragma unroll
    for (int cg = 0; cg < 2; ++cg) {
        const int combo = q4 * 256 + F.wave * 32 + 16 * cg + l15; const int g = combo & 1, c = combo >> 1;
        bf16x8 hb[4];
#pragma unroll
        for (int s2 = 0; s2 < 4; ++s2) { f32x4 h0, h1;
#pragma unroll
            for (int r = 0; r < 4; ++r) { h0[r] = gelu_tanh(acc[cg][2 * s2][r] + p.cb1[kv * 128 + 32 * s2 + 4 * grp + r]); h1[r] = gelu_tanh(acc[cg][2 * s2 + 1][r] + p.cb1[kv * 128 + 32 * s2 + 16 + 4 * grp + r]); }
            hb[s2] = pack_p(h0, h1); }
        f32x4 o[4];
#pragma unroll
        for (int dt = 0; dt < 4; ++dt) {
            o[dt] = (f32x4){0.f, 0.f, 0.f, 0.f};
            const bf16* w2 = p.W2T + (size_t)kv * 64 * 128 + (size_t)(16 * dt + l15) * 128 + 4 * grp;
#pragma unroll
            for (int s2 = 0; s2 < 4; ++s2) { const uint2 x0 = *(const uint2*)(w2 + 32 * s2), x1 = *(const uint2*)(w2 + 32 * s2 + 16);
                union { v4u u; bf16x8 b; } wa; wa.u.x = x0.x; wa.u.y = x0.y; wa.u.z = x1.x; wa.u.w = x1.y;
                o[dt] = MFMA16(wa.b, hb[s2], o[dt]); }
        }
        if (kv == 0) {
            const int pos = (c + 1) * 32 - 1;
#pragma unroll
            for (int dt = 0; dt < 2; ++dt)
#pragma unroll
                for (int r = 0; r < 4; ++r) { const float2 cs = p.ROPE[pos * 32 + 16 * dt + 4 * grp + r]; const float x1 = o[dt][r], x2 = o[dt + 2][r];
                    o[dt][r] = x1 * cs.x - x2 * cs.y; o[dt + 2][r] = x2 * cs.x + x1 * cs.y; }
        }
        float* dst = ((kv == 0) ? p.CK : p.CV) + (((size_t)(1 + b) * 512 + c) * 2 + g) * 64 + 4 * grp;
#pragma unroll
        for (int dt = 0; dt < 4; ++dt) *(f32x4*)(dst + 16 * dt) = o[dt];
    }
}
__device__ __forceinline__ void ph_cmp_samples(const KP& p, const Fr& F) {
    for (int wu = F.bid; wu < 256; wu += F.G) cmp_sample_wg(p, wu, F);
}
__device__ __forceinline__ void ph_cmp_prompt(const KP& p, const Fr& F) {
    for (int unit = F.gw; unit < 128; unit += F.NGW) cmp_prompt_unit(p, unit, F.lane);
}

__device__ __forceinline__ float rope_val(const float* row, int base, int i, float2 cs) {
    const int ii = i & 31;
    const float x1 = row[base + ii], x2 = row[base + ii + 32];
    return (i < 32) ? (x1 * cs.x - x2 * cs.y) : (x2 * cs.x + x1 * cs.y);
}
__device__ __forceinline__ void ph_nsa_prep(const KP& p, const Fr& F) {
    const float* H0 = p.BIGF; float* out = p.out;
    const size_t gt = (size_t)F.bid * NTHR + F.tid, GT = (size_t)F.G * NTHR;
    const size_t total = (size_t)TS * 1280;
    for (size_t idx = gt + (size_t)T * 1280; idx < total; idx += GT) {
        const int r = (int)(idx / 1280), c = (int)(idx % 1280);
        const bool smp = r >= T; const int b = r - T; const int pos = smp ? T : r;
        const float* row = H0 + (size_t)r * PA;
        const int i = c & 63;
        const float2 cs = p.ROPE[pos * 32 + (i & 31)];
        if (c < 512) { p.QR[(size_t)r * 512 + c] = rope_val(row, c & ~63, i, cs); continue; }
        const int sec = (c - 512) >> 7; const int gd = (c - 512) & 127; const int base = c & ~63;
        float v;
        if (sec == 2 || sec == 4) v = rope_val(row, base, i, cs); else v = row[c];
        const int kv = sec & 1;
        if (sec < 2) {
            if (!smp) out[O_CMP_P + (size_t)r * 256 + kv * 128 + gd] = v; else out[O_CMP_S + (size_t)b * 256 + kv * 128 + gd] = v;
        } else if (sec < 4) {
            if (!smp) out[O_SLC_P + (size_t)r * 256 + kv * 128 + gd] = v; else out[O_SLC_S + (size_t)b * 256 + kv * 128 + gd] = v;
            if (kv == 0) p.KS[(size_t)r * 128 + gd] = v; else p.VS[(size_t)r * 128 + gd] = v;
        } else {
            if (kv == 0) p.KW[(size_t)r * 128 + gd] = v; else p.VW[(size_t)r * 128 + gd] = v;
            if (!smp) { if (r >= T - 512) out[O_WIN_P + (size_t)(r - (T - 512)) * 256 + kv * 128 + gd] = v; }
            else out[O_WIN_S + ((size_t)b * 512 + 511) * 256 + kv * 128 + gd] = v;
        }
    }
    const size_t tot2 = (size_t)NSMP * 511 * 256;
    for (size_t idx = gt; idx < tot2; idx += GT) {
        const int b = (int)(idx / (511 * 256)); const int rem = (int)(idx % (511 * 256));
        out[O_WIN_S + (size_t)b * 512 * 256 + rem] = p.st_win[(size_t)b * 512 * 256 + 256 + rem];
    }
}

constexpr float QSCALE = 0.18033688011112042f;

__device__ __forceinline__ size_t kfrag_off(int kt, int ks, int lane) { return ((size_t)(kt * 2 + ks) * 64 + lane) * 8; }
__device__ __forceinline__ size_t vfrag_off(int st, int dt, int lane) { return ((size_t)(st * 4 + dt) * 64 + lane) * 8; }
__device__ __forceinline__ size_t vfrag_elem(int key, int d) {
    const int st = key >> 5, kk = key & 31, tile = kk >> 4, r16 = kk & 15, grp = r16 >> 2, reg = r16 & 3;
    return ((size_t)(st * 4 + (d >> 4)) * 64 + (d & 15) + 16 * grp) * 8 + tile * 4 + reg;
}
__device__ __forceinline__ size_t k8_off(int key, int d) { return ((size_t)(key >> 4) * 64 + (key & 15) + 16 * ((d & 31) >> 3)) * 16 + (d >> 5) * 8 + (d & 7); }
__device__ __forceinline__ size_t v8_off(int key, int d) {
    const int blk = key >> 6, st = (key >> 5) & 1, kk = key & 31, tile = kk >> 4, r16 = kk & 15, grp = r16 >> 2, reg = r16 & 3;
    return ((size_t)(blk * 4 + (d >> 4)) * 64 + (d & 15) + 16 * grp) * 16 + st * 8 + tile * 4 + reg;
}
__device__ __forceinline__ size_t kfrag_elem(int key, int d) {
    return ((size_t)((key >> 4) * 2 + (d >> 5)) * 64 + (key & 15) + 16 * ((d & 31) >> 3)) * 8 + (d & 7);
}

__device__ __forceinline__ void ph_nsa_prep_fast(const KP& p, const Fr& F) {
    const float* H0 = p.BIGF; float* out = p.out;
    const size_t gt = (size_t)F.bid * NTHR + F.tid, GT = (size_t)F.G * NTHR;
    for (size_t idx = gt; idx < (size_t)T * 160; idx += GT) {
        const int t = (int)(idx / 160), u = (int)(idx % 160);
        const int c0 = u * 8; const float* row = H0 + (size_t)t * PA;
        const float4 a0 = *(const float4*)(row + c0), a1 = *(const float4*)(row + c0 + 4);
        float v[8] = {a0.x, a0.y, a0.z, a0.w, a1.x, a1.y, a1.z, a1.w};
        const int sec = (u < 64) ? -1 : ((u - 64) >> 4);
        const bool roped = (sec == -1 || sec == 2 || sec == 4);
        if (roped) {
            const int d0 = c0 & 63; const int pc = (d0 < 32) ? c0 + 32 : c0 - 32;
            const float4 b0 = *(const float4*)(row + pc), b1 = *(const float4*)(row + pc + 4);
            const float w[8] = {b0.x, b0.y, b0.z, b0.w, b1.x, b1.y, b1.z, b1.w};
            const float4* rp = (const float4*)(p.ROPE + t * 32 + (d0 & 31)); const float4 r0 = rp[0], r1 = rp[1], r2 = rp[2], r3 = rp[3];
            const float cs[8] = {r0.x, r0.z, r1.x, r1.z, r2.x, r2.z, r3.x, r3.z}, sn[8] = {r0.y, r0.w, r1.y, r1.w, r2.y, r2.w, r3.y, r3.w};
#pragma unroll
            for (int j = 0; j < 8; ++j) v[j] = (d0 < 32) ? (v[j] * cs[j] - w[j] * sn[j]) : (v[j] * cs[j] + w[j] * sn[j]);
        }
        if (sec == -1) {
            v4u o; o.x = pk2(v[0] * QSCALE, v[1] * QSCALE); o.y = pk2(v[2] * QSCALE, v[3] * QSCALE); o.z = pk2(v[4] * QSCALE, v[5] * QSCALE); o.w = pk2(v[6] * QSCALE, v[7] * QSCALE);
            *(v4u*)(p.QB + (size_t)t * 512 + c0) = o; continue;
        }
        const int gd = (c0 - 512) & 127, g = gd >> 6, d0 = gd & 63, kv = sec & 1;
        const float4 o0 = make_float4(v[0], v[1], v[2], v[3]), o1 = make_float4(v[4], v[5], v[6], v[7]);
        if (sec < 2) { float* o = out + O_CMP_P + (size_t)t * 256 + kv * 128 + gd; *(float4*)o = o0; *(float4*)(o + 4) = o1;
            const int i = t & 31; const float* pe = p.cpe + (kv * 32 + i) * 64 + d0; const float4 e0 = *(const float4*)pe, e1 = *(const float4*)(pe + 4);
            v4u w; w.x = pk2(v[0] + e0.x, v[1] + e0.y); w.y = pk2(v[2] + e0.z, v[3] + e0.w); w.z = pk2(v[4] + e1.x, v[5] + e1.y); w.w = pk2(v[6] + e1.z, v[7] + e1.w);
            *(v4u*)(p.ACP + ((size_t)kv * 1024 + (t >> 5) * 2 + g) * 2048 + i * 64 + d0) = w; continue; }
        if (sec < 4) { float* o = out + O_SLC_P + (size_t)t * 256 + kv * 128 + gd; *(float4*)o = o0; *(float4*)(o + 4) = o1; }
        else if (t >= T - 512) { float* o = out + O_WIN_P + (size_t)(t - (T - 512)) * 256 + kv * 128 + gd; *(float4*)o = o0; *(float4*)(o + 4) = o1; }
        if (sec < 4) {
            if (kv == 0) {
                int w0 = 0, w1 = 0;
                w0 = __builtin_amdgcn_cvt_pk_fp8_f32(v[0], v[1], w0, false); w0 = __builtin_amdgcn_cvt_pk_fp8_f32(v[2], v[3], w0, true);
                w1 = __builtin_amdgcn_cvt_pk_fp8_f32(v[4], v[5], w1, false); w1 = __builtin_amdgcn_cvt_pk_fp8_f32(v[6], v[7], w1, true);
                *(uint2*)(p.KS8 + (size_t)g * T * 64 + k8_off(t, d0)) = make_uint2((unsigned)w0, (unsigned)w1);
            } else {
#pragma unroll
                for (int j = 0; j < 8; ++j) p.VS8[(size_t)g * T * 64 + v8_off(t, d0 + j)] = (unsigned char)(__builtin_amdgcn_cvt_pk_fp8_f32(v[j], 0.f, 0, false) & 0xff);
            }
            continue;
        }
        bf16* KF = p.KWF; bf16* VF = p.VWF;
        if (kv == 0) {
            v4u o; o.x = pk2(v[0], v[1]); o.y = pk2(v[2], v[3]); o.z = pk2(v[4], v[5]); o.w = pk2(v[6], v[7]);
            *(v4u*)(KF + (size_t)g * T * 64 + kfrag_elem(t, d0)) = o;
        } else {
#pragma unroll
            for (int j = 0; j < 8; ++j) VF[(size_t)g * T * 64 + vfrag_elem(t, d0 + j)] = (bf16)f2bf(v[j]);
        }
    }
}

struct AttW { f32x4 o[4]; float m, l; };
__device__ __forceinline__ void attw_init(AttW& a) {
#pragma unroll
    for (int i = 0; i < 4; ++i) a.o[i] = (f32x4){0.f, 0.f, 0.f, 0.f};
    a.m = -INFINITY; a.l = 0.f;
}
__device__ __forceinline__ void qk_step(const bf16x8 (&kf)[2][2], const bf16x8 (&qf)[2], f32x4& s0, f32x4& s1) {
    const f32x4 z = {0.f, 0.f, 0.f, 0.f};
    s0 = MFMA16(kf[0][0], qf[0], z); s0 = MFMA16(kf[0][1], qf[1], s0);
    s1 = MFMA16(kf[1][0], qf[0], z); s1 = MFMA16(kf[1][1], qf[1], s1);
}
__device__ __forceinline__ bf16x8 pack_p(const f32x4& p0, const f32x4& p1) {
    union { v4u u; bf16x8 b; } c;
    c.u.x = pg8::cvt_pk_bf16(p0[0], p0[1]); c.u.y = pg8::cvt_pk_bf16(p0[2], p0[3]); c.u.z = pg8::cvt_pk_bf16(p1[0], p1[1]); c.u.w = pg8::cvt_pk_bf16(p1[2], p1[3]);
    return c.b;
}
__device__ __forceinline__ void att_update(AttW& a, const f32x4& s0, const f32x4& s1, const bf16x8 (&vf)[4]) {
    float mx = fmaxf(fmaxf(fmaxf(s0[0], s0[1]), fmaxf(s0[2], s0[3])), fmaxf(fmaxf(s1[0], s1[1]), fmaxf(s1[2], s1[3])));
    mx = fmaxf(mx, __shfl_xor(mx, 16)); mx = fmaxf(mx, __shfl_xor(mx, 32));
    const float mn = fmaxf(a.m, mx);
    const float ms = (mn == -INFINITY) ? 0.f : mn;
    const float alpha = __builtin_amdgcn_exp2f(a.m - ms);
    f32x4 p0, p1;
#pragma unroll
    for (int i = 0; i < 4; ++i) { p0[i] = __builtin_amdgcn_exp2f(s0[i] - ms); p1[i] = __builtin_amdgcn_exp2f(s1[i] - ms); }
    a.l = a.l * alpha + ((p0[0] + p0[1]) + (p0[2] + p0[3])) + ((p1[0] + p1[1]) + (p1[2] + p1[3]));
    a.m = mn;
    const bf16x8 pf = pack_p(p0, p1);
#pragma unroll
    for (int dt = 0; dt < 4; ++dt) { a.o[dt] = a.o[dt] * alpha; a.o[dt] = MFMA16(vf[dt], pf, a.o[dt]); }
}
__device__ __forceinline__ float grp_sum(float v) { v += __shfl_xor(v, 16); v += __shfl_xor(v, 32); return v; }

__device__ __forceinline__ void nsa_fast_unit(const KP& p, int unit, float* wl, int lane) {
    asm volatile("" : "+v"(lane));
    const int g = unit & 1, t0 = (unit >> 1) * 16;
    const int qi = lane & 15, grp = lane >> 4, t = t0 + qi;
    float* imp = wl; int* sel = (int*)(wl + 4096);
    const float* grow = p.BIGF + (size_t)t * PA + C_GATE + g * 4;
    bf16x8 qf[4][2];
#pragma unroll
    for (int h = 0; h < 4; ++h)
#pragma unroll
        for (int ks = 0; ks < 2; ++ks) qf[h][ks] = *(const bf16x8*)(p.QB + (size_t)t * 512 + (g * 4 + h) * 64 + 32 * ks + 8 * grp);
    AttW st[4];
    {
        const bf16* CKF = p.CKF + (size_t)g * 512 * 64; const bf16* CVF = p.CVF + (size_t)g * 512 * 64;
        const int nmax = (t0 + 16) >> 5; const int nsteps = (nmax + 31) >> 5;
        const int nval = (t + 1) >> 5;
        float m[4], l[4];
#pragma unroll
        for (int h = 0; h < 4; ++h) { m[h] = -INFINITY; l[h] = 0.f; }
        for (int s = 0; s < nsteps; ++s) {
            bf16x8 kf[2][2];
#pragma unroll
            for (int tl = 0; tl < 2; ++tl)
#pragma unroll
                for (int ks = 0; ks < 2; ++ks) kf[tl][ks] = *(const bf16x8*)(CKF + kfrag_off(2 * s + tl, ks, lane));
            const int cb = 32 * s + 4 * grp;
#pragma unroll
            for (int h = 0; h < 4; ++h) {
                f32x4 s0, s1; qk_step(kf, qf[h], s0, s1);
#pragma unroll
                for (int i = 0; i < 4; ++i) { if (cb + i >= nval) s0[i] = -INFINITY; if (cb + 16 + i >= nval) s1[i] = -INFINITY; }
                float mx = fmaxf(fmaxf(fmaxf(s0[0], s0[1]), fmaxf(s0[2], s0[3])), fmaxf(fmaxf(s1[0], s1[1]), fmaxf(s1[2], s1[3])));
                mx = fmaxf(mx, __shfl_xor(mx, 16)); mx = fmaxf(mx, __shfl_xor(mx, 32));
                const float mn = fmaxf(m[h], mx); const float ms = (mn == -INFINITY) ? 0.f : mn;
                float sum = 0.f;
#pragma unroll
                for (int i = 0; i < 4; ++i) sum += __builtin_amdgcn_exp2f(s0[i] - ms) + __builtin_amdgcn_exp2f(s1[i] - ms);
                l[h] = l[h] * __builtin_amdgcn_exp2f(m[h] - ms) + sum; m[h] = mn;
            }
        }
        float il[4];
#pragma unroll
        for (int h = 0; h < 4; ++h) { const float lt = grp_sum(l[h]); il[h] = lt > 0.f ? 1.f / lt : 0.f; if (m[h] == -INFINITY) m[h] = 0.f; attw_init(st[h]); }
        for (int s = 0; s < nsteps; ++s) {
            bf16x8 kf[2][2], vf[4];
#pragma unroll
            for (int tl = 0; tl < 2; ++tl)
#pragma unroll
                for (int ks = 0; ks < 2; ++ks) kf[tl][ks] = *(const bf16x8*)(CKF + kfrag_off(2 * s + tl, ks, lane));
#pragma unroll
            for (int dt = 0; dt < 4; ++dt) vf[dt] = *(const bf16x8*)(CVF + vfrag_off(s, dt, lane));
            const int cb = 32 * s + 4 * grp;
            float i4[4] = {0.f, 0.f, 0.f, 0.f};
#pragma unroll
            for (int h = 0; h < 4; ++h) {
                f32x4 s0, s1; qk_step(kf, qf[h], s0, s1);
                f32x4 p0, p1;
#pragma unroll
                for (int i = 0; i < 4; ++i) {
                    p0[i] = (cb + i < nval) ? __builtin_amdgcn_exp2f(s0[i] - m[h]) * il[h] : 0.f;
                    p1[i] = (cb + 16 + i < nval) ? __builtin_amdgcn_exp2f(s1[i] - m[h]) * il[h] : 0.f; }
                i4[0] += p0[0] + p0[1]; i4[1] += p0[2] + p0[3]; i4[2] += p1[0] + p1[1]; i4[3] += p1[2] + p1[3];
                const bf16x8 pf = pack_p(p0, p1);
#pragma unroll
                for (int dt = 0; dt < 4; ++dt) st[h].o[dt] = MFMA16(vf[dt], pf, st[h].o[dt]);
            }
            *(float2*)(imp + qi * 256 + 16 * s + 2 * grp) = make_float2(i4[0], i4[1]);
            *(float2*)(imp + qi * 256 + 16 * s + 8 + 2 * grp) = make_float2(i4[2], i4[3]);
        }
        wave_lds_sync();
    }
    const int cur = t0 >> 6;
    {
        if (cur + 1 <= 16) {
            for (int idx = lane; idx < 256; idx += 64) sel[idx] = ((idx & 15) <= cur) ? (idx & 15) : -1;
        } else {
            for (int q = 0; q < 16; ++q) {
                unsigned key[4];
#pragma unroll
                for (int j = 0; j < 4; ++j) { const int blk = lane + 64 * j; const float v = imp[q * 256 + blk];
                    key[j] = (blk >= 1 && blk <= cur - 2) ? ((__float_as_uint(v) & 0xFFFFFF00u) | (unsigned)(255 - blk)) : 0u; }
                if (lane == 0) { sel[q * 16 + 0] = 0; sel[q * 16 + 1] = cur; sel[q * 16 + 2] = cur - 1; }
                for (int n = 3; n < 16; ++n) {
                    unsigned best = max(max(key[0], key[1]), max(key[2], key[3]));
#pragma unroll
                    for (int o = 1; o < 64; o <<= 1) best = max(best, (unsigned)__shfl_xor((int)best, o));
                    const int blk = 255 - (int)(best & 255u);
#pragma unroll
                    for (int j = 0; j < 4; ++j) if (lane + 64 * j == blk) key[j] = 0u;
                    if (lane == 0) sel[q * 16 + n] = blk;
                }
            }
        }
        wave_lds_sync();
    }
    float* acc = wl;
    {
#pragma unroll
        for (int h = 0; h < 4; ++h) { const float gs = sigmoidf_(grow[h]);
#pragma unroll
            for (int dt = 0; dt < 4; ++dt) *(f32x4*)(acc + (qi * 4 + h) * 64 + 16 * dt + 4 * grp) = st[h].o[dt] * gs; }
        wave_lds_sync();
    }
    {
        const bf16* KF = p.KWF + (size_t)g * T * 64; const bf16* VF = p.VWF + (size_t)g * T * 64;
        int kstart = t0 - 512; if (kstart < 0) kstart = 0; kstart &= ~31;
        const int nsteps = (t0 + 16 - kstart + 31) >> 5;
#pragma unroll
        for (int h = 0; h < 4; ++h) attw_init(st[h]);
        auto issue = [&](int s_, bf16x8 (&K)[2][2], bf16x8 (&V)[4]) {
            const int k0 = kstart + 32 * s_;
#pragma unroll
            for (int tl = 0; tl < 2; ++tl)
#pragma unroll
                for (int ks = 0; ks < 2; ++ks) K[tl][ks] = *(const bf16x8*)(KF + kfrag_off((k0 >> 4) + tl, ks, lane));
#pragma unroll
            for (int dt = 0; dt < 4; ++dt) V[dt] = *(const bf16x8*)(VF + vfrag_off(k0 >> 5, dt, lane));
        };
        auto compute = [&](int s_, const bf16x8 (&K)[2][2], const bf16x8 (&V)[4]) {
            const int k0 = kstart + 32 * s_;
            const bool need_mask = (k0 + 31 > t0) || (k0 < t0 + 15 - 512);
            const int pb = k0 + 4 * grp;
#pragma unroll
            for (int h = 0; h < 4; ++h) {
                f32x4 s0, s1; qk_step(K, qf[h], s0, s1);
                if (need_mask) {
#pragma unroll
                    for (int i = 0; i < 4; ++i) { const int p0 = pb + i, p1 = pb + 16 + i;
                        if (p0 > t || p0 < t - 512) s0[i] = -INFINITY; if (p1 > t || p1 < t - 512) s1[i] = -INFINITY; }
                }
                att_update(st[h], s0, s1, V);
            }
        };
        bf16x8 kA[2][2], vA[4], kB[2][2], vB[4];
        issue(0, kA, vA);
        for (int s = 0; s < nsteps; s += 2) {
            if (s + 1 < nsteps) issue(s + 1, kB, vB);
            compute(s, kA, vA);
            if (s + 1 < nsteps) { if (s + 2 < nsteps) issue(s + 2, kA, vA); compute(s + 1, kB, vB); }
        }
#pragma unroll
        for (int h = 0; h < 4; ++h) { const float lt = grp_sum(st[h].l); const float gs = sigmoidf_(grow[16 + h]) * (lt > 0.f ? 1.f / lt : 0.f);
#pragma unroll
            for (int dt = 0; dt < 4; ++dt) { f32x4* a = (f32x4*)(acc + (qi * 4 + h) * 64 + 16 * dt + 4 * grp); *a = *a + st[h].o[dt] * gs; } }
        wave_lds_sync();
    }
    *(int4*)(p.SEL + ((size_t)g * T + t0) * 16 + lane * 4) = *(const int4*)(sel + lane * 4);
#pragma unroll 4
    for (int q = 0; q < 16; ++q) *(f32x4*)(p.NSACC + (size_t)(t0 + q) * 512 + g * 256 + 4 * lane) = *(const f32x4*)(acc + q * 256 + 4 * lane);
    wave_lds_sync();
}

__device__ __forceinline__ void nsa_slc_item(const KP& p, int tq, int g, int lane) {
    asm volatile("" : "+v"(lane));
    const int l15 = lane & 15, grp = lane >> 4, hn = lane & 3;
    const bf16* KF = p.KSF + (size_t)g * T * 64; const bf16* VF = p.VSF + (size_t)g * T * 64;
    const int* selp = p.SEL + ((size_t)g * T + tq) * 16;
    int sb[16];
#pragma unroll
    for (int i = 0; i < 16; ++i) sb[i] = __builtin_amdgcn_readfirstlane(selp[i]);
    bf16x8 qs[2];
#pragma unroll
    for (int ks = 0; ks < 2; ++ks) qs[ks] = *(const bf16x8*)(p.QB + (size_t)tq * 512 + (g * 4 + hn) * 64 + 32 * ks + 8 * grp);
    AttW a; attw_init(a);
    bf16x8 kf[2][2][2], vf[2][4];
    auto issue = [&](int i, int buf) {
        const int blk = sb[i >> 1]; int k0 = blk * 64 + 32 * (i & 1); if (blk < 0 || k0 > tq) k0 = 0;
#pragma unroll
        for (int tl = 0; tl < 2; ++tl)
#pragma unroll
            for (int ks = 0; ks < 2; ++ks) kf[buf][tl][ks] = *(const bf16x8*)(KF + kfrag_off((k0 >> 4) + tl, ks, lane));
#pragma unroll
        for (int dt = 0; dt < 4; ++dt) vf[buf][dt] = *(const bf16x8*)(VF + vfrag_off(k0 >> 5, dt, lane));
    };
    issue(0, 0);
#pragma unroll
    for (int i = 0; i < 32; ++i) {
        const int buf = i & 1;
        if (i + 1 < 32) issue(i + 1, buf ^ 1);
        const int blk = sb[i >> 1]; const int k0 = blk * 64 + 32 * (i & 1);
        const bool dead = (blk < 0) || (k0 > tq);
        f32x4 s0, s1; qk_step(kf[buf], qs, s0, s1);
        const int pb = k0 + 4 * grp;
#pragma unroll
        for (int j = 0; j < 4; ++j) { if (dead || pb + j > tq) s0[j] = -INFINITY; if (dead || pb + 16 + j > tq) s1[j] = -INFINITY; }
        att_update(a, s0, s1, vf[buf]);
    }
    const float lt = grp_sum(a.l);
    if (l15 < 4) {
        const float gs = sigmoidf_(p.BIGF[(size_t)tq * PA + C_GATE + 8 + g * 4 + l15]) * (lt > 0.f ? 1.f / lt : 0.f);
#pragma unroll
        for (int dt = 0; dt < 4; ++dt) {
            const size_t o = (size_t)tq * 512 + g * 256 + l15 * 64 + 16 * dt + 4 * grp;
            const f32x4 base = *(const f32x4*)(p.NSACC + o); const f32x4 v = base + a.o[dt] * gs;
            uint2 w; w.x = pk2(v[0], v[1]); w.y = pk2(v[2], v[3]);
            *(uint2*)(p.MIXB + (size_t)tq * 1024 + g * 256 + l15 * 64 + 16 * dt + 4 * grp) = w;
        }
    }
}

__device__ __forceinline__ void ph_compress(const KP& p, const Fr& F) {
    float* flat = (float*)F.lds;
    float* hid = (float*)(F.lds + 32768);
    float* res = (float*)(F.lds + 32768 + 2048);
    const float* H0 = p.BIGF;
    const int tid = F.tid;
    for (int item = F.bid; item < 512; item += F.G) {
        const int c = item & 511, s = item >> 9;
        for (int e = tid; e < 8192; e += NTHR) {
            const int kv = e >> 12, g = (e >> 11) & 1, k = e & 2047, i = k >> 6, d = k & 63;
            const int row = c * 32 + i;
            float v;
            if (s == 0) v = H0[(size_t)row * PA + C_KC + kv * 128 + g * 64 + d];
            else { const int b = s - 1; const int page = p.page_table[b * NPAGES + (row >> 7)];
                   v = p.cache_cmp[((((size_t)page * 128 + (row & 127)) * 2 + kv) * 2 + g) * 64 + d]; }
            flat[e] = v + p.cpe[(kv * 32 + i) * 64 + d];
        }
        __syncthreads();
        {
            const int kv = tid >> 8, g = (tid >> 7) & 1, j = tid & 127;
            const float* w = p.cw1 + (size_t)kv * 2048 * 128 + j;
            const float* fl = flat + (kv * 2 + g) * 2048;
            float acc = p.cb1[kv * 128 + j];
            for (int k = 0; k < 2048; ++k) acc += fl[k] * w[(size_t)k * 128];
            hid[(kv * 2 + g) * 128 + j] = gelu_tanh(acc);
        }
        __syncthreads();
        if (tid < 256) {
            const int kv = tid >> 7, g = (tid >> 6) & 1, d = tid & 63;
            const float* w = p.cw2 + (size_t)kv * 128 * 64 + d;
            const float* hh = hid + (kv * 2 + g) * 128;
            float acc = 0.f;
            for (int j = 0; j < 128; ++j) acc += hh[j] * w[j * 64];
            res[(kv * 2 + g) * 64 + d] = acc;
        }
        __syncthreads();
        if (tid < 256) {
            const int kv = tid >> 7, g = (tid >> 6) & 1, d = tid & 63;
            const float* rr = res + (kv * 2 + g) * 64;
            float v = rr[d];
            if (kv == 0) {
                const int pos = (c + 1) * 32 - 1; const float2 cs = p.ROPE[pos * 32 + (d & 31)];
                const float x1 = rr[d & 31], x2 = rr[(d & 31) + 32];
                v = (d < 32) ? (x1 * cs.x - x2 * cs.y) : (x2 * cs.x + x1 * cs.y);
                p.CK[(((size_t)s * 512 + c) * 2 + g) * 64 + d] = v;
                if (s == 0) p.CKF[(size_t)g * 512 * 64 + kfrag_elem(c, d)] = (bf16)f2bf(v);
            } else { p.CV[(((size_t)s * 512 + c) * 2 + g) * 64 + d] = v; if (s == 0) p.CVF[(size_t)g * 512 * 64 + vfrag_elem(c, d)] = (bf16)f2bf(v); }
        }
        __syncthreads();
    }
}

__device__ __forceinline__ void ph_gdn_prep(const KP& p, const Fr& F) {
    const float* H0 = p.BIGF; const int lane = F.lane;
    for (int item = T * 8 + F.gw; item < TS * 8; item += F.NGW) {
        const int r = item >> 3, h = item & 7;
        const bool smp = r >= T; const int b = r - T;
        float cv[3];
#pragma unroll
        for (int part = 0; part < 3; ++part) {
            const int ch = part * 512 + h * 64 + lane;
            float acc = 0.f;
#pragma unroll
            for (int j = 0; j < 4; ++j) {
                float u;
                if (!smp) { const int t = r + j - 3; u = (t >= 0) ? H0[(size_t)t * PA + C_GQKV + ch] : 0.f; }
                else { u = (j < 3) ? p.st_gconv[((size_t)b * 3 + j) * 1536 + ch] : H0[(size_t)r * PA + C_GQKV + ch]; }
                acc += p.gconv_w[j * 1536 + ch] * u;
            }
            cv[part] = siluf_(acc);
        }
        const float qn = wave_sum(cv[0] * cv[0]), kn = wave_sum(cv[1] * cv[1]);
        const size_t o = ((size_t)r * 8 + h) * 64 + lane;
        p.GQ[o] = cv[0] * rsqrtf(qn + NORM_EPS) * 0.125f;
        p.GK[o] = cv[1] * rsqrtf(kn + NORM_EPS);
        p.GV[o] = cv[2];
        if (lane == 0) {
            const float av = H0[(size_t)r * PA + C_A + h], bt = H0[(size_t)r * PA + C_BT + h];
            p.Gg[(size_t)r * 8 + h] = -expf(p.gA[h]) * softplusf_(av + p.gdt[h]);
            p.Gb[(size_t)r * 8 + h] = sigmoidf_(bt);
        }
    }
    const size_t gt = (size_t)F.bid * NTHR + F.tid, GT = (size_t)F.G * NTHR;
    for (size_t idx = gt; idx < (size_t)3 * 1536; idx += GT) {
        const int j = (int)(idx / 1536), ch = (int)(idx % 1536);
        p.out[O_GCONV_P + idx] = H0[(size_t)(T - 3 + j) * PA + C_GQKV + ch];
    }
    for (size_t idx = gt; idx < (size_t)NSMP * 3 * 1536; idx += GT) {
        const int b = (int)(idx / (3 * 1536)), j = (int)((idx / 1536) % 3), ch = (int)(idx % 1536);
        p.out[O_GCONV_S + idx] = (j < 2) ? p.st_gconv[((size_t)b * 3 + j + 1) * 1536 + ch] : H0[(size_t)(T + b) * PA + C_GQKV + ch];
    }
}

template <int NH, class KF>
__device__ __forceinline__ void wave_attend(const float* qs, float* sc, int scstride, int nkeys, KF kf, float (&outv)[NH], float (&den)[NH], int lane, float* mxout = nullptr) {
    float mx[NH];
#pragma unroll
    for (int h = 0; h < NH; ++h) mx[h] = -INFINITY;
    for (int j = lane; j < nkeys; j += 64) {
        const float *kp, *vp; const bool ok = kf(j, kp, vp);
        float s[NH];
#pragma unroll
        for (int h = 0; h < NH; ++h) s[h] = 0.f;
        if (ok) {
            for (int d4 = 0; d4 < 16; ++d4) {
                const float4 kvv = ((const float4*)kp)[d4];
#pragma unroll
                for (int h = 0; h < NH; ++h) { const float* q = qs + h * 64 + d4 * 4; s[h] += kvv.x * q[0] + kvv.y * q[1] + kvv.z * q[2] + kvv.w * q[3]; }
            }
        }
#pragma unroll
        for (int h = 0; h < NH; ++h) { const float v = ok ? s[h] * 0.125f : -INFINITY; sc[h * scstride + j] = v; mx[h] = fmaxf(mx[h], v); }
    }
#pragma unroll
    for (int h = 0; h < NH; ++h) { mx[h] = wave_max(mx[h]); if (!(mx[h] > -INFINITY)) mx[h] = 0.f; if (mxout) mxout[h] = mx[h]; }
    float sm[NH];
#pragma unroll
    for (int h = 0; h < NH; ++h) sm[h] = 0.f;
    for (int j = lane; j < nkeys; j += 64) {
#pragma unroll
        for (int h = 0; h < NH; ++h) { const float v = sc[h * scstride + j]; const float pp = (v == -INFINITY) ? 0.f : expf(v - mx[h]); sc[h * scstride + j] = pp; sm[h] += pp; }
    }
#pragma unroll
    for (int h = 0; h < NH; ++h) { sm[h] = wave_sum(sm[h]); den[h] = sm[h] > 0.f ? sm[h] : 1.f; }
    wave_lds_sync();
    {
        const int kq = lane >> 4, d4 = lane & 15;
        float4 acc[NH];
#pragma unroll
        for (int h = 0; h < NH; ++h) acc[h] = make_float4(0.f, 0.f, 0.f, 0.f);
        for (int j0 = 0; j0 < nkeys; j0 += 32) {
            float4 v[8];
#pragma unroll
            for (int u = 0; u < 8; ++u) { const int j = j0 + 4 * u + kq; const float *kp, *vp; const bool ok = (j < nkeys) && kf(j, kp, vp);
                v[u] = ok ? *(const float4*)(vp + 4 * d4) : make_float4(0.f, 0.f, 0.f, 0.f); }
#pragma unroll
            for (int u = 0; u < 8; ++u) { const int j = j0 + 4 * u + kq;
#pragma unroll
                for (int h = 0; h < NH; ++h) { const float pp = (j < nkeys) ? sc[h * scstride + j] : 0.f;
                    acc[h].x += pp * v[u].x; acc[h].y += pp * v[u].y; acc[h].z += pp * v[u].z; acc[h].w += pp * v[u].w; } }
        }
#pragma unroll
        for (int h = 0; h < NH; ++h) {
            float4 a = acc[h];
            a.x += __shfl_xor(a.x, 16); a.y += __shfl_xor(a.y, 16); a.z += __shfl_xor(a.z, 16); a.w += __shfl_xor(a.w, 16);
            a.x += __shfl_xor(a.x, 32); a.y += __shfl_xor(a.y, 32); a.z += __shfl_xor(a.z, 32); a.w += __shfl_xor(a.w, 32);
            const float x0 = __shfl(a.x, lane >> 2), x1 = __shfl(a.y, lane >> 2), x2 = __shfl(a.z, lane >> 2), x3 = __shfl(a.w, lane >> 2);
            const int cc = lane & 3; outv[h] = cc == 0 ? x0 : (cc == 1 ? x1 : (cc == 2 ? x2 : x3));
        }
    }
#pragma unroll
    for (int h = 0; h < NH; ++h) outv[h] /= den[h];
    wave_lds_sync();
}

__device__ __forceinline__ void nsa_smp_cs(const KP& p, int b, int g, float* wl, int lane) {
    float* qs = wl; float* sc = wl + 256; float* imp = wl + 256 + 4 * 1088; int* sel = (int*)(wl + 256 + 4 * 1088 + 320); long long* bb = (long long*)(wl + 256 + 4 * 1088 + 320 + 16);
    const int r = T + b; const int qpos = T;
    const float* grow = p.BIGF + (size_t)r * PA + C_GATE;
#pragma unroll
    for (int h = 0; h < 4; ++h) qs[h * 64 + lane] = p.QR[(size_t)r * 512 + (g * 4 + h) * 64 + lane];
    wave_lds_sync();
    float ocmp[4], oslc[4], den[4];
    {
        const float* CKp = p.CK + (size_t)(1 + b) * 512 * 128; const float* CVp = p.CV + (size_t)(1 + b) * 512 * 128;
        auto kf = [&](int j, const float*& kp, const float*& vp) -> bool { kp = CKp + (j * 2 + g) * 64; vp = CVp + (j * 2 + g) * 64; return true; };
        wave_attend<4>(qs, sc, 1088, 512, kf, ocmp, den, lane);
        for (int blk = lane; blk < 320; blk += 64) {
            float v = 0.f;
            if (blk < 256) {
#pragma unroll
                for (int h = 0; h < 4; ++h) v += (sc[h * 1088 + 2 * blk] + sc[h * 1088 + 2 * blk + 1]) / den[h];
            }
            imp[blk] = v;
        }
        wave_lds_sync();
    }
    {
        const int cur = qpos >> 6;
        float val[5];
#pragma unroll
        for (int j = 0; j < 5; ++j) { const int blk = lane + 64 * j; val[j] = (blk >= 1 && blk <= cur - 2) ? imp[blk] : -1.f; }
        if (lane == 0) { sel[0] = 0; sel[1] = cur; sel[2] = cur - 1; }
        for (int n = 3; n < 16; ++n) {
            float bv = -2.f; int bi = 0x7fffffff;
#pragma unroll
            for (int j = 0; j < 5; ++j) if (val[j] > bv) { bv = val[j]; bi = lane + 64 * j; }
#pragma unroll
            for (int o = 1; o < 64; o <<= 1) { const float ov = __shfl_xor(bv, o); const int oi = __shfl_xor(bi, o); if (ov > bv || (ov == bv && oi < bi)) { bv = ov; bi = oi; } }
#pragma unroll
            for (int j = 0; j < 5; ++j) if (lane + 64 * j == bi) val[j] = -3.f;
            if (lane == 0) sel[n] = bi;
        }
        wave_lds_sync();
        if (lane < 16) { const int blk = sel[lane]; long long o = 0;
            if (blk < 256) { const int page = p.page_table[b * NPAGES + (blk >> 1)]; o = ((long long)page * 128 + (blk & 1) * 64) * 256; }
            bb[lane] = o; }
        wave_lds_sync();
    }
    {
        auto kf = [&](int j, const float*& kp, const float*& vp) -> bool {
            const int blk = sel[j >> 6]; const int pos = blk * 64 + (j & 63); if (pos > qpos) return false;
            if (pos == T) { kp = p.KS + (size_t)r * 128 + g * 64; vp = p.VS + (size_t)r * 128 + g * 64; return true; }
            const float* base = p.cache_slc + bb[j >> 6] + (j & 63) * 256;
            kp = base + g * 64; vp = base + 128 + g * 64; return true; };
        wave_attend<4>(qs, sc, 1088, 1024, kf, oslc, den, lane);
    }
#pragma unroll
    for (int h = 0; h < 4; ++h) {
        const int hh = g * 4 + h;
        p.SMIXF[((size_t)b * 3 + 0) * 512 + hh * 64 + lane] = sigmoidf_(grow[hh]) * ocmp[h];
        p.SMIXF[((size_t)b * 3 + 1) * 512 + hh * 64 + lane] = sigmoidf_(grow[8 + hh]) * oslc[h];
    }
    wave_lds_sync();
}
__device__ __forceinline__ void nsa_smp_win(const KP& p, int b, int g, float* wl, int lane) {
    float* qs = wl; float* sc = wl + 256;
    const int r = T + b;
    const float* grow = p.BIGF + (size_t)r * PA + C_GATE;
#pragma unroll
    for (int h = 0; h < 4; ++h) qs[h * 64 + lane] = p.QR[(size_t)r * 512 + (g * 4 + h) * 64 + lane];
    wave_lds_sync();
    float owin[4], den[4];
    auto kf = [&](int j, const float*& kp, const float*& vp) -> bool {
        if (j == 512) { kp = p.KW + (size_t)r * 128 + g * 64; vp = p.VW + (size_t)r * 128 + g * 64; return true; }
        const float* base = p.st_win + ((size_t)b * 512 + j) * 256;
        kp = base + g * 64; vp = base + 128 + g * 64; return true; };
    wave_attend<4>(qs, sc, 528, 513, kf, owin, den, lane);
#pragma unroll
    for (int h = 0; h < 4; ++h) { const int hh = g * 4 + h; p.SMIXF[((size_t)b * 3 + 2) * 512 + hh * 64 + lane] = sigmoidf_(grow[16 + hh]) * owin[h]; }
    wave_lds_sync();
}

__device__ __forceinline__ void gdn_scan_item(const KP& p, int item, float* wl, int lane) {
    asm volatile("" : "+v"(lane));
    float* kq = wl;
    const int b = (item >> 3) - 1, h = item & 7;
    const int r = T + b; const size_t o = ((size_t)r * 8 + h) * 64;
    kq[lane] = p.GK[o + lane]; kq[64 + lane] = p.GQ[o + lane];
    wave_lds_sync();
    const float dec = expf(p.Gg[(size_t)r * 8 + h]), bt = p.Gb[(size_t)r * 8 + h];
    const float* Sp = p.st_gS + ((size_t)b * 8 + h) * 4096 + lane;
    float* so = p.out + O_GS_S + ((size_t)b * 8 + h) * 4096 + lane;
    float S[64]; float kv = 0.f;
#pragma unroll
    for (int i = 0; i < 64; ++i) { S[i] = Sp[i * 64] * dec; kv += kq[i] * S[i]; }
    const float vn = (p.GV[o + lane] - kv) * bt;
    float ov = 0.f;
#pragma unroll
    for (int i = 0; i < 64; ++i) { const float sn = S[i] + kq[i] * vn; ov += kq[64 + i] * sn; so[i * 64] = sn; }
    p.OG[o + lane] = ov;
    wave_lds_sync();
}

constexpr int GDN_WL = 34816;
__device__ __forceinline__ int kperm(int ks, int grp, int j) { return 32 * ks + 16 * (j >> 2) + 4 * grp + (j & 3); }

__device__ __forceinline__ void gdn_chunk_unit(const KP& p, int unit, unsigned char* ldsb, int woff, int lane) {
    asm volatile("" : "+v"(lane), "+s"(woff));
    unsigned char* wlb = ldsb + woff;
    const int n = unit >> 3, h = unit & 7, t0 = 64 * n;
    const int l15 = lane & 15, grp = lane >> 4;
    float* Af = (float*)wlb; bf16* kt = (bf16*)(wlb + 16384); bf16* qt = kt + 64 * 72; bf16* tmp = (bf16*)wlb;
    {
        const float* H0 = p.BIGF;
        float w[3][4], u1[3], u2[3], u3[3];
#pragma unroll
        for (int part = 0; part < 3; ++part) {
            const int ch = part * 512 + h * 64 + lane;
#pragma unroll
            for (int j = 0; j < 4; ++j) w[part][j] = p.gconv_w[j * 1536 + ch];
            u1[part] = (t0 >= 1) ? H0[(size_t)(t0 - 1) * PA + C_GQKV + ch] : 0.f;
            u2[part] = (t0 >= 2) ? H0[(size_t)(t0 - 2) * PA + C_GQKV + ch] : 0.f;
            u3[part] = (t0 >= 3) ? H0[(size_t)(t0 - 3) * PA + C_GQKV + ch] : 0.f;
        }
        int roff = 0;
#pragma unroll 4
        for (int i = 0; i < 64; ++i) {
            float cv[3];
#pragma unroll
            for (int part = 0; part < 3; ++part) {
                const float u0 = H0[(size_t)t0 * PA + C_GQKV + part * 512 + h * 64 + lane + roff];
                cv[part] = siluf_(w[part][0] * u3[part] + w[part][1] * u2[part] + w[part][2] * u1[part] + w[part][3] * u0);
                u3[part] = u2[part]; u2[part] = u1[part]; u1[part] = u0;
            }
            roff += PA; asm volatile("" : "+s"(roff));
            const float qn = wave_sum(cv[0] * cv[0]), kn = wave_sum(cv[1] * cv[1]);
            qt[i * 72 + lane] = (bf16)f2bf(cv[0] * rsqrtf(qn + NORM_EPS) * 0.125f);
            kt[i * 72 + lane] = (bf16)f2bf(cv[1] * rsqrtf(kn + NORM_EPS));
            p.GV[((size_t)(t0 + i) * 8 + h) * 64 + lane] = cv[2];
        }
    }
    const float gl_ = -expf(p.gA[h]) * softplusf_(p.BIGF[(size_t)(t0 + lane) * PA + C_A + h] + p.gdt[h]);
    const float beta = sigmoidf_(p.BIGF[(size_t)(t0 + lane) * PA + C_BT + h]);
    float gc = gl_;
#pragma unroll
    for (int o = 1; o < 64; o <<= 1) { const float tv = __shfl_up(gc, o); if (lane >= o) gc += tv; }
    const float gclast = __shfl(gc, 63);
#define GPAD(i) ((float*)(kt + (i) * 72 + 64))
    { float* pd = GPAD(lane); pd[0] = gc; pd[1] = beta; pd[2] = expf(gc); pd[3] = expf(gclast - gc); }
    wave_lds_sync();
    bf16* QKF = p.G_QKF + (size_t)unit * 4096;
#pragma unroll
    for (int it = 0; it < 4; ++it) {
        const int i = 16 * it + l15;
        const float gci = GPAD(i)[0], bi = GPAD(i)[1];
        bf16x8 bk[2], bq[2];
#pragma unroll
        for (int ks = 0; ks < 2; ++ks) { bk[ks] = *(const bf16x8*)(kt + i * 72 + 32 * ks + 8 * grp); bq[ks] = *(const bf16x8*)(qt + i * 72 + 32 * ks + 8 * grp); }
#pragma unroll
        for (int jt = 0; jt < 4; ++jt) {
            uint2 qkp = make_uint2(0u, 0u);
            if (jt <= it) {
                bf16x8 ak[2];
#pragma unroll
                for (int ks = 0; ks < 2; ++ks) ak[ks] = *(const bf16x8*)(kt + (16 * jt + l15) * 72 + 32 * ks + 8 * grp);
                f32x4 aa = {0.f, 0.f, 0.f, 0.f}, aq = {0.f, 0.f, 0.f, 0.f};
                aa = MFMA16(ak[0], bk[0], aa); aa = MFMA16(ak[1], bk[1], aa);
                aq = MFMA16(ak[0], bq[0], aq); aq = MFMA16(ak[1], bq[1], aq);
                f32x4 av, qv;
#pragma unroll
                for (int r = 0; r < 4; ++r) {
                    const int j = 16 * jt + 4 * grp + r; const float gcj = GPAD(j)[0];
                    const float e = (j <= i) ? expf(gci - gcj) : 0.f;
                    av[r] = (j < i) ? bi * aa[r] * e : 0.f; qv[r] = aq[r] * e;
                }
                *(f32x4*)(Af + i * 64 + 16 * jt + 4 * grp) = av;
                qkp.x = pk2(qv[0], qv[1]); qkp.y = pk2(qv[2], qv[3]);
            }
            *(uint2*)(QKF + ((size_t)(it * 2 + (jt >> 1)) * 64 + lane) * 8 + (jt & 1) * 4) = qkp;
        }
    }
    wave_lds_sync();
    {
        float* UF = p.G_UF + (size_t)unit * 4096;
        const int vq = lane >> 4;
#pragma unroll
        for (int pass = 0; pass < 2; ++pass) {
            float x[64];
            int goff = 0;
#pragma unroll
            for (int i = 0; i < 64; ++i) {
                const float bi = GPAD(i)[1];
                float acc;
                if (pass == 0) { acc = p.GV[((size_t)t0 * 8 + h) * 64 + lane + goff] * bi; goff += 512; asm volatile("" : "+s"(goff)); }
                else { const float ei = GPAD(i)[2];
                       acc = __uint_as_float((unsigned)kt[i * 72 + lane] << 16) * bi * ei; }
#pragma unroll
                for (int jj = 0; jj < (i + 3) / 4; ++jj) {
                    const float4 a4 = *(const float4*)(Af + i * 64 + 4 * jj);
                    acc -= a4.x * x[4 * jj + 0];
                    if (4 * jj + 1 < i) acc -= a4.y * x[4 * jj + 1];
                    if (4 * jj + 2 < i) acc -= a4.z * x[4 * jj + 2];
                    if (4 * jj + 3 < i) acc -= a4.w * x[4 * jj + 3];
                }
                x[i] = acc;
                if ((i & 3) == 3) asm volatile("" ::: "memory");
            }
            if (pass == 0) {
#pragma unroll
                for (int c4 = 0; c4 < 16; ++c4) {
                    const int mt = c4 >> 2, lp = l15 + 16 * (c4 & 3);
                    *(f32x4*)(UF + ((size_t)(vq * 4 + mt) * 64 + lp) * 4) = (f32x4){x[4 * c4], x[4 * c4 + 1], x[4 * c4 + 2], x[4 * c4 + 3]};
                }
            } else {
                wave_lds_sync();
#pragma unroll
                for (int c = 0; c < 64; ++c) tmp[c * 72 + lane] = (bf16)f2bf(-x[c]);
            }
            asm volatile("" ::: "memory");
        }
    }
    wave_lds_sync();
    {
        bf16* WF = p.G_WF + (size_t)unit * 4096; bf16* QGF = p.G_QGF + (size_t)unit * 4096; bf16* KDF = p.G_KDF + (size_t)unit * 4096;
#pragma unroll
        for (int mt = 0; mt < 4; ++mt) {
            const float egc = GPAD(16 * mt + l15)[2];
#pragma unroll
            for (int ks = 0; ks < 2; ++ks) {
                const int c = 16 * mt + l15, k0 = 32 * ks + 4 * grp;
                const uint2 w0 = *(const uint2*)(tmp + c * 72 + k0), w1 = *(const uint2*)(tmp + c * 72 + k0 + 16);
                v4u wv; wv.x = w0.x; wv.y = w0.y; wv.z = w1.x; wv.w = w1.y;
                *(v4u*)(WF + ((size_t)(mt * 2 + ks) * 64 + lane) * 8) = wv;
                const uint2 q0 = *(const uint2*)(qt + c * 72 + k0), q1 = *(const uint2*)(qt + c * 72 + k0 + 16);
                v4u qv;
                qv.x = pk2(__uint_as_float(q0.x << 16) * egc, __uint_as_float(q0.x & 0xffff0000u) * egc); qv.y = pk2(__uint_as_float(q0.y << 16) * egc, __uint_as_float(q0.y & 0xffff0000u) * egc);
                qv.z = pk2(__uint_as_float(q1.x << 16) * egc, __uint_as_float(q1.x & 0xffff0000u) * egc); qv.w = pk2(__uint_as_float(q1.y << 16) * egc, __uint_as_float(q1.y & 0xffff0000u) * egc);
                *(v4u*)(QGF + ((size_t)(mt * 2 + ks) * 64 + lane) * 8) = qv;
                float kd[8];
#pragma unroll
                for (int j = 0; j < 8; ++j) { const int cc = kperm(ks, grp, j); kd[j] = __uint_as_float((unsigned)kt[cc * 72 + 16 * mt + l15] << 16) * GPAD(cc)[3]; }
                v4u kv; kv.x = pk2(kd[0], kd[1]); kv.y = pk2(kd[2], kd[3]); kv.z = pk2(kd[4], kd[5]); kv.w = pk2(kd[6], kd[7]);
                *(v4u*)(KDF + ((size_t)(mt * 2 + ks) * 64 + lane) * 8) = kv;
            }
        }
        if (lane == 0) p.G_GL[unit] = expf(gclast);
    }
    wave_lds_sync();
#undef GPAD
}

constexpr int CH_SLOT = 32768;
__device__ __forceinline__ void gdn_chain_wg(const KP& p, int h, int wave, int lane, unsigned char* ldsb) {
    asm volatile("" : "+v"(lane));
    const int l15 = lane & 15, grp = lane >> 4;
    float* GLs = (float*)(ldsb + 4 * CH_SLOT);
    if (wave < 4) GLs[wave * 64 + lane] = p.G_GL[(size_t)(wave * 64 + lane) * 8 + h];
#define CH_BAR() do { asm volatile("s_waitcnt lgkmcnt(0)" ::: "memory"); __builtin_amdgcn_s_barrier(); asm volatile("" ::: "memory"); } while (0)
    if (wave >= 4) {
        const int lw = wave - 4;
        const unsigned char* gb = (lw == 0) ? (const unsigned char*)p.G_WF : (lw == 1) ? (const unsigned char*)p.G_KDF : (const unsigned char*)p.G_UF + (size_t)(lw - 2) * 8192;
        const size_t ustride = (lw < 2) ? 8192 : 16384;
        gb += (size_t)h * ustride + (size_t)lane * 16;
        auto src = [&](int n, int k) -> const v4u* { return (const v4u*)(gb + (size_t)n * 8 * ustride + k * 1024); };
        v4u rs[4][8];
#pragma unroll
        for (int j = 0; j < 4; ++j)
#pragma unroll
            for (int k = 0; k < 8; ++k) rs[j][k] = *src(j, k);
#pragma unroll
        for (int j = 0; j < 2; ++j) {
#pragma unroll
            for (int k = 0; k < 8; ++k) { *(v4u*)(ldsb + j * CH_SLOT + (lw * 512 + k * 64 + lane) * 16) = rs[j][k]; rs[j][k] = *src(4 + j, k); }
        }
        CH_BAR();
        for (int n0 = 0; n0 < 256; n0 += 4) {
#pragma unroll
            for (int j = 0; j < 4; ++j) {
                const int n = n0 + j, st = n + 2;
                if (st < 256) {
                    const int set = (j + 2) & 3;
#pragma unroll
                    for (int k = 0; k < 8; ++k) { *(v4u*)(ldsb + (st & 3) * CH_SLOT + (lw * 512 + k * 64 + lane) * 16) = rs[set][k]; if (st + 4 < 256) rs[set][k] = *src(st + 4, k); }
                }
                CH_BAR();
            }
        }
#undef CH_BAR
        return;
    }
    const int vq = wave;
    f32x4 S[4];
#pragma unroll
    for (int i = 0; i < 4; ++i) S[i] = (f32x4){0.f, 0.f, 0.f, 0.f};
    asm volatile("s_waitcnt lgkmcnt(0)" ::: "memory"); __builtin_amdgcn_s_barrier(); asm volatile("" ::: "memory");
    for (int n = 0; n < 256; ++n) {
        const unsigned char* sl = ldsb + (n & 3) * CH_SLOT;
        bf16x8 wf[4][2], kdf[4][2]; f32x4 uf[4];
#pragma unroll
        for (int mt = 0; mt < 4; ++mt) {
#pragma unroll
            for (int ks = 0; ks < 2; ++ks) { wf[mt][ks] = *(const bf16x8*)(sl + ((mt * 2 + ks) * 64 + lane) * 16); kdf[mt][ks] = *(const bf16x8*)(sl + 8192 + ((mt * 2 + ks) * 64 + lane) * 16); }
            uf[mt] = *(const f32x4*)(sl + 16384 + ((vq * 4 + mt) * 64 + lane) * 16);
        }
        const float gl = GLs[n];
        const size_t fo = ((size_t)((n * 8 + h) * 4 + vq) * 2) * 512;
        bf16x8 sB[2];
#pragma unroll
        for (int ks = 0; ks < 2; ++ks) { sB[ks] = pack_p(S[2 * ks], S[2 * ks + 1]); *(bf16x8*)(p.G_SPF + fo + ((size_t)ks * 64 + lane) * 8) = sB[ks]; }
        f32x4 v[4];
#pragma unroll
        for (int mt = 0; mt < 4; ++mt) { v[mt] = uf[mt]; v[mt] = MFMA16(wf[mt][0], sB[0], v[mt]); v[mt] = MFMA16(wf[mt][1], sB[1], v[mt]); }
        bf16x8 vB[2];
#pragma unroll
        for (int ks = 0; ks < 2; ++ks) { vB[ks] = pack_p(v[2 * ks], v[2 * ks + 1]); *(bf16x8*)(p.G_VNF + fo + ((size_t)ks * 64 + lane) * 8) = vB[ks]; }
#pragma unroll
        for (int mt = 0; mt < 4; ++mt) { S[mt] = S[mt] * gl; S[mt] = MFMA16(kdf[mt][0], vB[0], S[mt]); S[mt] = MFMA16(kdf[mt][1], vB[1], S[mt]); }
        asm volatile("s_waitcnt lgkmcnt(0)" ::: "memory"); __builtin_amdgcn_s_barrier(); asm volatile("" ::: "memory");
    }
    float* so = p.out + O_GS_P + (size_t)h * 4096;
#pragma unroll
    for (int mt = 0; mt < 4; ++mt)
#pragma unroll
        for (int r = 0; r < 4; ++r) so[(16 * mt + 4 * grp + r) * 64 + 16 * vq + l15] = S[mt][r];
}

__device__ __forceinline__ void gdn_out_unit(const KP& p, int unit, int lane) {
    asm volatile("" : "+v"(lane));
    const int n = unit >> 3, h = unit & 7, t0 = 64 * n; const int l15 = lane & 15, grp = lane >> 4;
    const bf16* QGF = p.G_QGF + (size_t)unit * 4096; const bf16* QKF = p.G_QKF + (size_t)unit * 4096;
    f32x4 o[4][4];
#pragma unroll
    for (int mt = 0; mt < 4; ++mt)
#pragma unroll
        for (int vq = 0; vq < 4; ++vq) o[mt][vq] = (f32x4){0.f, 0.f, 0.f, 0.f};
#pragma unroll
    for (int ks = 0; ks < 2; ++ks) {
        bf16x8 sp[4], vn[4];
#pragma unroll
        for (int vq = 0; vq < 4; ++vq) { const size_t fo = ((size_t)(unit * 4 + vq) * 2 + ks) * 512 + (size_t)lane * 8; sp[vq] = *(const bf16x8*)(p.G_SPF + fo); vn[vq] = *(const bf16x8*)(p.G_VNF + fo); }
#pragma unroll
        for (int mt = 0; mt < 4; ++mt) {
            const bf16x8 qg = *(const bf16x8*)(QGF + ((size_t)(mt * 2 + ks) * 64 + lane) * 8), qk = *(const bf16x8*)(QKF + ((size_t)(mt * 2 + ks) * 64 + lane) * 8);
#pragma unroll
            for (int vq = 0; vq < 4; ++vq) { o[mt][vq] = MFMA16(qg, sp[vq], o[mt][vq]); o[mt][vq] = MFMA16(qk, vn[vq], o[mt][vq]); }
        }
    }
    float nw[4];
#pragma unroll
    for (int vq = 0; vq < 4; ++vq) nw[vq] = p.gnw[16 * vq + l15];
#pragma unroll
    for (int mt = 0; mt < 4; ++mt)
#pragma unroll
        for (int r = 0; r < 4; ++r) {
            float ss = 0.f;
#pragma unroll
            for (int vq = 0; vq < 4; ++vq) ss += o[mt][vq][r] * o[mt][vq][r];
            ss += __shfl_xor(ss, 1); ss += __shfl_xor(ss, 2); ss += __shfl_xor(ss, 4); ss += __shfl_xor(ss, 8);
            const float rs = rsqrtf(ss * (1.f / 64.f) + NORM_EPS);
            const int t = t0 + 16 * mt + 4 * grp + r;
            const float* zr = p.BIGF + (size_t)t * PA + C_Z + h * 64;
#pragma unroll
            for (int vq = 0; vq < 4; ++vq) p.MIXB[(size_t)t * 1024 + 512 + h * 64 + 16 * vq + l15] = (bf16)f2bf(o[mt][vq][r] * rs * nw[vq] * siluf_(zr[16 * vq + l15]));
        }
}

#define MFMA8(a, b, c) __builtin_amdgcn_mfma_f32_16x16x32_fp8_fp8((a), (b), (c), 0, 0, 0)
__device__ __forceinline__ long pack_fp8(const f32x4& a, const f32x4& b) {
    int w0 = 0, w1 = 0;
    w0 = __builtin_amdgcn_cvt_pk_fp8_f32(a[0], a[1], w0, false); w0 = __builtin_amdgcn_cvt_pk_fp8_f32(a[2], a[3], w0, true);
    w1 = __builtin_amdgcn_cvt_pk_fp8_f32(b[0], b[1], w1, false); w1 = __builtin_amdgcn_cvt_pk_fp8_f32(b[2], b[3], w1, true);
    return (long)(((unsigned long long)(unsigned)w1 << 32) | (unsigned long long)(unsigned)w0);
}
template <bool GEN>
__device__ __forceinline__ void nsa_slc_item8(const KP& p, int tq, int g, int lane) {
    asm volatile("" : "+v"(lane));
    const int l15 = lane & 15, grp = lane >> 4, hn = lane & 3;
    const unsigned char* KF = p.KS8 + (size_t)g * T * 64; const unsigned char* VF = p.VS8 + (size_t)g * T * 64;
    const int* selp = p.SEL + ((size_t)g * T + tq) * 16;
    int sb[16];
#pragma unroll
    for (int i = 0; i < 16; ++i) sb[i] = __builtin_amdgcn_readfirstlane(selp[i]);
    long qs[2];
#pragma unroll
    for (int ks = 0; ks < 2; ++ks) {
        const bf16x8 qb = *(const bf16x8*)(p.QB + (size_t)tq * 512 + (g * 4 + hn) * 64 + 32 * ks + 8 * grp);
        f32x4 a, b;
#pragma unroll
        for (int j = 0; j < 4; ++j) { a[j] = __uint_as_float((unsigned)(unsigned short)qb[j] << 16) * (1.f / QSCALE); b[j] = __uint_as_float((unsigned)(unsigned short)qb[4 + j] << 16) * (1.f / QSCALE); }
        qs[ks] = pack_fp8(a, b);
    }
    AttW a; attw_init(a);
    long kf[3][4][2], vf[3][2][4];
    auto issue = [&](int bi, int buf) {
        int blk = sb[bi]; if (GEN && (blk < 0 || blk * 64 > tq)) blk = 0;
        typedef long l2_t __attribute__((ext_vector_type(2)));
#pragma unroll
        for (int tl = 0; tl < 4; ++tl) { const l2_t x = *(const l2_t*)(KF + ((size_t)(blk * 4 + tl) * 64 + lane) * 16); kf[buf][tl][0] = x[0]; kf[buf][tl][1] = x[1]; }
#pragma unroll
        for (int dt = 0; dt < 4; ++dt) { const l2_t x = *(const l2_t*)(VF + ((size_t)(blk * 4 + dt) * 64 + lane) * 16); vf[buf][0][dt] = x[0]; vf[buf][1][dt] = x[1]; }
    };
    issue(0, 0); issue(1, 1);
#pragma unroll
    for (int bi = 0; bi < 16; ++bi) {
        const int buf = bi % 3;
        if (bi + 2 < 16) issue(bi + 2, (bi + 2) % 3);
        const int blk = sb[bi]; const int k0 = blk * 64;
        if (GEN && (blk < 0 || k0 > tq)) continue;
        const f32x4 z = {0.f, 0.f, 0.f, 0.f};
        f32x4 sc[4];
#pragma unroll
        for (int tl = 0; tl < 4; ++tl) { sc[tl] = MFMA8(kf[buf][tl][0], qs[0], z); sc[tl] = MFMA8(kf[buf][tl][1], qs[1], sc[tl]); }
        if (GEN ? (k0 + 63 > tq) : (bi == 1)) {
#pragma unroll
            for (int tl = 0; tl < 4; ++tl)
#pragma unroll
                for (int j = 0; j < 4; ++j) if (k0 + 16 * tl + 4 * grp + j > tq) sc[tl][j] = -INFINITY;
        }
        float mx = fmaxf(fmaxf(fmaxf(fmaxf(sc[0][0], sc[0][1]), fmaxf(sc[0][2], sc[0][3])), fmaxf(fmaxf(sc[1][0], sc[1][1]), fmaxf(sc[1][2], sc[1][3]))),
                         fmaxf(fmaxf(fmaxf(sc[2][0], sc[2][1]), fmaxf(sc[2][2], sc[2][3])), fmaxf(fmaxf(sc[3][0], sc[3][1]), fmaxf(sc[3][2], sc[3][3]))));
        mx = fmaxf(mx, __shfl_xor(mx, 16)); mx = fmaxf(mx, __shfl_xor(mx, 32));
        const float mn = fmaxf(a.m, mx * QSCALE);
        const float alpha = __builtin_amdgcn_exp2f(a.m - mn);
        const float mb = 7.f - mn;
        f32x4 pp[4]; float sum = 0.f;
#pragma unroll
        for (int tl = 0; tl < 4; ++tl) {
#pragma unroll
            for (int j = 0; j < 4; ++j) pp[tl][j] = __builtin_amdgcn_exp2f(fmaf(sc[tl][j], QSCALE, mb));
            sum += (pp[tl][0] + pp[tl][1]) + (pp[tl][2] + pp[tl][3]);
        }
        a.l = a.l * alpha + sum; a.m = mn;
        const long pf0 = pack_fp8(pp[0], pp[1]), pf1 = pack_fp8(pp[2], pp[3]);
#pragma unroll
        for (int dt = 0; dt < 4; ++dt) { a.o[dt] = a.o[dt] * alpha; a.o[dt] = MFMA8(vf[buf][0][dt], pf0, a.o[dt]); a.o[dt] = MFMA8(vf[buf][1][dt], pf1, a.o[dt]); }
    }
    const float lt = grp_sum(a.l);
    if (l15 < 4) {
        const float gs = sigmoidf_(p.BIGF[(size_t)tq * PA + C_GATE + 8 + g * 4 + l15]) * (lt > 0.f ? 1.f / lt : 0.f);
#pragma unroll
        for (int dt = 0; dt < 4; ++dt) {
            const size_t o = (size_t)tq * 512 + g * 256 + l15 * 64 + 16 * dt + 4 * grp;
            const f32x4 base = *(const f32x4*)(p.NSACC + o); const f32x4 v = base + a.o[dt] * gs;
            uint2 w; w.x = pk2(v[0], v[1]); w.y = pk2(v[2], v[3]);
            *(uint2*)(p.MIXB + (size_t)tq * 1024 + g * 256 + l15 * 64 + 16 * dt + 4 * grp) = w;
        }
    }
}

__device__ __forceinline__ void ph_gdn_chunks(const KP& p, const Fr& F) {
    if (F.wave < 4) for (int unit = F.bid * 4 + F.wave; unit < 2048; unit += F.G * 4) gdn_chunk_unit(p, unit, F.lds, F.wave * GDN_WL, F.lane);
    else { const int unit = F.bid * 4 + (F.wave - 4); if (unit < 128) cmp_prompt_unit(p, unit, F.lane); }
}
__device__ __forceinline__ void ph_mix_a(const KP& p, const Fr& F) {
    if (F.bid < 32) gdn_scan_item(p, (F.bid + 1) * 8 + F.wave, (float*)(F.lds + 8 * FAST_WL + 1024 + F.wave * 512), F.lane);
    float* wl = (float*)(F.lds + F.wave * FAST_WL);
    for (int unit = F.gw; unit < 2048; unit += F.NGW) nsa_fast_unit(p, unit, wl, F.lane);
}
__device__ __forceinline__ void ph_mix_b(const KP& p, const Fr& F) {
    if (F.bid < 8) { gdn_chain_wg(p, F.bid, F.wave, F.lane, F.lds); return; }
    if (F.bid < 24) {
        const int it = (F.bid - 8) * 4 + (F.wave & 3);
        if (F.wave < 4) nsa_smp_cs(p, it >> 1, it & 1, (float*)(F.lds + F.wave * 20480), F.lane);
        else nsa_smp_win(p, it >> 1, it & 1, (float*)(F.lds + 81920 + (F.wave - 4) * 12288), F.lane);
        return;
    }
    const int g = F.bid & 1, fr = (F.bid - 24) >> 1, NW = ((F.G - 24) >> 1) * 8;
    for (int tq = fr * 8 + F.wave; tq < T; tq += NW) { if (tq >= 1024) nsa_slc_item8<false>(p, tq, g, F.lane); else nsa_slc_item8<true>(p, tq, g, F.lane); }
}

__device__ __forceinline__ void ph_gdn_out(const KP& p, const Fr& F) {
    const float* H0 = p.BIGF; const int lane = F.lane;
    for (int unit = F.gw; unit < 2048; unit += F.NGW) gdn_out_unit(p, unit, lane);
    for (int idx = F.bid * NTHR + F.tid; idx < NSMP * 512; idx += F.G * NTHR) { const int b = idx >> 9, c = idx & 511; const float* sp = p.SMIXF + (size_t)b * 3 * 512 + c;
        p.MIXB[(size_t)(T + b) * 1024 + c] = (bf16)f2bf(sp[0] + sp[512] + sp[1024]); }
    for (int item = T * 8 + F.gw; item < TS * 8; item += F.NGW) {
        const int r = item >> 3, h = item & 7;
        const float o = p.OG[((size_t)r * 8 + h) * 64 + lane];
        const float ms = wave_sum(o * o) * (1.f / 64.f);
        const float z = H0[(size_t)r * PA + C_Z + h * 64 + lane];
        p.MIXB[(size_t)r * 1024 + 512 + h * 64 + lane] = (bf16)f2bf(o * rsqrtf(ms + NORM_EPS) * p.gnw[lane] * siluf_(z));
    }
}

__device__ __forceinline__ void ph_ln(const Fr& F, const float* Xp, const float* Xs, const float* Fm, const float* gam, const float* bet, float* outp, float* outs, bf16* ob) {
    const int lane = F.lane;
    for (int r = F.gw; r < TS; r += F.NGW) {
        const float4* xr = (const float4*)((r < T) ? Xp + (size_t)r * DM : Xs + (size_t)(r - T) * DM) + lane; const float4* fr = (const float4*)(Fm + (size_t)r * DM) + lane;
        f32x4 v[4]; float s = 0.f;
#pragma unroll
        for (int j = 0; j < 4; ++j) { const float4 x = xr[64 * j], f = fr[64 * j]; v[j] = (f32x4){DN_ALPHA * x.x + f.x, DN_ALPHA * x.y + f.y, DN_ALPHA * x.z + f.z, DN_ALPHA * x.w + f.w}; s += (v[j][0] + v[j][1]) + (v[j][2] + v[j][3]); }
        const float mean = wave_sum(s) * (1.f / DM); float q = 0.f;
#pragma unroll
        for (int j = 0; j < 4; ++j) { v[j] = v[j] - mean; q += (v[j][0] * v[j][0] + v[j][1] * v[j][1]) + (v[j][2] * v[j][2] + v[j][3] * v[j][3]); }
        const float rstd = rsqrtf(wave_sum(q) * (1.f / DM) + LN_EPS);
        float4* o = (float4*)((r < T) ? outp + (size_t)r * DM : outs + (size_t)(r - T) * DM) + lane;
#pragma unroll
        for (int j = 0; j < 4; ++j) { const float4 g4 = ((const float4*)gam)[lane + 64 * j], b4 = ((const float4*)bet)[lane + 64 * j];
            const float4 y = make_float4(v[j][0] * rstd * g4.x + b4.x, v[j][1] * rstd * g4.y + b4.y, v[j][2] * rstd * g4.z + b4.z, v[j][3] * rstd * g4.w + b4.w);
            o[64 * j] = y; if (ob) { uint2 w; w.x = pk2(y.x, y.y); w.y = pk2(y.z, y.w); *((uint2*)(ob + (size_t)r * DM) + lane + 64 * j) = w; } }
    }
}

__device__ __forceinline__ void ph_ffn_act(const KP& p, const Fr& F, int layer) {
    const float* U = p.BIGF; const float* cw = p.ffn_cw + (size_t)layer * 3 * DFF2; const float* cb = p.ffn_cb + (size_t)layer * DFF2;
    const size_t gt = (size_t)F.bid * NTHR + F.tid, GT = (size_t)F.G * NTHR;
    const size_t total = (size_t)TS * DFF;
    for (size_t idx = gt; idx < total; idx += GT) {
        const int r = (int)(idx / DFF), j = (int)(idx % DFF);
        const bool smp = r >= T; const int b = r - T;
        float c2[2];
#pragma unroll
        for (int half = 0; half < 2; ++half) {
            const int ch = half * DFF + j;
            float acc = cb[ch];
#pragma unroll
            for (int k = 0; k < 3; ++k) {
                float u;
                if (!smp) { const int t = r + k - 2; u = (t >= 0) ? U[(size_t)t * DFF2 + ch] : 0.f; }
                else u = (k < 2) ? p.st_ffn[(((size_t)b * 2 + layer) * 2 + k) * DFF2 + ch] : U[(size_t)r * DFF2 + ch];
                acc += cw[k * DFF2 + ch] * u;
            }
            c2[half] = acc;
        }
        p.HFFB[idx] = (bf16)f2bf(siluf_(c2[0]) * c2[1]);
    }
    for (size_t idx = gt; idx < (size_t)2 * DFF2; idx += GT) {
        const int k = (int)(idx / DFF2), ch = (int)(idx % DFF2);
        p.out[O_FFN_P + ((size_t)layer * 2 + k) * DFF2 + ch] = U[(size_t)(T - 2 + k) * DFF2 + ch];
    }
    for (size_t idx = gt; idx < (size_t)NSMP * 2 * DFF2; idx += GT) {
        const int b = (int)(idx / (2 * DFF2)), k = (int)((idx / DFF2) % 2), ch = (int)(idx % DFF2);
        p.out[O_FFN_S + (((size_t)b * 2 + layer) * 2 + k) * DFF2 + ch] =
            (k == 0) ? p.st_ffn[(((size_t)b * 2 + layer) * 2 + 1) * DFF2 + ch] : U[(size_t)(T + b) * DFF2 + ch];
    }
}

__device__ __forceinline__ void ph_dil_prep(const KP& p, const Fr& F) {
    const float* H1 = p.BIGF;
    const size_t gt = (size_t)F.bid * NTHR + F.tid, GT = (size_t)F.G * NTHR;
    const size_t total = (size_t)TS * 2048;
    for (size_t idx = gt + (size_t)T * 2048; idx < total; idx += GT) {
        const int r = (int)(idx >> 11), c = (int)(idx & 2047);
        const bool smp = r >= T; const int pos = smp ? T : r;
        const float* row = H1 + (size_t)r * 3072;
        const int i = c & 63; const float2 cs = p.ROPE[pos * 32 + (i & 31)];
        const float v = rope_val(row, c & ~63, i, cs);
        if (c < 1024) p.QD[(size_t)r * 1024 + c] = v; else p.KD[(size_t)r * 1024 + (c - 1024)] = v;
    }
}
__device__ __forceinline__ void ph_dil_cache(const KP& p, const Fr& F) {
    const float* H1 = p.BIGF;
    const size_t gt = (size_t)F.bid * NTHR + F.tid, GT = (size_t)F.G * NTHR;
    const size_t tots4 = (size_t)NSMP * 2048 * 512;
    for (size_t idx = gt; idx < tots4; idx += GT) {
        const int b = (int)(idx / (2048 * 512)); const int i = (int)((idx / 512) % 2048); const int c4 = (int)(idx % 512);
        float4 v;
        if (i < 2047) v = ((const float4*)p.st_dil)[((size_t)b * 2048 + i + 1) * 512 + c4];
        else { const int c = c4 * 4; const int r = T + b;
               v = (c < 1024) ? *(const float4*)(p.KD + (size_t)r * 1024 + c) : *(const float4*)(H1 + (size_t)r * 3072 + 2048 + (c - 1024)); }
        ((float4*)(p.out + O_DIL_S))[idx] = v;
    }
}
__device__ __forceinline__ void ph_dil_attn(const KP& p, const Fr& F) {
    const float* H1 = p.BIGF; const int lane = F.lane;
    float* qs = (float*)(F.lds + F.wave * 4096); float* sc = qs + 64;
    float* ex = (float*)(F.lds + 32768);
    const int il = F.wave / 3, gi = F.wave - 3 * il;
    const int item = F.bid * 2 + il; const int b = item >> 4, h = item & 15, r = T + b;
    if (F.wave < 6 && item < NSMP * 16) {
        qs[lane] = p.QD[(size_t)r * 1024 + h * 64 + lane];
        wave_lds_sync();
        const int dd = gi == 0 ? 1 : (gi == 1 ? 4 : 16);
        auto kf = [&](int j, const float*& kp, const float*& vp) -> bool {
            const int pos = T - j * dd;
            if (pos == T) { kp = p.KD + (size_t)r * 1024 + h * 64; vp = H1 + (size_t)r * 3072 + 2048 + h * 64; return true; }
            const float* base = p.st_dil + ((size_t)b * 2048 + (pos - (T - 2048))) * 2048;
            kp = base + h * 64; vp = base + 1024 + h * 64; return true; };
        float o[1], den[1], mx[1];
        wave_attend<1>(qs, sc, 448, 129, kf, o, den, lane, mx);
        float* e = ex + (il * 3 + gi) * 68;
        e[lane] = o[0] * den[0]; if (lane == 0) { e[64] = mx[0]; e[65] = den[0]; }
    }
    __syncthreads();
    if (F.wave < 6 && gi == 0 && item < NSMP * 16) {
        const float* e = ex + il * 3 * 68;
        const float m0 = e[64], m1 = e[68 + 64], m2 = e[136 + 64]; const float M = fmaxf(m0, fmaxf(m1, m2));
        const float w0 = expf(m0 - M), w1 = expf(m1 - M), w2 = expf(m2 - M);
        const float num = w0 * e[lane] + w1 * e[68 + lane] + w2 * e[136 + lane], dn = w0 * e[65] + w1 * e[68 + 65] + w2 * e[136 + 65];
        p.MIXB[(size_t)r * 1024 + h * 64 + lane] = (bf16)f2bf(num / dn);
    }
}

__device__ __forceinline__ void ph_dil_prep_fast(const KP& p, const Fr& F) {
    const float* H1 = p.BIGF;
    const size_t gt = (size_t)F.bid * NTHR + F.tid, GT = (size_t)F.G * NTHR;
    for (size_t idx = gt; idx < (size_t)T * 128; idx += GT) {
        const int t = (int)(idx >> 7), u = (int)(idx & 127);
        const int hq = u >> 2, d0 = (u & 3) * 8, c0 = hq * 64 + d0; const float* row = H1 + (size_t)t * 3072;
        const float4 a0 = *(const float4*)(row + c0), a1 = *(const float4*)(row + c0 + 4), b0 = *(const float4*)(row + c0 + 32), b1 = *(const float4*)(row + c0 + 36);
        const float4* rp = (const float4*)(p.ROPE + t * 32 + d0); const float4 r0 = rp[0], r1 = rp[1], r2 = rp[2], r3 = rp[3];
        const float x1[8] = {a0.x, a0.y, a0.z, a0.w, a1.x, a1.y, a1.z, a1.w}, x2[8] = {b0.x, b0.y, b0.z, b0.w, b1.x, b1.y, b1.z, b1.w};
        const float cs[8] = {r0.x, r0.z, r1.x, r1.z, r2.x, r2.z, r3.x, r3.z}, sn[8] = {r0.y, r0.w, r1.y, r1.w, r2.y, r2.w, r3.y, r3.w};
        float lo[8], hi[8];
#pragma unroll
        for (int j = 0; j < 8; ++j) { lo[j] = x1[j] * cs[j] - x2[j] * sn[j]; hi[j] = x2[j] * cs[j] + x1[j] * sn[j]; }
        if (hq < 16) {
            v4u o; o.x = pk2(lo[0] * QSCALE, lo[1] * QSCALE); o.y = pk2(lo[2] * QSCALE, lo[3] * QSCALE); o.z = pk2(lo[4] * QSCALE, lo[5] * QSCALE); o.w = pk2(lo[6] * QSCALE, lo[7] * QSCALE);
            *(v4u*)(p.QDB + (size_t)t * 1024 + c0) = o;
            o.x = pk2(hi[0] * QSCALE, hi[1] * QSCALE); o.y = pk2(hi[2] * QSCALE, hi[3] * QSCALE); o.z = pk2(hi[4] * QSCALE, hi[5] * QSCALE); o.w = pk2(hi[6] * QSCALE, hi[7] * QSCALE);
            *(v4u*)(p.QDB + (size_t)t * 1024 + c0 + 32) = o;
        } else {
            const int h = hq - 16, kc = h * 64 + d0;
            v4u ol, oh; ol.x = pk2(lo[0], lo[1]); ol.y = pk2(lo[2], lo[3]); ol.z = pk2(lo[4], lo[5]); ol.w = pk2(lo[6], lo[7]);
            oh.x = pk2(hi[0], hi[1]); oh.y = pk2(hi[2], hi[3]); oh.z = pk2(hi[4], hi[5]); oh.w = pk2(hi[6], hi[7]);
#pragma unroll
            for (int pass = 0; pass < 3; ++pass) { const int sh = 2 * pass; const int pi = (t & ((1 << sh) - 1)) * (T >> sh) + (t >> sh);
                bf16* kb = (pass == 0 ? p.DKF[0] : pass == 1 ? p.DKF[1] : p.DKF[2]) + (size_t)h * T * 64;
                *(v4u*)(kb + kfrag_elem(pi, d0)) = ol; *(v4u*)(kb + kfrag_elem(pi, d0 + 32)) = oh; }
            if (t >= T - 2048) { float* op = p.out + O_DIL_P + (size_t)(t - (T - 2048)) * 2048 + kc;
                *(float4*)op = make_float4(lo[0], lo[1], lo[2], lo[3]); *(float4*)(op + 4) = make_float4(lo[4], lo[5], lo[6], lo[7]);
                *(float4*)(op + 32) = make_float4(hi[0], hi[1], hi[2], hi[3]); *(float4*)(op + 36) = make_float4(hi[4], hi[5], hi[6], hi[7]); }
        }
    }
    for (size_t idx = gt; idx < (size_t)2048 * 256; idx += GT) {
        const int i = (int)(idx >> 8), c4 = (int)(idx & 255);
        *(float4*)(p.out + O_DIL_P + (size_t)i * 2048 + 1024 + c4 * 4) = *(const float4*)(H1 + (size_t)(T - 2048 + i) * 3072 + 2048 + c4 * 4);
    }
    const int lane = F.lane, l15 = lane & 15, grp = lane >> 4;
    for (int unit = F.gw; unit < 3 * 16 * 512; unit += F.NGW) {
        const int st = unit & 511, h = (unit >> 9) & 15, pass = unit >> 13; const int sh = 2 * pass, Td = T >> sh;
        const int pi0 = 32 * st, r = pi0 / Td, s0 = pi0 - r * Td;
        bf16* dst = p.DVF[pass] + (size_t)h * T * 64;
#pragma unroll
        for (int dt = 0; dt < 4; ++dt) {
            float v[8];
#pragma unroll
            for (int j = 0; j < 8; ++j) { const int s = s0 + 16 * (j >> 2) + 4 * grp + (j & 3); const int t = (s << sh) + r;
                v[j] = H1[(size_t)t * 3072 + 2048 + h * 64 + 16 * dt + l15]; }
            v4u o; o.x = pk2(v[0], v[1]); o.y = pk2(v[2], v[3]); o.z = pk2(v[4], v[5]); o.w = pk2(v[6], v[7]);
            *(v4u*)(dst + vfrag_off(st, dt, lane)) = o;
        }
    }
}

__device__ __forceinline__ void dil_pass(const KP& p, int unit, int pass, unsigned char* ldsb, int w4, int lane) {
    asm volatile("" : "+v"(lane));
    const int h = unit & 15, P0 = (unit >> 4) * 256;
    const int l15 = lane & 15, grp = lane >> 4;
    float* stO = (float*)ldsb; float* stML = stO + 256 * 64;
    {
        const int sh = 2 * pass, Td = T >> sh;
        const bf16* KF = (pass == 0 ? p.DKF[0] : pass == 1 ? p.DKF[1] : p.DKF[2]) + (size_t)h * T * 64;
        const bf16* VF = (pass == 0 ? p.DVF[0] : pass == 1 ? p.DVF[1] : p.DVF[2]) + (size_t)h * T * 64;
        for (int tt = 0; tt < 4; ++tt) {
            const int tl = 4 * w4 + tt;
            const int r = tl >> (4 - sh), s0 = (P0 >> sh) + 16 * (tl & ((16 >> sh) - 1));
            const int sq = s0 + l15, tq = (sq << sh) + r, tloc = tq - P0;
            bf16x8 qf[2];
#pragma unroll
            for (int ks = 0; ks < 2; ++ks) qf[ks] = *(const bf16x8*)(p.QDB + (size_t)tq * 1024 + h * 64 + 32 * ks + 8 * grp);
            AttW a;
            if (pass == 0) attw_init(a);
            else {
#pragma unroll
                for (int dt = 0; dt < 4; ++dt) a.o[dt] = *(const f32x4*)(stO + tloc * 64 + 16 * dt + 4 * grp);
                a.m = stML[tloc * 2]; a.l = (grp == 0) ? stML[tloc * 2 + 1] : 0.f;
            }
            int kstart = s0 - 128; if (kstart < 0) kstart = 0; kstart &= ~31;
            const int nsteps = (s0 + 16 - kstart + 31) >> 5;
            const int base = r * Td;
            bf16x8 kf[3][2][2], vf[3][4];
            auto issue = [&](int s, int buf) {
                const int k0 = kstart + 32 * s;
#pragma unroll
                for (int tl2 = 0; tl2 < 2; ++tl2)
#pragma unroll
                    for (int ks = 0; ks < 2; ++ks) kf[buf][tl2][ks] = *(const bf16x8*)(KF + kfrag_off(((base + k0) >> 4) + tl2, ks, lane));
#pragma unroll
                for (int dt = 0; dt < 4; ++dt) vf[buf][dt] = *(const bf16x8*)(VF + vfrag_off((base + k0) >> 5, dt, lane));
            };
            issue(0, 0); if (nsteps > 1) issue(1, 1);
#pragma unroll
            for (int s = 0; s < 5; ++s) {
                if (s < nsteps) {
                    if (s + 2 < nsteps) issue(s + 2, (s + 2) % 3);
                    const int k0 = kstart + 32 * s;
                    f32x4 s0v, s1v; qk_step(kf[s % 3], qf, s0v, s1v);
                    if ((k0 + 31 > s0) || (k0 < s0 + 15 - 128)) {
                        const int pb = k0 + 4 * grp;
#pragma unroll
                        for (int i = 0; i < 4; ++i) { const int p0 = pb + i, p1 = pb + 16 + i;
                            if (p0 > sq || p0 < sq - 128) s0v[i] = -INFINITY; if (p1 > sq || p1 < sq - 128) s1v[i] = -INFINITY; }
                    }
                    att_update(a, s0v, s1v, vf[s % 3]);
                }
            }
            const float lt = grp_sum(a.l);
            if (pass < 2) {
#pragma unroll
                for (int dt = 0; dt < 4; ++dt) *(f32x4*)(stO + tloc * 64 + 16 * dt + 4 * grp) = a.o[dt];
                if (grp == 0) { stML[tloc * 2] = a.m; stML[tloc * 2 + 1] = lt; }
            } else {
                const float il = lt > 0.f ? 1.f / lt : 0.f;
#pragma unroll
                for (int dt = 0; dt < 4; ++dt) { uint2 o; o.x = pk2(a.o[dt][0] * il, a.o[dt][1] * il); o.y = pk2(a.o[dt][2] * il, a.o[dt][3] * il);
                    *(uint2*)(p.MIXB + (size_t)tq * 1024 + h * 64 + 16 * dt + 4 * grp) = o; }
            }
        }
    }
}
__device__ __forceinline__ void ph_dil_combo(const KP& p, const Fr& F) {
    const float* H1 = p.BIGF; const int lane = F.lane;
    const int cw = F.bid * 4 + F.wave;
#pragma unroll 1
    for (int u = 0; u < 4; ++u) {
#pragma unroll
        for (int pass = 0; pass < 3; ++pass) {
            if (F.wave >= 4) dil_pass(p, F.bid + u * F.G, pass, F.lds, F.wave - 4, lane);
            else {
                const int ci = u * 3 + pass;
                const int g0 = ci * 2 + (ci < 8 ? ci : 8), g1 = g0 + 2 + (ci < 8 ? 1 : 0);
                auto srcp = [&](int itn) -> const float4* {
                    const size_t idx = ((size_t)itn * 1024 + cw) * 64 + lane;
                    const int b = (int)(idx >> 20), i = (int)((idx >> 9) & 2047), c4 = (int)(idx & 511);
                    const int c = c4 * 4, r = T + b;
                    const float4* s_old = ((const float4*)p.st_dil) + ((size_t)b * 2048 + (i < 2047 ? i + 1 : 2047)) * 512 + c4;
                    const float4* s_new = (c < 1024) ? (const float4*)(p.KD + (size_t)r * 1024 + c) : (const float4*)(H1 + (size_t)r * 3072 + 2048 + (c - 1024));
                    return (i == 2047) ? s_new : s_old; };
                float4* dstp = (float4*)(p.out + O_DIL_S) + (size_t)cw * 64 + lane;
#pragma unroll 1
                for (int gi = g0; gi < g1; ++gi) {
                    const int i0 = gi * 16;
                    const float4 v0 = *srcp(i0), v1 = *srcp(i0 + 1), v2 = *srcp(i0 + 2), v3 = *srcp(i0 + 3), v4 = *srcp(i0 + 4), v5 = *srcp(i0 + 5), v6 = *srcp(i0 + 6), v7 = *srcp(i0 + 7);
                    const float4 v8 = *srcp(i0 + 8), v9 = *srcp(i0 + 9), v10 = *srcp(i0 + 10), v11 = *srcp(i0 + 11), v12 = *srcp(i0 + 12), v13 = *srcp(i0 + 13), v14 = *srcp(i0 + 14), v15 = *srcp(i0 + 15);
                    float4* d = dstp + (size_t)i0 * 65536;
                    d[0] = v0; d[65536] = v1; d[2 * 65536] = v2; d[3 * 65536] = v3; d[4 * 65536] = v4; d[5 * 65536] = v5; d[6 * 65536] = v6; d[7 * 65536] = v7;
                    d[8 * 65536] = v8; d[9 * 65536] = v9; d[10 * 65536] = v10; d[11 * 65536] = v11; d[12 * 65536] = v12; d[13 * 65536] = v13; d[14 * 65536] = v14; d[15 * 65536] = v15;
                }
            }
            __syncthreads();
        }
    }
}

constexpr int NPHASE = 22;
__global__ void __launch_bounds__(NTHR, 2) mega(KP p) {
    extern __shared__ __attribute__((aligned(16))) unsigned char lds[];
    Fr F; F.lds = lds; F.tid = threadIdx.x; F.lane = 0; F.wave = __builtin_amdgcn_readfirstlane(F.tid >> 6);
    F.bid = blockIdx.x; F.G = gridDim.x; F.gw = F.bid * NWAVES + F.wave; F.NGW = F.G * NWAVES;
    for (int u = F.tid; u < (LDS_BYTES - RING_BYTES) / 4; u += NTHR) ((unsigned*)(lds + RING_BYTES))[u] = 0u;
    __syncthreads();
    XcdBarrier bar; bar.bar = p.ctl + 4096; bar.x = 0; bar.st = nullptr;
    if (!MK_PER_PHASE) bar = xcd_barrier_post(p.ctl + 4096, (volatile LAS unsigned*)(lds + MISC_OFF + 32));
    const int lo = p.ph_lo, hi = p.ph_hi;
#define IN(k) (lo <= (k) && (k) < hi)

    int ph = 0;
#if PROBE_ON
#define PROBE_STAMP(k) do { if (blockIdx.x == 0 && threadIdx.x == 0) ((unsigned long long*)(p.ctl + 65536))[k] = __builtin_amdgcn_s_memrealtime(); } while (0)
#define PROBE_STAMPB(k, blk) do { if (blockIdx.x == (blk) && threadIdx.x == 0) ((unsigned long long*)(p.ctl + 65536))[k] = __builtin_amdgcn_s_memrealtime(); } while (0)
    PROBE_STAMP(0);
#else
#define PROBE_STAMP(k) do { } while (0)
#define PROBE_STAMPB(k, blk) do { } while (0)
#endif
#define PHASE(...) do { { unsigned t_ = threadIdx.x; asm volatile("" : "+v"(t_)); F.lane = (int)(t_ & 63u); } if (IN(ph)) { __VA_ARGS__ } if (IN(ph) && IN(ph + 1)) xcd_barrier(bar); ++ph; PROBE_STAMP(ph); } while (0)
    PHASE(ph_prologue(p, F););
    PHASE(ph_gemm_f32(F, p.ACTB, p.WT_A, PAP, DM, p.BIGF, PA, PA); ph_cmp_samples(p, F););
    PHASE(ph_nsa_prep(p, F); ph_nsa_prep_fast(p, F); ph_gdn_prep(p, F););
    PHASE(ph_gdn_chunks(p, F););
    PHASE(ph_mix_a(p, F););
    PHASE(ph_mix_b(p, F););
    PHASE(ph_gdn_out(p, F););
    PHASE(ph_gemm_f32(F, p.MIXB, p.WT_OA, DM, DM, p.MO, DM, DM););
    PHASE(ph_ln(F, p.x_prompt, p.x_sample, p.MO, p.ln_mix_g, p.ln_mix_b, p.X1, p.X1 + (size_t)T * DM, p.ACTB););
    PHASE(ph_ffn_gemm(p, F, p.WT_FI0, 0););
    PHASE(ph_ffn_fix(p, F, 0););
    PHASE(ph_gemm_f32(F, p.HFFB, p.WT_FO0, DM, DFF, p.MO, DM, DM););
    PHASE(ph_ln(F, p.X1, p.X1 + (size_t)T * DM, p.MO, p.ln_ffn_g, p.ln_ffn_b, p.X2, p.X2 + (size_t)T * DM, p.ACTB););
    PHASE(ph_gemm_f32(F, p.ACTB, p.WT_CI, 3072, DM, p.BIGF, 3072, 3072););
    PHASE(ph_dil_prep(p, F); ph_dil_prep_fast(p, F););
    PHASE(ph_dil_attn(p, F); __syncthreads(); ph_dil_combo(p, F););
    PHASE(ph_gemm_f32(F, p.MIXB, p.WT_CO, DM, DM, p.MO, DM, DM););
    PHASE(ph_ln(F, p.X2, p.X2 + (size_t)T * DM, p.MO, p.ln_mix_g + DM, p.ln_mix_b + DM, p.X3, p.X3 + (size_t)T * DM, p.ACTB););
    PHASE(ph_ffn_gemm(p, F, p.WT_FI1, 1););
    PHASE(ph_ffn_fix(p, F, 1););
    PHASE(ph_gemm_f32(F, p.HFFB, p.WT_FO1, DM, DFF, p.MO, DM, DM););
    PHASE(ph_ln(F, p.X3, p.X3 + (size_t)T * DM, p.MO, p.ln_ffn_g + DM, p.ln_ffn_b + DM, p.out + O_Y_P, p.out + O_Y_S, nullptr););
#undef PHASE
#if PROBE_ON
    xcd_barrier(bar);
    if (blockIdx.x == 0) { __syncthreads(); const unsigned long long* pts = (const unsigned long long*)(p.ctl + 65536); const float x = (float)(pts[PROBE_B] - pts[PROBE_A]) * 1e-5f;
        for (int i = threadIdx.x; i < NSMP * DM; i += NTHR) p.out[O_Y_S + i] *= (1.f + x); }
#endif
#undef IN
}

static inline size_t align_up(size_t x) { return (x + 255) & ~(size_t)255; }

extern "C" void kernel_launch(void* const* d_in, const int* in_sizes, int n_in, void* d_out, int out_size, void* d_ws, size_t ws_size, hipStream_t stream) {
    static int grid = 0;
    if (grid == 0) {
        int dev = 0, cus = 0, per_cu = 0;
        if (hipGetDevice(&dev) != hipSuccess || hipDeviceGetAttribute(&cus, hipDeviceAttributeMultiprocessorCount, dev) != hipSuccess) { fprintf(stderr, "kernel_launch: device query failed\n"); grid = -1; return; }
        if (hipFuncSetAttribute((const void*)mega, hipFuncAttributeMaxDynamicSharedMemorySize, LDS_BYTES) != hipSuccess) { fprintf(stderr, "kernel_launch: hipFuncSetAttribute failed\n"); grid = -1; return; }
        if (hipOccupancyMaxActiveBlocksPerMultiprocessor(&per_cu, (const void*)mega, NTHR, LDS_BYTES) != hipSuccess || per_cu < 1) { fprintf(stderr, "kernel_launch: occupancy query says %d blocks per CU\n", per_cu); }
        (void)hipGetLastError();
        grid = cus;
    }
    if (grid < 0) return;
    if ((size_t)out_size != O_END) fprintf(stderr, "kernel_launch: out_size %d != expected %zu\n", out_size, (size_t)O_END);
    KP p{};
    p.x_prompt = (const float*)d_in[0]; p.x_sample = (const float*)d_in[1]; p.cache_cmp = (const float*)d_in[2]; p.cache_slc = (const float*)d_in[3];
    p.st_win = (const float*)d_in[4]; p.st_gconv = (const float*)d_in[5]; p.st_gS = (const float*)d_in[6]; p.st_dil = (const float*)d_in[7];
    p.st_ffn = (const float*)d_in[8]; p.page_table = (const int*)d_in[9]; p.w_in_a = (const float*)d_in[10]; p.cw1 = (const float*)d_in[11];
    p.cb1 = (const float*)d_in[12]; p.cw2 = (const float*)d_in[13]; p.cpe = (const float*)d_in[14]; p.gconv_w = (const float*)d_in[15];
    p.gA = (const float*)d_in[16]; p.gdt = (const float*)d_in[17]; p.gnw = (const float*)d_in[18]; p.w_out_a = (const float*)d_in[19];
    p.w_in_c = (const float*)d_in[20]; p.w_out_c = (const float*)d_in[21]; p.ln_mix_g = (const float*)d_in[22]; p.ln_mix_b = (const float*)d_in[23];
    p.ffn_w_in = (const float*)d_in[24]; p.ffn_cw = (const float*)d_in[25]; p.ffn_cb = (const float*)d_in[26]; p.ffn_w_out = (const float*)d_in[27];
    p.ln_ffn_g = (const float*)d_in[28]; p.ln_ffn_b = (const float*)d_in[29];
    p.out = (float*)d_out;
    char* ws = (char*)d_ws; size_t off = 0;
    auto alloc = [&](size_t bytes) { void* q = (void*)(ws + off); off = align_up(off + bytes); return q; };
    p.ctl = (unsigned*)alloc(1 << 20);
    p.WT_A = (bf16*)alloc((size_t)PAP * DM * 2); p.WT_OA = (bf16*)alloc((size_t)DM * DM * 2);
    p.WT_FI0 = (bf16*)alloc((size_t)DFF2 * DM * 2); p.WT_FI1 = (bf16*)alloc((size_t)DFF2 * DM * 2);
    p.WT_FO0 = (bf16*)alloc((size_t)DM * DFF * 2); p.WT_FO1 = (bf16*)alloc((size_t)DM * DFF * 2);
    p.WT_CI = (bf16*)alloc((size_t)3072 * DM * 2); p.WT_CO = (bf16*)alloc((size_t)DM * DM * 2);
    p.ROPE = (float2*)alloc((size_t)(T + 1) * 32 * 8);
    p.ACTB = (bf16*)alloc((size_t)TSP * DM * 2); p.MIXB = (bf16*)alloc((size_t)TSP * DM * 2); p.HFFB = (bf16*)alloc((size_t)TSP * DFF * 2);
    p.KS8 = (unsigned char*)alloc((size_t)2 * T * 64); p.VS8 = (unsigned char*)alloc((size_t)2 * T * 64);
    p.QB = (bf16*)alloc((size_t)T * 512 * 2); p.KSF = (bf16*)alloc((size_t)2 * T * 64 * 2); p.VSF = (bf16*)alloc((size_t)2 * T * 64 * 2);
    p.KWF = (bf16*)alloc((size_t)2 * T * 64 * 2); p.VWF = (bf16*)alloc((size_t)2 * T * 64 * 2); p.CKF = (bf16*)alloc((size_t)2 * 512 * 64 * 2); p.CVF = (bf16*)alloc((size_t)2 * 512 * 64 * 2);
    p.ACP = (bf16*)alloc((size_t)2048 * 2048 * 2);
    p.W2T = (bf16*)alloc((size_t)2 * 64 * 128 * 2);
    p.AC = nullptr; p.WT_C = (bf16*)alloc((size_t)256 * 2048 * 2); p.HID = nullptr; p.SMIXF = (float*)alloc((size_t)NSMP * 3 * 512 * 4);
    p.UB = (float*)alloc((size_t)256 * 4 * DFF2 * 4);
    p.NSACC = (float*)alloc((size_t)T * 512 * 4); p.SEL = (int*)alloc((size_t)2 * T * 16 * 4);
    p.QDB = (bf16*)alloc((size_t)T * 1024 * 2);
    for (int i = 0; i < 3; ++i) { p.DKF[i] = (bf16*)alloc((size_t)T * 1024 * 2); p.DVF[i] = (bf16*)alloc((size_t)T * 1024 * 2); }
    p.G_WF = (bf16*)alloc((size_t)2048 * 4096 * 2); p.G_KDF = (bf16*)alloc((size_t)2048 * 4096 * 2); p.G_QGF = (bf16*)alloc((size_t)2048 * 4096 * 2); p.G_QKF = (bf16*)alloc((size_t)2048 * 4096 * 2);
    p.G_SPF = (bf16*)alloc((size_t)2048 * 4096 * 2); p.G_VNF = (bf16*)alloc((size_t)2048 * 4096 * 2); p.G_UF = (float*)alloc((size_t)2048 * 4096 * 4); p.G_GL = (float*)alloc((size_t)2048 * 4);
    p.BIGF = (float*)alloc((size_t)TSP * DFF2 * 4); p.MO = (float*)alloc((size_t)TSP * DM * 4);
    p.X1 = (float*)alloc((size_t)TS * DM * 4); p.X2 = (float*)alloc((size_t)TS * DM * 4); p.X3 = (float*)alloc((size_t)TS * DM * 4);
    p.QR = (float*)alloc((size_t)TS * 512 * 4);
    p.KS = (float*)alloc((size_t)TS * 128 * 4); p.VS = (float*)alloc((size_t)TS * 128 * 4); p.KW = (float*)alloc((size_t)TS * 128 * 4); p.VW = (float*)alloc((size_t)TS * 128 * 4);
    p.CK = (float*)alloc((size_t)33 * 512 * 128 * 4); p.CV = (float*)alloc((size_t)33 * 512 * 128 * 4);
    p.GQ = (float*)alloc((size_t)TS * 512 * 4); p.GK = (float*)alloc((size_t)TS * 512 * 4); p.GV = (float*)alloc((size_t)TS * 512 * 4); p.OG = (float*)alloc((size_t)TS * 512 * 4);
    p.Gg = (float*)alloc((size_t)TS * 8 * 4); p.Gb = (float*)alloc((size_t)TS * 8 * 4);
    p.QD = (float*)alloc((size_t)TS * DM * 4); p.KD = (float*)alloc((size_t)TS * DM * 4);
    if (off > ws_size) { fprintf(stderr, "kernel_launch: workspace too small: need %zu have %zu\n", off, ws_size); return; }
    if (hipMemsetAsync(p.ctl, 0, 1 << 20, stream) != hipSuccess) { fprintf(stderr, "kernel_launch: memset failed\n"); return; }
#if MK_PER_PHASE
    for (int k = 0; k < NPHASE; ++k) { p.ph_lo = k; p.ph_hi = k + 1; hipLaunchKernelGGL(mega, dim3(grid), dim3(NTHR), LDS_BYTES, stream, p); }
#else
    p.ph_lo = 0; p.ph_hi = NPHASE;
    hipLaunchKernelGGL(mega, dim3(grid), dim3(NTHR), LDS_BYTES, stream, p);
#endif
    const hipError_t le = hipPeekAtLastError();
    if (le != hipSuccess) fprintf(stderr, "kernel_launch: launch failed: %s\n", hipGetErrorName(le));
}
```

```cpp
#include <hip/hip_runtime.h>
#include <cstdint>
#include <cstdio>
#include <cmath>

namespace pg8 {
#define PG8_LAS __attribute__((address_space(3)))
typedef unsigned short bf16_t;
typedef short bf16x8 __attribute__((ext_vector_type(8)));
typedef float f32x4 __attribute__((ext_vector_type(4)));
typedef unsigned u32x4 __attribute__((ext_vector_type(4)));
constexpr int BM = 256, BK = 64, HALF = 128, HTB = HALF * BK * 2  , STAGE_BYTES = 8 * HTB, NXCD = 8, WGM = 8;

__host__ __device__ __forceinline__ int lds_byte(int r, int c) { const int st = (r >> 4) * 2 + (c >> 5), rr = r & 15, cc = c & 31, ob = rr * 64 + cc * 2; return st * 1024 + (ob ^ (((ob >> 9) & 1) << 5)); }
__host__ __device__ __forceinline__ void stage_rc(int b, int& R, int& C) { const int st = b / 1024, sb = b % 1024, swz = sb ^ (((sb >> 9) & 1) << 5); R = (st >> 1) * 16 + swz / 64; C = (st & 1) * 32 + (swz % 64) / 2; }
__host__ __device__ __forceinline__ int perm32(int rho) { const int n = rho >> 4, i = rho & 15; return 8 * (i >> 2) + 4 * n + (i & 3); }

struct Unit { int pm, pn; };
struct Gemm { const bf16_t* A; const bf16_t* Bt; int M, N, K; };

struct StaticOrder {
    int nM, nN, nwg, G, c;
    __host__ __device__ void init(int M, int N, int G_, int c_) { nM = M / BM; nN = N / BM; nwg = nM * nN; G = G_; c = c_; }
    __host__ __device__ bool next(int i, Unit& u) const {
        const long L = (long)i * G + c; if (L >= nwg) return false;
        int wgid = (int)L; { const int q = nwg / NXCD, r = nwg % NXCD, xcd = wgid % NXCD, off = wgid / NXCD; wgid = (xcd < r ? xcd * (q + 1) : r * (q + 1) + (xcd - r) * q) + off; }
        const int nig = WGM * nN, gid = wgid / nig, fm = gid * WGM, gsz = (nM - fm) < WGM ? (nM - fm) : WGM;
        u.pm = fm + ((wgid % nig) % gsz); u.pn = (wgid % nig) / gsz; return true;
    }
    __device__ __forceinline__ void a_ready(const Unit&) const {}
    __device__ __forceinline__ void done(const Unit&) const {}
};

typedef __bf16 bf16x2_t __attribute__((ext_vector_type(2)));
typedef float f32x2_t __attribute__((ext_vector_type(2)));
__device__ __forceinline__ unsigned cvt_pk_bf16(float lo, float hi) { const f32x2_t v = {lo, hi}; return __builtin_bit_cast(unsigned, __builtin_convertvector(v, bf16x2_t)); }
typedef float f32x2 __attribute__((ext_vector_type(2)));
__device__ __forceinline__ f32x2 gelu_pk(f32x2 v) {
    const f32x2 av = __builtin_elementwise_abs(v), d = av * 0.2316418882f + 1.0f;
    f32x2 t; t.x = __builtin_amdgcn_rcpf(d.x); t.y = __builtin_amdgcn_rcpf(d.y);
    f32x2 q = t * 0.5307027145f + (-0.7265760135f); q = q * t + 0.7107068705f; q = q * t + (-0.142248368f); q = q * t + 0.127414796f; q = q * t;
    const f32x2 s = (v * v) * (-0.72134752044f);
    f32x2 e; e.x = __builtin_amdgcn_exp2f(s.x); e.y = __builtin_amdgcn_exp2f(s.y);
    const f32x2 m = v * (q * e), r = v - m;
    f32x2 o; o.x = v.x < 0.f ? m.x : r.x; o.y = v.y < 0.f ? m.y : r.y; return o;
}

template <int ACT  > struct EpiBf16 {
    static constexpr bool PERM = true, AFTER_DRAIN = false; static_assert(ACT == 0 || ACT == 1, "EpiBf16: ACT is 0 (none) or 1 (gelu_pk)");
    bf16_t* O; int ldc; const float* bias; int split_cols; size_t split_stride; float scale0;
    __device__ __forceinline__ void operator()(const f32x4 (&acc)[2][2][4][2], const Unit& u, int wr, int wc, int fr, int fq) const {
        const int row0 = u.pm * BM + wr * 64 + fr; int colt = u.pn * BM; bf16_t* base = O;
        float sc = 1.f; if (split_cols) { const int t = colt / split_cols; base += (size_t)t * split_stride; colt -= t * split_cols; if (t == 0) sc = scale0; }
        const int col0 = colt + wc * 32 + 8 * fq, bcol0 = u.pn * BM + wc * 32 + 8 * fq;
        f32x4 bv[2][2];
#pragma unroll
        for (int bj = 0; bj < 2; ++bj)
#pragma unroll
            for (int n = 0; n < 2; ++n) bv[bj][n] = bias ? *(const f32x4*)(bias + bcol0 + bj * HALF + 4 * n) : (f32x4){0.f, 0.f, 0.f, 0.f};
#pragma unroll
        for (int ai = 0; ai < 2; ++ai)
#pragma unroll
            for (int m = 0; m < 4; ++m) { bf16_t* rowp = base + (size_t)(row0 + ai * HALF + m * 16) * ldc + col0;
#pragma unroll
                for (int bj = 0; bj < 2; ++bj) { f32x4 v0 = acc[ai][bj][m][0] + bv[bj][0], v1 = acc[ai][bj][m][1] + bv[bj][1];
                    if (ACT == 1) { f32x2 a = gelu_pk((f32x2){v0[0], v0[1]}), b = gelu_pk((f32x2){v0[2], v0[3]}), c = gelu_pk((f32x2){v1[0], v1[1]}), d = gelu_pk((f32x2){v1[2], v1[3]});
                        v0 = (f32x4){a.x, a.y, b.x, b.y}; v1 = (f32x4){c.x, c.y, d.x, d.y}; }
                    v0 = v0 * sc; v1 = v1 * sc; u32x4 w; w.x = cvt_pk_bf16(v0[0], v0[1]); w.y = cvt_pk_bf16(v0[2], v0[3]); w.z = cvt_pk_bf16(v1[0], v1[1]); w.w = cvt_pk_bf16(v1[2], v1[3]);
                    *(u32x4*)(rowp + bj * HALF) = w; } }
    }
};

struct EpiF32 {
    static constexpr bool PERM = false, AFTER_DRAIN = false;
    float* O; int ldc; int ncols;
    __device__ __forceinline__ void operator()(const f32x4 (&acc)[2][2][4][2], const Unit& u, int wr, int wc, int fr, int fq) const {
        const int row0 = u.pm * BM + wr * 64 + fr; const int col0 = u.pn * BM + wc * 32 + 4 * fq;
#pragma unroll
        for (int ai = 0; ai < 2; ++ai)
#pragma unroll
            for (int m = 0; m < 4; ++m) { float* rowp = O + (size_t)(row0 + ai * HALF + m * 16) * ldc;
#pragma unroll
                for (int bj = 0; bj < 2; ++bj)
#pragma unroll
                    for (int n = 0; n < 2; ++n) { const int c = col0 + bj * HALF + n * 16; if (c < ncols) *(f32x4*)(rowp + c) = acc[ai][bj][m][n]; } }
    }
};
template <class Epi, class Sched, bool ALIGN_EPI = false, bool SP2 = false>
__device__ __forceinline__ void gemm_phase(PG8_LAS unsigned char* lds, const Gemm g, const Sched& S, const Epi& E) {
    const int tid = threadIdx.x, wid = __builtin_amdgcn_readfirstlane(tid >> 6), lane = tid & 63, wr = wid >> 2, wc = wid & 3, fr = lane & 15, fq = lane >> 4;
    const int K = g.K, nt = K / BK;
    unsigned voffA[2], voffB[2];
#pragma unroll
    for (int i = 0; i < 2; ++i) { int R, C; stage_rc(tid * 16 + i * 8192, R, C); const int Rb = Epi::PERM ? ((R & ~31) + perm32(R & 31)) : R;
        voffA[i] = (unsigned)(R * K + C) * 2u; voffB[i] = (unsigned)(Rb * K + C) * 2u; }
    const size_t kstep = (size_t)(BK * 2);
    const size_t hstep = (size_t)HALF * K * 2;
    const size_t tstep = 2 * hstep;
    const unsigned ldsw = (unsigned)wid * 1024u;
    const int aoff = lds_byte(wr * 64 + fr, fq * 8), boff = lds_byte(wc * 32 + fr, fq * 8);
#define PG8_SA(b, h) (((b) * 2 + (h)) * HTB)
#define PG8_SB(b, h) ((4 + (b) * 2 + (h)) * HTB)
#define PG8_STAGE(bufoff, gbase, voff) do { _Pragma("unroll") for (int _i = 0; _i < 2; ++_i) \
        __builtin_amdgcn_global_load_lds((const unsigned*)((const char*)(gbase) + (voff)[_i]), (PG8_LAS unsigned*)(lds + (bufoff) + ldsw + _i * 8192), 16, 0, 0); } while (0)
#define PG8_LDA(dst, b, h) do { _Pragma("unroll") for (int m = 0; m < 4; ++m) _Pragma("unroll") for (int k = 0; k < 2; ++k) dst[m][k] = *(const PG8_LAS bf16x8*)(lds + PG8_SA(b, h) + aoff + m * 2048 + k * 1024); } while (0)
#define PG8_LDB(dst, b, h) do { _Pragma("unroll") for (int n = 0; n < 2; ++n) _Pragma("unroll") for (int k = 0; k < 2; ++k) dst[n][k] = *(const PG8_LAS bf16x8*)(lds + PG8_SB(b, h) + boff + n * 2048 + k * 1024); } while (0)
#define PG8_MMA(ai, bj, At, Bt) do { __builtin_amdgcn_s_setprio(1); _Pragma("unroll") for (int m = 0; m < 4; ++m) _Pragma("unroll") for (int n = 0; n < 2; ++n) _Pragma("unroll") for (int k = 0; k < 2; ++k) \
        acc[ai][bj][m][n] = __builtin_amdgcn_mfma_f32_16x16x32_bf16(Bt[n][k], At[m][k], acc[ai][bj][m][n], 0, 0, 0); __builtin_amdgcn_s_setprio(0); } while (0)
#define PG8_WAIT_V(n) asm volatile("s_waitcnt vmcnt(" #n ")" ::: "memory")
#define PG8_WAIT_L(n) asm volatile("s_waitcnt lgkmcnt(" #n ")" ::: "memory")
#define PG8_BAR __builtin_amdgcn_s_barrier()
#define PG8_SCHED __builtin_amdgcn_sched_barrier(0)
    Unit cur, nxt; int ui = 0;
    if (!S.next(0, cur)) return;
    f32x4 acc[2][2][4][2];
#pragma unroll
    for (int a = 0; a < 2; ++a)
#pragma unroll
        for (int b = 0; b < 2; ++b)
#pragma unroll
            for (int m = 0; m < 4; ++m)
#pragma unroll
                for (int n = 0; n < 2; ++n) acc[a][b][m][n] = (f32x4){0.f, 0.f, 0.f, 0.f};
    bf16x8 At[4][2], B0[2][2], B1[2][2];
    const char* cA = (const char*)g.A + (size_t)cur.pm * tstep; const char* cB = (const char*)g.Bt + (size_t)cur.pn * tstep;
    S.a_ready(cur);
    if constexpr (SP2) {
        PG8_STAGE(PG8_SB(0, 0), cB, voffB); PG8_STAGE(PG8_SB(0, 1), cB + hstep, voffB); PG8_STAGE(PG8_SA(0, 0), cA, voffA); PG8_STAGE(PG8_SA(0, 1), cA + hstep, voffA);
        if (wr == 1) PG8_BAR;
        PG8_WAIT_V(2); PG8_BAR;
        PG8_STAGE(PG8_SB(1, 0), cB + kstep, voffB); PG8_STAGE(PG8_SA(1, 0), cA + kstep, voffA); PG8_STAGE(PG8_SB(1, 1), cB + hstep + kstep, voffB);
        PG8_WAIT_V(6); PG8_BAR;
    } else {
        PG8_STAGE(PG8_SB(0, 0), cB, voffB); PG8_STAGE(PG8_SA(0, 0), cA, voffA); PG8_STAGE(PG8_SB(0, 1), cB + hstep, voffB); PG8_STAGE(PG8_SA(0, 1), cA + hstep, voffA);
        if (wr == 1) PG8_BAR;
        PG8_WAIT_V(4); PG8_BAR;
        PG8_STAGE(PG8_SB(1, 0), cB + kstep, voffB); PG8_STAGE(PG8_SA(1, 0), cA + kstep, voffA); PG8_STAGE(PG8_SB(1, 1), cB + hstep + kstep, voffB);
        PG8_WAIT_V(6); PG8_BAR;
    }
    for (;;) {
        const bool has_next = S.next(ui + 1, nxt);
        const char* nA = has_next ? (const char*)g.A + (size_t)nxt.pm * tstep : cA; const char* nB = has_next ? (const char*)g.Bt + (size_t)nxt.pn * tstep : cB;
        for (int t = 0; t < nt; t += 2) {
            const bool last = (t == nt - 2);
            const char* a1 = cA + (size_t)(t + 1) * kstep;
            const char* a2 = last ? nA : cA + (size_t)(t + 2) * kstep; const char* b2 = last ? nB : cB + (size_t)(t + 2) * kstep;
            const char* a3 = a2 + kstep; const char* b3 = b2 + kstep;
            if (last && has_next) S.a_ready(nxt);
            if constexpr (SP2) {
            PG8_LDB(B0, 0, 0); PG8_LDB(B1, 0, 1); PG8_SCHED; PG8_LDA(At, 0, 0); PG8_STAGE(PG8_SA(1, 1), a1 + hstep, voffA);
            PG8_WAIT_V(8); PG8_WAIT_L(0); PG8_BAR; PG8_MMA(0, 0, At, B0); PG8_MMA(0, 1, At, B1); PG8_BAR; PG8_SCHED;
            PG8_LDA(At, 0, 1); PG8_STAGE(PG8_SB(0, 0), b2, voffB); PG8_STAGE(PG8_SB(0, 1), b2 + hstep, voffB); PG8_STAGE(PG8_SA(0, 0), a2, voffA);
            PG8_WAIT_V(8); PG8_WAIT_L(0); PG8_BAR; PG8_MMA(1, 0, At, B0); PG8_MMA(1, 1, At, B1); PG8_BAR; PG8_SCHED;
            PG8_LDB(B0, 1, 0); PG8_LDB(B1, 1, 1); PG8_SCHED; PG8_LDA(At, 1, 0); PG8_STAGE(PG8_SA(0, 1), a2 + hstep, voffA);
            PG8_WAIT_V(8); PG8_WAIT_L(0); PG8_BAR; PG8_MMA(0, 0, At, B0); PG8_MMA(0, 1, At, B1); PG8_BAR; PG8_SCHED;
            PG8_LDA(At, 1, 1); PG8_STAGE(PG8_SB(1, 0), b3, voffB); PG8_STAGE(PG8_SB(1, 1), b3 + hstep, voffB); PG8_STAGE(PG8_SA(1, 0), a3, voffA);
            PG8_WAIT_V(8); PG8_WAIT_L(0); PG8_BAR; PG8_MMA(1, 0, At, B0); PG8_MMA(1, 1, At, B1); PG8_BAR; PG8_SCHED;
            } else {
            PG8_LDB(B0, 0, 0); PG8_SCHED; PG8_LDA(At, 0, 0); PG8_STAGE(PG8_SA(1, 1), a1 + hstep, voffA);
            PG8_WAIT_L(8); PG8_BAR; PG8_WAIT_L(0); PG8_MMA(0, 0, At, B0); PG8_BAR; PG8_SCHED;
            PG8_LDB(B1, 0, 1); PG8_STAGE(PG8_SB(0, 0), b2, voffB);
            PG8_BAR; PG8_WAIT_L(0); PG8_MMA(0, 1, At, B1); PG8_BAR;
            PG8_LDA(At, 0, 1); PG8_STAGE(PG8_SA(0, 0), a2, voffA);
            PG8_BAR; PG8_WAIT_L(0); PG8_MMA(1, 0, At, B0); PG8_BAR; PG8_SCHED;
            PG8_STAGE(PG8_SB(0, 1), b2 + hstep, voffB);
            PG8_WAIT_V(6); PG8_BAR; PG8_MMA(1, 1, At, B1); PG8_BAR;
            PG8_LDB(B0, 1, 0); PG8_SCHED; PG8_LDA(At, 1, 0); PG8_STAGE(PG8_SA(0, 1), a2 + hstep, voffA);
            PG8_WAIT_L(8); PG8_BAR; PG8_WAIT_L(0); PG8_MMA(0, 0, At, B0); PG8_BAR; PG8_SCHED;
            PG8_LDB(B1, 1, 1); PG8_STAGE(PG8_SB(1, 0), b3, voffB);
            PG8_BAR; PG8_WAIT_L(0); PG8_MMA(0, 1, At, B1); PG8_BAR;
            PG8_LDA(At, 1, 1); PG8_STAGE(PG8_SA(1, 0), a3, voffA);
            PG8_BAR; PG8_WAIT_L(0); PG8_MMA(1, 0, At, B0); PG8_BAR; PG8_SCHED;
            PG8_STAGE(PG8_SB(1, 1), b3 + hstep, voffB);
            PG8_WAIT_V(6); PG8_BAR; PG8_MMA(1, 1, At, B1); PG8_BAR;
            }
        }
        if constexpr (ALIGN_EPI) { if (wr == 0) PG8_BAR; }
        if constexpr (!Epi::AFTER_DRAIN) { E(acc, cur, wr, wc, fr, fq); S.done(cur); }
        if (!has_next) break;
#pragma unroll
        for (int a = 0; a < 2; ++a)
#pragma unroll
            for (int b = 0; b < 2; ++b)
#pragma unroll
                for (int m = 0; m < 4; ++m)
#pragma unroll
                    for (int n = 0; n < 2; ++n) acc[a][b][m][n] = (f32x4){0.f, 0.f, 0.f, 0.f};
        cur = nxt; cA = nA; cB = nB; ++ui;
        if constexpr (ALIGN_EPI) { if (wr == 1) PG8_BAR; }
    }
    PG8_WAIT_V(0);
    if constexpr (!ALIGN_EPI) { if (wr == 0) PG8_BAR; }
    PG8_BAR;
    if constexpr (Epi::AFTER_DRAIN) { E.fused(acc, cur, wr, wc, fr, fq, lds, wid, lane); S.done(cur); }
#undef PG8_SA
#undef PG8_SB
#undef PG8_STAGE
#undef PG8_LDA
#undef PG8_LDB
#undef PG8_MMA
#undef PG8_WAIT_V
#undef PG8_WAIT_L
#undef PG8_BAR
#undef PG8_SCHED
}
}

#define LAS __attribute__((address_space(3)))
#define XB_TMO      128
#define XB_XCNT(j)  (256  + 64 * (j))
#define XB_XSUB(j)  (1280 + 64 * (j))
#define XB_XGEN(j)  (2304 + 64 * (j))
#define XB_TOP      3328
#define XB_TOPGEN   3392
#define XCD_BAR_WORDS 3456
#define XB_SPIN_CAP (1u << 26)

__device__ __forceinline__ unsigned xb_ld(unsigned* p)              { return __hip_atomic_load(p, __ATOMIC_RELAXED, __HIP_MEMORY_SCOPE_AGENT); }
__device__ __forceinline__ unsigned xb_add(unsigned* p, unsigned v) { return __hip_atomic_fetch_add(p, v, __ATOMIC_RELAXED, __HIP_MEMORY_SCOPE_AGENT); }
__device__ __forceinline__ unsigned xb_xcc_id() { return (unsigned)__builtin_amdgcn_s_getreg((3 << 11) | 20) & 0xFu; }
#define XB_SPIN(cond, bar) do { unsigned _sp = 0; while (cond) { __builtin_amdgcn_s_sleep(1); \
    if ((++_sp & 255u) == 0u) { if (xb_ld(&(bar)[XB_TMO])) break; if (_sp > XB_SPIN_CAP) { atomicAdd(&(bar)[XB_TMO], 1u); break; } } } } while (0)

struct XcdBarrier {
    unsigned* bar; unsigned x;
    volatile LAS unsigned* st;
};

__device__ __forceinline__ XcdBarrier xcd_barrier_post(unsigned* bar, volatile LAS unsigned* st) {
    XcdBarrier b; b.bar = bar; b.x = xb_xcc_id(); b.st = st;
    if (threadIdx.x == 0) (void)xb_add(&bar[XB_XCNT(b.x)], 1u);
    return b;
}
__device__ __forceinline__ void xcd_barrier_complete(unsigned* bar, unsigned x, unsigned& nloc, unsigned& nx) {
    const unsigned G = gridDim.x * gridDim.y * gridDim.z;
    unsigned sum, cnt, mine, sp = 0u;
    for (;;) {
        sum = 0u; cnt = 0u; mine = 0u;
#pragma unroll
        for (unsigned j = 0; j < 16; ++j) { const unsigned c = xb_ld(&bar[XB_XCNT(j)]); sum += c; cnt += (c > 0u) ? 1u : 0u; mine = (j == x) ? c : mine; }
        if (sum == G) break;
        __builtin_amdgcn_s_sleep(1);
        if ((++sp & 255u) == 0u) { if (xb_ld(&bar[XB_TMO])) break; if (sp > XB_SPIN_CAP) { atomicAdd(&bar[XB_TMO], 1u); break; } }
    }
    nloc = mine > 0u ? mine : 1u; nx = cnt > 0u ? cnt : 1u;
}

__device__ __forceinline__ void xcd_barrier(const XcdBarrier& b) {
    asm volatile("s_waitcnt vmcnt(0)" ::: "memory");
    __syncthreads();
    if (threadIdx.x == 0) {
        unsigned* bar = b.bar;
        __builtin_amdgcn_s_waitcnt(0);
        unsigned nloc = b.st[0], nx = b.st[1];
        if (nloc == 0u) { xcd_barrier_complete(bar, b.x, nloc, nx); b.st[0] = nloc; b.st[1] = nx; }
        const unsigned old = xb_add(&bar[XB_XSUB(b.x)], 1u);
        const unsigned gen = old / nloc;
        if (old + 1u == (gen + 1u) * nloc) {
            __builtin_amdgcn_fence(__ATOMIC_RELEASE, "agent");
            asm volatile("s_waitcnt vmcnt(0)" ::: "memory");
            const unsigned og = xb_add(&bar[XB_TOP], 1u);
            const unsigned tg = og / nx;
            if (og + 1u == (tg + 1u) * nx) xb_add(&bar[XB_TOPGEN], 1u);
            else XB_SPIN(xb_ld(&bar[XB_TOPGEN]) == tg, bar);
            __builtin_amdgcn_fence(__ATOMIC_ACQUIRE, "agent");
            xb_add(&bar[XB_XGEN(b.x)], 1u);
            asm volatile("s_waitcnt vmcnt(0)" ::: "memory");
        } else {
            XB_SPIN(xb_ld(&bar[XB_XGEN(b.x)]) == gen, bar);
            __builtin_amdgcn_fence(__ATOMIC_ACQUIRE, "agent");
            asm volatile("s_waitcnt vmcnt(0)" ::: "memory");
        }
    }
    __syncthreads();
}

#ifndef PG8_SP2
#define PG8_SP2 true
#endif
#ifndef PG8_ALIGN
#define PG8_ALIGN true
#endif
#ifndef PROBE_ON
#define PROBE_ON 0
#define PROBE_A 0
#define PROBE_B 1
#endif
#ifndef MK_PER_PHASE
#define MK_PER_PHASE 0
#endif

constexpr int T = 16384, NSMP = 32, TS = T + NSMP, TSP = T + 256, DM = 1024;
constexpr int PA = 3368, PAP = 3584;
constexpr int C_Q = 0, C_KC = 512, C_VC = 640, C_KS = 768, C_VS = 896, C_KW = 1024, C_VW = 1152, C_GATE = 1280,
              C_GQKV = 1304, C_A = 2840, C_BT = 2848, C_Z = 2856;
constexpr int DFF = 2816, DFF2 = 5632;
constexpr float DN_ALPHA = 1.4142135623730951f;
constexpr float LN_EPS = 1e-5f, NORM_EPS = 1e-6f;
constexpr int NPAGES = 128;
constexpr int NWAVES = 8, NTHR = 512;

constexpr size_t O_Y_P = 0;
constexpr size_t O_Y_S = O_Y_P + (size_t)T * DM;
constexpr size_t O_CMP_P = O_Y_S + (size_t)NSMP * DM;
constexpr size_t O_CMP_S = O_CMP_P + (size_t)T * 256;
constexpr size_t O_SLC_P = O_CMP_S + (size_t)NSMP * 256;
constexpr size_t O_SLC_S = O_SLC_P + (size_t)T * 256;
constexpr size_t O_WIN_P = O_SLC_S + (size_t)NSMP * 256;
constexpr size_t O_WIN_S = O_WIN_P + (size_t)512 * 256;
constexpr size_t O_GCONV_P = O_WIN_S + (size_t)NSMP * 512 * 256;
constexpr size_t O_GCONV_S = O_GCONV_P + (size_t)3 * 1536;
constexpr size_t O_GS_P = O_GCONV_S + (size_t)NSMP * 3 * 1536;
constexpr size_t O_GS_S = O_GS_P + (size_t)8 * 64 * 64;
constexpr size_t O_DIL_P = O_GS_S + (size_t)NSMP * 8 * 64 * 64;
constexpr size_t O_DIL_S = O_DIL_P + (size_t)2048 * 2048;
constexpr size_t O_FFN_P = O_DIL_S + (size_t)NSMP * 2048 * 2048;
constexpr size_t O_FFN_S = O_FFN_P + (size_t)2 * 2 * DFF2;
constexpr size_t O_END = O_FFN_S + (size_t)NSMP * 2 * 2 * DFF2;

constexpr int RING_BYTES = 131072;
constexpr int FAST_WL = 17408;
constexpr int MISC_OFF = 8 * FAST_WL + 64;
constexpr int LDS_BYTES = 147456;

typedef unsigned short bf16;
typedef unsigned v4u __attribute__((ext_vector_type(4)));

__device__ __forceinline__ unsigned f2bf(float f) { return (unsigned)__builtin_bit_cast(unsigned short, (__bf16)f); }
__device__ __forceinline__ unsigned pk2(float lo, float hi) { return pg8::cvt_pk_bf16(lo, hi); }
typedef short bf16x8 __attribute__((ext_vector_type(8)));
typedef float f32x4 __attribute__((ext_vector_type(4)));
#define MFMA16(a, b, c) __builtin_amdgcn_mfma_f32_16x16x32_bf16((a), (b), (c), 0, 0, 0)
__device__ __forceinline__ float wave_sum(float v) {
#pragma unroll
    for (int o = 1; o < 64; o <<= 1) v += __shfl_xor(v, o);
    return v;
}
__device__ __forceinline__ float wave_max(float v) {
#pragma unroll
    for (int o = 1; o < 64; o <<= 1) v = fmaxf(v, __shfl_xor(v, o));
    return v;
}
__device__ __forceinline__ void wave_lds_sync() { asm volatile("s_waitcnt lgkmcnt(0)" ::: "memory"); __builtin_amdgcn_wave_barrier(); asm volatile("" ::: "memory"); }
__device__ __forceinline__ float fexp_(float x) { return __builtin_amdgcn_exp2f(x * 1.4426950408889634f); }
__device__ __forceinline__ float fsilu_(float x) { return x * __builtin_amdgcn_rcpf(1.f + fexp_(-x)); }
__device__ __forceinline__ float sigmoidf_(float x) { return 1.f / (1.f + expf(-x)); }
__device__ __forceinline__ float siluf_(float x) { return x / (1.f + expf(-x)); }
__device__ __forceinline__ float gelu_tanh(float x) { const float c = 0.7978845608028654f; return 0.5f * x * (1.f + tanhf(c * (x + 0.044715f * x * x * x))); }
__device__ __forceinline__ float softplusf_(float x) { return x > 20.f ? x : log1pf(expf(x)); }

struct KP {
    const float *x_prompt, *x_sample, *cache_cmp, *cache_slc, *st_win, *st_gconv, *st_gS, *st_dil, *st_ffn;
    const int* page_table;
    const float *w_in_a, *cw1, *cb1, *cw2, *cpe, *gconv_w, *gA, *gdt, *gnw, *w_out_a, *w_in_c, *w_out_c, *ln_mix_g, *ln_mix_b,
                *ffn_w_in, *ffn_cw, *ffn_cb, *ffn_w_out, *ln_ffn_g, *ln_ffn_b;
    float* out;
    unsigned* ctl;
    bf16 *WT_A, *WT_OA, *WT_FI0, *WT_FI1, *WT_FO0, *WT_FO1, *WT_CI, *WT_CO;
    float2* ROPE;
    bf16 *ACTB, *MIXB, *HFFB;
    bf16 *QB, *KSF, *VSF, *KWF, *VWF, *CKF, *CVF;
    unsigned char *KS8, *VS8;
    bf16 *QDB; bf16* DKF[3]; bf16* DVF[3];
    bf16 *AC, *WT_C, *HID, *W2T, *ACP; float* SMIXF; float* NSACC; int* SEL; float* UB;
    bf16 *G_WF, *G_KDF, *G_QGF, *G_QKF, *G_SPF, *G_VNF; float *G_UF, *G_GL;
    float *BIGF, *MO, *X1, *X2, *X3, *QR, *KS, *VS, *KW, *VW, *CK, *CV, *GQ, *GK, *GV, *OG, *Gg, *Gb, *QD, *KD;
    int ph_lo, ph_hi;
};

struct Fr { unsigned char* lds; int tid, lane, wave, gw, NGW, bid, G; };

__device__ __forceinline__ int ffn_row(int u) { const int half = u >= DFF ? 1 : 0, jc = u - half * DFF; return 256 * (jc >> 7) + 128 * half + (jc & 127); }
__device__ __forceinline__ void transpose_item(const float* W, int K, int N, int NT, bf16* WT, float* scr, int item, int lane, int rowmap = 0) {
    const int nblk = NT / 32, kb = item / nblk, nb = item % nblk, k0 = 64 * kb, n0 = 32 * nb;
#pragma unroll 8
    for (int i = 0; i < 32; ++i) { const int kk = 2 * i + (lane >> 5); const int n = n0 + (lane & 31); scr[kk * 33 + (lane & 31)] = (n < N) ? W[(size_t)(k0 + kk) * N + n] : 0.f; }
    wave_lds_sync();
    const int c = lane & 7;
#pragma unroll
    for (int j = 0; j < 4; ++j) { const int n = (lane >> 3) + 8 * j; const float* s = scr + (8 * c) * 33 + n;
        v4u o; o.x = pk2(s[0 * 33], s[1 * 33]); o.y = pk2(s[2 * 33], s[3 * 33]); o.z = pk2(s[4 * 33], s[5 * 33]); o.w = pk2(s[6 * 33], s[7 * 33]);
        const int row = rowmap ? ffn_row(n0 + n) : n0 + n;
        *(v4u*)(WT + (size_t)row * K + k0 + 8 * c) = o; }
    wave_lds_sync();
}
__device__ __forceinline__ void ph_prologue(const KP& p, const Fr& F) {
    float* scr = (float*)(F.lds + F.wave * 16384);
    const int I_A = 16 * (PAP / 32), I_OA = 16 * 32, I_FI = 16 * (DFF2 / 32), I_FO = (DFF / 64) * 32, I_CI = 16 * (3072 / 32), I_CO = 16 * 32;
    const int NITEMS = I_A + I_OA + 2 * I_FI + 2 * I_FO + I_CI + I_CO + 256 + 8;
    for (int it = F.gw; it < NITEMS; it += F.NGW) {
        int r = it;
        if (r < I_A) { transpose_item(p.w_in_a, DM, PA, PAP, p.WT_A, scr, r, F.lane); continue; } r -= I_A;
        if (r < I_OA) { transpose_item(p.w_out_a, DM, DM, DM, p.WT_OA, scr, r, F.lane); continue; } r -= I_OA;
        if (r < I_FI) { transpose_item(p.ffn_w_in, DM, DFF2, DFF2, p.WT_FI0, scr, r, F.lane, 1); continue; } r -= I_FI;
        if (r < I_FI) { transpose_item(p.ffn_w_in + (size_t)DM * DFF2, DM, DFF2, DFF2, p.WT_FI1, scr, r, F.lane, 1); continue; } r -= I_FI;
        if (r < I_FO) { transpose_item(p.ffn_w_out, DFF, DM, DM, p.WT_FO0, scr, r, F.lane); continue; } r -= I_FO;
        if (r < I_FO) { transpose_item(p.ffn_w_out + (size_t)DFF * DM, DFF, DM, DM, p.WT_FO1, scr, r, F.lane); continue; } r -= I_FO;
        if (r < I_CI) { transpose_item(p.w_in_c, DM, 3072, 3072, p.WT_CI, scr, r, F.lane); continue; } r -= I_CI;
        if (r < I_CO) { transpose_item(p.w_out_c, DM, DM, DM, p.WT_CO, scr, r, F.lane); continue; } r -= I_CO;
        if (r < 256) { const int kv = r >> 7; transpose_item(p.cw1 + (size_t)kv * 2048 * 128, 2048, 128, 128, p.WT_C + (size_t)kv * 128 * 2048, scr, r & 127, F.lane); continue; } r -= 256;
        { const int kv = r >> 2; transpose_item(p.cw2 + (size_t)kv * 128 * 64, 128, 64, 64, p.W2T + (size_t)kv * 64 * 128, scr, r & 3, F.lane); }
    }
    const size_t gt = (size_t)F.bid * NTHR + F.tid, GT = (size_t)F.G * NTHR;
    for (size_t i4 = gt; i4 < (size_t)TSP * (DM / 4); i4 += GT) {
        const int r = (int)(i4 / (DM / 4)), c4 = (int)(i4 % (DM / 4));
        float4 v = make_float4(0.f, 0.f, 0.f, 0.f);
        if (r < T) v = ((const float4*)p.x_prompt)[(size_t)r * (DM / 4) + c4]; else if (r < TS) v = ((const float4*)p.x_sample)[(size_t)(r - T) * (DM / 4) + c4];
        uint2 o; o.x = pk2(v.x, v.y); o.y = pk2(v.z, v.w);
        ((uint2*)p.ACTB)[i4] = o;
    }
    for (size_t idx = gt; idx < (size_t)(T + 1) * 32; idx += GT) {
        const int pos = (int)(idx >> 5), i = (int)(idx & 31);
        const float inv = (float)pow(10000.0, -2.0 * (double)i / 64.0);
        const float ang = (float)pos * inv;
        p.ROPE[idx] = make_float2((float)cos((double)ang), (float)sin((double)ang));
    }
}

__device__ __forceinline__ size_t vfrag_elem(int key, int d);
__device__ __forceinline__ size_t kfrag_elem(int key, int d);
__device__ __forceinline__ bf16x8 pack_p(const f32x4& p0, const f32x4& p1);
template <bool FFNMAP = false>
__device__ __forceinline__ void skinny_gemm(const Fr& F, const bf16* A, const bf16* Bt, int K, int ncols, float* C, int ldc) {
    const int lane = F.lane, l15 = lane & 15, grp = lane >> 4;
    const bf16* a0 = A + (size_t)(T + l15) * K + 8 * grp; const bf16* a1 = a0 + (size_t)16 * K;
    for (int nt = F.gw; nt * 16 < ncols; nt += F.NGW) {
        const bf16* bp = Bt + (size_t)(nt * 16 + l15) * K + 8 * grp;
        f32x4 c0 = {0.f, 0.f, 0.f, 0.f}, c1 = {0.f, 0.f, 0.f, 0.f};
#pragma unroll 4
        for (int k = 0; k < K; k += 32) {
            const bf16x8 b = *(const bf16x8*)(bp + k), x0 = *(const bf16x8*)(a0 + k), x1 = *(const bf16x8*)(a1 + k);
            c0 = MFMA16(x0, b, c0); c1 = MFMA16(x1, b, c1);
        }
        int n = nt * 16 + l15;
        if (FFNMAP) n = ((n >> 7) & 1) * DFF + (n >> 8) * 128 + (n & 127);
        if (n < ncols) {
#pragma unroll
            for (int r = 0; r < 4; ++r) { C[(size_t)(T + 4 * grp + r) * ldc + n] = c0[r]; C[(size_t)(T + 16 + 4 * grp + r) * ldc + n] = c1[r]; }
        }
    }
}
__device__ __forceinline__ void ph_gemm_f32(const Fr& F, const bf16* A, const bf16* Bt, int N, int K, float* C, int ldc, int ncols) {
    skinny_gemm(F, A, Bt, K, ncols, C, ldc);
    pg8::Gemm g{A, Bt, T, N, K}; pg8::StaticOrder S; S.init(T, N, F.G, F.bid);
    pg8::EpiF32 E{C, ldc, ncols};
    pg8::gemm_phase<pg8::EpiF32, pg8::StaticOrder, PG8_ALIGN, PG8_SP2>((PG8_LAS unsigned char*)F.lds, g, S, E);
}
__device__ __forceinline__ float dpp_ror1(float x) { return __int_as_float(__builtin_amdgcn_update_dpp(0, __float_as_int(x), 0x121, 0xf, 0xf, false)); }
__device__ __forceinline__ float dpp_ror2(float x) { return __int_as_float(__builtin_amdgcn_update_dpp(0, __float_as_int(x), 0x122, 0xf, 0xf, false)); }
struct EpiFfn {
    static constexpr bool PERM = true, AFTER_DRAIN = false;
    bf16* H; float* UB; const float* cw; const float* cb;
    __device__ __forceinline__ void operator()(const pg8::f32x4 (&acc)[2][2][4][2], const pg8::Unit& u, int wr, int wc, int fr, int fq) const {
#pragma unroll
        for (int n = 0; n < 2; ++n) {
            const int jc = u.pn * 128 + wc * 32 + 8 * fq + 4 * n;
            pg8::f32x4 w0[2], w1[2], w2[2], bb[2];
#pragma unroll
            for (int bj = 0; bj < 2; ++bj) { const int uc = bj * DFF + jc;
                w0[bj] = *(const pg8::f32x4*)(cw + uc); w1[bj] = *(const pg8::f32x4*)(cw + DFF2 + uc); w2[bj] = *(const pg8::f32x4*)(cw + 2 * DFF2 + uc); bb[bj] = *(const pg8::f32x4*)(cb + uc); }
#pragma unroll
            for (int ai = 0; ai < 2; ++ai) {
                const int sl = u.pm * 4 + ai * 2 + wr;
                pg8::f32x4 pr1[2], pr2[2];
#pragma unroll
                for (int m = 0; m < 4; ++m) {
                    pg8::f32x4 c[2];
#pragma unroll
                    for (int bj = 0; bj < 2; ++bj) {
                        const pg8::f32x4 uu = acc[ai][bj][m][n]; pg8::f32x4 r1, r2;
#pragma unroll
                        for (int e = 0; e < 4; ++e) { r1[e] = dpp_ror1(uu[e]); r2[e] = dpp_ror2(uu[e]); }
                        pg8::f32x4 p1 = r1, p2 = r2;
                        if (m > 0) { if (fr == 0) p1 = pr1[bj]; if (fr < 2) p2 = pr2[bj]; }
                        c[bj] = bb[bj] + w0[bj] * p2 + w1[bj] * p1 + w2[bj] * uu;
                        pr1[bj] = r1; pr2[bj] = r2;
                        const int uc = bj * DFF + jc;
                        if (m == 0 && fr < 2) *(pg8::f32x4*)(UB + ((size_t)sl * 4 + fr) * DFF2 + uc) = uu;
                        if (m == 3 && fr >= 14) *(pg8::f32x4*)(UB + ((size_t)sl * 4 + 2 + (fr - 14)) * DFF2 + uc) = uu;
                    }
                    if (!(m == 0 && fr < 2)) {
                        const int t = u.pm * 256 + ai * 128 + wr * 64 + m * 16 + fr;
                        uint2 o; o.x = pk2(fsilu_(c[0][0]) * c[1][0], fsilu_(c[0][1]) * c[1][1]); o.y = pk2(fsilu_(c[0][2]) * c[1][2], fsilu_(c[0][3]) * c[1][3]);
                        *(uint2*)(H + (size_t)t * DFF + jc) = o;
                    }
                }
            }
        }
    }
};
__device__ __forceinline__ void ph_ffn_gemm(const KP& p, const Fr& F, const bf16* Bt, int layer) {
    skinny_gemm<true>(F, p.ACTB, Bt, DM, DFF2, p.BIGF, DFF2);
    pg8::Gemm g{p.ACTB, Bt, T, DFF2, DM}; pg8::StaticOrder S; S.init(T, DFF2, F.G, F.bid);
    EpiFfn E{p.HFFB, p.UB, p.ffn_cw + (size_t)layer * 3 * DFF2, p.ffn_cb + (size_t)layer * DFF2};
    pg8::gemm_phase<EpiFfn, pg8::StaticOrder, PG8_ALIGN, PG8_SP2>((PG8_LAS unsigned char*)F.lds, g, S, E);
}
__device__ __forceinline__ void ph_ffn_fix(const KP& p, const Fr& F, int layer) {
    const float* cw = p.ffn_cw + (size_t)layer * 3 * DFF2; const float* cb = p.ffn_cb + (size_t)layer * DFF2; const float* U = p.BIGF;
    const int gt = F.bid * NTHR + F.tid, GT = F.G * NTHR;
    for (int idx = gt; idx < 512 * DFF; idx += GT) {
        const int rr = idx / DFF, j = idx - rr * DFF; const int sl = rr >> 1, q = rr & 1;
        float c2[2];
#pragma unroll
        for (int half = 0; half < 2; ++half) { const int ch = half * DFF + j;
            const float u0 = p.UB[((size_t)sl * 4 + q) * DFF2 + ch];
            const float um1 = q ? p.UB[((size_t)sl * 4) * DFF2 + ch] : (sl ? p.UB[((size_t)(sl - 1) * 4 + 3) * DFF2 + ch] : 0.f);
            const float um2 = sl ? p.UB[((size_t)(sl - 1) * 4 + 2 + q) * DFF2 + ch] : 0.f;
            c2[half] = cb[ch] + cw[ch] * um2 + cw[DFF2 + ch] * um1 + cw[2 * DFF2 + ch] * u0; }
        p.HFFB[(size_t)(64 * sl + q) * DFF + j] = (bf16)f2bf(siluf_(c2[0]) * c2[1]);
    }
    for (int idx = gt; idx < NSMP * DFF; idx += GT) {
        const int b = idx / DFF, j = idx - b * DFF;
        float c2[2];
#pragma unroll
        for (int half = 0; half < 2; ++half) { const int ch = half * DFF + j;
            const float* hs = p.st_ffn + (((size_t)b * 2 + layer) * 2) * DFF2 + ch;
            c2[half] = cb[ch] + cw[ch] * hs[0] + cw[DFF2 + ch] * hs[DFF2] + cw[2 * DFF2 + ch] * U[(size_t)(T + b) * DFF2 + ch]; }
        p.HFFB[(size_t)(T + b) * DFF + j] = (bf16)f2bf(siluf_(c2[0]) * c2[1]);
    }
    for (int idx = gt; idx < 2 * DFF2; idx += GT) { const int k = idx / DFF2, ch = idx - k * DFF2;
        p.out[O_FFN_P + ((size_t)layer * 2 + k) * DFF2 + ch] = p.UB[((size_t)255 * 4 + 2 + k) * DFF2 + ch]; }
    for (int idx = gt; idx < NSMP * 2 * DFF2; idx += GT) { const int b = idx / (2 * DFF2), k = (idx / DFF2) & 1, ch = idx % DFF2;
        p.out[O_FFN_S + (((size_t)b * 2 + layer) * 2 + k) * DFF2 + ch] = (k == 0) ? p.st_ffn[(((size_t)b * 2 + layer) * 2 + 1) * DFF2 + ch] : U[(size_t)(T + b) * DFF2 + ch]; }
}
struct EpiCmp {
    static constexpr bool PERM = false, AFTER_DRAIN = false;
    bf16* HID; const float* b1;
    __device__ __forceinline__ void operator()(const pg8::f32x4 (&acc)[2][2][4][2], const pg8::Unit& u, int wr, int wc, int fr, int fq) const {
#pragma unroll
        for (int ai = 0; ai < 2; ++ai)
#pragma unroll
            for (int m = 0; m < 4; ++m) { const int combo = u.pm * 128 + wr * 64 + m * 16 + fr;
#pragma unroll
                for (int n = 0; n < 2; ++n) { const int j0 = wc * 32 + n * 16 + 4 * fq; const pg8::f32x4 v = acc[ai][ai][m][n]; const float* bb = b1 + ai * 128 + j0;
                    uint2 o; o.x = pk2(gelu_tanh(v[0] + bb[0]), gelu_tanh(v[1] + bb[1])); o.y = pk2(gelu_tanh(v[2] + bb[2]), gelu_tanh(v[3] + bb[3]));
                    *(uint2*)(HID + ((size_t)combo * 2 + ai) * 128 + j0) = o; } }
    }
};
__device__ __forceinline__ void ph_cmp_gemm(const KP& p, const Fr& F) {
    pg8::Gemm g{p.AC, p.WT_C, 65536, 256, 2048}; pg8::StaticOrder S; S.init(65536, 256, F.G, F.bid);
    EpiCmp E{p.HID, p.cb1};
    pg8::gemm_phase<EpiCmp, pg8::StaticOrder, PG8_ALIGN, PG8_SP2>((PG8_LAS unsigned char*)F.lds, g, S, E);
}
__device__ __forceinline__ void ph_cmp_stage2(const KP& p, const Fr& F) {
    const int lane = F.lane, l15 = lane & 15, grp = lane >> 4;
    for (int tile = F.gw; tile < 4096; tile += F.NGW) {
        const int kv = tile & 1, combo0 = (tile >> 1) * 16;
        const bf16* hid = p.HID + ((size_t)(combo0 + l15) * 2 + kv) * 128 + 8 * grp; const bf16* w2 = p.W2T + (size_t)kv * 64 * 128 + (size_t)l15 * 128 + 8 * grp;
        f32x4 acc[4];
#pragma unroll
        for (int nt = 0; nt < 4; ++nt) acc[nt] = (f32x4){0.f, 0.f, 0.f, 0.f};
#pragma unroll
        for (int ks = 0; ks < 4; ++ks) { const bf16x8 a = *(const bf16x8*)(hid + 32 * ks);
#pragma unroll
            for (int nt = 0; nt < 4; ++nt) acc[nt] = MFMA16(a, *(const bf16x8*)(w2 + (size_t)nt * 16 * 128 + 32 * ks), acc[nt]); }
#pragma unroll
        for (int r = 0; r < 4; ++r) {
            const int combo = combo0 + 4 * grp + r; const int g = combo & 1, c = (combo >> 1) & 511, b = combo >> 10;
            float* dst = ((kv == 0) ? p.CK : p.CV) + (((size_t)(1 + b) * 512 + c) * 2 + g) * 64;
            if (kv == 0) {
                const int pos = (c + 1) * 32 - 1;
#pragma unroll
                for (int nt = 0; nt < 2; ++nt) { const float2 cs = p.ROPE[pos * 32 + 16 * nt + l15]; const float x1 = acc[nt][r], x2 = acc[nt + 2][r];
                    dst[16 * nt + l15] = x1 * cs.x - x2 * cs.y; dst[16 * (nt + 2) + l15] = x2 * cs.x + x1 * cs.y; }
            } else {
#pragma unroll
                for (int nt = 0; nt < 4; ++nt) dst[16 * nt + l15] = acc[nt][r];
            }
        }
    }
}
__device__ __forceinline__ void cmp_prompt_unit(const KP& p, int unit, int lane) {
    asm volatile("" : "+v"(lane));
    const int l15 = lane & 15, grp = lane >> 4;
    const int kv = unit & 1, combo = (unit >> 1) * 16 + l15; const int g = combo & 1, c = combo >> 1;
    const bf16* w1 = p.WT_C + ((size_t)kv * 128 + l15) * 2048 + 8 * grp;
    f32x4 acc[8];
#pragma unroll
    for (int jt = 0; jt < 8; ++jt) acc[jt] = (f32x4){0.f, 0.f, 0.f, 0.f};
    const bf16* fl = p.ACP + ((size_t)kv * 1024 + combo) * 2048 + 8 * grp;
#pragma unroll 4
    for (int ks = 0; ks < 64; ++ks) {
        const bf16x8 fb = *(const bf16x8*)(fl + 32 * ks);
#pragma unroll
        for (int jt = 0; jt < 8; ++jt) acc[jt] = MFMA16(*(const bf16x8*)(w1 + (size_t)jt * 16 * 2048 + 32 * ks), fb, acc[jt]);
    }
    bf16x8 hb[4];
#pragma unroll
    for (int s2 = 0; s2 < 4; ++s2) {
        f32x4 h0, h1;
#pragma unroll
        for (int r = 0; r < 4; ++r) { h0[r] = gelu_tanh(acc[2 * s2][r] + p.cb1[kv * 128 + 32 * s2 + 4 * grp + r]); h1[r] = gelu_tanh(acc[2 * s2 + 1][r] + p.cb1[kv * 128 + 32 * s2 + 16 + 4 * grp + r]); }
        hb[s2] = pack_p(h0, h1);
    }
    f32x4 o[4];
#pragma unroll
    for (int dt = 0; dt < 4; ++dt) {
        o[dt] = (f32x4){0.f, 0.f, 0.f, 0.f};
        const bf16* w2 = p.W2T + (size_t)kv * 64 * 128 + (size_t)(16 * dt + l15) * 128 + 4 * grp;
#pragma unroll
        for (int s2 = 0; s2 < 4; ++s2) { const uint2 x0 = *(const uint2*)(w2 + 32 * s2), x1 = *(const uint2*)(w2 + 32 * s2 + 16);
            union { v4u u; bf16x8 b; } wa; wa.u.x = x0.x; wa.u.y = x0.y; wa.u.z = x1.x; wa.u.w = x1.y;
            o[dt] = MFMA16(wa.b, hb[s2], o[dt]); }
    }
    if (kv == 0) {
        const int pos = (c + 1) * 32 - 1;
#pragma unroll
        for (int dt = 0; dt < 2; ++dt)
#pragma unroll
            for (int r = 0; r < 4; ++r) { const float2 cs = p.ROPE[pos * 32 + 16 * dt + 4 * grp + r]; const float x1 = o[dt][r], x2 = o[dt + 2][r];
                o[dt][r] = x1 * cs.x - x2 * cs.y; o[dt + 2][r] = x2 * cs.x + x1 * cs.y; }
    }
#pragma unroll
    for (int dt = 0; dt < 4; ++dt)
#pragma unroll
        for (int r = 0; r < 4; ++r) { const int d = 16 * dt + 4 * grp + r;
            if (kv == 0) p.CKF[(size_t)g * 512 * 64 + kfrag_elem(c, d)] = (bf16)f2bf(o[dt][r]); else p.CVF[(size_t)g * 512 * 64 + vfrag_elem(c, d)] = (bf16)f2bf(o[dt][r]); }
}
__device__ __forceinline__ void cmp_sample_unit(const KP& p, int unit, int lane) {
    asm volatile("" : "+v"(lane));
    const int l15 = lane & 15, grp = lane >> 4;
    const int b = unit >> 6, kv = (unit >> 5) & 1, cb = unit & 31;
    const bf16* w1 = p.WT_C + ((size_t)kv * 128 + l15) * 2048 + 8 * grp;
    const float* src[2];
#pragma unroll
    for (int cg = 0; cg < 2; ++cg) { const int combo = cb * 32 + 16 * cg + l15; const int g = combo & 1, c = combo >> 1;
        const int page = p.page_table[b * NPAGES + (c >> 2)];
        src[cg] = p.cache_cmp + (((size_t)page * 128 + (c & 3) * 32) * 4 + kv * 2 + g) * 64 + 8 * grp; }
    const float* pe = p.cpe + (size_t)kv * 32 * 64 + 8 * grp;
    f32x4 acc[2][8];
#pragma unroll
    for (int cg = 0; cg < 2; ++cg)
#pragma unroll
        for (int jt = 0; jt < 8; ++jt) acc[cg][jt] = (f32x4){0.f, 0.f, 0.f, 0.f};
#pragma unroll 2
    for (int ks = 0; ks < 64; ++ks) {
        const int i = ks >> 1, dd = 32 * (ks & 1);
        const float4 e0 = *(const float4*)(pe + i * 64 + dd), e1 = *(const float4*)(pe + i * 64 + dd + 4);
        bf16x8 fb[2];
#pragma unroll
        for (int cg = 0; cg < 2; ++cg) { const float4 a0 = *(const float4*)(src[cg] + i * 256 + dd), a1 = *(const float4*)(src[cg] + i * 256 + dd + 4);
            union { v4u u; bf16x8 b; } t; t.u.x = pk2(a0.x + e0.x, a0.y + e0.y); t.u.y = pk2(a0.z + e0.z, a0.w + e0.w); t.u.z = pk2(a1.x + e1.x, a1.y + e1.y); t.u.w = pk2(a1.z + e1.z, a1.w + e1.w); fb[cg] = t.b; }
#pragma unroll
        for (int jt = 0; jt < 8; ++jt) { const bf16x8 wa = *(const bf16x8*)(w1 + (size_t)jt * 16 * 2048 + 32 * ks);
            acc[0][jt] = MFMA16(wa, fb[0], acc[0][jt]); acc[1][jt] = MFMA16(wa, fb[1], acc[1][jt]); }
    }
#pragma unroll
    for (int cg = 0; cg < 2; ++cg) {
        const int combo = cb * 32 + 16 * cg + l15; const int g = combo & 1, c = combo >> 1;
        bf16x8 hb[4];
#pragma unroll
        for (int s2 = 0; s2 < 4; ++s2) { f32x4 h0, h1;
#pragma unroll
            for (int r = 0; r < 4; ++r) { h0[r] = gelu_tanh(acc[cg][2 * s2][r] + p.cb1[kv * 128 + 32 * s2 + 4 * grp + r]); h1[r] = gelu_tanh(acc[cg][2 * s2 + 1][r] + p.cb1[kv * 128 + 32 * s2 + 16 + 4 * grp + r]); }
            hb[s2] = pack_p(h0, h1); }
        f32x4 o[4];
#pragma unroll
        for (int dt = 0; dt < 4; ++dt) {
            o[dt] = (f32x4){0.f, 0.f, 0.f, 0.f};
            const bf16* w2 = p.W2T + (size_t)kv * 64 * 128 + (size_t)(16 * dt + l15) * 128 + 4 * grp;
#pragma unroll
            for (int s2 = 0; s2 < 4; ++s2) { const uint2 x0 = *(const uint2*)(w2 + 32 * s2), x1 = *(const uint2*)(w2 + 32 * s2 + 16);
                union { v4u u; bf16x8 b; } wa; wa.u.x = x0.x; wa.u.y = x0.y; wa.u.z = x1.x; wa.u.w = x1.y;
                o[dt] = MFMA16(wa.b, hb[s2], o[dt]); }
        }
        if (kv == 0) {
            const int pos = (c + 1) * 32 - 1;
#pragma unroll
            for (int dt = 0; dt < 2; ++dt)
#pragma unroll
                for (int r = 0; r < 4; ++r) { const float2 cs = p.ROPE[pos * 32 + 16 * dt + 4 * grp + r]; const float x1 = o[dt][r], x2 = o[dt + 2][r];
                    o[dt][r] = x1 * cs.x - x2 * cs.y; o[dt + 2][r] = x2 * cs.x + x1 * cs.y; }
        }
        float* dst = ((kv == 0) ? p.CK : p.CV) + (((size_t)(1 + b) * 512 + c) * 2 + g) * 64 + 4 * grp;
#pragma unroll
        for (int dt = 0; dt < 4; ++dt) *(f32x4*)(dst + 16 * dt) = o[dt];
    }
}
constexpr int W1S_PITCH = 528;
constexpr int W1S_BYTES = 128 * W1S_PITCH;
__device__ __forceinline__ void cmp_sample_wg(const KP& p, int wu, const Fr& F) {
    int lane = F.lane; asm volatile("" : "+v"(lane));
    const int l15 = lane & 15, grp = lane >> 4, tid = F.tid;
    const int b = wu >> 3, kv = (wu >> 2) & 1, q4 = wu & 3;
    const float* src[2];
#pragma unroll
    for (int cg = 0; cg < 2; ++cg) { const int combo = q4 * 256 + F.wave * 32 + 16 * cg + l15; const int g = combo & 1, c = combo >> 1;
        const int page = p.page_table[b * NPAGES + (c >> 2)];
        src[cg] = p.cache_cmp + (((size_t)page * 128 + (c & 3) * 32) * 4 + kv * 2 + g) * 64 + 8 * grp; }
    const float* pe = p.cpe + (size_t)kv * 32 * 64 + 8 * grp;
    const bf16* wg = p.WT_C + (size_t)kv * 128 * 2048;
    f32x4 acc[2][8];
#pragma unroll
    for (int cg = 0; cg < 2; ++cg)
#pragma unroll
        for (int jt = 0; jt < 8; ++jt) acc[cg][jt] = (f32x4){0.f, 0.f, 0.f, 0.f};
    v4u wreg[8];
#pragma unroll
    for (int k = 0; k < 8; ++k) { const int c = tid + 512 * k; wreg[k] = *(const v4u*)(wg + (size_t)(c >> 5) * 2048 + (c & 31) * 8); }
#pragma unroll
    for (int k = 0; k < 8; ++k) { const int c = tid + 512 * k; *(v4u*)(F.lds + (c >> 5) * W1S_PITCH + (c & 31) * 16) = wreg[k]; }
    __syncthreads();
#pragma unroll 1
    for (int sl = 0; sl < 8; ++sl) {
        if (sl + 1 < 8) {
#pragma unroll
            for (int k = 0; k < 8; ++k) { const int c = tid + 512 * k; wreg[k] = *(const v4u*)(wg + (size_t)(c >> 5) * 2048 + (sl + 1) * 256 + (c & 31) * 8); }
        }
        const unsigned char* wl = F.lds + (sl & 1) * W1S_BYTES + l15 * W1S_PITCH + grp * 16;
#pragma unroll 2
        for (int kk = 0; kk < 8; ++kk) {
            const int ks = sl * 8 + kk, i = ks >> 1, dd = 32 * (ks & 1);
            const float4 e0 = *(const float4*)(pe + i * 64 + dd), e1 = *(const float4*)(pe + i * 64 + dd + 4);
            bf16x8 fb[2];
#pragma unroll
            for (int cg = 0; cg < 2; ++cg) { const float4 a0 = *(const float4*)(src[cg] + i * 256 + dd), a1 = *(const float4*)(src[cg] + i * 256 + dd + 4);
                union { v4u u; bf16x8 b; } t; t.u.x = pk2(a0.x + e0.x, a0.y + e0.y); t.u.y = pk2(a0.z + e0.z, a0.w + e0.w); t.u.z = pk2(a1.x + e1.x, a1.y + e1.y); t.u.w = pk2(a1.z + e1.z, a1.w + e1.w); fb[cg] = t.b; }
#pragma unroll
            for (int jt = 0; jt < 8; ++jt) { const bf16x8 wa = *(const bf16x8*)(wl + jt * 16 * W1S_PITCH + kk * 64);
                acc[0][jt] = MFMA16(wa, fb[0], acc[0][jt]); acc[1][jt] = MFMA16(wa, fb[1], acc[1][jt]); }
        }
        if (sl + 1 < 8) {
#pragma unroll
            for (int k = 0; k < 8; ++k) { const int c = tid + 512 * k; *(v4u*)(F.lds + ((sl + 1) & 1) * W1S_BYTES + (c >> 5) * W1S_PITCH + (c & 31) * 16) = wreg[k]; }
        }
        __syncthreads();
    }
#pragma unroll
    for (int cg = 0; cg < 2; ++cg) {
        const int combo = q4 * 256 + F.wave * 32 + 16 * cg + l15; const int g = combo & 1, c = combo >> 1;
        bf16x8 hb[4];
#pragma unroll
        for (int s2 = 0; s2 < 4; ++s2) { f32x4 h0, h1;
#pragma unroll
            for (int r = 0; r < 4; ++r) { h0[r] = gelu_tanh(acc[cg][2 * s2][r] + p.cb1[kv * 128 + 32 * s2 + 4 * grp + r]); h1[r] = gelu_tanh(acc[cg][2 * s2 + 1][r] + p.cb1[kv * 128 + 32 * s2 + 16 + 4 * grp + r]); }
            hb[s2] = pack_p(h0, h1); }
        f32x4 o[4];
#pragma unroll
        for (int dt = 0; dt < 4; ++dt) {
            o[dt] = (f32x4){0.f, 0.f, 0.f, 0.f};
            const bf16* w2 = p.W2T + (size_t)kv * 64 * 128 + (size_t)(16 * dt + l15) * 128 + 4 * grp;
#pragma unroll
            for (int s2 = 0; s2 < 4; ++s2) { const uint2 x0 = *(const uint2*)(w2 + 32 * s2), x1 = *(const uint2*)(w2 + 32 * s2 + 16);
                union { v4u u; bf16x8 b; } wa; wa.u.x = x0.x; wa.u.y = x0.y; wa.u.z = x1.x; wa.u.w = x1.y;
                o[dt] = MFMA16(wa.b, hb[s2], o[dt]); }
        }
        if (kv == 0) {
            const int pos = (c + 1) * 32 - 1;
#pragma unroll
            for (int dt = 0; dt < 2; ++dt)
#pragma unroll
                for (int r = 0; r < 4; ++r) { const float2 cs = p.ROPE[pos * 32 + 16 * dt + 4 * grp + r]; const float x1 = o[dt][r], x2 = o[dt + 2][r];
                    o[dt][r] = x1 * cs.x - x2 * cs.y; o[dt + 2][r] = x2 * cs.x + x1 * cs.y; }
        }
        float* dst = ((kv == 0) ? p.CK : p.CV) + (((size_t)(1 + b) * 512 + c) * 2 + g) * 64 + 4 * grp;
#pragma unroll
        for (int dt = 0; dt < 4; ++dt) *(f32x4*)(dst + 16 * dt) = o[dt];
    }
}
__device__ __forceinline__ void ph_cmp_samples(const KP& p, const Fr& F) {
    for (int wu = F.bid; wu < 256; wu += F.G) cmp_sample_wg(p, wu, F);
}
__device__ __forceinline__ void ph_cmp_prompt(const KP& p, const Fr& F) {
    for (int unit = F.gw; unit < 128; unit += F.NGW) cmp_prompt_unit(p, unit, F.lane);
}

__device__ __forceinline__ float rope_val(const float* row, int base, int i, float2 cs) {
    const int ii = i & 31;
    const float x1 = row[base + ii], x2 = row[base + ii + 32];
    return (i < 32) ? (x1 * cs.x - x2 * cs.y) : (x2 * cs.x + x1 * cs.y);
}
__device__ __forceinline__ void ph_nsa_prep(const KP& p, const Fr& F) {
    const float* H0 = p.BIGF; float* out = p.out;
    const size_t gt = (size_t)F.bid * NTHR + F.tid, GT = (size_t)F.G * NTHR;
    const size_t total = (size_t)TS * 1280;
    for (size_t idx = gt + (size_t)T * 1280; idx < total; idx += GT) {
        const int r = (int)(idx / 1280), c = (int)(idx % 1280);
        const bool smp = r >= T; const int b = r - T; const int pos = smp ? T : r;
        const float* row = H0 + (size_t)r * PA;
        const int i = c & 63;
        const float2 cs = p.ROPE[pos * 32 + (i & 31)];
        if (c < 512) { p.QR[(size_t)r * 512 + c] = rope_val(row, c & ~63, i, cs); continue; }
        const int sec = (c - 512) >> 7; const int gd = (c - 512) & 127; const int base = c & ~63;
        float v;
        if (sec == 2 || sec == 4) v = rope_val(row, base, i, cs); else v = row[c];
        const int kv = sec & 1;
        if (sec < 2) {
            if (!smp) out[O_CMP_P + (size_t)r * 256 + kv * 128 + gd] = v; else out[O_CMP_S + (size_t)b * 256 + kv * 128 + gd] = v;
        } else if (sec < 4) {
            if (!smp) out[O_SLC_P + (size_t)r * 256 + kv * 128 + gd] = v; else out[O_SLC_S + (size_t)b * 256 + kv * 128 + gd] = v;
            if (kv == 0) p.KS[(size_t)r * 128 + gd] = v; else p.VS[(size_t)r * 128 + gd] = v;
        } else {
            if (kv == 0) p.KW[(size_t)r * 128 + gd] = v; else p.VW[(size_t)r * 128 + gd] = v;
            if (!smp) { if (r >= T - 512) out[O_WIN_P + (size_t)(r - (T - 512)) * 256 + kv * 128 + gd] = v; }
            else out[O_WIN_S + ((size_t)b * 512 + 511) * 256 + kv * 128 + gd] = v;
        }
    }
    const size_t tot2 = (size_t)NSMP * 511 * 256;
    for (size_t idx = gt; idx < tot2; idx += GT) {
        const int b = (int)(idx / (511 * 256)); const int rem = (int)(idx % (511 * 256));
        out[O_WIN_S + (size_t)b * 512 * 256 + rem] = p.st_win[(size_t)b * 512 * 256 + 256 + rem];
    }
}

constexpr float QSCALE = 0.18033688011112042f;

__device__ __forceinline__ size_t kfrag_off(int kt, int ks, int lane) { return ((size_t)(kt * 2 + ks) * 64 + lane) * 8; }
__device__ __forceinline__ size_t vfrag_off(int st, int dt, int lane) { return ((size_t)(st * 4 + dt) * 64 + lane) * 8; }
__device__ __forceinline__ size_t vfrag_elem(int key, int d) {
    const int st = key >> 5, kk = key & 31, tile = kk >> 4, r16 = kk & 15, grp = r16 >> 2, reg = r16 & 3;
    return ((size_t)(st * 4 + (d >> 4)) * 64 + (d & 15) + 16 * grp) * 8 + tile * 4 + reg;
}
__device__ __forceinline__ size_t k8_off(int key, int d) { return ((size_t)(key >> 4) * 64 + (key & 15) + 16 * ((d & 31) >> 3)) * 16 + (d >> 5) * 8 + (d & 7); }
__device__ __forceinline__ size_t v8_off(int key, int d) {
    const int blk = key >> 6, st = (key >> 5) & 1, kk = key & 31, tile = kk >> 4, r16 = kk & 15, grp = r16 >> 2, reg = r16 & 3;
    return ((size_t)(blk * 4 + (d >> 4)) * 64 + (d & 15) + 16 * grp) * 16 + st * 8 + tile * 4 + reg;
}
__device__ __forceinline__ size_t kfrag_elem(int key, int d) {
    return ((size_t)((key >> 4) * 2 + (d >> 5)) * 64 + (key & 15) + 16 * ((d & 31) >> 3)) * 8 + (d & 7);
}

__device__ __forceinline__ void ph_nsa_prep_fast(const KP& p, const Fr& F) {
    const float* H0 = p.BIGF; float* out = p.out;
    const size_t gt = (size_t)F.bid * NTHR + F.tid, GT = (size_t)F.G * NTHR;
    for (size_t idx = gt; idx < (size_t)T * 160; idx += GT) {
        const int t = (int)(idx / 160), u = (int)(idx % 160);
        const int c0 = u * 8; const float* row = H0 + (size_t)t * PA;
        const float4 a0 = *(const float4*)(row + c0), a1 = *(const float4*)(row + c0 + 4);
        float v[8] = {a0.x, a0.y, a0.z, a0.w, a1.x, a1.y, a1.z, a1.w};
        const int sec = (u < 64) ? -1 : ((u - 64) >> 4);
        const bool roped = (sec == -1 || sec == 2 || sec == 4);
        if (roped) {
            const int d0 = c0 & 63; const int pc = (d0 < 32) ? c0 + 32 : c0 - 32;
            const float4 b0 = *(const float4*)(row + pc), b1 = *(const float4*)(row + pc + 4);
            const float w[8] = {b0.x, b0.y, b0.z, b0.w, b1.x, b1.y, b1.z, b1.w};
            const float4* rp = (const float4*)(p.ROPE + t * 32 + (d0 & 31)); const float4 r0 = rp[0], r1 = rp[1], r2 = rp[2], r3 = rp[3];
            const float cs[8] = {r0.x, r0.z, r1.x, r1.z, r2.x, r2.z, r3.x, r3.z}, sn[8] = {r0.y, r0.w, r1.y, r1.w, r2.y, r2.w, r3.y, r3.w};
#pragma unroll
            for (int j = 0; j < 8; ++j) v[j] = (d0 < 32) ? (v[j] * cs[j] - w[j] * sn[j]) : (v[j] * cs[j] + w[j] * sn[j]);
        }
        if (sec == -1) {
            v4u o; o.x = pk2(v[0] * QSCALE, v[1] * QSCALE); o.y = pk2(v[2] * QSCALE, v[3] * QSCALE); o.z = pk2(v[4] * QSCALE, v[5] * QSCALE); o.w = pk2(v[6] * QSCALE, v[7] * QSCALE);
            *(v4u*)(p.QB + (size_t)t * 512 + c0) = o; continue;
        }
        const int gd = (c0 - 512) & 127, g = gd >> 6, d0 = gd & 63, kv = sec & 1;
        const float4 o0 = make_float4(v[0], v[1], v[2], v[3]), o1 = make_float4(v[4], v[5], v[6], v[7]);
        if (sec < 2) { float* o = out + O_CMP_P + (size_t)t * 256 + kv * 128 + gd; *(float4*)o = o0; *(float4*)(o + 4) = o1;
            const int i = t & 31; const float* pe = p.cpe + (kv * 32 + i) * 64 + d0; const float4 e0 = *(const float4*)pe, e1 = *(const float4*)(pe + 4);
            v4u w; w.x = pk2(v[0] + e0.x, v[1] + e0.y); w.y = pk2(v[2] + e0.z, v[3] + e0.w); w.z = pk2(v[4] + e1.x, v[5] + e1.y); w.w = pk2(v[6] + e1.z, v[7] + e1.w);
            *(v4u*)(p.ACP + ((size_t)kv * 1024 + (t >> 5) * 2 + g) * 2048 + i * 64 + d0) = w; continue; }
        if (sec < 4) { float* o = out + O_SLC_P + (size_t)t * 256 + kv * 128 + gd; *(float4*)o = o0; *(float4*)(o + 4) = o1; }
        else if (t >= T - 512) { float* o = out + O_WIN_P + (size_t)(t - (T - 512)) * 256 + kv * 128 + gd; *(float4*)o = o0; *(float4*)(o + 4) = o1; }
        if (sec < 4) {
            if (kv == 0) {
                int w0 = 0, w1 = 0;
                w0 = __builtin_amdgcn_cvt_pk_fp8_f32(v[0], v[1], w0, false); w0 = __builtin_amdgcn_cvt_pk_fp8_f32(v[2], v[3], w0, true);
                w1 = __builtin_amdgcn_cvt_pk_fp8_f32(v[4], v[5], w1, false); w1 = __builtin_amdgcn_cvt_pk_fp8_f32(v[6], v[7], w1, true);
                *(uint2*)(p.KS8 + (size_t)g * T * 64 + k8_off(t, d0)) = make_uint2((unsigned)w0, (unsigned)w1);
            } else {
#pragma unroll
                for (int j = 0; j < 8; ++j) p.VS8[(size_t)g * T * 64 + v8_off(t, d0 + j)] = (unsigned char)(__builtin_amdgcn_cvt_pk_fp8_f32(v[j], 0.f, 0, false) & 0xff);
            }
            continue;
        }
        bf16* KF = p.KWF; bf16* VF = p.VWF;
        if (kv == 0) {
            v4u o; o.x = pk2(v[0], v[1]); o.y = pk2(v[2], v[3]); o.z = pk2(v[4], v[5]); o.w = pk2(v[6], v[7]);
            *(v4u*)(KF + (size_t)g * T * 64 + kfrag_elem(t, d0)) = o;
        } else {
#pragma unroll
            for (int j = 0; j < 8; ++j) VF[(size_t)g * T * 64 + vfrag_elem(t, d0 + j)] = (bf16)f2bf(v[j]);
        }
    }
}

struct AttW { f32x4 o[4]; float m, l; };
__device__ __forceinline__ void attw_init(AttW& a) {
#pragma unroll
    for (int i = 0; i < 4; ++i) a.o[i] = (f32x4){0.f, 0.f, 0.f, 0.f};
    a.m = -INFINITY; a.l = 0.f;
}
__device__ __forceinline__ void qk_step(const bf16x8 (&kf)[2][2], const bf16x8 (&qf)[2], f32x4& s0, f32x4& s1) {
    const f32x4 z = {0.f, 0.f, 0.f, 0.f};
    s0 = MFMA16(kf[0][0], qf[0], z); s0 = MFMA16(kf[0][1], qf[1], s0);
    s1 = MFMA16(kf[1][0], qf[0], z); s1 = MFMA16(kf[1][1], qf[1], s1);
}
__device__ __forceinline__ bf16x8 pack_p(const f32x4& p0, const f32x4& p1) {
    union { v4u u; bf16x8 b; } c;
    c.u.x = pg8::cvt_pk_bf16(p0[0], p0[1]); c.u.y = pg8::cvt_pk_bf16(p0[2], p0[3]); c.u.z = pg8::cvt_pk_bf16(p1[0], p1[1]); c.u.w = pg8::cvt_pk_bf16(p1[2], p1[3]);
    return c.b;
}
__device__ __forceinline__ void att_update(AttW& a, const f32x4& s0, const f32x4& s1, const bf16x8 (&vf)[4]) {
    float mx = fmaxf(fmaxf(fmaxf(s0[0], s0[1]), fmaxf(s0[2], s0[3])), fmaxf(fmaxf(s1[0], s1[1]), fmaxf(s1[2], s1[3])));
    mx = fmaxf(mx, __shfl_xor(mx, 16)); mx = fmaxf(mx, __shfl_xor(mx, 32));
    const float mn = fmaxf(a.m, mx);
    const float ms = (mn == -INFINITY) ? 0.f : mn;
    const float alpha = __builtin_amdgcn_exp2f(a.m - ms);
    f32x4 p0, p1;
#pragma unroll
    for (int i = 0; i < 4; ++i) { p0[i] = __builtin_amdgcn_exp2f(s0[i] - ms); p1[i] = __builtin_amdgcn_exp2f(s1[i] - ms); }
    a.l = a.l * alpha + ((p0[0] + p0[1]) + (p0[2] + p0[3])) + ((p1[0] + p1[1]) + (p1[2] + p1[3]));
    a.m = mn;
    const bf16x8 pf = pack_p(p0, p1);
#pragma unroll
    for (int dt = 0; dt < 4; ++dt) { a.o[dt] = a.o[dt] * alpha; a.o[dt] = MFMA16(vf[dt], pf, a.o[dt]); }
}
__device__ __forceinline__ float grp_sum(float v) { v += __shfl_xor(v, 16); v += __shfl_xor(v, 32); return v; }

__device__ __forceinline__ void nsa_fast_unit(const KP& p, int unit, float* wl, int lane) {
    asm volatile("" : "+v"(lane));
    const int g = unit & 1, t0 = (unit >> 1) * 16;
    const int qi = lane & 15, grp = lane >> 4, t = t0 + qi;
    float* imp = wl; int* sel = (int*)(wl + 4096);
    const float* grow = p.BIGF + (size_t)t * PA + C_GATE + g * 4;
    bf16x8 qf[4][2];
#pragma unroll
    for (int h = 0; h < 4; ++h)
#pragma unroll
        for (int ks = 0; ks < 2; ++ks) qf[h][ks] = *(const bf16x8*)(p.QB + (size_t)t * 512 + (g * 4 + h) * 64 + 32 * ks + 8 * grp);
    AttW st[4];
    {
        const bf16* CKF = p.CKF + (size_t)g * 512 * 64; const bf16* CVF = p.CVF + (size_t)g * 512 * 64;
        const int nmax = (t0 + 16) >> 5; const int nsteps = (nmax + 31) >> 5;
        const int nval = (t + 1) >> 5;
        float m[4], l[4];
#pragma unroll
        for (int h = 0; h < 4; ++h) { m[h] = -INFINITY; l[h] = 0.f; }
        for (int s = 0; s < nsteps; ++s) {
            bf16x8 kf[2][2];
#pragma unroll
            for (int tl = 0; tl < 2; ++tl)
#pragma unroll
                for (int ks = 0; ks < 2; ++ks) kf[tl][ks] = *(const bf16x8*)(CKF + kfrag_off(2 * s + tl, ks, lane));
            const int cb = 32 * s + 4 * grp;
#pragma unroll
            for (int h = 0; h < 4; ++h) {
                f32x4 s0, s1; qk_step(kf, qf[h], s0, s1);
#pragma unroll
                for (int i = 0; i < 4; ++i) { if (cb + i >= nval) s0[i] = -INFINITY; if (cb + 16 + i >= nval) s1[i] = -INFINITY; }
                float mx = fmaxf(fmaxf(fmaxf(s0[0], s0[1]), fmaxf(s0[2], s0[3])), fmaxf(fmaxf(s1[0], s1[1]), fmaxf(s1[2], s1[3])));
                mx = fmaxf(mx, __shfl_xor(mx, 16)); mx = fmaxf(mx, __shfl_xor(mx, 32));
                const float mn = fmaxf(m[h], mx); const float ms = (mn == -INFINITY) ? 0.f : mn;
                float sum = 0.f;
#pragma unroll
                for (int i = 0; i < 4; ++i) sum += __builtin_amdgcn_exp2f(s0[i] - ms) + __builtin_amdgcn_exp2f(s1[i] - ms);
                l[h] = l[h] * __builtin_amdgcn_exp2f(m[h] - ms) + sum; m[h] = mn;
            }
        }
        float il[4];
#pragma unroll
        for (int h = 0; h < 4; ++h) { const float lt = grp_sum(l[h]); il[h] = lt > 0.f ? 1.f / lt : 0.f; if (m[h] == -INFINITY) m[h] = 0.f; attw_init(st[h]); }
        for (int s = 0; s < nsteps; ++s) {
            bf16x8 kf[2][2], vf[4];
#pragma unroll
            for (int tl = 0; tl < 2; ++tl)
#pragma unroll
                for (int ks = 0; ks < 2; ++ks) kf[tl][ks] = *(const bf16x8*)(CKF + kfrag_off(2 * s + tl, ks, lane));
#pragma unroll
            for (int dt = 0; dt < 4; ++dt) vf[dt] = *(const bf16x8*)(CVF + vfrag_off(s, dt, lane));
            const int cb = 32 * s + 4 * grp;
            float i4[4] = {0.f, 0.f, 0.f, 0.f};
#pragma unroll
            for (int h = 0; h < 4; ++h) {
                f32x4 s0, s1; qk_step(kf, qf[h], s0, s1);
                f32x4 p0, p1;
#pragma unroll
                for (int i = 0; i < 4; ++i) {
                    p0[i] = (cb + i < nval) ? __builtin_amdgcn_exp2f(s0[i] - m[h]) * il[h] : 0.f;
                    p1[i] = (cb + 16 + i < nval) ? __builtin_amdgcn_exp2f(s1[i] - m[h]) * il[h] : 0.f; }
                i4[0] += p0[0] + p0[1]; i4[1] += p0[2] + p0[3]; i4[2] += p1[0] + p1[1]; i4[3] += p1[2] + p1[3];
                const bf16x8 pf = pack_p(p0, p1);
#pragma unroll
                for (int dt = 0; dt < 4; ++dt) st[h].o[dt] = MFMA16(vf[dt], pf, st[h].o[dt]);
            }
            *(float2*)(imp + qi * 256 + 16 * s + 2 * grp) = make_float2(i4[0], i4[1]);
            *(float2*)(imp + qi * 256 + 16 * s + 8 + 2 * grp) = make_float2(i4[2], i4[3]);
        }
        wave_lds_sync();
    }
    const int cur = t0 >> 6;
    {
        if (cur + 1 <= 16) {
            for (int idx = lane; idx < 256; idx += 64) sel[idx] = ((idx & 15) <= cur) ? (idx & 15) : -1;
        } else {
            for (int q = 0; q < 16; ++q) {
                unsigned key[4];
#pragma unroll
                for (int j = 0; j < 4; ++j) { const int blk = lane + 64 * j; const float v = imp[q * 256 + blk];
                    key[j] = (blk >= 1 && blk <= cur - 2) ? ((__float_as_uint(v) & 0xFFFFFF00u) | (unsigned)(255 - blk)) : 0u; }
                if (lane == 0) { sel[q * 16 + 0] = 0; sel[q * 16 + 1] = cur; sel[q * 16 + 2] = cur - 1; }
                for (int n = 3; n < 16; ++n) {
                    unsigned best = max(max(key[0], key[1]), max(key[2], key[3]));
#pragma unroll
                    for (int o = 1; o < 64; o <<= 1) best = max(best, (unsigned)__shfl_xor((int)best, o));
                    const int blk = 255 - (int)(best & 255u);
#pragma unroll
                    for (int j = 0; j < 4; ++j) if (lane + 64 * j == blk) key[j] = 0u;
                    if (lane == 0) sel[q * 16 + n] = blk;
                }
            }
        }
        wave_lds_sync();
    }
    float* acc = wl;
    {
#pragma unroll
        for (int h = 0; h < 4; ++h) { const float gs = sigmoidf_(grow[h]);
#pragma unroll
            for (int dt = 0; dt < 4; ++dt) *(f32x4*)(acc + (qi * 4 + h) * 64 + 16 * dt + 4 * grp) = st[h].o[dt] * gs; }
        wave_lds_sync();
    }
    {
        const bf16* KF = p.KWF + (size_t)g * T * 64; const bf16* VF = p.VWF + (size_t)g * T * 64;
        int kstart = t0 - 512; if (kstart < 0) kstart = 0; kstart &= ~31;
        const int nsteps = (t0 + 16 - kstart + 31) >> 5;
#pragma unroll
        for (int h = 0; h < 4; ++h) attw_init(st[h]);
        auto issue = [&](int s_, bf16x8 (&K)[2][2], bf16x8 (&V)[4]) {
            const int k0 = kstart + 32 * s_;
#pragma unroll
            for (int tl = 0; tl < 2; ++tl)
#pragma unroll
                for (int ks = 0; ks < 2; ++ks) K[tl][ks] = *(const bf16x8*)(KF + kfrag_off((k0 >> 4) + tl, ks, lane));
#pragma unroll
            for (int dt = 0; dt < 4; ++dt) V[dt] = *(const bf16x8*)(VF + vfrag_off(k0 >> 5, dt, lane));
        };
        auto compute = [&](int s_, const bf16x8 (&K)[2][2], const bf16x8 (&V)[4]) {
            const int k0 = kstart + 32 * s_;
            const bool need_mask = (k0 + 31 > t0) || (k0 < t0 + 15 - 512);
            const int pb = k0 + 4 * grp;
#pragma unroll
            for (int h = 0; h < 4; ++h) {
                f32x4 s0, s1; qk_step(K, qf[h], s0, s1);
                if (need_mask) {
#pragma unroll
                    for (int i = 0; i < 4; ++i) { const int p0 = pb + i, p1 = pb + 16 + i;
                        if (p0 > t || p0 < t - 512) s0[i] = -INFINITY; if (p1 > t || p1 < t - 512) s1[i] = -INFINITY; }
                }
                att_update(st[h], s0, s1, V);
            }
        };
        bf16x8 kA[2][2], vA[4], kB[2][2], vB[4];
        issue(0, kA, vA);
        for (int s = 0; s < nsteps; s += 2) {
            if (s + 1 < nsteps) issue(s + 1, kB, vB);
            compute(s, kA, vA);
            if (s + 1 < nsteps) { if (s + 2 < nsteps) issue(s + 2, kA, vA); compute(s + 1, kB, vB); }
        }
#pragma unroll
        for (int h = 0; h < 4; ++h) { const float lt = grp_sum(st[h].l); const float gs = sigmoidf_(grow[16 + h]) * (lt > 0.f ? 1.f / lt : 0.f);
#pragma unroll
            for (int dt = 0; dt < 4; ++dt) { f32x4* a = (f32x4*)(acc + (qi * 4 + h) * 64 + 16 * dt + 4 * grp); *a = *a + st[h].o[dt] * gs; } }
        wave_lds_sync();
    }
    *(int4*)(p.SEL + ((size_t)g * T + t0) * 16 + lane * 4) = *(const int4*)(sel + lane * 4);
#pragma unroll 4
    for (int q = 0; q < 16; ++q) *(f32x4*)(p.NSACC + (size_t)(t0 + q) * 512 + g * 256 + 4 * lane) = *(const f32x4*)(acc + q * 256 + 4 * lane);
    wave_lds_sync();
}

__device__ __forceinline__ void nsa_slc_item(const KP& p, int tq, int g, int lane) {
    asm volatile("" : "+v"(lane));
    const int l15 = lane & 15, grp = lane >> 4, hn = lane & 3;
    const bf16* KF = p.KSF + (size_t)g * T * 64; const bf16* VF = p.VSF + (size_t)g * T * 64;
    const int* selp = p.SEL + ((size_t)g * T + tq) * 16;
    int sb[16];
#pragma unroll
    for (int i = 0; i < 16; ++i) sb[i] = __builtin_amdgcn_readfirstlane(selp[i]);
    bf16x8 qs[2];
#pragma unroll
    for (int ks = 0; ks < 2; ++ks) qs[ks] = *(const bf16x8*)(p.QB + (size_t)tq * 512 + (g * 4 + hn) * 64 + 32 * ks + 8 * grp);
    AttW a; attw_init(a);
    bf16x8 kf[2][2][2], vf[2][4];
    auto issue = [&](int i, int buf) {
        const int blk = sb[i >> 1]; int k0 = blk * 64 + 32 * (i & 1); if (blk < 0 || k0 > tq) k0 = 0;
#pragma unroll
        for (int tl = 0; tl < 2; ++tl)
#pragma unroll
            for (int ks = 0; ks < 2; ++ks) kf[buf][tl][ks] = *(const bf16x8*)(KF + kfrag_off((k0 >> 4) + tl, ks, lane));
#pragma unroll
        for (int dt = 0; dt < 4; ++dt) vf[buf][dt] = *(const bf16x8*)(VF + vfrag_off(k0 >> 5, dt, lane));
    };
    issue(0, 0);
#pragma unroll
    for (int i = 0; i < 32; ++i) {
        const int buf = i & 1;
        if (i + 1 < 32) issue(i + 1, buf ^ 1);
        const int blk = sb[i >> 1]; const int k0 = blk * 64 + 32 * (i & 1);
        const bool dead = (blk < 0) || (k0 > tq);
        f32x4 s0, s1; qk_step(kf[buf], qs, s0, s1);
        const int pb = k0 + 4 * grp;
#pragma unroll
        for (int j = 0; j < 4; ++j) { if (dead || pb + j > tq) s0[j] = -INFINITY; if (dead || pb + 16 + j > tq) s1[j] = -INFINITY; }
        att_update(a, s0, s1, vf[buf]);
    }
    const float lt = grp_sum(a.l);
    if (l15 < 4) {
        const float gs = sigmoidf_(p.BIGF[(size_t)tq * PA + C_GATE + 8 + g * 4 + l15]) * (lt > 0.f ? 1.f / lt : 0.f);
#pragma unroll
        for (int dt = 0; dt < 4; ++dt) {
            const size_t o = (size_t)tq * 512 + g * 256 + l15 * 64 + 16 * dt + 4 * grp;
            const f32x4 base = *(const f32x4*)(p.NSACC + o); const f32x4 v = base + a.o[dt] * gs;
            uint2 w; w.x = pk2(v[0], v[1]); w.y = pk2(v[2], v[3]);
            *(uint2*)(p.MIXB + (size_t)tq * 1024 + g * 256 + l15 * 64 + 16 * dt + 4 * grp) = w;
        }
    }
}

__device__ __forceinline__ void ph_compress(const KP& p, const Fr& F) {
    float* flat = (float*)F.lds;
    float* hid = (float*)(F.lds + 32768);
    float* res = (float*)(F.lds + 32768 + 2048);
    const float* H0 = p.BIGF;
    const int tid = F.tid;
    for (int item = F.bid; item < 512; item += F.G) {
        const int c = item & 511, s = item >> 9;
        for (int e = tid; e < 8192; e += NTHR) {
            const int kv = e >> 12, g = (e >> 11) & 1, k = e & 2047, i = k >> 6, d = k & 63;
            const int row = c * 32 + i;
            float v;
            if (s == 0) v = H0[(size_t)row * PA + C_KC + kv * 128 + g * 64 + d];
            else { const int b = s - 1; const int page = p.page_table[b * NPAGES + (row >> 7)];
                   v = p.cache_cmp[((((size_t)page * 128 + (row & 127)) * 2 + kv) * 2 + g) * 64 + d]; }
            flat[e] = v + p.cpe[(kv * 32 + i) * 64 + d];
        }
        __syncthreads();
        {
            const int kv = tid >> 8, g = (tid >> 7) & 1, j = tid & 127;
            const float* w = p.cw1 + (size_t)kv * 2048 * 128 + j;
            const float* fl = flat + (kv * 2 + g) * 2048;
            float acc = p.cb1[kv * 128 + j];
            for (int k = 0; k < 2048; ++k) acc += fl[k] * w[(size_t)k * 128];
            hid[(kv * 2 + g) * 128 + j] = gelu_tanh(acc);
        }
        __syncthreads();
        if (tid < 256) {
            const int kv = tid >> 7, g = (tid >> 6) & 1, d = tid & 63;
            const float* w = p.cw2 + (size_t)kv * 128 * 64 + d;
            const float* hh = hid + (kv * 2 + g) * 128;
            float acc = 0.f;
            for (int j = 0; j < 128; ++j) acc += hh[j] * w[j * 64];
            res[(kv * 2 + g) * 64 + d] = acc;
        }
        __syncthreads();
        if (tid < 256) {
            const int kv = tid >> 7, g = (tid >> 6) & 1, d = tid & 63;
            const float* rr = res + (kv * 2 + g) * 64;
            float v = rr[d];
            if (kv == 0) {
                const int pos = (c + 1) * 32 - 1; const float2 cs = p.ROPE[pos * 32 + (d & 31)];
                const float x1 = rr[d & 31], x2 = rr[(d & 31) + 32];
                v = (d < 32) ? (x1 * cs.x - x2 * cs.y) : (x2 * cs.x + x1 * cs.y);
                p.CK[(((size_t)s * 512 + c) * 2 + g) * 64 + d] = v;
                if (s == 0) p.CKF[(size_t)g * 512 * 64 + kfrag_elem(c, d)] = (bf16)f2bf(v);
            } else { p.CV[(((size_t)s * 512 + c) * 2 + g) * 64 + d] = v; if (s == 0) p.CVF[(size_t)g * 512 * 64 + vfrag_elem(c, d)] = (bf16)f2bf(v); }
        }
        __syncthreads();
    }
}

__device__ __forceinline__ void ph_gdn_prep(const KP& p, const Fr& F) {
    const float* H0 = p.BIGF; const int lane = F.lane;
    for (int item = T * 8 + F.gw; item < TS * 8; item += F.NGW) {
        const int r = item >> 3, h = item & 7;
        const bool smp = r >= T; const int b = r - T;
        float cv[3];
#pragma unroll
        for (int part = 0; part < 3; ++part) {
            const int ch = part * 512 + h * 64 + lane;
            float acc = 0.f;
#pragma unroll
            for (int j = 0; j < 4; ++j) {
                float u;
                if (!smp) { const int t = r + j - 3; u = (t >= 0) ? H0[(size_t)t * PA + C_GQKV + ch] : 0.f; }
                else { u = (j < 3) ? p.st_gconv[((size_t)b * 3 + j) * 1536 + ch] : H0[(size_t)r * PA + C_GQKV + ch]; }
                acc += p.gconv_w[j * 1536 + ch] * u;
            }
            cv[part] = siluf_(acc);
        }
        const float qn = wave_sum(cv[0] * cv[0]), kn = wave_sum(cv[1] * cv[1]);
        const size_t o = ((size_t)r * 8 + h) * 64 + lane;
        p.GQ[o] = cv[0] * rsqrtf(qn + NORM_EPS) * 0.125f;
        p.GK[o] = cv[1] * rsqrtf(kn + NORM_EPS);
        p.GV[o] = cv[2];
        if (lane == 0) {
            const float av = H0[(size_t)r * PA + C_A + h], bt = H0[(size_t)r * PA + C_BT + h];
            p.Gg[(size_t)r * 8 + h] = -expf(p.gA[h]) * softplusf_(av + p.gdt[h]);
            p.Gb[(size_t)r * 8 + h] = sigmoidf_(bt);
        }
    }
    const size_t gt = (size_t)F.bid * NTHR + F.tid, GT = (size_t)F.G * NTHR;
    for (size_t idx = gt; idx < (size_t)3 * 1536; idx += GT) {
        const int j = (int)(idx / 1536), ch = (int)(idx % 1536);
        p.out[O_GCONV_P + idx] = H0[(size_t)(T - 3 + j) * PA + C_GQKV + ch];
    }
    for (size_t idx = gt; idx < (size_t)NSMP * 3 * 1536; idx += GT) {
        const int b = (int)(idx / (3 * 1536)), j = (int)((idx / 1536) % 3), ch = (int)(idx % 1536);
        p.out[O_GCONV_S + idx] = (j < 2) ? p.st_gconv[((size_t)b * 3 + j + 1) * 1536 + ch] : H0[(size_t)(T + b) * PA + C_GQKV + ch];
    }
}

template <int NH, class KF>
__device__ __forceinline__ void wave_attend(const float* qs, float* sc, int scstride, int nkeys, KF kf, float (&outv)[NH], float (&den)[NH], int lane, float* mxout = nullptr) {
    float mx[NH];
#pragma unroll
    for (int h = 0; h < NH; ++h) mx[h] = -INFINITY;
    for (int j = lane; j < nkeys; j += 64) {
        const float *kp, *vp; const bool ok = kf(j, kp, vp);
        float s[NH];
#pragma unroll
        for (int h = 0; h < NH; ++h) s[h] = 0.f;
        if (ok) {
            for (int d4 = 0; d4 < 16; ++d4) {
                const float4 kvv = ((const float4*)kp)[d4];
#pragma unroll
                for (int h = 0; h < NH; ++h) { const float* q = qs + h * 64 + d4 * 4; s[h] += kvv.x * q[0] + kvv.y * q[1] + kvv.z * q[2] + kvv.w * q[3]; }
            }
        }
#pragma unroll
        for (int h = 0; h < NH; ++h) { const float v = ok ? s[h] * 0.125f : -INFINITY; sc[h * scstride + j] = v; mx[h] = fmaxf(mx[h], v); }
    }
#pragma unroll
    for (int h = 0; h < NH; ++h) { mx[h] = wave_max(mx[h]); if (!(mx[h] > -INFINITY)) mx[h] = 0.f; if (mxout) mxout[h] = mx[h]; }
    float sm[NH];
#pragma unroll
    for (int h = 0; h < NH; ++h) sm[h] = 0.f;
    for (int j = lane; j < nkeys; j += 64) {
#pragma unroll
        for (int h = 0; h < NH; ++h) { const float v = sc[h * scstride + j]; const float pp = (v == -INFINITY) ? 0.f : expf(v - mx[h]); sc[h * scstride + j] = pp; sm[h] += pp; }
    }
#pragma unroll
    for (int h = 0; h < NH; ++h) { sm[h] = wave_sum(sm[h]); den[h] = sm[h] > 0.f ? sm[h] : 1.f; }
    wave_lds_sync();
    {
        const int kq = lane >> 4, d4 = lane & 15;
        float4 acc[NH];
#pragma unroll
        for (int h = 0; h < NH; ++h) acc[h] = make_float4(0.f, 0.f, 0.f, 0.f);
        for (int j0 = 0; j0 < nkeys; j0 += 32) {
            float4 v[8];
#pragma unroll
            for (int u = 0; u < 8; ++u) { const int j = j0 + 4 * u + kq; const float *kp, *vp; const bool ok = (j < nkeys) && kf(j, kp, vp);
                v[u] = ok ? *(const float4*)(vp + 4 * d4) : make_float4(0.f, 0.f, 0.f, 0.f); }
#pragma unroll
            for (int u = 0; u < 8; ++u) { const int j = j0 + 4 * u + kq;
#pragma unroll
                for (int h = 0; h < NH; ++h) { const float pp = (j < nkeys) ? sc[h * scstride + j] : 0.f;
                    acc[h].x += pp * v[u].x; acc[h].y += pp * v[u].y; acc[h].z += pp * v[u].z; acc[h].w += pp * v[u].w; } }
        }
#pragma unroll
        for (int h = 0; h < NH; ++h) {
            float4 a = acc[h];
            a.x += __shfl_xor(a.x, 16); a.y += __shfl_xor(a.y, 16); a.z += __shfl_xor(a.z, 16); a.w += __shfl_xor(a.w, 16);
            a.x += __shfl_xor(a.x, 32); a.y += __shfl_xor(a.y, 32); a.z += __shfl_xor(a.z, 32); a.w += __shfl_xor(a.w, 32);
            const float x0 = __shfl(a.x, lane >> 2), x1 = __shfl(a.y, lane >> 2), x2 = __shfl(a.z, lane >> 2), x3 = __shfl(a.w, lane >> 2);
            const int cc = lane & 3; outv[h] = cc == 0 ? x0 : (cc == 1 ? x1 : (cc == 2 ? x2 : x3));
        }
    }
#pragma unroll
    for (int h = 0; h < NH; ++h) outv[h] /= den[h];
    wave_lds_sync();
}

__device__ __forceinline__ void nsa_smp_cs(const KP& p, int b, int g, float* wl, int lane) {
    float* qs = wl; float* sc = wl + 256; float* imp = wl + 256 + 4 * 1088; int* sel = (int*)(wl + 256 + 4 * 1088 + 320); long long* bb = (long long*)(wl + 256 + 4 * 1088 + 320 + 16);
    const int r = T + b; const int qpos = T;
    const float* grow = p.BIGF + (size_t)r * PA + C_GATE;
#pragma unroll
    for (int h = 0; h < 4; ++h) qs[h * 64 + lane] = p.QR[(size_t)r * 512 + (g * 4 + h) * 64 + lane];
    wave_lds_sync();
    float ocmp[4], oslc[4], den[4];
    {
        const float* CKp = p.CK + (size_t)(1 + b) * 512 * 128; const float* CVp = p.CV + (size_t)(1 + b) * 512 * 128;
        auto kf = [&](int j, const float*& kp, const float*& vp) -> bool { kp = CKp + (j * 2 + g) * 64; vp = CVp + (j * 2 + g) * 64; return true; };
        wave_attend<4>(qs, sc, 1088, 512, kf, ocmp, den, lane);
        for (int blk = lane; blk < 320; blk += 64) {
            float v = 0.f;
            if (blk < 256) {
#pragma unroll
                for (int h = 0; h < 4; ++h) v += (sc[h * 1088 + 2 * blk] + sc[h * 1088 + 2 * blk + 1]) / den[h];
            }
            imp[blk] = v;
        }
        wave_lds_sync();
    }
    {
        const int cur = qpos >> 6;
        float val[5];
#pragma unroll
        for (int j = 0; j < 5; ++j) { const int blk = lane + 64 * j; val[j] = (blk >= 1 && blk <= cur - 2) ? imp[blk] : -1.f; }
        if (lane == 0) { sel[0] = 0; sel[1] = cur; sel[2] = cur - 1; }
        for (int n = 3; n < 16; ++n) {
            float bv = -2.f; int bi = 0x7fffffff;
#pragma unroll
            for (int j = 0; j < 5; ++j) if (val[j] > bv) { bv = val[j]; bi = lane + 64 * j; }
#pragma unroll
            for (int o = 1; o < 64; o <<= 1) { const float ov = __shfl_xor(bv, o); const int oi = __shfl_xor(bi, o); if (ov > bv || (ov == bv && oi < bi)) { bv = ov; bi = oi; } }
#pragma unroll
            for (int j = 0; j < 5; ++j) if (lane + 64 * j == bi) val[j] = -3.f;
            if (lane == 0) sel[n] = bi;
        }
        wave_lds_sync();
        if (lane < 16) { const int blk = sel[lane]; long long o = 0;
            if (blk < 256) { const int page = p.page_table[b * NPAGES + (blk >> 1)]; o = ((long long)page * 128 + (blk & 1) * 64) * 256; }
            bb[lane] = o; }
        wave_lds_sync();
    }
    {
        auto kf = [&](int j, const float*& kp, const float*& vp) -> bool {
            const int blk = sel[j >> 6]; const int pos = blk * 64 + (j & 63); if (pos > qpos) return false;
            if (pos == T) { kp = p.KS + (size_t)r * 128 + g * 64; vp = p.VS + (size_t)r * 128 + g * 64; return true; }
            const float* base = p.cache_slc + bb[j >> 6] + (j & 63) * 256;
            kp = base + g * 64; vp = base + 128 + g * 64; return true; };
        wave_attend<4>(qs, sc, 1088, 1024, kf, oslc, den, lane);
    }
#pragma unroll
    for (int h = 0; h < 4; ++h) {
        const int hh = g * 4 + h;
        p.SMIXF[((size_t)b * 3 + 0) * 512 + hh * 64 + lane] = sigmoidf_(grow[hh]) * ocmp[h];
        p.SMIXF[((size_t)b * 3 + 1) * 512 + hh * 64 + lane] = sigmoidf_(grow[8 + hh]) * oslc[h];
    }
    wave_lds_sync();
}
__device__ __forceinline__ void nsa_smp_win(const KP& p, int b, int g, float* wl, int lane) {
    float* qs = wl; float* sc = wl + 256;
    const int r = T + b;
    const float* grow = p.BIGF + (size_t)r * PA + C_GATE;
#pragma unroll
    for (int h = 0; h < 4; ++h) qs[h * 64 + lane] = p.QR[(size_t)r * 512 + (g * 4 + h) * 64 + lane];
    wave_lds_sync();
    float owin[4], den[4];
    auto kf = [&](int j, const float*& kp, const float*& vp) -> bool {
        if (j == 512) { kp = p.KW + (size_t)r * 128 + g * 64; vp = p.VW + (size_t)r * 128 + g * 64; return true; }
        const float* base = p.st_win + ((size_t)b * 512 + j) * 256;
        kp = base + g * 64; vp = base + 128 + g * 64; return true; };
    wave_attend<4>(qs, sc, 528, 513, kf, owin, den, lane);
#pragma unroll
    for (int h = 0; h < 4; ++h) { const int hh = g * 4 + h; p.SMIXF[((size_t)b * 3 + 2) * 512 + hh * 64 + lane] = sigmoidf_(grow[16 + hh]) * owin[h]; }
    wave_lds_sync();
}

__device__ __forceinline__ void gdn_scan_item(const KP& p, int item, float* wl, int lane) {
    asm volatile("" : "+v"(lane));
    float* kq = wl;
    const int b = (item >> 3) - 1, h = item & 7;
    const int r = T + b; const size_t o = ((size_t)r * 8 + h) * 64;
    kq[lane] = p.GK[o + lane]; kq[64 + lane] = p.GQ[o + lane];
    wave_lds_sync();
    const float dec = expf(p.Gg[(size_t)r * 8 + h]), bt = p.Gb[(size_t)r * 8 + h];
    const float* Sp = p.st_gS + ((size_t)b * 8 + h) * 4096 + lane;
    float* so = p.out + O_GS_S + ((size_t)b * 8 + h) * 4096 + lane;
    float S[64]; float kv = 0.f;
#pragma unroll
    for (int i = 0; i < 64; ++i) { S[i] = Sp[i * 64] * dec; kv += kq[i] * S[i]; }
    const float vn = (p.GV[o + lane] - kv) * bt;
    float ov = 0.f;
#pragma unroll
    for (int i = 0; i < 64; ++i) { const float sn = S[i] + kq[i] * vn; ov += kq[64 + i] * sn; so[i * 64] = sn; }
    p.OG[o + lane] = ov;
    wave_lds_sync();
}

constexpr int GDN_WL = 34816;
__device__ __forceinline__ int kperm(int ks, int grp, int j) { return 32 * ks + 16 * (j >> 2) + 4 * grp + (j & 3); }

__device__ __forceinline__ void gdn_chunk_unit(const KP& p, int unit, unsigned char* ldsb, int woff, int lane) {
    asm volatile("" : "+v"(lane), "+s"(woff));
    unsigned char* wlb = ldsb + woff;
    const int n = unit >> 3, h = unit & 7, t0 = 64 * n;
    const int l15 = lane & 15, grp = lane >> 4;
    float* Af = (float*)wlb; bf16* kt = (bf16*)(wlb + 16384); bf16* qt = kt + 64 * 72; bf16* tmp = (bf16*)wlb;
    {
        const float* H0 = p.BIGF;
        float w[3][4], u1[3], u2[3], u3[3];
#pragma unroll
        for (int part = 0; part < 3; ++part) {
            const int ch = part * 512 + h * 64 + lane;
#pragma unroll
            for (int j = 0; j < 4; ++j) w[part][j] = p.gconv_w[j * 1536 + ch];
            u1[part] = (t0 >= 1) ? H0[(size_t)(t0 - 1) * PA + C_GQKV + ch] : 0.f;
            u2[part] = (t0 >= 2) ? H0[(size_t)(t0 - 2) * PA + C_GQKV + ch] : 0.f;
            u3[part] = (t0 >= 3) ? H0[(size_t)(t0 - 3) * PA + C_GQKV + ch] : 0.f;
        }
        int roff = 0;
#pragma unroll 4
        for (int i = 0; i < 64; ++i) {
            float cv[3];
#pragma unroll
            for (int part = 0; part < 3; ++part) {
                const float u0 = H0[(size_t)t0 * PA + C_GQKV + part * 512 + h * 64 + lane + roff];
                cv[part] = siluf_(w[part][0] * u3[part] + w[part][1] * u2[part] + w[part][2] * u1[part] + w[part][3] * u0);
                u3[part] = u2[part]; u2[part] = u1[part]; u1[part] = u0;
            }
            roff += PA; asm volatile("" : "+s"(roff));
            const float qn = wave_sum(cv[0] * cv[0]), kn = wave_sum(cv[1] * cv[1]);
            qt[i * 72 + lane] = (bf16)f2bf(cv[0] * rsqrtf(qn + NORM_EPS) * 0.125f);
            kt[i * 72 + lane] = (bf16)f2bf(cv[1] * rsqrtf(kn + NORM_EPS));
            p.GV[((size_t)(t0 + i) * 8 + h) * 64 + lane] = cv[2];
        }
    }
    const float gl_ = -fexp_(p.gA[h]) * softplusf_(p.BIGF[(size_t)(t0 + lane) * PA + C_A + h] + p.gdt[h]);
    const float beta = sigmoidf_(p.BIGF[(size_t)(t0 + lane) * PA + C_BT + h]);
    float gc = gl_;
#pragma unroll
    for (int o = 1; o < 64; o <<= 1) { const float tv = __shfl_up(gc, o); if (lane >= o) gc += tv; }
    const float gclast = __shfl(gc, 63);
#define GPAD(i) ((float*)(kt + (i) * 72 + 64))
    { float* pd = GPAD(lane); pd[0] = gc; pd[1] = beta; pd[2] = fexp_(gc); pd[3] = fexp_(gclast - gc); }
    wave_lds_sync();
    bf16* QKF = p.G_QKF + (size_t)unit * 4096;
#pragma unroll
    for (int it = 0; it < 4; ++it) {
        const int i = 16 * it + l15;
        const float gci = GPAD(i)[0], bi = GPAD(i)[1];
        bf16x8 bk[2], bq[2];
#pragma unroll
        for (int ks = 0; ks < 2; ++ks) { bk[ks] = *(const bf16x8*)(kt + i * 72 + 32 * ks + 8 * grp); bq[ks] = *(const bf16x8*)(qt + i * 72 + 32 * ks + 8 * grp); }
#pragma unroll
        for (int jt = 0; jt < 4; ++jt) {
            uint2 qkp = make_uint2(0u, 0u);
            if (jt <= it) {
                bf16x8 ak[2];
#pragma unroll
                for (int ks = 0; ks < 2; ++ks) ak[ks] = *(const bf16x8*)(kt + (16 * jt + l15) * 72 + 32 * ks + 8 * grp);
                f32x4 aa = {0.f, 0.f, 0.f, 0.f}, aq = {0.f, 0.f, 0.f, 0.f};
                aa = MFMA16(ak[0], bk[0], aa); aa = MFMA16(ak[1], bk[1], aa);
                aq = MFMA16(ak[0], bq[0], aq); aq = MFMA16(ak[1], bq[1], aq);
                f32x4 av, qv;
#pragma unroll
                for (int r = 0; r < 4; ++r) {
                    const int j = 16 * jt + 4 * grp + r; const float gcj = GPAD(j)[0];
                    const float e = (j <= i) ? fexp_(gci - gcj) : 0.f;
                    av[r] = (j < i) ? bi * aa[r] * e : 0.f; qv[r] = aq[r] * e;
                }
                *(f32x4*)(Af + i * 64 + 16 * jt + 4 * grp) = av;
                qkp.x = pk2(qv[0], qv[1]); qkp.y = pk2(qv[2], qv[3]);
            }
            *(uint2*)(QKF + ((size_t)(it * 2 + (jt >> 1)) * 64 + lane) * 8 + (jt & 1) * 4) = qkp;
        }
    }
    wave_lds_sync();
    {
        float* UF = p.G_UF + (size_t)unit * 4096;
        const int vq = lane >> 4;
#pragma unroll
        for (int pass = 0; pass < 2; ++pass) {
            float x[64];
            int goff = 0;
#pragma unroll
            for (int i = 0; i < 64; ++i) {
                const float bi = GPAD(i)[1];
                float acc;
                if (pass == 0) { acc = p.GV[((size_t)t0 * 8 + h) * 64 + lane + goff] * bi; goff += 512; asm volatile("" : "+s"(goff)); }
                else { const float ei = GPAD(i)[2];
                       acc = __uint_as_float((unsigned)kt[i * 72 + lane] << 16) * bi * ei; }
#pragma unroll
                for (int jj = 0; jj < (i + 3) / 4; ++jj) {
                    const float4 a4 = *(const float4*)(Af + i * 64 + 4 * jj);
                    acc -= a4.x * x[4 * jj + 0];
                    if (4 * jj + 1 < i) acc -= a4.y * x[4 * jj + 1];
                    if (4 * jj + 2 < i) acc -= a4.z * x[4 * jj + 2];
                    if (4 * jj + 3 < i) acc -= a4.w * x[4 * jj + 3];
                }
                x[i] = acc;
                if ((i & 3) == 3) asm volatile("" ::: "memory");
            }
            if (pass == 0) {
#pragma unroll
                for (int c4 = 0; c4 < 16; ++c4) {
                    const int mt = c4 >> 2, lp = l15 + 16 * (c4 & 3);
                    *(f32x4*)(UF + ((size_t)(vq * 4 + mt) * 64 + lp) * 4) = (f32x4){x[4 * c4], x[4 * c4 + 1], x[4 * c4 + 2], x[4 * c4 + 3]};
                }
            } else {
                wave_lds_sync();
#pragma unroll
                for (int c = 0; c < 64; ++c) tmp[c * 72 + lane] = (bf16)f2bf(-x[c]);
            }
            asm volatile("" ::: "memory");
        }
    }
    wave_lds_sync();
    {
        bf16* WF = p.G_WF + (size_t)unit * 4096; bf16* QGF = p.G_QGF + (size_t)unit * 4096; bf16* KDF = p.G_KDF + (size_t)unit * 4096;
#pragma unroll
        for (int mt = 0; mt < 4; ++mt) {
            const float egc = GPAD(16 * mt + l15)[2];
#pragma unroll
            for (int ks = 0; ks < 2; ++ks) {
                const int c = 16 * mt + l15, k0 = 32 * ks + 4 * grp;
                const uint2 w0 = *(const uint2*)(tmp + c * 72 + k0), w1 = *(const uint2*)(tmp + c * 72 + k0 + 16);
                v4u wv; wv.x = w0.x; wv.y = w0.y; wv.z = w1.x; wv.w = w1.y;
                *(v4u*)(WF + ((size_t)(mt * 2 + ks) * 64 + lane) * 8) = wv;
                const uint2 q0 = *(const uint2*)(qt + c * 72 + k0), q1 = *(const uint2*)(qt + c * 72 + k0 + 16);
                v4u qv;
                qv.x = pk2(__uint_as_float(q0.x << 16) * egc, __uint_as_float(q0.x & 0xffff0000u) * egc); qv.y = pk2(__uint_as_float(q0.y << 16) * egc, __uint_as_float(q0.y & 0xffff0000u) * egc);
                qv.z = pk2(__uint_as_float(q1.x << 16) * egc, __uint_as_float(q1.x & 0xffff0000u) * egc); qv.w = pk2(__uint_as_float(q1.y << 16) * egc, __uint_as_float(q1.y & 0xffff0000u) * egc);
                *(v4u*)(QGF + ((size_t)(mt * 2 + ks) * 64 + lane) * 8) = qv;
                float kd[8];
#pragma unroll
                for (int j = 0; j < 8; ++j) { const int cc = kperm(ks, grp, j); kd[j] = __uint_as_float((unsigned)kt[cc * 72 + 16 * mt + l15] << 16) * GPAD(cc)[3]; }
                v4u kv; kv.x = pk2(kd[0], kd[1]); kv.y = pk2(kd[2], kd[3]); kv.z = pk2(kd[4], kd[5]); kv.w = pk2(kd[6], kd[7]);
                *(v4u*)(KDF + ((size_t)(mt * 2 + ks) * 64 + lane) * 8) = kv;
            }
        }
        if (lane == 0) p.G_GL[unit] = fexp_(gclast);
    }
    wave_lds_sync();
#undef GPAD
}

constexpr int CH_SLOT = 32768;
__device__ __forceinline__ void gdn_chain_wg(const KP& p, int h, int wave, int lane, unsigned char* ldsb) {
    asm volatile("" : "+v"(lane));
    const int l15 = lane & 15, grp = lane >> 4;
    float* GLs = (float*)(ldsb + 4 * CH_SLOT);
    if (wave < 4) GLs[wave * 64 + lane] = p.G_GL[(size_t)(wave * 64 + lane) * 8 + h];
#define CH_BAR() do { asm volatile("s_waitcnt lgkmcnt(0)" ::: "memory"); __builtin_amdgcn_s_barrier(); asm volatile("" ::: "memory"); } while (0)
    if (wave >= 4) {
        const int lw = wave - 4;
        const unsigned char* gb = (lw == 0) ? (const unsigned char*)p.G_WF : (lw == 1) ? (const unsigned char*)p.G_KDF : (const unsigned char*)p.G_UF + (size_t)(lw - 2) * 8192;
        const size_t ustride = (lw < 2) ? 8192 : 16384;
        gb += (size_t)h * ustride + (size_t)lane * 16;
        auto src = [&](int n, int k) -> const v4u* { return (const v4u*)(gb + (size_t)n * 8 * ustride + k * 1024); };
        v4u rs[4][8];
#pragma unroll
        for (int j = 0; j < 4; ++j)
#pragma unroll
            for (int k = 0; k < 8; ++k) rs[j][k] = *src(j, k);
#pragma unroll
        for (int j = 0; j < 2; ++j) {
#pragma unroll
            for (int k = 0; k < 8; ++k) { *(v4u*)(ldsb + j * CH_SLOT + (lw * 512 + k * 64 + lane) * 16) = rs[j][k]; rs[j][k] = *src(4 + j, k); }
        }
        CH_BAR();
        for (int n0 = 0; n0 < 256; n0 += 4) {
#pragma unroll
            for (int j = 0; j < 4; ++j) {
                const int n = n0 + j, st = n + 2;
                if (st < 256) {
                    const int set = (j + 2) & 3;
#pragma unroll
                    for (int k = 0; k < 8; ++k) { *(v4u*)(ldsb + (st & 3) * CH_SLOT + (lw * 512 + k * 64 + lane) * 16) = rs[set][k]; if (st + 4 < 256) rs[set][k] = *src(st + 4, k); }
                }
                CH_BAR();
            }
        }
#undef CH_BAR
        return;
    }
    const int vq = wave;
    f32x4 S[4];
#pragma unroll
    for (int i = 0; i < 4; ++i) S[i] = (f32x4){0.f, 0.f, 0.f, 0.f};
    asm volatile("s_waitcnt lgkmcnt(0)" ::: "memory"); __builtin_amdgcn_s_barrier(); asm volatile("" ::: "memory");
    for (int n = 0; n < 256; ++n) {
        const unsigned char* sl = ldsb + (n & 3) * CH_SLOT;
        bf16x8 wf[4][2], kdf[4][2]; f32x4 uf[4];
#pragma unroll
        for (int mt = 0; mt < 4; ++mt) {
#pragma unroll
            for (int ks = 0; ks < 2; ++ks) { wf[mt][ks] = *(const bf16x8*)(sl + ((mt * 2 + ks) * 64 + lane) * 16); kdf[mt][ks] = *(const bf16x8*)(sl + 8192 + ((mt * 2 + ks) * 64 + lane) * 16); }
            uf[mt] = *(const f32x4*)(sl + 16384 + ((vq * 4 + mt) * 64 + lane) * 16);
        }
        const float gl = GLs[n];
        const size_t fo = ((size_t)((n * 8 + h) * 4 + vq) * 2) * 512;
        bf16x8 sB[2];
#pragma unroll
        for (int ks = 0; ks < 2; ++ks) { sB[ks] = pack_p(S[2 * ks], S[2 * ks + 1]); *(bf16x8*)(p.G_SPF + fo + ((size_t)ks * 64 + lane) * 8) = sB[ks]; }
        f32x4 v[4];
#pragma unroll
        for (int mt = 0; mt < 4; ++mt) { v[mt] = uf[mt]; v[mt] = MFMA16(wf[mt][0], sB[0], v[mt]); v[mt] = MFMA16(wf[mt][1], sB[1], v[mt]); }
        bf16x8 vB[2];
#pragma unroll
        for (int ks = 0; ks < 2; ++ks) { vB[ks] = pack_p(v[2 * ks], v[2 * ks + 1]); *(bf16x8*)(p.G_VNF + fo + ((size_t)ks * 64 + lane) * 8) = vB[ks]; }
#pragma unroll
        for (int mt = 0; mt < 4; ++mt) { S[mt] = S[mt] * gl; S[mt] = MFMA16(kdf[mt][0], vB[0], S[mt]); S[mt] = MFMA16(kdf[mt][1], vB[1], S[mt]); }
        asm volatile("s_waitcnt lgkmcnt(0)" ::: "memory"); __builtin_amdgcn_s_barrier(); asm volatile("" ::: "memory");
    }
    float* so = p.out + O_GS_P + (size_t)h * 4096;
#pragma unroll
    for (int mt = 0; mt < 4; ++mt)
#pragma unroll
        for (int r = 0; r < 4; ++r) so[(16 * mt + 4 * grp + r) * 64 + 16 * vq + l15] = S[mt][r];
}

__device__ __forceinline__ void gdn_out_unit(const KP& p, int unit, int lane) {
    asm volatile("" : "+v"(lane));
    const int n = unit >> 3, h = unit & 7, t0 = 64 * n; const int l15 = lane & 15, grp = lane >> 4;
    const bf16* QGF = p.G_QGF + (size_t)unit * 4096; const bf16* QKF = p.G_QKF + (size_t)unit * 4096;
    f32x4 o[4][4];
#pragma unroll
    for (int mt = 0; mt < 4; ++mt)
#pragma unroll
        for (int vq = 0; vq < 4; ++vq) o[mt][vq] = (f32x4){0.f, 0.f, 0.f, 0.f};
#pragma unroll
    for (int ks = 0; ks < 2; ++ks) {
        bf16x8 sp[4], vn[4];
#pragma unroll
        for (int vq = 0; vq < 4; ++vq) { const size_t fo = ((size_t)(unit * 4 + vq) * 2 + ks) * 512 + (size_t)lane * 8; sp[vq] = *(const bf16x8*)(p.G_SPF + fo); vn[vq] = *(const bf16x8*)(p.G_VNF + fo); }
#pragma unroll
        for (int mt = 0; mt < 4; ++mt) {
            const bf16x8 qg = *(const bf16x8*)(QGF + ((size_t)(mt * 2 + ks) * 64 + lane) * 8), qk = *(const bf16x8*)(QKF + ((size_t)(mt * 2 + ks) * 64 + lane) * 8);
#pragma unroll
            for (int vq = 0; vq < 4; ++vq) { o[mt][vq] = MFMA16(qg, sp[vq], o[mt][vq]); o[mt][vq] = MFMA16(qk, vn[vq], o[mt][vq]); }
        }
    }
    float nw[4];
#pragma unroll
    for (int vq = 0; vq < 4; ++vq) nw[vq] = p.gnw[16 * vq + l15];
#pragma unroll
    for (int mt = 0; mt < 4; ++mt)
#pragma unroll
        for (int r = 0; r < 4; ++r) {
            float ss = 0.f;
#pragma unroll
            for (int vq = 0; vq < 4; ++vq) ss += o[mt][vq][r] * o[mt][vq][r];
            ss += __shfl_xor(ss, 1); ss += __shfl_xor(ss, 2); ss += __shfl_xor(ss, 4); ss += __shfl_xor(ss, 8);
            const float rs = rsqrtf(ss * (1.f / 64.f) + NORM_EPS);
            const int t = t0 + 16 * mt + 4 * grp + r;
            const float* zr = p.BIGF + (size_t)t * PA + C_Z + h * 64;
#pragma unroll
            for (int vq = 0; vq < 4; ++vq) p.MIXB[(size_t)t * 1024 + 512 + h * 64 + 16 * vq + l15] = (bf16)f2bf(o[mt][vq][r] * rs * nw[vq] * siluf_(zr[16 * vq + l15]));
        }
}

#define MFMA8(a, b, c) __builtin_amdgcn_mfma_f32_16x16x32_fp8_fp8((a), (b), (c), 0, 0, 0)
__device__ __forceinline__ long pack_fp8(const f32x4& a, const f32x4& b) {
    int w0 = 0, w1 = 0;
    w0 = __builtin_amdgcn_cvt_pk_fp8_f32(a[0], a[1], w0, false); w0 = __builtin_amdgcn_cvt_pk_fp8_f32(a[2], a[3], w0, true);
    w1 = __builtin_amdgcn_cvt_pk_fp8_f32(b[0], b[1], w1, false); w1 = __builtin_amdgcn_cvt_pk_fp8_f32(b[2], b[3], w1, true);
    return (long)(((unsigned long long)(unsigned)w1 << 32) | (unsigned long long)(unsigned)w0);
}
template <bool GEN>
__device__ __forceinline__ void nsa_slc_item8(const KP& p, int tq, int g, int lane) {
    asm volatile("" : "+v"(lane));
    const int l15 = lane & 15, grp = lane >> 4, hn = lane & 3;
    const unsigned char* KF = p.KS8 + (size_t)g * T * 64; const unsigned char* VF = p.VS8 + (size_t)g * T * 64;
    const int* selp = p.SEL + ((size_t)g * T + tq) * 16;
    int sb[16];
#pragma unroll
    for (int i = 0; i < 16; ++i) sb[i] = __builtin_amdgcn_readfirstlane(selp[i]);
    long qs[2];
#pragma unroll
    for (int ks = 0; ks < 2; ++ks) {
        const bf16x8 qb = *(const bf16x8*)(p.QB + (size_t)tq * 512 + (g * 4 + hn) * 64 + 32 * ks + 8 * grp);
        f32x4 a, b;
#pragma unroll
        for (int j = 0; j < 4; ++j) { a[j] = __uint_as_float((unsigned)(unsigned short)qb[j] << 16) * (1.f / QSCALE); b[j] = __uint_as_float((unsigned)(unsigned short)qb[4 + j] << 16) * (1.f / QSCALE); }
        qs[ks] = pack_fp8(a, b);
    }
    AttW a; attw_init(a);
    long kf[3][4][2], vf[3][2][4];
    auto issue = [&](int bi, int buf) {
        int blk = sb[bi]; if (GEN && (blk < 0 || blk * 64 > tq)) blk = 0;
        typedef long l2_t __attribute__((ext_vector_type(2)));
#pragma unroll
        for (int tl = 0; tl < 4; ++tl) { const l2_t x = *(const l2_t*)(KF + ((size_t)(blk * 4 + tl) * 64 + lane) * 16); kf[buf][tl][0] = x[0]; kf[buf][tl][1] = x[1]; }
#pragma unroll
        for (int dt = 0; dt < 4; ++dt) { const l2_t x = *(const l2_t*)(VF + ((size_t)(blk * 4 + dt) * 64 + lane) * 16); vf[buf][0][dt] = x[0]; vf[buf][1][dt] = x[1]; }
    };
    issue(0, 0); issue(1, 1);
#pragma unroll
    for (int bi = 0; bi < 16; ++bi) {
        const int buf = bi % 3;
        if (bi + 2 < 16) issue(bi + 2, (bi + 2) % 3);
        const int blk = sb[bi]; const int k0 = blk * 64;
        if (GEN && (blk < 0 || k0 > tq)) continue;
        const f32x4 z = {0.f, 0.f, 0.f, 0.f};
        f32x4 sc[4];
#pragma unroll
        for (int tl = 0; tl < 4; ++tl) { sc[tl] = MFMA8(kf[buf][tl][0], qs[0], z); sc[tl] = MFMA8(kf[buf][tl][1], qs[1], sc[tl]); }
        if (GEN ? (k0 + 63 > tq) : (bi == 1)) {
#pragma unroll
            for (int tl = 0; tl < 4; ++tl)
#pragma unroll
                for (int j = 0; j < 4; ++j) if (k0 + 16 * tl + 4 * grp + j > tq) sc[tl][j] = -INFINITY;
        }
        float mx = fmaxf(fmaxf(fmaxf(fmaxf(sc[0][0], sc[0][1]), fmaxf(sc[0][2], sc[0][3])), fmaxf(fmaxf(sc[1][0], sc[1][1]), fmaxf(sc[1][2], sc[1][3]))),
                         fmaxf(fmaxf(fmaxf(sc[2][0], sc[2][1]), fmaxf(sc[2][2], sc[2][3])), fmaxf(fmaxf(sc[3][0], sc[3][1]), fmaxf(sc[3][2], sc[3][3]))));
        mx = fmaxf(mx, __shfl_xor(mx, 16)); mx = fmaxf(mx, __shfl_xor(mx, 32));
        const float mn = fmaxf(a.m, mx * QSCALE);
        const float alpha = __builtin_amdgcn_exp2f(a.m - mn);
        const float mb = 7.f - mn;
        f32x4 pp[4]; float sum = 0.f;
#pragma unroll
        for (int tl = 0; tl < 4; ++tl) {
#pragma unroll
            for (int j = 0; j < 4; ++j) pp[tl][j] = __builtin_amdgcn_exp2f(fmaf(sc[tl][j], QSCALE, mb));
            sum += (pp[tl][0] + pp[tl][1]) + (pp[tl][2] + pp[tl][3]);
        }
        a.l = a.l * alpha + sum; a.m = mn;
        const long pf0 = pack_fp8(pp[0], pp[1]), pf1 = pack_fp8(pp[2], pp[3]);
#pragma unroll
        for (int dt = 0; dt < 4; ++dt) { a.o[dt] = a.o[dt] * alpha; a.o[dt] = MFMA8(vf[buf][0][dt], pf0, a.o[dt]); a.o[dt] = MFMA8(vf[buf][1][dt], pf1, a.o[dt]); }
    }
    const float lt = grp_sum(a.l);
    if (l15 < 4) {
        const float gs = sigmoidf_(p.BIGF[(size_t)tq * PA + C_GATE + 8 + g * 4 + l15]) * (lt > 0.f ? 1.f / lt : 0.f);
#pragma unroll
        for (int dt = 0; dt < 4; ++dt) {
            const size_t o = (size_t)tq * 512 + g * 256 + l15 * 64 + 16 * dt + 4 * grp;
            const f32x4 base = *(const f32x4*)(p.NSACC + o); const f32x4 v = base + a.o[dt] * gs;
            uint2 w; w.x = pk2(v[0], v[1]); w.y = pk2(v[2], v[3]);
            *(uint2*)(p.MIXB + (size_t)tq * 1024 + g * 256 + l15 * 64 + 16 * dt + 4 * grp) = w;
        }
    }
}

__device__ __forceinline__ void ph_gdn_chunks(const KP& p, const Fr& F) {
    if (F.wave < 4) for (int unit = F.bid * 4 + F.wave; unit < 2048; unit += F.G * 4) gdn_chunk_unit(p, unit, F.lds, F.wave * GDN_WL, F.lane);
    else { const int unit = F.bid * 4 + (F.wave - 4); if (unit < 128) cmp_prompt_unit(p, unit, F.lane); }
}
__device__ __forceinline__ void ph_mix_a(const KP& p, const Fr& F) {
    if (F.bid < 32) gdn_scan_item(p, (F.bid + 1) * 8 + F.wave, (float*)(F.lds + 8 * FAST_WL + 1024 + F.wave * 512), F.lane);
    float* wl = (float*)(F.lds + F.wave * FAST_WL);
    for (int unit = F.gw; unit < 2048; unit += F.NGW) nsa_fast_unit(p, unit, wl, F.lane);
}
__device__ __forceinline__ void ph_mix_b(const KP& p, const Fr& F) {
    if (F.bid < 8) { gdn_chain_wg(p, F.bid, F.wave, F.lane, F.lds); return; }
    if (F.bid < 24) {
        const int it = (F.bid - 8) * 4 + (F.wave & 3);
        if (F.wave < 4) nsa_smp_cs(p, it >> 1, it & 1, (float*)(F.lds + F.wave * 20480), F.lane);
        else nsa_smp_win(p, it >> 1, it & 1, (float*)(F.lds + 81920 + (F.wave - 4) * 12288), F.lane);
        return;
    }
    const int g = F.bid & 1, fr = (F.bid - 24) >> 1, NW = ((F.G - 24) >> 1) * 8;
    for (int tq = fr * 8 + F.wave; tq < T; tq += NW) { if (tq >= 1024) nsa_slc_item8<false>(p, tq, g, F.lane); else nsa_slc_item8<true>(p, tq, g, F.lane); }
}

__device__ __forceinline__ void ph_gdn_out(const KP& p, const Fr& F) {
    const float* H0 = p.BIGF; const int lane = F.lane;
    for (int unit = F.gw; unit < 2048; unit += F.NGW) gdn_out_unit(p, unit, lane);
    for (int idx = F.bid * NTHR + F.tid; idx < NSMP * 512; idx += F.G * NTHR) { const int b = idx >> 9, c = idx & 511; const float* sp = p.SMIXF + (size_t)b * 3 * 512 + c;
        p.MIXB[(size_t)(T + b) * 1024 + c] = (bf16)f2bf(sp[0] + sp[512] + sp[1024]); }
    for (int item = T * 8 + F.gw; item < TS * 8; item += F.NGW) {
        const int r = item >> 3, h = item & 7;
        const float o = p.OG[((size_t)r * 8 + h) * 64 + lane];
        const float ms = wave_sum(o * o) * (1.f / 64.f);
        const float z = H0[(size_t)r * PA + C_Z + h * 64 + lane];
        p.MIXB[(size_t)r * 1024 + 512 + h * 64 + lane] = (bf16)f2bf(o * rsqrtf(ms + NORM_EPS) * p.gnw[lane] * siluf_(z));
    }
}

__device__ __forceinline__ void ph_ln(const Fr& F, const float* Xp, const float* Xs, const float* Fm, const float* gam, const float* bet, float* outp, float* outs, bf16* ob) {
    const int lane = F.lane;
    for (int r = F.gw; r < TS; r += F.NGW) {
        const float4* xr = (const float4*)((r < T) ? Xp + (size_t)r * DM : Xs + (size_t)(r - T) * DM) + lane; const float4* fr = (const float4*)(Fm + (size_t)r * DM) + lane;
        f32x4 v[4]; float s = 0.f;
#pragma unroll
        for (int j = 0; j < 4; ++j) { const float4 x = xr[64 * j], f = fr[64 * j]; v[j] = (f32x4){DN_ALPHA * x.x + f.x, DN_ALPHA * x.y + f.y, DN_ALPHA * x.z + f.z, DN_ALPHA * x.w + f.w}; s += (v[j][0] + v[j][1]) + (v[j][2] + v[j][3]); }
        const float mean = wave_sum(s) * (1.f / DM); float q = 0.f;
#pragma unroll
        for (int j = 0; j < 4; ++j) { v[j] = v[j] - mean; q += (v[j][0] * v[j][0] + v[j][1] * v[j][1]) + (v[j][2] * v[j][2] + v[j][3] * v[j][3]); }
        const float rstd = rsqrtf(wave_sum(q) * (1.f / DM) + LN_EPS);
        float4* o = (float4*)((r < T) ? outp + (size_t)r * DM : outs + (size_t)(r - T) * DM) + lane;
#pragma unroll
        for (int j = 0; j < 4; ++j) { const float4 g4 = ((const float4*)gam)[lane + 64 * j], b4 = ((const float4*)bet)[lane + 64 * j];
            const float4 y = make_float4(v[j][0] * rstd * g4.x + b4.x, v[j][1] * rstd * g4.y + b4.y, v[j][2] * rstd * g4.z + b4.z, v[j][3] * rstd * g4.w + b4.w);
            o[64 * j] = y; if (ob) { uint2 w; w.x = pk2(y.x, y.y); w.y = pk2(y.z, y.w); *((uint2*)(ob + (size_t)r * DM) + lane + 64 * j) = w; } }
    }
}

__device__ __forceinline__ void ph_ffn_act(const KP& p, const Fr& F, int layer) {
    const float* U = p.BIGF; const float* cw = p.ffn_cw + (size_t)layer * 3 * DFF2; const float* cb = p.ffn_cb + (size_t)layer * DFF2;
    const size_t gt = (size_t)F.bid * NTHR + F.tid, GT = (size_t)F.G * NTHR;
    const size_t total = (size_t)TS * DFF;
    for (size_t idx = gt; idx < total; idx += GT) {
        const int r = (int)(idx / DFF), j = (int)(idx % DFF);
        const bool smp = r >= T; const int b = r - T;
        float c2[2];
#pragma unroll
        for (int half = 0; half < 2; ++half) {
            const int ch = half * DFF + j;
            float acc = cb[ch];
#pragma unroll
            for (int k = 0; k < 3; ++k) {
                float u;
                if (!smp) { const int t = r + k - 2; u = (t >= 0) ? U[(size_t)t * DFF2 + ch] : 0.f; }
                else u = (k < 2) ? p.st_ffn[(((size_t)b * 2 + layer) * 2 + k) * DFF2 + ch] : U[(size_t)r * DFF2 + ch];
                acc += cw[k * DFF2 + ch] * u;
            }
            c2[half] = acc;
        }
        p.HFFB[idx] = (bf16)f2bf(siluf_(c2[0]) * c2[1]);
    }
    for (size_t idx = gt; idx < (size_t)2 * DFF2; idx += GT) {
        const int k = (int)(idx / DFF2), ch = (int)(idx % DFF2);
        p.out[O_FFN_P + ((size_t)layer * 2 + k) * DFF2 + ch] = U[(size_t)(T - 2 + k) * DFF2 + ch];
    }
    for (size_t idx = gt; idx < (size_t)NSMP * 2 * DFF2; idx += GT) {
        const int b = (int)(idx / (2 * DFF2)), k = (int)((idx / DFF2) % 2), ch = (int)(idx % DFF2);
        p.out[O_FFN_S + (((size_t)b * 2 + layer) * 2 + k) * DFF2 + ch] =
            (k == 0) ? p.st_ffn[(((size_t)b * 2 + layer) * 2 + 1) * DFF2 + ch] : U[(size_t)(T + b) * DFF2 + ch];
    }
}

__device__ __forceinline__ void ph_dil_prep(const KP& p, const Fr& F) {
    const float* H1 = p.BIGF;
    const size_t gt = (size_t)F.bid * NTHR + F.tid, GT = (size_t)F.G * NTHR;
    const size_t total = (size_t)TS * 2048;
    for (size_t idx = gt + (size_t)T * 2048; idx < total; idx += GT) {
        const int r = (int)(idx >> 11), c = (int)(idx & 2047);
        const bool smp = r >= T; const int pos = smp ? T : r;
        const float* row = H1 + (size_t)r * 3072;
        const int i = c & 63; const float2 cs = p.ROPE[pos * 32 + (i & 31)];
        const float v = rope_val(row, c & ~63, i, cs);
        if (c < 1024) p.QD[(size_t)r * 1024 + c] = v; else p.KD[(size_t)r * 1024 + (c - 1024)] = v;
    }
}
__device__ __forceinline__ void ph_dil_cache(const KP& p, const Fr& F) {
    const float* H1 = p.BIGF;
    const size_t gt = (size_t)F.bid * NTHR + F.tid, GT = (size_t)F.G * NTHR;
    const size_t tots4 = (size_t)NSMP * 2048 * 512;
    for (size_t idx = gt; idx < tots4; idx += GT) {
        const int b = (int)(idx / (2048 * 512)); const int i = (int)((idx / 512) % 2048); const int c4 = (int)(idx % 512);
        float4 v;
        if (i < 2047) v = ((const float4*)p.st_dil)[((size_t)b * 2048 + i + 1) * 512 + c4];
        else { const int c = c4 * 4; const int r = T + b;
               v = (c < 1024) ? *(const float4*)(p.KD + (size_t)r * 1024 + c) : *(const float4*)(H1 + (size_t)r * 3072 + 2048 + (c - 1024)); }
        ((float4*)(p.out + O_DIL_S))[idx] = v;
    }
}
__device__ __forceinline__ void ph_dil_attn(const KP& p, const Fr& F) {
    const float* H1 = p.BIGF; const int lane = F.lane;
    float* qs = (float*)(F.lds + F.wave * 4096); float* sc = qs + 64;
    float* ex = (float*)(F.lds + 32768);
    const int il = F.wave / 3, gi = F.wave - 3 * il;
    const int item = F.bid * 2 + il; const int b = item >> 4, h = item & 15, r = T + b;
    if (F.wave < 6 && item < NSMP * 16) {
        qs[lane] = p.QD[(size_t)r * 1024 + h * 64 + lane];
        wave_lds_sync();
        const int dd = gi == 0 ? 1 : (gi == 1 ? 4 : 16);
        auto kf = [&](int j, const float*& kp, const float*& vp) -> bool {
            const int pos = T - j * dd;
            if (pos == T) { kp = p.KD + (size_t)r * 1024 + h * 64; vp = H1 + (size_t)r * 3072 + 2048 + h * 64; return true; }
            const float* base = p.st_dil + ((size_t)b * 2048 + (pos - (T - 2048))) * 2048;
            kp = base + h * 64; vp = base + 1024 + h * 64; return true; };
        float o[1], den[1], mx[1];
        wave_attend<1>(qs, sc, 448, 129, kf, o, den, lane, mx);
        float* e = ex + (il * 3 + gi) * 68;
        e[lane] = o[0] * den[0]; if (lane == 0) { e[64] = mx[0]; e[65] = den[0]; }
    }
    __syncthreads();
    if (F.wave < 6 && gi == 0 && item < NSMP * 16) {
        const float* e = ex + il * 3 * 68;
        const float m0 = e[64], m1 = e[68 + 64], m2 = e[136 + 64]; const float M = fmaxf(m0, fmaxf(m1, m2));
        const float w0 = expf(m0 - M), w1 = expf(m1 - M), w2 = expf(m2 - M);
        const float num = w0 * e[lane] + w1 * e[68 + lane] + w2 * e[136 + lane], dn = w0 * e[65] + w1 * e[68 + 65] + w2 * e[136 + 65];
        p.MIXB[(size_t)r * 1024 + h * 64 + lane] = (bf16)f2bf(num / dn);
    }
}

__device__ __forceinline__ void ph_dil_prep_fast(const KP& p, const Fr& F) {
    const float* H1 = p.BIGF;
    const size_t gt = (size_t)F.bid * NTHR + F.tid, GT = (size_t)F.G * NTHR;
    for (size_t idx = gt; idx < (size_t)T * 128; idx += GT) {
        const int t = (int)(idx >> 7), u = (int)(idx & 127);
        const int hq = u >> 2, d0 = (u & 3) * 8, c0 = hq * 64 + d0; const float* row = H1 + (size_t)t * 3072;
        const float4 a0 = *(const float4*)(row + c0), a1 = *(const float4*)(row + c0 + 4), b0 = *(const float4*)(row + c0 + 32), b1 = *(const float4*)(row + c0 + 36);
        const float4* rp = (const float4*)(p.ROPE + t * 32 + d0); const float4 r0 = rp[0], r1 = rp[1], r2 = rp[2], r3 = rp[3];
        const float x1[8] = {a0.x, a0.y, a0.z, a0.w, a1.x, a1.y, a1.z, a1.w}, x2[8] = {b0.x, b0.y, b0.z, b0.w, b1.x, b1.y, b1.z, b1.w};
        const float cs[8] = {r0.x, r0.z, r1.x, r1.z, r2.x, r2.z, r3.x, r3.z}, sn[8] = {r0.y, r0.w, r1.y, r1.w, r2.y, r2.w, r3.y, r3.w};
        float lo[8], hi[8];
#pragma unroll
        for (int j = 0; j < 8; ++j) { lo[j] = x1[j] * cs[j] - x2[j] * sn[j]; hi[j] = x2[j] * cs[j] + x1[j] * sn[j]; }
        if (hq < 16) {
            v4u o; o.x = pk2(lo[0] * QSCALE, lo[1] * QSCALE); o.y = pk2(lo[2] * QSCALE, lo[3] * QSCALE); o.z = pk2(lo[4] * QSCALE, lo[5] * QSCALE); o.w = pk2(lo[6] * QSCALE, lo[7] * QSCALE);
            *(v4u*)(p.QDB + (size_t)t * 1024 + c0) = o;
            o.x = pk2(hi[0] * QSCALE, hi[1] * QSCALE); o.y = pk2(hi[2] * QSCALE, hi[3] * QSCALE); o.z = pk2(hi[4] * QSCALE, hi[5] * QSCALE); o.w = pk2(hi[6] * QSCALE, hi[7] * QSCALE);
            *(v4u*)(p.QDB + (size_t)t * 1024 + c0 + 32) = o;
        } else {
            const int h = hq - 16, kc = h * 64 + d0;
            v4u ol, oh; ol.x = pk2(lo[0], lo[1]); ol.y = pk2(lo[2], lo[3]); ol.z = pk2(lo[4], lo[5]); ol.w = pk2(lo[6], lo[7]);
            oh.x = pk2(hi[0], hi[1]); oh.y = pk2(hi[2], hi[3]); oh.z = pk2(hi[4], hi[5]); oh.w = pk2(hi[6], hi[7]);
#pragma unroll
            for (int pass = 0; pass < 3; ++pass) { const int sh = 2 * pass; const int pi = (t & ((1 << sh) - 1)) * (T >> sh) + (t >> sh);
                bf16* kb = (pass == 0 ? p.DKF[0] : pass == 1 ? p.DKF[1] : p.DKF[2]) + (size_t)h * T * 64;
                *(v4u*)(kb + kfrag_elem(pi, d0)) = ol; *(v4u*)(kb + kfrag_elem(pi, d0 + 32)) = oh; }
            if (t >= T - 2048) { float* op = p.out + O_DIL_P + (size_t)(t - (T - 2048)) * 2048 + kc;
                *(float4*)op = make_float4(lo[0], lo[1], lo[2], lo[3]); *(float4*)(op + 4) = make_float4(lo[4], lo[5], lo[6], lo[7]);
                *(float4*)(op + 32) = make_float4(hi[0], hi[1], hi[2], hi[3]); *(float4*)(op + 36) = make_float4(hi[4], hi[5], hi[6], hi[7]); }
        }
    }
    for (size_t idx = gt; idx < (size_t)2048 * 256; idx += GT) {
        const int i = (int)(idx >> 8), c4 = (int)(idx & 255);
        *(float4*)(p.out + O_DIL_P + (size_t)i * 2048 + 1024 + c4 * 4) = *(const float4*)(H1 + (size_t)(T - 2048 + i) * 3072 + 2048 + c4 * 4);
    }
    const int lane = F.lane, l15 = lane & 15, grp = lane >> 4;
    for (int unit = F.gw; unit < 3 * 16 * 512; unit += F.NGW) {
        const int st = unit & 511, h = (unit >> 9) & 15, pass = unit >> 13; const int sh = 2 * pass, Td = T >> sh;
        const int pi0 = 32 * st, r = pi0 / Td, s0 = pi0 - r * Td;
        bf16* dst = p.DVF[pass] + (size_t)h * T * 64;
#pragma unroll
        for (int dt = 0; dt < 4; ++dt) {
            float v[8];
#pragma unroll
            for (int j = 0; j < 8; ++j) { const int s = s0 + 16 * (j >> 2) + 4 * grp + (j & 3); const int t = (s << sh) + r;
                v[j] = H1[(size_t)t * 3072 + 2048 + h * 64 + 16 * dt + l15]; }
            v4u o; o.x = pk2(v[0], v[1]); o.y = pk2(v[2], v[3]); o.z = pk2(v[4], v[5]); o.w = pk2(v[6], v[7]);
            *(v4u*)(dst + vfrag_off(st, dt, lane)) = o;
        }
    }
}

__device__ __forceinline__ void dil_pass(const KP& p, int unit, int pass, unsigned char* ldsb, int w4, int lane) {
    asm volatile("" : "+v"(lane));
    const int h = unit & 15, P0 = (unit >> 4) * 256;
    const int l15 = lane & 15, grp = lane >> 4;
    float* stO = (float*)ldsb; float* stML = stO + 256 * 64;
    {
        const int sh = 2 * pass, Td = T >> sh;
        const bf16* KF = (pass == 0 ? p.DKF[0] : pass == 1 ? p.DKF[1] : p.DKF[2]) + (size_t)h * T * 64;
        const bf16* VF = (pass == 0 ? p.DVF[0] : pass == 1 ? p.DVF[1] : p.DVF[2]) + (size_t)h * T * 64;
        for (int tt = 0; tt < 4; ++tt) {
            const int tl = 4 * w4 + tt;
            const int r = tl >> (4 - sh), s0 = (P0 >> sh) + 16 * (tl & ((16 >> sh) - 1));
            const int sq = s0 + l15, tq = (sq << sh) + r, tloc = tq - P0;
            bf16x8 qf[2];
#pragma unroll
            for (int ks = 0; ks < 2; ++ks) qf[ks] = *(const bf16x8*)(p.QDB + (size_t)tq * 1024 + h * 64 + 32 * ks + 8 * grp);
            AttW a;
            if (pass == 0) attw_init(a);
            else {
#pragma unroll
                for (int dt = 0; dt < 4; ++dt) a.o[dt] = *(const f32x4*)(stO + tloc * 64 + 16 * dt + 4 * grp);
                a.m = stML[tloc * 2]; a.l = (grp == 0) ? stML[tloc * 2 + 1] : 0.f;
            }
            int kstart = s0 - 128; if (kstart < 0) kstart = 0; kstart &= ~31;
            const int nsteps = (s0 + 16 - kstart + 31) >> 5;
            const int base = r * Td;
            bf16x8 kf[3][2][2], vf[3][4];
            auto issue = [&](int s, int buf) {
                const int k0 = kstart + 32 * s;
#pragma unroll
                for (int tl2 = 0; tl2 < 2; ++tl2)
#pragma unroll
                    for (int ks = 0; ks < 2; ++ks) kf[buf][tl2][ks] = *(const bf16x8*)(KF + kfrag_off(((base + k0) >> 4) + tl2, ks, lane));
#pragma unroll
                for (int dt = 0; dt < 4; ++dt) vf[buf][dt] = *(const bf16x8*)(VF + vfrag_off((base + k0) >> 5, dt, lane));
            };
            issue(0, 0); if (nsteps > 1) issue(1, 1);
#pragma unroll
            for (int s = 0; s < 5; ++s) {
                if (s < nsteps) {
                    if (s + 2 < nsteps) issue(s + 2, (s + 2) % 3);
                    const int k0 = kstart + 32 * s;
                    f32x4 s0v, s1v; qk_step(kf[s % 3], qf, s0v, s1v);
                    if ((k0 + 31 > s0) || (k0 < s0 + 15 - 128)) {
                        const int pb = k0 + 4 * grp;
#pragma unroll
                        for (int i = 0; i < 4; ++i) { const int p0 = pb + i, p1 = pb + 16 + i;
                            if (p0 > sq || p0 < sq - 128) s0v[i] = -INFINITY; if (p1 > sq || p1 < sq - 128) s1v[i] = -INFINITY; }
                    }
                    att_update(a, s0v, s1v, vf[s % 3]);
                }
            }
            const float lt = grp_sum(a.l);
            if (pass < 2) {
#pragma unroll
                for (int dt = 0; dt < 4; ++dt) *(f32x4*)(stO + tloc * 64 + 16 * dt + 4 * grp) = a.o[dt];
                if (grp == 0) { stML[tloc * 2] = a.m; stML[tloc * 2 + 1] = lt; }
            } else {
                const float il = lt > 0.f ? 1.f / lt : 0.f;
#pragma unroll
                for (int dt = 0; dt < 4; ++dt) { uint2 o; o.x = pk2(a.o[dt][0] * il, a.o[dt][1] * il); o.y = pk2(a.o[dt][2] * il, a.o[dt][3] * il);
                    *(uint2*)(p.MIXB + (size_t)tq * 1024 + h * 64 + 16 * dt + 4 * grp) = o; }
            }
        }
    }
}
__device__ __forceinline__ void ph_dil_combo(const KP& p, const Fr& F) {
    const float* H1 = p.BIGF; const int lane = F.lane;
    const int cw = F.bid * 4 + F.wave;
#pragma unroll 1
    for (int u = 0; u < 4; ++u) {
#pragma unroll
        for (int pass = 0; pass < 3; ++pass) {
            if (F.wave >= 4) dil_pass(p, F.bid + u * F.G, pass, F.lds, F.wave - 4, lane);
            else {
                const int ci = u * 3 + pass;
                const int g0 = ci * 2 + (ci < 8 ? ci : 8), g1 = g0 + 2 + (ci < 8 ? 1 : 0);
                auto srcp = [&](int itn) -> const float4* {
                    const size_t idx = ((size_t)itn * 1024 + cw) * 64 + lane;
                    const int b = (int)(idx >> 20), i = (int)((idx >> 9) & 2047), c4 = (int)(idx & 511);
                    const int c = c4 * 4, r = T + b;
                    const float4* s_old = ((const float4*)p.st_dil) + ((size_t)b * 2048 + (i < 2047 ? i + 1 : 2047)) * 512 + c4;
                    const float4* s_new = (c < 1024) ? (const float4*)(p.KD + (size_t)r * 1024 + c) : (const float4*)(H1 + (size_t)r * 3072 + 2048 + (c - 1024));
                    return (i == 2047) ? s_new : s_old; };
                float4* dstp = (float4*)(p.out + O_DIL_S) + (size_t)cw * 64 + lane;
#pragma unroll 1
                for (int gi = g0; gi < g1; ++gi) {
                    const int i0 = gi * 16;
                    const float4 v0 = *srcp(i0), v1 = *srcp(i0 + 1), v2 = *srcp(i0 + 2), v3 = *srcp(i0 + 3), v4 = *srcp(i0 + 4), v5 = *srcp(i0 + 5), v6 = *srcp(i0 + 6), v7 = *srcp(i0 + 7);
                    const float4 v8 = *srcp(i0 + 8), v9 = *srcp(i0 + 9), v10 = *srcp(i0 + 10), v11 = *srcp(i0 + 11), v12 = *srcp(i0 + 12), v13 = *srcp(i0 + 13), v14 = *srcp(i0 + 14), v15 = *srcp(i0 + 15);
                    float4* d = dstp + (size_t)i0 * 65536;
                    d[0] = v0; d[65536] = v1; d[2 * 65536] = v2; d[3 * 65536] = v3; d[4 * 65536] = v4; d[5 * 65536] = v5; d[6 * 65536] = v6; d[7 * 65536] = v7;
                    d[8 * 65536] = v8; d[9 * 65536] = v9; d[10 * 65536] = v10; d[11 * 65536] = v11; d[12 * 65536] = v12; d[13 * 65536] = v13; d[14 * 65536] = v14; d[15 * 65536] = v15;
                }
            }
            __syncthreads();
        }
    }
}

constexpr int NPHASE = 22;
__global__ void __launch_bounds__(NTHR, 2) mega(KP p) {
    extern __shared__ __attribute__((aligned(16))) unsigned char lds[];
    Fr F; F.lds = lds; F.tid = threadIdx.x; F.lane = 0; F.wave = __builtin_amdgcn_readfirstlane(F.tid >> 6);
    F.bid = blockIdx.x; F.G = gridDim.x; F.gw = F.bid * NWAVES + F.wave; F.NGW = F.G * NWAVES;
    for (int u = F.tid; u < (LDS_BYTES - RING_BYTES) / 4; u += NTHR) ((unsigned*)(lds + RING_BYTES))[u] = 0u;
    __syncthreads();
    XcdBarrier bar; bar.bar = p.ctl + 4096; bar.x = 0; bar.st = nullptr;
    if (!MK_PER_PHASE) bar = xcd_barrier_post(p.ctl + 4096, (volatile LAS unsigned*)(lds + MISC_OFF + 32));
    const int lo = p.ph_lo, hi = p.ph_hi;
#define IN(k) (lo <= (k) && (k) < hi)

    int ph = 0;
#if PROBE_ON
#define PROBE_STAMP(k) do { if (blockIdx.x == 0 && threadIdx.x == 0) ((unsigned long long*)(p.ctl + 65536))[k] = __builtin_amdgcn_s_memrealtime(); } while (0)
#define PROBE_STAMPB(k, blk) do { if (blockIdx.x == (blk) && threadIdx.x == 0) ((unsigned long long*)(p.ctl + 65536))[k] = __builtin_amdgcn_s_memrealtime(); } while (0)
    PROBE_STAMP(0);
#else
#define PROBE_STAMP(k) do { } while (0)
#define PROBE_STAMPB(k, blk) do { } while (0)
#endif
#define PHASE(...) do { { unsigned t_ = threadIdx.x; asm volatile("" : "+v"(t_)); F.lane = (int)(t_ & 63u); } if (IN(ph)) { __VA_ARGS__ } if (IN(ph) && IN(ph + 1)) xcd_barrier(bar); ++ph; PROBE_STAMP(ph); } while (0)
    PHASE(ph_prologue(p, F););
    PHASE(ph_gemm_f32(F, p.ACTB, p.WT_A, PAP, DM, p.BIGF, PA, PA); ph_cmp_samples(p, F););
    PHASE(ph_nsa_prep(p, F); ph_nsa_prep_fast(p, F); ph_gdn_prep(p, F););
    PHASE(ph_gdn_chunks(p, F););
    PHASE(ph_mix_a(p, F););
    PHASE(ph_mix_b(p, F););
    PHASE(ph_gdn_out(p, F););
    PHASE(ph_gemm_f32(F, p.MIXB, p.WT_OA, DM, DM, p.MO, DM, DM););
    PHASE(ph_ln(F, p.x_prompt, p.x_sample, p.MO, p.ln_mix_g, p.ln_mix_b, p.X1, p.X1 + (size_t)T * DM, p.ACTB););
    PHASE(ph_ffn_gemm(p, F, p.WT_FI0, 0););
    PHASE(ph_ffn_fix(p, F, 0););
    PHASE(ph_gemm_f32(F, p.HFFB, p.WT_FO0, DM, DFF, p.MO, DM, DM););
    PHASE(ph_ln(F, p.X1, p.X1 + (size_t)T * DM, p.MO, p.ln_ffn_g, p.ln_ffn_b, p.X2, p.X2 + (size_t)T * DM, p.ACTB););
    PHASE(ph_gemm_f32(F, p.ACTB, p.WT_CI, 3072, DM, p.BIGF, 3072, 3072););
    PHASE(ph_dil_prep(p, F); ph_dil_prep_fast(p, F););
    PHASE(ph_dil_attn(p, F); __syncthreads(); ph_dil_combo(p, F););
    PHASE(ph_gemm_f32(F, p.MIXB, p.WT_CO, DM, DM, p.MO, DM, DM););
    PHASE(ph_ln(F, p.X2, p.X2 + (size_t)T * DM, p.MO, p.ln_mix_g + DM, p.ln_mix_b + DM, p.X3, p.X3 + (size_t)T * DM, p.ACTB););
    PHASE(ph_ffn_gemm(p, F, p.WT_FI1, 1););
    PHASE(ph_ffn_fix(p, F, 1););
    PHASE(ph_gemm_f32(F, p.HFFB, p.WT_FO1, DM, DFF, p.MO, DM, DM););
    PHASE(ph_ln(F, p.X3, p.X3 + (size_t)T * DM, p.MO, p.ln_ffn_g + DM, p.ln_ffn_b + DM, p.out + O_Y_P, p.out + O_Y_S, nullptr););
#undef PHASE
#if PROBE_ON
    xcd_barrier(bar);
    if (blockIdx.x == 0) { __syncthreads(); const unsigned long long* pts = (const unsigned long long*)(p.ctl + 65536); const float x = (float)(pts[PROBE_B] - pts[PROBE_A]) * 1e-5f;
        for (int i = threadIdx.x; i < NSMP * DM; i += NTHR) p.out[O_Y_S + i] *= (1.f + x); }
#endif
#undef IN
}

static inline size_t align_up(size_t x) { return (x + 255) & ~(size_t)255; }

extern "C" void kernel_launch(void* const* d_in, const int* in_sizes, int n_in, void* d_out, int out_size, void* d_ws, size_t ws_size, hipStream_t stream) {
    static int grid = 0;
    if (grid == 0) {
        int dev = 0, cus = 0, per_cu = 0;
        if (hipGetDevice(&dev) != hipSuccess || hipDeviceGetAttribute(&cus, hipDeviceAttributeMultiprocessorCount, dev) != hipSuccess) { fprintf(stderr, "kernel_launch: device query failed\n"); grid = -1; return; }
        if (hipFuncSetAttribute((const void*)mega, hipFuncAttributeMaxDynamicSharedMemorySize, LDS_BYTES) != hipSuccess) { fprintf(stderr, "kernel_launch: hipFuncSetAttribute failed\n"); grid = -1; return; }
        if (hipOccupancyMaxActiveBlocksPerMultiprocessor(&per_cu, (const void*)mega, NTHR, LDS_BYTES) != hipSuccess || per_cu < 1) { fprintf(stderr, "kernel_launch: occupancy query says %d blocks per CU\n", per_cu); }
        (void)hipGetLastError();
        grid = cus;
    }
    if (grid < 0) return;
    if ((size_t)out_size != O_END) fprintf(stderr, "kernel_launch: out_size %d != expected %zu\n", out_size, (size_t)O_END);
    KP p{};
    p.x_prompt = (const float*)d_in[0]; p.x_sample = (const float*)d_in[1]; p.cache_cmp = (const float*)d_in[2]; p.cache_slc = (const float*)d_in[3];
    p.st_win = (const float*)d_in[4]; p.st_gconv = (const float*)d_in[5]; p.st_gS = (const float*)d_in[6]; p.st_dil = (const float*)d_in[7];
    p.st_ffn = (const float*)d_in[8]; p.page_table = (const int*)d_in[9]; p.w_in_a = (const float*)d_in[10]; p.cw1 = (const float*)d_in[11];
    p.cb1 = (const float*)d_in[12]; p.cw2 = (const float*)d_in[13]; p.cpe = (const float*)d_in[14]; p.gconv_w = (const float*)d_in[15];
    p.gA = (const float*)d_in[16]; p.gdt = (const float*)d_in[17]; p.gnw = (const float*)d_in[18]; p.w_out_a = (const float*)d_in[19];
    p.w_in_c = (const float*)d_in[20]; p.w_out_c = (const float*)d_in[21]; p.ln_mix_g = (const float*)d_in[22]; p.ln_mix_b = (const float*)d_in[23];
    p.ffn_w_in = (const float*)d_in[24]; p.ffn_cw = (const float*)d_in[25]; p.ffn_cb = (const float*)d_in[26]; p.ffn_w_out = (const float*)d_in[27];
    p.ln_ffn_g = (const float*)d_in[28]; p.ln_ffn_b = (const float*)d_in[29];
    p.out = (float*)d_out;
    char* ws = (char*)d_ws; size_t off = 0;
    auto alloc = [&](size_t bytes) { void* q = (void*)(ws + off); off = align_up(off + bytes); return q; };
    p.ctl = (unsigned*)alloc(1 << 20);
    p.WT_A = (bf16*)alloc((size_t)PAP * DM * 2); p.WT_OA = (bf16*)alloc((size_t)DM * DM * 2);
    p.WT_FI0 = (bf16*)alloc((size_t)DFF2 * DM * 2); p.WT_FI1 = (bf16*)alloc((size_t)DFF2 * DM * 2);
    p.WT_FO0 = (bf16*)alloc((size_t)DM * DFF * 2); p.WT_FO1 = (bf16*)alloc((size_t)DM * DFF * 2);
    p.WT_CI = (bf16*)alloc((size_t)3072 * DM * 2); p.WT_CO = (bf16*)alloc((size_t)DM * DM * 2);
    p.ROPE = (float2*)alloc((size_t)(T + 1) * 32 * 8);
    p.ACTB = (bf16*)alloc((size_t)TSP * DM * 2); p.MIXB = (bf16*)alloc((size_t)TSP * DM * 2); p.HFFB = (bf16*)alloc((size_t)TSP * DFF * 2);
    p.KS8 = (unsigned char*)alloc((size_t)2 * T * 64); p.VS8 = (unsigned char*)alloc((size_t)2 * T * 64);
    p.QB = (bf16*)alloc((size_t)T * 512 * 2); p.KSF = (bf16*)alloc((size_t)2 * T * 64 * 2); p.VSF = (bf16*)alloc((size_t)2 * T * 64 * 2);
    p.KWF = (bf16*)alloc((size_t)2 * T * 64 * 2); p.VWF = (bf16*)alloc((size_t)2 * T * 64 * 2); p.CKF = (bf16*)alloc((size_t)2 * 512 * 64 * 2); p.CVF = (bf16*)alloc((size_t)2 * 512 * 64 * 2);
    p.ACP = (bf16*)alloc((size_t)2048 * 2048 * 2);
    p.W2T = (bf16*)alloc((size_t)2 * 64 * 128 * 2);
    p.AC = nullptr; p.WT_C = (bf16*)alloc((size_t)256 * 2048 * 2); p.HID = nullptr; p.SMIXF = (float*)alloc((size_t)NSMP * 3 * 512 * 4);
    p.UB = (float*)alloc((size_t)256 * 4 * DFF2 * 4);
    p.NSACC = (float*)alloc((size_t)T * 512 * 4); p.SEL = (int*)alloc((size_t)2 * T * 16 * 4);
    p.QDB = (bf16*)alloc((size_t)T * 1024 * 2);
    for (int i = 0; i < 3; ++i) { p.DKF[i] = (bf16*)alloc((size_t)T * 1024 * 2); p.DVF[i] = (bf16*)alloc((size_t)T * 1024 * 2); }
    p.G_WF = (bf16*)alloc((size_t)2048 * 4096 * 2); p.G_KDF = (bf16*)alloc((size_t)2048 * 4096 * 2); p.G_QGF = (bf16*)alloc((size_t)2048 * 4096 * 2); p.G_QKF = (bf16*)alloc((size_t)2048 * 4096 * 2);
    p.G_SPF = (bf16*)alloc((size_t)2048 * 4096 * 2); p.G_VNF = (bf16*)alloc((size_t)2048 * 4096 * 2); p.G_UF = (float*)alloc((size_t)2048 * 4096 * 4); p.G_GL = (float*)alloc((size_t)2048 * 4);
    p.BIGF = (float*)alloc((size_t)TSP * DFF2 * 4); p.MO = (float*)alloc((size_t)TSP * DM * 4);
    p.X1 = (float*)alloc((size_t)TS * DM * 4); p.X2 = (float*)alloc((size_t)TS * DM * 4); p.X3 = (float*)alloc((size_t)TS * DM * 4);
    p.QR = (float*)alloc((size_t)TS * 512 * 4);
    p.KS = (float*)alloc((size_t)TS * 128 * 4); p.VS = (float*)alloc((size_t)TS * 128 * 4); p.KW = (float*)alloc((size_t)TS * 128 * 4); p.VW = (float*)alloc((size_t)TS * 128 * 4);
    p.CK = (float*)alloc((size_t)33 * 512 * 128 * 4); p.CV = (float*)alloc((size_t)33 * 512 * 128 * 4);
    p.GQ = (float*)alloc((size_t)TS * 512 * 4); p.GK = (float*)alloc((size_t)TS * 512 * 4); p.GV = (float*)alloc((size_t)TS * 512 * 4); p.OG = (float*)alloc((size_t)TS * 512 * 4);
    p.Gg = (float*)alloc((size_t)TS * 8 * 4); p.Gb = (float*)alloc((size_t)TS * 8 * 4);
    p.QD = (float*)alloc((size_t)TS * DM * 4); p.KD = (float*)alloc((size_t)TS * DM * 4);
    if (off > ws_size) { fprintf(stderr, "kernel_launch: workspace too small: need %zu have %zu\n", off, ws_size); return; }
    if (hipMemsetAsync(p.ctl, 0, 1 << 20, stream) != hipSuccess) { fprintf(stderr, "kernel_launch: memset failed\n"); return; }
#if MK_PER_PHASE
    for (int k = 0; k < NPHASE; ++k) { p.ph_lo = k; p.ph_hi = k + 1; hipLaunchKernelGGL(mega, dim3(grid), dim3(NTHR), LDS_BYTES, stream, p); }
#else
    p.ph_lo = 0; p.ph_hi = NPHASE;
    hipLaunchKernelGGL(mega, dim3(grid), dim3(NTHR), LDS_BYTES, stream, p);
#endif
    const hipError_t le = hipPeekAtLastError();
    if (le != hipSuccess) fprintf(stderr, "kernel_launch: launch failed: %s\n", hipGetErrorName(le));
}
```

```cpp
#include <hip/hip_runtime.h>
#include <cstdint>
#include <cstdio>
#include <cmath>

namespace pg8 {
#define PG8_LAS __attribute__((address_space(3)))
typedef unsigned short bf16_t;
typedef short bf16x8 __attribute__((ext_vector_type(8)));
typedef float f32x4 __attribute__((ext_vector_type(4)));
typedef unsigned u32x4 __attribute__((ext_vector_type(4)));
constexpr int BM = 256, BK = 64, HALF = 128, HTB = HALF * BK * 2  , STAGE_BYTES = 8 * HTB, NXCD = 8, WGM = 8;

__host__ __device__ __forceinline__ int lds_byte(int r, int c) { const int st = (r >> 4) * 2 + (c >> 5), rr = r & 15, cc = c & 31, ob = rr * 64 + cc * 2; return st * 1024 + (ob ^ (((ob >> 9) & 1) << 5)); }
__host__ __device__ __forceinline__ void stage_rc(int b, int& R, int& C) { const int st = b / 1024, sb = b % 1024, swz = sb ^ (((sb >> 9) & 1) << 5); R = (st >> 1) * 16 + swz / 64; C = (st & 1) * 32 + (swz % 64) / 2; }
__host__ __device__ __forceinline__ int perm32(int rho) { const int n = rho >> 4, i = rho & 15; return 8 * (i >> 2) + 4 * n + (i & 3); }

struct Unit { int pm, pn; };
struct Gemm { const bf16_t* A; const bf16_t* Bt; int M, N, K; };

struct StaticOrder {
    int nM, nN, nwg, G, c;
    __host__ __device__ void init(int M, int N, int G_, int c_) { nM = M / BM; nN = N / BM; nwg = nM * nN; G = G_; c = c_; }
    __host__ __device__ bool next(int i, Unit& u) const {
        const long L = (long)i * G + c; if (L >= nwg) return false;
        int wgid = (int)L; { const int q = nwg / NXCD, r = nwg % NXCD, xcd = wgid % NXCD, off = wgid / NXCD; wgid = (xcd < r ? xcd * (q + 1) : r * (q + 1) + (xcd - r) * q) + off; }
        const int nig = WGM * nN, gid = wgid / nig, fm = gid * WGM, gsz = (nM - fm) < WGM ? (nM - fm) : WGM;
        u.pm = fm + ((wgid % nig) % gsz); u.pn = (wgid % nig) / gsz; return true;
    }
    __device__ __forceinline__ void a_ready(const Unit&) const {}
    __device__ __forceinline__ void done(const Unit&) const {}
};

typedef __bf16 bf16x2_t __attribute__((ext_vector_type(2)));
typedef float f32x2_t __attribute__((ext_vector_type(2)));
__device__ __forceinline__ unsigned cvt_pk_bf16(float lo, float hi) { const f32x2_t v = {lo, hi}; return __builtin_bit_cast(unsigned, __builtin_convertvector(v, bf16x2_t)); }
typedef float f32x2 __attribute__((ext_vector_type(2)));
__device__ __forceinline__ f32x2 gelu_pk(f32x2 v) {
    const f32x2 av = __builtin_elementwise_abs(v), d = av * 0.2316418882f + 1.0f;
    f32x2 t; t.x = __builtin_amdgcn_rcpf(d.x); t.y = __builtin_amdgcn_rcpf(d.y);
    f32x2 q = t * 0.5307027145f + (-0.7265760135f); q = q * t + 0.7107068705f; q = q * t + (-0.142248368f); q = q * t + 0.127414796f; q = q * t;
    const f32x2 s = (v * v) * (-0.72134752044f);
    f32x2 e; e.x = __builtin_amdgcn_exp2f(s.x); e.y = __builtin_amdgcn_exp2f(s.y);
    const f32x2 m = v * (q * e), r = v - m;
    f32x2 o; o.x = v.x < 0.f ? m.x : r.x; o.y = v.y < 0.f ? m.y : r.y; return o;
}

template <int ACT  > struct EpiBf16 {
    static constexpr bool PERM = true, AFTER_DRAIN = false; static_assert(ACT == 0 || ACT == 1, "EpiBf16: ACT is 0 (none) or 1 (gelu_pk)");
    bf16_t* O; int ldc; const float* bias; int split_cols; size_t split_stride; float scale0;
    __device__ __forceinline__ void operator()(const f32x4 (&acc)[2][2][4][2], const Unit& u, int wr, int wc, int fr, int fq) const {
        const int row0 = u.pm * BM + wr * 64 + fr; int colt = u.pn * BM; bf16_t* base = O;
        float sc = 1.f; if (split_cols) { const int t = colt / split_cols; base += (size_t)t * split_stride; colt -= t * split_cols; if (t == 0) sc = scale0; }
        const int col0 = colt + wc * 32 + 8 * fq, bcol0 = u.pn * BM + wc * 32 + 8 * fq;
        f32x4 bv[2][2];
#pragma unroll
        for (int bj = 0; bj < 2; ++bj)
#pragma unroll
            for (int n = 0; n < 2; ++n) bv[bj][n] = bias ? *(const f32x4*)(bias + bcol0 + bj * HALF + 4 * n) : (f32x4){0.f, 0.f, 0.f, 0.f};
#pragma unroll
        for (int ai = 0; ai < 2; ++ai)
#pragma unroll
            for (int m = 0; m < 4; ++m) { bf16_t* rowp = base + (size_t)(row0 + ai * HALF + m * 16) * ldc + col0;
#pragma unroll
                for (int bj = 0; bj < 2; ++bj) { f32x4 v0 = acc[ai][bj][m][0] + bv[bj][0], v1 = acc[ai][bj][m][1] + bv[bj][1];
                    if (ACT == 1) { f32x2 a = gelu_pk((f32x2){v0[0], v0[1]}), b = gelu_pk((f32x2){v0[2], v0[3]}), c = gelu_pk((f32x2){v1[0], v1[1]}), d = gelu_pk((f32x2){v1[2], v1[3]});
                        v0 = (f32x4){a.x, a.y, b.x, b.y}; v1 = (f32x4){c.x, c.y, d.x, d.y}; }
                    v0 = v0 * sc; v1 = v1 * sc; u32x4 w; w.x = cvt_pk_bf16(v0[0], v0[1]); w.y = cvt_pk_bf16(v0[2], v0[3]); w.z = cvt_pk_bf16(v1[0], v1[1]); w.w = cvt_pk_bf16(v1[2], v1[3]);
                    *(u32x4*)(rowp + bj * HALF) = w; } }
    }
};

struct EpiF32 {
    static constexpr bool PERM = false, AFTER_DRAIN = false;
    float* O; int ldc; int ncols;
    __device__ __forceinline__ void operator()(const f32x4 (&acc)[2][2][4][2], const Unit& u, int wr, int wc, int fr, int fq) const {
        const int row0 = u.pm * BM + wr * 64 + fr; const int col0 = u.pn * BM + wc * 32 + 4 * fq;
#pragma unroll
        for (int ai = 0; ai < 2; ++ai)
#pragma unroll
            for (int m = 0; m < 4; ++m) { float* rowp = O + (size_t)(row0 + ai * HALF + m * 16) * ldc;
#pragma unroll
                for (int bj = 0; bj < 2; ++bj)
#pragma unroll
                    for (int n = 0; n < 2; ++n) { const int c = col0 + bj * HALF + n * 16; if (c < ncols) *(f32x4*)(rowp + c) = acc[ai][bj][m][n]; } }
    }
};
template <class Epi, class Sched, bool ALIGN_EPI = false, bool SP2 = false>
__device__ __forceinline__ void gemm_phase(PG8_LAS unsigned char* lds, const Gemm g, const Sched& S, const Epi& E) {
    const int tid = threadIdx.x, wid = __builtin_amdgcn_readfirstlane(tid >> 6), lane = tid & 63, wr = wid >> 2, wc = wid & 3, fr = lane & 15, fq = lane >> 4;
    const int K = g.K, nt = K / BK;
    unsigned voffA[2], voffB[2];
#pragma unroll
    for (int i = 0; i < 2; ++i) { int R, C; stage_rc(tid * 16 + i * 8192, R, C); const int Rb = Epi::PERM ? ((R & ~31) + perm32(R & 31)) : R;
        voffA[i] = (unsigned)(R * K + C) * 2u; voffB[i] = (unsigned)(Rb * K + C) * 2u; }
    const size_t kstep = (size_t)(BK * 2);
    const size_t hstep = (size_t)HALF * K * 2;
    const size_t tstep = 2 * hstep;
    const unsigned ldsw = (unsigned)wid * 1024u;
    const int aoff = lds_byte(wr * 64 + fr, fq * 8), boff = lds_byte(wc * 32 + fr, fq * 8);
#define PG8_SA(b, h) (((b) * 2 + (h)) * HTB)
#define PG8_SB(b, h) ((4 + (b) * 2 + (h)) * HTB)
#define PG8_STAGE(bufoff, gbase, voff) do { _Pragma("unroll") for (int _i = 0; _i < 2; ++_i) \
        __builtin_amdgcn_global_load_lds((const unsigned*)((const char*)(gbase) + (voff)[_i]), (PG8_LAS unsigned*)(lds + (bufoff) + ldsw + _i * 8192), 16, 0, 0); } while (0)
#define PG8_LDA(dst, b, h) do { _Pragma("unroll") for (int m = 0; m < 4; ++m) _Pragma("unroll") for (int k = 0; k < 2; ++k) dst[m][k] = *(const PG8_LAS bf16x8*)(lds + PG8_SA(b, h) + aoff + m * 2048 + k * 1024); } while (0)
#define PG8_LDB(dst, b, h) do { _Pragma("unroll") for (int n = 0; n < 2; ++n) _Pragma("unroll") for (int k = 0; k < 2; ++k) dst[n][k] = *(const PG8_LAS bf16x8*)(lds + PG8_SB(b, h) + boff + n * 2048 + k * 1024); } while (0)
#define PG8_MMA(ai, bj, At, Bt) do { __builtin_amdgcn_s_setprio(1); _Pragma("unroll") for (int m = 0; m < 4; ++m) _Pragma("unroll") for (int n = 0; n < 2; ++n) _Pragma("unroll") for (int k = 0; k < 2; ++k) \
        acc[ai][bj][m][n] = __builtin_amdgcn_mfma_f32_16x16x32_bf16(Bt[n][k], At[m][k], acc[ai][bj][m][n], 0, 0, 0); __builtin_amdgcn_s_setprio(0); } while (0)
#define PG8_WAIT_V(n) asm volatile("s_waitcnt vmcnt(" #n ")" ::: "memory")
#define PG8_WAIT_L(n) asm volatile("s_waitcnt lgkmcnt(" #n ")" ::: "memory")
#define PG8_BAR __builtin_amdgcn_s_barrier()
#define PG8_SCHED __builtin_amdgcn_sched_barrier(0)
    Unit cur, nxt; int ui = 0;
    if (!S.next(0, cur)) return;
    f32x4 acc[2][2][4][2];
#pragma unroll
    for (int a = 0; a < 2; ++a)
#pragma unroll
        for (int b = 0; b < 2; ++b)
#pragma unroll
            for (int m = 0; m < 4; ++m)
#pragma unroll
                for (int n = 0; n < 2; ++n) acc[a][b][m][n] = (f32x4){0.f, 0.f, 0.f, 0.f};
    bf16x8 At[4][2], B0[2][2], B1[2][2];
    const char* cA = (const char*)g.A + (size_t)cur.pm * tstep; const char* cB = (const char*)g.Bt + (size_t)cur.pn * tstep;
    S.a_ready(cur);
    if constexpr (SP2) {
        PG8_STAGE(PG8_SB(0, 0), cB, voffB); PG8_STAGE(PG8_SB(0, 1), cB + hstep, voffB); PG8_STAGE(PG8_SA(0, 0), cA, voffA); PG8_STAGE(PG8_SA(0, 1), cA + hstep, voffA);
        if (wr == 1) PG8_BAR;
        PG8_WAIT_V(2); PG8_BAR;
        PG8_STAGE(PG8_SB(1, 0), cB + kstep, voffB); PG8_STAGE(PG8_SA(1, 0), cA + kstep, voffA); PG8_STAGE(PG8_SB(1, 1), cB + hstep + kstep, voffB);
        PG8_WAIT_V(6); PG8_BAR;
    } else {
        PG8_STAGE(PG8_SB(0, 0), cB, voffB); PG8_STAGE(PG8_SA(0, 0), cA, voffA); PG8_STAGE(PG8_SB(0, 1), cB + hstep, voffB); PG8_STAGE(PG8_SA(0, 1), cA + hstep, voffA);
        if (wr == 1) PG8_BAR;
        PG8_WAIT_V(4); PG8_BAR;
        PG8_STAGE(PG8_SB(1, 0), cB + kstep, voffB); PG8_STAGE(PG8_SA(1, 0), cA + kstep, voffA); PG8_STAGE(PG8_SB(1, 1), cB + hstep + kstep, voffB);
        PG8_WAIT_V(6); PG8_BAR;
    }
    for (;;) {
        const bool has_next = S.next(ui + 1, nxt);
        const char* nA = has_next ? (const char*)g.A + (size_t)nxt.pm * tstep : cA; const char* nB = has_next ? (const char*)g.Bt + (size_t)nxt.pn * tstep : cB;
        for (int t = 0; t < nt; t += 2) {
            const bool last = (t == nt - 2);
            const char* a1 = cA + (size_t)(t + 1) * kstep;
            const char* a2 = last ? nA : cA + (size_t)(t + 2) * kstep; const char* b2 = last ? nB : cB + (size_t)(t + 2) * kstep;
            const char* a3 = a2 + kstep; const char* b3 = b2 + kstep;
            if (last && has_next) S.a_ready(nxt);
            if constexpr (SP2) {
            PG8_LDB(B0, 0, 0); PG8_LDB(B1, 0, 1); PG8_SCHED; PG8_LDA(At, 0, 0); PG8_STAGE(PG8_SA(1, 1), a1 + hstep, voffA);
            PG8_WAIT_V(8); PG8_WAIT_L(0); PG8_BAR; PG8_MMA(0, 0, At, B0); PG8_MMA(0, 1, At, B1); PG8_BAR; PG8_SCHED;
            PG8_LDA(At, 0, 1); PG8_STAGE(PG8_SB(0, 0), b2, voffB); PG8_STAGE(PG8_SB(0, 1), b2 + hstep, voffB); PG8_STAGE(PG8_SA(0, 0), a2, voffA);
            PG8_WAIT_V(8); PG8_WAIT_L(0); PG8_BAR; PG8_MMA(1, 0, At, B0); PG8_MMA(1, 1, At, B1); PG8_BAR; PG8_SCHED;
            PG8_LDB(B0, 1, 0); PG8_LDB(B1, 1, 1); PG8_SCHED; PG8_LDA(At, 1, 0); PG8_STAGE(PG8_SA(0, 1), a2 + hstep, voffA);
            PG8_WAIT_V(8); PG8_WAIT_L(0); PG8_BAR; PG8_MMA(0, 0, At, B0); PG8_MMA(0, 1, At, B1); PG8_BAR; PG8_SCHED;
            PG8_LDA(At, 1, 1); PG8_STAGE(PG8_SB(1, 0), b3, voffB); PG8_STAGE(PG8_SB(1, 1), b3 + hstep, voffB); PG8_STAGE(PG8_SA(1, 0), a3, voffA);
            PG8_WAIT_V(8); PG8_WAIT_L(0); PG8_BAR; PG8_MMA(1, 0, At, B0); PG8_MMA(1, 1, At, B1); PG8_BAR; PG8_SCHED;
            } else {
            PG8_LDB(B0, 0, 0); PG8_SCHED; PG8_LDA(At, 0, 0); PG8_STAGE(PG8_SA(1, 1), a1 + hstep, voffA);
            PG8_WAIT_L(8); PG8_BAR; PG8_WAIT_L(0); PG8_MMA(0, 0, At, B0); PG8_BAR; PG8_SCHED;
            PG8_LDB(B1, 0, 1); PG8_STAGE(PG8_SB(0, 0), b2, voffB);
            PG8_BAR; PG8_WAIT_L(0); PG8_MMA(0, 1, At, B1); PG8_BAR;
            PG8_LDA(At, 0, 1); PG8_STAGE(PG8_SA(0, 0), a2, voffA);
            PG8_BAR; PG8_WAIT_L(0); PG8_MMA(1, 0, At, B0); PG8_BAR; PG8_SCHED;
            PG8_STAGE(PG8_SB(0, 1), b2 + hstep, voffB);
            PG8_WAIT_V(6); PG8_BAR; PG8_MMA(1, 1, At, B1); PG8_BAR;
            PG8_LDB(B0, 1, 0); PG8_SCHED; PG8_LDA(At, 1, 0); PG8_STAGE(PG8_SA(0, 1), a2 + hstep, voffA);
            PG8_WAIT_L(8); PG8_BAR; PG8_WAIT_L(0); PG8_MMA(0, 0, At, B0); PG8_BAR; PG8_SCHED;
            PG8_LDB(B1, 1, 1); PG8_STAGE(PG8_SB(1, 0), b3, voffB);
            PG8_BAR; PG8_WAIT_L(0); PG8_MMA(0, 1, At, B1); PG8_BAR;
            PG8_LDA(At, 1, 1); PG8_STAGE(PG8_SA(1, 0), a3, voffA);
            PG8_BAR; PG8_WAIT_L(0); PG8_MMA(1, 0, At, B0); PG8_BAR; PG8_SCHED;
            PG8_STAGE(PG8_SB(1, 1), b3 + hstep, voffB);
            PG8_WAIT_V(6); PG8_BAR; PG8_MMA(1, 1, At, B1); PG8_BAR;
            }
        }
        if constexpr (ALIGN_EPI) { if (wr == 0) PG8_BAR; }
        if constexpr (!Epi::AFTER_DRAIN) { E(acc, cur, wr, wc, fr, fq); S.done(cur); }
        if (!has_next) break;
#pragma unroll
        for (int a = 0; a < 2; ++a)
#pragma unroll
            for (int b = 0; b < 2; ++b)
#pragma unroll
                for (int m = 0; m < 4; ++m)
#pragma unroll
                    for (int n = 0; n < 2; ++n) acc[a][b][m][n] = (f32x4){0.f, 0.f, 0.f, 0.f};
        cur = nxt; cA = nA; cB = nB; ++ui;
        if constexpr (ALIGN_EPI) { if (wr == 1) PG8_BAR; }
    }
    PG8_WAIT_V(0);
    if constexpr (!ALIGN_EPI) { if (wr == 0) PG8_BAR; }
    PG8_BAR;
    if constexpr (Epi::AFTER_DRAIN) { E.fused(acc, cur, wr, wc, fr, fq, lds, wid, lane); S.done(cur); }
#undef PG8_SA
#undef PG8_SB
#undef PG8_STAGE
#undef PG8_LDA
#undef PG8_LDB
#undef PG8_MMA
#undef PG8_WAIT_V
#undef PG8_WAIT_L
#undef PG8_BAR
#undef PG8_SCHED
}
}

#define LAS __attribute__((address_space(3)))
#define XB_TMO      128
#define XB_XCNT(j)  (256  + 64 * (j))
#define XB_XSUB(j)  (1280 + 64 * (j))
#define XB_XGEN(j)  (2304 + 64 * (j))
#define XB_TOP      3328
#define XB_TOPGEN   3392
#define XCD_BAR_WORDS 3456
#define XB_SPIN_CAP (1u << 26)

__device__ __forceinline__ unsigned xb_ld(unsigned* p)              { return __hip_atomic_load(p, __ATOMIC_RELAXED, __HIP_MEMORY_SCOPE_AGENT); }
__device__ __forceinline__ unsigned xb_add(unsigned* p, unsigned v) { return __hip_atomic_fetch_add(p, v, __ATOMIC_RELAXED, __HIP_MEMORY_SCOPE_AGENT); }
__device__ __forceinline__ unsigned xb_xcc_id() { return (unsigned)__builtin_amdgcn_s_getreg((3 << 11) | 20) & 0xFu; }
#define XB_SPIN(cond, bar) do { unsigned _sp = 0; while (cond) { __builtin_amdgcn_s_sleep(1); \
    if ((++_sp & 255u) == 0u) { if (xb_ld(&(bar)[XB_TMO])) break; if (_sp > XB_SPIN_CAP) { atomicAdd(&(bar)[XB_TMO], 1u); break; } } } } while (0)

struct XcdBarrier {
    unsigned* bar; unsigned x;
    volatile LAS unsigned* st;
};

__device__ __forceinline__ XcdBarrier xcd_barrier_post(unsigned* bar, volatile LAS unsigned* st) {
    XcdBarrier b; b.bar = bar; b.x = xb_xcc_id(); b.st = st;
    if (threadIdx.x == 0) (void)xb_add(&bar[XB_XCNT(b.x)], 1u);
    return b;
}
__device__ __forceinline__ void xcd_barrier_complete(unsigned* bar, unsigned x, unsigned& nloc, unsigned& nx) {
    const unsigned G = gridDim.x * gridDim.y * gridDim.z;
    unsigned sum, cnt, mine, sp = 0u;
    for (;;) {
        sum = 0u; cnt = 0u; mine = 0u;
#pragma unroll
        for (unsigned j = 0; j < 16; ++j) { const unsigned c = xb_ld(&bar[XB_XCNT(j)]); sum += c; cnt += (c > 0u) ? 1u : 0u; mine = (j == x) ? c : mine; }
        if (sum == G) break;
        __builtin_amdgcn_s_sleep(1);
        if ((++sp & 255u) == 0u) { if (xb_ld(&bar[XB_TMO])) break; if (sp > XB_SPIN_CAP) { atomicAdd(&bar[XB_TMO], 1u); break; } }
    }
    nloc = mine > 0u ? mine : 1u; nx = cnt > 0u ? cnt : 1u;
}

__device__ __forceinline__ void xcd_barrier(const XcdBarrier& b) {
    asm volatile("s_waitcnt vmcnt(0)" ::: "memory");
    __syncthreads();
    if (threadIdx.x == 0) {
        unsigned* bar = b.bar;
        __builtin_amdgcn_s_waitcnt(0);
        unsigned nloc = b.st[0], nx = b.st[1];
        if (nloc == 0u) { xcd_barrier_complete(bar, b.x, nloc, nx); b.st[0] = nloc; b.st[1] = nx; }
        const unsigned old = xb_add(&bar[XB_XSUB(b.x)], 1u);
        const unsigned gen = old / nloc;
        if (old + 1u == (gen + 1u) * nloc) {
            __builtin_amdgcn_fence(__ATOMIC_RELEASE, "agent");
            asm volatile("s_waitcnt vmcnt(0)" ::: "memory");
            const unsigned og = xb_add(&bar[XB_TOP], 1u);
            const unsigned tg = og / nx;
            if (og + 1u == (tg + 1u) * nx) xb_add(&bar[XB_TOPGEN], 1u);
            else XB_SPIN(xb_ld(&bar[XB_TOPGEN]) == tg, bar);
            __builtin_amdgcn_fence(__ATOMIC_ACQUIRE, "agent");
            xb_add(&bar[XB_XGEN(b.x)], 1u);
            asm volatile("s_waitcnt vmcnt(0)" ::: "memory");
        } else {
            XB_SPIN(xb_ld(&bar[XB_XGEN(b.x)]) == gen, bar);
            __builtin_amdgcn_fence(__ATOMIC_ACQUIRE, "agent");
            asm volatile("s_waitcnt vmcnt(0)" ::: "memory");
        }
    }
    __syncthreads();
}

#ifndef PG8_SP2
#define PG8_SP2 true
#endif
#ifndef PG8_ALIGN
#define PG8_ALIGN true
#endif
#ifndef PROBE_ON
#define PROBE_ON 0
#define PROBE_A 0
#define PROBE_B 1
#endif
#ifndef MK_PER_PHASE
#define MK_PER_PHASE 0
#endif

constexpr int T = 16384, NSMP = 32, TS = T + NSMP, TSP = T + 256, DM = 1024;
constexpr int PA = 3368, PAP = 3584;
constexpr int C_Q = 0, C_KC = 512, C_VC = 640, C_KS = 768, C_VS = 896, C_KW = 1024, C_VW = 1152, C_GATE = 1280,
              C_GQKV = 1304, C_A = 2840, C_BT = 2848, C_Z = 2856;
constexpr int DFF = 2816, DFF2 = 5632;
constexpr float DN_ALPHA = 1.4142135623730951f;
constexpr float LN_EPS = 1e-5f, NORM_EPS = 1e-6f;
constexpr int NPAGES = 128;
constexpr int NWAVES = 8, NTHR = 512;

constexpr size_t O_Y_P = 0;
constexpr size_t O_Y_S = O_Y_P + (size_t)T * DM;
constexpr size_t O_CMP_P = O_Y_S + (size_t)NSMP * DM;
constexpr size_t O_CMP_S = O_CMP_P + (size_t)T * 256;
constexpr size_t O_SLC_P = O_CMP_S + (size_t)NSMP * 256;
constexpr size_t O_SLC_S = O_SLC_P + (size_t)T * 256;
constexpr size_t O_WIN_P = O_SLC_S + (size_t)NSMP * 256;
constexpr size_t O_WIN_S = O_WIN_P + (size_t)512 * 256;
constexpr size_t O_GCONV_P = O_WIN_S + (size_t)NSMP * 512 * 256;
constexpr size_t O_GCONV_S = O_GCONV_P + (size_t)3 * 1536;
constexpr size_t O_GS_P = O_GCONV_S + (size_t)NSMP * 3 * 1536;
constexpr size_t O_GS_S = O_GS_P + (size_t)8 * 64 * 64;
constexpr size_t O_DIL_P = O_GS_S + (size_t)NSMP * 8 * 64 * 64;
constexpr size_t O_DIL_S = O_DIL_P + (size_t)2048 * 2048;
constexpr size_t O_FFN_P = O_DIL_S + (size_t)NSMP * 2048 * 2048;
constexpr size_t O_FFN_S = O_FFN_P + (size_t)2 * 2 * DFF2;
constexpr size_t O_END = O_FFN_S + (size_t)NSMP * 2 * 2 * DFF2;

constexpr int RING_BYTES = 131072;
constexpr int FAST_WL = 17408;
constexpr int MISC_OFF = 8 * FAST_WL + 64;
constexpr int LDS_BYTES = 147456;

typedef unsigned short bf16;
typedef unsigned v4u __attribute__((ext_vector_type(4)));

__device__ __forceinline__ unsigned f2bf(float f) { return (unsigned)__builtin_bit_cast(unsigned short, (__bf16)f); }
__device__ __forceinline__ unsigned pk2(float lo, float hi) { return pg8::cvt_pk_bf16(lo, hi); }
typedef short bf16x8 __attribute__((ext_vector_type(8)));
typedef float f32x4 __attribute__((ext_vector_type(4)));
#define MFMA16(a, b, c) __builtin_amdgcn_mfma_f32_16x16x32_bf16((a), (b), (c), 0, 0, 0)
__device__ __forceinline__ float wave_sum(float v) {
#pragma unroll
    for (int o = 1; o < 64; o <<= 1) v += __shfl_xor(v, o);
    return v;
}
__device__ __forceinline__ float wave_max(float v) {
#pragma unroll
    for (int o = 1; o < 64; o <<= 1) v = fmaxf(v, __shfl_xor(v, o));
    return v;
}
__device__ __forceinline__ void wave_lds_sync() { asm volatile("s_waitcnt lgkmcnt(0)" ::: "memory"); __builtin_amdgcn_wave_barrier(); asm volatile("" ::: "memory"); }
__device__ __forceinline__ float fexp_(float x) { return __builtin_amdgcn_exp2f(x * 1.4426950408889634f); }
__device__ __forceinline__ float fsilu_(float x) { return x * __builtin_amdgcn_rcpf(1.f + fexp_(-x)); }
__device__ __forceinline__ float sigmoidf_(float x) { return 1.f / (1.f + expf(-x)); }
__device__ __forceinline__ float siluf_(float x) { return x / (1.f + expf(-x)); }
__device__ __forceinline__ float gelu_tanh(float x) { const float c = 0.7978845608028654f; return 0.5f * x * (1.f + tanhf(c * (x + 0.044715f * x * x * x))); }
__device__ __forceinline__ float softplusf_(float x) { return x > 20.f ? x : log1pf(expf(x)); }

struct KP {
    const float *x_prompt, *x_sample, *cache_cmp, *cache_slc, *st_win, *st_gconv, *st_gS, *st_dil, *st_ffn;
    const int* page_table;
    const float *w_in_a, *cw1, *cb1, *cw2, *cpe, *gconv_w, *gA, *gdt, *gnw, *w_out_a, *w_in_c, *w_out_c, *ln_mix_g, *ln_mix_b,
                *ffn_w_in, *ffn_cw, *ffn_cb, *ffn_w_out, *ln_ffn_g, *ln_ffn_b;
    float* out;
    unsigned* ctl;
    bf16 *WT_A, *WT_OA, *WT_FI0, *WT_FI1, *WT_FO0, *WT_FO1, *WT_CI, *WT_CO;
    float2* ROPE;
    bf16 *ACTB, *MIXB, *HFFB;
    bf16 *QB, *KSF, *VSF, *KWF, *VWF, *CKF, *CVF;
    unsigned char *KS8, *VS8;
    bf16 *QDB; bf16* DKF[3]; bf16* DVF[3];
    bf16 *AC, *WT_C, *HID, *W2T, *ACP; float* SMIXF; float* NSACC; int* SEL; float* UB;
    bf16 *G_WF, *G_KDF, *G_QGF, *G_QKF, *G_SPF, *G_VNF; float *G_UF, *G_GL;
    float *BIGF, *MO, *X1, *X2, *X3, *QR, *KS, *VS, *KW, *VW, *CK, *CV, *GQ, *GK, *GV, *OG, *Gg, *Gb, *QD, *KD;
    int ph_lo, ph_hi;
};

struct Fr { unsigned char* lds; int tid, lane, wave, gw, NGW, bid, G; };

__device__ __forceinline__ int ffn_row(int u) { const int half = u >= DFF ? 1 : 0, jc = u - half * DFF; return 256 * (jc >> 7) + 128 * half + (jc & 127); }
__device__ __forceinline__ void transpose_item(const float* W, int K, int N, int NT, bf16* WT, float* scr, int item, int lane, int rowmap = 0) {
    const int nblk = NT / 32, kb = item / nblk, nb = item % nblk, k0 = 64 * kb, n0 = 32 * nb;
#pragma unroll 8
    for (int i = 0; i < 32; ++i) { const int kk = 2 * i + (lane >> 5); const int n = n0 + (lane & 31); scr[kk * 33 + (lane & 31)] = (n < N) ? W[(size_t)(k0 + kk) * N + n] : 0.f; }
    wave_lds_sync();
    const int c = lane & 7;
#pragma unroll
    for (int j = 0; j < 4; ++j) { const int n = (lane >> 3) + 8 * j; const float* s = scr + (8 * c) * 33 + n;
        v4u o; o.x = pk2(s[0 * 33], s[1 * 33]); o.y = pk2(s[2 * 33], s[3 * 33]); o.z = pk2(s[4 * 33], s[5 * 33]); o.w = pk2(s[6 * 33], s[7 * 33]);
        const int row = rowmap ? ffn_row(n0 + n) : n0 + n;
        *(v4u*)(WT + (size_t)row * K + k0 + 8 * c) = o; }
    wave_lds_sync();
}
__device__ __forceinline__ void ph_prologue(const KP& p, const Fr& F) {
    float* scr = (float*)(F.lds + F.wave * 16384);
    const int I_A = 16 * (PAP / 32), I_OA = 16 * 32, I_FI = 16 * (DFF2 / 32), I_FO = (DFF / 64) * 32, I_CI = 16 * (3072 / 32), I_CO = 16 * 32;
    const int NITEMS = I_A + I_OA + 2 * I_FI + 2 * I_FO + I_CI + I_CO + 256 + 8;
    for (int it = F.gw; it < NITEMS; it += F.NGW) {
        int r = it;
        if (r < I_A) { transpose_item(p.w_in_a, DM, PA, PAP, p.WT_A, scr, r, F.lane); continue; } r -= I_A;
        if (r < I_OA) { transpose_item(p.w_out_a, DM, DM, DM, p.WT_OA, scr, r, F.lane); continue; } r -= I_OA;
        if (r < I_FI) { transpose_item(p.ffn_w_in, DM, DFF2, DFF2, p.WT_FI0, scr, r, F.lane, 1); continue; } r -= I_FI;
        if (r < I_FI) { transpose_item(p.ffn_w_in + (size_t)DM * DFF2, DM, DFF2, DFF2, p.WT_FI1, scr, r, F.lane, 1); continue; } r -= I_FI;
        if (r < I_FO) { transpose_item(p.ffn_w_out, DFF, DM, DM, p.WT_FO0, scr, r, F.lane); continue; } r -= I_FO;
        if (r < I_FO) { transpose_item(p.ffn_w_out + (size_t)DFF * DM, DFF, DM, DM, p.WT_FO1, scr, r, F.lane); continue; } r -= I_FO;
        if (r < I_CI) { transpose_item(p.w_in_c, DM, 3072, 3072, p.WT_CI, scr, r, F.lane); continue; } r -= I_CI;
        if (r < I_CO) { transpose_item(p.w_out_c, DM, DM, DM, p.WT_CO, scr, r, F.lane); continue; } r -= I_CO;
        if (r < 256) { const int kv = r >> 7; transpose_item(p.cw1 + (size_t)kv * 2048 * 128, 2048, 128, 128, p.WT_C + (size_t)kv * 128 * 2048, scr, r & 127, F.lane); continue; } r -= 256;
        { const int kv = r >> 2; transpose_item(p.cw2 + (size_t)kv * 128 * 64, 128, 64, 64, p.W2T + (size_t)kv * 64 * 128, scr, r & 3, F.lane); }
    }
    const size_t gt = (size_t)F.bid * NTHR + F.tid, GT = (size_t)F.G * NTHR;
    for (size_t i4 = gt; i4 < (size_t)TSP * (DM / 4); i4 += GT) {
        const int r = (int)(i4 / (DM / 4)), c4 = (int)(i4 % (DM / 4));
        float4 v = make_float4(0.f, 0.f, 0.f, 0.f);
        if (r < T) v = ((const float4*)p.x_prompt)[(size_t)r * (DM / 4) + c4]; else if (r < TS) v = ((const float4*)p.x_sample)[(size_t)(r - T) * (DM / 4) + c4];
        uint2 o; o.x = pk2(v.x, v.y); o.y = pk2(v.z, v.w);
        ((uint2*)p.ACTB)[i4] = o;
    }
    for (size_t idx = gt; idx < (size_t)(T + 1) * 32; idx += GT) {
        const int pos = (int)(idx >> 5), i = (int)(idx & 31);
        const float inv = (float)pow(10000.0, -2.0 * (double)i / 64.0);
        const float ang = (float)pos * inv;
        p.ROPE[idx] = make_float2((float)cos((double)ang), (float)sin((double)ang));
    }
}

__device__ __forceinline__ size_t vfrag_elem(int key, int d);
__device__ __forceinline__ size_t kfrag_elem(int key, int d);
__device__ __forceinline__ bf16x8 pack_p(const f32x4& p0, const f32x4& p1);
template <bool FFNMAP = false>
__device__ __forceinline__ void skinny_gemm(const Fr& F, const bf16* A, const bf16* Bt, int K, int ncols, float* C, int ldc) {
    const int lane = F.lane, l15 = lane & 15, grp = lane >> 4;
    const bf16* a0 = A + (size_t)(T + l15) * K + 8 * grp; const bf16* a1 = a0 + (size_t)16 * K;
    for (int nt = F.gw; nt * 16 < ncols; nt += F.NGW) {
        const bf16* bp = Bt + (size_t)(nt * 16 + l15) * K + 8 * grp;
        f32x4 c0 = {0.f, 0.f, 0.f, 0.f}, c1 = {0.f, 0.f, 0.f, 0.f};
#pragma unroll 4
        for (int k = 0; k < K; k += 32) {
            const bf16x8 b = *(const bf16x8*)(bp + k), x0 = *(const bf16x8*)(a0 + k), x1 = *(const bf16x8*)(a1 + k);
            c0 = MFMA16(x0, b, c0); c1 = MFMA16(x1, b, c1);
        }
        int n = nt * 16 + l15;
        if (FFNMAP) n = ((n >> 7) & 1) * DFF + (n >> 8) * 128 + (n & 127);
        if (n < ncols) {
#pragma unroll
            for (int r = 0; r < 4; ++r) { C[(size_t)(T + 4 * grp + r) * ldc + n] = c0[r]; C[(size_t)(T + 16 + 4 * grp + r) * ldc + n] = c1[r]; }
        }
    }
}
__device__ __forceinline__ void ph_gemm_f32(const Fr& F, const bf16* A, const bf16* Bt, int N, int K, float* C, int ldc, int ncols) {
    skinny_gemm(F, A, Bt, K, ncols, C, ldc);
    pg8::Gemm g{A, Bt, T, N, K}; pg8::StaticOrder S; S.init(T, N, F.G, F.bid);
    pg8::EpiF32 E{C, ldc, ncols};
    pg8::gemm_phase<pg8::EpiF32, pg8::StaticOrder, PG8_ALIGN, PG8_SP2>((PG8_LAS unsigned char*)F.lds, g, S, E);
}
__device__ __forceinline__ float dpp_ror1(float x) { return __int_as_float(__builtin_amdgcn_update_dpp(0, __float_as_int(x), 0x121, 0xf, 0xf, false)); }
__device__ __forceinline__ float dpp_ror2(float x) { return __int_as_float(__builtin_amdgcn_update_dpp(0, __float_as_int(x), 0x122, 0xf, 0xf, false)); }
struct EpiFfn {
    static constexpr bool PERM = true, AFTER_DRAIN = false;
    bf16* H; float* UB; const float* cw; const float* cb;
    __device__ __forceinline__ void operator()(const pg8::f32x4 (&acc)[2][2][4][2], const pg8::Unit& u, int wr, int wc, int fr, int fq) const {
#pragma unroll
        for (int n = 0; n < 2; ++n) {
            const int jc = u.pn * 128 + wc * 32 + 8 * fq + 4 * n;
            pg8::f32x4 w0[2], w1[2], w2[2], bb[2];
#pragma unroll
            for (int bj = 0; bj < 2; ++bj) { const int uc = bj * DFF + jc;
                w0[bj] = *(const pg8::f32x4*)(cw + uc); w1[bj] = *(const pg8::f32x4*)(cw + DFF2 + uc); w2[bj] = *(const pg8::f32x4*)(cw + 2 * DFF2 + uc); bb[bj] = *(const pg8::f32x4*)(cb + uc); }
#pragma unroll
            for (int ai = 0; ai < 2; ++ai) {
                const int sl = u.pm * 4 + ai * 2 + wr;
                pg8::f32x4 pr1[2], pr2[2];
#pragma unroll
                for (int m = 0; m < 4; ++m) {
                    pg8::f32x4 c[2];
#pragma unroll
                    for (int bj = 0; bj < 2; ++bj) {
                        const pg8::f32x4 uu = acc[ai][bj][m][n]; pg8::f32x4 r1, r2;
#pragma unroll
                        for (int e = 0; e < 4; ++e) { r1[e] = dpp_ror1(uu[e]); r2[e] = dpp_ror2(uu[e]); }
                        pg8::f32x4 p1 = r1, p2 = r2;
                        if (m > 0) { if (fr == 0) p1 = pr1[bj]; if (fr < 2) p2 = pr2[bj]; }
                        c[bj] = bb[bj] + w0[bj] * p2 + w1[bj] * p1 + w2[bj] * uu;
                        pr1[bj] = r1; pr2[bj] = r2;
                        const int uc = bj * DFF + jc;
                        if (m == 0 && fr < 2) *(pg8::f32x4*)(UB + ((size_t)sl * 4 + fr) * DFF2 + uc) = uu;
                        if (m == 3 && fr >= 14) *(pg8::f32x4*)(UB + ((size_t)sl * 4 + 2 + (fr - 14)) * DFF2 + uc) = uu;
                    }
                    if (!(m == 0 && fr < 2)) {
                        const int t = u.pm * 256 + ai * 128 + wr * 64 + m * 16 + fr;
                        uint2 o; o.x = pk2(fsilu_(c[0][0]) * c[1][0], fsilu_(c[0][1]) * c[1][1]); o.y = pk2(fsilu_(c[0][2]) * c[1][2], fsilu_(c[0][3]) * c[1][3]);
                        *(uint2*)(H + (size_t)t * DFF + jc) = o;
                    }
                }
            }
        }
    }
};
__device__ __forceinline__ void ph_ffn_gemm(const KP& p, const Fr& F, const bf16* Bt, int layer) {
    skinny_gemm<true>(F, p.ACTB, Bt, DM, DFF2, p.BIGF, DFF2);
    pg8::Gemm g{p.ACTB, Bt, T, DFF2, DM}; pg8::StaticOrder S; S.init(T, DFF2, F.G, F.bid);
    EpiFfn E{p.HFFB, p.UB, p.ffn_cw + (size_t)layer * 3 * DFF2, p.ffn_cb + (size_t)layer * DFF2};
    pg8::gemm_phase<EpiFfn, pg8::StaticOrder, PG8_ALIGN, PG8_SP2>((PG8_LAS unsigned char*)F.lds, g, S, E);
}
__device__ __forceinline__ void ph_ffn_fix(const KP& p, const Fr& F, int layer) {
    const float* cw = p.ffn_cw + (size_t)layer * 3 * DFF2; const float* cb = p.ffn_cb + (size_t)layer * DFF2; const float* U = p.BIGF;
    const int gt = F.bid * NTHR + F.tid, GT = F.G * NTHR;
    for (int idx = gt; idx < 512 * DFF; idx += GT) {
        const int rr = idx / DFF, j = idx - rr * DFF; const int sl = rr >> 1, q = rr & 1;
        float c2[2];
#pragma unroll
        for (int half = 0; half < 2; ++half) { const int ch = half * DFF + j;
            const float u0 = p.UB[((size_t)sl * 4 + q) * DFF2 + ch];
            const float um1 = q ? p.UB[((size_t)sl * 4) * DFF2 + ch] : (sl ? p.UB[((size_t)(sl - 1) * 4 + 3) * DFF2 + ch] : 0.f);
            const float um2 = sl ? p.UB[((size_t)(sl - 1) * 4 + 2 + q) * DFF2 + ch] : 0.f;
            c2[half] = cb[ch] + cw[ch] * um2 + cw[DFF2 + ch] * um1 + cw[2 * DFF2 + ch] * u0; }
        p.HFFB[(size_t)(64 * sl + q) * DFF + j] = (bf16)f2bf(siluf_(c2[0]) * c2[1]);
    }
    for (int idx = gt; idx < NSMP * DFF; idx += GT) {
        const int b = idx / DFF, j = idx - b * DFF;
        float c2[2];
#pragma unroll
        for (int half = 0; half < 2; ++half) { const int ch = half * DFF + j;
            const float* hs = p.st_ffn + (((size_t)b * 2 + layer) * 2) * DFF2 + ch;
            c2[half] = cb[ch] + cw[ch] * hs[0] + cw[DFF2 + ch] * hs[DFF2] + cw[2 * DFF2 + ch] * U[(size_t)(T + b) * DFF2 + ch]; }
        p.HFFB[(size_t)(T + b) * DFF + j] = (bf16)f2bf(siluf_(c2[0]) * c2[1]);
    }
    for (int idx = gt; idx < 2 * DFF2; idx += GT) { const int k = idx / DFF2, ch = idx - k * DFF2;
        p.out[O_FFN_P + ((size_t)layer * 2 + k) * DFF2 + ch] = p.UB[((size_t)255 * 4 + 2 + k) * DFF2 + ch]; }
    for (int idx = gt; idx < NSMP * 2 * DFF2; idx += GT) { const int b = idx / (2 * DFF2), k = (idx / DFF2) & 1, ch = idx % DFF2;
        p.out[O_FFN_S + (((size_t)b * 2 + layer) * 2 + k) * DFF2 + ch] = (k == 0) ? p.st_ffn[(((size_t)b * 2 + layer) * 2 + 1) * DFF2 + ch] : U[(size_t)(T + b) * DFF2 + ch]; }
}
struct EpiCmp {
    static constexpr bool PERM = false, AFTER_DRAIN = false;
    bf16* HID; const float* b1;
    __device__ __forceinline__ void operator()(const pg8::f32x4 (&acc)[2][2][4][2], const pg8::Unit& u, int wr, int wc, int fr, int fq) const {
#pragma unroll
        for (int ai = 0; ai < 2; ++ai)
#pragma unroll
            for (int m = 0; m < 4; ++m) { const int combo = u.pm * 128 + wr * 64 + m * 16 + fr;
#pragma unroll
                for (int n = 0; n < 2; ++n) { const int j0 = wc * 32 + n * 16 + 4 * fq; const pg8::f32x4 v = acc[ai][ai][m][n]; const float* bb = b1 + ai * 128 + j0;
                    uint2 o; o.x = pk2(gelu_tanh(v[0] + bb[0]), gelu_tanh(v[1] + bb[1])); o.y = pk2(gelu_tanh(v[2] + bb[2]), gelu_tanh(v[3] + bb[3]));
                    *(uint2*)(HID + ((size_t)combo * 2 + ai) * 128 + j0) = o; } }
    }
};
__device__ __forceinline__ void ph_cmp_gemm(const KP& p, const Fr& F) {
    pg8::Gemm g{p.AC, p.WT_C, 65536, 256, 2048}; pg8::StaticOrder S; S.init(65536, 256, F.G, F.bid);
    EpiCmp E{p.HID, p.cb1};
    pg8::gemm_phase<EpiCmp, pg8::StaticOrder, PG8_ALIGN, PG8_SP2>((PG8_LAS unsigned char*)F.lds, g, S, E);
}
__device__ __forceinline__ void ph_cmp_stage2(const KP& p, const Fr& F) {
    const int lane = F.lane, l15 = lane & 15, grp = lane >> 4;
    for (int tile = F.gw; tile < 4096; tile += F.NGW) {
        const int kv = tile & 1, combo0 = (tile >> 1) * 16;
        const bf16* hid = p.HID + ((size_t)(combo0 + l15) * 2 + kv) * 128 + 8 * grp; const bf16* w2 = p.W2T + (size_t)kv * 64 * 128 + (size_t)l15 * 128 + 8 * grp;
        f32x4 acc[4];
#pragma unroll
        for (int nt = 0; nt < 4; ++nt) acc[nt] = (f32x4){0.f, 0.f, 0.f, 0.f};
#pragma unroll
        for (int ks = 0; ks < 4; ++ks) { const bf16x8 a = *(const bf16x8*)(hid + 32 * ks);
#pragma unroll
            for (int nt = 0; nt < 4; ++nt) acc[nt] = MFMA16(a, *(const bf16x8*)(w2 + (size_t)nt * 16 * 128 + 32 * ks), acc[nt]); }
#pragma unroll
        for (int r = 0; r < 4; ++r) {
            const int combo = combo0 + 4 * grp + r; const int g = combo & 1, c = (combo >> 1) & 511, b = combo >> 10;
            float* dst = ((kv == 0) ? p.CK : p.CV) + (((size_t)(1 + b) * 512 + c) * 2 + g) * 64;
            if (kv == 0) {
                const int pos = (c + 1) * 32 - 1;
#pragma unroll
                for (int nt = 0; nt < 2; ++nt) { const float2 cs = p.ROPE[pos * 32 + 16 * nt + l15]; const float x1 = acc[nt][r], x2 = acc[nt + 2][r];
                    dst[16 * nt + l15] = x1 * cs.x - x2 * cs.y; dst[16 * (nt + 2) + l15] = x2 * cs.x + x1 * cs.y; }
            } else {
#pragma unroll
                for (int nt = 0; nt < 4; ++nt) dst[16 * nt + l15] = acc[nt][r];
            }
        }
    }
}
__device__ __forceinline__ void cmp_prompt_unit(const KP& p, int unit, int lane) {
    asm volatile("" : "+v"(lane));
    const int l15 = lane & 15, grp = lane >> 4;
    const int kv = unit & 1, combo = (unit >> 1) * 16 + l15; const int g = combo & 1, c = combo >> 1;
    const bf16* w1 = p.WT_C + ((size_t)kv * 128 + l15) * 2048 + 8 * grp;
    f32x4 acc[8];
#pragma unroll
    for (int jt = 0; jt < 8; ++jt) acc[jt] = (f32x4){0.f, 0.f, 0.f, 0.f};
    const bf16* fl = p.ACP + ((size_t)kv * 1024 + combo) * 2048 + 8 * grp;
#pragma unroll 4
    for (int ks = 0; ks < 64; ++ks) {
        const bf16x8 fb = *(const bf16x8*)(fl + 32 * ks);
#pragma unroll
        for (int jt = 0; jt < 8; ++jt) acc[jt] = MFMA16(*(const bf16x8*)(w1 + (size_t)jt * 16 * 2048 + 32 * ks), fb, acc[jt]);
    }
    bf16x8 hb[4];
#pragma unroll
    for (int s2 = 0; s2 < 4; ++s2) {
        f32x4 h0, h1;
#pragma unroll
        for (int r = 0; r < 4; ++r) { h0[r] = gelu_tanh(acc[2 * s2][r] + p.cb1[kv * 128 + 32 * s2 + 4 * grp + r]); h1[r] = gelu_tanh(acc[2 * s2 + 1][r] + p.cb1[kv * 128 + 32 * s2 + 16 + 4 * grp + r]); }
        hb[s2] = pack_p(h0, h1);
    }
    f32x4 o[4];
#pragma unroll
    for (int dt = 0; dt < 4; ++dt) {
        o[dt] = (f32x4){0.f, 0.f, 0.f, 0.f};
        const bf16* w2 = p.W2T + (size_t)kv * 64 * 128 + (size_t)(16 * dt + l15) * 128 + 4 * grp;
#pragma unroll
        for (int s2 = 0; s2 < 4; ++s2) { const uint2 x0 = *(const uint2*)(w2 + 32 * s2), x1 = *(const uint2*)(w2 + 32 * s2 + 16);
            union { v4u u; bf16x8 b; } wa; wa.u.x = x0.x; wa.u.y = x0.y; wa.u.z = x1.x; wa.u.w = x1.y;
            o[dt] = MFMA16(wa.b, hb[s2], o[dt]); }
    }
    if (kv == 0) {
        const int pos = (c + 1) * 32 - 1;
#pragma unroll
        for (int dt = 0; dt < 2; ++dt)
#pragma unroll
            for (int r = 0; r < 4; ++r) { const float2 cs = p.ROPE[pos * 32 + 16 * dt + 4 * grp + r]; const float x1 = o[dt][r], x2 = o[dt + 2][r];
                o[dt][r] = x1 * cs.x - x2 * cs.y; o[dt + 2][r] = x2 * cs.x + x1 * cs.y; }
    }
#pragma unroll
    for (int dt = 0; dt < 4; ++dt)
#pragma unroll
        for (int r = 0; r < 4; ++r) { const int d = 16 * dt + 4 * grp + r;
            if (kv == 0) p.CKF[(size_t)g * 512 * 64 + kfrag_elem(c, d)] = (bf16)f2bf(o[dt][r]); else p.CVF[(size_t)g * 512 * 64 + vfrag_elem(c, d)] = (bf16)f2bf(o[dt][r]); }
}
__device__ __forceinline__ void cmp_sample_unit(const KP& p, int unit, int lane) {
    asm volatile("" : "+v"(lane));
    const int l15 = lane & 15, grp = lane >> 4;
    const int b = unit >> 6, kv = (unit >> 5) & 1, cb = unit & 31;
    const bf16* w1 = p.WT_C + ((size_t)kv * 128 + l15) * 2048 + 8 * grp;
    const float* src[2];
#pragma unroll
    for (int cg = 0; cg < 2; ++cg) { const int combo = cb * 32 + 16 * cg + l15; const int g = combo & 1, c = combo >> 1;
        const int page = p.page_table[b * NPAGES + (c >> 2)];
        src[cg] = p.cache_cmp + (((size_t)page * 128 + (c & 3) * 32) * 4 + kv * 2 + g) * 64 + 8 * grp; }
    const float* pe = p.cpe + (size_t)kv * 32 * 64 + 8 * grp;
    f32x4 acc[2][8];
#pragma unroll
    for (int cg = 0; cg < 2; ++cg)
#pragma unroll
        for (int jt = 0; jt < 8; ++jt) acc[cg][jt] = (f32x4){0.f, 0.f, 0.f, 0.f};
#pragma unroll 2
    for (int ks = 0; ks < 64; ++ks) {
        const int i = ks >> 1, dd = 32 * (ks & 1);
        const float4 e0 = *(const float4*)(pe + i * 64 + dd), e1 = *(const float4*)(pe + i * 64 + dd + 4);
        bf16x8 fb[2];
#pragma unroll
        for (int cg = 0; cg < 2; ++cg) { const float4 a0 = *(const float4*)(src[cg] + i * 256 + dd), a1 = *(const float4*)(src[cg] + i * 256 + dd + 4);
            union { v4u u; bf16x8 b; } t; t.u.x = pk2(a0.x + e0.x, a0.y + e0.y); t.u.y = pk2(a0.z + e0.z, a0.w + e0.w); t.u.z = pk2(a1.x + e1.x, a1.y + e1.y); t.u.w = pk2(a1.z + e1.z, a1.w + e1.w); fb[cg] = t.b; }
#pragma unroll
        for (int jt = 0; jt < 8; ++jt) { const bf16x8 wa = *(const bf16x8*)(w1 + (size_t)jt * 16 * 2048 + 32 * ks);
            acc[0][jt] = MFMA16(wa, fb[0], acc[0][jt]); acc[1][jt] = MFMA16(wa, fb[1], acc[1][jt]); }
    }
#pragma unroll
    for (int cg = 0; cg < 2; ++cg) {
        const int combo = cb * 32 + 16 * cg + l15; const int g = combo & 1, c = combo >> 1;
        bf16x8 hb[4];
#pragma unroll
        for (int s2 = 0; s2 < 4; ++s2) { f32x4 h0, h1;
#pragma unroll
            for (int r = 0; r < 4; ++r) { h0[r] = gelu_tanh(acc[cg][2 * s2][r] + p.cb1[kv * 128 + 32 * s2 + 4 * grp + r]); h1[r] = gelu_tanh(acc[cg][2 * s2 + 1][r] + p.cb1[kv * 128 + 32 * s2 + 16 + 4 * grp + r]); }
            hb[s2] = pack_p(h0, h1); }
        f32x4 o[4];
#pragma unroll
        for (int dt = 0; dt < 4; ++dt) {
            o[dt] = (f32x4){0.f, 0.f, 0.f, 0.f};
            const bf16* w2 = p.W2T + (size_t)kv * 64 * 128 + (size_t)(16 * dt + l15) * 128 + 4 * grp;
#pragma unroll
            for (int s2 = 0; s2 < 4; ++s2) { const uint2 x0 = *(const uint2*)(w2 + 32 * s2), x1 = *(const uint2*)(w2 + 32 * s2 + 16);
                union { v4u u; bf16x8 b; } wa; wa.u.x = x0.x; wa.u.y = x0.y; wa.u.z = x1.x; wa.u.w = x1.y;
                o[dt] = MFMA16(wa.b, hb[s2], o[dt]); }
        }
        if (kv == 0) {
            const int pos = (c + 1) * 32 - 1;
#pragma unroll
            for (int dt = 0; dt < 2; ++dt)
#pragma unroll
                for (int r = 0; r < 4; ++r) { const float2 cs = p.ROPE[pos * 32 + 16 * dt + 4 * grp + r]; const float x1 = o[dt][r], x2 = o[dt + 2][r];
                    o[dt][r] = x1 * cs.x - x2 * cs.y; o[dt + 2][r] = x2 * cs.x + x1 * cs.y; }
        }
        float* dst = ((kv == 0) ? p.CK : p.CV) + (((size_t)(1 + b) * 512 + c) * 2 + g) * 64 + 4 * grp;
#pragma unroll
        for (int dt = 0; dt < 4; ++dt) *(f32x4*)(dst + 16 * dt) = o[dt];
    }
}
constexpr int W1S_PITCH = 528;
constexpr int W1S_BYTES = 128 * W1S_PITCH;
__device__ __forceinline__ void cmp_sample_wg(const KP& p, int wu, const Fr& F) {
    int lane = F.lane; asm volatile("" : "+v"(lane));
    const int l15 = lane & 15, grp = lane >> 4, tid = F.tid;
    const int b = wu >> 3, kv = (wu >> 2) & 1, q4 = wu & 3;
    const float* src[2];
#pragma unroll
    for (int cg = 0; cg < 2; ++cg) { const int combo = q4 * 256 + F.wave * 32 + 16 * cg + l15; const int g = combo & 1, c = combo >> 1;
        const int page = p.page_table[b * NPAGES + (c >> 2)];
        src[cg] = p.cache_cmp + (((size_t)page * 128 + (c & 3) * 32) * 4 + kv * 2 + g) * 64 + 8 * grp; }
    const float* pe = p.cpe + (size_t)kv * 32 * 64 + 8 * grp;
    const bf16* wg = p.WT_C + (size_t)kv * 128 * 2048;
    f32x4 acc[2][8];
#pragma unroll
    for (int cg = 0; cg < 2; ++cg)
#pragma unroll
        for (int jt = 0; jt < 8; ++jt) acc[cg][jt] = (f32x4){0.f, 0.f, 0.f, 0.f};
    v4u wreg[8];
#pragma unroll
    for (int k = 0; k < 8; ++k) { const int c = tid + 512 * k; wreg[k] = *(const v4u*)(wg + (size_t)(c >> 5) * 2048 + (c & 31) * 8); }
#pragma unroll
    for (int k = 0; k < 8; ++k) { const int c = tid + 512 * k; *(v4u*)(F.lds + (c >> 5) * W1S_PITCH + (c & 31) * 16) = wreg[k]; }
    __syncthreads();
#pragma unroll 1
    for (int sl = 0; sl < 8; ++sl) {
        if (sl + 1 < 8) {
#pragma unroll
            for (int k = 0; k < 8; ++k) { const int c = tid + 512 * k; wreg[k] = *(const v4u*)(wg + (size_t)(c >> 5) * 2048 + (sl + 1) * 256 + (c & 31) * 8); }
        }
        const unsigned char* wl = F.lds + (sl & 1) * W1S_BYTES + l15 * W1S_PITCH + grp * 16;
#pragma unroll 2
        for (int kk = 0; kk < 8; ++kk) {
            const int ks = sl * 8 + kk, i = ks >> 1, dd = 32 * (ks & 1);
            const float4 e0 = *(const float4*)(pe + i * 64 + dd), e1 = *(const float4*)(pe + i * 64 + dd + 4);
            bf16x8 fb[2];
#pragma unroll
            for (int cg = 0; cg < 2; ++cg) { const float4 a0 = *(const float4*)(src[cg] + i * 256 + dd), a1 = *(const float4*)(src[cg] + i * 256 + dd + 4);
                union { v4u u; bf16x8 b; } t; t.u.x = pk2(a0.x + e0.x, a0.y + e0.y); t.u.y = pk2(a0.z + e0.z, a0.w + e0.w); t.u.z = pk2(a1.x + e1.x, a1.y + e1.y); t.u.w = pk2(a1.z + e1.z, a1.w + e1.w); fb[cg] = t.b; }
#pragma unroll
            for (int jt = 0; jt < 8; ++jt) { const bf16x8 wa = *(const bf16x8*)(wl + jt * 16 * W1S_PITCH + kk * 64);
                acc[0][jt] = MFMA16(wa, fb[0], acc[0][jt]); acc[1][jt] = MFMA16(wa, fb[1], acc[1][jt]); }
        }
        if (sl + 1 < 8) {
#pragma unroll
            for (int k = 0; k < 8; ++k) { const int c = tid + 512 * k; *(v4u*)(F.lds + ((sl + 1) & 1) * W1S_BYTES + (c >> 5) * W1S_PITCH + (c & 31) * 16) = wreg[k]; }
        }
        __syncthreads();
    }
#pragma unroll
    for (int cg = 0; cg < 2; ++cg) {
        const int combo = q4 * 256 + F.wave * 32 + 16 * cg + l15; const int g = combo & 1, c = combo >> 1;
        bf16x8 hb[4];
#pragma unroll
        for (int s2 = 0; s2 < 4; ++s2) { f32x4 h0, h1;
#pragma unroll
            for (int r = 0; r < 4; ++r) { h0[r] = gelu_tanh(acc[cg][2 * s2][r] + p.cb1[kv * 128 + 32 * s2 + 4 * grp + r]); h1[r] = gelu_tanh(acc[cg][2 * s2 + 1][r] + p.cb1[kv * 128 + 32 * s2 + 16 + 4 * grp + r]); }
            hb[s2] = pack_p(h0, h1); }
        f32x4 o[4];
#pragma unroll
        for (int dt = 0; dt < 4; ++dt) {
            o[dt] = (f32x4){0.f, 0.f, 0.f, 0.f};
            const bf16* w2 = p.W2T + (size_t)kv * 64 * 128 + (size_t)(16 * dt + l15) * 128 + 4 * grp;
#pragma unroll
            for (int s2 = 0; s2 < 4; ++s2) { const uint2 x0 = *(const uint2*)(w2 + 32 * s2), x1 = *(const uint2*)(w2 + 32 * s2 + 16);
                union { v4u u; bf16x8 b; } wa; wa.u.x = x0.x; wa.u.y = x0.y; wa.u.z = x1.x; wa.u.w = x1.y;
                o[dt] = MFMA16(wa.b, hb[s2], o[dt]); }
        }
        if (kv == 0) {
            const int pos = (c + 1) * 32 - 1;
#pragma unroll
            for (int dt = 0; dt < 2; ++dt)
#pragma unroll
                for (int r = 0; r < 4; ++r) { const float2 cs = p.ROPE[pos * 32 + 16 * dt + 4 * grp + r]; const float x1 = o[dt][r], x2 = o[dt + 2][r];
                    o[dt][r] = x1 * cs.x - x2 * cs.y; o[dt + 2][r] = x2 * cs.x + x1 * cs.y; }
        }
        float* dst = ((kv == 0) ? p.CK : p.CV) + (((size_t)(1 + b) * 512 + c) * 2 + g) * 64 + 4 * grp;
#pragma unroll
        for (int dt = 0; dt < 4; ++dt) *(f32x4*)(dst + 16 * dt) = o[dt];
    }
}
__device__ __forceinline__ void ph_cmp_samples(const KP& p, const Fr& F) {
    for (int wu = F.bid; wu < 256; wu += F.G) cmp_sample_wg(p, wu, F);
}
__device__ __forceinline__ void ph_cmp_prompt(const KP& p, const Fr& F) {
    for (int unit = F.gw; unit < 128; unit += F.NGW) cmp_prompt_unit(p, unit, F.lane);
}

__device__ __forceinline__ float rope_val(const float* row, int base, int i, float2 cs) {
    const int ii = i & 31;
    const float x1 = row[base + ii], x2 = row[base + ii + 32];
    return (i < 32) ? (x1 * cs.x - x2 * cs.y) : (x2 * cs.x + x1 * cs.y);
}
__device__ __forceinline__ void ph_nsa_prep(const KP& p, const Fr& F) {
    const float* H0 = p.BIGF; float* out = p.out;
    const size_t gt = (size_t)F.bid * NTHR + F.tid, GT = (size_t)F.G * NTHR;
    const size_t total = (size_t)TS * 1280;
    for (size_t idx = gt + (size_t)T * 1280; idx < total; idx += GT) {
        const int r = (int)(idx / 1280), c = (int)(idx % 1280);
        const bool smp = r >= T; const int b = r - T; const int pos = smp ? T : r;
        const float* row = H0 + (size_t)r * PA;
        const int i = c & 63;
        const float2 cs = p.ROPE[pos * 32 + (i & 31)];
        if (c < 512) { p.QR[(size_t)r * 512 + c] = rope_val(row, c & ~63, i, cs); continue; }
        const int sec = (c - 512) >> 7; const int gd = (c - 512) & 127; const int base = c & ~63;
        float v;
        if (sec == 2 || sec == 4) v = rope_val(row, base, i, cs); else v = row[c];
        const int kv = sec & 1;
        if (sec < 2) {
            if (!smp) out[O_CMP_P + (size_t)r * 256 + kv * 128 + gd] = v; else out[O_CMP_S + (size_t)b * 256 + kv * 128 + gd] = v;
        } else if (sec < 4) {
            if (!smp) out[O_SLC_P + (size_t)r * 256 + kv * 128 + gd] = v; else out[O_SLC_S + (size_t)b * 256 + kv * 128 + gd] = v;
            if (kv == 0) p.KS[(size_t)r * 128 + gd] = v; else p.VS[(size_t)r * 128 + gd] = v;
        } else {
            if (kv == 0) p.KW[(size_t)r * 128 + gd] = v; else p.VW[(size_t)r * 128 + gd] = v;
            if (!smp) { if (r >= T - 512) out[O_WIN_P + (size_t)(r - (T - 512)) * 256 + kv * 128 + gd] = v; }
            else out[O_WIN_S + ((size_t)b * 512 + 511) * 256 + kv * 128 + gd] = v;
        }
    }
    const size_t tot2 = (size_t)NSMP * 511 * 256;
    for (size_t idx = gt; idx < tot2; idx += GT) {
        const int b = (int)(idx / (511 * 256)); const int rem = (int)(idx % (511 * 256));
        out[O_WIN_S + (size_t)b * 512 * 256 + rem] = p.st_win[(size_t)b * 512 * 256 + 256 + rem];
    }
}

constexpr float QSCALE = 0.18033688011112042f;

__device__ __forceinline__ size_t kfrag_off(int kt, int ks, int lane) { return ((size_t)(kt * 2 + ks) * 64 + lane) * 8; }
__device__ __forceinline__ size_t vfrag_off(int st, int dt, int lane) { return ((size_t)(st * 4 + dt) * 64 + lane) * 8; }
__device__ __forceinline__ size_t vfrag_elem(int key, int d) {
    const int st = key >> 5, kk = key & 31, tile = kk >> 4, r16 = kk & 15, grp = r16 >> 2, reg = r16 & 3;
    return ((size_t)(st * 4 + (d >> 4)) * 64 + (d & 15) + 16 * grp) * 8 + tile * 4 + reg;
}
__device__ __forceinline__ size_t k8_off(int key, int d) { return ((size_t)(key >> 4) * 64 + (key & 15) + 16 * ((d & 31) >> 3)) * 16 + (d >> 5) * 8 + (d & 7); }
__device__ __forceinline__ size_t v8_off(int key, int d) {
    const int blk = key >> 6, st = (key >> 5) & 1, kk = key & 31, tile = kk >> 4, r16 = kk & 15, grp = r16 >> 2, reg = r16 & 3;
    return ((size_t)(blk * 4 + (d >> 4)) * 64 + (d & 15) + 16 * grp) * 16 + st * 8 + tile * 4 + reg;
}
__device__ __forceinline__ size_t kfrag_elem(int key, int d) {
    return ((size_t)((key >> 4) * 2 + (d >> 5)) * 64 + (key & 15) + 16 * ((d & 31) >> 3)) * 8 + (d & 7);
}

__device__ __forceinline__ void ph_nsa_prep_fast(const KP& p, const Fr& F) {
    const float* H0 = p.BIGF; float* out = p.out;
    const size_t gt = (size_t)F.bid * NTHR + F.tid, GT = (size_t)F.G * NTHR;
    for (size_t idx = gt; idx < (size_t)T * 160; idx += GT) {
        const int t = (int)(idx / 160), u = (int)(idx % 160);
        const int c0 = u * 8; const float* row = H0 + (size_t)t * PA;
        const float4 a0 = *(const float4*)(row + c0), a1 = *(const float4*)(row + c0 + 4);
        float v[8] = {a0.x, a0.y, a0.z, a0.w, a1.x, a1.y, a1.z, a1.w};
        const int sec = (u < 64) ? -1 : ((u - 64) >> 4);
        const bool roped = (sec == -1 || sec == 2 || sec == 4);
        if (roped) {
            const int d0 = c0 & 63; const int pc = (d0 < 32) ? c0 + 32 : c0 - 32;
            const float4 b0 = *(const float4*)(row + pc), b1 = *(const float4*)(row + pc + 4);
            const float w[8] = {b0.x, b0.y, b0.z, b0.w, b1.x, b1.y, b1.z, b1.w};
            const float4* rp = (const float4*)(p.ROPE + t * 32 + (d0 & 31)); const float4 r0 = rp[0], r1 = rp[1], r2 = rp[2], r3 = rp[3];
            const float cs[8] = {r0.x, r0.z, r1.x, r1.z, r2.x, r2.z, r3.x, r3.z}, sn[8] = {r0.y, r0.w, r1.y, r1.w, r2.y, r2.w, r3.y, r3.w};
#pragma unroll
            for (int j = 0; j < 8; ++j) v[j] = (d0 < 32) ? (v[j] * cs[j] - w[j] * sn[j]) : (v[j] * cs[j] + w[j] * sn[j]);
        }
        if (sec == -1) {
            v4u o; o.x = pk2(v[0] * QSCALE, v[1] * QSCALE); o.y = pk2(v[2] * QSCALE, v[3] * QSCALE); o.z = pk2(v[4] * QSCALE, v[5] * QSCALE); o.w = pk2(v[6] * QSCALE, v[7] * QSCALE);
            *(v4u*)(p.QB + (size_t)t * 512 + c0) = o; continue;
        }
        const int gd = (c0 - 512) & 127, g = gd >> 6, d0 = gd & 63, kv = sec & 1;
        const float4 o0 = make_float4(v[0], v[1], v[2], v[3]), o1 = make_float4(v[4], v[5], v[6], v[7]);
        if (sec < 2) { float* o = out + O_CMP_P + (size_t)t * 256 + kv * 128 + gd; *(float4*)o = o0; *(float4*)(o + 4) = o1;
            const int i = t & 31; const float* pe = p.cpe + (kv * 32 + i) * 64 + d0; const float4 e0 = *(const float4*)pe, e1 = *(const float4*)(pe + 4);
            v4u w; w.x = pk2(v[0] + e0.x, v[1] + e0.y); w.y = pk2(v[2] + e0.z, v[3] + e0.w); w.z = pk2(v[4] + e1.x, v[5] + e1.y); w.w = pk2(v[6] + e1.z, v[7] + e1.w);
            *(v4u*)(p.ACP + ((size_t)kv * 1024 + (t >> 5) * 2 + g) * 2048 + i * 64 + d0) = w; continue; }
        if (sec < 4) { float* o = out + O_SLC_P + (size_t)t * 256 + kv * 128 + gd; *(float4*)o = o0; *(float4*)(o + 4) = o1; }
        else if (t >= T - 512) { float* o = out + O_WIN_P + (size_t)(t - (T - 512)) * 256 + kv * 128 + gd; *(float4*)o = o0; *(float4*)(o + 4) = o1; }
        if (sec < 4) {
            if (kv == 0) {
                int w0 = 0, w1 = 0;
                w0 = __builtin_amdgcn_cvt_pk_fp8_f32(v[0], v[1], w0, false); w0 = __builtin_amdgcn_cvt_pk_fp8_f32(v[2], v[3], w0, true);
                w1 = __builtin_amdgcn_cvt_pk_fp8_f32(v[4], v[5], w1, false); w1 = __builtin_amdgcn_cvt_pk_fp8_f32(v[6], v[7], w1, true);
                *(uint2*)(p.KS8 + (size_t)g * T * 64 + k8_off(t, d0)) = make_uint2((unsigned)w0, (unsigned)w1);
            } else {
#pragma unroll
                for (int j = 0; j < 8; ++j) p.VS8[(size_t)g * T * 64 + v8_off(t, d0 + j)] = (unsigned char)(__builtin_amdgcn_cvt_pk_fp8_f32(v[j], 0.f, 0, false) & 0xff);
            }
            continue;
        }
        bf16* KF = p.KWF; bf16* VF = p.VWF;
        if (kv == 0) {
            v4u o; o.x = pk2(v[0], v[1]); o.y = pk2(v[2], v[3]); o.z = pk2(v[4], v[5]); o.w = pk2(v[6], v[7]);
            *(v4u*)(KF + (size_t)g * T * 64 + kfrag_elem(t, d0)) = o;
        } else {
#pragma unroll
            for (int j = 0; j < 8; ++j) VF[(size_t)g * T * 64 + vfrag_elem(t, d0 + j)] = (bf16)f2bf(v[j]);
        }
    }
}

struct AttW { f32x4 o[4]; float m, l; };
__device__ __forceinline__ void attw_init(AttW& a) {
#pragma unroll
    for (int i = 0; i < 4; ++i) a.o[i] = (f32x4){0.f, 0.f, 0.f, 0.f};
    a.m = -INFINITY; a.l = 0.f;
}
__device__ __forceinline__ void qk_step(const bf16x8 (&kf)[2][2], const bf16x8 (&qf)[2], f32x4& s0, f32x4& s1) {
    const f32x4 z = {0.f, 0.f, 0.f, 0.f};
    s0 = MFMA16(kf[0][0], qf[0], z); s0 = MFMA16(kf[0][1], qf[1], s0);
    s1 = MFMA16(kf[1][0], qf[0], z); s1 = MFMA16(kf[1][1], qf[1], s1);
}
__device__ __forceinline__ bf16x8 pack_p(const f32x4& p0, const f32x4& p1) {
    union { v4u u; bf16x8 b; } c;
    c.u.x = pg8::cvt_pk_bf16(p0[0], p0[1]); c.u.y = pg8::cvt_pk_bf16(p0[2], p0[3]); c.u.z = pg8::cvt_pk_bf16(p1[0], p1[1]); c.u.w = pg8::cvt_pk_bf16(p1[2], p1[3]);
    return c.b;
}
__device__ __forceinline__ void att_update(AttW& a, const f32x4& s0, const f32x4& s1, const bf16x8 (&vf)[4]) {
    float mx = fmaxf(fmaxf(fmaxf(s0[0], s0[1]), fmaxf(s0[2], s0[3])), fmaxf(fmaxf(s1[0], s1[1]), fmaxf(s1[2], s1[3])));
    mx = fmaxf(mx, __shfl_xor(mx, 16)); mx = fmaxf(mx, __shfl_xor(mx, 32));
    const float mn = fmaxf(a.m, mx);
    const float ms = (mn == -INFINITY) ? 0.f : mn;
    const float alpha = __builtin_amdgcn_exp2f(a.m - ms);
    f32x4 p0, p1;
#pragma unroll
    for (int i = 0; i < 4; ++i) { p0[i] = __builtin_amdgcn_exp2f(s0[i] - ms); p1[i] = __builtin_amdgcn_exp2f(s1[i] - ms); }
    a.l = a.l * alpha + ((p0[0] + p0[1]) + (p0[2] + p0[3])) + ((p1[0] + p1[1]) + (p1[2] + p1[3]));
    a.m = mn;
    const bf16x8 pf = pack_p(p0, p1);
#pragma unroll
    for (int dt = 0; dt < 4; ++dt) { a.o[dt] = a.o[dt] * alpha; a.o[dt] = MFMA16(vf[dt], pf, a.o[dt]); }
}
__device__ __forceinline__ float grp_sum(float v) { v += __shfl_xor(v, 16); v += __shfl_xor(v, 32); return v; }

__device__ __forceinline__ void nsa_fast_unit(const KP& p, int unit, float* wl, int lane) {
    asm volatile("" : "+v"(lane));
    const int g = unit & 1, t0 = (unit >> 1) * 16;
    const int qi = lane & 15, grp = lane >> 4, t = t0 + qi;
    float* imp = wl; int* sel = (int*)(wl + 4096);
    const float* grow = p.BIGF + (size_t)t * PA + C_GATE + g * 4;
    bf16x8 qf[4][2];
#pragma unroll
    for (int h = 0; h < 4; ++h)
#pragma unroll
        for (int ks = 0; ks < 2; ++ks) qf[h][ks] = *(const bf16x8*)(p.QB + (size_t)t * 512 + (g * 4 + h) * 64 + 32 * ks + 8 * grp);
    AttW st[4];
    {
        const bf16* CKF = p.CKF + (size_t)g * 512 * 64; const bf16* CVF = p.CVF + (size_t)g * 512 * 64;
        const int nmax = (t0 + 16) >> 5; const int nsteps = (nmax + 31) >> 5;
        const int nval = (t + 1) >> 5;
        float m[4], l[4];
#pragma unroll
        for (int h = 0; h < 4; ++h) { m[h] = -INFINITY; l[h] = 0.f; }
        for (int s = 0; s < nsteps; ++s) {
            bf16x8 kf[2][2];
#pragma unroll
            for (int tl = 0; tl < 2; ++tl)
#pragma unroll
                for (int ks = 0; ks < 2; ++ks) kf[tl][ks] = *(const bf16x8*)(CKF + kfrag_off(2 * s + tl, ks, lane));
            const int cb = 32 * s + 4 * grp;
#pragma unroll
            for (int h = 0; h < 4; ++h) {
                f32x4 s0, s1; qk_step(kf, qf[h], s0, s1);
#pragma unroll
                for (int i = 0; i < 4; ++i) { if (cb + i >= nval) s0[i] = -INFINITY; if (cb + 16 + i >= nval) s1[i] = -INFINITY; }
                float mx = fmaxf(fmaxf(fmaxf(s0[0], s0[1]), fmaxf(s0[2], s0[3])), fmaxf(fmaxf(s1[0], s1[1]), fmaxf(s1[2], s1[3])));
                mx = fmaxf(mx, __shfl_xor(mx, 16)); mx = fmaxf(mx, __shfl_xor(mx, 32));
                const float mn = fmaxf(m[h], mx); const float ms = (mn == -INFINITY) ? 0.f : mn;
                float sum = 0.f;
#pragma unroll
                for (int i = 0; i < 4; ++i) sum += __builtin_amdgcn_exp2f(s0[i] - ms) + __builtin_amdgcn_exp2f(s1[i] - ms);
                l[h] = l[h] * __builtin_amdgcn_exp2f(m[h] - ms) + sum; m[h] = mn;
            }
        }
        float il[4];
#pragma unroll
        for (int h = 0; h < 4; ++h) { const float lt = grp_sum(l[h]); il[h] = lt > 0.f ? 1.f / lt : 0.f; if (m[h] == -INFINITY) m[h] = 0.f; attw_init(st[h]); }
        for (int s = 0; s < nsteps; ++s) {
            bf16x8 kf[2][2], vf[4];
#pragma unroll
            for (int tl = 0; tl < 2; ++tl)
#pragma unroll
                for (int ks = 0; ks < 2; ++ks) kf[tl][ks] = *(const bf16x8*)(CKF + kfrag_off(2 * s + tl, ks, lane));
#pragma unroll
            for (int dt = 0; dt < 4; ++dt) vf[dt] = *(const bf16x8*)(CVF + vfrag_off(s, dt, lane));
            const int cb = 32 * s + 4 * grp;
            float i4[4] = {0.f, 0.f, 0.f, 0.f};
#pragma unroll
            for (int h = 0; h < 4; ++h) {
                f32x4 s0, s1; qk_step(kf, qf[h], s0, s1);
                f32x4 p0, p1;
#pragma unroll
                for (int i = 0; i < 4; ++i) {
                    p0[i] = (cb + i < nval) ? __builtin_amdgcn_exp2f(s0[i] - m[h]) * il[h] : 0.f;
                    p1[i] = (cb + 16 + i < nval) ? __builtin_amdgcn_exp2f(s1[i] - m[h]) * il[h] : 0.f; }
                i4[0] += p0[0] + p0[1]; i4[1] += p0[2] + p0[3]; i4[2] += p1[0] + p1[1]; i4[3] += p1[2] + p1[3];
                const bf16x8 pf = pack_p(p0, p1);
#pragma unroll
                for (int dt = 0; dt < 4; ++dt) st[h].o[dt] = MFMA16(vf[dt], pf, st[h].o[dt]);
            }
            *(float2*)(imp + qi * 256 + 16 * s + 2 * grp) = make_float2(i4[0], i4[1]);
            *(float2*)(imp + qi * 256 + 16 * s + 8 + 2 * grp) = make_float2(i4[2], i4[3]);
        }
        wave_lds_sync();
    }
    const int cur = t0 >> 6;
    {
        if (cur + 1 <= 16) {
            for (int idx = lane; idx < 256; idx += 64) sel[idx] = ((idx & 15) <= cur) ? (idx & 15) : -1;
        } else {
            for (int q0 = 0; q0 < 16; q0 += 4) {
                unsigned key[4][4];
#pragma unroll
                for (int qq = 0; qq < 4; ++qq)
#pragma unroll
                    for (int j = 0; j < 4; ++j) { const int blk = lane + 64 * j; const float v = imp[(q0 + qq) * 256 + blk];
                        key[qq][j] = (blk >= 1 && blk <= cur - 2) ? ((__float_as_uint(v) & 0xFFFFFF00u) | (unsigned)(255 - blk)) : 0u; }
                if (lane < 4) { sel[(q0 + lane) * 16 + 0] = 0; sel[(q0 + lane) * 16 + 1] = cur; sel[(q0 + lane) * 16 + 2] = cur - 1; }
                for (int n = 3; n < 16; ++n) {
                    unsigned best[4];
#pragma unroll
                    for (int qq = 0; qq < 4; ++qq) best[qq] = max(max(key[qq][0], key[qq][1]), max(key[qq][2], key[qq][3]));
#pragma unroll
                    for (int o = 1; o < 64; o <<= 1) {
#pragma unroll
                        for (int qq = 0; qq < 4; ++qq) best[qq] = max(best[qq], (unsigned)__shfl_xor((int)best[qq], o));
                    }
#pragma unroll
                    for (int qq = 0; qq < 4; ++qq) {
                        const int blk = 255 - (int)(best[qq] & 255u);
#pragma unroll
                        for (int j = 0; j < 4; ++j) if (lane + 64 * j == blk) key[qq][j] = 0u;
                        if (lane == 0) sel[(q0 + qq) * 16 + n] = blk;
                    }
                }
            }
        }
        wave_lds_sync();
    }
    float* acc = wl;
    {
#pragma unroll
        for (int h = 0; h < 4; ++h) { const float gs = sigmoidf_(grow[h]);
#pragma unroll
            for (int dt = 0; dt < 4; ++dt) *(f32x4*)(acc + (qi * 4 + h) * 64 + 16 * dt + 4 * grp) = st[h].o[dt] * gs; }
        wave_lds_sync();
    }
    {
        const bf16* KF = p.KWF + (size_t)g * T * 64; const bf16* VF = p.VWF + (size_t)g * T * 64;
        int kstart = t0 - 512; if (kstart < 0) kstart = 0; kstart &= ~31;
        const int nsteps = (t0 + 16 - kstart + 31) >> 5;
#pragma unroll
        for (int h = 0; h < 4; ++h) attw_init(st[h]);
        auto issue = [&](int s_, bf16x8 (&K)[2][2], bf16x8 (&V)[4]) {
            const int k0 = kstart + 32 * s_;
#pragma unroll
            for (int tl = 0; tl < 2; ++tl)
#pragma unroll
                for (int ks = 0; ks < 2; ++ks) K[tl][ks] = *(const bf16x8*)(KF + kfrag_off((k0 >> 4) + tl, ks, lane));
#pragma unroll
            for (int dt = 0; dt < 4; ++dt) V[dt] = *(const bf16x8*)(VF + vfrag_off(k0 >> 5, dt, lane));
        };
        auto compute = [&](int s_, const bf16x8 (&K)[2][2], const bf16x8 (&V)[4]) {
            const int k0 = kstart + 32 * s_;
            const bool need_mask = (k0 + 31 > t0) || (k0 < t0 + 15 - 512);
            const int pb = k0 + 4 * grp;
#pragma unroll
            for (int h = 0; h < 4; ++h) {
                f32x4 s0, s1; qk_step(K, qf[h], s0, s1);
                if (need_mask) {
#pragma unroll
                    for (int i = 0; i < 4; ++i) { const int p0 = pb + i, p1 = pb + 16 + i;
                        if (p0 > t || p0 < t - 512) s0[i] = -INFINITY; if (p1 > t || p1 < t - 512) s1[i] = -INFINITY; }
                }
                att_update(st[h], s0, s1, V);
            }
        };
        bf16x8 kA[2][2], vA[4], kB[2][2], vB[4];
        issue(0, kA, vA);
        for (int s = 0; s < nsteps; s += 2) {
            if (s + 1 < nsteps) issue(s + 1, kB, vB);
            compute(s, kA, vA);
            if (s + 1 < nsteps) { if (s + 2 < nsteps) issue(s + 2, kA, vA); compute(s + 1, kB, vB); }
        }
#pragma unroll
        for (int h = 0; h < 4; ++h) { const float lt = grp_sum(st[h].l); const float gs = sigmoidf_(grow[16 + h]) * (lt > 0.f ? 1.f / lt : 0.f);
#pragma unroll
            for (int dt = 0; dt < 4; ++dt) { f32x4* a = (f32x4*)(acc + (qi * 4 + h) * 64 + 16 * dt + 4 * grp); *a = *a + st[h].o[dt] * gs; } }
        wave_lds_sync();
    }
    *(int4*)(p.SEL + ((size_t)g * T + t0) * 16 + lane * 4) = *(const int4*)(sel + lane * 4);
#pragma unroll 4
    for (int q = 0; q < 16; ++q) *(f32x4*)(p.NSACC + (size_t)(t0 + q) * 512 + g * 256 + 4 * lane) = *(const f32x4*)(acc + q * 256 + 4 * lane);
    wave_lds_sync();
}

__device__ __forceinline__ void nsa_slc_item(const KP& p, int tq, int g, int lane) {
    asm volatile("" : "+v"(lane));
    const int l15 = lane & 15, grp = lane >> 4, hn = lane & 3;
    const bf16* KF = p.KSF + (size_t)g * T * 64; const bf16* VF = p.VSF + (size_t)g * T * 64;
    const int* selp = p.SEL + ((size_t)g * T + tq) * 16;
    int sb[16];
#pragma unroll
    for (int i = 0; i < 16; ++i) sb[i] = __builtin_amdgcn_readfirstlane(selp[i]);
    bf16x8 qs[2];
#pragma unroll
    for (int ks = 0; ks < 2; ++ks) qs[ks] = *(const bf16x8*)(p.QB + (size_t)tq * 512 + (g * 4 + hn) * 64 + 32 * ks + 8 * grp);
    AttW a; attw_init(a);
    bf16x8 kf[2][2][2], vf[2][4];
    auto issue = [&](int i, int buf) {
        const int blk = sb[i >> 1]; int k0 = blk * 64 + 32 * (i & 1); if (blk < 0 || k0 > tq) k0 = 0;
#pragma unroll
        for (int tl = 0; tl < 2; ++tl)
#pragma unroll
            for (int ks = 0; ks < 2; ++ks) kf[buf][tl][ks] = *(const bf16x8*)(KF + kfrag_off((k0 >> 4) + tl, ks, lane));
#pragma unroll
        for (int dt = 0; dt < 4; ++dt) vf[buf][dt] = *(const bf16x8*)(VF + vfrag_off(k0 >> 5, dt, lane));
    };
    issue(0, 0);
#pragma unroll
    for (int i = 0; i < 32; ++i) {
        const int buf = i & 1;
        if (i + 1 < 32) issue(i + 1, buf ^ 1);
        const int blk = sb[i >> 1]; const int k0 = blk * 64 + 32 * (i & 1);
        const bool dead = (blk < 0) || (k0 > tq);
        f32x4 s0, s1; qk_step(kf[buf], qs, s0, s1);
        const int pb = k0 + 4 * grp;
#pragma unroll
        for (int j = 0; j < 4; ++j) { if (dead || pb + j > tq) s0[j] = -INFINITY; if (dead || pb + 16 + j > tq) s1[j] = -INFINITY; }
        att_update(a, s0, s1, vf[buf]);
    }
    const float lt = grp_sum(a.l);
    if (l15 < 4) {
        const float gs = sigmoidf_(p.BIGF[(size_t)tq * PA + C_GATE + 8 + g * 4 + l15]) * (lt > 0.f ? 1.f / lt : 0.f);
#pragma unroll
        for (int dt = 0; dt < 4; ++dt) {
            const size_t o = (size_t)tq * 512 + g * 256 + l15 * 64 + 16 * dt + 4 * grp;
            const f32x4 base = *(const f32x4*)(p.NSACC + o); const f32x4 v = base + a.o[dt] * gs;
            uint2 w; w.x = pk2(v[0], v[1]); w.y = pk2(v[2], v[3]);
            *(uint2*)(p.MIXB + (size_t)tq * 1024 + g * 256 + l15 * 64 + 16 * dt + 4 * grp) = w;
        }
    }
}

__device__ __forceinline__ void ph_compress(const KP& p, const Fr& F) {
    float* flat = (float*)F.lds;
    float* hid = (float*)(F.lds + 32768);
    float* res = (float*)(F.lds + 32768 + 2048);
    const float* H0 = p.BIGF;
    const int tid = F.tid;
    for (int item = F.bid; item < 512; item += F.G) {
        const int c = item & 511, s = item >> 9;
        for (int e = tid; e < 8192; e += NTHR) {
            const int kv = e >> 12, g = (e >> 11) & 1, k = e & 2047, i = k >> 6, d = k & 63;
            const int row = c * 32 + i;
            float v;
            if (s == 0) v = H0[(size_t)row * PA + C_KC + kv * 128 + g * 64 + d];
            else { const int b = s - 1; const int page = p.page_table[b * NPAGES + (row >> 7)];
                   v = p.cache_cmp[((((size_t)page * 128 + (row & 127)) * 2 + kv) * 2 + g) * 64 + d]; }
            flat[e] = v + p.cpe[(kv * 32 + i) * 64 + d];
        }
        __syncthreads();
        {
            const int kv = tid >> 8, g = (tid >> 7) & 1, j = tid & 127;
            const float* w = p.cw1 + (size_t)kv * 2048 * 128 + j;
            const float* fl = flat + (kv * 2 + g) * 2048;
            float acc = p.cb1[kv * 128 + j];
            for (int k = 0; k < 2048; ++k) acc += fl[k] * w[(size_t)k * 128];
            hid[(kv * 2 + g) * 128 + j] = gelu_tanh(acc);
        }
        __syncthreads();
        if (tid < 256) {
            const int kv = tid >> 7, g = (tid >> 6) & 1, d = tid & 63;
            const float* w = p.cw2 + (size_t)kv * 128 * 64 + d;
            const float* hh = hid + (kv * 2 + g) * 128;
            float acc = 0.f;
            for (int j = 0; j < 128; ++j) acc += hh[j] * w[j * 64];
            res[(kv * 2 + g) * 64 + d] = acc;
        }
        __syncthreads();
        if (tid < 256) {
            const int kv = tid >> 7, g = (tid >> 6) & 1, d = tid & 63;
            const float* rr = res + (kv * 2 + g) * 64;
            float v = rr[d];
            if (kv == 0) {
                const int pos = (c + 1) * 32 - 1; const float2 cs = p.ROPE[pos * 32 + (d & 31)];
                const float x1 = rr[d & 31], x2 = rr[(d & 31) + 32];
                v = (d < 32) ? (x1 * cs.x - x2 * cs.y) : (x2 * cs.x + x1 * cs.y);
                p.CK[(((size_t)s * 512 + c) * 2 + g) * 64 + d] = v;
                if (s == 0) p.CKF[(size_t)g * 512 * 64 + kfrag_elem(c, d)] = (bf16)f2bf(v);
            } else { p.CV[(((size_t)s * 512 + c) * 2 + g) * 64 + d] = v; if (s == 0) p.CVF[(size_t)g * 512 * 64 + vfrag_elem(c, d)] = (bf16)f2bf(v); }
        }
        __syncthreads();
    }
}

__device__ __forceinline__ void ph_gdn_prep(const KP& p, const Fr& F) {
    const float* H0 = p.BIGF; const int lane = F.lane;
    for (int item = T * 8 + F.gw; item < TS * 8; item += F.NGW) {
        const int r = item >> 3, h = item & 7;
        const bool smp = r >= T; const int b = r - T;
        float cv[3];
#pragma unroll
        for (int part = 0; part < 3; ++part) {
            const int ch = part * 512 + h * 64 + lane;
            float acc = 0.f;
#pragma unroll
            for (int j = 0; j < 4; ++j) {
                float u;
                if (!smp) { const int t = r + j - 3; u = (t >= 0) ? H0[(size_t)t * PA + C_GQKV + ch] : 0.f; }
                else { u = (j < 3) ? p.st_gconv[((size_t)b * 3 + j) * 1536 + ch] : H0[(size_t)r * PA + C_GQKV + ch]; }
                acc += p.gconv_w[j * 1536 + ch] * u;
            }
            cv[part] = siluf_(acc);
        }
        const float qn = wave_sum(cv[0] * cv[0]), kn = wave_sum(cv[1] * cv[1]);
        const size_t o = ((size_t)r * 8 + h) * 64 + lane;
        p.GQ[o] = cv[0] * rsqrtf(qn + NORM_EPS) * 0.125f;
        p.GK[o] = cv[1] * rsqrtf(kn + NORM_EPS);
        p.GV[o] = cv[2];
        if (lane == 0) {
            const float av = H0[(size_t)r * PA + C_A + h], bt = H0[(size_t)r * PA + C_BT + h];
            p.Gg[(size_t)r * 8 + h] = -expf(p.gA[h]) * softplusf_(av + p.gdt[h]);
            p.Gb[(size_t)r * 8 + h] = sigmoidf_(bt);
        }
    }
    const size_t gt = (size_t)F.bid * NTHR + F.tid, GT = (size_t)F.G * NTHR;
    for (size_t idx = gt; idx < (size_t)3 * 1536; idx += GT) {
        const int j = (int)(idx / 1536), ch = (int)(idx % 1536);
        p.out[O_GCONV_P + idx] = H0[(size_t)(T - 3 + j) * PA + C_GQKV + ch];
    }
    for (size_t idx = gt; idx < (size_t)NSMP * 3 * 1536; idx += GT) {
        const int b = (int)(idx / (3 * 1536)), j = (int)((idx / 1536) % 3), ch = (int)(idx % 1536);
        p.out[O_GCONV_S + idx] = (j < 2) ? p.st_gconv[((size_t)b * 3 + j + 1) * 1536 + ch] : H0[(size_t)(T + b) * PA + C_GQKV + ch];
    }
}

template <int NH, class KF>
__device__ __forceinline__ void wave_attend(const float* qs, float* sc, int scstride, int nkeys, KF kf, float (&outv)[NH], float (&den)[NH], int lane, float* mxout = nullptr) {
    float mx[NH];
#pragma unroll
    for (int h = 0; h < NH; ++h) mx[h] = -INFINITY;
    for (int j = lane; j < nkeys; j += 64) {
        const float *kp, *vp; const bool ok = kf(j, kp, vp);
        float s[NH];
#pragma unroll
        for (int h = 0; h < NH; ++h) s[h] = 0.f;
        if (ok) {
            for (int d4 = 0; d4 < 16; ++d4) {
                const float4 kvv = ((const float4*)kp)[d4];
#pragma unroll
                for (int h = 0; h < NH; ++h) { const float* q = qs + h * 64 + d4 * 4; s[h] += kvv.x * q[0] + kvv.y * q[1] + kvv.z * q[2] + kvv.w * q[3]; }
            }
        }
#pragma unroll
        for (int h = 0; h < NH; ++h) { const float v = ok ? s[h] * 0.125f : -INFINITY; sc[h * scstride + j] = v; mx[h] = fmaxf(mx[h], v); }
    }
#pragma unroll
    for (int h = 0; h < NH; ++h) { mx[h] = wave_max(mx[h]); if (!(mx[h] > -INFINITY)) mx[h] = 0.f; if (mxout) mxout[h] = mx[h]; }
    float sm[NH];
#pragma unroll
    for (int h = 0; h < NH; ++h) sm[h] = 0.f;
    for (int j = lane; j < nkeys; j += 64) {
#pragma unroll
        for (int h = 0; h < NH; ++h) { const float v = sc[h * scstride + j]; const float pp = (v == -INFINITY) ? 0.f : expf(v - mx[h]); sc[h * scstride + j] = pp; sm[h] += pp; }
    }
#pragma unroll
    for (int h = 0; h < NH; ++h) { sm[h] = wave_sum(sm[h]); den[h] = sm[h] > 0.f ? sm[h] : 1.f; }
    wave_lds_sync();
    {
        const int kq = lane >> 4, d4 = lane & 15;
        float4 acc[NH];
#pragma unroll
        for (int h = 0; h < NH; ++h) acc[h] = make_float4(0.f, 0.f, 0.f, 0.f);
        for (int j0 = 0; j0 < nkeys; j0 += 32) {
            float4 v[8];
#pragma unroll
            for (int u = 0; u < 8; ++u) { const int j = j0 + 4 * u + kq; const float *kp, *vp; const bool ok = (j < nkeys) && kf(j, kp, vp);
                v[u] = ok ? *(const float4*)(vp + 4 * d4) : make_float4(0.f, 0.f, 0.f, 0.f); }
#pragma unroll
            for (int u = 0; u < 8; ++u) { const int j = j0 + 4 * u + kq;
#pragma unroll
                for (int h = 0; h < NH; ++h) { const float pp = (j < nkeys) ? sc[h * scstride + j] : 0.f;
                    acc[h].x += pp * v[u].x; acc[h].y += pp * v[u].y; acc[h].z += pp * v[u].z; acc[h].w += pp * v[u].w; } }
        }
#pragma unroll
        for (int h = 0; h < NH; ++h) {
            float4 a = acc[h];
            a.x += __shfl_xor(a.x, 16); a.y += __shfl_xor(a.y, 16); a.z += __shfl_xor(a.z, 16); a.w += __shfl_xor(a.w, 16);
            a.x += __shfl_xor(a.x, 32); a.y += __shfl_xor(a.y, 32); a.z += __shfl_xor(a.z, 32); a.w += __shfl_xor(a.w, 32);
            const float x0 = __shfl(a.x, lane >> 2), x1 = __shfl(a.y, lane >> 2), x2 = __shfl(a.z, lane >> 2), x3 = __shfl(a.w, lane >> 2);
            const int cc = lane & 3; outv[h] = cc == 0 ? x0 : (cc == 1 ? x1 : (cc == 2 ? x2 : x3));
        }
    }
#pragma unroll
    for (int h = 0; h < NH; ++h) outv[h] /= den[h];
    wave_lds_sync();
}

__device__ __forceinline__ void nsa_smp_cs(const KP& p, int b, int g, float* wl, int lane) {
    float* qs = wl; float* sc = wl + 256; float* imp = wl + 256 + 4 * 1088; int* sel = (int*)(wl + 256 + 4 * 1088 + 320); long long* bb = (long long*)(wl + 256 + 4 * 1088 + 320 + 16);
    const int r = T + b; const int qpos = T;
    const float* grow = p.BIGF + (size_t)r * PA + C_GATE;
#pragma unroll
    for (int h = 0; h < 4; ++h) qs[h * 64 + lane] = p.QR[(size_t)r * 512 + (g * 4 + h) * 64 + lane];
    wave_lds_sync();
    float ocmp[4], oslc[4], den[4];
    {
        const float* CKp = p.CK + (size_t)(1 + b) * 512 * 128; const float* CVp = p.CV + (size_t)(1 + b) * 512 * 128;
        auto kf = [&](int j, const float*& kp, const float*& vp) -> bool { kp = CKp + (j * 2 + g) * 64; vp = CVp + (j * 2 + g) * 64; return true; };
        wave_attend<4>(qs, sc, 1088, 512, kf, ocmp, den, lane);
        for (int blk = lane; blk < 320; blk += 64) {
            float v = 0.f;
            if (blk < 256) {
#pragma unroll
                for (int h = 0; h < 4; ++h) v += (sc[h * 1088 + 2 * blk] + sc[h * 1088 + 2 * blk + 1]) / den[h];
            }
            imp[blk] = v;
        }
        wave_lds_sync();
    }
    {
        const int cur = qpos >> 6;
        float val[5];
#pragma unroll
        for (int j = 0; j < 5; ++j) { const int blk = lane + 64 * j; val[j] = (blk >= 1 && blk <= cur - 2) ? imp[blk] : -1.f; }
        if (lane == 0) { sel[0] = 0; sel[1] = cur; sel[2] = cur - 1; }
        for (int n = 3; n < 16; ++n) {
            float bv = -2.f; int bi = 0x7fffffff;
#pragma unroll
            for (int j = 0; j < 5; ++j) if (val[j] > bv) { bv = val[j]; bi = lane + 64 * j; }
#pragma unroll
            for (int o = 1; o < 64; o <<= 1) { const float ov = __shfl_xor(bv, o); const int oi = __shfl_xor(bi, o); if (ov > bv || (ov == bv && oi < bi)) { bv = ov; bi = oi; } }
#pragma unroll
            for (int j = 0; j < 5; ++j) if (lane + 64 * j == bi) val[j] = -3.f;
            if (lane == 0) sel[n] = bi;
        }
        wave_lds_sync();
        if (lane < 16) { const int blk = sel[lane]; long long o = 0;
            if (blk < 256) { const int page = p.page_table[b * NPAGES + (blk >> 1)]; o = ((long long)page * 128 + (blk & 1) * 64) * 256; }
            bb[lane] = o; }
        wave_lds_sync();
    }
    {
        auto kf = [&](int j, const float*& kp, const float*& vp) -> bool {
            const int blk = sel[j >> 6]; const int pos = blk * 64 + (j & 63); if (pos > qpos) return false;
            if (pos == T) { kp = p.KS + (size_t)r * 128 + g * 64; vp = p.VS + (size_t)r * 128 + g * 64; return true; }
            const float* base = p.cache_slc + bb[j >> 6] + (j & 63) * 256;
            kp = base + g * 64; vp = base + 128 + g * 64; return true; };
        wave_attend<4>(qs, sc, 1088, 1024, kf, oslc, den, lane);
    }
#pragma unroll
    for (int h = 0; h < 4; ++h) {
        const int hh = g * 4 + h;
        p.SMIXF[((size_t)b * 3 + 0) * 512 + hh * 64 + lane] = sigmoidf_(grow[hh]) * ocmp[h];
        p.SMIXF[((size_t)b * 3 + 1) * 512 + hh * 64 + lane] = sigmoidf_(grow[8 + hh]) * oslc[h];
    }
    wave_lds_sync();
}
__device__ __forceinline__ void nsa_smp_win(const KP& p, int b, int g, float* wl, int lane) {
    float* qs = wl; float* sc = wl + 256;
    const int r = T + b;
    const float* grow = p.BIGF + (size_t)r * PA + C_GATE;
#pragma unroll
    for (int h = 0; h < 4; ++h) qs[h * 64 + lane] = p.QR[(size_t)r * 512 + (g * 4 + h) * 64 + lane];
    wave_lds_sync();
    float owin[4], den[4];
    auto kf = [&](int j, const float*& kp, const float*& vp) -> bool {
        if (j == 512) { kp = p.KW + (size_t)r * 128 + g * 64; vp = p.VW + (size_t)r * 128 + g * 64; return true; }
        const float* base = p.st_win + ((size_t)b * 512 + j) * 256;
        kp = base + g * 64; vp = base + 128 + g * 64; return true; };
    wave_attend<4>(qs, sc, 528, 513, kf, owin, den, lane);
#pragma unroll
    for (int h = 0; h < 4; ++h) { const int hh = g * 4 + h; p.SMIXF[((size_t)b * 3 + 2) * 512 + hh * 64 + lane] = sigmoidf_(grow[16 + hh]) * owin[h]; }
    wave_lds_sync();
}

__device__ __forceinline__ void gdn_scan_item(const KP& p, int item, float* wl, int lane) {
    asm volatile("" : "+v"(lane));
    float* kq = wl;
    const int b = (item >> 3) - 1, h = item & 7;
    const int r = T + b; const size_t o = ((size_t)r * 8 + h) * 64;
    kq[lane] = p.GK[o + lane]; kq[64 + lane] = p.GQ[o + lane];
    wave_lds_sync();
    const float dec = expf(p.Gg[(size_t)r * 8 + h]), bt = p.Gb[(size_t)r * 8 + h];
    const float* Sp = p.st_gS + ((size_t)b * 8 + h) * 4096 + lane;
    float* so = p.out + O_GS_S + ((size_t)b * 8 + h) * 4096 + lane;
    float S[64]; float kv = 0.f;
#pragma unroll
    for (int i = 0; i < 64; ++i) { S[i] = Sp[i * 64] * dec; kv += kq[i] * S[i]; }
    const float vn = (p.GV[o + lane] - kv) * bt;
    float ov = 0.f;
#pragma unroll
    for (int i = 0; i < 64; ++i) { const float sn = S[i] + kq[i] * vn; ov += kq[64 + i] * sn; so[i * 64] = sn; }
    p.OG[o + lane] = ov;
    wave_lds_sync();
}

constexpr int GDN_WL = 34816;
__device__ __forceinline__ int kperm(int ks, int grp, int j) { return 32 * ks + 16 * (j >> 2) + 4 * grp + (j & 3); }

__device__ __forceinline__ void gdn_chunk_unit(const KP& p, int unit, unsigned char* ldsb, int woff, int lane) {
    asm volatile("" : "+v"(lane), "+s"(woff));
    unsigned char* wlb = ldsb + woff;
    const int n = unit >> 3, h = unit & 7, t0 = 64 * n;
    const int l15 = lane & 15, grp = lane >> 4;
    float* Af = (float*)wlb; bf16* kt = (bf16*)(wlb + 16384); bf16* qt = kt + 64 * 72; bf16* tmp = (bf16*)wlb;
    {
        const float* H0 = p.BIGF;
        float w[3][4], u1[3], u2[3], u3[3];
#pragma unroll
        for (int part = 0; part < 3; ++part) {
            const int ch = part * 512 + h * 64 + lane;
#pragma unroll
            for (int j = 0; j < 4; ++j) w[part][j] = p.gconv_w[j * 1536 + ch];
            u1[part] = (t0 >= 1) ? H0[(size_t)(t0 - 1) * PA + C_GQKV + ch] : 0.f;
            u2[part] = (t0 >= 2) ? H0[(size_t)(t0 - 2) * PA + C_GQKV + ch] : 0.f;
            u3[part] = (t0 >= 3) ? H0[(size_t)(t0 - 3) * PA + C_GQKV + ch] : 0.f;
        }
        int roff = 0;
#pragma unroll 4
        for (int i = 0; i < 64; ++i) {
            float cv[3];
#pragma unroll
            for (int part = 0; part < 3; ++part) {
                const float u0 = H0[(size_t)t0 * PA + C_GQKV + part * 512 + h * 64 + lane + roff];
                cv[part] = siluf_(w[part][0] * u3[part] + w[part][1] * u2[part] + w[part][2] * u1[part] + w[part][3] * u0);
                u3[part] = u2[part]; u2[part] = u1[part]; u1[part] = u0;
            }
            roff += PA; asm volatile("" : "+s"(roff));
            const float qn = wave_sum(cv[0] * cv[0]), kn = wave_sum(cv[1] * cv[1]);
            qt[i * 72 + lane] = (bf16)f2bf(cv[0] * rsqrtf(qn + NORM_EPS) * 0.125f);
            kt[i * 72 + lane] = (bf16)f2bf(cv[1] * rsqrtf(kn + NORM_EPS));
            p.GV[((size_t)(t0 + i) * 8 + h) * 64 + lane] = cv[2];
        }
    }
    const float gl_ = -fexp_(p.gA[h]) * softplusf_(p.BIGF[(size_t)(t0 + lane) * PA + C_A + h] + p.gdt[h]);
    const float beta = sigmoidf_(p.BIGF[(size_t)(t0 + lane) * PA + C_BT + h]);
    float gc = gl_;
#pragma unroll
    for (int o = 1; o < 64; o <<= 1) { const float tv = __shfl_up(gc, o); if (lane >= o) gc += tv; }
    const float gclast = __shfl(gc, 63);
#define GPAD(i) ((float*)(kt + (i) * 72 + 64))
    { float* pd = GPAD(lane); pd[0] = gc; pd[1] = beta; pd[2] = fexp_(gc); pd[3] = fexp_(gclast - gc); }
    wave_lds_sync();
    bf16* QKF = p.G_QKF + (size_t)unit * 4096;
#pragma unroll
    for (int it = 0; it < 4; ++it) {
        const int i = 16 * it + l15;
        const float gci = GPAD(i)[0], bi = GPAD(i)[1];
        bf16x8 bk[2], bq[2];
#pragma unroll
        for (int ks = 0; ks < 2; ++ks) { bk[ks] = *(const bf16x8*)(kt + i * 72 + 32 * ks + 8 * grp); bq[ks] = *(const bf16x8*)(qt + i * 72 + 32 * ks + 8 * grp); }
#pragma unroll
        for (int jt = 0; jt < 4; ++jt) {
            uint2 qkp = make_uint2(0u, 0u);
            if (jt <= it) {
                bf16x8 ak[2];
#pragma unroll
                for (int ks = 0; ks < 2; ++ks) ak[ks] = *(const bf16x8*)(kt + (16 * jt + l15) * 72 + 32 * ks + 8 * grp);
                f32x4 aa = {0.f, 0.f, 0.f, 0.f}, aq = {0.f, 0.f, 0.f, 0.f};
                aa = MFMA16(ak[0], bk[0], aa); aa = MFMA16(ak[1], bk[1], aa);
                aq = MFMA16(ak[0], bq[0], aq); aq = MFMA16(ak[1], bq[1], aq);
                f32x4 av, qv;
#pragma unroll
                for (int r = 0; r < 4; ++r) {
                    const int j = 16 * jt + 4 * grp + r; const float gcj = GPAD(j)[0];
                    const float e = (j <= i) ? fexp_(gci - gcj) : 0.f;
                    av[r] = (j < i) ? bi * aa[r] * e : 0.f; qv[r] = aq[r] * e;
                }
                *(f32x4*)(Af + i * 64 + 16 * jt + 4 * grp) = av;
                qkp.x = pk2(qv[0], qv[1]); qkp.y = pk2(qv[2], qv[3]);
            }
            *(uint2*)(QKF + ((size_t)(it * 2 + (jt >> 1)) * 64 + lane) * 8 + (jt & 1) * 4) = qkp;
        }
    }
    wave_lds_sync();
    {
        float* UF = p.G_UF + (size_t)unit * 4096;
        const int vq = lane >> 4;
#pragma unroll
        for (int pass = 0; pass < 2; ++pass) {
            float x[64];
            int goff = 0;
#pragma unroll
            for (int i = 0; i < 64; ++i) {
                const float bi = GPAD(i)[1];
                float acc;
                if (pass == 0) { acc = p.GV[((size_t)t0 * 8 + h) * 64 + lane + goff] * bi; goff += 512; asm volatile("" : "+s"(goff)); }
                else { const float ei = GPAD(i)[2];
                       acc = __uint_as_float((unsigned)kt[i * 72 + lane] << 16) * bi * ei; }
#pragma unroll
                for (int jj = 0; jj < (i + 3) / 4; ++jj) {
                    const float4 a4 = *(const float4*)(Af + i * 64 + 4 * jj);
                    acc -= a4.x * x[4 * jj + 0];
                    if (4 * jj + 1 < i) acc -= a4.y * x[4 * jj + 1];
                    if (4 * jj + 2 < i) acc -= a4.z * x[4 * jj + 2];
                    if (4 * jj + 3 < i) acc -= a4.w * x[4 * jj + 3];
                }
                x[i] = acc;
                if ((i & 3) == 3) asm volatile("" ::: "memory");
            }
            if (pass == 0) {
#pragma unroll
                for (int c4 = 0; c4 < 16; ++c4) {
                    const int mt = c4 >> 2, lp = l15 + 16 * (c4 & 3);
                    *(f32x4*)(UF + ((size_t)(vq * 4 + mt) * 64 + lp) * 4) = (f32x4){x[4 * c4], x[4 * c4 + 1], x[4 * c4 + 2], x[4 * c4 + 3]};
                }
            } else {
                wave_lds_sync();
#pragma unroll
                for (int c = 0; c < 64; ++c) tmp[c * 72 + lane] = (bf16)f2bf(-x[c]);
            }
            asm volatile("" ::: "memory");
        }
    }
    wave_lds_sync();
    {
        bf16* WF = p.G_WF + (size_t)unit * 4096; bf16* QGF = p.G_QGF + (size_t)unit * 4096; bf16* KDF = p.G_KDF + (size_t)unit * 4096;
#pragma unroll
        for (int mt = 0; mt < 4; ++mt) {
            const float egc = GPAD(16 * mt + l15)[2];
#pragma unroll
            for (int ks = 0; ks < 2; ++ks) {
                const int c = 16 * mt + l15, k0 = 32 * ks + 4 * grp;
                const uint2 w0 = *(const uint2*)(tmp + c * 72 + k0), w1 = *(const uint2*)(tmp + c * 72 + k0 + 16);
                v4u wv; wv.x = w0.x; wv.y = w0.y; wv.z = w1.x; wv.w = w1.y;
                *(v4u*)(WF + ((size_t)(mt * 2 + ks) * 64 + lane) * 8) = wv;
                const uint2 q0 = *(const uint2*)(qt + c * 72 + k0), q1 = *(const uint2*)(qt + c * 72 + k0 + 16);
                v4u qv;
                qv.x = pk2(__uint_as_float(q0.x << 16) * egc, __uint_as_float(q0.x & 0xffff0000u) * egc); qv.y = pk2(__uint_as_float(q0.y << 16) * egc, __uint_as_float(q0.y & 0xffff0000u) * egc);
                qv.z = pk2(__uint_as_float(q1.x << 16) * egc, __uint_as_float(q1.x & 0xffff0000u) * egc); qv.w = pk2(__uint_as_float(q1.y << 16) * egc, __uint_as_float(q1.y & 0xffff0000u) * egc);
                *(v4u*)(QGF + ((size_t)(mt * 2 + ks) * 64 + lane) * 8) = qv;
                float kd[8];
#pragma unroll
                for (int j = 0; j < 8; ++j) { const int cc = kperm(ks, grp, j); kd[j] = __uint_as_float((unsigned)kt[cc * 72 + 16 * mt + l15] << 16) * GPAD(cc)[3]; }
                v4u kv; kv.x = pk2(kd[0], kd[1]); kv.y = pk2(kd[2], kd[3]); kv.z = pk2(kd[4], kd[5]); kv.w = pk2(kd[6], kd[7]);
                *(v4u*)(KDF + ((size_t)(mt * 2 + ks) * 64 + lane) * 8) = kv;
            }
        }
        if (lane == 0) p.G_GL[unit] = fexp_(gclast);
    }
    wave_lds_sync();
#undef GPAD
}

constexpr int CH_SLOT = 32768;
__device__ __forceinline__ void gdn_chain_wg(const KP& p, int h, int wave, int lane, unsigned char* ldsb) {
    asm volatile("" : "+v"(lane));
    const int l15 = lane & 15, grp = lane >> 4;
    float* GLs = (float*)(ldsb + 4 * CH_SLOT);
    if (wave < 4) GLs[wave * 64 + lane] = p.G_GL[(size_t)(wave * 64 + lane) * 8 + h];
#define CH_BAR() do { asm volatile("s_waitcnt lgkmcnt(0)" ::: "memory"); __builtin_amdgcn_s_barrier(); asm volatile("" ::: "memory"); } while (0)
    if (wave >= 4) {
        const int lw = wave - 4;
        const unsigned char* gb = (lw == 0) ? (const unsigned char*)p.G_WF : (lw == 1) ? (const unsigned char*)p.G_KDF : (const unsigned char*)p.G_UF + (size_t)(lw - 2) * 8192;
        const size_t ustride = (lw < 2) ? 8192 : 16384;
        gb += (size_t)h * ustride + (size_t)lane * 16;
        auto src = [&](int n, int k) -> const v4u* { return (const v4u*)(gb + (size_t)n * 8 * ustride + k * 1024); };
        v4u rs[4][8];
#pragma unroll
        for (int j = 0; j < 4; ++j)
#pragma unroll
            for (int k = 0; k < 8; ++k) rs[j][k] = *src(j, k);
#pragma unroll
        for (int j = 0; j < 2; ++j) {
#pragma unroll
            for (int k = 0; k < 8; ++k) { *(v4u*)(ldsb + j * CH_SLOT + (lw * 512 + k * 64 + lane) * 16) = rs[j][k]; rs[j][k] = *src(4 + j, k); }
        }
        CH_BAR();
        for (int n0 = 0; n0 < 256; n0 += 4) {
#pragma unroll
            for (int j = 0; j < 4; ++j) {
                const int n = n0 + j, st = n + 2;
                if (st < 256) {
                    const int set = (j + 2) & 3;
#pragma unroll
                    for (int k = 0; k < 8; ++k) { *(v4u*)(ldsb + (st & 3) * CH_SLOT + (lw * 512 + k * 64 + lane) * 16) = rs[set][k]; if (st + 4 < 256) rs[set][k] = *src(st + 4, k); }
                }
                CH_BAR();
            }
        }
#undef CH_BAR
        return;
    }
    const int vq = wave;
    f32x4 S[4];
#pragma unroll
    for (int i = 0; i < 4; ++i) S[i] = (f32x4){0.f, 0.f, 0.f, 0.f};
    asm volatile("s_waitcnt lgkmcnt(0)" ::: "memory"); __builtin_amdgcn_s_barrier(); asm volatile("" ::: "memory");
    for (int n = 0; n < 256; ++n) {
        const unsigned char* sl = ldsb + (n & 3) * CH_SLOT;
        bf16x8 wf[4][2], kdf[4][2]; f32x4 uf[4];
#pragma unroll
        for (int mt = 0; mt < 4; ++mt) {
#pragma unroll
            for (int ks = 0; ks < 2; ++ks) { wf[mt][ks] = *(const bf16x8*)(sl + ((mt * 2 + ks) * 64 + lane) * 16); kdf[mt][ks] = *(const bf16x8*)(sl + 8192 + ((mt * 2 + ks) * 64 + lane) * 16); }
            uf[mt] = *(const f32x4*)(sl + 16384 + ((vq * 4 + mt) * 64 + lane) * 16);
        }
        const float gl = GLs[n];
        const size_t fo = ((size_t)((n * 8 + h) * 4 + vq) * 2) * 512;
        bf16x8 sB[2];
#pragma unroll
        for (int ks = 0; ks < 2; ++ks) { sB[ks] = pack_p(S[2 * ks], S[2 * ks + 1]); *(bf16x8*)(p.G_SPF + fo + ((size_t)ks * 64 + lane) * 8) = sB[ks]; }
        f32x4 v[4];
#pragma unroll
        for (int mt = 0; mt < 4; ++mt) { v[mt] = uf[mt]; v[mt] = MFMA16(wf[mt][0], sB[0], v[mt]); v[mt] = MFMA16(wf[mt][1], sB[1], v[mt]); }
        bf16x8 vB[2];
#pragma unroll
        for (int ks = 0; ks < 2; ++ks) { vB[ks] = pack_p(v[2 * ks], v[2 * ks + 1]); *(bf16x8*)(p.G_VNF + fo + ((size_t)ks * 64 + lane) * 8) = vB[ks]; }
#pragma unroll
        for (int mt = 0; mt < 4; ++mt) { S[mt] = S[mt] * gl; S[mt] = MFMA16(kdf[mt][0], vB[0], S[mt]); S[mt] = MFMA16(kdf[mt][1], vB[1], S[mt]); }
        asm volatile("s_waitcnt lgkmcnt(0)" ::: "memory"); __builtin_amdgcn_s_barrier(); asm volatile("" ::: "memory");
    }
    float* so = p.out + O_GS_P + (size_t)h * 4096;
#pragma unroll
    for (int mt = 0; mt < 4; ++mt)
#pragma unroll
        for (int r = 0; r < 4; ++r) so[(16 * mt + 4 * grp + r) * 64 + 16 * vq + l15] = S[mt][r];
}

__device__ __forceinline__ void gdn_out_unit(const KP& p, int unit, int lane) {
    asm volatile("" : "+v"(lane));
    const int n = unit >> 3, h = unit & 7, t0 = 64 * n; const int l15 = lane & 15, grp = lane >> 4;
    const bf16* QGF = p.G_QGF + (size_t)unit * 4096; const bf16* QKF = p.G_QKF + (size_t)unit * 4096;
    f32x4 o[4][4];
#pragma unroll
    for (int mt = 0; mt < 4; ++mt)
#pragma unroll
        for (int vq = 0; vq < 4; ++vq) o[mt][vq] = (f32x4){0.f, 0.f, 0.f, 0.f};
#pragma unroll
    for (int ks = 0; ks < 2; ++ks) {
        bf16x8 sp[4], vn[4];
#pragma unroll
        for (int vq = 0; vq < 4; ++vq) { const size_t fo = ((size_t)(unit * 4 + vq) * 2 + ks) * 512 + (size_t)lane * 8; sp[vq] = *(const bf16x8*)(p.G_SPF + fo); vn[vq] = *(const bf16x8*)(p.G_VNF + fo); }
#pragma unroll
        for (int mt = 0; mt < 4; ++mt) {
            const bf16x8 qg = *(const bf16x8*)(QGF + ((size_t)(mt * 2 + ks) * 64 + lane) * 8), qk = *(const bf16x8*)(QKF + ((size_t)(mt * 2 + ks) * 64 + lane) * 8);
#pragma unroll
            for (int vq = 0; vq < 4; ++vq) { o[mt][vq] = MFMA16(qg, sp[vq], o[mt][vq]); o[mt][vq] = MFMA16(qk, vn[vq], o[mt][vq]); }
        }
    }
    float nw[4];
#pragma unroll
    for (int vq = 0; vq < 4; ++vq) nw[vq] = p.gnw[16 * vq + l15];
#pragma unroll
    for (int mt = 0; mt < 4; ++mt)
#pragma unroll
        for (int r = 0; r < 4; ++r) {
            float ss = 0.f;
#pragma unroll
            for (int vq = 0; vq < 4; ++vq) ss += o[mt][vq][r] * o[mt][vq][r];
            ss += __shfl_xor(ss, 1); ss += __shfl_xor(ss, 2); ss += __shfl_xor(ss, 4); ss += __shfl_xor(ss, 8);
            const float rs = rsqrtf(ss * (1.f / 64.f) + NORM_EPS);
            const int t = t0 + 16 * mt + 4 * grp + r;
            const float* zr = p.BIGF + (size_t)t * PA + C_Z + h * 64;
#pragma unroll
            for (int vq = 0; vq < 4; ++vq) p.MIXB[(size_t)t * 1024 + 512 + h * 64 + 16 * vq + l15] = (bf16)f2bf(o[mt][vq][r] * rs * nw[vq] * siluf_(zr[16 * vq + l15]));
        }
}

#define MFMA8(a, b, c) __builtin_amdgcn_mfma_f32_16x16x32_fp8_fp8((a), (b), (c), 0, 0, 0)
__device__ __forceinline__ long pack_fp8(const f32x4& a, const f32x4& b) {
    int w0 = 0, w1 = 0;
    w0 = __builtin_amdgcn_cvt_pk_fp8_f32(a[0], a[1], w0, false); w0 = __builtin_amdgcn_cvt_pk_fp8_f32(a[2], a[3], w0, true);
    w1 = __builtin_amdgcn_cvt_pk_fp8_f32(b[0], b[1], w1, false); w1 = __builtin_amdgcn_cvt_pk_fp8_f32(b[2], b[3], w1, true);
    return (long)(((unsigned long long)(unsigned)w1 << 32) | (unsigned long long)(unsigned)w0);
}
template <bool GEN>
__device__ __forceinline__ void nsa_slc_item8(const KP& p, int tq, int g, int lane) {
    asm volatile("" : "+v"(lane));
    const int l15 = lane & 15, grp = lane >> 4, hn = lane & 3;
    const unsigned char* KF = p.KS8 + (size_t)g * T * 64; const unsigned char* VF = p.VS8 + (size_t)g * T * 64;
    const int* selp = p.SEL + ((size_t)g * T + tq) * 16;
    int sb[16];
#pragma unroll
    for (int i = 0; i < 16; ++i) sb[i] = __builtin_amdgcn_readfirstlane(selp[i]);
    long qs[2];
#pragma unroll
    for (int ks = 0; ks < 2; ++ks) {
        const bf16x8 qb = *(const bf16x8*)(p.QB + (size_t)tq * 512 + (g * 4 + hn) * 64 + 32 * ks + 8 * grp);
        f32x4 a, b;
#pragma unroll
        for (int j = 0; j < 4; ++j) { a[j] = __uint_as_float((unsigned)(unsigned short)qb[j] << 16) * (1.f / QSCALE); b[j] = __uint_as_float((unsigned)(unsigned short)qb[4 + j] << 16) * (1.f / QSCALE); }
        qs[ks] = pack_fp8(a, b);
    }
    AttW a; attw_init(a);
    long kf[3][4][2], vf[3][2][4];
    auto issue = [&](int bi, int buf) {
        int blk = sb[bi]; if (GEN && (blk < 0 || blk * 64 > tq)) blk = 0;
        typedef long l2_t __attribute__((ext_vector_type(2)));
#pragma unroll
        for (int tl = 0; tl < 4; ++tl) { const l2_t x = *(const l2_t*)(KF + ((size_t)(blk * 4 + tl) * 64 + lane) * 16); kf[buf][tl][0] = x[0]; kf[buf][tl][1] = x[1]; }
#pragma unroll
        for (int dt = 0; dt < 4; ++dt) { const l2_t x = *(const l2_t*)(VF + ((size_t)(blk * 4 + dt) * 64 + lane) * 16); vf[buf][0][dt] = x[0]; vf[buf][1][dt] = x[1]; }
    };
    issue(0, 0); issue(1, 1);
#pragma unroll
    for (int bi = 0; bi < 16; ++bi) {
        const int buf = bi % 3;
        if (bi + 2 < 16) issue(bi + 2, (bi + 2) % 3);
        const int blk = sb[bi]; const int k0 = blk * 64;
        if (GEN && (blk < 0 || k0 > tq)) continue;
        const f32x4 z = {0.f, 0.f, 0.f, 0.f};
        f32x4 sc[4];
#pragma unroll
        for (int tl = 0; tl < 4; ++tl) { sc[tl] = MFMA8(kf[buf][tl][0], qs[0], z); sc[tl] = MFMA8(kf[buf][tl][1], qs[1], sc[tl]); }
        if (GEN ? (k0 + 63 > tq) : (bi == 1)) {
#pragma unroll
            for (int tl = 0; tl < 4; ++tl)
#pragma unroll
                for (int j = 0; j < 4; ++j) if (k0 + 16 * tl + 4 * grp + j > tq) sc[tl][j] = -INFINITY;
        }
        float mx = fmaxf(fmaxf(fmaxf(fmaxf(sc[0][0], sc[0][1]), fmaxf(sc[0][2], sc[0][3])), fmaxf(fmaxf(sc[1][0], sc[1][1]), fmaxf(sc[1][2], sc[1][3]))),
                         fmaxf(fmaxf(fmaxf(sc[2][0], sc[2][1]), fmaxf(sc[2][2], sc[2][3])), fmaxf(fmaxf(sc[3][0], sc[3][1]), fmaxf(sc[3][2], sc[3][3]))));
        mx = fmaxf(mx, __shfl_xor(mx, 16)); mx = fmaxf(mx, __shfl_xor(mx, 32));
        const float mn = fmaxf(a.m, mx * QSCALE);
        const float alpha = __builtin_amdgcn_exp2f(a.m - mn);
        const float mb = 7.f - mn;
        f32x4 pp[4]; float sum = 0.f;
#pragma unroll
        for (int tl = 0; tl < 4; ++tl) {
#pragma unroll
            for (int j = 0; j < 4; ++j) pp[tl][j] = __builtin_amdgcn_exp2f(fmaf(sc[tl][j], QSCALE, mb));
            sum += (pp[tl][0] + pp[tl][1]) + (pp[tl][2] + pp[tl][3]);
        }
        a.l = a.l * alpha + sum; a.m = mn;
        const long pf0 = pack_fp8(pp[0], pp[1]), pf1 = pack_fp8(pp[2], pp[3]);
#pragma unroll
        for (int dt = 0; dt < 4; ++dt) { a.o[dt] = a.o[dt] * alpha; a.o[dt] = MFMA8(vf[buf][0][dt], pf0, a.o[dt]); a.o[dt] = MFMA8(vf[buf][1][dt], pf1, a.o[dt]); }
    }
    const float lt = grp_sum(a.l);
    if (l15 < 4) {
        const float gs = sigmoidf_(p.BIGF[(size_t)tq * PA + C_GATE + 8 + g * 4 + l15]) * (lt > 0.f ? 1.f / lt : 0.f);
#pragma unroll
        for (int dt = 0; dt < 4; ++dt) {
            const size_t o = (size_t)tq * 512 + g * 256 + l15 * 64 + 16 * dt + 4 * grp;
            const f32x4 base = *(const f32x4*)(p.NSACC + o); const f32x4 v = base + a.o[dt] * gs;
            uint2 w; w.x = pk2(v[0], v[1]); w.y = pk2(v[2], v[3]);
            *(uint2*)(p.MIXB + (size_t)tq * 1024 + g * 256 + l15 * 64 + 16 * dt + 4 * grp) = w;
        }
    }
}

__device__ __forceinline__ void ph_gdn_chunks(const KP& p, const Fr& F) {
    if (F.wave < 4) for (int unit = F.bid * 4 + F.wave; unit < 2048; unit += F.G * 4) gdn_chunk_unit(p, unit, F.lds, F.wave * GDN_WL, F.lane);
    else { const int unit = F.bid * 4 + (F.wave - 4); if (unit < 128) cmp_prompt_unit(p, unit, F.lane); }
}
__device__ __forceinline__ void ph_mix_a(const KP& p, const Fr& F) {
    if (F.bid < 32) gdn_scan_item(p, (F.bid + 1) * 8 + F.wave, (float*)(F.lds + 8 * FAST_WL + 1024 + F.wave * 512), F.lane);
    float* wl = (float*)(F.lds + F.wave * FAST_WL);
    for (int unit = F.gw; unit < 2048; unit += F.NGW) nsa_fast_unit(p, unit, wl, F.lane);
}
__device__ __forceinline__ void ph_mix_b(const KP& p, const Fr& F) {
    if (F.bid < 8) { gdn_chain_wg(p, F.bid, F.wave, F.lane, F.lds); return; }
    if (F.bid < 24) {
        const int it = (F.bid - 8) * 4 + (F.wave & 3);
        if (F.wave < 4) nsa_smp_cs(p, it >> 1, it & 1, (float*)(F.lds + F.wave * 20480), F.lane);
        else nsa_smp_win(p, it >> 1, it & 1, (float*)(F.lds + 81920 + (F.wave - 4) * 12288), F.lane);
        return;
    }
    const int g = F.bid & 1, fr = (F.bid - 24) >> 1, NW = ((F.G - 24) >> 1) * 8;
    for (int tq = fr * 8 + F.wave; tq < T; tq += NW) { if (tq >= 1024) nsa_slc_item8<false>(p, tq, g, F.lane); else nsa_slc_item8<true>(p, tq, g, F.lane); }
}

__device__ __forceinline__ void ph_gdn_out(const KP& p, const Fr& F) {
    const float* H0 = p.BIGF; const int lane = F.lane;
    for (int unit = F.gw; unit < 2048; unit += F.NGW) gdn_out_unit(p, unit, lane);
    for (int idx = F.bid * NTHR + F.tid; idx < NSMP * 512; idx += F.G * NTHR) { const int b = idx >> 9, c = idx & 511; const float* sp = p.SMIXF + (size_t)b * 3 * 512 + c;
        p.MIXB[(size_t)(T + b) * 1024 + c] = (bf16)f2bf(sp[0] + sp[512] + sp[1024]); }
    for (int item = T * 8 + F.gw; item < TS * 8; item += F.NGW) {
        const int r = item >> 3, h = item & 7;
        const float o = p.OG[((size_t)r * 8 + h) * 64 + lane];
        const float ms = wave_sum(o * o) * (1.f / 64.f);
        const float z = H0[(size_t)r * PA + C_Z + h * 64 + lane];
        p.MIXB[(size_t)r * 1024 + 512 + h * 64 + lane] = (bf16)f2bf(o * rsqrtf(ms + NORM_EPS) * p.gnw[lane] * siluf_(z));
    }
}

__device__ __forceinline__ void ph_ln(const Fr& F, const float* Xp, const float* Xs, const float* Fm, const float* gam, const float* bet, float* outp, float* outs, bf16* ob) {
    const int lane = F.lane;
    for (int r = F.gw; r < TS; r += F.NGW) {
        const float4* xr = (const float4*)((r < T) ? Xp + (size_t)r * DM : Xs + (size_t)(r - T) * DM) + lane; const float4* fr = (const float4*)(Fm + (size_t)r * DM) + lane;
        f32x4 v[4]; float s = 0.f;
#pragma unroll
        for (int j = 0; j < 4; ++j) { const float4 x = xr[64 * j], f = fr[64 * j]; v[j] = (f32x4){DN_ALPHA * x.x + f.x, DN_ALPHA * x.y + f.y, DN_ALPHA * x.z + f.z, DN_ALPHA * x.w + f.w}; s += (v[j][0] + v[j][1]) + (v[j][2] + v[j][3]); }
        const float mean = wave_sum(s) * (1.f / DM); float q = 0.f;
#pragma unroll
        for (int j = 0; j < 4; ++j) { v[j] = v[j] - mean; q += (v[j][0] * v[j][0] + v[j][1] * v[j][1]) + (v[j][2] * v[j][2] + v[j][3] * v[j][3]); }
        const float rstd = rsqrtf(wave_sum(q) * (1.f / DM) + LN_EPS);
        float4* o = (float4*)((r < T) ? outp + (size_t)r * DM : outs + (size_t)(r - T) * DM) + lane;
#pragma unroll
        for (int j = 0; j < 4; ++j) { const float4 g4 = ((const float4*)gam)[lane + 64 * j], b4 = ((const float4*)bet)[lane + 64 * j];
            const float4 y = make_float4(v[j][0] * rstd * g4.x + b4.x, v[j][1] * rstd * g4.y + b4.y, v[j][2] * rstd * g4.z + b4.z, v[j][3] * rstd * g4.w + b4.w);
            o[64 * j] = y; if (ob) { uint2 w; w.x = pk2(y.x, y.y); w.y = pk2(y.z, y.w); *((uint2*)(ob + (size_t)r * DM) + lane + 64 * j) = w; } }
    }
}

__device__ __forceinline__ void ph_ffn_act(const KP& p, const Fr& F, int layer) {
    const float* U = p.BIGF; const float* cw = p.ffn_cw + (size_t)layer * 3 * DFF2; const float* cb = p.ffn_cb + (size_t)layer * DFF2;
    const size_t gt = (size_t)F.bid * NTHR + F.tid, GT = (size_t)F.G * NTHR;
    const size_t total = (size_t)TS * DFF;
    for (size_t idx = gt; idx < total; idx += GT) {
        const int r = (int)(idx / DFF), j = (int)(idx % DFF);
        const bool smp = r >= T; const int b = r - T;
        float c2[2];
#pragma unroll
        for (int half = 0; half < 2; ++half) {
            const int ch = half * DFF + j;
            float acc = cb[ch];
#pragma unroll
            for (int k = 0; k < 3; ++k) {
                float u;
                if (!smp) { const int t = r + k - 2; u = (t >= 0) ? U[(size_t)t * DFF2 + ch] : 0.f; }
                else u = (k < 2) ? p.st_ffn[(((size_t)b * 2 + layer) * 2 + k) * DFF2 + ch] : U[(size_t)r * DFF2 + ch];
                acc += cw[k * DFF2 + ch] * u;
            }
            c2[half] = acc;
        }
        p.HFFB[idx] = (bf16)f2bf(siluf_(c2[0]) * c2[1]);
    }
    for (size_t idx = gt; idx < (size_t)2 * DFF2; idx += GT) {
        const int k = (int)(idx / DFF2), ch = (int)(idx % DFF2);
        p.out[O_FFN_P + ((size_t)layer * 2 + k) * DFF2 + ch] = U[(size_t)(T - 2 + k) * DFF2 + ch];
    }
    for (size_t idx = gt; idx < (size_t)NSMP * 2 * DFF2; idx += GT) {
        const int b = (int)(idx / (2 * DFF2)), k = (int)((idx / DFF2) % 2), ch = (int)(idx % DFF2);
        p.out[O_FFN_S + (((size_t)b * 2 + layer) * 2 + k) * DFF2 + ch] =
            (k == 0) ? p.st_ffn[(((size_t)b * 2 + layer) * 2 + 1) * DFF2 + ch] : U[(size_t)(T + b) * DFF2 + ch];
    }
}

__device__ __forceinline__ void ph_dil_prep(const KP& p, const Fr& F) {
    const float* H1 = p.BIGF;
    const size_t gt = (size_t)F.bid * NTHR + F.tid, GT = (size_t)F.G * NTHR;
    const size_t total = (size_t)TS * 2048;
    for (size_t idx = gt + (size_t)T * 2048; idx < total; idx += GT) {
        const int r = (int)(idx >> 11), c = (int)(idx & 2047);
        const bool smp = r >= T; const int pos = smp ? T : r;
        const float* row = H1 + (size_t)r * 3072;
        const int i = c & 63; const float2 cs = p.ROPE[pos * 32 + (i & 31)];
        const float v = rope_val(row, c & ~63, i, cs);
        if (c < 1024) p.QD[(size_t)r * 1024 + c] = v; else p.KD[(size_t)r * 1024 + (c - 1024)] = v;
    }
}
__device__ __forceinline__ void ph_dil_cache(const KP& p, const Fr& F) {
    const float* H1 = p.BIGF;
    const size_t gt = (size_t)F.bid * NTHR + F.tid, GT = (size_t)F.G * NTHR;
    const size_t tots4 = (size_t)NSMP * 2048 * 512;
    for (size_t idx = gt; idx < tots4; idx += GT) {
        const int b = (int)(idx / (2048 * 512)); const int i = (int)((idx / 512) % 2048); const int c4 = (int)(idx % 512);
        float4 v;
        if (i < 2047) v = ((const float4*)p.st_dil)[((size_t)b * 2048 + i + 1) * 512 + c4];
        else { const int c = c4 * 4; const int r = T + b;
               v = (c < 1024) ? *(const float4*)(p.KD + (size_t)r * 1024 + c) : *(const float4*)(H1 + (size_t)r * 3072 + 2048 + (c - 1024)); }
        ((float4*)(p.out + O_DIL_S))[idx] = v;
    }
}
__device__ __forceinline__ void ph_dil_attn(const KP& p, const Fr& F) {
    const float* H1 = p.BIGF; const int lane = F.lane;
    float* qs = (float*)(F.lds + F.wave * 4096); float* sc = qs + 64;
    float* ex = (float*)(F.lds + 32768);
    const int il = F.wave / 3, gi = F.wave - 3 * il;
    const int item = F.bid * 2 + il; const int b = item >> 4, h = item & 15, r = T + b;
    if (F.wave < 6 && item < NSMP * 16) {
        qs[lane] = p.QD[(size_t)r * 1024 + h * 64 + lane];
        wave_lds_sync();
        const int dd = gi == 0 ? 1 : (gi == 1 ? 4 : 16);
        auto kf = [&](int j, const float*& kp, const float*& vp) -> bool {
            const int pos = T - j * dd;
            if (pos == T) { kp = p.KD + (size_t)r * 1024 + h * 64; vp = H1 + (size_t)r * 3072 + 2048 + h * 64; return true; }
            const float* base = p.st_dil + ((size_t)b * 2048 + (pos - (T - 2048))) * 2048;
            kp = base + h * 64; vp = base + 1024 + h * 64; return true; };
        float o[1], den[1], mx[1];
        wave_attend<1>(qs, sc, 448, 129, kf, o, den, lane, mx);
        float* e = ex + (il * 3 + gi) * 68;
        e[lane] = o[0] * den[0]; if (lane == 0) { e[64] = mx[0]; e[65] = den[0]; }
    }
    __syncthreads();
    if (F.wave < 6 && gi == 0 && item < NSMP * 16) {
        const float* e = ex + il * 3 * 68;
        const float m0 = e[64], m1 = e[68 + 64], m2 = e[136 + 64]; const float M = fmaxf(m0, fmaxf(m1, m2));
        const float w0 = expf(m0 - M), w1 = expf(m1 - M), w2 = expf(m2 - M);
        const float num = w0 * e[lane] + w1 * e[68 + lane] + w2 * e[136 + lane], dn = w0 * e[65] + w1 * e[68 + 65] + w2 * e[136 + 65];
        p.MIXB[(size_t)r * 1024 + h * 64 + lane] = (bf16)f2bf(num / dn);
    }
}

__device__ __forceinline__ void ph_dil_prep_fast(const KP& p, const Fr& F) {
    const float* H1 = p.BIGF;
    const size_t gt = (size_t)F.bid * NTHR + F.tid, GT = (size_t)F.G * NTHR;
    for (size_t idx = gt; idx < (size_t)T * 128; idx += GT) {
        const int t = (int)(idx >> 7), u = (int)(idx & 127);
        const int hq = u >> 2, d0 = (u & 3) * 8, c0 = hq * 64 + d0; const float* row = H1 + (size_t)t * 3072;
        const float4 a0 = *(const float4*)(row + c0), a1 = *(const float4*)(row + c0 + 4), b0 = *(const float4*)(row + c0 + 32), b1 = *(const float4*)(row + c0 + 36);
        const float4* rp = (const float4*)(p.ROPE + t * 32 + d0); const float4 r0 = rp[0], r1 = rp[1], r2 = rp[2], r3 = rp[3];
        const float x1[8] = {a0.x, a0.y, a0.z, a0.w, a1.x, a1.y, a1.z, a1.w}, x2[8] = {b0.x, b0.y, b0.z, b0.w, b1.x, b1.y, b1.z, b1.w};
        const float cs[8] = {r0.x, r0.z, r1.x, r1.z, r2.x, r2.z, r3.x, r3.z}, sn[8] = {r0.y, r0.w, r1.y, r1.w, r2.y, r2.w, r3.y, r3.w};
        float lo[8], hi[8];
#pragma unroll
        for (int j = 0; j < 8; ++j) { lo[j] = x1[j] * cs[j] - x2[j] * sn[j]; hi[j] = x2[j] * cs[j] + x1[j] * sn[j]; }
        if (hq < 16) {
            v4u o; o.x = pk2(lo[0] * QSCALE, lo[1] * QSCALE); o.y = pk2(lo[2] * QSCALE, lo[3] * QSCALE); o.z = pk2(lo[4] * QSCALE, lo[5] * QSCALE); o.w = pk2(lo[6] * QSCALE, lo[7] * QSCALE);
            *(v4u*)(p.QDB + (size_t)t * 1024 + c0) = o;
            o.x = pk2(hi[0] * QSCALE, hi[1] * QSCALE); o.y = pk2(hi[2] * QSCALE, hi[3] * QSCALE); o.z = pk2(hi[4] * QSCALE, hi[5] * QSCALE); o.w = pk2(hi[6] * QSCALE, hi[7] * QSCALE);
            *(v4u*)(p.QDB + (size_t)t * 1024 + c0 + 32) = o;
        } else {
            const int h = hq - 16, kc = h * 64 + d0;
            v4u ol, oh; ol.x = pk2(lo[0], lo[1]); ol.y = pk2(lo[2], lo[3]); ol.z = pk2(lo[4], lo[5]); ol.w = pk2(lo[6], lo[7]);
            oh.x = pk2(hi[0], hi[1]); oh.y = pk2(hi[2], hi[3]); oh.z = pk2(hi[4], hi[5]); oh.w = pk2(hi[6], hi[7]);
#pragma unroll
            for (int pass = 0; pass < 3; ++pass) { const int sh = 2 * pass; const int pi = (t & ((1 << sh) - 1)) * (T >> sh) + (t >> sh);
                bf16* kb = (pass == 0 ? p.DKF[0] : pass == 1 ? p.DKF[1] : p.DKF[2]) + (size_t)h * T * 64;
                *(v4u*)(kb + kfrag_elem(pi, d0)) = ol; *(v4u*)(kb + kfrag_elem(pi, d0 + 32)) = oh; }
            if (t >= T - 2048) { float* op = p.out + O_DIL_P + (size_t)(t - (T - 2048)) * 2048 + kc;
                *(float4*)op = make_float4(lo[0], lo[1], lo[2], lo[3]); *(float4*)(op + 4) = make_float4(lo[4], lo[5], lo[6], lo[7]);
                *(float4*)(op + 32) = make_float4(hi[0], hi[1], hi[2], hi[3]); *(float4*)(op + 36) = make_float4(hi[4], hi[5], hi[6], hi[7]); }
        }
    }
    for (size_t idx = gt; idx < (size_t)2048 * 256; idx += GT) {
        const int i = (int)(idx >> 8), c4 = (int)(idx & 255);
        *(float4*)(p.out + O_DIL_P + (size_t)i * 2048 + 1024 + c4 * 4) = *(const float4*)(H1 + (size_t)(T - 2048 + i) * 3072 + 2048 + c4 * 4);
    }
    const int lane = F.lane, l15 = lane & 15, grp = lane >> 4;
    for (int unit = F.gw; unit < 3 * 16 * 512; unit += F.NGW) {
        const int st = unit & 511, h = (unit >> 9) & 15, pass = unit >> 13; const int sh = 2 * pass, Td = T >> sh;
        const int pi0 = 32 * st, r = pi0 / Td, s0 = pi0 - r * Td;
        bf16* dst = p.DVF[pass] + (size_t)h * T * 64;
#pragma unroll
        for (int dt = 0; dt < 4; ++dt) {
            float v[8];
#pragma unroll
            for (int j = 0; j < 8; ++j) { const int s = s0 + 16 * (j >> 2) + 4 * grp + (j & 3); const int t = (s << sh) + r;
                v[j] = H1[(size_t)t * 3072 + 2048 + h * 64 + 16 * dt + l15]; }
            v4u o; o.x = pk2(v[0], v[1]); o.y = pk2(v[2], v[3]); o.z = pk2(v[4], v[5]); o.w = pk2(v[6], v[7]);
            *(v4u*)(dst + vfrag_off(st, dt, lane)) = o;
        }
    }
}

__device__ __forceinline__ void dil_pass(const KP& p, int unit, int pass, unsigned char* ldsb, int w4, int lane) {
    asm volatile("" : "+v"(lane));
    const int h = unit & 15, P0 = (unit >> 4) * 256;
    const int l15 = lane & 15, grp = lane >> 4;
    float* stO = (float*)ldsb; float* stML = stO + 256 * 64;
    {
        const int sh = 2 * pass, Td = T >> sh;
        const bf16* KF = (pass == 0 ? p.DKF[0] : pass == 1 ? p.DKF[1] : p.DKF[2]) + (size_t)h * T * 64;
        const bf16* VF = (pass == 0 ? p.DVF[0] : pass == 1 ? p.DVF[1] : p.DVF[2]) + (size_t)h * T * 64;
        for (int tt = 0; tt < 4; ++tt) {
            const int tl = 4 * w4 + tt;
            const int r = tl >> (4 - sh), s0 = (P0 >> sh) + 16 * (tl & ((16 >> sh) - 1));
            const int sq = s0 + l15, tq = (sq << sh) + r, tloc = tq - P0;
            bf16x8 qf[2];
#pragma unroll
            for (int ks = 0; ks < 2; ++ks) qf[ks] = *(const bf16x8*)(p.QDB + (size_t)tq * 1024 + h * 64 + 32 * ks + 8 * grp);
            AttW a;
            if (pass == 0) attw_init(a);
            else {
#pragma unroll
                for (int dt = 0; dt < 4; ++dt) a.o[dt] = *(const f32x4*)(stO + tloc * 64 + 16 * dt + 4 * grp);
                a.m = stML[tloc * 2]; a.l = (grp == 0) ? stML[tloc * 2 + 1] : 0.f;
            }
            int kstart = s0 - 128; if (kstart < 0) kstart = 0; kstart &= ~31;
            const int nsteps = (s0 + 16 - kstart + 31) >> 5;
            const int base = r * Td;
            bf16x8 kf[3][2][2], vf[3][4];
            auto issue = [&](int s, int buf) {
                const int k0 = kstart + 32 * s;
#pragma unroll
                for (int tl2 = 0; tl2 < 2; ++tl2)
#pragma unroll
                    for (int ks = 0; ks < 2; ++ks) kf[buf][tl2][ks] = *(const bf16x8*)(KF + kfrag_off(((base + k0) >> 4) + tl2, ks, lane));
#pragma unroll
                for (int dt = 0; dt < 4; ++dt) vf[buf][dt] = *(const bf16x8*)(VF + vfrag_off((base + k0) >> 5, dt, lane));
            };
            issue(0, 0); if (nsteps > 1) issue(1, 1);
#pragma unroll
            for (int s = 0; s < 5; ++s) {
                if (s < nsteps) {
                    if (s + 2 < nsteps) issue(s + 2, (s + 2) % 3);
                    const int k0 = kstart + 32 * s;
                    f32x4 s0v, s1v; qk_step(kf[s % 3], qf, s0v, s1v);
                    if ((k0 + 31 > s0) || (k0 < s0 + 15 - 128)) {
                        const int pb = k0 + 4 * grp;
#pragma unroll
                        for (int i = 0; i < 4; ++i) { const int p0 = pb + i, p1 = pb + 16 + i;
                            if (p0 > sq || p0 < sq - 128) s0v[i] = -INFINITY; if (p1 > sq || p1 < sq - 128) s1v[i] = -INFINITY; }
                    }
                    att_update(a, s0v, s1v, vf[s % 3]);
                }
            }
            const float lt = grp_sum(a.l);
            if (pass < 2) {
#pragma unroll
                for (int dt = 0; dt < 4; ++dt) *(f32x4*)(stO + tloc * 64 + 16 * dt + 4 * grp) = a.o[dt];
                if (grp == 0) { stML[tloc * 2] = a.m; stML[tloc * 2 + 1] = lt; }
            } else {
                const float il = lt > 0.f ? 1.f / lt : 0.f;
#pragma unroll
                for (int dt = 0; dt < 4; ++dt) { uint2 o; o.x = pk2(a.o[dt][0] * il, a.o[dt][1] * il); o.y = pk2(a.o[dt][2] * il, a.o[dt][3] * il);
                    *(uint2*)(p.MIXB + (size_t)tq * 1024 + h * 64 + 16 * dt + 4 * grp) = o; }
            }
        }
    }
}
__device__ __forceinline__ void ph_dil_combo(const KP& p, const Fr& F) {
    const float* H1 = p.BIGF; const int lane = F.lane;
    const int cw = F.bid * 4 + F.wave;
#pragma unroll 1
    for (int u = 0; u < 4; ++u) {
#pragma unroll
        for (int pass = 0; pass < 3; ++pass) {
            if (F.wave >= 4) dil_pass(p, F.bid + u * F.G, pass, F.lds, F.wave - 4, lane);
            else {
                const int ci = u * 3 + pass;
                const int g0 = ci * 2 + (ci < 8 ? ci : 8), g1 = g0 + 2 + (ci < 8 ? 1 : 0);
                auto srcp = [&](int itn) -> const float4* {
                    const size_t idx = ((size_t)itn * 1024 + cw) * 64 + lane;
                    const int b = (int)(idx >> 20), i = (int)((idx >> 9) & 2047), c4 = (int)(idx & 511);
                    const int c = c4 * 4, r = T + b;
                    const float4* s_old = ((const float4*)p.st_dil) + ((size_t)b * 2048 + (i < 2047 ? i + 1 : 2047)) * 512 + c4;
                    const float4* s_new = (c < 1024) ? (const float4*)(p.KD + (size_t)r * 1024 + c) : (const float4*)(H1 + (size_t)r * 3072 + 2048 + (c - 1024));
                    return (i == 2047) ? s_new : s_old; };
                float4* dstp = (float4*)(p.out + O_DIL_S) + (size_t)cw * 64 + lane;
#pragma unroll 1
                for (int gi = g0; gi < g1; ++gi) {
                    const int i0 = gi * 16;
                    const float4 v0 = *srcp(i0), v1 = *srcp(i0 + 1), v2 = *srcp(i0 + 2), v3 = *srcp(i0 + 3), v4 = *srcp(i0 + 4), v5 = *srcp(i0 + 5), v6 = *srcp(i0 + 6), v7 = *srcp(i0 + 7);
                    const float4 v8 = *srcp(i0 + 8), v9 = *srcp(i0 + 9), v10 = *srcp(i0 + 10), v11 = *srcp(i0 + 11), v12 = *srcp(i0 + 12), v13 = *srcp(i0 + 13), v14 = *srcp(i0 + 14), v15 = *srcp(i0 + 15);
                    float4* d = dstp + (size_t)i0 * 65536;
                    d[0] = v0; d[65536] = v1; d[2 * 65536] = v2; d[3 * 65536] = v3; d[4 * 65536] = v4; d[5 * 65536] = v5; d[6 * 65536] = v6; d[7 * 65536] = v7;
                    d[8 * 65536] = v8; d[9 * 65536] = v9; d[10 * 65536] = v10; d[11 * 65536] = v11; d[12 * 65536] = v12; d[13 * 65536] = v13; d[14 * 65536] = v14; d[15 * 65536] = v15;
                }
            }
            __syncthreads();
        }
    }
}

constexpr int NPHASE = 22;
__global__ void __launch_bounds__(NTHR, 2) mega(KP p) {
    extern __shared__ __attribute__((aligned(16))) unsigned char lds[];
    Fr F; F.lds = lds; F.tid = threadIdx.x; F.lane = 0; F.wave = __builtin_amdgcn_readfirstlane(F.tid >> 6);
    F.bid = blockIdx.x; F.G = gridDim.x; F.gw = F.bid * NWAVES + F.wave; F.NGW = F.G * NWAVES;
    for (int u = F.tid; u < (LDS_BYTES - RING_BYTES) / 4; u += NTHR) ((unsigned*)(lds + RING_BYTES))[u] = 0u;
    __syncthreads();
    XcdBarrier bar; bar.bar = p.ctl + 4096; bar.x = 0; bar.st = nullptr;
    if (!MK_PER_PHASE) bar = xcd_barrier_post(p.ctl + 4096, (volatile LAS unsigned*)(lds + MISC_OFF + 32));
    const int lo = p.ph_lo, hi = p.ph_hi;
#define IN(k) (lo <= (k) && (k) < hi)

    int ph = 0;
#if PROBE_ON
#define PROBE_STAMP(k) do { if (blockIdx.x == 0 && threadIdx.x == 0) ((unsigned long long*)(p.ctl + 65536))[k] = __builtin_amdgcn_s_memrealtime(); } while (0)
#define PROBE_STAMPB(k, blk) do { if (blockIdx.x == (blk) && threadIdx.x == 0) ((unsigned long long*)(p.ctl + 65536))[k] = __builtin_amdgcn_s_memrealtime(); } while (0)
    PROBE_STAMP(0);
#else
#define PROBE_STAMP(k) do { } while (0)
#define PROBE_STAMPB(k, blk) do { } while (0)
#endif
#define PHASE(...) do { { unsigned t_ = threadIdx.x; asm volatile("" : "+v"(t_)); F.lane = (int)(t_ & 63u); } if (IN(ph)) { __VA_ARGS__ } if (IN(ph) && IN(ph + 1)) xcd_barrier(bar); ++ph; PROBE_STAMP(ph); } while (0)
    PHASE(ph_prologue(p, F););
    PHASE(ph_gemm_f32(F, p.ACTB, p.WT_A, PAP, DM, p.BIGF, PA, PA); ph_cmp_samples(p, F););
    PHASE(ph_nsa_prep(p, F); ph_nsa_prep_fast(p, F); ph_gdn_prep(p, F););
    PHASE(ph_gdn_chunks(p, F););
    PHASE(ph_mix_a(p, F););
    PHASE(ph_mix_b(p, F););
    PHASE(ph_gdn_out(p, F););
    PHASE(ph_gemm_f32(F, p.MIXB, p.WT_OA, DM, DM, p.MO, DM, DM););
    PHASE(ph_ln(F, p.x_prompt, p.x_sample, p.MO, p.ln_mix_g, p.ln_mix_b, p.X1, p.X1 + (size_t)T * DM, p.ACTB););
    PHASE(ph_ffn_gemm(p, F, p.WT_FI0, 0););
    PHASE(ph_ffn_fix(p, F, 0););
    PHASE(ph_gemm_f32(F, p.HFFB, p.WT_FO0, DM, DFF, p.MO, DM, DM););
    PHASE(ph_ln(F, p.X1, p.X1 + (size_t)T * DM, p.MO, p.ln_ffn_g, p.ln_ffn_b, p.X2, p.X2 + (size_t)T * DM, p.ACTB););
    PHASE(ph_gemm_f32(F, p.ACTB, p.WT_CI, 3072, DM, p.BIGF, 3072, 3072););
    PHASE(ph_dil_prep(p, F); ph_dil_prep_fast(p, F););
    PHASE(ph_dil_attn(p, F); __syncthreads(); ph_dil_combo(p, F););
    PHASE(ph_gemm_f32(F, p.MIXB, p.WT_CO, DM, DM, p.MO, DM, DM););
    PHASE(ph_ln(F, p.X2, p.X2 + (size_t)T * DM, p.MO, p.ln_mix_g + DM, p.ln_mix_b + DM, p.X3, p.X3 + (size_t)T * DM, p.ACTB););
    PHASE(ph_ffn_gemm(p, F, p.WT_FI1, 1););
    PHASE(ph_ffn_fix(p, F, 1););
    PHASE(ph_gemm_f32(F, p.HFFB, p.WT_FO1, DM, DFF, p.MO, DM, DM););
    PHASE(ph_ln(F, p.X3, p.X3 + (size_t)T * DM, p.MO, p.ln_ffn_g + DM, p.ln_ffn_b + DM, p.out + O_Y_P, p.out + O_Y_S, nullptr););
#undef PHASE
#if PROBE_ON
    xcd_barrier(bar);
    if (blockIdx.x == 0) { __syncthreads(); const unsigned long long* pts = (const unsigned long long*)(p.ctl + 65536); const float x = (float)(pts[PROBE_B] - pts[PROBE_A]) * 1e-5f;
        for (int i = threadIdx.x; i < NSMP * DM; i += NTHR) p.out[O_Y_S + i] *= (1.f + x); }
#endif
#undef IN
}

static inline size_t align_up(size_t x) { return (x + 255) & ~(size_t)255; }

extern "C" void kernel_launch(void* const* d_in, const int* in_sizes, int n_in, void* d_out, int out_size, void* d_ws, size_t ws_size, hipStream_t stream) {
    static int grid = 0;
    if (grid == 0) {
        int dev = 0, cus = 0, per_cu = 0;
        if (hipGetDevice(&dev) != hipSuccess || hipDeviceGetAttribute(&cus, hipDeviceAttributeMultiprocessorCount, dev) != hipSuccess) { fprintf(stderr, "kernel_launch: device query failed\n"); grid = -1; return; }
        if (hipFuncSetAttribute((const void*)mega, hipFuncAttributeMaxDynamicSharedMemorySize, LDS_BYTES) != hipSuccess) { fprintf(stderr, "kernel_launch: hipFuncSetAttribute failed\n"); grid = -1; return; }
        if (hipOccupancyMaxActiveBlocksPerMultiprocessor(&per_cu, (const void*)mega, NTHR, LDS_BYTES) != hipSuccess || per_cu < 1) { fprintf(stderr, "kernel_launch: occupancy query says %d blocks per CU\n", per_cu); }
        (void)hipGetLastError();
        grid = cus;
    }
    if (grid < 0) return;
    if ((size_t)out_size != O_END) fprintf(stderr, "kernel_launch: out_size %d != expected %zu\n", out_size, (size_t)O_END);
    KP p{};
    p.x_prompt = (const float*)d_in[0]; p.x_sample = (const float*)d_in[1]; p.cache_cmp = (const float*)d_in[2]; p.cache_slc = (const float*)d_in[3];
    p.st_win = (const float*)d_in[4]; p.st_gconv = (const float*)d_in[5]; p.st_gS = (const float*)d_in[6]; p.st_dil = (const float*)d_in[7];
    p.st_ffn = (const float*)d_in[8]; p.page_table = (const int*)d_in[9]; p.w_in_a = (const float*)d_in[10]; p.cw1 = (const float*)d_in[11];
    p.cb1 = (const float*)d_in[12]; p.cw2 = (const float*)d_in[13]; p.cpe = (const float*)d_in[14]; p.gconv_w = (const float*)d_in[15];
    p.gA = (const float*)d_in[16]; p.gdt = (const float*)d_in[17]; p.gnw = (const float*)d_in[18]; p.w_out_a = (const float*)d_in[19];
    p.w_in_c = (const float*)d_in[20]; p.w_out_c = (const float*)d_in[21]; p.ln_mix_g = (const float*)d_in[22]; p.ln_mix_b = (const float*)d_in[23];
    p.ffn_w_in = (const float*)d_in[24]; p.ffn_cw = (const float*)d_in[25]; p.ffn_cb = (const float*)d_in[26]; p.ffn_w_out = (const float*)d_in[27];
    p.ln_ffn_g = (const float*)d_in[28]; p.ln_ffn_b = (const float*)d_in[29];
    p.out = (float*)d_out;
    char* ws = (char*)d_ws; size_t off = 0;
    auto alloc = [&](size_t bytes) { void* q = (void*)(ws + off); off = align_up(off + bytes); return q; };
    p.ctl = (unsigned*)alloc(1 << 20);
    p.WT_A = (bf16*)alloc((size_t)PAP * DM * 2); p.WT_OA = (bf16*)alloc((size_t)DM * DM * 2);
    p.WT_FI0 = (bf16*)alloc((size_t)DFF2 * DM * 2); p.WT_FI1 = (bf16*)alloc((size_t)DFF2 * DM * 2);
    p.WT_FO0 = (bf16*)alloc((size_t)DM * DFF * 2); p.WT_FO1 = (bf16*)alloc((size_t)DM * DFF * 2);
    p.WT_CI = (bf16*)alloc((size_t)3072 * DM * 2); p.WT_CO = (bf16*)alloc((size_t)DM * DM * 2);
    p.ROPE = (float2*)alloc((size_t)(T + 1) * 32 * 8);
    p.ACTB = (bf16*)alloc((size_t)TSP * DM * 2); p.MIXB = (bf16*)alloc((size_t)TSP * DM * 2); p.HFFB = (bf16*)alloc((size_t)TSP * DFF * 2);
    p.KS8 = (unsigned char*)alloc((size_t)2 * T * 64); p.VS8 = (unsigned char*)alloc((size_t)2 * T * 64);
    p.QB = (bf16*)alloc((size_t)T * 512 * 2); p.KSF = (bf16*)alloc((size_t)2 * T * 64 * 2); p.VSF = (bf16*)alloc((size_t)2 * T * 64 * 2);
    p.KWF = (bf16*)alloc((size_t)2 * T * 64 * 2); p.VWF = (bf16*)alloc((size_t)2 * T * 64 * 2); p.CKF = (bf16*)alloc((size_t)2 * 512 * 64 * 2); p.CVF = (bf16*)alloc((size_t)2 * 512 * 64 * 2);
    p.ACP = (bf16*)alloc((size_t)2048 * 2048 * 2);
    p.W2T = (bf16*)alloc((size_t)2 * 64 * 128 * 2);
    p.AC = nullptr; p.WT_C = (bf16*)alloc((size_t)256 * 2048 * 2); p.HID = nullptr; p.SMIXF = (float*)alloc((size_t)NSMP * 3 * 512 * 4);
    p.UB = (float*)alloc((size_t)256 * 4 * DFF2 * 4);
    p.NSACC = (float*)alloc((size_t)T * 512 * 4); p.SEL = (int*)alloc((size_t)2 * T * 16 * 4);
    p.QDB = (bf16*)alloc((size_t)T * 1024 * 2);
    for (int i = 0; i < 3; ++i) { p.DKF[i] = (bf16*)alloc((size_t)T * 1024 * 2); p.DVF[i] = (bf16*)alloc((size_t)T * 1024 * 2); }
    p.G_WF = (bf16*)alloc((size_t)2048 * 4096 * 2); p.G_KDF = (bf16*)alloc((size_t)2048 * 4096 * 2); p.G_QGF = (bf16*)alloc((size_t)2048 * 4096 * 2); p.G_QKF = (bf16*)alloc((size_t)2048 * 4096 * 2);
    p.G_SPF = (bf16*)alloc((size_t)2048 * 4096 * 2); p.G_VNF = (bf16*)alloc((size_t)2048 * 4096 * 2); p.G_UF = (float*)alloc((size_t)2048 * 4096 * 4); p.G_GL = (float*)alloc((size_t)2048 * 4);
    p.BIGF = (float*)alloc((size_t)TSP * DFF2 * 4); p.MO = (float*)alloc((size_t)TSP * DM * 4);
    p.X1 = (float*)alloc((size_t)TS * DM * 4); p.X2 = (float*)alloc((size_t)TS * DM * 4); p.X3 = (float*)alloc((size_t)TS * DM * 4);
    p.QR = (float*)alloc((size_t)TS * 512 * 4);
    p.KS = (float*)alloc((size_t)TS * 128 * 4); p.VS = (float*)alloc((size_t)TS * 128 * 4); p.KW = (float*)alloc((size_t)TS * 128 * 4); p.VW = (float*)alloc((size_t)TS * 128 * 4);
    p.CK = (float*)alloc((size_t)33 * 512 * 128 * 4); p.CV = (float*)alloc((size_t)33 * 512 * 128 * 4);
    p.GQ = (float*)alloc((size_t)TS * 512 * 4); p.GK = (float*)alloc((size_t)TS * 512 * 4); p.GV = (float*)alloc((size_t)TS * 512 * 4); p.OG = (float*)alloc((size_t)TS * 512 * 4);
    p.Gg = (float*)alloc((size_t)TS * 8 * 4); p.Gb = (float*)alloc((size_t)TS * 8 * 4);
    p.QD = (float*)alloc((size_t)TS * DM * 4); p.KD = (float*)alloc((size_t)TS * DM * 4);
    if (off > ws_size) { fprintf(stderr, "kernel_launch: workspace too small: need %zu have %zu\n", off, ws_size); return; }
    if (hipMemsetAsync(p.ctl, 0, 1 << 20, stream) != hipSuccess) { fprintf(stderr, "kernel_launch: memset failed\n"); return; }
#if MK_PER_PHASE
    for (int k = 0; k < NPHASE; ++k) { p.ph_lo = k; p.ph_hi = k + 1; hipLaunchKernelGGL(mega, dim3(grid), dim3(NTHR), LDS_BYTES, stream, p); }
#else
    p.ph_lo = 0; p.ph_hi = NPHASE;
    hipLaunchKernelGGL(mega, dim3(grid), dim3(NTHR), LDS_BYTES, stream, p);
#endif
    const hipError_t le = hipPeekAtLastError();
    if (le != hipSuccess) fprintf(stderr, "kernel_launch: launch failed: %s\n", hipGetErrorName(le));
}
```

```cpp
#include <hip/hip_runtime.h>
#include <cstdint>
#include <cstdio>
#include <cmath>

namespace pg8 {
#define PG8_LAS __attribute__((address_space(3)))
typedef unsigned short bf16_t;
typedef short bf16x8 __attribute__((ext_vector_type(8)));
typedef float f32x4 __attribute__((ext_vector_type(4)));
typedef unsigned u32x4 __attribute__((ext_vector_type(4)));
constexpr int BM = 256, BK = 64, HALF = 128, HTB = HALF * BK * 2  , STAGE_BYTES = 8 * HTB, NXCD = 8, WGM = 8;

__host__ __device__ __forceinline__ int lds_byte(int r, int c) { const int st = (r >> 4) * 2 + (c >> 5), rr = r & 15, cc = c & 31, ob = rr * 64 + cc * 2; return st * 1024 + (ob ^ (((ob >> 9) & 1) << 5)); }
__host__ __device__ __forceinline__ void stage_rc(int b, int& R, int& C) { const int st = b / 1024, sb = b % 1024, swz = sb ^ (((sb >> 9) & 1) << 5); R = (st >> 1) * 16 + swz / 64; C = (st & 1) * 32 + (swz % 64) / 2; }
__host__ __device__ __forceinline__ int perm32(int rho) { const int n = rho >> 4, i = rho & 15; return 8 * (i >> 2) + 4 * n + (i & 3); }

struct Unit { int pm, pn; };
struct Gemm { const bf16_t* A; const bf16_t* Bt; int M, N, K; };

struct StaticOrder {
    int nM, nN, nwg, G, c;
    __host__ __device__ void init(int M, int N, int G_, int c_) { nM = M / BM; nN = N / BM; nwg = nM * nN; G = G_; c = c_; }
    __host__ __device__ bool next(int i, Unit& u) const {
        const long L = (long)i * G + c; if (L >= nwg) return false;
        int wgid = (int)L; { const int q = nwg / NXCD, r = nwg % NXCD, xcd = wgid % NXCD, off = wgid / NXCD; wgid = (xcd < r ? xcd * (q + 1) : r * (q + 1) + (xcd - r) * q) + off; }
        const int nig = WGM * nN, gid = wgid / nig, fm = gid * WGM, gsz = (nM - fm) < WGM ? (nM - fm) : WGM;
        u.pm = fm + ((wgid % nig) % gsz); u.pn = (wgid % nig) / gsz; return true;
    }
    __device__ __forceinline__ void a_ready(const Unit&) const {}
    __device__ __forceinline__ void done(const Unit&) const {}
};

typedef __bf16 bf16x2_t __attribute__((ext_vector_type(2)));
typedef float f32x2_t __attribute__((ext_vector_type(2)));
__device__ __forceinline__ unsigned cvt_pk_bf16(float lo, float hi) { const f32x2_t v = {lo, hi}; return __builtin_bit_cast(unsigned, __builtin_convertvector(v, bf16x2_t)); }
typedef float f32x2 __attribute__((ext_vector_type(2)));
__device__ __forceinline__ f32x2 gelu_pk(f32x2 v) {
    const f32x2 av = __builtin_elementwise_abs(v), d = av * 0.2316418882f + 1.0f;
    f32x2 t; t.x = __builtin_amdgcn_rcpf(d.x); t.y = __builtin_amdgcn_rcpf(d.y);
    f32x2 q = t * 0.5307027145f + (-0.7265760135f); q = q * t + 0.7107068705f; q = q * t + (-0.142248368f); q = q * t + 0.127414796f; q = q * t;
    const f32x2 s = (v * v) * (-0.72134752044f);
    f32x2 e; e.x = __builtin_amdgcn_exp2f(s.x); e.y = __builtin_amdgcn_exp2f(s.y);
    const f32x2 m = v * (q * e), r = v - m;
    f32x2 o; o.x = v.x < 0.f ? m.x : r.x; o.y = v.y < 0.f ? m.y : r.y; return o;
}

template <int ACT  > struct EpiBf16 {
    static constexpr bool PERM = true, AFTER_DRAIN = false; static_assert(ACT == 0 || ACT == 1, "EpiBf16: ACT is 0 (none) or 1 (gelu_pk)");
    bf16_t* O; int ldc; const float* bias; int split_cols; size_t split_stride; float scale0;
    __device__ __forceinline__ void operator()(const f32x4 (&acc)[2][2][4][2], const Unit& u, int wr, int wc, int fr, int fq) const {
        const int row0 = u.pm * BM + wr * 64 + fr; int colt = u.pn * BM; bf16_t* base = O;
        float sc = 1.f; if (split_cols) { const int t = colt / split_cols; base += (size_t)t * split_stride; colt -= t * split_cols; if (t == 0) sc = scale0; }
        const int col0 = colt + wc * 32 + 8 * fq, bcol0 = u.pn * BM + wc * 32 + 8 * fq;
        f32x4 bv[2][2];
#pragma unroll
        for (int bj = 0; bj < 2; ++bj)
#pragma unroll
            for (int n = 0; n < 2; ++n) bv[bj][n] = bias ? *(const f32x4*)(bias + bcol0 + bj * HALF + 4 * n) : (f32x4){0.f, 0.f, 0.f, 0.f};
#pragma unroll
        for (int ai = 0; ai < 2; ++ai)
#pragma unroll
            for (int m = 0; m < 4; ++m) { bf16_t* rowp = base + (size_t)(row0 + ai * HALF + m * 16) * ldc + col0;
#pragma unroll
                for (int bj = 0; bj < 2; ++bj) { f32x4 v0 = acc[ai][bj][m][0] + bv[bj][0], v1 = acc[ai][bj][m][1] + bv[bj][1];
                    if (ACT == 1) { f32x2 a = gelu_pk((f32x2){v0[0], v0[1]}), b = gelu_pk((f32x2){v0[2], v0[3]}), c = gelu_pk((f32x2){v1[0], v1[1]}), d = gelu_pk((f32x2){v1[2], v1[3]});
                        v0 = (f32x4){a.x, a.y, b.x, b.y}; v1 = (f32x4){c.x, c.y, d.x, d.y}; }
                    v0 = v0 * sc; v1 = v1 * sc; u32x4 w; w.x = cvt_pk_bf16(v0[0], v0[1]); w.y = cvt_pk_bf16(v0[2], v0[3]); w.z = cvt_pk_bf16(v1[0], v1[1]); w.w = cvt_pk_bf16(v1[2], v1[3]);
                    *(u32x4*)(rowp + bj * HALF) = w; } }
    }
};

struct EpiF32 {
    static constexpr bool PERM = false, AFTER_DRAIN = false;
    float* O; int ldc; int ncols;
    __device__ __forceinline__ void operator()(const f32x4 (&acc)[2][2][4][2], const Unit& u, int wr, int wc, int fr, int fq) const {
        const int row0 = u.pm * BM + wr * 64 + fr; const int col0 = u.pn * BM + wc * 32 + 4 * fq;
#pragma unroll
        for (int ai = 0; ai < 2; ++ai)
#pragma unroll
            for (int m = 0; m < 4; ++m) { float* rowp = O + (size_t)(row0 + ai * HALF + m * 16) * ldc;
#pragma unroll
                for (int bj = 0; bj < 2; ++bj)
#pragma unroll
                    for (int n = 0; n < 2; ++n) { const int c = col0 + bj * HALF + n * 16; if (c < ncols) *(f32x4*)(rowp + c) = acc[ai][bj][m][n]; } }
    }
};
template <class Epi, class Sched, bool ALIGN_EPI = false, bool SP2 = false>
__device__ __forceinline__ void gemm_phase(PG8_LAS unsigned char* lds, const Gemm g, const Sched& S, const Epi& E) {
    const int tid = threadIdx.x, wid = __builtin_amdgcn_readfirstlane(tid >> 6), lane = tid & 63, wr = wid >> 2, wc = wid & 3, fr = lane & 15, fq = lane >> 4;
    const int K = g.K, nt = K / BK;
    unsigned voffA[2], voffB[2];
#pragma unroll
    for (int i = 0; i < 2; ++i) { int R, C; stage_rc(tid * 16 + i * 8192, R, C); const int Rb = Epi::PERM ? ((R & ~31) + perm32(R & 31)) : R;
        voffA[i] = (unsigned)(R * K + C) * 2u; voffB[i] = (unsigned)(Rb * K + C) * 2u; }
    const size_t kstep = (size_t)(BK * 2);
    const size_t hstep = (size_t)HALF * K * 2;
    const size_t tstep = 2 * hstep;
    const unsigned ldsw = (unsigned)wid * 1024u;
    const int aoff = lds_byte(wr * 64 + fr, fq * 8), boff = lds_byte(wc * 32 + fr, fq * 8);
#define PG8_SA(b, h) (((b) * 2 + (h)) * HTB)
#define PG8_SB(b, h) ((4 + (b) * 2 + (h)) * HTB)
#define PG8_STAGE(bufoff, gbase, voff) do { _Pragma("unroll") for (int _i = 0; _i < 2; ++_i) \
        __builtin_amdgcn_global_load_lds((const unsigned*)((const char*)(gbase) + (voff)[_i]), (PG8_LAS unsigned*)(lds + (bufoff) + ldsw + _i * 8192), 16, 0, 0); } while (0)
#define PG8_LDA(dst, b, h) do { _Pragma("unroll") for (int m = 0; m < 4; ++m) _Pragma("unroll") for (int k = 0; k < 2; ++k) dst[m][k] = *(const PG8_LAS bf16x8*)(lds + PG8_SA(b, h) + aoff + m * 2048 + k * 1024); } while (0)
#define PG8_LDB(dst, b, h) do { _Pragma("unroll") for (int n = 0; n < 2; ++n) _Pragma("unroll") for (int k = 0; k < 2; ++k) dst[n][k] = *(const PG8_LAS bf16x8*)(lds + PG8_SB(b, h) + boff + n * 2048 + k * 1024); } while (0)
#define PG8_MMA(ai, bj, At, Bt) do { __builtin_amdgcn_s_setprio(1); _Pragma("unroll") for (int m = 0; m < 4; ++m) _Pragma("unroll") for (int n = 0; n < 2; ++n) _Pragma("unroll") for (int k = 0; k < 2; ++k) \
        acc[ai][bj][m][n] = __builtin_amdgcn_mfma_f32_16x16x32_bf16(Bt[n][k], At[m][k], acc[ai][bj][m][n], 0, 0, 0); __builtin_amdgcn_s_setprio(0); } while (0)
#define PG8_WAIT_V(n) asm volatile("s_waitcnt vmcnt(" #n ")" ::: "memory")
#define PG8_WAIT_L(n) asm volatile("s_waitcnt lgkmcnt(" #n ")" ::: "memory")
#define PG8_BAR __builtin_amdgcn_s_barrier()
#define PG8_SCHED __builtin_amdgcn_sched_barrier(0)
    Unit cur, nxt; int ui = 0;
    if (!S.next(0, cur)) return;
    f32x4 acc[2][2][4][2];
#pragma unroll
    for (int a = 0; a < 2; ++a)
#pragma unroll
        for (int b = 0; b < 2; ++b)
#pragma unroll
            for (int m = 0; m < 4; ++m)
#pragma unroll
                for (int n = 0; n < 2; ++n) acc[a][b][m][n] = (f32x4){0.f, 0.f, 0.f, 0.f};
    bf16x8 At[4][2], B0[2][2], B1[2][2];
    const char* cA = (const char*)g.A + (size_t)cur.pm * tstep; const char* cB = (const char*)g.Bt + (size_t)cur.pn * tstep;
    S.a_ready(cur);
    if constexpr (SP2) {
        PG8_STAGE(PG8_SB(0, 0), cB, voffB); PG8_STAGE(PG8_SB(0, 1), cB + hstep, voffB); PG8_STAGE(PG8_SA(0, 0), cA, voffA); PG8_STAGE(PG8_SA(0, 1), cA + hstep, voffA);
        if (wr == 1) PG8_BAR;
        PG8_WAIT_V(2); PG8_BAR;
        PG8_STAGE(PG8_SB(1, 0), cB + kstep, voffB); PG8_STAGE(PG8_SA(1, 0), cA + kstep, voffA); PG8_STAGE(PG8_SB(1, 1), cB + hstep + kstep, voffB);
        PG8_WAIT_V(6); PG8_BAR;
    } else {
        PG8_STAGE(PG8_SB(0, 0), cB, voffB); PG8_STAGE(PG8_SA(0, 0), cA, voffA); PG8_STAGE(PG8_SB(0, 1), cB + hstep, voffB); PG8_STAGE(PG8_SA(0, 1), cA + hstep, voffA);
        if (wr == 1) PG8_BAR;
        PG8_WAIT_V(4); PG8_BAR;
        PG8_STAGE(PG8_SB(1, 0), cB + kstep, voffB); PG8_STAGE(PG8_SA(1, 0), cA + kstep, voffA); PG8_STAGE(PG8_SB(1, 1), cB + hstep + kstep, voffB);
        PG8_WAIT_V(6); PG8_BAR;
    }
    for (;;) {
        const bool has_next = S.next(ui + 1, nxt);
        const char* nA = has_next ? (const char*)g.A + (size_t)nxt.pm * tstep : cA; const char* nB = has_next ? (const char*)g.Bt + (size_t)nxt.pn * tstep : cB;
        for (int t = 0; t < nt; t += 2) {
            const bool last = (t == nt - 2);
            const char* a1 = cA + (size_t)(t + 1) * kstep;
            const char* a2 = last ? nA : cA + (size_t)(t + 2) * kstep; const char* b2 = last ? nB : cB + (size_t)(t + 2) * kstep;
            const char* a3 = a2 + kstep; const char* b3 = b2 + kstep;
            if (last && has_next) S.a_ready(nxt);
            if constexpr (SP2) {
            PG8_LDB(B0, 0, 0); PG8_LDB(B1, 0, 1); PG8_SCHED; PG8_LDA(At, 0, 0); PG8_STAGE(PG8_SA(1, 1), a1 + hstep, voffA);
            PG8_WAIT_V(8); PG8_WAIT_L(0); PG8_BAR; PG8_MMA(0, 0, At, B0); PG8_MMA(0, 1, At, B1); PG8_BAR; PG8_SCHED;
            PG8_LDA(At, 0, 1); PG8_STAGE(PG8_SB(0, 0), b2, voffB); PG8_STAGE(PG8_SB(0, 1), b2 + hstep, voffB); PG8_STAGE(PG8_SA(0, 0), a2, voffA);
            PG8_WAIT_V(8); PG8_WAIT_L(0); PG8_BAR; PG8_MMA(1, 0, At, B0); PG8_MMA(1, 1, At, B1); PG8_BAR; PG8_SCHED;
            PG8_LDB(B0, 1, 0); PG8_LDB(B1, 1, 1); PG8_SCHED; PG8_LDA(At, 1, 0); PG8_STAGE(PG8_SA(0, 1), a2 + hstep, voffA);
            PG8_WAIT_V(8); PG8_WAIT_L(0); PG8_BAR; PG8_MMA(0, 0, At, B0); PG8_MMA(0, 1, At, B1); PG8_BAR; PG8_SCHED;
            PG8_LDA(At, 1, 1); PG8_STAGE(PG8_SB(1, 0), b3, voffB); PG8_STAGE(PG8_SB(1, 1), b3 + hstep, voffB); PG8_STAGE(PG8_SA(1, 0), a3, voffA);
            PG8_WAIT_V(8); PG8_WAIT_L(0); PG8_BAR; PG8_MMA(1, 0, At, B0); PG8_MMA(1, 1, At, B1); PG8_BAR; PG8_SCHED;
            } else {
            PG8_LDB(B0, 0, 0); PG8_SCHED; PG8_LDA(At, 0, 0); PG8_STAGE(PG8_SA(1, 1), a1 + hstep, voffA);
            PG8_WAIT_L(8); PG8_BAR; PG8_WAIT_L(0); PG8_MMA(0, 0, At, B0); PG8_BAR; PG8_SCHED;
            PG8_LDB(B1, 0, 1); PG8_STAGE(PG8_SB(0, 0), b2, voffB);
            PG8_BAR; PG8_WAIT_L(0); PG8_MMA(0, 1, At, B1); PG8_BAR;
            PG8_LDA(At, 0, 1); PG8_STAGE(PG8_SA(0, 0), a2, voffA);
            PG8_BAR; PG8_WAIT_L(0); PG8_MMA(1, 0, At, B0); PG8_BAR; PG8_SCHED;
            PG8_STAGE(PG8_SB(0, 1), b2 + hstep, voffB);
            PG8_WAIT_V(6); PG8_BAR; PG8_MMA(1, 1, At, B1); PG8_BAR;
            PG8_LDB(B0, 1, 0); PG8_SCHED; PG8_LDA(At, 1, 0); PG8_STAGE(PG8_SA(0, 1), a2 + hstep, voffA);
            PG8_WAIT_L(8); PG8_BAR; PG8_WAIT_L(0); PG8_MMA(0, 0, At, B0); PG8_BAR; PG8_SCHED;
            PG8_LDB(B1, 1, 1); PG8_STAGE(PG8_SB(1, 0), b3, voffB);
            PG8_BAR; PG8_WAIT_L(0); PG8_MMA(0, 1, At, B1); PG8_BAR;
            PG8_LDA(At, 1, 1); PG8_STAGE(PG8_SA(1, 0), a3, voffA);
            PG8_BAR; PG8_WAIT_L(0); PG8_MMA(1, 0, At, B0); PG8_BAR; PG8_SCHED;
            PG8_STAGE(PG8_SB(1, 1), b3 + hstep, voffB);
            PG8_WAIT_V(6); PG8_BAR; PG8_MMA(1, 1, At, B1); PG8_BAR;
            }
        }
        if constexpr (ALIGN_EPI) { if (wr == 0) PG8_BAR; }
        if constexpr (!Epi::AFTER_DRAIN) { E(acc, cur, wr, wc, fr, fq); S.done(cur); }
        if (!has_next) break;
#pragma unroll
        for (int a = 0; a < 2; ++a)
#pragma unroll
            for (int b = 0; b < 2; ++b)
#pragma unroll
                for (int m = 0; m < 4; ++m)
#pragma unroll
                    for (int n = 0; n < 2; ++n) acc[a][b][m][n] = (f32x4){0.f, 0.f, 0.f, 0.f};
        cur = nxt; cA = nA; cB = nB; ++ui;
        if constexpr (ALIGN_EPI) { if (wr == 1) PG8_BAR; }
    }
    PG8_WAIT_V(0);
    if constexpr (!ALIGN_EPI) { if (wr == 0) PG8_BAR; }
    PG8_BAR;
    if constexpr (Epi::AFTER_DRAIN) { E.fused(acc, cur, wr, wc, fr, fq, lds, wid, lane); S.done(cur); }
#undef PG8_SA
#undef PG8_SB
#undef PG8_STAGE
#undef PG8_LDA
#undef PG8_LDB
#undef PG8_MMA
#undef PG8_WAIT_V
#undef PG8_WAIT_L
#undef PG8_BAR
#undef PG8_SCHED
}
}

#define LAS __attribute__((address_space(3)))
#define XB_TMO      128
#define XB_XCNT(j)  (256  + 64 * (j))
#define XB_XSUB(j)  (1280 + 64 * (j))
#define XB_XGEN(j)  (2304 + 64 * (j))
#define XB_TOP      3328
#define XB_TOPGEN   3392
#define XCD_BAR_WORDS 3456
#define XB_SPIN_CAP (1u << 26)

__device__ __forceinline__ unsigned xb_ld(unsigned* p)              { return __hip_atomic_load(p, __ATOMIC_RELAXED, __HIP_MEMORY_SCOPE_AGENT); }
__device__ __forceinline__ unsigned xb_add(unsigned* p, unsigned v) { return __hip_atomic_fetch_add(p, v, __ATOMIC_RELAXED, __HIP_MEMORY_SCOPE_AGENT); }
__device__ __forceinline__ unsigned xb_xcc_id() { return (unsigned)__builtin_amdgcn_s_getreg((3 << 11) | 20) & 0xFu; }
#define XB_SPIN(cond, bar) do { unsigned _sp = 0; while (cond) { __builtin_amdgcn_s_sleep(1); \
    if ((++_sp & 255u) == 0u) { if (xb_ld(&(bar)[XB_TMO])) break; if (_sp > XB_SPIN_CAP) { atomicAdd(&(bar)[XB_TMO], 1u); break; } } } } while (0)

struct XcdBarrier {
    unsigned* bar; unsigned x;
    volatile LAS unsigned* st;
};

__device__ __forceinline__ XcdBarrier xcd_barrier_post(unsigned* bar, volatile LAS unsigned* st) {
    XcdBarrier b; b.bar = bar; b.x = xb_xcc_id(); b.st = st;
    if (threadIdx.x == 0) (void)xb_add(&bar[XB_XCNT(b.x)], 1u);
    return b;
}
__device__ __forceinline__ void xcd_barrier_complete(unsigned* bar, unsigned x, unsigned& nloc, unsigned& nx) {
    const unsigned G = gridDim.x * gridDim.y * gridDim.z;
    unsigned sum, cnt, mine, sp = 0u;
    for (;;) {
        sum = 0u; cnt = 0u; mine = 0u;
#pragma unroll
        for (unsigned j = 0; j < 16; ++j) { const unsigned c = xb_ld(&bar[XB_XCNT(j)]); sum += c; cnt += (c > 0u) ? 1u : 0u; mine = (j == x) ? c : mine; }
        if (sum == G) break;
        __builtin_amdgcn_s_sleep(1);
        if ((++sp & 255u) == 0u) { if (xb_ld(&bar[XB_TMO])) break; if (sp > XB_SPIN_CAP) { atomicAdd(&bar[XB_TMO], 1u); break; } }
    }
    nloc = mine > 0u ? mine : 1u; nx = cnt > 0u ? cnt : 1u;
}

__device__ __forceinline__ void xcd_barrier(const XcdBarrier& b) {
    asm volatile("s_waitcnt vmcnt(0)" ::: "memory");
    __syncthreads();
    if (threadIdx.x == 0) {
        unsigned* bar = b.bar;
        __builtin_amdgcn_s_waitcnt(0);
        unsigned nloc = b.st[0], nx = b.st[1];
        if (nloc == 0u) { xcd_barrier_complete(bar, b.x, nloc, nx); b.st[0] = nloc; b.st[1] = nx; }
        const unsigned old = xb_add(&bar[XB_XSUB(b.x)], 1u);
        const unsigned gen = old / nloc;
        if (old + 1u == (gen + 1u) * nloc) {
            __builtin_amdgcn_fence(__ATOMIC_RELEASE, "agent");
            asm volatile("s_waitcnt vmcnt(0)" ::: "memory");
            const unsigned og = xb_add(&bar[XB_TOP], 1u);
            const unsigned tg = og / nx;
            if (og + 1u == (tg + 1u) * nx) xb_add(&bar[XB_TOPGEN], 1u);
            else XB_SPIN(xb_ld(&bar[XB_TOPGEN]) == tg, bar);
            __builtin_amdgcn_fence(__ATOMIC_ACQUIRE, "agent");
            xb_add(&bar[XB_XGEN(b.x)], 1u);
            asm volatile("s_waitcnt vmcnt(0)" ::: "memory");
        } else {
            XB_SPIN(xb_ld(&bar[XB_XGEN(b.x)]) == gen, bar);
            __builtin_amdgcn_fence(__ATOMIC_ACQUIRE, "agent");
            asm volatile("s_waitcnt vmcnt(0)" ::: "memory");
        }
    }
    __syncthreads();
}

#ifndef PG8_SP2
#define PG8_SP2 true
#endif
#ifndef PG8_ALIGN
#define PG8_ALIGN true
#endif
#ifndef PROBE_ON
#define PROBE_ON 0
#define PROBE_A 0
#define PROBE_B 1
#endif
#ifndef MK_PER_PHASE
#define MK_PER_PHASE 0
#endif

constexpr int T = 16384, NSMP = 32, TS = T + NSMP, TSP = T + 256, DM = 1024;
constexpr int PA = 3368, PAP = 3584;
constexpr int C_Q = 0, C_KC = 512, C_VC = 640, C_KS = 768, C_VS = 896, C_KW = 1024, C_VW = 1152, C_GATE = 1280,
              C_GQKV = 1304, C_A = 2840, C_BT = 2848, C_Z = 2856;
constexpr int DFF = 2816, DFF2 = 5632;
constexpr float DN_ALPHA = 1.4142135623730951f;
constexpr float LN_EPS = 1e-5f, NORM_EPS = 1e-6f;
constexpr int NPAGES = 128;
constexpr int NWAVES = 8, NTHR = 512;

constexpr size_t O_Y_P = 0;
constexpr size_t O_Y_S = O_Y_P + (size_t)T * DM;
constexpr size_t O_CMP_P = O_Y_S + (size_t)NSMP * DM;
constexpr size_t O_CMP_S = O_CMP_P + (size_t)T * 256;
constexpr size_t O_SLC_P = O_CMP_S + (size_t)NSMP * 256;
constexpr size_t O_SLC_S = O_SLC_P + (size_t)T * 256;
constexpr size_t O_WIN_P = O_SLC_S + (size_t)NSMP * 256;
constexpr size_t O_WIN_S = O_WIN_P + (size_t)512 * 256;
constexpr size_t O_GCONV_P = O_WIN_S + (size_t)NSMP * 512 * 256;
constexpr size_t O_GCONV_S = O_GCONV_P + (size_t)3 * 1536;
constexpr size_t O_GS_P = O_GCONV_S + (size_t)NSMP * 3 * 1536;
constexpr size_t O_GS_S = O_GS_P + (size_t)8 * 64 * 64;
constexpr size_t O_DIL_P = O_GS_S + (size_t)NSMP * 8 * 64 * 64;
constexpr size_t O_DIL_S = O_DIL_P + (size_t)2048 * 2048;
constexpr size_t O_FFN_P = O_DIL_S + (size_t)NSMP * 2048 * 2048;
constexpr size_t O_FFN_S = O_FFN_P + (size_t)2 * 2 * DFF2;
constexpr size_t O_END = O_FFN_S + (size_t)NSMP * 2 * 2 * DFF2;

constexpr int RING_BYTES = 131072;
constexpr int FAST_WL = 17408;
constexpr int MISC_OFF = 8 * FAST_WL + 64;
constexpr int LDS_BYTES = 147456;

typedef unsigned short bf16;
typedef unsigned v4u __attribute__((ext_vector_type(4)));

__device__ __forceinline__ unsigned f2bf(float f) { return (unsigned)__builtin_bit_cast(unsigned short, (__bf16)f); }
__device__ __forceinline__ unsigned pk2(float lo, float hi) { return pg8::cvt_pk_bf16(lo, hi); }
typedef short bf16x8 __attribute__((ext_vector_type(8)));
typedef float f32x4 __attribute__((ext_vector_type(4)));
#define MFMA16(a, b, c) __builtin_amdgcn_mfma_f32_16x16x32_bf16((a), (b), (c), 0, 0, 0)
__device__ __forceinline__ float wave_sum(float v) {
#pragma unroll
    for (int o = 1; o < 64; o <<= 1) v += __shfl_xor(v, o);
    return v;
}
__device__ __forceinline__ float wave_max(float v) {
#pragma unroll
    for (int o = 1; o < 64; o <<= 1) v = fmaxf(v, __shfl_xor(v, o));
    return v;
}
__device__ __forceinline__ void wave_lds_sync() { asm volatile("s_waitcnt lgkmcnt(0)" ::: "memory"); __builtin_amdgcn_wave_barrier(); asm volatile("" ::: "memory"); }
__device__ __forceinline__ float fexp_(float x) { return __builtin_amdgcn_exp2f(x * 1.4426950408889634f); }
__device__ __forceinline__ float fsilu_(float x) { return x * __builtin_amdgcn_rcpf(1.f + fexp_(-x)); }
__device__ __forceinline__ float sigmoidf_(float x) { return 1.f / (1.f + expf(-x)); }
__device__ __forceinline__ float siluf_(float x) { return x / (1.f + expf(-x)); }
__device__ __forceinline__ float gelu_tanh(float x) { const float c = 0.7978845608028654f; return 0.5f * x * (1.f + tanhf(c * (x + 0.044715f * x * x * x))); }
__device__ __forceinline__ float softplusf_(float x) { return x > 20.f ? x : log1pf(expf(x)); }

struct KP {
    const float *x_prompt, *x_sample, *cache_cmp, *cache_slc, *st_win, *st_gconv, *st_gS, *st_dil, *st_ffn;
    const int* page_table;
    const float *w_in_a, *cw1, *cb1, *cw2, *cpe, *gconv_w, *gA, *gdt, *gnw, *w_out_a, *w_in_c, *w_out_c, *ln_mix_g, *ln_mix_b,
                *ffn_w_in, *ffn_cw, *ffn_cb, *ffn_w_out, *ln_ffn_g, *ln_ffn_b;
    float* out;
    unsigned* ctl;
    bf16 *WT_A, *WT_OA, *WT_FI0, *WT_FI1, *WT_FO0, *WT_FO1, *WT_CI, *WT_CO;
    float2* ROPE;
    bf16 *ACTB, *MIXB, *HFFB;
    bf16 *QB, *KSF, *VSF, *KWF, *VWF, *CKF, *CVF;
    unsigned char *KS8, *VS8;
    bf16 *QDB; bf16* DKF[3]; bf16* DVF[3];
    bf16 *AC, *WT_C, *HID, *W2T, *ACP; float* SMIXF; float* NSACC; int* SEL; float* UB;
    bf16 *G_WF, *G_KDF, *G_QGF, *G_QKF, *G_SPF, *G_VNF; float *G_UF, *G_GL;
    float *BIGF, *MO, *X1, *X2, *X3, *QR, *KS, *VS, *KW, *VW, *CK, *CV, *GQ, *GK, *GV, *OG, *Gg, *Gb, *QD, *KD;
    int ph_lo, ph_hi;
};

struct Fr { unsigned char* lds; int tid, lane, wave, gw, NGW, bid, G; };

__device__ __forceinline__ int ffn_row(int u) { const int half = u >= DFF ? 1 : 0, jc = u - half * DFF; return 256 * (jc >> 7) + 128 * half + (jc & 127); }
__device__ __forceinline__ void transpose_item(const float* W, int K, int N, int NT, bf16* WT, float* scr, int item, int lane, int rowmap = 0) {
    const int nblk = NT / 32, kb = item / nblk, nb = item % nblk, k0 = 64 * kb, n0 = 32 * nb;
#pragma unroll 8
    for (int i = 0; i < 32; ++i) { const int kk = 2 * i + (lane >> 5); const int n = n0 + (lane & 31); scr[kk * 33 + (lane & 31)] = (n < N) ? W[(size_t)(k0 + kk) * N + n] : 0.f; }
    wave_lds_sync();
    const int c = lane & 7;
#pragma unroll
    for (int j = 0; j < 4; ++j) { const int n = (lane >> 3) + 8 * j; const float* s = scr + (8 * c) * 33 + n;
        v4u o; o.x = pk2(s[0 * 33], s[1 * 33]); o.y = pk2(s[2 * 33], s[3 * 33]); o.z = pk2(s[4 * 33], s[5 * 33]); o.w = pk2(s[6 * 33], s[7 * 33]);
        const int row = rowmap ? ffn_row(n0 + n) : n0 + n;
        *(v4u*)(WT + (size_t)row * K + k0 + 8 * c) = o; }
    wave_lds_sync();
}
__device__ __forceinline__ void ph_prologue(const KP& p, const Fr& F) {
    float* scr = (float*)(F.lds + F.wave * 16384);
    const int I_A = 16 * (PAP / 32), I_OA = 16 * 32, I_FI = 16 * (DFF2 / 32), I_FO = (DFF / 64) * 32, I_CI = 16 * (3072 / 32), I_CO = 16 * 32;
    const int NITEMS = I_A + I_OA + 2 * I_FI + 2 * I_FO + I_CI + I_CO + 256 + 8;
    for (int it = F.gw; it < NITEMS; it += F.NGW) {
        int r = it;
        if (r < I_A) { transpose_item(p.w_in_a, DM, PA, PAP, p.WT_A, scr, r, F.lane); continue; } r -= I_A;
        if (r < I_OA) { transpose_item(p.w_out_a, DM, DM, DM, p.WT_OA, scr, r, F.lane); continue; } r -= I_OA;
        if (r < I_FI) { transpose_item(p.ffn_w_in, DM, DFF2, DFF2, p.WT_FI0, scr, r, F.lane, 1); continue; } r -= I_FI;
        if (r < I_FI) { transpose_item(p.ffn_w_in + (size_t)DM * DFF2, DM, DFF2, DFF2, p.WT_FI1, scr, r, F.lane, 1); continue; } r -= I_FI;
        if (r < I_FO) { transpose_item(p.ffn_w_out, DFF, DM, DM, p.WT_FO0, scr, r, F.lane); continue; } r -= I_FO;
        if (r < I_FO) { transpose_item(p.ffn_w_out + (size_t)DFF * DM, DFF, DM, DM, p.WT_FO1, scr, r, F.lane); continue; } r -= I_FO;
        if (r < I_CI) { transpose_item(p.w_in_c, DM, 3072, 3072, p.WT_CI, scr, r, F.lane); continue; } r -= I_CI;
        if (r < I_CO) { transpose_item(p.w_out_c, DM, DM, DM, p.WT_CO, scr, r, F.lane); continue; } r -= I_CO;
        if (r < 256) { const int kv = r >> 7; transpose_item(p.cw1 + (size_t)kv * 2048 * 128, 2048, 128, 128, p.WT_C + (size_t)kv * 128 * 2048, scr, r & 127, F.lane); continue; } r -= 256;
        { const int kv = r >> 2; transpose_item(p.cw2 + (size_t)kv * 128 * 64, 128, 64, 64, p.W2T + (size_t)kv * 64 * 128, scr, r & 3, F.lane); }
    }
    const size_t gt = (size_t)F.bid * NTHR + F.tid, GT = (size_t)F.G * NTHR;
    for (size_t i4 = gt; i4 < (size_t)TSP * (DM / 4); i4 += GT) {
        const int r = (int)(i4 / (DM / 4)), c4 = (int)(i4 % (DM / 4));
        float4 v = make_float4(0.f, 0.f, 0.f, 0.f);
        if (r < T) v = ((const float4*)p.x_prompt)[(size_t)r * (DM / 4) + c4]; else if (r < TS) v = ((const float4*)p.x_sample)[(size_t)(r - T) * (DM / 4) + c4];
        uint2 o; o.x = pk2(v.x, v.y); o.y = pk2(v.z, v.w);
        ((uint2*)p.ACTB)[i4] = o;
    }
    for (size_t idx = gt; idx < (size_t)(T + 1) * 32; idx += GT) {
        const int pos = (int)(idx >> 5), i = (int)(idx & 31);
        const float inv = (float)pow(10000.0, -2.0 * (double)i / 64.0);
        const float ang = (float)pos * inv;
        p.ROPE[idx] = make_float2((float)cos((double)ang), (float)sin((double)ang));
    }
}

__device__ __forceinline__ size_t vfrag_elem(int key, int d);
__device__ __forceinline__ size_t kfrag_elem(int key, int d);
__device__ __forceinline__ bf16x8 pack_p(const f32x4& p0, const f32x4& p1);
template <bool FFNMAP = false>
__device__ __forceinline__ void skinny_gemm(const Fr& F, const bf16* A, const bf16* Bt, int K, int ncols, float* C, int ldc) {
    const int lane = F.lane, l15 = lane & 15, grp = lane >> 4;
    const int kper = K >> 3, k0 = F.wave * kper;
    const bf16* a0 = A + (size_t)(T + l15) * K + 8 * grp + k0; const bf16* a1 = a0 + (size_t)16 * K;
    f32x4* red = (f32x4*)F.lds;
    const int ntiles = (ncols + 15) >> 4;
    for (int nt = F.bid; nt < ntiles; nt += F.G) {
        const bf16* bp = Bt + (size_t)(nt * 16 + l15) * K + 8 * grp + k0;
        f32x4 c0 = {0.f, 0.f, 0.f, 0.f}, c1 = {0.f, 0.f, 0.f, 0.f};
#pragma unroll 4
        for (int k = 0; k < kper; k += 32) {
            const bf16x8 b = *(const bf16x8*)(bp + k), x0 = *(const bf16x8*)(a0 + k), x1 = *(const bf16x8*)(a1 + k);
            c0 = MFMA16(x0, b, c0); c1 = MFMA16(x1, b, c1);
        }
        red[(F.wave * 2 + 0) * 64 + lane] = c0; red[(F.wave * 2 + 1) * 64 + lane] = c1;
        __syncthreads();
        if (F.wave == 0) {
#pragma unroll
            for (int w = 1; w < 8; ++w) { c0 = c0 + red[(w * 2 + 0) * 64 + lane]; c1 = c1 + red[(w * 2 + 1) * 64 + lane]; }
            int n = nt * 16 + l15;
            if (FFNMAP) n = ((n >> 7) & 1) * DFF + (n >> 8) * 128 + (n & 127);
            if (n < ncols) {
#pragma unroll
                for (int r = 0; r < 4; ++r) { C[(size_t)(T + 4 * grp + r) * ldc + n] = c0[r]; C[(size_t)(T + 16 + 4 * grp + r) * ldc + n] = c1[r]; }
            }
        }
        __syncthreads();
    }
}
__device__ __forceinline__ void ph_gemm_f32(const Fr& F, const bf16* A, const bf16* Bt, int N, int K, float* C, int ldc, int ncols) {
    skinny_gemm(F, A, Bt, K, ncols, C, ldc);
    pg8::Gemm g{A, Bt, T, N, K}; pg8::StaticOrder S; S.init(T, N, F.G, F.bid);
    pg8::EpiF32 E{C, ldc, ncols};
    pg8::gemm_phase<pg8::EpiF32, pg8::StaticOrder, PG8_ALIGN, PG8_SP2>((PG8_LAS unsigned char*)F.lds, g, S, E);
}
__device__ __forceinline__ float dpp_ror1(float x) { return __int_as_float(__builtin_amdgcn_update_dpp(0, __float_as_int(x), 0x121, 0xf, 0xf, false)); }
__device__ __forceinline__ float dpp_ror2(float x) { return __int_as_float(__builtin_amdgcn_update_dpp(0, __float_as_int(x), 0x122, 0xf, 0xf, false)); }
struct EpiFfn {
    static constexpr bool PERM = true, AFTER_DRAIN = false;
    bf16* H; float* UB; const float* cw; const float* cb;
    __device__ __forceinline__ void operator()(const pg8::f32x4 (&acc)[2][2][4][2], const pg8::Unit& u, int wr, int wc, int fr, int fq) const {
#pragma unroll
        for (int n = 0; n < 2; ++n) {
            const int jc = u.pn * 128 + wc * 32 + 8 * fq + 4 * n;
            pg8::f32x4 w0[2], w1[2], w2[2], bb[2];
#pragma unroll
            for (int bj = 0; bj < 2; ++bj) { const int uc = bj * DFF + jc;
                w0[bj] = *(const pg8::f32x4*)(cw + uc); w1[bj] = *(const pg8::f32x4*)(cw + DFF2 + uc); w2[bj] = *(const pg8::f32x4*)(cw + 2 * DFF2 + uc); bb[bj] = *(const pg8::f32x4*)(cb + uc); }
#pragma unroll
            for (int ai = 0; ai < 2; ++ai) {
                const int sl = u.pm * 4 + ai * 2 + wr;
                pg8::f32x4 pr1[2], pr2[2];
#pragma unroll
                for (int m = 0; m < 4; ++m) {
                    pg8::f32x4 c[2];
#pragma unroll
                    for (int bj = 0; bj < 2; ++bj) {
                        const pg8::f32x4 uu = acc[ai][bj][m][n]; pg8::f32x4 r1, r2;
#pragma unroll
                        for (int e = 0; e < 4; ++e) { r1[e] = dpp_ror1(uu[e]); r2[e] = dpp_ror2(uu[e]); }
                        pg8::f32x4 p1 = r1, p2 = r2;
                        if (m > 0) { if (fr == 0) p1 = pr1[bj]; if (fr < 2) p2 = pr2[bj]; }
                        c[bj] = bb[bj] + w0[bj] * p2 + w1[bj] * p1 + w2[bj] * uu;
                        pr1[bj] = r1; pr2[bj] = r2;
                        const int uc = bj * DFF + jc;
                        if (m == 0 && fr < 2) *(pg8::f32x4*)(UB + ((size_t)sl * 4 + fr) * DFF2 + uc) = uu;
                        if (m == 3 && fr >= 14) *(pg8::f32x4*)(UB + ((size_t)sl * 4 + 2 + (fr - 14)) * DFF2 + uc) = uu;
                    }
                    if (!(m == 0 && fr < 2)) {
                        const int t = u.pm * 256 + ai * 128 + wr * 64 + m * 16 + fr;
                        uint2 o; o.x = pk2(fsilu_(c[0][0]) * c[1][0], fsilu_(c[0][1]) * c[1][1]); o.y = pk2(fsilu_(c[0][2]) * c[1][2], fsilu_(c[0][3]) * c[1][3]);
                        *(uint2*)(H + (size_t)t * DFF + jc) = o;
                    }
                }
            }
        }
    }
};
__device__ __forceinline__ void ph_ffn_gemm(const KP& p, const Fr& F, const bf16* Bt, int layer) {
    skinny_gemm<true>(F, p.ACTB, Bt, DM, DFF2, p.BIGF, DFF2);
    pg8::Gemm g{p.ACTB, Bt, T, DFF2, DM}; pg8::StaticOrder S; S.init(T, DFF2, F.G, F.bid);
    EpiFfn E{p.HFFB, p.UB, p.ffn_cw + (size_t)layer * 3 * DFF2, p.ffn_cb + (size_t)layer * DFF2};
    pg8::gemm_phase<EpiFfn, pg8::StaticOrder, PG8_ALIGN, PG8_SP2>((PG8_LAS unsigned char*)F.lds, g, S, E);
}
__device__ __forceinline__ void ph_ffn_fix(const KP& p, const Fr& F, int layer) {
    const float* cw = p.ffn_cw + (size_t)layer * 3 * DFF2; const float* cb = p.ffn_cb + (size_t)layer * DFF2; const float* U = p.BIGF;
    const int gt = F.bid * NTHR + F.tid, GT = F.G * NTHR;
    for (int idx = gt; idx < 512 * DFF; idx += GT) {
        const int rr = idx / DFF, j = idx - rr * DFF; const int sl = rr >> 1, q = rr & 1;
        float c2[2];
#pragma unroll
        for (int half = 0; half < 2; ++half) { const int ch = half * DFF + j;
            const float u0 = p.UB[((size_t)sl * 4 + q) * DFF2 + ch];
            const float um1 = q ? p.UB[((size_t)sl * 4) * DFF2 + ch] : (sl ? p.UB[((size_t)(sl - 1) * 4 + 3) * DFF2 + ch] : 0.f);
            const float um2 = sl ? p.UB[((size_t)(sl - 1) * 4 + 2 + q) * DFF2 + ch] : 0.f;
            c2[half] = cb[ch] + cw[ch] * um2 + cw[DFF2 + ch] * um1 + cw[2 * DFF2 + ch] * u0; }
        p.HFFB[(size_t)(64 * sl + q) * DFF + j] = (bf16)f2bf(siluf_(c2[0]) * c2[1]);
    }
    for (int idx = gt; idx < NSMP * DFF; idx += GT) {
        const int b = idx / DFF, j = idx - b * DFF;
        float c2[2];
#pragma unroll
        for (int half = 0; half < 2; ++half) { const int ch = half * DFF + j;
            const float* hs = p.st_ffn + (((size_t)b * 2 + layer) * 2) * DFF2 + ch;
            c2[half] = cb[ch] + cw[ch] * hs[0] + cw[DFF2 + ch] * hs[DFF2] + cw[2 * DFF2 + ch] * U[(size_t)(T + b) * DFF2 + ch]; }
        p.HFFB[(size_t)(T + b) * DFF + j] = (bf16)f2bf(siluf_(c2[0]) * c2[1]);
    }
    for (int idx = gt; idx < 2 * DFF2; idx += GT) { const int k = idx / DFF2, ch = idx - k * DFF2;
        p.out[O_FFN_P + ((size_t)layer * 2 + k) * DFF2 + ch] = p.UB[((size_t)255 * 4 + 2 + k) * DFF2 + ch]; }
    for (int idx = gt; idx < NSMP * 2 * DFF2; idx += GT) { const int b = idx / (2 * DFF2), k = (idx / DFF2) & 1, ch = idx % DFF2;
        p.out[O_FFN_S + (((size_t)b * 2 + layer) * 2 + k) * DFF2 + ch] = (k == 0) ? p.st_ffn[(((size_t)b * 2 + layer) * 2 + 1) * DFF2 + ch] : U[(size_t)(T + b) * DFF2 + ch]; }
}
struct EpiCmp {
    static constexpr bool PERM = false, AFTER_DRAIN = false;
    bf16* HID; const float* b1;
    __device__ __forceinline__ void operator()(const pg8::f32x4 (&acc)[2][2][4][2], const pg8::Unit& u, int wr, int wc, int fr, int fq) const {
#pragma unroll
        for (int ai = 0; ai < 2; ++ai)
#pragma unroll
            for (int m = 0; m < 4; ++m) { const int combo = u.pm * 128 + wr * 64 + m * 16 + fr;
#pragma unroll
                for (int n = 0; n < 2; ++n) { const int j0 = wc * 32 + n * 16 + 4 * fq; const pg8::f32x4 v = acc[ai][ai][m][n]; const float* bb = b1 + ai * 128 + j0;
                    uint2 o; o.x = pk2(gelu_tanh(v[0] + bb[0]), gelu_tanh(v[1] + bb[1])); o.y = pk2(gelu_tanh(v[2] + bb[2]), gelu_tanh(v[3] + bb[3]));
                    *(uint2*)(HID + ((size_t)combo * 2 + ai) * 128 + j0) = o; } }
    }
};
__device__ __forceinline__ void ph_cmp_gemm(const KP& p, const Fr& F) {
    pg8::Gemm g{p.AC, p.WT_C, 65536, 256, 2048}; pg8::StaticOrder S; S.init(65536, 256, F.G, F.bid);
    EpiCmp E{p.HID, p.cb1};
    pg8::gemm_phase<EpiCmp, pg8::StaticOrder, PG8_ALIGN, PG8_SP2>((PG8_LAS unsigned char*)F.lds, g, S, E);
}
__device__ __forceinline__ void ph_cmp_stage2(const KP& p, const Fr& F) {
    const int lane = F.lane, l15 = lane & 15, grp = lane >> 4;
    for (int tile = F.gw; tile < 4096; tile += F.NGW) {
        const int kv = tile & 1, combo0 = (tile >> 1) * 16;
        const bf16* hid = p.HID + ((size_t)(combo0 + l15) * 2 + kv) * 128 + 8 * grp; const bf16* w2 = p.W2T + (size_t)kv * 64 * 128 + (size_t)l15 * 128 + 8 * grp;
        f32x4 acc[4];
#pragma unroll
        for (int nt = 0; nt < 4; ++nt) acc[nt] = (f32x4){0.f, 0.f, 0.f, 0.f};
#pragma unroll
        for (int ks = 0; ks < 4; ++ks) { const bf16x8 a = *(const bf16x8*)(hid + 32 * ks);
#pragma unroll
            for (int nt = 0; nt < 4; ++nt) acc[nt] = MFMA16(a, *(const bf16x8*)(w2 + (size_t)nt * 16 * 128 + 32 * ks), acc[nt]); }
#pragma unroll
        for (int r = 0; r < 4; ++r) {
            const int combo = combo0 + 4 * grp + r; const int g = combo & 1, c = (combo >> 1) & 511, b = combo >> 10;
            float* dst = ((kv == 0) ? p.CK : p.CV) + (((size_t)(1 + b) * 512 + c) * 2 + g) * 64;
            if (kv == 0) {
                const int pos = (c + 1) * 32 - 1;
#pragma unroll
                for (int nt = 0; nt < 2; ++nt) { const float2 cs = p.ROPE[pos * 32 + 16 * nt + l15]; const float x1 = acc[nt][r], x2 = acc[nt + 2][r];
                    dst[16 * nt + l15] = x1 * cs.x - x2 * cs.y; dst[16 * (nt + 2) + l15] = x2 * cs.x + x1 * cs.y; }
            } else {
#pragma unroll
                for (int nt = 0; nt < 4; ++nt) dst[16 * nt + l15] = acc[nt][r];
            }
        }
    }
}
__device__ __forceinline__ void cmp_prompt_unit(const KP& p, int unit, int lane) {
    asm volatile("" : "+v"(lane));
    const int l15 = lane & 15, grp = lane >> 4;
    const int kv = unit & 1, combo = (unit >> 1) * 16 + l15; const int g = combo & 1, c = combo >> 1;
    const bf16* w1 = p.WT_C + ((size_t)kv * 128 + l15) * 2048 + 8 * grp;
    f32x4 acc[8];
#pragma unroll
    for (int jt = 0; jt < 8; ++jt) acc[jt] = (f32x4){0.f, 0.f, 0.f, 0.f};
    const bf16* fl = p.ACP + ((size_t)kv * 1024 + combo) * 2048 + 8 * grp;
#pragma unroll 4
    for (int ks = 0; ks < 64; ++ks) {
        const bf16x8 fb = *(const bf16x8*)(fl + 32 * ks);
#pragma unroll
        for (int jt = 0; jt < 8; ++jt) acc[jt] = MFMA16(*(const bf16x8*)(w1 + (size_t)jt * 16 * 2048 + 32 * ks), fb, acc[jt]);
    }
    bf16x8 hb[4];
#pragma unroll
    for (int s2 = 0; s2 < 4; ++s2) {
        f32x4 h0, h1;
#pragma unroll
        for (int r = 0; r < 4; ++r) { h0[r] = gelu_tanh(acc[2 * s2][r] + p.cb1[kv * 128 + 32 * s2 + 4 * grp + r]); h1[r] = gelu_tanh(acc[2 * s2 + 1][r] + p.cb1[kv * 128 + 32 * s2 + 16 + 4 * grp + r]); }
        hb[s2] = pack_p(h0, h1);
    }
    f32x4 o[4];
#pragma unroll
    for (int dt = 0; dt < 4; ++dt) {
        o[dt] = (f32x4){0.f, 0.f, 0.f, 0.f};
        const bf16* w2 = p.W2T + (size_t)kv * 64 * 128 + (size_t)(16 * dt + l15) * 128 + 4 * grp;
#pragma unroll
        for (int s2 = 0; s2 < 4; ++s2) { const uint2 x0 = *(const uint2*)(w2 + 32 * s2), x1 = *(const uint2*)(w2 + 32 * s2 + 16);
            union { v4u u; bf16x8 b; } wa; wa.u.x = x0.x; wa.u.y = x0.y; wa.u.z = x1.x; wa.u.w = x1.y;
            o[dt] = MFMA16(wa.b, hb[s2], o[dt]); }
    }
    if (kv == 0) {
        const int pos = (c + 1) * 32 - 1;
#pragma unroll
        for (int dt = 0; dt < 2; ++dt)
#pragma unroll
            for (int r = 0; r < 4; ++r) { const float2 cs = p.ROPE[pos * 32 + 16 * dt + 4 * grp + r]; const float x1 = o[dt][r], x2 = o[dt + 2][r];
                o[dt][r] = x1 * cs.x - x2 * cs.y; o[dt + 2][r] = x2 * cs.x + x1 * cs.y; }
    }
#pragma unroll
    for (int dt = 0; dt < 4; ++dt)
#pragma unroll
        for (int r = 0; r < 4; ++r) { const int d = 16 * dt + 4 * grp + r;
            if (kv == 0) p.CKF[(size_t)g * 512 * 64 + kfrag_elem(c, d)] = (bf16)f2bf(o[dt][r]); else p.CVF[(size_t)g * 512 * 64 + vfrag_elem(c, d)] = (bf16)f2bf(o[dt][r]); }
}
__device__ __forceinline__ void cmp_sample_unit(const KP& p, int unit, int lane) {
    asm volatile("" : "+v"(lane));
    const int l15 = lane & 15, grp = lane >> 4;
    const int b = unit >> 6, kv = (unit >> 5) & 1, cb = unit & 31;
    const bf16* w1 = p.WT_C + ((size_t)kv * 128 + l15) * 2048 + 8 * grp;
    const float* src[2];
#pragma unroll
    for (int cg = 0; cg < 2; ++cg) { const int combo = cb * 32 + 16 * cg + l15; const int g = combo & 1, c = combo >> 1;
        const int page = p.page_table[b * NPAGES + (c >> 2)];
        src[cg] = p.cache_cmp + (((size_t)page * 128 + (c & 3) * 32) * 4 + kv * 2 + g) * 64 + 8 * grp; }
    const float* pe = p.cpe + (size_t)kv * 32 * 64 + 8 * grp;
    f32x4 acc[2][8];
#pragma unroll
    for (int cg = 0; cg < 2; ++cg)
#pragma unroll
        for (int jt = 0; jt < 8; ++jt) acc[cg][jt] = (f32x4){0.f, 0.f, 0.f, 0.f};
#pragma unroll 2
    for (int ks = 0; ks < 64; ++ks) {
        const int i = ks >> 1, dd = 32 * (ks & 1);
        const float4 e0 = *(const float4*)(pe + i * 64 + dd), e1 = *(const float4*)(pe + i * 64 + dd + 4);
        bf16x8 fb[2];
#pragma unroll
        for (int cg = 0; cg < 2; ++cg) { const float4 a0 = *(const float4*)(src[cg] + i * 256 + dd), a1 = *(const float4*)(src[cg] + i * 256 + dd + 4);
            union { v4u u; bf16x8 b; } t; t.u.x = pk2(a0.x + e0.x, a0.y + e0.y); t.u.y = pk2(a0.z + e0.z, a0.w + e0.w); t.u.z = pk2(a1.x + e1.x, a1.y + e1.y); t.u.w = pk2(a1.z + e1.z, a1.w + e1.w); fb[cg] = t.b; }
#pragma unroll
        for (int jt = 0; jt < 8; ++jt) { const bf16x8 wa = *(const bf16x8*)(w1 + (size_t)jt * 16 * 2048 + 32 * ks);
            acc[0][jt] = MFMA16(wa, fb[0], acc[0][jt]); acc[1][jt] = MFMA16(wa, fb[1], acc[1][jt]); }
    }
#pragma unroll
    for (int cg = 0; cg < 2; ++cg) {
        const int combo = cb * 32 + 16 * cg + l15; const int g = combo & 1, c = combo >> 1;
        bf16x8 hb[4];
#pragma unroll
        for (int s2 = 0; s2 < 4; ++s2) { f32x4 h0, h1;
#pragma unroll
            for (int r = 0; r < 4; ++r) { h0[r] = gelu_tanh(acc[cg][2 * s2][r] + p.cb1[kv * 128 + 32 * s2 + 4 * grp + r]); h1[r] = gelu_tanh(acc[cg][2 * s2 + 1][r] + p.cb1[kv * 128 + 32 * s2 + 16 + 4 * grp + r]); }
            hb[s2] = pack_p(h0, h1); }
        f32x4 o[4];
#pragma unroll
        for (int dt = 0; dt < 4; ++dt) {
            o[dt] = (f32x4){0.f, 0.f, 0.f, 0.f};
            const bf16* w2 = p.W2T + (size_t)kv * 64 * 128 + (size_t)(16 * dt + l15) * 128 + 4 * grp;
#pragma unroll
            for (int s2 = 0; s2 < 4; ++s2) { const uint2 x0 = *(const uint2*)(w2 + 32 * s2), x1 = *(const uint2*)(w2 + 32 * s2 + 16);
                union { v4u u; bf16x8 b; } wa; wa.u.x = x0.x; wa.u.y = x0.y; wa.u.z = x1.x; wa.u.w = x1.y;
                o[dt] = MFMA16(wa.b, hb[s2], o[dt]); }
        }
        if (kv == 0) {
            const int pos = (c + 1) * 32 - 1;
#pragma unroll
            for (int dt = 0; dt < 2; ++dt)
#pragma unroll
                for (int r = 0; r < 4; ++r) { const float2 cs = p.ROPE[pos * 32 + 16 * dt + 4 * grp + r]; const float x1 = o[dt][r], x2 = o[dt + 2][r];
                    o[dt][r] = x1 * cs.x - x2 * cs.y; o[dt + 2][r] = x2 * cs.x + x1 * cs.y; }
        }
        float* dst = ((kv == 0) ? p.CK : p.CV) + (((size_t)(1 + b) * 512 + c) * 2 + g) * 64 + 4 * grp;
#pragma unroll
        for (int dt = 0; dt < 4; ++dt) *(f32x4*)(dst + 16 * dt) = o[dt];
    }
}
constexpr int W1S_PITCH = 528;
constexpr int W1S_BYTES = 128 * W1S_PITCH;
__device__ __forceinline__ void cmp_sample_wg(const KP& p, int wu, const Fr& F) {
    int lane = F.lane; asm volatile("" : "+v"(lane));
    const int l15 = lane & 15, grp = lane >> 4, tid = F.tid;
    const int b = wu >> 3, kv = (wu >> 2) & 1, q4 = wu & 3;
    const float* src[2];
#pragma unroll
    for (int cg = 0; cg < 2; ++cg) { const int combo = q4 * 256 + F.wave * 32 + 16 * cg + l15; const int g = combo & 1, c = combo >> 1;
        const int page = p.page_table[b * NPAGES + (c >> 2)];
        src[cg] = p.cache_cmp + (((size_t)page * 128 + (c & 3) * 32) * 4 + kv * 2 + g) * 64 + 8 * grp; }
    const float* pe = p.cpe + (size_t)kv * 32 * 64 + 8 * grp;
    const bf16* wg = p.WT_C + (size_t)kv * 128 * 2048;
    f32x4 acc[2][8];
#pragma unroll
    for (int cg = 0; cg < 2; ++cg)
#pragma unroll
        for (int jt = 0; jt < 8; ++jt) acc[cg][jt] = (f32x4){0.f, 0.f, 0.f, 0.f};
    v4u wreg[8];
#pragma unroll
    for (int k = 0; k < 8; ++k) { const int c = tid + 512 * k; wreg[k] = *(const v4u*)(wg + (size_t)(c >> 5) * 2048 + (c & 31) * 8); }
#pragma unroll
    for (int k = 0; k < 8; ++k) { const int c = tid + 512 * k; *(v4u*)(F.lds + (c >> 5) * W1S_PITCH + (c & 31) * 16) = wreg[k]; }
    __syncthreads();
#pragma unroll 1
    for (int sl = 0; sl < 8; ++sl) {
        if (sl + 1 < 8) {
#pragma unroll
            for (int k = 0; k < 8; ++k) { const int c = tid + 512 * k; wreg[k] = *(const v4u*)(wg + (size_t)(c >> 5) * 2048 + (sl + 1) * 256 + (c & 31) * 8); }
        }
        const unsigned char* wl = F.lds + (sl & 1) * W1S_BYTES + l15 * W1S_PITCH + grp * 16;
#pragma unroll 2
        for (int kk = 0; kk < 8; ++kk) {
            const int ks = sl * 8 + kk, i = ks >> 1, dd = 32 * (ks & 1);
            const float4 e0 = *(const float4*)(pe + i * 64 + dd), e1 = *(const float4*)(pe + i * 64 + dd + 4);
            bf16x8 fb[2];
#pragma unroll
            for (int cg = 0; cg < 2; ++cg) { const float4 a0 = *(const float4*)(src[cg] + i * 256 + dd), a1 = *(const float4*)(src[cg] + i * 256 + dd + 4);
                union { v4u u; bf16x8 b; } t; t.u.x = pk2(a0.x + e0.x, a0.y + e0.y); t.u.y = pk2(a0.z + e0.z, a0.w + e0.w); t.u.z = pk2(a1.x + e1.x, a1.y + e1.y); t.u.w = pk2(a1.z + e1.z, a1.w + e1.w); fb[cg] = t.b; }
#pragma unroll
            for (int jt = 0; jt < 8; ++jt) { const bf16x8 wa = *(const bf16x8*)(wl + jt * 16 * W1S_PITCH + kk * 64);
                acc[0][jt] = MFMA16(wa, fb[0], acc[0][jt]); acc[1][jt] = MFMA16(wa, fb[1], acc[1][jt]); }
        }
        if (sl + 1 < 8) {
#pragma unroll
            for (int k = 0; k < 8; ++k) { const int c = tid + 512 * k; *(v4u*)(F.lds + ((sl + 1) & 1) * W1S_BYTES + (c >> 5) * W1S_PITCH + (c & 31) * 16) = wreg[k]; }
        }
        __syncthreads();
    }
#pragma unroll
    for (int cg = 0; cg < 2; ++cg) {
        const int combo = q4 * 256 + F.wave * 32 + 16 * cg + l15; const int g = combo & 1, c = combo >> 1;
        bf16x8 hb[4];
#pragma unroll
        for (int s2 = 0; s2 < 4; ++s2) { f32x4 h0, h1;
#pragma unroll
            for (int r = 0; r < 4; ++r) { h0[r] = gelu_tanh(acc[cg][2 * s2][r] + p.cb1[kv * 128 + 32 * s2 + 4 * grp + r]); h1[r] = gelu_tanh(acc[cg][2 * s2 + 1][r] + p.cb1[kv * 128 + 32 * s2 + 16 + 4 * grp + r]); }
            hb[s2] = pack_p(h0, h1); }
        f32x4 o[4];
#pragma unroll
        for (int dt = 0; dt < 4; ++dt) {
            o[dt] = (f32x4){0.f, 0.f, 0.f, 0.f};
            const bf16* w2 = p.W2T + (size_t)kv * 64 * 128 + (size_t)(16 * dt + l15) * 128 + 4 * grp;
#pragma unroll
            for (int s2 = 0; s2 < 4; ++s2) { const uint2 x0 = *(const uint2*)(w2 + 32 * s2), x1 = *(const uint2*)(w2 + 32 * s2 + 16);
                union { v4u u; bf16x8 b; } wa; wa.u.x = x0.x; wa.u.y = x0.y; wa.u.z = x1.x; wa.u.w = x1.y;
                o[dt] = MFMA16(wa.b, hb[s2], o[dt]); }
        }
        if (kv == 0) {
            const int pos = (c + 1) * 32 - 1;
#pragma unroll
            for (int dt = 0; dt < 2; ++dt)
#pragma unroll
                for (int r = 0; r < 4; ++r) { const float2 cs = p.ROPE[pos * 32 + 16 * dt + 4 * grp + r]; const float x1 = o[dt][r], x2 = o[dt + 2][r];
                    o[dt][r] = x1 * cs.x - x2 * cs.y; o[dt + 2][r] = x2 * cs.x + x1 * cs.y; }
        }
        float* dst = ((kv == 0) ? p.CK : p.CV) + (((size_t)(1 + b) * 512 + c) * 2 + g) * 64 + 4 * grp;
#pragma unroll
        for (int dt = 0; dt < 4; ++dt) *(f32x4*)(dst + 16 * dt) = o[dt];
    }
}
__device__ __forceinline__ void ph_cmp_samples(const KP& p, const Fr& F) {
    for (int wu = F.bid; wu < 256; wu += F.G) cmp_sample_wg(p, wu, F);
}
__device__ __forceinline__ void ph_cmp_prompt(const KP& p, const Fr& F) {
    for (int unit = F.gw; unit < 128; unit += F.NGW) cmp_prompt_unit(p, unit, F.lane);
}

__device__ __forceinline__ float rope_val(const float* row, int base, int i, float2 cs) {
    const int ii = i & 31;
    const float x1 = row[base + ii], x2 = row[base + ii + 32];
    return (i < 32) ? (x1 * cs.x - x2 * cs.y) : (x2 * cs.x + x1 * cs.y);
}
__device__ __forceinline__ void ph_nsa_prep(const KP& p, const Fr& F) {
    const float* H0 = p.BIGF; float* out = p.out;
    const size_t gt = (size_t)F.bid * NTHR + F.tid, GT = (size_t)F.G * NTHR;
    const size_t total = (size_t)TS * 1280;
    for (size_t idx = gt + (size_t)T * 1280; idx < total; idx += GT) {
        const int r = (int)(idx / 1280), c = (int)(idx % 1280);
        const bool smp = r >= T; const int b = r - T; const int pos = smp ? T : r;
        const float* row = H0 + (size_t)r * PA;
        const int i = c & 63;
        const float2 cs = p.ROPE[pos * 32 + (i & 31)];
        if (c < 512) { p.QR[(size_t)r * 512 + c] = rope_val(row, c & ~63, i, cs); continue; }
        const int sec = (c - 512) >> 7; const int gd = (c - 512) & 127; const int base = c & ~63;
        float v;
        if (sec == 2 || sec == 4) v = rope_val(row, base, i, cs); else v = row[c];
        const int kv = sec & 1;
        if (sec < 2) {
            if (!smp) out[O_CMP_P + (size_t)r * 256 + kv * 128 + gd] = v; else out[O_CMP_S + (size_t)b * 256 + kv * 128 + gd] = v;
        } else if (sec < 4) {
            if (!smp) out[O_SLC_P + (size_t)r * 256 + kv * 128 + gd] = v; else out[O_SLC_S + (size_t)b * 256 + kv * 128 + gd] = v;
            if (kv == 0) p.KS[(size_t)r * 128 + gd] = v; else p.VS[(size_t)r * 128 + gd] = v;
        } else {
            if (kv == 0) p.KW[(size_t)r * 128 + gd] = v; else p.VW[(size_t)r * 128 + gd] = v;
            if (!smp) { if (r >= T - 512) out[O_WIN_P + (size_t)(r - (T - 512)) * 256 + kv * 128 + gd] = v; }
            else out[O_WIN_S + ((size_t)b * 512 + 511) * 256 + kv * 128 + gd] = v;
        }
    }
    const size_t tot2 = (size_t)NSMP * 511 * 256;
    for (size_t idx = gt; idx < tot2; idx += GT) {
        const int b = (int)(idx / (511 * 256)); const int rem = (int)(idx % (511 * 256));
        out[O_WIN_S + (size_t)b * 512 * 256 + rem] = p.st_win[(size_t)b * 512 * 256 + 256 + rem];
    }
}

constexpr float QSCALE = 0.18033688011112042f;

__device__ __forceinline__ size_t kfrag_off(int kt, int ks, int lane) { return ((size_t)(kt * 2 + ks) * 64 + lane) * 8; }
__device__ __forceinline__ size_t vfrag_off(int st, int dt, int lane) { return ((size_t)(st * 4 + dt) * 64 + lane) * 8; }
__device__ __forceinline__ size_t vfrag_elem(int key, int d) {
    const int st = key >> 5, kk = key & 31, tile = kk >> 4, r16 = kk & 15, grp = r16 >> 2, reg = r16 & 3;
    return ((size_t)(st * 4 + (d >> 4)) * 64 + (d & 15) + 16 * grp) * 8 + tile * 4 + reg;
}
__device__ __forceinline__ size_t k8_off(int key, int d) { return ((size_t)(key >> 4) * 64 + (key & 15) + 16 * ((d & 31) >> 3)) * 16 + (d >> 5) * 8 + (d & 7); }
__device__ __forceinline__ size_t v8_off(int key, int d) {
    const int blk = key >> 6, st = (key >> 5) & 1, kk = key & 31, tile = kk >> 4, r16 = kk & 15, grp = r16 >> 2, reg = r16 & 3;
    return ((size_t)(blk * 4 + (d >> 4)) * 64 + (d & 15) + 16 * grp) * 16 + st * 8 + tile * 4 + reg;
}
__device__ __forceinline__ size_t kfrag_elem(int key, int d) {
    return ((size_t)((key >> 4) * 2 + (d >> 5)) * 64 + (key & 15) + 16 * ((d & 31) >> 3)) * 8 + (d & 7);
}

__device__ __forceinline__ void ph_nsa_prep_fast(const KP& p, const Fr& F) {
    const float* H0 = p.BIGF; float* out = p.out;
    const size_t gt = (size_t)F.bid * NTHR + F.tid, GT = (size_t)F.G * NTHR;
    for (size_t idx = gt; idx < (size_t)T * 160; idx += GT) {
        const int t = (int)(idx / 160), u = (int)(idx % 160);
        const int c0 = u * 8; const float* row = H0 + (size_t)t * PA;
        const float4 a0 = *(const float4*)(row + c0), a1 = *(const float4*)(row + c0 + 4);
        float v[8] = {a0.x, a0.y, a0.z, a0.w, a1.x, a1.y, a1.z, a1.w};
        const int sec = (u < 64) ? -1 : ((u - 64) >> 4);
        const bool roped = (sec == -1 || sec == 2 || sec == 4);
        if (roped) {
            const int d0 = c0 & 63; const int pc = (d0 < 32) ? c0 + 32 : c0 - 32;
            const float4 b0 = *(const float4*)(row + pc), b1 = *(const float4*)(row + pc + 4);
            const float w[8] = {b0.x, b0.y, b0.z, b0.w, b1.x, b1.y, b1.z, b1.w};
            const float4* rp = (const float4*)(p.ROPE + t * 32 + (d0 & 31)); const float4 r0 = rp[0], r1 = rp[1], r2 = rp[2], r3 = rp[3];
            const float cs[8] = {r0.x, r0.z, r1.x, r1.z, r2.x, r2.z, r3.x, r3.z}, sn[8] = {r0.y, r0.w, r1.y, r1.w, r2.y, r2.w, r3.y, r3.w};
#pragma unroll
            for (int j = 0; j < 8; ++j) v[j] = (d0 < 32) ? (v[j] * cs[j] - w[j] * sn[j]) : (v[j] * cs[j] + w[j] * sn[j]);
        }
        if (sec == -1) {
            v4u o; o.x = pk2(v[0] * QSCALE, v[1] * QSCALE); o.y = pk2(v[2] * QSCALE, v[3] * QSCALE); o.z = pk2(v[4] * QSCALE, v[5] * QSCALE); o.w = pk2(v[6] * QSCALE, v[7] * QSCALE);
            *(v4u*)(p.QB + (size_t)t * 512 + c0) = o; continue;
        }
        const int gd = (c0 - 512) & 127, g = gd >> 6, d0 = gd & 63, kv = sec & 1;
        const float4 o0 = make_float4(v[0], v[1], v[2], v[3]), o1 = make_float4(v[4], v[5], v[6], v[7]);
        if (sec < 2) { float* o = out + O_CMP_P + (size_t)t * 256 + kv * 128 + gd; *(float4*)o = o0; *(float4*)(o + 4) = o1;
            const int i = t & 31; const float* pe = p.cpe + (kv * 32 + i) * 64 + d0; const float4 e0 = *(const float4*)pe, e1 = *(const float4*)(pe + 4);
            v4u w; w.x = pk2(v[0] + e0.x, v[1] + e0.y); w.y = pk2(v[2] + e0.z, v[3] + e0.w); w.z = pk2(v[4] + e1.x, v[5] + e1.y); w.w = pk2(v[6] + e1.z, v[7] + e1.w);
            *(v4u*)(p.ACP + ((size_t)kv * 1024 + (t >> 5) * 2 + g) * 2048 + i * 64 + d0) = w; continue; }
        if (sec < 4) { float* o = out + O_SLC_P + (size_t)t * 256 + kv * 128 + gd; *(float4*)o = o0; *(float4*)(o + 4) = o1; }
        else if (t >= T - 512) { float* o = out + O_WIN_P + (size_t)(t - (T - 512)) * 256 + kv * 128 + gd; *(float4*)o = o0; *(float4*)(o + 4) = o1; }
        if (sec < 4) {
            if (kv == 0) {
                int w0 = 0, w1 = 0;
                w0 = __builtin_amdgcn_cvt_pk_fp8_f32(v[0], v[1], w0, false); w0 = __builtin_amdgcn_cvt_pk_fp8_f32(v[2], v[3], w0, true);
                w1 = __builtin_amdgcn_cvt_pk_fp8_f32(v[4], v[5], w1, false); w1 = __builtin_amdgcn_cvt_pk_fp8_f32(v[6], v[7], w1, true);
                *(uint2*)(p.KS8 + (size_t)g * T * 64 + k8_off(t, d0)) = make_uint2((unsigned)w0, (unsigned)w1);
            } else {
#pragma unroll
                for (int j = 0; j < 8; ++j) p.VS8[(size_t)g * T * 64 + v8_off(t, d0 + j)] = (unsigned char)(__builtin_amdgcn_cvt_pk_fp8_f32(v[j], 0.f, 0, false) & 0xff);
            }
            continue;
        }
        bf16* KF = p.KWF; bf16* VF = p.VWF;
        if (kv == 0) {
            v4u o; o.x = pk2(v[0], v[1]); o.y = pk2(v[2], v[3]); o.z = pk2(v[4], v[5]); o.w = pk2(v[6], v[7]);
            *(v4u*)(KF + (size_t)g * T * 64 + kfrag_elem(t, d0)) = o;
        } else {
#pragma unroll
            for (int j = 0; j < 8; ++j) VF[(size_t)g * T * 64 + vfrag_elem(t, d0 + j)] = (bf16)f2bf(v[j]);
        }
    }
}

struct AttW { f32x4 o[4]; float m, l; };
__device__ __forceinline__ void attw_init(AttW& a) {
#pragma unroll
    for (int i = 0; i < 4; ++i) a.o[i] = (f32x4){0.f, 0.f, 0.f, 0.f};
    a.m = -INFINITY; a.l = 0.f;
}
__device__ __forceinline__ void qk_step(const bf16x8 (&kf)[2][2], const bf16x8 (&qf)[2], f32x4& s0, f32x4& s1) {
    const f32x4 z = {0.f, 0.f, 0.f, 0.f};
    s0 = MFMA16(kf[0][0], qf[0], z); s0 = MFMA16(kf[0][1], qf[1], s0);
    s1 = MFMA16(kf[1][0], qf[0], z); s1 = MFMA16(kf[1][1], qf[1], s1);
}
__device__ __forceinline__ bf16x8 pack_p(const f32x4& p0, const f32x4& p1) {
    union { v4u u; bf16x8 b; } c;
    c.u.x = pg8::cvt_pk_bf16(p0[0], p0[1]); c.u.y = pg8::cvt_pk_bf16(p0[2], p0[3]); c.u.z = pg8::cvt_pk_bf16(p1[0], p1[1]); c.u.w = pg8::cvt_pk_bf16(p1[2], p1[3]);
    return c.b;
}
__device__ __forceinline__ void att_update(AttW& a, const f32x4& s0, const f32x4& s1, const bf16x8 (&vf)[4]) {
    float mx = fmaxf(fmaxf(fmaxf(s0[0], s0[1]), fmaxf(s0[2], s0[3])), fmaxf(fmaxf(s1[0], s1[1]), fmaxf(s1[2], s1[3])));
    mx = fmaxf(mx, __shfl_xor(mx, 16)); mx = fmaxf(mx, __shfl_xor(mx, 32));
    const float mn = fmaxf(a.m, mx);
    const float ms = (mn == -INFINITY) ? 0.f : mn;
    const float alpha = __builtin_amdgcn_exp2f(a.m - ms);
    f32x4 p0, p1;
#pragma unroll
    for (int i = 0; i < 4; ++i) { p0[i] = __builtin_amdgcn_exp2f(s0[i] - ms); p1[i] = __builtin_amdgcn_exp2f(s1[i] - ms); }
    a.l = a.l * alpha + ((p0[0] + p0[1]) + (p0[2] + p0[3])) + ((p1[0] + p1[1]) + (p1[2] + p1[3]));
    a.m = mn;
    const bf16x8 pf = pack_p(p0, p1);
#pragma unroll
    for (int dt = 0; dt < 4; ++dt) { a.o[dt] = a.o[dt] * alpha; a.o[dt] = MFMA16(vf[dt], pf, a.o[dt]); }
}
__device__ __forceinline__ float grp_sum(float v) { v += __shfl_xor(v, 16); v += __shfl_xor(v, 32); return v; }

__device__ __forceinline__ void nsa_fast_unit(const KP& p, int unit, float* wl, int lane) {
    asm volatile("" : "+v"(lane));
    const int g = unit & 1, t0 = (unit >> 1) * 16;
    const int qi = lane & 15, grp = lane >> 4, t = t0 + qi;
    float* imp = wl; int* sel = (int*)(wl + 4096);
    const float* grow = p.BIGF + (size_t)t * PA + C_GATE + g * 4;
    bf16x8 qf[4][2];
#pragma unroll
    for (int h = 0; h < 4; ++h)
#pragma unroll
        for (int ks = 0; ks < 2; ++ks) qf[h][ks] = *(const bf16x8*)(p.QB + (size_t)t * 512 + (g * 4 + h) * 64 + 32 * ks + 8 * grp);
    AttW st[4];
    {
        const bf16* CKF = p.CKF + (size_t)g * 512 * 64; const bf16* CVF = p.CVF + (size_t)g * 512 * 64;
        const int nmax = (t0 + 16) >> 5; const int nsteps = (nmax + 31) >> 5;
        const int nval = (t + 1) >> 5;
        float m[4], l[4];
#pragma unroll
        for (int h = 0; h < 4; ++h) { m[h] = -INFINITY; l[h] = 0.f; }
        for (int s = 0; s < nsteps; ++s) {
            bf16x8 kf[2][2];
#pragma unroll
            for (int tl = 0; tl < 2; ++tl)
#pragma unroll
                for (int ks = 0; ks < 2; ++ks) kf[tl][ks] = *(const bf16x8*)(CKF + kfrag_off(2 * s + tl, ks, lane));
            const int cb = 32 * s + 4 * grp;
#pragma unroll
            for (int h = 0; h < 4; ++h) {
                f32x4 s0, s1; qk_step(kf, qf[h], s0, s1);
#pragma unroll
                for (int i = 0; i < 4; ++i) { if (cb + i >= nval) s0[i] = -INFINITY; if (cb + 16 + i >= nval) s1[i] = -INFINITY; }
                float mx = fmaxf(fmaxf(fmaxf(s0[0], s0[1]), fmaxf(s0[2], s0[3])), fmaxf(fmaxf(s1[0], s1[1]), fmaxf(s1[2], s1[3])));
                mx = fmaxf(mx, __shfl_xor(mx, 16)); mx = fmaxf(mx, __shfl_xor(mx, 32));
                const float mn = fmaxf(m[h], mx); const float ms = (mn == -INFINITY) ? 0.f : mn;
                float sum = 0.f;
#pragma unroll
                for (int i = 0; i < 4; ++i) sum += __builtin_amdgcn_exp2f(s0[i] - ms) + __builtin_amdgcn_exp2f(s1[i] - ms);
                l[h] = l[h] * __builtin_amdgcn_exp2f(m[h] - ms) + sum; m[h] = mn;
            }
        }
        float il[4];
#pragma unroll
        for (int h = 0; h < 4; ++h) { const float lt = grp_sum(l[h]); il[h] = lt > 0.f ? 1.f / lt : 0.f; if (m[h] == -INFINITY) m[h] = 0.f; attw_init(st[h]); }
        for (int s = 0; s < nsteps; ++s) {
            bf16x8 kf[2][2], vf[4];
#pragma unroll
            for (int tl = 0; tl < 2; ++tl)
#pragma unroll
                for (int ks = 0; ks < 2; ++ks) kf[tl][ks] = *(const bf16x8*)(CKF + kfrag_off(2 * s + tl, ks, lane));
#pragma unroll
            for (int dt = 0; dt < 4; ++dt) vf[dt] = *(const bf16x8*)(CVF + vfrag_off(s, dt, lane));
            const int cb = 32 * s + 4 * grp;
            float i4[4] = {0.f, 0.f, 0.f, 0.f};
#pragma unroll
            for (int h = 0; h < 4; ++h) {
                f32x4 s0, s1; qk_step(kf, qf[h], s0, s1);
                f32x4 p0, p1;
#pragma unroll
                for (int i = 0; i < 4; ++i) {
                    p0[i] = (cb + i < nval) ? __builtin_amdgcn_exp2f(s0[i] - m[h]) * il[h] : 0.f;
                    p1[i] = (cb + 16 + i < nval) ? __builtin_amdgcn_exp2f(s1[i] - m[h]) * il[h] : 0.f; }
                i4[0] += p0[0] + p0[1]; i4[1] += p0[2] + p0[3]; i4[2] += p1[0] + p1[1]; i4[3] += p1[2] + p1[3];
                const bf16x8 pf = pack_p(p0, p1);
#pragma unroll
                for (int dt = 0; dt < 4; ++dt) st[h].o[dt] = MFMA16(vf[dt], pf, st[h].o[dt]);
            }
            *(float2*)(imp + qi * 256 + 16 * s + 2 * grp) = make_float2(i4[0], i4[1]);
            *(float2*)(imp + qi * 256 + 16 * s + 8 + 2 * grp) = make_float2(i4[2], i4[3]);
        }
        wave_lds_sync();
    }
    const int cur = t0 >> 6;
    {
        if (cur + 1 <= 16) {
            for (int idx = lane; idx < 256; idx += 64) sel[idx] = ((idx & 15) <= cur) ? (idx & 15) : -1;
        } else {
            for (int q0 = 0; q0 < 16; q0 += 4) {
                unsigned key[4][4];
#pragma unroll
                for (int qq = 0; qq < 4; ++qq)
#pragma unroll
                    for (int j = 0; j < 4; ++j) { const int blk = lane + 64 * j; const float v = imp[(q0 + qq) * 256 + blk];
                        key[qq][j] = (blk >= 1 && blk <= cur - 2) ? ((__float_as_uint(v) & 0xFFFFFF00u) | (unsigned)(255 - blk)) : 0u; }
                if (lane < 4) { sel[(q0 + lane) * 16 + 0] = 0; sel[(q0 + lane) * 16 + 1] = cur; sel[(q0 + lane) * 16 + 2] = cur - 1; }
                for (int n = 3; n < 16; ++n) {
                    unsigned best[4];
#pragma unroll
                    for (int qq = 0; qq < 4; ++qq) best[qq] = max(max(key[qq][0], key[qq][1]), max(key[qq][2], key[qq][3]));
#pragma unroll
                    for (int o = 1; o < 64; o <<= 1) {
#pragma unroll
                        for (int qq = 0; qq < 4; ++qq) best[qq] = max(best[qq], (unsigned)__shfl_xor((int)best[qq], o));
                    }
#pragma unroll
                    for (int qq = 0; qq < 4; ++qq) {
                        const int blk = 255 - (int)(best[qq] & 255u);
#pragma unroll
                        for (int j = 0; j < 4; ++j) if (lane + 64 * j == blk) key[qq][j] = 0u;
                        if (lane == 0) sel[(q0 + qq) * 16 + n] = blk;
                    }
                }
            }
        }
        wave_lds_sync();
    }
    float* acc = wl;
    {
#pragma unroll
        for (int h = 0; h < 4; ++h) { const float gs = sigmoidf_(grow[h]);
#pragma unroll
            for (int dt = 0; dt < 4; ++dt) *(f32x4*)(acc + (qi * 4 + h) * 64 + 16 * dt + 4 * grp) = st[h].o[dt] * gs; }
        wave_lds_sync();
    }
    {
        const bf16* KF = p.KWF + (size_t)g * T * 64; const bf16* VF = p.VWF + (size_t)g * T * 64;
        int kstart = t0 - 512; if (kstart < 0) kstart = 0; kstart &= ~31;
        const int nsteps = (t0 + 16 - kstart + 31) >> 5;
#pragma unroll
        for (int h = 0; h < 4; ++h) attw_init(st[h]);
        auto issue = [&](int s_, bf16x8 (&K)[2][2], bf16x8 (&V)[4]) {
            const int k0 = kstart + 32 * s_;
#pragma unroll
            for (int tl = 0; tl < 2; ++tl)
#pragma unroll
                for (int ks = 0; ks < 2; ++ks) K[tl][ks] = *(const bf16x8*)(KF + kfrag_off((k0 >> 4) + tl, ks, lane));
#pragma unroll
            for (int dt = 0; dt < 4; ++dt) V[dt] = *(const bf16x8*)(VF + vfrag_off(k0 >> 5, dt, lane));
        };
        auto compute = [&](int s_, const bf16x8 (&K)[2][2], const bf16x8 (&V)[4]) {
            const int k0 = kstart + 32 * s_;
            const bool need_mask = (k0 + 31 > t0) || (k0 < t0 + 15 - 512);
            const int pb = k0 + 4 * grp;
#pragma unroll
            for (int h = 0; h < 4; ++h) {
                f32x4 s0, s1; qk_step(K, qf[h], s0, s1);
                if (need_mask) {
#pragma unroll
                    for (int i = 0; i < 4; ++i) { const int p0 = pb + i, p1 = pb + 16 + i;
                        if (p0 > t || p0 < t - 512) s0[i] = -INFINITY; if (p1 > t || p1 < t - 512) s1[i] = -INFINITY; }
                }
                att_update(st[h], s0, s1, V);
            }
        };
        bf16x8 kA[2][2], vA[4], kB[2][2], vB[4];
        issue(0, kA, vA);
        for (int s = 0; s < nsteps; s += 2) {
            if (s + 1 < nsteps) issue(s + 1, kB, vB);
            compute(s, kA, vA);
            if (s + 1 < nsteps) { if (s + 2 < nsteps) issue(s + 2, kA, vA); compute(s + 1, kB, vB); }
        }
#pragma unroll
        for (int h = 0; h < 4; ++h) { const float lt = grp_sum(st[h].l); const float gs = sigmoidf_(grow[16 + h]) * (lt > 0.f ? 1.f / lt : 0.f);
#pragma unroll
            for (int dt = 0; dt < 4; ++dt) { f32x4* a = (f32x4*)(acc + (qi * 4 + h) * 64 + 16 * dt + 4 * grp); *a = *a + st[h].o[dt] * gs; } }
        wave_lds_sync();
    }
    *(int4*)(p.SEL + ((size_t)g * T + t0) * 16 + lane * 4) = *(const int4*)(sel + lane * 4);
#pragma unroll 4
    for (int q = 0; q < 16; ++q) *(f32x4*)(p.NSACC + (size_t)(t0 + q) * 512 + g * 256 + 4 * lane) = *(const f32x4*)(acc + q * 256 + 4 * lane);
    wave_lds_sync();
}

__device__ __forceinline__ void nsa_slc_item(const KP& p, int tq, int g, int lane) {
    asm volatile("" : "+v"(lane));
    const int l15 = lane & 15, grp = lane >> 4, hn = lane & 3;
    const bf16* KF = p.KSF + (size_t)g * T * 64; const bf16* VF = p.VSF + (size_t)g * T * 64;
    const int* selp = p.SEL + ((size_t)g * T + tq) * 16;
    int sb[16];
#pragma unroll
    for (int i = 0; i < 16; ++i) sb[i] = __builtin_amdgcn_readfirstlane(selp[i]);
    bf16x8 qs[2];
#pragma unroll
    for (int ks = 0; ks < 2; ++ks) qs[ks] = *(const bf16x8*)(p.QB + (size_t)tq * 512 + (g * 4 + hn) * 64 + 32 * ks + 8 * grp);
    AttW a; attw_init(a);
    bf16x8 kf[2][2][2], vf[2][4];
    auto issue = [&](int i, int buf) {
        const int blk = sb[i >> 1]; int k0 = blk * 64 + 32 * (i & 1); if (blk < 0 || k0 > tq) k0 = 0;
#pragma unroll
        for (int tl = 0; tl < 2; ++tl)
#pragma unroll
            for (int ks = 0; ks < 2; ++ks) kf[buf][tl][ks] = *(const bf16x8*)(KF + kfrag_off((k0 >> 4) + tl, ks, lane));
#pragma unroll
        for (int dt = 0; dt < 4; ++dt) vf[buf][dt] = *(const bf16x8*)(VF + vfrag_off(k0 >> 5, dt, lane));
    };
    issue(0, 0);
#pragma unroll
    for (int i = 0; i < 32; ++i) {
        const int buf = i & 1;
        if (i + 1 < 32) issue(i + 1, buf ^ 1);
        const int blk = sb[i >> 1]; const int k0 = blk * 64 + 32 * (i & 1);
        const bool dead = (blk < 0) || (k0 > tq);
        f32x4 s0, s1; qk_step(kf[buf], qs, s0, s1);
        const int pb = k0 + 4 * grp;
#pragma unroll
        for (int j = 0; j < 4; ++j) { if (dead || pb + j > tq) s0[j] = -INFINITY; if (dead || pb + 16 + j > tq) s1[j] = -INFINITY; }
        att_update(a, s0, s1, vf[buf]);
    }
    const float lt = grp_sum(a.l);
    if (l15 < 4) {
        const float gs = sigmoidf_(p.BIGF[(size_t)tq * PA + C_GATE + 8 + g * 4 + l15]) * (lt > 0.f ? 1.f / lt : 0.f);
#pragma unroll
        for (int dt = 0; dt < 4; ++dt) {
            const size_t o = (size_t)tq * 512 + g * 256 + l15 * 64 + 16 * dt + 4 * grp;
            const f32x4 base = *(const f32x4*)(p.NSACC + o); const f32x4 v = base + a.o[dt] * gs;
            uint2 w; w.x = pk2(v[0], v[1]); w.y = pk2(v[2], v[3]);
            *(uint2*)(p.MIXB + (size_t)tq * 1024 + g * 256 + l15 * 64 + 16 * dt + 4 * grp) = w;
        }
    }
}

__device__ __forceinline__ void ph_compress(const KP& p, const Fr& F) {
    float* flat = (float*)F.lds;
    float* hid = (float*)(F.lds + 32768);
    float* res = (float*)(F.lds + 32768 + 2048);
    const float* H0 = p.BIGF;
    const int tid = F.tid;
    for (int item = F.bid; item < 512; item += F.G) {
        const int c = item & 511, s = item >> 9;
        for (int e = tid; e < 8192; e += NTHR) {
            const int kv = e >> 12, g = (e >> 11) & 1, k = e & 2047, i = k >> 6, d = k & 63;
            const int row = c * 32 + i;
            float v;
            if (s == 0) v = H0[(size_t)row * PA + C_KC + kv * 128 + g * 64 + d];
            else { const int b = s - 1; const int page = p.page_table[b * NPAGES + (row >> 7)];
                   v = p.cache_cmp[((((size_t)page * 128 + (row & 127)) * 2 + kv) * 2 + g) * 64 + d]; }
            flat[e] = v + p.cpe[(kv * 32 + i) * 64 + d];
        }
        __syncthreads();
        {
            const int kv = tid >> 8, g = (tid >> 7) & 1, j = tid & 127;
            const float* w = p.cw1 + (size_t)kv * 2048 * 128 + j;
            const float* fl = flat + (kv * 2 + g) * 2048;
            float acc = p.cb1[kv * 128 + j];
            for (int k = 0; k < 2048; ++k) acc += fl[k] * w[(size_t)k * 128];
            hid[(kv * 2 + g) * 128 + j] = gelu_tanh(acc);
        }
        __syncthreads();
        if (tid < 256) {
            const int kv = tid >> 7, g = (tid >> 6) & 1, d = tid & 63;
            const float* w = p.cw2 + (size_t)kv * 128 * 64 + d;
            const float* hh = hid + (kv * 2 + g) * 128;
            float acc = 0.f;
            for (int j = 0; j < 128; ++j) acc += hh[j] * w[j * 64];
            res[(kv * 2 + g) * 64 + d] = acc;
        }
        __syncthreads();
        if (tid < 256) {
            const int kv = tid >> 7, g = (tid >> 6) & 1, d = tid & 63;
            const float* rr = res + (kv * 2 + g) * 64;
            float v = rr[d];
            if (kv == 0) {
                const int pos = (c + 1) * 32 - 1; const float2 cs = p.ROPE[pos * 32 + (d & 31)];
                const float x1 = rr[d & 31], x2 = rr[(d & 31) + 32];
                v = (d < 32) ? (x1 * cs.x - x2 * cs.y) : (x2 * cs.x + x1 * cs.y);
                p.CK[(((size_t)s * 512 + c) * 2 + g) * 64 + d] = v;
                if (s == 0) p.CKF[(size_t)g * 512 * 64 + kfrag_elem(c, d)] = (bf16)f2bf(v);
            } else { p.CV[(((size_t)s * 512 + c) * 2 + g) * 64 + d] = v; if (s == 0) p.CVF[(size_t)g * 512 * 64 + vfrag_elem(c, d)] = (bf16)f2bf(v); }
        }
        __syncthreads();
    }
}

__device__ __forceinline__ void ph_gdn_prep(const KP& p, const Fr& F) {
    const float* H0 = p.BIGF; const int lane = F.lane;
    for (int item = T * 8 + F.gw; item < TS * 8; item += F.NGW) {
        const int r = item >> 3, h = item & 7;
        const bool smp = r >= T; const int b = r - T;
        float cv[3];
#pragma unroll
        for (int part = 0; part < 3; ++part) {
            const int ch = part * 512 + h * 64 + lane;
            float acc = 0.f;
#pragma unroll
            for (int j = 0; j < 4; ++j) {
                float u;
                if (!smp) { const int t = r + j - 3; u = (t >= 0) ? H0[(size_t)t * PA + C_GQKV + ch] : 0.f; }
                else { u = (j < 3) ? p.st_gconv[((size_t)b * 3 + j) * 1536 + ch] : H0[(size_t)r * PA + C_GQKV + ch]; }
                acc += p.gconv_w[j * 1536 + ch] * u;
            }
            cv[part] = siluf_(acc);
        }
        const float qn = wave_sum(cv[0] * cv[0]), kn = wave_sum(cv[1] * cv[1]);
        const size_t o = ((size_t)r * 8 + h) * 64 + lane;
        p.GQ[o] = cv[0] * rsqrtf(qn + NORM_EPS) * 0.125f;
        p.GK[o] = cv[1] * rsqrtf(kn + NORM_EPS);
        p.GV[o] = cv[2];
        if (lane == 0) {
            const float av = H0[(size_t)r * PA + C_A + h], bt = H0[(size_t)r * PA + C_BT + h];
            p.Gg[(size_t)r * 8 + h] = -expf(p.gA[h]) * softplusf_(av + p.gdt[h]);
            p.Gb[(size_t)r * 8 + h] = sigmoidf_(bt);
        }
    }
    const size_t gt = (size_t)F.bid * NTHR + F.tid, GT = (size_t)F.G * NTHR;
    for (size_t idx = gt; idx < (size_t)3 * 1536; idx += GT) {
        const int j = (int)(idx / 1536), ch = (int)(idx % 1536);
        p.out[O_GCONV_P + idx] = H0[(size_t)(T - 3 + j) * PA + C_GQKV + ch];
    }
    for (size_t idx = gt; idx < (size_t)NSMP * 3 * 1536; idx += GT) {
        const int b = (int)(idx / (3 * 1536)), j = (int)((idx / 1536) % 3), ch = (int)(idx % 1536);
        p.out[O_GCONV_S + idx] = (j < 2) ? p.st_gconv[((size_t)b * 3 + j + 1) * 1536 + ch] : H0[(size_t)(T + b) * PA + C_GQKV + ch];
    }
}

template <int NH, class KF>
__device__ __forceinline__ void wave_attend(const float* qs, float* sc, int scstride, int nkeys, KF kf, float (&outv)[NH], float (&den)[NH], int lane, float* mxout = nullptr) {
    float mx[NH];
#pragma unroll
    for (int h = 0; h < NH; ++h) mx[h] = -INFINITY;
    for (int j = lane; j < nkeys; j += 64) {
        const float *kp, *vp; const bool ok = kf(j, kp, vp);
        float s[NH];
#pragma unroll
        for (int h = 0; h < NH; ++h) s[h] = 0.f;
        if (ok) {
            for (int d4 = 0; d4 < 16; ++d4) {
                const float4 kvv = ((const float4*)kp)[d4];
#pragma unroll
                for (int h = 0; h < NH; ++h) { const float* q = qs + h * 64 + d4 * 4; s[h] += kvv.x * q[0] + kvv.y * q[1] + kvv.z * q[2] + kvv.w * q[3]; }
            }
        }
#pragma unroll
        for (int h = 0; h < NH; ++h) { const float v = ok ? s[h] * 0.125f : -INFINITY; sc[h * scstride + j] = v; mx[h] = fmaxf(mx[h], v); }
    }
#pragma unroll
    for (int h = 0; h < NH; ++h) { mx[h] = wave_max(mx[h]); if (!(mx[h] > -INFINITY)) mx[h] = 0.f; if (mxout) mxout[h] = mx[h]; }
    float sm[NH];
#pragma unroll
    for (int h = 0; h < NH; ++h) sm[h] = 0.f;
    for (int j = lane; j < nkeys; j += 64) {
#pragma unroll
        for (int h = 0; h < NH; ++h) { const float v = sc[h * scstride + j]; const float pp = (v == -INFINITY) ? 0.f : expf(v - mx[h]); sc[h * scstride + j] = pp; sm[h] += pp; }
    }
#pragma unroll
    for (int h = 0; h < NH; ++h) { sm[h] = wave_sum(sm[h]); den[h] = sm[h] > 0.f ? sm[h] : 1.f; }
    wave_lds_sync();
    {
        const int kq = lane >> 4, d4 = lane & 15;
        float4 acc[NH];
#pragma unroll
        for (int h = 0; h < NH; ++h) acc[h] = make_float4(0.f, 0.f, 0.f, 0.f);
        for (int j0 = 0; j0 < nkeys; j0 += 32) {
            float4 v[8];
#pragma unroll
            for (int u = 0; u < 8; ++u) { const int j = j0 + 4 * u + kq; const float *kp, *vp; const bool ok = (j < nkeys) && kf(j, kp, vp);
                v[u] = ok ? *(const float4*)(vp + 4 * d4) : make_float4(0.f, 0.f, 0.f, 0.f); }
#pragma unroll
            for (int u = 0; u < 8; ++u) { const int j = j0 + 4 * u + kq;
#pragma unroll
                for (int h = 0; h < NH; ++h) { const float pp = (j < nkeys) ? sc[h * scstride + j] : 0.f;
                    acc[h].x += pp * v[u].x; acc[h].y += pp * v[u].y; acc[h].z += pp * v[u].z; acc[h].w += pp * v[u].w; } }
        }
#pragma unroll
        for (int h = 0; h < NH; ++h) {
            float4 a = acc[h];
            a.x += __shfl_xor(a.x, 16); a.y += __shfl_xor(a.y, 16); a.z += __shfl_xor(a.z, 16); a.w += __shfl_xor(a.w, 16);
            a.x += __shfl_xor(a.x, 32); a.y += __shfl_xor(a.y, 32); a.z += __shfl_xor(a.z, 32); a.w += __shfl_xor(a.w, 32);
            const float x0 = __shfl(a.x, lane >> 2), x1 = __shfl(a.y, lane >> 2), x2 = __shfl(a.z, lane >> 2), x3 = __shfl(a.w, lane >> 2);
            const int cc = lane & 3; outv[h] = cc == 0 ? x0 : (cc == 1 ? x1 : (cc == 2 ? x2 : x3));
        }
    }
#pragma unroll
    for (int h = 0; h < NH; ++h) outv[h] /= den[h];
    wave_lds_sync();
}

__device__ __forceinline__ void nsa_smp_cs(const KP& p, int b, int g, float* wl, int lane) {
    float* qs = wl; float* sc = wl + 256; float* imp = wl + 256 + 4 * 1088; int* sel = (int*)(wl + 256 + 4 * 1088 + 320); long long* bb = (long long*)(wl + 256 + 4 * 1088 + 320 + 16);
    const int r = T + b; const int qpos = T;
    const float* grow = p.BIGF + (size_t)r * PA + C_GATE;
#pragma unroll
    for (int h = 0; h < 4; ++h) qs[h * 64 + lane] = p.QR[(size_t)r * 512 + (g * 4 + h) * 64 + lane];
    wave_lds_sync();
    float ocmp[4], oslc[4], den[4];
    {
        const float* CKp = p.CK + (size_t)(1 + b) * 512 * 128; const float* CVp = p.CV + (size_t)(1 + b) * 512 * 128;
        auto kf = [&](int j, const float*& kp, const float*& vp) -> bool { kp = CKp + (j * 2 + g) * 64; vp = CVp + (j * 2 + g) * 64; return true; };
        wave_attend<4>(qs, sc, 1088, 512, kf, ocmp, den, lane);
        for (int blk = lane; blk < 320; blk += 64) {
            float v = 0.f;
            if (blk < 256) {
#pragma unroll
                for (int h = 0; h < 4; ++h) v += (sc[h * 1088 + 2 * blk] + sc[h * 1088 + 2 * blk + 1]) / den[h];
            }
            imp[blk] = v;
        }
        wave_lds_sync();
    }
    {
        const int cur = qpos >> 6;
        float val[5];
#pragma unroll
        for (int j = 0; j < 5; ++j) { const int blk = lane + 64 * j; val[j] = (blk >= 1 && blk <= cur - 2) ? imp[blk] : -1.f; }
        if (lane == 0) { sel[0] = 0; sel[1] = cur; sel[2] = cur - 1; }
        for (int n = 3; n < 16; ++n) {
            float bv = -2.f; int bi = 0x7fffffff;
#pragma unroll
            for (int j = 0; j < 5; ++j) if (val[j] > bv) { bv = val[j]; bi = lane + 64 * j; }
#pragma unroll
            for (int o = 1; o < 64; o <<= 1) { const float ov = __shfl_xor(bv, o); const int oi = __shfl_xor(bi, o); if (ov > bv || (ov == bv && oi < bi)) { bv = ov; bi = oi; } }
#pragma unroll
            for (int j = 0; j < 5; ++j) if (lane + 64 * j == bi) val[j] = -3.f;
            if (lane == 0) sel[n] = bi;
        }
        wave_lds_sync();
        if (lane < 16) { const int blk = sel[lane]; long long o = 0;
            if (blk < 256) { const int page = p.page_table[b * NPAGES + (blk >> 1)]; o = ((long long)page * 128 + (blk & 1) * 64) * 256; }
            bb[lane] = o; }
        wave_lds_sync();
    }
    {
        auto kf = [&](int j, const float*& kp, const float*& vp) -> bool {
            const int blk = sel[j >> 6]; const int pos = blk * 64 + (j & 63); if (pos > qpos) return false;
            if (pos == T) { kp = p.KS + (size_t)r * 128 + g * 64; vp = p.VS + (size_t)r * 128 + g * 64; return true; }
            const float* base = p.cache_slc + bb[j >> 6] + (j & 63) * 256;
            kp = base + g * 64; vp = base + 128 + g * 64; return true; };
        wave_attend<4>(qs, sc, 1088, 1024, kf, oslc, den, lane);
    }
#pragma unroll
    for (int h = 0; h < 4; ++h) {
        const int hh = g * 4 + h;
        p.SMIXF[((size_t)b * 3 + 0) * 512 + hh * 64 + lane] = sigmoidf_(grow[hh]) * ocmp[h];
        p.SMIXF[((size_t)b * 3 + 1) * 512 + hh * 64 + lane] = sigmoidf_(grow[8 + hh]) * oslc[h];
    }
    wave_lds_sync();
}
__device__ __forceinline__ void nsa_smp_win(const KP& p, int b, int g, float* wl, int lane) {
    float* qs = wl; float* sc = wl + 256;
    const int r = T + b;
    const float* grow = p.BIGF + (size_t)r * PA + C_GATE;
#pragma unroll
    for (int h = 0; h < 4; ++h) qs[h * 64 + lane] = p.QR[(size_t)r * 512 + (g * 4 + h) * 64 + lane];
    wave_lds_sync();
    float owin[4], den[4];
    auto kf = [&](int j, const float*& kp, const float*& vp) -> bool {
        if (j == 512) { kp = p.KW + (size_t)r * 128 + g * 64; vp = p.VW + (size_t)r * 128 + g * 64; return true; }
        const float* base = p.st_win + ((size_t)b * 512 + j) * 256;
        kp = base + g * 64; vp = base + 128 + g * 64; return true; };
    wave_attend<4>(qs, sc, 528, 513, kf, owin, den, lane);
#pragma unroll
    for (int h = 0; h < 4; ++h) { const int hh = g * 4 + h; p.SMIXF[((size_t)b * 3 + 2) * 512 + hh * 64 + lane] = sigmoidf_(grow[16 + hh]) * owin[h]; }
    wave_lds_sync();
}

__device__ __forceinline__ void gdn_scan_item(const KP& p, int item, float* wl, int lane) {
    asm volatile("" : "+v"(lane));
    float* kq = wl;
    const int b = (item >> 3) - 1, h = item & 7;
    const int r = T + b; const size_t o = ((size_t)r * 8 + h) * 64;
    kq[lane] = p.GK[o + lane]; kq[64 + lane] = p.GQ[o + lane];
    wave_lds_sync();
    const float dec = expf(p.Gg[(size_t)r * 8 + h]), bt = p.Gb[(size_t)r * 8 + h];
    const float* Sp = p.st_gS + ((size_t)b * 8 + h) * 4096 + lane;
    float* so = p.out + O_GS_S + ((size_t)b * 8 + h) * 4096 + lane;
    float S[64]; float kv = 0.f;
#pragma unroll
    for (int i = 0; i < 64; ++i) { S[i] = Sp[i * 64] * dec; kv += kq[i] * S[i]; }
    const float vn = (p.GV[o + lane] - kv) * bt;
    float ov = 0.f;
#pragma unroll
    for (int i = 0; i < 64; ++i) { const float sn = S[i] + kq[i] * vn; ov += kq[64 + i] * sn; so[i * 64] = sn; }
    p.OG[o + lane] = ov;
    wave_lds_sync();
}

constexpr int GDN_WL = 34816;
__device__ __forceinline__ int kperm(int ks, int grp, int j) { return 32 * ks + 16 * (j >> 2) + 4 * grp + (j & 3); }

__device__ __forceinline__ void gdn_chunk_unit(const KP& p, int unit, unsigned char* ldsb, int woff, int lane) {
    asm volatile("" : "+v"(lane), "+s"(woff));
    unsigned char* wlb = ldsb + woff;
    const int n = unit >> 3, h = unit & 7, t0 = 64 * n;
    const int l15 = lane & 15, grp = lane >> 4;
    float* Af = (float*)wlb; bf16* kt = (bf16*)(wlb + 16384); bf16* qt = kt + 64 * 72; bf16* tmp = (bf16*)wlb;
    {
        const float* H0 = p.BIGF;
        float w[3][4], u1[3], u2[3], u3[3];
#pragma unroll
        for (int part = 0; part < 3; ++part) {
            const int ch = part * 512 + h * 64 + lane;
#pragma unroll
            for (int j = 0; j < 4; ++j) w[part][j] = p.gconv_w[j * 1536 + ch];
            u1[part] = (t0 >= 1) ? H0[(size_t)(t0 - 1) * PA + C_GQKV + ch] : 0.f;
            u2[part] = (t0 >= 2) ? H0[(size_t)(t0 - 2) * PA + C_GQKV + ch] : 0.f;
            u3[part] = (t0 >= 3) ? H0[(size_t)(t0 - 3) * PA + C_GQKV + ch] : 0.f;
        }
        int roff = 0;
#pragma unroll 4
        for (int i = 0; i < 64; ++i) {
            float cv[3];
#pragma unroll
            for (int part = 0; part < 3; ++part) {
                const float u0 = H0[(size_t)t0 * PA + C_GQKV + part * 512 + h * 64 + lane + roff];
                cv[part] = siluf_(w[part][0] * u3[part] + w[part][1] * u2[part] + w[part][2] * u1[part] + w[part][3] * u0);
                u3[part] = u2[part]; u2[part] = u1[part]; u1[part] = u0;
            }
            roff += PA; asm volatile("" : "+s"(roff));
            const float qn = wave_sum(cv[0] * cv[0]), kn = wave_sum(cv[1] * cv[1]);
            qt[i * 72 + lane] = (bf16)f2bf(cv[0] * rsqrtf(qn + NORM_EPS) * 0.125f);
            kt[i * 72 + lane] = (bf16)f2bf(cv[1] * rsqrtf(kn + NORM_EPS));
            p.GV[((size_t)(t0 + i) * 8 + h) * 64 + lane] = cv[2];
        }
    }
    const float gl_ = -fexp_(p.gA[h]) * softplusf_(p.BIGF[(size_t)(t0 + lane) * PA + C_A + h] + p.gdt[h]);
    const float beta = sigmoidf_(p.BIGF[(size_t)(t0 + lane) * PA + C_BT + h]);
    float gc = gl_;
#pragma unroll
    for (int o = 1; o < 64; o <<= 1) { const float tv = __shfl_up(gc, o); if (lane >= o) gc += tv; }
    const float gclast = __shfl(gc, 63);
#define GPAD(i) ((float*)(kt + (i) * 72 + 64))
    { float* pd = GPAD(lane); pd[0] = gc; pd[1] = beta; pd[2] = fexp_(gc); pd[3] = fexp_(gclast - gc); }
    wave_lds_sync();
    bf16* QKF = p.G_QKF + (size_t)unit * 4096;
#pragma unroll
    for (int it = 0; it < 4; ++it) {
        const int i = 16 * it + l15;
        const float gci = GPAD(i)[0], bi = GPAD(i)[1];
        bf16x8 bk[2], bq[2];
#pragma unroll
        for (int ks = 0; ks < 2; ++ks) { bk[ks] = *(const bf16x8*)(kt + i * 72 + 32 * ks + 8 * grp); bq[ks] = *(const bf16x8*)(qt + i * 72 + 32 * ks + 8 * grp); }
#pragma unroll
        for (int jt = 0; jt < 4; ++jt) {
            uint2 qkp = make_uint2(0u, 0u);
            if (jt <= it) {
                bf16x8 ak[2];
#pragma unroll
                for (int ks = 0; ks < 2; ++ks) ak[ks] = *(const bf16x8*)(kt + (16 * jt + l15) * 72 + 32 * ks + 8 * grp);
                f32x4 aa = {0.f, 0.f, 0.f, 0.f}, aq = {0.f, 0.f, 0.f, 0.f};
                aa = MFMA16(ak[0], bk[0], aa); aa = MFMA16(ak[1], bk[1], aa);
                aq = MFMA16(ak[0], bq[0], aq); aq = MFMA16(ak[1], bq[1], aq);
                f32x4 av, qv;
#pragma unroll
                for (int r = 0; r < 4; ++r) {
                    const int j = 16 * jt + 4 * grp + r; const float gcj = GPAD(j)[0];
                    const float e = (j <= i) ? fexp_(gci - gcj) : 0.f;
                    av[r] = (j < i) ? bi * aa[r] * e : 0.f; qv[r] = aq[r] * e;
                }
                *(f32x4*)(Af + i * 64 + 16 * jt + 4 * grp) = av;
                qkp.x = pk2(qv[0], qv[1]); qkp.y = pk2(qv[2], qv[3]);
            }
            *(uint2*)(QKF + ((size_t)(it * 2 + (jt >> 1)) * 64 + lane) * 8 + (jt & 1) * 4) = qkp;
        }
    }
    wave_lds_sync();
    {
        float* UF = p.G_UF + (size_t)unit * 4096;
        const int vq = lane >> 4;
#pragma unroll
        for (int pass = 0; pass < 2; ++pass) {
            float x[64];
            int goff = 0;
#pragma unroll
            for (int i = 0; i < 64; ++i) {
                const float bi = GPAD(i)[1];
                float acc;
                if (pass == 0) { acc = p.GV[((size_t)t0 * 8 + h) * 64 + lane + goff] * bi; goff += 512; asm volatile("" : "+s"(goff)); }
                else { const float ei = GPAD(i)[2];
                       acc = __uint_as_float((unsigned)kt[i * 72 + lane] << 16) * bi * ei; }
#pragma unroll
                for (int jj = 0; jj < (i + 3) / 4; ++jj) {
                    const float4 a4 = *(const float4*)(Af + i * 64 + 4 * jj);
                    acc -= a4.x * x[4 * jj + 0];
                    if (4 * jj + 1 < i) acc -= a4.y * x[4 * jj + 1];
                    if (4 * jj + 2 < i) acc -= a4.z * x[4 * jj + 2];
                    if (4 * jj + 3 < i) acc -= a4.w * x[4 * jj + 3];
                }
                x[i] = acc;
                if ((i & 3) == 3) asm volatile("" ::: "memory");
            }
            if (pass == 0) {
#pragma unroll
                for (int c4 = 0; c4 < 16; ++c4) {
                    const int mt = c4 >> 2, lp = l15 + 16 * (c4 & 3);
                    *(f32x4*)(UF + ((size_t)(vq * 4 + mt) * 64 + lp) * 4) = (f32x4){x[4 * c4], x[4 * c4 + 1], x[4 * c4 + 2], x[4 * c4 + 3]};
                }
            } else {
                wave_lds_sync();
#pragma unroll
                for (int c = 0; c < 64; ++c) tmp[c * 72 + lane] = (bf16)f2bf(-x[c]);
            }
            asm volatile("" ::: "memory");
        }
    }
    wave_lds_sync();
    {
        bf16* WF = p.G_WF + (size_t)unit * 4096; bf16* QGF = p.G_QGF + (size_t)unit * 4096; bf16* KDF = p.G_KDF + (size_t)unit * 4096;
#pragma unroll
        for (int mt = 0; mt < 4; ++mt) {
            const float egc = GPAD(16 * mt + l15)[2];
#pragma unroll
            for (int ks = 0; ks < 2; ++ks) {
                const int c = 16 * mt + l15, k0 = 32 * ks + 4 * grp;
                const uint2 w0 = *(const uint2*)(tmp + c * 72 + k0), w1 = *(const uint2*)(tmp + c * 72 + k0 + 16);
                v4u wv; wv.x = w0.x; wv.y = w0.y; wv.z = w1.x; wv.w = w1.y;
                *(v4u*)(WF + ((size_t)(mt * 2 + ks) * 64 + lane) * 8) = wv;
                const uint2 q0 = *(const uint2*)(qt + c * 72 + k0), q1 = *(const uint2*)(qt + c * 72 + k0 + 16);
                v4u qv;
                qv.x = pk2(__uint_as_float(q0.x << 16) * egc, __uint_as_float(q0.x & 0xffff0000u) * egc); qv.y = pk2(__uint_as_float(q0.y << 16) * egc, __uint_as_float(q0.y & 0xffff0000u) * egc);
                qv.z = pk2(__uint_as_float(q1.x << 16) * egc, __uint_as_float(q1.x & 0xffff0000u) * egc); qv.w = pk2(__uint_as_float(q1.y << 16) * egc, __uint_as_float(q1.y & 0xffff0000u) * egc);
                *(v4u*)(QGF + ((size_t)(mt * 2 + ks) * 64 + lane) * 8) = qv;
                float kd[8];
#pragma unroll
                for (int j = 0; j < 8; ++j) { const int cc = kperm(ks, grp, j); kd[j] = __uint_as_float((unsigned)kt[cc * 72 + 16 * mt + l15] << 16) * GPAD(cc)[3]; }
                v4u kv; kv.x = pk2(kd[0], kd[1]); kv.y = pk2(kd[2], kd[3]); kv.z = pk2(kd[4], kd[5]); kv.w = pk2(kd[6], kd[7]);
                *(v4u*)(KDF + ((size_t)(mt * 2 + ks) * 64 + lane) * 8) = kv;
            }
        }
        if (lane == 0) p.G_GL[unit] = fexp_(gclast);
    }
    wave_lds_sync();
#undef GPAD
}

constexpr int CH_SLOT = 32768;
__device__ __forceinline__ void gdn_chain_wg(const KP& p, int h, int wave, int lane, unsigned char* ldsb) {
    asm volatile("" : "+v"(lane));
    const int l15 = lane & 15, grp = lane >> 4;
    float* GLs = (float*)(ldsb + 4 * CH_SLOT);
    if (wave < 4) GLs[wave * 64 + lane] = p.G_GL[(size_t)(wave * 64 + lane) * 8 + h];
#define CH_BAR() do { asm volatile("s_waitcnt lgkmcnt(0)" ::: "memory"); __builtin_amdgcn_s_barrier(); asm volatile("" ::: "memory"); } while (0)
    if (wave >= 4) {
        const int lw = wave - 4;
        const unsigned char* gb = (lw == 0) ? (const unsigned char*)p.G_WF : (lw == 1) ? (const unsigned char*)p.G_KDF : (const unsigned char*)p.G_UF + (size_t)(lw - 2) * 8192;
        const size_t ustride = (lw < 2) ? 8192 : 16384;
        gb += (size_t)h * ustride + (size_t)lane * 16;
        auto src = [&](int n, int k) -> const v4u* { return (const v4u*)(gb + (size_t)n * 8 * ustride + k * 1024); };
        v4u rs[4][8];
#pragma unroll
        for (int j = 0; j < 4; ++j)
#pragma unroll
            for (int k = 0; k < 8; ++k) rs[j][k] = *src(j, k);
#pragma unroll
        for (int j = 0; j < 2; ++j) {
#pragma unroll
            for (int k = 0; k < 8; ++k) { *(v4u*)(ldsb + j * CH_SLOT + (lw * 512 + k * 64 + lane) * 16) = rs[j][k]; rs[j][k] = *src(4 + j, k); }
        }
        CH_BAR();
        for (int n0 = 0; n0 < 256; n0 += 4) {
#pragma unroll
            for (int j = 0; j < 4; ++j) {
                const int n = n0 + j, st = n + 2;
                if (st < 256) {
                    const int set = (j + 2) & 3;
#pragma unroll
                    for (int k = 0; k < 8; ++k) { *(v4u*)(ldsb + (st & 3) * CH_SLOT + (lw * 512 + k * 64 + lane) * 16) = rs[set][k]; if (st + 4 < 256) rs[set][k] = *src(st + 4, k); }
                }
                CH_BAR();
            }
        }
#undef CH_BAR
        return;
    }
    const int vq = wave;
    f32x4 S[4];
#pragma unroll
    for (int i = 0; i < 4; ++i) S[i] = (f32x4){0.f, 0.f, 0.f, 0.f};
    asm volatile("s_waitcnt lgkmcnt(0)" ::: "memory"); __builtin_amdgcn_s_barrier(); asm volatile("" ::: "memory");
    for (int n = 0; n < 256; ++n) {
        const unsigned char* sl = ldsb + (n & 3) * CH_SLOT;
        bf16x8 wf[4][2], kdf[4][2]; f32x4 uf[4];
#pragma unroll
        for (int mt = 0; mt < 4; ++mt) {
#pragma unroll
            for (int ks = 0; ks < 2; ++ks) { wf[mt][ks] = *(const bf16x8*)(sl + ((mt * 2 + ks) * 64 + lane) * 16); kdf[mt][ks] = *(const bf16x8*)(sl + 8192 + ((mt * 2 + ks) * 64 + lane) * 16); }
            uf[mt] = *(const f32x4*)(sl + 16384 + ((vq * 4 + mt) * 64 + lane) * 16);
        }
        const float gl = GLs[n];
        const size_t fo = ((size_t)((n * 8 + h) * 4 + vq) * 2) * 512;
        bf16x8 sB[2];
#pragma unroll
        for (int ks = 0; ks < 2; ++ks) { sB[ks] = pack_p(S[2 * ks], S[2 * ks + 1]); *(bf16x8*)(p.G_SPF + fo + ((size_t)ks * 64 + lane) * 8) = sB[ks]; }
        f32x4 v[4];
#pragma unroll
        for (int mt = 0; mt < 4; ++mt) { v[mt] = uf[mt]; v[mt] = MFMA16(wf[mt][0], sB[0], v[mt]); v[mt] = MFMA16(wf[mt][1], sB[1], v[mt]); }
        bf16x8 vB[2];
#pragma unroll
        for (int ks = 0; ks < 2; ++ks) { vB[ks] = pack_p(v[2 * ks], v[2 * ks + 1]); *(bf16x8*)(p.G_VNF + fo + ((size_t)ks * 64 + lane) * 8) = vB[ks]; }
#pragma unroll
        for (int mt = 0; mt < 4; ++mt) { S[mt] = S[mt] * gl; S[mt] = MFMA16(kdf[mt][0], vB[0], S[mt]); S[mt] = MFMA16(kdf[mt][1], vB[1], S[mt]); }
        asm volatile("s_waitcnt lgkmcnt(0)" ::: "memory"); __builtin_amdgcn_s_barrier(); asm volatile("" ::: "memory");
    }
    float* so = p.out + O_GS_P + (size_t)h * 4096;
#pragma unroll
    for (int mt = 0; mt < 4; ++mt)
#pragma unroll
        for (int r = 0; r < 4; ++r) so[(16 * mt + 4 * grp + r) * 64 + 16 * vq + l15] = S[mt][r];
}

__device__ __forceinline__ void gdn_out_unit(const KP& p, int unit, int lane) {
    asm volatile("" : "+v"(lane));
    const int n = unit >> 3, h = unit & 7, t0 = 64 * n; const int l15 = lane & 15, grp = lane >> 4;
    const bf16* QGF = p.G_QGF + (size_t)unit * 4096; const bf16* QKF = p.G_QKF + (size_t)unit * 4096;
    f32x4 o[4][4];
#pragma unroll
    for (int mt = 0; mt < 4; ++mt)
#pragma unroll
        for (int vq = 0; vq < 4; ++vq) o[mt][vq] = (f32x4){0.f, 0.f, 0.f, 0.f};
#pragma unroll
    for (int ks = 0; ks < 2; ++ks) {
        bf16x8 sp[4], vn[4];
#pragma unroll
        for (int vq = 0; vq < 4; ++vq) { const size_t fo = ((size_t)(unit * 4 + vq) * 2 + ks) * 512 + (size_t)lane * 8; sp[vq] = *(const bf16x8*)(p.G_SPF + fo); vn[vq] = *(const bf16x8*)(p.G_VNF + fo); }
#pragma unroll
        for (int mt = 0; mt < 4; ++mt) {
            const bf16x8 qg = *(const bf16x8*)(QGF + ((size_t)(mt * 2 + ks) * 64 + lane) * 8), qk = *(const bf16x8*)(QKF + ((size_t)(mt * 2 + ks) * 64 + lane) * 8);
#pragma unroll
            for (int vq = 0; vq < 4; ++vq) { o[mt][vq] = MFMA16(qg, sp[vq], o[mt][vq]); o[mt][vq] = MFMA16(qk, vn[vq], o[mt][vq]); }
        }
    }
    float nw[4];
#pragma unroll
    for (int vq = 0; vq < 4; ++vq) nw[vq] = p.gnw[16 * vq + l15];
#pragma unroll
    for (int mt = 0; mt < 4; ++mt)
#pragma unroll
        for (int r = 0; r < 4; ++r) {
            float ss = 0.f;
#pragma unroll
            for (int vq = 0; vq < 4; ++vq) ss += o[mt][vq][r] * o[mt][vq][r];
            ss += __shfl_xor(ss, 1); ss += __shfl_xor(ss, 2); ss += __shfl_xor(ss, 4); ss += __shfl_xor(ss, 8);
            const float rs = rsqrtf(ss * (1.f / 64.f) + NORM_EPS);
            const int t = t0 + 16 * mt + 4 * grp + r;
            const float* zr = p.BIGF + (size_t)t * PA + C_Z + h * 64;
#pragma unroll
            for (int vq = 0; vq < 4; ++vq) p.MIXB[(size_t)t * 1024 + 512 + h * 64 + 16 * vq + l15] = (bf16)f2bf(o[mt][vq][r] * rs * nw[vq] * siluf_(zr[16 * vq + l15]));
        }
}

#define MFMA8(a, b, c) __builtin_amdgcn_mfma_f32_16x16x32_fp8_fp8((a), (b), (c), 0, 0, 0)
__device__ __forceinline__ long pack_fp8(const f32x4& a, const f32x4& b) {
    int w0 = 0, w1 = 0;
    w0 = __builtin_amdgcn_cvt_pk_fp8_f32(a[0], a[1], w0, false); w0 = __builtin_amdgcn_cvt_pk_fp8_f32(a[2], a[3], w0, true);
    w1 = __builtin_amdgcn_cvt_pk_fp8_f32(b[0], b[1], w1, false); w1 = __builtin_amdgcn_cvt_pk_fp8_f32(b[2], b[3], w1, true);
    return (long)(((unsigned long long)(unsigned)w1 << 32) | (unsigned long long)(unsigned)w0);
}
template <bool GEN>
__device__ __forceinline__ void nsa_slc_item8(const KP& p, int tq, int g, int lane) {
    asm volatile("" : "+v"(lane));
    const int l15 = lane & 15, grp = lane >> 4, hn = lane & 3;
    const unsigned char* KF = p.KS8 + (size_t)g * T * 64; const unsigned char* VF = p.VS8 + (size_t)g * T * 64;
    const int* selp = p.SEL + ((size_t)g * T + tq) * 16;
    int sb[16];
#pragma unroll
    for (int i = 0; i < 16; ++i) sb[i] = __builtin_amdgcn_readfirstlane(selp[i]);
    long qs[2];
#pragma unroll
    for (int ks = 0; ks < 2; ++ks) {
        const bf16x8 qb = *(const bf16x8*)(p.QB + (size_t)tq * 512 + (g * 4 + hn) * 64 + 32 * ks + 8 * grp);
        f32x4 a, b;
#pragma unroll
        for (int j = 0; j < 4; ++j) { a[j] = __uint_as_float((unsigned)(unsigned short)qb[j] << 16) * (1.f / QSCALE); b[j] = __uint_as_float((unsigned)(unsigned short)qb[4 + j] << 16) * (1.f / QSCALE); }
        qs[ks] = pack_fp8(a, b);
    }
    AttW a; attw_init(a);
    long kf[3][4][2], vf[3][2][4];
    auto issue = [&](int bi, int buf) {
        int blk = sb[bi]; if (GEN && (blk < 0 || blk * 64 > tq)) blk = 0;
        typedef long l2_t __attribute__((ext_vector_type(2)));
#pragma unroll
        for (int tl = 0; tl < 4; ++tl) { const l2_t x = *(const l2_t*)(KF + ((size_t)(blk * 4 + tl) * 64 + lane) * 16); kf[buf][tl][0] = x[0]; kf[buf][tl][1] = x[1]; }
#pragma unroll
        for (int dt = 0; dt < 4; ++dt) { const l2_t x = *(const l2_t*)(VF + ((size_t)(blk * 4 + dt) * 64 + lane) * 16); vf[buf][0][dt] = x[0]; vf[buf][1][dt] = x[1]; }
    };
    issue(0, 0); issue(1, 1);
#pragma unroll
    for (int bi = 0; bi < 16; ++bi) {
        const int buf = bi % 3;
        if (bi + 2 < 16) issue(bi + 2, (bi + 2) % 3);
        const int blk = sb[bi]; const int k0 = blk * 64;
        if (GEN && (blk < 0 || k0 > tq)) continue;
        const f32x4 z = {0.f, 0.f, 0.f, 0.f};
        f32x4 sc[4];
#pragma unroll
        for (int tl = 0; tl < 4; ++tl) { sc[tl] = MFMA8(kf[buf][tl][0], qs[0], z); sc[tl] = MFMA8(kf[buf][tl][1], qs[1], sc[tl]); }
        if (GEN ? (k0 + 63 > tq) : (bi == 1)) {
#pragma unroll
            for (int tl = 0; tl < 4; ++tl)
#pragma unroll
                for (int j = 0; j < 4; ++j) if (k0 + 16 * tl + 4 * grp + j > tq) sc[tl][j] = -INFINITY;
        }
        float mx = fmaxf(fmaxf(fmaxf(fmaxf(sc[0][0], sc[0][1]), fmaxf(sc[0][2], sc[0][3])), fmaxf(fmaxf(sc[1][0], sc[1][1]), fmaxf(sc[1][2], sc[1][3]))),
                         fmaxf(fmaxf(fmaxf(sc[2][0], sc[2][1]), fmaxf(sc[2][2], sc[2][3])), fmaxf(fmaxf(sc[3][0], sc[3][1]), fmaxf(sc[3][2], sc[3][3]))));
        mx = fmaxf(mx, __shfl_xor(mx, 16)); mx = fmaxf(mx, __shfl_xor(mx, 32));
        const float mn = fmaxf(a.m, mx * QSCALE);
        const float alpha = __builtin_amdgcn_exp2f(a.m - mn);
        const float mb = 7.f - mn;
        f32x4 pp[4]; float sum = 0.f;
#pragma unroll
        for (int tl = 0; tl < 4; ++tl) {
#pragma unroll
            for (int j = 0; j < 4; ++j) pp[tl][j] = __builtin_amdgcn_exp2f(fmaf(sc[tl][j], QSCALE, mb));
            sum += (pp[tl][0] + pp[tl][1]) + (pp[tl][2] + pp[tl][3]);
        }
        a.l = a.l * alpha + sum; a.m = mn;
        const long pf0 = pack_fp8(pp[0], pp[1]), pf1 = pack_fp8(pp[2], pp[3]);
#pragma unroll
        for (int dt = 0; dt < 4; ++dt) { a.o[dt] = a.o[dt] * alpha; a.o[dt] = MFMA8(vf[buf][0][dt], pf0, a.o[dt]); a.o[dt] = MFMA8(vf[buf][1][dt], pf1, a.o[dt]); }
    }
    const float lt = grp_sum(a.l);
    if (l15 < 4) {
        const float gs = sigmoidf_(p.BIGF[(size_t)tq * PA + C_GATE + 8 + g * 4 + l15]) * (lt > 0.f ? 1.f / lt : 0.f);
#pragma unroll
        for (int dt = 0; dt < 4; ++dt) {
            const size_t o = (size_t)tq * 512 + g * 256 + l15 * 64 + 16 * dt + 4 * grp;
            const f32x4 base = *(const f32x4*)(p.NSACC + o); const f32x4 v = base + a.o[dt] * gs;
            uint2 w; w.x = pk2(v[0], v[1]); w.y = pk2(v[2], v[3]);
            *(uint2*)(p.MIXB + (size_t)tq * 1024 + g * 256 + l15 * 64 + 16 * dt + 4 * grp) = w;
        }
    }
}

__device__ __forceinline__ void ph_gdn_chunks(const KP& p, const Fr& F) {
    if (F.wave < 4) for (int unit = F.bid * 4 + F.wave; unit < 2048; unit += F.G * 4) gdn_chunk_unit(p, unit, F.lds, F.wave * GDN_WL, F.lane);
    else { const int unit = F.bid * 4 + (F.wave - 4); if (unit < 128) cmp_prompt_unit(p, unit, F.lane); }
}
__device__ __forceinline__ void ph_mix_a(const KP& p, const Fr& F) {
    if (F.bid < 32) gdn_scan_item(p, (F.bid + 1) * 8 + F.wave, (float*)(F.lds + 8 * FAST_WL + 1024 + F.wave * 512), F.lane);
    float* wl = (float*)(F.lds + F.wave * FAST_WL);
    for (int unit = F.gw; unit < 2048; unit += F.NGW) nsa_fast_unit(p, unit, wl, F.lane);
}
__device__ __forceinline__ void ph_mix_b(const KP& p, const Fr& F) {
    if (F.bid < 8) { gdn_chain_wg(p, F.bid, F.wave, F.lane, F.lds); return; }
    if (F.bid < 24) {
        const int it = (F.bid - 8) * 4 + (F.wave & 3);
        if (F.wave < 4) nsa_smp_cs(p, it >> 1, it & 1, (float*)(F.lds + F.wave * 20480), F.lane);
        else nsa_smp_win(p, it >> 1, it & 1, (float*)(F.lds + 81920 + (F.wave - 4) * 12288), F.lane);
        return;
    }
    const int g = F.bid & 1, fr = (F.bid - 24) >> 1, NW = ((F.G - 24) >> 1) * 8;
    for (int tq = fr * 8 + F.wave; tq < T; tq += NW) { if (tq >= 1024) nsa_slc_item8<false>(p, tq, g, F.lane); else nsa_slc_item8<true>(p, tq, g, F.lane); }
}

__device__ __forceinline__ void ph_gdn_out(const KP& p, const Fr& F) {
    const float* H0 = p.BIGF; const int lane = F.lane;
    for (int unit = F.gw; unit < 2048; unit += F.NGW) gdn_out_unit(p, unit, lane);
    for (int idx = F.bid * NTHR + F.tid; idx < NSMP * 512; idx += F.G * NTHR) { const int b = idx >> 9, c = idx & 511; const float* sp = p.SMIXF + (size_t)b * 3 * 512 + c;
        p.MIXB[(size_t)(T + b) * 1024 + c] = (bf16)f2bf(sp[0] + sp[512] + sp[1024]); }
    for (int item = T * 8 + F.gw; item < TS * 8; item += F.NGW) {
        const int r = item >> 3, h = item & 7;
        const float o = p.OG[((size_t)r * 8 + h) * 64 + lane];
        const float ms = wave_sum(o * o) * (1.f / 64.f);
        const float z = H0[(size_t)r * PA + C_Z + h * 64 + lane];
        p.MIXB[(size_t)r * 1024 + 512 + h * 64 + lane] = (bf16)f2bf(o * rsqrtf(ms + NORM_EPS) * p.gnw[lane] * siluf_(z));
    }
}

__device__ __forceinline__ void ph_ln(const Fr& F, const float* Xp, const float* Xs, const float* Fm, const float* gam, const float* bet, float* outp, float* outs, bf16* ob) {
    const int lane = F.lane;
    for (int r = F.gw; r < TS; r += F.NGW) {
        const float4* xr = (const float4*)((r < T) ? Xp + (size_t)r * DM : Xs + (size_t)(r - T) * DM) + lane; const float4* fr = (const float4*)(Fm + (size_t)r * DM) + lane;
        f32x4 v[4]; float s = 0.f;
#pragma unroll
        for (int j = 0; j < 4; ++j) { const float4 x = xr[64 * j], f = fr[64 * j]; v[j] = (f32x4){DN_ALPHA * x.x + f.x, DN_ALPHA * x.y + f.y, DN_ALPHA * x.z + f.z, DN_ALPHA * x.w + f.w}; s += (v[j][0] + v[j][1]) + (v[j][2] + v[j][3]); }
        const float mean = wave_sum(s) * (1.f / DM); float q = 0.f;
#pragma unroll
        for (int j = 0; j < 4; ++j) { v[j] = v[j] - mean; q += (v[j][0] * v[j][0] + v[j][1] * v[j][1]) + (v[j][2] * v[j][2] + v[j][3] * v[j][3]); }
        const float rstd = rsqrtf(wave_sum(q) * (1.f / DM) + LN_EPS);
        float4* o = (float4*)((r < T) ? outp + (size_t)r * DM : outs + (size_t)(r - T) * DM) + lane;
#pragma unroll
        for (int j = 0; j < 4; ++j) { const float4 g4 = ((const float4*)gam)[lane + 64 * j], b4 = ((const float4*)bet)[lane + 64 * j];
            const float4 y = make_float4(v[j][0] * rstd * g4.x + b4.x, v[j][1] * rstd * g4.y + b4.y, v[j][2] * rstd * g4.z + b4.z, v[j][3] * rstd * g4.w + b4.w);
            o[64 * j] = y; if (ob) { uint2 w; w.x = pk2(y.x, y.y); w.y = pk2(y.z, y.w); *((uint2*)(ob + (size_t)r * DM) + lane + 64 * j) = w; } }
    }
}

__device__ __forceinline__ void ph_ffn_act(const KP& p, const Fr& F, int layer) {
    const float* U = p.BIGF; const float* cw = p.ffn_cw + (size_t)layer * 3 * DFF2; const float* cb = p.ffn_cb + (size_t)layer * DFF2;
    const size_t gt = (size_t)F.bid * NTHR + F.tid, GT = (size_t)F.G * NTHR;
    const size_t total = (size_t)TS * DFF;
    for (size_t idx = gt; idx < total; idx += GT) {
        const int r = (int)(idx / DFF), j = (int)(idx % DFF);
        const bool smp = r >= T; const int b = r - T;
        float c2[2];
#pragma unroll
        for (int half = 0; half < 2; ++half) {
            const int ch = half * DFF + j;
            float acc = cb[ch];
#pragma unroll
            for (int k = 0; k < 3; ++k) {
                float u;
                if (!smp) { const int t = r + k - 2; u = (t >= 0) ? U[(size_t)t * DFF2 + ch] : 0.f; }
                else u = (k < 2) ? p.st_ffn[(((size_t)b * 2 + layer) * 2 + k) * DFF2 + ch] : U[(size_t)r * DFF2 + ch];
                acc += cw[k * DFF2 + ch] * u;
            }
            c2[half] = acc;
        }
        p.HFFB[idx] = (bf16)f2bf(siluf_(c2[0]) * c2[1]);
    }
    for (size_t idx = gt; idx < (size_t)2 * DFF2; idx += GT) {
        const int k = (int)(idx / DFF2), ch = (int)(idx % DFF2);
        p.out[O_FFN_P + ((size_t)layer * 2 + k) * DFF2 + ch] = U[(size_t)(T - 2 + k) * DFF2 + ch];
    }
    for (size_t idx = gt; idx < (size_t)NSMP * 2 * DFF2; idx += GT) {
        const int b = (int)(idx / (2 * DFF2)), k = (int)((idx / DFF2) % 2), ch = (int)(idx % DFF2);
        p.out[O_FFN_S + (((size_t)b * 2 + layer) * 2 + k) * DFF2 + ch] =
            (k == 0) ? p.st_ffn[(((size_t)b * 2 + layer) * 2 + 1) * DFF2 + ch] : U[(size_t)(T + b) * DFF2 + ch];
    }
}

__device__ __forceinline__ void ph_dil_prep(const KP& p, const Fr& F) {
    const float* H1 = p.BIGF;
    const size_t gt = (size_t)F.bid * NTHR + F.tid, GT = (size_t)F.G * NTHR;
    const size_t total = (size_t)TS * 2048;
    for (size_t idx = gt + (size_t)T * 2048; idx < total; idx += GT) {
        const int r = (int)(idx >> 11), c = (int)(idx & 2047);
        const bool smp = r >= T; const int pos = smp ? T : r;
        const float* row = H1 + (size_t)r * 3072;
        const int i = c & 63; const float2 cs = p.ROPE[pos * 32 + (i & 31)];
        const float v = rope_val(row, c & ~63, i, cs);
        if (c < 1024) p.QD[(size_t)r * 1024 + c] = v; else p.KD[(size_t)r * 1024 + (c - 1024)] = v;
    }
}
__device__ __forceinline__ void ph_dil_cache(const KP& p, const Fr& F) {
    const float* H1 = p.BIGF;
    const size_t gt = (size_t)F.bid * NTHR + F.tid, GT = (size_t)F.G * NTHR;
    const size_t tots4 = (size_t)NSMP * 2048 * 512;
    for (size_t idx = gt; idx < tots4; idx += GT) {
        const int b = (int)(idx / (2048 * 512)); const int i = (int)((idx / 512) % 2048); const int c4 = (int)(idx % 512);
        float4 v;
        if (i < 2047) v = ((const float4*)p.st_dil)[((size_t)b * 2048 + i + 1) * 512 + c4];
        else { const int c = c4 * 4; const int r = T + b;
               v = (c < 1024) ? *(const float4*)(p.KD + (size_t)r * 1024 + c) : *(const float4*)(H1 + (size_t)r * 3072 + 2048 + (c - 1024)); }
        ((float4*)(p.out + O_DIL_S))[idx] = v;
    }
}
__device__ __forceinline__ void ph_dil_attn(const KP& p, const Fr& F) {
    const float* H1 = p.BIGF; const int lane = F.lane;
    float* qs = (float*)(F.lds + F.wave * 4096); float* sc = qs + 64;
    float* ex = (float*)(F.lds + 32768);
    const int il = F.wave / 3, gi = F.wave - 3 * il;
    const int item = F.bid * 2 + il; const int b = item >> 4, h = item & 15, r = T + b;
    if (F.wave < 6 && item < NSMP * 16) {
        qs[lane] = p.QD[(size_t)r * 1024 + h * 64 + lane];
        wave_lds_sync();
        const int dd = gi == 0 ? 1 : (gi == 1 ? 4 : 16);
        auto kf = [&](int j, const float*& kp, const float*& vp) -> bool {
            const int pos = T - j * dd;
            if (pos == T) { kp = p.KD + (size_t)r * 1024 + h * 64; vp = H1 + (size_t)r * 3072 + 2048 + h * 64; return true; }
            const float* base = p.st_dil + ((size_t)b * 2048 + (pos - (T - 2048))) * 2048;
            kp = base + h * 64; vp = base + 1024 + h * 64; return true; };
        float o[1], den[1], mx[1];
        wave_attend<1>(qs, sc, 448, 129, kf, o, den, lane, mx);
        float* e = ex + (il * 3 + gi) * 68;
        e[lane] = o[0] * den[0]; if (lane == 0) { e[64] = mx[0]; e[65] = den[0]; }
    }
    __syncthreads();
    if (F.wave < 6 && gi == 0 && item < NSMP * 16) {
        const float* e = ex + il * 3 * 68;
        const float m0 = e[64], m1 = e[68 + 64], m2 = e[136 + 64]; const float M = fmaxf(m0, fmaxf(m1, m2));
        const float w0 = expf(m0 - M), w1 = expf(m1 - M), w2 = expf(m2 - M);
        const float num = w0 * e[lane] + w1 * e[68 + lane] + w2 * e[136 + lane], dn = w0 * e[65] + w1 * e[68 + 65] + w2 * e[136 + 65];
        p.MIXB[(size_t)r * 1024 + h * 64 + lane] = (bf16)f2bf(num / dn);
    }
}

__device__ __forceinline__ void ph_dil_prep_fast(const KP& p, const Fr& F) {
    const float* H1 = p.BIGF;
    const size_t gt = (size_t)F.bid * NTHR + F.tid, GT = (size_t)F.G * NTHR;
    for (size_t idx = gt; idx < (size_t)T * 128; idx += GT) {
        const int t = (int)(idx >> 7), u = (int)(idx & 127);
        const int hq = u >> 2, d0 = (u & 3) * 8, c0 = hq * 64 + d0; const float* row = H1 + (size_t)t * 3072;
        const float4 a0 = *(const float4*)(row + c0), a1 = *(const float4*)(row + c0 + 4), b0 = *(const float4*)(row + c0 + 32), b1 = *(const float4*)(row + c0 + 36);
        const float4* rp = (const float4*)(p.ROPE + t * 32 + d0); const float4 r0 = rp[0], r1 = rp[1], r2 = rp[2], r3 = rp[3];
        const float x1[8] = {a0.x, a0.y, a0.z, a0.w, a1.x, a1.y, a1.z, a1.w}, x2[8] = {b0.x, b0.y, b0.z, b0.w, b1.x, b1.y, b1.z, b1.w};
        const float cs[8] = {r0.x, r0.z, r1.x, r1.z, r2.x, r2.z, r3.x, r3.z}, sn[8] = {r0.y, r0.w, r1.y, r1.w, r2.y, r2.w, r3.y, r3.w};
        float lo[8], hi[8];
#pragma unroll
        for (int j = 0; j < 8; ++j) { lo[j] = x1[j] * cs[j] - x2[j] * sn[j]; hi[j] = x2[j] * cs[j] + x1[j] * sn[j]; }
        if (hq < 16) {
            v4u o; o.x = pk2(lo[0] * QSCALE, lo[1] * QSCALE); o.y = pk2(lo[2] * QSCALE, lo[3] * QSCALE); o.z = pk2(lo[4] * QSCALE, lo[5] * QSCALE); o.w = pk2(lo[6] * QSCALE, lo[7] * QSCALE);
            *(v4u*)(p.QDB + (size_t)t * 1024 + c0) = o;
            o.x = pk2(hi[0] * QSCALE, hi[1] * QSCALE); o.y = pk2(hi[2] * QSCALE, hi[3] * QSCALE); o.z = pk2(hi[4] * QSCALE, hi[5] * QSCALE); o.w = pk2(hi[6] * QSCALE, hi[7] * QSCALE);
            *(v4u*)(p.QDB + (size_t)t * 1024 + c0 + 32) = o;
        } else {
            const int h = hq - 16, kc = h * 64 + d0;
            v4u ol, oh; ol.x = pk2(lo[0], lo[1]); ol.y = pk2(lo[2], lo[3]); ol.z = pk2(lo[4], lo[5]); ol.w = pk2(lo[6], lo[7]);
            oh.x = pk2(hi[0], hi[1]); oh.y = pk2(hi[2], hi[3]); oh.z = pk2(hi[4], hi[5]); oh.w = pk2(hi[6], hi[7]);
#pragma unroll
            for (int pass = 0; pass < 3; ++pass) { const int sh = 2 * pass; const int pi = (t & ((1 << sh) - 1)) * (T >> sh) + (t >> sh);
                bf16* kb = (pass == 0 ? p.DKF[0] : pass == 1 ? p.DKF[1] : p.DKF[2]) + (size_t)h * T * 64;
                *(v4u*)(kb + kfrag_elem(pi, d0)) = ol; *(v4u*)(kb + kfrag_elem(pi, d0 + 32)) = oh; }
            if (t >= T - 2048) { float* op = p.out + O_DIL_P + (size_t)(t - (T - 2048)) * 2048 + kc;
                *(float4*)op = make_float4(lo[0], lo[1], lo[2], lo[3]); *(float4*)(op + 4) = make_float4(lo[4], lo[5], lo[6], lo[7]);
                *(float4*)(op + 32) = make_float4(hi[0], hi[1], hi[2], hi[3]); *(float4*)(op + 36) = make_float4(hi[4], hi[5], hi[6], hi[7]); }
        }
    }
    for (size_t idx = gt; idx < (size_t)2048 * 256; idx += GT) {
        const int i = (int)(idx >> 8), c4 = (int)(idx & 255);
        *(float4*)(p.out + O_DIL_P + (size_t)i * 2048 + 1024 + c4 * 4) = *(const float4*)(H1 + (size_t)(T - 2048 + i) * 3072 + 2048 + c4 * 4);
    }
    const int lane = F.lane, l15 = lane & 15, grp = lane >> 4;
    for (int unit = F.gw; unit < 3 * 16 * 512; unit += F.NGW) {
        const int st = unit & 511, h = (unit >> 9) & 15, pass = unit >> 13; const int sh = 2 * pass, Td = T >> sh;
        const int pi0 = 32 * st, r = pi0 / Td, s0 = pi0 - r * Td;
        bf16* dst = p.DVF[pass] + (size_t)h * T * 64;
#pragma unroll
        for (int dt = 0; dt < 4; ++dt) {
            float v[8];
#pragma unroll
            for (int j = 0; j < 8; ++j) { const int s = s0 + 16 * (j >> 2) + 4 * grp + (j & 3); const int t = (s << sh) + r;
                v[j] = H1[(size_t)t * 3072 + 2048 + h * 64 + 16 * dt + l15]; }
            v4u o; o.x = pk2(v[0], v[1]); o.y = pk2(v[2], v[3]); o.z = pk2(v[4], v[5]); o.w = pk2(v[6], v[7]);
            *(v4u*)(dst + vfrag_off(st, dt, lane)) = o;
        }
    }
}

__device__ __forceinline__ void dil_pass(const KP& p, int unit, int pass, unsigned char* ldsb, int w4, int lane) {
    asm volatile("" : "+v"(lane));
    const int h = unit & 15, P0 = (unit >> 4) * 256;
    const int l15 = lane & 15, grp = lane >> 4;
    float* stO = (float*)ldsb; float* stML = stO + 256 * 64;
    {
        const int sh = 2 * pass, Td = T >> sh;
        const bf16* KF = (pass == 0 ? p.DKF[0] : pass == 1 ? p.DKF[1] : p.DKF[2]) + (size_t)h * T * 64;
        const bf16* VF = (pass == 0 ? p.DVF[0] : pass == 1 ? p.DVF[1] : p.DVF[2]) + (size_t)h * T * 64;
        for (int tt = 0; tt < 4; ++tt) {
            const int tl = 4 * w4 + tt;
            const int r = tl >> (4 - sh), s0 = (P0 >> sh) + 16 * (tl & ((16 >> sh) - 1));
            const int sq = s0 + l15, tq = (sq << sh) + r, tloc = tq - P0;
            bf16x8 qf[2];
#pragma unroll
            for (int ks = 0; ks < 2; ++ks) qf[ks] = *(const bf16x8*)(p.QDB + (size_t)tq * 1024 + h * 64 + 32 * ks + 8 * grp);
            AttW a;
            if (pass == 0) attw_init(a);
            else {
#pragma unroll
                for (int dt = 0; dt < 4; ++dt) a.o[dt] = *(const f32x4*)(stO + tloc * 64 + 16 * dt + 4 * grp);
                a.m = stML[tloc * 2]; a.l = (grp == 0) ? stML[tloc * 2 + 1] : 0.f;
            }
            int kstart = s0 - 128; if (kstart < 0) kstart = 0; kstart &= ~31;
            const int nsteps = (s0 + 16 - kstart + 31) >> 5;
            const int base = r * Td;
            bf16x8 kf[3][2][2], vf[3][4];
            auto issue = [&](int s, int buf) {
                const int k0 = kstart + 32 * s;
#pragma unroll
                for (int tl2 = 0; tl2 < 2; ++tl2)
#pragma unroll
                    for (int ks = 0; ks < 2; ++ks) kf[buf][tl2][ks] = *(const bf16x8*)(KF + kfrag_off(((base + k0) >> 4) + tl2, ks, lane));
#pragma unroll
                for (int dt = 0; dt < 4; ++dt) vf[buf][dt] = *(const bf16x8*)(VF + vfrag_off((base + k0) >> 5, dt, lane));
            };
            issue(0, 0); if (nsteps > 1) issue(1, 1);
#pragma unroll
            for (int s = 0; s < 5; ++s) {
                if (s < nsteps) {
                    if (s + 2 < nsteps) issue(s + 2, (s + 2) % 3);
                    const int k0 = kstart + 32 * s;
                    f32x4 s0v, s1v; qk_step(kf[s % 3], qf, s0v, s1v);
                    if ((k0 + 31 > s0) || (k0 < s0 + 15 - 128)) {
                        const int pb = k0 + 4 * grp;
#pragma unroll
                        for (int i = 0; i < 4; ++i) { const int p0 = pb + i, p1 = pb + 16 + i;
                            if (p0 > sq || p0 < sq - 128) s0v[i] = -INFINITY; if (p1 > sq || p1 < sq - 128) s1v[i] = -INFINITY; }
                    }
                    att_update(a, s0v, s1v, vf[s % 3]);
                }
            }
            const float lt = grp_sum(a.l);
            if (pass < 2) {
#pragma unroll
                for (int dt = 0; dt < 4; ++dt) *(f32x4*)(stO + tloc * 64 + 16 * dt + 4 * grp) = a.o[dt];
                if (grp == 0) { stML[tloc * 2] = a.m; stML[tloc * 2 + 1] = lt; }
            } else {
                const float il = lt > 0.f ? 1.f / lt : 0.f;
#pragma unroll
                for (int dt = 0; dt < 4; ++dt) { uint2 o; o.x = pk2(a.o[dt][0] * il, a.o[dt][1] * il); o.y = pk2(a.o[dt][2] * il, a.o[dt][3] * il);
                    *(uint2*)(p.MIXB + (size_t)tq * 1024 + h * 64 + 16 * dt + 4 * grp) = o; }
            }
        }
    }
}
__device__ __forceinline__ void ph_dil_combo(const KP& p, const Fr& F) {
    const float* H1 = p.BIGF; const int lane = F.lane;
    const int cw = F.bid * 4 + F.wave;
#pragma unroll 1
    for (int u = 0; u < 4; ++u) {
#pragma unroll
        for (int pass = 0; pass < 3; ++pass) {
            if (F.wave >= 4) dil_pass(p, F.bid + u * F.G, pass, F.lds, F.wave - 4, lane);
            else {
                const int ci = u * 3 + pass;
                const int g0 = ci * 2 + (ci < 8 ? ci : 8), g1 = g0 + 2 + (ci < 8 ? 1 : 0);
                auto srcp = [&](int itn) -> const float4* {
                    const size_t idx = ((size_t)itn * 1024 + cw) * 64 + lane;
                    const int b = (int)(idx >> 20), i = (int)((idx >> 9) & 2047), c4 = (int)(idx & 511);
                    const int c = c4 * 4, r = T + b;
                    const float4* s_old = ((const float4*)p.st_dil) + ((size_t)b * 2048 + (i < 2047 ? i + 1 : 2047)) * 512 + c4;
                    const float4* s_new = (c < 1024) ? (const float4*)(p.KD + (size_t)r * 1024 + c) : (const float4*)(H1 + (size_t)r * 3072 + 2048 + (c - 1024));
                    return (i == 2047) ? s_new : s_old; };
                float4* dstp = (float4*)(p.out + O_DIL_S) + (size_t)cw * 64 + lane;
#pragma unroll 1
                for (int gi = g0; gi < g1; ++gi) {
                    const int i0 = gi * 16;
                    const float4 v0 = *srcp(i0), v1 = *srcp(i0 + 1), v2 = *srcp(i0 + 2), v3 = *srcp(i0 + 3), v4 = *srcp(i0 + 4), v5 = *srcp(i0 + 5), v6 = *srcp(i0 + 6), v7 = *srcp(i0 + 7);
                    const float4 v8 = *srcp(i0 + 8), v9 = *srcp(i0 + 9), v10 = *srcp(i0 + 10), v11 = *srcp(i0 + 11), v12 = *srcp(i0 + 12), v13 = *srcp(i0 + 13), v14 = *srcp(i0 + 14), v15 = *srcp(i0 + 15);
                    float4* d = dstp + (size_t)i0 * 65536;
                    d[0] = v0; d[65536] = v1; d[2 * 65536] = v2; d[3 * 65536] = v3; d[4 * 65536] = v4; d[5 * 65536] = v5; d[6 * 65536] = v6; d[7 * 65536] = v7;
                    d[8 * 65536] = v8; d[9 * 65536] = v9; d[10 * 65536] = v10; d[11 * 65536] = v11; d[12 * 65536] = v12; d[13 * 65536] = v13; d[14 * 65536] = v14; d[15 * 65536] = v15;
                }
            }
            __syncthreads();
        }
    }
}

constexpr int NPHASE = 22;
__global__ void __launch_bounds__(NTHR, 2) mega(KP p) {
    extern __shared__ __attribute__((aligned(16))) unsigned char lds[];
    Fr F; F.lds = lds; F.tid = threadIdx.x; F.lane = 0; F.wave = __builtin_amdgcn_readfirstlane(F.tid >> 6);
    F.bid = blockIdx.x; F.G = gridDim.x; F.gw = F.bid * NWAVES + F.wave; F.NGW = F.G * NWAVES;
    for (int u = F.tid; u < (LDS_BYTES - RING_BYTES) / 4; u += NTHR) ((unsigned*)(lds + RING_BYTES))[u] = 0u;
    __syncthreads();
    XcdBarrier bar; bar.bar = p.ctl + 4096; bar.x = 0; bar.st = nullptr;
    if (!MK_PER_PHASE) bar = xcd_barrier_post(p.ctl + 4096, (volatile LAS unsigned*)(lds + MISC_OFF + 32));
    const int lo = p.ph_lo, hi = p.ph_hi;
#define IN(k) (lo <= (k) && (k) < hi)

    int ph = 0;
#if PROBE_ON
#define PROBE_STAMP(k) do { if (blockIdx.x == 0 && threadIdx.x == 0) ((unsigned long long*)(p.ctl + 65536))[k] = __builtin_amdgcn_s_memrealtime(); } while (0)
#define PROBE_STAMPB(k, blk) do { if (blockIdx.x == (blk) && threadIdx.x == 0) ((unsigned long long*)(p.ctl + 65536))[k] = __builtin_amdgcn_s_memrealtime(); } while (0)
    PROBE_STAMP(0);
#else
#define PROBE_STAMP(k) do { } while (0)
#define PROBE_STAMPB(k, blk) do { } while (0)
#endif
#define PHASE(...) do { { unsigned t_ = threadIdx.x; asm volatile("" : "+v"(t_)); F.lane = (int)(t_ & 63u); } if (IN(ph)) { __VA_ARGS__ } if (IN(ph) && IN(ph + 1)) xcd_barrier(bar); ++ph; PROBE_STAMP(ph); } while (0)
    PHASE(ph_prologue(p, F););
    PHASE(ph_gemm_f32(F, p.ACTB, p.WT_A, PAP, DM, p.BIGF, PA, PA); ph_cmp_samples(p, F););
    PHASE(ph_nsa_prep(p, F); ph_nsa_prep_fast(p, F); ph_gdn_prep(p, F););
    PHASE(ph_gdn_chunks(p, F););
    PHASE(ph_mix_a(p, F););
    PHASE(ph_mix_b(p, F););
    PHASE(ph_gdn_out(p, F););
    PHASE(ph_gemm_f32(F, p.MIXB, p.WT_OA, DM, DM, p.MO, DM, DM););
    PHASE(ph_ln(F, p.x_prompt, p.x_sample, p.MO, p.ln_mix_g, p.ln_mix_b, p.X1, p.X1 + (size_t)T * DM, p.ACTB););
    PHASE(ph_ffn_gemm(p, F, p.WT_FI0, 0););
    PHASE(ph_ffn_fix(p, F, 0););
    PHASE(ph_gemm_f32(F, p.HFFB, p.WT_FO0, DM, DFF, p.MO, DM, DM););
    PHASE(ph_ln(F, p.X1, p.X1 + (size_t)T * DM, p.MO, p.ln_ffn_g, p.ln_ffn_b, p.X2, p.X2 + (size_t)T * DM, p.ACTB););
    PHASE(ph_gemm_f32(F, p.ACTB, p.WT_CI, 3072, DM, p.BIGF, 3072, 3072););
    PHASE(ph_dil_prep(p, F); ph_dil_prep_fast(p, F););
    PHASE(ph_dil_attn(p, F); __syncthreads(); ph_dil_combo(p, F););
    PHASE(ph_gemm_f32(F, p.MIXB, p.WT_CO, DM, DM, p.MO, DM, DM););
    PHASE(ph_ln(F, p.X2, p.X2 + (size_t)T * DM, p.MO, p.ln_mix_g + DM, p.ln_mix_b + DM, p.X3, p.X3 + (size_t)T * DM, p.ACTB););
    PHASE(ph_ffn_gemm(p, F, p.WT_FI1, 1););
    PHASE(ph_ffn_fix(p, F, 1););
    PHASE(ph_gemm_f32(F, p.HFFB, p.WT_FO1, DM, DFF, p.MO, DM, DM););
    PHASE(ph_ln(F, p.X3, p.X3 + (size_t)T * DM, p.MO, p.ln_ffn_g + DM, p.ln_ffn_b + DM, p.out + O_Y_P, p.out + O_Y_S, nullptr););
#undef PHASE
#if PROBE_ON
    xcd_barrier(bar);
    if (blockIdx.x == 0) { __syncthreads(); const unsigned long long* pts = (const unsigned long long*)(p.ctl + 65536); const float x = (float)(pts[PROBE_B] - pts[PROBE_A]) * 1e-5f;
        for (int i = threadIdx.x; i < NSMP * DM; i += NTHR) p.out[O_Y_S + i] *= (1.f + x); }
#endif
#undef IN
}

static inline size_t align_up(size_t x) { return (x + 255) & ~(size_t)255; }

extern "C" void kernel_launch(void* const* d_in, const int* in_sizes, int n_in, void* d_out, int out_size, void* d_ws, size_t ws_size, hipStream_t stream) {
    static int grid = 0;
    if (grid == 0) {
        int dev = 0, cus = 0, per_cu = 0;
        if (hipGetDevice(&dev) != hipSuccess || hipDeviceGetAttribute(&cus, hipDeviceAttributeMultiprocessorCount, dev) != hipSuccess) { fprintf(stderr, "kernel_launch: device query failed\n"); grid = -1; return; }
        if (hipFuncSetAttribute((const void*)mega, hipFuncAttributeMaxDynamicSharedMemorySize, LDS_BYTES) != hipSuccess) { fprintf(stderr, "kernel_launch: hipFuncSetAttribute failed\n"); grid = -1; return; }
        if (hipOccupancyMaxActiveBlocksPerMultiprocessor(&per_cu, (const void*)mega, NTHR, LDS_BYTES) != hipSuccess || per_cu < 1) { fprintf(stderr, "kernel_launch: occupancy query says %d blocks per CU\n", per_cu); }
        (void)hipGetLastError();
        grid = cus;
    }
    if (grid < 0) return;
    if ((size_t)out_size != O_END) fprintf(stderr, "kernel_launch: out_size %d != expected %zu\n", out_size, (size_t)O_END);
    KP p{};
    p.x_prompt = (const float*)d_in[0]; p.x_sample = (const float*)d_in[1]; p.cache_cmp = (const float*)d_in[2]; p.cache_slc = (const float*)d_in[3];
    p.st_win = (const float*)d_in[4]; p.st_gconv = (const float*)d_in[5]; p.st_gS = (const float*)d_in[6]; p.st_dil = (const float*)d_in[7];
    p.st_ffn = (const float*)d_in[8]; p.page_table = (const int*)d_in[9]; p.w_in_a = (const float*)d_in[10]; p.cw1 = (const float*)d_in[11];
    p.cb1 = (const float*)d_in[12]; p.cw2 = (const float*)d_in[13]; p.cpe = (const float*)d_in[14]; p.gconv_w = (const float*)d_in[15];
    p.gA = (const float*)d_in[16]; p.gdt = (const float*)d_in[17]; p.gnw = (const float*)d_in[18]; p.w_out_a = (const float*)d_in[19];
    p.w_in_c = (const float*)d_in[20]; p.w_out_c = (const float*)d_in[21]; p.ln_mix_g = (const float*)d_in[22]; p.ln_mix_b = (const float*)d_in[23];
    p.ffn_w_in = (const float*)d_in[24]; p.ffn_cw = (const float*)d_in[25]; p.ffn_cb = (const float*)d_in[26]; p.ffn_w_out = (const float*)d_in[27];
    p.ln_ffn_g = (const float*)d_in[28]; p.ln_ffn_b = (const float*)d_in[29];
    p.out = (float*)d_out;
    char* ws = (char*)d_ws; size_t off = 0;
    auto alloc = [&](size_t bytes) { void* q = (void*)(ws + off); off = align_up(off + bytes); return q; };
    p.ctl = (unsigned*)alloc(1 << 20);
    p.WT_A = (bf16*)alloc((size_t)PAP * DM * 2); p.WT_OA = (bf16*)alloc((size_t)DM * DM * 2);
    p.WT_FI0 = (bf16*)alloc((size_t)DFF2 * DM * 2); p.WT_FI1 = (bf16*)alloc((size_t)DFF2 * DM * 2);
    p.WT_FO0 = (bf16*)alloc((size_t)DM * DFF * 2); p.WT_FO1 = (bf16*)alloc((size_t)DM * DFF * 2);
    p.WT_CI = (bf16*)alloc((size_t)3072 * DM * 2); p.WT_CO = (bf16*)alloc((size_t)DM * DM * 2);
    p.ROPE = (float2*)alloc((size_t)(T + 1) * 32 * 8);
    p.ACTB = (bf16*)alloc((size_t)TSP * DM * 2); p.MIXB = (bf16*)alloc((size_t)TSP * DM * 2); p.HFFB = (bf16*)alloc((size_t)TSP * DFF * 2);
    p.KS8 = (unsigned char*)alloc((size_t)2 * T * 64); p.VS8 = (unsigned char*)alloc((size_t)2 * T * 64);
    p.QB = (bf16*)alloc((size_t)T * 512 * 2); p.KSF = (bf16*)alloc((size_t)2 * T * 64 * 2); p.VSF = (bf16*)alloc((size_t)2 * T * 64 * 2);
    p.KWF = (bf16*)alloc((size_t)2 * T * 64 * 2); p.VWF = (bf16*)alloc((size_t)2 * T * 64 * 2); p.CKF = (bf16*)alloc((size_t)2 * 512 * 64 * 2); p.CVF = (bf16*)alloc((size_t)2 * 512 * 64 * 2);
    p.ACP = (bf16*)alloc((size_t)2048 * 2048 * 2);
    p.W2T = (bf16*)alloc((size_t)2 * 64 * 128 * 2);
    p.AC = nullptr; p.WT_C = (bf16*)alloc((size_t)256 * 2048 * 2); p.HID = nullptr; p.SMIXF = (float*)alloc((size_t)NSMP * 3 * 512 * 4);
    p.UB = (float*)alloc((size_t)256 * 4 * DFF2 * 4);
    p.NSACC = (float*)alloc((size_t)T * 512 * 4); p.SEL = (int*)alloc((size_t)2 * T * 16 * 4);
    p.QDB = (bf16*)alloc((size_t)T * 1024 * 2);
    for (int i = 0; i < 3; ++i) { p.DKF[i] = (bf16*)alloc((size_t)T * 1024 * 2); p.DVF[i] = (bf16*)alloc((size_t)T * 1024 * 2); }
    p.G_WF = (bf16*)alloc((size_t)2048 * 4096 * 2); p.G_KDF = (bf16*)alloc((size_t)2048 * 4096 * 2); p.G_QGF = (bf16*)alloc((size_t)2048 * 4096 * 2); p.G_QKF = (bf16*)alloc((size_t)2048 * 4096 * 2);
    p.G_SPF = (bf16*)alloc((size_t)2048 * 4096 * 2); p.G_VNF = (bf16*)alloc((size_t)2048 * 4096 * 2); p.G_UF = (float*)alloc((size_t)2048 * 4096 * 4); p.G_GL = (float*)alloc((size_t)2048 * 4);
    p.BIGF = (float*)alloc((size_t)TSP * DFF2 * 4); p.MO = (float*)alloc((size_t)TSP * DM * 4);
    p.X1 = (float*)alloc((size_t)TS * DM * 4); p.X2 = (float*)alloc((size_t)TS * DM * 4); p.X3 = (float*)alloc((size_t)TS * DM * 4);
    p.QR = (float*)alloc((size_t)TS * 512 * 4);
    p.KS = (float*)alloc((size_t)TS * 128 * 4); p.VS = (float*)alloc((size_t)TS * 128 * 4); p.KW = (float*)alloc((size_t)TS * 128 * 4); p.VW = (float*)alloc((size_t)TS * 128 * 4);
    p.CK = (float*)alloc((size_t)33 * 512 * 128 * 4); p.CV = (float*)alloc((size_t)33 * 512 * 128 * 4);
    p.GQ = (float*)alloc((size_t)TS * 512 * 4); p.GK = (float*)alloc((size_t)TS * 512 * 4); p.GV = (float*)alloc((size_t)TS * 512 * 4); p.OG = (float*)alloc((size_t)TS * 512 * 4);
    p.Gg = (float*)alloc((size_t)TS * 8 * 4); p.Gb = (float*)alloc((size_t)TS * 8 * 4);
    p.QD = (float*)alloc((size_t)TS * DM * 4); p.KD = (float*)alloc((size_t)TS * DM * 4);
    if (off > ws_size) { fprintf(stderr, "kernel_launch: workspace too small: need %zu have %zu\n", off, ws_size); return; }
    if (hipMemsetAsync(p.ctl, 0, 1 << 20, stream) != hipSuccess) { fprintf(stderr, "kernel_launch: memset failed\n"); return; }
#if MK_PER_PHASE
    for (int k = 0; k < NPHASE; ++k) { p.ph_lo = k; p.ph_hi = k + 1; hipLaunchKernelGGL(mega, dim3(grid), dim3(NTHR), LDS_BYTES, stream, p); }
#else
    p.ph_lo = 0; p.ph_hi = NPHASE;
    hipLaunchKernelGGL(mega, dim3(grid), dim3(NTHR), LDS_BYTES, stream, p);
#endif
    const hipError_t le = hipPeekAtLastError();
    if (le != hipSuccess) fprintf(stderr, "kernel_launch: launch failed: %s\n", hipGetErrorName(le));
}
```

```cpp
#include <hip/hip_runtime.h>
#include <cstdint>
#include <cstdio>
#include <cmath>

namespace pg8 {
#define PG8_LAS __attribute__((address_space(3)))
typedef unsigned short bf16_t;
typedef short bf16x8 __attribute__((ext_vector_type(8)));
typedef float f32x4 __attribute__((ext_vector_type(4)));
typedef unsigned u32x4 __attribute__((ext_vector_type(4)));
constexpr int BM = 256, BK = 64, HALF = 128, HTB = HALF * BK * 2  , STAGE_BYTES = 8 * HTB, NXCD = 8, WGM = 8;

__host__ __device__ __forceinline__ int lds_byte(int r, int c) { const int st = (r >> 4) * 2 + (c >> 5), rr = r & 15, cc = c & 31, ob = rr * 64 + cc * 2; return st * 1024 + (ob ^ (((ob >> 9) & 1) << 5)); }
__host__ __device__ __forceinline__ void stage_rc(int b, int& R, int& C) { const int st = b / 1024, sb = b % 1024, swz = sb ^ (((sb >> 9) & 1) << 5); R = (st >> 1) * 16 + swz / 64; C = (st & 1) * 32 + (swz % 64) / 2; }
__host__ __device__ __forceinline__ int perm32(int rho) { const int n = rho >> 4, i = rho & 15; return 8 * (i >> 2) + 4 * n + (i & 3); }

struct Unit { int pm, pn; };
struct Gemm { const bf16_t* A; const bf16_t* Bt; int M, N, K; };

struct StaticOrder {
    int nM, nN, nwg, G, c;
    __host__ __device__ void init(int M, int N, int G_, int c_) { nM = M / BM; nN = N / BM; nwg = nM * nN; G = G_; c = c_; }
    __host__ __device__ bool next(int i, Unit& u) const {
        const long L = (long)i * G + c; if (L >= nwg) return false;
        int wgid = (int)L; { const int q = nwg / NXCD, r = nwg % NXCD, xcd = wgid % NXCD, off = wgid / NXCD; wgid = (xcd < r ? xcd * (q + 1) : r * (q + 1) + (xcd - r) * q) + off; }
        const int nig = WGM * nN, gid = wgid / nig, fm = gid * WGM, gsz = (nM - fm) < WGM ? (nM - fm) : WGM;
        u.pm = fm + ((wgid % nig) % gsz); u.pn = (wgid % nig) / gsz; return true;
    }
    __device__ __forceinline__ void a_ready(const Unit&) const {}
    __device__ __forceinline__ void done(const Unit&) const {}
};

typedef __bf16 bf16x2_t __attribute__((ext_vector_type(2)));
typedef float f32x2_t __attribute__((ext_vector_type(2)));
__device__ __forceinline__ unsigned cvt_pk_bf16(float lo, float hi) { const f32x2_t v = {lo, hi}; return __builtin_bit_cast(unsigned, __builtin_convertvector(v, bf16x2_t)); }
typedef float f32x2 __attribute__((ext_vector_type(2)));
__device__ __forceinline__ f32x2 gelu_pk(f32x2 v) {
    const f32x2 av = __builtin_elementwise_abs(v), d = av * 0.2316418882f + 1.0f;
    f32x2 t; t.x = __builtin_amdgcn_rcpf(d.x); t.y = __builtin_amdgcn_rcpf(d.y);
    f32x2 q = t * 0.5307027145f + (-0.7265760135f); q = q * t + 0.7107068705f; q = q * t + (-0.142248368f); q = q * t + 0.127414796f; q = q * t;
    const f32x2 s = (v * v) * (-0.72134752044f);
    f32x2 e; e.x = __builtin_amdgcn_exp2f(s.x); e.y = __builtin_amdgcn_exp2f(s.y);
    const f32x2 m = v * (q * e), r = v - m;
    f32x2 o; o.x = v.x < 0.f ? m.x : r.x; o.y = v.y < 0.f ? m.y : r.y; return o;
}

template <int ACT  > struct EpiBf16 {
    static constexpr bool PERM = true, AFTER_DRAIN = false; static_assert(ACT == 0 || ACT == 1, "EpiBf16: ACT is 0 (none) or 1 (gelu_pk)");
    bf16_t* O; int ldc; const float* bias; int split_cols; size_t split_stride; float scale0;
    __device__ __forceinline__ void operator()(const f32x4 (&acc)[2][2][4][2], const Unit& u, int wr, int wc, int fr, int fq) const {
        const int row0 = u.pm * BM + wr * 64 + fr; int colt = u.pn * BM; bf16_t* base = O;
        float sc = 1.f; if (split_cols) { const int t = colt / split_cols; base += (size_t)t * split_stride; colt -= t * split_cols; if (t == 0) sc = scale0; }
        const int col0 = colt + wc * 32 + 8 * fq, bcol0 = u.pn * BM + wc * 32 + 8 * fq;
        f32x4 bv[2][2];
#pragma unroll
        for (int bj = 0; bj < 2; ++bj)
#pragma unroll
            for (int n = 0; n < 2; ++n) bv[bj][n] = bias ? *(const f32x4*)(bias + bcol0 + bj * HALF + 4 * n) : (f32x4){0.f, 0.f, 0.f, 0.f};
#pragma unroll
        for (int ai = 0; ai < 2; ++ai)
#pragma unroll
            for (int m = 0; m < 4; ++m) { bf16_t* rowp = base + (size_t)(row0 + ai * HALF + m * 16) * ldc + col0;
#pragma unroll
                for (int bj = 0; bj < 2; ++bj) { f32x4 v0 = acc[ai][bj][m][0] + bv[bj][0], v1 = acc[ai][bj][m][1] + bv[bj][1];
                    if (ACT == 1) { f32x2 a = gelu_pk((f32x2){v0[0], v0[1]}), b = gelu_pk((f32x2){v0[2], v0[3]}), c = gelu_pk((f32x2){v1[0], v1[1]}), d = gelu_pk((f32x2){v1[2], v1[3]});
                        v0 = (f32x4){a.x, a.y, b.x, b.y}; v1 = (f32x4){c.x, c.y, d.x, d.y}; }
                    v0 = v0 * sc; v1 = v1 * sc; u32x4 w; w.x = cvt_pk_bf16(v0[0], v0[1]); w.y = cvt_pk_bf16(v0[2], v0[3]); w.z = cvt_pk_bf16(v1[0], v1[1]); w.w = cvt_pk_bf16(v1[2], v1[3]);
                    *(u32x4*)(rowp + bj * HALF) = w; } }
    }
};

struct EpiF32 {
    static constexpr bool PERM = false, AFTER_DRAIN = false;
    float* O; int ldc; int ncols;
    __device__ __forceinline__ void operator()(const f32x4 (&acc)[2][2][4][2], const Unit& u, int wr, int wc, int fr, int fq) const {
        const int row0 = u.pm * BM + wr * 64 + fr; const int col0 = u.pn * BM + wc * 32 + 4 * fq;
#pragma unroll
        for (int ai = 0; ai < 2; ++ai)
#pragma unroll
            for (int m = 0; m < 4; ++m) { float* rowp = O + (size_t)(row0 + ai * HALF + m * 16) * ldc;
#pragma unroll
                for (int bj = 0; bj < 2; ++bj)
#pragma unroll
                    for (int n = 0; n < 2; ++n) { const int c = col0 + bj * HALF + n * 16; if (c < ncols) *(f32x4*)(rowp + c) = acc[ai][bj][m][n]; } }
    }
};
template <class Epi, class Sched, bool ALIGN_EPI = false, bool SP2 = false>
__device__ __forceinline__ void gemm_phase(PG8_LAS unsigned char* lds, const Gemm g, const Sched& S, const Epi& E) {
    const int tid = threadIdx.x, wid = __builtin_amdgcn_readfirstlane(tid >> 6), lane = tid & 63, wr = wid >> 2, wc = wid & 3, fr = lane & 15, fq = lane >> 4;
    const int K = g.K, nt = K / BK;
    unsigned voffA[2], voffB[2];
#pragma unroll
    for (int i = 0; i < 2; ++i) { int R, C; stage_rc(tid * 16 + i * 8192, R, C); const int Rb = Epi::PERM ? ((R & ~31) + perm32(R & 31)) : R;
        voffA[i] = (unsigned)(R * K + C) * 2u; voffB[i] = (unsigned)(Rb * K + C) * 2u; }
    const size_t kstep = (size_t)(BK * 2);
    const size_t hstep = (size_t)HALF * K * 2;
    const size_t tstep = 2 * hstep;
    const unsigned ldsw = (unsigned)wid * 1024u;
    const int aoff = lds_byte(wr * 64 + fr, fq * 8), boff = lds_byte(wc * 32 + fr, fq * 8);
#define PG8_SA(b, h) (((b) * 2 + (h)) * HTB)
#define PG8_SB(b, h) ((4 + (b) * 2 + (h)) * HTB)
#define PG8_STAGE(bufoff, gbase, voff) do { _Pragma("unroll") for (int _i = 0; _i < 2; ++_i) \
        __builtin_amdgcn_global_load_lds((const unsigned*)((const char*)(gbase) + (voff)[_i]), (PG8_LAS unsigned*)(lds + (bufoff) + ldsw + _i * 8192), 16, 0, 0); } while (0)
#define PG8_LDA(dst, b, h) do { _Pragma("unroll") for (int m = 0; m < 4; ++m) _Pragma("unroll") for (int k = 0; k < 2; ++k) dst[m][k] = *(const PG8_LAS bf16x8*)(lds + PG8_SA(b, h) + aoff + m * 2048 + k * 1024); } while (0)
#define PG8_LDB(dst, b, h) do { _Pragma("unroll") for (int n = 0; n < 2; ++n) _Pragma("unroll") for (int k = 0; k < 2; ++k) dst[n][k] = *(const PG8_LAS bf16x8*)(lds + PG8_SB(b, h) + boff + n * 2048 + k * 1024); } while (0)
#define PG8_MMA(ai, bj, At, Bt) do { __builtin_amdgcn_s_setprio(1); _Pragma("unroll") for (int m = 0; m < 4; ++m) _Pragma("unroll") for (int n = 0; n < 2; ++n) _Pragma("unroll") for (int k = 0; k < 2; ++k) \
        acc[ai][bj][m][n] = __builtin_amdgcn_mfma_f32_16x16x32_bf16(Bt[n][k], At[m][k], acc[ai][bj][m][n], 0, 0, 0); __builtin_amdgcn_s_setprio(0); } while (0)
#define PG8_WAIT_V(n) asm volatile("s_waitcnt vmcnt(" #n ")" ::: "memory")
#define PG8_WAIT_L(n) asm volatile("s_waitcnt lgkmcnt(" #n ")" ::: "memory")
#define PG8_BAR __builtin_amdgcn_s_barrier()
#define PG8_SCHED __builtin_amdgcn_sched_barrier(0)
    Unit cur, nxt; int ui = 0;
    if (!S.next(0, cur)) return;
    f32x4 acc[2][2][4][2];
#pragma unroll
    for (int a = 0; a < 2; ++a)
#pragma unroll
        for (int b = 0; b < 2; ++b)
#pragma unroll
            for (int m = 0; m < 4; ++m)
#pragma unroll
                for (int n = 0; n < 2; ++n) acc[a][b][m][n] = (f32x4){0.f, 0.f, 0.f, 0.f};
    bf16x8 At[4][2], B0[2][2], B1[2][2];
    const char* cA = (const char*)g.A + (size_t)cur.pm * tstep; const char* cB = (const char*)g.Bt + (size_t)cur.pn * tstep;
    S.a_ready(cur);
    if constexpr (SP2) {
        PG8_STAGE(PG8_SB(0, 0), cB, voffB); PG8_STAGE(PG8_SB(0, 1), cB + hstep, voffB); PG8_STAGE(PG8_SA(0, 0), cA, voffA); PG8_STAGE(PG8_SA(0, 1), cA + hstep, voffA);
        if (wr == 1) PG8_BAR;
        PG8_WAIT_V(2); PG8_BAR;
        PG8_STAGE(PG8_SB(1, 0), cB + kstep, voffB); PG8_STAGE(PG8_SA(1, 0), cA + kstep, voffA); PG8_STAGE(PG8_SB(1, 1), cB + hstep + kstep, voffB);
        PG8_WAIT_V(6); PG8_BAR;
    } else {
        PG8_STAGE(PG8_SB(0, 0), cB, voffB); PG8_STAGE(PG8_SA(0, 0), cA, voffA); PG8_STAGE(PG8_SB(0, 1), cB + hstep, voffB); PG8_STAGE(PG8_SA(0, 1), cA + hstep, voffA);
        if (wr == 1) PG8_BAR;
        PG8_WAIT_V(4); PG8_BAR;
        PG8_STAGE(PG8_SB(1, 0), cB + kstep, voffB); PG8_STAGE(PG8_SA(1, 0), cA + kstep, voffA); PG8_STAGE(PG8_SB(1, 1), cB + hstep + kstep, voffB);
        PG8_WAIT_V(6); PG8_BAR;
    }
    for (;;) {
        const bool has_next = S.next(ui + 1, nxt);
        const char* nA = has_next ? (const char*)g.A + (size_t)nxt.pm * tstep : cA; const char* nB = has_next ? (const char*)g.Bt + (size_t)nxt.pn * tstep : cB;
        for (int t = 0; t < nt; t += 2) {
            const bool last = (t == nt - 2);
            const char* a1 = cA + (size_t)(t + 1) * kstep;
            const char* a2 = last ? nA : cA + (size_t)(t + 2) * kstep; const char* b2 = last ? nB : cB + (size_t)(t + 2) * kstep;
            const char* a3 = a2 + kstep; const char* b3 = b2 + kstep;
            if (last && has_next) S.a_ready(nxt);
            if constexpr (SP2) {
            PG8_LDB(B0, 0, 0); PG8_LDB(B1, 0, 1); PG8_SCHED; PG8_LDA(At, 0, 0); PG8_STAGE(PG8_SA(1, 1), a1 + hstep, voffA);
            PG8_WAIT_V(8); PG8_WAIT_L(0); PG8_BAR; PG8_MMA(0, 0, At, B0); PG8_MMA(0, 1, At, B1); PG8_BAR; PG8_SCHED;
            PG8_LDA(At, 0, 1); PG8_STAGE(PG8_SB(0, 0), b2, voffB); PG8_STAGE(PG8_SB(0, 1), b2 + hstep, voffB); PG8_STAGE(PG8_SA(0, 0), a2, voffA);
            PG8_WAIT_V(8); PG8_WAIT_L(0); PG8_BAR; PG8_MMA(1, 0, At, B0); PG8_MMA(1, 1, At, B1); PG8_BAR; PG8_SCHED;
            PG8_LDB(B0, 1, 0); PG8_LDB(B1, 1, 1); PG8_SCHED; PG8_LDA(At, 1, 0); PG8_STAGE(PG8_SA(0, 1), a2 + hstep, voffA);
            PG8_WAIT_V(8); PG8_WAIT_L(0); PG8_BAR; PG8_MMA(0, 0, At, B0); PG8_MMA(0, 1, At, B1); PG8_BAR; PG8_SCHED;
            PG8_LDA(At, 1, 1); PG8_STAGE(PG8_SB(1, 0), b3, voffB); PG8_STAGE(PG8_SB(1, 1), b3 + hstep, voffB); PG8_STAGE(PG8_SA(1, 0), a3, voffA);
            PG8_WAIT_V(8); PG8_WAIT_L(0); PG8_BAR; PG8_MMA(1, 0, At, B0); PG8_MMA(1, 1, At, B1); PG8_BAR; PG8_SCHED;
            } else {
            PG8_LDB(B0, 0, 0); PG8_SCHED; PG8_LDA(At, 0, 0); PG8_STAGE(PG8_SA(1, 1), a1 + hstep, voffA);
            PG8_WAIT_L(8); PG8_BAR; PG8_WAIT_L(0); PG8_MMA(0, 0, At, B0); PG8_BAR; PG8_SCHED;
            PG8_LDB(B1, 0, 1); PG8_STAGE(PG8_SB(0, 0), b2, voffB);
            PG8_BAR; PG8_WAIT_L(0); PG8_MMA(0, 1, At, B1); PG8_BAR;
            PG8_LDA(At, 0, 1); PG8_STAGE(PG8_SA(0, 0), a2, voffA);
            PG8_BAR; PG8_WAIT_L(0); PG8_MMA(1, 0, At, B0); PG8_BAR; PG8_SCHED;
            PG8_STAGE(PG8_SB(0, 1), b2 + hstep, voffB);
            PG8_WAIT_V(6); PG8_BAR; PG8_MMA(1, 1, At, B1); PG8_BAR;
            PG8_LDB(B0, 1, 0); PG8_SCHED; PG8_LDA(At, 1, 0); PG8_STAGE(PG8_SA(0, 1), a2 + hstep, voffA);
            PG8_WAIT_L(8); PG8_BAR; PG8_WAIT_L(0); PG8_MMA(0, 0, At, B0); PG8_BAR; PG8_SCHED;
            PG8_LDB(B1, 1, 1); PG8_STAGE(PG8_SB(1, 0), b3, voffB);
            PG8_BAR; PG8_WAIT_L(0); PG8_MMA(0, 1, At, B1); PG8_BAR;
            PG8_LDA(At, 1, 1); PG8_STAGE(PG8_SA(1, 0), a3, voffA);
            PG8_BAR; PG8_WAIT_L(0); PG8_MMA(1, 0, At, B0); PG8_BAR; PG8_SCHED;
            PG8_STAGE(PG8_SB(1, 1), b3 + hstep, voffB);
            PG8_WAIT_V(6); PG8_BAR; PG8_MMA(1, 1, At, B1); PG8_BAR;
            }
        }
        if constexpr (ALIGN_EPI) { if (wr == 0) PG8_BAR; }
        if constexpr (!Epi::AFTER_DRAIN) { E(acc, cur, wr, wc, fr, fq); S.done(cur); }
        if (!has_next) break;
#pragma unroll
        for (int a = 0; a < 2; ++a)
#pragma unroll
            for (int b = 0; b < 2; ++b)
#pragma unroll
                for (int m = 0; m < 4; ++m)
#pragma unroll
                    for (int n = 0; n < 2; ++n) acc[a][b][m][n] = (f32x4){0.f, 0.f, 0.f, 0.f};
        cur = nxt; cA = nA; cB = nB; ++ui;
        if constexpr (ALIGN_EPI) { if (wr == 1) PG8_BAR; }
    }
    PG8_WAIT_V(0);
    if constexpr (!ALIGN_EPI) { if (wr == 0) PG8_BAR; }
    PG8_BAR;
    if constexpr (Epi::AFTER_DRAIN) { E.fused(acc, cur, wr, wc, fr, fq, lds, wid, lane); S.done(cur); }
#undef PG8_SA
#undef PG8_SB
#undef PG8_STAGE
#undef PG8_LDA
#undef PG8_LDB
#undef PG8_MMA
#undef PG8_WAIT_V
#undef PG8_WAIT_L
#undef PG8_BAR
#undef PG8_SCHED
}
}

#define LAS __attribute__((address_space(3)))
#define XB_TMO      128
#define XB_XCNT(j)  (256  + 64 * (j))
#define XB_XSUB(j)  (1280 + 64 * (j))
#define XB_XGEN(j)  (2304 + 64 * (j))
#define XB_TOP      3328
#define XB_TOPGEN   3392
#define XCD_BAR_WORDS 3456
#define XB_SPIN_CAP (1u << 26)

__device__ __forceinline__ unsigned xb_ld(unsigned* p)              { return __hip_atomic_load(p, __ATOMIC_RELAXED, __HIP_MEMORY_SCOPE_AGENT); }
__device__ __forceinline__ unsigned xb_add(unsigned* p, unsigned v) { return __hip_atomic_fetch_add(p, v, __ATOMIC_RELAXED, __HIP_MEMORY_SCOPE_AGENT); }
__device__ __forceinline__ unsigned xb_xcc_id() { return (unsigned)__builtin_amdgcn_s_getreg((3 << 11) | 20) & 0xFu; }
#define XB_SPIN(cond, bar) do { unsigned _sp = 0; while (cond) { __builtin_amdgcn_s_sleep(1); \
    if ((++_sp & 255u) == 0u) { if (xb_ld(&(bar)[XB_TMO])) break; if (_sp > XB_SPIN_CAP) { atomicAdd(&(bar)[XB_TMO], 1u); break; } } } } while (0)

struct XcdBarrier {
    unsigned* bar; unsigned x;
    volatile LAS unsigned* st;
};

__device__ __forceinline__ XcdBarrier xcd_barrier_post(unsigned* bar, volatile LAS unsigned* st) {
    XcdBarrier b; b.bar = bar; b.x = xb_xcc_id(); b.st = st;
    if (threadIdx.x == 0) (void)xb_add(&bar[XB_XCNT(b.x)], 1u);
    return b;
}
__device__ __forceinline__ void xcd_barrier_complete(unsigned* bar, unsigned x, unsigned& nloc, unsigned& nx) {
    const unsigned G = gridDim.x * gridDim.y * gridDim.z;
    unsigned sum, cnt, mine, sp = 0u;
    for (;;) {
        sum = 0u; cnt = 0u; mine = 0u;
#pragma unroll
        for (unsigned j = 0; j < 16; ++j) { const unsigned c = xb_ld(&bar[XB_XCNT(j)]); sum += c; cnt += (c > 0u) ? 1u : 0u; mine = (j == x) ? c : mine; }
        if (sum == G) break;
        __builtin_amdgcn_s_sleep(1);
        if ((++sp & 255u) == 0u) { if (xb_ld(&bar[XB_TMO])) break; if (sp > XB_SPIN_CAP) { atomicAdd(&bar[XB_TMO], 1u); break; } }
    }
    nloc = mine > 0u ? mine : 1u; nx = cnt > 0u ? cnt : 1u;
}

__device__ __forceinline__ void xcd_barrier(const XcdBarrier& b) {
    asm volatile("s_waitcnt vmcnt(0)" ::: "memory");
    __syncthreads();
    if (threadIdx.x == 0) {
        unsigned* bar = b.bar;
        __builtin_amdgcn_s_waitcnt(0);
        unsigned nloc = b.st[0], nx = b.st[1];
        if (nloc == 0u) { xcd_barrier_complete(bar, b.x, nloc, nx); b.st[0] = nloc; b.st[1] = nx; }
        const unsigned old = xb_add(&bar[XB_XSUB(b.x)], 1u);
        const unsigned gen = old / nloc;
        if (old + 1u == (gen + 1u) * nloc) {
            __builtin_amdgcn_fence(__ATOMIC_RELEASE, "agent");
            asm volatile("s_waitcnt vmcnt(0)" ::: "memory");
            const unsigned og = xb_add(&bar[XB_TOP], 1u);
            const unsigned tg = og / nx;
            if (og + 1u == (tg + 1u) * nx) xb_add(&bar[XB_TOPGEN], 1u);
            else XB_SPIN(xb_ld(&bar[XB_TOPGEN]) == tg, bar);
            __builtin_amdgcn_fence(__ATOMIC_ACQUIRE, "agent");
            xb_add(&bar[XB_XGEN(b.x)], 1u);
            asm volatile("s_waitcnt vmcnt(0)" ::: "memory");
        } else {
            XB_SPIN(xb_ld(&bar[XB_XGEN(b.x)]) == gen, bar);
            __builtin_amdgcn_fence(__ATOMIC_ACQUIRE, "agent");
            asm volatile("s_waitcnt vmcnt(0)" ::: "memory");
        }
    }
    __syncthreads();
}

#ifndef PG8_SP2
#define PG8_SP2 true
#endif
#ifndef PG8_ALIGN
#define PG8_ALIGN true
#endif
#ifndef PROBE_ON
#define PROBE_ON 0
#define PROBE_A 0
#define PROBE_B 1
#endif
#ifndef MK_PER_PHASE
#define MK_PER_PHASE 0
#endif

constexpr int T = 16384, NSMP = 32, TS = T + NSMP, TSP = T + 256, DM = 1024;
constexpr int PA = 3368, PAP = 3584;
constexpr int C_Q = 0, C_KC = 512, C_VC = 640, C_KS = 768, C_VS = 896, C_KW = 1024, C_VW = 1152, C_GATE = 1280,
              C_GQKV = 1304, C_A = 2840, C_BT = 2848, C_Z = 2856;
constexpr int DFF = 2816, DFF2 = 5632;
constexpr float DN_ALPHA = 1.4142135623730951f;
constexpr float LN_EPS = 1e-5f, NORM_EPS = 1e-6f;
constexpr int NPAGES = 128;
constexpr int NWAVES = 8, NTHR = 512;

constexpr size_t O_Y_P = 0;
constexpr size_t O_Y_S = O_Y_P + (size_t)T * DM;
constexpr size_t O_CMP_P = O_Y_S + (size_t)NSMP * DM;
constexpr size_t O_CMP_S = O_CMP_P + (size_t)T * 256;
constexpr size_t O_SLC_P = O_CMP_S + (size_t)NSMP * 256;
constexpr size_t O_SLC_S = O_SLC_P + (size_t)T * 256;
constexpr size_t O_WIN_P = O_SLC_S + (size_t)NSMP * 256;
constexpr size_t O_WIN_S = O_WIN_P + (size_t)512 * 256;
constexpr size_t O_GCONV_P = O_WIN_S + (size_t)NSMP * 512 * 256;
constexpr size_t O_GCONV_S = O_GCONV_P + (size_t)3 * 1536;
constexpr size_t O_GS_P = O_GCONV_S + (size_t)NSMP * 3 * 1536;
constexpr size_t O_GS_S = O_GS_P + (size_t)8 * 64 * 64;
constexpr size_t O_DIL_P = O_GS_S + (size_t)NSMP * 8 * 64 * 64;
constexpr size_t O_DIL_S = O_DIL_P + (size_t)2048 * 2048;
constexpr size_t O_FFN_P = O_DIL_S + (size_t)NSMP * 2048 * 2048;
constexpr size_t O_FFN_S = O_FFN_P + (size_t)2 * 2 * DFF2;
constexpr size_t O_END = O_FFN_S + (size_t)NSMP * 2 * 2 * DFF2;

constexpr int RING_BYTES = 131072;
constexpr int FAST_WL = 17408;
constexpr int MISC_OFF = 8 * FAST_WL + 64;
constexpr int LDS_BYTES = 147456;

typedef unsigned short bf16;
typedef unsigned v4u __attribute__((ext_vector_type(4)));

__device__ __forceinline__ unsigned f2bf(float f) { return (unsigned)__builtin_bit_cast(unsigned short, (__bf16)f); }
__device__ __forceinline__ unsigned pk2(float lo, float hi) { return pg8::cvt_pk_bf16(lo, hi); }
typedef short bf16x8 __attribute__((ext_vector_type(8)));
typedef float f32x4 __attribute__((ext_vector_type(4)));
#define MFMA16(a, b, c) __builtin_amdgcn_mfma_f32_16x16x32_bf16((a), (b), (c), 0, 0, 0)
__device__ __forceinline__ float wave_sum(float v) {
#pragma unroll
    for (int o = 1; o < 64; o <<= 1) v += __shfl_xor(v, o);
    return v;
}
__device__ __forceinline__ float wave_max(float v) {
#pragma unroll
    for (int o = 1; o < 64; o <<= 1) v = fmaxf(v, __shfl_xor(v, o));
    return v;
}
__device__ __forceinline__ void wave_lds_sync() { asm volatile("s_waitcnt lgkmcnt(0)" ::: "memory"); __builtin_amdgcn_wave_barrier(); asm volatile("" ::: "memory"); }
__device__ __forceinline__ float fexp_(float x) { return __builtin_amdgcn_exp2f(x * 1.4426950408889634f); }
__device__ __forceinline__ float fsilu_(float x) { return x * __builtin_amdgcn_rcpf(1.f + fexp_(-x)); }
__device__ __forceinline__ float sigmoidf_(float x) { return 1.f / (1.f + expf(-x)); }
__device__ __forceinline__ float siluf_(float x) { return x / (1.f + expf(-x)); }
__device__ __forceinline__ float gelu_tanh(float x) { const float c = 0.7978845608028654f; return 0.5f * x * (1.f + tanhf(c * (x + 0.044715f * x * x * x))); }
__device__ __forceinline__ float softplusf_(float x) { return x > 20.f ? x : log1pf(expf(x)); }

struct KP {
    const float *x_prompt, *x_sample, *cache_cmp, *cache_slc, *st_win, *st_gconv, *st_gS, *st_dil, *st_ffn;
    const int* page_table;
    const float *w_in_a, *cw1, *cb1, *cw2, *cpe, *gconv_w, *gA, *gdt, *gnw, *w_out_a, *w_in_c, *w_out_c, *ln_mix_g, *ln_mix_b,
                *ffn_w_in, *ffn_cw, *ffn_cb, *ffn_w_out, *ln_ffn_g, *ln_ffn_b;
    float* out;
    unsigned* ctl;
    bf16 *WT_A, *WT_OA, *WT_FI0, *WT_FI1, *WT_FO0, *WT_FO1, *WT_CI, *WT_CO;
    float2* ROPE;
    bf16 *ACTB, *MIXB, *HFFB, *MOB;
    bf16 *QB, *KSF, *VSF, *KWF, *VWF, *CKF, *CVF;
    unsigned char *KS8, *VS8;
    bf16 *QDB; bf16* DKF[3]; bf16* DVF[3];
    bf16 *AC, *WT_C, *HID, *W2T, *ACP; float* SMIXF; float* NSACC; int* SEL; float* UB;
    bf16 *G_WF, *G_KDF, *G_QGF, *G_QKF, *G_SPF, *G_VNF; float *G_UF, *G_GL;
    float *BIGF, *MO, *X1, *X2, *X3, *QR, *KS, *VS, *KW, *VW, *CK, *CV, *GQ, *GK, *GV, *OG, *Gg, *Gb, *QD, *KD;
    int ph_lo, ph_hi;
};

struct Fr { unsigned char* lds; int tid, lane, wave, gw, NGW, bid, G; };

__device__ __forceinline__ int ffn_row(int u) { const int half = u >= DFF ? 1 : 0, jc = u - half * DFF; return 256 * (jc >> 7) + 128 * half + (jc & 127); }
__device__ __forceinline__ void transpose_item(const float* W, int K, int N, int NT, bf16* WT, float* scr, int item, int lane, int rowmap = 0) {
    const int nblk = NT / 32, kb = item / nblk, nb = item % nblk, k0 = 64 * kb, n0 = 32 * nb;
#pragma unroll 8
    for (int i = 0; i < 32; ++i) { const int kk = 2 * i + (lane >> 5); const int n = n0 + (lane & 31); scr[kk * 33 + (lane & 31)] = (n < N) ? W[(size_t)(k0 + kk) * N + n] : 0.f; }
    wave_lds_sync();
    const int c = lane & 7;
#pragma unroll
    for (int j = 0; j < 4; ++j) { const int n = (lane >> 3) + 8 * j; const float* s = scr + (8 * c) * 33 + n;
        v4u o; o.x = pk2(s[0 * 33], s[1 * 33]); o.y = pk2(s[2 * 33], s[3 * 33]); o.z = pk2(s[4 * 33], s[5 * 33]); o.w = pk2(s[6 * 33], s[7 * 33]);
        const int row = rowmap ? ffn_row(n0 + n) : n0 + n;
        *(v4u*)(WT + (size_t)row * K + k0 + 8 * c) = o; }
    wave_lds_sync();
}
__device__ __forceinline__ void ph_prologue(const KP& p, const Fr& F) {
    float* scr = (float*)(F.lds + F.wave * 16384);
    const int I_A = 16 * (PAP / 32), I_OA = 16 * 32, I_FI = 16 * (DFF2 / 32), I_FO = (DFF / 64) * 32, I_CI = 16 * (3072 / 32), I_CO = 16 * 32;
    const int NITEMS = I_A + I_OA + 2 * I_FI + 2 * I_FO + I_CI + I_CO + 256 + 8;
    for (int it = F.gw; it < NITEMS; it += F.NGW) {
        int r = it;
        if (r < I_A) { transpose_item(p.w_in_a, DM, PA, PAP, p.WT_A, scr, r, F.lane); continue; } r -= I_A;
        if (r < I_OA) { transpose_item(p.w_out_a, DM, DM, DM, p.WT_OA, scr, r, F.lane); continue; } r -= I_OA;
        if (r < I_FI) { transpose_item(p.ffn_w_in, DM, DFF2, DFF2, p.WT_FI0, scr, r, F.lane, 1); continue; } r -= I_FI;
        if (r < I_FI) { transpose_item(p.ffn_w_in + (size_t)DM * DFF2, DM, DFF2, DFF2, p.WT_FI1, scr, r, F.lane, 1); continue; } r -= I_FI;
        if (r < I_FO) { transpose_item(p.ffn_w_out, DFF, DM, DM, p.WT_FO0, scr, r, F.lane); continue; } r -= I_FO;
        if (r < I_FO) { transpose_item(p.ffn_w_out + (size_t)DFF * DM, DFF, DM, DM, p.WT_FO1, scr, r, F.lane); continue; } r -= I_FO;
        if (r < I_CI) { transpose_item(p.w_in_c, DM, 3072, 3072, p.WT_CI, scr, r, F.lane); continue; } r -= I_CI;
        if (r < I_CO) { transpose_item(p.w_out_c, DM, DM, DM, p.WT_CO, scr, r, F.lane); continue; } r -= I_CO;
        if (r < 256) { const int kv = r >> 7; transpose_item(p.cw1 + (size_t)kv * 2048 * 128, 2048, 128, 128, p.WT_C + (size_t)kv * 128 * 2048, scr, r & 127, F.lane); continue; } r -= 256;
        { const int kv = r >> 2; transpose_item(p.cw2 + (size_t)kv * 128 * 64, 128, 64, 64, p.W2T + (size_t)kv * 64 * 128, scr, r & 3, F.lane); }
    }
    const size_t gt = (size_t)F.bid * NTHR + F.tid, GT = (size_t)F.G * NTHR;
    for (size_t i4 = gt; i4 < (size_t)TSP * (DM / 4); i4 += GT) {
        const int r = (int)(i4 / (DM / 4)), c4 = (int)(i4 % (DM / 4));
        float4 v = make_float4(0.f, 0.f, 0.f, 0.f);
        if (r < T) v = ((const float4*)p.x_prompt)[(size_t)r * (DM / 4) + c4]; else if (r < TS) v = ((const float4*)p.x_sample)[(size_t)(r - T) * (DM / 4) + c4];
        uint2 o; o.x = pk2(v.x, v.y); o.y = pk2(v.z, v.w);
        ((uint2*)p.ACTB)[i4] = o;
    }
    for (size_t idx = gt; idx < (size_t)(T + 1) * 32; idx += GT) {
        const int pos = (int)(idx >> 5), i = (int)(idx & 31);
        const float inv = (float)pow(10000.0, -2.0 * (double)i / 64.0);
        const float ang = (float)pos * inv;
        p.ROPE[idx] = make_float2((float)cos((double)ang), (float)sin((double)ang));
    }
}

__device__ __forceinline__ size_t vfrag_elem(int key, int d);
__device__ __forceinline__ size_t kfrag_elem(int key, int d);
__device__ __forceinline__ bf16x8 pack_p(const f32x4& p0, const f32x4& p1);
template <bool FFNMAP = false, bool OUTBF = false>
__device__ __forceinline__ void skinny_gemm(const Fr& F, const bf16* A, const bf16* Bt, int K, int ncols, float* C, int ldc) {
    const int lane = F.lane, l15 = lane & 15, grp = lane >> 4;
    const int kper = K >> 3, k0 = F.wave * kper;
    const bf16* a0 = A + (size_t)(T + l15) * K + 8 * grp + k0; const bf16* a1 = a0 + (size_t)16 * K;
    f32x4* red = (f32x4*)F.lds;
    const int ntiles = (ncols + 15) >> 4;
    for (int nt = F.bid; nt < ntiles; nt += F.G) {
        const bf16* bp = Bt + (size_t)(nt * 16 + l15) * K + 8 * grp + k0;
        f32x4 c0 = {0.f, 0.f, 0.f, 0.f}, c1 = {0.f, 0.f, 0.f, 0.f};
#pragma unroll 4
        for (int k = 0; k < kper; k += 32) {
            const bf16x8 b = *(const bf16x8*)(bp + k), x0 = *(const bf16x8*)(a0 + k), x1 = *(const bf16x8*)(a1 + k);
            c0 = MFMA16(x0, b, c0); c1 = MFMA16(x1, b, c1);
        }
        red[(F.wave * 2 + 0) * 64 + lane] = c0; red[(F.wave * 2 + 1) * 64 + lane] = c1;
        __syncthreads();
        if (F.wave == 0) {
#pragma unroll
            for (int w = 1; w < 8; ++w) { c0 = c0 + red[(w * 2 + 0) * 64 + lane]; c1 = c1 + red[(w * 2 + 1) * 64 + lane]; }
            int n = nt * 16 + l15;
            if (FFNMAP) n = ((n >> 7) & 1) * DFF + (n >> 8) * 128 + (n & 127);
            if (n < ncols) {
#pragma unroll
                for (int r = 0; r < 4; ++r) {
                    if (OUTBF) { ((bf16*)C)[(size_t)(T + 4 * grp + r) * ldc + n] = (bf16)f2bf(c0[r]); ((bf16*)C)[(size_t)(T + 16 + 4 * grp + r) * ldc + n] = (bf16)f2bf(c1[r]); }
                    else { C[(size_t)(T + 4 * grp + r) * ldc + n] = c0[r]; C[(size_t)(T + 16 + 4 * grp + r) * ldc + n] = c1[r]; } }
            }
        }
        __syncthreads();
    }
}
__device__ __forceinline__ void ph_gemm_f32(const Fr& F, const bf16* A, const bf16* Bt, int N, int K, float* C, int ldc, int ncols) {
    skinny_gemm(F, A, Bt, K, ncols, C, ldc);
    pg8::Gemm g{A, Bt, T, N, K}; pg8::StaticOrder S; S.init(T, N, F.G, F.bid);
    pg8::EpiF32 E{C, ldc, ncols};
    pg8::gemm_phase<pg8::EpiF32, pg8::StaticOrder, PG8_ALIGN, PG8_SP2>((PG8_LAS unsigned char*)F.lds, g, S, E);
}
__device__ __forceinline__ void ph_gemm_bf16(const Fr& F, const bf16* A, const bf16* Bt, int K, bf16* C) {
    skinny_gemm<false, true>(F, A, Bt, K, DM, (float*)C, DM);
    pg8::Gemm g{A, Bt, T, DM, K}; pg8::StaticOrder S; S.init(T, DM, F.G, F.bid);
    pg8::EpiBf16<0> E{C, DM, nullptr, 0, 0, 1.f};
    pg8::gemm_phase<pg8::EpiBf16<0>, pg8::StaticOrder, PG8_ALIGN, PG8_SP2>((PG8_LAS unsigned char*)F.lds, g, S, E);
}
__device__ __forceinline__ void ph_ln_b(const Fr& F, bf16* XB, const bf16* FB, const float* gam, const float* bet, float* outp, float* outs) {
    const int lane = F.lane;
    for (int r = F.gw; r < TS; r += F.NGW) {
        float v[16]; float s = 0.f;
#pragma unroll
        for (int j = 0; j < 2; ++j) {
            const v4u x = *(const v4u*)(XB + (size_t)r * DM + 512 * j + 8 * lane), f = *(const v4u*)(FB + (size_t)r * DM + 512 * j + 8 * lane);
#pragma unroll
            for (int e = 0; e < 4; ++e) {
                v[8 * j + 2 * e] = DN_ALPHA * __uint_as_float(x[e] << 16) + __uint_as_float(f[e] << 16);
                v[8 * j + 2 * e + 1] = DN_ALPHA * __uint_as_float(x[e] & 0xffff0000u) + __uint_as_float(f[e] & 0xffff0000u);
            }
        }
#pragma unroll
        for (int i = 0; i < 16; ++i) s += v[i];
        const float mean = wave_sum(s) * (1.f / DM); float q = 0.f;
#pragma unroll
        for (int i = 0; i < 16; ++i) { v[i] -= mean; q += v[i] * v[i]; }
        const float rstd = rsqrtf(wave_sum(q) * (1.f / DM) + LN_EPS);
#pragma unroll
        for (int j = 0; j < 2; ++j) {
            const int c0 = 512 * j + 8 * lane;
            const float4 g0 = *(const float4*)(gam + c0), g1 = *(const float4*)(gam + c0 + 4), b0 = *(const float4*)(bet + c0), b1 = *(const float4*)(bet + c0 + 4);
            const float y0 = v[8 * j + 0] * rstd * g0.x + b0.x, y1 = v[8 * j + 1] * rstd * g0.y + b0.y, y2 = v[8 * j + 2] * rstd * g0.z + b0.z, y3 = v[8 * j + 3] * rstd * g0.w + b0.w;
            const float y4 = v[8 * j + 4] * rstd * g1.x + b1.x, y5 = v[8 * j + 5] * rstd * g1.y + b1.y, y6 = v[8 * j + 6] * rstd * g1.z + b1.z, y7 = v[8 * j + 7] * rstd * g1.w + b1.w;
            if (outp) { float* o = ((r < T) ? outp + (size_t)r * DM : outs + (size_t)(r - T) * DM) + c0;
                *(float4*)o = make_float4(y0, y1, y2, y3); *(float4*)(o + 4) = make_float4(y4, y5, y6, y7); }
            else { v4u w; w.x = pk2(y0, y1); w.y = pk2(y2, y3); w.z = pk2(y4, y5); w.w = pk2(y6, y7); *(v4u*)(XB + (size_t)r * DM + c0) = w; }
        }
    }
}
__device__ __forceinline__ float dpp_ror1(float x) { return __int_as_float(__builtin_amdgcn_update_dpp(0, __float_as_int(x), 0x121, 0xf, 0xf, false)); }
__device__ __forceinline__ float dpp_ror2(float x) { return __int_as_float(__builtin_amdgcn_update_dpp(0, __float_as_int(x), 0x122, 0xf, 0xf, false)); }
struct EpiFfn {
    static constexpr bool PERM = true, AFTER_DRAIN = false;
    bf16* H; float* UB; const float* cw; const float* cb;
    __device__ __forceinline__ void operator()(const pg8::f32x4 (&acc)[2][2][4][2], const pg8::Unit& u, int wr, int wc, int fr, int fq) const {
#pragma unroll
        for (int n = 0; n < 2; ++n) {
            const int jc = u.pn * 128 + wc * 32 + 8 * fq + 4 * n;
            pg8::f32x4 w0[2], w1[2], w2[2], bb[2];
#pragma unroll
            for (int bj = 0; bj < 2; ++bj) { const int uc = bj * DFF + jc;
                w0[bj] = *(const pg8::f32x4*)(cw + uc); w1[bj] = *(const pg8::f32x4*)(cw + DFF2 + uc); w2[bj] = *(const pg8::f32x4*)(cw + 2 * DFF2 + uc); bb[bj] = *(const pg8::f32x4*)(cb + uc); }
#pragma unroll
            for (int ai = 0; ai < 2; ++ai) {
                const int sl = u.pm * 4 + ai * 2 + wr;
                pg8::f32x4 pr1[2], pr2[2];
#pragma unroll
                for (int m = 0; m < 4; ++m) {
                    pg8::f32x4 c[2];
#pragma unroll
                    for (int bj = 0; bj < 2; ++bj) {
                        const pg8::f32x4 uu = acc[ai][bj][m][n]; pg8::f32x4 r1, r2;
#pragma unroll
                        for (int e = 0; e < 4; ++e) { r1[e] = dpp_ror1(uu[e]); r2[e] = dpp_ror2(uu[e]); }
                        pg8::f32x4 p1 = r1, p2 = r2;
                        if (m > 0) { if (fr == 0) p1 = pr1[bj]; if (fr < 2) p2 = pr2[bj]; }
                        c[bj] = bb[bj] + w0[bj] * p2 + w1[bj] * p1 + w2[bj] * uu;
                        pr1[bj] = r1; pr2[bj] = r2;
                        const int uc = bj * DFF + jc;
                        if (m == 0 && fr < 2) *(pg8::f32x4*)(UB + ((size_t)sl * 4 + fr) * DFF2 + uc) = uu;
                        if (m == 3 && fr >= 14) *(pg8::f32x4*)(UB + ((size_t)sl * 4 + 2 + (fr - 14)) * DFF2 + uc) = uu;
                    }
                    if (!(m == 0 && fr < 2)) {
                        const int t = u.pm * 256 + ai * 128 + wr * 64 + m * 16 + fr;
                        uint2 o; o.x = pk2(fsilu_(c[0][0]) * c[1][0], fsilu_(c[0][1]) * c[1][1]); o.y = pk2(fsilu_(c[0][2]) * c[1][2], fsilu_(c[0][3]) * c[1][3]);
                        *(uint2*)(H + (size_t)t * DFF + jc) = o;
                    }
                }
            }
        }
    }
};
__device__ __forceinline__ void ph_ffn_gemm(const KP& p, const Fr& F, const bf16* Bt, int layer) {
    skinny_gemm<true>(F, p.ACTB, Bt, DM, DFF2, p.BIGF, DFF2);
    pg8::Gemm g{p.ACTB, Bt, T, DFF2, DM}; pg8::StaticOrder S; S.init(T, DFF2, F.G, F.bid);
    EpiFfn E{p.HFFB, p.UB, p.ffn_cw + (size_t)layer * 3 * DFF2, p.ffn_cb + (size_t)layer * DFF2};
    pg8::gemm_phase<EpiFfn, pg8::StaticOrder, PG8_ALIGN, PG8_SP2>((PG8_LAS unsigned char*)F.lds, g, S, E);
}
__device__ __forceinline__ void ph_ffn_fix(const KP& p, const Fr& F, int layer) {
    const float* cw = p.ffn_cw + (size_t)layer * 3 * DFF2; const float* cb = p.ffn_cb + (size_t)layer * DFF2; const float* U = p.BIGF;
    const int gt = F.bid * NTHR + F.tid, GT = F.G * NTHR;
    for (int idx = gt; idx < 512 * DFF; idx += GT) {
        const int rr = idx / DFF, j = idx - rr * DFF; const int sl = rr >> 1, q = rr & 1;
        float c2[2];
#pragma unroll
        for (int half = 0; half < 2; ++half) { const int ch = half * DFF + j;
            const float u0 = p.UB[((size_t)sl * 4 + q) * DFF2 + ch];
            const float um1 = q ? p.UB[((size_t)sl * 4) * DFF2 + ch] : (sl ? p.UB[((size_t)(sl - 1) * 4 + 3) * DFF2 + ch] : 0.f);
            const float um2 = sl ? p.UB[((size_t)(sl - 1) * 4 + 2 + q) * DFF2 + ch] : 0.f;
            c2[half] = cb[ch] + cw[ch] * um2 + cw[DFF2 + ch] * um1 + cw[2 * DFF2 + ch] * u0; }
        p.HFFB[(size_t)(64 * sl + q) * DFF + j] = (bf16)f2bf(siluf_(c2[0]) * c2[1]);
    }
    for (int idx = gt; idx < NSMP * DFF; idx += GT) {
        const int b = idx / DFF, j = idx - b * DFF;
        float c2[2];
#pragma unroll
        for (int half = 0; half < 2; ++half) { const int ch = half * DFF + j;
            const float* hs = p.st_ffn + (((size_t)b * 2 + layer) * 2) * DFF2 + ch;
            c2[half] = cb[ch] + cw[ch] * hs[0] + cw[DFF2 + ch] * hs[DFF2] + cw[2 * DFF2 + ch] * U[(size_t)(T + b) * DFF2 + ch]; }
        p.HFFB[(size_t)(T + b) * DFF + j] = (bf16)f2bf(siluf_(c2[0]) * c2[1]);
    }
    for (int idx = gt; idx < 2 * DFF2; idx += GT) { const int k = idx / DFF2, ch = idx - k * DFF2;
        p.out[O_FFN_P + ((size_t)layer * 2 + k) * DFF2 + ch] = p.UB[((size_t)255 * 4 + 2 + k) * DFF2 + ch]; }
    for (int idx = gt; idx < NSMP * 2 * DFF2; idx += GT) { const int b = idx / (2 * DFF2), k = (idx / DFF2) & 1, ch = idx % DFF2;
        p.out[O_FFN_S + (((size_t)b * 2 + layer) * 2 + k) * DFF2 + ch] = (k == 0) ? p.st_ffn[(((size_t)b * 2 + layer) * 2 + 1) * DFF2 + ch] : U[(size_t)(T + b) * DFF2 + ch]; }
}
struct EpiCmp {
    static constexpr bool PERM = false, AFTER_DRAIN = false;
    bf16* HID; const float* b1;
    __device__ __forceinline__ void operator()(const pg8::f32x4 (&acc)[2][2][4][2], const pg8::Unit& u, int wr, int wc, int fr, int fq) const {
#pragma unroll
        for (int ai = 0; ai < 2; ++ai)
#pragma unroll
            for (int m = 0; m < 4; ++m) { const int combo = u.pm * 128 + wr * 64 + m * 16 + fr;
#pragma unroll
                for (int n = 0; n < 2; ++n) { const int j0 = wc * 32 + n * 16 + 4 * fq; const pg8::f32x4 v = acc[ai][ai][m][n]; const float* bb = b1 + ai * 128 + j0;
                    uint2 o; o.x = pk2(gelu_tanh(v[0] + bb[0]), gelu_tanh(v[1] + bb[1])); o.y = pk2(gelu_tanh(v[2] + bb[2]), gelu_tanh(v[3] + bb[3]));
                    *(uint2*)(HID + ((size_t)combo * 2 + ai) * 128 + j0) = o; } }
    }
};
__device__ __forceinline__ void ph_cmp_gemm(const KP& p, const Fr& F) {
    pg8::Gemm g{p.AC, p.WT_C, 65536, 256, 2048}; pg8::StaticOrder S; S.init(65536, 256, F.G, F.bid);
    EpiCmp E{p.HID, p.cb1};
    pg8::gemm_phase<EpiCmp, pg8::StaticOrder, PG8_ALIGN, PG8_SP2>((PG8_LAS unsigned char*)F.lds, g, S, E);
}
__device__ __forceinline__ void ph_cmp_stage2(const KP& p, const Fr& F) {
    const int lane = F.lane, l15 = lane & 15, grp = lane >> 4;
    for (int tile = F.gw; tile < 4096; tile += F.NGW) {
        const int kv = tile & 1, combo0 = (tile >> 1) * 16;
        const bf16* hid = p.HID + ((size_t)(combo0 + l15) * 2 + kv) * 128 + 8 * grp; const bf16* w2 = p.W2T + (size_t)kv * 64 * 128 + (size_t)l15 * 128 + 8 * grp;
        f32x4 acc[4];
#pragma unroll
        for (int nt = 0; nt < 4; ++nt) acc[nt] = (f32x4){0.f, 0.f, 0.f, 0.f};
#pragma unroll
        for (int ks = 0; ks < 4; ++ks) { const bf16x8 a = *(const bf16x8*)(hid + 32 * ks);
#pragma unroll
            for (int nt = 0; nt < 4; ++nt) acc[nt] = MFMA16(a, *(const bf16x8*)(w2 + (size_t)nt * 16 * 128 + 32 * ks), acc[nt]); }
#pragma unroll
        for (int r = 0; r < 4; ++r) {
            const int combo = combo0 + 4 * grp + r; const int g = combo & 1, c = (combo >> 1) & 511, b = combo >> 10;
            float* dst = ((kv == 0) ? p.CK : p.CV) + (((size_t)(1 + b) * 512 + c) * 2 + g) * 64;
            if (kv == 0) {
                const int pos = (c + 1) * 32 - 1;
#pragma unroll
                for (int nt = 0; nt < 2; ++nt) { const float2 cs = p.ROPE[pos * 32 + 16 * nt + l15]; const float x1 = acc[nt][r], x2 = acc[nt + 2][r];
                    dst[16 * nt + l15] = x1 * cs.x - x2 * cs.y; dst[16 * (nt + 2) + l15] = x2 * cs.x + x1 * cs.y; }
            } else {
#pragma unroll
                for (int nt = 0; nt < 4; ++nt) dst[16 * nt + l15] = acc[nt][r];
            }
        }
    }
}
__device__ __forceinline__ void cmp_prompt_unit(const KP& p, int unit, int lane) {
    asm volatile("" : "+v"(lane));
    const int l15 = lane & 15, grp = lane >> 4;
    const int kv = unit & 1, combo = (unit >> 1) * 16 + l15; const int g = combo & 1, c = combo >> 1;
    const bf16* w1 = p.WT_C + ((size_t)kv * 128 + l15) * 2048 + 8 * grp;
    f32x4 acc[8];
#pragma unroll
    for (int jt = 0; jt < 8; ++jt) acc[jt] = (f32x4){0.f, 0.f, 0.f, 0.f};
    const bf16* fl = p.ACP + ((size_t)kv * 1024 + combo) * 2048 + 8 * grp;
#pragma unroll 4
    for (int ks = 0; ks < 64; ++ks) {
        const bf16x8 fb = *(const bf16x8*)(fl + 32 * ks);
#pragma unroll
        for (int jt = 0; jt < 8; ++jt) acc[jt] = MFMA16(*(const bf16x8*)(w1 + (size_t)jt * 16 * 2048 + 32 * ks), fb, acc[jt]);
    }
    bf16x8 hb[4];
#pragma unroll
    for (int s2 = 0; s2 < 4; ++s2) {
        f32x4 h0, h1;
#pragma unroll
        for (int r = 0; r < 4; ++r) { h0[r] = gelu_tanh(acc[2 * s2][r] + p.cb1[kv * 128 + 32 * s2 + 4 * grp + r]); h1[r] = gelu_tanh(acc[2 * s2 + 1][r] + p.cb1[kv * 128 + 32 * s2 + 16 + 4 * grp + r]); }
        hb[s2] = pack_p(h0, h1);
    }
    f32x4 o[4];
#pragma unroll
    for (int dt = 0; dt < 4; ++dt) {
        o[dt] = (f32x4){0.f, 0.f, 0.f, 0.f};
        const bf16* w2 = p.W2T + (size_t)kv * 64 * 128 + (size_t)(16 * dt + l15) * 128 + 4 * grp;
#pragma unroll
        for (int s2 = 0; s2 < 4; ++s2) { const uint2 x0 = *(const uint2*)(w2 + 32 * s2), x1 = *(const uint2*)(w2 + 32 * s2 + 16);
            union { v4u u; bf16x8 b; } wa; wa.u.x = x0.x; wa.u.y = x0.y; wa.u.z = x1.x; wa.u.w = x1.y;
            o[dt] = MFMA16(wa.b, hb[s2], o[dt]); }
    }
    if (kv == 0) {
        const int pos = (c + 1) * 32 - 1;
#pragma unroll
        for (int dt = 0; dt < 2; ++dt)
#pragma unroll
            for (int r = 0; r < 4; ++r) { const float2 cs = p.ROPE[pos * 32 + 16 * dt + 4 * grp + r]; const float x1 = o[dt][r], x2 = o[dt + 2][r];
                o[dt][r] = x1 * cs.x - x2 * cs.y; o[dt + 2][r] = x2 * cs.x + x1 * cs.y; }
    }
#pragma unroll
    for (int dt = 0; dt < 4; ++dt)
#pragma unroll
        for (int r = 0; r < 4; ++r) { const int d = 16 * dt + 4 * grp + r;
            if (kv == 0) p.CKF[(size_t)g * 512 * 64 + kfrag_elem(c, d)] = (bf16)f2bf(o[dt][r]); else p.CVF[(size_t)g * 512 * 64 + vfrag_elem(c, d)] = (bf16)f2bf(o[dt][r]); }
}
__device__ __forceinline__ void cmp_sample_unit(const KP& p, int unit, int lane) {
    asm volatile("" : "+v"(lane));
    const int l15 = lane & 15, grp = lane >> 4;
    const int b = unit >> 6, kv = (unit >> 5) & 1, cb = unit & 31;
    const bf16* w1 = p.WT_C + ((size_t)kv * 128 + l15) * 2048 + 8 * grp;
    const float* src[2];
#pragma unroll
    for (int cg = 0; cg < 2; ++cg) { const int combo = cb * 32 + 16 * cg + l15; const int g = combo & 1, c = combo >> 1;
        const int page = p.page_table[b * NPAGES + (c >> 2)];
        src[cg] = p.cache_cmp + (((size_t)page * 128 + (c & 3) * 32) * 4 + kv * 2 + g) * 64 + 8 * grp; }
    const float* pe = p.cpe + (size_t)kv * 32 * 64 + 8 * grp;
    f32x4 acc[2][8];
#pragma unroll
    for (int cg = 0; cg < 2; ++cg)
#pragma unroll
        for (int jt = 0; jt < 8; ++jt) acc[cg][jt] = (f32x4){0.f, 0.f, 0.f, 0.f};
#pragma unroll 2
    for (int ks = 0; ks < 64; ++ks) {
        const int i = ks >> 1, dd = 32 * (ks & 1);
        const float4 e0 = *(const float4*)(pe + i * 64 + dd), e1 = *(const float4*)(pe + i * 64 + dd + 4);
        bf16x8 fb[2];
#pragma unroll
        for (int cg = 0; cg < 2; ++cg) { const float4 a0 = *(const float4*)(src[cg] + i * 256 + dd), a1 = *(const float4*)(src[cg] + i * 256 + dd + 4);
            union { v4u u; bf16x8 b; } t; t.u.x = pk2(a0.x + e0.x, a0.y + e0.y); t.u.y = pk2(a0.z + e0.z, a0.w + e0.w); t.u.z = pk2(a1.x + e1.x, a1.y + e1.y); t.u.w = pk2(a1.z + e1.z, a1.w + e1.w); fb[cg] = t.b; }
#pragma unroll
        for (int jt = 0; jt < 8; ++jt) { const bf16x8 wa = *(const bf16x8*)(w1 + (size_t)jt * 16 * 2048 + 32 * ks);
            acc[0][jt] = MFMA16(wa, fb[0], acc[0][jt]); acc[1][jt] = MFMA16(wa, fb[1], acc[1][jt]); }
    }
#pragma unroll
    for (int cg = 0; cg < 2; ++cg) {
        const int combo = cb * 32 + 16 * cg + l15; const int g = combo & 1, c = combo >> 1;
        bf16x8 hb[4];
#pragma unroll
        for (int s2 = 0; s2 < 4; ++s2) { f32x4 h0, h1;
#pragma unroll
            for (int r = 0; r < 4; ++r) { h0[r] = gelu_tanh(acc[cg][2 * s2][r] + p.cb1[kv * 128 + 32 * s2 + 4 * grp + r]); h1[r] = gelu_tanh(acc[cg][2 * s2 + 1][r] + p.cb1[kv * 128 + 32 * s2 + 16 + 4 * grp + r]); }
            hb[s2] = pack_p(h0, h1); }
        f32x4 o[4];
#pragma unroll
        for (int dt = 0; dt < 4; ++dt) {
            o[dt] = (f32x4){0.f, 0.f, 0.f, 0.f};
            const bf16* w2 = p.W2T + (size_t)kv * 64 * 128 + (size_t)(16 * dt + l15) * 128 + 4 * grp;
#pragma unroll
            for (int s2 = 0; s2 < 4; ++s2) { const uint2 x0 = *(const uint2*)(w2 + 32 * s2), x1 = *(const uint2*)(w2 + 32 * s2 + 16);
                union { v4u u; bf16x8 b; } wa; wa.u.x = x0.x; wa.u.y = x0.y; wa.u.z = x1.x; wa.u.w = x1.y;
                o[dt] = MFMA16(wa.b, hb[s2], o[dt]); }
        }
        if (kv == 0) {
            const int pos = (c + 1) * 32 - 1;
#pragma unroll
            for (int dt = 0; dt < 2; ++dt)
#pragma unroll
                for (int r = 0; r < 4; ++r) { const float2 cs = p.ROPE[pos * 32 + 16 * dt + 4 * grp + r]; const float x1 = o[dt][r], x2 = o[dt + 2][r];
                    o[dt][r] = x1 * cs.x - x2 * cs.y; o[dt + 2][r] = x2 * cs.x + x1 * cs.y; }
        }
        float* dst = ((kv == 0) ? p.CK : p.CV) + (((size_t)(1 + b) * 512 + c) * 2 + g) * 64 + 4 * grp;
#pragma unroll
        for (int dt = 0; dt < 4; ++dt) *(f32x4*)(dst + 16 * dt) = o[dt];
    }
}
constexpr int W1S_PITCH = 528;
constexpr int W1S_BYTES = 128 * W1S_PITCH;
__device__ __forceinline__ void cmp_sample_wg(const KP& p, int wu, const Fr& F) {
    int lane = F.lane; asm volatile("" : "+v"(lane));
    const int l15 = lane & 15, grp = lane >> 4, tid = F.tid;
    const int b = wu >> 3, kv = (wu >> 2) & 1, q4 = wu & 3;
    const float* src[2];
#pragma unroll
    for (int cg = 0; cg < 2; ++cg) { const int combo = q4 * 256 + F.wave * 32 + 16 * cg + l15; const int g = combo & 1, c = combo >> 1;
        const int page = p.page_table[b * NPAGES + (c >> 2)];
        src[cg] = p.cache_cmp + (((size_t)page * 128 + (c & 3) * 32) * 4 + kv * 2 + g) * 64 + 8 * grp; }
    const float* pe = p.cpe + (size_t)kv * 32 * 64 + 8 * grp;
    const bf16* wg = p.WT_C + (size_t)kv * 128 * 2048;
    f32x4 acc[2][8];
#pragma unroll
    for (int cg = 0; cg < 2; ++cg)
#pragma unroll
        for (int jt = 0; jt < 8; ++jt) acc[cg][jt] = (f32x4){0.f, 0.f, 0.f, 0.f};
    v4u wreg[8];
#pragma unroll
    for (int k = 0; k < 8; ++k) { const int c = tid + 512 * k; wreg[k] = *(const v4u*)(wg + (size_t)(c >> 5) * 2048 + (c & 31) * 8); }
#pragma unroll
    for (int k = 0; k < 8; ++k) { const int c = tid + 512 * k; *(v4u*)(F.lds + (c >> 5) * W1S_PITCH + (c & 31) * 16) = wreg[k]; }
    __syncthreads();
#pragma unroll 1
    for (int sl = 0; sl < 8; ++sl) {
        if (sl + 1 < 8) {
#pragma unroll
            for (int k = 0; k < 8; ++k) { const int c = tid + 512 * k; wreg[k] = *(const v4u*)(wg + (size_t)(c >> 5) * 2048 + (sl + 1) * 256 + (c & 31) * 8); }
        }
        const unsigned char* wl = F.lds + (sl & 1) * W1S_BYTES + l15 * W1S_PITCH + grp * 16;
#pragma unroll 2
        for (int kk = 0; kk < 8; ++kk) {
            const int ks = sl * 8 + kk, i = ks >> 1, dd = 32 * (ks & 1);
            const float4 e0 = *(const float4*)(pe + i * 64 + dd), e1 = *(const float4*)(pe + i * 64 + dd + 4);
            bf16x8 fb[2];
#pragma unroll
            for (int cg = 0; cg < 2; ++cg) { const float4 a0 = *(const float4*)(src[cg] + i * 256 + dd), a1 = *(const float4*)(src[cg] + i * 256 + dd + 4);
                union { v4u u; bf16x8 b; } t; t.u.x = pk2(a0.x + e0.x, a0.y + e0.y); t.u.y = pk2(a0.z + e0.z, a0.w + e0.w); t.u.z = pk2(a1.x + e1.x, a1.y + e1.y); t.u.w = pk2(a1.z + e1.z, a1.w + e1.w); fb[cg] = t.b; }
#pragma unroll
            for (int jt = 0; jt < 8; ++jt) { const bf16x8 wa = *(const bf16x8*)(wl + jt * 16 * W1S_PITCH + kk * 64);
                acc[0][jt] = MFMA16(wa, fb[0], acc[0][jt]); acc[1][jt] = MFMA16(wa, fb[1], acc[1][jt]); }
        }
        if (sl + 1 < 8) {
#pragma unroll
            for (int k = 0; k < 8; ++k) { const int c = tid + 512 * k; *(v4u*)(F.lds + ((sl + 1) & 1) * W1S_BYTES + (c >> 5) * W1S_PITCH + (c & 31) * 16) = wreg[k]; }
        }
        __syncthreads();
    }
#pragma unroll
    for (int cg = 0; cg < 2; ++cg) {
        const int combo = q4 * 256 + F.wave * 32 + 16 * cg + l15; const int g = combo & 1, c = combo >> 1;
        bf16x8 hb[4];
#pragma unroll
        for (int s2 = 0; s2 < 4; ++s2) { f32x4 h0, h1;
#pragma unroll
            for (int r = 0; r < 4; ++r) { h0[r] = gelu_tanh(acc[cg][2 * s2][r] + p.cb1[kv * 128 + 32 * s2 + 4 * grp + r]); h1[r] = gelu_tanh(acc[cg][2 * s2 + 1][r] + p.cb1[kv * 128 + 32 * s2 + 16 + 4 * grp + r]); }
            hb[s2] = pack_p(h0, h1); }
        f32x4 o[4];
#pragma unroll
        for (int dt = 0; dt < 4; ++dt) {
            o[dt] = (f32x4){0.f, 0.f, 0.f, 0.f};
            const bf16* w2 = p.W2T + (size_t)kv * 64 * 128 + (size_t)(16 * dt + l15) * 128 + 4 * grp;
#pragma unroll
            for (int s2 = 0; s2 < 4; ++s2) { const uint2 x0 = *(const uint2*)(w2 + 32 * s2), x1 = *(const uint2*)(w2 + 32 * s2 + 16);
                union { v4u u; bf16x8 b; } wa; wa.u.x = x0.x; wa.u.y = x0.y; wa.u.z = x1.x; wa.u.w = x1.y;
                o[dt] = MFMA16(wa.b, hb[s2], o[dt]); }
        }
        if (kv == 0) {
            const int pos = (c + 1) * 32 - 1;
#pragma unroll
            for (int dt = 0; dt < 2; ++dt)
#pragma unroll
                for (int r = 0; r < 4; ++r) { const float2 cs = p.ROPE[pos * 32 + 16 * dt + 4 * grp + r]; const float x1 = o[dt][r], x2 = o[dt + 2][r];
                    o[dt][r] = x1 * cs.x - x2 * cs.y; o[dt + 2][r] = x2 * cs.x + x1 * cs.y; }
        }
        float* dst = ((kv == 0) ? p.CK : p.CV) + (((size_t)(1 + b) * 512 + c) * 2 + g) * 64 + 4 * grp;
#pragma unroll
        for (int dt = 0; dt < 4; ++dt) *(f32x4*)(dst + 16 * dt) = o[dt];
    }
}
__device__ __forceinline__ void ph_cmp_samples(const KP& p, const Fr& F) {
    for (int wu = F.bid; wu < 256; wu += F.G) cmp_sample_wg(p, wu, F);
}
__device__ __forceinline__ void ph_cmp_prompt(const KP& p, const Fr& F) {
    for (int unit = F.gw; unit < 128; unit += F.NGW) cmp_prompt_unit(p, unit, F.lane);
}

__device__ __forceinline__ float rope_val(const float* row, int base, int i, float2 cs) {
    const int ii = i & 31;
    const float x1 = row[base + ii], x2 = row[base + ii + 32];
    return (i < 32) ? (x1 * cs.x - x2 * cs.y) : (x2 * cs.x + x1 * cs.y);
}
__device__ __forceinline__ void ph_nsa_prep(const KP& p, const Fr& F) {
    const float* H0 = p.BIGF; float* out = p.out;
    const size_t gt = (size_t)F.bid * NTHR + F.tid, GT = (size_t)F.G * NTHR;
    const size_t total = (size_t)TS * 1280;
    for (size_t idx = gt + (size_t)T * 1280; idx < total; idx += GT) {
        const int r = (int)(idx / 1280), c = (int)(idx % 1280);
        const bool smp = r >= T; const int b = r - T; const int pos = smp ? T : r;
        const float* row = H0 + (size_t)r * PA;
        const int i = c & 63;
        const float2 cs = p.ROPE[pos * 32 + (i & 31)];
        if (c < 512) { p.QR[(size_t)r * 512 + c] = rope_val(row, c & ~63, i, cs); continue; }
        const int sec = (c - 512) >> 7; const int gd = (c - 512) & 127; const int base = c & ~63;
        float v;
        if (sec == 2 || sec == 4) v = rope_val(row, base, i, cs); else v = row[c];
        const int kv = sec & 1;
        if (sec < 2) {
            if (!smp) out[O_CMP_P + (size_t)r * 256 + kv * 128 + gd] = v; else out[O_CMP_S + (size_t)b * 256 + kv * 128 + gd] = v;
        } else if (sec < 4) {
            if (!smp) out[O_SLC_P + (size_t)r * 256 + kv * 128 + gd] = v; else out[O_SLC_S + (size_t)b * 256 + kv * 128 + gd] = v;
            if (kv == 0) p.KS[(size_t)r * 128 + gd] = v; else p.VS[(size_t)r * 128 + gd] = v;
        } else {
            if (kv == 0) p.KW[(size_t)r * 128 + gd] = v; else p.VW[(size_t)r * 128 + gd] = v;
            if (!smp) { if (r >= T - 512) out[O_WIN_P + (size_t)(r - (T - 512)) * 256 + kv * 128 + gd] = v; }
            else out[O_WIN_S + ((size_t)b * 512 + 511) * 256 + kv * 128 + gd] = v;
        }
    }
    const size_t tot2 = (size_t)NSMP * 511 * 256;
    for (size_t idx = gt; idx < tot2; idx += GT) {
        const int b = (int)(idx / (511 * 256)); const int rem = (int)(idx % (511 * 256));
        out[O_WIN_S + (size_t)b * 512 * 256 + rem] = p.st_win[(size_t)b * 512 * 256 + 256 + rem];
    }
}

constexpr float QSCALE = 0.18033688011112042f;

__device__ __forceinline__ size_t kfrag_off(int kt, int ks, int lane) { return ((size_t)(kt * 2 + ks) * 64 + lane) * 8; }
__device__ __forceinline__ size_t vfrag_off(int st, int dt, int lane) { return ((size_t)(st * 4 + dt) * 64 + lane) * 8; }
__device__ __forceinline__ size_t vfrag_elem(int key, int d) {
    const int st = key >> 5, kk = key & 31, tile = kk >> 4, r16 = kk & 15, grp = r16 >> 2, reg = r16 & 3;
    return ((size_t)(st * 4 + (d >> 4)) * 64 + (d & 15) + 16 * grp) * 8 + tile * 4 + reg;
}
__device__ __forceinline__ size_t k8_off(int key, int d) { return ((size_t)(key >> 4) * 64 + (key & 15) + 16 * ((d & 31) >> 3)) * 16 + (d >> 5) * 8 + (d & 7); }
__device__ __forceinline__ size_t v8_off(int key, int d) {
    const int blk = key >> 6, st = (key >> 5) & 1, kk = key & 31, tile = kk >> 4, r16 = kk & 15, grp = r16 >> 2, reg = r16 & 3;
    return ((size_t)(blk * 4 + (d >> 4)) * 64 + (d & 15) + 16 * grp) * 16 + st * 8 + tile * 4 + reg;
}
__device__ __forceinline__ size_t kfrag_elem(int key, int d) {
    return ((size_t)((key >> 4) * 2 + (d >> 5)) * 64 + (key & 15) + 16 * ((d & 31) >> 3)) * 8 + (d & 7);
}

__device__ __forceinline__ void ph_nsa_prep_fast(const KP& p, const Fr& F) {
    const float* H0 = p.BIGF; float* out = p.out;
    const size_t gt = (size_t)F.bid * NTHR + F.tid, GT = (size_t)F.G * NTHR;
    for (size_t idx = gt; idx < (size_t)T * 160; idx += GT) {
        const int t = (int)(idx / 160), u = (int)(idx % 160);
        const int c0 = u * 8; const float* row = H0 + (size_t)t * PA;
        const float4 a0 = *(const float4*)(row + c0), a1 = *(const float4*)(row + c0 + 4);
        float v[8] = {a0.x, a0.y, a0.z, a0.w, a1.x, a1.y, a1.z, a1.w};
        const int sec = (u < 64) ? -1 : ((u - 64) >> 4);
        const bool roped = (sec == -1 || sec == 2 || sec == 4);
        if (roped) {
            const int d0 = c0 & 63; const int pc = (d0 < 32) ? c0 + 32 : c0 - 32;
            const float4 b0 = *(const float4*)(row + pc), b1 = *(const float4*)(row + pc + 4);
            const float w[8] = {b0.x, b0.y, b0.z, b0.w, b1.x, b1.y, b1.z, b1.w};
            const float4* rp = (const float4*)(p.ROPE + t * 32 + (d0 & 31)); const float4 r0 = rp[0], r1 = rp[1], r2 = rp[2], r3 = rp[3];
            const float cs[8] = {r0.x, r0.z, r1.x, r1.z, r2.x, r2.z, r3.x, r3.z}, sn[8] = {r0.y, r0.w, r1.y, r1.w, r2.y, r2.w, r3.y, r3.w};
#pragma unroll
            for (int j = 0; j < 8; ++j) v[j] = (d0 < 32) ? (v[j] * cs[j] - w[j] * sn[j]) : (v[j] * cs[j] + w[j] * sn[j]);
        }
        if (sec == -1) {
            v4u o; o.x = pk2(v[0] * QSCALE, v[1] * QSCALE); o.y = pk2(v[2] * QSCALE, v[3] * QSCALE); o.z = pk2(v[4] * QSCALE, v[5] * QSCALE); o.w = pk2(v[6] * QSCALE, v[7] * QSCALE);
            *(v4u*)(p.QB + (size_t)t * 512 + c0) = o; continue;
        }
        const int gd = (c0 - 512) & 127, g = gd >> 6, d0 = gd & 63, kv = sec & 1;
        const float4 o0 = make_float4(v[0], v[1], v[2], v[3]), o1 = make_float4(v[4], v[5], v[6], v[7]);
        if (sec < 2) { float* o = out + O_CMP_P + (size_t)t * 256 + kv * 128 + gd; *(float4*)o = o0; *(float4*)(o + 4) = o1;
            const int i = t & 31; const float* pe = p.cpe + (kv * 32 + i) * 64 + d0; const float4 e0 = *(const float4*)pe, e1 = *(const float4*)(pe + 4);
            v4u w; w.x = pk2(v[0] + e0.x, v[1] + e0.y); w.y = pk2(v[2] + e0.z, v[3] + e0.w); w.z = pk2(v[4] + e1.x, v[5] + e1.y); w.w = pk2(v[6] + e1.z, v[7] + e1.w);
            *(v4u*)(p.ACP + ((size_t)kv * 1024 + (t >> 5) * 2 + g) * 2048 + i * 64 + d0) = w; continue; }
        if (sec < 4) { float* o = out + O_SLC_P + (size_t)t * 256 + kv * 128 + gd; *(float4*)o = o0; *(float4*)(o + 4) = o1; }
        else if (t >= T - 512) { float* o = out + O_WIN_P + (size_t)(t - (T - 512)) * 256 + kv * 128 + gd; *(float4*)o = o0; *(float4*)(o + 4) = o1; }
        if (sec < 4) {
            if (kv == 0) {
                int w0 = 0, w1 = 0;
                w0 = __builtin_amdgcn_cvt_pk_fp8_f32(v[0], v[1], w0, false); w0 = __builtin_amdgcn_cvt_pk_fp8_f32(v[2], v[3], w0, true);
                w1 = __builtin_amdgcn_cvt_pk_fp8_f32(v[4], v[5], w1, false); w1 = __builtin_amdgcn_cvt_pk_fp8_f32(v[6], v[7], w1, true);
                *(uint2*)(p.KS8 + (size_t)g * T * 64 + k8_off(t, d0)) = make_uint2((unsigned)w0, (unsigned)w1);
            } else {
#pragma unroll
                for (int j = 0; j < 8; ++j) p.VS8[(size_t)g * T * 64 + v8_off(t, d0 + j)] = (unsigned char)(__builtin_amdgcn_cvt_pk_fp8_f32(v[j], 0.f, 0, false) & 0xff);
            }
            continue;
        }
        bf16* KF = p.KWF; bf16* VF = p.VWF;
        if (kv == 0) {
            v4u o; o.x = pk2(v[0], v[1]); o.y = pk2(v[2], v[3]); o.z = pk2(v[4], v[5]); o.w = pk2(v[6], v[7]);
            *(v4u*)(KF + (size_t)g * T * 64 + kfrag_elem(t, d0)) = o;
        } else {
#pragma unroll
            for (int j = 0; j < 8; ++j) VF[(size_t)g * T * 64 + vfrag_elem(t, d0 + j)] = (bf16)f2bf(v[j]);
        }
    }
}

struct AttW { f32x4 o[4]; float m, l; };
__device__ __forceinline__ void attw_init(AttW& a) {
#pragma unroll
    for (int i = 0; i < 4; ++i) a.o[i] = (f32x4){0.f, 0.f, 0.f, 0.f};
    a.m = -INFINITY; a.l = 0.f;
}
__device__ __forceinline__ void qk_step(const bf16x8 (&kf)[2][2], const bf16x8 (&qf)[2], f32x4& s0, f32x4& s1) {
    const f32x4 z = {0.f, 0.f, 0.f, 0.f};
    s0 = MFMA16(kf[0][0], qf[0], z); s0 = MFMA16(kf[0][1], qf[1], s0);
    s1 = MFMA16(kf[1][0], qf[0], z); s1 = MFMA16(kf[1][1], qf[1], s1);
}
__device__ __forceinline__ bf16x8 pack_p(const f32x4& p0, const f32x4& p1) {
    union { v4u u; bf16x8 b; } c;
    c.u.x = pg8::cvt_pk_bf16(p0[0], p0[1]); c.u.y = pg8::cvt_pk_bf16(p0[2], p0[3]); c.u.z = pg8::cvt_pk_bf16(p1[0], p1[1]); c.u.w = pg8::cvt_pk_bf16(p1[2], p1[3]);
    return c.b;
}
__device__ __forceinline__ void att_update(AttW& a, const f32x4& s0, const f32x4& s1, const bf16x8 (&vf)[4]) {
    float mx = fmaxf(fmaxf(fmaxf(s0[0], s0[1]), fmaxf(s0[2], s0[3])), fmaxf(fmaxf(s1[0], s1[1]), fmaxf(s1[2], s1[3])));
    mx = fmaxf(mx, __shfl_xor(mx, 16)); mx = fmaxf(mx, __shfl_xor(mx, 32));
    const float mn = fmaxf(a.m, mx);
    const float ms = (mn == -INFINITY) ? 0.f : mn;
    const float alpha = __builtin_amdgcn_exp2f(a.m - ms);
    f32x4 p0, p1;
#pragma unroll
    for (int i = 0; i < 4; ++i) { p0[i] = __builtin_amdgcn_exp2f(s0[i] - ms); p1[i] = __builtin_amdgcn_exp2f(s1[i] - ms); }
    a.l = a.l * alpha + ((p0[0] + p0[1]) + (p0[2] + p0[3])) + ((p1[0] + p1[1]) + (p1[2] + p1[3]));
    a.m = mn;
    const bf16x8 pf = pack_p(p0, p1);
#pragma unroll
    for (int dt = 0; dt < 4; ++dt) { a.o[dt] = a.o[dt] * alpha; a.o[dt] = MFMA16(vf[dt], pf, a.o[dt]); }
}
__device__ __forceinline__ float grp_sum(float v) { v += __shfl_xor(v, 16); v += __shfl_xor(v, 32); return v; }

__device__ __forceinline__ void nsa_fast_unit(const KP& p, int unit, float* wl, int lane) {
    asm volatile("" : "+v"(lane));
    const int g = unit & 1, t0 = (unit >> 1) * 16;
    const int qi = lane & 15, grp = lane >> 4, t = t0 + qi;
    float* imp = wl; int* sel = (int*)(wl + 4096);
    const float* grow = p.BIGF + (size_t)t * PA + C_GATE + g * 4;
    bf16x8 qf[4][2];
#pragma unroll
    for (int h = 0; h < 4; ++h)
#pragma unroll
        for (int ks = 0; ks < 2; ++ks) qf[h][ks] = *(const bf16x8*)(p.QB + (size_t)t * 512 + (g * 4 + h) * 64 + 32 * ks + 8 * grp);
    AttW st[4];
    {
        const bf16* CKF = p.CKF + (size_t)g * 512 * 64; const bf16* CVF = p.CVF + (size_t)g * 512 * 64;
        const int nmax = (t0 + 16) >> 5; const int nsteps = (nmax + 31) >> 5;
        const int nval = (t + 1) >> 5;
        float m[4], l[4];
#pragma unroll
        for (int h = 0; h < 4; ++h) { m[h] = -INFINITY; l[h] = 0.f; }
        for (int s = 0; s < nsteps; ++s) {
            bf16x8 kf[2][2];
#pragma unroll
            for (int tl = 0; tl < 2; ++tl)
#pragma unroll
                for (int ks = 0; ks < 2; ++ks) kf[tl][ks] = *(const bf16x8*)(CKF + kfrag_off(2 * s + tl, ks, lane));
            const int cb = 32 * s + 4 * grp;
#pragma unroll
            for (int h = 0; h < 4; ++h) {
                f32x4 s0, s1; qk_step(kf, qf[h], s0, s1);
#pragma unroll
                for (int i = 0; i < 4; ++i) { if (cb + i >= nval) s0[i] = -INFINITY; if (cb + 16 + i >= nval) s1[i] = -INFINITY; }
                float mx = fmaxf(fmaxf(fmaxf(s0[0], s0[1]), fmaxf(s0[2], s0[3])), fmaxf(fmaxf(s1[0], s1[1]), fmaxf(s1[2], s1[3])));
                mx = fmaxf(mx, __shfl_xor(mx, 16)); mx = fmaxf(mx, __shfl_xor(mx, 32));
                const float mn = fmaxf(m[h], mx); const float ms = (mn == -INFINITY) ? 0.f : mn;
                float sum = 0.f;
#pragma unroll
                for (int i = 0; i < 4; ++i) sum += __builtin_amdgcn_exp2f(s0[i] - ms) + __builtin_amdgcn_exp2f(s1[i] - ms);
                l[h] = l[h] * __builtin_amdgcn_exp2f(m[h] - ms) + sum; m[h] = mn;
            }
        }
        float il[4];
#pragma unroll
        for (int h = 0; h < 4; ++h) { const float lt = grp_sum(l[h]); il[h] = lt > 0.f ? 1.f / lt : 0.f; if (m[h] == -INFINITY) m[h] = 0.f; attw_init(st[h]); }
        for (int s = 0; s < nsteps; ++s) {
            bf16x8 kf[2][2], vf[4];
#pragma unroll
            for (int tl = 0; tl < 2; ++tl)
#pragma unroll
                for (int ks = 0; ks < 2; ++ks) kf[tl][ks] = *(const bf16x8*)(CKF + kfrag_off(2 * s + tl, ks, lane));
#pragma unroll
            for (int dt = 0; dt < 4; ++dt) vf[dt] = *(const bf16x8*)(CVF + vfrag_off(s, dt, lane));
            const int cb = 32 * s + 4 * grp;
            float i4[4] = {0.f, 0.f, 0.f, 0.f};
#pragma unroll
            for (int h = 0; h < 4; ++h) {
                f32x4 s0, s1; qk_step(kf, qf[h], s0, s1);
                f32x4 p0, p1;
#pragma unroll
                for (int i = 0; i < 4; ++i) {
                    p0[i] = (cb + i < nval) ? __builtin_amdgcn_exp2f(s0[i] - m[h]) * il[h] : 0.f;
                    p1[i] = (cb + 16 + i < nval) ? __builtin_amdgcn_exp2f(s1[i] - m[h]) * il[h] : 0.f; }
                i4[0] += p0[0] + p0[1]; i4[1] += p0[2] + p0[3]; i4[2] += p1[0] + p1[1]; i4[3] += p1[2] + p1[3];
                const bf16x8 pf = pack_p(p0, p1);
#pragma unroll
                for (int dt = 0; dt < 4; ++dt) st[h].o[dt] = MFMA16(vf[dt], pf, st[h].o[dt]);
            }
            *(float2*)(imp + qi * 256 + 16 * s + 2 * grp) = make_float2(i4[0], i4[1]);
            *(float2*)(imp + qi * 256 + 16 * s + 8 + 2 * grp) = make_float2(i4[2], i4[3]);
        }
        wave_lds_sync();
    }
    const int cur = t0 >> 6;
    {
        if (cur + 1 <= 16) {
            for (int idx = lane; idx < 256; idx += 64) sel[idx] = ((idx & 15) <= cur) ? (idx & 15) : -1;
        } else {
            for (int q0 = 0; q0 < 16; q0 += 4) {
                unsigned key[4][4];
#pragma unroll
                for (int qq = 0; qq < 4; ++qq)
#pragma unroll
                    for (int j = 0; j < 4; ++j) { const int blk = lane + 64 * j; const float v = imp[(q0 + qq) * 256 + blk];
                        key[qq][j] = (blk >= 1 && blk <= cur - 2) ? ((__float_as_uint(v) & 0xFFFFFF00u) | (unsigned)(255 - blk)) : 0u; }
                if (lane < 4) { sel[(q0 + lane) * 16 + 0] = 0; sel[(q0 + lane) * 16 + 1] = cur; sel[(q0 + lane) * 16 + 2] = cur - 1; }
                for (int n = 3; n < 16; ++n) {
                    unsigned best[4];
#pragma unroll
                    for (int qq = 0; qq < 4; ++qq) best[qq] = max(max(key[qq][0], key[qq][1]), max(key[qq][2], key[qq][3]));
#pragma unroll
                    for (int o = 1; o < 64; o <<= 1) {
#pragma unroll
                        for (int qq = 0; qq < 4; ++qq) best[qq] = max(best[qq], (unsigned)__shfl_xor((int)best[qq], o));
                    }
#pragma unroll
                    for (int qq = 0; qq < 4; ++qq) {
                        const int blk = 255 - (int)(best[qq] & 255u);
#pragma unroll
                        for (int j = 0; j < 4; ++j) if (lane + 64 * j == blk) key[qq][j] = 0u;
                        if (lane == 0) sel[(q0 + qq) * 16 + n] = blk;
                    }
                }
            }
        }
        wave_lds_sync();
    }
    float* acc = wl;
    {
#pragma unroll
        for (int h = 0; h < 4; ++h) { const float gs = sigmoidf_(grow[h]);
#pragma unroll
            for (int dt = 0; dt < 4; ++dt) *(f32x4*)(acc + (qi * 4 + h) * 64 + 16 * dt + 4 * grp) = st[h].o[dt] * gs; }
        wave_lds_sync();
    }
    {
        const bf16* KF = p.KWF + (size_t)g * T * 64; const bf16* VF = p.VWF + (size_t)g * T * 64;
        int kstart = t0 - 512; if (kstart < 0) kstart = 0; kstart &= ~31;
        const int nsteps = (t0 + 16 - kstart + 31) >> 5;
#pragma unroll
        for (int h = 0; h < 4; ++h) attw_init(st[h]);
        auto issue = [&](int s_, bf16x8 (&K)[2][2], bf16x8 (&V)[4]) {
            const int k0 = kstart + 32 * s_;
#pragma unroll
            for (int tl = 0; tl < 2; ++tl)
#pragma unroll
                for (int ks = 0; ks < 2; ++ks) K[tl][ks] = *(const bf16x8*)(KF + kfrag_off((k0 >> 4) + tl, ks, lane));
#pragma unroll
            for (int dt = 0; dt < 4; ++dt) V[dt] = *(const bf16x8*)(VF + vfrag_off(k0 >> 5, dt, lane));
        };
        auto compute = [&](int s_, const bf16x8 (&K)[2][2], const bf16x8 (&V)[4]) {
            const int k0 = kstart + 32 * s_;
            const bool need_mask = (k0 + 31 > t0) || (k0 < t0 + 15 - 512);
            const int pb = k0 + 4 * grp;
#pragma unroll
            for (int h = 0; h < 4; ++h) {
                f32x4 s0, s1; qk_step(K, qf[h], s0, s1);
                if (need_mask) {
#pragma unroll
                    for (int i = 0; i < 4; ++i) { const int p0 = pb + i, p1 = pb + 16 + i;
                        if (p0 > t || p0 < t - 512) s0[i] = -INFINITY; if (p1 > t || p1 < t - 512) s1[i] = -INFINITY; }
                }
                att_update(st[h], s0, s1, V);
            }
        };
        bf16x8 kA[2][2], vA[4], kB[2][2], vB[4];
        issue(0, kA, vA);
        for (int s = 0; s < nsteps; s += 2) {
            if (s + 1 < nsteps) issue(s + 1, kB, vB);
            compute(s, kA, vA);
            if (s + 1 < nsteps) { if (s + 2 < nsteps) issue(s + 2, kA, vA); compute(s + 1, kB, vB); }
        }
#pragma unroll
        for (int h = 0; h < 4; ++h) { const float lt = grp_sum(st[h].l); const float gs = sigmoidf_(grow[16 + h]) * (lt > 0.f ? 1.f / lt : 0.f);
#pragma unroll
            for (int dt = 0; dt < 4; ++dt) { f32x4* a = (f32x4*)(acc + (qi * 4 + h) * 64 + 16 * dt + 4 * grp); *a = *a + st[h].o[dt] * gs; } }
        wave_lds_sync();
    }
    *(int4*)(p.SEL + ((size_t)g * T + t0) * 16 + lane * 4) = *(const int4*)(sel + lane * 4);
#pragma unroll 4
    for (int q = 0; q < 16; ++q) *(f32x4*)(p.NSACC + (size_t)(t0 + q) * 512 + g * 256 + 4 * lane) = *(const f32x4*)(acc + q * 256 + 4 * lane);
    wave_lds_sync();
}

__device__ __forceinline__ void nsa_slc_item(const KP& p, int tq, int g, int lane) {
    asm volatile("" : "+v"(lane));
    const int l15 = lane & 15, grp = lane >> 4, hn = lane & 3;
    const bf16* KF = p.KSF + (size_t)g * T * 64; const bf16* VF = p.VSF + (size_t)g * T * 64;
    const int* selp = p.SEL + ((size_t)g * T + tq) * 16;
    int sb[16];
#pragma unroll
    for (int i = 0; i < 16; ++i) sb[i] = __builtin_amdgcn_readfirstlane(selp[i]);
    bf16x8 qs[2];
#pragma unroll
    for (int ks = 0; ks < 2; ++ks) qs[ks] = *(const bf16x8*)(p.QB + (size_t)tq * 512 + (g * 4 + hn) * 64 + 32 * ks + 8 * grp);
    AttW a; attw_init(a);
    bf16x8 kf[2][2][2], vf[2][4];
    auto issue = [&](int i, int buf) {
        const int blk = sb[i >> 1]; int k0 = blk * 64 + 32 * (i & 1); if (blk < 0 || k0 > tq) k0 = 0;
#pragma unroll
        for (int tl = 0; tl < 2; ++tl)
#pragma unroll
            for (int ks = 0; ks < 2; ++ks) kf[buf][tl][ks] = *(const bf16x8*)(KF + kfrag_off((k0 >> 4) + tl, ks, lane));
#pragma unroll
        for (int dt = 0; dt < 4; ++dt) vf[buf][dt] = *(const bf16x8*)(VF + vfrag_off(k0 >> 5, dt, lane));
    };
    issue(0, 0);
#pragma unroll
    for (int i = 0; i < 32; ++i) {
        const int buf = i & 1;
        if (i + 1 < 32) issue(i + 1, buf ^ 1);
        const int blk = sb[i >> 1]; const int k0 = blk * 64 + 32 * (i & 1);
        const bool dead = (blk < 0) || (k0 > tq);
        f32x4 s0, s1; qk_step(kf[buf], qs, s0, s1);
        const int pb = k0 + 4 * grp;
#pragma unroll
        for (int j = 0; j < 4; ++j) { if (dead || pb + j > tq) s0[j] = -INFINITY; if (dead || pb + 16 + j > tq) s1[j] = -INFINITY; }
        att_update(a, s0, s1, vf[buf]);
    }
    const float lt = grp_sum(a.l);
    if (l15 < 4) {
        const float gs = sigmoidf_(p.BIGF[(size_t)tq * PA + C_GATE + 8 + g * 4 + l15]) * (lt > 0.f ? 1.f / lt : 0.f);
#pragma unroll
        for (int dt = 0; dt < 4; ++dt) {
            const size_t o = (size_t)tq * 512 + g * 256 + l15 * 64 + 16 * dt + 4 * grp;
            const f32x4 base = *(const f32x4*)(p.NSACC + o); const f32x4 v = base + a.o[dt] * gs;
            uint2 w; w.x = pk2(v[0], v[1]); w.y = pk2(v[2], v[3]);
            *(uint2*)(p.MIXB + (size_t)tq * 1024 + g * 256 + l15 * 64 + 16 * dt + 4 * grp) = w;
        }
    }
}

__device__ __forceinline__ void ph_compress(const KP& p, const Fr& F) {
    float* flat = (float*)F.lds;
    float* hid = (float*)(F.lds + 32768);
    float* res = (float*)(F.lds + 32768 + 2048);
    const float* H0 = p.BIGF;
    const int tid = F.tid;
    for (int item = F.bid; item < 512; item += F.G) {
        const int c = item & 511, s = item >> 9;
        for (int e = tid; e < 8192; e += NTHR) {
            const int kv = e >> 12, g = (e >> 11) & 1, k = e & 2047, i = k >> 6, d = k & 63;
            const int row = c * 32 + i;
            float v;
            if (s == 0) v = H0[(size_t)row * PA + C_KC + kv * 128 + g * 64 + d];
            else { const int b = s - 1; const int page = p.page_table[b * NPAGES + (row >> 7)];
                   v = p.cache_cmp[((((size_t)page * 128 + (row & 127)) * 2 + kv) * 2 + g) * 64 + d]; }
            flat[e] = v + p.cpe[(kv * 32 + i) * 64 + d];
        }
        __syncthreads();
        {
            const int kv = tid >> 8, g = (tid >> 7) & 1, j = tid & 127;
            const float* w = p.cw1 + (size_t)kv * 2048 * 128 + j;
            const float* fl = flat + (kv * 2 + g) * 2048;
            float acc = p.cb1[kv * 128 + j];
            for (int k = 0; k < 2048; ++k) acc += fl[k] * w[(size_t)k * 128];
            hid[(kv * 2 + g) * 128 + j] = gelu_tanh(acc);
        }
        __syncthreads();
        if (tid < 256) {
            const int kv = tid >> 7, g = (tid >> 6) & 1, d = tid & 63;
            const float* w = p.cw2 + (size_t)kv * 128 * 64 + d;
            const float* hh = hid + (kv * 2 + g) * 128;
            float acc = 0.f;
            for (int j = 0; j < 128; ++j) acc += hh[j] * w[j * 64];
            res[(kv * 2 + g) * 64 + d] = acc;
        }
        __syncthreads();
        if (tid < 256) {
            const int kv = tid >> 7, g = (tid >> 6) & 1, d = tid & 63;
            const float* rr = res + (kv * 2 + g) * 64;
            float v = rr[d];
            if (kv == 0) {
                const int pos = (c + 1) * 32 - 1; const float2 cs = p.ROPE[pos * 32 + (d & 31)];
                const float x1 = rr[d & 31], x2 = rr[(d & 31) + 32];
                v = (d < 32) ? (x1 * cs.x - x2 * cs.y) : (x2 * cs.x + x1 * cs.y);
                p.CK[(((size_t)s * 512 + c) * 2 + g) * 64 + d] = v;
                if (s == 0) p.CKF[(size_t)g * 512 * 64 + kfrag_elem(c, d)] = (bf16)f2bf(v);
            } else { p.CV[(((size_t)s * 512 + c) * 2 + g) * 64 + d] = v; if (s == 0) p.CVF[(size_t)g * 512 * 64 + vfrag_elem(c, d)] = (bf16)f2bf(v); }
        }
        __syncthreads();
    }
}

__device__ __forceinline__ void ph_gdn_prep(const KP& p, const Fr& F) {
    const float* H0 = p.BIGF; const int lane = F.lane;
    for (int item = T * 8 + F.gw; item < TS * 8; item += F.NGW) {
        const int r = item >> 3, h = item & 7;
        const bool smp = r >= T; const int b = r - T;
        float cv[3];
#pragma unroll
        for (int part = 0; part < 3; ++part) {
            const int ch = part * 512 + h * 64 + lane;
            float acc = 0.f;
#pragma unroll
            for (int j = 0; j < 4; ++j) {
                float u;
                if (!smp) { const int t = r + j - 3; u = (t >= 0) ? H0[(size_t)t * PA + C_GQKV + ch] : 0.f; }
                else { u = (j < 3) ? p.st_gconv[((size_t)b * 3 + j) * 1536 + ch] : H0[(size_t)r * PA + C_GQKV + ch]; }
                acc += p.gconv_w[j * 1536 + ch] * u;
            }
            cv[part] = siluf_(acc);
        }
        const float qn = wave_sum(cv[0] * cv[0]), kn = wave_sum(cv[1] * cv[1]);
        const size_t o = ((size_t)r * 8 + h) * 64 + lane;
        p.GQ[o] = cv[0] * rsqrtf(qn + NORM_EPS) * 0.125f;
        p.GK[o] = cv[1] * rsqrtf(kn + NORM_EPS);
        p.GV[o] = cv[2];
        if (lane == 0) {
            const float av = H0[(size_t)r * PA + C_A + h], bt = H0[(size_t)r * PA + C_BT + h];
            p.Gg[(size_t)r * 8 + h] = -expf(p.gA[h]) * softplusf_(av + p.gdt[h]);
            p.Gb[(size_t)r * 8 + h] = sigmoidf_(bt);
        }
    }
    const size_t gt = (size_t)F.bid * NTHR + F.tid, GT = (size_t)F.G * NTHR;
    for (size_t idx = gt; idx < (size_t)3 * 1536; idx += GT) {
        const int j = (int)(idx / 1536), ch = (int)(idx % 1536);
        p.out[O_GCONV_P + idx] = H0[(size_t)(T - 3 + j) * PA + C_GQKV + ch];
    }
    for (size_t idx = gt; idx < (size_t)NSMP * 3 * 1536; idx += GT) {
        const int b = (int)(idx / (3 * 1536)), j = (int)((idx / 1536) % 3), ch = (int)(idx % 1536);
        p.out[O_GCONV_S + idx] = (j < 2) ? p.st_gconv[((size_t)b * 3 + j + 1) * 1536 + ch] : H0[(size_t)(T + b) * PA + C_GQKV + ch];
    }
}

template <int NH, class KF>
__device__ __forceinline__ void wave_attend(const float* qs, float* sc, int scstride, int nkeys, KF kf, float (&outv)[NH], float (&den)[NH], int lane, float* mxout = nullptr) {
    float mx[NH];
#pragma unroll
    for (int h = 0; h < NH; ++h) mx[h] = -INFINITY;
    for (int j = lane; j < nkeys; j += 64) {
        const float *kp, *vp; const bool ok = kf(j, kp, vp);
        float s[NH];
#pragma unroll
        for (int h = 0; h < NH; ++h) s[h] = 0.f;
        if (ok) {
            for (int d4 = 0; d4 < 16; ++d4) {
                const float4 kvv = ((const float4*)kp)[d4];
#pragma unroll
                for (int h = 0; h < NH; ++h) { const float* q = qs + h * 64 + d4 * 4; s[h] += kvv.x * q[0] + kvv.y * q[1] + kvv.z * q[2] + kvv.w * q[3]; }
            }
        }
#pragma unroll
        for (int h = 0; h < NH; ++h) { const float v = ok ? s[h] * 0.125f : -INFINITY; sc[h * scstride + j] = v; mx[h] = fmaxf(mx[h], v); }
    }
#pragma unroll
    for (int h = 0; h < NH; ++h) { mx[h] = wave_max(mx[h]); if (!(mx[h] > -INFINITY)) mx[h] = 0.f; if (mxout) mxout[h] = mx[h]; }
    float sm[NH];
#pragma unroll
    for (int h = 0; h < NH; ++h) sm[h] = 0.f;
    for (int j = lane; j < nkeys; j += 64) {
#pragma unroll
        for (int h = 0; h < NH; ++h) { const float v = sc[h * scstride + j]; const float pp = (v == -INFINITY) ? 0.f : expf(v - mx[h]); sc[h * scstride + j] = pp; sm[h] += pp; }
    }
#pragma unroll
    for (int h = 0; h < NH; ++h) { sm[h] = wave_sum(sm[h]); den[h] = sm[h] > 0.f ? sm[h] : 1.f; }
    wave_lds_sync();
    {
        const int kq = lane >> 4, d4 = lane & 15;
        float4 acc[NH];
#pragma unroll
        for (int h = 0; h < NH; ++h) acc[h] = make_float4(0.f, 0.f, 0.f, 0.f);
        for (int j0 = 0; j0 < nkeys; j0 += 32) {
            float4 v[8];
#pragma unroll
            for (int u = 0; u < 8; ++u) { const int j = j0 + 4 * u + kq; const float *kp, *vp; const bool ok = (j < nkeys) && kf(j, kp, vp);
                v[u] = ok ? *(const float4*)(vp + 4 * d4) : make_float4(0.f, 0.f, 0.f, 0.f); }
#pragma unroll
            for (int u = 0; u < 8; ++u) { const int j = j0 + 4 * u + kq;
#pragma unroll
                for (int h = 0; h < NH; ++h) { const float pp = (j < nkeys) ? sc[h * scstride + j] : 0.f;
                    acc[h].x += pp * v[u].x; acc[h].y += pp * v[u].y; acc[h].z += pp * v[u].z; acc[h].w += pp * v[u].w; } }
        }
#pragma unroll
        for (int h = 0; h < NH; ++h) {
            float4 a = acc[h];
            a.x += __shfl_xor(a.x, 16); a.y += __shfl_xor(a.y, 16); a.z += __shfl_xor(a.z, 16); a.w += __shfl_xor(a.w, 16);
            a.x += __shfl_xor(a.x, 32); a.y += __shfl_xor(a.y, 32); a.z += __shfl_xor(a.z, 32); a.w += __shfl_xor(a.w, 32);
            const float x0 = __shfl(a.x, lane >> 2), x1 = __shfl(a.y, lane >> 2), x2 = __shfl(a.z, lane >> 2), x3 = __shfl(a.w, lane >> 2);
            const int cc = lane & 3; outv[h] = cc == 0 ? x0 : (cc == 1 ? x1 : (cc == 2 ? x2 : x3));
        }
    }
#pragma unroll
    for (int h = 0; h < NH; ++h) outv[h] /= den[h];
    wave_lds_sync();
}

__device__ __forceinline__ void nsa_smp_cs(const KP& p, int b, int g, float* wl, int lane) {
    float* qs = wl; float* sc = wl + 256; float* imp = wl + 256 + 4 * 1088; int* sel = (int*)(wl + 256 + 4 * 1088 + 320); long long* bb = (long long*)(wl + 256 + 4 * 1088 + 320 + 16);
    const int r = T + b; const int qpos = T;
    const float* grow = p.BIGF + (size_t)r * PA + C_GATE;
#pragma unroll
    for (int h = 0; h < 4; ++h) qs[h * 64 + lane] = p.QR[(size_t)r * 512 + (g * 4 + h) * 64 + lane];
    wave_lds_sync();
    float ocmp[4], oslc[4], den[4];
    {
        const float* CKp = p.CK + (size_t)(1 + b) * 512 * 128; const float* CVp = p.CV + (size_t)(1 + b) * 512 * 128;
        auto kf = [&](int j, const float*& kp, const float*& vp) -> bool { kp = CKp + (j * 2 + g) * 64; vp = CVp + (j * 2 + g) * 64; return true; };
        wave_attend<4>(qs, sc, 1088, 512, kf, ocmp, den, lane);
        for (int blk = lane; blk < 320; blk += 64) {
            float v = 0.f;
            if (blk < 256) {
#pragma unroll
                for (int h = 0; h < 4; ++h) v += (sc[h * 1088 + 2 * blk] + sc[h * 1088 + 2 * blk + 1]) / den[h];
            }
            imp[blk] = v;
        }
        wave_lds_sync();
    }
    {
        const int cur = qpos >> 6;
        float val[5];
#pragma unroll
        for (int j = 0; j < 5; ++j) { const int blk = lane + 64 * j; val[j] = (blk >= 1 && blk <= cur - 2) ? imp[blk] : -1.f; }
        if (lane == 0) { sel[0] = 0; sel[1] = cur; sel[2] = cur - 1; }
        for (int n = 3; n < 16; ++n) {
            float bv = -2.f; int bi = 0x7fffffff;
#pragma unroll
            for (int j = 0; j < 5; ++j) if (val[j] > bv) { bv = val[j]; bi = lane + 64 * j; }
#pragma unroll
            for (int o = 1; o < 64; o <<= 1) { const float ov = __shfl_xor(bv, o); const int oi = __shfl_xor(bi, o); if (ov > bv || (ov == bv && oi < bi)) { bv = ov; bi = oi; } }
#pragma unroll
            for (int j = 0; j < 5; ++j) if (lane + 64 * j == bi) val[j] = -3.f;
            if (lane == 0) sel[n] = bi;
        }
        wave_lds_sync();
        if (lane < 16) { const int blk = sel[lane]; long long o = 0;
            if (blk < 256) { const int page = p.page_table[b * NPAGES + (blk >> 1)]; o = ((long long)page * 128 + (blk & 1) * 64) * 256; }
            bb[lane] = o; }
        wave_lds_sync();
    }
    {
        auto kf = [&](int j, const float*& kp, const float*& vp) -> bool {
            const int blk = sel[j >> 6]; const int pos = blk * 64 + (j & 63); if (pos > qpos) return false;
            if (pos == T) { kp = p.KS + (size_t)r * 128 + g * 64; vp = p.VS + (size_t)r * 128 + g * 64; return true; }
            const float* base = p.cache_slc + bb[j >> 6] + (j & 63) * 256;
            kp = base + g * 64; vp = base + 128 + g * 64; return true; };
        wave_attend<4>(qs, sc, 1088, 1024, kf, oslc, den, lane);
    }
#pragma unroll
    for (int h = 0; h < 4; ++h) {
        const int hh = g * 4 + h;
        p.SMIXF[((size_t)b * 3 + 0) * 512 + hh * 64 + lane] = sigmoidf_(grow[hh]) * ocmp[h];
        p.SMIXF[((size_t)b * 3 + 1) * 512 + hh * 64 + lane] = sigmoidf_(grow[8 + hh]) * oslc[h];
    }
    wave_lds_sync();
}
__device__ __forceinline__ void nsa_smp_win(const KP& p, int b, int g, float* wl, int lane) {
    float* qs = wl; float* sc = wl + 256;
    const int r = T + b;
    const float* grow = p.BIGF + (size_t)r * PA + C_GATE;
#pragma unroll
    for (int h = 0; h < 4; ++h) qs[h * 64 + lane] = p.QR[(size_t)r * 512 + (g * 4 + h) * 64 + lane];
    wave_lds_sync();
    float owin[4], den[4];
    auto kf = [&](int j, const float*& kp, const float*& vp) -> bool {
        if (j == 512) { kp = p.KW + (size_t)r * 128 + g * 64; vp = p.VW + (size_t)r * 128 + g * 64; return true; }
        const float* base = p.st_win + ((size_t)b * 512 + j) * 256;
        kp = base + g * 64; vp = base + 128 + g * 64; return true; };
    wave_attend<4>(qs, sc, 528, 513, kf, owin, den, lane);
#pragma unroll
    for (int h = 0; h < 4; ++h) { const int hh = g * 4 + h; p.SMIXF[((size_t)b * 3 + 2) * 512 + hh * 64 + lane] = sigmoidf_(grow[16 + hh]) * owin[h]; }
    wave_lds_sync();
}

__device__ __forceinline__ void gdn_scan_item(const KP& p, int item, float* wl, int lane) {
    asm volatile("" : "+v"(lane));
    float* kq = wl;
    const int b = (item >> 3) - 1, h = item & 7;
    const int r = T + b; const size_t o = ((size_t)r * 8 + h) * 64;
    kq[lane] = p.GK[o + lane]; kq[64 + lane] = p.GQ[o + lane];
    wave_lds_sync();
    const float dec = expf(p.Gg[(size_t)r * 8 + h]), bt = p.Gb[(size_t)r * 8 + h];
    const float* Sp = p.st_gS + ((size_t)b * 8 + h) * 4096 + lane;
    float* so = p.out + O_GS_S + ((size_t)b * 8 + h) * 4096 + lane;
    float S[64]; float kv = 0.f;
#pragma unroll
    for (int i = 0; i < 64; ++i) { S[i] = Sp[i * 64] * dec; kv += kq[i] * S[i]; }
    const float vn = (p.GV[o + lane] - kv) * bt;
    float ov = 0.f;
#pragma unroll
    for (int i = 0; i < 64; ++i) { const float sn = S[i] + kq[i] * vn; ov += kq[64 + i] * sn; so[i * 64] = sn; }
    p.OG[o + lane] = ov;
    wave_lds_sync();
}

constexpr int GDN_WL = 34816;
__device__ __forceinline__ int kperm(int ks, int grp, int j) { return 32 * ks + 16 * (j >> 2) + 4 * grp + (j & 3); }

__device__ __forceinline__ void gdn_chunk_unit(const KP& p, int unit, unsigned char* ldsb, int woff, int lane) {
    asm volatile("" : "+v"(lane), "+s"(woff));
    unsigned char* wlb = ldsb + woff;
    const int n = unit >> 3, h = unit & 7, t0 = 64 * n;
    const int l15 = lane & 15, grp = lane >> 4;
    float* Af = (float*)wlb; bf16* kt = (bf16*)(wlb + 16384); bf16* qt = kt + 64 * 72; bf16* tmp = (bf16*)wlb;
    {
        const float* H0 = p.BIGF;
        float w[3][4], u1[3], u2[3], u3[3];
#pragma unroll
        for (int part = 0; part < 3; ++part) {
            const int ch = part * 512 + h * 64 + lane;
#pragma unroll
            for (int j = 0; j < 4; ++j) w[part][j] = p.gconv_w[j * 1536 + ch];
            u1[part] = (t0 >= 1) ? H0[(size_t)(t0 - 1) * PA + C_GQKV + ch] : 0.f;
            u2[part] = (t0 >= 2) ? H0[(size_t)(t0 - 2) * PA + C_GQKV + ch] : 0.f;
            u3[part] = (t0 >= 3) ? H0[(size_t)(t0 - 3) * PA + C_GQKV + ch] : 0.f;
        }
        int roff = 0;
#pragma unroll 4
        for (int i = 0; i < 64; ++i) {
            float cv[3];
#pragma unroll
            for (int part = 0; part < 3; ++part) {
                const float u0 = H0[(size_t)t0 * PA + C_GQKV + part * 512 + h * 64 + lane + roff];
                cv[part] = siluf_(w[part][0] * u3[part] + w[part][1] * u2[part] + w[part][2] * u1[part] + w[part][3] * u0);
                u3[part] = u2[part]; u2[part] = u1[part]; u1[part] = u0;
            }
            roff += PA; asm volatile("" : "+s"(roff));
            const float qn = wave_sum(cv[0] * cv[0]), kn = wave_sum(cv[1] * cv[1]);
            qt[i * 72 + lane] = (bf16)f2bf(cv[0] * rsqrtf(qn + NORM_EPS) * 0.125f);
            kt[i * 72 + lane] = (bf16)f2bf(cv[1] * rsqrtf(kn + NORM_EPS));
            p.GV[((size_t)(t0 + i) * 8 + h) * 64 + lane] = cv[2];
        }
    }
    const float gl_ = -fexp_(p.gA[h]) * softplusf_(p.BIGF[(size_t)(t0 + lane) * PA + C_A + h] + p.gdt[h]);
    const float beta = sigmoidf_(p.BIGF[(size_t)(t0 + lane) * PA + C_BT + h]);
    float gc = gl_;
#pragma unroll
    for (int o = 1; o < 64; o <<= 1) { const float tv = __shfl_up(gc, o); if (lane >= o) gc += tv; }
    const float gclast = __shfl(gc, 63);
#define GPAD(i) ((float*)(kt + (i) * 72 + 64))
    { float* pd = GPAD(lane); pd[0] = gc; pd[1] = beta; pd[2] = fexp_(gc); pd[3] = fexp_(gclast - gc); }
    wave_lds_sync();
    bf16* QKF = p.G_QKF + (size_t)unit * 4096;
#pragma unroll
    for (int it = 0; it < 4; ++it) {
        const int i = 16 * it + l15;
        const float gci = GPAD(i)[0], bi = GPAD(i)[1];
        bf16x8 bk[2], bq[2];
#pragma unroll
        for (int ks = 0; ks < 2; ++ks) { bk[ks] = *(const bf16x8*)(kt + i * 72 + 32 * ks + 8 * grp); bq[ks] = *(const bf16x8*)(qt + i * 72 + 32 * ks + 8 * grp); }
#pragma unroll
        for (int jt = 0; jt < 4; ++jt) {
            uint2 qkp = make_uint2(0u, 0u);
            if (jt <= it) {
                bf16x8 ak[2];
#pragma unroll
                for (int ks = 0; ks < 2; ++ks) ak[ks] = *(const bf16x8*)(kt + (16 * jt + l15) * 72 + 32 * ks + 8 * grp);
                f32x4 aa = {0.f, 0.f, 0.f, 0.f}, aq = {0.f, 0.f, 0.f, 0.f};
                aa = MFMA16(ak[0], bk[0], aa); aa = MFMA16(ak[1], bk[1], aa);
                aq = MFMA16(ak[0], bq[0], aq); aq = MFMA16(ak[1], bq[1], aq);
                f32x4 av, qv;
#pragma unroll
                for (int r = 0; r < 4; ++r) {
                    const int j = 16 * jt + 4 * grp + r; const float gcj = GPAD(j)[0];
                    const float e = (j <= i) ? fexp_(gci - gcj) : 0.f;
                    av[r] = (j < i) ? bi * aa[r] * e : 0.f; qv[r] = aq[r] * e;
                }
                *(f32x4*)(Af + i * 64 + 16 * jt + 4 * grp) = av;
                qkp.x = pk2(qv[0], qv[1]); qkp.y = pk2(qv[2], qv[3]);
            }
            *(uint2*)(QKF + ((size_t)(it * 2 + (jt >> 1)) * 64 + lane) * 8 + (jt & 1) * 4) = qkp;
        }
    }
    wave_lds_sync();
    {
        float* UF = p.G_UF + (size_t)unit * 4096;
        const int vq = lane >> 4;
#pragma unroll
        for (int pass = 0; pass < 2; ++pass) {
            float x[64];
            int goff = 0;
#pragma unroll
            for (int i = 0; i < 64; ++i) {
                const float bi = GPAD(i)[1];
                float acc;
                if (pass == 0) { acc = p.GV[((size_t)t0 * 8 + h) * 64 + lane + goff] * bi; goff += 512; asm volatile("" : "+s"(goff)); }
                else { const float ei = GPAD(i)[2];
                       acc = __uint_as_float((unsigned)kt[i * 72 + lane] << 16) * bi * ei; }
#pragma unroll
                for (int jj = 0; jj < (i + 3) / 4; ++jj) {
                    const float4 a4 = *(const float4*)(Af + i * 64 + 4 * jj);
                    acc -= a4.x * x[4 * jj + 0];
                    if (4 * jj + 1 < i) acc -= a4.y * x[4 * jj + 1];
                    if (4 * jj + 2 < i) acc -= a4.z * x[4 * jj + 2];
                    if (4 * jj + 3 < i) acc -= a4.w * x[4 * jj + 3];
                }
                x[i] = acc;
                if ((i & 3) == 3) asm volatile("" ::: "memory");
            }
            if (pass == 0) {
#pragma unroll
                for (int c4 = 0; c4 < 16; ++c4) {
                    const int mt = c4 >> 2, lp = l15 + 16 * (c4 & 3);
                    *(f32x4*)(UF + ((size_t)(vq * 4 + mt) * 64 + lp) * 4) = (f32x4){x[4 * c4], x[4 * c4 + 1], x[4 * c4 + 2], x[4 * c4 + 3]};
                }
            } else {
                wave_lds_sync();
#pragma unroll
                for (int c = 0; c < 64; ++c) tmp[c * 72 + lane] = (bf16)f2bf(-x[c]);
            }
            asm volatile("" ::: "memory");
        }
    }
    wave_lds_sync();
    {
        bf16* WF = p.G_WF + (size_t)unit * 4096; bf16* QGF = p.G_QGF + (size_t)unit * 4096; bf16* KDF = p.G_KDF + (size_t)unit * 4096;
#pragma unroll
        for (int mt = 0; mt < 4; ++mt) {
            const float egc = GPAD(16 * mt + l15)[2];
#pragma unroll
            for (int ks = 0; ks < 2; ++ks) {
                const int c = 16 * mt + l15, k0 = 32 * ks + 4 * grp;
                const uint2 w0 = *(const uint2*)(tmp + c * 72 + k0), w1 = *(const uint2*)(tmp + c * 72 + k0 + 16);
                v4u wv; wv.x = w0.x; wv.y = w0.y; wv.z = w1.x; wv.w = w1.y;
                *(v4u*)(WF + ((size_t)(mt * 2 + ks) * 64 + lane) * 8) = wv;
                const uint2 q0 = *(const uint2*)(qt + c * 72 + k0), q1 = *(const uint2*)(qt + c * 72 + k0 + 16);
                v4u qv;
                qv.x = pk2(__uint_as_float(q0.x << 16) * egc, __uint_as_float(q0.x & 0xffff0000u) * egc); qv.y = pk2(__uint_as_float(q0.y << 16) * egc, __uint_as_float(q0.y & 0xffff0000u) * egc);
                qv.z = pk2(__uint_as_float(q1.x << 16) * egc, __uint_as_float(q1.x & 0xffff0000u) * egc); qv.w = pk2(__uint_as_float(q1.y << 16) * egc, __uint_as_float(q1.y & 0xffff0000u) * egc);
                *(v4u*)(QGF + ((size_t)(mt * 2 + ks) * 64 + lane) * 8) = qv;
                float kd[8];
#pragma unroll
                for (int j = 0; j < 8; ++j) { const int cc = kperm(ks, grp, j); kd[j] = __uint_as_float((unsigned)kt[cc * 72 + 16 * mt + l15] << 16) * GPAD(cc)[3]; }
                v4u kv; kv.x = pk2(kd[0], kd[1]); kv.y = pk2(kd[2], kd[3]); kv.z = pk2(kd[4], kd[5]); kv.w = pk2(kd[6], kd[7]);
                *(v4u*)(KDF + ((size_t)(mt * 2 + ks) * 64 + lane) * 8) = kv;
            }
        }
        if (lane == 0) p.G_GL[unit] = fexp_(gclast);
    }
    wave_lds_sync();
#undef GPAD
}

constexpr int CH_SLOT = 32768;
__device__ __forceinline__ void gdn_chain_wg(const KP& p, int h, int wave, int lane, unsigned char* ldsb) {
    asm volatile("" : "+v"(lane));
    const int l15 = lane & 15, grp = lane >> 4;
    float* GLs = (float*)(ldsb + 4 * CH_SLOT);
    if (wave < 4) GLs[wave * 64 + lane] = p.G_GL[(size_t)(wave * 64 + lane) * 8 + h];
#define CH_BAR() do { asm volatile("s_waitcnt lgkmcnt(0)" ::: "memory"); __builtin_amdgcn_s_barrier(); asm volatile("" ::: "memory"); } while (0)
    if (wave >= 4) {
        const int lw = wave - 4;
        const unsigned char* gb = (lw == 0) ? (const unsigned char*)p.G_WF : (lw == 1) ? (const unsigned char*)p.G_KDF : (const unsigned char*)p.G_UF + (size_t)(lw - 2) * 8192;
        const size_t ustride = (lw < 2) ? 8192 : 16384;
        gb += (size_t)h * ustride + (size_t)lane * 16;
        auto src = [&](int n, int k) -> const v4u* { return (const v4u*)(gb + (size_t)n * 8 * ustride + k * 1024); };
        v4u rs[4][8];
#pragma unroll
        for (int j = 0; j < 4; ++j)
#pragma unroll
            for (int k = 0; k < 8; ++k) rs[j][k] = *src(j, k);
#pragma unroll
        for (int j = 0; j < 2; ++j) {
#pragma unroll
            for (int k = 0; k < 8; ++k) { *(v4u*)(ldsb + j * CH_SLOT + (lw * 512 + k * 64 + lane) * 16) = rs[j][k]; rs[j][k] = *src(4 + j, k); }
        }
        CH_BAR();
        for (int n0 = 0; n0 < 256; n0 += 4) {
#pragma unroll
            for (int j = 0; j < 4; ++j) {
                const int n = n0 + j, st = n + 2;
                if (st < 256) {
                    const int set = (j + 2) & 3;
#pragma unroll
                    for (int k = 0; k < 8; ++k) { *(v4u*)(ldsb + (st & 3) * CH_SLOT + (lw * 512 + k * 64 + lane) * 16) = rs[set][k]; if (st + 4 < 256) rs[set][k] = *src(st + 4, k); }
                }
                CH_BAR();
            }
        }
#undef CH_BAR
        return;
    }
    const int vq = wave;
    f32x4 S[4];
#pragma unroll
    for (int i = 0; i < 4; ++i) S[i] = (f32x4){0.f, 0.f, 0.f, 0.f};
    asm volatile("s_waitcnt lgkmcnt(0)" ::: "memory"); __builtin_amdgcn_s_barrier(); asm volatile("" ::: "memory");
    for (int n = 0; n < 256; ++n) {
        const unsigned char* sl = ldsb + (n & 3) * CH_SLOT;
        bf16x8 wf[4][2], kdf[4][2]; f32x4 uf[4];
#pragma unroll
        for (int mt = 0; mt < 4; ++mt) {
#pragma unroll
            for (int ks = 0; ks < 2; ++ks) { wf[mt][ks] = *(const bf16x8*)(sl + ((mt * 2 + ks) * 64 + lane) * 16); kdf[mt][ks] = *(const bf16x8*)(sl + 8192 + ((mt * 2 + ks) * 64 + lane) * 16); }
            uf[mt] = *(const f32x4*)(sl + 16384 + ((vq * 4 + mt) * 64 + lane) * 16);
        }
        const float gl = GLs[n];
        const size_t fo = ((size_t)((n * 8 + h) * 4 + vq) * 2) * 512;
        bf16x8 sB[2];
#pragma unroll
        for (int ks = 0; ks < 2; ++ks) { sB[ks] = pack_p(S[2 * ks], S[2 * ks + 1]); *(bf16x8*)(p.G_SPF + fo + ((size_t)ks * 64 + lane) * 8) = sB[ks]; }
        f32x4 v[4];
#pragma unroll
        for (int mt = 0; mt < 4; ++mt) { v[mt] = uf[mt]; v[mt] = MFMA16(wf[mt][0], sB[0], v[mt]); v[mt] = MFMA16(wf[mt][1], sB[1], v[mt]); }
        bf16x8 vB[2];
#pragma unroll
        for (int ks = 0; ks < 2; ++ks) { vB[ks] = pack_p(v[2 * ks], v[2 * ks + 1]); *(bf16x8*)(p.G_VNF + fo + ((size_t)ks * 64 + lane) * 8) = vB[ks]; }
#pragma unroll
        for (int mt = 0; mt < 4; ++mt) { S[mt] = S[mt] * gl; S[mt] = MFMA16(kdf[mt][0], vB[0], S[mt]); S[mt] = MFMA16(kdf[mt][1], vB[1], S[mt]); }
        asm volatile("s_waitcnt lgkmcnt(0)" ::: "memory"); __builtin_amdgcn_s_barrier(); asm volatile("" ::: "memory");
    }
    float* so = p.out + O_GS_P + (size_t)h * 4096;
#pragma unroll
    for (int mt = 0; mt < 4; ++mt)
#pragma unroll
        for (int r = 0; r < 4; ++r) so[(16 * mt + 4 * grp + r) * 64 + 16 * vq + l15] = S[mt][r];
}

__device__ __forceinline__ void gdn_out_unit(const KP& p, int unit, int lane) {
    asm volatile("" : "+v"(lane));
    const int n = unit >> 3, h = unit & 7, t0 = 64 * n; const int l15 = lane & 15, grp = lane >> 4;
    const bf16* QGF = p.G_QGF + (size_t)unit * 4096; const bf16* QKF = p.G_QKF + (size_t)unit * 4096;
    f32x4 o[4][4];
#pragma unroll
    for (int mt = 0; mt < 4; ++mt)
#pragma unroll
        for (int vq = 0; vq < 4; ++vq) o[mt][vq] = (f32x4){0.f, 0.f, 0.f, 0.f};
#pragma unroll
    for (int ks = 0; ks < 2; ++ks) {
        bf16x8 sp[4], vn[4];
#pragma unroll
        for (int vq = 0; vq < 4; ++vq) { const size_t fo = ((size_t)(unit * 4 + vq) * 2 + ks) * 512 + (size_t)lane * 8; sp[vq] = *(const bf16x8*)(p.G_SPF + fo); vn[vq] = *(const bf16x8*)(p.G_VNF + fo); }
#pragma unroll
        for (int mt = 0; mt < 4; ++mt) {
            const bf16x8 qg = *(const bf16x8*)(QGF + ((size_t)(mt * 2 + ks) * 64 + lane) * 8), qk = *(const bf16x8*)(QKF + ((size_t)(mt * 2 + ks) * 64 + lane) * 8);
#pragma unroll
            for (int vq = 0; vq < 4; ++vq) { o[mt][vq] = MFMA16(qg, sp[vq], o[mt][vq]); o[mt][vq] = MFMA16(qk, vn[vq], o[mt][vq]); }
        }
    }
    float nw[4];
#pragma unroll
    for (int vq = 0; vq < 4; ++vq) nw[vq] = p.gnw[16 * vq + l15];
#pragma unroll
    for (int mt = 0; mt < 4; ++mt)
#pragma unroll
        for (int r = 0; r < 4; ++r) {
            float ss = 0.f;
#pragma unroll
            for (int vq = 0; vq < 4; ++vq) ss += o[mt][vq][r] * o[mt][vq][r];
            ss += __shfl_xor(ss, 1); ss += __shfl_xor(ss, 2); ss += __shfl_xor(ss, 4); ss += __shfl_xor(ss, 8);
            const float rs = rsqrtf(ss * (1.f / 64.f) + NORM_EPS);
            const int t = t0 + 16 * mt + 4 * grp + r;
            const float* zr = p.BIGF + (size_t)t * PA + C_Z + h * 64;
#pragma unroll
            for (int vq = 0; vq < 4; ++vq) p.MIXB[(size_t)t * 1024 + 512 + h * 64 + 16 * vq + l15] = (bf16)f2bf(o[mt][vq][r] * rs * nw[vq] * siluf_(zr[16 * vq + l15]));
        }
}

#define MFMA8(a, b, c) __builtin_amdgcn_mfma_f32_16x16x32_fp8_fp8((a), (b), (c), 0, 0, 0)
__device__ __forceinline__ long pack_fp8(const f32x4& a, const f32x4& b) {
    int w0 = 0, w1 = 0;
    w0 = __builtin_amdgcn_cvt_pk_fp8_f32(a[0], a[1], w0, false); w0 = __builtin_amdgcn_cvt_pk_fp8_f32(a[2], a[3], w0, true);
    w1 = __builtin_amdgcn_cvt_pk_fp8_f32(b[0], b[1], w1, false); w1 = __builtin_amdgcn_cvt_pk_fp8_f32(b[2], b[3], w1, true);
    return (long)(((unsigned long long)(unsigned)w1 << 32) | (unsigned long long)(unsigned)w0);
}
template <bool GEN>
__device__ __forceinline__ void nsa_slc_item8(const KP& p, int tq, int g, int lane) {
    asm volatile("" : "+v"(lane));
    const int l15 = lane & 15, grp = lane >> 4, hn = lane & 3;
    const unsigned char* KF = p.KS8 + (size_t)g * T * 64; const unsigned char* VF = p.VS8 + (size_t)g * T * 64;
    const int* selp = p.SEL + ((size_t)g * T + tq) * 16;
    int sb[16];
#pragma unroll
    for (int i = 0; i < 16; ++i) sb[i] = __builtin_amdgcn_readfirstlane(selp[i]);
    long qs[2];
#pragma unroll
    for (int ks = 0; ks < 2; ++ks) {
        const bf16x8 qb = *(const bf16x8*)(p.QB + (size_t)tq * 512 + (g * 4 + hn) * 64 + 32 * ks + 8 * grp);
        f32x4 a, b;
#pragma unroll
        for (int j = 0; j < 4; ++j) { a[j] = __uint_as_float((unsigned)(unsigned short)qb[j] << 16) * (1.f / QSCALE); b[j] = __uint_as_float((unsigned)(unsigned short)qb[4 + j] << 16) * (1.f / QSCALE); }
        qs[ks] = pack_fp8(a, b);
    }
    AttW a; attw_init(a);
    long kf[3][4][2], vf[3][2][4];
    auto issue = [&](int bi, int buf) {
        int blk = sb[bi]; if (GEN && (blk < 0 || blk * 64 > tq)) blk = 0;
        typedef long l2_t __attribute__((ext_vector_type(2)));
#pragma unroll
        for (int tl = 0; tl < 4; ++tl) { const l2_t x = *(const l2_t*)(KF + ((size_t)(blk * 4 + tl) * 64 + lane) * 16); kf[buf][tl][0] = x[0]; kf[buf][tl][1] = x[1]; }
#pragma unroll
        for (int dt = 0; dt < 4; ++dt) { const l2_t x = *(const l2_t*)(VF + ((size_t)(blk * 4 + dt) * 64 + lane) * 16); vf[buf][0][dt] = x[0]; vf[buf][1][dt] = x[1]; }
    };
    issue(0, 0); issue(1, 1);
#pragma unroll
    for (int bi = 0; bi < 16; ++bi) {
        const int buf = bi % 3;
        if (bi + 2 < 16) issue(bi + 2, (bi + 2) % 3);
        const int blk = sb[bi]; const int k0 = blk * 64;
        if (GEN && (blk < 0 || k0 > tq)) continue;
        const f32x4 z = {0.f, 0.f, 0.f, 0.f};
        f32x4 sc[4];
#pragma unroll
        for (int tl = 0; tl < 4; ++tl) { sc[tl] = MFMA8(kf[buf][tl][0], qs[0], z); sc[tl] = MFMA8(kf[buf][tl][1], qs[1], sc[tl]); }
        if (GEN ? (k0 + 63 > tq) : (bi == 1)) {
#pragma unroll
            for (int tl = 0; tl < 4; ++tl)
#pragma unroll
                for (int j = 0; j < 4; ++j) if (k0 + 16 * tl + 4 * grp + j > tq) sc[tl][j] = -INFINITY;
        }
        float mx = fmaxf(fmaxf(fmaxf(fmaxf(sc[0][0], sc[0][1]), fmaxf(sc[0][2], sc[0][3])), fmaxf(fmaxf(sc[1][0], sc[1][1]), fmaxf(sc[1][2], sc[1][3]))),
                         fmaxf(fmaxf(fmaxf(sc[2][0], sc[2][1]), fmaxf(sc[2][2], sc[2][3])), fmaxf(fmaxf(sc[3][0], sc[3][1]), fmaxf(sc[3][2], sc[3][3]))));
        mx = fmaxf(mx, __shfl_xor(mx, 16)); mx = fmaxf(mx, __shfl_xor(mx, 32));
        const float mn = fmaxf(a.m, mx * QSCALE);
        const float alpha = __builtin_amdgcn_exp2f(a.m - mn);
        const float mb = 7.f - mn;
        f32x4 pp[4]; float sum = 0.f;
#pragma unroll
        for (int tl = 0; tl < 4; ++tl) {
#pragma unroll
            for (int j = 0; j < 4; ++j) pp[tl][j] = __builtin_amdgcn_exp2f(fmaf(sc[tl][j], QSCALE, mb));
            sum += (pp[tl][0] + pp[tl][1]) + (pp[tl][2] + pp[tl][3]);
        }
        a.l = a.l * alpha + sum; a.m = mn;
        const long pf0 = pack_fp8(pp[0], pp[1]), pf1 = pack_fp8(pp[2], pp[3]);
#pragma unroll
        for (int dt = 0; dt < 4; ++dt) { a.o[dt] = a.o[dt] * alpha; a.o[dt] = MFMA8(vf[buf][0][dt], pf0, a.o[dt]); a.o[dt] = MFMA8(vf[buf][1][dt], pf1, a.o[dt]); }
    }
    const float lt = grp_sum(a.l);
    if (l15 < 4) {
        const float gs = sigmoidf_(p.BIGF[(size_t)tq * PA + C_GATE + 8 + g * 4 + l15]) * (lt > 0.f ? 1.f / lt : 0.f);
#pragma unroll
        for (int dt = 0; dt < 4; ++dt) {
            const size_t o = (size_t)tq * 512 + g * 256 + l15 * 64 + 16 * dt + 4 * grp;
            const f32x4 base = *(const f32x4*)(p.NSACC + o); const f32x4 v = base + a.o[dt] * gs;
            uint2 w; w.x = pk2(v[0], v[1]); w.y = pk2(v[2], v[3]);
            *(uint2*)(p.MIXB + (size_t)tq * 1024 + g * 256 + l15 * 64 + 16 * dt + 4 * grp) = w;
        }
    }
}

__device__ __forceinline__ void ph_gdn_chunks(const KP& p, const Fr& F) {
    if (F.wave < 4) for (int unit = F.bid * 4 + F.wave; unit < 2048; unit += F.G * 4) gdn_chunk_unit(p, unit, F.lds, F.wave * GDN_WL, F.lane);
    else { const int unit = F.bid * 4 + (F.wave - 4); if (unit < 128) cmp_prompt_unit(p, unit, F.lane); }
}
__device__ __forceinline__ void ph_mix_a(const KP& p, const Fr& F) {
    if (F.bid < 32) gdn_scan_item(p, (F.bid + 1) * 8 + F.wave, (float*)(F.lds + 8 * FAST_WL + 1024 + F.wave * 512), F.lane);
    float* wl = (float*)(F.lds + F.wave * FAST_WL);
    for (int unit = F.gw; unit < 2048; unit += F.NGW) nsa_fast_unit(p, unit, wl, F.lane);
}
__device__ __forceinline__ void ph_mix_b(const KP& p, const Fr& F) {
    if (F.bid < 8) { gdn_chain_wg(p, F.bid, F.wave, F.lane, F.lds); return; }
    if (F.bid < 24) {
        const int it = (F.bid - 8) * 4 + (F.wave & 3);
        if (F.wave < 4) nsa_smp_cs(p, it >> 1, it & 1, (float*)(F.lds + F.wave * 20480), F.lane);
        else nsa_smp_win(p, it >> 1, it & 1, (float*)(F.lds + 81920 + (F.wave - 4) * 12288), F.lane);
        return;
    }
    const int g = F.bid & 1, fr = (F.bid - 24) >> 1, NW = ((F.G - 24) >> 1) * 8;
    for (int tq = fr * 8 + F.wave; tq < T; tq += NW) { if (tq >= 1024) nsa_slc_item8<false>(p, tq, g, F.lane); else nsa_slc_item8<true>(p, tq, g, F.lane); }
}

__device__ __forceinline__ void ph_gdn_out(const KP& p, const Fr& F) {
    const float* H0 = p.BIGF; const int lane = F.lane;
    for (int unit = F.gw; unit < 2048; unit += F.NGW) gdn_out_unit(p, unit, lane);
    for (int idx = F.bid * NTHR + F.tid; idx < NSMP * 512; idx += F.G * NTHR) { const int b = idx >> 9, c = idx & 511; const float* sp = p.SMIXF + (size_t)b * 3 * 512 + c;
        p.MIXB[(size_t)(T + b) * 1024 + c] = (bf16)f2bf(sp[0] + sp[512] + sp[1024]); }
    for (int item = T * 8 + F.gw; item < TS * 8; item += F.NGW) {
        const int r = item >> 3, h = item & 7;
        const float o = p.OG[((size_t)r * 8 + h) * 64 + lane];
        const float ms = wave_sum(o * o) * (1.f / 64.f);
        const float z = H0[(size_t)r * PA + C_Z + h * 64 + lane];
        p.MIXB[(size_t)r * 1024 + 512 + h * 64 + lane] = (bf16)f2bf(o * rsqrtf(ms + NORM_EPS) * p.gnw[lane] * siluf_(z));
    }
}

__device__ __forceinline__ void ph_ln(const Fr& F, const float* Xp, const float* Xs, const float* Fm, const float* gam, const float* bet, float* outp, float* outs, bf16* ob) {
    const int lane = F.lane;
    for (int r = F.gw; r < TS; r += F.NGW) {
        const float4* xr = (const float4*)((r < T) ? Xp + (size_t)r * DM : Xs + (size_t)(r - T) * DM) + lane; const float4* fr = (const float4*)(Fm + (size_t)r * DM) + lane;
        f32x4 v[4]; float s = 0.f;
#pragma unroll
        for (int j = 0; j < 4; ++j) { const float4 x = xr[64 * j], f = fr[64 * j]; v[j] = (f32x4){DN_ALPHA * x.x + f.x, DN_ALPHA * x.y + f.y, DN_ALPHA * x.z + f.z, DN_ALPHA * x.w + f.w}; s += (v[j][0] + v[j][1]) + (v[j][2] + v[j][3]); }
        const float mean = wave_sum(s) * (1.f / DM); float q = 0.f;
#pragma unroll
        for (int j = 0; j < 4; ++j) { v[j] = v[j] - mean; q += (v[j][0] * v[j][0] + v[j][1] * v[j][1]) + (v[j][2] * v[j][2] + v[j][3] * v[j][3]); }
        const float rstd = rsqrtf(wave_sum(q) * (1.f / DM) + LN_EPS);
        float4* o = (float4*)((r < T) ? outp + (size_t)r * DM : outs + (size_t)(r - T) * DM) + lane;
#pragma unroll
        for (int j = 0; j < 4; ++j) { const float4 g4 = ((const float4*)gam)[lane + 64 * j], b4 = ((const float4*)bet)[lane + 64 * j];
            const float4 y = make_float4(v[j][0] * rstd * g4.x + b4.x, v[j][1] * rstd * g4.y + b4.y, v[j][2] * rstd * g4.z + b4.z, v[j][3] * rstd * g4.w + b4.w);
            o[64 * j] = y; if (ob) { uint2 w; w.x = pk2(y.x, y.y); w.y = pk2(y.z, y.w); *((uint2*)(ob + (size_t)r * DM) + lane + 64 * j) = w; } }
    }
}

__device__ __forceinline__ void ph_ffn_act(const KP& p, const Fr& F, int layer) {
    const float* U = p.BIGF; const float* cw = p.ffn_cw + (size_t)layer * 3 * DFF2; const float* cb = p.ffn_cb + (size_t)layer * DFF2;
    const size_t gt = (size_t)F.bid * NTHR + F.tid, GT = (size_t)F.G * NTHR;
    const size_t total = (size_t)TS * DFF;
    for (size_t idx = gt; idx < total; idx += GT) {
        const int r = (int)(idx / DFF), j = (int)(idx % DFF);
        const bool smp = r >= T; const int b = r - T;
        float c2[2];
#pragma unroll
        for (int half = 0; half < 2; ++half) {
            const int ch = half * DFF + j;
            float acc = cb[ch];
#pragma unroll
            for (int k = 0; k < 3; ++k) {
                float u;
                if (!smp) { const int t = r + k - 2; u = (t >= 0) ? U[(size_t)t * DFF2 + ch] : 0.f; }
                else u = (k < 2) ? p.st_ffn[(((size_t)b * 2 + layer) * 2 + k) * DFF2 + ch] : U[(size_t)r * DFF2 + ch];
                acc += cw[k * DFF2 + ch] * u;
            }
            c2[half] = acc;
        }
        p.HFFB[idx] = (bf16)f2bf(siluf_(c2[0]) * c2[1]);
    }
    for (size_t idx = gt; idx < (size_t)2 * DFF2; idx += GT) {
        const int k = (int)(idx / DFF2), ch = (int)(idx % DFF2);
        p.out[O_FFN_P + ((size_t)layer * 2 + k) * DFF2 + ch] = U[(size_t)(T - 2 + k) * DFF2 + ch];
    }
    for (size_t idx = gt; idx < (size_t)NSMP * 2 * DFF2; idx += GT) {
        const int b = (int)(idx / (2 * DFF2)), k = (int)((idx / DFF2) % 2), ch = (int)(idx % DFF2);
        p.out[O_FFN_S + (((size_t)b * 2 + layer) * 2 + k) * DFF2 + ch] =
            (k == 0) ? p.st_ffn[(((size_t)b * 2 + layer) * 2 + 1) * DFF2 + ch] : U[(size_t)(T + b) * DFF2 + ch];
    }
}

__device__ __forceinline__ void ph_dil_prep(const KP& p, const Fr& F) {
    const float* H1 = p.BIGF;
    const size_t gt = (size_t)F.bid * NTHR + F.tid, GT = (size_t)F.G * NTHR;
    const size_t total = (size_t)TS * 2048;
    for (size_t idx = gt + (size_t)T * 2048; idx < total; idx += GT) {
        const int r = (int)(idx >> 11), c = (int)(idx & 2047);
        const bool smp = r >= T; const int pos = smp ? T : r;
        const float* row = H1 + (size_t)r * 3072;
        const int i = c & 63; const float2 cs = p.ROPE[pos * 32 + (i & 31)];
        const float v = rope_val(row, c & ~63, i, cs);
        if (c < 1024) p.QD[(size_t)r * 1024 + c] = v; else p.KD[(size_t)r * 1024 + (c - 1024)] = v;
    }
}
__device__ __forceinline__ void ph_dil_cache(const KP& p, const Fr& F) {
    const float* H1 = p.BIGF;
    const size_t gt = (size_t)F.bid * NTHR + F.tid, GT = (size_t)F.G * NTHR;
    const size_t tots4 = (size_t)NSMP * 2048 * 512;
    for (size_t idx = gt; idx < tots4; idx += GT) {
        const int b = (int)(idx / (2048 * 512)); const int i = (int)((idx / 512) % 2048); const int c4 = (int)(idx % 512);
        float4 v;
        if (i < 2047) v = ((const float4*)p.st_dil)[((size_t)b * 2048 + i + 1) * 512 + c4];
        else { const int c = c4 * 4; const int r = T + b;
               v = (c < 1024) ? *(const float4*)(p.KD + (size_t)r * 1024 + c) : *(const float4*)(H1 + (size_t)r * 3072 + 2048 + (c - 1024)); }
        ((float4*)(p.out + O_DIL_S))[idx] = v;
    }
}
__device__ __forceinline__ void ph_dil_attn(const KP& p, const Fr& F) {
    const float* H1 = p.BIGF; const int lane = F.lane;
    float* qs = (float*)(F.lds + F.wave * 4096); float* sc = qs + 64;
    float* ex = (float*)(F.lds + 32768);
    const int il = F.wave / 3, gi = F.wave - 3 * il;
    const int item = F.bid * 2 + il; const int b = item >> 4, h = item & 15, r = T + b;
    if (F.wave < 6 && item < NSMP * 16) {
        qs[lane] = p.QD[(size_t)r * 1024 + h * 64 + lane];
        wave_lds_sync();
        const int dd = gi == 0 ? 1 : (gi == 1 ? 4 : 16);
        auto kf = [&](int j, const float*& kp, const float*& vp) -> bool {
            const int pos = T - j * dd;
            if (pos == T) { kp = p.KD + (size_t)r * 1024 + h * 64; vp = H1 + (size_t)r * 3072 + 2048 + h * 64; return true; }
            const float* base = p.st_dil + ((size_t)b * 2048 + (pos - (T - 2048))) * 2048;
            kp = base + h * 64; vp = base + 1024 + h * 64; return true; };
        float o[1], den[1], mx[1];
        wave_attend<1>(qs, sc, 448, 129, kf, o, den, lane, mx);
        float* e = ex + (il * 3 + gi) * 68;
        e[lane] = o[0] * den[0]; if (lane == 0) { e[64] = mx[0]; e[65] = den[0]; }
    }
    __syncthreads();
    if (F.wave < 6 && gi == 0 && item < NSMP * 16) {
        const float* e = ex + il * 3 * 68;
        const float m0 = e[64], m1 = e[68 + 64], m2 = e[136 + 64]; const float M = fmaxf(m0, fmaxf(m1, m2));
        const float w0 = expf(m0 - M), w1 = expf(m1 - M), w2 = expf(m2 - M);
        const float num = w0 * e[lane] + w1 * e[68 + lane] + w2 * e[136 + lane], dn = w0 * e[65] + w1 * e[68 + 65] + w2 * e[136 + 65];
        p.MIXB[(size_t)r * 1024 + h * 64 + lane] = (bf16)f2bf(num / dn);
    }
}

__device__ __forceinline__ void ph_dil_prep_fast(const KP& p, const Fr& F) {
    const float* H1 = p.BIGF;
    const size_t gt = (size_t)F.bid * NTHR + F.tid, GT = (size_t)F.G * NTHR;
    for (size_t idx = gt; idx < (size_t)T * 128; idx += GT) {
        const int t = (int)(idx >> 7), u = (int)(idx & 127);
        const int hq = u >> 2, d0 = (u & 3) * 8, c0 = hq * 64 + d0; const float* row = H1 + (size_t)t * 3072;
        const float4 a0 = *(const float4*)(row + c0), a1 = *(const float4*)(row + c0 + 4), b0 = *(const float4*)(row + c0 + 32), b1 = *(const float4*)(row + c0 + 36);
        const float4* rp = (const float4*)(p.ROPE + t * 32 + d0); const float4 r0 = rp[0], r1 = rp[1], r2 = rp[2], r3 = rp[3];
        const float x1[8] = {a0.x, a0.y, a0.z, a0.w, a1.x, a1.y, a1.z, a1.w}, x2[8] = {b0.x, b0.y, b0.z, b0.w, b1.x, b1.y, b1.z, b1.w};
        const float cs[8] = {r0.x, r0.z, r1.x, r1.z, r2.x, r2.z, r3.x, r3.z}, sn[8] = {r0.y, r0.w, r1.y, r1.w, r2.y, r2.w, r3.y, r3.w};
        float lo[8], hi[8];
#pragma unroll
        for (int j = 0; j < 8; ++j) { lo[j] = x1[j] * cs[j] - x2[j] * sn[j]; hi[j] = x2[j] * cs[j] + x1[j] * sn[j]; }
        if (hq < 16) {
            v4u o; o.x = pk2(lo[0] * QSCALE, lo[1] * QSCALE); o.y = pk2(lo[2] * QSCALE, lo[3] * QSCALE); o.z = pk2(lo[4] * QSCALE, lo[5] * QSCALE); o.w = pk2(lo[6] * QSCALE, lo[7] * QSCALE);
            *(v4u*)(p.QDB + (size_t)t * 1024 + c0) = o;
            o.x = pk2(hi[0] * QSCALE, hi[1] * QSCALE); o.y = pk2(hi[2] * QSCALE, hi[3] * QSCALE); o.z = pk2(hi[4] * QSCALE, hi[5] * QSCALE); o.w = pk2(hi[6] * QSCALE, hi[7] * QSCALE);
            *(v4u*)(p.QDB + (size_t)t * 1024 + c0 + 32) = o;
        } else {
            const int h = hq - 16, kc = h * 64 + d0;
            v4u ol, oh; ol.x = pk2(lo[0], lo[1]); ol.y = pk2(lo[2], lo[3]); ol.z = pk2(lo[4], lo[5]); ol.w = pk2(lo[6], lo[7]);
            oh.x = pk2(hi[0], hi[1]); oh.y = pk2(hi[2], hi[3]); oh.z = pk2(hi[4], hi[5]); oh.w = pk2(hi[6], hi[7]);
#pragma unroll
            for (int pass = 0; pass < 3; ++pass) { const int sh = 2 * pass; const int pi = (t & ((1 << sh) - 1)) * (T >> sh) + (t >> sh);
                bf16* kb = (pass == 0 ? p.DKF[0] : pass == 1 ? p.DKF[1] : p.DKF[2]) + (size_t)h * T * 64;
                *(v4u*)(kb + kfrag_elem(pi, d0)) = ol; *(v4u*)(kb + kfrag_elem(pi, d0 + 32)) = oh; }
            if (t >= T - 2048) { float* op = p.out + O_DIL_P + (size_t)(t - (T - 2048)) * 2048 + kc;
                *(float4*)op = make_float4(lo[0], lo[1], lo[2], lo[3]); *(float4*)(op + 4) = make_float4(lo[4], lo[5], lo[6], lo[7]);
                *(float4*)(op + 32) = make_float4(hi[0], hi[1], hi[2], hi[3]); *(float4*)(op + 36) = make_float4(hi[4], hi[5], hi[6], hi[7]); }
        }
    }
    for (size_t idx = gt; idx < (size_t)2048 * 256; idx += GT) {
        const int i = (int)(idx >> 8), c4 = (int)(idx & 255);
        *(float4*)(p.out + O_DIL_P + (size_t)i * 2048 + 1024 + c4 * 4) = *(const float4*)(H1 + (size_t)(T - 2048 + i) * 3072 + 2048 + c4 * 4);
    }
    const int lane = F.lane, l15 = lane & 15, grp = lane >> 4;
    for (int unit = F.gw; unit < 3 * 16 * 512; unit += F.NGW) {
        const int st = unit & 511, h = (unit >> 9) & 15, pass = unit >> 13; const int sh = 2 * pass, Td = T >> sh;
        const int pi0 = 32 * st, r = pi0 / Td, s0 = pi0 - r * Td;
        bf16* dst = p.DVF[pass] + (size_t)h * T * 64;
#pragma unroll
        for (int dt = 0; dt < 4; ++dt) {
            float v[8];
#pragma unroll
            for (int j = 0; j < 8; ++j) { const int s = s0 + 16 * (j >> 2) + 4 * grp + (j & 3); const int t = (s << sh) + r;
                v[j] = H1[(size_t)t * 3072 + 2048 + h * 64 + 16 * dt + l15]; }
            v4u o; o.x = pk2(v[0], v[1]); o.y = pk2(v[2], v[3]); o.z = pk2(v[4], v[5]); o.w = pk2(v[6], v[7]);
            *(v4u*)(dst + vfrag_off(st, dt, lane)) = o;
        }
    }
}

__device__ __forceinline__ void dil_pass(const KP& p, int unit, int pass, unsigned char* ldsb, int w4, int lane) {
    asm volatile("" : "+v"(lane));
    const int h = unit & 15, P0 = (unit >> 4) * 256;
    const int l15 = lane & 15, grp = lane >> 4;
    float* stO = (float*)ldsb; float* stML = stO + 256 * 64;
    {
        const int sh = 2 * pass, Td = T >> sh;
        const bf16* KF = (pass == 0 ? p.DKF[0] : pass == 1 ? p.DKF[1] : p.DKF[2]) + (size_t)h * T * 64;
        const bf16* VF = (pass == 0 ? p.DVF[0] : pass == 1 ? p.DVF[1] : p.DVF[2]) + (size_t)h * T * 64;
        for (int tt = 0; tt < 4; ++tt) {
            const int tl = 4 * w4 + tt;
            const int r = tl >> (4 - sh), s0 = (P0 >> sh) + 16 * (tl & ((16 >> sh) - 1));
            const int sq = s0 + l15, tq = (sq << sh) + r, tloc = tq - P0;
            bf16x8 qf[2];
#pragma unroll
            for (int ks = 0; ks < 2; ++ks) qf[ks] = *(const bf16x8*)(p.QDB + (size_t)tq * 1024 + h * 64 + 32 * ks + 8 * grp);
            AttW a;
            if (pass == 0) attw_init(a);
            else {
#pragma unroll
                for (int dt = 0; dt < 4; ++dt) a.o[dt] = *(const f32x4*)(stO + tloc * 64 + 16 * dt + 4 * grp);
                a.m = stML[tloc * 2]; a.l = (grp == 0) ? stML[tloc * 2 + 1] : 0.f;
            }
            int kstart = s0 - 128; if (kstart < 0) kstart = 0; kstart &= ~31;
            const int nsteps = (s0 + 16 - kstart + 31) >> 5;
            const int base = r * Td;
            bf16x8 kf[3][2][2], vf[3][4];
            auto issue = [&](int s, int buf) {
                const int k0 = kstart + 32 * s;
#pragma unroll
                for (int tl2 = 0; tl2 < 2; ++tl2)
#pragma unroll
                    for (int ks = 0; ks < 2; ++ks) kf[buf][tl2][ks] = *(const bf16x8*)(KF + kfrag_off(((base + k0) >> 4) + tl2, ks, lane));
#pragma unroll
                for (int dt = 0; dt < 4; ++dt) vf[buf][dt] = *(const bf16x8*)(VF + vfrag_off((base + k0) >> 5, dt, lane));
            };
            issue(0, 0); if (nsteps > 1) issue(1, 1);
#pragma unroll
            for (int s = 0; s < 5; ++s) {
                if (s < nsteps) {
                    if (s + 2 < nsteps) issue(s + 2, (s + 2) % 3);
                    const int k0 = kstart + 32 * s;
                    f32x4 s0v, s1v; qk_step(kf[s % 3], qf, s0v, s1v);
                    if ((k0 + 31 > s0) || (k0 < s0 + 15 - 128)) {
                        const int pb = k0 + 4 * grp;
#pragma unroll
                        for (int i = 0; i < 4; ++i) { const int p0 = pb + i, p1 = pb + 16 + i;
                            if (p0 > sq || p0 < sq - 128) s0v[i] = -INFINITY; if (p1 > sq || p1 < sq - 128) s1v[i] = -INFINITY; }
                    }
                    att_update(a, s0v, s1v, vf[s % 3]);
                }
            }
            const float lt = grp_sum(a.l);
            if (pass < 2) {
#pragma unroll
                for (int dt = 0; dt < 4; ++dt) *(f32x4*)(stO + tloc * 64 + 16 * dt + 4 * grp) = a.o[dt];
                if (grp == 0) { stML[tloc * 2] = a.m; stML[tloc * 2 + 1] = lt; }
            } else {
                const float il = lt > 0.f ? 1.f / lt : 0.f;
#pragma unroll
                for (int dt = 0; dt < 4; ++dt) { uint2 o; o.x = pk2(a.o[dt][0] * il, a.o[dt][1] * il); o.y = pk2(a.o[dt][2] * il, a.o[dt][3] * il);
                    *(uint2*)(p.MIXB + (size_t)tq * 1024 + h * 64 + 16 * dt + 4 * grp) = o; }
            }
        }
    }
}
__device__ __forceinline__ void ph_dil_combo(const KP& p, const Fr& F) {
    const float* H1 = p.BIGF; const int lane = F.lane;
    const int cw = F.bid * 4 + F.wave;
#pragma unroll 1
    for (int u = 0; u < 4; ++u) {
#pragma unroll
        for (int pass = 0; pass < 3; ++pass) {
            if (F.wave >= 4) dil_pass(p, F.bid + u * F.G, pass, F.lds, F.wave - 4, lane);
            else {
                const int ci = u * 3 + pass;
                const int g0 = ci * 2 + (ci < 8 ? ci : 8), g1 = g0 + 2 + (ci < 8 ? 1 : 0);
                auto srcp = [&](int itn) -> const float4* {
                    const size_t idx = ((size_t)itn * 1024 + cw) * 64 + lane;
                    const int b = (int)(idx >> 20), i = (int)((idx >> 9) & 2047), c4 = (int)(idx & 511);
                    const int c = c4 * 4, r = T + b;
                    const float4* s_old = ((const float4*)p.st_dil) + ((size_t)b * 2048 + (i < 2047 ? i + 1 : 2047)) * 512 + c4;
                    const float4* s_new = (c < 1024) ? (const float4*)(p.KD + (size_t)r * 1024 + c) : (const float4*)(H1 + (size_t)r * 3072 + 2048 + (c - 1024));
                    return (i == 2047) ? s_new : s_old; };
                float4* dstp = (float4*)(p.out + O_DIL_S) + (size_t)cw * 64 + lane;
#pragma unroll 1
                for (int gi = g0; gi < g1; ++gi) {
                    const int i0 = gi * 16;
                    const float4 v0 = *srcp(i0), v1 = *srcp(i0 + 1), v2 = *srcp(i0 + 2), v3 = *srcp(i0 + 3), v4 = *srcp(i0 + 4), v5 = *srcp(i0 + 5), v6 = *srcp(i0 + 6), v7 = *srcp(i0 + 7);
                    const float4 v8 = *srcp(i0 + 8), v9 = *srcp(i0 + 9), v10 = *srcp(i0 + 10), v11 = *srcp(i0 + 11), v12 = *srcp(i0 + 12), v13 = *srcp(i0 + 13), v14 = *srcp(i0 + 14), v15 = *srcp(i0 + 15);
                    float4* d = dstp + (size_t)i0 * 65536;
                    d[0] = v0; d[65536] = v1; d[2 * 65536] = v2; d[3 * 65536] = v3; d[4 * 65536] = v4; d[5 * 65536] = v5; d[6 * 65536] = v6; d[7 * 65536] = v7;
                    d[8 * 65536] = v8; d[9 * 65536] = v9; d[10 * 65536] = v10; d[11 * 65536] = v11; d[12 * 65536] = v12; d[13 * 65536] = v13; d[14 * 65536] = v14; d[15 * 65536] = v15;
                }
            }
            __syncthreads();
        }
    }
}

constexpr int NPHASE = 22;
__global__ void __launch_bounds__(NTHR, 2) mega(KP p) {
    extern __shared__ __attribute__((aligned(16))) unsigned char lds[];
    Fr F; F.lds = lds; F.tid = threadIdx.x; F.lane = 0; F.wave = __builtin_amdgcn_readfirstlane(F.tid >> 6);
    F.bid = blockIdx.x; F.G = gridDim.x; F.gw = F.bid * NWAVES + F.wave; F.NGW = F.G * NWAVES;
    for (int u = F.tid; u < (LDS_BYTES - RING_BYTES) / 4; u += NTHR) ((unsigned*)(lds + RING_BYTES))[u] = 0u;
    __syncthreads();
    XcdBarrier bar; bar.bar = p.ctl + 4096; bar.x = 0; bar.st = nullptr;
    if (!MK_PER_PHASE) bar = xcd_barrier_post(p.ctl + 4096, (volatile LAS unsigned*)(lds + MISC_OFF + 32));
    const int lo = p.ph_lo, hi = p.ph_hi;
#define IN(k) (lo <= (k) && (k) < hi)

    int ph = 0;
#if PROBE_ON
#define PROBE_STAMP(k) do { if (blockIdx.x == 0 && threadIdx.x == 0) ((unsigned long long*)(p.ctl + 65536))[k] = __builtin_amdgcn_s_memrealtime(); } while (0)
#define PROBE_STAMPB(k, blk) do { if (blockIdx.x == (blk) && threadIdx.x == 0) ((unsigned long long*)(p.ctl + 65536))[k] = __builtin_amdgcn_s_memrealtime(); } while (0)
    PROBE_STAMP(0);
#else
#define PROBE_STAMP(k) do { } while (0)
#define PROBE_STAMPB(k, blk) do { } while (0)
#endif
#define PHASE(...) do { { unsigned t_ = threadIdx.x; asm volatile("" : "+v"(t_)); F.lane = (int)(t_ & 63u); } if (IN(ph)) { __VA_ARGS__ } if (IN(ph) && IN(ph + 1)) xcd_barrier(bar); ++ph; PROBE_STAMP(ph); } while (0)
    PHASE(ph_prologue(p, F););
    PHASE(ph_gemm_f32(F, p.ACTB, p.WT_A, PAP, DM, p.BIGF, PA, PA); ph_cmp_samples(p, F););
    PHASE(ph_nsa_prep(p, F); ph_nsa_prep_fast(p, F); ph_gdn_prep(p, F););
    PHASE(ph_gdn_chunks(p, F););
    PHASE(ph_mix_a(p, F););
    PHASE(ph_mix_b(p, F););
    PHASE(ph_gdn_out(p, F););
    PHASE(ph_gemm_bf16(F, p.MIXB, p.WT_OA, DM, p.MOB););
    PHASE(ph_ln_b(F, p.ACTB, p.MOB, p.ln_mix_g, p.ln_mix_b, nullptr, nullptr););
    PHASE(ph_ffn_gemm(p, F, p.WT_FI0, 0););
    PHASE(ph_ffn_fix(p, F, 0););
    PHASE(ph_gemm_bf16(F, p.HFFB, p.WT_FO0, DFF, p.MOB););
    PHASE(ph_ln_b(F, p.ACTB, p.MOB, p.ln_ffn_g, p.ln_ffn_b, nullptr, nullptr););
    PHASE(ph_gemm_f32(F, p.ACTB, p.WT_CI, 3072, DM, p.BIGF, 3072, 3072););
    PHASE(ph_dil_prep(p, F); ph_dil_prep_fast(p, F););
    PHASE(ph_dil_attn(p, F); __syncthreads(); ph_dil_combo(p, F););
    PHASE(ph_gemm_bf16(F, p.MIXB, p.WT_CO, DM, p.MOB););
    PHASE(ph_ln_b(F, p.ACTB, p.MOB, p.ln_mix_g + DM, p.ln_mix_b + DM, nullptr, nullptr););
    PHASE(ph_ffn_gemm(p, F, p.WT_FI1, 1););
    PHASE(ph_ffn_fix(p, F, 1););
    PHASE(ph_gemm_bf16(F, p.HFFB, p.WT_FO1, DFF, p.MOB););
    PHASE(ph_ln_b(F, p.ACTB, p.MOB, p.ln_ffn_g + DM, p.ln_ffn_b + DM, p.out + O_Y_P, p.out + O_Y_S););
#undef PHASE
#if PROBE_ON
    xcd_barrier(bar);
    if (blockIdx.x == 0) { __syncthreads(); const unsigned long long* pts = (const unsigned long long*)(p.ctl + 65536); const float x = (float)(pts[PROBE_B] - pts[PROBE_A]) * 1e-5f;
        for (int i = threadIdx.x; i < NSMP * DM; i += NTHR) p.out[O_Y_S + i] *= (1.f + x); }
#endif
#undef IN
}

static inline size_t align_up(size_t x) { return (x + 255) & ~(size_t)255; }

extern "C" void kernel_launch(void* const* d_in, const int* in_sizes, int n_in, void* d_out, int out_size, void* d_ws, size_t ws_size, hipStream_t stream) {
    static int grid = 0;
    if (grid == 0) {
        int dev = 0, cus = 0, per_cu = 0;
        if (hipGetDevice(&dev) != hipSuccess || hipDeviceGetAttribute(&cus, hipDeviceAttributeMultiprocessorCount, dev) != hipSuccess) { fprintf(stderr, "kernel_launch: device query failed\n"); grid = -1; return; }
        if (hipFuncSetAttribute((const void*)mega, hipFuncAttributeMaxDynamicSharedMemorySize, LDS_BYTES) != hipSuccess) { fprintf(stderr, "kernel_launch: hipFuncSetAttribute failed\n"); grid = -1; return; }
        if (hipOccupancyMaxActiveBlocksPerMultiprocessor(&per_cu, (const void*)mega, NTHR, LDS_BYTES) != hipSuccess || per_cu < 1) { fprintf(stderr, "kernel_launch: occupancy query says %d blocks per CU\n", per_cu); }
        (void)hipGetLastError();
        grid = cus;
    }
    if (grid < 0) return;
    if ((size_t)out_size != O_END) fprintf(stderr, "kernel_launch: out_size %d != expected %zu\n", out_size, (size_t)O_END);
    KP p{};
    p.x_prompt = (const float*)d_in[0]; p.x_sample = (const float*)d_in[1]; p.cache_cmp = (const float*)d_in[2]; p.cache_slc = (const float*)d_in[3];
    p.st_win = (const float*)d_in[4]; p.st_gconv = (const float*)d_in[5]; p.st_gS = (const float*)d_in[6]; p.st_dil = (const float*)d_in[7];
    p.st_ffn = (const float*)d_in[8]; p.page_table = (const int*)d_in[9]; p.w_in_a = (const float*)d_in[10]; p.cw1 = (const float*)d_in[11];
    p.cb1 = (const float*)d_in[12]; p.cw2 = (const float*)d_in[13]; p.cpe = (const float*)d_in[14]; p.gconv_w = (const float*)d_in[15];
    p.gA = (const float*)d_in[16]; p.gdt = (const float*)d_in[17]; p.gnw = (const float*)d_in[18]; p.w_out_a = (const float*)d_in[19];
    p.w_in_c = (const float*)d_in[20]; p.w_out_c = (const float*)d_in[21]; p.ln_mix_g = (const float*)d_in[22]; p.ln_mix_b = (const float*)d_in[23];
    p.ffn_w_in = (const float*)d_in[24]; p.ffn_cw = (const float*)d_in[25]; p.ffn_cb = (const float*)d_in[26]; p.ffn_w_out = (const float*)d_in[27];
    p.ln_ffn_g = (const float*)d_in[28]; p.ln_ffn_b = (const float*)d_in[29];
    p.out = (float*)d_out;
    char* ws = (char*)d_ws; size_t off = 0;
    auto alloc = [&](size_t bytes) { void* q = (void*)(ws + off); off = align_up(off + bytes); return q; };
    p.ctl = (unsigned*)alloc(1 << 20);
    p.WT_A = (bf16*)alloc((size_t)PAP * DM * 2); p.WT_OA = (bf16*)alloc((size_t)DM * DM * 2);
    p.WT_FI0 = (bf16*)alloc((size_t)DFF2 * DM * 2); p.WT_FI1 = (bf16*)alloc((size_t)DFF2 * DM * 2);
    p.WT_FO0 = (bf16*)alloc((size_t)DM * DFF * 2); p.WT_FO1 = (bf16*)alloc((size_t)DM * DFF * 2);
    p.WT_CI = (bf16*)alloc((size_t)3072 * DM * 2); p.WT_CO = (bf16*)alloc((size_t)DM * DM * 2);
    p.ROPE = (float2*)alloc((size_t)(T + 1) * 32 * 8);
    p.ACTB = (bf16*)alloc((size_t)TSP * DM * 2); p.MIXB = (bf16*)alloc((size_t)TSP * DM * 2); p.HFFB = (bf16*)alloc((size_t)TSP * DFF * 2);
    p.KS8 = (unsigned char*)alloc((size_t)2 * T * 64); p.VS8 = (unsigned char*)alloc((size_t)2 * T * 64);
    p.QB = (bf16*)alloc((size_t)T * 512 * 2); p.KSF = (bf16*)alloc((size_t)2 * T * 64 * 2); p.VSF = (bf16*)alloc((size_t)2 * T * 64 * 2);
    p.KWF = (bf16*)alloc((size_t)2 * T * 64 * 2); p.VWF = (bf16*)alloc((size_t)2 * T * 64 * 2); p.CKF = (bf16*)alloc((size_t)2 * 512 * 64 * 2); p.CVF = (bf16*)alloc((size_t)2 * 512 * 64 * 2);
    p.ACP = (bf16*)alloc((size_t)2048 * 2048 * 2);
    p.W2T = (bf16*)alloc((size_t)2 * 64 * 128 * 2);
    p.AC = nullptr; p.WT_C = (bf16*)alloc((size_t)256 * 2048 * 2); p.HID = nullptr; p.SMIXF = (float*)alloc((size_t)NSMP * 3 * 512 * 4);
    p.UB = (float*)alloc((size_t)256 * 4 * DFF2 * 4);
    p.NSACC = (float*)alloc((size_t)T * 512 * 4); p.SEL = (int*)alloc((size_t)2 * T * 16 * 4);
    p.QDB = (bf16*)alloc((size_t)T * 1024 * 2);
    for (int i = 0; i < 3; ++i) { p.DKF[i] = (bf16*)alloc((size_t)T * 1024 * 2); p.DVF[i] = (bf16*)alloc((size_t)T * 1024 * 2); }
    p.G_WF = (bf16*)alloc((size_t)2048 * 4096 * 2); p.G_KDF = (bf16*)alloc((size_t)2048 * 4096 * 2); p.G_QGF = (bf16*)alloc((size_t)2048 * 4096 * 2); p.G_QKF = (bf16*)alloc((size_t)2048 * 4096 * 2);
    p.G_SPF = (bf16*)alloc((size_t)2048 * 4096 * 2); p.G_VNF = (bf16*)alloc((size_t)2048 * 4096 * 2); p.G_UF = (float*)alloc((size_t)2048 * 4096 * 4); p.G_GL = (float*)alloc((size_t)2048 * 4);
    p.MOB = (bf16*)alloc((size_t)TSP * DM * 2);
    p.BIGF = (float*)alloc((size_t)TSP * DFF2 * 4); p.MO = (float*)alloc((size_t)TSP * DM * 4);
    p.X1 = (float*)alloc((size_t)TS * DM * 4); p.X2 = (float*)alloc((size_t)TS * DM * 4); p.X3 = (float*)alloc((size_t)TS * DM * 4);
    p.QR = (float*)alloc((size_t)TS * 512 * 4);
    p.KS = (float*)alloc((size_t)TS * 128 * 4); p.VS = (float*)alloc((size_t)TS * 128 * 4); p.KW = (float*)alloc((size_t)TS * 128 * 4); p.VW = (float*)alloc((size_t)TS * 128 * 4);
    p.CK = (float*)alloc((size_t)33 * 512 * 128 * 4); p.CV = (float*)alloc((size_t)33 * 512 * 128 * 4);
    p.GQ = (float*)alloc((size_t)TS * 512 * 4); p.GK = (float*)alloc((size_t)TS * 512 * 4); p.GV = (float*)alloc((size_t)TS * 512 * 4); p.OG = (float*)alloc((size_t)TS * 512 * 4);
    p.Gg = (float*)alloc((size_t)TS * 8 * 4); p.Gb = (float*)alloc((size_t)TS * 8 * 4);
    p.QD = (float*)alloc((size_t)TS * DM * 4); p.KD = (float*)alloc((size_t)TS * DM * 4);
    if (off > ws_size) { fprintf(stderr, "kernel_launch: workspace too small: need %zu have %zu\n", off, ws_size); return; }
    if (hipMemsetAsync(p.ctl, 0, 1 << 20, stream) != hipSuccess) { fprintf(stderr, "kernel_launch: memset failed\n"); return; }
#if MK_PER_PHASE
    for (int k = 0; k < NPHASE; ++k) { p.ph_lo = k; p.ph_hi = k + 1; hipLaunchKernelGGL(mega, dim3(grid), dim3(NTHR), LDS_BYTES, stream, p); }
#else
    p.ph_lo = 0; p.ph_hi = NPHASE;
    hipLaunchKernelGGL(mega, dim3(grid), dim3(NTHR), LDS_BYTES, stream, p);
#endif
    const hipError_t le = hipPeekAtLastError();
    if (le != hipSuccess) fprintf(stderr, "kernel_launch: launch failed: %s\n", hipGetErrorName(le));
}
```

```cpp
#include <hip/hip_runtime.h>
#include <cstdint>
#include <cstdio>
#include <cmath>

namespace pg8 {
#define PG8_LAS __attribute__((address_space(3)))
typedef unsigned short bf16_t;
typedef short bf16x8 __attribute__((ext_vector_type(8)));
typedef float f32x4 __attribute__((ext_vector_type(4)));
typedef unsigned u32x4 __attribute__((ext_vector_type(4)));
constexpr int BM = 256, BK = 64, HALF = 128, HTB = HALF * BK * 2  , STAGE_BYTES = 8 * HTB, NXCD = 8, WGM = 8;

__host__ __device__ __forceinline__ int lds_byte(int r, int c) { const int st = (r >> 4) * 2 + (c >> 5), rr = r & 15, cc = c & 31, ob = rr * 64 + cc * 2; return st * 1024 + (ob ^ (((ob >> 9) & 1) << 5)); }
__host__ __device__ __forceinline__ void stage_rc(int b, int& R, int& C) { const int st = b / 1024, sb = b % 1024, swz = sb ^ (((sb >> 9) & 1) << 5); R = (st >> 1) * 16 + swz / 64; C = (st & 1) * 32 + (swz % 64) / 2; }
__host__ __device__ __forceinline__ int perm32(int rho) { const int n = rho >> 4, i = rho & 15; return 8 * (i >> 2) + 4 * n + (i & 3); }

struct Unit { int pm, pn; };
struct Gemm { const bf16_t* A; const bf16_t* Bt; int M, N, K; };

struct StaticOrder {
    int nM, nN, nwg, G, c;
    __host__ __device__ void init(int M, int N, int G_, int c_) { nM = M / BM; nN = N / BM; nwg = nM * nN; G = G_; c = c_; }
    __host__ __device__ bool next(int i, Unit& u) const {
        const long L = (long)i * G + c; if (L >= nwg) return false;
        int wgid = (int)L; { const int q = nwg / NXCD, r = nwg % NXCD, xcd = wgid % NXCD, off = wgid / NXCD; wgid = (xcd < r ? xcd * (q + 1) : r * (q + 1) + (xcd - r) * q) + off; }
        const int nig = WGM * nN, gid = wgid / nig, fm = gid * WGM, gsz = (nM - fm) < WGM ? (nM - fm) : WGM;
        u.pm = fm + ((wgid % nig) % gsz); u.pn = (wgid % nig) / gsz; return true;
    }
    __device__ __forceinline__ void a_ready(const Unit&) const {}
    __device__ __forceinline__ void done(const Unit&) const {}
};

typedef __bf16 bf16x2_t __attribute__((ext_vector_type(2)));
typedef float f32x2_t __attribute__((ext_vector_type(2)));
__device__ __forceinline__ unsigned cvt_pk_bf16(float lo, float hi) { const f32x2_t v = {lo, hi}; return __builtin_bit_cast(unsigned, __builtin_convertvector(v, bf16x2_t)); }
typedef float f32x2 __attribute__((ext_vector_type(2)));
__device__ __forceinline__ f32x2 gelu_pk(f32x2 v) {
    const f32x2 av = __builtin_elementwise_abs(v), d = av * 0.2316418882f + 1.0f;
    f32x2 t; t.x = __builtin_amdgcn_rcpf(d.x); t.y = __builtin_amdgcn_rcpf(d.y);
    f32x2 q = t * 0.5307027145f + (-0.7265760135f); q = q * t + 0.7107068705f; q = q * t + (-0.142248368f); q = q * t + 0.127414796f; q = q * t;
    const f32x2 s = (v * v) * (-0.72134752044f);
    f32x2 e; e.x = __builtin_amdgcn_exp2f(s.x); e.y = __builtin_amdgcn_exp2f(s.y);
    const f32x2 m = v * (q * e), r = v - m;
    f32x2 o; o.x = v.x < 0.f ? m.x : r.x; o.y = v.y < 0.f ? m.y : r.y; return o;
}

template <int ACT  > struct EpiBf16 {
    static constexpr bool PERM = true, AFTER_DRAIN = false; static_assert(ACT == 0 || ACT == 1, "EpiBf16: ACT is 0 (none) or 1 (gelu_pk)");
    bf16_t* O; int ldc; const float* bias; int split_cols; size_t split_stride; float scale0;
    __device__ __forceinline__ void operator()(const f32x4 (&acc)[2][2][4][2], const Unit& u, int wr, int wc, int fr, int fq) const {
        const int row0 = u.pm * BM + wr * 64 + fr; int colt = u.pn * BM; bf16_t* base = O;
        float sc = 1.f; if (split_cols) { const int t = colt / split_cols; base += (size_t)t * split_stride; colt -= t * split_cols; if (t == 0) sc = scale0; }
        const int col0 = colt + wc * 32 + 8 * fq, bcol0 = u.pn * BM + wc * 32 + 8 * fq;
        f32x4 bv[2][2];
#pragma unroll
        for (int bj = 0; bj < 2; ++bj)
#pragma unroll
            for (int n = 0; n < 2; ++n) bv[bj][n] = bias ? *(const f32x4*)(bias + bcol0 + bj * HALF + 4 * n) : (f32x4){0.f, 0.f, 0.f, 0.f};
#pragma unroll
        for (int ai = 0; ai < 2; ++ai)
#pragma unroll
            for (int m = 0; m < 4; ++m) { bf16_t* rowp = base + (size_t)(row0 + ai * HALF + m * 16) * ldc + col0;
#pragma unroll
                for (int bj = 0; bj < 2; ++bj) { f32x4 v0 = acc[ai][bj][m][0] + bv[bj][0], v1 = acc[ai][bj][m][1] + bv[bj][1];
                    if (ACT == 1) { f32x2 a = gelu_pk((f32x2){v0[0], v0[1]}), b = gelu_pk((f32x2){v0[2], v0[3]}), c = gelu_pk((f32x2){v1[0], v1[1]}), d = gelu_pk((f32x2){v1[2], v1[3]});
                        v0 = (f32x4){a.x, a.y, b.x, b.y}; v1 = (f32x4){c.x, c.y, d.x, d.y}; }
                    v0 = v0 * sc; v1 = v1 * sc; u32x4 w; w.x = cvt_pk_bf16(v0[0], v0[1]); w.y = cvt_pk_bf16(v0[2], v0[3]); w.z = cvt_pk_bf16(v1[0], v1[1]); w.w = cvt_pk_bf16(v1[2], v1[3]);
                    *(u32x4*)(rowp + bj * HALF) = w; } }
    }
};

struct EpiF32 {
    static constexpr bool PERM = false, AFTER_DRAIN = false;
    float* O; int ldc; int ncols;
    __device__ __forceinline__ void operator()(const f32x4 (&acc)[2][2][4][2], const Unit& u, int wr, int wc, int fr, int fq) const {
        const int row0 = u.pm * BM + wr * 64 + fr; const int col0 = u.pn * BM + wc * 32 + 4 * fq;
#pragma unroll
        for (int ai = 0; ai < 2; ++ai)
#pragma unroll
            for (int m = 0; m < 4; ++m) { float* rowp = O + (size_t)(row0 + ai * HALF + m * 16) * ldc;
#pragma unroll
                for (int bj = 0; bj < 2; ++bj)
#pragma unroll
                    for (int n = 0; n < 2; ++n) { const int c = col0 + bj * HALF + n * 16; if (c < ncols) *(f32x4*)(rowp + c) = acc[ai][bj][m][n]; } }
    }
};
template <class Epi, class Sched, bool ALIGN_EPI = false, bool SP2 = false>
__device__ __forceinline__ void gemm_phase(PG8_LAS unsigned char* lds, const Gemm g, const Sched& S, const Epi& E) {
    const int tid = threadIdx.x, wid = __builtin_amdgcn_readfirstlane(tid >> 6), lane = tid & 63, wr = wid >> 2, wc = wid & 3, fr = lane & 15, fq = lane >> 4;
    const int K = g.K, nt = K / BK;
    unsigned voffA[2], voffB[2];
#pragma unroll
    for (int i = 0; i < 2; ++i) { int R, C; stage_rc(tid * 16 + i * 8192, R, C); const int Rb = Epi::PERM ? ((R & ~31) + perm32(R & 31)) : R;
        voffA[i] = (unsigned)(R * K + C) * 2u; voffB[i] = (unsigned)(Rb * K + C) * 2u; }
    const size_t kstep = (size_t)(BK * 2);
    const size_t hstep = (size_t)HALF * K * 2;
    const size_t tstep = 2 * hstep;
    const unsigned ldsw = (unsigned)wid * 1024u;
    const int aoff = lds_byte(wr * 64 + fr, fq * 8), boff = lds_byte(wc * 32 + fr, fq * 8);
#define PG8_SA(b, h) (((b) * 2 + (h)) * HTB)
#define PG8_SB(b, h) ((4 + (b) * 2 + (h)) * HTB)
#define PG8_STAGE(bufoff, gbase, voff) do { _Pragma("unroll") for (int _i = 0; _i < 2; ++_i) \
        __builtin_amdgcn_global_load_lds((const unsigned*)((const char*)(gbase) + (voff)[_i]), (PG8_LAS unsigned*)(lds + (bufoff) + ldsw + _i * 8192), 16, 0, 0); } while (0)
#define PG8_LDA(dst, b, h) do { _Pragma("unroll") for (int m = 0; m < 4; ++m) _Pragma("unroll") for (int k = 0; k < 2; ++k) dst[m][k] = *(const PG8_LAS bf16x8*)(lds + PG8_SA(b, h) + aoff + m * 2048 + k * 1024); } while (0)
#define PG8_LDB(dst, b, h) do { _Pragma("unroll") for (int n = 0; n < 2; ++n) _Pragma("unroll") for (int k = 0; k < 2; ++k) dst[n][k] = *(const PG8_LAS bf16x8*)(lds + PG8_SB(b, h) + boff + n * 2048 + k * 1024); } while (0)
#define PG8_MMA(ai, bj, At, Bt) do { __builtin_amdgcn_s_setprio(1); _Pragma("unroll") for (int m = 0; m < 4; ++m) _Pragma("unroll") for (int n = 0; n < 2; ++n) _Pragma("unroll") for (int k = 0; k < 2; ++k) \
        acc[ai][bj][m][n] = __builtin_amdgcn_mfma_f32_16x16x32_bf16(Bt[n][k], At[m][k], acc[ai][bj][m][n], 0, 0, 0); __builtin_amdgcn_s_setprio(0); } while (0)
#define PG8_WAIT_V(n) asm volatile("s_waitcnt vmcnt(" #n ")" ::: "memory")
#define PG8_WAIT_L(n) asm volatile("s_waitcnt lgkmcnt(" #n ")" ::: "memory")
#define PG8_BAR __builtin_amdgcn_s_barrier()
#define PG8_SCHED __builtin_amdgcn_sched_barrier(0)
    Unit cur, nxt; int ui = 0;
    if (!S.next(0, cur)) return;
    f32x4 acc[2][2][4][2];
#pragma unroll
    for (int a = 0; a < 2; ++a)
#pragma unroll
        for (int b = 0; b < 2; ++b)
#pragma unroll
            for (int m = 0; m < 4; ++m)
#pragma unroll
                for (int n = 0; n < 2; ++n) acc[a][b][m][n] = (f32x4){0.f, 0.f, 0.f, 0.f};
    bf16x8 At[4][2], B0[2][2], B1[2][2];
    const char* cA = (const char*)g.A + (size_t)cur.pm * tstep; const char* cB = (const char*)g.Bt + (size_t)cur.pn * tstep;
    S.a_ready(cur);
    if constexpr (SP2) {
        PG8_STAGE(PG8_SB(0, 0), cB, voffB); PG8_STAGE(PG8_SB(0, 1), cB + hstep, voffB); PG8_STAGE(PG8_SA(0, 0), cA, voffA); PG8_STAGE(PG8_SA(0, 1), cA + hstep, voffA);
        if (wr == 1) PG8_BAR;
        PG8_WAIT_V(2); PG8_BAR;
        PG8_STAGE(PG8_SB(1, 0), cB + kstep, voffB); PG8_STAGE(PG8_SA(1, 0), cA + kstep, voffA); PG8_STAGE(PG8_SB(1, 1), cB + hstep + kstep, voffB);
        PG8_WAIT_V(6); PG8_BAR;
    } else {
        PG8_STAGE(PG8_SB(0, 0), cB, voffB); PG8_STAGE(PG8_SA(0, 0), cA, voffA); PG8_STAGE(PG8_SB(0, 1), cB + hstep, voffB); PG8_STAGE(PG8_SA(0, 1), cA + hstep, voffA);
        if (wr == 1) PG8_BAR;
        PG8_WAIT_V(4); PG8_BAR;
        PG8_STAGE(PG8_SB(1, 0), cB + kstep, voffB); PG8_STAGE(PG8_SA(1, 0), cA + kstep, voffA); PG8_STAGE(PG8_SB(1, 1), cB + hstep + kstep, voffB);
        PG8_WAIT_V(6); PG8_BAR;
    }
    for (;;) {
        const bool has_next = S.next(ui + 1, nxt);
        const char* nA = has_next ? (const char*)g.A + (size_t)nxt.pm * tstep : cA; const char* nB = has_next ? (const char*)g.Bt + (size_t)nxt.pn * tstep : cB;
        for (int t = 0; t < nt; t += 2) {
            const bool last = (t == nt - 2);
            const char* a1 = cA + (size_t)(t + 1) * kstep;
            const char* a2 = last ? nA : cA + (size_t)(t + 2) * kstep; const char* b2 = last ? nB : cB + (size_t)(t + 2) * kstep;
            const char* a3 = a2 + kstep; const char* b3 = b2 + kstep;
            if (last && has_next) S.a_ready(nxt);
            if constexpr (SP2) {
            PG8_LDB(B0, 0, 0); PG8_LDB(B1, 0, 1); PG8_SCHED; PG8_LDA(At, 0, 0); PG8_STAGE(PG8_SA(1, 1), a1 + hstep, voffA);
            PG8_WAIT_V(8); PG8_WAIT_L(0); PG8_BAR; PG8_MMA(0, 0, At, B0); PG8_MMA(0, 1, At, B1); PG8_BAR; PG8_SCHED;
            PG8_LDA(At, 0, 1); PG8_STAGE(PG8_SB(0, 0), b2, voffB); PG8_STAGE(PG8_SB(0, 1), b2 + hstep, voffB); PG8_STAGE(PG8_SA(0, 0), a2, voffA);
            PG8_WAIT_V(8); PG8_WAIT_L(0); PG8_BAR; PG8_MMA(1, 0, At, B0); PG8_MMA(1, 1, At, B1); PG8_BAR; PG8_SCHED;
            PG8_LDB(B0, 1, 0); PG8_LDB(B1, 1, 1); PG8_SCHED; PG8_LDA(At, 1, 0); PG8_STAGE(PG8_SA(0, 1), a2 + hstep, voffA);
            PG8_WAIT_V(8); PG8_WAIT_L(0); PG8_BAR; PG8_MMA(0, 0, At, B0); PG8_MMA(0, 1, At, B1); PG8_BAR; PG8_SCHED;
            PG8_LDA(At, 1, 1); PG8_STAGE(PG8_SB(1, 0), b3, voffB); PG8_STAGE(PG8_SB(1, 1), b3 + hstep, voffB); PG8_STAGE(PG8_SA(1, 0), a3, voffA);
            PG8_WAIT_V(8); PG8_WAIT_L(0); PG8_BAR; PG8_MMA(1, 0, At, B0); PG8_MMA(1, 1, At, B1); PG8_BAR; PG8_SCHED;
            } else {
            PG8_LDB(B0, 0, 0); PG8_SCHED; PG8_LDA(At, 0, 0); PG8_STAGE(PG8_SA(1, 1), a1 + hstep, voffA);
            PG8_WAIT_L(8); PG8_BAR; PG8_WAIT_L(0); PG8_MMA(0, 0, At, B0); PG8_BAR; PG8_SCHED;
            PG8_LDB(B1, 0, 1); PG8_STAGE(PG8_SB(0, 0), b2, voffB);
            PG8_BAR; PG8_WAIT_L(0); PG8_MMA(0, 1, At, B1); PG8_BAR;
            PG8_LDA(At, 0, 1); PG8_STAGE(PG8_SA(0, 0), a2, voffA);
            PG8_BAR; PG8_WAIT_L(0); PG8_MMA(1, 0, At, B0); PG8_BAR; PG8_SCHED;
            PG8_STAGE(PG8_SB(0, 1), b2 + hstep, voffB);
            PG8_WAIT_V(6); PG8_BAR; PG8_MMA(1, 1, At, B1); PG8_BAR;
            PG8_LDB(B0, 1, 0); PG8_SCHED; PG8_LDA(At, 1, 0); PG8_STAGE(PG8_SA(0, 1), a2 + hstep, voffA);
            PG8_WAIT_L(8); PG8_BAR; PG8_WAIT_L(0); PG8_MMA(0, 0, At, B0); PG8_BAR; PG8_SCHED;
            PG8_LDB(B1, 1, 1); PG8_STAGE(PG8_SB(1, 0), b3, voffB);
            PG8_BAR; PG8_WAIT_L(0); PG8_MMA(0, 1, At, B1); PG8_BAR;
            PG8_LDA(At, 1, 1); PG8_STAGE(PG8_SA(1, 0), a3, voffA);
            PG8_BAR; PG8_WAIT_L(0); PG8_MMA(1, 0, At, B0); PG8_BAR; PG8_SCHED;
            PG8_STAGE(PG8_SB(1, 1), b3 + hstep, voffB);
            PG8_WAIT_V(6); PG8_BAR; PG8_MMA(1, 1, At, B1); PG8_BAR;
            }
        }
        if constexpr (ALIGN_EPI) { if (wr == 0) PG8_BAR; }
        if constexpr (!Epi::AFTER_DRAIN) { E(acc, cur, wr, wc, fr, fq); S.done(cur); }
        if (!has_next) break;
#pragma unroll
        for (int a = 0; a < 2; ++a)
#pragma unroll
            for (int b = 0; b < 2; ++b)
#pragma unroll
                for (int m = 0; m < 4; ++m)
#pragma unroll
                    for (int n = 0; n < 2; ++n) acc[a][b][m][n] = (f32x4){0.f, 0.f, 0.f, 0.f};
        cur = nxt; cA = nA; cB = nB; ++ui;
        if constexpr (ALIGN_EPI) { if (wr == 1) PG8_BAR; }
    }
    PG8_WAIT_V(0);
    if constexpr (!ALIGN_EPI) { if (wr == 0) PG8_BAR; }
    PG8_BAR;
    if constexpr (Epi::AFTER_DRAIN) { E.fused(acc, cur, wr, wc, fr, fq, lds, wid, lane); S.done(cur); }
#undef PG8_SA
#undef PG8_SB
#undef PG8_STAGE
#undef PG8_LDA
#undef PG8_LDB
#undef PG8_MMA
#undef PG8_WAIT_V
#undef PG8_WAIT_L
#undef PG8_BAR
#undef PG8_SCHED
}
}

#define LAS __attribute__((address_space(3)))
#define XB_TMO      128
#define XB_XCNT(j)  (256  + 64 * (j))
#define XB_XSUB(j)  (1280 + 64 * (j))
#define XB_XGEN(j)  (2304 + 64 * (j))
#define XB_TOP      3328
#define XB_TOPGEN   3392
#define XCD_BAR_WORDS 3456
#define XB_SPIN_CAP (1u << 26)

__device__ __forceinline__ unsigned xb_ld(unsigned* p)              { return __hip_atomic_load(p, __ATOMIC_RELAXED, __HIP_MEMORY_SCOPE_AGENT); }
__device__ __forceinline__ unsigned xb_add(unsigned* p, unsigned v) { return __hip_atomic_fetch_add(p, v, __ATOMIC_RELAXED, __HIP_MEMORY_SCOPE_AGENT); }
__device__ __forceinline__ unsigned xb_xcc_id() { return (unsigned)__builtin_amdgcn_s_getreg((3 << 11) | 20) & 0xFu; }
#define XB_SPIN(cond, bar) do { unsigned _sp = 0; while (cond) { __builtin_amdgcn_s_sleep(1); \
    if ((++_sp & 255u) == 0u) { if (xb_ld(&(bar)[XB_TMO])) break; if (_sp > XB_SPIN_CAP) { atomicAdd(&(bar)[XB_TMO], 1u); break; } } } } while (0)

struct XcdBarrier {
    unsigned* bar; unsigned x;
    volatile LAS unsigned* st;
};

__device__ __forceinline__ XcdBarrier xcd_barrier_post(unsigned* bar, volatile LAS unsigned* st) {
    XcdBarrier b; b.bar = bar; b.x = xb_xcc_id(); b.st = st;
    if (threadIdx.x == 0) (void)xb_add(&bar[XB_XCNT(b.x)], 1u);
    return b;
}
__device__ __forceinline__ void xcd_barrier_complete(unsigned* bar, unsigned x, unsigned& nloc, unsigned& nx) {
    const unsigned G = gridDim.x * gridDim.y * gridDim.z;
    unsigned sum, cnt, mine, sp = 0u;
    for (;;) {
        sum = 0u; cnt = 0u; mine = 0u;
#pragma unroll
        for (unsigned j = 0; j < 16; ++j) { const unsigned c = xb_ld(&bar[XB_XCNT(j)]); sum += c; cnt += (c > 0u) ? 1u : 0u; mine = (j == x) ? c : mine; }
        if (sum == G) break;
        __builtin_amdgcn_s_sleep(1);
        if ((++sp & 255u) == 0u) { if (xb_ld(&bar[XB_TMO])) break; if (sp > XB_SPIN_CAP) { atomicAdd(&bar[XB_TMO], 1u); break; } }
    }
    nloc = mine > 0u ? mine : 1u; nx = cnt > 0u ? cnt : 1u;
}

__device__ __forceinline__ void xcd_barrier(const XcdBarrier& b) {
    asm volatile("s_waitcnt vmcnt(0)" ::: "memory");
    __syncthreads();
    if (threadIdx.x == 0) {
        unsigned* bar = b.bar;
        __builtin_amdgcn_s_waitcnt(0);
        unsigned nloc = b.st[0], nx = b.st[1];
        if (nloc == 0u) { xcd_barrier_complete(bar, b.x, nloc, nx); b.st[0] = nloc; b.st[1] = nx; }
        const unsigned old = xb_add(&bar[XB_XSUB(b.x)], 1u);
        const unsigned gen = old / nloc;
        if (old + 1u == (gen + 1u) * nloc) {
            __builtin_amdgcn_fence(__ATOMIC_RELEASE, "agent");
            asm volatile("s_waitcnt vmcnt(0)" ::: "memory");
            const unsigned og = xb_add(&bar[XB_TOP], 1u);
            const unsigned tg = og / nx;
            if (og + 1u == (tg + 1u) * nx) xb_add(&bar[XB_TOPGEN], 1u);
            else XB_SPIN(xb_ld(&bar[XB_TOPGEN]) == tg, bar);
            __builtin_amdgcn_fence(__ATOMIC_ACQUIRE, "agent");
            xb_add(&bar[XB_XGEN(b.x)], 1u);
            asm volatile("s_waitcnt vmcnt(0)" ::: "memory");
        } else {
            XB_SPIN(xb_ld(&bar[XB_XGEN(b.x)]) == gen, bar);
            __builtin_amdgcn_fence(__ATOMIC_ACQUIRE, "agent");
            asm volatile("s_waitcnt vmcnt(0)" ::: "memory");
        }
    }
    __syncthreads();
}

#ifndef PG8_SP2
#define PG8_SP2 true
#endif
#ifndef PG8_ALIGN
#define PG8_ALIGN true
#endif
#ifndef PROBE_ON
#define PROBE_ON 0
#define PROBE_A 0
#define PROBE_B 1
#endif
#ifndef MK_PER_PHASE
#define MK_PER_PHASE 0
#endif

constexpr int T = 16384, NSMP = 32, TS = T + NSMP, TSP = T + 256, DM = 1024;
constexpr int PA = 3368, PAP = 3584;
constexpr int C_Q = 0, C_KC = 512, C_VC = 640, C_KS = 768, C_VS = 896, C_KW = 1024, C_VW = 1152, C_GATE = 1280,
              C_GQKV = 1304, C_A = 2840, C_BT = 2848, C_Z = 2856;
constexpr int DFF = 2816, DFF2 = 5632;
constexpr float DN_ALPHA = 1.4142135623730951f;
constexpr float LN_EPS = 1e-5f, NORM_EPS = 1e-6f;
constexpr int NPAGES = 128;
constexpr int NWAVES = 8, NTHR = 512;

constexpr size_t O_Y_P = 0;
constexpr size_t O_Y_S = O_Y_P + (size_t)T * DM;
constexpr size_t O_CMP_P = O_Y_S + (size_t)NSMP * DM;
constexpr size_t O_CMP_S = O_CMP_P + (size_t)T * 256;
constexpr size_t O_SLC_P = O_CMP_S + (size_t)NSMP * 256;
constexpr size_t O_SLC_S = O_SLC_P + (size_t)T * 256;
constexpr size_t O_WIN_P = O_SLC_S + (size_t)NSMP * 256;
constexpr size_t O_WIN_S = O_WIN_P + (size_t)512 * 256;
constexpr size_t O_GCONV_P = O_WIN_S + (size_t)NSMP * 512 * 256;
constexpr size_t O_GCONV_S = O_GCONV_P + (size_t)3 * 1536;
constexpr size_t O_GS_P = O_GCONV_S + (size_t)NSMP * 3 * 1536;
constexpr size_t O_GS_S = O_GS_P + (size_t)8 * 64 * 64;
constexpr size_t O_DIL_P = O_GS_S + (size_t)NSMP * 8 * 64 * 64;
constexpr size_t O_DIL_S = O_DIL_P + (size_t)2048 * 2048;
constexpr size_t O_FFN_P = O_DIL_S + (size_t)NSMP * 2048 * 2048;
constexpr size_t O_FFN_S = O_FFN_P + (size_t)2 * 2 * DFF2;
constexpr size_t O_END = O_FFN_S + (size_t)NSMP * 2 * 2 * DFF2;

constexpr int RING_BYTES = 131072;
constexpr int FAST_WL = 17408;
constexpr int MISC_OFF = 8 * FAST_WL + 64;
constexpr int LDS_BYTES = 147456;

typedef unsigned short bf16;
typedef unsigned v4u __attribute__((ext_vector_type(4)));

__device__ __forceinline__ unsigned f2bf(float f) { return (unsigned)__builtin_bit_cast(unsigned short, (__bf16)f); }
__device__ __forceinline__ unsigned pk2(float lo, float hi) { return pg8::cvt_pk_bf16(lo, hi); }
typedef short bf16x8 __attribute__((ext_vector_type(8)));
typedef float f32x4 __attribute__((ext_vector_type(4)));
#define MFMA16(a, b, c) __builtin_amdgcn_mfma_f32_16x16x32_bf16((a), (b), (c), 0, 0, 0)
__device__ __forceinline__ float wave_sum(float v) {
#pragma unroll
    for (int o = 1; o < 64; o <<= 1) v += __shfl_xor(v, o);
    return v;
}
__device__ __forceinline__ float wave_max(float v) {
#pragma unroll
    for (int o = 1; o < 64; o <<= 1) v = fmaxf(v, __shfl_xor(v, o));
    return v;
}
__device__ __forceinline__ void wave_lds_sync() { asm volatile("s_waitcnt lgkmcnt(0)" ::: "memory"); __builtin_amdgcn_wave_barrier(); asm volatile("" ::: "memory"); }
__device__ __forceinline__ float fexp_(float x) { return __builtin_amdgcn_exp2f(x * 1.4426950408889634f); }
__device__ __forceinline__ float fsilu_(float x) { return x * __builtin_amdgcn_rcpf(1.f + fexp_(-x)); }
__device__ __forceinline__ float sigmoidf_(float x) { return 1.f / (1.f + expf(-x)); }
__device__ __forceinline__ float siluf_(float x) { return x / (1.f + expf(-x)); }
__device__ __forceinline__ float gelu_tanh(float x) { const float c = 0.7978845608028654f; return 0.5f * x * (1.f + tanhf(c * (x + 0.044715f * x * x * x))); }
__device__ __forceinline__ float softplusf_(float x) { return x > 20.f ? x : log1pf(expf(x)); }

struct KP {
    const float *x_prompt, *x_sample, *cache_cmp, *cache_slc, *st_win, *st_gconv, *st_gS, *st_dil, *st_ffn;
    const int* page_table;
    const float *w_in_a, *cw1, *cb1, *cw2, *cpe, *gconv_w, *gA, *gdt, *gnw, *w_out_a, *w_in_c, *w_out_c, *ln_mix_g, *ln_mix_b,
                *ffn_w_in, *ffn_cw, *ffn_cb, *ffn_w_out, *ln_ffn_g, *ln_ffn_b;
    float* out;
    unsigned* ctl;
    bf16 *WT_A, *WT_OA, *WT_FI0, *WT_FI1, *WT_FO0, *WT_FO1, *WT_CI, *WT_CO;
    float2* ROPE;
    bf16 *ACTB, *MIXB, *HFFB, *MOB, *H1B;
    bf16 *QB, *KSF, *VSF, *KWF, *VWF, *CKF, *CVF;
    unsigned char *KS8, *VS8;
    bf16 *QDB; bf16* DKF[3]; bf16* DVF[3];
    bf16 *AC, *WT_C, *HID, *W2T, *ACP; float* SMIXF; float* NSACC; int* SEL; float* UB;
    bf16 *G_WF, *G_KDF, *G_QGF, *G_QKF, *G_SPF, *G_VNF; float *G_UF, *G_GL;
    float *BIGF, *MO, *X1, *X2, *X3, *QR, *KS, *VS, *KW, *VW, *CK, *CV, *GQ, *GK, *GV, *OG, *Gg, *Gb, *QD, *KD;
    int ph_lo, ph_hi;
};

struct Fr { unsigned char* lds; int tid, lane, wave, gw, NGW, bid, G; };

__device__ __forceinline__ int ffn_row(int u) { const int half = u >= DFF ? 1 : 0, jc = u - half * DFF; return 256 * (jc >> 7) + 128 * half + (jc & 127); }
__device__ __forceinline__ void transpose_item(const float* W, int K, int N, int NT, bf16* WT, float* scr, int item, int lane, int rowmap = 0) {
    const int nblk = NT / 32, kb = item / nblk, nb = item % nblk, k0 = 64 * kb, n0 = 32 * nb;
#pragma unroll 8
    for (int i = 0; i < 32; ++i) { const int kk = 2 * i + (lane >> 5); const int n = n0 + (lane & 31); scr[kk * 33 + (lane & 31)] = (n < N) ? W[(size_t)(k0 + kk) * N + n] : 0.f; }
    wave_lds_sync();
    const int c = lane & 7;
#pragma unroll
    for (int j = 0; j < 4; ++j) { const int n = (lane >> 3) + 8 * j; const float* s = scr + (8 * c) * 33 + n;
        v4u o; o.x = pk2(s[0 * 33], s[1 * 33]); o.y = pk2(s[2 * 33], s[3 * 33]); o.z = pk2(s[4 * 33], s[5 * 33]); o.w = pk2(s[6 * 33], s[7 * 33]);
        const int row = rowmap ? ffn_row(n0 + n) : n0 + n;
        *(v4u*)(WT + (size_t)row * K + k0 + 8 * c) = o; }
    wave_lds_sync();
}
__device__ __forceinline__ void ph_prologue(const KP& p, const Fr& F) {
    float* scr = (float*)(F.lds + F.wave * 16384);
    const int I_A = 16 * (PAP / 32), I_OA = 16 * 32, I_FI = 16 * (DFF2 / 32), I_FO = (DFF / 64) * 32, I_CI = 16 * (3072 / 32), I_CO = 16 * 32;
    const int NITEMS = I_A + I_OA + 2 * I_FI + 2 * I_FO + I_CI + I_CO + 256 + 8;
    for (int it = F.gw; it < NITEMS; it += F.NGW) {
        int r = it;
        if (r < I_A) { transpose_item(p.w_in_a, DM, PA, PAP, p.WT_A, scr, r, F.lane); continue; } r -= I_A;
        if (r < I_OA) { transpose_item(p.w_out_a, DM, DM, DM, p.WT_OA, scr, r, F.lane); continue; } r -= I_OA;
        if (r < I_FI) { transpose_item(p.ffn_w_in, DM, DFF2, DFF2, p.WT_FI0, scr, r, F.lane, 1); continue; } r -= I_FI;
        if (r < I_FI) { transpose_item(p.ffn_w_in + (size_t)DM * DFF2, DM, DFF2, DFF2, p.WT_FI1, scr, r, F.lane, 1); continue; } r -= I_FI;
        if (r < I_FO) { transpose_item(p.ffn_w_out, DFF, DM, DM, p.WT_FO0, scr, r, F.lane); continue; } r -= I_FO;
        if (r < I_FO) { transpose_item(p.ffn_w_out + (size_t)DFF * DM, DFF, DM, DM, p.WT_FO1, scr, r, F.lane); continue; } r -= I_FO;
        if (r < I_CI) { transpose_item(p.w_in_c, DM, 3072, 3072, p.WT_CI, scr, r, F.lane); continue; } r -= I_CI;
        if (r < I_CO) { transpose_item(p.w_out_c, DM, DM, DM, p.WT_CO, scr, r, F.lane); continue; } r -= I_CO;
        if (r < 256) { const int kv = r >> 7; transpose_item(p.cw1 + (size_t)kv * 2048 * 128, 2048, 128, 128, p.WT_C + (size_t)kv * 128 * 2048, scr, r & 127, F.lane); continue; } r -= 256;
        { const int kv = r >> 2; transpose_item(p.cw2 + (size_t)kv * 128 * 64, 128, 64, 64, p.W2T + (size_t)kv * 64 * 128, scr, r & 3, F.lane); }
    }
    const size_t gt = (size_t)F.bid * NTHR + F.tid, GT = (size_t)F.G * NTHR;
    for (size_t i4 = gt; i4 < (size_t)TSP * (DM / 4); i4 += GT) {
        const int r = (int)(i4 / (DM / 4)), c4 = (int)(i4 % (DM / 4));
        float4 v = make_float4(0.f, 0.f, 0.f, 0.f);
        if (r < T) v = ((const float4*)p.x_prompt)[(size_t)r * (DM / 4) + c4]; else if (r < TS) v = ((const float4*)p.x_sample)[(size_t)(r - T) * (DM / 4) + c4];
        uint2 o; o.x = pk2(v.x, v.y); o.y = pk2(v.z, v.w);
        ((uint2*)p.ACTB)[i4] = o;
    }
    for (size_t idx = gt; idx < (size_t)(T + 1) * 32; idx += GT) {
        const int pos = (int)(idx >> 5), i = (int)(idx & 31);
        const float inv = (float)pow(10000.0, -2.0 * (double)i / 64.0);
        const float ang = (float)pos * inv;
        p.ROPE[idx] = make_float2((float)cos((double)ang), (float)sin((double)ang));
    }
}

__device__ __forceinline__ size_t vfrag_elem(int key, int d);
__device__ __forceinline__ size_t kfrag_elem(int key, int d);
__device__ __forceinline__ bf16x8 pack_p(const f32x4& p0, const f32x4& p1);
template <bool FFNMAP = false, bool OUTBF = false>
__device__ __forceinline__ void skinny_gemm(const Fr& F, const bf16* A, const bf16* Bt, int K, int ncols, float* C, int ldc) {
    const int lane = F.lane, l15 = lane & 15, grp = lane >> 4;
    const int kper = K >> 3, k0 = F.wave * kper;
    const bf16* a0 = A + (size_t)(T + l15) * K + 8 * grp + k0; const bf16* a1 = a0 + (size_t)16 * K;
    f32x4* red = (f32x4*)F.lds;
    const int ntiles = (ncols + 15) >> 4;
    for (int nt = F.bid; nt < ntiles; nt += F.G) {
        const bf16* bp = Bt + (size_t)(nt * 16 + l15) * K + 8 * grp + k0;
        f32x4 c0 = {0.f, 0.f, 0.f, 0.f}, c1 = {0.f, 0.f, 0.f, 0.f};
#pragma unroll 4
        for (int k = 0; k < kper; k += 32) {
            const bf16x8 b = *(const bf16x8*)(bp + k), x0 = *(const bf16x8*)(a0 + k), x1 = *(const bf16x8*)(a1 + k);
            c0 = MFMA16(x0, b, c0); c1 = MFMA16(x1, b, c1);
        }
        red[(F.wave * 2 + 0) * 64 + lane] = c0; red[(F.wave * 2 + 1) * 64 + lane] = c1;
        __syncthreads();
        if (F.wave == 0) {
#pragma unroll
            for (int w = 1; w < 8; ++w) { c0 = c0 + red[(w * 2 + 0) * 64 + lane]; c1 = c1 + red[(w * 2 + 1) * 64 + lane]; }
            int n = nt * 16 + l15;
            if (FFNMAP) n = ((n >> 7) & 1) * DFF + (n >> 8) * 128 + (n & 127);
            if (n < ncols) {
#pragma unroll
                for (int r = 0; r < 4; ++r) {
                    if (OUTBF) { ((bf16*)C)[(size_t)(T + 4 * grp + r) * ldc + n] = (bf16)f2bf(c0[r]); ((bf16*)C)[(size_t)(T + 16 + 4 * grp + r) * ldc + n] = (bf16)f2bf(c1[r]); }
                    else { C[(size_t)(T + 4 * grp + r) * ldc + n] = c0[r]; C[(size_t)(T + 16 + 4 * grp + r) * ldc + n] = c1[r]; } }
            }
        }
        __syncthreads();
    }
}
__device__ __forceinline__ void ph_gemm_f32(const Fr& F, const bf16* A, const bf16* Bt, int N, int K, float* C, int ldc, int ncols) {
    skinny_gemm(F, A, Bt, K, ncols, C, ldc);
    pg8::Gemm g{A, Bt, T, N, K}; pg8::StaticOrder S; S.init(T, N, F.G, F.bid);
    pg8::EpiF32 E{C, ldc, ncols};
    pg8::gemm_phase<pg8::EpiF32, pg8::StaticOrder, PG8_ALIGN, PG8_SP2>((PG8_LAS unsigned char*)F.lds, g, S, E);
}
__device__ __forceinline__ void ph_gemm_h1(const KP& p, const Fr& F) {
    skinny_gemm(F, p.ACTB, p.WT_CI, DM, 3072, p.BIGF, 3072);
    pg8::Gemm g{p.ACTB, p.WT_CI, T, 3072, DM}; pg8::StaticOrder S; S.init(T, 3072, F.G, F.bid);
    pg8::EpiBf16<0> E{p.H1B, 3072, nullptr, 0, 0, 1.f};
    pg8::gemm_phase<pg8::EpiBf16<0>, pg8::StaticOrder, PG8_ALIGN, PG8_SP2>((PG8_LAS unsigned char*)F.lds, g, S, E);
}
__device__ __forceinline__ void ph_gemm_bf16(const Fr& F, const bf16* A, const bf16* Bt, int K, bf16* C) {
    skinny_gemm<false, true>(F, A, Bt, K, DM, (float*)C, DM);
    pg8::Gemm g{A, Bt, T, DM, K}; pg8::StaticOrder S; S.init(T, DM, F.G, F.bid);
    pg8::EpiBf16<0> E{C, DM, nullptr, 0, 0, 1.f};
    pg8::gemm_phase<pg8::EpiBf16<0>, pg8::StaticOrder, PG8_ALIGN, PG8_SP2>((PG8_LAS unsigned char*)F.lds, g, S, E);
}
__device__ __forceinline__ void ph_ln_b(const Fr& F, bf16* XB, const bf16* FB, const float* gam, const float* bet, float* outp, float* outs) {
    const int lane = F.lane;
    for (int r = F.gw; r < TS; r += F.NGW) {
        float v[16]; float s = 0.f;
#pragma unroll
        for (int j = 0; j < 2; ++j) {
            const v4u x = *(const v4u*)(XB + (size_t)r * DM + 512 * j + 8 * lane), f = *(const v4u*)(FB + (size_t)r * DM + 512 * j + 8 * lane);
#pragma unroll
            for (int e = 0; e < 4; ++e) {
                v[8 * j + 2 * e] = DN_ALPHA * __uint_as_float(x[e] << 16) + __uint_as_float(f[e] << 16);
                v[8 * j + 2 * e + 1] = DN_ALPHA * __uint_as_float(x[e] & 0xffff0000u) + __uint_as_float(f[e] & 0xffff0000u);
            }
        }
#pragma unroll
        for (int i = 0; i < 16; ++i) s += v[i];
        const float mean = wave_sum(s) * (1.f / DM); float q = 0.f;
#pragma unroll
        for (int i = 0; i < 16; ++i) { v[i] -= mean; q += v[i] * v[i]; }
        const float rstd = rsqrtf(wave_sum(q) * (1.f / DM) + LN_EPS);
#pragma unroll
        for (int j = 0; j < 2; ++j) {
            const int c0 = 512 * j + 8 * lane;
            const float4 g0 = *(const float4*)(gam + c0), g1 = *(const float4*)(gam + c0 + 4), b0 = *(const float4*)(bet + c0), b1 = *(const float4*)(bet + c0 + 4);
            const float y0 = v[8 * j + 0] * rstd * g0.x + b0.x, y1 = v[8 * j + 1] * rstd * g0.y + b0.y, y2 = v[8 * j + 2] * rstd * g0.z + b0.z, y3 = v[8 * j + 3] * rstd * g0.w + b0.w;
            const float y4 = v[8 * j + 4] * rstd * g1.x + b1.x, y5 = v[8 * j + 5] * rstd * g1.y + b1.y, y6 = v[8 * j + 6] * rstd * g1.z + b1.z, y7 = v[8 * j + 7] * rstd * g1.w + b1.w;
            if (outp) { float* o = ((r < T) ? outp + (size_t)r * DM : outs + (size_t)(r - T) * DM) + c0;
                *(float4*)o = make_float4(y0, y1, y2, y3); *(float4*)(o + 4) = make_float4(y4, y5, y6, y7); }
            else { v4u w; w.x = pk2(y0, y1); w.y = pk2(y2, y3); w.z = pk2(y4, y5); w.w = pk2(y6, y7); *(v4u*)(XB + (size_t)r * DM + c0) = w; }
        }
    }
}
__device__ __forceinline__ float dpp_ror1(float x) { return __int_as_float(__builtin_amdgcn_update_dpp(0, __float_as_int(x), 0x121, 0xf, 0xf, false)); }
__device__ __forceinline__ float dpp_ror2(float x) { return __int_as_float(__builtin_amdgcn_update_dpp(0, __float_as_int(x), 0x122, 0xf, 0xf, false)); }
struct EpiFfn {
    static constexpr bool PERM = true, AFTER_DRAIN = false;
    bf16* H; float* UB; const float* cw; const float* cb;
    __device__ __forceinline__ void operator()(const pg8::f32x4 (&acc)[2][2][4][2], const pg8::Unit& u, int wr, int wc, int fr, int fq) const {
#pragma unroll
        for (int n = 0; n < 2; ++n) {
            const int jc = u.pn * 128 + wc * 32 + 8 * fq + 4 * n;
            pg8::f32x4 w0[2], w1[2], w2[2], bb[2];
#pragma unroll
            for (int bj = 0; bj < 2; ++bj) { const int uc = bj * DFF + jc;
                w0[bj] = *(const pg8::f32x4*)(cw + uc); w1[bj] = *(const pg8::f32x4*)(cw + DFF2 + uc); w2[bj] = *(const pg8::f32x4*)(cw + 2 * DFF2 + uc); bb[bj] = *(const pg8::f32x4*)(cb + uc); }
#pragma unroll
            for (int ai = 0; ai < 2; ++ai) {
                const int sl = u.pm * 4 + ai * 2 + wr;
                pg8::f32x4 pr1[2], pr2[2];
#pragma unroll
                for (int m = 0; m < 4; ++m) {
                    pg8::f32x4 c[2];
#pragma unroll
                    for (int bj = 0; bj < 2; ++bj) {
                        const pg8::f32x4 uu = acc[ai][bj][m][n]; pg8::f32x4 r1, r2;
#pragma unroll
                        for (int e = 0; e < 4; ++e) { r1[e] = dpp_ror1(uu[e]); r2[e] = dpp_ror2(uu[e]); }
                        pg8::f32x4 p1 = r1, p2 = r2;
                        if (m > 0) { if (fr == 0) p1 = pr1[bj]; if (fr < 2) p2 = pr2[bj]; }
                        c[bj] = bb[bj] + w0[bj] * p2 + w1[bj] * p1 + w2[bj] * uu;
                        pr1[bj] = r1; pr2[bj] = r2;
                        const int uc = bj * DFF + jc;
                        if (m == 0 && fr < 2) *(pg8::f32x4*)(UB + ((size_t)sl * 4 + fr) * DFF2 + uc) = uu;
                        if (m == 3 && fr >= 14) *(pg8::f32x4*)(UB + ((size_t)sl * 4 + 2 + (fr - 14)) * DFF2 + uc) = uu;
                    }
                    if (!(m == 0 && fr < 2)) {
                        const int t = u.pm * 256 + ai * 128 + wr * 64 + m * 16 + fr;
                        uint2 o; o.x = pk2(fsilu_(c[0][0]) * c[1][0], fsilu_(c[0][1]) * c[1][1]); o.y = pk2(fsilu_(c[0][2]) * c[1][2], fsilu_(c[0][3]) * c[1][3]);
                        *(uint2*)(H + (size_t)t * DFF + jc) = o;
                    }
                }
            }
        }
    }
};
__device__ __forceinline__ void ph_ffn_gemm(const KP& p, const Fr& F, const bf16* Bt, int layer) {
    skinny_gemm<true>(F, p.ACTB, Bt, DM, DFF2, p.BIGF, DFF2);
    pg8::Gemm g{p.ACTB, Bt, T, DFF2, DM}; pg8::StaticOrder S; S.init(T, DFF2, F.G, F.bid);
    EpiFfn E{p.HFFB, p.UB, p.ffn_cw + (size_t)layer * 3 * DFF2, p.ffn_cb + (size_t)layer * DFF2};
    pg8::gemm_phase<EpiFfn, pg8::StaticOrder, PG8_ALIGN, PG8_SP2>((PG8_LAS unsigned char*)F.lds, g, S, E);
}
__device__ __forceinline__ void ph_ffn_fix(const KP& p, const Fr& F, int layer) {
    const float* cw = p.ffn_cw + (size_t)layer * 3 * DFF2; const float* cb = p.ffn_cb + (size_t)layer * DFF2; const float* U = p.BIGF;
    const int gt = F.bid * NTHR + F.tid, GT = F.G * NTHR;
    for (int idx = gt; idx < 512 * DFF; idx += GT) {
        const int rr = idx / DFF, j = idx - rr * DFF; const int sl = rr >> 1, q = rr & 1;
        float c2[2];
#pragma unroll
        for (int half = 0; half < 2; ++half) { const int ch = half * DFF + j;
            const float u0 = p.UB[((size_t)sl * 4 + q) * DFF2 + ch];
            const float um1 = q ? p.UB[((size_t)sl * 4) * DFF2 + ch] : (sl ? p.UB[((size_t)(sl - 1) * 4 + 3) * DFF2 + ch] : 0.f);
            const float um2 = sl ? p.UB[((size_t)(sl - 1) * 4 + 2 + q) * DFF2 + ch] : 0.f;
            c2[half] = cb[ch] + cw[ch] * um2 + cw[DFF2 + ch] * um1 + cw[2 * DFF2 + ch] * u0; }
        p.HFFB[(size_t)(64 * sl + q) * DFF + j] = (bf16)f2bf(siluf_(c2[0]) * c2[1]);
    }
    for (int idx = gt; idx < NSMP * DFF; idx += GT) {
        const int b = idx / DFF, j = idx - b * DFF;
        float c2[2];
#pragma unroll
        for (int half = 0; half < 2; ++half) { const int ch = half * DFF + j;
            const float* hs = p.st_ffn + (((size_t)b * 2 + layer) * 2) * DFF2 + ch;
            c2[half] = cb[ch] + cw[ch] * hs[0] + cw[DFF2 + ch] * hs[DFF2] + cw[2 * DFF2 + ch] * U[(size_t)(T + b) * DFF2 + ch]; }
        p.HFFB[(size_t)(T + b) * DFF + j] = (bf16)f2bf(siluf_(c2[0]) * c2[1]);
    }
    for (int idx = gt; idx < 2 * DFF2; idx += GT) { const int k = idx / DFF2, ch = idx - k * DFF2;
        p.out[O_FFN_P + ((size_t)layer * 2 + k) * DFF2 + ch] = p.UB[((size_t)255 * 4 + 2 + k) * DFF2 + ch]; }
    for (int idx = gt; idx < NSMP * 2 * DFF2; idx += GT) { const int b = idx / (2 * DFF2), k = (idx / DFF2) & 1, ch = idx % DFF2;
        p.out[O_FFN_S + (((size_t)b * 2 + layer) * 2 + k) * DFF2 + ch] = (k == 0) ? p.st_ffn[(((size_t)b * 2 + layer) * 2 + 1) * DFF2 + ch] : U[(size_t)(T + b) * DFF2 + ch]; }
}
struct EpiCmp {
    static constexpr bool PERM = false, AFTER_DRAIN = false;
    bf16* HID; const float* b1;
    __device__ __forceinline__ void operator()(const pg8::f32x4 (&acc)[2][2][4][2], const pg8::Unit& u, int wr, int wc, int fr, int fq) const {
#pragma unroll
        for (int ai = 0; ai < 2; ++ai)
#pragma unroll
            for (int m = 0; m < 4; ++m) { const int combo = u.pm * 128 + wr * 64 + m * 16 + fr;
#pragma unroll
                for (int n = 0; n < 2; ++n) { const int j0 = wc * 32 + n * 16 + 4 * fq; const pg8::f32x4 v = acc[ai][ai][m][n]; const float* bb = b1 + ai * 128 + j0;
                    uint2 o; o.x = pk2(gelu_tanh(v[0] + bb[0]), gelu_tanh(v[1] + bb[1])); o.y = pk2(gelu_tanh(v[2] + bb[2]), gelu_tanh(v[3] + bb[3]));
                    *(uint2*)(HID + ((size_t)combo * 2 + ai) * 128 + j0) = o; } }
    }
};
__device__ __forceinline__ void ph_cmp_gemm(const KP& p, const Fr& F) {
    pg8::Gemm g{p.AC, p.WT_C, 65536, 256, 2048}; pg8::StaticOrder S; S.init(65536, 256, F.G, F.bid);
    EpiCmp E{p.HID, p.cb1};
    pg8::gemm_phase<EpiCmp, pg8::StaticOrder, PG8_ALIGN, PG8_SP2>((PG8_LAS unsigned char*)F.lds, g, S, E);
}
__device__ __forceinline__ void ph_cmp_stage2(const KP& p, const Fr& F) {
    const int lane = F.lane, l15 = lane & 15, grp = lane >> 4;
    for (int tile = F.gw; tile < 4096; tile += F.NGW) {
        const int kv = tile & 1, combo0 = (tile >> 1) * 16;
        const bf16* hid = p.HID + ((size_t)(combo0 + l15) * 2 + kv) * 128 + 8 * grp; const bf16* w2 = p.W2T + (size_t)kv * 64 * 128 + (size_t)l15 * 128 + 8 * grp;
        f32x4 acc[4];
#pragma unroll
        for (int nt = 0; nt < 4; ++nt) acc[nt] = (f32x4){0.f, 0.f, 0.f, 0.f};
#pragma unroll
        for (int ks = 0; ks < 4; ++ks) { const bf16x8 a = *(const bf16x8*)(hid + 32 * ks);
#pragma unroll
            for (int nt = 0; nt < 4; ++nt) acc[nt] = MFMA16(a, *(const bf16x8*)(w2 + (size_t)nt * 16 * 128 + 32 * ks), acc[nt]); }
#pragma unroll
        for (int r = 0; r < 4; ++r) {
            const int combo = combo0 + 4 * grp + r; const int g = combo & 1, c = (combo >> 1) & 511, b = combo >> 10;
            float* dst = ((kv == 0) ? p.CK : p.CV) + (((size_t)(1 + b) * 512 + c) * 2 + g) * 64;
            if (kv == 0) {
                const int pos = (c + 1) * 32 - 1;
#pragma unroll
                for (int nt = 0; nt < 2; ++nt) { const float2 cs = p.ROPE[pos * 32 + 16 * nt + l15]; const float x1 = acc[nt][r], x2 = acc[nt + 2][r];
                    dst[16 * nt + l15] = x1 * cs.x - x2 * cs.y; dst[16 * (nt + 2) + l15] = x2 * cs.x + x1 * cs.y; }
            } else {
#pragma unroll
                for (int nt = 0; nt < 4; ++nt) dst[16 * nt + l15] = acc[nt][r];
            }
        }
    }
}
__device__ __forceinline__ void cmp_prompt_unit(const KP& p, int unit, int lane) {
    asm volatile("" : "+v"(lane));
    const int l15 = lane & 15, grp = lane >> 4;
    const int kv = unit & 1, combo = (unit >> 1) * 16 + l15; const int g = combo & 1, c = combo >> 1;
    const bf16* w1 = p.WT_C + ((size_t)kv * 128 + l15) * 2048 + 8 * grp;
    f32x4 acc[8];
#pragma unroll
    for (int jt = 0; jt < 8; ++jt) acc[jt] = (f32x4){0.f, 0.f, 0.f, 0.f};
    const bf16* fl = p.ACP + ((size_t)kv * 1024 + combo) * 2048 + 8 * grp;
#pragma unroll 4
    for (int ks = 0; ks < 64; ++ks) {
        const bf16x8 fb = *(const bf16x8*)(fl + 32 * ks);
#pragma unroll
        for (int jt = 0; jt < 8; ++jt) acc[jt] = MFMA16(*(const bf16x8*)(w1 + (size_t)jt * 16 * 2048 + 32 * ks), fb, acc[jt]);
    }
    bf16x8 hb[4];
#pragma unroll
    for (int s2 = 0; s2 < 4; ++s2) {
        f32x4 h0, h1;
#pragma unroll
        for (int r = 0; r < 4; ++r) { h0[r] = gelu_tanh(acc[2 * s2][r] + p.cb1[kv * 128 + 32 * s2 + 4 * grp + r]); h1[r] = gelu_tanh(acc[2 * s2 + 1][r] + p.cb1[kv * 128 + 32 * s2 + 16 + 4 * grp + r]); }
        hb[s2] = pack_p(h0, h1);
    }
    f32x4 o[4];
#pragma unroll
    for (int dt = 0; dt < 4; ++dt) {
        o[dt] = (f32x4){0.f, 0.f, 0.f, 0.f};
        const bf16* w2 = p.W2T + (size_t)kv * 64 * 128 + (size_t)(16 * dt + l15) * 128 + 4 * grp;
#pragma unroll
        for (int s2 = 0; s2 < 4; ++s2) { const uint2 x0 = *(const uint2*)(w2 + 32 * s2), x1 = *(const uint2*)(w2 + 32 * s2 + 16);
            union { v4u u; bf16x8 b; } wa; wa.u.x = x0.x; wa.u.y = x0.y; wa.u.z = x1.x; wa.u.w = x1.y;
            o[dt] = MFMA16(wa.b, hb[s2], o[dt]); }
    }
    if (kv == 0) {
        const int pos = (c + 1) * 32 - 1;
#pragma unroll
        for (int dt = 0; dt < 2; ++dt)
#pragma unroll
            for (int r = 0; r < 4; ++r) { const float2 cs = p.ROPE[pos * 32 + 16 * dt + 4 * grp + r]; const float x1 = o[dt][r], x2 = o[dt + 2][r];
                o[dt][r] = x1 * cs.x - x2 * cs.y; o[dt + 2][r] = x2 * cs.x + x1 * cs.y; }
    }
#pragma unroll
    for (int dt = 0; dt < 4; ++dt)
#pragma unroll
        for (int r = 0; r < 4; ++r) { const int d = 16 * dt + 4 * grp + r;
            if (kv == 0) p.CKF[(size_t)g * 512 * 64 + kfrag_elem(c, d)] = (bf16)f2bf(o[dt][r]); else p.CVF[(size_t)g * 512 * 64 + vfrag_elem(c, d)] = (bf16)f2bf(o[dt][r]); }
}
__device__ __forceinline__ void cmp_sample_unit(const KP& p, int unit, int lane) {
    asm volatile("" : "+v"(lane));
    const int l15 = lane & 15, grp = lane >> 4;
    const int b = unit >> 6, kv = (unit >> 5) & 1, cb = unit & 31;
    const bf16* w1 = p.WT_C + ((size_t)kv * 128 + l15) * 2048 + 8 * grp;
    const float* src[2];
#pragma unroll
    for (int cg = 0; cg < 2; ++cg) { const int combo = cb * 32 + 16 * cg + l15; const int g = combo & 1, c = combo >> 1;
        const int page = p.page_table[b * NPAGES + (c >> 2)];
        src[cg] = p.cache_cmp + (((size_t)page * 128 + (c & 3) * 32) * 4 + kv * 2 + g) * 64 + 8 * grp; }
    const float* pe = p.cpe + (size_t)kv * 32 * 64 + 8 * grp;
    f32x4 acc[2][8];
#pragma unroll
    for (int cg = 0; cg < 2; ++cg)
#pragma unroll
        for (int jt = 0; jt < 8; ++jt) acc[cg][jt] = (f32x4){0.f, 0.f, 0.f, 0.f};
#pragma unroll 2
    for (int ks = 0; ks < 64; ++ks) {
        const int i = ks >> 1, dd = 32 * (ks & 1);
        const float4 e0 = *(const float4*)(pe + i * 64 + dd), e1 = *(const float4*)(pe + i * 64 + dd + 4);
        bf16x8 fb[2];
#pragma unroll
        for (int cg = 0; cg < 2; ++cg) { const float4 a0 = *(const float4*)(src[cg] + i * 256 + dd), a1 = *(const float4*)(src[cg] + i * 256 + dd + 4);
            union { v4u u; bf16x8 b; } t; t.u.x = pk2(a0.x + e0.x, a0.y + e0.y); t.u.y = pk2(a0.z + e0.z, a0.w + e0.w); t.u.z = pk2(a1.x + e1.x, a1.y + e1.y); t.u.w = pk2(a1.z + e1.z, a1.w + e1.w); fb[cg] = t.b; }
#pragma unroll
        for (int jt = 0; jt < 8; ++jt) { const bf16x8 wa = *(const bf16x8*)(w1 + (size_t)jt * 16 * 2048 + 32 * ks);
            acc[0][jt] = MFMA16(wa, fb[0], acc[0][jt]); acc[1][jt] = MFMA16(wa, fb[1], acc[1][jt]); }
    }
#pragma unroll
    for (int cg = 0; cg < 2; ++cg) {
        const int combo = cb * 32 + 16 * cg + l15; const int g = combo & 1, c = combo >> 1;
        bf16x8 hb[4];
#pragma unroll
        for (int s2 = 0; s2 < 4; ++s2) { f32x4 h0, h1;
#pragma unroll
            for (int r = 0; r < 4; ++r) { h0[r] = gelu_tanh(acc[cg][2 * s2][r] + p.cb1[kv * 128 + 32 * s2 + 4 * grp + r]); h1[r] = gelu_tanh(acc[cg][2 * s2 + 1][r] + p.cb1[kv * 128 + 32 * s2 + 16 + 4 * grp + r]); }
            hb[s2] = pack_p(h0, h1); }
        f32x4 o[4];
#pragma unroll
        for (int dt = 0; dt < 4; ++dt) {
            o[dt] = (f32x4){0.f, 0.f, 0.f, 0.f};
            const bf16* w2 = p.W2T + (size_t)kv * 64 * 128 + (size_t)(16 * dt + l15) * 128 + 4 * grp;
#pragma unroll
            for (int s2 = 0; s2 < 4; ++s2) { const uint2 x0 = *(const uint2*)(w2 + 32 * s2), x1 = *(const uint2*)(w2 + 32 * s2 + 16);
                union { v4u u; bf16x8 b; } wa; wa.u.x = x0.x; wa.u.y = x0.y; wa.u.z = x1.x; wa.u.w = x1.y;
                o[dt] = MFMA16(wa.b, hb[s2], o[dt]); }
        }
        if (kv == 0) {
            const int pos = (c + 1) * 32 - 1;
#pragma unroll
            for (int dt = 0; dt < 2; ++dt)
#pragma unroll
                for (int r = 0; r < 4; ++r) { const float2 cs = p.ROPE[pos * 32 + 16 * dt + 4 * grp + r]; const float x1 = o[dt][r], x2 = o[dt + 2][r];
                    o[dt][r] = x1 * cs.x - x2 * cs.y; o[dt + 2][r] = x2 * cs.x + x1 * cs.y; }
        }
        float* dst = ((kv == 0) ? p.CK : p.CV) + (((size_t)(1 + b) * 512 + c) * 2 + g) * 64 + 4 * grp;
#pragma unroll
        for (int dt = 0; dt < 4; ++dt) *(f32x4*)(dst + 16 * dt) = o[dt];
    }
}
constexpr int W1S_PITCH = 528;
constexpr int W1S_BYTES = 128 * W1S_PITCH;
__device__ __forceinline__ void cmp_sample_wg(const KP& p, int wu, const Fr& F) {
    int lane = F.lane; asm volatile("" : "+v"(lane));
    const int l15 = lane & 15, grp = lane >> 4, tid = F.tid;
    const int b = wu >> 3, kv = (wu >> 2) & 1, q4 = wu & 3;
    const float* src[2];
#pragma unroll
    for (int cg = 0; cg < 2; ++cg) { const int combo = q4 * 256 + F.wave * 32 + 16 * cg + l15; const int g = combo & 1, c = combo >> 1;
        const int page = p.page_table[b * NPAGES + (c >> 2)];
        src[cg] = p.cache_cmp + (((size_t)page * 128 + (c & 3) * 32) * 4 + kv * 2 + g) * 64 + 8 * grp; }
    const float* pe = p.cpe + (size_t)kv * 32 * 64 + 8 * grp;
    const bf16* wg = p.WT_C + (size_t)kv * 128 * 2048;
    f32x4 acc[2][8];
#pragma unroll
    for (int cg = 0; cg < 2; ++cg)
#pragma unroll
        for (int jt = 0; jt < 8; ++jt) acc[cg][jt] = (f32x4){0.f, 0.f, 0.f, 0.f};
    v4u wreg[8];
#pragma unroll
    for (int k = 0; k < 8; ++k) { const int c = tid + 512 * k; wreg[k] = *(const v4u*)(wg + (size_t)(c >> 5) * 2048 + (c & 31) * 8); }
#pragma unroll
    for (int k = 0; k < 8; ++k) { const int c = tid + 512 * k; *(v4u*)(F.lds + (c >> 5) * W1S_PITCH + (c & 31) * 16) = wreg[k]; }
    __syncthreads();
#pragma unroll 1
    for (int sl = 0; sl < 8; ++sl) {
        if (sl + 1 < 8) {
#pragma unroll
            for (int k = 0; k < 8; ++k) { const int c = tid + 512 * k; wreg[k] = *(const v4u*)(wg + (size_t)(c >> 5) * 2048 + (sl + 1) * 256 + (c & 31) * 8); }
        }
        const unsigned char* wl = F.lds + (sl & 1) * W1S_BYTES + l15 * W1S_PITCH + grp * 16;
#pragma unroll 4
        for (int kk = 0; kk < 8; ++kk) {
            const int ks = sl * 8 + kk, i = ks >> 1, dd = 32 * (ks & 1);
            const float4 e0 = *(const float4*)(pe + i * 64 + dd), e1 = *(const float4*)(pe + i * 64 + dd + 4);
            bf16x8 fb[2];
#pragma unroll
            for (int cg = 0; cg < 2; ++cg) { const float4 a0 = *(const float4*)(src[cg] + i * 256 + dd), a1 = *(const float4*)(src[cg] + i * 256 + dd + 4);
                union { v4u u; bf16x8 b; } t; t.u.x = pk2(a0.x + e0.x, a0.y + e0.y); t.u.y = pk2(a0.z + e0.z, a0.w + e0.w); t.u.z = pk2(a1.x + e1.x, a1.y + e1.y); t.u.w = pk2(a1.z + e1.z, a1.w + e1.w); fb[cg] = t.b; }
#pragma unroll
            for (int jt = 0; jt < 8; ++jt) { const bf16x8 wa = *(const bf16x8*)(wl + jt * 16 * W1S_PITCH + kk * 64);
                acc[0][jt] = MFMA16(wa, fb[0], acc[0][jt]); acc[1][jt] = MFMA16(wa, fb[1], acc[1][jt]); }
        }
        if (sl + 1 < 8) {
#pragma unroll
            for (int k = 0; k < 8; ++k) { const int c = tid + 512 * k; *(v4u*)(F.lds + ((sl + 1) & 1) * W1S_BYTES + (c >> 5) * W1S_PITCH + (c & 31) * 16) = wreg[k]; }
        }
        __syncthreads();
    }
#pragma unroll
    for (int cg = 0; cg < 2; ++cg) {
        const int combo = q4 * 256 + F.wave * 32 + 16 * cg + l15; const int g = combo & 1, c = combo >> 1;
        bf16x8 hb[4];
#pragma unroll
        for (int s2 = 0; s2 < 4; ++s2) { f32x4 h0, h1;
#pragma unroll
            for (int r = 0; r < 4; ++r) { h0[r] = gelu_tanh(acc[cg][2 * s2][r] + p.cb1[kv * 128 + 32 * s2 + 4 * grp + r]); h1[r] = gelu_tanh(acc[cg][2 * s2 + 1][r] + p.cb1[kv * 128 + 32 * s2 + 16 + 4 * grp + r]); }
            hb[s2] = pack_p(h0, h1); }
        f32x4 o[4];
#pragma unroll
        for (int dt = 0; dt < 4; ++dt) {
            o[dt] = (f32x4){0.f, 0.f, 0.f, 0.f};
            const bf16* w2 = p.W2T + (size_t)kv * 64 * 128 + (size_t)(16 * dt + l15) * 128 + 4 * grp;
#pragma unroll
            for (int s2 = 0; s2 < 4; ++s2) { const uint2 x0 = *(const uint2*)(w2 + 32 * s2), x1 = *(const uint2*)(w2 + 32 * s2 + 16);
                union { v4u u; bf16x8 b; } wa; wa.u.x = x0.x; wa.u.y = x0.y; wa.u.z = x1.x; wa.u.w = x1.y;
                o[dt] = MFMA16(wa.b, hb[s2], o[dt]); }
        }
        if (kv == 0) {
            const int pos = (c + 1) * 32 - 1;
#pragma unroll
            for (int dt = 0; dt < 2; ++dt)
#pragma unroll
                for (int r = 0; r < 4; ++r) { const float2 cs = p.ROPE[pos * 32 + 16 * dt + 4 * grp + r]; const float x1 = o[dt][r], x2 = o[dt + 2][r];
                    o[dt][r] = x1 * cs.x - x2 * cs.y; o[dt + 2][r] = x2 * cs.x + x1 * cs.y; }
        }
        float* dst = ((kv == 0) ? p.CK : p.CV) + (((size_t)(1 + b) * 512 + c) * 2 + g) * 64 + 4 * grp;
#pragma unroll
        for (int dt = 0; dt < 4; ++dt) *(f32x4*)(dst + 16 * dt) = o[dt];
    }
}
__device__ __forceinline__ void ph_cmp_samples(const KP& p, const Fr& F) {
    for (int wu = F.bid; wu < 256; wu += F.G) cmp_sample_wg(p, wu, F);
}
__device__ __forceinline__ void ph_cmp_prompt(const KP& p, const Fr& F) {
    for (int unit = F.gw; unit < 128; unit += F.NGW) cmp_prompt_unit(p, unit, F.lane);
}

__device__ __forceinline__ float rope_val(const float* row, int base, int i, float2 cs) {
    const int ii = i & 31;
    const float x1 = row[base + ii], x2 = row[base + ii + 32];
    return (i < 32) ? (x1 * cs.x - x2 * cs.y) : (x2 * cs.x + x1 * cs.y);
}
__device__ __forceinline__ void ph_nsa_prep(const KP& p, const Fr& F) {
    const float* H0 = p.BIGF; float* out = p.out;
    const size_t gt = (size_t)F.bid * NTHR + F.tid, GT = (size_t)F.G * NTHR;
    const size_t total = (size_t)TS * 1280;
    for (size_t idx = gt + (size_t)T * 1280; idx < total; idx += GT) {
        const int r = (int)(idx / 1280), c = (int)(idx % 1280);
        const bool smp = r >= T; const int b = r - T; const int pos = smp ? T : r;
        const float* row = H0 + (size_t)r * PA;
        const int i = c & 63;
        const float2 cs = p.ROPE[pos * 32 + (i & 31)];
        if (c < 512) { p.QR[(size_t)r * 512 + c] = rope_val(row, c & ~63, i, cs); continue; }
        const int sec = (c - 512) >> 7; const int gd = (c - 512) & 127; const int base = c & ~63;
        float v;
        if (sec == 2 || sec == 4) v = rope_val(row, base, i, cs); else v = row[c];
        const int kv = sec & 1;
        if (sec < 2) {
            if (!smp) out[O_CMP_P + (size_t)r * 256 + kv * 128 + gd] = v; else out[O_CMP_S + (size_t)b * 256 + kv * 128 + gd] = v;
        } else if (sec < 4) {
            if (!smp) out[O_SLC_P + (size_t)r * 256 + kv * 128 + gd] = v; else out[O_SLC_S + (size_t)b * 256 + kv * 128 + gd] = v;
            if (kv == 0) p.KS[(size_t)r * 128 + gd] = v; else p.VS[(size_t)r * 128 + gd] = v;
        } else {
            if (kv == 0) p.KW[(size_t)r * 128 + gd] = v; else p.VW[(size_t)r * 128 + gd] = v;
            if (!smp) { if (r >= T - 512) out[O_WIN_P + (size_t)(r - (T - 512)) * 256 + kv * 128 + gd] = v; }
            else out[O_WIN_S + ((size_t)b * 512 + 511) * 256 + kv * 128 + gd] = v;
        }
    }
    const size_t tot2 = (size_t)NSMP * 511 * 256;
    for (size_t idx = gt; idx < tot2; idx += GT) {
        const int b = (int)(idx / (511 * 256)); const int rem = (int)(idx % (511 * 256));
        out[O_WIN_S + (size_t)b * 512 * 256 + rem] = p.st_win[(size_t)b * 512 * 256 + 256 + rem];
    }
}

constexpr float QSCALE = 0.18033688011112042f;

__device__ __forceinline__ size_t kfrag_off(int kt, int ks, int lane) { return ((size_t)(kt * 2 + ks) * 64 + lane) * 8; }
__device__ __forceinline__ size_t vfrag_off(int st, int dt, int lane) { return ((size_t)(st * 4 + dt) * 64 + lane) * 8; }
__device__ __forceinline__ size_t vfrag_elem(int key, int d) {
    const int st = key >> 5, kk = key & 31, tile = kk >> 4, r16 = kk & 15, grp = r16 >> 2, reg = r16 & 3;
    return ((size_t)(st * 4 + (d >> 4)) * 64 + (d & 15) + 16 * grp) * 8 + tile * 4 + reg;
}
__device__ __forceinline__ size_t k8_off(int key, int d) { return ((size_t)(key >> 4) * 64 + (key & 15) + 16 * ((d & 31) >> 3)) * 16 + (d >> 5) * 8 + (d & 7); }
__device__ __forceinline__ size_t v8_off(int key, int d) {
    const int blk = key >> 6, st = (key >> 5) & 1, kk = key & 31, tile = kk >> 4, r16 = kk & 15, grp = r16 >> 2, reg = r16 & 3;
    return ((size_t)(blk * 4 + (d >> 4)) * 64 + (d & 15) + 16 * grp) * 16 + st * 8 + tile * 4 + reg;
}
__device__ __forceinline__ size_t kfrag_elem(int key, int d) {
    return ((size_t)((key >> 4) * 2 + (d >> 5)) * 64 + (key & 15) + 16 * ((d & 31) >> 3)) * 8 + (d & 7);
}

__device__ __forceinline__ void ph_nsa_prep_fast(const KP& p, const Fr& F) {
    const float* H0 = p.BIGF; float* out = p.out;
    const size_t gt = (size_t)F.bid * NTHR + F.tid, GT = (size_t)F.G * NTHR;
    for (size_t idx = gt; idx < (size_t)T * 160; idx += GT) {
        const int t = (int)(idx / 160), u = (int)(idx % 160);
        const int c0 = u * 8; const float* row = H0 + (size_t)t * PA;
        const float4 a0 = *(const float4*)(row + c0), a1 = *(const float4*)(row + c0 + 4);
        float v[8] = {a0.x, a0.y, a0.z, a0.w, a1.x, a1.y, a1.z, a1.w};
        const int sec = (u < 64) ? -1 : ((u - 64) >> 4);
        const bool roped = (sec == -1 || sec == 2 || sec == 4);
        if (roped) {
            const int d0 = c0 & 63; const int pc = (d0 < 32) ? c0 + 32 : c0 - 32;
            const float4 b0 = *(const float4*)(row + pc), b1 = *(const float4*)(row + pc + 4);
            const float w[8] = {b0.x, b0.y, b0.z, b0.w, b1.x, b1.y, b1.z, b1.w};
            const float4* rp = (const float4*)(p.ROPE + t * 32 + (d0 & 31)); const float4 r0 = rp[0], r1 = rp[1], r2 = rp[2], r3 = rp[3];
            const float cs[8] = {r0.x, r0.z, r1.x, r1.z, r2.x, r2.z, r3.x, r3.z}, sn[8] = {r0.y, r0.w, r1.y, r1.w, r2.y, r2.w, r3.y, r3.w};
#pragma unroll
            for (int j = 0; j < 8; ++j) v[j] = (d0 < 32) ? (v[j] * cs[j] - w[j] * sn[j]) : (v[j] * cs[j] + w[j] * sn[j]);
        }
        if (sec == -1) {
            v4u o; o.x = pk2(v[0] * QSCALE, v[1] * QSCALE); o.y = pk2(v[2] * QSCALE, v[3] * QSCALE); o.z = pk2(v[4] * QSCALE, v[5] * QSCALE); o.w = pk2(v[6] * QSCALE, v[7] * QSCALE);
            *(v4u*)(p.QB + (size_t)t * 512 + c0) = o; continue;
        }
        const int gd = (c0 - 512) & 127, g = gd >> 6, d0 = gd & 63, kv = sec & 1;
        const float4 o0 = make_float4(v[0], v[1], v[2], v[3]), o1 = make_float4(v[4], v[5], v[6], v[7]);
        if (sec < 2) { float* o = out + O_CMP_P + (size_t)t * 256 + kv * 128 + gd; *(float4*)o = o0; *(float4*)(o + 4) = o1;
            const int i = t & 31; const float* pe = p.cpe + (kv * 32 + i) * 64 + d0; const float4 e0 = *(const float4*)pe, e1 = *(const float4*)(pe + 4);
            v4u w; w.x = pk2(v[0] + e0.x, v[1] + e0.y); w.y = pk2(v[2] + e0.z, v[3] + e0.w); w.z = pk2(v[4] + e1.x, v[5] + e1.y); w.w = pk2(v[6] + e1.z, v[7] + e1.w);
            *(v4u*)(p.ACP + ((size_t)kv * 1024 + (t >> 5) * 2 + g) * 2048 + i * 64 + d0) = w; continue; }
        if (sec < 4) { float* o = out + O_SLC_P + (size_t)t * 256 + kv * 128 + gd; *(float4*)o = o0; *(float4*)(o + 4) = o1; }
        else if (t >= T - 512) { float* o = out + O_WIN_P + (size_t)(t - (T - 512)) * 256 + kv * 128 + gd; *(float4*)o = o0; *(float4*)(o + 4) = o1; }
        if (sec < 4) {
            if (kv == 0) {
                int w0 = 0, w1 = 0;
                w0 = __builtin_amdgcn_cvt_pk_fp8_f32(v[0], v[1], w0, false); w0 = __builtin_amdgcn_cvt_pk_fp8_f32(v[2], v[3], w0, true);
                w1 = __builtin_amdgcn_cvt_pk_fp8_f32(v[4], v[5], w1, false); w1 = __builtin_amdgcn_cvt_pk_fp8_f32(v[6], v[7], w1, true);
                *(uint2*)(p.KS8 + (size_t)g * T * 64 + k8_off(t, d0)) = make_uint2((unsigned)w0, (unsigned)w1);
            } else {
#pragma unroll
                for (int j = 0; j < 8; ++j) p.VS8[(size_t)g * T * 64 + v8_off(t, d0 + j)] = (unsigned char)(__builtin_amdgcn_cvt_pk_fp8_f32(v[j], 0.f, 0, false) & 0xff);
            }
            continue;
        }
        bf16* KF = p.KWF; bf16* VF = p.VWF;
        if (kv == 0) {
            v4u o; o.x = pk2(v[0], v[1]); o.y = pk2(v[2], v[3]); o.z = pk2(v[4], v[5]); o.w = pk2(v[6], v[7]);
            *(v4u*)(KF + (size_t)g * T * 64 + kfrag_elem(t, d0)) = o;
        } else {
#pragma unroll
            for (int j = 0; j < 8; ++j) VF[(size_t)g * T * 64 + vfrag_elem(t, d0 + j)] = (bf16)f2bf(v[j]);
        }
    }
}

struct AttW { f32x4 o[4]; float m, l; };
__device__ __forceinline__ void attw_init(AttW& a) {
#pragma unroll
    for (int i = 0; i < 4; ++i) a.o[i] = (f32x4){0.f, 0.f, 0.f, 0.f};
    a.m = -INFINITY; a.l = 0.f;
}
__device__ __forceinline__ void qk_step(const bf16x8 (&kf)[2][2], const bf16x8 (&qf)[2], f32x4& s0, f32x4& s1) {
    const f32x4 z = {0.f, 0.f, 0.f, 0.f};
    s0 = MFMA16(kf[0][0], qf[0], z); s0 = MFMA16(kf[0][1], qf[1], s0);
    s1 = MFMA16(kf[1][0], qf[0], z); s1 = MFMA16(kf[1][1], qf[1], s1);
}
__device__ __forceinline__ bf16x8 pack_p(const f32x4& p0, const f32x4& p1) {
    union { v4u u; bf16x8 b; } c;
    c.u.x = pg8::cvt_pk_bf16(p0[0], p0[1]); c.u.y = pg8::cvt_pk_bf16(p0[2], p0[3]); c.u.z = pg8::cvt_pk_bf16(p1[0], p1[1]); c.u.w = pg8::cvt_pk_bf16(p1[2], p1[3]);
    return c.b;
}
__device__ __forceinline__ void att_update(AttW& a, const f32x4& s0, const f32x4& s1, const bf16x8 (&vf)[4]) {
    float mx = fmaxf(fmaxf(fmaxf(s0[0], s0[1]), fmaxf(s0[2], s0[3])), fmaxf(fmaxf(s1[0], s1[1]), fmaxf(s1[2], s1[3])));
    mx = fmaxf(mx, __shfl_xor(mx, 16)); mx = fmaxf(mx, __shfl_xor(mx, 32));
    const float mn = fmaxf(a.m, mx);
    const float ms = (mn == -INFINITY) ? 0.f : mn;
    const float alpha = __builtin_amdgcn_exp2f(a.m - ms);
    f32x4 p0, p1;
#pragma unroll
    for (int i = 0; i < 4; ++i) { p0[i] = __builtin_amdgcn_exp2f(s0[i] - ms); p1[i] = __builtin_amdgcn_exp2f(s1[i] - ms); }
    a.l = a.l * alpha + ((p0[0] + p0[1]) + (p0[2] + p0[3])) + ((p1[0] + p1[1]) + (p1[2] + p1[3]));
    a.m = mn;
    const bf16x8 pf = pack_p(p0, p1);
#pragma unroll
    for (int dt = 0; dt < 4; ++dt) { a.o[dt] = a.o[dt] * alpha; a.o[dt] = MFMA16(vf[dt], pf, a.o[dt]); }
}
__device__ __forceinline__ float grp_sum(float v) { v += __shfl_xor(v, 16); v += __shfl_xor(v, 32); return v; }

__device__ __forceinline__ void nsa_fast_unit(const KP& p, int unit, float* wl, int lane) {
    asm volatile("" : "+v"(lane));
    const int g = unit & 1, t0 = (unit >> 1) * 16;
    const int qi = lane & 15, grp = lane >> 4, t = t0 + qi;
    float* imp = wl; int* sel = (int*)(wl + 4096);
    const float* grow = p.BIGF + (size_t)t * PA + C_GATE + g * 4;
    bf16x8 qf[4][2];
#pragma unroll
    for (int h = 0; h < 4; ++h)
#pragma unroll
        for (int ks = 0; ks < 2; ++ks) qf[h][ks] = *(const bf16x8*)(p.QB + (size_t)t * 512 + (g * 4 + h) * 64 + 32 * ks + 8 * grp);
    AttW st[4];
    {
        const bf16* CKF = p.CKF + (size_t)g * 512 * 64; const bf16* CVF = p.CVF + (size_t)g * 512 * 64;
        const int nmax = (t0 + 16) >> 5; const int nsteps = (nmax + 31) >> 5;
        const int nval = (t + 1) >> 5;
        float m[4], l[4];
#pragma unroll
        for (int h = 0; h < 4; ++h) { m[h] = -INFINITY; l[h] = 0.f; }
        for (int s = 0; s < nsteps; ++s) {
            bf16x8 kf[2][2];
#pragma unroll
            for (int tl = 0; tl < 2; ++tl)
#pragma unroll
                for (int ks = 0; ks < 2; ++ks) kf[tl][ks] = *(const bf16x8*)(CKF + kfrag_off(2 * s + tl, ks, lane));
            const int cb = 32 * s + 4 * grp;
#pragma unroll
            for (int h = 0; h < 4; ++h) {
                f32x4 s0, s1; qk_step(kf, qf[h], s0, s1);
#pragma unroll
                for (int i = 0; i < 4; ++i) { if (cb + i >= nval) s0[i] = -INFINITY; if (cb + 16 + i >= nval) s1[i] = -INFINITY; }
                float mx = fmaxf(fmaxf(fmaxf(s0[0], s0[1]), fmaxf(s0[2], s0[3])), fmaxf(fmaxf(s1[0], s1[1]), fmaxf(s1[2], s1[3])));
                mx = fmaxf(mx, __shfl_xor(mx, 16)); mx = fmaxf(mx, __shfl_xor(mx, 32));
                const float mn = fmaxf(m[h], mx); const float ms = (mn == -INFINITY) ? 0.f : mn;
                float sum = 0.f;
#pragma unroll
                for (int i = 0; i < 4; ++i) sum += __builtin_amdgcn_exp2f(s0[i] - ms) + __builtin_amdgcn_exp2f(s1[i] - ms);
                l[h] = l[h] * __builtin_amdgcn_exp2f(m[h] - ms) + sum; m[h] = mn;
            }
        }
        float il[4];
#pragma unroll
        for (int h = 0; h < 4; ++h) { const float lt = grp_sum(l[h]); il[h] = lt > 0.f ? 1.f / lt : 0.f; if (m[h] == -INFINITY) m[h] = 0.f; attw_init(st[h]); }
        for (int s = 0; s < nsteps; ++s) {
            bf16x8 kf[2][2], vf[4];
#pragma unroll
            for (int tl = 0; tl < 2; ++tl)
#pragma unroll
                for (int ks = 0; ks < 2; ++ks) kf[tl][ks] = *(const bf16x8*)(CKF + kfrag_off(2 * s + tl, ks, lane));
#pragma unroll
            for (int dt = 0; dt < 4; ++dt) vf[dt] = *(const bf16x8*)(CVF + vfrag_off(s, dt, lane));
            const int cb = 32 * s + 4 * grp;
            float i4[4] = {0.f, 0.f, 0.f, 0.f};
#pragma unroll
            for (int h = 0; h < 4; ++h) {
                f32x4 s0, s1; qk_step(kf, qf[h], s0, s1);
                f32x4 p0, p1;
#pragma unroll
                for (int i = 0; i < 4; ++i) {
                    p0[i] = (cb + i < nval) ? __builtin_amdgcn_exp2f(s0[i] - m[h]) * il[h] : 0.f;
                    p1[i] = (cb + 16 + i < nval) ? __builtin_amdgcn_exp2f(s1[i] - m[h]) * il[h] : 0.f; }
                i4[0] += p0[0] + p0[1]; i4[1] += p0[2] + p0[3]; i4[2] += p1[0] + p1[1]; i4[3] += p1[2] + p1[3];
                const bf16x8 pf = pack_p(p0, p1);
#pragma unroll
                for (int dt = 0; dt < 4; ++dt) st[h].o[dt] = MFMA16(vf[dt], pf, st[h].o[dt]);
            }
            *(float2*)(imp + qi * 256 + 16 * s + 2 * grp) = make_float2(i4[0], i4[1]);
            *(float2*)(imp + qi * 256 + 16 * s + 8 + 2 * grp) = make_float2(i4[2], i4[3]);
        }
        wave_lds_sync();
    }
    const int cur = t0 >> 6;
    {
        if (cur + 1 <= 16) {
            for (int idx = lane; idx < 256; idx += 64) sel[idx] = ((idx & 15) <= cur) ? (idx & 15) : -1;
        } else {
            for (int q0 = 0; q0 < 16; q0 += 4) {
                unsigned key[4][4];
#pragma unroll
                for (int qq = 0; qq < 4; ++qq)
#pragma unroll
                    for (int j = 0; j < 4; ++j) { const int blk = lane + 64 * j; const float v = imp[(q0 + qq) * 256 + blk];
                        key[qq][j] = (blk >= 1 && blk <= cur - 2) ? ((__float_as_uint(v) & 0xFFFFFF00u) | (unsigned)(255 - blk)) : 0u; }
                if (lane < 4) { sel[(q0 + lane) * 16 + 0] = 0; sel[(q0 + lane) * 16 + 1] = cur; sel[(q0 + lane) * 16 + 2] = cur - 1; }
                for (int n = 3; n < 16; ++n) {
                    unsigned best[4];
#pragma unroll
                    for (int qq = 0; qq < 4; ++qq) best[qq] = max(max(key[qq][0], key[qq][1]), max(key[qq][2], key[qq][3]));
#pragma unroll
                    for (int o = 1; o < 64; o <<= 1) {
#pragma unroll
                        for (int qq = 0; qq < 4; ++qq) best[qq] = max(best[qq], (unsigned)__shfl_xor((int)best[qq], o));
                    }
#pragma unroll
                    for (int qq = 0; qq < 4; ++qq) {
                        const int blk = 255 - (int)(best[qq] & 255u);
#pragma unroll
                        for (int j = 0; j < 4; ++j) if (lane + 64 * j == blk) key[qq][j] = 0u;
                        if (lane == 0) sel[(q0 + qq) * 16 + n] = blk;
                    }
                }
            }
        }
        wave_lds_sync();
    }
    float* acc = wl;
    {
#pragma unroll
        for (int h = 0; h < 4; ++h) { const float gs = sigmoidf_(grow[h]);
#pragma unroll
            for (int dt = 0; dt < 4; ++dt) *(f32x4*)(acc + (qi * 4 + h) * 64 + 16 * dt + 4 * grp) = st[h].o[dt] * gs; }
        wave_lds_sync();
    }
    {
        const bf16* KF = p.KWF + (size_t)g * T * 64; const bf16* VF = p.VWF + (size_t)g * T * 64;
        int kstart = t0 - 512; if (kstart < 0) kstart = 0; kstart &= ~31;
        const int nsteps = (t0 + 16 - kstart + 31) >> 5;
#pragma unroll
        for (int h = 0; h < 4; ++h) attw_init(st[h]);
        auto issue = [&](int s_, bf16x8 (&K)[2][2], bf16x8 (&V)[4]) {
            const int k0 = kstart + 32 * s_;
#pragma unroll
            for (int tl = 0; tl < 2; ++tl)
#pragma unroll
                for (int ks = 0; ks < 2; ++ks) K[tl][ks] = *(const bf16x8*)(KF + kfrag_off((k0 >> 4) + tl, ks, lane));
#pragma unroll
            for (int dt = 0; dt < 4; ++dt) V[dt] = *(const bf16x8*)(VF + vfrag_off(k0 >> 5, dt, lane));
        };
        auto compute = [&](int s_, const bf16x8 (&K)[2][2], const bf16x8 (&V)[4]) {
            const int k0 = kstart + 32 * s_;
            const bool need_mask = (k0 + 31 > t0) || (k0 < t0 + 15 - 512);
            const int pb = k0 + 4 * grp;
#pragma unroll
            for (int h = 0; h < 4; ++h) {
                f32x4 s0, s1; qk_step(K, qf[h], s0, s1);
                if (need_mask) {
#pragma unroll
                    for (int i = 0; i < 4; ++i) { const int p0 = pb + i, p1 = pb + 16 + i;
                        if (p0 > t || p0 < t - 512) s0[i] = -INFINITY; if (p1 > t || p1 < t - 512) s1[i] = -INFINITY; }
                }
                att_update(st[h], s0, s1, V);
            }
        };
        bf16x8 kA[2][2], vA[4], kB[2][2], vB[4];
        issue(0, kA, vA);
        for (int s = 0; s < nsteps; s += 2) {
            if (s + 1 < nsteps) issue(s + 1, kB, vB);
            compute(s, kA, vA);
            if (s + 1 < nsteps) { if (s + 2 < nsteps) issue(s + 2, kA, vA); compute(s + 1, kB, vB); }
        }
#pragma unroll
        for (int h = 0; h < 4; ++h) { const float lt = grp_sum(st[h].l); const float gs = sigmoidf_(grow[16 + h]) * (lt > 0.f ? 1.f / lt : 0.f);
#pragma unroll
            for (int dt = 0; dt < 4; ++dt) { f32x4* a = (f32x4*)(acc + (qi * 4 + h) * 64 + 16 * dt + 4 * grp); *a = *a + st[h].o[dt] * gs; } }
        wave_lds_sync();
    }
    *(int4*)(p.SEL + ((size_t)g * T + t0) * 16 + lane * 4) = *(const int4*)(sel + lane * 4);
#pragma unroll 4
    for (int q = 0; q < 16; ++q) *(f32x4*)(p.NSACC + (size_t)(t0 + q) * 512 + g * 256 + 4 * lane) = *(const f32x4*)(acc + q * 256 + 4 * lane);
    wave_lds_sync();
}

__device__ __forceinline__ void nsa_slc_item(const KP& p, int tq, int g, int lane) {
    asm volatile("" : "+v"(lane));
    const int l15 = lane & 15, grp = lane >> 4, hn = lane & 3;
    const bf16* KF = p.KSF + (size_t)g * T * 64; const bf16* VF = p.VSF + (size_t)g * T * 64;
    const int* selp = p.SEL + ((size_t)g * T + tq) * 16;
    int sb[16];
#pragma unroll
    for (int i = 0; i < 16; ++i) sb[i] = __builtin_amdgcn_readfirstlane(selp[i]);
    bf16x8 qs[2];
#pragma unroll
    for (int ks = 0; ks < 2; ++ks) qs[ks] = *(const bf16x8*)(p.QB + (size_t)tq * 512 + (g * 4 + hn) * 64 + 32 * ks + 8 * grp);
    AttW a; attw_init(a);
    bf16x8 kf[2][2][2], vf[2][4];
    auto issue = [&](int i, int buf) {
        const int blk = sb[i >> 1]; int k0 = blk * 64 + 32 * (i & 1); if (blk < 0 || k0 > tq) k0 = 0;
#pragma unroll
        for (int tl = 0; tl < 2; ++tl)
#pragma unroll
            for (int ks = 0; ks < 2; ++ks) kf[buf][tl][ks] = *(const bf16x8*)(KF + kfrag_off((k0 >> 4) + tl, ks, lane));
#pragma unroll
        for (int dt = 0; dt < 4; ++dt) vf[buf][dt] = *(const bf16x8*)(VF + vfrag_off(k0 >> 5, dt, lane));
    };
    issue(0, 0);
#pragma unroll
    for (int i = 0; i < 32; ++i) {
        const int buf = i & 1;
        if (i + 1 < 32) issue(i + 1, buf ^ 1);
        const int blk = sb[i >> 1]; const int k0 = blk * 64 + 32 * (i & 1);
        const bool dead = (blk < 0) || (k0 > tq);
        f32x4 s0, s1; qk_step(kf[buf], qs, s0, s1);
        const int pb = k0 + 4 * grp;
#pragma unroll
        for (int j = 0; j < 4; ++j) { if (dead || pb + j > tq) s0[j] = -INFINITY; if (dead || pb + 16 + j > tq) s1[j] = -INFINITY; }
        att_update(a, s0, s1, vf[buf]);
    }
    const float lt = grp_sum(a.l);
    if (l15 < 4) {
        const float gs = sigmoidf_(p.BIGF[(size_t)tq * PA + C_GATE + 8 + g * 4 + l15]) * (lt > 0.f ? 1.f / lt : 0.f);
#pragma unroll
        for (int dt = 0; dt < 4; ++dt) {
            const size_t o = (size_t)tq * 512 + g * 256 + l15 * 64 + 16 * dt + 4 * grp;
            const f32x4 base = *(const f32x4*)(p.NSACC + o); const f32x4 v = base + a.o[dt] * gs;
            uint2 w; w.x = pk2(v[0], v[1]); w.y = pk2(v[2], v[3]);
            *(uint2*)(p.MIXB + (size_t)tq * 1024 + g * 256 + l15 * 64 + 16 * dt + 4 * grp) = w;
        }
    }
}

__device__ __forceinline__ void ph_compress(const KP& p, const Fr& F) {
    float* flat = (float*)F.lds;
    float* hid = (float*)(F.lds + 32768);
    float* res = (float*)(F.lds + 32768 + 2048);
    const float* H0 = p.BIGF;
    const int tid = F.tid;
    for (int item = F.bid; item < 512; item += F.G) {
        const int c = item & 511, s = item >> 9;
        for (int e = tid; e < 8192; e += NTHR) {
            const int kv = e >> 12, g = (e >> 11) & 1, k = e & 2047, i = k >> 6, d = k & 63;
            const int row = c * 32 + i;
            float v;
            if (s == 0) v = H0[(size_t)row * PA + C_KC + kv * 128 + g * 64 + d];
            else { const int b = s - 1; const int page = p.page_table[b * NPAGES + (row >> 7)];
                   v = p.cache_cmp[((((size_t)page * 128 + (row & 127)) * 2 + kv) * 2 + g) * 64 + d]; }
            flat[e] = v + p.cpe[(kv * 32 + i) * 64 + d];
        }
        __syncthreads();
        {
            const int kv = tid >> 8, g = (tid >> 7) & 1, j = tid & 127;
            const float* w = p.cw1 + (size_t)kv * 2048 * 128 + j;
            const float* fl = flat + (kv * 2 + g) * 2048;
            float acc = p.cb1[kv * 128 + j];
            for (int k = 0; k < 2048; ++k) acc += fl[k] * w[(size_t)k * 128];
            hid[(kv * 2 + g) * 128 + j] = gelu_tanh(acc);
        }
        __syncthreads();
        if (tid < 256) {
            const int kv = tid >> 7, g = (tid >> 6) & 1, d = tid & 63;
            const float* w = p.cw2 + (size_t)kv * 128 * 64 + d;
            const float* hh = hid + (kv * 2 + g) * 128;
            float acc = 0.f;
            for (int j = 0; j < 128; ++j) acc += hh[j] * w[j * 64];
            res[(kv * 2 + g) * 64 + d] = acc;
        }
        __syncthreads();
        if (tid < 256) {
            const int kv = tid >> 7, g = (tid >> 6) & 1, d = tid & 63;
            const float* rr = res + (kv * 2 + g) * 64;
            float v = rr[d];
            if (kv == 0) {
                const int pos = (c + 1) * 32 - 1; const float2 cs = p.ROPE[pos * 32 + (d & 31)];
                const float x1 = rr[d & 31], x2 = rr[(d & 31) + 32];
                v = (d < 32) ? (x1 * cs.x - x2 * cs.y) : (x2 * cs.x + x1 * cs.y);
                p.CK[(((size_t)s * 512 + c) * 2 + g) * 64 + d] = v;
                if (s == 0) p.CKF[(size_t)g * 512 * 64 + kfrag_elem(c, d)] = (bf16)f2bf(v);
            } else { p.CV[(((size_t)s * 512 + c) * 2 + g) * 64 + d] = v; if (s == 0) p.CVF[(size_t)g * 512 * 64 + vfrag_elem(c, d)] = (bf16)f2bf(v); }
        }
        __syncthreads();
    }
}

__device__ __forceinline__ void ph_gdn_prep(const KP& p, const Fr& F) {
    const float* H0 = p.BIGF; const int lane = F.lane;
    for (int item = T * 8 + F.gw; item < TS * 8; item += F.NGW) {
        const int r = item >> 3, h = item & 7;
        const bool smp = r >= T; const int b = r - T;
        float cv[3];
#pragma unroll
        for (int part = 0; part < 3; ++part) {
            const int ch = part * 512 + h * 64 + lane;
            float acc = 0.f;
#pragma unroll
            for (int j = 0; j < 4; ++j) {
                float u;
                if (!smp) { const int t = r + j - 3; u = (t >= 0) ? H0[(size_t)t * PA + C_GQKV + ch] : 0.f; }
                else { u = (j < 3) ? p.st_gconv[((size_t)b * 3 + j) * 1536 + ch] : H0[(size_t)r * PA + C_GQKV + ch]; }
                acc += p.gconv_w[j * 1536 + ch] * u;
            }
            cv[part] = siluf_(acc);
        }
        const float qn = wave_sum(cv[0] * cv[0]), kn = wave_sum(cv[1] * cv[1]);
        const size_t o = ((size_t)r * 8 + h) * 64 + lane;
        p.GQ[o] = cv[0] * rsqrtf(qn + NORM_EPS) * 0.125f;
        p.GK[o] = cv[1] * rsqrtf(kn + NORM_EPS);
        p.GV[o] = cv[2];
        if (lane == 0) {
            const float av = H0[(size_t)r * PA + C_A + h], bt = H0[(size_t)r * PA + C_BT + h];
            p.Gg[(size_t)r * 8 + h] = -expf(p.gA[h]) * softplusf_(av + p.gdt[h]);
            p.Gb[(size_t)r * 8 + h] = sigmoidf_(bt);
        }
    }
    const size_t gt = (size_t)F.bid * NTHR + F.tid, GT = (size_t)F.G * NTHR;
    for (size_t idx = gt; idx < (size_t)3 * 1536; idx += GT) {
        const int j = (int)(idx / 1536), ch = (int)(idx % 1536);
        p.out[O_GCONV_P + idx] = H0[(size_t)(T - 3 + j) * PA + C_GQKV + ch];
    }
    for (size_t idx = gt; idx < (size_t)NSMP * 3 * 1536; idx += GT) {
        const int b = (int)(idx / (3 * 1536)), j = (int)((idx / 1536) % 3), ch = (int)(idx % 1536);
        p.out[O_GCONV_S + idx] = (j < 2) ? p.st_gconv[((size_t)b * 3 + j + 1) * 1536 + ch] : H0[(size_t)(T + b) * PA + C_GQKV + ch];
    }
}

template <int NH, class KF>
__device__ __forceinline__ void wave_attend(const float* qs, float* sc, int scstride, int nkeys, KF kf, float (&outv)[NH], float (&den)[NH], int lane, float* mxout = nullptr) {
    float mx[NH];
#pragma unroll
    for (int h = 0; h < NH; ++h) mx[h] = -INFINITY;
    for (int j = lane; j < nkeys; j += 64) {
        const float *kp, *vp; const bool ok = kf(j, kp, vp);
        float s[NH];
#pragma unroll
        for (int h = 0; h < NH; ++h) s[h] = 0.f;
        if (ok) {
            for (int d4 = 0; d4 < 16; ++d4) {
                const float4 kvv = ((const float4*)kp)[d4];
#pragma unroll
                for (int h = 0; h < NH; ++h) { const float* q = qs + h * 64 + d4 * 4; s[h] += kvv.x * q[0] + kvv.y * q[1] + kvv.z * q[2] + kvv.w * q[3]; }
            }
        }
#pragma unroll
        for (int h = 0; h < NH; ++h) { const float v = ok ? s[h] * 0.125f : -INFINITY; sc[h * scstride + j] = v; mx[h] = fmaxf(mx[h], v); }
    }
#pragma unroll
    for (int h = 0; h < NH; ++h) { mx[h] = wave_max(mx[h]); if (!(mx[h] > -INFINITY)) mx[h] = 0.f; if (mxout) mxout[h] = mx[h]; }
    float sm[NH];
#pragma unroll
    for (int h = 0; h < NH; ++h) sm[h] = 0.f;
    for (int j = lane; j < nkeys; j += 64) {
#pragma unroll
        for (int h = 0; h < NH; ++h) { const float v = sc[h * scstride + j]; const float pp = (v == -INFINITY) ? 0.f : expf(v - mx[h]); sc[h * scstride + j] = pp; sm[h] += pp; }
    }
#pragma unroll
    for (int h = 0; h < NH; ++h) { sm[h] = wave_sum(sm[h]); den[h] = sm[h] > 0.f ? sm[h] : 1.f; }
    wave_lds_sync();
    {
        const int kq = lane >> 4, d4 = lane & 15;
        float4 acc[NH];
#pragma unroll
        for (int h = 0; h < NH; ++h) acc[h] = make_float4(0.f, 0.f, 0.f, 0.f);
        for (int j0 = 0; j0 < nkeys; j0 += 32) {
            float4 v[8];
#pragma unroll
            for (int u = 0; u < 8; ++u) { const int j = j0 + 4 * u + kq; const float *kp, *vp; const bool ok = (j < nkeys) && kf(j, kp, vp);
                v[u] = ok ? *(const float4*)(vp + 4 * d4) : make_float4(0.f, 0.f, 0.f, 0.f); }
#pragma unroll
            for (int u = 0; u < 8; ++u) { const int j = j0 + 4 * u + kq;
#pragma unroll
                for (int h = 0; h < NH; ++h) { const float pp = (j < nkeys) ? sc[h * scstride + j] : 0.f;
                    acc[h].x += pp * v[u].x; acc[h].y += pp * v[u].y; acc[h].z += pp * v[u].z; acc[h].w += pp * v[u].w; } }
        }
#pragma unroll
        for (int h = 0; h < NH; ++h) {
            float4 a = acc[h];
            a.x += __shfl_xor(a.x, 16); a.y += __shfl_xor(a.y, 16); a.z += __shfl_xor(a.z, 16); a.w += __shfl_xor(a.w, 16);
            a.x += __shfl_xor(a.x, 32); a.y += __shfl_xor(a.y, 32); a.z += __shfl_xor(a.z, 32); a.w += __shfl_xor(a.w, 32);
            const float x0 = __shfl(a.x, lane >> 2), x1 = __shfl(a.y, lane >> 2), x2 = __shfl(a.z, lane >> 2), x3 = __shfl(a.w, lane >> 2);
            const int cc = lane & 3; outv[h] = cc == 0 ? x0 : (cc == 1 ? x1 : (cc == 2 ? x2 : x3));
        }
    }
#pragma unroll
    for (int h = 0; h < NH; ++h) outv[h] /= den[h];
    wave_lds_sync();
}

__device__ __forceinline__ void nsa_smp_cs(const KP& p, int b, int g, float* wl, int lane) {
    float* qs = wl; float* sc = wl + 256; float* imp = wl + 256 + 4 * 1088; int* sel = (int*)(wl + 256 + 4 * 1088 + 320); long long* bb = (long long*)(wl + 256 + 4 * 1088 + 320 + 16);
    const int r = T + b; const int qpos = T;
    const float* grow = p.BIGF + (size_t)r * PA + C_GATE;
#pragma unroll
    for (int h = 0; h < 4; ++h) qs[h * 64 + lane] = p.QR[(size_t)r * 512 + (g * 4 + h) * 64 + lane];
    wave_lds_sync();
    float ocmp[4], oslc[4], den[4];
    {
        const float* CKp = p.CK + (size_t)(1 + b) * 512 * 128; const float* CVp = p.CV + (size_t)(1 + b) * 512 * 128;
        auto kf = [&](int j, const float*& kp, const float*& vp) -> bool { kp = CKp + (j * 2 + g) * 64; vp = CVp + (j * 2 + g) * 64; return true; };
        wave_attend<4>(qs, sc, 1088, 512, kf, ocmp, den, lane);
        for (int blk = lane; blk < 320; blk += 64) {
            float v = 0.f;
            if (blk < 256) {
#pragma unroll
                for (int h = 0; h < 4; ++h) v += (sc[h * 1088 + 2 * blk] + sc[h * 1088 + 2 * blk + 1]) / den[h];
            }
            imp[blk] = v;
        }
        wave_lds_sync();
    }
    {
        const int cur = qpos >> 6;
        float val[5];
#pragma unroll
        for (int j = 0; j < 5; ++j) { const int blk = lane + 64 * j; val[j] = (blk >= 1 && blk <= cur - 2) ? imp[blk] : -1.f; }
        if (lane == 0) { sel[0] = 0; sel[1] = cur; sel[2] = cur - 1; }
        for (int n = 3; n < 16; ++n) {
            float bv = -2.f; int bi = 0x7fffffff;
#pragma unroll
            for (int j = 0; j < 5; ++j) if (val[j] > bv) { bv = val[j]; bi = lane + 64 * j; }
#pragma unroll
            for (int o = 1; o < 64; o <<= 1) { const float ov = __shfl_xor(bv, o); const int oi = __shfl_xor(bi, o); if (ov > bv || (ov == bv && oi < bi)) { bv = ov; bi = oi; } }
#pragma unroll
            for (int j = 0; j < 5; ++j) if (lane + 64 * j == bi) val[j] = -3.f;
            if (lane == 0) sel[n] = bi;
        }
        wave_lds_sync();
        if (lane < 16) { const int blk = sel[lane]; long long o = 0;
            if (blk < 256) { const int page = p.page_table[b * NPAGES + (blk >> 1)]; o = ((long long)page * 128 + (blk & 1) * 64) * 256; }
            bb[lane] = o; }
        wave_lds_sync();
    }
    {
        auto kf = [&](int j, const float*& kp, const float*& vp) -> bool {
            const int blk = sel[j >> 6]; const int pos = blk * 64 + (j & 63); if (pos > qpos) return false;
            if (pos == T) { kp = p.KS + (size_t)r * 128 + g * 64; vp = p.VS + (size_t)r * 128 + g * 64; return true; }
            const float* base = p.cache_slc + bb[j >> 6] + (j & 63) * 256;
            kp = base + g * 64; vp = base + 128 + g * 64; return true; };
        wave_attend<4>(qs, sc, 1088, 1024, kf, oslc, den, lane);
    }
#pragma unroll
    for (int h = 0; h < 4; ++h) {
        const int hh = g * 4 + h;
        p.SMIXF[((size_t)b * 3 + 0) * 512 + hh * 64 + lane] = sigmoidf_(grow[hh]) * ocmp[h];
        p.SMIXF[((size_t)b * 3 + 1) * 512 + hh * 64 + lane] = sigmoidf_(grow[8 + hh]) * oslc[h];
    }
    wave_lds_sync();
}
__device__ __forceinline__ void nsa_smp_win(const KP& p, int b, int g, float* wl, int lane) {
    float* qs = wl; float* sc = wl + 256;
    const int r = T + b;
    const float* grow = p.BIGF + (size_t)r * PA + C_GATE;
#pragma unroll
    for (int h = 0; h < 4; ++h) qs[h * 64 + lane] = p.QR[(size_t)r * 512 + (g * 4 + h) * 64 + lane];
    wave_lds_sync();
    float owin[4], den[4];
    auto kf = [&](int j, const float*& kp, const float*& vp) -> bool {
        if (j == 512) { kp = p.KW + (size_t)r * 128 + g * 64; vp = p.VW + (size_t)r * 128 + g * 64; return true; }
        const float* base = p.st_win + ((size_t)b * 512 + j) * 256;
        kp = base + g * 64; vp = base + 128 + g * 64; return true; };
    wave_attend<4>(qs, sc, 528, 513, kf, owin, den, lane);
#pragma unroll
    for (int h = 0; h < 4; ++h) { const int hh = g * 4 + h; p.SMIXF[((size_t)b * 3 + 2) * 512 + hh * 64 + lane] = sigmoidf_(grow[16 + hh]) * owin[h]; }
    wave_lds_sync();
}

__device__ __forceinline__ void gdn_scan_item(const KP& p, int item, float* wl, int lane) {
    asm volatile("" : "+v"(lane));
    float* kq = wl;
    const int b = (item >> 3) - 1, h = item & 7;
    const int r = T + b; const size_t o = ((size_t)r * 8 + h) * 64;
    kq[lane] = p.GK[o + lane]; kq[64 + lane] = p.GQ[o + lane];
    wave_lds_sync();
    const float dec = expf(p.Gg[(size_t)r * 8 + h]), bt = p.Gb[(size_t)r * 8 + h];
    const float* Sp = p.st_gS + ((size_t)b * 8 + h) * 4096 + lane;
    float* so = p.out + O_GS_S + ((size_t)b * 8 + h) * 4096 + lane;
    float S[64]; float kv = 0.f;
#pragma unroll
    for (int i = 0; i < 64; ++i) { S[i] = Sp[i * 64] * dec; kv += kq[i] * S[i]; }
    const float vn = (p.GV[o + lane] - kv) * bt;
    float ov = 0.f;
#pragma unroll
    for (int i = 0; i < 64; ++i) { const float sn = S[i] + kq[i] * vn; ov += kq[64 + i] * sn; so[i * 64] = sn; }
    p.OG[o + lane] = ov;
    wave_lds_sync();
}

constexpr int GDN_WL = 34816;
__device__ __forceinline__ int kperm(int ks, int grp, int j) { return 32 * ks + 16 * (j >> 2) + 4 * grp + (j & 3); }

__device__ __forceinline__ void gdn_chunk_unit(const KP& p, int unit, unsigned char* ldsb, int woff, int lane) {
    asm volatile("" : "+v"(lane), "+s"(woff));
    unsigned char* wlb = ldsb + woff;
    const int n = unit >> 3, h = unit & 7, t0 = 64 * n;
    const int l15 = lane & 15, grp = lane >> 4;
    float* Af = (float*)wlb; bf16* kt = (bf16*)(wlb + 16384); bf16* qt = kt + 64 * 72; bf16* tmp = (bf16*)wlb;
    {
        const float* H0 = p.BIGF;
        float w[3][4], u1[3], u2[3], u3[3];
#pragma unroll
        for (int part = 0; part < 3; ++part) {
            const int ch = part * 512 + h * 64 + lane;
#pragma unroll
            for (int j = 0; j < 4; ++j) w[part][j] = p.gconv_w[j * 1536 + ch];
            u1[part] = (t0 >= 1) ? H0[(size_t)(t0 - 1) * PA + C_GQKV + ch] : 0.f;
            u2[part] = (t0 >= 2) ? H0[(size_t)(t0 - 2) * PA + C_GQKV + ch] : 0.f;
            u3[part] = (t0 >= 3) ? H0[(size_t)(t0 - 3) * PA + C_GQKV + ch] : 0.f;
        }
        int roff = 0;
#pragma unroll 4
        for (int i = 0; i < 64; ++i) {
            float cv[3];
#pragma unroll
            for (int part = 0; part < 3; ++part) {
                const float u0 = H0[(size_t)t0 * PA + C_GQKV + part * 512 + h * 64 + lane + roff];
                cv[part] = siluf_(w[part][0] * u3[part] + w[part][1] * u2[part] + w[part][2] * u1[part] + w[part][3] * u0);
                u3[part] = u2[part]; u2[part] = u1[part]; u1[part] = u0;
            }
            roff += PA; asm volatile("" : "+s"(roff));
            const float qn = wave_sum(cv[0] * cv[0]), kn = wave_sum(cv[1] * cv[1]);
            qt[i * 72 + lane] = (bf16)f2bf(cv[0] * rsqrtf(qn + NORM_EPS) * 0.125f);
            kt[i * 72 + lane] = (bf16)f2bf(cv[1] * rsqrtf(kn + NORM_EPS));
            p.GV[((size_t)(t0 + i) * 8 + h) * 64 + lane] = cv[2];
        }
    }
    const float gl_ = -fexp_(p.gA[h]) * softplusf_(p.BIGF[(size_t)(t0 + lane) * PA + C_A + h] + p.gdt[h]);
    const float beta = sigmoidf_(p.BIGF[(size_t)(t0 + lane) * PA + C_BT + h]);
    float gc = gl_;
#pragma unroll
    for (int o = 1; o < 64; o <<= 1) { const float tv = __shfl_up(gc, o); if (lane >= o) gc += tv; }
    const float gclast = __shfl(gc, 63);
#define GPAD(i) ((float*)(kt + (i) * 72 + 64))
    { float* pd = GPAD(lane); pd[0] = gc; pd[1] = beta; pd[2] = fexp_(gc); pd[3] = fexp_(gclast - gc); }
    wave_lds_sync();
    bf16* QKF = p.G_QKF + (size_t)unit * 4096;
#pragma unroll
    for (int it = 0; it < 4; ++it) {
        const int i = 16 * it + l15;
        const float gci = GPAD(i)[0], bi = GPAD(i)[1];
        bf16x8 bk[2], bq[2];
#pragma unroll
        for (int ks = 0; ks < 2; ++ks) { bk[ks] = *(const bf16x8*)(kt + i * 72 + 32 * ks + 8 * grp); bq[ks] = *(const bf16x8*)(qt + i * 72 + 32 * ks + 8 * grp); }
#pragma unroll
        for (int jt = 0; jt < 4; ++jt) {
            uint2 qkp = make_uint2(0u, 0u);
            if (jt <= it) {
                bf16x8 ak[2];
#pragma unroll
                for (int ks = 0; ks < 2; ++ks) ak[ks] = *(const bf16x8*)(kt + (16 * jt + l15) * 72 + 32 * ks + 8 * grp);
                f32x4 aa = {0.f, 0.f, 0.f, 0.f}, aq = {0.f, 0.f, 0.f, 0.f};
                aa = MFMA16(ak[0], bk[0], aa); aa = MFMA16(ak[1], bk[1], aa);
                aq = MFMA16(ak[0], bq[0], aq); aq = MFMA16(ak[1], bq[1], aq);
                f32x4 av, qv;
#pragma unroll
                for (int r = 0; r < 4; ++r) {
                    const int j = 16 * jt + 4 * grp + r; const float gcj = GPAD(j)[0];
                    const float e = (j <= i) ? fexp_(gci - gcj) : 0.f;
                    av[r] = (j < i) ? bi * aa[r] * e : 0.f; qv[r] = aq[r] * e;
                }
                *(f32x4*)(Af + i * 64 + 16 * jt + 4 * grp) = av;
                qkp.x = pk2(qv[0], qv[1]); qkp.y = pk2(qv[2], qv[3]);
            }
            *(uint2*)(QKF + ((size_t)(it * 2 + (jt >> 1)) * 64 + lane) * 8 + (jt & 1) * 4) = qkp;
        }
    }
    wave_lds_sync();
    {
        float* UF = p.G_UF + (size_t)unit * 4096;
        const int vq = lane >> 4;
#pragma unroll
        for (int pass = 0; pass < 2; ++pass) {
            float x[64];
            int goff = 0;
#pragma unroll
            for (int i = 0; i < 64; ++i) {
                const float bi = GPAD(i)[1];
                float acc;
                if (pass == 0) { acc = p.GV[((size_t)t0 * 8 + h) * 64 + lane + goff] * bi; goff += 512; asm volatile("" : "+s"(goff)); }
                else { const float ei = GPAD(i)[2];
                       acc = __uint_as_float((unsigned)kt[i * 72 + lane] << 16) * bi * ei; }
#pragma unroll
                for (int jj = 0; jj < (i + 3) / 4; ++jj) {
                    const float4 a4 = *(const float4*)(Af + i * 64 + 4 * jj);
                    acc -= a4.x * x[4 * jj + 0];
                    if (4 * jj + 1 < i) acc -= a4.y * x[4 * jj + 1];
                    if (4 * jj + 2 < i) acc -= a4.z * x[4 * jj + 2];
                    if (4 * jj + 3 < i) acc -= a4.w * x[4 * jj + 3];
                }
                x[i] = acc;
                if ((i & 3) == 3) asm volatile("" ::: "memory");
            }
            if (pass == 0) {
#pragma unroll
                for (int c4 = 0; c4 < 16; ++c4) {
                    const int mt = c4 >> 2, lp = l15 + 16 * (c4 & 3);
                    *(f32x4*)(UF + ((size_t)(vq * 4 + mt) * 64 + lp) * 4) = (f32x4){x[4 * c4], x[4 * c4 + 1], x[4 * c4 + 2], x[4 * c4 + 3]};
                }
            } else {
                wave_lds_sync();
#pragma unroll
                for (int c = 0; c < 64; ++c) tmp[c * 72 + lane] = (bf16)f2bf(-x[c]);
            }
            asm volatile("" ::: "memory");
        }
    }
    wave_lds_sync();
    {
        bf16* WF = p.G_WF + (size_t)unit * 4096; bf16* QGF = p.G_QGF + (size_t)unit * 4096; bf16* KDF = p.G_KDF + (size_t)unit * 4096;
#pragma unroll
        for (int mt = 0; mt < 4; ++mt) {
            const float egc = GPAD(16 * mt + l15)[2];
#pragma unroll
            for (int ks = 0; ks < 2; ++ks) {
                const int c = 16 * mt + l15, k0 = 32 * ks + 4 * grp;
                const uint2 w0 = *(const uint2*)(tmp + c * 72 + k0), w1 = *(const uint2*)(tmp + c * 72 + k0 + 16);
                v4u wv; wv.x = w0.x; wv.y = w0.y; wv.z = w1.x; wv.w = w1.y;
                *(v4u*)(WF + ((size_t)(mt * 2 + ks) * 64 + lane) * 8) = wv;
                const uint2 q0 = *(const uint2*)(qt + c * 72 + k0), q1 = *(const uint2*)(qt + c * 72 + k0 + 16);
                v4u qv;
                qv.x = pk2(__uint_as_float(q0.x << 16) * egc, __uint_as_float(q0.x & 0xffff0000u) * egc); qv.y = pk2(__uint_as_float(q0.y << 16) * egc, __uint_as_float(q0.y & 0xffff0000u) * egc);
                qv.z = pk2(__uint_as_float(q1.x << 16) * egc, __uint_as_float(q1.x & 0xffff0000u) * egc); qv.w = pk2(__uint_as_float(q1.y << 16) * egc, __uint_as_float(q1.y & 0xffff0000u) * egc);
                *(v4u*)(QGF + ((size_t)(mt * 2 + ks) * 64 + lane) * 8) = qv;
                float kd[8];
#pragma unroll
                for (int j = 0; j < 8; ++j) { const int cc = kperm(ks, grp, j); kd[j] = __uint_as_float((unsigned)kt[cc * 72 + 16 * mt + l15] << 16) * GPAD(cc)[3]; }
                v4u kv; kv.x = pk2(kd[0], kd[1]); kv.y = pk2(kd[2], kd[3]); kv.z = pk2(kd[4], kd[5]); kv.w = pk2(kd[6], kd[7]);
                *(v4u*)(KDF + ((size_t)(mt * 2 + ks) * 64 + lane) * 8) = kv;
            }
        }
        if (lane == 0) p.G_GL[unit] = fexp_(gclast);
    }
    wave_lds_sync();
#undef GPAD
}

constexpr int CH_SLOT = 32768;
__device__ __forceinline__ void gdn_chain_wg(const KP& p, int h, int wave, int lane, unsigned char* ldsb) {
    asm volatile("" : "+v"(lane));
    const int l15 = lane & 15, grp = lane >> 4;
    float* GLs = (float*)(ldsb + 4 * CH_SLOT);
    if (wave < 4) GLs[wave * 64 + lane] = p.G_GL[(size_t)(wave * 64 + lane) * 8 + h];
#define CH_BAR() do { asm volatile("s_waitcnt lgkmcnt(0)" ::: "memory"); __builtin_amdgcn_s_barrier(); asm volatile("" ::: "memory"); } while (0)
    if (wave >= 4) {
        const int lw = wave - 4;
        const unsigned char* gb = (lw == 0) ? (const unsigned char*)p.G_WF : (lw == 1) ? (const unsigned char*)p.G_KDF : (const unsigned char*)p.G_UF + (size_t)(lw - 2) * 8192;
        const size_t ustride = (lw < 2) ? 8192 : 16384;
        gb += (size_t)h * ustride + (size_t)lane * 16;
        auto src = [&](int n, int k) -> const v4u* { return (const v4u*)(gb + (size_t)n * 8 * ustride + k * 1024); };
        v4u rs[4][8];
#pragma unroll
        for (int j = 0; j < 4; ++j)
#pragma unroll
            for (int k = 0; k < 8; ++k) rs[j][k] = *src(j, k);
#pragma unroll
        for (int j = 0; j < 2; ++j) {
#pragma unroll
            for (int k = 0; k < 8; ++k) { *(v4u*)(ldsb + j * CH_SLOT + (lw * 512 + k * 64 + lane) * 16) = rs[j][k]; rs[j][k] = *src(4 + j, k); }
        }
        CH_BAR();
        for (int n0 = 0; n0 < 256; n0 += 4) {
#pragma unroll
            for (int j = 0; j < 4; ++j) {
                const int n = n0 + j, st = n + 2;
                if (st < 256) {
                    const int set = (j + 2) & 3;
#pragma unroll
                    for (int k = 0; k < 8; ++k) { *(v4u*)(ldsb + (st & 3) * CH_SLOT + (lw * 512 + k * 64 + lane) * 16) = rs[set][k]; if (st + 4 < 256) rs[set][k] = *src(st + 4, k); }
                }
                CH_BAR();
            }
        }
#undef CH_BAR
        return;
    }
    const int vq = wave;
    f32x4 S[4];
#pragma unroll
    for (int i = 0; i < 4; ++i) S[i] = (f32x4){0.f, 0.f, 0.f, 0.f};
    asm volatile("s_waitcnt lgkmcnt(0)" ::: "memory"); __builtin_amdgcn_s_barrier(); asm volatile("" ::: "memory");
    for (int n = 0; n < 256; ++n) {
        const unsigned char* sl = ldsb + (n & 3) * CH_SLOT;
        bf16x8 wf[4][2], kdf[4][2]; f32x4 uf[4];
#pragma unroll
        for (int mt = 0; mt < 4; ++mt) {
#pragma unroll
            for (int ks = 0; ks < 2; ++ks) { wf[mt][ks] = *(const bf16x8*)(sl + ((mt * 2 + ks) * 64 + lane) * 16); kdf[mt][ks] = *(const bf16x8*)(sl + 8192 + ((mt * 2 + ks) * 64 + lane) * 16); }
            uf[mt] = *(const f32x4*)(sl + 16384 + ((vq * 4 + mt) * 64 + lane) * 16);
        }
        const float gl = GLs[n];
        const size_t fo = ((size_t)((n * 8 + h) * 4 + vq) * 2) * 512;
        bf16x8 sB[2];
#pragma unroll
        for (int ks = 0; ks < 2; ++ks) { sB[ks] = pack_p(S[2 * ks], S[2 * ks + 1]); *(bf16x8*)(p.G_SPF + fo + ((size_t)ks * 64 + lane) * 8) = sB[ks]; }
        f32x4 v[4];
#pragma unroll
        for (int mt = 0; mt < 4; ++mt) { v[mt] = uf[mt]; v[mt] = MFMA16(wf[mt][0], sB[0], v[mt]); v[mt] = MFMA16(wf[mt][1], sB[1], v[mt]); }
        bf16x8 vB[2];
#pragma unroll
        for (int ks = 0; ks < 2; ++ks) { vB[ks] = pack_p(v[2 * ks], v[2 * ks + 1]); *(bf16x8*)(p.G_VNF + fo + ((size_t)ks * 64 + lane) * 8) = vB[ks]; }
#pragma unroll
        for (int mt = 0; mt < 4; ++mt) { S[mt] = S[mt] * gl; S[mt] = MFMA16(kdf[mt][0], vB[0], S[mt]); S[mt] = MFMA16(kdf[mt][1], vB[1], S[mt]); }
        asm volatile("s_waitcnt lgkmcnt(0)" ::: "memory"); __builtin_amdgcn_s_barrier(); asm volatile("" ::: "memory");
    }
    float* so = p.out + O_GS_P + (size_t)h * 4096;
#pragma unroll
    for (int mt = 0; mt < 4; ++mt)
#pragma unroll
        for (int r = 0; r < 4; ++r) so[(16 * mt + 4 * grp + r) * 64 + 16 * vq + l15] = S[mt][r];
}

__device__ __forceinline__ void gdn_out_unit(const KP& p, int unit, int lane) {
    asm volatile("" : "+v"(lane));
    const int n = unit >> 3, h = unit & 7, t0 = 64 * n; const int l15 = lane & 15, grp = lane >> 4;
    const bf16* QGF = p.G_QGF + (size_t)unit * 4096; const bf16* QKF = p.G_QKF + (size_t)unit * 4096;
    f32x4 o[4][4];
#pragma unroll
    for (int mt = 0; mt < 4; ++mt)
#pragma unroll
        for (int vq = 0; vq < 4; ++vq) o[mt][vq] = (f32x4){0.f, 0.f, 0.f, 0.f};
#pragma unroll
    for (int ks = 0; ks < 2; ++ks) {
        bf16x8 sp[4], vn[4];
#pragma unroll
        for (int vq = 0; vq < 4; ++vq) { const size_t fo = ((size_t)(unit * 4 + vq) * 2 + ks) * 512 + (size_t)lane * 8; sp[vq] = *(const bf16x8*)(p.G_SPF + fo); vn[vq] = *(const bf16x8*)(p.G_VNF + fo); }
#pragma unroll
        for (int mt = 0; mt < 4; ++mt) {
            const bf16x8 qg = *(const bf16x8*)(QGF + ((size_t)(mt * 2 + ks) * 64 + lane) * 8), qk = *(const bf16x8*)(QKF + ((size_t)(mt * 2 + ks) * 64 + lane) * 8);
#pragma unroll
            for (int vq = 0; vq < 4; ++vq) { o[mt][vq] = MFMA16(qg, sp[vq], o[mt][vq]); o[mt][vq] = MFMA16(qk, vn[vq], o[mt][vq]); }
        }
    }
    float nw[4];
#pragma unroll
    for (int vq = 0; vq < 4; ++vq) nw[vq] = p.gnw[16 * vq + l15];
#pragma unroll
    for (int mt = 0; mt < 4; ++mt)
#pragma unroll
        for (int r = 0; r < 4; ++r) {
            float ss = 0.f;
#pragma unroll
            for (int vq = 0; vq < 4; ++vq) ss += o[mt][vq][r] * o[mt][vq][r];
            ss += __shfl_xor(ss, 1); ss += __shfl_xor(ss, 2); ss += __shfl_xor(ss, 4); ss += __shfl_xor(ss, 8);
            const float rs = rsqrtf(ss * (1.f / 64.f) + NORM_EPS);
            const int t = t0 + 16 * mt + 4 * grp + r;
            const float* zr = p.BIGF + (size_t)t * PA + C_Z + h * 64;
#pragma unroll
            for (int vq = 0; vq < 4; ++vq) p.MIXB[(size_t)t * 1024 + 512 + h * 64 + 16 * vq + l15] = (bf16)f2bf(o[mt][vq][r] * rs * nw[vq] * siluf_(zr[16 * vq + l15]));
        }
}

#define MFMA8(a, b, c) __builtin_amdgcn_mfma_f32_16x16x32_fp8_fp8((a), (b), (c), 0, 0, 0)
__device__ __forceinline__ long pack_fp8(const f32x4& a, const f32x4& b) {
    int w0 = 0, w1 = 0;
    w0 = __builtin_amdgcn_cvt_pk_fp8_f32(a[0], a[1], w0, false); w0 = __builtin_amdgcn_cvt_pk_fp8_f32(a[2], a[3], w0, true);
    w1 = __builtin_amdgcn_cvt_pk_fp8_f32(b[0], b[1], w1, false); w1 = __builtin_amdgcn_cvt_pk_fp8_f32(b[2], b[3], w1, true);
    return (long)(((unsigned long long)(unsigned)w1 << 32) | (unsigned long long)(unsigned)w0);
}
template <bool GEN>
__device__ __forceinline__ void nsa_slc_item8(const KP& p, int tq, int g, int lane) {
    asm volatile("" : "+v"(lane));
    const int l15 = lane & 15, grp = lane >> 4, hn = lane & 3;
    const unsigned char* KF = p.KS8 + (size_t)g * T * 64; const unsigned char* VF = p.VS8 + (size_t)g * T * 64;
    const int* selp = p.SEL + ((size_t)g * T + tq) * 16;
    int sb[16];
#pragma unroll
    for (int i = 0; i < 16; ++i) sb[i] = __builtin_amdgcn_readfirstlane(selp[i]);
    long qs[2];
#pragma unroll
    for (int ks = 0; ks < 2; ++ks) {
        const bf16x8 qb = *(const bf16x8*)(p.QB + (size_t)tq * 512 + (g * 4 + hn) * 64 + 32 * ks + 8 * grp);
        f32x4 a, b;
#pragma unroll
        for (int j = 0; j < 4; ++j) { a[j] = __uint_as_float((unsigned)(unsigned short)qb[j] << 16) * (1.f / QSCALE); b[j] = __uint_as_float((unsigned)(unsigned short)qb[4 + j] << 16) * (1.f / QSCALE); }
        qs[ks] = pack_fp8(a, b);
    }
    AttW a; attw_init(a);
    long kf[3][4][2], vf[3][2][4];
    auto issue = [&](int bi, int buf) {
        int blk = sb[bi]; if (GEN && (blk < 0 || blk * 64 > tq)) blk = 0;
        typedef long l2_t __attribute__((ext_vector_type(2)));
#pragma unroll
        for (int tl = 0; tl < 4; ++tl) { const l2_t x = *(const l2_t*)(KF + ((size_t)(blk * 4 + tl) * 64 + lane) * 16); kf[buf][tl][0] = x[0]; kf[buf][tl][1] = x[1]; }
#pragma unroll
        for (int dt = 0; dt < 4; ++dt) { const l2_t x = *(const l2_t*)(VF + ((size_t)(blk * 4 + dt) * 64 + lane) * 16); vf[buf][0][dt] = x[0]; vf[buf][1][dt] = x[1]; }
    };
    issue(0, 0); issue(1, 1);
#pragma unroll
    for (int bi = 0; bi < 16; ++bi) {
        const int buf = bi % 3;
        if (bi + 2 < 16) issue(bi + 2, (bi + 2) % 3);
        const int blk = sb[bi]; const int k0 = blk * 64;
        if (GEN && (blk < 0 || k0 > tq)) continue;
        const f32x4 z = {0.f, 0.f, 0.f, 0.f};
        f32x4 sc[4];
#pragma unroll
        for (int tl = 0; tl < 4; ++tl) { sc[tl] = MFMA8(kf[buf][tl][0], qs[0], z); sc[tl] = MFMA8(kf[buf][tl][1], qs[1], sc[tl]); }
        if (GEN ? (k0 + 63 > tq) : (bi == 1)) {
#pragma unroll
            for (int tl = 0; tl < 4; ++tl)
#pragma unroll
                for (int j = 0; j < 4; ++j) if (k0 + 16 * tl + 4 * grp + j > tq) sc[tl][j] = -INFINITY;
        }
        float mx = fmaxf(fmaxf(fmaxf(fmaxf(sc[0][0], sc[0][1]), fmaxf(sc[0][2], sc[0][3])), fmaxf(fmaxf(sc[1][0], sc[1][1]), fmaxf(sc[1][2], sc[1][3]))),
                         fmaxf(fmaxf(fmaxf(sc[2][0], sc[2][1]), fmaxf(sc[2][2], sc[2][3])), fmaxf(fmaxf(sc[3][0], sc[3][1]), fmaxf(sc[3][2], sc[3][3]))));
        mx = fmaxf(mx, __shfl_xor(mx, 16)); mx = fmaxf(mx, __shfl_xor(mx, 32));
        const float mn = fmaxf(a.m, mx * QSCALE);
        const float alpha = __builtin_amdgcn_exp2f(a.m - mn);
        const float mb = 7.f - mn;
        f32x4 pp[4]; float sum = 0.f;
#pragma unroll
        for (int tl = 0; tl < 4; ++tl) {
#pragma unroll
            for (int j = 0; j < 4; ++j) pp[tl][j] = __builtin_amdgcn_exp2f(fmaf(sc[tl][j], QSCALE, mb));
            sum += (pp[tl][0] + pp[tl][1]) + (pp[tl][2] + pp[tl][3]);
        }
        a.l = a.l * alpha + sum; a.m = mn;
        const long pf0 = pack_fp8(pp[0], pp[1]), pf1 = pack_fp8(pp[2], pp[3]);
#pragma unroll
        for (int dt = 0; dt < 4; ++dt) { a.o[dt] = a.o[dt] * alpha; a.o[dt] = MFMA8(vf[buf][0][dt], pf0, a.o[dt]); a.o[dt] = MFMA8(vf[buf][1][dt], pf1, a.o[dt]); }
    }
    const float lt = grp_sum(a.l);
    if (l15 < 4) {
        const float gs = sigmoidf_(p.BIGF[(size_t)tq * PA + C_GATE + 8 + g * 4 + l15]) * (lt > 0.f ? 1.f / lt : 0.f);
#pragma unroll
        for (int dt = 0; dt < 4; ++dt) {
            const size_t o = (size_t)tq * 512 + g * 256 + l15 * 64 + 16 * dt + 4 * grp;
            const f32x4 base = *(const f32x4*)(p.NSACC + o); const f32x4 v = base + a.o[dt] * gs;
            uint2 w; w.x = pk2(v[0], v[1]); w.y = pk2(v[2], v[3]);
            *(uint2*)(p.MIXB + (size_t)tq * 1024 + g * 256 + l15 * 64 + 16 * dt + 4 * grp) = w;
        }
    }
}

__device__ __forceinline__ void ph_gdn_chunks(const KP& p, const Fr& F) {
    if (F.wave < 4) for (int unit = F.bid * 4 + F.wave; unit < 2048; unit += F.G * 4) gdn_chunk_unit(p, unit, F.lds, F.wave * GDN_WL, F.lane);
    else { const int unit = F.bid * 4 + (F.wave - 4); if (unit < 128) cmp_prompt_unit(p, unit, F.lane); }
}
__device__ __forceinline__ void ph_mix_a(const KP& p, const Fr& F) {
    if (F.bid < 32) gdn_scan_item(p, (F.bid + 1) * 8 + F.wave, (float*)(F.lds + 8 * FAST_WL + 1024 + F.wave * 512), F.lane);
    float* wl = (float*)(F.lds + F.wave * FAST_WL);
    for (int unit = F.gw; unit < 2048; unit += F.NGW) nsa_fast_unit(p, unit, wl, F.lane);
}
__device__ __forceinline__ void ph_mix_b(const KP& p, const Fr& F) {
    if (F.bid < 8) { gdn_chain_wg(p, F.bid, F.wave, F.lane, F.lds); return; }
    if (F.bid < 24) {
        const int it = (F.bid - 8) * 4 + (F.wave & 3);
        if (F.wave < 4) nsa_smp_cs(p, it >> 1, it & 1, (float*)(F.lds + F.wave * 20480), F.lane);
        else nsa_smp_win(p, it >> 1, it & 1, (float*)(F.lds + 81920 + (F.wave - 4) * 12288), F.lane);
        return;
    }
    const int g = F.bid & 1, fr = (F.bid - 24) >> 1, NW = ((F.G - 24) >> 1) * 8;
    for (int tq = fr * 8 + F.wave; tq < T; tq += NW) { if (tq >= 1024) nsa_slc_item8<false>(p, tq, g, F.lane); else nsa_slc_item8<true>(p, tq, g, F.lane); }
}

__device__ __forceinline__ void ph_gdn_out(const KP& p, const Fr& F) {
    const float* H0 = p.BIGF; const int lane = F.lane;
    for (int unit = F.gw; unit < 2048; unit += F.NGW) gdn_out_unit(p, unit, lane);
    for (int idx = F.bid * NTHR + F.tid; idx < NSMP * 512; idx += F.G * NTHR) { const int b = idx >> 9, c = idx & 511; const float* sp = p.SMIXF + (size_t)b * 3 * 512 + c;
        p.MIXB[(size_t)(T + b) * 1024 + c] = (bf16)f2bf(sp[0] + sp[512] + sp[1024]); }
    for (int item = T * 8 + F.gw; item < TS * 8; item += F.NGW) {
        const int r = item >> 3, h = item & 7;
        const float o = p.OG[((size_t)r * 8 + h) * 64 + lane];
        const float ms = wave_sum(o * o) * (1.f / 64.f);
        const float z = H0[(size_t)r * PA + C_Z + h * 64 + lane];
        p.MIXB[(size_t)r * 1024 + 512 + h * 64 + lane] = (bf16)f2bf(o * rsqrtf(ms + NORM_EPS) * p.gnw[lane] * siluf_(z));
    }
}

__device__ __forceinline__ void ph_ln(const Fr& F, const float* Xp, const float* Xs, const float* Fm, const float* gam, const float* bet, float* outp, float* outs, bf16* ob) {
    const int lane = F.lane;
    for (int r = F.gw; r < TS; r += F.NGW) {
        const float4* xr = (const float4*)((r < T) ? Xp + (size_t)r * DM : Xs + (size_t)(r - T) * DM) + lane; const float4* fr = (const float4*)(Fm + (size_t)r * DM) + lane;
        f32x4 v[4]; float s = 0.f;
#pragma unroll
        for (int j = 0; j < 4; ++j) { const float4 x = xr[64 * j], f = fr[64 * j]; v[j] = (f32x4){DN_ALPHA * x.x + f.x, DN_ALPHA * x.y + f.y, DN_ALPHA * x.z + f.z, DN_ALPHA * x.w + f.w}; s += (v[j][0] + v[j][1]) + (v[j][2] + v[j][3]); }
        const float mean = wave_sum(s) * (1.f / DM); float q = 0.f;
#pragma unroll
        for (int j = 0; j < 4; ++j) { v[j] = v[j] - mean; q += (v[j][0] * v[j][0] + v[j][1] * v[j][1]) + (v[j][2] * v[j][2] + v[j][3] * v[j][3]); }
        const float rstd = rsqrtf(wave_sum(q) * (1.f / DM) + LN_EPS);
        float4* o = (float4*)((r < T) ? outp + (size_t)r * DM : outs + (size_t)(r - T) * DM) + lane;
#pragma unroll
        for (int j = 0; j < 4; ++j) { const float4 g4 = ((const float4*)gam)[lane + 64 * j], b4 = ((const float4*)bet)[lane + 64 * j];
            const float4 y = make_float4(v[j][0] * rstd * g4.x + b4.x, v[j][1] * rstd * g4.y + b4.y, v[j][2] * rstd * g4.z + b4.z, v[j][3] * rstd * g4.w + b4.w);
            o[64 * j] = y; if (ob) { uint2 w; w.x = pk2(y.x, y.y); w.y = pk2(y.z, y.w); *((uint2*)(ob + (size_t)r * DM) + lane + 64 * j) = w; } }
    }
}

__device__ __forceinline__ void ph_ffn_act(const KP& p, const Fr& F, int layer) {
    const float* U = p.BIGF; const float* cw = p.ffn_cw + (size_t)layer * 3 * DFF2; const float* cb = p.ffn_cb + (size_t)layer * DFF2;
    const size_t gt = (size_t)F.bid * NTHR + F.tid, GT = (size_t)F.G * NTHR;
    const size_t total = (size_t)TS * DFF;
    for (size_t idx = gt; idx < total; idx += GT) {
        const int r = (int)(idx / DFF), j = (int)(idx % DFF);
        const bool smp = r >= T; const int b = r - T;
        float c2[2];
#pragma unroll
        for (int half = 0; half < 2; ++half) {
            const int ch = half * DFF + j;
            float acc = cb[ch];
#pragma unroll
            for (int k = 0; k < 3; ++k) {
                float u;
                if (!smp) { const int t = r + k - 2; u = (t >= 0) ? U[(size_t)t * DFF2 + ch] : 0.f; }
                else u = (k < 2) ? p.st_ffn[(((size_t)b * 2 + layer) * 2 + k) * DFF2 + ch] : U[(size_t)r * DFF2 + ch];
                acc += cw[k * DFF2 + ch] * u;
            }
            c2[half] = acc;
        }
        p.HFFB[idx] = (bf16)f2bf(siluf_(c2[0]) * c2[1]);
    }
    for (size_t idx = gt; idx < (size_t)2 * DFF2; idx += GT) {
        const int k = (int)(idx / DFF2), ch = (int)(idx % DFF2);
        p.out[O_FFN_P + ((size_t)layer * 2 + k) * DFF2 + ch] = U[(size_t)(T - 2 + k) * DFF2 + ch];
    }
    for (size_t idx = gt; idx < (size_t)NSMP * 2 * DFF2; idx += GT) {
        const int b = (int)(idx / (2 * DFF2)), k = (int)((idx / DFF2) % 2), ch = (int)(idx % DFF2);
        p.out[O_FFN_S + (((size_t)b * 2 + layer) * 2 + k) * DFF2 + ch] =
            (k == 0) ? p.st_ffn[(((size_t)b * 2 + layer) * 2 + 1) * DFF2 + ch] : U[(size_t)(T + b) * DFF2 + ch];
    }
}

__device__ __forceinline__ void ph_dil_prep(const KP& p, const Fr& F) {
    const float* H1 = p.BIGF;
    const size_t gt = (size_t)F.bid * NTHR + F.tid, GT = (size_t)F.G * NTHR;
    const size_t total = (size_t)TS * 2048;
    for (size_t idx = gt + (size_t)T * 2048; idx < total; idx += GT) {
        const int r = (int)(idx >> 11), c = (int)(idx & 2047);
        const bool smp = r >= T; const int pos = smp ? T : r;
        const float* row = H1 + (size_t)r * 3072;
        const int i = c & 63; const float2 cs = p.ROPE[pos * 32 + (i & 31)];
        const float v = rope_val(row, c & ~63, i, cs);
        if (c < 1024) p.QD[(size_t)r * 1024 + c] = v; else p.KD[(size_t)r * 1024 + (c - 1024)] = v;
    }
}
__device__ __forceinline__ void ph_dil_cache(const KP& p, const Fr& F) {
    const float* H1 = p.BIGF;
    const size_t gt = (size_t)F.bid * NTHR + F.tid, GT = (size_t)F.G * NTHR;
    const size_t tots4 = (size_t)NSMP * 2048 * 512;
    for (size_t idx = gt; idx < tots4; idx += GT) {
        const int b = (int)(idx / (2048 * 512)); const int i = (int)((idx / 512) % 2048); const int c4 = (int)(idx % 512);
        float4 v;
        if (i < 2047) v = ((const float4*)p.st_dil)[((size_t)b * 2048 + i + 1) * 512 + c4];
        else { const int c = c4 * 4; const int r = T + b;
               v = (c < 1024) ? *(const float4*)(p.KD + (size_t)r * 1024 + c) : *(const float4*)(H1 + (size_t)r * 3072 + 2048 + (c - 1024)); }
        ((float4*)(p.out + O_DIL_S))[idx] = v;
    }
}
__device__ __forceinline__ void ph_dil_attn(const KP& p, const Fr& F) {
    const float* H1 = p.BIGF; const int lane = F.lane;
    float* qs = (float*)(F.lds + F.wave * 4096); float* sc = qs + 64;
    float* ex = (float*)(F.lds + 32768);
    const int il = F.wave / 3, gi = F.wave - 3 * il;
    const int item = F.bid * 2 + il; const int b = item >> 4, h = item & 15, r = T + b;
    if (F.wave < 6 && item < NSMP * 16) {
        qs[lane] = p.QD[(size_t)r * 1024 + h * 64 + lane];
        wave_lds_sync();
        const int dd = gi == 0 ? 1 : (gi == 1 ? 4 : 16);
        auto kf = [&](int j, const float*& kp, const float*& vp) -> bool {
            const int pos = T - j * dd;
            if (pos == T) { kp = p.KD + (size_t)r * 1024 + h * 64; vp = H1 + (size_t)r * 3072 + 2048 + h * 64; return true; }
            const float* base = p.st_dil + ((size_t)b * 2048 + (pos - (T - 2048))) * 2048;
            kp = base + h * 64; vp = base + 1024 + h * 64; return true; };
        float o[1], den[1], mx[1];
        wave_attend<1>(qs, sc, 448, 129, kf, o, den, lane, mx);
        float* e = ex + (il * 3 + gi) * 68;
        e[lane] = o[0] * den[0]; if (lane == 0) { e[64] = mx[0]; e[65] = den[0]; }
    }
    __syncthreads();
    if (F.wave < 6 && gi == 0 && item < NSMP * 16) {
        const float* e = ex + il * 3 * 68;
        const float m0 = e[64], m1 = e[68 + 64], m2 = e[136 + 64]; const float M = fmaxf(m0, fmaxf(m1, m2));
        const float w0 = expf(m0 - M), w1 = expf(m1 - M), w2 = expf(m2 - M);
        const float num = w0 * e[lane] + w1 * e[68 + lane] + w2 * e[136 + lane], dn = w0 * e[65] + w1 * e[68 + 65] + w2 * e[136 + 65];
        p.MIXB[(size_t)r * 1024 + h * 64 + lane] = (bf16)f2bf(num / dn);
    }
}

__device__ __forceinline__ void ph_dil_prep_fast(const KP& p, const Fr& F) {
    const float* H1 = p.BIGF;
    const size_t gt = (size_t)F.bid * NTHR + F.tid, GT = (size_t)F.G * NTHR;
    for (size_t idx = gt; idx < (size_t)T * 128; idx += GT) {
        const int t = (int)(idx >> 7), u = (int)(idx & 127);
        const int hq = u >> 2, d0 = (u & 3) * 8, c0 = hq * 64 + d0; const bf16* row = p.H1B + (size_t)t * 3072;
        const v4u ua = *(const v4u*)(row + c0), ub = *(const v4u*)(row + c0 + 32);
        const float4* rp = (const float4*)(p.ROPE + t * 32 + d0); const float4 r0 = rp[0], r1 = rp[1], r2 = rp[2], r3 = rp[3];
        float x1[8], x2[8];
#pragma unroll
        for (int e = 0; e < 4; ++e) { x1[2 * e] = __uint_as_float(ua[e] << 16); x1[2 * e + 1] = __uint_as_float(ua[e] & 0xffff0000u); x2[2 * e] = __uint_as_float(ub[e] << 16); x2[2 * e + 1] = __uint_as_float(ub[e] & 0xffff0000u); }
        const float cs[8] = {r0.x, r0.z, r1.x, r1.z, r2.x, r2.z, r3.x, r3.z}, sn[8] = {r0.y, r0.w, r1.y, r1.w, r2.y, r2.w, r3.y, r3.w};
        float lo[8], hi[8];
#pragma unroll
        for (int j = 0; j < 8; ++j) { lo[j] = x1[j] * cs[j] - x2[j] * sn[j]; hi[j] = x2[j] * cs[j] + x1[j] * sn[j]; }
        if (hq < 16) {
            v4u o; o.x = pk2(lo[0] * QSCALE, lo[1] * QSCALE); o.y = pk2(lo[2] * QSCALE, lo[3] * QSCALE); o.z = pk2(lo[4] * QSCALE, lo[5] * QSCALE); o.w = pk2(lo[6] * QSCALE, lo[7] * QSCALE);
            *(v4u*)(p.QDB + (size_t)t * 1024 + c0) = o;
            o.x = pk2(hi[0] * QSCALE, hi[1] * QSCALE); o.y = pk2(hi[2] * QSCALE, hi[3] * QSCALE); o.z = pk2(hi[4] * QSCALE, hi[5] * QSCALE); o.w = pk2(hi[6] * QSCALE, hi[7] * QSCALE);
            *(v4u*)(p.QDB + (size_t)t * 1024 + c0 + 32) = o;
        } else {
            const int h = hq - 16, kc = h * 64 + d0;
            v4u ol, oh; ol.x = pk2(lo[0], lo[1]); ol.y = pk2(lo[2], lo[3]); ol.z = pk2(lo[4], lo[5]); ol.w = pk2(lo[6], lo[7]);
            oh.x = pk2(hi[0], hi[1]); oh.y = pk2(hi[2], hi[3]); oh.z = pk2(hi[4], hi[5]); oh.w = pk2(hi[6], hi[7]);
#pragma unroll
            for (int pass = 0; pass < 3; ++pass) { const int sh = 2 * pass; const int pi = (t & ((1 << sh) - 1)) * (T >> sh) + (t >> sh);
                bf16* kb = (pass == 0 ? p.DKF[0] : pass == 1 ? p.DKF[1] : p.DKF[2]) + (size_t)h * T * 64;
                *(v4u*)(kb + kfrag_elem(pi, d0)) = ol; *(v4u*)(kb + kfrag_elem(pi, d0 + 32)) = oh; }
            if (t >= T - 2048) { float* op = p.out + O_DIL_P + (size_t)(t - (T - 2048)) * 2048 + kc;
                *(float4*)op = make_float4(lo[0], lo[1], lo[2], lo[3]); *(float4*)(op + 4) = make_float4(lo[4], lo[5], lo[6], lo[7]);
                *(float4*)(op + 32) = make_float4(hi[0], hi[1], hi[2], hi[3]); *(float4*)(op + 36) = make_float4(hi[4], hi[5], hi[6], hi[7]); }
        }
    }
    for (size_t idx = gt; idx < (size_t)2048 * 256; idx += GT) {
        const int i = (int)(idx >> 8), c4 = (int)(idx & 255);
        const uint2 uv = *(const uint2*)(p.H1B + (size_t)(T - 2048 + i) * 3072 + 2048 + c4 * 4);
        *(float4*)(p.out + O_DIL_P + (size_t)i * 2048 + 1024 + c4 * 4) = make_float4(__uint_as_float(uv.x << 16), __uint_as_float(uv.x & 0xffff0000u), __uint_as_float(uv.y << 16), __uint_as_float(uv.y & 0xffff0000u));
    }
    const int lane = F.lane, l15 = lane & 15, grp = lane >> 4;
    for (int unit = F.gw; unit < 3 * 16 * 512; unit += F.NGW) {
        const int st = unit & 511, h = (unit >> 9) & 15, pass = unit >> 13; const int sh = 2 * pass, Td = T >> sh;
        const int pi0 = 32 * st, r = pi0 / Td, s0 = pi0 - r * Td;
        bf16* dst = p.DVF[pass] + (size_t)h * T * 64;
#pragma unroll
        for (int dt = 0; dt < 4; ++dt) {
            unsigned v[8];
#pragma unroll
            for (int j = 0; j < 8; ++j) { const int s = s0 + 16 * (j >> 2) + 4 * grp + (j & 3); const int t = (s << sh) + r;
                v[j] = p.H1B[(size_t)t * 3072 + 2048 + h * 64 + 16 * dt + l15]; }
            v4u o; o.x = v[0] | (v[1] << 16); o.y = v[2] | (v[3] << 16); o.z = v[4] | (v[5] << 16); o.w = v[6] | (v[7] << 16);
            *(v4u*)(dst + vfrag_off(st, dt, lane)) = o;
        }
    }
}

__device__ __forceinline__ void dil_pass(const KP& p, int unit, int pass, unsigned char* ldsb, int w4, int lane) {
    asm volatile("" : "+v"(lane));
    const int h = unit & 15, P0 = (unit >> 4) * 256;
    const int l15 = lane & 15, grp = lane >> 4;
    float* stO = (float*)ldsb; float* stML = stO + 256 * 64;
    {
        const int sh = 2 * pass, Td = T >> sh;
        const bf16* KF = (pass == 0 ? p.DKF[0] : pass == 1 ? p.DKF[1] : p.DKF[2]) + (size_t)h * T * 64;
        const bf16* VF = (pass == 0 ? p.DVF[0] : pass == 1 ? p.DVF[1] : p.DVF[2]) + (size_t)h * T * 64;
        for (int tt = 0; tt < 4; ++tt) {
            const int tl = 4 * w4 + tt;
            const int r = tl >> (4 - sh), s0 = (P0 >> sh) + 16 * (tl & ((16 >> sh) - 1));
            const int sq = s0 + l15, tq = (sq << sh) + r, tloc = tq - P0;
            bf16x8 qf[2];
#pragma unroll
            for (int ks = 0; ks < 2; ++ks) qf[ks] = *(const bf16x8*)(p.QDB + (size_t)tq * 1024 + h * 64 + 32 * ks + 8 * grp);
            AttW a;
            if (pass == 0) attw_init(a);
            else {
#pragma unroll
                for (int dt = 0; dt < 4; ++dt) a.o[dt] = *(const f32x4*)(stO + tloc * 64 + 16 * dt + 4 * grp);
                a.m = stML[tloc * 2]; a.l = (grp == 0) ? stML[tloc * 2 + 1] : 0.f;
            }
            int kstart = s0 - 128; if (kstart < 0) kstart = 0; kstart &= ~31;
            const int nsteps = (s0 + 16 - kstart + 31) >> 5;
            const int base = r * Td;
            bf16x8 kf[3][2][2], vf[3][4];
            auto issue = [&](int s, int buf) {
                const int k0 = kstart + 32 * s;
#pragma unroll
                for (int tl2 = 0; tl2 < 2; ++tl2)
#pragma unroll
                    for (int ks = 0; ks < 2; ++ks) kf[buf][tl2][ks] = *(const bf16x8*)(KF + kfrag_off(((base + k0) >> 4) + tl2, ks, lane));
#pragma unroll
                for (int dt = 0; dt < 4; ++dt) vf[buf][dt] = *(const bf16x8*)(VF + vfrag_off((base + k0) >> 5, dt, lane));
            };
            issue(0, 0); if (nsteps > 1) issue(1, 1);
#pragma unroll
            for (int s = 0; s < 5; ++s) {
                if (s < nsteps) {
                    if (s + 2 < nsteps) issue(s + 2, (s + 2) % 3);
                    const int k0 = kstart + 32 * s;
                    f32x4 s0v, s1v; qk_step(kf[s % 3], qf, s0v, s1v);
                    if ((k0 + 31 > s0) || (k0 < s0 + 15 - 128)) {
                        const int pb = k0 + 4 * grp;
#pragma unroll
                        for (int i = 0; i < 4; ++i) { const int p0 = pb + i, p1 = pb + 16 + i;
                            if (p0 > sq || p0 < sq - 128) s0v[i] = -INFINITY; if (p1 > sq || p1 < sq - 128) s1v[i] = -INFINITY; }
                    }
                    att_update(a, s0v, s1v, vf[s % 3]);
                }
            }
            const float lt = grp_sum(a.l);
            if (pass < 2) {
#pragma unroll
                for (int dt = 0; dt < 4; ++dt) *(f32x4*)(stO + tloc * 64 + 16 * dt + 4 * grp) = a.o[dt];
                if (grp == 0) { stML[tloc * 2] = a.m; stML[tloc * 2 + 1] = lt; }
            } else {
                const float il = lt > 0.f ? 1.f / lt : 0.f;
#pragma unroll
                for (int dt = 0; dt < 4; ++dt) { uint2 o; o.x = pk2(a.o[dt][0] * il, a.o[dt][1] * il); o.y = pk2(a.o[dt][2] * il, a.o[dt][3] * il);
                    *(uint2*)(p.MIXB + (size_t)tq * 1024 + h * 64 + 16 * dt + 4 * grp) = o; }
            }
        }
    }
}
__device__ __forceinline__ void ph_dil_combo(const KP& p, const Fr& F) {
    const float* H1 = p.BIGF; const int lane = F.lane;
    const int cw = F.bid * 4 + F.wave;
#pragma unroll 1
    for (int u = 0; u < 4; ++u) {
#pragma unroll
        for (int pass = 0; pass < 3; ++pass) {
            if (F.wave >= 4) dil_pass(p, F.bid + u * F.G, pass, F.lds, F.wave - 4, lane);
            else {
                const int ci = u * 3 + pass;
                const int g0 = ci * 2 + (ci < 8 ? ci : 8), g1 = g0 + 2 + (ci < 8 ? 1 : 0);
                auto srcp = [&](int itn) -> const float4* {
                    const size_t idx = ((size_t)itn * 1024 + cw) * 64 + lane;
                    const int b = (int)(idx >> 20), i = (int)((idx >> 9) & 2047), c4 = (int)(idx & 511);
                    const int c = c4 * 4, r = T + b;
                    const float4* s_old = ((const float4*)p.st_dil) + ((size_t)b * 2048 + (i < 2047 ? i + 1 : 2047)) * 512 + c4;
                    const float4* s_new = (c < 1024) ? (const float4*)(p.KD + (size_t)r * 1024 + c) : (const float4*)(H1 + (size_t)r * 3072 + 2048 + (c - 1024));
                    return (i == 2047) ? s_new : s_old; };
                float4* dstp = (float4*)(p.out + O_DIL_S) + (size_t)cw * 64 + lane;
#pragma unroll 1
                for (int gi = g0; gi < g1; ++gi) {
                    const int i0 = gi * 16;
                    const float4 v0 = *srcp(i0), v1 = *srcp(i0 + 1), v2 = *srcp(i0 + 2), v3 = *srcp(i0 + 3), v4 = *srcp(i0 + 4), v5 = *srcp(i0 + 5), v6 = *srcp(i0 + 6), v7 = *srcp(i0 + 7);
                    const float4 v8 = *srcp(i0 + 8), v9 = *srcp(i0 + 9), v10 = *srcp(i0 + 10), v11 = *srcp(i0 + 11), v12 = *srcp(i0 + 12), v13 = *srcp(i0 + 13), v14 = *srcp(i0 + 14), v15 = *srcp(i0 + 15);
                    float4* d = dstp + (size_t)i0 * 65536;
                    d[0] = v0; d[65536] = v1; d[2 * 65536] = v2; d[3 * 65536] = v3; d[4 * 65536] = v4; d[5 * 65536] = v5; d[6 * 65536] = v6; d[7 * 65536] = v7;
                    d[8 * 65536] = v8; d[9 * 65536] = v9; d[10 * 65536] = v10; d[11 * 65536] = v11; d[12 * 65536] = v12; d[13 * 65536] = v13; d[14 * 65536] = v14; d[15 * 65536] = v15;
                }
            }
            __syncthreads();
        }
    }
}

constexpr int NPHASE = 22;
__global__ void __launch_bounds__(NTHR, 2) mega(KP p) {
    extern __shared__ __attribute__((aligned(16))) unsigned char lds[];
    Fr F; F.lds = lds; F.tid = threadIdx.x; F.lane = 0; F.wave = __builtin_amdgcn_readfirstlane(F.tid >> 6);
    F.bid = blockIdx.x; F.G = gridDim.x; F.gw = F.bid * NWAVES + F.wave; F.NGW = F.G * NWAVES;
    for (int u = F.tid; u < (LDS_BYTES - RING_BYTES) / 4; u += NTHR) ((unsigned*)(lds + RING_BYTES))[u] = 0u;
    __syncthreads();
    XcdBarrier bar; bar.bar = p.ctl + 4096; bar.x = 0; bar.st = nullptr;
    if (!MK_PER_PHASE) bar = xcd_barrier_post(p.ctl + 4096, (volatile LAS unsigned*)(lds + MISC_OFF + 32));
    const int lo = p.ph_lo, hi = p.ph_hi;
#define IN(k) (lo <= (k) && (k) < hi)

    int ph = 0;
#if PROBE_ON
#define PROBE_STAMP(k) do { if (blockIdx.x == 0 && threadIdx.x == 0) ((unsigned long long*)(p.ctl + 65536))[k] = __builtin_amdgcn_s_memrealtime(); } while (0)
#define PROBE_STAMPB(k, blk) do { if (blockIdx.x == (blk) && threadIdx.x == 0) ((unsigned long long*)(p.ctl + 65536))[k] = __builtin_amdgcn_s_memrealtime(); } while (0)
    PROBE_STAMP(0);
#else
#define PROBE_STAMP(k) do { } while (0)
#define PROBE_STAMPB(k, blk) do { } while (0)
#endif
#define PHASE(...) do { { unsigned t_ = threadIdx.x; asm volatile("" : "+v"(t_)); F.lane = (int)(t_ & 63u); } if (IN(ph)) { __VA_ARGS__ } if (IN(ph) && IN(ph + 1)) xcd_barrier(bar); ++ph; PROBE_STAMP(ph); } while (0)
    PHASE(ph_prologue(p, F););
    PHASE(ph_gemm_f32(F, p.ACTB, p.WT_A, PAP, DM, p.BIGF, PA, PA); ph_cmp_samples(p, F););
    PHASE(ph_nsa_prep(p, F); ph_nsa_prep_fast(p, F); ph_gdn_prep(p, F););
    PHASE(ph_gdn_chunks(p, F););
    PHASE(ph_mix_a(p, F););
    PHASE(ph_mix_b(p, F););
    PHASE(ph_gdn_out(p, F););
    PHASE(ph_gemm_bf16(F, p.MIXB, p.WT_OA, DM, p.MOB););
    PHASE(ph_ln_b(F, p.ACTB, p.MOB, p.ln_mix_g, p.ln_mix_b, nullptr, nullptr););
    PHASE(ph_ffn_gemm(p, F, p.WT_FI0, 0););
    PHASE(ph_ffn_fix(p, F, 0););
    PHASE(ph_gemm_bf16(F, p.HFFB, p.WT_FO0, DFF, p.MOB););
    PHASE(ph_ln_b(F, p.ACTB, p.MOB, p.ln_ffn_g, p.ln_ffn_b, nullptr, nullptr););
    PHASE(ph_gemm_h1(p, F););
    PHASE(ph_dil_prep(p, F); ph_dil_prep_fast(p, F););
    PHASE(ph_dil_attn(p, F); __syncthreads(); ph_dil_combo(p, F););
    PHASE(ph_gemm_bf16(F, p.MIXB, p.WT_CO, DM, p.MOB););
    PHASE(ph_ln_b(F, p.ACTB, p.MOB, p.ln_mix_g + DM, p.ln_mix_b + DM, nullptr, nullptr););
    PHASE(ph_ffn_gemm(p, F, p.WT_FI1, 1););
    PHASE(ph_ffn_fix(p, F, 1););
    PHASE(ph_gemm_bf16(F, p.HFFB, p.WT_FO1, DFF, p.MOB););
    PHASE(ph_ln_b(F, p.ACTB, p.MOB, p.ln_ffn_g + DM, p.ln_ffn_b + DM, p.out + O_Y_P, p.out + O_Y_S););
#undef PHASE
#if PROBE_ON
    xcd_barrier(bar);
    if (blockIdx.x == 0) { __syncthreads(); const unsigned long long* pts = (const unsigned long long*)(p.ctl + 65536); const float x = (float)(pts[PROBE_B] - pts[PROBE_A]) * 1e-5f;
        for (int i = threadIdx.x; i < NSMP * DM; i += NTHR) p.out[O_Y_S + i] *= (1.f + x); }
#endif
#undef IN
}

static inline size_t align_up(size_t x) { return (x + 255) & ~(size_t)255; }

extern "C" void kernel_launch(void* const* d_in, const int* in_sizes, int n_in, void* d_out, int out_size, void* d_ws, size_t ws_size, hipStream_t stream) {
    static int grid = 0;
    if (grid == 0) {
        int dev = 0, cus = 0, per_cu = 0;
        if (hipGetDevice(&dev) != hipSuccess || hipDeviceGetAttribute(&cus, hipDeviceAttributeMultiprocessorCount, dev) != hipSuccess) { fprintf(stderr, "kernel_launch: device query failed\n"); grid = -1; return; }
        if (hipFuncSetAttribute((const void*)mega, hipFuncAttributeMaxDynamicSharedMemorySize, LDS_BYTES) != hipSuccess) { fprintf(stderr, "kernel_launch: hipFuncSetAttribute failed\n"); grid = -1; return; }
        if (hipOccupancyMaxActiveBlocksPerMultiprocessor(&per_cu, (const void*)mega, NTHR, LDS_BYTES) != hipSuccess || per_cu < 1) { fprintf(stderr, "kernel_launch: occupancy query says %d blocks per CU\n", per_cu); }
        (void)hipGetLastError();
        grid = cus;
    }
    if (grid < 0) return;
    if ((size_t)out_size != O_END) fprintf(stderr, "kernel_launch: out_size %d != expected %zu\n", out_size, (size_t)O_END);
    KP p{};
    p.x_prompt = (const float*)d_in[0]; p.x_sample = (const float*)d_in[1]; p.cache_cmp = (const float*)d_in[2]; p.cache_slc = (const float*)d_in[3];
    p.st_win = (const float*)d_in[4]; p.st_gconv = (const float*)d_in[5]; p.st_gS = (const float*)d_in[6]; p.st_dil = (const float*)d_in[7];
    p.st_ffn = (const float*)d_in[8]; p.page_table = (const int*)d_in[9]; p.w_in_a = (const float*)d_in[10]; p.cw1 = (const float*)d_in[11];
    p.cb1 = (const float*)d_in[12]; p.cw2 = (const float*)d_in[13]; p.cpe = (const float*)d_in[14]; p.gconv_w = (const float*)d_in[15];
    p.gA = (const float*)d_in[16]; p.gdt = (const float*)d_in[17]; p.gnw = (const float*)d_in[18]; p.w_out_a = (const float*)d_in[19];
    p.w_in_c = (const float*)d_in[20]; p.w_out_c = (const float*)d_in[21]; p.ln_mix_g = (const float*)d_in[22]; p.ln_mix_b = (const float*)d_in[23];
    p.ffn_w_in = (const float*)d_in[24]; p.ffn_cw = (const float*)d_in[25]; p.ffn_cb = (const float*)d_in[26]; p.ffn_w_out = (const float*)d_in[27];
    p.ln_ffn_g = (const float*)d_in[28]; p.ln_ffn_b = (const float*)d_in[29];
    p.out = (float*)d_out;
    char* ws = (char*)d_ws; size_t off = 0;
    auto alloc = [&](size_t bytes) { void* q = (void*)(ws + off); off = align_up(off + bytes); return q; };
    p.ctl = (unsigned*)alloc(1 << 20);
    p.WT_A = (bf16*)alloc((size_t)PAP * DM * 2); p.WT_OA = (bf16*)alloc((size_t)DM * DM * 2);
    p.WT_FI0 = (bf16*)alloc((size_t)DFF2 * DM * 2); p.WT_FI1 = (bf16*)alloc((size_t)DFF2 * DM * 2);
    p.WT_FO0 = (bf16*)alloc((size_t)DM * DFF * 2); p.WT_FO1 = (bf16*)alloc((size_t)DM * DFF * 2);
    p.WT_CI = (bf16*)alloc((size_t)3072 * DM * 2); p.WT_CO = (bf16*)alloc((size_t)DM * DM * 2);
    p.ROPE = (float2*)alloc((size_t)(T + 1) * 32 * 8);
    p.ACTB = (bf16*)alloc((size_t)TSP * DM * 2); p.MIXB = (bf16*)alloc((size_t)TSP * DM * 2); p.HFFB = (bf16*)alloc((size_t)TSP * DFF * 2);
    p.KS8 = (unsigned char*)alloc((size_t)2 * T * 64); p.VS8 = (unsigned char*)alloc((size_t)2 * T * 64);
    p.QB = (bf16*)alloc((size_t)T * 512 * 2); p.KSF = (bf16*)alloc((size_t)2 * T * 64 * 2); p.VSF = (bf16*)alloc((size_t)2 * T * 64 * 2);
    p.KWF = (bf16*)alloc((size_t)2 * T * 64 * 2); p.VWF = (bf16*)alloc((size_t)2 * T * 64 * 2); p.CKF = (bf16*)alloc((size_t)2 * 512 * 64 * 2); p.CVF = (bf16*)alloc((size_t)2 * 512 * 64 * 2);
    p.ACP = (bf16*)alloc((size_t)2048 * 2048 * 2);
    p.W2T = (bf16*)alloc((size_t)2 * 64 * 128 * 2);
    p.AC = nullptr; p.WT_C = (bf16*)alloc((size_t)256 * 2048 * 2); p.HID = nullptr; p.SMIXF = (float*)alloc((size_t)NSMP * 3 * 512 * 4);
    p.UB = (float*)alloc((size_t)256 * 4 * DFF2 * 4);
    p.NSACC = (float*)alloc((size_t)T * 512 * 4); p.SEL = (int*)alloc((size_t)2 * T * 16 * 4);
    p.QDB = (bf16*)alloc((size_t)T * 1024 * 2);
    for (int i = 0; i < 3; ++i) { p.DKF[i] = (bf16*)alloc((size_t)T * 1024 * 2); p.DVF[i] = (bf16*)alloc((size_t)T * 1024 * 2); }
    p.G_WF = (bf16*)alloc((size_t)2048 * 4096 * 2); p.G_KDF = (bf16*)alloc((size_t)2048 * 4096 * 2); p.G_QGF = (bf16*)alloc((size_t)2048 * 4096 * 2); p.G_QKF = (bf16*)alloc((size_t)2048 * 4096 * 2);
    p.G_SPF = (bf16*)alloc((size_t)2048 * 4096 * 2); p.G_VNF = (bf16*)alloc((size_t)2048 * 4096 * 2); p.G_UF = (float*)alloc((size_t)2048 * 4096 * 4); p.G_GL = (float*)alloc((size_t)2048 * 4);
    p.MOB = (bf16*)alloc((size_t)TSP * DM * 2); p.H1B = (bf16*)alloc((size_t)T * 3072 * 2);
    p.BIGF = (float*)alloc((size_t)TSP * DFF2 * 4); p.MO = (float*)alloc((size_t)TSP * DM * 4);
    p.X1 = (float*)alloc((size_t)TS * DM * 4); p.X2 = (float*)alloc((size_t)TS * DM * 4); p.X3 = (float*)alloc((size_t)TS * DM * 4);
    p.QR = (float*)alloc((size_t)TS * 512 * 4);
    p.KS = (float*)alloc((size_t)TS * 128 * 4); p.VS = (float*)alloc((size_t)TS * 128 * 4); p.KW = (float*)alloc((size_t)TS * 128 * 4); p.VW = (float*)alloc((size_t)TS * 128 * 4);
    p.CK = (float*)alloc((size_t)33 * 512 * 128 * 4); p.CV = (float*)alloc((size_t)33 * 512 * 128 * 4);
    p.GQ = (float*)alloc((size_t)TS * 512 * 4); p.GK = (float*)alloc((size_t)TS * 512 * 4); p.GV = (float*)alloc((size_t)TS * 512 * 4); p.OG = (float*)alloc((size_t)TS * 512 * 4);
    p.Gg = (float*)alloc((size_t)TS * 8 * 4); p.Gb = (float*)alloc((size_t)TS * 8 * 4);
    p.QD = (float*)alloc((size_t)TS * DM * 4); p.KD = (float*)alloc((size_t)TS * DM * 4);
    if (off > ws_size) { fprintf(stderr, "kernel_launch: workspace too small: need %zu have %zu\n", off, ws_size); return; }
    if (hipMemsetAsync(p.ctl, 0, 1 << 20, stream) != hipSuccess) { fprintf(stderr, "kernel_launch: memset failed\n"); return; }
#if MK_PER_PHASE
    for (int k = 0; k < NPHASE; ++k) { p.ph_lo = k; p.ph_hi = k + 1; hipLaunchKernelGGL(mega, dim3(grid), dim3(NTHR), LDS_BYTES, stream, p); }
#else
    p.ph_lo = 0; p.ph_hi = NPHASE;
    hipLaunchKernelGGL(mega, dim3(grid), dim3(NTHR), LDS_BYTES, stream, p);
#endif
    const hipError_t le = hipPeekAtLastError();
    if (le != hipSuccess) fprintf(stderr, "kernel_launch: launch failed: %s\n", hipGetErrorName(le));
}
```

```cpp
#include <hip/hip_runtime.h>
#include <cstdint>
#include <cstdio>
#include <cmath>

namespace pg8 {
#define PG8_LAS __attribute__((address_space(3)))
typedef unsigned short bf16_t;
typedef short bf16x8 __attribute__((ext_vector_type(8)));
typedef float f32x4 __attribute__((ext_vector_type(4)));
typedef unsigned u32x4 __attribute__((ext_vector_type(4)));
constexpr int BM = 256, BK = 64, HALF = 128, HTB = HALF * BK * 2  , STAGE_BYTES = 8 * HTB, NXCD = 8, WGM = 8;

__host__ __device__ __forceinline__ int lds_byte(int r, int c) { const int st = (r >> 4) * 2 + (c >> 5), rr = r & 15, cc = c & 31, ob = rr * 64 + cc * 2; return st * 1024 + (ob ^ (((ob >> 9) & 1) << 5)); }
__host__ __device__ __forceinline__ void stage_rc(int b, int& R, int& C) { const int st = b / 1024, sb = b % 1024, swz = sb ^ (((sb >> 9) & 1) << 5); R = (st >> 1) * 16 + swz / 64; C = (st & 1) * 32 + (swz % 64) / 2; }
__host__ __device__ __forceinline__ int perm32(int rho) { const int n = rho >> 4, i = rho & 15; return 8 * (i >> 2) + 4 * n + (i & 3); }

struct Unit { int pm, pn; };
struct Gemm { const bf16_t* A; const bf16_t* Bt; int M, N, K; };

struct StaticOrder {
    int nM, nN, nwg, G, c;
    __host__ __device__ void init(int M, int N, int G_, int c_) { nM = M / BM; nN = N / BM; nwg = nM * nN; G = G_; c = c_; }
    __host__ __device__ bool next(int i, Unit& u) const {
        const long L = (long)i * G + c; if (L >= nwg) return false;
        int wgid = (int)L; { const int q = nwg / NXCD, r = nwg % NXCD, xcd = wgid % NXCD, off = wgid / NXCD; wgid = (xcd < r ? xcd * (q + 1) : r * (q + 1) + (xcd - r) * q) + off; }
        const int nig = WGM * nN, gid = wgid / nig, fm = gid * WGM, gsz = (nM - fm) < WGM ? (nM - fm) : WGM;
        u.pm = fm + ((wgid % nig) % gsz); u.pn = (wgid % nig) / gsz; return true;
    }
    __device__ __forceinline__ void a_ready(const Unit&) const {}
    __device__ __forceinline__ void done(const Unit&) const {}
};

typedef __bf16 bf16x2_t __attribute__((ext_vector_type(2)));
typedef float f32x2_t __attribute__((ext_vector_type(2)));
__device__ __forceinline__ unsigned cvt_pk_bf16(float lo, float hi) { const f32x2_t v = {lo, hi}; return __builtin_bit_cast(unsigned, __builtin_convertvector(v, bf16x2_t)); }
typedef float f32x2 __attribute__((ext_vector_type(2)));
__device__ __forceinline__ f32x2 gelu_pk(f32x2 v) {
    const f32x2 av = __builtin_elementwise_abs(v), d = av * 0.2316418882f + 1.0f;
    f32x2 t; t.x = __builtin_amdgcn_rcpf(d.x); t.y = __builtin_amdgcn_rcpf(d.y);
    f32x2 q = t * 0.5307027145f + (-0.7265760135f); q = q * t + 0.7107068705f; q = q * t + (-0.142248368f); q = q * t + 0.127414796f; q = q * t;
    const f32x2 s = (v * v) * (-0.72134752044f);
    f32x2 e; e.x = __builtin_amdgcn_exp2f(s.x); e.y = __builtin_amdgcn_exp2f(s.y);
    const f32x2 m = v * (q * e), r = v - m;
    f32x2 o; o.x = v.x < 0.f ? m.x : r.x; o.y = v.y < 0.f ? m.y : r.y; return o;
}

template <int ACT  > struct EpiBf16 {
    static constexpr bool PERM = true, AFTER_DRAIN = false; static_assert(ACT == 0 || ACT == 1, "EpiBf16: ACT is 0 (none) or 1 (gelu_pk)");
    bf16_t* O; int ldc; const float* bias; int split_cols; size_t split_stride; float scale0;
    __device__ __forceinline__ void operator()(const f32x4 (&acc)[2][2][4][2], const Unit& u, int wr, int wc, int fr, int fq) const {
        const int row0 = u.pm * BM + wr * 64 + fr; int colt = u.pn * BM; bf16_t* base = O;
        float sc = 1.f; if (split_cols) { const int t = colt / split_cols; base += (size_t)t * split_stride; colt -= t * split_cols; if (t == 0) sc = scale0; }
        const int col0 = colt + wc * 32 + 8 * fq, bcol0 = u.pn * BM + wc * 32 + 8 * fq;
        f32x4 bv[2][2];
#pragma unroll
        for (int bj = 0; bj < 2; ++bj)
#pragma unroll
            for (int n = 0; n < 2; ++n) bv[bj][n] = bias ? *(const f32x4*)(bias + bcol0 + bj * HALF + 4 * n) : (f32x4){0.f, 0.f, 0.f, 0.f};
#pragma unroll
        for (int ai = 0; ai < 2; ++ai)
#pragma unroll
            for (int m = 0; m < 4; ++m) { bf16_t* rowp = base + (size_t)(row0 + ai * HALF + m * 16) * ldc + col0;
#pragma unroll
                for (int bj = 0; bj < 2; ++bj) { f32x4 v0 = acc[ai][bj][m][0] + bv[bj][0], v1 = acc[ai][bj][m][1] + bv[bj][1];
                    if (ACT == 1) { f32x2 a = gelu_pk((f32x2){v0[0], v0[1]}), b = gelu_pk((f32x2){v0[2], v0[3]}), c = gelu_pk((f32x2){v1[0], v1[1]}), d = gelu_pk((f32x2){v1[2], v1[3]});
                        v0 = (f32x4){a.x, a.y, b.x, b.y}; v1 = (f32x4){c.x, c.y, d.x, d.y}; }
                    v0 = v0 * sc; v1 = v1 * sc; u32x4 w; w.x = cvt_pk_bf16(v0[0], v0[1]); w.y = cvt_pk_bf16(v0[2], v0[3]); w.z = cvt_pk_bf16(v1[0], v1[1]); w.w = cvt_pk_bf16(v1[2], v1[3]);
                    *(u32x4*)(rowp + bj * HALF) = w; } }
    }
};

struct EpiF32 {
    static constexpr bool PERM = false, AFTER_DRAIN = false;
    float* O; int ldc; int ncols;
    __device__ __forceinline__ void operator()(const f32x4 (&acc)[2][2][4][2], const Unit& u, int wr, int wc, int fr, int fq) const {
        const int row0 = u.pm * BM + wr * 64 + fr; const int col0 = u.pn * BM + wc * 32 + 4 * fq;
#pragma unroll
        for (int ai = 0; ai < 2; ++ai)
#pragma unroll
            for (int m = 0; m < 4; ++m) { float* rowp = O + (size_t)(row0 + ai * HALF + m * 16) * ldc;
#pragma unroll
                for (int bj = 0; bj < 2; ++bj)
#pragma unroll
                    for (int n = 0; n < 2; ++n) { const int c = col0 + bj * HALF + n * 16; if (c < ncols) *(f32x4*)(rowp + c) = acc[ai][bj][m][n]; } }
    }
};
template <class Epi, class Sched, bool ALIGN_EPI = false, bool SP2 = false>
__device__ __forceinline__ void gemm_phase(PG8_LAS unsigned char* lds, const Gemm g, const Sched& S, const Epi& E) {
    const int tid = threadIdx.x, wid = __builtin_amdgcn_readfirstlane(tid >> 6), lane = tid & 63, wr = wid >> 2, wc = wid & 3, fr = lane & 15, fq = lane >> 4;
    const int K = g.K, nt = K / BK;
    unsigned voffA[2], voffB[2];
#pragma unroll
    for (int i = 0; i < 2; ++i) { int R, C; stage_rc(tid * 16 + i * 8192, R, C); const int Rb = Epi::PERM ? ((R & ~31) + perm32(R & 31)) : R;
        voffA[i] = (unsigned)(R * K + C) * 2u; voffB[i] = (unsigned)(Rb * K + C) * 2u; }
    const size_t kstep = (size_t)(BK * 2);
    const size_t hstep = (size_t)HALF * K * 2;
    const size_t tstep = 2 * hstep;
    const unsigned ldsw = (unsigned)wid * 1024u;
    const int aoff = lds_byte(wr * 64 + fr, fq * 8), boff = lds_byte(wc * 32 + fr, fq * 8);
#define PG8_SA(b, h) (((b) * 2 + (h)) * HTB)
#define PG8_SB(b, h) ((4 + (b) * 2 + (h)) * HTB)
#define PG8_STAGE(bufoff, gbase, voff) do { _Pragma("unroll") for (int _i = 0; _i < 2; ++_i) \
        __builtin_amdgcn_global_load_lds((const unsigned*)((const char*)(gbase) + (voff)[_i]), (PG8_LAS unsigned*)(lds + (bufoff) + ldsw + _i * 8192), 16, 0, 0); } while (0)
#define PG8_LDA(dst, b, h) do { _Pragma("unroll") for (int m = 0; m < 4; ++m) _Pragma("unroll") for (int k = 0; k < 2; ++k) dst[m][k] = *(const PG8_LAS bf16x8*)(lds + PG8_SA(b, h) + aoff + m * 2048 + k * 1024); } while (0)
#define PG8_LDB(dst, b, h) do { _Pragma("unroll") for (int n = 0; n < 2; ++n) _Pragma("unroll") for (int k = 0; k < 2; ++k) dst[n][k] = *(const PG8_LAS bf16x8*)(lds + PG8_SB(b, h) + boff + n * 2048 + k * 1024); } while (0)
#define PG8_MMA(ai, bj, At, Bt) do { __builtin_amdgcn_s_setprio(1); _Pragma("unroll") for (int m = 0; m < 4; ++m) _Pragma("unroll") for (int n = 0; n < 2; ++n) _Pragma("unroll") for (int k = 0; k < 2; ++k) \
        acc[ai][bj][m][n] = __builtin_amdgcn_mfma_f32_16x16x32_bf16(Bt[n][k], At[m][k], acc[ai][bj][m][n], 0, 0, 0); __builtin_amdgcn_s_setprio(0); } while (0)
#define PG8_WAIT_V(n) asm volatile("s_waitcnt vmcnt(" #n ")" ::: "memory")
#define PG8_WAIT_L(n) asm volatile("s_waitcnt lgkmcnt(" #n ")" ::: "memory")
#define PG8_BAR __builtin_amdgcn_s_barrier()
#define PG8_SCHED __builtin_amdgcn_sched_barrier(0)
    Unit cur, nxt; int ui = 0;
    if (!S.next(0, cur)) return;
    f32x4 acc[2][2][4][2];
#pragma unroll
    for (int a = 0; a < 2; ++a)
#pragma unroll
        for (int b = 0; b < 2; ++b)
#pragma unroll
            for (int m = 0; m < 4; ++m)
#pragma unroll
                for (int n = 0; n < 2; ++n) acc[a][b][m][n] = (f32x4){0.f, 0.f, 0.f, 0.f};
    bf16x8 At[4][2], B0[2][2], B1[2][2];
    const char* cA = (const char*)g.A + (size_t)cur.pm * tstep; const char* cB = (const char*)g.Bt + (size_t)cur.pn * tstep;
    S.a_ready(cur);
    if constexpr (SP2) {
        PG8_STAGE(PG8_SB(0, 0), cB, voffB); PG8_STAGE(PG8_SB(0, 1), cB + hstep, voffB); PG8_STAGE(PG8_SA(0, 0), cA, voffA); PG8_STAGE(PG8_SA(0, 1), cA + hstep, voffA);
        if (wr == 1) PG8_BAR;
        PG8_WAIT_V(2); PG8_BAR;
        PG8_STAGE(PG8_SB(1, 0), cB + kstep, voffB); PG8_STAGE(PG8_SA(1, 0), cA + kstep, voffA); PG8_STAGE(PG8_SB(1, 1), cB + hstep + kstep, voffB);
        PG8_WAIT_V(6); PG8_BAR;
    } else {
        PG8_STAGE(PG8_SB(0, 0), cB, voffB); PG8_STAGE(PG8_SA(0, 0), cA, voffA); PG8_STAGE(PG8_SB(0, 1), cB + hstep, voffB); PG8_STAGE(PG8_SA(0, 1), cA + hstep, voffA);
        if (wr == 1) PG8_BAR;
        PG8_WAIT_V(4); PG8_BAR;
        PG8_STAGE(PG8_SB(1, 0), cB + kstep, voffB); PG8_STAGE(PG8_SA(1, 0), cA + kstep, voffA); PG8_STAGE(PG8_SB(1, 1), cB + hstep + kstep, voffB);
        PG8_WAIT_V(6); PG8_BAR;
    }
    for (;;) {
        const bool has_next = S.next(ui + 1, nxt);
        const char* nA = has_next ? (const char*)g.A + (size_t)nxt.pm * tstep : cA; const char* nB = has_next ? (const char*)g.Bt + (size_t)nxt.pn * tstep : cB;
        for (int t = 0; t < nt; t += 2) {
            const bool last = (t == nt - 2);
            const char* a1 = cA + (size_t)(t + 1) * kstep;
            const char* a2 = last ? nA : cA + (size_t)(t + 2) * kstep; const char* b2 = last ? nB : cB + (size_t)(t + 2) * kstep;
            const char* a3 = a2 + kstep; const char* b3 = b2 + kstep;
            if (last && has_next) S.a_ready(nxt);
            if constexpr (SP2) {
            PG8_LDB(B0, 0, 0); PG8_LDB(B1, 0, 1); PG8_SCHED; PG8_LDA(At, 0, 0); PG8_STAGE(PG8_SA(1, 1), a1 + hstep, voffA);
            PG8_WAIT_V(8); PG8_WAIT_L(0); PG8_BAR; PG8_MMA(0, 0, At, B0); PG8_MMA(0, 1, At, B1); PG8_BAR; PG8_SCHED;
            PG8_LDA(At, 0, 1); PG8_STAGE(PG8_SB(0, 0), b2, voffB); PG8_STAGE(PG8_SB(0, 1), b2 + hstep, voffB); PG8_STAGE(PG8_SA(0, 0), a2, voffA);
            PG8_WAIT_V(8); PG8_WAIT_L(0); PG8_BAR; PG8_MMA(1, 0, At, B0); PG8_MMA(1, 1, At, B1); PG8_BAR; PG8_SCHED;
            PG8_LDB(B0, 1, 0); PG8_LDB(B1, 1, 1); PG8_SCHED; PG8_LDA(At, 1, 0); PG8_STAGE(PG8_SA(0, 1), a2 + hstep, voffA);
            PG8_WAIT_V(8); PG8_WAIT_L(0); PG8_BAR; PG8_MMA(0, 0, At, B0); PG8_MMA(0, 1, At, B1); PG8_BAR; PG8_SCHED;
            PG8_LDA(At, 1, 1); PG8_STAGE(PG8_SB(1, 0), b3, voffB); PG8_STAGE(PG8_SB(1, 1), b3 + hstep, voffB); PG8_STAGE(PG8_SA(1, 0), a3, voffA);
            PG8_WAIT_V(8); PG8_WAIT_L(0); PG8_BAR; PG8_MMA(1, 0, At, B0); PG8_MMA(1, 1, At, B1); PG8_BAR; PG8_SCHED;
            } else {
            PG8_LDB(B0, 0, 0); PG8_SCHED; PG8_LDA(At, 0, 0); PG8_STAGE(PG8_SA(1, 1), a1 + hstep, voffA);
            PG8_WAIT_L(8); PG8_BAR; PG8_WAIT_L(0); PG8_MMA(0, 0, At, B0); PG8_BAR; PG8_SCHED;
            PG8_LDB(B1, 0, 1); PG8_STAGE(PG8_SB(0, 0), b2, voffB);
            PG8_BAR; PG8_WAIT_L(0); PG8_MMA(0, 1, At, B1); PG8_BAR;
            PG8_LDA(At, 0, 1); PG8_STAGE(PG8_SA(0, 0), a2, voffA);
            PG8_BAR; PG8_WAIT_L(0); PG8_MMA(1, 0, At, B0); PG8_BAR; PG8_SCHED;
            PG8_STAGE(PG8_SB(0, 1), b2 + hstep, voffB);
            PG8_WAIT_V(6); PG8_BAR; PG8_MMA(1, 1, At, B1); PG8_BAR;
            PG8_LDB(B0, 1, 0); PG8_SCHED; PG8_LDA(At, 1, 0); PG8_STAGE(PG8_SA(0, 1), a2 + hstep, voffA);
            PG8_WAIT_L(8); PG8_BAR; PG8_WAIT_L(0); PG8_MMA(0, 0, At, B0); PG8_BAR; PG8_SCHED;
            PG8_LDB(B1, 1, 1); PG8_STAGE(PG8_SB(1, 0), b3, voffB);
            PG8_BAR; PG8_WAIT_L(0); PG8_MMA(0, 1, At, B1); PG8_BAR;
            PG8_LDA(At, 1, 1); PG8_STAGE(PG8_SA(1, 0), a3, voffA);
            PG8_BAR; PG8_WAIT_L(0); PG8_MMA(1, 0, At, B0); PG8_BAR; PG8_SCHED;
            PG8_STAGE(PG8_SB(1, 1), b3 + hstep, voffB);
            PG8_WAIT_V(6); PG8_BAR; PG8_MMA(1, 1, At, B1); PG8_BAR;
            }
        }
        if constexpr (ALIGN_EPI) { if (wr == 0) PG8_BAR; }
        if constexpr (!Epi::AFTER_DRAIN) { E(acc, cur, wr, wc, fr, fq); S.done(cur); }
        if (!has_next) break;
#pragma unroll
        for (int a = 0; a < 2; ++a)
#pragma unroll
            for (int b = 0; b < 2; ++b)
#pragma unroll
                for (int m = 0; m < 4; ++m)
#pragma unroll
                    for (int n = 0; n < 2; ++n) acc[a][b][m][n] = (f32x4){0.f, 0.f, 0.f, 0.f};
        cur = nxt; cA = nA; cB = nB; ++ui;
        if constexpr (ALIGN_EPI) { if (wr == 1) PG8_BAR; }
    }
    PG8_WAIT_V(0);
    if constexpr (!ALIGN_EPI) { if (wr == 0) PG8_BAR; }
    PG8_BAR;
    if constexpr (Epi::AFTER_DRAIN) { E.fused(acc, cur, wr, wc, fr, fq, lds, wid, lane); S.done(cur); }
#undef PG8_SA
#undef PG8_SB
#undef PG8_STAGE
#undef PG8_LDA
#undef PG8_LDB
#undef PG8_MMA
#undef PG8_WAIT_V
#undef PG8_WAIT_L
#undef PG8_BAR
#undef PG8_SCHED
}
}

#define LAS __attribute__((address_space(3)))
#define XB_TMO      128
#define XB_XCNT(j)  (256  + 64 * (j))
#define XB_XSUB(j)  (1280 + 64 * (j))
#define XB_XGEN(j)  (2304 + 64 * (j))
#define XB_TOP      3328
#define XB_TOPGEN   3392
#define XCD_BAR_WORDS 3456
#define XB_SPIN_CAP (1u << 26)

__device__ __forceinline__ unsigned xb_ld(unsigned* p)              { return __hip_atomic_load(p, __ATOMIC_RELAXED, __HIP_MEMORY_SCOPE_AGENT); }
__device__ __forceinline__ unsigned xb_add(unsigned* p, unsigned v) { return __hip_atomic_fetch_add(p, v, __ATOMIC_RELAXED, __HIP_MEMORY_SCOPE_AGENT); }
__device__ __forceinline__ unsigned xb_xcc_id() { return (unsigned)__builtin_amdgcn_s_getreg((3 << 11) | 20) & 0xFu; }
#define XB_SPIN(cond, bar) do { unsigned _sp = 0; while (cond) { __builtin_amdgcn_s_sleep(1); \
    if ((++_sp & 255u) == 0u) { if (xb_ld(&(bar)[XB_TMO])) break; if (_sp > XB_SPIN_CAP) { atomicAdd(&(bar)[XB_TMO], 1u); break; } } } } while (0)

struct XcdBarrier {
    unsigned* bar; unsigned x;
    volatile LAS unsigned* st;
};

__device__ __forceinline__ XcdBarrier xcd_barrier_post(unsigned* bar, volatile LAS unsigned* st) {
    XcdBarrier b; b.bar = bar; b.x = xb_xcc_id(); b.st = st;
    if (threadIdx.x == 0) (void)xb_add(&bar[XB_XCNT(b.x)], 1u);
    return b;
}
__device__ __forceinline__ void xcd_barrier_complete(unsigned* bar, unsigned x, unsigned& nloc, unsigned& nx) {
    const unsigned G = gridDim.x * gridDim.y * gridDim.z;
    unsigned sum, cnt, mine, sp = 0u;
    for (;;) {
        sum = 0u; cnt = 0u; mine = 0u;
#pragma unroll
        for (unsigned j = 0; j < 16; ++j) { const unsigned c = xb_ld(&bar[XB_XCNT(j)]); sum += c; cnt += (c > 0u) ? 1u : 0u; mine = (j == x) ? c : mine; }
        if (sum == G) break;
        __builtin_amdgcn_s_sleep(1);
        if ((++sp & 255u) == 0u) { if (xb_ld(&bar[XB_TMO])) break; if (sp > XB_SPIN_CAP) { atomicAdd(&bar[XB_TMO], 1u); break; } }
    }
    nloc = mine > 0u ? mine : 1u; nx = cnt > 0u ? cnt : 1u;
}

__device__ __forceinline__ void xcd_barrier(const XcdBarrier& b) {
    asm volatile("s_waitcnt vmcnt(0)" ::: "memory");
    __syncthreads();
    if (threadIdx.x == 0) {
        unsigned* bar = b.bar;
        __builtin_amdgcn_s_waitcnt(0);
        unsigned nloc = b.st[0], nx = b.st[1];
        if (nloc == 0u) { xcd_barrier_complete(bar, b.x, nloc, nx); b.st[0] = nloc; b.st[1] = nx; }
        const unsigned old = xb_add(&bar[XB_XSUB(b.x)], 1u);
        const unsigned gen = old / nloc;
        if (old + 1u == (gen + 1u) * nloc) {
            __builtin_amdgcn_fence(__ATOMIC_RELEASE, "agent");
            asm volatile("s_waitcnt vmcnt(0)" ::: "memory");
            const unsigned og = xb_add(&bar[XB_TOP], 1u);
            const unsigned tg = og / nx;
            if (og + 1u == (tg + 1u) * nx) xb_add(&bar[XB_TOPGEN], 1u);
            else XB_SPIN(xb_ld(&bar[XB_TOPGEN]) == tg, bar);
            __builtin_amdgcn_fence(__ATOMIC_ACQUIRE, "agent");
            xb_add(&bar[XB_XGEN(b.x)], 1u);
            asm volatile("s_waitcnt vmcnt(0)" ::: "memory");
        } else {
            XB_SPIN(xb_ld(&bar[XB_XGEN(b.x)]) == gen, bar);
            __builtin_amdgcn_fence(__ATOMIC_ACQUIRE, "agent");
            asm volatile("s_waitcnt vmcnt(0)" ::: "memory");
        }
    }
    __syncthreads();
}

#ifndef PG8_SP2
#define PG8_SP2 true
#endif
#ifndef PG8_ALIGN
#define PG8_ALIGN true
#endif
#ifndef PROBE_ON
#define PROBE_ON 0
#define PROBE_A 0
#define PROBE_B 1
#endif
#ifndef MK_PER_PHASE
#define MK_PER_PHASE 0
#endif

constexpr int T = 16384, NSMP = 32, TS = T + NSMP, TSP = T + 256, DM = 1024;
constexpr int PA = 3368, PAP = 3584;
constexpr int C_Q = 0, C_KC = 512, C_VC = 640, C_KS = 768, C_VS = 896, C_KW = 1024, C_VW = 1152, C_GATE = 1280,
              C_GQKV = 1304, C_A = 2840, C_BT = 2848, C_Z = 2856;
constexpr int DFF = 2816, DFF2 = 5632;
constexpr float DN_ALPHA = 1.4142135623730951f;
constexpr float LN_EPS = 1e-5f, NORM_EPS = 1e-6f;
constexpr int NPAGES = 128;
constexpr int NWAVES = 8, NTHR = 512;

constexpr size_t O_Y_P = 0;
constexpr size_t O_Y_S = O_Y_P + (size_t)T * DM;
constexpr size_t O_CMP_P = O_Y_S + (size_t)NSMP * DM;
constexpr size_t O_CMP_S = O_CMP_P + (size_t)T * 256;
constexpr size_t O_SLC_P = O_CMP_S + (size_t)NSMP * 256;
constexpr size_t O_SLC_S = O_SLC_P + (size_t)T * 256;
constexpr size_t O_WIN_P = O_SLC_S + (size_t)NSMP * 256;
constexpr size_t O_WIN_S = O_WIN_P + (size_t)512 * 256;
constexpr size_t O_GCONV_P = O_WIN_S + (size_t)NSMP * 512 * 256;
constexpr size_t O_GCONV_S = O_GCONV_P + (size_t)3 * 1536;
constexpr size_t O_GS_P = O_GCONV_S + (size_t)NSMP * 3 * 1536;
constexpr size_t O_GS_S = O_GS_P + (size_t)8 * 64 * 64;
constexpr size_t O_DIL_P = O_GS_S + (size_t)NSMP * 8 * 64 * 64;
constexpr size_t O_DIL_S = O_DIL_P + (size_t)2048 * 2048;
constexpr size_t O_FFN_P = O_DIL_S + (size_t)NSMP * 2048 * 2048;
constexpr size_t O_FFN_S = O_FFN_P + (size_t)2 * 2 * DFF2;
constexpr size_t O_END = O_FFN_S + (size_t)NSMP * 2 * 2 * DFF2;

constexpr int RING_BYTES = 131072;
constexpr int FAST_WL = 17408;
constexpr int MISC_OFF = 8 * FAST_WL + 64;
constexpr int LDS_BYTES = 147456;

typedef unsigned short bf16;
typedef unsigned v4u __attribute__((ext_vector_type(4)));

__device__ __forceinline__ unsigned f2bf(float f) { return (unsigned)__builtin_bit_cast(unsigned short, (__bf16)f); }
__device__ __forceinline__ unsigned pk2(float lo, float hi) { return pg8::cvt_pk_bf16(lo, hi); }
typedef short bf16x8 __attribute__((ext_vector_type(8)));
typedef float f32x4 __attribute__((ext_vector_type(4)));
#define MFMA16(a, b, c) __builtin_amdgcn_mfma_f32_16x16x32_bf16((a), (b), (c), 0, 0, 0)
__device__ __forceinline__ float wave_sum(float v) {
#pragma unroll
    for (int o = 1; o < 64; o <<= 1) v += __shfl_xor(v, o);
    return v;
}
__device__ __forceinline__ float wave_max(float v) {
#pragma unroll
    for (int o = 1; o < 64; o <<= 1) v = fmaxf(v, __shfl_xor(v, o));
    return v;
}
__device__ __forceinline__ void wave_lds_sync() { asm volatile("s_waitcnt lgkmcnt(0)" ::: "memory"); __builtin_amdgcn_wave_barrier(); asm volatile("" ::: "memory"); }
__device__ __forceinline__ float fexp_(float x) { return __builtin_amdgcn_exp2f(x * 1.4426950408889634f); }
__device__ __forceinline__ float fsilu_(float x) { return x * __builtin_amdgcn_rcpf(1.f + fexp_(-x)); }
__device__ __forceinline__ float sigmoidf_(float x) { return 1.f / (1.f + expf(-x)); }
__device__ __forceinline__ float siluf_(float x) { return x / (1.f + expf(-x)); }
__device__ __forceinline__ float gelu_tanh(float x) { const float c = 0.7978845608028654f; return 0.5f * x * (1.f + tanhf(c * (x + 0.044715f * x * x * x))); }
__device__ __forceinline__ float softplusf_(float x) { return x > 20.f ? x : log1pf(expf(x)); }

struct KP {
    const float *x_prompt, *x_sample, *cache_cmp, *cache_slc, *st_win, *st_gconv, *st_gS, *st_dil, *st_ffn;
    const int* page_table;
    const float *w_in_a, *cw1, *cb1, *cw2, *cpe, *gconv_w, *gA, *gdt, *gnw, *w_out_a, *w_in_c, *w_out_c, *ln_mix_g, *ln_mix_b,
                *ffn_w_in, *ffn_cw, *ffn_cb, *ffn_w_out, *ln_ffn_g, *ln_ffn_b;
    float* out;
    unsigned* ctl;
    bf16 *WT_A, *WT_OA, *WT_FI0, *WT_FI1, *WT_FO0, *WT_FO1, *WT_CI, *WT_CO;
    float2* ROPE;
    bf16 *ACTB, *MIXB, *HFFB, *MOB, *H1B, *H0B; float* ZF;
    bf16 *QB, *KSF, *VSF, *KWF, *VWF, *CKF, *CVF;
    unsigned char *KS8, *VS8;
    bf16 *QDB; bf16* DKF[3]; bf16* DVF[3];
    bf16 *AC, *WT_C, *HID, *W2T, *ACP; float* SMIXF; float* NSACC; int* SEL; float* UB;
    bf16 *G_WF, *G_KDF, *G_QGF, *G_QKF, *G_SPF, *G_VNF; float *G_UF, *G_GL;
    float *BIGF, *MO, *X1, *X2, *X3, *QR, *KS, *VS, *KW, *VW, *CK, *CV, *GQ, *GK, *GV, *OG, *Gg, *Gb, *QD, *KD;
    int ph_lo, ph_hi;
};

struct Fr { unsigned char* lds; int tid, lane, wave, gw, NGW, bid, G; };
__device__ __forceinline__ float h0f(const KP& p, int t, int c) { return __uint_as_float((unsigned)p.H0B[(size_t)t * PAP + c] << 16); }

__device__ __forceinline__ int ffn_row(int u) { const int half = u >= DFF ? 1 : 0, jc = u - half * DFF; return 256 * (jc >> 7) + 128 * half + (jc & 127); }
__device__ __forceinline__ void transpose_item(const float* W, int K, int N, int NT, bf16* WT, float* scr, int item, int lane, int rowmap = 0) {
    const int nblk = NT / 32, kb = item / nblk, nb = item % nblk, k0 = 64 * kb, n0 = 32 * nb;
#pragma unroll 8
    for (int i = 0; i < 32; ++i) { const int kk = 2 * i + (lane >> 5); const int n = n0 + (lane & 31); scr[kk * 33 + (lane & 31)] = (n < N) ? W[(size_t)(k0 + kk) * N + n] : 0.f; }
    wave_lds_sync();
    const int c = lane & 7;
#pragma unroll
    for (int j = 0; j < 4; ++j) { const int n = (lane >> 3) + 8 * j; const float* s = scr + (8 * c) * 33 + n;
        v4u o; o.x = pk2(s[0 * 33], s[1 * 33]); o.y = pk2(s[2 * 33], s[3 * 33]); o.z = pk2(s[4 * 33], s[5 * 33]); o.w = pk2(s[6 * 33], s[7 * 33]);
        const int row = rowmap ? ffn_row(n0 + n) : n0 + n;
        *(v4u*)(WT + (size_t)row * K + k0 + 8 * c) = o; }
    wave_lds_sync();
}
__device__ __forceinline__ void ph_prologue(const KP& p, const Fr& F) {
    float* scr = (float*)(F.lds + F.wave * 16384);
    const int I_A = 16 * (PAP / 32), I_OA = 16 * 32, I_FI = 16 * (DFF2 / 32), I_FO = (DFF / 64) * 32, I_CI = 16 * (3072 / 32), I_CO = 16 * 32;
    const int NITEMS = I_A + I_OA + 2 * I_FI + 2 * I_FO + I_CI + I_CO + 256 + 8;
    for (int it = F.gw; it < NITEMS; it += F.NGW) {
        int r = it;
        if (r < I_A) { transpose_item(p.w_in_a, DM, PA, PAP, p.WT_A, scr, r, F.lane); continue; } r -= I_A;
        if (r < I_OA) { transpose_item(p.w_out_a, DM, DM, DM, p.WT_OA, scr, r, F.lane); continue; } r -= I_OA;
        if (r < I_FI) { transpose_item(p.ffn_w_in, DM, DFF2, DFF2, p.WT_FI0, scr, r, F.lane, 1); continue; } r -= I_FI;
        if (r < I_FI) { transpose_item(p.ffn_w_in + (size_t)DM * DFF2, DM, DFF2, DFF2, p.WT_FI1, scr, r, F.lane, 1); continue; } r -= I_FI;
        if (r < I_FO) { transpose_item(p.ffn_w_out, DFF, DM, DM, p.WT_FO0, scr, r, F.lane); continue; } r -= I_FO;
        if (r < I_FO) { transpose_item(p.ffn_w_out + (size_t)DFF * DM, DFF, DM, DM, p.WT_FO1, scr, r, F.lane); continue; } r -= I_FO;
        if (r < I_CI) { transpose_item(p.w_in_c, DM, 3072, 3072, p.WT_CI, scr, r, F.lane); continue; } r -= I_CI;
        if (r < I_CO) { transpose_item(p.w_out_c, DM, DM, DM, p.WT_CO, scr, r, F.lane); continue; } r -= I_CO;
        if (r < 256) { const int kv = r >> 7; transpose_item(p.cw1 + (size_t)kv * 2048 * 128, 2048, 128, 128, p.WT_C + (size_t)kv * 128 * 2048, scr, r & 127, F.lane); continue; } r -= 256;
        { const int kv = r >> 2; transpose_item(p.cw2 + (size_t)kv * 128 * 64, 128, 64, 64, p.W2T + (size_t)kv * 64 * 128, scr, r & 3, F.lane); }
    }
    const size_t gt = (size_t)F.bid * NTHR + F.tid, GT = (size_t)F.G * NTHR;
    for (size_t i4 = gt; i4 < (size_t)TSP * (DM / 4); i4 += GT) {
        const int r = (int)(i4 / (DM / 4)), c4 = (int)(i4 % (DM / 4));
        float4 v = make_float4(0.f, 0.f, 0.f, 0.f);
        if (r < T) v = ((const float4*)p.x_prompt)[(size_t)r * (DM / 4) + c4]; else if (r < TS) v = ((const float4*)p.x_sample)[(size_t)(r - T) * (DM / 4) + c4];
        uint2 o; o.x = pk2(v.x, v.y); o.y = pk2(v.z, v.w);
        ((uint2*)p.ACTB)[i4] = o;
    }
    for (size_t idx = gt; idx < (size_t)(T + 1) * 32; idx += GT) {
        const int pos = (int)(idx >> 5), i = (int)(idx & 31);
        const float inv = (float)pow(10000.0, -2.0 * (double)i / 64.0);
        const float ang = (float)pos * inv;
        p.ROPE[idx] = make_float2((float)cos((double)ang), (float)sin((double)ang));
    }
}

__device__ __forceinline__ size_t vfrag_elem(int key, int d);
__device__ __forceinline__ size_t kfrag_elem(int key, int d);
__device__ __forceinline__ bf16x8 pack_p(const f32x4& p0, const f32x4& p1);
template <bool FFNMAP = false, bool OUTBF = false>
__device__ __forceinline__ void skinny_gemm(const Fr& F, const bf16* A, const bf16* Bt, int K, int ncols, float* C, int ldc) {
    const int lane = F.lane, l15 = lane & 15, grp = lane >> 4;
    const int kper = K >> 3, k0 = F.wave * kper;
    const bf16* a0 = A + (size_t)(T + l15) * K + 8 * grp + k0; const bf16* a1 = a0 + (size_t)16 * K;
    f32x4* red = (f32x4*)F.lds;
    const int ntiles = (ncols + 15) >> 4;
    for (int nt = F.bid; nt < ntiles; nt += F.G) {
        const bf16* bp = Bt + (size_t)(nt * 16 + l15) * K + 8 * grp + k0;
        f32x4 c0 = {0.f, 0.f, 0.f, 0.f}, c1 = {0.f, 0.f, 0.f, 0.f};
#pragma unroll 4
        for (int k = 0; k < kper; k += 32) {
            const bf16x8 b = *(const bf16x8*)(bp + k), x0 = *(const bf16x8*)(a0 + k), x1 = *(const bf16x8*)(a1 + k);
            c0 = MFMA16(x0, b, c0); c1 = MFMA16(x1, b, c1);
        }
        red[(F.wave * 2 + 0) * 64 + lane] = c0; red[(F.wave * 2 + 1) * 64 + lane] = c1;
        __syncthreads();
        if (F.wave == 0) {
#pragma unroll
            for (int w = 1; w < 8; ++w) { c0 = c0 + red[(w * 2 + 0) * 64 + lane]; c1 = c1 + red[(w * 2 + 1) * 64 + lane]; }
            int n = nt * 16 + l15;
            if (FFNMAP) n = ((n >> 7) & 1) * DFF + (n >> 8) * 128 + (n & 127);
            if (n < ncols) {
#pragma unroll
                for (int r = 0; r < 4; ++r) {
                    if (OUTBF) { ((bf16*)C)[(size_t)(T + 4 * grp + r) * ldc + n] = (bf16)f2bf(c0[r]); ((bf16*)C)[(size_t)(T + 16 + 4 * grp + r) * ldc + n] = (bf16)f2bf(c1[r]); }
                    else { C[(size_t)(T + 4 * grp + r) * ldc + n] = c0[r]; C[(size_t)(T + 16 + 4 * grp + r) * ldc + n] = c1[r]; } }
            }
        }
        __syncthreads();
    }
}
__device__ __forceinline__ void ph_gemm_f32(const Fr& F, const bf16* A, const bf16* Bt, int N, int K, float* C, int ldc, int ncols) {
    skinny_gemm(F, A, Bt, K, ncols, C, ldc);
    pg8::Gemm g{A, Bt, T, N, K}; pg8::StaticOrder S; S.init(T, N, F.G, F.bid);
    pg8::EpiF32 E{C, ldc, ncols};
    pg8::gemm_phase<pg8::EpiF32, pg8::StaticOrder, PG8_ALIGN, PG8_SP2>((PG8_LAS unsigned char*)F.lds, g, S, E);
}
__device__ __forceinline__ void ph_gemm_h1(const KP& p, const Fr& F) {
    skinny_gemm(F, p.ACTB, p.WT_CI, DM, 3072, p.BIGF, 3072);
    pg8::Gemm g{p.ACTB, p.WT_CI, T, 3072, DM}; pg8::StaticOrder S; S.init(T, 3072, F.G, F.bid);
    pg8::EpiBf16<0> E{p.H1B, 3072, nullptr, 0, 0, 1.f};
    pg8::gemm_phase<pg8::EpiBf16<0>, pg8::StaticOrder, PG8_ALIGN, PG8_SP2>((PG8_LAS unsigned char*)F.lds, g, S, E);
}
__device__ __forceinline__ void ph_gemm_h0(const KP& p, const Fr& F) {
    skinny_gemm(F, p.ACTB, p.WT_A, DM, PA, p.BIGF, PA);
    pg8::Gemm g{p.ACTB, p.WT_A, T, PAP, DM}; pg8::StaticOrder S; S.init(T, PAP, F.G, F.bid);
    pg8::EpiBf16<0> E{p.H0B, PAP, nullptr, 0, 0, 1.f};
    pg8::gemm_phase<pg8::EpiBf16<0>, pg8::StaticOrder, PG8_ALIGN, PG8_SP2>((PG8_LAS unsigned char*)F.lds, g, S, E);
}
__device__ __forceinline__ void ph_gemm_bf16(const Fr& F, const bf16* A, const bf16* Bt, int K, bf16* C) {
    skinny_gemm<false, true>(F, A, Bt, K, DM, (float*)C, DM);
    pg8::Gemm g{A, Bt, T, DM, K}; pg8::StaticOrder S; S.init(T, DM, F.G, F.bid);
    pg8::EpiBf16<0> E{C, DM, nullptr, 0, 0, 1.f};
    pg8::gemm_phase<pg8::EpiBf16<0>, pg8::StaticOrder, PG8_ALIGN, PG8_SP2>((PG8_LAS unsigned char*)F.lds, g, S, E);
}
__device__ __forceinline__ void ph_ln_b(const Fr& F, bf16* XB, const bf16* FB, const float* gam, const float* bet, float* outp, float* outs) {
    const int lane = F.lane;
    for (int r = F.gw; r < TS; r += F.NGW) {
        float v[16]; float s = 0.f;
#pragma unroll
        for (int j = 0; j < 2; ++j) {
            const v4u x = *(const v4u*)(XB + (size_t)r * DM + 512 * j + 8 * lane), f = *(const v4u*)(FB + (size_t)r * DM + 512 * j + 8 * lane);
#pragma unroll
            for (int e = 0; e < 4; ++e) {
                v[8 * j + 2 * e] = DN_ALPHA * __uint_as_float(x[e] << 16) + __uint_as_float(f[e] << 16);
                v[8 * j + 2 * e + 1] = DN_ALPHA * __uint_as_float(x[e] & 0xffff0000u) + __uint_as_float(f[e] & 0xffff0000u);
            }
        }
#pragma unroll
        for (int i = 0; i < 16; ++i) s += v[i];
        const float mean = wave_sum(s) * (1.f / DM); float q = 0.f;
#pragma unroll
        for (int i = 0; i < 16; ++i) { v[i] -= mean; q += v[i] * v[i]; }
        const float rstd = rsqrtf(wave_sum(q) * (1.f / DM) + LN_EPS);
#pragma unroll
        for (int j = 0; j < 2; ++j) {
            const int c0 = 512 * j + 8 * lane;
            const float4 g0 = *(const float4*)(gam + c0), g1 = *(const float4*)(gam + c0 + 4), b0 = *(const float4*)(bet + c0), b1 = *(const float4*)(bet + c0 + 4);
            const float y0 = v[8 * j + 0] * rstd * g0.x + b0.x, y1 = v[8 * j + 1] * rstd * g0.y + b0.y, y2 = v[8 * j + 2] * rstd * g0.z + b0.z, y3 = v[8 * j + 3] * rstd * g0.w + b0.w;
            const float y4 = v[8 * j + 4] * rstd * g1.x + b1.x, y5 = v[8 * j + 5] * rstd * g1.y + b1.y, y6 = v[8 * j + 6] * rstd * g1.z + b1.z, y7 = v[8 * j + 7] * rstd * g1.w + b1.w;
            if (outp) { float* o = ((r < T) ? outp + (size_t)r * DM : outs + (size_t)(r - T) * DM) + c0;
                *(float4*)o = make_float4(y0, y1, y2, y3); *(float4*)(o + 4) = make_float4(y4, y5, y6, y7); }
            else { v4u w; w.x = pk2(y0, y1); w.y = pk2(y2, y3); w.z = pk2(y4, y5); w.w = pk2(y6, y7); *(v4u*)(XB + (size_t)r * DM + c0) = w; }
        }
    }
}
__device__ __forceinline__ float dpp_ror1(float x) { return __int_as_float(__builtin_amdgcn_update_dpp(0, __float_as_int(x), 0x121, 0xf, 0xf, false)); }
__device__ __forceinline__ float dpp_ror2(float x) { return __int_as_float(__builtin_amdgcn_update_dpp(0, __float_as_int(x), 0x122, 0xf, 0xf, false)); }
struct EpiFfn {
    static constexpr bool PERM = true, AFTER_DRAIN = false;
    bf16* H; float* UB; const float* cw; const float* cb;
    __device__ __forceinline__ void operator()(const pg8::f32x4 (&acc)[2][2][4][2], const pg8::Unit& u, int wr, int wc, int fr, int fq) const {
#pragma unroll
        for (int n = 0; n < 2; ++n) {
            const int jc = u.pn * 128 + wc * 32 + 8 * fq + 4 * n;
            pg8::f32x4 w0[2], w1[2], w2[2], bb[2];
#pragma unroll
            for (int bj = 0; bj < 2; ++bj) { const int uc = bj * DFF + jc;
                w0[bj] = *(const pg8::f32x4*)(cw + uc); w1[bj] = *(const pg8::f32x4*)(cw + DFF2 + uc); w2[bj] = *(const pg8::f32x4*)(cw + 2 * DFF2 + uc); bb[bj] = *(const pg8::f32x4*)(cb + uc); }
#pragma unroll
            for (int ai = 0; ai < 2; ++ai) {
                const int sl = u.pm * 4 + ai * 2 + wr;
                pg8::f32x4 pr1[2], pr2[2];
#pragma unroll
                for (int m = 0; m < 4; ++m) {
                    pg8::f32x4 c[2];
#pragma unroll
                    for (int bj = 0; bj < 2; ++bj) {
                        const pg8::f32x4 uu = acc[ai][bj][m][n]; pg8::f32x4 r1, r2;
#pragma unroll
                        for (int e = 0; e < 4; ++e) { r1[e] = dpp_ror1(uu[e]); r2[e] = dpp_ror2(uu[e]); }
                        pg8::f32x4 p1 = r1, p2 = r2;
                        if (m > 0) { if (fr == 0) p1 = pr1[bj]; if (fr < 2) p2 = pr2[bj]; }
                        c[bj] = bb[bj] + w0[bj] * p2 + w1[bj] * p1 + w2[bj] * uu;
                        pr1[bj] = r1; pr2[bj] = r2;
                        const int uc = bj * DFF + jc;
                        if (m == 0 && fr < 2) *(pg8::f32x4*)(UB + ((size_t)sl * 4 + fr) * DFF2 + uc) = uu;
                        if (m == 3 && fr >= 14) *(pg8::f32x4*)(UB + ((size_t)sl * 4 + 2 + (fr - 14)) * DFF2 + uc) = uu;
                    }
                    if (!(m == 0 && fr < 2)) {
                        const int t = u.pm * 256 + ai * 128 + wr * 64 + m * 16 + fr;
                        uint2 o; o.x = pk2(fsilu_(c[0][0]) * c[1][0], fsilu_(c[0][1]) * c[1][1]); o.y = pk2(fsilu_(c[0][2]) * c[1][2], fsilu_(c[0][3]) * c[1][3]);
                        *(uint2*)(H + (size_t)t * DFF + jc) = o;
                    }
                }
            }
        }
    }
};
__device__ __forceinline__ void ph_ffn_gemm(const KP& p, const Fr& F, const bf16* Bt, int layer) {
    skinny_gemm<true>(F, p.ACTB, Bt, DM, DFF2, p.BIGF, DFF2);
    pg8::Gemm g{p.ACTB, Bt, T, DFF2, DM}; pg8::StaticOrder S; S.init(T, DFF2, F.G, F.bid);
    EpiFfn E{p.HFFB, p.UB, p.ffn_cw + (size_t)layer * 3 * DFF2, p.ffn_cb + (size_t)layer * DFF2};
    pg8::gemm_phase<EpiFfn, pg8::StaticOrder, PG8_ALIGN, PG8_SP2>((PG8_LAS unsigned char*)F.lds, g, S, E);
}
__device__ __forceinline__ void ph_ffn_fix(const KP& p, const Fr& F, int layer) {
    const float* cw = p.ffn_cw + (size_t)layer * 3 * DFF2; const float* cb = p.ffn_cb + (size_t)layer * DFF2; const float* U = p.BIGF;
    const int gt = F.bid * NTHR + F.tid, GT = F.G * NTHR;
    for (int idx = gt; idx < 512 * DFF; idx += GT) {
        const int rr = idx / DFF, j = idx - rr * DFF; const int sl = rr >> 1, q = rr & 1;
        float c2[2];
#pragma unroll
        for (int half = 0; half < 2; ++half) { const int ch = half * DFF + j;
            const float u0 = p.UB[((size_t)sl * 4 + q) * DFF2 + ch];
            const float um1 = q ? p.UB[((size_t)sl * 4) * DFF2 + ch] : (sl ? p.UB[((size_t)(sl - 1) * 4 + 3) * DFF2 + ch] : 0.f);
            const float um2 = sl ? p.UB[((size_t)(sl - 1) * 4 + 2 + q) * DFF2 + ch] : 0.f;
            c2[half] = cb[ch] + cw[ch] * um2 + cw[DFF2 + ch] * um1 + cw[2 * DFF2 + ch] * u0; }
        p.HFFB[(size_t)(64 * sl + q) * DFF + j] = (bf16)f2bf(siluf_(c2[0]) * c2[1]);
    }
    for (int idx = gt; idx < NSMP * DFF; idx += GT) {
        const int b = idx / DFF, j = idx - b * DFF;
        float c2[2];
#pragma unroll
        for (int half = 0; half < 2; ++half) { const int ch = half * DFF + j;
            const float* hs = p.st_ffn + (((size_t)b * 2 + layer) * 2) * DFF2 + ch;
            c2[half] = cb[ch] + cw[ch] * hs[0] + cw[DFF2 + ch] * hs[DFF2] + cw[2 * DFF2 + ch] * U[(size_t)(T + b) * DFF2 + ch]; }
        p.HFFB[(size_t)(T + b) * DFF + j] = (bf16)f2bf(siluf_(c2[0]) * c2[1]);
    }
    for (int idx = gt; idx < 2 * DFF2; idx += GT) { const int k = idx / DFF2, ch = idx - k * DFF2;
        p.out[O_FFN_P + ((size_t)layer * 2 + k) * DFF2 + ch] = p.UB[((size_t)255 * 4 + 2 + k) * DFF2 + ch]; }
    for (int idx = gt; idx < NSMP * 2 * DFF2; idx += GT) { const int b = idx / (2 * DFF2), k = (idx / DFF2) & 1, ch = idx % DFF2;
        p.out[O_FFN_S + (((size_t)b * 2 + layer) * 2 + k) * DFF2 + ch] = (k == 0) ? p.st_ffn[(((size_t)b * 2 + layer) * 2 + 1) * DFF2 + ch] : U[(size_t)(T + b) * DFF2 + ch]; }
}
struct EpiCmp {
    static constexpr bool PERM = false, AFTER_DRAIN = false;
    bf16* HID; const float* b1;
    __device__ __forceinline__ void operator()(const pg8::f32x4 (&acc)[2][2][4][2], const pg8::Unit& u, int wr, int wc, int fr, int fq) const {
#pragma unroll
        for (int ai = 0; ai < 2; ++ai)
#pragma unroll
            for (int m = 0; m < 4; ++m) { const int combo = u.pm * 128 + wr * 64 + m * 16 + fr;
#pragma unroll
                for (int n = 0; n < 2; ++n) { const int j0 = wc * 32 + n * 16 + 4 * fq; const pg8::f32x4 v = acc[ai][ai][m][n]; const float* bb = b1 + ai * 128 + j0;
                    uint2 o; o.x = pk2(gelu_tanh(v[0] + bb[0]), gelu_tanh(v[1] + bb[1])); o.y = pk2(gelu_tanh(v[2] + bb[2]), gelu_tanh(v[3] + bb[3]));
                    *(uint2*)(HID + ((size_t)combo * 2 + ai) * 128 + j0) = o; } }
    }
};
__device__ __forceinline__ void ph_cmp_gemm(const KP& p, const Fr& F) {
    pg8::Gemm g{p.AC, p.WT_C, 65536, 256, 2048}; pg8::StaticOrder S; S.init(65536, 256, F.G, F.bid);
    EpiCmp E{p.HID, p.cb1};
    pg8::gemm_phase<EpiCmp, pg8::StaticOrder, PG8_ALIGN, PG8_SP2>((PG8_LAS unsigned char*)F.lds, g, S, E);
}
__device__ __forceinline__ void ph_cmp_stage2(const KP& p, const Fr& F) {
    const int lane = F.lane, l15 = lane & 15, grp = lane >> 4;
    for (int tile = F.gw; tile < 4096; tile += F.NGW) {
        const int kv = tile & 1, combo0 = (tile >> 1) * 16;
        const bf16* hid = p.HID + ((size_t)(combo0 + l15) * 2 + kv) * 128 + 8 * grp; const bf16* w2 = p.W2T + (size_t)kv * 64 * 128 + (size_t)l15 * 128 + 8 * grp;
        f32x4 acc[4];
#pragma unroll
        for (int nt = 0; nt < 4; ++nt) acc[nt] = (f32x4){0.f, 0.f, 0.f, 0.f};
#pragma unroll
        for (int ks = 0; ks < 4; ++ks) { const bf16x8 a = *(const bf16x8*)(hid + 32 * ks);
#pragma unroll
            for (int nt = 0; nt < 4; ++nt) acc[nt] = MFMA16(a, *(const bf16x8*)(w2 + (size_t)nt * 16 * 128 + 32 * ks), acc[nt]); }
#pragma unroll
        for (int r = 0; r < 4; ++r) {
            const int combo = combo0 + 4 * grp + r; const int g = combo & 1, c = (combo >> 1) & 511, b = combo >> 10;
            float* dst = ((kv == 0) ? p.CK : p.CV) + (((size_t)(1 + b) * 512 + c) * 2 + g) * 64;
            if (kv == 0) {
                const int pos = (c + 1) * 32 - 1;
#pragma unroll
                for (int nt = 0; nt < 2; ++nt) { const float2 cs = p.ROPE[pos * 32 + 16 * nt + l15]; const float x1 = acc[nt][r], x2 = acc[nt + 2][r];
                    dst[16 * nt + l15] = x1 * cs.x - x2 * cs.y; dst[16 * (nt + 2) + l15] = x2 * cs.x + x1 * cs.y; }
            } else {
#pragma unroll
                for (int nt = 0; nt < 4; ++nt) dst[16 * nt + l15] = acc[nt][r];
            }
        }
    }
}
__device__ __forceinline__ void cmp_prompt_unit(const KP& p, int unit, int lane) {
    asm volatile("" : "+v"(lane));
    const int l15 = lane & 15, grp = lane >> 4;
    const int kv = unit & 1, combo = (unit >> 1) * 16 + l15; const int g = combo & 1, c = combo >> 1;
    const bf16* w1 = p.WT_C + ((size_t)kv * 128 + l15) * 2048 + 8 * grp;
    f32x4 acc[8];
#pragma unroll
    for (int jt = 0; jt < 8; ++jt) acc[jt] = (f32x4){0.f, 0.f, 0.f, 0.f};
    const bf16* fl = p.ACP + ((size_t)kv * 1024 + combo) * 2048 + 8 * grp;
#pragma unroll 4
    for (int ks = 0; ks < 64; ++ks) {
        const bf16x8 fb = *(const bf16x8*)(fl + 32 * ks);
#pragma unroll
        for (int jt = 0; jt < 8; ++jt) acc[jt] = MFMA16(*(const bf16x8*)(w1 + (size_t)jt * 16 * 2048 + 32 * ks), fb, acc[jt]);
    }
    bf16x8 hb[4];
#pragma unroll
    for (int s2 = 0; s2 < 4; ++s2) {
        f32x4 h0, h1;
#pragma unroll
        for (int r = 0; r < 4; ++r) { h0[r] = gelu_tanh(acc[2 * s2][r] + p.cb1[kv * 128 + 32 * s2 + 4 * grp + r]); h1[r] = gelu_tanh(acc[2 * s2 + 1][r] + p.cb1[kv * 128 + 32 * s2 + 16 + 4 * grp + r]); }
        hb[s2] = pack_p(h0, h1);
    }
    f32x4 o[4];
#pragma unroll
    for (int dt = 0; dt < 4; ++dt) {
        o[dt] = (f32x4){0.f, 0.f, 0.f, 0.f};
        const bf16* w2 = p.W2T + (size_t)kv * 64 * 128 + (size_t)(16 * dt + l15) * 128 + 4 * grp;
#pragma unroll
        for (int s2 = 0; s2 < 4; ++s2) { const uint2 x0 = *(const uint2*)(w2 + 32 * s2), x1 = *(const uint2*)(w2 + 32 * s2 + 16);
            union { v4u u; bf16x8 b; } wa; wa.u.x = x0.x; wa.u.y = x0.y; wa.u.z = x1.x; wa.u.w = x1.y;
            o[dt] = MFMA16(wa.b, hb[s2], o[dt]); }
    }
    if (kv == 0) {
        const int pos = (c + 1) * 32 - 1;
#pragma unroll
        for (int dt = 0; dt < 2; ++dt)
#pragma unroll
            for (int r = 0; r < 4; ++r) { const float2 cs = p.ROPE[pos * 32 + 16 * dt + 4 * grp + r]; const float x1 = o[dt][r], x2 = o[dt + 2][r];
                o[dt][r] = x1 * cs.x - x2 * cs.y; o[dt + 2][r] = x2 * cs.x + x1 * cs.y; }
    }
#pragma unroll
    for (int dt = 0; dt < 4; ++dt)
#pragma unroll
        for (int r = 0; r < 4; ++r) { const int d = 16 * dt + 4 * grp + r;
            if (kv == 0) p.CKF[(size_t)g * 512 * 64 + kfrag_elem(c, d)] = (bf16)f2bf(o[dt][r]); else p.CVF[(size_t)g * 512 * 64 + vfrag_elem(c, d)] = (bf16)f2bf(o[dt][r]); }
}
__device__ __forceinline__ void cmp_sample_unit(const KP& p, int unit, int lane) {
    asm volatile("" : "+v"(lane));
    const int l15 = lane & 15, grp = lane >> 4;
    const int b = unit >> 6, kv = (unit >> 5) & 1, cb = unit & 31;
    const bf16* w1 = p.WT_C + ((size_t)kv * 128 + l15) * 2048 + 8 * grp;
    const float* src[2];
#pragma unroll
    for (int cg = 0; cg < 2; ++cg) { const int combo = cb * 32 + 16 * cg + l15; const int g = combo & 1, c = combo >> 1;
        const int page = p.page_table[b * NPAGES + (c >> 2)];
        src[cg] = p.cache_cmp + (((size_t)page * 128 + (c & 3) * 32) * 4 + kv * 2 + g) * 64 + 8 * grp; }
    const float* pe = p.cpe + (size_t)kv * 32 * 64 + 8 * grp;
    f32x4 acc[2][8];
#pragma unroll
    for (int cg = 0; cg < 2; ++cg)
#pragma unroll
        for (int jt = 0; jt < 8; ++jt) acc[cg][jt] = (f32x4){0.f, 0.f, 0.f, 0.f};
#pragma unroll 2
    for (int ks = 0; ks < 64; ++ks) {
        const int i = ks >> 1, dd = 32 * (ks & 1);
        const float4 e0 = *(const float4*)(pe + i * 64 + dd), e1 = *(const float4*)(pe + i * 64 + dd + 4);
        bf16x8 fb[2];
#pragma unroll
        for (int cg = 0; cg < 2; ++cg) { const float4 a0 = *(const float4*)(src[cg] + i * 256 + dd), a1 = *(const float4*)(src[cg] + i * 256 + dd + 4);
            union { v4u u; bf16x8 b; } t; t.u.x = pk2(a0.x + e0.x, a0.y + e0.y); t.u.y = pk2(a0.z + e0.z, a0.w + e0.w); t.u.z = pk2(a1.x + e1.x, a1.y + e1.y); t.u.w = pk2(a1.z + e1.z, a1.w + e1.w); fb[cg] = t.b; }
#pragma unroll
        for (int jt = 0; jt < 8; ++jt) { const bf16x8 wa = *(const bf16x8*)(w1 + (size_t)jt * 16 * 2048 + 32 * ks);
            acc[0][jt] = MFMA16(wa, fb[0], acc[0][jt]); acc[1][jt] = MFMA16(wa, fb[1], acc[1][jt]); }
    }
#pragma unroll
    for (int cg = 0; cg < 2; ++cg) {
        const int combo = cb * 32 + 16 * cg + l15; const int g = combo & 1, c = combo >> 1;
        bf16x8 hb[4];
#pragma unroll
        for (int s2 = 0; s2 < 4; ++s2) { f32x4 h0, h1;
#pragma unroll
            for (int r = 0; r < 4; ++r) { h0[r] = gelu_tanh(acc[cg][2 * s2][r] + p.cb1[kv * 128 + 32 * s2 + 4 * grp + r]); h1[r] = gelu_tanh(acc[cg][2 * s2 + 1][r] + p.cb1[kv * 128 + 32 * s2 + 16 + 4 * grp + r]); }
            hb[s2] = pack_p(h0, h1); }
        f32x4 o[4];
#pragma unroll
        for (int dt = 0; dt < 4; ++dt) {
            o[dt] = (f32x4){0.f, 0.f, 0.f, 0.f};
            const bf16* w2 = p.W2T + (size_t)kv * 64 * 128 + (size_t)(16 * dt + l15) * 128 + 4 * grp;
#pragma unroll
            for (int s2 = 0; s2 < 4; ++s2) { const uint2 x0 = *(const uint2*)(w2 + 32 * s2), x1 = *(const uint2*)(w2 + 32 * s2 + 16);
                union { v4u u; bf16x8 b; } wa; wa.u.x = x0.x; wa.u.y = x0.y; wa.u.z = x1.x; wa.u.w = x1.y;
                o[dt] = MFMA16(wa.b, hb[s2], o[dt]); }
        }
        if (kv == 0) {
            const int pos = (c + 1) * 32 - 1;
#pragma unroll
            for (int dt = 0; dt < 2; ++dt)
#pragma unroll
                for (int r = 0; r < 4; ++r) { const float2 cs = p.ROPE[pos * 32 + 16 * dt + 4 * grp + r]; const float x1 = o[dt][r], x2 = o[dt + 2][r];
                    o[dt][r] = x1 * cs.x - x2 * cs.y; o[dt + 2][r] = x2 * cs.x + x1 * cs.y; }
        }
        float* dst = ((kv == 0) ? p.CK : p.CV) + (((size_t)(1 + b) * 512 + c) * 2 + g) * 64 + 4 * grp;
#pragma unroll
        for (int dt = 0; dt < 4; ++dt) *(f32x4*)(dst + 16 * dt) = o[dt];
    }
}
constexpr int W1S_PITCH = 528;
constexpr int W1S_BYTES = 128 * W1S_PITCH;
__device__ __forceinline__ void cmp_sample_wg(const KP& p, int wu, const Fr& F) {
    int lane = F.lane; asm volatile("" : "+v"(lane));
    const int l15 = lane & 15, grp = lane >> 4, tid = F.tid;
    const int b = wu >> 3, kv = (wu >> 2) & 1, q4 = wu & 3;
    const float* src[2];
#pragma unroll
    for (int cg = 0; cg < 2; ++cg) { const int combo = q4 * 256 + F.wave * 32 + 16 * cg + l15; const int g = combo & 1, c = combo >> 1;
        const int page = p.page_table[b * NPAGES + (c >> 2)];
        src[cg] = p.cache_cmp + (((size_t)page * 128 + (c & 3) * 32) * 4 + kv * 2 + g) * 64 + 8 * grp; }
    const float* pe = p.cpe + (size_t)kv * 32 * 64 + 8 * grp;
    const bf16* wg = p.WT_C + (size_t)kv * 128 * 2048;
    f32x4 acc[2][8];
#pragma unroll
    for (int cg = 0; cg < 2; ++cg)
#pragma unroll
        for (int jt = 0; jt < 8; ++jt) acc[cg][jt] = (f32x4){0.f, 0.f, 0.f, 0.f};
    v4u wreg[8];
#pragma unroll
    for (int k = 0; k < 8; ++k) { const int c = tid + 512 * k; wreg[k] = *(const v4u*)(wg + (size_t)(c >> 5) * 2048 + (c & 31) * 8); }
#pragma unroll
    for (int k = 0; k < 8; ++k) { const int c = tid + 512 * k; *(v4u*)(F.lds + (c >> 5) * W1S_PITCH + (c & 31) * 16) = wreg[k]; }
    __syncthreads();
#pragma unroll 1
    for (int sl = 0; sl < 8; ++sl) {
        if (sl + 1 < 8) {
#pragma unroll
            for (int k = 0; k < 8; ++k) { const int c = tid + 512 * k; wreg[k] = *(const v4u*)(wg + (size_t)(c >> 5) * 2048 + (sl + 1) * 256 + (c & 31) * 8); }
        }
        const unsigned char* wl = F.lds + (sl & 1) * W1S_BYTES + l15 * W1S_PITCH + grp * 16;
#pragma unroll 4
        for (int kk = 0; kk < 8; ++kk) {
            const int ks = sl * 8 + kk, i = ks >> 1, dd = 32 * (ks & 1);
            const float4 e0 = *(const float4*)(pe + i * 64 + dd), e1 = *(const float4*)(pe + i * 64 + dd + 4);
            bf16x8 fb[2];
#pragma unroll
            for (int cg = 0; cg < 2; ++cg) { const float4 a0 = *(const float4*)(src[cg] + i * 256 + dd), a1 = *(const float4*)(src[cg] + i * 256 + dd + 4);
                union { v4u u; bf16x8 b; } t; t.u.x = pk2(a0.x + e0.x, a0.y + e0.y); t.u.y = pk2(a0.z + e0.z, a0.w + e0.w); t.u.z = pk2(a1.x + e1.x, a1.y + e1.y); t.u.w = pk2(a1.z + e1.z, a1.w + e1.w); fb[cg] = t.b; }
#pragma unroll
            for (int jt = 0; jt < 8; ++jt) { const bf16x8 wa = *(const bf16x8*)(wl + jt * 16 * W1S_PITCH + kk * 64);
                acc[0][jt] = MFMA16(wa, fb[0], acc[0][jt]); acc[1][jt] = MFMA16(wa, fb[1], acc[1][jt]); }
        }
        if (sl + 1 < 8) {
#pragma unroll
            for (int k = 0; k < 8; ++k) { const int c = tid + 512 * k; *(v4u*)(F.lds + ((sl + 1) & 1) * W1S_BYTES + (c >> 5) * W1S_PITCH + (c & 31) * 16) = wreg[k]; }
        }
        __syncthreads();
    }
#pragma unroll
    for (int cg = 0; cg < 2; ++cg) {
        const int combo = q4 * 256 + F.wave * 32 + 16 * cg + l15; const int g = combo & 1, c = combo >> 1;
        bf16x8 hb[4];
#pragma unroll
        for (int s2 = 0; s2 < 4; ++s2) { f32x4 h0, h1;
#pragma unroll
            for (int r = 0; r < 4; ++r) { h0[r] = gelu_tanh(acc[cg][2 * s2][r] + p.cb1[kv * 128 + 32 * s2 + 4 * grp + r]); h1[r] = gelu_tanh(acc[cg][2 * s2 + 1][r] + p.cb1[kv * 128 + 32 * s2 + 16 + 4 * grp + r]); }
            hb[s2] = pack_p(h0, h1); }
        f32x4 o[4];
#pragma unroll
        for (int dt = 0; dt < 4; ++dt) {
            o[dt] = (f32x4){0.f, 0.f, 0.f, 0.f};
            const bf16* w2 = p.W2T + (size_t)kv * 64 * 128 + (size_t)(16 * dt + l15) * 128 + 4 * grp;
#pragma unroll
            for (int s2 = 0; s2 < 4; ++s2) { const uint2 x0 = *(const uint2*)(w2 + 32 * s2), x1 = *(const uint2*)(w2 + 32 * s2 + 16);
                union { v4u u; bf16x8 b; } wa; wa.u.x = x0.x; wa.u.y = x0.y; wa.u.z = x1.x; wa.u.w = x1.y;
                o[dt] = MFMA16(wa.b, hb[s2], o[dt]); }
        }
        if (kv == 0) {
            const int pos = (c + 1) * 32 - 1;
#pragma unroll
            for (int dt = 0; dt < 2; ++dt)
#pragma unroll
                for (int r = 0; r < 4; ++r) { const float2 cs = p.ROPE[pos * 32 + 16 * dt + 4 * grp + r]; const float x1 = o[dt][r], x2 = o[dt + 2][r];
                    o[dt][r] = x1 * cs.x - x2 * cs.y; o[dt + 2][r] = x2 * cs.x + x1 * cs.y; }
        }
        float* dst = ((kv == 0) ? p.CK : p.CV) + (((size_t)(1 + b) * 512 + c) * 2 + g) * 64 + 4 * grp;
#pragma unroll
        for (int dt = 0; dt < 4; ++dt) *(f32x4*)(dst + 16 * dt) = o[dt];
    }
}
__device__ __forceinline__ void ph_cmp_samples(const KP& p, const Fr& F) {
    for (int wu = F.bid; wu < 256; wu += F.G) cmp_sample_wg(p, wu, F);
}
__device__ __forceinline__ void ph_cmp_prompt(const KP& p, const Fr& F) {
    for (int unit = F.gw; unit < 128; unit += F.NGW) cmp_prompt_unit(p, unit, F.lane);
}

__device__ __forceinline__ float rope_val(const float* row, int base, int i, float2 cs) {
    const int ii = i & 31;
    const float x1 = row[base + ii], x2 = row[base + ii + 32];
    return (i < 32) ? (x1 * cs.x - x2 * cs.y) : (x2 * cs.x + x1 * cs.y);
}
__device__ __forceinline__ void ph_nsa_prep(const KP& p, const Fr& F) {
    const float* H0 = p.BIGF; float* out = p.out;
    const size_t gt = (size_t)F.bid * NTHR + F.tid, GT = (size_t)F.G * NTHR;
    const size_t total = (size_t)TS * 1280;
    for (size_t idx = gt + (size_t)T * 1280; idx < total; idx += GT) {
        const int r = (int)(idx / 1280), c = (int)(idx % 1280);
        const bool smp = r >= T; const int b = r - T; const int pos = smp ? T : r;
        const float* row = H0 + (size_t)r * PA;
        const int i = c & 63;
        const float2 cs = p.ROPE[pos * 32 + (i & 31)];
        if (c < 512) { p.QR[(size_t)r * 512 + c] = rope_val(row, c & ~63, i, cs); continue; }
        const int sec = (c - 512) >> 7; const int gd = (c - 512) & 127; const int base = c & ~63;
        float v;
        if (sec == 2 || sec == 4) v = rope_val(row, base, i, cs); else v = row[c];
        const int kv = sec & 1;
        if (sec < 2) {
            if (!smp) out[O_CMP_P + (size_t)r * 256 + kv * 128 + gd] = v; else out[O_CMP_S + (size_t)b * 256 + kv * 128 + gd] = v;
        } else if (sec < 4) {
            if (!smp) out[O_SLC_P + (size_t)r * 256 + kv * 128 + gd] = v; else out[O_SLC_S + (size_t)b * 256 + kv * 128 + gd] = v;
            if (kv == 0) p.KS[(size_t)r * 128 + gd] = v; else p.VS[(size_t)r * 128 + gd] = v;
        } else {
            if (kv == 0) p.KW[(size_t)r * 128 + gd] = v; else p.VW[(size_t)r * 128 + gd] = v;
            if (!smp) { if (r >= T - 512) out[O_WIN_P + (size_t)(r - (T - 512)) * 256 + kv * 128 + gd] = v; }
            else out[O_WIN_S + ((size_t)b * 512 + 511) * 256 + kv * 128 + gd] = v;
        }
    }
    const size_t tot2 = (size_t)NSMP * 511 * 256;
    for (size_t idx = gt; idx < tot2; idx += GT) {
        const int b = (int)(idx / (511 * 256)); const int rem = (int)(idx % (511 * 256));
        out[O_WIN_S + (size_t)b * 512 * 256 + rem] = p.st_win[(size_t)b * 512 * 256 + 256 + rem];
    }
}

constexpr float QSCALE = 0.18033688011112042f;

__device__ __forceinline__ size_t kfrag_off(int kt, int ks, int lane) { return ((size_t)(kt * 2 + ks) * 64 + lane) * 8; }
__device__ __forceinline__ size_t vfrag_off(int st, int dt, int lane) { return ((size_t)(st * 4 + dt) * 64 + lane) * 8; }
__device__ __forceinline__ size_t vfrag_elem(int key, int d) {
    const int st = key >> 5, kk = key & 31, tile = kk >> 4, r16 = kk & 15, grp = r16 >> 2, reg = r16 & 3;
    return ((size_t)(st * 4 + (d >> 4)) * 64 + (d & 15) + 16 * grp) * 8 + tile * 4 + reg;
}
__device__ __forceinline__ size_t k8_off(int key, int d) { return ((size_t)(key >> 4) * 64 + (key & 15) + 16 * ((d & 31) >> 3)) * 16 + (d >> 5) * 8 + (d & 7); }
__device__ __forceinline__ size_t v8_off(int key, int d) {
    const int blk = key >> 6, st = (key >> 5) & 1, kk = key & 31, tile = kk >> 4, r16 = kk & 15, grp = r16 >> 2, reg = r16 & 3;
    return ((size_t)(blk * 4 + (d >> 4)) * 64 + (d & 15) + 16 * grp) * 16 + st * 8 + tile * 4 + reg;
}
__device__ __forceinline__ size_t kfrag_elem(int key, int d) {
    return ((size_t)((key >> 4) * 2 + (d >> 5)) * 64 + (key & 15) + 16 * ((d & 31) >> 3)) * 8 + (d & 7);
}

__device__ __forceinline__ void ph_nsa_prep_fast(const KP& p, const Fr& F) {
    const float* H0 = p.BIGF; float* out = p.out;
    const size_t gt = (size_t)F.bid * NTHR + F.tid, GT = (size_t)F.G * NTHR;
    for (size_t idx = gt; idx < (size_t)T * 64; idx += GT) {
        const int t = (int)(idx >> 6), u = (int)(idx & 63);
        const v4u uz = *(const v4u*)(p.H0B + (size_t)t * PAP + C_Z + 8 * u); float* zo = p.ZF + (size_t)t * 512 + 8 * u;
        *(float4*)zo = make_float4(__uint_as_float(uz[0] << 16), __uint_as_float(uz[0] & 0xffff0000u), __uint_as_float(uz[1] << 16), __uint_as_float(uz[1] & 0xffff0000u));
        *(float4*)(zo + 4) = make_float4(__uint_as_float(uz[2] << 16), __uint_as_float(uz[2] & 0xffff0000u), __uint_as_float(uz[3] << 16), __uint_as_float(uz[3] & 0xffff0000u));
    }
    for (size_t idx = gt; idx < (size_t)T * 160; idx += GT) {
        const int t = (int)(idx / 160), u = (int)(idx % 160);
        const int c0 = u * 8; const bf16* row = p.H0B + (size_t)t * PAP;
        const v4u ua = *(const v4u*)(row + c0);
        float v[8];
#pragma unroll
        for (int e = 0; e < 4; ++e) { v[2 * e] = __uint_as_float(ua[e] << 16); v[2 * e + 1] = __uint_as_float(ua[e] & 0xffff0000u); }
        const int sec = (u < 64) ? -1 : ((u - 64) >> 4);
        const bool roped = (sec == -1 || sec == 2 || sec == 4);
        if (roped) {
            const int d0 = c0 & 63; const int pc = (d0 < 32) ? c0 + 32 : c0 - 32;
            const v4u ub = *(const v4u*)(row + pc);
            float w[8];
#pragma unroll
            for (int e = 0; e < 4; ++e) { w[2 * e] = __uint_as_float(ub[e] << 16); w[2 * e + 1] = __uint_as_float(ub[e] & 0xffff0000u); }
            const float4* rp = (const float4*)(p.ROPE + t * 32 + (d0 & 31)); const float4 r0 = rp[0], r1 = rp[1], r2 = rp[2], r3 = rp[3];
            const float cs[8] = {r0.x, r0.z, r1.x, r1.z, r2.x, r2.z, r3.x, r3.z}, sn[8] = {r0.y, r0.w, r1.y, r1.w, r2.y, r2.w, r3.y, r3.w};
#pragma unroll
            for (int j = 0; j < 8; ++j) v[j] = (d0 < 32) ? (v[j] * cs[j] - w[j] * sn[j]) : (v[j] * cs[j] + w[j] * sn[j]);
        }
        if (sec == -1) {
            v4u o; o.x = pk2(v[0] * QSCALE, v[1] * QSCALE); o.y = pk2(v[2] * QSCALE, v[3] * QSCALE); o.z = pk2(v[4] * QSCALE, v[5] * QSCALE); o.w = pk2(v[6] * QSCALE, v[7] * QSCALE);
            *(v4u*)(p.QB + (size_t)t * 512 + c0) = o; continue;
        }
        const int gd = (c0 - 512) & 127, g = gd >> 6, d0 = gd & 63, kv = sec & 1;
        const float4 o0 = make_float4(v[0], v[1], v[2], v[3]), o1 = make_float4(v[4], v[5], v[6], v[7]);
        if (sec < 2) { float* o = out + O_CMP_P + (size_t)t * 256 + kv * 128 + gd; *(float4*)o = o0; *(float4*)(o + 4) = o1;
            const int i = t & 31; const float* pe = p.cpe + (kv * 32 + i) * 64 + d0; const float4 e0 = *(const float4*)pe, e1 = *(const float4*)(pe + 4);
            v4u w; w.x = pk2(v[0] + e0.x, v[1] + e0.y); w.y = pk2(v[2] + e0.z, v[3] + e0.w); w.z = pk2(v[4] + e1.x, v[5] + e1.y); w.w = pk2(v[6] + e1.z, v[7] + e1.w);
            *(v4u*)(p.ACP + ((size_t)kv * 1024 + (t >> 5) * 2 + g) * 2048 + i * 64 + d0) = w; continue; }
        if (sec < 4) { float* o = out + O_SLC_P + (size_t)t * 256 + kv * 128 + gd; *(float4*)o = o0; *(float4*)(o + 4) = o1; }
        else if (t >= T - 512) { float* o = out + O_WIN_P + (size_t)(t - (T - 512)) * 256 + kv * 128 + gd; *(float4*)o = o0; *(float4*)(o + 4) = o1; }
        if (sec < 4) {
            if (kv == 0) {
                int w0 = 0, w1 = 0;
                w0 = __builtin_amdgcn_cvt_pk_fp8_f32(v[0], v[1], w0, false); w0 = __builtin_amdgcn_cvt_pk_fp8_f32(v[2], v[3], w0, true);
                w1 = __builtin_amdgcn_cvt_pk_fp8_f32(v[4], v[5], w1, false); w1 = __builtin_amdgcn_cvt_pk_fp8_f32(v[6], v[7], w1, true);
                *(uint2*)(p.KS8 + (size_t)g * T * 64 + k8_off(t, d0)) = make_uint2((unsigned)w0, (unsigned)w1);
            } else {
#pragma unroll
                for (int j = 0; j < 8; ++j) p.VS8[(size_t)g * T * 64 + v8_off(t, d0 + j)] = (unsigned char)(__builtin_amdgcn_cvt_pk_fp8_f32(v[j], 0.f, 0, false) & 0xff);
            }
            continue;
        }
        bf16* KF = p.KWF; bf16* VF = p.VWF;
        if (kv == 0) {
            v4u o; o.x = pk2(v[0], v[1]); o.y = pk2(v[2], v[3]); o.z = pk2(v[4], v[5]); o.w = pk2(v[6], v[7]);
            *(v4u*)(KF + (size_t)g * T * 64 + kfrag_elem(t, d0)) = o;
        } else {
#pragma unroll
            for (int j = 0; j < 8; ++j) VF[(size_t)g * T * 64 + vfrag_elem(t, d0 + j)] = (bf16)f2bf(v[j]);
        }
    }
}

struct AttW { f32x4 o[4]; float m, l; };
__device__ __forceinline__ void attw_init(AttW& a) {
#pragma unroll
    for (int i = 0; i < 4; ++i) a.o[i] = (f32x4){0.f, 0.f, 0.f, 0.f};
    a.m = -INFINITY; a.l = 0.f;
}
__device__ __forceinline__ void qk_step(const bf16x8 (&kf)[2][2], const bf16x8 (&qf)[2], f32x4& s0, f32x4& s1) {
    const f32x4 z = {0.f, 0.f, 0.f, 0.f};
    s0 = MFMA16(kf[0][0], qf[0], z); s0 = MFMA16(kf[0][1], qf[1], s0);
    s1 = MFMA16(kf[1][0], qf[0], z); s1 = MFMA16(kf[1][1], qf[1], s1);
}
__device__ __forceinline__ bf16x8 pack_p(const f32x4& p0, const f32x4& p1) {
    union { v4u u; bf16x8 b; } c;
    c.u.x = pg8::cvt_pk_bf16(p0[0], p0[1]); c.u.y = pg8::cvt_pk_bf16(p0[2], p0[3]); c.u.z = pg8::cvt_pk_bf16(p1[0], p1[1]); c.u.w = pg8::cvt_pk_bf16(p1[2], p1[3]);
    return c.b;
}
__device__ __forceinline__ void att_update(AttW& a, const f32x4& s0, const f32x4& s1, const bf16x8 (&vf)[4]) {
    float mx = fmaxf(fmaxf(fmaxf(s0[0], s0[1]), fmaxf(s0[2], s0[3])), fmaxf(fmaxf(s1[0], s1[1]), fmaxf(s1[2], s1[3])));
    mx = fmaxf(mx, __shfl_xor(mx, 16)); mx = fmaxf(mx, __shfl_xor(mx, 32));
    const float mn = fmaxf(a.m, mx);
    const float ms = (mn == -INFINITY) ? 0.f : mn;
    const float alpha = __builtin_amdgcn_exp2f(a.m - ms);
    f32x4 p0, p1;
#pragma unroll
    for (int i = 0; i < 4; ++i) { p0[i] = __builtin_amdgcn_exp2f(s0[i] - ms); p1[i] = __builtin_amdgcn_exp2f(s1[i] - ms); }
    a.l = a.l * alpha + ((p0[0] + p0[1]) + (p0[2] + p0[3])) + ((p1[0] + p1[1]) + (p1[2] + p1[3]));
    a.m = mn;
    const bf16x8 pf = pack_p(p0, p1);
#pragma unroll
    for (int dt = 0; dt < 4; ++dt) { a.o[dt] = a.o[dt] * alpha; a.o[dt] = MFMA16(vf[dt], pf, a.o[dt]); }
}
__device__ __forceinline__ float grp_sum(float v) { v += __shfl_xor(v, 16); v += __shfl_xor(v, 32); return v; }

__device__ __forceinline__ void nsa_fast_unit(const KP& p, int unit, float* wl, int lane) {
    asm volatile("" : "+v"(lane));
    const int g = unit & 1, t0 = (unit >> 1) * 16;
    const int qi = lane & 15, grp = lane >> 4, t = t0 + qi;
    float* imp = wl; int* sel = (int*)(wl + 4096);
    const bf16* growb = p.H0B + (size_t)t * PAP + C_GATE + g * 4;
#define GROWF(i) __uint_as_float((unsigned)growb[i] << 16)
    bf16x8 qf[4][2];
#pragma unroll
    for (int h = 0; h < 4; ++h)
#pragma unroll
        for (int ks = 0; ks < 2; ++ks) qf[h][ks] = *(const bf16x8*)(p.QB + (size_t)t * 512 + (g * 4 + h) * 64 + 32 * ks + 8 * grp);
    AttW st[4];
    {
        const bf16* CKF = p.CKF + (size_t)g * 512 * 64; const bf16* CVF = p.CVF + (size_t)g * 512 * 64;
        const int nmax = (t0 + 16) >> 5; const int nsteps = (nmax + 31) >> 5;
        const int nval = (t + 1) >> 5;
        float m[4], l[4];
#pragma unroll
        for (int h = 0; h < 4; ++h) { m[h] = -INFINITY; l[h] = 0.f; }
        for (int s = 0; s < nsteps; ++s) {
            bf16x8 kf[2][2];
#pragma unroll
            for (int tl = 0; tl < 2; ++tl)
#pragma unroll
                for (int ks = 0; ks < 2; ++ks) kf[tl][ks] = *(const bf16x8*)(CKF + kfrag_off(2 * s + tl, ks, lane));
            const int cb = 32 * s + 4 * grp;
#pragma unroll
            for (int h = 0; h < 4; ++h) {
                f32x4 s0, s1; qk_step(kf, qf[h], s0, s1);
#pragma unroll
                for (int i = 0; i < 4; ++i) { if (cb + i >= nval) s0[i] = -INFINITY; if (cb + 16 + i >= nval) s1[i] = -INFINITY; }
                float mx = fmaxf(fmaxf(fmaxf(s0[0], s0[1]), fmaxf(s0[2], s0[3])), fmaxf(fmaxf(s1[0], s1[1]), fmaxf(s1[2], s1[3])));
                mx = fmaxf(mx, __shfl_xor(mx, 16)); mx = fmaxf(mx, __shfl_xor(mx, 32));
                const float mn = fmaxf(m[h], mx); const float ms = (mn == -INFINITY) ? 0.f : mn;
                float sum = 0.f;
#pragma unroll
                for (int i = 0; i < 4; ++i) sum += __builtin_amdgcn_exp2f(s0[i] - ms) + __builtin_amdgcn_exp2f(s1[i] - ms);
                l[h] = l[h] * __builtin_amdgcn_exp2f(m[h] - ms) + sum; m[h] = mn;
            }
        }
        float il[4];
#pragma unroll
        for (int h = 0; h < 4; ++h) { const float lt = grp_sum(l[h]); il[h] = lt > 0.f ? 1.f / lt : 0.f; if (m[h] == -INFINITY) m[h] = 0.f; attw_init(st[h]); }
        for (int s = 0; s < nsteps; ++s) {
            bf16x8 kf[2][2], vf[4];
#pragma unroll
            for (int tl = 0; tl < 2; ++tl)
#pragma unroll
                for (int ks = 0; ks < 2; ++ks) kf[tl][ks] = *(const bf16x8*)(CKF + kfrag_off(2 * s + tl, ks, lane));
#pragma unroll
            for (int dt = 0; dt < 4; ++dt) vf[dt] = *(const bf16x8*)(CVF + vfrag_off(s, dt, lane));
            const int cb = 32 * s + 4 * grp;
            float i4[4] = {0.f, 0.f, 0.f, 0.f};
#pragma unroll
            for (int h = 0; h < 4; ++h) {
                f32x4 s0, s1; qk_step(kf, qf[h], s0, s1);
                f32x4 p0, p1;
#pragma unroll
                for (int i = 0; i < 4; ++i) {
                    p0[i] = (cb + i < nval) ? __builtin_amdgcn_exp2f(s0[i] - m[h]) * il[h] : 0.f;
                    p1[i] = (cb + 16 + i < nval) ? __builtin_amdgcn_exp2f(s1[i] - m[h]) * il[h] : 0.f; }
                i4[0] += p0[0] + p0[1]; i4[1] += p0[2] + p0[3]; i4[2] += p1[0] + p1[1]; i4[3] += p1[2] + p1[3];
                const bf16x8 pf = pack_p(p0, p1);
#pragma unroll
                for (int dt = 0; dt < 4; ++dt) st[h].o[dt] = MFMA16(vf[dt], pf, st[h].o[dt]);
            }
            *(float2*)(imp + qi * 256 + 16 * s + 2 * grp) = make_float2(i4[0], i4[1]);
            *(float2*)(imp + qi * 256 + 16 * s + 8 + 2 * grp) = make_float2(i4[2], i4[3]);
        }
        wave_lds_sync();
    }
    const int cur = t0 >> 6;
    {
        if (cur + 1 <= 16) {
            for (int idx = lane; idx < 256; idx += 64) sel[idx] = ((idx & 15) <= cur) ? (idx & 15) : -1;
        } else {
            for (int q0 = 0; q0 < 16; q0 += 4) {
                unsigned key[4][4];
#pragma unroll
                for (int qq = 0; qq < 4; ++qq)
#pragma unroll
                    for (int j = 0; j < 4; ++j) { const int blk = lane + 64 * j; const float v = imp[(q0 + qq) * 256 + blk];
                        key[qq][j] = (blk >= 1 && blk <= cur - 2) ? ((__float_as_uint(v) & 0xFFFFFF00u) | (unsigned)(255 - blk)) : 0u; }
                if (lane < 4) { sel[(q0 + lane) * 16 + 0] = 0; sel[(q0 + lane) * 16 + 1] = cur; sel[(q0 + lane) * 16 + 2] = cur - 1; }
                for (int n = 3; n < 16; ++n) {
                    unsigned best[4];
#pragma unroll
                    for (int qq = 0; qq < 4; ++qq) best[qq] = max(max(key[qq][0], key[qq][1]), max(key[qq][2], key[qq][3]));
#pragma unroll
                    for (int o = 1; o < 64; o <<= 1) {
#pragma unroll
                        for (int qq = 0; qq < 4; ++qq) best[qq] = max(best[qq], (unsigned)__shfl_xor((int)best[qq], o));
                    }
#pragma unroll
                    for (int qq = 0; qq < 4; ++qq) {
                        const int blk = 255 - (int)(best[qq] & 255u);
#pragma unroll
                        for (int j = 0; j < 4; ++j) if (lane + 64 * j == blk) key[qq][j] = 0u;
                        if (lane == 0) sel[(q0 + qq) * 16 + n] = blk;
                    }
                }
            }
        }
        wave_lds_sync();
    }
    float* acc = wl;
    {
#pragma unroll
        for (int h = 0; h < 4; ++h) { const float gs = sigmoidf_(GROWF(h));
#pragma unroll
            for (int dt = 0; dt < 4; ++dt) *(f32x4*)(acc + (qi * 4 + h) * 64 + 16 * dt + 4 * grp) = st[h].o[dt] * gs; }
        wave_lds_sync();
    }
    {
        const bf16* KF = p.KWF + (size_t)g * T * 64; const bf16* VF = p.VWF + (size_t)g * T * 64;
        int kstart = t0 - 512; if (kstart < 0) kstart = 0; kstart &= ~31;
        const int nsteps = (t0 + 16 - kstart + 31) >> 5;
#pragma unroll
        for (int h = 0; h < 4; ++h) attw_init(st[h]);
        auto issue = [&](int s_, bf16x8 (&K)[2][2], bf16x8 (&V)[4]) {
            const int k0 = kstart + 32 * s_;
#pragma unroll
            for (int tl = 0; tl < 2; ++tl)
#pragma unroll
                for (int ks = 0; ks < 2; ++ks) K[tl][ks] = *(const bf16x8*)(KF + kfrag_off((k0 >> 4) + tl, ks, lane));
#pragma unroll
            for (int dt = 0; dt < 4; ++dt) V[dt] = *(const bf16x8*)(VF + vfrag_off(k0 >> 5, dt, lane));
        };
        auto compute = [&](int s_, const bf16x8 (&K)[2][2], const bf16x8 (&V)[4]) {
            const int k0 = kstart + 32 * s_;
            const bool need_mask = (k0 + 31 > t0) || (k0 < t0 + 15 - 512);
            const int pb = k0 + 4 * grp;
#pragma unroll
            for (int h = 0; h < 4; ++h) {
                f32x4 s0, s1; qk_step(K, qf[h], s0, s1);
                if (need_mask) {
#pragma unroll
                    for (int i = 0; i < 4; ++i) { const int p0 = pb + i, p1 = pb + 16 + i;
                        if (p0 > t || p0 < t - 512) s0[i] = -INFINITY; if (p1 > t || p1 < t - 512) s1[i] = -INFINITY; }
                }
                att_update(st[h], s0, s1, V);
            }
        };
        bf16x8 kA[2][2], vA[4], kB[2][2], vB[4];
        issue(0, kA, vA);
        for (int s = 0; s < nsteps; s += 2) {
            if (s + 1 < nsteps) issue(s + 1, kB, vB);
            compute(s, kA, vA);
            if (s + 1 < nsteps) { if (s + 2 < nsteps) issue(s + 2, kA, vA); compute(s + 1, kB, vB); }
        }
#pragma unroll
        for (int h = 0; h < 4; ++h) { const float lt = grp_sum(st[h].l); const float gs = sigmoidf_(GROWF(16 + h)) * (lt > 0.f ? 1.f / lt : 0.f);
#pragma unroll
            for (int dt = 0; dt < 4; ++dt) { f32x4* a = (f32x4*)(acc + (qi * 4 + h) * 64 + 16 * dt + 4 * grp); *a = *a + st[h].o[dt] * gs; } }
        wave_lds_sync();
    }
    *(int4*)(p.SEL + ((size_t)g * T + t0) * 16 + lane * 4) = *(const int4*)(sel + lane * 4);
#pragma unroll 4
    for (int q = 0; q < 16; ++q) *(f32x4*)(p.NSACC + (size_t)(t0 + q) * 512 + g * 256 + 4 * lane) = *(const f32x4*)(acc + q * 256 + 4 * lane);
    wave_lds_sync();
}

__device__ __forceinline__ void nsa_slc_item(const KP& p, int tq, int g, int lane) {
    asm volatile("" : "+v"(lane));
    const int l15 = lane & 15, grp = lane >> 4, hn = lane & 3;
    const bf16* KF = p.KSF + (size_t)g * T * 64; const bf16* VF = p.VSF + (size_t)g * T * 64;
    const int* selp = p.SEL + ((size_t)g * T + tq) * 16;
    int sb[16];
#pragma unroll
    for (int i = 0; i < 16; ++i) sb[i] = __builtin_amdgcn_readfirstlane(selp[i]);
    bf16x8 qs[2];
#pragma unroll
    for (int ks = 0; ks < 2; ++ks) qs[ks] = *(const bf16x8*)(p.QB + (size_t)tq * 512 + (g * 4 + hn) * 64 + 32 * ks + 8 * grp);
    AttW a; attw_init(a);
    bf16x8 kf[2][2][2], vf[2][4];
    auto issue = [&](int i, int buf) {
        const int blk = sb[i >> 1]; int k0 = blk * 64 + 32 * (i & 1); if (blk < 0 || k0 > tq) k0 = 0;
#pragma unroll
        for (int tl = 0; tl < 2; ++tl)
#pragma unroll
            for (int ks = 0; ks < 2; ++ks) kf[buf][tl][ks] = *(const bf16x8*)(KF + kfrag_off((k0 >> 4) + tl, ks, lane));
#pragma unroll
        for (int dt = 0; dt < 4; ++dt) vf[buf][dt] = *(const bf16x8*)(VF + vfrag_off(k0 >> 5, dt, lane));
    };
    issue(0, 0);
#pragma unroll
    for (int i = 0; i < 32; ++i) {
        const int buf = i & 1;
        if (i + 1 < 32) issue(i + 1, buf ^ 1);
        const int blk = sb[i >> 1]; const int k0 = blk * 64 + 32 * (i & 1);
        const bool dead = (blk < 0) || (k0 > tq);
        f32x4 s0, s1; qk_step(kf[buf], qs, s0, s1);
        const int pb = k0 + 4 * grp;
#pragma unroll
        for (int j = 0; j < 4; ++j) { if (dead || pb + j > tq) s0[j] = -INFINITY; if (dead || pb + 16 + j > tq) s1[j] = -INFINITY; }
        att_update(a, s0, s1, vf[buf]);
    }
    const float lt = grp_sum(a.l);
    if (l15 < 4) {
        const float gs = sigmoidf_(p.BIGF[(size_t)tq * PA + C_GATE + 8 + g * 4 + l15]) * (lt > 0.f ? 1.f / lt : 0.f);
#pragma unroll
        for (int dt = 0; dt < 4; ++dt) {
            const size_t o = (size_t)tq * 512 + g * 256 + l15 * 64 + 16 * dt + 4 * grp;
            const f32x4 base = *(const f32x4*)(p.NSACC + o); const f32x4 v = base + a.o[dt] * gs;
            uint2 w; w.x = pk2(v[0], v[1]); w.y = pk2(v[2], v[3]);
            *(uint2*)(p.MIXB + (size_t)tq * 1024 + g * 256 + l15 * 64 + 16 * dt + 4 * grp) = w;
        }
    }
}

__device__ __forceinline__ void ph_compress(const KP& p, const Fr& F) {
    float* flat = (float*)F.lds;
    float* hid = (float*)(F.lds + 32768);
    float* res = (float*)(F.lds + 32768 + 2048);
    const float* H0 = p.BIGF;
    const int tid = F.tid;
    for (int item = F.bid; item < 512; item += F.G) {
        const int c = item & 511, s = item >> 9;
        for (int e = tid; e < 8192; e += NTHR) {
            const int kv = e >> 12, g = (e >> 11) & 1, k = e & 2047, i = k >> 6, d = k & 63;
            const int row = c * 32 + i;
            float v;
            if (s == 0) v = H0[(size_t)row * PA + C_KC + kv * 128 + g * 64 + d];
            else { const int b = s - 1; const int page = p.page_table[b * NPAGES + (row >> 7)];
                   v = p.cache_cmp[((((size_t)page * 128 + (row & 127)) * 2 + kv) * 2 + g) * 64 + d]; }
            flat[e] = v + p.cpe[(kv * 32 + i) * 64 + d];
        }
        __syncthreads();
        {
            const int kv = tid >> 8, g = (tid >> 7) & 1, j = tid & 127;
            const float* w = p.cw1 + (size_t)kv * 2048 * 128 + j;
            const float* fl = flat + (kv * 2 + g) * 2048;
            float acc = p.cb1[kv * 128 + j];
            for (int k = 0; k < 2048; ++k) acc += fl[k] * w[(size_t)k * 128];
            hid[(kv * 2 + g) * 128 + j] = gelu_tanh(acc);
        }
        __syncthreads();
        if (tid < 256) {
            const int kv = tid >> 7, g = (tid >> 6) & 1, d = tid & 63;
            const float* w = p.cw2 + (size_t)kv * 128 * 64 + d;
            const float* hh = hid + (kv * 2 + g) * 128;
            float acc = 0.f;
            for (int j = 0; j < 128; ++j) acc += hh[j] * w[j * 64];
            res[(kv * 2 + g) * 64 + d] = acc;
        }
        __syncthreads();
        if (tid < 256) {
            const int kv = tid >> 7, g = (tid >> 6) & 1, d = tid & 63;
            const float* rr = res + (kv * 2 + g) * 64;
            float v = rr[d];
            if (kv == 0) {
                const int pos = (c + 1) * 32 - 1; const float2 cs = p.ROPE[pos * 32 + (d & 31)];
                const float x1 = rr[d & 31], x2 = rr[(d & 31) + 32];
                v = (d < 32) ? (x1 * cs.x - x2 * cs.y) : (x2 * cs.x + x1 * cs.y);
                p.CK[(((size_t)s * 512 + c) * 2 + g) * 64 + d] = v;
                if (s == 0) p.CKF[(size_t)g * 512 * 64 + kfrag_elem(c, d)] = (bf16)f2bf(v);
            } else { p.CV[(((size_t)s * 512 + c) * 2 + g) * 64 + d] = v; if (s == 0) p.CVF[(size_t)g * 512 * 64 + vfrag_elem(c, d)] = (bf16)f2bf(v); }
        }
        __syncthreads();
    }
}

__device__ __forceinline__ void ph_gdn_prep(const KP& p, const Fr& F) {
    const float* H0 = p.BIGF; const int lane = F.lane;
    for (int item = T * 8 + F.gw; item < TS * 8; item += F.NGW) {
        const int r = item >> 3, h = item & 7;
        const bool smp = r >= T; const int b = r - T;
        float cv[3];
#pragma unroll
        for (int part = 0; part < 3; ++part) {
            const int ch = part * 512 + h * 64 + lane;
            float acc = 0.f;
#pragma unroll
            for (int j = 0; j < 4; ++j) {
                float u;
                if (!smp) { const int t = r + j - 3; u = (t >= 0) ? H0[(size_t)t * PA + C_GQKV + ch] : 0.f; }
                else { u = (j < 3) ? p.st_gconv[((size_t)b * 3 + j) * 1536 + ch] : H0[(size_t)r * PA + C_GQKV + ch]; }
                acc += p.gconv_w[j * 1536 + ch] * u;
            }
            cv[part] = siluf_(acc);
        }
        const float qn = wave_sum(cv[0] * cv[0]), kn = wave_sum(cv[1] * cv[1]);
        const size_t o = ((size_t)r * 8 + h) * 64 + lane;
        p.GQ[o] = cv[0] * rsqrtf(qn + NORM_EPS) * 0.125f;
        p.GK[o] = cv[1] * rsqrtf(kn + NORM_EPS);
        p.GV[o] = cv[2];
        if (lane == 0) {
            const float av = H0[(size_t)r * PA + C_A + h], bt = H0[(size_t)r * PA + C_BT + h];
            p.Gg[(size_t)r * 8 + h] = -expf(p.gA[h]) * softplusf_(av + p.gdt[h]);
            p.Gb[(size_t)r * 8 + h] = sigmoidf_(bt);
        }
    }
    const size_t gt = (size_t)F.bid * NTHR + F.tid, GT = (size_t)F.G * NTHR;
    for (size_t idx = gt; idx < (size_t)3 * 1536; idx += GT) {
        const int j = (int)(idx / 1536), ch = (int)(idx % 1536);
        p.out[O_GCONV_P + idx] = h0f(p, T - 3 + j, C_GQKV + ch);
    }
    for (size_t idx = gt; idx < (size_t)NSMP * 3 * 1536; idx += GT) {
        const int b = (int)(idx / (3 * 1536)), j = (int)((idx / 1536) % 3), ch = (int)(idx % 1536);
        p.out[O_GCONV_S + idx] = (j < 2) ? p.st_gconv[((size_t)b * 3 + j + 1) * 1536 + ch] : H0[(size_t)(T + b) * PA + C_GQKV + ch];
    }
}

template <int NH, class KF>
__device__ __forceinline__ void wave_attend(const float* qs, float* sc, int scstride, int nkeys, KF kf, float (&outv)[NH], float (&den)[NH], int lane, float* mxout = nullptr) {
    float mx[NH];
#pragma unroll
    for (int h = 0; h < NH; ++h) mx[h] = -INFINITY;
    for (int j = lane; j < nkeys; j += 64) {
        const float *kp, *vp; const bool ok = kf(j, kp, vp);
        float s[NH];
#pragma unroll
        for (int h = 0; h < NH; ++h) s[h] = 0.f;
        if (ok) {
            for (int d4 = 0; d4 < 16; ++d4) {
                const float4 kvv = ((const float4*)kp)[d4];
#pragma unroll
                for (int h = 0; h < NH; ++h) { const float* q = qs + h * 64 + d4 * 4; s[h] += kvv.x * q[0] + kvv.y * q[1] + kvv.z * q[2] + kvv.w * q[3]; }
            }
        }
#pragma unroll
        for (int h = 0; h < NH; ++h) { const float v = ok ? s[h] * 0.125f : -INFINITY; sc[h * scstride + j] = v; mx[h] = fmaxf(mx[h], v); }
    }
#pragma unroll
    for (int h = 0; h < NH; ++h) { mx[h] = wave_max(mx[h]); if (!(mx[h] > -INFINITY)) mx[h] = 0.f; if (mxout) mxout[h] = mx[h]; }
    float sm[NH];
#pragma unroll
    for (int h = 0; h < NH; ++h) sm[h] = 0.f;
    for (int j = lane; j < nkeys; j += 64) {
#pragma unroll
        for (int h = 0; h < NH; ++h) { const float v = sc[h * scstride + j]; const float pp = (v == -INFINITY) ? 0.f : expf(v - mx[h]); sc[h * scstride + j] = pp; sm[h] += pp; }
    }
#pragma unroll
    for (int h = 0; h < NH; ++h) { sm[h] = wave_sum(sm[h]); den[h] = sm[h] > 0.f ? sm[h] : 1.f; }
    wave_lds_sync();
    {
        const int kq = lane >> 4, d4 = lane & 15;
        float4 acc[NH];
#pragma unroll
        for (int h = 0; h < NH; ++h) acc[h] = make_float4(0.f, 0.f, 0.f, 0.f);
        for (int j0 = 0; j0 < nkeys; j0 += 32) {
            float4 v[8];
#pragma unroll
            for (int u = 0; u < 8; ++u) { const int j = j0 + 4 * u + kq; const float *kp, *vp; const bool ok = (j < nkeys) && kf(j, kp, vp);
                v[u] = ok ? *(const float4*)(vp + 4 * d4) : make_float4(0.f, 0.f, 0.f, 0.f); }
#pragma unroll
            for (int u = 0; u < 8; ++u) { const int j = j0 + 4 * u + kq;
#pragma unroll
                for (int h = 0; h < NH; ++h) { const float pp = (j < nkeys) ? sc[h * scstride + j] : 0.f;
                    acc[h].x += pp * v[u].x; acc[h].y += pp * v[u].y; acc[h].z += pp * v[u].z; acc[h].w += pp * v[u].w; } }
        }
#pragma unroll
        for (int h = 0; h < NH; ++h) {
            float4 a = acc[h];
            a.x += __shfl_xor(a.x, 16); a.y += __shfl_xor(a.y, 16); a.z += __shfl_xor(a.z, 16); a.w += __shfl_xor(a.w, 16);
            a.x += __shfl_xor(a.x, 32); a.y += __shfl_xor(a.y, 32); a.z += __shfl_xor(a.z, 32); a.w += __shfl_xor(a.w, 32);
            const float x0 = __shfl(a.x, lane >> 2), x1 = __shfl(a.y, lane >> 2), x2 = __shfl(a.z, lane >> 2), x3 = __shfl(a.w, lane >> 2);
            const int cc = lane & 3; outv[h] = cc == 0 ? x0 : (cc == 1 ? x1 : (cc == 2 ? x2 : x3));
        }
    }
#pragma unroll
    for (int h = 0; h < NH; ++h) outv[h] /= den[h];
    wave_lds_sync();
}

__device__ __forceinline__ void nsa_smp_cs(const KP& p, int b, int g, float* wl, int lane) {
    float* qs = wl; float* sc = wl + 256; float* imp = wl + 256 + 4 * 1088; int* sel = (int*)(wl + 256 + 4 * 1088 + 320); long long* bb = (long long*)(wl + 256 + 4 * 1088 + 320 + 16);
    const int r = T + b; const int qpos = T;
    const float* grow = p.BIGF + (size_t)r * PA + C_GATE;
#pragma unroll
    for (int h = 0; h < 4; ++h) qs[h * 64 + lane] = p.QR[(size_t)r * 512 + (g * 4 + h) * 64 + lane];
    wave_lds_sync();
    float ocmp[4], oslc[4], den[4];
    {
        const float* CKp = p.CK + (size_t)(1 + b) * 512 * 128; const float* CVp = p.CV + (size_t)(1 + b) * 512 * 128;
        auto kf = [&](int j, const float*& kp, const float*& vp) -> bool { kp = CKp + (j * 2 + g) * 64; vp = CVp + (j * 2 + g) * 64; return true; };
        wave_attend<4>(qs, sc, 1088, 512, kf, ocmp, den, lane);
        for (int blk = lane; blk < 320; blk += 64) {
            float v = 0.f;
            if (blk < 256) {
#pragma unroll
                for (int h = 0; h < 4; ++h) v += (sc[h * 1088 + 2 * blk] + sc[h * 1088 + 2 * blk + 1]) / den[h];
            }
            imp[blk] = v;
        }
        wave_lds_sync();
    }
    {
        const int cur = qpos >> 6;
        float val[5];
#pragma unroll
        for (int j = 0; j < 5; ++j) { const int blk = lane + 64 * j; val[j] = (blk >= 1 && blk <= cur - 2) ? imp[blk] : -1.f; }
        if (lane == 0) { sel[0] = 0; sel[1] = cur; sel[2] = cur - 1; }
        for (int n = 3; n < 16; ++n) {
            float bv = -2.f; int bi = 0x7fffffff;
#pragma unroll
            for (int j = 0; j < 5; ++j) if (val[j] > bv) { bv = val[j]; bi = lane + 64 * j; }
#pragma unroll
            for (int o = 1; o < 64; o <<= 1) { const float ov = __shfl_xor(bv, o); const int oi = __shfl_xor(bi, o); if (ov > bv || (ov == bv && oi < bi)) { bv = ov; bi = oi; } }
#pragma unroll
            for (int j = 0; j < 5; ++j) if (lane + 64 * j == bi) val[j] = -3.f;
            if (lane == 0) sel[n] = bi;
        }
        wave_lds_sync();
        if (lane < 16) { const int blk = sel[lane]; long long o = 0;
            if (blk < 256) { const int page = p.page_table[b * NPAGES + (blk >> 1)]; o = ((long long)page * 128 + (blk & 1) * 64) * 256; }
            bb[lane] = o; }
        wave_lds_sync();
    }
    {
        auto kf = [&](int j, const float*& kp, const float*& vp) -> bool {
            const int blk = sel[j >> 6]; const int pos = blk * 64 + (j & 63); if (pos > qpos) return false;
            if (pos == T) { kp = p.KS + (size_t)r * 128 + g * 64; vp = p.VS + (size_t)r * 128 + g * 64; return true; }
            const float* base = p.cache_slc + bb[j >> 6] + (j & 63) * 256;
            kp = base + g * 64; vp = base + 128 + g * 64; return true; };
        wave_attend<4>(qs, sc, 1088, 1024, kf, oslc, den, lane);
    }
#pragma unroll
    for (int h = 0; h < 4; ++h) {
        const int hh = g * 4 + h;
        p.SMIXF[((size_t)b * 3 + 0) * 512 + hh * 64 + lane] = sigmoidf_(grow[hh]) * ocmp[h];
        p.SMIXF[((size_t)b * 3 + 1) * 512 + hh * 64 + lane] = sigmoidf_(grow[8 + hh]) * oslc[h];
    }
    wave_lds_sync();
}
__device__ __forceinline__ void nsa_smp_win(const KP& p, int b, int g, float* wl, int lane) {
    float* qs = wl; float* sc = wl + 256;
    const int r = T + b;
    const float* grow = p.BIGF + (size_t)r * PA + C_GATE;
#pragma unroll
    for (int h = 0; h < 4; ++h) qs[h * 64 + lane] = p.QR[(size_t)r * 512 + (g * 4 + h) * 64 + lane];
    wave_lds_sync();
    float owin[4], den[4];
    auto kf = [&](int j, const float*& kp, const float*& vp) -> bool {
        if (j == 512) { kp = p.KW + (size_t)r * 128 + g * 64; vp = p.VW + (size_t)r * 128 + g * 64; return true; }
        const float* base = p.st_win + ((size_t)b * 512 + j) * 256;
        kp = base + g * 64; vp = base + 128 + g * 64; return true; };
    wave_attend<4>(qs, sc, 528, 513, kf, owin, den, lane);
#pragma unroll
    for (int h = 0; h < 4; ++h) { const int hh = g * 4 + h; p.SMIXF[((size_t)b * 3 + 2) * 512 + hh * 64 + lane] = sigmoidf_(grow[16 + hh]) * owin[h]; }
    wave_lds_sync();
}

__device__ __forceinline__ void gdn_scan_item(const KP& p, int item, float* wl, int lane) {
    asm volatile("" : "+v"(lane));
    float* kq = wl;
    const int b = (item >> 3) - 1, h = item & 7;
    const int r = T + b; const size_t o = ((size_t)r * 8 + h) * 64;
    kq[lane] = p.GK[o + lane]; kq[64 + lane] = p.GQ[o + lane];
    wave_lds_sync();
    const float dec = expf(p.Gg[(size_t)r * 8 + h]), bt = p.Gb[(size_t)r * 8 + h];
    const float* Sp = p.st_gS + ((size_t)b * 8 + h) * 4096 + lane;
    float* so = p.out + O_GS_S + ((size_t)b * 8 + h) * 4096 + lane;
    float S[64]; float kv = 0.f;
#pragma unroll
    for (int i = 0; i < 64; ++i) { S[i] = Sp[i * 64] * dec; kv += kq[i] * S[i]; }
    const float vn = (p.GV[o + lane] - kv) * bt;
    float ov = 0.f;
#pragma unroll
    for (int i = 0; i < 64; ++i) { const float sn = S[i] + kq[i] * vn; ov += kq[64 + i] * sn; so[i * 64] = sn; }
    p.OG[o + lane] = ov;
    wave_lds_sync();
}

constexpr int GDN_WL = 34816;
__device__ __forceinline__ int kperm(int ks, int grp, int j) { return 32 * ks + 16 * (j >> 2) + 4 * grp + (j & 3); }

__device__ __forceinline__ void gdn_chunk_unit(const KP& p, int unit, unsigned char* ldsb, int woff, int lane) {
    asm volatile("" : "+v"(lane), "+s"(woff));
    unsigned char* wlb = ldsb + woff;
    const int n = unit >> 3, h = unit & 7, t0 = 64 * n;
    const int l15 = lane & 15, grp = lane >> 4;
    float* Af = (float*)wlb; bf16* kt = (bf16*)(wlb + 16384); bf16* qt = kt + 64 * 72; bf16* tmp = (bf16*)wlb;
    {
        const float* H0 = p.BIGF;
        float w[3][4], u1[3], u2[3], u3[3];
#pragma unroll
        for (int part = 0; part < 3; ++part) {
            const int ch = part * 512 + h * 64 + lane;
#pragma unroll
            for (int j = 0; j < 4; ++j) w[part][j] = p.gconv_w[j * 1536 + ch];
            u1[part] = (t0 >= 1) ? h0f(p, t0 - 1, C_GQKV + ch) : 0.f;
            u2[part] = (t0 >= 2) ? h0f(p, t0 - 2, C_GQKV + ch) : 0.f;
            u3[part] = (t0 >= 3) ? h0f(p, t0 - 3, C_GQKV + ch) : 0.f;
        }
        int roff = 0;
#pragma unroll 4
        for (int i = 0; i < 64; ++i) {
            float cv[3];
#pragma unroll
            for (int part = 0; part < 3; ++part) {
                const float u0 = __uint_as_float((unsigned)p.H0B[(size_t)t0 * PAP + C_GQKV + part * 512 + h * 64 + lane + roff] << 16);
                cv[part] = siluf_(w[part][0] * u3[part] + w[part][1] * u2[part] + w[part][2] * u1[part] + w[part][3] * u0);
                u3[part] = u2[part]; u2[part] = u1[part]; u1[part] = u0;
            }
            roff += PAP; asm volatile("" : "+s"(roff));
            const float qn = wave_sum(cv[0] * cv[0]), kn = wave_sum(cv[1] * cv[1]);
            qt[i * 72 + lane] = (bf16)f2bf(cv[0] * rsqrtf(qn + NORM_EPS) * 0.125f);
            kt[i * 72 + lane] = (bf16)f2bf(cv[1] * rsqrtf(kn + NORM_EPS));
            p.GV[((size_t)(t0 + i) * 8 + h) * 64 + lane] = cv[2];
        }
    }
    const float gl_ = -fexp_(p.gA[h]) * softplusf_(h0f(p, t0 + lane, C_A + h) + p.gdt[h]);
    const float beta = sigmoidf_(h0f(p, t0 + lane, C_BT + h));
    float gc = gl_;
#pragma unroll
    for (int o = 1; o < 64; o <<= 1) { const float tv = __shfl_up(gc, o); if (lane >= o) gc += tv; }
    const float gclast = __shfl(gc, 63);
#define GPAD(i) ((float*)(kt + (i) * 72 + 64))
    { float* pd = GPAD(lane); pd[0] = gc; pd[1] = beta; pd[2] = fexp_(gc); pd[3] = fexp_(gclast - gc); }
    wave_lds_sync();
    bf16* QKF = p.G_QKF + (size_t)unit * 4096;
#pragma unroll
    for (int it = 0; it < 4; ++it) {
        const int i = 16 * it + l15;
        const float gci = GPAD(i)[0], bi = GPAD(i)[1];
        bf16x8 bk[2], bq[2];
#pragma unroll
        for (int ks = 0; ks < 2; ++ks) { bk[ks] = *(const bf16x8*)(kt + i * 72 + 32 * ks + 8 * grp); bq[ks] = *(const bf16x8*)(qt + i * 72 + 32 * ks + 8 * grp); }
#pragma unroll
        for (int jt = 0; jt < 4; ++jt) {
            uint2 qkp = make_uint2(0u, 0u);
            if (jt <= it) {
                bf16x8 ak[2];
#pragma unroll
                for (int ks = 0; ks < 2; ++ks) ak[ks] = *(const bf16x8*)(kt + (16 * jt + l15) * 72 + 32 * ks + 8 * grp);
                f32x4 aa = {0.f, 0.f, 0.f, 0.f}, aq = {0.f, 0.f, 0.f, 0.f};
                aa = MFMA16(ak[0], bk[0], aa); aa = MFMA16(ak[1], bk[1], aa);
                aq = MFMA16(ak[0], bq[0], aq); aq = MFMA16(ak[1], bq[1], aq);
                f32x4 av, qv;
#pragma unroll
                for (int r = 0; r < 4; ++r) {
                    const int j = 16 * jt + 4 * grp + r; const float gcj = GPAD(j)[0];
                    const float e = (j <= i) ? fexp_(gci - gcj) : 0.f;
                    av[r] = (j < i) ? bi * aa[r] * e : 0.f; qv[r] = aq[r] * e;
                }
                *(f32x4*)(Af + i * 64 + 16 * jt + 4 * grp) = av;
                qkp.x = pk2(qv[0], qv[1]); qkp.y = pk2(qv[2], qv[3]);
            }
            *(uint2*)(QKF + ((size_t)(it * 2 + (jt >> 1)) * 64 + lane) * 8 + (jt & 1) * 4) = qkp;
        }
    }
    wave_lds_sync();
    {
        float* UF = p.G_UF + (size_t)unit * 4096;
        const int vq = lane >> 4;
#pragma unroll
        for (int pass = 0; pass < 2; ++pass) {
            float x[64];
            int goff = 0;
#pragma unroll
            for (int i = 0; i < 64; ++i) {
                const float bi = GPAD(i)[1];
                float acc;
                if (pass == 0) { acc = p.GV[((size_t)t0 * 8 + h) * 64 + lane + goff] * bi; goff += 512; asm volatile("" : "+s"(goff)); }
                else { const float ei = GPAD(i)[2];
                       acc = __uint_as_float((unsigned)kt[i * 72 + lane] << 16) * bi * ei; }
#pragma unroll
                for (int jj = 0; jj < (i + 3) / 4; ++jj) {
                    const float4 a4 = *(const float4*)(Af + i * 64 + 4 * jj);
                    acc -= a4.x * x[4 * jj + 0];
                    if (4 * jj + 1 < i) acc -= a4.y * x[4 * jj + 1];
                    if (4 * jj + 2 < i) acc -= a4.z * x[4 * jj + 2];
                    if (4 * jj + 3 < i) acc -= a4.w * x[4 * jj + 3];
                }
                x[i] = acc;
                if ((i & 3) == 3) asm volatile("" ::: "memory");
            }
            if (pass == 0) {
#pragma unroll
                for (int c4 = 0; c4 < 16; ++c4) {
                    const int mt = c4 >> 2, lp = l15 + 16 * (c4 & 3);
                    *(f32x4*)(UF + ((size_t)(vq * 4 + mt) * 64 + lp) * 4) = (f32x4){x[4 * c4], x[4 * c4 + 1], x[4 * c4 + 2], x[4 * c4 + 3]};
                }
            } else {
                wave_lds_sync();
#pragma unroll
                for (int c = 0; c < 64; ++c) tmp[c * 72 + lane] = (bf16)f2bf(-x[c]);
            }
            asm volatile("" ::: "memory");
        }
    }
    wave_lds_sync();
    {
        bf16* WF = p.G_WF + (size_t)unit * 4096; bf16* QGF = p.G_QGF + (size_t)unit * 4096; bf16* KDF = p.G_KDF + (size_t)unit * 4096;
#pragma unroll
        for (int mt = 0; mt < 4; ++mt) {
            const float egc = GPAD(16 * mt + l15)[2];
#pragma unroll
            for (int ks = 0; ks < 2; ++ks) {
                const int c = 16 * mt + l15, k0 = 32 * ks + 4 * grp;
                const uint2 w0 = *(const uint2*)(tmp + c * 72 + k0), w1 = *(const uint2*)(tmp + c * 72 + k0 + 16);
                v4u wv; wv.x = w0.x; wv.y = w0.y; wv.z = w1.x; wv.w = w1.y;
                *(v4u*)(WF + ((size_t)(mt * 2 + ks) * 64 + lane) * 8) = wv;
                const uint2 q0 = *(const uint2*)(qt + c * 72 + k0), q1 = *(const uint2*)(qt + c * 72 + k0 + 16);
                v4u qv;
                qv.x = pk2(__uint_as_float(q0.x << 16) * egc, __uint_as_float(q0.x & 0xffff0000u) * egc); qv.y = pk2(__uint_as_float(q0.y << 16) * egc, __uint_as_float(q0.y & 0xffff0000u) * egc);
                qv.z = pk2(__uint_as_float(q1.x << 16) * egc, __uint_as_float(q1.x & 0xffff0000u) * egc); qv.w = pk2(__uint_as_float(q1.y << 16) * egc, __uint_as_float(q1.y & 0xffff0000u) * egc);
                *(v4u*)(QGF + ((size_t)(mt * 2 + ks) * 64 + lane) * 8) = qv;
                float kd[8];
#pragma unroll
                for (int j = 0; j < 8; ++j) { const int cc = kperm(ks, grp, j); kd[j] = __uint_as_float((unsigned)kt[cc * 72 + 16 * mt + l15] << 16) * GPAD(cc)[3]; }
                v4u kv; kv.x = pk2(kd[0], kd[1]); kv.y = pk2(kd[2], kd[3]); kv.z = pk2(kd[4], kd[5]); kv.w = pk2(kd[6], kd[7]);
                *(v4u*)(KDF + ((size_t)(mt * 2 + ks) * 64 + lane) * 8) = kv;
            }
        }
        if (lane == 0) p.G_GL[unit] = fexp_(gclast);
    }
    wave_lds_sync();
#undef GPAD
}

constexpr int CH_SLOT = 32768;
__device__ __forceinline__ void gdn_chain_wg(const KP& p, int h, int wave, int lane, unsigned char* ldsb) {
    asm volatile("" : "+v"(lane));
    const int l15 = lane & 15, grp = lane >> 4;
    float* GLs = (float*)(ldsb + 4 * CH_SLOT);
    if (wave < 4) GLs[wave * 64 + lane] = p.G_GL[(size_t)(wave * 64 + lane) * 8 + h];
#define CH_BAR() do { asm volatile("s_waitcnt lgkmcnt(0)" ::: "memory"); __builtin_amdgcn_s_barrier(); asm volatile("" ::: "memory"); } while (0)
    if (wave >= 4) {
        const int lw = wave - 4;
        const unsigned char* gb = (lw == 0) ? (const unsigned char*)p.G_WF : (lw == 1) ? (const unsigned char*)p.G_KDF : (const unsigned char*)p.G_UF + (size_t)(lw - 2) * 8192;
        const size_t ustride = (lw < 2) ? 8192 : 16384;
        gb += (size_t)h * ustride + (size_t)lane * 16;
        auto src = [&](int n, int k) -> const v4u* { return (const v4u*)(gb + (size_t)n * 8 * ustride + k * 1024); };
        v4u rs[4][8];
#pragma unroll
        for (int j = 0; j < 4; ++j)
#pragma unroll
            for (int k = 0; k < 8; ++k) rs[j][k] = *src(j, k);
#pragma unroll
        for (int j = 0; j < 2; ++j) {
#pragma unroll
            for (int k = 0; k < 8; ++k) { *(v4u*)(ldsb + j * CH_SLOT + (lw * 512 + k * 64 + lane) * 16) = rs[j][k]; rs[j][k] = *src(4 + j, k); }
        }
        CH_BAR();
        for (int n0 = 0; n0 < 256; n0 += 4) {
#pragma unroll
            for (int j = 0; j < 4; ++j) {
                const int n = n0 + j, st = n + 2;
                if (st < 256) {
                    const int set = (j + 2) & 3;
#pragma unroll
                    for (int k = 0; k < 8; ++k) { *(v4u*)(ldsb + (st & 3) * CH_SLOT + (lw * 512 + k * 64 + lane) * 16) = rs[set][k]; if (st + 4 < 256) rs[set][k] = *src(st + 4, k); }
                }
                CH_BAR();
            }
        }
#undef CH_BAR
        return;
    }
    const int vq = wave;
    f32x4 S[4];
#pragma unroll
    for (int i = 0; i < 4; ++i) S[i] = (f32x4){0.f, 0.f, 0.f, 0.f};
    asm volatile("s_waitcnt lgkmcnt(0)" ::: "memory"); __builtin_amdgcn_s_barrier(); asm volatile("" ::: "memory");
    for (int n = 0; n < 256; ++n) {
        const unsigned char* sl = ldsb + (n & 3) * CH_SLOT;
        bf16x8 wf[4][2], kdf[4][2]; f32x4 uf[4];
#pragma unroll
        for (int mt = 0; mt < 4; ++mt) {
#pragma unroll
            for (int ks = 0; ks < 2; ++ks) { wf[mt][ks] = *(const bf16x8*)(sl + ((mt * 2 + ks) * 64 + lane) * 16); kdf[mt][ks] = *(const bf16x8*)(sl + 8192 + ((mt * 2 + ks) * 64 + lane) * 16); }
            uf[mt] = *(const f32x4*)(sl + 16384 + ((vq * 4 + mt) * 64 + lane) * 16);
        }
        const float gl = GLs[n];
        const size_t fo = ((size_t)((n * 8 + h) * 4 + vq) * 2) * 512;
        bf16x8 sB[2];
#pragma unroll
        for (int ks = 0; ks < 2; ++ks) { sB[ks] = pack_p(S[2 * ks], S[2 * ks + 1]); *(bf16x8*)(p.G_SPF + fo + ((size_t)ks * 64 + lane) * 8) = sB[ks]; }
        f32x4 v[4];
#pragma unroll
        for (int mt = 0; mt < 4; ++mt) { v[mt] = uf[mt]; v[mt] = MFMA16(wf[mt][0], sB[0], v[mt]); v[mt] = MFMA16(wf[mt][1], sB[1], v[mt]); }
        bf16x8 vB[2];
#pragma unroll
        for (int ks = 0; ks < 2; ++ks) { vB[ks] = pack_p(v[2 * ks], v[2 * ks + 1]); *(bf16x8*)(p.G_VNF + fo + ((size_t)ks * 64 + lane) * 8) = vB[ks]; }
#pragma unroll
        for (int mt = 0; mt < 4; ++mt) { S[mt] = S[mt] * gl; S[mt] = MFMA16(kdf[mt][0], vB[0], S[mt]); S[mt] = MFMA16(kdf[mt][1], vB[1], S[mt]); }
        asm volatile("s_waitcnt lgkmcnt(0)" ::: "memory"); __builtin_amdgcn_s_barrier(); asm volatile("" ::: "memory");
    }
    float* so = p.out + O_GS_P + (size_t)h * 4096;
#pragma unroll
    for (int mt = 0; mt < 4; ++mt)
#pragma unroll
        for (int r = 0; r < 4; ++r) so[(16 * mt + 4 * grp + r) * 64 + 16 * vq + l15] = S[mt][r];
}

__device__ __forceinline__ void gdn_out_unit(const KP& p, int unit, int lane) {
    asm volatile("" : "+v"(lane));
    const int n = unit >> 3, h = unit & 7, t0 = 64 * n; const int l15 = lane & 15, grp = lane >> 4;
    const bf16* QGF = p.G_QGF + (size_t)unit * 4096; const bf16* QKF = p.G_QKF + (size_t)unit * 4096;
    f32x4 o[4][4];
#pragma unroll
    for (int mt = 0; mt < 4; ++mt)
#pragma unroll
        for (int vq = 0; vq < 4; ++vq) o[mt][vq] = (f32x4){0.f, 0.f, 0.f, 0.f};
#pragma unroll
    for (int ks = 0; ks < 2; ++ks) {
        bf16x8 sp[4], vn[4];
#pragma unroll
        for (int vq = 0; vq < 4; ++vq) { const size_t fo = ((size_t)(unit * 4 + vq) * 2 + ks) * 512 + (size_t)lane * 8; sp[vq] = *(const bf16x8*)(p.G_SPF + fo); vn[vq] = *(const bf16x8*)(p.G_VNF + fo); }
#pragma unroll
        for (int mt = 0; mt < 4; ++mt) {
            const bf16x8 qg = *(const bf16x8*)(QGF + ((size_t)(mt * 2 + ks) * 64 + lane) * 8), qk = *(const bf16x8*)(QKF + ((size_t)(mt * 2 + ks) * 64 + lane) * 8);
#pragma unroll
            for (int vq = 0; vq < 4; ++vq) { o[mt][vq] = MFMA16(qg, sp[vq], o[mt][vq]); o[mt][vq] = MFMA16(qk, vn[vq], o[mt][vq]); }
        }
    }
    float nw[4];
#pragma unroll
    for (int vq = 0; vq < 4; ++vq) nw[vq] = p.gnw[16 * vq + l15];
#pragma unroll
    for (int mt = 0; mt < 4; ++mt)
#pragma unroll
        for (int r = 0; r < 4; ++r) {
            float ss = 0.f;
#pragma unroll
            for (int vq = 0; vq < 4; ++vq) ss += o[mt][vq][r] * o[mt][vq][r];
            ss += __shfl_xor(ss, 1); ss += __shfl_xor(ss, 2); ss += __shfl_xor(ss, 4); ss += __shfl_xor(ss, 8);
            const float rs = rsqrtf(ss * (1.f / 64.f) + NORM_EPS);
            const int t = t0 + 16 * mt + 4 * grp + r;
            const float* zr = p.ZF + (size_t)t * 512 + h * 64;
#pragma unroll
            for (int vq = 0; vq < 4; ++vq) p.MIXB[(size_t)t * 1024 + 512 + h * 64 + 16 * vq + l15] = (bf16)f2bf(o[mt][vq][r] * rs * nw[vq] * siluf_(zr[16 * vq + l15]));
        }
}

#define MFMA8(a, b, c) __builtin_amdgcn_mfma_f32_16x16x32_fp8_fp8((a), (b), (c), 0, 0, 0)
__device__ __forceinline__ long pack_fp8(const f32x4& a, const f32x4& b) {
    int w0 = 0, w1 = 0;
    w0 = __builtin_amdgcn_cvt_pk_fp8_f32(a[0], a[1], w0, false); w0 = __builtin_amdgcn_cvt_pk_fp8_f32(a[2], a[3], w0, true);
    w1 = __builtin_amdgcn_cvt_pk_fp8_f32(b[0], b[1], w1, false); w1 = __builtin_amdgcn_cvt_pk_fp8_f32(b[2], b[3], w1, true);
    return (long)(((unsigned long long)(unsigned)w1 << 32) | (unsigned long long)(unsigned)w0);
}
template <bool GEN>
__device__ __forceinline__ void nsa_slc_item8(const KP& p, int tq, int g, int lane) {
    asm volatile("" : "+v"(lane));
    const int l15 = lane & 15, grp = lane >> 4, hn = lane & 3;
    const unsigned char* KF = p.KS8 + (size_t)g * T * 64; const unsigned char* VF = p.VS8 + (size_t)g * T * 64;
    const int* selp = p.SEL + ((size_t)g * T + tq) * 16;
    int sb[16];
#pragma unroll
    for (int i = 0; i < 16; ++i) sb[i] = __builtin_amdgcn_readfirstlane(selp[i]);
    long qs[2];
#pragma unroll
    for (int ks = 0; ks < 2; ++ks) {
        const bf16x8 qb = *(const bf16x8*)(p.QB + (size_t)tq * 512 + (g * 4 + hn) * 64 + 32 * ks + 8 * grp);
        f32x4 a, b;
#pragma unroll
        for (int j = 0; j < 4; ++j) { a[j] = __uint_as_float((unsigned)(unsigned short)qb[j] << 16) * (1.f / QSCALE); b[j] = __uint_as_float((unsigned)(unsigned short)qb[4 + j] << 16) * (1.f / QSCALE); }
        qs[ks] = pack_fp8(a, b);
    }
    AttW a; attw_init(a);
    long kf[3][4][2], vf[3][2][4];
    auto issue = [&](int bi, int buf) {
        int blk = sb[bi]; if (GEN && (blk < 0 || blk * 64 > tq)) blk = 0;
        typedef long l2_t __attribute__((ext_vector_type(2)));
#pragma unroll
        for (int tl = 0; tl < 4; ++tl) { const l2_t x = *(const l2_t*)(KF + ((size_t)(blk * 4 + tl) * 64 + lane) * 16); kf[buf][tl][0] = x[0]; kf[buf][tl][1] = x[1]; }
#pragma unroll
        for (int dt = 0; dt < 4; ++dt) { const l2_t x = *(const l2_t*)(VF + ((size_t)(blk * 4 + dt) * 64 + lane) * 16); vf[buf][0][dt] = x[0]; vf[buf][1][dt] = x[1]; }
    };
    issue(0, 0); issue(1, 1);
#pragma unroll
    for (int bi = 0; bi < 16; ++bi) {
        const int buf = bi % 3;
        if (bi + 2 < 16) issue(bi + 2, (bi + 2) % 3);
        const int blk = sb[bi]; const int k0 = blk * 64;
        if (GEN && (blk < 0 || k0 > tq)) continue;
        const f32x4 z = {0.f, 0.f, 0.f, 0.f};
        f32x4 sc[4];
#pragma unroll
        for (int tl = 0; tl < 4; ++tl) { sc[tl] = MFMA8(kf[buf][tl][0], qs[0], z); sc[tl] = MFMA8(kf[buf][tl][1], qs[1], sc[tl]); }
        if (GEN ? (k0 + 63 > tq) : (bi == 1)) {
#pragma unroll
            for (int tl = 0; tl < 4; ++tl)
#pragma unroll
                for (int j = 0; j < 4; ++j) if (k0 + 16 * tl + 4 * grp + j > tq) sc[tl][j] = -INFINITY;
        }
        float mx = fmaxf(fmaxf(fmaxf(fmaxf(sc[0][0], sc[0][1]), fmaxf(sc[0][2], sc[0][3])), fmaxf(fmaxf(sc[1][0], sc[1][1]), fmaxf(sc[1][2], sc[1][3]))),
                         fmaxf(fmaxf(fmaxf(sc[2][0], sc[2][1]), fmaxf(sc[2][2], sc[2][3])), fmaxf(fmaxf(sc[3][0], sc[3][1]), fmaxf(sc[3][2], sc[3][3]))));
        mx = fmaxf(mx, __shfl_xor(mx, 16)); mx = fmaxf(mx, __shfl_xor(mx, 32));
        const float mn = fmaxf(a.m, mx * QSCALE);
        const float alpha = __builtin_amdgcn_exp2f(a.m - mn);
        const float mb = 7.f - mn;
        f32x4 pp[4]; float sum = 0.f;
#pragma unroll
        for (int tl = 0; tl < 4; ++tl) {
#pragma unroll
            for (int j = 0; j < 4; ++j) pp[tl][j] = __builtin_amdgcn_exp2f(fmaf(sc[tl][j], QSCALE, mb));
            sum += (pp[tl][0] + pp[tl][1]) + (pp[tl][2] + pp[tl][3]);
        }
        a.l = a.l * alpha + sum; a.m = mn;
        const long pf0 = pack_fp8(pp[0], pp[1]), pf1 = pack_fp8(pp[2], pp[3]);
#pragma unroll
        for (int dt = 0; dt < 4; ++dt) { a.o[dt] = a.o[dt] * alpha; a.o[dt] = MFMA8(vf[buf][0][dt], pf0, a.o[dt]); a.o[dt] = MFMA8(vf[buf][1][dt], pf1, a.o[dt]); }
    }
    const float lt = grp_sum(a.l);
    if (l15 < 4) {
        const float gs = sigmoidf_(h0f(p, tq, C_GATE + 8 + g * 4 + l15)) * (lt > 0.f ? 1.f / lt : 0.f);
#pragma unroll
        for (int dt = 0; dt < 4; ++dt) {
            const size_t o = (size_t)tq * 512 + g * 256 + l15 * 64 + 16 * dt + 4 * grp;
            const f32x4 base = *(const f32x4*)(p.NSACC + o); const f32x4 v = base + a.o[dt] * gs;
            uint2 w; w.x = pk2(v[0], v[1]); w.y = pk2(v[2], v[3]);
            *(uint2*)(p.MIXB + (size_t)tq * 1024 + g * 256 + l15 * 64 + 16 * dt + 4 * grp) = w;
        }
    }
}

__device__ __forceinline__ void ph_gdn_chunks(const KP& p, const Fr& F) {
    if (F.wave < 4) for (int unit = F.bid * 4 + F.wave; unit < 2048; unit += F.G * 4) gdn_chunk_unit(p, unit, F.lds, F.wave * GDN_WL, F.lane);
    else { const int unit = F.bid * 4 + (F.wave - 4); if (unit < 128) cmp_prompt_unit(p, unit, F.lane); }
}
__device__ __forceinline__ void ph_mix_a(const KP& p, const Fr& F) {
    if (F.bid < 32) gdn_scan_item(p, (F.bid + 1) * 8 + F.wave, (float*)(F.lds + 8 * FAST_WL + 1024 + F.wave * 512), F.lane);
    float* wl = (float*)(F.lds + F.wave * FAST_WL);
    for (int unit = F.gw; unit < 2048; unit += F.NGW) nsa_fast_unit(p, unit, wl, F.lane);
}
__device__ __forceinline__ void ph_mix_b(const KP& p, const Fr& F) {
    if (F.bid < 8) { gdn_chain_wg(p, F.bid, F.wave, F.lane, F.lds); return; }
    if (F.bid < 24) {
        const int it = (F.bid - 8) * 4 + (F.wave & 3);
        if (F.wave < 4) nsa_smp_cs(p, it >> 1, it & 1, (float*)(F.lds + F.wave * 20480), F.lane);
        else nsa_smp_win(p, it >> 1, it & 1, (float*)(F.lds + 81920 + (F.wave - 4) * 12288), F.lane);
        return;
    }
    const int g = F.bid & 1, fr = (F.bid - 24) >> 1, NW = ((F.G - 24) >> 1) * 8;
    for (int tq = fr * 8 + F.wave; tq < T; tq += NW) { if (tq >= 1024) nsa_slc_item8<false>(p, tq, g, F.lane); else nsa_slc_item8<true>(p, tq, g, F.lane); }
}

__device__ __forceinline__ void ph_gdn_out(const KP& p, const Fr& F) {
    const float* H0 = p.BIGF; const int lane = F.lane;
    for (int unit = F.gw; unit < 2048; unit += F.NGW) gdn_out_unit(p, unit, lane);
    for (int idx = F.bid * NTHR + F.tid; idx < NSMP * 512; idx += F.G * NTHR) { const int b = idx >> 9, c = idx & 511; const float* sp = p.SMIXF + (size_t)b * 3 * 512 + c;
        p.MIXB[(size_t)(T + b) * 1024 + c] = (bf16)f2bf(sp[0] + sp[512] + sp[1024]); }
    for (int item = T * 8 + F.gw; item < TS * 8; item += F.NGW) {
        const int r = item >> 3, h = item & 7;
        const float o = p.OG[((size_t)r * 8 + h) * 64 + lane];
        const float ms = wave_sum(o * o) * (1.f / 64.f);
        const float z = H0[(size_t)r * PA + C_Z + h * 64 + lane];
        p.MIXB[(size_t)r * 1024 + 512 + h * 64 + lane] = (bf16)f2bf(o * rsqrtf(ms + NORM_EPS) * p.gnw[lane] * siluf_(z));
    }
}

__device__ __forceinline__ void ph_ln(const Fr& F, const float* Xp, const float* Xs, const float* Fm, const float* gam, const float* bet, float* outp, float* outs, bf16* ob) {
    const int lane = F.lane;
    for (int r = F.gw; r < TS; r += F.NGW) {
        const float4* xr = (const float4*)((r < T) ? Xp + (size_t)r * DM : Xs + (size_t)(r - T) * DM) + lane; const float4* fr = (const float4*)(Fm + (size_t)r * DM) + lane;
        f32x4 v[4]; float s = 0.f;
#pragma unroll
        for (int j = 0; j < 4; ++j) { const float4 x = xr[64 * j], f = fr[64 * j]; v[j] = (f32x4){DN_ALPHA * x.x + f.x, DN_ALPHA * x.y + f.y, DN_ALPHA * x.z + f.z, DN_ALPHA * x.w + f.w}; s += (v[j][0] + v[j][1]) + (v[j][2] + v[j][3]); }
        const float mean = wave_sum(s) * (1.f / DM); float q = 0.f;
#pragma unroll
        for (int j = 0; j < 4; ++j) { v[j] = v[j] - mean; q += (v[j][0] * v[j][0] + v[j][1] * v[j][1]) + (v[j][2] * v[j][2] + v[j][3] * v[j][3]); }
        const float rstd = rsqrtf(wave_sum(q) * (1.f / DM) + LN_EPS);
        float4* o = (float4*)((r < T) ? outp + (size_t)r * DM : outs + (size_t)(r - T) * DM) + lane;
#pragma unroll
        for (int j = 0; j < 4; ++j) { const float4 g4 = ((const float4*)gam)[lane + 64 * j], b4 = ((const float4*)bet)[lane + 64 * j];
            const float4 y = make_float4(v[j][0] * rstd * g4.x + b4.x, v[j][1] * rstd * g4.y + b4.y, v[j][2] * rstd * g4.z + b4.z, v[j][3] * rstd * g4.w + b4.w);
            o[64 * j] = y; if (ob) { uint2 w; w.x = pk2(y.x, y.y); w.y = pk2(y.z, y.w); *((uint2*)(ob + (size_t)r * DM) + lane + 64 * j) = w; } }
    }
}

__device__ __forceinline__ void ph_ffn_act(const KP& p, const Fr& F, int layer) {
    const float* U = p.BIGF; const float* cw = p.ffn_cw + (size_t)layer * 3 * DFF2; const float* cb = p.ffn_cb + (size_t)layer * DFF2;
    const size_t gt = (size_t)F.bid * NTHR + F.tid, GT = (size_t)F.G * NTHR;
    const size_t total = (size_t)TS * DFF;
    for (size_t idx = gt; idx < total; idx += GT) {
        const int r = (int)(idx / DFF), j = (int)(idx % DFF);
        const bool smp = r >= T; const int b = r - T;
        float c2[2];
#pragma unroll
        for (int half = 0; half < 2; ++half) {
            const int ch = half * DFF + j;
            float acc = cb[ch];
#pragma unroll
            for (int k = 0; k < 3; ++k) {
                float u;
                if (!smp) { const int t = r + k - 2; u = (t >= 0) ? U[(size_t)t * DFF2 + ch] : 0.f; }
                else u = (k < 2) ? p.st_ffn[(((size_t)b * 2 + layer) * 2 + k) * DFF2 + ch] : U[(size_t)r * DFF2 + ch];
                acc += cw[k * DFF2 + ch] * u;
            }
            c2[half] = acc;
        }
        p.HFFB[idx] = (bf16)f2bf(siluf_(c2[0]) * c2[1]);
    }
    for (size_t idx = gt; idx < (size_t)2 * DFF2; idx += GT) {
        const int k = (int)(idx / DFF2), ch = (int)(idx % DFF2);
        p.out[O_FFN_P + ((size_t)layer * 2 + k) * DFF2 + ch] = U[(size_t)(T - 2 + k) * DFF2 + ch];
    }
    for (size_t idx = gt; idx < (size_t)NSMP * 2 * DFF2; idx += GT) {
        const int b = (int)(idx / (2 * DFF2)), k = (int)((idx / DFF2) % 2), ch = (int)(idx % DFF2);
        p.out[O_FFN_S + (((size_t)b * 2 + layer) * 2 + k) * DFF2 + ch] =
            (k == 0) ? p.st_ffn[(((size_t)b * 2 + layer) * 2 + 1) * DFF2 + ch] : U[(size_t)(T + b) * DFF2 + ch];
    }
}

__device__ __forceinline__ void ph_dil_prep(const KP& p, const Fr& F) {
    const float* H1 = p.BIGF;
    const size_t gt = (size_t)F.bid * NTHR + F.tid, GT = (size_t)F.G * NTHR;
    const size_t total = (size_t)TS * 2048;
    for (size_t idx = gt + (size_t)T * 2048; idx < total; idx += GT) {
        const int r = (int)(idx >> 11), c = (int)(idx & 2047);
        const bool smp = r >= T; const int pos = smp ? T : r;
        const float* row = H1 + (size_t)r * 3072;
        const int i = c & 63; const float2 cs = p.ROPE[pos * 32 + (i & 31)];
        const float v = rope_val(row, c & ~63, i, cs);
        if (c < 1024) p.QD[(size_t)r * 1024 + c] = v; else p.KD[(size_t)r * 1024 + (c - 1024)] = v;
    }
}
__device__ __forceinline__ void ph_dil_cache(const KP& p, const Fr& F) {
    const float* H1 = p.BIGF;
    const size_t gt = (size_t)F.bid * NTHR + F.tid, GT = (size_t)F.G * NTHR;
    const size_t tots4 = (size_t)NSMP * 2048 * 512;
    for (size_t idx = gt; idx < tots4; idx += GT) {
        const int b = (int)(idx / (2048 * 512)); const int i = (int)((idx / 512) % 2048); const int c4 = (int)(idx % 512);
        float4 v;
        if (i < 2047) v = ((const float4*)p.st_dil)[((size_t)b * 2048 + i + 1) * 512 + c4];
        else { const int c = c4 * 4; const int r = T + b;
               v = (c < 1024) ? *(const float4*)(p.KD + (size_t)r * 1024 + c) : *(const float4*)(H1 + (size_t)r * 3072 + 2048 + (c - 1024)); }
        ((float4*)(p.out + O_DIL_S))[idx] = v;
    }
}
__device__ __forceinline__ void ph_dil_attn(const KP& p, const Fr& F) {
    const float* H1 = p.BIGF; const int lane = F.lane;
    float* qs = (float*)(F.lds + F.wave * 4096); float* sc = qs + 64;
    float* ex = (float*)(F.lds + 32768);
    const int il = F.wave / 3, gi = F.wave - 3 * il;
    const int item = F.bid * 2 + il; const int b = item >> 4, h = item & 15, r = T + b;
    if (F.wave < 6 && item < NSMP * 16) {
        qs[lane] = p.QD[(size_t)r * 1024 + h * 64 + lane];
        wave_lds_sync();
        const int dd = gi == 0 ? 1 : (gi == 1 ? 4 : 16);
        auto kf = [&](int j, const float*& kp, const float*& vp) -> bool {
            const int pos = T - j * dd;
            if (pos == T) { kp = p.KD + (size_t)r * 1024 + h * 64; vp = H1 + (size_t)r * 3072 + 2048 + h * 64; return true; }
            const float* base = p.st_dil + ((size_t)b * 2048 + (pos - (T - 2048))) * 2048;
            kp = base + h * 64; vp = base + 1024 + h * 64; return true; };
        float o[1], den[1], mx[1];
        wave_attend<1>(qs, sc, 448, 129, kf, o, den, lane, mx);
        float* e = ex + (il * 3 + gi) * 68;
        e[lane] = o[0] * den[0]; if (lane == 0) { e[64] = mx[0]; e[65] = den[0]; }
    }
    __syncthreads();
    if (F.wave < 6 && gi == 0 && item < NSMP * 16) {
        const float* e = ex + il * 3 * 68;
        const float m0 = e[64], m1 = e[68 + 64], m2 = e[136 + 64]; const float M = fmaxf(m0, fmaxf(m1, m2));
        const float w0 = expf(m0 - M), w1 = expf(m1 - M), w2 = expf(m2 - M);
        const float num = w0 * e[lane] + w1 * e[68 + lane] + w2 * e[136 + lane], dn = w0 * e[65] + w1 * e[68 + 65] + w2 * e[136 + 65];
        p.MIXB[(size_t)r * 1024 + h * 64 + lane] = (bf16)f2bf(num / dn);
    }
}

__device__ __forceinline__ void ph_dil_prep_fast(const KP& p, const Fr& F) {
    const float* H1 = p.BIGF;
    const size_t gt = (size_t)F.bid * NTHR + F.tid, GT = (size_t)F.G * NTHR;
    for (size_t idx = gt; idx < (size_t)T * 128; idx += GT) {
        const int t = (int)(idx >> 7), u = (int)(idx & 127);
        const int hq = u >> 2, d0 = (u & 3) * 8, c0 = hq * 64 + d0; const bf16* row = p.H1B + (size_t)t * 3072;
        const v4u ua = *(const v4u*)(row + c0), ub = *(const v4u*)(row + c0 + 32);
        const float4* rp = (const float4*)(p.ROPE + t * 32 + d0); const float4 r0 = rp[0], r1 = rp[1], r2 = rp[2], r3 = rp[3];
        float x1[8], x2[8];
#pragma unroll
        for (int e = 0; e < 4; ++e) { x1[2 * e] = __uint_as_float(ua[e] << 16); x1[2 * e + 1] = __uint_as_float(ua[e] & 0xffff0000u); x2[2 * e] = __uint_as_float(ub[e] << 16); x2[2 * e + 1] = __uint_as_float(ub[e] & 0xffff0000u); }
        const float cs[8] = {r0.x, r0.z, r1.x, r1.z, r2.x, r2.z, r3.x, r3.z}, sn[8] = {r0.y, r0.w, r1.y, r1.w, r2.y, r2.w, r3.y, r3.w};
        float lo[8], hi[8];
#pragma unroll
        for (int j = 0; j < 8; ++j) { lo[j] = x1[j] * cs[j] - x2[j] * sn[j]; hi[j] = x2[j] * cs[j] + x1[j] * sn[j]; }
        if (hq < 16) {
            v4u o; o.x = pk2(lo[0] * QSCALE, lo[1] * QSCALE); o.y = pk2(lo[2] * QSCALE, lo[3] * QSCALE); o.z = pk2(lo[4] * QSCALE, lo[5] * QSCALE); o.w = pk2(lo[6] * QSCALE, lo[7] * QSCALE);
            *(v4u*)(p.QDB + (size_t)t * 1024 + c0) = o;
            o.x = pk2(hi[0] * QSCALE, hi[1] * QSCALE); o.y = pk2(hi[2] * QSCALE, hi[3] * QSCALE); o.z = pk2(hi[4] * QSCALE, hi[5] * QSCALE); o.w = pk2(hi[6] * QSCALE, hi[7] * QSCALE);
            *(v4u*)(p.QDB + (size_t)t * 1024 + c0 + 32) = o;
        } else {
            const int h = hq - 16, kc = h * 64 + d0;
            v4u ol, oh; ol.x = pk2(lo[0], lo[1]); ol.y = pk2(lo[2], lo[3]); ol.z = pk2(lo[4], lo[5]); ol.w = pk2(lo[6], lo[7]);
            oh.x = pk2(hi[0], hi[1]); oh.y = pk2(hi[2], hi[3]); oh.z = pk2(hi[4], hi[5]); oh.w = pk2(hi[6], hi[7]);
#pragma unroll
            for (int pass = 0; pass < 3; ++pass) { const int sh = 2 * pass; const int pi = (t & ((1 << sh) - 1)) * (T >> sh) + (t >> sh);
                bf16* kb = (pass == 0 ? p.DKF[0] : pass == 1 ? p.DKF[1] : p.DKF[2]) + (size_t)h * T * 64;
                *(v4u*)(kb + kfrag_elem(pi, d0)) = ol; *(v4u*)(kb + kfrag_elem(pi, d0 + 32)) = oh; }
            if (t >= T - 2048) { float* op = p.out + O_DIL_P + (size_t)(t - (T - 2048)) * 2048 + kc;
                *(float4*)op = make_float4(lo[0], lo[1], lo[2], lo[3]); *(float4*)(op + 4) = make_float4(lo[4], lo[5], lo[6], lo[7]);
                *(float4*)(op + 32) = make_float4(hi[0], hi[1], hi[2], hi[3]); *(float4*)(op + 36) = make_float4(hi[4], hi[5], hi[6], hi[7]); }
        }
    }
    for (size_t idx = gt; idx < (size_t)2048 * 256; idx += GT) {
        const int i = (int)(idx >> 8), c4 = (int)(idx & 255);
        const uint2 uv = *(const uint2*)(p.H1B + (size_t)(T - 2048 + i) * 3072 + 2048 + c4 * 4);
        *(float4*)(p.out + O_DIL_P + (size_t)i * 2048 + 1024 + c4 * 4) = make_float4(__uint_as_float(uv.x << 16), __uint_as_float(uv.x & 0xffff0000u), __uint_as_float(uv.y << 16), __uint_as_float(uv.y & 0xffff0000u));
    }
    const int lane = F.lane, l15 = lane & 15, grp = lane >> 4;
    for (int unit = F.gw; unit < 3 * 16 * 512; unit += F.NGW) {
        const int st = unit & 511, h = (unit >> 9) & 15, pass = unit >> 13; const int sh = 2 * pass, Td = T >> sh;
        const int pi0 = 32 * st, r = pi0 / Td, s0 = pi0 - r * Td;
        bf16* dst = p.DVF[pass] + (size_t)h * T * 64;
#pragma unroll
        for (int dt = 0; dt < 4; ++dt) {
            unsigned v[8];
#pragma unroll
            for (int j = 0; j < 8; ++j) { const int s = s0 + 16 * (j >> 2) + 4 * grp + (j & 3); const int t = (s << sh) + r;
                v[j] = p.H1B[(size_t)t * 3072 + 2048 + h * 64 + 16 * dt + l15]; }
            v4u o; o.x = v[0] | (v[1] << 16); o.y = v[2] | (v[3] << 16); o.z = v[4] | (v[5] << 16); o.w = v[6] | (v[7] << 16);
            *(v4u*)(dst + vfrag_off(st, dt, lane)) = o;
        }
    }
}

__device__ __forceinline__ void dil_pass(const KP& p, int unit, int pass, unsigned char* ldsb, int w4, int lane) {
    asm volatile("" : "+v"(lane));
    const int h = unit & 15, P0 = (unit >> 4) * 256;
    const int l15 = lane & 15, grp = lane >> 4;
    float* stO = (float*)ldsb; float* stML = stO + 256 * 64;
    {
        const int sh = 2 * pass, Td = T >> sh;
        const bf16* KF = (pass == 0 ? p.DKF[0] : pass == 1 ? p.DKF[1] : p.DKF[2]) + (size_t)h * T * 64;
        const bf16* VF = (pass == 0 ? p.DVF[0] : pass == 1 ? p.DVF[1] : p.DVF[2]) + (size_t)h * T * 64;
        for (int tt = 0; tt < 4; ++tt) {
            const int tl = 4 * w4 + tt;
            const int r = tl >> (4 - sh), s0 = (P0 >> sh) + 16 * (tl & ((16 >> sh) - 1));
            const int sq = s0 + l15, tq = (sq << sh) + r, tloc = tq - P0;
            bf16x8 qf[2];
#pragma unroll
            for (int ks = 0; ks < 2; ++ks) qf[ks] = *(const bf16x8*)(p.QDB + (size_t)tq * 1024 + h * 64 + 32 * ks + 8 * grp);
            AttW a;
            if (pass == 0) attw_init(a);
            else {
#pragma unroll
                for (int dt = 0; dt < 4; ++dt) a.o[dt] = *(const f32x4*)(stO + tloc * 64 + 16 * dt + 4 * grp);
                a.m = stML[tloc * 2]; a.l = (grp == 0) ? stML[tloc * 2 + 1] : 0.f;
            }
            int kstart = s0 - 128; if (kstart < 0) kstart = 0; kstart &= ~31;
            const int nsteps = (s0 + 16 - kstart + 31) >> 5;
            const int base = r * Td;
            bf16x8 kf[3][2][2], vf[3][4];
            auto issue = [&](int s, int buf) {
                const int k0 = kstart + 32 * s;
#pragma unroll
                for (int tl2 = 0; tl2 < 2; ++tl2)
#pragma unroll
                    for (int ks = 0; ks < 2; ++ks) kf[buf][tl2][ks] = *(const bf16x8*)(KF + kfrag_off(((base + k0) >> 4) + tl2, ks, lane));
#pragma unroll
                for (int dt = 0; dt < 4; ++dt) vf[buf][dt] = *(const bf16x8*)(VF + vfrag_off((base + k0) >> 5, dt, lane));
            };
            issue(0, 0); if (nsteps > 1) issue(1, 1);
#pragma unroll
            for (int s = 0; s < 5; ++s) {
                if (s < nsteps) {
                    if (s + 2 < nsteps) issue(s + 2, (s + 2) % 3);
                    const int k0 = kstart + 32 * s;
                    f32x4 s0v, s1v; qk_step(kf[s % 3], qf, s0v, s1v);
                    if ((k0 + 31 > s0) || (k0 < s0 + 15 - 128)) {
                        const int pb = k0 + 4 * grp;
#pragma unroll
                        for (int i = 0; i < 4; ++i) { const int p0 = pb + i, p1 = pb + 16 + i;
                            if (p0 > sq || p0 < sq - 128) s0v[i] = -INFINITY; if (p1 > sq || p1 < sq - 128) s1v[i] = -INFINITY; }
                    }
                    att_update(a, s0v, s1v, vf[s % 3]);
                }
            }
            const float lt = grp_sum(a.l);
            if (pass < 2) {
#pragma unroll
                for (int dt = 0; dt < 4; ++dt) *(f32x4*)(stO + tloc * 64 + 16 * dt + 4 * grp) = a.o[dt];
                if (grp == 0) { stML[tloc * 2] = a.m; stML[tloc * 2 + 1] = lt; }
            } else {
                const float il = lt > 0.f ? 1.f / lt : 0.f;
#pragma unroll
                for (int dt = 0; dt < 4; ++dt) { uint2 o; o.x = pk2(a.o[dt][0] * il, a.o[dt][1] * il); o.y = pk2(a.o[dt][2] * il, a.o[dt][3] * il);
                    *(uint2*)(p.MIXB + (size_t)tq * 1024 + h * 64 + 16 * dt + 4 * grp) = o; }
            }
        }
    }
}
__device__ __forceinline__ void ph_dil_combo(const KP& p, const Fr& F) {
    const float* H1 = p.BIGF; const int lane = F.lane;
    const int cw = F.bid * 4 + F.wave;
#pragma unroll 1
    for (int u = 0; u < 4; ++u) {
#pragma unroll
        for (int pass = 0; pass < 3; ++pass) {
            if (F.wave >= 4) dil_pass(p, F.bid + u * F.G, pass, F.lds, F.wave - 4, lane);
            else {
                const int ci = u * 3 + pass;
                const int g0 = ci * 2 + (ci < 8 ? ci : 8), g1 = g0 + 2 + (ci < 8 ? 1 : 0);
                auto srcp = [&](int itn) -> const float4* {
                    const size_t idx = ((size_t)itn * 1024 + cw) * 64 + lane;
                    const int b = (int)(idx >> 20), i = (int)((idx >> 9) & 2047), c4 = (int)(idx & 511);
                    const int c = c4 * 4, r = T + b;
                    const float4* s_old = ((const float4*)p.st_dil) + ((size_t)b * 2048 + (i < 2047 ? i + 1 : 2047)) * 512 + c4;
                    const float4* s_new = (c < 1024) ? (const float4*)(p.KD + (size_t)r * 1024 + c) : (const float4*)(H1 + (size_t)r * 3072 + 2048 + (c - 1024));
                    return (i == 2047) ? s_new : s_old; };
                float4* dstp = (float4*)(p.out + O_DIL_S) + (size_t)cw * 64 + lane;
#pragma unroll 1
                for (int gi = g0; gi < g1; ++gi) {
                    const int i0 = gi * 16;
                    const float4 v0 = *srcp(i0), v1 = *srcp(i0 + 1), v2 = *srcp(i0 + 2), v3 = *srcp(i0 + 3), v4 = *srcp(i0 + 4), v5 = *srcp(i0 + 5), v6 = *srcp(i0 + 6), v7 = *srcp(i0 + 7);
                    const float4 v8 = *srcp(i0 + 8), v9 = *srcp(i0 + 9), v10 = *srcp(i0 + 10), v11 = *srcp(i0 + 11), v12 = *srcp(i0 + 12), v13 = *srcp(i0 + 13), v14 = *srcp(i0 + 14), v15 = *srcp(i0 + 15);
                    float4* d = dstp + (size_t)i0 * 65536;
                    d[0] = v0; d[65536] = v1; d[2 * 65536] = v2; d[3 * 65536] = v3; d[4 * 65536] = v4; d[5 * 65536] = v5; d[6 * 65536] = v6; d[7 * 65536] = v7;
                    d[8 * 65536] = v8; d[9 * 65536] = v9; d[10 * 65536] = v10; d[11 * 65536] = v11; d[12 * 65536] = v12; d[13 * 65536] = v13; d[14 * 65536] = v14; d[15 * 65536] = v15;
                }
            }
            __syncthreads();
        }
    }
}

constexpr int NPHASE = 22;
__global__ void __launch_bounds__(NTHR, 2) mega(KP p) {
    extern __shared__ __attribute__((aligned(16))) unsigned char lds[];
    Fr F; F.lds = lds; F.tid = threadIdx.x; F.lane = 0; F.wave = __builtin_amdgcn_readfirstlane(F.tid >> 6);
    F.bid = blockIdx.x; F.G = gridDim.x; F.gw = F.bid * NWAVES + F.wave; F.NGW = F.G * NWAVES;
    for (int u = F.tid; u < (LDS_BYTES - RING_BYTES) / 4; u += NTHR) ((unsigned*)(lds + RING_BYTES))[u] = 0u;
    __syncthreads();
    XcdBarrier bar; bar.bar = p.ctl + 4096; bar.x = 0; bar.st = nullptr;
    if (!MK_PER_PHASE) bar = xcd_barrier_post(p.ctl + 4096, (volatile LAS unsigned*)(lds + MISC_OFF + 32));
    const int lo = p.ph_lo, hi = p.ph_hi;
#define IN(k) (lo <= (k) && (k) < hi)

    int ph = 0;
#if PROBE_ON
#define PROBE_STAMP(k) do { if (blockIdx.x == 0 && threadIdx.x == 0) ((unsigned long long*)(p.ctl + 65536))[k] = __builtin_amdgcn_s_memrealtime(); } while (0)
#define PROBE_STAMPB(k, blk) do { if (blockIdx.x == (blk) && threadIdx.x == 0) ((unsigned long long*)(p.ctl + 65536))[k] = __builtin_amdgcn_s_memrealtime(); } while (0)
    PROBE_STAMP(0);
#else
#define PROBE_STAMP(k) do { } while (0)
#define PROBE_STAMPB(k, blk) do { } while (0)
#endif
#define PHASE(...) do { { unsigned t_ = threadIdx.x; asm volatile("" : "+v"(t_)); F.lane = (int)(t_ & 63u); } if (IN(ph)) { __VA_ARGS__ } if (IN(ph) && IN(ph + 1)) xcd_barrier(bar); ++ph; PROBE_STAMP(ph); } while (0)
    PHASE(ph_prologue(p, F););
    PHASE(ph_gemm_h0(p, F); ph_cmp_samples(p, F););
    PHASE(ph_nsa_prep(p, F); ph_nsa_prep_fast(p, F); ph_gdn_prep(p, F););
    PHASE(ph_gdn_chunks(p, F););
    PHASE(ph_mix_a(p, F););
    PHASE(ph_mix_b(p, F););
    PHASE(ph_gdn_out(p, F););
    PHASE(ph_gemm_bf16(F, p.MIXB, p.WT_OA, DM, p.MOB););
    PHASE(ph_ln_b(F, p.ACTB, p.MOB, p.ln_mix_g, p.ln_mix_b, nullptr, nullptr););
    PHASE(ph_ffn_gemm(p, F, p.WT_FI0, 0););
    PHASE(ph_ffn_fix(p, F, 0););
    PHASE(ph_gemm_bf16(F, p.HFFB, p.WT_FO0, DFF, p.MOB););
    PHASE(ph_ln_b(F, p.ACTB, p.MOB, p.ln_ffn_g, p.ln_ffn_b, nullptr, nullptr););
    PHASE(ph_gemm_h1(p, F););
    PHASE(ph_dil_prep(p, F); ph_dil_prep_fast(p, F););
    PHASE(ph_dil_attn(p, F); __syncthreads(); ph_dil_combo(p, F););
    PHASE(ph_gemm_bf16(F, p.MIXB, p.WT_CO, DM, p.MOB););
    PHASE(ph_ln_b(F, p.ACTB, p.MOB, p.ln_mix_g + DM, p.ln_mix_b + DM, nullptr, nullptr););
    PHASE(ph_ffn_gemm(p, F, p.WT_FI1, 1););
    PHASE(ph_ffn_fix(p, F, 1););
    PHASE(ph_gemm_bf16(F, p.HFFB, p.WT_FO1, DFF, p.MOB););
    PHASE(ph_ln_b(F, p.ACTB, p.MOB, p.ln_ffn_g + DM, p.ln_ffn_b + DM, p.out + O_Y_P, p.out + O_Y_S););
#undef PHASE
#if PROBE_ON
    xcd_barrier(bar);
    if (blockIdx.x == 0) { __syncthreads(); const unsigned long long* pts = (const unsigned long long*)(p.ctl + 65536); const float x = (float)(pts[PROBE_B] - pts[PROBE_A]) * 1e-5f;
        for (int i = threadIdx.x; i < NSMP * DM; i += NTHR) p.out[O_Y_S + i] *= (1.f + x); }
#endif
#undef IN
}

static inline size_t align_up(size_t x) { return (x + 255) & ~(size_t)255; }

extern "C" void kernel_launch(void* const* d_in, const int* in_sizes, int n_in, void* d_out, int out_size, void* d_ws, size_t ws_size, hipStream_t stream) {
    static int grid = 0;
    if (grid == 0) {
        int dev = 0, cus = 0, per_cu = 0;
        if (hipGetDevice(&dev) != hipSuccess || hipDeviceGetAttribute(&cus, hipDeviceAttributeMultiprocessorCount, dev) != hipSuccess) { fprintf(stderr, "kernel_launch: device query failed\n"); grid = -1; return; }
        if (hipFuncSetAttribute((const void*)mega, hipFuncAttributeMaxDynamicSharedMemorySize, LDS_BYTES) != hipSuccess) { fprintf(stderr, "kernel_launch: hipFuncSetAttribute failed\n"); grid = -1; return; }
        if (hipOccupancyMaxActiveBlocksPerMultiprocessor(&per_cu, (const void*)mega, NTHR, LDS_BYTES) != hipSuccess || per_cu < 1) { fprintf(stderr, "kernel_launch: occupancy query says %d blocks per CU\n", per_cu); }
        (void)hipGetLastError();
        grid = cus;
    }
    if (grid < 0) return;
    if ((size_t)out_size != O_END) fprintf(stderr, "kernel_launch: out_size %d != expected %zu\n", out_size, (size_t)O_END);
    KP p{};
    p.x_prompt = (const float*)d_in[0]; p.x_sample = (const float*)d_in[1]; p.cache_cmp = (const float*)d_in[2]; p.cache_slc = (const float*)d_in[3];
    p.st_win = (const float*)d_in[4]; p.st_gconv = (const float*)d_in[5]; p.st_gS = (const float*)d_in[6]; p.st_dil = (const float*)d_in[7];
    p.st_ffn = (const float*)d_in[8]; p.page_table = (const int*)d_in[9]; p.w_in_a = (const float*)d_in[10]; p.cw1 = (const float*)d_in[11];
    p.cb1 = (const float*)d_in[12]; p.cw2 = (const float*)d_in[13]; p.cpe = (const float*)d_in[14]; p.gconv_w = (const float*)d_in[15];
    p.gA = (const float*)d_in[16]; p.gdt = (const float*)d_in[17]; p.gnw = (const float*)d_in[18]; p.w_out_a = (const float*)d_in[19];
    p.w_in_c = (const float*)d_in[20]; p.w_out_c = (const float*)d_in[21]; p.ln_mix_g = (const float*)d_in[22]; p.ln_mix_b = (const float*)d_in[23];
    p.ffn_w_in = (const float*)d_in[24]; p.ffn_cw = (const float*)d_in[25]; p.ffn_cb = (const float*)d_in[26]; p.ffn_w_out = (const float*)d_in[27];
    p.ln_ffn_g = (const float*)d_in[28]; p.ln_ffn_b = (const float*)d_in[29];
    p.out = (float*)d_out;
    char* ws = (char*)d_ws; size_t off = 0;
    auto alloc = [&](size_t bytes) { void* q = (void*)(ws + off); off = align_up(off + bytes); return q; };
    p.ctl = (unsigned*)alloc(1 << 20);
    p.WT_A = (bf16*)alloc((size_t)PAP * DM * 2); p.WT_OA = (bf16*)alloc((size_t)DM * DM * 2);
    p.WT_FI0 = (bf16*)alloc((size_t)DFF2 * DM * 2); p.WT_FI1 = (bf16*)alloc((size_t)DFF2 * DM * 2);
    p.WT_FO0 = (bf16*)alloc((size_t)DM * DFF * 2); p.WT_FO1 = (bf16*)alloc((size_t)DM * DFF * 2);
    p.WT_CI = (bf16*)alloc((size_t)3072 * DM * 2); p.WT_CO = (bf16*)alloc((size_t)DM * DM * 2);
    p.ROPE = (float2*)alloc((size_t)(T + 1) * 32 * 8);
    p.ACTB = (bf16*)alloc((size_t)TSP * DM * 2); p.MIXB = (bf16*)alloc((size_t)TSP * DM * 2); p.HFFB = (bf16*)alloc((size_t)TSP * DFF * 2);
    p.KS8 = (unsigned char*)alloc((size_t)2 * T * 64); p.VS8 = (unsigned char*)alloc((size_t)2 * T * 64);
    p.QB = (bf16*)alloc((size_t)T * 512 * 2); p.KSF = (bf16*)alloc((size_t)2 * T * 64 * 2); p.VSF = (bf16*)alloc((size_t)2 * T * 64 * 2);
    p.KWF = (bf16*)alloc((size_t)2 * T * 64 * 2); p.VWF = (bf16*)alloc((size_t)2 * T * 64 * 2); p.CKF = (bf16*)alloc((size_t)2 * 512 * 64 * 2); p.CVF = (bf16*)alloc((size_t)2 * 512 * 64 * 2);
    p.ACP = (bf16*)alloc((size_t)2048 * 2048 * 2);
    p.W2T = (bf16*)alloc((size_t)2 * 64 * 128 * 2);
    p.AC = nullptr; p.WT_C = (bf16*)alloc((size_t)256 * 2048 * 2); p.HID = nullptr; p.SMIXF = (float*)alloc((size_t)NSMP * 3 * 512 * 4);
    p.UB = (float*)alloc((size_t)256 * 4 * DFF2 * 4);
    p.NSACC = (float*)alloc((size_t)T * 512 * 4); p.SEL = (int*)alloc((size_t)2 * T * 16 * 4);
    p.QDB = (bf16*)alloc((size_t)T * 1024 * 2);
    for (int i = 0; i < 3; ++i) { p.DKF[i] = (bf16*)alloc((size_t)T * 1024 * 2); p.DVF[i] = (bf16*)alloc((size_t)T * 1024 * 2); }
    p.G_WF = (bf16*)alloc((size_t)2048 * 4096 * 2); p.G_KDF = (bf16*)alloc((size_t)2048 * 4096 * 2); p.G_QGF = (bf16*)alloc((size_t)2048 * 4096 * 2); p.G_QKF = (bf16*)alloc((size_t)2048 * 4096 * 2);
    p.G_SPF = (bf16*)alloc((size_t)2048 * 4096 * 2); p.G_VNF = (bf16*)alloc((size_t)2048 * 4096 * 2); p.G_UF = (float*)alloc((size_t)2048 * 4096 * 4); p.G_GL = (float*)alloc((size_t)2048 * 4);
    p.MOB = (bf16*)alloc((size_t)TSP * DM * 2); p.H1B = (bf16*)alloc((size_t)T * 3072 * 2); p.H0B = (bf16*)alloc((size_t)T * PAP * 2); p.ZF = (float*)alloc((size_t)T * 512 * 4);
    p.BIGF = (float*)alloc((size_t)TSP * DFF2 * 4); p.MO = (float*)alloc((size_t)TSP * DM * 4);
    p.X1 = (float*)alloc((size_t)TS * DM * 4); p.X2 = (float*)alloc((size_t)TS * DM * 4); p.X3 = (float*)alloc((size_t)TS * DM * 4);
    p.QR = (float*)alloc((size_t)TS * 512 * 4);
    p.KS = (float*)alloc((size_t)TS * 128 * 4); p.VS = (float*)alloc((size_t)TS * 128 * 4); p.KW = (float*)alloc((size_t)TS * 128 * 4); p.VW = (float*)alloc((size_t)TS * 128 * 4);
    p.CK = (float*)alloc((size_t)33 * 512 * 128 * 4); p.CV = (float*)alloc((size_t)33 * 512 * 128 * 4);
    p.GQ = (float*)alloc((size_t)TS * 512 * 4); p.GK = (float*)alloc((size_t)TS * 512 * 4); p.GV = (float*)alloc((size_t)TS * 512 * 4); p.OG = (float*)alloc((size_t)TS * 512 * 4);
    p.Gg = (float*)alloc((size_t)TS * 8 * 4); p.Gb = (float*)alloc((size_t)TS * 8 * 4);
    p.QD = (float*)alloc((size_t)TS * DM * 4); p.KD = (float*)alloc((size_t)TS * DM * 4);
    if (off > ws_size) { fprintf(stderr, "kernel_launch: workspace too small: need %zu have %zu\n", off, ws_size); return; }
    if (hipMemsetAsync(p.ctl, 0, 1 << 20, stream) != hipSuccess) { fprintf(stderr, "kernel_launch: memset failed\n"); return; }
#if MK_PER_PHASE
    for (int k = 0; k < NPHASE; ++k) { p.ph_lo = k; p.ph_hi = k + 1; hipLaunchKernelGGL(mega, dim3(grid), dim3(NTHR), LDS_BYTES, stream, p); }
#else
    p.ph_lo = 0; p.ph_hi = NPHASE;
    hipLaunchKernelGGL(mega, dim3(grid), dim3(NTHR), LDS_BYTES, stream, p);
#endif
    const hipError_t le = hipPeekAtLastError();
    if (le != hipSuccess) fprintf(stderr, "kernel_launch: launch failed: %s\n", hipGetErrorName(le));
}
```

```cpp
#include <hip/hip_runtime.h>
#include <cstdint>
#include <cstdio>
#include <cmath>

namespace pg8 {
#define PG8_LAS __attribute__((address_space(3)))
typedef unsigned short bf16_t;
typedef short bf16x8 __attribute__((ext_vector_type(8)));
typedef float f32x4 __attribute__((ext_vector_type(4)));
typedef unsigned u32x4 __attribute__((ext_vector_type(4)));
constexpr int BM = 256, BK = 64, HALF = 128, HTB = HALF * BK * 2  , STAGE_BYTES = 8 * HTB, NXCD = 8, WGM = 8;

__host__ __device__ __forceinline__ int lds_byte(int r, int c) { const int st = (r >> 4) * 2 + (c >> 5), rr = r & 15, cc = c & 31, ob = rr * 64 + cc * 2; return st * 1024 + (ob ^ (((ob >> 9) & 1) << 5)); }
__host__ __device__ __forceinline__ void stage_rc(int b, int& R, int& C) { const int st = b / 1024, sb = b % 1024, swz = sb ^ (((sb >> 9) & 1) << 5); R = (st >> 1) * 16 + swz / 64; C = (st & 1) * 32 + (swz % 64) / 2; }
__host__ __device__ __forceinline__ int perm32(int rho) { const int n = rho >> 4, i = rho & 15; return 8 * (i >> 2) + 4 * n + (i & 3); }

struct Unit { int pm, pn; };
struct Gemm { const bf16_t* A; const bf16_t* Bt; int M, N, K; };

struct StaticOrder {
    int nM, nN, nwg, G, c;
    __host__ __device__ void init(int M, int N, int G_, int c_) { nM = M / BM; nN = N / BM; nwg = nM * nN; G = G_; c = c_; }
    __host__ __device__ bool next(int i, Unit& u) const {
        const long L = (long)i * G + c; if (L >= nwg) return false;
        int wgid = (int)L; { const int q = nwg / NXCD, r = nwg % NXCD, xcd = wgid % NXCD, off = wgid / NXCD; wgid = (xcd < r ? xcd * (q + 1) : r * (q + 1) + (xcd - r) * q) + off; }
        const int nig = WGM * nN, gid = wgid / nig, fm = gid * WGM, gsz = (nM - fm) < WGM ? (nM - fm) : WGM;
        u.pm = fm + ((wgid % nig) % gsz); u.pn = (wgid % nig) / gsz; return true;
    }
    __device__ __forceinline__ void a_ready(const Unit&) const {}
    __device__ __forceinline__ void done(const Unit&) const {}
};

typedef __bf16 bf16x2_t __attribute__((ext_vector_type(2)));
typedef float f32x2_t __attribute__((ext_vector_type(2)));
__device__ __forceinline__ unsigned cvt_pk_bf16(float lo, float hi) { const f32x2_t v = {lo, hi}; return __builtin_bit_cast(unsigned, __builtin_convertvector(v, bf16x2_t)); }
typedef float f32x2 __attribute__((ext_vector_type(2)));
__device__ __forceinline__ f32x2 gelu_pk(f32x2 v) {
    const f32x2 av = __builtin_elementwise_abs(v), d = av * 0.2316418882f + 1.0f;
    f32x2 t; t.x = __builtin_amdgcn_rcpf(d.x); t.y = __builtin_amdgcn_rcpf(d.y);
    f32x2 q = t * 0.5307027145f + (-0.7265760135f); q = q * t + 0.7107068705f; q = q * t + (-0.142248368f); q = q * t + 0.127414796f; q = q * t;
    const f32x2 s = (v * v) * (-0.72134752044f);
    f32x2 e; e.x = __builtin_amdgcn_exp2f(s.x); e.y = __builtin_amdgcn_exp2f(s.y);
    const f32x2 m = v * (q * e), r = v - m;
    f32x2 o; o.x = v.x < 0.f ? m.x : r.x; o.y = v.y < 0.f ? m.y : r.y; return o;
}

template <int ACT  > struct EpiBf16 {
    static constexpr bool PERM = true, AFTER_DRAIN = false; static_assert(ACT == 0 || ACT == 1, "EpiBf16: ACT is 0 (none) or 1 (gelu_pk)");
    bf16_t* O; int ldc; const float* bias; int split_cols; size_t split_stride; float scale0;
    __device__ __forceinline__ void operator()(const f32x4 (&acc)[2][2][4][2], const Unit& u, int wr, int wc, int fr, int fq) const {
        const int row0 = u.pm * BM + wr * 64 + fr; int colt = u.pn * BM; bf16_t* base = O;
        float sc = 1.f; if (split_cols) { const int t = colt / split_cols; base += (size_t)t * split_stride; colt -= t * split_cols; if (t == 0) sc = scale0; }
        const int col0 = colt + wc * 32 + 8 * fq, bcol0 = u.pn * BM + wc * 32 + 8 * fq;
        f32x4 bv[2][2];
#pragma unroll
        for (int bj = 0; bj < 2; ++bj)
#pragma unroll
            for (int n = 0; n < 2; ++n) bv[bj][n] = bias ? *(const f32x4*)(bias + bcol0 + bj * HALF + 4 * n) : (f32x4){0.f, 0.f, 0.f, 0.f};
#pragma unroll
        for (int ai = 0; ai < 2; ++ai)
#pragma unroll
            for (int m = 0; m < 4; ++m) { bf16_t* rowp = base + (size_t)(row0 + ai * HALF + m * 16) * ldc + col0;
#pragma unroll
                for (int bj = 0; bj < 2; ++bj) { f32x4 v0 = acc[ai][bj][m][0] + bv[bj][0], v1 = acc[ai][bj][m][1] + bv[bj][1];
                    if (ACT == 1) { f32x2 a = gelu_pk((f32x2){v0[0], v0[1]}), b = gelu_pk((f32x2){v0[2], v0[3]}), c = gelu_pk((f32x2){v1[0], v1[1]}), d = gelu_pk((f32x2){v1[2], v1[3]});
                        v0 = (f32x4){a.x, a.y, b.x, b.y}; v1 = (f32x4){c.x, c.y, d.x, d.y}; }
                    v0 = v0 * sc; v1 = v1 * sc; u32x4 w; w.x = cvt_pk_bf16(v0[0], v0[1]); w.y = cvt_pk_bf16(v0[2], v0[3]); w.z = cvt_pk_bf16(v1[0], v1[1]); w.w = cvt_pk_bf16(v1[2], v1[3]);
                    *(u32x4*)(rowp + bj * HALF) = w; } }
    }
};

struct EpiF32 {
    static constexpr bool PERM = false, AFTER_DRAIN = false;
    float* O; int ldc; int ncols;
    __device__ __forceinline__ void operator()(const f32x4 (&acc)[2][2][4][2], const Unit& u, int wr, int wc, int fr, int fq) const {
        const int row0 = u.pm * BM + wr * 64 + fr; const int col0 = u.pn * BM + wc * 32 + 4 * fq;
#pragma unroll
        for (int ai = 0; ai < 2; ++ai)
#pragma unroll
            for (int m = 0; m < 4; ++m) { float* rowp = O + (size_t)(row0 + ai * HALF + m * 16) * ldc;
#pragma unroll
                for (int bj = 0; bj < 2; ++bj)
#pragma unroll
                    for (int n = 0; n < 2; ++n) { const int c = col0 + bj * HALF + n * 16; if (c < ncols) *(f32x4*)(rowp + c) = acc[ai][bj][m][n]; } }
    }
};
template <class Epi, class Sched, bool ALIGN_EPI = false, bool SP2 = false>
__device__ __forceinline__ void gemm_phase(PG8_LAS unsigned char* lds, const Gemm g, const Sched& S, const Epi& E) {
    const int tid = threadIdx.x, wid = __builtin_amdgcn_readfirstlane(tid >> 6), lane = tid & 63, wr = wid >> 2, wc = wid & 3, fr = lane & 15, fq = lane >> 4;
    const int K = g.K, nt = K / BK;
    unsigned voffA[2], voffB[2];
#pragma unroll
    for (int i = 0; i < 2; ++i) { int R, C; stage_rc(tid * 16 + i * 8192, R, C); const int Rb = Epi::PERM ? ((R & ~31) + perm32(R & 31)) : R;
        voffA[i] = (unsigned)(R * K + C) * 2u; voffB[i] = (unsigned)(Rb * K + C) * 2u; }
    const size_t kstep = (size_t)(BK * 2);
    const size_t hstep = (size_t)HALF * K * 2;
    const size_t tstep = 2 * hstep;
    const unsigned ldsw = (unsigned)wid * 1024u;
    const int aoff = lds_byte(wr * 64 + fr, fq * 8), boff = lds_byte(wc * 32 + fr, fq * 8);
#define PG8_SA(b, h) (((b) * 2 + (h)) * HTB)
#define PG8_SB(b, h) ((4 + (b) * 2 + (h)) * HTB)
#define PG8_STAGE(bufoff, gbase, voff) do { _Pragma("unroll") for (int _i = 0; _i < 2; ++_i) \
        __builtin_amdgcn_global_load_lds((const unsigned*)((const char*)(gbase) + (voff)[_i]), (PG8_LAS unsigned*)(lds + (bufoff) + ldsw + _i * 8192), 16, 0, 0); } while (0)
#define PG8_LDA(dst, b, h) do { _Pragma("unroll") for (int m = 0; m < 4; ++m) _Pragma("unroll") for (int k = 0; k < 2; ++k) dst[m][k] = *(const PG8_LAS bf16x8*)(lds + PG8_SA(b, h) + aoff + m * 2048 + k * 1024); } while (0)
#define PG8_LDB(dst, b, h) do { _Pragma("unroll") for (int n = 0; n < 2; ++n) _Pragma("unroll") for (int k = 0; k < 2; ++k) dst[n][k] = *(const PG8_LAS bf16x8*)(lds + PG8_SB(b, h) + boff + n * 2048 + k * 1024); } while (0)
#define PG8_MMA(ai, bj, At, Bt) do { __builtin_amdgcn_s_setprio(1); _Pragma("unroll") for (int m = 0; m < 4; ++m) _Pragma("unroll") for (int n = 0; n < 2; ++n) _Pragma("unroll") for (int k = 0; k < 2; ++k) \
        acc[ai][bj][m][n] = __builtin_amdgcn_mfma_f32_16x16x32_bf16(Bt[n][k], At[m][k], acc[ai][bj][m][n], 0, 0, 0); __builtin_amdgcn_s_setprio(0); } while (0)
#define PG8_WAIT_V(n) asm volatile("s_waitcnt vmcnt(" #n ")" ::: "memory")
#define PG8_WAIT_L(n) asm volatile("s_waitcnt lgkmcnt(" #n ")" ::: "memory")
#define PG8_BAR __builtin_amdgcn_s_barrier()
#define PG8_SCHED __builtin_amdgcn_sched_barrier(0)
    Unit cur, nxt; int ui = 0;
    if (!S.next(0, cur)) return;
    f32x4 acc[2][2][4][2];
#pragma unroll
    for (int a = 0; a < 2; ++a)
#pragma unroll
        for (int b = 0; b < 2; ++b)
#pragma unroll
            for (int m = 0; m < 4; ++m)
#pragma unroll
                for (int n = 0; n < 2; ++n) acc[a][b][m][n] = (f32x4){0.f, 0.f, 0.f, 0.f};
    bf16x8 At[4][2], B0[2][2], B1[2][2];
    const char* cA = (const char*)g.A + (size_t)cur.pm * tstep; const char* cB = (const char*)g.Bt + (size_t)cur.pn * tstep;
    S.a_ready(cur);
    if constexpr (SP2) {
        PG8_STAGE(PG8_SB(0, 0), cB, voffB); PG8_STAGE(PG8_SB(0, 1), cB + hstep, voffB); PG8_STAGE(PG8_SA(0, 0), cA, voffA); PG8_STAGE(PG8_SA(0, 1), cA + hstep, voffA);
        if (wr == 1) PG8_BAR;
        PG8_WAIT_V(2); PG8_BAR;
        PG8_STAGE(PG8_SB(1, 0), cB + kstep, voffB); PG8_STAGE(PG8_SA(1, 0), cA + kstep, voffA); PG8_STAGE(PG8_SB(1, 1), cB + hstep + kstep, voffB);
        PG8_WAIT_V(6); PG8_BAR;
    } else {
        PG8_STAGE(PG8_SB(0, 0), cB, voffB); PG8_STAGE(PG8_SA(0, 0), cA, voffA); PG8_STAGE(PG8_SB(0, 1), cB + hstep, voffB); PG8_STAGE(PG8_SA(0, 1), cA + hstep, voffA);
        if (wr == 1) PG8_BAR;
        PG8_WAIT_V(4); PG8_BAR;
        PG8_STAGE(PG8_SB(1, 0), cB + kstep, voffB); PG8_STAGE(PG8_SA(1, 0), cA + kstep, voffA); PG8_STAGE(PG8_SB(1, 1), cB + hstep + kstep, voffB);
        PG8_WAIT_V(6); PG8_BAR;
    }
    for (;;) {
        const bool has_next = S.next(ui + 1, nxt);
        const char* nA = has_next ? (const char*)g.A + (size_t)nxt.pm * tstep : cA; const char* nB = has_next ? (const char*)g.Bt + (size_t)nxt.pn * tstep : cB;
        for (int t = 0; t < nt; t += 2) {
            const bool last = (t == nt - 2);
            const char* a1 = cA + (size_t)(t + 1) * kstep;
            const char* a2 = last ? nA : cA + (size_t)(t + 2) * kstep; const char* b2 = last ? nB : cB + (size_t)(t + 2) * kstep;
            const char* a3 = a2 + kstep; const char* b3 = b2 + kstep;
            if (last && has_next) S.a_ready(nxt);
            if constexpr (SP2) {
            PG8_LDB(B0, 0, 0); PG8_LDB(B1, 0, 1); PG8_SCHED; PG8_LDA(At, 0, 0); PG8_STAGE(PG8_SA(1, 1), a1 + hstep, voffA);
            PG8_WAIT_V(8); PG8_WAIT_L(0); PG8_BAR; PG8_MMA(0, 0, At, B0); PG8_MMA(0, 1, At, B1); PG8_BAR; PG8_SCHED;
            PG8_LDA(At, 0, 1); PG8_STAGE(PG8_SB(0, 0), b2, voffB); PG8_STAGE(PG8_SB(0, 1), b2 + hstep, voffB); PG8_STAGE(PG8_SA(0, 0), a2, voffA);
            PG8_WAIT_V(8); PG8_WAIT_L(0); PG8_BAR; PG8_MMA(1, 0, At, B0); PG8_MMA(1, 1, At, B1); PG8_BAR; PG8_SCHED;
            PG8_LDB(B0, 1, 0); PG8_LDB(B1, 1, 1); PG8_SCHED; PG8_LDA(At, 1, 0); PG8_STAGE(PG8_SA(0, 1), a2 + hstep, voffA);
            PG8_WAIT_V(8); PG8_WAIT_L(0); PG8_BAR; PG8_MMA(0, 0, At, B0); PG8_MMA(0, 1, At, B1); PG8_BAR; PG8_SCHED;
            PG8_LDA(At, 1, 1); PG8_STAGE(PG8_SB(1, 0), b3, voffB); PG8_STAGE(PG8_SB(1, 1), b3 + hstep, voffB); PG8_STAGE(PG8_SA(1, 0), a3, voffA);
            PG8_WAIT_V(8); PG8_WAIT_L(0); PG8_BAR; PG8_MMA(1, 0, At, B0); PG8_MMA(1, 1, At, B1); PG8_BAR; PG8_SCHED;
            } else {
            PG8_LDB(B0, 0, 0); PG8_SCHED; PG8_LDA(At, 0, 0); PG8_STAGE(PG8_SA(1, 1), a1 + hstep, voffA);
            PG8_WAIT_L(8); PG8_BAR; PG8_WAIT_L(0); PG8_MMA(0, 0, At, B0); PG8_BAR; PG8_SCHED;
            PG8_LDB(B1, 0, 1); PG8_STAGE(PG8_SB(0, 0), b2, voffB);
            PG8_BAR; PG8_WAIT_L(0); PG8_MMA(0, 1, At, B1); PG8_BAR;
            PG8_LDA(At, 0, 1); PG8_STAGE(PG8_SA(0, 0), a2, voffA);
            PG8_BAR; PG8_WAIT_L(0); PG8_MMA(1, 0, At, B0); PG8_BAR; PG8_SCHED;
            PG8_STAGE(PG8_SB(0, 1), b2 + hstep, voffB);
            PG8_WAIT_V(6); PG8_BAR; PG8_MMA(1, 1, At, B1); PG8_BAR;
            PG8_LDB(B0, 1, 0); PG8_SCHED; PG8_LDA(At, 1, 0); PG8_STAGE(PG8_SA(0, 1), a2 + hstep, voffA);
            PG8_WAIT_L(8); PG8_BAR; PG8_WAIT_L(0); PG8_MMA(0, 0, At, B0); PG8_BAR; PG8_SCHED;
            PG8_LDB(B1, 1, 1); PG8_STAGE(PG8_SB(1, 0), b3, voffB);
            PG8_BAR; PG8_WAIT_L(0); PG8_MMA(0, 1, At, B1); PG8_BAR;
            PG8_LDA(At, 1, 1); PG8_STAGE(PG8_SA(1, 0), a3, voffA);
            PG8_BAR; PG8_WAIT_L(0); PG8_MMA(1, 0, At, B0); PG8_BAR; PG8_SCHED;
            PG8_STAGE(PG8_SB(1, 1), b3 + hstep, voffB);
            PG8_WAIT_V(6); PG8_BAR; PG8_MMA(1, 1, At, B1); PG8_BAR;
            }
        }
        if constexpr (ALIGN_EPI) { if (wr == 0) PG8_BAR; }
        if constexpr (!Epi::AFTER_DRAIN) { E(acc, cur, wr, wc, fr, fq); S.done(cur); }
        if (!has_next) break;
#pragma unroll
        for (int a = 0; a < 2; ++a)
#pragma unroll
            for (int b = 0; b < 2; ++b)
#pragma unroll
                for (int m = 0; m < 4; ++m)
#pragma unroll
                    for (int n = 0; n < 2; ++n) acc[a][b][m][n] = (f32x4){0.f, 0.f, 0.f, 0.f};
        cur = nxt; cA = nA; cB = nB; ++ui;
        if constexpr (ALIGN_EPI) { if (wr == 1) PG8_BAR; }
    }
    PG8_WAIT_V(0);
    if constexpr (!ALIGN_EPI) { if (wr == 0) PG8_BAR; }
    PG8_BAR;
    if constexpr (Epi::AFTER_DRAIN) { E.fused(acc, cur, wr, wc, fr, fq, lds, wid, lane); S.done(cur); }
#undef PG8_SA
#undef PG8_SB
#undef PG8_STAGE
#undef PG8_LDA
#undef PG8_LDB
#undef PG8_MMA
#undef PG8_WAIT_V
#undef PG8_WAIT_L
#undef PG8_BAR
#undef PG8_SCHED
}
}

#define LAS __attribute__((address_space(3)))
#define XB_TMO      128
#define XB_XCNT(j)  (256  + 64 * (j))
#define XB_XSUB(j)  (1280 + 64 * (j))
#define XB_XGEN(j)  (2304 + 64 * (j))
#define XB_TOP      3328
#define XB_TOPGEN   3392
#define XCD_BAR_WORDS 3456
#define XB_SPIN_CAP (1u << 26)

__device__ __forceinline__ unsigned xb_ld(unsigned* p)              { return __hip_atomic_load(p, __ATOMIC_RELAXED, __HIP_MEMORY_SCOPE_AGENT); }
__device__ __forceinline__ unsigned xb_add(unsigned* p, unsigned v) { return __hip_atomic_fetch_add(p, v, __ATOMIC_RELAXED, __HIP_MEMORY_SCOPE_AGENT); }
__device__ __forceinline__ unsigned xb_xcc_id() { return (unsigned)__builtin_amdgcn_s_getreg((3 << 11) | 20) & 0xFu; }
#define XB_SPIN(cond, bar) do { unsigned _sp = 0; while (cond) { __builtin_amdgcn_s_sleep(1); \
    if ((++_sp & 255u) == 0u) { if (xb_ld(&(bar)[XB_TMO])) break; if (_sp > XB_SPIN_CAP) { atomicAdd(&(bar)[XB_TMO], 1u); break; } } } } while (0)

struct XcdBarrier {
    unsigned* bar; unsigned x;
    volatile LAS unsigned* st;
};

__device__ __forceinline__ XcdBarrier xcd_barrier_post(unsigned* bar, volatile LAS unsigned* st) {
    XcdBarrier b; b.bar = bar; b.x = xb_xcc_id(); b.st = st;
    if (threadIdx.x == 0) (void)xb_add(&bar[XB_XCNT(b.x)], 1u);
    return b;
}
__device__ __forceinline__ void xcd_barrier_complete(unsigned* bar, unsigned x, unsigned& nloc, unsigned& nx) {
    const unsigned G = gridDim.x * gridDim.y * gridDim.z;
    unsigned sum, cnt, mine, sp = 0u;
    for (;;) {
        sum = 0u; cnt = 0u; mine = 0u;
#pragma unroll
        for (unsigned j = 0; j < 16; ++j) { const unsigned c = xb_ld(&bar[XB_XCNT(j)]); sum += c; cnt += (c > 0u) ? 1u : 0u; mine = (j == x) ? c : mine; }
        if (sum == G) break;
        __builtin_amdgcn_s_sleep(1);
        if ((++sp & 255u) == 0u) { if (xb_ld(&bar[XB_TMO])) break; if (sp > XB_SPIN_CAP) { atomicAdd(&bar[XB_TMO], 1u); break; } }
    }
    nloc = mine > 0u ? mine : 1u; nx = cnt > 0u ? cnt : 1u;
}

__device__ __forceinline__ void xcd_barrier(const XcdBarrier& b) {
    asm volatile("s_waitcnt vmcnt(0)" ::: "memory");
    __syncthreads();
    if (threadIdx.x == 0) {
        unsigned* bar = b.bar;
        __builtin_amdgcn_s_waitcnt(0);
        unsigned nloc = b.st[0], nx = b.st[1];
        if (nloc == 0u) { xcd_barrier_complete(bar, b.x, nloc, nx); b.st[0] = nloc; b.st[1] = nx; }
        const unsigned old = xb_add(&bar[XB_XSUB(b.x)], 1u);
        const unsigned gen = old / nloc;
        if (old + 1u == (gen + 1u) * nloc) {
            __builtin_amdgcn_fence(__ATOMIC_RELEASE, "agent");
            asm volatile("s_waitcnt vmcnt(0)" ::: "memory");
            const unsigned og = xb_add(&bar[XB_TOP], 1u);
            const unsigned tg = og / nx;
            if (og + 1u == (tg + 1u) * nx) xb_add(&bar[XB_TOPGEN], 1u);
            else XB_SPIN(xb_ld(&bar[XB_TOPGEN]) == tg, bar);
            __builtin_amdgcn_fence(__ATOMIC_ACQUIRE, "agent");
            xb_add(&bar[XB_XGEN(b.x)], 1u);
            asm volatile("s_waitcnt vmcnt(0)" ::: "memory");
        } else {
            XB_SPIN(xb_ld(&bar[XB_XGEN(b.x)]) == gen, bar);
            __builtin_amdgcn_fence(__ATOMIC_ACQUIRE, "agent");
            asm volatile("s_waitcnt vmcnt(0)" ::: "memory");
        }
    }
    __syncthreads();
}

#ifndef PG8_SP2
#define PG8_SP2 true
#endif
#ifndef PG8_ALIGN
#define PG8_ALIGN true
#endif
#ifndef PROBE_ON
#define PROBE_ON 0
#define PROBE_A 0
#define PROBE_B 1
#endif
#ifndef MK_PER_PHASE
#define MK_PER_PHASE 0
#endif

constexpr int T = 16384, NSMP = 32, TS = T + NSMP, TSP = T + 256, DM = 1024;
constexpr int PA = 3368, PAP = 3584;
constexpr int C_Q = 0, C_KC = 512, C_VC = 640, C_KS = 768, C_VS = 896, C_KW = 1024, C_VW = 1152, C_GATE = 1280,
              C_GQKV = 1304, C_A = 2840, C_BT = 2848, C_Z = 2856;
constexpr int DFF = 2816, DFF2 = 5632;
constexpr float DN_ALPHA = 1.4142135623730951f;
constexpr float LN_EPS = 1e-5f, NORM_EPS = 1e-6f;
constexpr int NPAGES = 128;
constexpr int NWAVES = 8, NTHR = 512;

constexpr size_t O_Y_P = 0;
constexpr size_t O_Y_S = O_Y_P + (size_t)T * DM;
constexpr size_t O_CMP_P = O_Y_S + (size_t)NSMP * DM;
constexpr size_t O_CMP_S = O_CMP_P + (size_t)T * 256;
constexpr size_t O_SLC_P = O_CMP_S + (size_t)NSMP * 256;
constexpr size_t O_SLC_S = O_SLC_P + (size_t)T * 256;
constexpr size_t O_WIN_P = O_SLC_S + (size_t)NSMP * 256;
constexpr size_t O_WIN_S = O_WIN_P + (size_t)512 * 256;
constexpr size_t O_GCONV_P = O_WIN_S + (size_t)NSMP * 512 * 256;
constexpr size_t O_GCONV_S = O_GCONV_P + (size_t)3 * 1536;
constexpr size_t O_GS_P = O_GCONV_S + (size_t)NSMP * 3 * 1536;
constexpr size_t O_GS_S = O_GS_P + (size_t)8 * 64 * 64;
constexpr size_t O_DIL_P = O_GS_S + (size_t)NSMP * 8 * 64 * 64;
constexpr size_t O_DIL_S = O_DIL_P + (size_t)2048 * 2048;
constexpr size_t O_FFN_P = O_DIL_S + (size_t)NSMP * 2048 * 2048;
constexpr size_t O_FFN_S = O_FFN_P + (size_t)2 * 2 * DFF2;
constexpr size_t O_END = O_FFN_S + (size_t)NSMP * 2 * 2 * DFF2;

constexpr int RING_BYTES = 131072;
constexpr int FAST_WL = 17408;
constexpr int MISC_OFF = 8 * FAST_WL + 64;
constexpr int LDS_BYTES = 147456;

typedef unsigned short bf16;
typedef unsigned v4u __attribute__((ext_vector_type(4)));

__device__ __forceinline__ unsigned f2bf(float f) { return (unsigned)__builtin_bit_cast(unsigned short, (__bf16)f); }
__device__ __forceinline__ unsigned pk2(float lo, float hi) { return pg8::cvt_pk_bf16(lo, hi); }
typedef short bf16x8 __attribute__((ext_vector_type(8)));
typedef float f32x4 __attribute__((ext_vector_type(4)));
#define MFMA16(a, b, c) __builtin_amdgcn_mfma_f32_16x16x32_bf16((a), (b), (c), 0, 0, 0)
__device__ __forceinline__ float wave_sum(float v) {
#pragma unroll
    for (int o = 1; o < 64; o <<= 1) v += __shfl_xor(v, o);
    return v;
}
__device__ __forceinline__ float wave_max(float v) {
#pragma unroll
    for (int o = 1; o < 64; o <<= 1) v = fmaxf(v, __shfl_xor(v, o));
    return v;
}
__device__ __forceinline__ void wave_lds_sync() { asm volatile("s_waitcnt lgkmcnt(0)" ::: "memory"); __builtin_amdgcn_wave_barrier(); asm volatile("" ::: "memory"); }
__device__ __forceinline__ float fexp_(float x) { return __builtin_amdgcn_exp2f(x * 1.4426950408889634f); }
__device__ __forceinline__ float fsilu_(float x) { return x * __builtin_amdgcn_rcpf(1.f + fexp_(-x)); }
__device__ __forceinline__ float sigmoidf_(float x) { return 1.f / (1.f + expf(-x)); }
__device__ __forceinline__ float siluf_(float x) { return x / (1.f + expf(-x)); }
__device__ __forceinline__ float gelu_tanh(float x) { const float c = 0.7978845608028654f; return 0.5f * x * (1.f + tanhf(c * (x + 0.044715f * x * x * x))); }
__device__ __forceinline__ float softplusf_(float x) { return x > 20.f ? x : log1pf(expf(x)); }

struct KP {
    const float *x_prompt, *x_sample, *cache_cmp, *cache_slc, *st_win, *st_gconv, *st_gS, *st_dil, *st_ffn;
    const int* page_table;
    const float *w_in_a, *cw1, *cb1, *cw2, *cpe, *gconv_w, *gA, *gdt, *gnw, *w_out_a, *w_in_c, *w_out_c, *ln_mix_g, *ln_mix_b,
                *ffn_w_in, *ffn_cw, *ffn_cb, *ffn_w_out, *ln_ffn_g, *ln_ffn_b;
    float* out;
    unsigned* ctl;
    bf16 *WT_A, *WT_OA, *WT_FI0, *WT_FI1, *WT_FO0, *WT_FO1, *WT_CI, *WT_CO;
    float2* ROPE;
    bf16 *ACTB, *MIXB, *HFFB, *MOB, *H1B, *H0B; float* ZF;
    bf16 *QB, *KSF, *VSF, *KWF, *VWF, *CKF, *CVF;
    unsigned char *KS8, *VS8;
    bf16 *QDB; bf16* DKF[3]; bf16* DVF[3];
    bf16 *AC, *WT_C, *HID, *W2T, *ACP; float* SMIXF; float* NSACC; int* SEL; float* UB;
    bf16 *G_WF, *G_KDF, *G_QGF, *G_QKF, *G_SPF, *G_VNF; float *G_UF, *G_GL;
    float *BIGF, *MO, *X1, *X2, *X3, *QR, *KS, *VS, *KW, *VW, *CK, *CV, *GQ, *GK, *GV, *OG, *Gg, *Gb, *QD, *KD;
    int ph_lo, ph_hi;
};

struct Fr { unsigned char* lds; int tid, lane, wave, gw, NGW, bid, G; int tgt, tGT; };
__device__ __forceinline__ float h0f(const KP& p, int t, int c) { return __uint_as_float((unsigned)p.H0B[(size_t)t * PAP + c] << 16); }

__device__ __forceinline__ int ffn_row(int u) { const int half = u >= DFF ? 1 : 0, jc = u - half * DFF; return 256 * (jc >> 7) + 128 * half + (jc & 127); }
__device__ __forceinline__ void transpose_item(const float* W, int K, int N, int NT, bf16* WT, float* scr, int item, int lane, int rowmap = 0) {
    const int nblk = NT / 32, kb = item / nblk, nb = item % nblk, k0 = 64 * kb, n0 = 32 * nb;
#pragma unroll 8
    for (int i = 0; i < 32; ++i) { const int kk = 2 * i + (lane >> 5); const int n = n0 + (lane & 31); scr[kk * 33 + (lane & 31)] = (n < N) ? W[(size_t)(k0 + kk) * N + n] : 0.f; }
    wave_lds_sync();
    const int c = lane & 7;
#pragma unroll
    for (int j = 0; j < 4; ++j) { const int n = (lane >> 3) + 8 * j; const float* s = scr + (8 * c) * 33 + n;
        v4u o; o.x = pk2(s[0 * 33], s[1 * 33]); o.y = pk2(s[2 * 33], s[3 * 33]); o.z = pk2(s[4 * 33], s[5 * 33]); o.w = pk2(s[6 * 33], s[7 * 33]);
        const int row = rowmap ? ffn_row(n0 + n) : n0 + n;
        *(v4u*)(WT + (size_t)row * K + k0 + 8 * c) = o; }
    wave_lds_sync();
}
__device__ __forceinline__ void ph_prologue(const KP& p, const Fr& F) {
    float* scr = (float*)(F.lds + F.wave * 16384);
    const int I_A = 16 * (PAP / 32), I_OA = 16 * 32, I_FI = 16 * (DFF2 / 32), I_FO = (DFF / 64) * 32, I_CI = 16 * (3072 / 32), I_CO = 16 * 32;
    const int NITEMS = I_A + I_OA + 2 * I_FI + 2 * I_FO + I_CI + I_CO + 256 + 8;
    for (int it = F.gw; it < NITEMS; it += F.NGW) {
        int r = it;
        if (r < I_A) { transpose_item(p.w_in_a, DM, PA, PAP, p.WT_A, scr, r, F.lane); continue; } r -= I_A;
        if (r < I_OA) { transpose_item(p.w_out_a, DM, DM, DM, p.WT_OA, scr, r, F.lane); continue; } r -= I_OA;
        if (r < I_FI) { transpose_item(p.ffn_w_in, DM, DFF2, DFF2, p.WT_FI0, scr, r, F.lane, 1); continue; } r -= I_FI;
        if (r < I_FI) { transpose_item(p.ffn_w_in + (size_t)DM * DFF2, DM, DFF2, DFF2, p.WT_FI1, scr, r, F.lane, 1); continue; } r -= I_FI;
        if (r < I_FO) { transpose_item(p.ffn_w_out, DFF, DM, DM, p.WT_FO0, scr, r, F.lane); continue; } r -= I_FO;
        if (r < I_FO) { transpose_item(p.ffn_w_out + (size_t)DFF * DM, DFF, DM, DM, p.WT_FO1, scr, r, F.lane); continue; } r -= I_FO;
        if (r < I_CI) { transpose_item(p.w_in_c, DM, 3072, 3072, p.WT_CI, scr, r, F.lane); continue; } r -= I_CI;
        if (r < I_CO) { transpose_item(p.w_out_c, DM, DM, DM, p.WT_CO, scr, r, F.lane); continue; } r -= I_CO;
        if (r < 256) { const int kv = r >> 7; transpose_item(p.cw1 + (size_t)kv * 2048 * 128, 2048, 128, 128, p.WT_C + (size_t)kv * 128 * 2048, scr, r & 127, F.lane); continue; } r -= 256;
        { const int kv = r >> 2; transpose_item(p.cw2 + (size_t)kv * 128 * 64, 128, 64, 64, p.W2T + (size_t)kv * 64 * 128, scr, r & 3, F.lane); }
    }
    const size_t gt = (size_t)F.bid * NTHR + F.tid, GT = (size_t)F.G * NTHR;
    for (size_t i4 = gt; i4 < (size_t)TSP * (DM / 4); i4 += GT) {
        const int r = (int)(i4 / (DM / 4)), c4 = (int)(i4 % (DM / 4));
        float4 v = make_float4(0.f, 0.f, 0.f, 0.f);
        if (r < T) v = ((const float4*)p.x_prompt)[(size_t)r * (DM / 4) + c4]; else if (r < TS) v = ((const float4*)p.x_sample)[(size_t)(r - T) * (DM / 4) + c4];
        uint2 o; o.x = pk2(v.x, v.y); o.y = pk2(v.z, v.w);
        ((uint2*)p.ACTB)[i4] = o;
    }
    for (size_t idx = gt; idx < (size_t)(T + 1) * 32; idx += GT) {
        const int pos = (int)(idx >> 5), i = (int)(idx & 31);
        const float inv = (float)pow(10000.0, -2.0 * (double)i / 64.0);
        const float ang = (float)pos * inv;
        p.ROPE[idx] = make_float2((float)cos((double)ang), (float)sin((double)ang));
    }
}

__device__ __forceinline__ size_t vfrag_elem(int key, int d);
__device__ __forceinline__ size_t kfrag_elem(int key, int d);
__device__ __forceinline__ bf16x8 pack_p(const f32x4& p0, const f32x4& p1);
template <bool FFNMAP = false, bool OUTBF = false>
__device__ __forceinline__ void skinny_gemm(const Fr& F, const bf16* A, const bf16* Bt, int K, int ncols, float* C, int ldc) {
    const int lane = F.lane, l15 = lane & 15, grp = lane >> 4;
    const int kper = K >> 3, k0 = F.wave * kper;
    const bf16* a0 = A + (size_t)(T + l15) * K + 8 * grp + k0; const bf16* a1 = a0 + (size_t)16 * K;
    f32x4* red = (f32x4*)F.lds;
    const int ntiles = (ncols + 15) >> 4;
    for (int nt = F.bid; nt < ntiles; nt += F.G) {
        const bf16* bp = Bt + (size_t)(nt * 16 + l15) * K + 8 * grp + k0;
        f32x4 c0 = {0.f, 0.f, 0.f, 0.f}, c1 = {0.f, 0.f, 0.f, 0.f};
#pragma unroll 4
        for (int k = 0; k < kper; k += 32) {
            const bf16x8 b = *(const bf16x8*)(bp + k), x0 = *(const bf16x8*)(a0 + k), x1 = *(const bf16x8*)(a1 + k);
            c0 = MFMA16(x0, b, c0); c1 = MFMA16(x1, b, c1);
        }
        red[(F.wave * 2 + 0) * 64 + lane] = c0; red[(F.wave * 2 + 1) * 64 + lane] = c1;
        __syncthreads();
        if (F.wave == 0) {
#pragma unroll
            for (int w = 1; w < 8; ++w) { c0 = c0 + red[(w * 2 + 0) * 64 + lane]; c1 = c1 + red[(w * 2 + 1) * 64 + lane]; }
            int n = nt * 16 + l15;
            if (FFNMAP) n = ((n >> 7) & 1) * DFF + (n >> 8) * 128 + (n & 127);
            if (n < ncols) {
#pragma unroll
                for (int r = 0; r < 4; ++r) {
                    if (OUTBF) { ((bf16*)C)[(size_t)(T + 4 * grp + r) * ldc + n] = (bf16)f2bf(c0[r]); ((bf16*)C)[(size_t)(T + 16 + 4 * grp + r) * ldc + n] = (bf16)f2bf(c1[r]); }
                    else { C[(size_t)(T + 4 * grp + r) * ldc + n] = c0[r]; C[(size_t)(T + 16 + 4 * grp + r) * ldc + n] = c1[r]; } }
            }
        }
        __syncthreads();
    }
}
__device__ __forceinline__ void ph_gemm_f32(const Fr& F, const bf16* A, const bf16* Bt, int N, int K, float* C, int ldc, int ncols) {
    skinny_gemm(F, A, Bt, K, ncols, C, ldc);
    pg8::Gemm g{A, Bt, T, N, K}; pg8::StaticOrder S; S.init(T, N, F.G, F.bid);
    pg8::EpiF32 E{C, ldc, ncols};
    pg8::gemm_phase<pg8::EpiF32, pg8::StaticOrder, PG8_ALIGN, PG8_SP2>((PG8_LAS unsigned char*)F.lds, g, S, E);
}
__device__ __forceinline__ void ph_gemm_h1(const KP& p, const Fr& F) {
    skinny_gemm(F, p.ACTB, p.WT_CI, DM, 3072, p.BIGF, 3072);
    pg8::Gemm g{p.ACTB, p.WT_CI, T, 3072, DM}; pg8::StaticOrder S; S.init(T, 3072, F.G, F.bid);
    pg8::EpiBf16<0> E{p.H1B, 3072, nullptr, 0, 0, 1.f};
    pg8::gemm_phase<pg8::EpiBf16<0>, pg8::StaticOrder, PG8_ALIGN, PG8_SP2>((PG8_LAS unsigned char*)F.lds, g, S, E);
}
__device__ __forceinline__ void ph_gemm_h0(const KP& p, const Fr& F) {
    skinny_gemm(F, p.ACTB, p.WT_A, DM, PA, p.BIGF, PA);
    pg8::Gemm g{p.ACTB, p.WT_A, T, PAP, DM}; pg8::StaticOrder S; S.init(T, PAP, F.G, F.bid);
    pg8::EpiBf16<0> E{p.H0B, PAP, nullptr, 0, 0, 1.f};
    pg8::gemm_phase<pg8::EpiBf16<0>, pg8::StaticOrder, PG8_ALIGN, PG8_SP2>((PG8_LAS unsigned char*)F.lds, g, S, E);
}
__device__ __forceinline__ void ph_gemm_bf16(const Fr& F, const bf16* A, const bf16* Bt, int K, bf16* C) {
    skinny_gemm<false, true>(F, A, Bt, K, DM, (float*)C, DM);
    pg8::Gemm g{A, Bt, T, DM, K}; pg8::StaticOrder S; S.init(T, DM, F.G, F.bid);
    pg8::EpiBf16<0> E{C, DM, nullptr, 0, 0, 1.f};
    pg8::gemm_phase<pg8::EpiBf16<0>, pg8::StaticOrder, PG8_ALIGN, PG8_SP2>((PG8_LAS unsigned char*)F.lds, g, S, E);
}
__device__ __forceinline__ void ph_ln_b(const Fr& F, bf16* XB, const bf16* FB, const float* gam, const float* bet, float* outp, float* outs) {
    const int lane = F.lane;
    for (int r = F.gw; r < TS; r += F.NGW) {
        float v[16]; float s = 0.f;
#pragma unroll
        for (int j = 0; j < 2; ++j) {
            const v4u x = *(const v4u*)(XB + (size_t)r * DM + 512 * j + 8 * lane), f = *(const v4u*)(FB + (size_t)r * DM + 512 * j + 8 * lane);
#pragma unroll
            for (int e = 0; e < 4; ++e) {
                v[8 * j + 2 * e] = DN_ALPHA * __uint_as_float(x[e] << 16) + __uint_as_float(f[e] << 16);
                v[8 * j + 2 * e + 1] = DN_ALPHA * __uint_as_float(x[e] & 0xffff0000u) + __uint_as_float(f[e] & 0xffff0000u);
            }
        }
#pragma unroll
        for (int i = 0; i < 16; ++i) s += v[i];
        const float mean = wave_sum(s) * (1.f / DM); float q = 0.f;
#pragma unroll
        for (int i = 0; i < 16; ++i) { v[i] -= mean; q += v[i] * v[i]; }
        const float rstd = rsqrtf(wave_sum(q) * (1.f / DM) + LN_EPS);
#pragma unroll
        for (int j = 0; j < 2; ++j) {
            const int c0 = 512 * j + 8 * lane;
            const float4 g0 = *(const float4*)(gam + c0), g1 = *(const float4*)(gam + c0 + 4), b0 = *(const float4*)(bet + c0), b1 = *(const float4*)(bet + c0 + 4);
            const float y0 = v[8 * j + 0] * rstd * g0.x + b0.x, y1 = v[8 * j + 1] * rstd * g0.y + b0.y, y2 = v[8 * j + 2] * rstd * g0.z + b0.z, y3 = v[8 * j + 3] * rstd * g0.w + b0.w;
            const float y4 = v[8 * j + 4] * rstd * g1.x + b1.x, y5 = v[8 * j + 5] * rstd * g1.y + b1.y, y6 = v[8 * j + 6] * rstd * g1.z + b1.z, y7 = v[8 * j + 7] * rstd * g1.w + b1.w;
            if (outp) { float* o = ((r < T) ? outp + (size_t)r * DM : outs + (size_t)(r - T) * DM) + c0;
                *(float4*)o = make_float4(y0, y1, y2, y3); *(float4*)(o + 4) = make_float4(y4, y5, y6, y7); }
            else { v4u w; w.x = pk2(y0, y1); w.y = pk2(y2, y3); w.z = pk2(y4, y5); w.w = pk2(y6, y7); *(v4u*)(XB + (size_t)r * DM + c0) = w; }
        }
    }
}
__device__ __forceinline__ float dpp_ror1(float x) { return __int_as_float(__builtin_amdgcn_update_dpp(0, __float_as_int(x), 0x121, 0xf, 0xf, false)); }
__device__ __forceinline__ float dpp_ror2(float x) { return __int_as_float(__builtin_amdgcn_update_dpp(0, __float_as_int(x), 0x122, 0xf, 0xf, false)); }
struct EpiFfn {
    static constexpr bool PERM = true, AFTER_DRAIN = false;
    bf16* H; float* UB; const float* cw; const float* cb;
    __device__ __forceinline__ void operator()(const pg8::f32x4 (&acc)[2][2][4][2], const pg8::Unit& u, int wr, int wc, int fr, int fq) const {
#pragma unroll
        for (int n = 0; n < 2; ++n) {
            const int jc = u.pn * 128 + wc * 32 + 8 * fq + 4 * n;
            pg8::f32x4 w0[2], w1[2], w2[2], bb[2];
#pragma unroll
            for (int bj = 0; bj < 2; ++bj) { const int uc = bj * DFF + jc;
                w0[bj] = *(const pg8::f32x4*)(cw + uc); w1[bj] = *(const pg8::f32x4*)(cw + DFF2 + uc); w2[bj] = *(const pg8::f32x4*)(cw + 2 * DFF2 + uc); bb[bj] = *(const pg8::f32x4*)(cb + uc); }
#pragma unroll
            for (int ai = 0; ai < 2; ++ai) {
                const int sl = u.pm * 4 + ai * 2 + wr;
                pg8::f32x4 pr1[2], pr2[2];
#pragma unroll
                for (int m = 0; m < 4; ++m) {
                    pg8::f32x4 c[2];
#pragma unroll
                    for (int bj = 0; bj < 2; ++bj) {
                        const pg8::f32x4 uu = acc[ai][bj][m][n]; pg8::f32x4 r1, r2;
#pragma unroll
                        for (int e = 0; e < 4; ++e) { r1[e] = dpp_ror1(uu[e]); r2[e] = dpp_ror2(uu[e]); }
                        pg8::f32x4 p1 = r1, p2 = r2;
                        if (m > 0) { if (fr == 0) p1 = pr1[bj]; if (fr < 2) p2 = pr2[bj]; }
                        c[bj] = bb[bj] + w0[bj] * p2 + w1[bj] * p1 + w2[bj] * uu;
                        pr1[bj] = r1; pr2[bj] = r2;
                        const int uc = bj * DFF + jc;
                        if (m == 0 && fr < 2) *(pg8::f32x4*)(UB + ((size_t)sl * 4 + fr) * DFF2 + uc) = uu;
                        if (m == 3 && fr >= 14) *(pg8::f32x4*)(UB + ((size_t)sl * 4 + 2 + (fr - 14)) * DFF2 + uc) = uu;
                    }
                    if (!(m == 0 && fr < 2)) {
                        const int t = u.pm * 256 + ai * 128 + wr * 64 + m * 16 + fr;
                        uint2 o; o.x = pk2(fsilu_(c[0][0]) * c[1][0], fsilu_(c[0][1]) * c[1][1]); o.y = pk2(fsilu_(c[0][2]) * c[1][2], fsilu_(c[0][3]) * c[1][3]);
                        *(uint2*)(H + (size_t)t * DFF + jc) = o;
                    }
                }
            }
        }
    }
};
__device__ __forceinline__ void ph_ffn_gemm(const KP& p, const Fr& F, const bf16* Bt, int layer) {
    skinny_gemm<true>(F, p.ACTB, Bt, DM, DFF2, p.BIGF, DFF2);
    pg8::Gemm g{p.ACTB, Bt, T, DFF2, DM}; pg8::StaticOrder S; S.init(T, DFF2, F.G, F.bid);
    EpiFfn E{p.HFFB, p.UB, p.ffn_cw + (size_t)layer * 3 * DFF2, p.ffn_cb + (size_t)layer * DFF2};
    pg8::gemm_phase<EpiFfn, pg8::StaticOrder, PG8_ALIGN, PG8_SP2>((PG8_LAS unsigned char*)F.lds, g, S, E);
}
__device__ __forceinline__ void ph_ffn_fix(const KP& p, const Fr& F, int layer) {
    const float* cw = p.ffn_cw + (size_t)layer * 3 * DFF2; const float* cb = p.ffn_cb + (size_t)layer * DFF2; const float* U = p.BIGF;
    const int gt = F.bid * NTHR + F.tid, GT = F.G * NTHR;
    for (int idx = gt; idx < 512 * DFF; idx += GT) {
        const int rr = idx / DFF, j = idx - rr * DFF; const int sl = rr >> 1, q = rr & 1;
        float c2[2];
#pragma unroll
        for (int half = 0; half < 2; ++half) { const int ch = half * DFF + j;
            const float u0 = p.UB[((size_t)sl * 4 + q) * DFF2 + ch];
            const float um1 = q ? p.UB[((size_t)sl * 4) * DFF2 + ch] : (sl ? p.UB[((size_t)(sl - 1) * 4 + 3) * DFF2 + ch] : 0.f);
            const float um2 = sl ? p.UB[((size_t)(sl - 1) * 4 + 2 + q) * DFF2 + ch] : 0.f;
            c2[half] = cb[ch] + cw[ch] * um2 + cw[DFF2 + ch] * um1 + cw[2 * DFF2 + ch] * u0; }
        p.HFFB[(size_t)(64 * sl + q) * DFF + j] = (bf16)f2bf(siluf_(c2[0]) * c2[1]);
    }
    for (int idx = gt; idx < NSMP * DFF; idx += GT) {
        const int b = idx / DFF, j = idx - b * DFF;
        float c2[2];
#pragma unroll
        for (int half = 0; half < 2; ++half) { const int ch = half * DFF + j;
            const float* hs = p.st_ffn + (((size_t)b * 2 + layer) * 2) * DFF2 + ch;
            c2[half] = cb[ch] + cw[ch] * hs[0] + cw[DFF2 + ch] * hs[DFF2] + cw[2 * DFF2 + ch] * U[(size_t)(T + b) * DFF2 + ch]; }
        p.HFFB[(size_t)(T + b) * DFF + j] = (bf16)f2bf(siluf_(c2[0]) * c2[1]);
    }
    for (int idx = gt; idx < 2 * DFF2; idx += GT) { const int k = idx / DFF2, ch = idx - k * DFF2;
        p.out[O_FFN_P + ((size_t)layer * 2 + k) * DFF2 + ch] = p.UB[((size_t)255 * 4 + 2 + k) * DFF2 + ch]; }
    for (int idx = gt; idx < NSMP * 2 * DFF2; idx += GT) { const int b = idx / (2 * DFF2), k = (idx / DFF2) & 1, ch = idx % DFF2;
        p.out[O_FFN_S + (((size_t)b * 2 + layer) * 2 + k) * DFF2 + ch] = (k == 0) ? p.st_ffn[(((size_t)b * 2 + layer) * 2 + 1) * DFF2 + ch] : U[(size_t)(T + b) * DFF2 + ch]; }
}
struct EpiCmp {
    static constexpr bool PERM = false, AFTER_DRAIN = false;
    bf16* HID; const float* b1;
    __device__ __forceinline__ void operator()(const pg8::f32x4 (&acc)[2][2][4][2], const pg8::Unit& u, int wr, int wc, int fr, int fq) const {
#pragma unroll
        for (int ai = 0; ai < 2; ++ai)
#pragma unroll
            for (int m = 0; m < 4; ++m) { const int combo = u.pm * 128 + wr * 64 + m * 16 + fr;
#pragma unroll
                for (int n = 0; n < 2; ++n) { const int j0 = wc * 32 + n * 16 + 4 * fq; const pg8::f32x4 v = acc[ai][ai][m][n]; const float* bb = b1 + ai * 128 + j0;
                    uint2 o; o.x = pk2(gelu_tanh(v[0] + bb[0]), gelu_tanh(v[1] + bb[1])); o.y = pk2(gelu_tanh(v[2] + bb[2]), gelu_tanh(v[3] + bb[3]));
                    *(uint2*)(HID + ((size_t)combo * 2 + ai) * 128 + j0) = o; } }
    }
};
__device__ __forceinline__ void ph_cmp_gemm(const KP& p, const Fr& F) {
    pg8::Gemm g{p.AC, p.WT_C, 65536, 256, 2048}; pg8::StaticOrder S; S.init(65536, 256, F.G, F.bid);
    EpiCmp E{p.HID, p.cb1};
    pg8::gemm_phase<EpiCmp, pg8::StaticOrder, PG8_ALIGN, PG8_SP2>((PG8_LAS unsigned char*)F.lds, g, S, E);
}
__device__ __forceinline__ void ph_cmp_stage2(const KP& p, const Fr& F) {
    const int lane = F.lane, l15 = lane & 15, grp = lane >> 4;
    for (int tile = F.gw; tile < 4096; tile += F.NGW) {
        const int kv = tile & 1, combo0 = (tile >> 1) * 16;
        const bf16* hid = p.HID + ((size_t)(combo0 + l15) * 2 + kv) * 128 + 8 * grp; const bf16* w2 = p.W2T + (size_t)kv * 64 * 128 + (size_t)l15 * 128 + 8 * grp;
        f32x4 acc[4];
#pragma unroll
        for (int nt = 0; nt < 4; ++nt) acc[nt] = (f32x4){0.f, 0.f, 0.f, 0.f};
#pragma unroll
        for (int ks = 0; ks < 4; ++ks) { const bf16x8 a = *(const bf16x8*)(hid + 32 * ks);
#pragma unroll
            for (int nt = 0; nt < 4; ++nt) acc[nt] = MFMA16(a, *(const bf16x8*)(w2 + (size_t)nt * 16 * 128 + 32 * ks), acc[nt]); }
#pragma unroll
        for (int r = 0; r < 4; ++r) {
            const int combo = combo0 + 4 * grp + r; const int g = combo & 1, c = (combo >> 1) & 511, b = combo >> 10;
            float* dst = ((kv == 0) ? p.CK : p.CV) + (((size_t)(1 + b) * 512 + c) * 2 + g) * 64;
            if (kv == 0) {
                const int pos = (c + 1) * 32 - 1;
#pragma unroll
                for (int nt = 0; nt < 2; ++nt) { const float2 cs = p.ROPE[pos * 32 + 16 * nt + l15]; const float x1 = acc[nt][r], x2 = acc[nt + 2][r];
                    dst[16 * nt + l15] = x1 * cs.x - x2 * cs.y; dst[16 * (nt + 2) + l15] = x2 * cs.x + x1 * cs.y; }
            } else {
#pragma unroll
                for (int nt = 0; nt < 4; ++nt) dst[16 * nt + l15] = acc[nt][r];
            }
        }
    }
}
__device__ __forceinline__ void cmp_prompt_unit(const KP& p, int unit, int lane) {
    asm volatile("" : "+v"(lane));
    const int l15 = lane & 15, grp = lane >> 4;
    const int kv = unit & 1, combo = (unit >> 1) * 16 + l15; const int g = combo & 1, c = combo >> 1;
    const bf16* w1 = p.WT_C + ((size_t)kv * 128 + l15) * 2048 + 8 * grp;
    f32x4 acc[8];
#pragma unroll
    for (int jt = 0; jt < 8; ++jt) acc[jt] = (f32x4){0.f, 0.f, 0.f, 0.f};
    const bf16* hsrc = p.H0B + (size_t)(c * 32) * PAP + C_KC + kv * 128 + g * 64 + 8 * grp; const float* pe = p.cpe + (size_t)kv * 32 * 64 + 8 * grp;
#pragma unroll 4
    for (int ks = 0; ks < 64; ++ks) {
        const int i = ks >> 1, dd = 32 * (ks & 1);
        const v4u hx = *(const v4u*)(hsrc + (size_t)i * PAP + dd); const float4 e0 = *(const float4*)(pe + i * 64 + dd), e1 = *(const float4*)(pe + i * 64 + dd + 4);
        union { v4u u; bf16x8 b; } fbu;
        fbu.u.x = pk2(__uint_as_float(hx[0] << 16) + e0.x, __uint_as_float(hx[0] & 0xffff0000u) + e0.y); fbu.u.y = pk2(__uint_as_float(hx[1] << 16) + e0.z, __uint_as_float(hx[1] & 0xffff0000u) + e0.w);
        fbu.u.z = pk2(__uint_as_float(hx[2] << 16) + e1.x, __uint_as_float(hx[2] & 0xffff0000u) + e1.y); fbu.u.w = pk2(__uint_as_float(hx[3] << 16) + e1.z, __uint_as_float(hx[3] & 0xffff0000u) + e1.w);
        const bf16x8 fb = fbu.b;
#pragma unroll
        for (int jt = 0; jt < 8; ++jt) acc[jt] = MFMA16(*(const bf16x8*)(w1 + (size_t)jt * 16 * 2048 + 32 * ks), fb, acc[jt]);
    }
    bf16x8 hb[4];
#pragma unroll
    for (int s2 = 0; s2 < 4; ++s2) {
        f32x4 h0, h1;
#pragma unroll
        for (int r = 0; r < 4; ++r) { h0[r] = gelu_tanh(acc[2 * s2][r] + p.cb1[kv * 128 + 32 * s2 + 4 * grp + r]); h1[r] = gelu_tanh(acc[2 * s2 + 1][r] + p.cb1[kv * 128 + 32 * s2 + 16 + 4 * grp + r]); }
        hb[s2] = pack_p(h0, h1);
    }
    f32x4 o[4];
#pragma unroll
    for (int dt = 0; dt < 4; ++dt) {
        o[dt] = (f32x4){0.f, 0.f, 0.f, 0.f};
        const bf16* w2 = p.W2T + (size_t)kv * 64 * 128 + (size_t)(16 * dt + l15) * 128 + 4 * grp;
#pragma unroll
        for (int s2 = 0; s2 < 4; ++s2) { const uint2 x0 = *(const uint2*)(w2 + 32 * s2), x1 = *(const uint2*)(w2 + 32 * s2 + 16);
            union { v4u u; bf16x8 b; } wa; wa.u.x = x0.x; wa.u.y = x0.y; wa.u.z = x1.x; wa.u.w = x1.y;
            o[dt] = MFMA16(wa.b, hb[s2], o[dt]); }
    }
    if (kv == 0) {
        const int pos = (c + 1) * 32 - 1;
#pragma unroll
        for (int dt = 0; dt < 2; ++dt)
#pragma unroll
            for (int r = 0; r < 4; ++r) { const float2 cs = p.ROPE[pos * 32 + 16 * dt + 4 * grp + r]; const float x1 = o[dt][r], x2 = o[dt + 2][r];
                o[dt][r] = x1 * cs.x - x2 * cs.y; o[dt + 2][r] = x2 * cs.x + x1 * cs.y; }
    }
#pragma unroll
    for (int dt = 0; dt < 4; ++dt)
#pragma unroll
        for (int r = 0; r < 4; ++r) { const int d = 16 * dt + 4 * grp + r;
            if (kv == 0) p.CKF[(size_t)g * 512 * 64 + kfrag_elem(c, d)] = (bf16)f2bf(o[dt][r]); else p.CVF[(size_t)g * 512 * 64 + vfrag_elem(c, d)] = (bf16)f2bf(o[dt][r]); }
}
__device__ __forceinline__ void cmp_sample_unit(const KP& p, int unit, int lane) {
    asm volatile("" : "+v"(lane));
    const int l15 = lane & 15, grp = lane >> 4;
    const int b = unit >> 6, kv = (unit >> 5) & 1, cb = unit & 31;
    const bf16* w1 = p.WT_C + ((size_t)kv * 128 + l15) * 2048 + 8 * grp;
    const float* src[2];
#pragma unroll
    for (int cg = 0; cg < 2; ++cg) { const int combo = cb * 32 + 16 * cg + l15; const int g = combo & 1, c = combo >> 1;
        const int page = p.page_table[b * NPAGES + (c >> 2)];
        src[cg] = p.cache_cmp + (((size_t)page * 128 + (c & 3) * 32) * 4 + kv * 2 + g) * 64 + 8 * grp; }
    const float* pe = p.cpe + (size_t)kv * 32 * 64 + 8 * grp;
    f32x4 acc[2][8];
#pragma unroll
    for (int cg = 0; cg < 2; ++cg)
#pragma unroll
        for (int jt = 0; jt < 8; ++jt) acc[cg][jt] = (f32x4){0.f, 0.f, 0.f, 0.f};
#pragma unroll 2
    for (int ks = 0; ks < 64; ++ks) {
        const int i = ks >> 1, dd = 32 * (ks & 1);
        const float4 e0 = *(const float4*)(pe + i * 64 + dd), e1 = *(const float4*)(pe + i * 64 + dd + 4);
        bf16x8 fb[2];
#pragma unroll
        for (int cg = 0; cg < 2; ++cg) { const float4 a0 = *(const float4*)(src[cg] + i * 256 + dd), a1 = *(const float4*)(src[cg] + i * 256 + dd + 4);
            union { v4u u; bf16x8 b; } t; t.u.x = pk2(a0.x + e0.x, a0.y + e0.y); t.u.y = pk2(a0.z + e0.z, a0.w + e0.w); t.u.z = pk2(a1.x + e1.x, a1.y + e1.y); t.u.w = pk2(a1.z + e1.z, a1.w + e1.w); fb[cg] = t.b; }
#pragma unroll
        for (int jt = 0; jt < 8; ++jt) { const bf16x8 wa = *(const bf16x8*)(w1 + (size_t)jt * 16 * 2048 + 32 * ks);
            acc[0][jt] = MFMA16(wa, fb[0], acc[0][jt]); acc[1][jt] = MFMA16(wa, fb[1], acc[1][jt]); }
    }
#pragma unroll
    for (int cg = 0; cg < 2; ++cg) {
        const int combo = cb * 32 + 16 * cg + l15; const int g = combo & 1, c = combo >> 1;
        bf16x8 hb[4];
#pragma unroll
        for (int s2 = 0; s2 < 4; ++s2) { f32x4 h0, h1;
#pragma unroll
            for (int r = 0; r < 4; ++r) { h0[r] = gelu_tanh(acc[cg][2 * s2][r] + p.cb1[kv * 128 + 32 * s2 + 4 * grp + r]); h1[r] = gelu_tanh(acc[cg][2 * s2 + 1][r] + p.cb1[kv * 128 + 32 * s2 + 16 + 4 * grp + r]); }
            hb[s2] = pack_p(h0, h1); }
        f32x4 o[4];
#pragma unroll
        for (int dt = 0; dt < 4; ++dt) {
            o[dt] = (f32x4){0.f, 0.f, 0.f, 0.f};
            const bf16* w2 = p.W2T + (size_t)kv * 64 * 128 + (size_t)(16 * dt + l15) * 128 + 4 * grp;
#pragma unroll
            for (int s2 = 0; s2 < 4; ++s2) { const uint2 x0 = *(const uint2*)(w2 + 32 * s2), x1 = *(const uint2*)(w2 + 32 * s2 + 16);
                union { v4u u; bf16x8 b; } wa; wa.u.x = x0.x; wa.u.y = x0.y; wa.u.z = x1.x; wa.u.w = x1.y;
                o[dt] = MFMA16(wa.b, hb[s2], o[dt]); }
        }
        if (kv == 0) {
            const int pos = (c + 1) * 32 - 1;
#pragma unroll
            for (int dt = 0; dt < 2; ++dt)
#pragma unroll
                for (int r = 0; r < 4; ++r) { const float2 cs = p.ROPE[pos * 32 + 16 * dt + 4 * grp + r]; const float x1 = o[dt][r], x2 = o[dt + 2][r];
                    o[dt][r] = x1 * cs.x - x2 * cs.y; o[dt + 2][r] = x2 * cs.x + x1 * cs.y; }
        }
        float* dst = ((kv == 0) ? p.CK : p.CV) + (((size_t)(1 + b) * 512 + c) * 2 + g) * 64 + 4 * grp;
#pragma unroll
        for (int dt = 0; dt < 4; ++dt) *(f32x4*)(dst + 16 * dt) = o[dt];
    }
}
constexpr int W1S_PITCH = 528;
constexpr int W1S_BYTES = 128 * W1S_PITCH;
__device__ __forceinline__ void cmp_sample_wg(const KP& p, int wu, const Fr& F) {
    int lane = F.lane; asm volatile("" : "+v"(lane));
    const int l15 = lane & 15, grp = lane >> 4, tid = F.tid;
    const int b = wu >> 3, kv = (wu >> 2) & 1, q4 = wu & 3;
    const float* src[2];
#pragma unroll
    for (int cg = 0; cg < 2; ++cg) { const int combo = q4 * 256 + F.wave * 32 + 16 * cg + l15; const int g = combo & 1, c = combo >> 1;
        const int page = p.page_table[b * NPAGES + (c >> 2)];
        src[cg] = p.cache_cmp + (((size_t)page * 128 + (c & 3) * 32) * 4 + kv * 2 + g) * 64 + 8 * grp; }
    const float* pe = p.cpe + (size_t)kv * 32 * 64 + 8 * grp;
    const bf16* wg = p.WT_C + (size_t)kv * 128 * 2048;
    f32x4 acc[2][8];
#pragma unroll
    for (int cg = 0; cg < 2; ++cg)
#pragma unroll
        for (int jt = 0; jt < 8; ++jt) acc[cg][jt] = (f32x4){0.f, 0.f, 0.f, 0.f};
    v4u wreg[8];
#pragma unroll
    for (int k = 0; k < 8; ++k) { const int c = tid + 512 * k; wreg[k] = *(const v4u*)(wg + (size_t)(c >> 5) * 2048 + (c & 31) * 8); }
#pragma unroll
    for (int k = 0; k < 8; ++k) { const int c = tid + 512 * k; *(v4u*)(F.lds + (c >> 5) * W1S_PITCH + (c & 31) * 16) = wreg[k]; }
    __syncthreads();
#pragma unroll 1
    for (int sl = 0; sl < 8; ++sl) {
        if (sl + 1 < 8) {
#pragma unroll
            for (int k = 0; k < 8; ++k) { const int c = tid + 512 * k; wreg[k] = *(const v4u*)(wg + (size_t)(c >> 5) * 2048 + (sl + 1) * 256 + (c & 31) * 8); }
        }
        const unsigned char* wl = F.lds + (sl & 1) * W1S_BYTES + l15 * W1S_PITCH + grp * 16;
#pragma unroll 4
        for (int kk = 0; kk < 8; ++kk) {
            const int ks = sl * 8 + kk, i = ks >> 1, dd = 32 * (ks & 1);
            const float4 e0 = *(const float4*)(pe + i * 64 + dd), e1 = *(const float4*)(pe + i * 64 + dd + 4);
            bf16x8 fb[2];
#pragma unroll
            for (int cg = 0; cg < 2; ++cg) { const float4 a0 = *(const float4*)(src[cg] + i * 256 + dd), a1 = *(const float4*)(src[cg] + i * 256 + dd + 4);
                union { v4u u; bf16x8 b; } t; t.u.x = pk2(a0.x + e0.x, a0.y + e0.y); t.u.y = pk2(a0.z + e0.z, a0.w + e0.w); t.u.z = pk2(a1.x + e1.x, a1.y + e1.y); t.u.w = pk2(a1.z + e1.z, a1.w + e1.w); fb[cg] = t.b; }
#pragma unroll
            for (int jt = 0; jt < 8; ++jt) { const bf16x8 wa = *(const bf16x8*)(wl + jt * 16 * W1S_PITCH + kk * 64);
                acc[0][jt] = MFMA16(wa, fb[0], acc[0][jt]); acc[1][jt] = MFMA16(wa, fb[1], acc[1][jt]); }
        }
        if (sl + 1 < 8) {
#pragma unroll
            for (int k = 0; k < 8; ++k) { const int c = tid + 512 * k; *(v4u*)(F.lds + ((sl + 1) & 1) * W1S_BYTES + (c >> 5) * W1S_PITCH + (c & 31) * 16) = wreg[k]; }
        }
        __syncthreads();
    }
#pragma unroll
    for (int cg = 0; cg < 2; ++cg) {
        const int combo = q4 * 256 + F.wave * 32 + 16 * cg + l15; const int g = combo & 1, c = combo >> 1;
        bf16x8 hb[4];
#pragma unroll
        for (int s2 = 0; s2 < 4; ++s2) { f32x4 h0, h1;
#pragma unroll
            for (int r = 0; r < 4; ++r) { h0[r] = gelu_tanh(acc[cg][2 * s2][r] + p.cb1[kv * 128 + 32 * s2 + 4 * grp + r]); h1[r] = gelu_tanh(acc[cg][2 * s2 + 1][r] + p.cb1[kv * 128 + 32 * s2 + 16 + 4 * grp + r]); }
            hb[s2] = pack_p(h0, h1); }
        f32x4 o[4];
#pragma unroll
        for (int dt = 0; dt < 4; ++dt) {
            o[dt] = (f32x4){0.f, 0.f, 0.f, 0.f};
            const bf16* w2 = p.W2T + (size_t)kv * 64 * 128 + (size_t)(16 * dt + l15) * 128 + 4 * grp;
#pragma unroll
            for (int s2 = 0; s2 < 4; ++s2) { const uint2 x0 = *(const uint2*)(w2 + 32 * s2), x1 = *(const uint2*)(w2 + 32 * s2 + 16);
                union { v4u u; bf16x8 b; } wa; wa.u.x = x0.x; wa.u.y = x0.y; wa.u.z = x1.x; wa.u.w = x1.y;
                o[dt] = MFMA16(wa.b, hb[s2], o[dt]); }
        }
        if (kv == 0) {
            const int pos = (c + 1) * 32 - 1;
#pragma unroll
            for (int dt = 0; dt < 2; ++dt)
#pragma unroll
                for (int r = 0; r < 4; ++r) { const float2 cs = p.ROPE[pos * 32 + 16 * dt + 4 * grp + r]; const float x1 = o[dt][r], x2 = o[dt + 2][r];
                    o[dt][r] = x1 * cs.x - x2 * cs.y; o[dt + 2][r] = x2 * cs.x + x1 * cs.y; }
        }
        float* dst = ((kv == 0) ? p.CK : p.CV) + (((size_t)(1 + b) * 512 + c) * 2 + g) * 64 + 4 * grp;
#pragma unroll
        for (int dt = 0; dt < 4; ++dt) *(f32x4*)(dst + 16 * dt) = o[dt];
    }
}
__device__ __forceinline__ void ph_cmp_samples(const KP& p, const Fr& F) {
    for (int wu = F.bid; wu < 256; wu += F.G) cmp_sample_wg(p, wu, F);
}
__device__ __forceinline__ void ph_cmp_prompt(const KP& p, const Fr& F) {
    for (int unit = F.gw; unit < 128; unit += F.NGW) cmp_prompt_unit(p, unit, F.lane);
}

__device__ __forceinline__ float rope_val(const float* row, int base, int i, float2 cs) {
    const int ii = i & 31;
    const float x1 = row[base + ii], x2 = row[base + ii + 32];
    return (i < 32) ? (x1 * cs.x - x2 * cs.y) : (x2 * cs.x + x1 * cs.y);
}
__device__ __forceinline__ void ph_nsa_prep(const KP& p, const Fr& F) {
    const float* H0 = p.BIGF; float* out = p.out;
    const size_t gt = (size_t)F.tgt, GT = (size_t)F.tGT;
    const size_t total = (size_t)TS * 1280;
    for (size_t idx = gt + (size_t)T * 1280; idx < total; idx += GT) {
        const int r = (int)(idx / 1280), c = (int)(idx % 1280);
        const bool smp = r >= T; const int b = r - T; const int pos = smp ? T : r;
        const float* row = H0 + (size_t)r * PA;
        const int i = c & 63;
        const float2 cs = p.ROPE[pos * 32 + (i & 31)];
        if (c < 512) { p.QR[(size_t)r * 512 + c] = rope_val(row, c & ~63, i, cs); continue; }
        const int sec = (c - 512) >> 7; const int gd = (c - 512) & 127; const int base = c & ~63;
        float v;
        if (sec == 2 || sec == 4) v = rope_val(row, base, i, cs); else v = row[c];
        const int kv = sec & 1;
        if (sec < 2) {
            if (!smp) out[O_CMP_P + (size_t)r * 256 + kv * 128 + gd] = v; else out[O_CMP_S + (size_t)b * 256 + kv * 128 + gd] = v;
        } else if (sec < 4) {
            if (!smp) out[O_SLC_P + (size_t)r * 256 + kv * 128 + gd] = v; else out[O_SLC_S + (size_t)b * 256 + kv * 128 + gd] = v;
            if (kv == 0) p.KS[(size_t)r * 128 + gd] = v; else p.VS[(size_t)r * 128 + gd] = v;
        } else {
            if (kv == 0) p.KW[(size_t)r * 128 + gd] = v; else p.VW[(size_t)r * 128 + gd] = v;
            if (!smp) { if (r >= T - 512) out[O_WIN_P + (size_t)(r - (T - 512)) * 256 + kv * 128 + gd] = v; }
            else out[O_WIN_S + ((size_t)b * 512 + 511) * 256 + kv * 128 + gd] = v;
        }
    }
    const size_t tot2 = (size_t)NSMP * 511 * 256;
    for (size_t idx = gt; idx < tot2; idx += GT) {
        const int b = (int)(idx / (511 * 256)); const int rem = (int)(idx % (511 * 256));
        out[O_WIN_S + (size_t)b * 512 * 256 + rem] = p.st_win[(size_t)b * 512 * 256 + 256 + rem];
    }
}

constexpr float QSCALE = 0.18033688011112042f;

__device__ __forceinline__ size_t kfrag_off(int kt, int ks, int lane) { return ((size_t)(kt * 2 + ks) * 64 + lane) * 8; }
__device__ __forceinline__ size_t vfrag_off(int st, int dt, int lane) { return ((size_t)(st * 4 + dt) * 64 + lane) * 8; }
__device__ __forceinline__ size_t vfrag_elem(int key, int d) {
    const int st = key >> 5, kk = key & 31, tile = kk >> 4, r16 = kk & 15, grp = r16 >> 2, reg = r16 & 3;
    return ((size_t)(st * 4 + (d >> 4)) * 64 + (d & 15) + 16 * grp) * 8 + tile * 4 + reg;
}
__device__ __forceinline__ size_t k8_off(int key, int d) { return ((size_t)(key >> 4) * 64 + (key & 15) + 16 * ((d & 31) >> 3)) * 16 + (d >> 5) * 8 + (d & 7); }
__device__ __forceinline__ size_t v8_off(int key, int d) {
    const int blk = key >> 6, st = (key >> 5) & 1, kk = key & 31, tile = kk >> 4, r16 = kk & 15, grp = r16 >> 2, reg = r16 & 3;
    return ((size_t)(blk * 4 + (d >> 4)) * 64 + (d & 15) + 16 * grp) * 16 + st * 8 + tile * 4 + reg;
}
__device__ __forceinline__ size_t kfrag_elem(int key, int d) {
    return ((size_t)((key >> 4) * 2 + (d >> 5)) * 64 + (key & 15) + 16 * ((d & 31) >> 3)) * 8 + (d & 7);
}

__device__ __forceinline__ void ph_nsa_prep_fast(const KP& p, const Fr& F) {
    const float* H0 = p.BIGF; float* out = p.out;
    const size_t gt = (size_t)F.tgt, GT = (size_t)F.tGT;
    for (size_t idx = gt; idx < (size_t)T * 64; idx += GT) {
        const int t = (int)(idx >> 6), u = (int)(idx & 63);
        const v4u uz = *(const v4u*)(p.H0B + (size_t)t * PAP + C_Z + 8 * u); float* zo = p.ZF + (size_t)t * 512 + 8 * u;
        *(float4*)zo = make_float4(__uint_as_float(uz[0] << 16), __uint_as_float(uz[0] & 0xffff0000u), __uint_as_float(uz[1] << 16), __uint_as_float(uz[1] & 0xffff0000u));
        *(float4*)(zo + 4) = make_float4(__uint_as_float(uz[2] << 16), __uint_as_float(uz[2] & 0xffff0000u), __uint_as_float(uz[3] << 16), __uint_as_float(uz[3] & 0xffff0000u));
    }
    for (size_t idx = gt; idx < (size_t)T * 160; idx += GT) {
        const int t = (int)(idx / 160), u = (int)(idx % 160);
        const int c0 = u * 8; const bf16* row = p.H0B + (size_t)t * PAP;
        const v4u ua = *(const v4u*)(row + c0);
        float v[8];
#pragma unroll
        for (int e = 0; e < 4; ++e) { v[2 * e] = __uint_as_float(ua[e] << 16); v[2 * e + 1] = __uint_as_float(ua[e] & 0xffff0000u); }
        const int sec = (u < 64) ? -1 : ((u - 64) >> 4);
        const bool roped = (sec == -1 || sec == 2 || sec == 4);
        if (roped) {
            const int d0 = c0 & 63; const int pc = (d0 < 32) ? c0 + 32 : c0 - 32;
            const v4u ub = *(const v4u*)(row + pc);
            float w[8];
#pragma unroll
            for (int e = 0; e < 4; ++e) { w[2 * e] = __uint_as_float(ub[e] << 16); w[2 * e + 1] = __uint_as_float(ub[e] & 0xffff0000u); }
            const float4* rp = (const float4*)(p.ROPE + t * 32 + (d0 & 31)); const float4 r0 = rp[0], r1 = rp[1], r2 = rp[2], r3 = rp[3];
            const float cs[8] = {r0.x, r0.z, r1.x, r1.z, r2.x, r2.z, r3.x, r3.z}, sn[8] = {r0.y, r0.w, r1.y, r1.w, r2.y, r2.w, r3.y, r3.w};
#pragma unroll
            for (int j = 0; j < 8; ++j) v[j] = (d0 < 32) ? (v[j] * cs[j] - w[j] * sn[j]) : (v[j] * cs[j] + w[j] * sn[j]);
        }
        if (sec == -1) {
            v4u o; o.x = pk2(v[0] * QSCALE, v[1] * QSCALE); o.y = pk2(v[2] * QSCALE, v[3] * QSCALE); o.z = pk2(v[4] * QSCALE, v[5] * QSCALE); o.w = pk2(v[6] * QSCALE, v[7] * QSCALE);
            *(v4u*)(p.QB + (size_t)t * 512 + c0) = o; continue;
        }
        const int gd = (c0 - 512) & 127, g = gd >> 6, d0 = gd & 63, kv = sec & 1;
        const float4 o0 = make_float4(v[0], v[1], v[2], v[3]), o1 = make_float4(v[4], v[5], v[6], v[7]);
        if (sec < 2) { float* o = out + O_CMP_P + (size_t)t * 256 + kv * 128 + gd; *(float4*)o = o0; *(float4*)(o + 4) = o1;
            continue; }
        if (sec < 4) { float* o = out + O_SLC_P + (size_t)t * 256 + kv * 128 + gd; *(float4*)o = o0; *(float4*)(o + 4) = o1; }
        else if (t >= T - 512) { float* o = out + O_WIN_P + (size_t)(t - (T - 512)) * 256 + kv * 128 + gd; *(float4*)o = o0; *(float4*)(o + 4) = o1; }
        if (sec < 4) {
            if (kv == 0) {
                int w0 = 0, w1 = 0;
                w0 = __builtin_amdgcn_cvt_pk_fp8_f32(v[0], v[1], w0, false); w0 = __builtin_amdgcn_cvt_pk_fp8_f32(v[2], v[3], w0, true);
                w1 = __builtin_amdgcn_cvt_pk_fp8_f32(v[4], v[5], w1, false); w1 = __builtin_amdgcn_cvt_pk_fp8_f32(v[6], v[7], w1, true);
                *(uint2*)(p.KS8 + (size_t)g * T * 64 + k8_off(t, d0)) = make_uint2((unsigned)w0, (unsigned)w1);
            } else {
#pragma unroll
                for (int j = 0; j < 8; ++j) p.VS8[(size_t)g * T * 64 + v8_off(t, d0 + j)] = (unsigned char)(__builtin_amdgcn_cvt_pk_fp8_f32(v[j], 0.f, 0, false) & 0xff);
            }
            continue;
        }
        bf16* KF = p.KWF; bf16* VF = p.VWF;
        if (kv == 0) {
            v4u o; o.x = pk2(v[0], v[1]); o.y = pk2(v[2], v[3]); o.z = pk2(v[4], v[5]); o.w = pk2(v[6], v[7]);
            *(v4u*)(KF + (size_t)g * T * 64 + kfrag_elem(t, d0)) = o;
        } else {
#pragma unroll
            for (int j = 0; j < 8; ++j) VF[(size_t)g * T * 64 + vfrag_elem(t, d0 + j)] = (bf16)f2bf(v[j]);
        }
    }
}

struct AttW { f32x4 o[4]; float m, l; };
__device__ __forceinline__ void attw_init(AttW& a) {
#pragma unroll
    for (int i = 0; i < 4; ++i) a.o[i] = (f32x4){0.f, 0.f, 0.f, 0.f};
    a.m = -INFINITY; a.l = 0.f;
}
__device__ __forceinline__ void qk_step(const bf16x8 (&kf)[2][2], const bf16x8 (&qf)[2], f32x4& s0, f32x4& s1) {
    const f32x4 z = {0.f, 0.f, 0.f, 0.f};
    s0 = MFMA16(kf[0][0], qf[0], z); s0 = MFMA16(kf[0][1], qf[1], s0);
    s1 = MFMA16(kf[1][0], qf[0], z); s1 = MFMA16(kf[1][1], qf[1], s1);
}
__device__ __forceinline__ bf16x8 pack_p(const f32x4& p0, const f32x4& p1) {
    union { v4u u; bf16x8 b; } c;
    c.u.x = pg8::cvt_pk_bf16(p0[0], p0[1]); c.u.y = pg8::cvt_pk_bf16(p0[2], p0[3]); c.u.z = pg8::cvt_pk_bf16(p1[0], p1[1]); c.u.w = pg8::cvt_pk_bf16(p1[2], p1[3]);
    return c.b;
}
__device__ __forceinline__ void att_update(AttW& a, const f32x4& s0, const f32x4& s1, const bf16x8 (&vf)[4]) {
    float mx = fmaxf(fmaxf(fmaxf(s0[0], s0[1]), fmaxf(s0[2], s0[3])), fmaxf(fmaxf(s1[0], s1[1]), fmaxf(s1[2], s1[3])));
    mx = fmaxf(mx, __shfl_xor(mx, 16)); mx = fmaxf(mx, __shfl_xor(mx, 32));
    const float mn = fmaxf(a.m, mx);
    const float ms = (mn == -INFINITY) ? 0.f : mn;
    const float alpha = __builtin_amdgcn_exp2f(a.m - ms);
    f32x4 p0, p1;
#pragma unroll
    for (int i = 0; i < 4; ++i) { p0[i] = __builtin_amdgcn_exp2f(s0[i] - ms); p1[i] = __builtin_amdgcn_exp2f(s1[i] - ms); }
    a.l = a.l * alpha + ((p0[0] + p0[1]) + (p0[2] + p0[3])) + ((p1[0] + p1[1]) + (p1[2] + p1[3]));
    a.m = mn;
    const bf16x8 pf = pack_p(p0, p1);
#pragma unroll
    for (int dt = 0; dt < 4; ++dt) { a.o[dt] = a.o[dt] * alpha; a.o[dt] = MFMA16(vf[dt], pf, a.o[dt]); }
}
__device__ __forceinline__ float grp_sum(float v) { v += __shfl_xor(v, 16); v += __shfl_xor(v, 32); return v; }

__device__ __forceinline__ void nsa_fast_unit(const KP& p, int unit, float* wl, int lane) {
    asm volatile("" : "+v"(lane));
    const int g = unit & 1, t0 = (unit >> 1) * 16;
    const int qi = lane & 15, grp = lane >> 4, t = t0 + qi;
    float* imp = wl; int* sel = (int*)(wl + 4096);
    const bf16* growb = p.H0B + (size_t)t * PAP + C_GATE + g * 4;
#define GROWF(i) __uint_as_float((unsigned)growb[i] << 16)
    bf16x8 qf[4][2];
#pragma unroll
    for (int h = 0; h < 4; ++h)
#pragma unroll
        for (int ks = 0; ks < 2; ++ks) qf[h][ks] = *(const bf16x8*)(p.QB + (size_t)t * 512 + (g * 4 + h) * 64 + 32 * ks + 8 * grp);
    AttW st[4];
    {
        const bf16* CKF = p.CKF + (size_t)g * 512 * 64; const bf16* CVF = p.CVF + (size_t)g * 512 * 64;
        const int nmax = (t0 + 16) >> 5; const int nsteps = (nmax + 31) >> 5;
        const int nval = (t + 1) >> 5;
        float m[4], l[4];
#pragma unroll
        for (int h = 0; h < 4; ++h) { m[h] = -INFINITY; l[h] = 0.f; }
        for (int s = 0; s < nsteps; ++s) {
            bf16x8 kf[2][2];
#pragma unroll
            for (int tl = 0; tl < 2; ++tl)
#pragma unroll
                for (int ks = 0; ks < 2; ++ks) kf[tl][ks] = *(const bf16x8*)(CKF + kfrag_off(2 * s + tl, ks, lane));
            const int cb = 32 * s + 4 * grp;
#pragma unroll
            for (int h = 0; h < 4; ++h) {
                f32x4 s0, s1; qk_step(kf, qf[h], s0, s1);
#pragma unroll
                for (int i = 0; i < 4; ++i) { if (cb + i >= nval) s0[i] = -INFINITY; if (cb + 16 + i >= nval) s1[i] = -INFINITY; }
                float mx = fmaxf(fmaxf(fmaxf(s0[0], s0[1]), fmaxf(s0[2], s0[3])), fmaxf(fmaxf(s1[0], s1[1]), fmaxf(s1[2], s1[3])));
                mx = fmaxf(mx, __shfl_xor(mx, 16)); mx = fmaxf(mx, __shfl_xor(mx, 32));
                const float mn = fmaxf(m[h], mx); const float ms = (mn == -INFINITY) ? 0.f : mn;
                float sum = 0.f;
#pragma unroll
                for (int i = 0; i < 4; ++i) sum += __builtin_amdgcn_exp2f(s0[i] - ms) + __builtin_amdgcn_exp2f(s1[i] - ms);
                l[h] = l[h] * __builtin_amdgcn_exp2f(m[h] - ms) + sum; m[h] = mn;
            }
        }
        float il[4];
#pragma unroll
        for (int h = 0; h < 4; ++h) { const float lt = grp_sum(l[h]); il[h] = lt > 0.f ? 1.f / lt : 0.f; if (m[h] == -INFINITY) m[h] = 0.f; attw_init(st[h]); }
        for (int s = 0; s < nsteps; ++s) {
            bf16x8 kf[2][2], vf[4];
#pragma unroll
            for (int tl = 0; tl < 2; ++tl)
#pragma unroll
                for (int ks = 0; ks < 2; ++ks) kf[tl][ks] = *(const bf16x8*)(CKF + kfrag_off(2 * s + tl, ks, lane));
#pragma unroll
            for (int dt = 0; dt < 4; ++dt) vf[dt] = *(const bf16x8*)(CVF + vfrag_off(s, dt, lane));
            const int cb = 32 * s + 4 * grp;
            float i4[4] = {0.f, 0.f, 0.f, 0.f};
#pragma unroll
            for (int h = 0; h < 4; ++h) {
                f32x4 s0, s1; qk_step(kf, qf[h], s0, s1);
                f32x4 p0, p1;
#pragma unroll
                for (int i = 0; i < 4; ++i) {
                    p0[i] = (cb + i < nval) ? __builtin_amdgcn_exp2f(s0[i] - m[h]) * il[h] : 0.f;
                    p1[i] = (cb + 16 + i < nval) ? __builtin_amdgcn_exp2f(s1[i] - m[h]) * il[h] : 0.f; }
                i4[0] += p0[0] + p0[1]; i4[1] += p0[2] + p0[3]; i4[2] += p1[0] + p1[1]; i4[3] += p1[2] + p1[3];
                const bf16x8 pf = pack_p(p0, p1);
#pragma unroll
                for (int dt = 0; dt < 4; ++dt) st[h].o[dt] = MFMA16(vf[dt], pf, st[h].o[dt]);
            }
            *(float2*)(imp + qi * 256 + 16 * s + 2 * grp) = make_float2(i4[0], i4[1]);
            *(float2*)(imp + qi * 256 + 16 * s + 8 + 2 * grp) = make_float2(i4[2], i4[3]);
        }
        wave_lds_sync();
    }
    const int cur = t0 >> 6;
    {
        if (cur + 1 <= 16) {
            for (int idx = lane; idx < 256; idx += 64) sel[idx] = ((idx & 15) <= cur) ? (idx & 15) : -1;
        } else {
            for (int q0 = 0; q0 < 16; q0 += 4) {
                unsigned key[4][4];
#pragma unroll
                for (int qq = 0; qq < 4; ++qq)
#pragma unroll
                    for (int j = 0; j < 4; ++j) { const int blk = lane + 64 * j; const float v = imp[(q0 + qq) * 256 + blk];
                        key[qq][j] = (blk >= 1 && blk <= cur - 2) ? ((__float_as_uint(v) & 0xFFFFFF00u) | (unsigned)(255 - blk)) : 0u; }
                if (lane < 4) { sel[(q0 + lane) * 16 + 0] = 0; sel[(q0 + lane) * 16 + 1] = cur; sel[(q0 + lane) * 16 + 2] = cur - 1; }
                for (int n = 3; n < 16; ++n) {
                    unsigned best[4];
#pragma unroll
                    for (int qq = 0; qq < 4; ++qq) best[qq] = max(max(key[qq][0], key[qq][1]), max(key[qq][2], key[qq][3]));
#pragma unroll
                    for (int o = 1; o < 64; o <<= 1) {
#pragma unroll
                        for (int qq = 0; qq < 4; ++qq) best[qq] = max(best[qq], (unsigned)__shfl_xor((int)best[qq], o));
                    }
#pragma unroll
                    for (int qq = 0; qq < 4; ++qq) {
                        const int blk = 255 - (int)(best[qq] & 255u);
#pragma unroll
                        for (int j = 0; j < 4; ++j) if (lane + 64 * j == blk) key[qq][j] = 0u;
                        if (lane == 0) sel[(q0 + qq) * 16 + n] = blk;
                    }
                }
            }
        }
        wave_lds_sync();
    }
    float* acc = wl;
    {
#pragma unroll
        for (int h = 0; h < 4; ++h) { const float gs = sigmoidf_(GROWF(h));
#pragma unroll
            for (int dt = 0; dt < 4; ++dt) *(f32x4*)(acc + (qi * 4 + h) * 64 + 16 * dt + 4 * grp) = st[h].o[dt] * gs; }
        wave_lds_sync();
    }
    {
        const bf16* KF = p.KWF + (size_t)g * T * 64; const bf16* VF = p.VWF + (size_t)g * T * 64;
        int kstart = t0 - 512; if (kstart < 0) kstart = 0; kstart &= ~31;
        const int nsteps = (t0 + 16 - kstart + 31) >> 5;
#pragma unroll
        for (int h = 0; h < 4; ++h) attw_init(st[h]);
        auto issue = [&](int s_, bf16x8 (&K)[2][2], bf16x8 (&V)[4]) {
            const int k0 = kstart + 32 * s_;
#pragma unroll
            for (int tl = 0; tl < 2; ++tl)
#pragma unroll
                for (int ks = 0; ks < 2; ++ks) K[tl][ks] = *(const bf16x8*)(KF + kfrag_off((k0 >> 4) + tl, ks, lane));
#pragma unroll
            for (int dt = 0; dt < 4; ++dt) V[dt] = *(const bf16x8*)(VF + vfrag_off(k0 >> 5, dt, lane));
        };
        auto compute = [&](int s_, const bf16x8 (&K)[2][2], const bf16x8 (&V)[4]) {
            const int k0 = kstart + 32 * s_;
            const bool need_mask = (k0 + 31 > t0) || (k0 < t0 + 15 - 512);
            const int pb = k0 + 4 * grp;
#pragma unroll
            for (int h = 0; h < 4; ++h) {
                f32x4 s0, s1; qk_step(K, qf[h], s0, s1);
                if (need_mask) {
#pragma unroll
                    for (int i = 0; i < 4; ++i) { const int p0 = pb + i, p1 = pb + 16 + i;
                        if (p0 > t || p0 < t - 512) s0[i] = -INFINITY; if (p1 > t || p1 < t - 512) s1[i] = -INFINITY; }
                }
                att_update(st[h], s0, s1, V);
            }
        };
        bf16x8 kA[2][2], vA[4], kB[2][2], vB[4];
        issue(0, kA, vA);
        for (int s = 0; s < nsteps; s += 2) {
            if (s + 1 < nsteps) issue(s + 1, kB, vB);
            compute(s, kA, vA);
            if (s + 1 < nsteps) { if (s + 2 < nsteps) issue(s + 2, kA, vA); compute(s + 1, kB, vB); }
        }
#pragma unroll
        for (int h = 0; h < 4; ++h) { const float lt = grp_sum(st[h].l); const float gs = sigmoidf_(GROWF(16 + h)) * (lt > 0.f ? 1.f / lt : 0.f);
#pragma unroll
            for (int dt = 0; dt < 4; ++dt) { f32x4* a = (f32x4*)(acc + (qi * 4 + h) * 64 + 16 * dt + 4 * grp); *a = *a + st[h].o[dt] * gs; } }
        wave_lds_sync();
    }
    *(int4*)(p.SEL + ((size_t)g * T + t0) * 16 + lane * 4) = *(const int4*)(sel + lane * 4);
#pragma unroll 4
    for (int q = 0; q < 16; ++q) *(f32x4*)(p.NSACC + (size_t)(t0 + q) * 512 + g * 256 + 4 * lane) = *(const f32x4*)(acc + q * 256 + 4 * lane);
    wave_lds_sync();
}

__device__ __forceinline__ void nsa_slc_item(const KP& p, int tq, int g, int lane) {
    asm volatile("" : "+v"(lane));
    const int l15 = lane & 15, grp = lane >> 4, hn = lane & 3;
    const bf16* KF = p.KSF + (size_t)g * T * 64; const bf16* VF = p.VSF + (size_t)g * T * 64;
    const int* selp = p.SEL + ((size_t)g * T + tq) * 16;
    int sb[16];
#pragma unroll
    for (int i = 0; i < 16; ++i) sb[i] = __builtin_amdgcn_readfirstlane(selp[i]);
    bf16x8 qs[2];
#pragma unroll
    for (int ks = 0; ks < 2; ++ks) qs[ks] = *(const bf16x8*)(p.QB + (size_t)tq * 512 + (g * 4 + hn) * 64 + 32 * ks + 8 * grp);
    AttW a; attw_init(a);
    bf16x8 kf[2][2][2], vf[2][4];
    auto issue = [&](int i, int buf) {
        const int blk = sb[i >> 1]; int k0 = blk * 64 + 32 * (i & 1); if (blk < 0 || k0 > tq) k0 = 0;
#pragma unroll
        for (int tl = 0; tl < 2; ++tl)
#pragma unroll
            for (int ks = 0; ks < 2; ++ks) kf[buf][tl][ks] = *(const bf16x8*)(KF + kfrag_off((k0 >> 4) + tl, ks, lane));
#pragma unroll
        for (int dt = 0; dt < 4; ++dt) vf[buf][dt] = *(const bf16x8*)(VF + vfrag_off(k0 >> 5, dt, lane));
    };
    issue(0, 0);
#pragma unroll
    for (int i = 0; i < 32; ++i) {
        const int buf = i & 1;
        if (i + 1 < 32) issue(i + 1, buf ^ 1);
        const int blk = sb[i >> 1]; const int k0 = blk * 64 + 32 * (i & 1);
        const bool dead = (blk < 0) || (k0 > tq);
        f32x4 s0, s1; qk_step(kf[buf], qs, s0, s1);
        const int pb = k0 + 4 * grp;
#pragma unroll
        for (int j = 0; j < 4; ++j) { if (dead || pb + j > tq) s0[j] = -INFINITY; if (dead || pb + 16 + j > tq) s1[j] = -INFINITY; }
        att_update(a, s0, s1, vf[buf]);
    }
    const float lt = grp_sum(a.l);
    if (l15 < 4) {
        const float gs = sigmoidf_(p.BIGF[(size_t)tq * PA + C_GATE + 8 + g * 4 + l15]) * (lt > 0.f ? 1.f / lt : 0.f);
#pragma unroll
        for (int dt = 0; dt < 4; ++dt) {
            const size_t o = (size_t)tq * 512 + g * 256 + l15 * 64 + 16 * dt + 4 * grp;
            const f32x4 base = *(const f32x4*)(p.NSACC + o); const f32x4 v = base + a.o[dt] * gs;
            uint2 w; w.x = pk2(v[0], v[1]); w.y = pk2(v[2], v[3]);
            *(uint2*)(p.MIXB + (size_t)tq * 1024 + g * 256 + l15 * 64 + 16 * dt + 4 * grp) = w;
        }
    }
}

__device__ __forceinline__ void ph_compress(const KP& p, const Fr& F) {
    float* flat = (float*)F.lds;
    float* hid = (float*)(F.lds + 32768);
    float* res = (float*)(F.lds + 32768 + 2048);
    const float* H0 = p.BIGF;
    const int tid = F.tid;
    for (int item = F.bid; item < 512; item += F.G) {
        const int c = item & 511, s = item >> 9;
        for (int e = tid; e < 8192; e += NTHR) {
            const int kv = e >> 12, g = (e >> 11) & 1, k = e & 2047, i = k >> 6, d = k & 63;
            const int row = c * 32 + i;
            float v;
            if (s == 0) v = H0[(size_t)row * PA + C_KC + kv * 128 + g * 64 + d];
            else { const int b = s - 1; const int page = p.page_table[b * NPAGES + (row >> 7)];
                   v = p.cache_cmp[((((size_t)page * 128 + (row & 127)) * 2 + kv) * 2 + g) * 64 + d]; }
            flat[e] = v + p.cpe[(kv * 32 + i) * 64 + d];
        }
        __syncthreads();
        {
            const int kv = tid >> 8, g = (tid >> 7) & 1, j = tid & 127;
            const float* w = p.cw1 + (size_t)kv * 2048 * 128 + j;
            const float* fl = flat + (kv * 2 + g) * 2048;
            float acc = p.cb1[kv * 128 + j];
            for (int k = 0; k < 2048; ++k) acc += fl[k] * w[(size_t)k * 128];
            hid[(kv * 2 + g) * 128 + j] = gelu_tanh(acc);
        }
        __syncthreads();
        if (tid < 256) {
            const int kv = tid >> 7, g = (tid >> 6) & 1, d = tid & 63;
            const float* w = p.cw2 + (size_t)kv * 128 * 64 + d;
            const float* hh = hid + (kv * 2 + g) * 128;
            float acc = 0.f;
            for (int j = 0; j < 128; ++j) acc += hh[j] * w[j * 64];
            res[(kv * 2 + g) * 64 + d] = acc;
        }
        __syncthreads();
        if (tid < 256) {
            const int kv = tid >> 7, g = (tid >> 6) & 1, d = tid & 63;
            const float* rr = res + (kv * 2 + g) * 64;
            float v = rr[d];
            if (kv == 0) {
                const int pos = (c + 1) * 32 - 1; const float2 cs = p.ROPE[pos * 32 + (d & 31)];
                const float x1 = rr[d & 31], x2 = rr[(d & 31) + 32];
                v = (d < 32) ? (x1 * cs.x - x2 * cs.y) : (x2 * cs.x + x1 * cs.y);
                p.CK[(((size_t)s * 512 + c) * 2 + g) * 64 + d] = v;
                if (s == 0) p.CKF[(size_t)g * 512 * 64 + kfrag_elem(c, d)] = (bf16)f2bf(v);
            } else { p.CV[(((size_t)s * 512 + c) * 2 + g) * 64 + d] = v; if (s == 0) p.CVF[(size_t)g * 512 * 64 + vfrag_elem(c, d)] = (bf16)f2bf(v); }
        }
        __syncthreads();
    }
}

__device__ __forceinline__ void ph_gdn_prep(const KP& p, const Fr& F) {
    const float* H0 = p.BIGF; const int lane = F.lane;
    for (int item = T * 8 + F.gw; item < TS * 8; item += F.NGW) {
        const int r = item >> 3, h = item & 7;
        const bool smp = r >= T; const int b = r - T;
        float cv[3];
#pragma unroll
        for (int part = 0; part < 3; ++part) {
            const int ch = part * 512 + h * 64 + lane;
            float acc = 0.f;
#pragma unroll
            for (int j = 0; j < 4; ++j) {
                float u;
                if (!smp) { const int t = r + j - 3; u = (t >= 0) ? H0[(size_t)t * PA + C_GQKV + ch] : 0.f; }
                else { u = (j < 3) ? p.st_gconv[((size_t)b * 3 + j) * 1536 + ch] : H0[(size_t)r * PA + C_GQKV + ch]; }
                acc += p.gconv_w[j * 1536 + ch] * u;
            }
            cv[part] = siluf_(acc);
        }
        const float qn = wave_sum(cv[0] * cv[0]), kn = wave_sum(cv[1] * cv[1]);
        const size_t o = ((size_t)r * 8 + h) * 64 + lane;
        p.GQ[o] = cv[0] * rsqrtf(qn + NORM_EPS) * 0.125f;
        p.GK[o] = cv[1] * rsqrtf(kn + NORM_EPS);
        p.GV[o] = cv[2];
        if (lane == 0) {
            const float av = H0[(size_t)r * PA + C_A + h], bt = H0[(size_t)r * PA + C_BT + h];
            p.Gg[(size_t)r * 8 + h] = -expf(p.gA[h]) * softplusf_(av + p.gdt[h]);
            p.Gb[(size_t)r * 8 + h] = sigmoidf_(bt);
        }
    }
    const size_t gt = (size_t)F.tgt, GT = (size_t)F.tGT;
    for (size_t idx = gt; idx < (size_t)3 * 1536; idx += GT) {
        const int j = (int)(idx / 1536), ch = (int)(idx % 1536);
        p.out[O_GCONV_P + idx] = h0f(p, T - 3 + j, C_GQKV + ch);
    }
    for (size_t idx = gt; idx < (size_t)NSMP * 3 * 1536; idx += GT) {
        const int b = (int)(idx / (3 * 1536)), j = (int)((idx / 1536) % 3), ch = (int)(idx % 1536);
        p.out[O_GCONV_S + idx] = (j < 2) ? p.st_gconv[((size_t)b * 3 + j + 1) * 1536 + ch] : H0[(size_t)(T + b) * PA + C_GQKV + ch];
    }
}

template <int NH, class KF>
__device__ __forceinline__ void wave_attend(const float* qs, float* sc, int scstride, int nkeys, KF kf, float (&outv)[NH], float (&den)[NH], int lane, float* mxout = nullptr) {
    float mx[NH];
#pragma unroll
    for (int h = 0; h < NH; ++h) mx[h] = -INFINITY;
    for (int j = lane; j < nkeys; j += 64) {
        const float *kp, *vp; const bool ok = kf(j, kp, vp);
        float s[NH];
#pragma unroll
        for (int h = 0; h < NH; ++h) s[h] = 0.f;
        if (ok) {
            for (int d4 = 0; d4 < 16; ++d4) {
                const float4 kvv = ((const float4*)kp)[d4];
#pragma unroll
                for (int h = 0; h < NH; ++h) { const float* q = qs + h * 64 + d4 * 4; s[h] += kvv.x * q[0] + kvv.y * q[1] + kvv.z * q[2] + kvv.w * q[3]; }
            }
        }
#pragma unroll
        for (int h = 0; h < NH; ++h) { const float v = ok ? s[h] * 0.125f : -INFINITY; sc[h * scstride + j] = v; mx[h] = fmaxf(mx[h], v); }
    }
#pragma unroll
    for (int h = 0; h < NH; ++h) { mx[h] = wave_max(mx[h]); if (!(mx[h] > -INFINITY)) mx[h] = 0.f; if (mxout) mxout[h] = mx[h]; }
    float sm[NH];
#pragma unroll
    for (int h = 0; h < NH; ++h) sm[h] = 0.f;
    for (int j = lane; j < nkeys; j += 64) {
#pragma unroll
        for (int h = 0; h < NH; ++h) { const float v = sc[h * scstride + j]; const float pp = (v == -INFINITY) ? 0.f : expf(v - mx[h]); sc[h * scstride + j] = pp; sm[h] += pp; }
    }
#pragma unroll
    for (int h = 0; h < NH; ++h) { sm[h] = wave_sum(sm[h]); den[h] = sm[h] > 0.f ? sm[h] : 1.f; }
    wave_lds_sync();
    {
        const int kq = lane >> 4, d4 = lane & 15;
        float4 acc[NH];
#pragma unroll
        for (int h = 0; h < NH; ++h) acc[h] = make_float4(0.f, 0.f, 0.f, 0.f);
        for (int j0 = 0; j0 < nkeys; j0 += 32) {
            float4 v[8];
#pragma unroll
            for (int u = 0; u < 8; ++u) { const int j = j0 + 4 * u + kq; const float *kp, *vp; const bool ok = (j < nkeys) && kf(j, kp, vp);
                v[u] = ok ? *(const float4*)(vp + 4 * d4) : make_float4(0.f, 0.f, 0.f, 0.f); }
#pragma unroll
            for (int u = 0; u < 8; ++u) { const int j = j0 + 4 * u + kq;
#pragma unroll
                for (int h = 0; h < NH; ++h) { const float pp = (j < nkeys) ? sc[h * scstride + j] : 0.f;
                    acc[h].x += pp * v[u].x; acc[h].y += pp * v[u].y; acc[h].z += pp * v[u].z; acc[h].w += pp * v[u].w; } }
        }
#pragma unroll
        for (int h = 0; h < NH; ++h) {
            float4 a = acc[h];
            a.x += __shfl_xor(a.x, 16); a.y += __shfl_xor(a.y, 16); a.z += __shfl_xor(a.z, 16); a.w += __shfl_xor(a.w, 16);
            a.x += __shfl_xor(a.x, 32); a.y += __shfl_xor(a.y, 32); a.z += __shfl_xor(a.z, 32); a.w += __shfl_xor(a.w, 32);
            const float x0 = __shfl(a.x, lane >> 2), x1 = __shfl(a.y, lane >> 2), x2 = __shfl(a.z, lane >> 2), x3 = __shfl(a.w, lane >> 2);
            const int cc = lane & 3; outv[h] = cc == 0 ? x0 : (cc == 1 ? x1 : (cc == 2 ? x2 : x3));
        }
    }
#pragma unroll
    for (int h = 0; h < NH; ++h) outv[h] /= den[h];
    wave_lds_sync();
}

__device__ __forceinline__ void nsa_smp_cs(const KP& p, int b, int g, float* wl, int lane) {
    float* qs = wl; float* sc = wl + 256; float* imp = wl + 256 + 4 * 1088; int* sel = (int*)(wl + 256 + 4 * 1088 + 320); long long* bb = (long long*)(wl + 256 + 4 * 1088 + 320 + 16);
    const int r = T + b; const int qpos = T;
    const float* grow = p.BIGF + (size_t)r * PA + C_GATE;
#pragma unroll
    for (int h = 0; h < 4; ++h) qs[h * 64 + lane] = p.QR[(size_t)r * 512 + (g * 4 + h) * 64 + lane];
    wave_lds_sync();
    float ocmp[4], oslc[4], den[4];
    {
        const float* CKp = p.CK + (size_t)(1 + b) * 512 * 128; const float* CVp = p.CV + (size_t)(1 + b) * 512 * 128;
        auto kf = [&](int j, const float*& kp, const float*& vp) -> bool { kp = CKp + (j * 2 + g) * 64; vp = CVp + (j * 2 + g) * 64; return true; };
        wave_attend<4>(qs, sc, 1088, 512, kf, ocmp, den, lane);
        for (int blk = lane; blk < 320; blk += 64) {
            float v = 0.f;
            if (blk < 256) {
#pragma unroll
                for (int h = 0; h < 4; ++h) v += (sc[h * 1088 + 2 * blk] + sc[h * 1088 + 2 * blk + 1]) / den[h];
            }
            imp[blk] = v;
        }
        wave_lds_sync();
    }
    {
        const int cur = qpos >> 6;
        float val[5];
#pragma unroll
        for (int j = 0; j < 5; ++j) { const int blk = lane + 64 * j; val[j] = (blk >= 1 && blk <= cur - 2) ? imp[blk] : -1.f; }
        if (lane == 0) { sel[0] = 0; sel[1] = cur; sel[2] = cur - 1; }
        for (int n = 3; n < 16; ++n) {
            float bv = -2.f; int bi = 0x7fffffff;
#pragma unroll
            for (int j = 0; j < 5; ++j) if (val[j] > bv) { bv = val[j]; bi = lane + 64 * j; }
#pragma unroll
            for (int o = 1; o < 64; o <<= 1) { const float ov = __shfl_xor(bv, o); const int oi = __shfl_xor(bi, o); if (ov > bv || (ov == bv && oi < bi)) { bv = ov; bi = oi; } }
#pragma unroll
            for (int j = 0; j < 5; ++j) if (lane + 64 * j == bi) val[j] = -3.f;
            if (lane == 0) sel[n] = bi;
        }
        wave_lds_sync();
        if (lane < 16) { const int blk = sel[lane]; long long o = 0;
            if (blk < 256) { const int page = p.page_table[b * NPAGES + (blk >> 1)]; o = ((long long)page * 128 + (blk & 1) * 64) * 256; }
            bb[lane] = o; }
        wave_lds_sync();
    }
    {
        auto kf = [&](int j, const float*& kp, const float*& vp) -> bool {
            const int blk = sel[j >> 6]; const int pos = blk * 64 + (j & 63); if (pos > qpos) return false;
            if (pos == T) { kp = p.KS + (size_t)r * 128 + g * 64; vp = p.VS + (size_t)r * 128 + g * 64; return true; }
            const float* base = p.cache_slc + bb[j >> 6] + (j & 63) * 256;
            kp = base + g * 64; vp = base + 128 + g * 64; return true; };
        wave_attend<4>(qs, sc, 1088, 1024, kf, oslc, den, lane);
    }
#pragma unroll
    for (int h = 0; h < 4; ++h) {
        const int hh = g * 4 + h;
        p.SMIXF[((size_t)b * 3 + 0) * 512 + hh * 64 + lane] = sigmoidf_(grow[hh]) * ocmp[h];
        p.SMIXF[((size_t)b * 3 + 1) * 512 + hh * 64 + lane] = sigmoidf_(grow[8 + hh]) * oslc[h];
    }
    wave_lds_sync();
}
__device__ __forceinline__ void nsa_smp_win(const KP& p, int b, int g, float* wl, int lane) {
    float* qs = wl; float* sc = wl + 256;
    const int r = T + b;
    const float* grow = p.BIGF + (size_t)r * PA + C_GATE;
#pragma unroll
    for (int h = 0; h < 4; ++h) qs[h * 64 + lane] = p.QR[(size_t)r * 512 + (g * 4 + h) * 64 + lane];
    wave_lds_sync();
    float owin[4], den[4];
    auto kf = [&](int j, const float*& kp, const float*& vp) -> bool {
        if (j == 512) { kp = p.KW + (size_t)r * 128 + g * 64; vp = p.VW + (size_t)r * 128 + g * 64; return true; }
        const float* base = p.st_win + ((size_t)b * 512 + j) * 256;
        kp = base + g * 64; vp = base + 128 + g * 64; return true; };
    wave_attend<4>(qs, sc, 528, 513, kf, owin, den, lane);
#pragma unroll
    for (int h = 0; h < 4; ++h) { const int hh = g * 4 + h; p.SMIXF[((size_t)b * 3 + 2) * 512 + hh * 64 + lane] = sigmoidf_(grow[16 + hh]) * owin[h]; }
    wave_lds_sync();
}

__device__ __forceinline__ void gdn_scan_item(const KP& p, int item, float* wl, int lane) {
    asm volatile("" : "+v"(lane));
    float* kq = wl;
    const int b = (item >> 3) - 1, h = item & 7;
    const int r = T + b; const size_t o = ((size_t)r * 8 + h) * 64;
    kq[lane] = p.GK[o + lane]; kq[64 + lane] = p.GQ[o + lane];
    wave_lds_sync();
    const float dec = expf(p.Gg[(size_t)r * 8 + h]), bt = p.Gb[(size_t)r * 8 + h];
    const float* Sp = p.st_gS + ((size_t)b * 8 + h) * 4096 + lane;
    float* so = p.out + O_GS_S + ((size_t)b * 8 + h) * 4096 + lane;
    float S[64]; float kv = 0.f;
#pragma unroll
    for (int i = 0; i < 64; ++i) { S[i] = Sp[i * 64] * dec; kv += kq[i] * S[i]; }
    const float vn = (p.GV[o + lane] - kv) * bt;
    float ov = 0.f;
#pragma unroll
    for (int i = 0; i < 64; ++i) { const float sn = S[i] + kq[i] * vn; ov += kq[64 + i] * sn; so[i * 64] = sn; }
    p.OG[o + lane] = ov;
    wave_lds_sync();
}

constexpr int GDN_WL = 34816;
__device__ __forceinline__ int kperm(int ks, int grp, int j) { return 32 * ks + 16 * (j >> 2) + 4 * grp + (j & 3); }

__device__ __forceinline__ void gdn_chunk_unit(const KP& p, int unit, unsigned char* ldsb, int woff, int lane) {
    asm volatile("" : "+v"(lane), "+s"(woff));
    unsigned char* wlb = ldsb + woff;
    const int n = unit >> 3, h = unit & 7, t0 = 64 * n;
    const int l15 = lane & 15, grp = lane >> 4;
    float* Af = (float*)wlb; bf16* kt = (bf16*)(wlb + 16384); bf16* qt = kt + 64 * 72; bf16* tmp = (bf16*)wlb;
    {
        const float* H0 = p.BIGF;
        float w[3][4], u1[3], u2[3], u3[3];
#pragma unroll
        for (int part = 0; part < 3; ++part) {
            const int ch = part * 512 + h * 64 + lane;
#pragma unroll
            for (int j = 0; j < 4; ++j) w[part][j] = p.gconv_w[j * 1536 + ch];
            u1[part] = (t0 >= 1) ? h0f(p, t0 - 1, C_GQKV + ch) : 0.f;
            u2[part] = (t0 >= 2) ? h0f(p, t0 - 2, C_GQKV + ch) : 0.f;
            u3[part] = (t0 >= 3) ? h0f(p, t0 - 3, C_GQKV + ch) : 0.f;
        }
        int roff = 0;
#pragma unroll 4
        for (int i = 0; i < 64; ++i) {
            float cv[3];
#pragma unroll
            for (int part = 0; part < 3; ++part) {
                const float u0 = __uint_as_float((unsigned)p.H0B[(size_t)t0 * PAP + C_GQKV + part * 512 + h * 64 + lane + roff] << 16);
                cv[part] = siluf_(w[part][0] * u3[part] + w[part][1] * u2[part] + w[part][2] * u1[part] + w[part][3] * u0);
                u3[part] = u2[part]; u2[part] = u1[part]; u1[part] = u0;
            }
            roff += PAP; asm volatile("" : "+s"(roff));
            const float qn = wave_sum(cv[0] * cv[0]), kn = wave_sum(cv[1] * cv[1]);
            qt[i * 72 + lane] = (bf16)f2bf(cv[0] * rsqrtf(qn + NORM_EPS) * 0.125f);
            kt[i * 72 + lane] = (bf16)f2bf(cv[1] * rsqrtf(kn + NORM_EPS));
            p.GV[((size_t)(t0 + i) * 8 + h) * 64 + lane] = cv[2];
        }
    }
    const float gl_ = -fexp_(p.gA[h]) * softplusf_(h0f(p, t0 + lane, C_A + h) + p.gdt[h]);
    const float beta = sigmoidf_(h0f(p, t0 + lane, C_BT + h));
    float gc = gl_;
#pragma unroll
    for (int o = 1; o < 64; o <<= 1) { const float tv = __shfl_up(gc, o); if (lane >= o) gc += tv; }
    const float gclast = __shfl(gc, 63);
#define GPAD(i) ((float*)(kt + (i) * 72 + 64))
    { float* pd = GPAD(lane); pd[0] = gc; pd[1] = beta; pd[2] = fexp_(gc); pd[3] = fexp_(gclast - gc); }
    wave_lds_sync();
    bf16* QKF = p.G_QKF + (size_t)unit * 4096;
#pragma unroll
    for (int it = 0; it < 4; ++it) {
        const int i = 16 * it + l15;
        const float gci = GPAD(i)[0], bi = GPAD(i)[1];
        bf16x8 bk[2], bq[2];
#pragma unroll
        for (int ks = 0; ks < 2; ++ks) { bk[ks] = *(const bf16x8*)(kt + i * 72 + 32 * ks + 8 * grp); bq[ks] = *(const bf16x8*)(qt + i * 72 + 32 * ks + 8 * grp); }
#pragma unroll
        for (int jt = 0; jt < 4; ++jt) {
            uint2 qkp = make_uint2(0u, 0u);
            if (jt <= it) {
                bf16x8 ak[2];
#pragma unroll
                for (int ks = 0; ks < 2; ++ks) ak[ks] = *(const bf16x8*)(kt + (16 * jt + l15) * 72 + 32 * ks + 8 * grp);
                f32x4 aa = {0.f, 0.f, 0.f, 0.f}, aq = {0.f, 0.f, 0.f, 0.f};
                aa = MFMA16(ak[0], bk[0], aa); aa = MFMA16(ak[1], bk[1], aa);
                aq = MFMA16(ak[0], bq[0], aq); aq = MFMA16(ak[1], bq[1], aq);
                f32x4 av, qv;
#pragma unroll
                for (int r = 0; r < 4; ++r) {
                    const int j = 16 * jt + 4 * grp + r; const float gcj = GPAD(j)[0];
                    const float e = (j <= i) ? fexp_(gci - gcj) : 0.f;
                    av[r] = (j < i) ? bi * aa[r] * e : 0.f; qv[r] = aq[r] * e;
                }
                *(f32x4*)(Af + i * 64 + 16 * jt + 4 * grp) = av;
                qkp.x = pk2(qv[0], qv[1]); qkp.y = pk2(qv[2], qv[3]);
            }
            *(uint2*)(QKF + ((size_t)(it * 2 + (jt >> 1)) * 64 + lane) * 8 + (jt & 1) * 4) = qkp;
        }
    }
    wave_lds_sync();
    {
        float* UF = p.G_UF + (size_t)unit * 4096;
        const int vq = lane >> 4;
#pragma unroll
        for (int pass = 0; pass < 2; ++pass) {
            float x[64];
            int goff = 0;
#pragma unroll
            for (int i = 0; i < 64; ++i) {
                const float bi = GPAD(i)[1];
                float acc;
                if (pass == 0) { acc = p.GV[((size_t)t0 * 8 + h) * 64 + lane + goff] * bi; goff += 512; asm volatile("" : "+s"(goff)); }
                else { const float ei = GPAD(i)[2];
                       acc = __uint_as_float((unsigned)kt[i * 72 + lane] << 16) * bi * ei; }
#pragma unroll
                for (int jj = 0; jj < (i + 3) / 4; ++jj) {
                    const float4 a4 = *(const float4*)(Af + i * 64 + 4 * jj);
                    acc -= a4.x * x[4 * jj + 0];
                    if (4 * jj + 1 < i) acc -= a4.y * x[4 * jj + 1];
                    if (4 * jj + 2 < i) acc -= a4.z * x[4 * jj + 2];
                    if (4 * jj + 3 < i) acc -= a4.w * x[4 * jj + 3];
                }
                x[i] = acc;
                if ((i & 3) == 3) asm volatile("" ::: "memory");
            }
            if (pass == 0) {
#pragma unroll
                for (int c4 = 0; c4 < 16; ++c4) {
                    const int mt = c4 >> 2, lp = l15 + 16 * (c4 & 3);
                    *(f32x4*)(UF + ((size_t)(vq * 4 + mt) * 64 + lp) * 4) = (f32x4){x[4 * c4], x[4 * c4 + 1], x[4 * c4 + 2], x[4 * c4 + 3]};
                }
            } else {
                wave_lds_sync();
#pragma unroll
                for (int c = 0; c < 64; ++c) tmp[c * 72 + lane] = (bf16)f2bf(-x[c]);
            }
            asm volatile("" ::: "memory");
        }
    }
    wave_lds_sync();
    {
        bf16* WF = p.G_WF + (size_t)unit * 4096; bf16* QGF = p.G_QGF + (size_t)unit * 4096; bf16* KDF = p.G_KDF + (size_t)unit * 4096;
#pragma unroll
        for (int mt = 0; mt < 4; ++mt) {
            const float egc = GPAD(16 * mt + l15)[2];
#pragma unroll
            for (int ks = 0; ks < 2; ++ks) {
                const int c = 16 * mt + l15, k0 = 32 * ks + 4 * grp;
                const uint2 w0 = *(const uint2*)(tmp + c * 72 + k0), w1 = *(const uint2*)(tmp + c * 72 + k0 + 16);
                v4u wv; wv.x = w0.x; wv.y = w0.y; wv.z = w1.x; wv.w = w1.y;
                *(v4u*)(WF + ((size_t)(mt * 2 + ks) * 64 + lane) * 8) = wv;
                const uint2 q0 = *(const uint2*)(qt + c * 72 + k0), q1 = *(const uint2*)(qt + c * 72 + k0 + 16);
                v4u qv;
                qv.x = pk2(__uint_as_float(q0.x << 16) * egc, __uint_as_float(q0.x & 0xffff0000u) * egc); qv.y = pk2(__uint_as_float(q0.y << 16) * egc, __uint_as_float(q0.y & 0xffff0000u) * egc);
                qv.z = pk2(__uint_as_float(q1.x << 16) * egc, __uint_as_float(q1.x & 0xffff0000u) * egc); qv.w = pk2(__uint_as_float(q1.y << 16) * egc, __uint_as_float(q1.y & 0xffff0000u) * egc);
                *(v4u*)(QGF + ((size_t)(mt * 2 + ks) * 64 + lane) * 8) = qv;
                float kd[8];
#pragma unroll
                for (int j = 0; j < 8; ++j) { const int cc = kperm(ks, grp, j); kd[j] = __uint_as_float((unsigned)kt[cc * 72 + 16 * mt + l15] << 16) * GPAD(cc)[3]; }
                v4u kv; kv.x = pk2(kd[0], kd[1]); kv.y = pk2(kd[2], kd[3]); kv.z = pk2(kd[4], kd[5]); kv.w = pk2(kd[6], kd[7]);
                *(v4u*)(KDF + ((size_t)(mt * 2 + ks) * 64 + lane) * 8) = kv;
            }
        }
        if (lane == 0) p.G_GL[unit] = fexp_(gclast);
    }
    wave_lds_sync();
#undef GPAD
}

constexpr int CH_SLOT = 32768;
__device__ __forceinline__ void gdn_chain_wg(const KP& p, int h, int wave, int lane, unsigned char* ldsb) {
    asm volatile("" : "+v"(lane));
    const int l15 = lane & 15, grp = lane >> 4;
    float* GLs = (float*)(ldsb + 4 * CH_SLOT);
    if (wave < 4) GLs[wave * 64 + lane] = p.G_GL[(size_t)(wave * 64 + lane) * 8 + h];
#define CH_BAR() do { asm volatile("s_waitcnt lgkmcnt(0)" ::: "memory"); __builtin_amdgcn_s_barrier(); asm volatile("" ::: "memory"); } while (0)
    if (wave >= 4) {
        const int lw = wave - 4;
        const unsigned char* gb = (lw == 0) ? (const unsigned char*)p.G_WF : (lw == 1) ? (const unsigned char*)p.G_KDF : (const unsigned char*)p.G_UF + (size_t)(lw - 2) * 8192;
        const size_t ustride = (lw < 2) ? 8192 : 16384;
        gb += (size_t)h * ustride + (size_t)lane * 16;
        auto src = [&](int n, int k) -> const v4u* { return (const v4u*)(gb + (size_t)n * 8 * ustride + k * 1024); };
        v4u rs[4][8];
#pragma unroll
        for (int j = 0; j < 4; ++j)
#pragma unroll
            for (int k = 0; k < 8; ++k) rs[j][k] = *src(j, k);
#pragma unroll
        for (int j = 0; j < 2; ++j) {
#pragma unroll
            for (int k = 0; k < 8; ++k) { *(v4u*)(ldsb + j * CH_SLOT + (lw * 512 + k * 64 + lane) * 16) = rs[j][k]; rs[j][k] = *src(4 + j, k); }
        }
        CH_BAR();
        for (int n0 = 0; n0 < 256; n0 += 4) {
#pragma unroll
            for (int j = 0; j < 4; ++j) {
                const int n = n0 + j, st = n + 2;
                if (st < 256) {
                    const int set = (j + 2) & 3;
#pragma unroll
                    for (int k = 0; k < 8; ++k) { *(v4u*)(ldsb + (st & 3) * CH_SLOT + (lw * 512 + k * 64 + lane) * 16) = rs[set][k]; if (st + 4 < 256) rs[set][k] = *src(st + 4, k); }
                }
                CH_BAR();
            }
        }
#undef CH_BAR
        return;
    }
    const int vq = wave;
    f32x4 S[4];
#pragma unroll
    for (int i = 0; i < 4; ++i) S[i] = (f32x4){0.f, 0.f, 0.f, 0.f};
    asm volatile("s_waitcnt lgkmcnt(0)" ::: "memory"); __builtin_amdgcn_s_barrier(); asm volatile("" ::: "memory");
    for (int n = 0; n < 256; ++n) {
        const unsigned char* sl = ldsb + (n & 3) * CH_SLOT;
        bf16x8 wf[4][2], kdf[4][2]; f32x4 uf[4];
#pragma unroll
        for (int mt = 0; mt < 4; ++mt) {
#pragma unroll
            for (int ks = 0; ks < 2; ++ks) { wf[mt][ks] = *(const bf16x8*)(sl + ((mt * 2 + ks) * 64 + lane) * 16); kdf[mt][ks] = *(const bf16x8*)(sl + 8192 + ((mt * 2 + ks) * 64 + lane) * 16); }
            uf[mt] = *(const f32x4*)(sl + 16384 + ((vq * 4 + mt) * 64 + lane) * 16);
        }
        const float gl = GLs[n];
        const size_t fo = ((size_t)((n * 8 + h) * 4 + vq) * 2) * 512;
        bf16x8 sB[2];
#pragma unroll
        for (int ks = 0; ks < 2; ++ks) { sB[ks] = pack_p(S[2 * ks], S[2 * ks + 1]); *(bf16x8*)(p.G_SPF + fo + ((size_t)ks * 64 + lane) * 8) = sB[ks]; }
        f32x4 v[4];
#pragma unroll
        for (int mt = 0; mt < 4; ++mt) { v[mt] = uf[mt]; v[mt] = MFMA16(wf[mt][0], sB[0], v[mt]); v[mt] = MFMA16(wf[mt][1], sB[1], v[mt]); }
        bf16x8 vB[2];
#pragma unroll
        for (int ks = 0; ks < 2; ++ks) { vB[ks] = pack_p(v[2 * ks], v[2 * ks + 1]); *(bf16x8*)(p.G_VNF + fo + ((size_t)ks * 64 + lane) * 8) = vB[ks]; }
#pragma unroll
        for (int mt = 0; mt < 4; ++mt) { S[mt] = S[mt] * gl; S[mt] = MFMA16(kdf[mt][0], vB[0], S[mt]); S[mt] = MFMA16(kdf[mt][1], vB[1], S[mt]); }
        asm volatile("s_waitcnt lgkmcnt(0)" ::: "memory"); __builtin_amdgcn_s_barrier(); asm volatile("" ::: "memory");
    }
    float* so = p.out + O_GS_P + (size_t)h * 4096;
#pragma unroll
    for (int mt = 0; mt < 4; ++mt)
#pragma unroll
        for (int r = 0; r < 4; ++r) so[(16 * mt + 4 * grp + r) * 64 + 16 * vq + l15] = S[mt][r];
}

__device__ __forceinline__ void gdn_out_unit(const KP& p, int unit, int lane) {
    asm volatile("" : "+v"(lane));
    const int n = unit >> 3, h = unit & 7, t0 = 64 * n; const int l15 = lane & 15, grp = lane >> 4;
    const bf16* QGF = p.G_QGF + (size_t)unit * 4096; const bf16* QKF = p.G_QKF + (size_t)unit * 4096;
    f32x4 o[4][4];
#pragma unroll
    for (int mt = 0; mt < 4; ++mt)
#pragma unroll
        for (int vq = 0; vq < 4; ++vq) o[mt][vq] = (f32x4){0.f, 0.f, 0.f, 0.f};
#pragma unroll
    for (int ks = 0; ks < 2; ++ks) {
        bf16x8 sp[4], vn[4];
#pragma unroll
        for (int vq = 0; vq < 4; ++vq) { const size_t fo = ((size_t)(unit * 4 + vq) * 2 + ks) * 512 + (size_t)lane * 8; sp[vq] = *(const bf16x8*)(p.G_SPF + fo); vn[vq] = *(const bf16x8*)(p.G_VNF + fo); }
#pragma unroll
        for (int mt = 0; mt < 4; ++mt) {
            const bf16x8 qg = *(const bf16x8*)(QGF + ((size_t)(mt * 2 + ks) * 64 + lane) * 8), qk = *(const bf16x8*)(QKF + ((size_t)(mt * 2 + ks) * 64 + lane) * 8);
#pragma unroll
            for (int vq = 0; vq < 4; ++vq) { o[mt][vq] = MFMA16(qg, sp[vq], o[mt][vq]); o[mt][vq] = MFMA16(qk, vn[vq], o[mt][vq]); }
        }
    }
    float nw[4];
#pragma unroll
    for (int vq = 0; vq < 4; ++vq) nw[vq] = p.gnw[16 * vq + l15];
#pragma unroll
    for (int mt = 0; mt < 4; ++mt)
#pragma unroll
        for (int r = 0; r < 4; ++r) {
            float ss = 0.f;
#pragma unroll
            for (int vq = 0; vq < 4; ++vq) ss += o[mt][vq][r] * o[mt][vq][r];
            ss += __shfl_xor(ss, 1); ss += __shfl_xor(ss, 2); ss += __shfl_xor(ss, 4); ss += __shfl_xor(ss, 8);
            const float rs = rsqrtf(ss * (1.f / 64.f) + NORM_EPS);
            const int t = t0 + 16 * mt + 4 * grp + r;
            const float* zr = p.ZF + (size_t)t * 512 + h * 64;
#pragma unroll
            for (int vq = 0; vq < 4; ++vq) p.MIXB[(size_t)t * 1024 + 512 + h * 64 + 16 * vq + l15] = (bf16)f2bf(o[mt][vq][r] * rs * nw[vq] * siluf_(zr[16 * vq + l15]));
        }
}

#define MFMA8(a, b, c) __builtin_amdgcn_mfma_f32_16x16x32_fp8_fp8((a), (b), (c), 0, 0, 0)
__device__ __forceinline__ long pack_fp8(const f32x4& a, const f32x4& b) {
    int w0 = 0, w1 = 0;
    w0 = __builtin_amdgcn_cvt_pk_fp8_f32(a[0], a[1], w0, false); w0 = __builtin_amdgcn_cvt_pk_fp8_f32(a[2], a[3], w0, true);
    w1 = __builtin_amdgcn_cvt_pk_fp8_f32(b[0], b[1], w1, false); w1 = __builtin_amdgcn_cvt_pk_fp8_f32(b[2], b[3], w1, true);
    return (long)(((unsigned long long)(unsigned)w1 << 32) | (unsigned long long)(unsigned)w0);
}
template <bool GEN>
__device__ __forceinline__ void nsa_slc_item8(const KP& p, int tq, int g, int lane) {
    asm volatile("" : "+v"(lane));
    const int l15 = lane & 15, grp = lane >> 4, hn = lane & 3;
    const unsigned char* KF = p.KS8 + (size_t)g * T * 64; const unsigned char* VF = p.VS8 + (size_t)g * T * 64;
    const int* selp = p.SEL + ((size_t)g * T + tq) * 16;
    int sb[16];
#pragma unroll
    for (int i = 0; i < 16; ++i) sb[i] = __builtin_amdgcn_readfirstlane(selp[i]);
    long qs[2];
#pragma unroll
    for (int ks = 0; ks < 2; ++ks) {
        const bf16x8 qb = *(const bf16x8*)(p.QB + (size_t)tq * 512 + (g * 4 + hn) * 64 + 32 * ks + 8 * grp);
        f32x4 a, b;
#pragma unroll
        for (int j = 0; j < 4; ++j) { a[j] = __uint_as_float((unsigned)(unsigned short)qb[j] << 16) * (1.f / QSCALE); b[j] = __uint_as_float((unsigned)(unsigned short)qb[4 + j] << 16) * (1.f / QSCALE); }
        qs[ks] = pack_fp8(a, b);
    }
    AttW a; attw_init(a);
    long kf[3][4][2], vf[3][2][4];
    auto issue = [&](int bi, int buf) {
        int blk = sb[bi]; if (GEN && (blk < 0 || blk * 64 > tq)) blk = 0;
        typedef long l2_t __attribute__((ext_vector_type(2)));
#pragma unroll
        for (int tl = 0; tl < 4; ++tl) { const l2_t x = *(const l2_t*)(KF + ((size_t)(blk * 4 + tl) * 64 + lane) * 16); kf[buf][tl][0] = x[0]; kf[buf][tl][1] = x[1]; }
#pragma unroll
        for (int dt = 0; dt < 4; ++dt) { const l2_t x = *(const l2_t*)(VF + ((size_t)(blk * 4 + dt) * 64 + lane) * 16); vf[buf][0][dt] = x[0]; vf[buf][1][dt] = x[1]; }
    };
    issue(0, 0); issue(1, 1);
#pragma unroll
    for (int bi = 0; bi < 16; ++bi) {
        const int buf = bi % 3;
        if (bi + 2 < 16) issue(bi + 2, (bi + 2) % 3);
        const int blk = sb[bi]; const int k0 = blk * 64;
        if (GEN && (blk < 0 || k0 > tq)) continue;
        const f32x4 z = {0.f, 0.f, 0.f, 0.f};
        f32x4 sc[4];
#pragma unroll
        for (int tl = 0; tl < 4; ++tl) { sc[tl] = MFMA8(kf[buf][tl][0], qs[0], z); sc[tl] = MFMA8(kf[buf][tl][1], qs[1], sc[tl]); }
        if (GEN ? (k0 + 63 > tq) : (bi == 1)) {
#pragma unroll
            for (int tl = 0; tl < 4; ++tl)
#pragma unroll
                for (int j = 0; j < 4; ++j) if (k0 + 16 * tl + 4 * grp + j > tq) sc[tl][j] = -INFINITY;
        }
        float mx = fmaxf(fmaxf(fmaxf(fmaxf(sc[0][0], sc[0][1]), fmaxf(sc[0][2], sc[0][3])), fmaxf(fmaxf(sc[1][0], sc[1][1]), fmaxf(sc[1][2], sc[1][3]))),
                         fmaxf(fmaxf(fmaxf(sc[2][0], sc[2][1]), fmaxf(sc[2][2], sc[2][3])), fmaxf(fmaxf(sc[3][0], sc[3][1]), fmaxf(sc[3][2], sc[3][3]))));
        mx = fmaxf(mx, __shfl_xor(mx, 16)); mx = fmaxf(mx, __shfl_xor(mx, 32));
        const float mn = fmaxf(a.m, mx * QSCALE);
        const float alpha = __builtin_amdgcn_exp2f(a.m - mn);
        const float mb = 7.f - mn;
        f32x4 pp[4]; float sum = 0.f;
#pragma unroll
        for (int tl = 0; tl < 4; ++tl) {
#pragma unroll
            for (int j = 0; j < 4; ++j) pp[tl][j] = __builtin_amdgcn_exp2f(fmaf(sc[tl][j], QSCALE, mb));
            sum += (pp[tl][0] + pp[tl][1]) + (pp[tl][2] + pp[tl][3]);
        }
        a.l = a.l * alpha + sum; a.m = mn;
        const long pf0 = pack_fp8(pp[0], pp[1]), pf1 = pack_fp8(pp[2], pp[3]);
#pragma unroll
        for (int dt = 0; dt < 4; ++dt) { a.o[dt] = a.o[dt] * alpha; a.o[dt] = MFMA8(vf[buf][0][dt], pf0, a.o[dt]); a.o[dt] = MFMA8(vf[buf][1][dt], pf1, a.o[dt]); }
    }
    const float lt = grp_sum(a.l);
    if (l15 < 4) {
        const float gs = sigmoidf_(h0f(p, tq, C_GATE + 8 + g * 4 + l15)) * (lt > 0.f ? 1.f / lt : 0.f);
#pragma unroll
        for (int dt = 0; dt < 4; ++dt) {
            const size_t o = (size_t)tq * 512 + g * 256 + l15 * 64 + 16 * dt + 4 * grp;
            const f32x4 base = *(const f32x4*)(p.NSACC + o); const f32x4 v = base + a.o[dt] * gs;
            uint2 w; w.x = pk2(v[0], v[1]); w.y = pk2(v[2], v[3]);
            *(uint2*)(p.MIXB + (size_t)tq * 1024 + g * 256 + l15 * 64 + 16 * dt + 4 * grp) = w;
        }
    }
}

__device__ __forceinline__ void ph_prep_chunks(const KP& p, const Fr& F) {
    if (F.wave < 4) { for (int unit = F.bid * 4 + F.wave; unit < 2048; unit += F.G * 4) gdn_chunk_unit(p, unit, F.lds, F.wave * GDN_WL, F.lane); }
    else {
        const int NP = F.G - 32;
        if (F.bid < NP) {
            Fr F2 = F; F2.tgt = F.bid * 256 + (F.tid - 256); F2.tGT = NP * 256; F2.gw = F.bid * 4 + (F.wave - 4); F2.NGW = NP * 4;
            ph_nsa_prep(p, F2); ph_nsa_prep_fast(p, F2); ph_gdn_prep(p, F2);
        } else { const int unit = (F.bid - NP) * 4 + (F.wave - 4); if (unit < 128) cmp_prompt_unit(p, unit, F.lane); }
    }
}
__device__ __forceinline__ void ph_mix_a(const KP& p, const Fr& F) {
    if (F.bid < 32) gdn_scan_item(p, (F.bid + 1) * 8 + F.wave, (float*)(F.lds + 8 * FAST_WL + 1024 + F.wave * 512), F.lane);
    float* wl = (float*)(F.lds + F.wave * FAST_WL);
    for (int unit = F.gw; unit < 2048; unit += F.NGW) nsa_fast_unit(p, unit, wl, F.lane);
}
__device__ __forceinline__ void ph_mix_b(const KP& p, const Fr& F) {
    if (F.bid < 8) { gdn_chain_wg(p, F.bid, F.wave, F.lane, F.lds); return; }
    if (F.bid < 24) {
        const int it = (F.bid - 8) * 4 + (F.wave & 3);
        if (F.wave < 4) nsa_smp_cs(p, it >> 1, it & 1, (float*)(F.lds + F.wave * 20480), F.lane);
        else nsa_smp_win(p, it >> 1, it & 1, (float*)(F.lds + 81920 + (F.wave - 4) * 12288), F.lane);
        return;
    }
    const int g = F.bid & 1, fr = (F.bid - 24) >> 1, NW = ((F.G - 24) >> 1) * 8;
    for (int tq = fr * 8 + F.wave; tq < T; tq += NW) { if (tq >= 1024) nsa_slc_item8<false>(p, tq, g, F.lane); else nsa_slc_item8<true>(p, tq, g, F.lane); }
}

__device__ __forceinline__ void ph_gdn_out(const KP& p, const Fr& F) {
    const float* H0 = p.BIGF; const int lane = F.lane;
    for (int unit = F.gw; unit < 2048; unit += F.NGW) gdn_out_unit(p, unit, lane);
    for (int idx = F.bid * NTHR + F.tid; idx < NSMP * 512; idx += F.G * NTHR) { const int b = idx >> 9, c = idx & 511; const float* sp = p.SMIXF + (size_t)b * 3 * 512 + c;
        p.MIXB[(size_t)(T + b) * 1024 + c] = (bf16)f2bf(sp[0] + sp[512] + sp[1024]); }
    for (int item = T * 8 + F.gw; item < TS * 8; item += F.NGW) {
        const int r = item >> 3, h = item & 7;
        const float o = p.OG[((size_t)r * 8 + h) * 64 + lane];
        const float ms = wave_sum(o * o) * (1.f / 64.f);
        const float z = H0[(size_t)r * PA + C_Z + h * 64 + lane];
        p.MIXB[(size_t)r * 1024 + 512 + h * 64 + lane] = (bf16)f2bf(o * rsqrtf(ms + NORM_EPS) * p.gnw[lane] * siluf_(z));
    }
}

__device__ __forceinline__ void ph_ln(const Fr& F, const float* Xp, const float* Xs, const float* Fm, const float* gam, const float* bet, float* outp, float* outs, bf16* ob) {
    const int lane = F.lane;
    for (int r = F.gw; r < TS; r += F.NGW) {
        const float4* xr = (const float4*)((r < T) ? Xp + (size_t)r * DM : Xs + (size_t)(r - T) * DM) + lane; const float4* fr = (const float4*)(Fm + (size_t)r * DM) + lane;
        f32x4 v[4]; float s = 0.f;
#pragma unroll
        for (int j = 0; j < 4; ++j) { const float4 x = xr[64 * j], f = fr[64 * j]; v[j] = (f32x4){DN_ALPHA * x.x + f.x, DN_ALPHA * x.y + f.y, DN_ALPHA * x.z + f.z, DN_ALPHA * x.w + f.w}; s += (v[j][0] + v[j][1]) + (v[j][2] + v[j][3]); }
        const float mean = wave_sum(s) * (1.f / DM); float q = 0.f;
#pragma unroll
        for (int j = 0; j < 4; ++j) { v[j] = v[j] - mean; q += (v[j][0] * v[j][0] + v[j][1] * v[j][1]) + (v[j][2] * v[j][2] + v[j][3] * v[j][3]); }
        const float rstd = rsqrtf(wave_sum(q) * (1.f / DM) + LN_EPS);
        float4* o = (float4*)((r < T) ? outp + (size_t)r * DM : outs + (size_t)(r - T) * DM) + lane;
#pragma unroll
        for (int j = 0; j < 4; ++j) { const float4 g4 = ((const float4*)gam)[lane + 64 * j], b4 = ((const float4*)bet)[lane + 64 * j];
            const float4 y = make_float4(v[j][0] * rstd * g4.x + b4.x, v[j][1] * rstd * g4.y + b4.y, v[j][2] * rstd * g4.z + b4.z, v[j][3] * rstd * g4.w + b4.w);
            o[64 * j] = y; if (ob) { uint2 w; w.x = pk2(y.x, y.y); w.y = pk2(y.z, y.w); *((uint2*)(ob + (size_t)r * DM) + lane + 64 * j) = w; } }
    }
}

__device__ __forceinline__ void ph_ffn_act(const KP& p, const Fr& F, int layer) {
    const float* U = p.BIGF; const float* cw = p.ffn_cw + (size_t)layer * 3 * DFF2; const float* cb = p.ffn_cb + (size_t)layer * DFF2;
    const size_t gt = (size_t)F.bid * NTHR + F.tid, GT = (size_t)F.G * NTHR;
    const size_t total = (size_t)TS * DFF;
    for (size_t idx = gt; idx < total; idx += GT) {
        const int r = (int)(idx / DFF), j = (int)(idx % DFF);
        const bool smp = r >= T; const int b = r - T;
        float c2[2];
#pragma unroll
        for (int half = 0; half < 2; ++half) {
            const int ch = half * DFF + j;
            float acc = cb[ch];
#pragma unroll
            for (int k = 0; k < 3; ++k) {
                float u;
                if (!smp) { const int t = r + k - 2; u = (t >= 0) ? U[(size_t)t * DFF2 + ch] : 0.f; }
                else u = (k < 2) ? p.st_ffn[(((size_t)b * 2 + layer) * 2 + k) * DFF2 + ch] : U[(size_t)r * DFF2 + ch];
                acc += cw[k * DFF2 + ch] * u;
            }
            c2[half] = acc;
        }
        p.HFFB[idx] = (bf16)f2bf(siluf_(c2[0]) * c2[1]);
    }
    for (size_t idx = gt; idx < (size_t)2 * DFF2; idx += GT) {
        const int k = (int)(idx / DFF2), ch = (int)(idx % DFF2);
        p.out[O_FFN_P + ((size_t)layer * 2 + k) * DFF2 + ch] = U[(size_t)(T - 2 + k) * DFF2 + ch];
    }
    for (size_t idx = gt; idx < (size_t)NSMP * 2 * DFF2; idx += GT) {
        const int b = (int)(idx / (2 * DFF2)), k = (int)((idx / DFF2) % 2), ch = (int)(idx % DFF2);
        p.out[O_FFN_S + (((size_t)b * 2 + layer) * 2 + k) * DFF2 + ch] =
            (k == 0) ? p.st_ffn[(((size_t)b * 2 + layer) * 2 + 1) * DFF2 + ch] : U[(size_t)(T + b) * DFF2 + ch];
    }
}

__device__ __forceinline__ void ph_dil_prep(const KP& p, const Fr& F) {
    const float* H1 = p.BIGF;
    const size_t gt = (size_t)F.bid * NTHR + F.tid, GT = (size_t)F.G * NTHR;
    const size_t total = (size_t)TS * 2048;
    for (size_t idx = gt + (size_t)T * 2048; idx < total; idx += GT) {
        const int r = (int)(idx >> 11), c = (int)(idx & 2047);
        const bool smp = r >= T; const int pos = smp ? T : r;
        const float* row = H1 + (size_t)r * 3072;
        const int i = c & 63; const float2 cs = p.ROPE[pos * 32 + (i & 31)];
        const float v = rope_val(row, c & ~63, i, cs);
        if (c < 1024) p.QD[(size_t)r * 1024 + c] = v; else p.KD[(size_t)r * 1024 + (c - 1024)] = v;
    }
}
__device__ __forceinline__ void ph_dil_cache(const KP& p, const Fr& F) {
    const float* H1 = p.BIGF;
    const size_t gt = (size_t)F.bid * NTHR + F.tid, GT = (size_t)F.G * NTHR;
    const size_t tots4 = (size_t)NSMP * 2048 * 512;
    for (size_t idx = gt; idx < tots4; idx += GT) {
        const int b = (int)(idx / (2048 * 512)); const int i = (int)((idx / 512) % 2048); const int c4 = (int)(idx % 512);
        float4 v;
        if (i < 2047) v = ((const float4*)p.st_dil)[((size_t)b * 2048 + i + 1) * 512 + c4];
        else { const int c = c4 * 4; const int r = T + b;
               v = (c < 1024) ? *(const float4*)(p.KD + (size_t)r * 1024 + c) : *(const float4*)(H1 + (size_t)r * 3072 + 2048 + (c - 1024)); }
        ((float4*)(p.out + O_DIL_S))[idx] = v;
    }
}
__device__ __forceinline__ void ph_dil_attn(const KP& p, const Fr& F) {
    const float* H1 = p.BIGF; const int lane = F.lane;
    float* qs = (float*)(F.lds + F.wave * 4096); float* sc = qs + 64;
    float* ex = (float*)(F.lds + 32768);
    const int il = F.wave / 3, gi = F.wave - 3 * il;
    const int item = F.bid * 2 + il; const int b = item >> 4, h = item & 15, r = T + b;
    if (F.wave < 6 && item < NSMP * 16) {
        qs[lane] = p.QD[(size_t)r * 1024 + h * 64 + lane];
        wave_lds_sync();
        const int dd = gi == 0 ? 1 : (gi == 1 ? 4 : 16);
        auto kf = [&](int j, const float*& kp, const float*& vp) -> bool {
            const int pos = T - j * dd;
            if (pos == T) { kp = p.KD + (size_t)r * 1024 + h * 64; vp = H1 + (size_t)r * 3072 + 2048 + h * 64; return true; }
            const float* base = p.st_dil + ((size_t)b * 2048 + (pos - (T - 2048))) * 2048;
            kp = base + h * 64; vp = base + 1024 + h * 64; return true; };
        float o[1], den[1], mx[1];
        wave_attend<1>(qs, sc, 448, 129, kf, o, den, lane, mx);
        float* e = ex + (il * 3 + gi) * 68;
        e[lane] = o[0] * den[0]; if (lane == 0) { e[64] = mx[0]; e[65] = den[0]; }
    }
    __syncthreads();
    if (F.wave < 6 && gi == 0 && item < NSMP * 16) {
        const float* e = ex + il * 3 * 68;
        const float m0 = e[64], m1 = e[68 + 64], m2 = e[136 + 64]; const float M = fmaxf(m0, fmaxf(m1, m2));
        const float w0 = expf(m0 - M), w1 = expf(m1 - M), w2 = expf(m2 - M);
        const float num = w0 * e[lane] + w1 * e[68 + lane] + w2 * e[136 + lane], dn = w0 * e[65] + w1 * e[68 + 65] + w2 * e[136 + 65];
        p.MIXB[(size_t)r * 1024 + h * 64 + lane] = (bf16)f2bf(num / dn);
    }
}

__device__ __forceinline__ void ph_dil_prep_fast(const KP& p, const Fr& F) {
    const float* H1 = p.BIGF;
    const size_t gt = (size_t)F.bid * NTHR + F.tid, GT = (size_t)F.G * NTHR;
    for (size_t idx = gt; idx < (size_t)T * 128; idx += GT) {
        const int t = (int)(idx >> 7), u = (int)(idx & 127);
        const int hq = u >> 2, d0 = (u & 3) * 8, c0 = hq * 64 + d0; const bf16* row = p.H1B + (size_t)t * 3072;
        const v4u ua = *(const v4u*)(row + c0), ub = *(const v4u*)(row + c0 + 32);
        const float4* rp = (const float4*)(p.ROPE + t * 32 + d0); const float4 r0 = rp[0], r1 = rp[1], r2 = rp[2], r3 = rp[3];
        float x1[8], x2[8];
#pragma unroll
        for (int e = 0; e < 4; ++e) { x1[2 * e] = __uint_as_float(ua[e] << 16); x1[2 * e + 1] = __uint_as_float(ua[e] & 0xffff0000u); x2[2 * e] = __uint_as_float(ub[e] << 16); x2[2 * e + 1] = __uint_as_float(ub[e] & 0xffff0000u); }
        const float cs[8] = {r0.x, r0.z, r1.x, r1.z, r2.x, r2.z, r3.x, r3.z}, sn[8] = {r0.y, r0.w, r1.y, r1.w, r2.y, r2.w, r3.y, r3.w};
        float lo[8], hi[8];
#pragma unroll
        for (int j = 0; j < 8; ++j) { lo[j] = x1[j] * cs[j] - x2[j] * sn[j]; hi[j] = x2[j] * cs[j] + x1[j] * sn[j]; }
        if (hq < 16) {
            v4u o; o.x = pk2(lo[0] * QSCALE, lo[1] * QSCALE); o.y = pk2(lo[2] * QSCALE, lo[3] * QSCALE); o.z = pk2(lo[4] * QSCALE, lo[5] * QSCALE); o.w = pk2(lo[6] * QSCALE, lo[7] * QSCALE);
            *(v4u*)(p.QDB + (size_t)t * 1024 + c0) = o;
            o.x = pk2(hi[0] * QSCALE, hi[1] * QSCALE); o.y = pk2(hi[2] * QSCALE, hi[3] * QSCALE); o.z = pk2(hi[4] * QSCALE, hi[5] * QSCALE); o.w = pk2(hi[6] * QSCALE, hi[7] * QSCALE);
            *(v4u*)(p.QDB + (size_t)t * 1024 + c0 + 32) = o;
        } else {
            const int h = hq - 16, kc = h * 64 + d0;
            v4u ol, oh; ol.x = pk2(lo[0], lo[1]); ol.y = pk2(lo[2], lo[3]); ol.z = pk2(lo[4], lo[5]); ol.w = pk2(lo[6], lo[7]);
            oh.x = pk2(hi[0], hi[1]); oh.y = pk2(hi[2], hi[3]); oh.z = pk2(hi[4], hi[5]); oh.w = pk2(hi[6], hi[7]);
#pragma unroll
            for (int pass = 0; pass < 3; ++pass) { const int sh = 2 * pass; const int pi = (t & ((1 << sh) - 1)) * (T >> sh) + (t >> sh);
                bf16* kb = (pass == 0 ? p.DKF[0] : pass == 1 ? p.DKF[1] : p.DKF[2]) + (size_t)h * T * 64;
                *(v4u*)(kb + kfrag_elem(pi, d0)) = ol; *(v4u*)(kb + kfrag_elem(pi, d0 + 32)) = oh; }
            if (t >= T - 2048) { float* op = p.out + O_DIL_P + (size_t)(t - (T - 2048)) * 2048 + kc;
                *(float4*)op = make_float4(lo[0], lo[1], lo[2], lo[3]); *(float4*)(op + 4) = make_float4(lo[4], lo[5], lo[6], lo[7]);
                *(float4*)(op + 32) = make_float4(hi[0], hi[1], hi[2], hi[3]); *(float4*)(op + 36) = make_float4(hi[4], hi[5], hi[6], hi[7]); }
        }
    }
    for (size_t idx = gt; idx < (size_t)2048 * 256; idx += GT) {
        const int i = (int)(idx >> 8), c4 = (int)(idx & 255);
        const uint2 uv = *(const uint2*)(p.H1B + (size_t)(T - 2048 + i) * 3072 + 2048 + c4 * 4);
        *(float4*)(p.out + O_DIL_P + (size_t)i * 2048 + 1024 + c4 * 4) = make_float4(__uint_as_float(uv.x << 16), __uint_as_float(uv.x & 0xffff0000u), __uint_as_float(uv.y << 16), __uint_as_float(uv.y & 0xffff0000u));
    }
    const int lane = F.lane, l15 = lane & 15, grp = lane >> 4;
    for (int unit = F.gw; unit < 3 * 16 * 512; unit += F.NGW) {
        const int st = unit & 511, h = (unit >> 9) & 15, pass = unit >> 13; const int sh = 2 * pass, Td = T >> sh;
        const int pi0 = 32 * st, r = pi0 / Td, s0 = pi0 - r * Td;
        bf16* dst = p.DVF[pass] + (size_t)h * T * 64;
#pragma unroll
        for (int dt = 0; dt < 4; ++dt) {
            unsigned v[8];
#pragma unroll
            for (int j = 0; j < 8; ++j) { const int s = s0 + 16 * (j >> 2) + 4 * grp + (j & 3); const int t = (s << sh) + r;
                v[j] = p.H1B[(size_t)t * 3072 + 2048 + h * 64 + 16 * dt + l15]; }
            v4u o; o.x = v[0] | (v[1] << 16); o.y = v[2] | (v[3] << 16); o.z = v[4] | (v[5] << 16); o.w = v[6] | (v[7] << 16);
            *(v4u*)(dst + vfrag_off(st, dt, lane)) = o;
        }
    }
}

__device__ __forceinline__ void dil_pass(const KP& p, int unit, int pass, unsigned char* ldsb, int w4, int lane) {
    asm volatile("" : "+v"(lane));
    const int h = unit & 15, P0 = (unit >> 4) * 256;
    const int l15 = lane & 15, grp = lane >> 4;
    float* stO = (float*)ldsb; float* stML = stO + 256 * 64;
    {
        const int sh = 2 * pass, Td = T >> sh;
        const bf16* KF = (pass == 0 ? p.DKF[0] : pass == 1 ? p.DKF[1] : p.DKF[2]) + (size_t)h * T * 64;
        const bf16* VF = (pass == 0 ? p.DVF[0] : pass == 1 ? p.DVF[1] : p.DVF[2]) + (size_t)h * T * 64;
        for (int tt = 0; tt < 4; ++tt) {
            const int tl = 4 * w4 + tt;
            const int r = tl >> (4 - sh), s0 = (P0 >> sh) + 16 * (tl & ((16 >> sh) - 1));
            const int sq = s0 + l15, tq = (sq << sh) + r, tloc = tq - P0;
            bf16x8 qf[2];
#pragma unroll
            for (int ks = 0; ks < 2; ++ks) qf[ks] = *(const bf16x8*)(p.QDB + (size_t)tq * 1024 + h * 64 + 32 * ks + 8 * grp);
            AttW a;
            if (pass == 0) attw_init(a);
            else {
#pragma unroll
                for (int dt = 0; dt < 4; ++dt) a.o[dt] = *(const f32x4*)(stO + tloc * 64 + 16 * dt + 4 * grp);
                a.m = stML[tloc * 2]; a.l = (grp == 0) ? stML[tloc * 2 + 1] : 0.f;
            }
            int kstart = s0 - 128; if (kstart < 0) kstart = 0; kstart &= ~31;
            const int nsteps = (s0 + 16 - kstart + 31) >> 5;
            const int base = r * Td;
            bf16x8 kf[3][2][2], vf[3][4];
            auto issue = [&](int s, int buf) {
                const int k0 = kstart + 32 * s;
#pragma unroll
                for (int tl2 = 0; tl2 < 2; ++tl2)
#pragma unroll
                    for (int ks = 0; ks < 2; ++ks) kf[buf][tl2][ks] = *(const bf16x8*)(KF + kfrag_off(((base + k0) >> 4) + tl2, ks, lane));
#pragma unroll
                for (int dt = 0; dt < 4; ++dt) vf[buf][dt] = *(const bf16x8*)(VF + vfrag_off((base + k0) >> 5, dt, lane));
            };
            issue(0, 0); if (nsteps > 1) issue(1, 1);
#pragma unroll
            for (int s = 0; s < 5; ++s) {
                if (s < nsteps) {
                    if (s + 2 < nsteps) issue(s + 2, (s + 2) % 3);
                    const int k0 = kstart + 32 * s;
                    f32x4 s0v, s1v; qk_step(kf[s % 3], qf, s0v, s1v);
                    if ((k0 + 31 > s0) || (k0 < s0 + 15 - 128)) {
                        const int pb = k0 + 4 * grp;
#pragma unroll
                        for (int i = 0; i < 4; ++i) { const int p0 = pb + i, p1 = pb + 16 + i;
                            if (p0 > sq || p0 < sq - 128) s0v[i] = -INFINITY; if (p1 > sq || p1 < sq - 128) s1v[i] = -INFINITY; }
                    }
                    att_update(a, s0v, s1v, vf[s % 3]);
                }
            }
            const float lt = grp_sum(a.l);
            if (pass < 2) {
#pragma unroll
                for (int dt = 0; dt < 4; ++dt) *(f32x4*)(stO + tloc * 64 + 16 * dt + 4 * grp) = a.o[dt];
                if (grp == 0) { stML[tloc * 2] = a.m; stML[tloc * 2 + 1] = lt; }
            } else {
                const float il = lt > 0.f ? 1.f / lt : 0.f;
#pragma unroll
                for (int dt = 0; dt < 4; ++dt) { uint2 o; o.x = pk2(a.o[dt][0] * il, a.o[dt][1] * il); o.y = pk2(a.o[dt][2] * il, a.o[dt][3] * il);
                    *(uint2*)(p.MIXB + (size_t)tq * 1024 + h * 64 + 16 * dt + 4 * grp) = o; }
            }
        }
    }
}
__device__ __forceinline__ void ph_dil_combo(const KP& p, const Fr& F) {
    const float* H1 = p.BIGF; const int lane = F.lane;
    const int cw = F.bid * 4 + F.wave;
#pragma unroll 1
    for (int u = 0; u < 4; ++u) {
#pragma unroll
        for (int pass = 0; pass < 3; ++pass) {
            if (F.wave >= 4) dil_pass(p, F.bid + u * F.G, pass, F.lds, F.wave - 4, lane);
            else {
                const int ci = u * 3 + pass;
                const int g0 = ci * 2 + (ci < 8 ? ci : 8), g1 = g0 + 2 + (ci < 8 ? 1 : 0);
                auto srcp = [&](int itn) -> const float4* {
                    const size_t idx = ((size_t)itn * 1024 + cw) * 64 + lane;
                    const int b = (int)(idx >> 20), i = (int)((idx >> 9) & 2047), c4 = (int)(idx & 511);
                    const int c = c4 * 4, r = T + b;
                    const float4* s_old = ((const float4*)p.st_dil) + ((size_t)b * 2048 + (i < 2047 ? i + 1 : 2047)) * 512 + c4;
                    const float4* s_new = (c < 1024) ? (const float4*)(p.KD + (size_t)r * 1024 + c) : (const float4*)(H1 + (size_t)r * 3072 + 2048 + (c - 1024));
                    return (i == 2047) ? s_new : s_old; };
                float4* dstp = (float4*)(p.out + O_DIL_S) + (size_t)cw * 64 + lane;
#pragma unroll 1
                for (int gi = g0; gi < g1; ++gi) {
                    const int i0 = gi * 16;
                    const float4 v0 = *srcp(i0), v1 = *srcp(i0 + 1), v2 = *srcp(i0 + 2), v3 = *srcp(i0 + 3), v4 = *srcp(i0 + 4), v5 = *srcp(i0 + 5), v6 = *srcp(i0 + 6), v7 = *srcp(i0 + 7);
                    const float4 v8 = *srcp(i0 + 8), v9 = *srcp(i0 + 9), v10 = *srcp(i0 + 10), v11 = *srcp(i0 + 11), v12 = *srcp(i0 + 12), v13 = *srcp(i0 + 13), v14 = *srcp(i0 + 14), v15 = *srcp(i0 + 15);
                    float4* d = dstp + (size_t)i0 * 65536;
                    d[0] = v0; d[65536] = v1; d[2 * 65536] = v2; d[3 * 65536] = v3; d[4 * 65536] = v4; d[5 * 65536] = v5; d[6 * 65536] = v6; d[7 * 65536] = v7;
                    d[8 * 65536] = v8; d[9 * 65536] = v9; d[10 * 65536] = v10; d[11 * 65536] = v11; d[12 * 65536] = v12; d[13 * 65536] = v13; d[14 * 65536] = v14; d[15 * 65536] = v15;
                }
            }
            __syncthreads();
        }
    }
}

constexpr int NPHASE = 21;
__global__ void __launch_bounds__(NTHR, 2) mega(KP p) {
    extern __shared__ __attribute__((aligned(16))) unsigned char lds[];
    Fr F; F.lds = lds; F.tid = threadIdx.x; F.lane = 0; F.wave = __builtin_amdgcn_readfirstlane(F.tid >> 6);
    F.bid = blockIdx.x; F.G = gridDim.x; F.gw = F.bid * NWAVES + F.wave; F.NGW = F.G * NWAVES; F.tgt = F.bid * NTHR + F.tid; F.tGT = F.G * NTHR;
    for (int u = F.tid; u < (LDS_BYTES - RING_BYTES) / 4; u += NTHR) ((unsigned*)(lds + RING_BYTES))[u] = 0u;
    __syncthreads();
    XcdBarrier bar; bar.bar = p.ctl + 4096; bar.x = 0; bar.st = nullptr;
    if (!MK_PER_PHASE) bar = xcd_barrier_post(p.ctl + 4096, (volatile LAS unsigned*)(lds + MISC_OFF + 32));
    const int lo = p.ph_lo, hi = p.ph_hi;
#define IN(k) (lo <= (k) && (k) < hi)

    int ph = 0;
#if PROBE_ON
#define PROBE_STAMP(k) do { if (blockIdx.x == 0 && threadIdx.x == 0) ((unsigned long long*)(p.ctl + 65536))[k] = __builtin_amdgcn_s_memrealtime(); } while (0)
#define PROBE_STAMPB(k, blk) do { if (blockIdx.x == (blk) && threadIdx.x == 0) ((unsigned long long*)(p.ctl + 65536))[k] = __builtin_amdgcn_s_memrealtime(); } while (0)
    PROBE_STAMP(0);
#else
#define PROBE_STAMP(k) do { } while (0)
#define PROBE_STAMPB(k, blk) do { } while (0)
#endif
#define PHASE(...) do { { unsigned t_ = threadIdx.x; asm volatile("" : "+v"(t_)); F.lane = (int)(t_ & 63u); } if (IN(ph)) { __VA_ARGS__ } if (IN(ph) && IN(ph + 1)) xcd_barrier(bar); ++ph; PROBE_STAMP(ph); } while (0)
    PHASE(ph_prologue(p, F););
    PHASE(ph_gemm_h0(p, F); ph_cmp_samples(p, F););
    PHASE(ph_prep_chunks(p, F););
    PHASE(ph_mix_a(p, F););
    PHASE(ph_mix_b(p, F););
    PHASE(ph_gdn_out(p, F););
    PHASE(ph_gemm_bf16(F, p.MIXB, p.WT_OA, DM, p.MOB););
    PHASE(ph_ln_b(F, p.ACTB, p.MOB, p.ln_mix_g, p.ln_mix_b, nullptr, nullptr););
    PHASE(ph_ffn_gemm(p, F, p.WT_FI0, 0););
    PHASE(ph_ffn_fix(p, F, 0););
    PHASE(ph_gemm_bf16(F, p.HFFB, p.WT_FO0, DFF, p.MOB););
    PHASE(ph_ln_b(F, p.ACTB, p.MOB, p.ln_ffn_g, p.ln_ffn_b, nullptr, nullptr););
    PHASE(ph_gemm_h1(p, F););
    PHASE(ph_dil_prep(p, F); ph_dil_prep_fast(p, F););
    PHASE(ph_dil_attn(p, F); __syncthreads(); ph_dil_combo(p, F););
    PHASE(ph_gemm_bf16(F, p.MIXB, p.WT_CO, DM, p.MOB););
    PHASE(ph_ln_b(F, p.ACTB, p.MOB, p.ln_mix_g + DM, p.ln_mix_b + DM, nullptr, nullptr););
    PHASE(ph_ffn_gemm(p, F, p.WT_FI1, 1););
    PHASE(ph_ffn_fix(p, F, 1););
    PHASE(ph_gemm_bf16(F, p.HFFB, p.WT_FO1, DFF, p.MOB););
    PHASE(ph_ln_b(F, p.ACTB, p.MOB, p.ln_ffn_g + DM, p.ln_ffn_b + DM, p.out + O_Y_P, p.out + O_Y_S););
#undef PHASE
#if PROBE_ON
    xcd_barrier(bar);
    if (blockIdx.x == 0) { __syncthreads(); const unsigned long long* pts = (const unsigned long long*)(p.ctl + 65536); const float x = (float)(pts[PROBE_B] - pts[PROBE_A]) * 1e-5f;
        for (int i = threadIdx.x; i < NSMP * DM; i += NTHR) p.out[O_Y_S + i] *= (1.f + x); }
#endif
#undef IN
}

static inline size_t align_up(size_t x) { return (x + 255) & ~(size_t)255; }

extern "C" void kernel_launch(void* const* d_in, const int* in_sizes, int n_in, void* d_out, int out_size, void* d_ws, size_t ws_size, hipStream_t stream) {
    static int grid = 0;
    if (grid == 0) {
        int dev = 0, cus = 0, per_cu = 0;
        if (hipGetDevice(&dev) != hipSuccess || hipDeviceGetAttribute(&cus, hipDeviceAttributeMultiprocessorCount, dev) != hipSuccess) { fprintf(stderr, "kernel_launch: device query failed\n"); grid = -1; return; }
        if (hipFuncSetAttribute((const void*)mega, hipFuncAttributeMaxDynamicSharedMemorySize, LDS_BYTES) != hipSuccess) { fprintf(stderr, "kernel_launch: hipFuncSetAttribute failed\n"); grid = -1; return; }
        if (hipOccupancyMaxActiveBlocksPerMultiprocessor(&per_cu, (const void*)mega, NTHR, LDS_BYTES) != hipSuccess || per_cu < 1) { fprintf(stderr, "kernel_launch: occupancy query says %d blocks per CU\n", per_cu); }
        (void)hipGetLastError();
        grid = cus;
    }
    if (grid < 0) return;
    if ((size_t)out_size != O_END) fprintf(stderr, "kernel_launch: out_size %d != expected %zu\n", out_size, (size_t)O_END);
    KP p{};
    p.x_prompt = (const float*)d_in[0]; p.x_sample = (const float*)d_in[1]; p.cache_cmp = (const float*)d_in[2]; p.cache_slc = (const float*)d_in[3];
    p.st_win = (const float*)d_in[4]; p.st_gconv = (const float*)d_in[5]; p.st_gS = (const float*)d_in[6]; p.st_dil = (const float*)d_in[7];
    p.st_ffn = (const float*)d_in[8]; p.page_table = (const int*)d_in[9]; p.w_in_a = (const float*)d_in[10]; p.cw1 = (const float*)d_in[11];
    p.cb1 = (const float*)d_in[12]; p.cw2 = (const float*)d_in[13]; p.cpe = (const float*)d_in[14]; p.gconv_w = (const float*)d_in[15];
    p.gA = (const float*)d_in[16]; p.gdt = (const float*)d_in[17]; p.gnw = (const float*)d_in[18]; p.w_out_a = (const float*)d_in[19];
    p.w_in_c = (const float*)d_in[20]; p.w_out_c = (const float*)d_in[21]; p.ln_mix_g = (const float*)d_in[22]; p.ln_mix_b = (const float*)d_in[23];
    p.ffn_w_in = (const float*)d_in[24]; p.ffn_cw = (const float*)d_in[25]; p.ffn_cb = (const float*)d_in[26]; p.ffn_w_out = (const float*)d_in[27];
    p.ln_ffn_g = (const float*)d_in[28]; p.ln_ffn_b = (const float*)d_in[29];
    p.out = (float*)d_out;
    char* ws = (char*)d_ws; size_t off = 0;
    auto alloc = [&](size_t bytes) { void* q = (void*)(ws + off); off = align_up(off + bytes); return q; };
    p.ctl = (unsigned*)alloc(1 << 20);
    p.WT_A = (bf16*)alloc((size_t)PAP * DM * 2); p.WT_OA = (bf16*)alloc((size_t)DM * DM * 2);
    p.WT_FI0 = (bf16*)alloc((size_t)DFF2 * DM * 2); p.WT_FI1 = (bf16*)alloc((size_t)DFF2 * DM * 2);
    p.WT_FO0 = (bf16*)alloc((size_t)DM * DFF * 2); p.WT_FO1 = (bf16*)alloc((size_t)DM * DFF * 2);
    p.WT_CI = (bf16*)alloc((size_t)3072 * DM * 2); p.WT_CO = (bf16*)alloc((size_t)DM * DM * 2);
    p.ROPE = (float2*)alloc((size_t)(T + 1) * 32 * 8);
    p.ACTB = (bf16*)alloc((size_t)TSP * DM * 2); p.MIXB = (bf16*)alloc((size_t)TSP * DM * 2); p.HFFB = (bf16*)alloc((size_t)TSP * DFF * 2);
    p.KS8 = (unsigned char*)alloc((size_t)2 * T * 64); p.VS8 = (unsigned char*)alloc((size_t)2 * T * 64);
    p.QB = (bf16*)alloc((size_t)T * 512 * 2); p.KSF = (bf16*)alloc((size_t)2 * T * 64 * 2); p.VSF = (bf16*)alloc((size_t)2 * T * 64 * 2);
    p.KWF = (bf16*)alloc((size_t)2 * T * 64 * 2); p.VWF = (bf16*)alloc((size_t)2 * T * 64 * 2); p.CKF = (bf16*)alloc((size_t)2 * 512 * 64 * 2); p.CVF = (bf16*)alloc((size_t)2 * 512 * 64 * 2);
    p.ACP = (bf16*)alloc((size_t)2048 * 2048 * 2);
    p.W2T = (bf16*)alloc((size_t)2 * 64 * 128 * 2);
    p.AC = nullptr; p.WT_C = (bf16*)alloc((size_t)256 * 2048 * 2); p.HID = nullptr; p.SMIXF = (float*)alloc((size_t)NSMP * 3 * 512 * 4);
    p.UB = (float*)alloc((size_t)256 * 4 * DFF2 * 4);
    p.NSACC = (float*)alloc((size_t)T * 512 * 4); p.SEL = (int*)alloc((size_t)2 * T * 16 * 4);
    p.QDB = (bf16*)alloc((size_t)T * 1024 * 2);
    for (int i = 0; i < 3; ++i) { p.DKF[i] = (bf16*)alloc((size_t)T * 1024 * 2); p.DVF[i] = (bf16*)alloc((size_t)T * 1024 * 2); }
    p.G_WF = (bf16*)alloc((size_t)2048 * 4096 * 2); p.G_KDF = (bf16*)alloc((size_t)2048 * 4096 * 2); p.G_QGF = (bf16*)alloc((size_t)2048 * 4096 * 2); p.G_QKF = (bf16*)alloc((size_t)2048 * 4096 * 2);
    p.G_SPF = (bf16*)alloc((size_t)2048 * 4096 * 2); p.G_VNF = (bf16*)alloc((size_t)2048 * 4096 * 2); p.G_UF = (float*)alloc((size_t)2048 * 4096 * 4); p.G_GL = (float*)alloc((size_t)2048 * 4);
    p.MOB = (bf16*)alloc((size_t)TSP * DM * 2); p.H1B = (bf16*)alloc((size_t)T * 3072 * 2); p.H0B = (bf16*)alloc((size_t)T * PAP * 2); p.ZF = (float*)alloc((size_t)T * 512 * 4);
    p.BIGF = (float*)alloc((size_t)TSP * DFF2 * 4); p.MO = (float*)alloc((size_t)TSP * DM * 4);
    p.X1 = (float*)alloc((size_t)TS * DM * 4); p.X2 = (float*)alloc((size_t)TS * DM * 4); p.X3 = (float*)alloc((size_t)TS * DM * 4);
    p.QR = (float*)alloc((size_t)TS * 512 * 4);
    p.KS = (float*)alloc((size_t)TS * 128 * 4); p.VS = (float*)alloc((size_t)TS * 128 * 4); p.KW = (float*)alloc((size_t)TS * 128 * 4); p.VW = (float*)alloc((size_t)TS * 128 * 4);
    p.CK = (float*)alloc((size_t)33 * 512 * 128 * 4); p.CV = (float*)alloc((size_t)33 * 512 * 128 * 4);
    p.GQ = (float*)alloc((size_t)TS * 512 * 4); p.GK = (float*)alloc((size_t)TS * 512 * 4); p.GV = (float*)alloc((size_t)TS * 512 * 4); p.OG = (float*)alloc((size_t)TS * 512 * 4);
    p.Gg = (float*)alloc((size_t)TS * 8 * 4); p.Gb = (float*)alloc((size_t)TS * 8 * 4);
    p.QD = (float*)alloc((size_t)TS * DM * 4); p.KD = (float*)alloc((size_t)TS * DM * 4);
    if (off > ws_size) { fprintf(stderr, "kernel_launch: workspace too small: need %zu have %zu\n", off, ws_size); return; }
    if (hipMemsetAsync(p.ctl, 0, 1 << 20, stream) != hipSuccess) { fprintf(stderr, "kernel_launch: memset failed\n"); return; }
#if MK_PER_PHASE
    for (int k = 0; k < NPHASE; ++k) { p.ph_lo = k; p.ph_hi = k + 1; hipLaunchKernelGGL(mega, dim3(grid), dim3(NTHR), LDS_BYTES, stream, p); }
#else
    p.ph_lo = 0; p.ph_hi = NPHASE;
    hipLaunchKernelGGL(mega, dim3(grid), dim3(NTHR), LDS_BYTES, stream, p);
#endif
    const hipError_t le = hipPeekAtLastError();
    if (le != hipSuccess) fprintf(stderr, "kernel_launch: launch failed: %s\n", hipGetErrorName(le));
}
```

```cpp
#include <hip/hip_runtime.h>
#include <cstdint>
#include <cstdio>
#include <cmath>

namespace pg8 {
#define PG8_LAS __attribute__((address_space(3)))
typedef unsigned short bf16_t;
typedef short bf16x8 __attribute__((ext_vector_type(8)));
typedef float f32x4 __attribute__((ext_vector_type(4)));
typedef unsigned u32x4 __attribute__((ext_vector_type(4)));
constexpr int BM = 256, BK = 64, HALF = 128, HTB = HALF * BK * 2  , STAGE_BYTES = 8 * HTB, NXCD = 8, WGM = 8;

__host__ __device__ __forceinline__ int lds_byte(int r, int c) { const int st = (r >> 4) * 2 + (c >> 5), rr = r & 15, cc = c & 31, ob = rr * 64 + cc * 2; return st * 1024 + (ob ^ (((ob >> 9) & 1) << 5)); }
__host__ __device__ __forceinline__ void stage_rc(int b, int& R, int& C) { const int st = b / 1024, sb = b % 1024, swz = sb ^ (((sb >> 9) & 1) << 5); R = (st >> 1) * 16 + swz / 64; C = (st & 1) * 32 + (swz % 64) / 2; }
__host__ __device__ __forceinline__ int perm32(int rho) { const int n = rho >> 4, i = rho & 15; return 8 * (i >> 2) + 4 * n + (i & 3); }

struct Unit { int pm, pn; };
struct Gemm { const bf16_t* A; const bf16_t* Bt; int M, N, K; };

struct StaticOrder {
    int nM, nN, nwg, G, c;
    __host__ __device__ void init(int M, int N, int G_, int c_) { nM = M / BM; nN = N / BM; nwg = nM * nN; G = G_; c = c_; }
    __host__ __device__ bool next(int i, Unit& u) const {
        const long L = (long)i * G + c; if (L >= nwg) return false;
        int wgid = (int)L; { const int q = nwg / NXCD, r = nwg % NXCD, xcd = wgid % NXCD, off = wgid / NXCD; wgid = (xcd < r ? xcd * (q + 1) : r * (q + 1) + (xcd - r) * q) + off; }
        const int nig = WGM * nN, gid = wgid / nig, fm = gid * WGM, gsz = (nM - fm) < WGM ? (nM - fm) : WGM;
        u.pm = fm + ((wgid % nig) % gsz); u.pn = (wgid % nig) / gsz; return true;
    }
    __device__ __forceinline__ void a_ready(const Unit&) const {}
    __device__ __forceinline__ void done(const Unit&) const {}
};

typedef __bf16 bf16x2_t __attribute__((ext_vector_type(2)));
typedef float f32x2_t __attribute__((ext_vector_type(2)));
__device__ __forceinline__ unsigned cvt_pk_bf16(float lo, float hi) { const f32x2_t v = {lo, hi}; return __builtin_bit_cast(unsigned, __builtin_convertvector(v, bf16x2_t)); }
typedef float f32x2 __attribute__((ext_vector_type(2)));
__device__ __forceinline__ f32x2 gelu_pk(f32x2 v) {
    const f32x2 av = __builtin_elementwise_abs(v), d = av * 0.2316418882f + 1.0f;
    f32x2 t; t.x = __builtin_amdgcn_rcpf(d.x); t.y = __builtin_amdgcn_rcpf(d.y);
    f32x2 q = t * 0.5307027145f + (-0.7265760135f); q = q * t + 0.7107068705f; q = q * t + (-0.142248368f); q = q * t + 0.127414796f; q = q * t;
    const f32x2 s = (v * v) * (-0.72134752044f);
    f32x2 e; e.x = __builtin_amdgcn_exp2f(s.x); e.y = __builtin_amdgcn_exp2f(s.y);
    const f32x2 m = v * (q * e), r = v - m;
    f32x2 o; o.x = v.x < 0.f ? m.x : r.x; o.y = v.y < 0.f ? m.y : r.y; return o;
}

template <int ACT  > struct EpiBf16 {
    static constexpr bool PERM = true, AFTER_DRAIN = false; static_assert(ACT == 0 || ACT == 1, "EpiBf16: ACT is 0 (none) or 1 (gelu_pk)");
    bf16_t* O; int ldc; const float* bias; int split_cols; size_t split_stride; float scale0;
    __device__ __forceinline__ void operator()(const f32x4 (&acc)[2][2][4][2], const Unit& u, int wr, int wc, int fr, int fq) const {
        const int row0 = u.pm * BM + wr * 64 + fr; int colt = u.pn * BM; bf16_t* base = O;
        float sc = 1.f; if (split_cols) { const int t = colt / split_cols; base += (size_t)t * split_stride; colt -= t * split_cols; if (t == 0) sc = scale0; }
        const int col0 = colt + wc * 32 + 8 * fq, bcol0 = u.pn * BM + wc * 32 + 8 * fq;
        f32x4 bv[2][2];
#pragma unroll
        for (int bj = 0; bj < 2; ++bj)
#pragma unroll
            for (int n = 0; n < 2; ++n) bv[bj][n] = bias ? *(const f32x4*)(bias + bcol0 + bj * HALF + 4 * n) : (f32x4){0.f, 0.f, 0.f, 0.f};
#pragma unroll
        for (int ai = 0; ai < 2; ++ai)
#pragma unroll
            for (int m = 0; m < 4; ++m) { bf16_t* rowp = base + (size_t)(row0 + ai * HALF + m * 16) * ldc + col0;
#pragma unroll
                for (int bj = 0; bj < 2; ++bj) { f32x4 v0 = acc[ai][bj][m][0] + bv[bj][0], v1 = acc[ai][bj][m][1] + bv[bj][1];
                    if (ACT == 1) { f32x2 a = gelu_pk((f32x2){v0[0], v0[1]}), b = gelu_pk((f32x2){v0[2], v0[3]}), c = gelu_pk((f32x2){v1[0], v1[1]}), d = gelu_pk((f32x2){v1[2], v1[3]});
                        v0 = (f32x4){a.x, a.y, b.x, b.y}; v1 = (f32x4){c.x, c.y, d.x, d.y}; }
                    v0 = v0 * sc; v1 = v1 * sc; u32x4 w; w.x = cvt_pk_bf16(v0[0], v0[1]); w.y = cvt_pk_bf16(v0[2], v0[3]); w.z = cvt_pk_bf16(v1[0], v1[1]); w.w = cvt_pk_bf16(v1[2], v1[3]);
                    *(u32x4*)(rowp + bj * HALF) = w; } }
    }
};

struct EpiF32 {
    static constexpr bool PERM = false, AFTER_DRAIN = false;
    float* O; int ldc; int ncols;
    __device__ __forceinline__ void operator()(const f32x4 (&acc)[2][2][4][2], const Unit& u, int wr, int wc, int fr, int fq) const {
        const int row0 = u.pm * BM + wr * 64 + fr; const int col0 = u.pn * BM + wc * 32 + 4 * fq;
#pragma unroll
        for (int ai = 0; ai < 2; ++ai)
#pragma unroll
            for (int m = 0; m < 4; ++m) { float* rowp = O + (size_t)(row0 + ai * HALF + m * 16) * ldc;
#pragma unroll
                for (int bj = 0; bj < 2; ++bj)
#pragma unroll
                    for (int n = 0; n < 2; ++n) { const int c = col0 + bj * HALF + n * 16; if (c < ncols) *(f32x4*)(rowp + c) = acc[ai][bj][m][n]; } }
    }
};
template <class Epi, class Sched, bool ALIGN_EPI = false, bool SP2 = false>
__device__ __forceinline__ void gemm_phase(PG8_LAS unsigned char* lds, const Gemm g, const Sched& S, const Epi& E) {
    const int tid = threadIdx.x, wid = __builtin_amdgcn_readfirstlane(tid >> 6), lane = tid & 63, wr = wid >> 2, wc = wid & 3, fr = lane & 15, fq = lane >> 4;
    const int K = g.K, nt = K / BK;
    unsigned voffA[2], voffB[2];
#pragma unroll
    for (int i = 0; i < 2; ++i) { int R, C; stage_rc(tid * 16 + i * 8192, R, C); const int Rb = Epi::PERM ? ((R & ~31) + perm32(R & 31)) : R;
        voffA[i] = (unsigned)(R * K + C) * 2u; voffB[i] = (unsigned)(Rb * K + C) * 2u; }
    const size_t kstep = (size_t)(BK * 2);
    const size_t hstep = (size_t)HALF * K * 2;
    const size_t tstep = 2 * hstep;
    const unsigned ldsw = (unsigned)wid * 1024u;
    const int aoff = lds_byte(wr * 64 + fr, fq * 8), boff = lds_byte(wc * 32 + fr, fq * 8);
#define PG8_SA(b, h) (((b) * 2 + (h)) * HTB)
#define PG8_SB(b, h) ((4 + (b) * 2 + (h)) * HTB)
#define PG8_STAGE(bufoff, gbase, voff) do { _Pragma("unroll") for (int _i = 0; _i < 2; ++_i) \
        __builtin_amdgcn_global_load_lds((const unsigned*)((const char*)(gbase) + (voff)[_i]), (PG8_LAS unsigned*)(lds + (bufoff) + ldsw + _i * 8192), 16, 0, 0); } while (0)
#define PG8_LDA(dst, b, h) do { _Pragma("unroll") for (int m = 0; m < 4; ++m) _Pragma("unroll") for (int k = 0; k < 2; ++k) dst[m][k] = *(const PG8_LAS bf16x8*)(lds + PG8_SA(b, h) + aoff + m * 2048 + k * 1024); } while (0)
#define PG8_LDB(dst, b, h) do { _Pragma("unroll") for (int n = 0; n < 2; ++n) _Pragma("unroll") for (int k = 0; k < 2; ++k) dst[n][k] = *(const PG8_LAS bf16x8*)(lds + PG8_SB(b, h) + boff + n * 2048 + k * 1024); } while (0)
#define PG8_MMA(ai, bj, At, Bt) do { __builtin_amdgcn_s_setprio(1); _Pragma("unroll") for (int m = 0; m < 4; ++m) _Pragma("unroll") for (int n = 0; n < 2; ++n) _Pragma("unroll") for (int k = 0; k < 2; ++k) \
        acc[ai][bj][m][n] = __builtin_amdgcn_mfma_f32_16x16x32_bf16(Bt[n][k], At[m][k], acc[ai][bj][m][n], 0, 0, 0); __builtin_amdgcn_s_setprio(0); } while (0)
#define PG8_WAIT_V(n) asm volatile("s_waitcnt vmcnt(" #n ")" ::: "memory")
#define PG8_WAIT_L(n) asm volatile("s_waitcnt lgkmcnt(" #n ")" ::: "memory")
#define PG8_BAR __builtin_amdgcn_s_barrier()
#define PG8_SCHED __builtin_amdgcn_sched_barrier(0)
    Unit cur, nxt; int ui = 0;
    if (!S.next(0, cur)) return;
    f32x4 acc[2][2][4][2];
#pragma unroll
    for (int a = 0; a < 2; ++a)
#pragma unroll
        for (int b = 0; b < 2; ++b)
#pragma unroll
            for (int m = 0; m < 4; ++m)
#pragma unroll
                for (int n = 0; n < 2; ++n) acc[a][b][m][n] = (f32x4){0.f, 0.f, 0.f, 0.f};
    bf16x8 At[4][2], B0[2][2], B1[2][2];
    const char* cA = (const char*)g.A + (size_t)cur.pm * tstep; const char* cB = (const char*)g.Bt + (size_t)cur.pn * tstep;
    S.a_ready(cur);
    if constexpr (SP2) {
        PG8_STAGE(PG8_SB(0, 0), cB, voffB); PG8_STAGE(PG8_SB(0, 1), cB + hstep, voffB); PG8_STAGE(PG8_SA(0, 0), cA, voffA); PG8_STAGE(PG8_SA(0, 1), cA + hstep, voffA);
        if (wr == 1) PG8_BAR;
        PG8_WAIT_V(2); PG8_BAR;
        PG8_STAGE(PG8_SB(1, 0), cB + kstep, voffB); PG8_STAGE(PG8_SA(1, 0), cA + kstep, voffA); PG8_STAGE(PG8_SB(1, 1), cB + hstep + kstep, voffB);
        PG8_WAIT_V(6); PG8_BAR;
    } else {
        PG8_STAGE(PG8_SB(0, 0), cB, voffB); PG8_STAGE(PG8_SA(0, 0), cA, voffA); PG8_STAGE(PG8_SB(0, 1), cB + hstep, voffB); PG8_STAGE(PG8_SA(0, 1), cA + hstep, voffA);
        if (wr == 1) PG8_BAR;
        PG8_WAIT_V(4); PG8_BAR;
        PG8_STAGE(PG8_SB(1, 0), cB + kstep, voffB); PG8_STAGE(PG8_SA(1, 0), cA + kstep, voffA); PG8_STAGE(PG8_SB(1, 1), cB + hstep + kstep, voffB);
        PG8_WAIT_V(6); PG8_BAR;
    }
    for (;;) {
        const bool has_next = S.next(ui + 1, nxt);
        const char* nA = has_next ? (const char*)g.A + (size_t)nxt.pm * tstep : cA; const char* nB = has_next ? (const char*)g.Bt + (size_t)nxt.pn * tstep : cB;
        for (int t = 0; t < nt; t += 2) {
            const bool last = (t == nt - 2);
            const char* a1 = cA + (size_t)(t + 1) * kstep;
            const char* a2 = last ? nA : cA + (size_t)(t + 2) * kstep; const char* b2 = last ? nB : cB + (size_t)(t + 2) * kstep;
            const char* a3 = a2 + kstep; const char* b3 = b2 + kstep;
            if (last && has_next) S.a_ready(nxt);
            if constexpr (SP2) {
            PG8_LDB(B0, 0, 0); PG8_LDB(B1, 0, 1); PG8_SCHED; PG8_LDA(At, 0, 0); PG8_STAGE(PG8_SA(1, 1), a1 + hstep, voffA);
            PG8_WAIT_V(8); PG8_WAIT_L(0); PG8_BAR; PG8_MMA(0, 0, At, B0); PG8_MMA(0, 1, At, B1); PG8_BAR; PG8_SCHED;
            PG8_LDA(At, 0, 1); PG8_STAGE(PG8_SB(0, 0), b2, voffB); PG8_STAGE(PG8_SB(0, 1), b2 + hstep, voffB); PG8_STAGE(PG8_SA(0, 0), a2, voffA);
            PG8_WAIT_V(8); PG8_WAIT_L(0); PG8_BAR; PG8_MMA(1, 0, At, B0); PG8_MMA(1, 1, At, B1); PG8_BAR; PG8_SCHED;
            PG8_LDB(B0, 1, 0); PG8_LDB(B1, 1, 1); PG8_SCHED; PG8_LDA(At, 1, 0); PG8_STAGE(PG8_SA(0, 1), a2 + hstep, voffA);
            PG8_WAIT_V(8); PG8_WAIT_L(0); PG8_BAR; PG8_MMA(0, 0, At, B0); PG8_MMA(0, 1, At, B1); PG8_BAR; PG8_SCHED;
            PG8_LDA(At, 1, 1); PG8_STAGE(PG8_SB(1, 0), b3, voffB); PG8_STAGE(PG8_SB(1, 1), b3 + hstep, voffB); PG8_STAGE(PG8_SA(1, 0), a3, voffA);
            PG8_WAIT_V(8); PG8_WAIT_L(0); PG8_BAR; PG8_MMA(1, 0, At, B0); PG8_MMA(1, 1, At, B1); PG8_BAR; PG8_SCHED;
            } else {
            PG8_LDB(B0, 0, 0); PG8_SCHED; PG8_LDA(At, 0, 0); PG8_STAGE(PG8_SA(1, 1), a1 + hstep, voffA);
            PG8_WAIT_L(8); PG8_BAR; PG8_WAIT_L(0); PG8_MMA(0, 0, At, B0); PG8_BAR; PG8_SCHED;
            PG8_LDB(B1, 0, 1); PG8_STAGE(PG8_SB(0, 0), b2, voffB);
            PG8_BAR; PG8_WAIT_L(0); PG8_MMA(0, 1, At, B1); PG8_BAR;
            PG8_LDA(At, 0, 1); PG8_STAGE(PG8_SA(0, 0), a2, voffA);
            PG8_BAR; PG8_WAIT_L(0); PG8_MMA(1, 0, At, B0); PG8_BAR; PG8_SCHED;
            PG8_STAGE(PG8_SB(0, 1), b2 + hstep, voffB);
            PG8_WAIT_V(6); PG8_BAR; PG8_MMA(1, 1, At, B1); PG8_BAR;
            PG8_LDB(B0, 1, 0); PG8_SCHED; PG8_LDA(At, 1, 0); PG8_STAGE(PG8_SA(0, 1), a2 + hstep, voffA);
            PG8_WAIT_L(8); PG8_BAR; PG8_WAIT_L(0); PG8_MMA(0, 0, At, B0); PG8_BAR; PG8_SCHED;
            PG8_LDB(B1, 1, 1); PG8_STAGE(PG8_SB(1, 0), b3, voffB);
            PG8_BAR; PG8_WAIT_L(0); PG8_MMA(0, 1, At, B1); PG8_BAR;
            PG8_LDA(At, 1, 1); PG8_STAGE(PG8_SA(1, 0), a3, voffA);
            PG8_BAR; PG8_WAIT_L(0); PG8_MMA(1, 0, At, B0); PG8_BAR; PG8_SCHED;
            PG8_STAGE(PG8_SB(1, 1), b3 + hstep, voffB);
            PG8_WAIT_V(6); PG8_BAR; PG8_MMA(1, 1, At, B1); PG8_BAR;
            }
        }
        if constexpr (ALIGN_EPI) { if (wr == 0) PG8_BAR; }
        if constexpr (!Epi::AFTER_DRAIN) { E(acc, cur, wr, wc, fr, fq); S.done(cur); }
        if (!has_next) break;
#pragma unroll
        for (int a = 0; a < 2; ++a)
#pragma unroll
            for (int b = 0; b < 2; ++b)
#pragma unroll
                for (int m = 0; m < 4; ++m)
#pragma unroll
                    for (int n = 0; n < 2; ++n) acc[a][b][m][n] = (f32x4){0.f, 0.f, 0.f, 0.f};
        cur = nxt; cA = nA; cB = nB; ++ui;
        if constexpr (ALIGN_EPI) { if (wr == 1) PG8_BAR; }
    }
    PG8_WAIT_V(0);
    if constexpr (!ALIGN_EPI) { if (wr == 0) PG8_BAR; }
    PG8_BAR;
    if constexpr (Epi::AFTER_DRAIN) { E.fused(acc, cur, wr, wc, fr, fq, lds, wid, lane); S.done(cur); }
#undef PG8_SA
#undef PG8_SB
#undef PG8_STAGE
#undef PG8_LDA
#undef PG8_LDB
#undef PG8_MMA
#undef PG8_WAIT_V
#undef PG8_WAIT_L
#undef PG8_BAR
#undef PG8_SCHED
}
}

#define LAS __attribute__((address_space(3)))
#define XB_TMO      128
#define XB_XCNT(j)  (256  + 64 * (j))
#define XB_XSUB(j)  (1280 + 64 * (j))
#define XB_XGEN(j)  (2304 + 64 * (j))
#define XB_TOP      3328
#define XB_TOPGEN   3392
#define XCD_BAR_WORDS 3456
#define XB_SPIN_CAP (1u << 26)

__device__ __forceinline__ unsigned xb_ld(unsigned* p)              { return __hip_atomic_load(p, __ATOMIC_RELAXED, __HIP_MEMORY_SCOPE_AGENT); }
__device__ __forceinline__ unsigned xb_add(unsigned* p, unsigned v) { return __hip_atomic_fetch_add(p, v, __ATOMIC_RELAXED, __HIP_MEMORY_SCOPE_AGENT); }
__device__ __forceinline__ unsigned xb_xcc_id() { return (unsigned)__builtin_amdgcn_s_getreg((3 << 11) | 20) & 0xFu; }
#define XB_SPIN(cond, bar) do { unsigned _sp = 0; while (cond) { __builtin_amdgcn_s_sleep(1); \
    if ((++_sp & 255u) == 0u) { if (xb_ld(&(bar)[XB_TMO])) break; if (_sp > XB_SPIN_CAP) { atomicAdd(&(bar)[XB_TMO], 1u); break; } } } } while (0)

struct XcdBarrier {
    unsigned* bar; unsigned x;
    volatile LAS unsigned* st;
};

__device__ __forceinline__ XcdBarrier xcd_barrier_post(unsigned* bar, volatile LAS unsigned* st) {
    XcdBarrier b; b.bar = bar; b.x = xb_xcc_id(); b.st = st;
    if (threadIdx.x == 0) (void)xb_add(&bar[XB_XCNT(b.x)], 1u);
    return b;
}
__device__ __forceinline__ void xcd_barrier_complete(unsigned* bar, unsigned x, unsigned& nloc, unsigned& nx) {
    const unsigned G = gridDim.x * gridDim.y * gridDim.z;
    unsigned sum, cnt, mine, sp = 0u;
    for (;;) {
        sum = 0u; cnt = 0u; mine = 0u;
#pragma unroll
        for (unsigned j = 0; j < 16; ++j) { const unsigned c = xb_ld(&bar[XB_XCNT(j)]); sum += c; cnt += (c > 0u) ? 1u : 0u; mine = (j == x) ? c : mine; }
        if (sum == G) break;
        __builtin_amdgcn_s_sleep(1);
        if ((++sp & 255u) == 0u) { if (xb_ld(&bar[XB_TMO])) break; if (sp > XB_SPIN_CAP) { atomicAdd(&bar[XB_TMO], 1u); break; } }
    }
    nloc = mine > 0u ? mine : 1u; nx = cnt > 0u ? cnt : 1u;
}

__device__ __forceinline__ void xcd_barrier(const XcdBarrier& b) {
    asm volatile("s_waitcnt vmcnt(0)" ::: "memory");
    __syncthreads();
    if (threadIdx.x == 0) {
        unsigned* bar = b.bar;
        __builtin_amdgcn_s_waitcnt(0);
        unsigned nloc = b.st[0], nx = b.st[1];
        if (nloc == 0u) { xcd_barrier_complete(bar, b.x, nloc, nx); b.st[0] = nloc; b.st[1] = nx; }
        const unsigned old = xb_add(&bar[XB_XSUB(b.x)], 1u);
        const unsigned gen = old / nloc;
        if (old + 1u == (gen + 1u) * nloc) {
            __builtin_amdgcn_fence(__ATOMIC_RELEASE, "agent");
            asm volatile("s_waitcnt vmcnt(0)" ::: "memory");
            const unsigned og = xb_add(&bar[XB_TOP], 1u);
            const unsigned tg = og / nx;
            if (og + 1u == (tg + 1u) * nx) xb_add(&bar[XB_TOPGEN], 1u);
            else XB_SPIN(xb_ld(&bar[XB_TOPGEN]) == tg, bar);
            __builtin_amdgcn_fence(__ATOMIC_ACQUIRE, "agent");
            xb_add(&bar[XB_XGEN(b.x)], 1u);
            asm volatile("s_waitcnt vmcnt(0)" ::: "memory");
        } else {
            XB_SPIN(xb_ld(&bar[XB_XGEN(b.x)]) == gen, bar);
            __builtin_amdgcn_fence(__ATOMIC_ACQUIRE, "agent");
            asm volatile("s_waitcnt vmcnt(0)" ::: "memory");
        }
    }
    __syncthreads();
}

#ifndef PG8_SP2
#define PG8_SP2 true
#endif
#ifndef PG8_ALIGN
#define PG8_ALIGN true
#endif
#ifndef PROBE_ON
#define PROBE_ON 0
#define PROBE_A 0
#define PROBE_B 1
#endif
#ifndef MK_PER_PHASE
#define MK_PER_PHASE 0
#endif

constexpr int T = 16384, NSMP = 32, TS = T + NSMP, TSP = T + 256, DM = 1024;
constexpr int PA = 3368, PAP = 3584;
constexpr int C_Q = 0, C_KC = 512, C_VC = 640, C_KS = 768, C_VS = 896, C_KW = 1024, C_VW = 1152, C_GATE = 1280,
              C_GQKV = 1304, C_A = 2840, C_BT = 2848, C_Z = 2856;
constexpr int DFF = 2816, DFF2 = 5632;
constexpr float DN_ALPHA = 1.4142135623730951f;
constexpr float LN_EPS = 1e-5f, NORM_EPS = 1e-6f;
constexpr int NPAGES = 128;
constexpr int NWAVES = 8, NTHR = 512;

constexpr size_t O_Y_P = 0;
constexpr size_t O_Y_S = O_Y_P + (size_t)T * DM;
constexpr size_t O_CMP_P = O_Y_S + (size_t)NSMP * DM;
constexpr size_t O_CMP_S = O_CMP_P + (size_t)T * 256;
constexpr size_t O_SLC_P = O_CMP_S + (size_t)NSMP * 256;
constexpr size_t O_SLC_S = O_SLC_P + (size_t)T * 256;
constexpr size_t O_WIN_P = O_SLC_S + (size_t)NSMP * 256;
constexpr size_t O_WIN_S = O_WIN_P + (size_t)512 * 256;
constexpr size_t O_GCONV_P = O_WIN_S + (size_t)NSMP * 512 * 256;
constexpr size_t O_GCONV_S = O_GCONV_P + (size_t)3 * 1536;
constexpr size_t O_GS_P = O_GCONV_S + (size_t)NSMP * 3 * 1536;
constexpr size_t O_GS_S = O_GS_P + (size_t)8 * 64 * 64;
constexpr size_t O_DIL_P = O_GS_S + (size_t)NSMP * 8 * 64 * 64;
constexpr size_t O_DIL_S = O_DIL_P + (size_t)2048 * 2048;
constexpr size_t O_FFN_P = O_DIL_S + (size_t)NSMP * 2048 * 2048;
constexpr size_t O_FFN_S = O_FFN_P + (size_t)2 * 2 * DFF2;
constexpr size_t O_END = O_FFN_S + (size_t)NSMP * 2 * 2 * DFF2;

constexpr int RING_BYTES = 131072;
constexpr int FAST_WL = 17408;
constexpr int MISC_OFF = 8 * FAST_WL + 64;
constexpr int LDS_BYTES = 147456;

typedef unsigned short bf16;
typedef unsigned v4u __attribute__((ext_vector_type(4)));

__device__ __forceinline__ unsigned f2bf(float f) { return (unsigned)__builtin_bit_cast(unsigned short, (__bf16)f); }
__device__ __forceinline__ unsigned pk2(float lo, float hi) { return pg8::cvt_pk_bf16(lo, hi); }
typedef short bf16x8 __attribute__((ext_vector_type(8)));
typedef float f32x4 __attribute__((ext_vector_type(4)));
#define MFMA16(a, b, c) __builtin_amdgcn_mfma_f32_16x16x32_bf16((a), (b), (c), 0, 0, 0)
__device__ __forceinline__ float wave_sum(float v) {
#pragma unroll
    for (int o = 1; o < 64; o <<= 1) v += __shfl_xor(v, o);
    return v;
}
__device__ __forceinline__ float wave_max(float v) {
#pragma unroll
    for (int o = 1; o < 64; o <<= 1) v = fmaxf(v, __shfl_xor(v, o));
    return v;
}
__device__ __forceinline__ void wave_lds_sync() { asm volatile("s_waitcnt lgkmcnt(0)" ::: "memory"); __builtin_amdgcn_wave_barrier(); asm volatile("" ::: "memory"); }
__device__ __forceinline__ float fexp_(float x) { return __builtin_amdgcn_exp2f(x * 1.4426950408889634f); }
__device__ __forceinline__ float fsilu_(float x) { return x * __builtin_amdgcn_rcpf(1.f + fexp_(-x)); }
__device__ __forceinline__ float sigmoidf_(float x) { return 1.f / (1.f + expf(-x)); }
__device__ __forceinline__ float siluf_(float x) { return x / (1.f + expf(-x)); }
__device__ __forceinline__ float gelu_tanh(float x) { const float c = 0.7978845608028654f; return 0.5f * x * (1.f + tanhf(c * (x + 0.044715f * x * x * x))); }
__device__ __forceinline__ float softplusf_(float x) { return x > 20.f ? x : log1pf(expf(x)); }

struct KP {
    const float *x_prompt, *x_sample, *cache_cmp, *cache_slc, *st_win, *st_gconv, *st_gS, *st_dil, *st_ffn;
    const int* page_table;
    const float *w_in_a, *cw1, *cb1, *cw2, *cpe, *gconv_w, *gA, *gdt, *gnw, *w_out_a, *w_in_c, *w_out_c, *ln_mix_g, *ln_mix_b,
                *ffn_w_in, *ffn_cw, *ffn_cb, *ffn_w_out, *ln_ffn_g, *ln_ffn_b;
    float* out;
    unsigned* ctl;
    bf16 *WT_A, *WT_OA, *WT_FI0, *WT_FI1, *WT_FO0, *WT_FO1, *WT_CI, *WT_CO;
    float2* ROPE;
    bf16 *ACTB, *MIXB, *HFFB, *MOB, *H1B, *H0B; float* ZF;
    bf16 *QB, *KSF, *VSF, *KWF, *VWF, *CKF, *CVF;
    unsigned char *KS8, *VS8;
    bf16 *QDB; bf16* DKF[3]; bf16* DVF[3];
    bf16 *AC, *WT_C, *HID, *W2T, *ACP; float* SMIXF; float* NSACC; int* SEL; float* UB;
    bf16 *G_WF, *G_KDF, *G_QGF, *G_QKF, *G_SPF, *G_VNF; float *G_UF, *G_GL;
    float *BIGF, *MO, *X1, *X2, *X3, *QR, *KS, *VS, *KW, *VW, *CK, *CV, *GQ, *GK, *GV, *OG, *Gg, *Gb, *QD, *KD;
    int ph_lo, ph_hi;
};

struct Fr { unsigned char* lds; int tid, lane, wave, gw, NGW, bid, G; int tgt, tGT; };
__device__ __forceinline__ float h0f(const KP& p, int t, int c) { return __uint_as_float((unsigned)p.H0B[(size_t)t * PAP + c] << 16); }

__device__ __forceinline__ int ffn_row(int u) { const int half = u >= DFF ? 1 : 0, jc = u - half * DFF; return 256 * (jc >> 7) + 128 * half + (jc & 127); }
__device__ __forceinline__ void transpose_item(const float* W, int K, int N, int NT, bf16* WT, float* scr, int item, int lane, int rowmap = 0) {
    const int nblk = NT / 32, kb = item / nblk, nb = item % nblk, k0 = 64 * kb, n0 = 32 * nb;
#pragma unroll 8
    for (int i = 0; i < 32; ++i) { const int kk = 2 * i + (lane >> 5); const int n = n0 + (lane & 31); scr[kk * 33 + (lane & 31)] = (n < N) ? W[(size_t)(k0 + kk) * N + n] : 0.f; }
    wave_lds_sync();
    const int c = lane & 7;
#pragma unroll
    for (int j = 0; j < 4; ++j) { const int n = (lane >> 3) + 8 * j; const float* s = scr + (8 * c) * 33 + n;
        v4u o; o.x = pk2(s[0 * 33], s[1 * 33]); o.y = pk2(s[2 * 33], s[3 * 33]); o.z = pk2(s[4 * 33], s[5 * 33]); o.w = pk2(s[6 * 33], s[7 * 33]);
        const int row = rowmap ? ffn_row(n0 + n) : n0 + n;
        *(v4u*)(WT + (size_t)row * K + k0 + 8 * c) = o; }
    wave_lds_sync();
}
__device__ __forceinline__ void ph_prologue(const KP& p, const Fr& F) {
    float* scr = (float*)(F.lds + F.wave * 16384);
    const int I_A = 16 * (PAP / 32), I_OA = 16 * 32, I_FI = 16 * (DFF2 / 32), I_FO = (DFF / 64) * 32, I_CI = 16 * (3072 / 32), I_CO = 16 * 32;
    const int NITEMS = I_A + I_OA + 2 * I_FI + 2 * I_FO + I_CI + I_CO + 256 + 8;
    for (int it = F.gw; it < NITEMS; it += F.NGW) {
        int r = it;
        if (r < I_A) { transpose_item(p.w_in_a, DM, PA, PAP, p.WT_A, scr, r, F.lane); continue; } r -= I_A;
        if (r < I_OA) { transpose_item(p.w_out_a, DM, DM, DM, p.WT_OA, scr, r, F.lane); continue; } r -= I_OA;
        if (r < I_FI) { transpose_item(p.ffn_w_in, DM, DFF2, DFF2, p.WT_FI0, scr, r, F.lane, 1); continue; } r -= I_FI;
        if (r < I_FI) { transpose_item(p.ffn_w_in + (size_t)DM * DFF2, DM, DFF2, DFF2, p.WT_FI1, scr, r, F.lane, 1); continue; } r -= I_FI;
        if (r < I_FO) { transpose_item(p.ffn_w_out, DFF, DM, DM, p.WT_FO0, scr, r, F.lane); continue; } r -= I_FO;
        if (r < I_FO) { transpose_item(p.ffn_w_out + (size_t)DFF * DM, DFF, DM, DM, p.WT_FO1, scr, r, F.lane); continue; } r -= I_FO;
        if (r < I_CI) { transpose_item(p.w_in_c, DM, 3072, 3072, p.WT_CI, scr, r, F.lane); continue; } r -= I_CI;
        if (r < I_CO) { transpose_item(p.w_out_c, DM, DM, DM, p.WT_CO, scr, r, F.lane); continue; } r -= I_CO;
        if (r < 256) { const int kv = r >> 7; transpose_item(p.cw1 + (size_t)kv * 2048 * 128, 2048, 128, 128, p.WT_C + (size_t)kv * 128 * 2048, scr, r & 127, F.lane); continue; } r -= 256;
        { const int kv = r >> 2; transpose_item(p.cw2 + (size_t)kv * 128 * 64, 128, 64, 64, p.W2T + (size_t)kv * 64 * 128, scr, r & 3, F.lane); }
    }
    const size_t gt = (size_t)F.bid * NTHR + F.tid, GT = (size_t)F.G * NTHR;
    for (size_t i4 = gt; i4 < (size_t)TSP * (DM / 4); i4 += GT) {
        const int r = (int)(i4 / (DM / 4)), c4 = (int)(i4 % (DM / 4));
        float4 v = make_float4(0.f, 0.f, 0.f, 0.f);
        if (r < T) v = ((const float4*)p.x_prompt)[(size_t)r * (DM / 4) + c4]; else if (r < TS) v = ((const float4*)p.x_sample)[(size_t)(r - T) * (DM / 4) + c4];
        uint2 o; o.x = pk2(v.x, v.y); o.y = pk2(v.z, v.w);
        ((uint2*)p.ACTB)[i4] = o;
    }
    for (size_t idx = gt; idx < (size_t)(T + 1) * 32; idx += GT) {
        const int pos = (int)(idx >> 5), i = (int)(idx & 31);
        const float inv = (float)pow(10000.0, -2.0 * (double)i / 64.0);
        const float ang = (float)pos * inv;
        p.ROPE[idx] = make_float2((float)cos((double)ang), (float)sin((double)ang));
    }
}

__device__ __forceinline__ size_t vfrag_elem(int key, int d);
__device__ __forceinline__ size_t kfrag_elem(int key, int d);
__device__ __forceinline__ bf16x8 pack_p(const f32x4& p0, const f32x4& p1);
template <bool FFNMAP = false, bool OUTBF = false>
__device__ __forceinline__ void skinny_gemm(const Fr& F, const bf16* A, const bf16* Bt, int K, int ncols, float* C, int ldc) {
    const int lane = F.lane, l15 = lane & 15, grp = lane >> 4;
    const int kper = K >> 3, k0 = F.wave * kper;
    const bf16* a0 = A + (size_t)(T + l15) * K + 8 * grp + k0; const bf16* a1 = a0 + (size_t)16 * K;
    f32x4* red = (f32x4*)F.lds;
    const int ntiles = (ncols + 15) >> 4;
    for (int nt = F.bid; nt < ntiles; nt += F.G) {
        const bf16* bp = Bt + (size_t)(nt * 16 + l15) * K + 8 * grp + k0;
        f32x4 c0 = {0.f, 0.f, 0.f, 0.f}, c1 = {0.f, 0.f, 0.f, 0.f};
#pragma unroll 4
        for (int k = 0; k < kper; k += 32) {
            const bf16x8 b = *(const bf16x8*)(bp + k), x0 = *(const bf16x8*)(a0 + k), x1 = *(const bf16x8*)(a1 + k);
            c0 = MFMA16(x0, b, c0); c1 = MFMA16(x1, b, c1);
        }
        red[(F.wave * 2 + 0) * 64 + lane] = c0; red[(F.wave * 2 + 1) * 64 + lane] = c1;
        __syncthreads();
        if (F.wave == 0) {
#pragma unroll
            for (int w = 1; w < 8; ++w) { c0 = c0 + red[(w * 2 + 0) * 64 + lane]; c1 = c1 + red[(w * 2 + 1) * 64 + lane]; }
            int n = nt * 16 + l15;
            if (FFNMAP) n = ((n >> 7) & 1) * DFF + (n >> 8) * 128 + (n & 127);
            if (n < ncols) {
#pragma unroll
                for (int r = 0; r < 4; ++r) {
                    if (OUTBF) { ((bf16*)C)[(size_t)(T + 4 * grp + r) * ldc + n] = (bf16)f2bf(c0[r]); ((bf16*)C)[(size_t)(T + 16 + 4 * grp + r) * ldc + n] = (bf16)f2bf(c1[r]); }
                    else { C[(size_t)(T + 4 * grp + r) * ldc + n] = c0[r]; C[(size_t)(T + 16 + 4 * grp + r) * ldc + n] = c1[r]; } }
            }
        }
        __syncthreads();
    }
}
__device__ __forceinline__ void ph_gemm_f32(const Fr& F, const bf16* A, const bf16* Bt, int N, int K, float* C, int ldc, int ncols) {
    skinny_gemm(F, A, Bt, K, ncols, C, ldc);
    pg8::Gemm g{A, Bt, T, N, K}; pg8::StaticOrder S; S.init(T, N, F.G, F.bid);
    pg8::EpiF32 E{C, ldc, ncols};
    pg8::gemm_phase<pg8::EpiF32, pg8::StaticOrder, PG8_ALIGN, PG8_SP2>((PG8_LAS unsigned char*)F.lds, g, S, E);
}
__device__ __forceinline__ void ph_gemm_h1(const KP& p, const Fr& F) {
    skinny_gemm(F, p.ACTB, p.WT_CI, DM, 3072, p.BIGF, 3072);
    pg8::Gemm g{p.ACTB, p.WT_CI, T, 3072, DM}; pg8::StaticOrder S; S.init(T, 3072, F.G, F.bid);
    pg8::EpiBf16<0> E{p.H1B, 3072, nullptr, 0, 0, 1.f};
    pg8::gemm_phase<pg8::EpiBf16<0>, pg8::StaticOrder, PG8_ALIGN, PG8_SP2>((PG8_LAS unsigned char*)F.lds, g, S, E);
}
__device__ __forceinline__ void ph_gemm_h0(const KP& p, const Fr& F) {
    skinny_gemm(F, p.ACTB, p.WT_A, DM, PA, p.BIGF, PA);
    pg8::Gemm g{p.ACTB, p.WT_A, T, PAP, DM}; pg8::StaticOrder S; S.init(T, PAP, F.G, F.bid);
    pg8::EpiBf16<0> E{p.H0B, PAP, nullptr, 0, 0, 1.f};
    pg8::gemm_phase<pg8::EpiBf16<0>, pg8::StaticOrder, PG8_ALIGN, PG8_SP2>((PG8_LAS unsigned char*)F.lds, g, S, E);
}
__device__ __forceinline__ void ph_gemm_bf16(const Fr& F, const bf16* A, const bf16* Bt, int K, bf16* C) {
    skinny_gemm<false, true>(F, A, Bt, K, DM, (float*)C, DM);
    pg8::Gemm g{A, Bt, T, DM, K}; pg8::StaticOrder S; S.init(T, DM, F.G, F.bid);
    pg8::EpiBf16<0> E{C, DM, nullptr, 0, 0, 1.f};
    pg8::gemm_phase<pg8::EpiBf16<0>, pg8::StaticOrder, PG8_ALIGN, PG8_SP2>((PG8_LAS unsigned char*)F.lds, g, S, E);
}
__device__ __forceinline__ void ph_ln_b(const Fr& F, bf16* XB, const bf16* FB, const float* gam, const float* bet, float* outp, float* outs) {
    const int lane = F.lane;
    for (int r = F.gw; r < TS; r += F.NGW) {
        float v[16]; float s = 0.f;
#pragma unroll
        for (int j = 0; j < 2; ++j) {
            const v4u x = *(const v4u*)(XB + (size_t)r * DM + 512 * j + 8 * lane), f = *(const v4u*)(FB + (size_t)r * DM + 512 * j + 8 * lane);
#pragma unroll
            for (int e = 0; e < 4; ++e) {
                v[8 * j + 2 * e] = DN_ALPHA * __uint_as_float(x[e] << 16) + __uint_as_float(f[e] << 16);
                v[8 * j + 2 * e + 1] = DN_ALPHA * __uint_as_float(x[e] & 0xffff0000u) + __uint_as_float(f[e] & 0xffff0000u);
            }
        }
#pragma unroll
        for (int i = 0; i < 16; ++i) s += v[i];
        const float mean = wave_sum(s) * (1.f / DM); float q = 0.f;
#pragma unroll
        for (int i = 0; i < 16; ++i) { v[i] -= mean; q += v[i] * v[i]; }
        const float rstd = rsqrtf(wave_sum(q) * (1.f / DM) + LN_EPS);
#pragma unroll
        for (int j = 0; j < 2; ++j) {
            const int c0 = 512 * j + 8 * lane;
            const float4 g0 = *(const float4*)(gam + c0), g1 = *(const float4*)(gam + c0 + 4), b0 = *(const float4*)(bet + c0), b1 = *(const float4*)(bet + c0 + 4);
            const float y0 = v[8 * j + 0] * rstd * g0.x + b0.x, y1 = v[8 * j + 1] * rstd * g0.y + b0.y, y2 = v[8 * j + 2] * rstd * g0.z + b0.z, y3 = v[8 * j + 3] * rstd * g0.w + b0.w;
            const float y4 = v[8 * j + 4] * rstd * g1.x + b1.x, y5 = v[8 * j + 5] * rstd * g1.y + b1.y, y6 = v[8 * j + 6] * rstd * g1.z + b1.z, y7 = v[8 * j + 7] * rstd * g1.w + b1.w;
            if (outp) { float* o = ((r < T) ? outp + (size_t)r * DM : outs + (size_t)(r - T) * DM) + c0;
                *(float4*)o = make_float4(y0, y1, y2, y3); *(float4*)(o + 4) = make_float4(y4, y5, y6, y7); }
            else { v4u w; w.x = pk2(y0, y1); w.y = pk2(y2, y3); w.z = pk2(y4, y5); w.w = pk2(y6, y7); *(v4u*)(XB + (size_t)r * DM + c0) = w; }
        }
    }
}
__device__ __forceinline__ float dpp_ror1(float x) { return __int_as_float(__builtin_amdgcn_update_dpp(0, __float_as_int(x), 0x121, 0xf, 0xf, false)); }
__device__ __forceinline__ float dpp_ror2(float x) { return __int_as_float(__builtin_amdgcn_update_dpp(0, __float_as_int(x), 0x122, 0xf, 0xf, false)); }
struct EpiFfn {
    static constexpr bool PERM = true, AFTER_DRAIN = false;
    bf16* H; float* UB; const float* cw; const float* cb;
    __device__ __forceinline__ void operator()(const pg8::f32x4 (&acc)[2][2][4][2], const pg8::Unit& u, int wr, int wc, int fr, int fq) const {
#pragma unroll
        for (int n = 0; n < 2; ++n) {
            const int jc = u.pn * 128 + wc * 32 + 8 * fq + 4 * n;
            pg8::f32x4 w0[2], w1[2], w2[2], bb[2];
#pragma unroll
            for (int bj = 0; bj < 2; ++bj) { const int uc = bj * DFF + jc;
                w0[bj] = *(const pg8::f32x4*)(cw + uc); w1[bj] = *(const pg8::f32x4*)(cw + DFF2 + uc); w2[bj] = *(const pg8::f32x4*)(cw + 2 * DFF2 + uc); bb[bj] = *(const pg8::f32x4*)(cb + uc); }
#pragma unroll
            for (int ai = 0; ai < 2; ++ai) {
                const int sl = u.pm * 4 + ai * 2 + wr;
                pg8::f32x4 pr1[2], pr2[2];
#pragma unroll
                for (int m = 0; m < 4; ++m) {
                    pg8::f32x4 c[2];
#pragma unroll
                    for (int bj = 0; bj < 2; ++bj) {
                        const pg8::f32x4 uu = acc[ai][bj][m][n]; pg8::f32x4 r1, r2;
#pragma unroll
                        for (int e = 0; e < 4; ++e) { r1[e] = dpp_ror1(uu[e]); r2[e] = dpp_ror2(uu[e]); }
                        pg8::f32x4 p1 = r1, p2 = r2;
                        if (m > 0) { if (fr == 0) p1 = pr1[bj]; if (fr < 2) p2 = pr2[bj]; }
                        c[bj] = bb[bj] + w0[bj] * p2 + w1[bj] * p1 + w2[bj] * uu;
                        pr1[bj] = r1; pr2[bj] = r2;
                        const int uc = bj * DFF + jc;
                        if (m == 0 && fr < 2) *(pg8::f32x4*)(UB + ((size_t)sl * 4 + fr) * DFF2 + uc) = uu;
                        if (m == 3 && fr >= 14) *(pg8::f32x4*)(UB + ((size_t)sl * 4 + 2 + (fr - 14)) * DFF2 + uc) = uu;
                    }
                    if (!(m == 0 && fr < 2)) {
                        const int t = u.pm * 256 + ai * 128 + wr * 64 + m * 16 + fr;
                        uint2 o; o.x = pk2(fsilu_(c[0][0]) * c[1][0], fsilu_(c[0][1]) * c[1][1]); o.y = pk2(fsilu_(c[0][2]) * c[1][2], fsilu_(c[0][3]) * c[1][3]);
                        *(uint2*)(H + (size_t)t * DFF + jc) = o;
                    }
                }
            }
        }
    }
};
__device__ __forceinline__ void ph_ffn_gemm(const KP& p, const Fr& F, const bf16* Bt, int layer) {
    skinny_gemm<true>(F, p.ACTB, Bt, DM, DFF2, p.BIGF, DFF2);
    pg8::Gemm g{p.ACTB, Bt, T, DFF2, DM}; pg8::StaticOrder S; S.init(T, DFF2, F.G, F.bid);
    EpiFfn E{p.HFFB, p.UB, p.ffn_cw + (size_t)layer * 3 * DFF2, p.ffn_cb + (size_t)layer * DFF2};
    pg8::gemm_phase<EpiFfn, pg8::StaticOrder, PG8_ALIGN, PG8_SP2>((PG8_LAS unsigned char*)F.lds, g, S, E);
}
__device__ __forceinline__ void ph_ffn_fix(const KP& p, const Fr& F, int layer) {
    const float* cw = p.ffn_cw + (size_t)layer * 3 * DFF2; const float* cb = p.ffn_cb + (size_t)layer * DFF2; const float* U = p.BIGF;
    const int gt = F.bid * NTHR + F.tid, GT = F.G * NTHR;
    for (int idx = gt; idx < 512 * DFF; idx += GT) {
        const int rr = idx / DFF, j = idx - rr * DFF; const int sl = rr >> 1, q = rr & 1;
        float c2[2];
#pragma unroll
        for (int half = 0; half < 2; ++half) { const int ch = half * DFF + j;
            const float u0 = p.UB[((size_t)sl * 4 + q) * DFF2 + ch];
            const float um1 = q ? p.UB[((size_t)sl * 4) * DFF2 + ch] : (sl ? p.UB[((size_t)(sl - 1) * 4 + 3) * DFF2 + ch] : 0.f);
            const float um2 = sl ? p.UB[((size_t)(sl - 1) * 4 + 2 + q) * DFF2 + ch] : 0.f;
            c2[half] = cb[ch] + cw[ch] * um2 + cw[DFF2 + ch] * um1 + cw[2 * DFF2 + ch] * u0; }
        p.HFFB[(size_t)(64 * sl + q) * DFF + j] = (bf16)f2bf(siluf_(c2[0]) * c2[1]);
    }
    for (int idx = gt; idx < NSMP * DFF; idx += GT) {
        const int b = idx / DFF, j = idx - b * DFF;
        float c2[2];
#pragma unroll
        for (int half = 0; half < 2; ++half) { const int ch = half * DFF + j;
            const float* hs = p.st_ffn + (((size_t)b * 2 + layer) * 2) * DFF2 + ch;
            c2[half] = cb[ch] + cw[ch] * hs[0] + cw[DFF2 + ch] * hs[DFF2] + cw[2 * DFF2 + ch] * U[(size_t)(T + b) * DFF2 + ch]; }
        p.HFFB[(size_t)(T + b) * DFF + j] = (bf16)f2bf(siluf_(c2[0]) * c2[1]);
    }
    for (int idx = gt; idx < 2 * DFF2; idx += GT) { const int k = idx / DFF2, ch = idx - k * DFF2;
        p.out[O_FFN_P + ((size_t)layer * 2 + k) * DFF2 + ch] = p.UB[((size_t)255 * 4 + 2 + k) * DFF2 + ch]; }
    for (int idx = gt; idx < NSMP * 2 * DFF2; idx += GT) { const int b = idx / (2 * DFF2), k = (idx / DFF2) & 1, ch = idx % DFF2;
        p.out[O_FFN_S + (((size_t)b * 2 + layer) * 2 + k) * DFF2 + ch] = (k == 0) ? p.st_ffn[(((size_t)b * 2 + layer) * 2 + 1) * DFF2 + ch] : U[(size_t)(T + b) * DFF2 + ch]; }
}
struct EpiCmp {
    static constexpr bool PERM = false, AFTER_DRAIN = false;
    bf16* HID; const float* b1;
    __device__ __forceinline__ void operator()(const pg8::f32x4 (&acc)[2][2][4][2], const pg8::Unit& u, int wr, int wc, int fr, int fq) const {
#pragma unroll
        for (int ai = 0; ai < 2; ++ai)
#pragma unroll
            for (int m = 0; m < 4; ++m) { const int combo = u.pm * 128 + wr * 64 + m * 16 + fr;
#pragma unroll
                for (int n = 0; n < 2; ++n) { const int j0 = wc * 32 + n * 16 + 4 * fq; const pg8::f32x4 v = acc[ai][ai][m][n]; const float* bb = b1 + ai * 128 + j0;
                    uint2 o; o.x = pk2(gelu_tanh(v[0] + bb[0]), gelu_tanh(v[1] + bb[1])); o.y = pk2(gelu_tanh(v[2] + bb[2]), gelu_tanh(v[3] + bb[3]));
                    *(uint2*)(HID + ((size_t)combo * 2 + ai) * 128 + j0) = o; } }
    }
};
__device__ __forceinline__ void ph_cmp_gemm(const KP& p, const Fr& F) {
    pg8::Gemm g{p.AC, p.WT_C, 65536, 256, 2048}; pg8::StaticOrder S; S.init(65536, 256, F.G, F.bid);
    EpiCmp E{p.HID, p.cb1};
    pg8::gemm_phase<EpiCmp, pg8::StaticOrder, PG8_ALIGN, PG8_SP2>((PG8_LAS unsigned char*)F.lds, g, S, E);
}
__device__ __forceinline__ void ph_cmp_stage2(const KP& p, const Fr& F) {
    const int lane = F.lane, l15 = lane & 15, grp = lane >> 4;
    for (int tile = F.gw; tile < 4096; tile += F.NGW) {
        const int kv = tile & 1, combo0 = (tile >> 1) * 16;
        const bf16* hid = p.HID + ((size_t)(combo0 + l15) * 2 + kv) * 128 + 8 * grp; const bf16* w2 = p.W2T + (size_t)kv * 64 * 128 + (size_t)l15 * 128 + 8 * grp;
        f32x4 acc[4];
#pragma unroll
        for (int nt = 0; nt < 4; ++nt) acc[nt] = (f32x4){0.f, 0.f, 0.f, 0.f};
#pragma unroll
        for (int ks = 0; ks < 4; ++ks) { const bf16x8 a = *(const bf16x8*)(hid + 32 * ks);
#pragma unroll
            for (int nt = 0; nt < 4; ++nt) acc[nt] = MFMA16(a, *(const bf16x8*)(w2 + (size_t)nt * 16 * 128 + 32 * ks), acc[nt]); }
#pragma unroll
        for (int r = 0; r < 4; ++r) {
            const int combo = combo0 + 4 * grp + r; const int g = combo & 1, c = (combo >> 1) & 511, b = combo >> 10;
            float* dst = ((kv == 0) ? p.CK : p.CV) + (((size_t)(1 + b) * 512 + c) * 2 + g) * 64;
            if (kv == 0) {
                const int pos = (c + 1) * 32 - 1;
#pragma unroll
                for (int nt = 0; nt < 2; ++nt) { const float2 cs = p.ROPE[pos * 32 + 16 * nt + l15]; const float x1 = acc[nt][r], x2 = acc[nt + 2][r];
                    dst[16 * nt + l15] = x1 * cs.x - x2 * cs.y; dst[16 * (nt + 2) + l15] = x2 * cs.x + x1 * cs.y; }
            } else {
#pragma unroll
                for (int nt = 0; nt < 4; ++nt) dst[16 * nt + l15] = acc[nt][r];
            }
        }
    }
}
__device__ __forceinline__ void cmp_prompt_unit(const KP& p, int unit, int lane) {
    asm volatile("" : "+v"(lane));
    const int l15 = lane & 15, grp = lane >> 4;
    const int kv = unit & 1, combo = (unit >> 1) * 16 + l15; const int g = combo & 1, c = combo >> 1;
    const bf16* w1 = p.WT_C + ((size_t)kv * 128 + l15) * 2048 + 8 * grp;
    f32x4 acc[8];
#pragma unroll
    for (int jt = 0; jt < 8; ++jt) acc[jt] = (f32x4){0.f, 0.f, 0.f, 0.f};
    const bf16* hsrc = p.H0B + (size_t)(c * 32) * PAP + C_KC + kv * 128 + g * 64 + 8 * grp; const float* pe = p.cpe + (size_t)kv * 32 * 64 + 8 * grp;
#pragma unroll 4
    for (int ks = 0; ks < 64; ++ks) {
        const int i = ks >> 1, dd = 32 * (ks & 1);
        const v4u hx = *(const v4u*)(hsrc + (size_t)i * PAP + dd); const float4 e0 = *(const float4*)(pe + i * 64 + dd), e1 = *(const float4*)(pe + i * 64 + dd + 4);
        union { v4u u; bf16x8 b; } fbu;
        fbu.u.x = pk2(__uint_as_float(hx[0] << 16) + e0.x, __uint_as_float(hx[0] & 0xffff0000u) + e0.y); fbu.u.y = pk2(__uint_as_float(hx[1] << 16) + e0.z, __uint_as_float(hx[1] & 0xffff0000u) + e0.w);
        fbu.u.z = pk2(__uint_as_float(hx[2] << 16) + e1.x, __uint_as_float(hx[2] & 0xffff0000u) + e1.y); fbu.u.w = pk2(__uint_as_float(hx[3] << 16) + e1.z, __uint_as_float(hx[3] & 0xffff0000u) + e1.w);
        const bf16x8 fb = fbu.b;
#pragma unroll
        for (int jt = 0; jt < 8; ++jt) acc[jt] = MFMA16(*(const bf16x8*)(w1 + (size_t)jt * 16 * 2048 + 32 * ks), fb, acc[jt]);
    }
    bf16x8 hb[4];
#pragma unroll
    for (int s2 = 0; s2 < 4; ++s2) {
        f32x4 h0, h1;
#pragma unroll
        for (int r = 0; r < 4; ++r) { h0[r] = gelu_tanh(acc[2 * s2][r] + p.cb1[kv * 128 + 32 * s2 + 4 * grp + r]); h1[r] = gelu_tanh(acc[2 * s2 + 1][r] + p.cb1[kv * 128 + 32 * s2 + 16 + 4 * grp + r]); }
        hb[s2] = pack_p(h0, h1);
    }
    f32x4 o[4];
#pragma unroll
    for (int dt = 0; dt < 4; ++dt) {
        o[dt] = (f32x4){0.f, 0.f, 0.f, 0.f};
        const bf16* w2 = p.W2T + (size_t)kv * 64 * 128 + (size_t)(16 * dt + l15) * 128 + 4 * grp;
#pragma unroll
        for (int s2 = 0; s2 < 4; ++s2) { const uint2 x0 = *(const uint2*)(w2 + 32 * s2), x1 = *(const uint2*)(w2 + 32 * s2 + 16);
            union { v4u u; bf16x8 b; } wa; wa.u.x = x0.x; wa.u.y = x0.y; wa.u.z = x1.x; wa.u.w = x1.y;
            o[dt] = MFMA16(wa.b, hb[s2], o[dt]); }
    }
    if (kv == 0) {
        const int pos = (c + 1) * 32 - 1;
#pragma unroll
        for (int dt = 0; dt < 2; ++dt)
#pragma unroll
            for (int r = 0; r < 4; ++r) { const float2 cs = p.ROPE[pos * 32 + 16 * dt + 4 * grp + r]; const float x1 = o[dt][r], x2 = o[dt + 2][r];
                o[dt][r] = x1 * cs.x - x2 * cs.y; o[dt + 2][r] = x2 * cs.x + x1 * cs.y; }
    }
#pragma unroll
    for (int dt = 0; dt < 4; ++dt)
#pragma unroll
        for (int r = 0; r < 4; ++r) { const int d = 16 * dt + 4 * grp + r;
            if (kv == 0) p.CKF[(size_t)g * 512 * 64 + kfrag_elem(c, d)] = (bf16)f2bf(o[dt][r]); else p.CVF[(size_t)g * 512 * 64 + vfrag_elem(c, d)] = (bf16)f2bf(o[dt][r]); }
}
__device__ __forceinline__ void cmp_sample_unit(const KP& p, int unit, int lane) {
    asm volatile("" : "+v"(lane));
    const int l15 = lane & 15, grp = lane >> 4;
    const int b = unit >> 6, kv = (unit >> 5) & 1, cb = unit & 31;
    const bf16* w1 = p.WT_C + ((size_t)kv * 128 + l15) * 2048 + 8 * grp;
    const float* src[2];
#pragma unroll
    for (int cg = 0; cg < 2; ++cg) { const int combo = cb * 32 + 16 * cg + l15; const int g = combo & 1, c = combo >> 1;
        const int page = p.page_table[b * NPAGES + (c >> 2)];
        src[cg] = p.cache_cmp + (((size_t)page * 128 + (c & 3) * 32) * 4 + kv * 2 + g) * 64 + 8 * grp; }
    const float* pe = p.cpe + (size_t)kv * 32 * 64 + 8 * grp;
    f32x4 acc[2][8];
#pragma unroll
    for (int cg = 0; cg < 2; ++cg)
#pragma unroll
        for (int jt = 0; jt < 8; ++jt) acc[cg][jt] = (f32x4){0.f, 0.f, 0.f, 0.f};
#pragma unroll 2
    for (int ks = 0; ks < 64; ++ks) {
        const int i = ks >> 1, dd = 32 * (ks & 1);
        const float4 e0 = *(const float4*)(pe + i * 64 + dd), e1 = *(const float4*)(pe + i * 64 + dd + 4);
        bf16x8 fb[2];
#pragma unroll
        for (int cg = 0; cg < 2; ++cg) { const float4 a0 = *(const float4*)(src[cg] + i * 256 + dd), a1 = *(const float4*)(src[cg] + i * 256 + dd + 4);
            union { v4u u; bf16x8 b; } t; t.u.x = pk2(a0.x + e0.x, a0.y + e0.y); t.u.y = pk2(a0.z + e0.z, a0.w + e0.w); t.u.z = pk2(a1.x + e1.x, a1.y + e1.y); t.u.w = pk2(a1.z + e1.z, a1.w + e1.w); fb[cg] = t.b; }
#pragma unroll
        for (int jt = 0; jt < 8; ++jt) { const bf16x8 wa = *(const bf16x8*)(w1 + (size_t)jt * 16 * 2048 + 32 * ks);
            acc[0][jt] = MFMA16(wa, fb[0], acc[0][jt]); acc[1][jt] = MFMA16(wa, fb[1], acc[1][jt]); }
    }
#pragma unroll
    for (int cg = 0; cg < 2; ++cg) {
        const int combo = cb * 32 + 16 * cg + l15; const int g = combo & 1, c = combo >> 1;
        bf16x8 hb[4];
#pragma unroll
        for (int s2 = 0; s2 < 4; ++s2) { f32x4 h0, h1;
#pragma unroll
            for (int r = 0; r < 4; ++r) { h0[r] = gelu_tanh(acc[cg][2 * s2][r] + p.cb1[kv * 128 + 32 * s2 + 4 * grp + r]); h1[r] = gelu_tanh(acc[cg][2 * s2 + 1][r] + p.cb1[kv * 128 + 32 * s2 + 16 + 4 * grp + r]); }
            hb[s2] = pack_p(h0, h1); }
        f32x4 o[4];
#pragma unroll
        for (int dt = 0; dt < 4; ++dt) {
            o[dt] = (f32x4){0.f, 0.f, 0.f, 0.f};
            const bf16* w2 = p.W2T + (size_t)kv * 64 * 128 + (size_t)(16 * dt + l15) * 128 + 4 * grp;
#pragma unroll
            for (int s2 = 0; s2 < 4; ++s2) { const uint2 x0 = *(const uint2*)(w2 + 32 * s2), x1 = *(const uint2*)(w2 + 32 * s2 + 16);
                union { v4u u; bf16x8 b; } wa; wa.u.x = x0.x; wa.u.y = x0.y; wa.u.z = x1.x; wa.u.w = x1.y;
                o[dt] = MFMA16(wa.b, hb[s2], o[dt]); }
        }
        if (kv == 0) {
            const int pos = (c + 1) * 32 - 1;
#pragma unroll
            for (int dt = 0; dt < 2; ++dt)
#pragma unroll
                for (int r = 0; r < 4; ++r) { const float2 cs = p.ROPE[pos * 32 + 16 * dt + 4 * grp + r]; const float x1 = o[dt][r], x2 = o[dt + 2][r];
                    o[dt][r] = x1 * cs.x - x2 * cs.y; o[dt + 2][r] = x2 * cs.x + x1 * cs.y; }
        }
        float* dst = ((kv == 0) ? p.CK : p.CV) + (((size_t)(1 + b) * 512 + c) * 2 + g) * 64 + 4 * grp;
#pragma unroll
        for (int dt = 0; dt < 4; ++dt) *(f32x4*)(dst + 16 * dt) = o[dt];
    }
}
constexpr int W1S_PITCH = 528;
constexpr int W1S_BYTES = 128 * W1S_PITCH;
__device__ __forceinline__ void cmp_sample_wg(const KP& p, int wu, const Fr& F) {
    int lane = F.lane; asm volatile("" : "+v"(lane));
    const int l15 = lane & 15, grp = lane >> 4, tid = F.tid;
    const int b = wu >> 3, kv = (wu >> 2) & 1, q4 = wu & 3;
    const float* src[2];
#pragma unroll
    for (int cg = 0; cg < 2; ++cg) { const int combo = q4 * 256 + F.wave * 32 + 16 * cg + l15; const int g = combo & 1, c = combo >> 1;
        const int page = p.page_table[b * NPAGES + (c >> 2)];
        src[cg] = p.cache_cmp + (((size_t)page * 128 + (c & 3) * 32) * 4 + kv * 2 + g) * 64 + 8 * grp; }
    const float* pe = p.cpe + (size_t)kv * 32 * 64 + 8 * grp;
    const bf16* wg = p.WT_C + (size_t)kv * 128 * 2048;
    f32x4 acc[2][8];
#pragma unroll
    for (int cg = 0; cg < 2; ++cg)
#pragma unroll
        for (int jt = 0; jt < 8; ++jt) acc[cg][jt] = (f32x4){0.f, 0.f, 0.f, 0.f};
    v4u wreg[8];
#pragma unroll
    for (int k = 0; k < 8; ++k) { const int c = tid + 512 * k; wreg[k] = *(const v4u*)(wg + (size_t)(c >> 5) * 2048 + (c & 31) * 8); }
#pragma unroll
    for (int k = 0; k < 8; ++k) { const int c = tid + 512 * k; *(v4u*)(F.lds + (c >> 5) * W1S_PITCH + (c & 31) * 16) = wreg[k]; }
    __syncthreads();
#pragma unroll 1
    for (int sl = 0; sl < 8; ++sl) {
        if (sl + 1 < 8) {
#pragma unroll
            for (int k = 0; k < 8; ++k) { const int c = tid + 512 * k; wreg[k] = *(const v4u*)(wg + (size_t)(c >> 5) * 2048 + (sl + 1) * 256 + (c & 31) * 8); }
        }
        const unsigned char* wl = F.lds + (sl & 1) * W1S_BYTES + l15 * W1S_PITCH + grp * 16;
#pragma unroll 4
        for (int kk = 0; kk < 8; ++kk) {
            const int ks = sl * 8 + kk, i = ks >> 1, dd = 32 * (ks & 1);
            const float4 e0 = *(const float4*)(pe + i * 64 + dd), e1 = *(const float4*)(pe + i * 64 + dd + 4);
            bf16x8 fb[2];
#pragma unroll
            for (int cg = 0; cg < 2; ++cg) { const float4 a0 = *(const float4*)(src[cg] + i * 256 + dd), a1 = *(const float4*)(src[cg] + i * 256 + dd + 4);
                union { v4u u; bf16x8 b; } t; t.u.x = pk2(a0.x + e0.x, a0.y + e0.y); t.u.y = pk2(a0.z + e0.z, a0.w + e0.w); t.u.z = pk2(a1.x + e1.x, a1.y + e1.y); t.u.w = pk2(a1.z + e1.z, a1.w + e1.w); fb[cg] = t.b; }
#pragma unroll
            for (int jt = 0; jt < 8; ++jt) { const bf16x8 wa = *(const bf16x8*)(wl + jt * 16 * W1S_PITCH + kk * 64);
                acc[0][jt] = MFMA16(wa, fb[0], acc[0][jt]); acc[1][jt] = MFMA16(wa, fb[1], acc[1][jt]); }
        }
        if (sl + 1 < 8) {
#pragma unroll
            for (int k = 0; k < 8; ++k) { const int c = tid + 512 * k; *(v4u*)(F.lds + ((sl + 1) & 1) * W1S_BYTES + (c >> 5) * W1S_PITCH + (c & 31) * 16) = wreg[k]; }
        }
        __syncthreads();
    }
#pragma unroll
    for (int cg = 0; cg < 2; ++cg) {
        const int combo = q4 * 256 + F.wave * 32 + 16 * cg + l15; const int g = combo & 1, c = combo >> 1;
        bf16x8 hb[4];
#pragma unroll
        for (int s2 = 0; s2 < 4; ++s2) { f32x4 h0, h1;
#pragma unroll
            for (int r = 0; r < 4; ++r) { h0[r] = gelu_tanh(acc[cg][2 * s2][r] + p.cb1[kv * 128 + 32 * s2 + 4 * grp + r]); h1[r] = gelu_tanh(acc[cg][2 * s2 + 1][r] + p.cb1[kv * 128 + 32 * s2 + 16 + 4 * grp + r]); }
            hb[s2] = pack_p(h0, h1); }
        f32x4 o[4];
#pragma unroll
        for (int dt = 0; dt < 4; ++dt) {
            o[dt] = (f32x4){0.f, 0.f, 0.f, 0.f};
            const bf16* w2 = p.W2T + (size_t)kv * 64 * 128 + (size_t)(16 * dt + l15) * 128 + 4 * grp;
#pragma unroll
            for (int s2 = 0; s2 < 4; ++s2) { const uint2 x0 = *(const uint2*)(w2 + 32 * s2), x1 = *(const uint2*)(w2 + 32 * s2 + 16);
                union { v4u u; bf16x8 b; } wa; wa.u.x = x0.x; wa.u.y = x0.y; wa.u.z = x1.x; wa.u.w = x1.y;
                o[dt] = MFMA16(wa.b, hb[s2], o[dt]); }
        }
        if (kv == 0) {
            const int pos = (c + 1) * 32 - 1;
#pragma unroll
            for (int dt = 0; dt < 2; ++dt)
#pragma unroll
                for (int r = 0; r < 4; ++r) { const float2 cs = p.ROPE[pos * 32 + 16 * dt + 4 * grp + r]; const float x1 = o[dt][r], x2 = o[dt + 2][r];
                    o[dt][r] = x1 * cs.x - x2 * cs.y; o[dt + 2][r] = x2 * cs.x + x1 * cs.y; }
        }
        float* dst = ((kv == 0) ? p.CK : p.CV) + (((size_t)(1 + b) * 512 + c) * 2 + g) * 64 + 4 * grp;
#pragma unroll
        for (int dt = 0; dt < 4; ++dt) *(f32x4*)(dst + 16 * dt) = o[dt];
    }
}
__device__ __forceinline__ void ph_cmp_samples(const KP& p, const Fr& F) {
    for (int wu = F.bid; wu < 256; wu += F.G) cmp_sample_wg(p, wu, F);
}
__device__ __forceinline__ void ph_cmp_prompt(const KP& p, const Fr& F) {
    for (int unit = F.gw; unit < 128; unit += F.NGW) cmp_prompt_unit(p, unit, F.lane);
}

__device__ __forceinline__ float rope_val(const float* row, int base, int i, float2 cs) {
    const int ii = i & 31;
    const float x1 = row[base + ii], x2 = row[base + ii + 32];
    return (i < 32) ? (x1 * cs.x - x2 * cs.y) : (x2 * cs.x + x1 * cs.y);
}
__device__ __forceinline__ void ph_nsa_prep(const KP& p, const Fr& F) {
    const float* H0 = p.BIGF; float* out = p.out;
    const size_t gt = (size_t)F.tgt, GT = (size_t)F.tGT;
    const size_t total = (size_t)TS * 1280;
    for (size_t idx = gt + (size_t)T * 1280; idx < total; idx += GT) {
        const int r = (int)(idx / 1280), c = (int)(idx % 1280);
        const bool smp = r >= T; const int b = r - T; const int pos = smp ? T : r;
        const float* row = H0 + (size_t)r * PA;
        const int i = c & 63;
        const float2 cs = p.ROPE[pos * 32 + (i & 31)];
        if (c < 512) { p.QR[(size_t)r * 512 + c] = rope_val(row, c & ~63, i, cs); continue; }
        const int sec = (c - 512) >> 7; const int gd = (c - 512) & 127; const int base = c & ~63;
        float v;
        if (sec == 2 || sec == 4) v = rope_val(row, base, i, cs); else v = row[c];
        const int kv = sec & 1;
        if (sec < 2) {
            if (!smp) out[O_CMP_P + (size_t)r * 256 + kv * 128 + gd] = v; else out[O_CMP_S + (size_t)b * 256 + kv * 128 + gd] = v;
        } else if (sec < 4) {
            if (!smp) out[O_SLC_P + (size_t)r * 256 + kv * 128 + gd] = v; else out[O_SLC_S + (size_t)b * 256 + kv * 128 + gd] = v;
            if (kv == 0) p.KS[(size_t)r * 128 + gd] = v; else p.VS[(size_t)r * 128 + gd] = v;
        } else {
            if (kv == 0) p.KW[(size_t)r * 128 + gd] = v; else p.VW[(size_t)r * 128 + gd] = v;
            if (!smp) { if (r >= T - 512) out[O_WIN_P + (size_t)(r - (T - 512)) * 256 + kv * 128 + gd] = v; }
            else out[O_WIN_S + ((size_t)b * 512 + 511) * 256 + kv * 128 + gd] = v;
        }
    }
    const size_t tot2 = (size_t)NSMP * 511 * 256;
    for (size_t idx = gt; idx < tot2; idx += GT) {
        const int b = (int)(idx / (511 * 256)); const int rem = (int)(idx % (511 * 256));
        out[O_WIN_S + (size_t)b * 512 * 256 + rem] = p.st_win[(size_t)b * 512 * 256 + 256 + rem];
    }
}

constexpr float QSCALE = 0.18033688011112042f;

__device__ __forceinline__ size_t kfrag_off(int kt, int ks, int lane) { return ((size_t)(kt * 2 + ks) * 64 + lane) * 8; }
__device__ __forceinline__ size_t vfrag_off(int st, int dt, int lane) { return ((size_t)(st * 4 + dt) * 64 + lane) * 8; }
__device__ __forceinline__ size_t vfrag_elem(int key, int d) {
    const int st = key >> 5, kk = key & 31, tile = kk >> 4, r16 = kk & 15, grp = r16 >> 2, reg = r16 & 3;
    return ((size_t)(st * 4 + (d >> 4)) * 64 + (d & 15) + 16 * grp) * 8 + tile * 4 + reg;
}
__device__ __forceinline__ size_t k8_off(int key, int d) { return ((size_t)(key >> 4) * 64 + (key & 15) + 16 * ((d & 31) >> 3)) * 16 + (d >> 5) * 8 + (d & 7); }
__device__ __forceinline__ size_t v8_off(int key, int d) {
    const int blk = key >> 6, st = (key >> 5) & 1, kk = key & 31, tile = kk >> 4, r16 = kk & 15, grp = r16 >> 2, reg = r16 & 3;
    return ((size_t)(blk * 4 + (d >> 4)) * 64 + (d & 15) + 16 * grp) * 16 + st * 8 + tile * 4 + reg;
}
__device__ __forceinline__ size_t kfrag_elem(int key, int d) {
    return ((size_t)((key >> 4) * 2 + (d >> 5)) * 64 + (key & 15) + 16 * ((d & 31) >> 3)) * 8 + (d & 7);
}

__device__ __forceinline__ void ph_nsa_prep_fast(const KP& p, const Fr& F) {
    const float* H0 = p.BIGF; float* out = p.out;
    const size_t gt = (size_t)F.tgt, GT = (size_t)F.tGT;
    for (size_t idx = gt; idx < (size_t)T * 64; idx += GT) {
        const int t = (int)(idx >> 6), u = (int)(idx & 63);
        const v4u uz = *(const v4u*)(p.H0B + (size_t)t * PAP + C_Z + 8 * u); float* zo = p.ZF + (size_t)t * 512 + 8 * u;
        *(float4*)zo = make_float4(__uint_as_float(uz[0] << 16), __uint_as_float(uz[0] & 0xffff0000u), __uint_as_float(uz[1] << 16), __uint_as_float(uz[1] & 0xffff0000u));
        *(float4*)(zo + 4) = make_float4(__uint_as_float(uz[2] << 16), __uint_as_float(uz[2] & 0xffff0000u), __uint_as_float(uz[3] << 16), __uint_as_float(uz[3] & 0xffff0000u));
    }
    for (size_t idx = gt; idx < (size_t)T * 160; idx += GT) {
        const int t = (int)(idx / 160), u = (int)(idx % 160);
        const int c0 = u * 8; const bf16* row = p.H0B + (size_t)t * PAP;
        const v4u ua = *(const v4u*)(row + c0);
        float v[8];
#pragma unroll
        for (int e = 0; e < 4; ++e) { v[2 * e] = __uint_as_float(ua[e] << 16); v[2 * e + 1] = __uint_as_float(ua[e] & 0xffff0000u); }
        const int sec = (u < 64) ? -1 : ((u - 64) >> 4);
        const bool roped = (sec == -1 || sec == 2 || sec == 4);
        if (roped) {
            const int d0 = c0 & 63; const int pc = (d0 < 32) ? c0 + 32 : c0 - 32;
            const v4u ub = *(const v4u*)(row + pc);
            float w[8];
#pragma unroll
            for (int e = 0; e < 4; ++e) { w[2 * e] = __uint_as_float(ub[e] << 16); w[2 * e + 1] = __uint_as_float(ub[e] & 0xffff0000u); }
            const float4* rp = (const float4*)(p.ROPE + t * 32 + (d0 & 31)); const float4 r0 = rp[0], r1 = rp[1], r2 = rp[2], r3 = rp[3];
            const float cs[8] = {r0.x, r0.z, r1.x, r1.z, r2.x, r2.z, r3.x, r3.z}, sn[8] = {r0.y, r0.w, r1.y, r1.w, r2.y, r2.w, r3.y, r3.w};
#pragma unroll
            for (int j = 0; j < 8; ++j) v[j] = (d0 < 32) ? (v[j] * cs[j] - w[j] * sn[j]) : (v[j] * cs[j] + w[j] * sn[j]);
        }
        if (sec == -1) {
            v4u o; o.x = pk2(v[0] * QSCALE, v[1] * QSCALE); o.y = pk2(v[2] * QSCALE, v[3] * QSCALE); o.z = pk2(v[4] * QSCALE, v[5] * QSCALE); o.w = pk2(v[6] * QSCALE, v[7] * QSCALE);
            *(v4u*)(p.QB + (size_t)t * 512 + c0) = o; continue;
        }
        const int gd = (c0 - 512) & 127, g = gd >> 6, d0 = gd & 63, kv = sec & 1;
        const float4 o0 = make_float4(v[0], v[1], v[2], v[3]), o1 = make_float4(v[4], v[5], v[6], v[7]);
        if (sec < 2) { float* o = out + O_CMP_P + (size_t)t * 256 + kv * 128 + gd; *(float4*)o = o0; *(float4*)(o + 4) = o1;
            continue; }
        if (sec < 4) { float* o = out + O_SLC_P + (size_t)t * 256 + kv * 128 + gd; *(float4*)o = o0; *(float4*)(o + 4) = o1; }
        else if (t >= T - 512) { float* o = out + O_WIN_P + (size_t)(t - (T - 512)) * 256 + kv * 128 + gd; *(float4*)o = o0; *(float4*)(o + 4) = o1; }
        if (sec < 4) {
            if (kv == 0) {
                int w0 = 0, w1 = 0;
                w0 = __builtin_amdgcn_cvt_pk_fp8_f32(v[0], v[1], w0, false); w0 = __builtin_amdgcn_cvt_pk_fp8_f32(v[2], v[3], w0, true);
                w1 = __builtin_amdgcn_cvt_pk_fp8_f32(v[4], v[5], w1, false); w1 = __builtin_amdgcn_cvt_pk_fp8_f32(v[6], v[7], w1, true);
                *(uint2*)(p.KS8 + (size_t)g * T * 64 + k8_off(t, d0)) = make_uint2((unsigned)w0, (unsigned)w1);
            } else {
#pragma unroll
                for (int j = 0; j < 8; ++j) p.VS8[(size_t)g * T * 64 + v8_off(t, d0 + j)] = (unsigned char)(__builtin_amdgcn_cvt_pk_fp8_f32(v[j], 0.f, 0, false) & 0xff);
            }
            continue;
        }
        bf16* KF = p.KWF; bf16* VF = p.VWF;
        if (kv == 0) {
            v4u o; o.x = pk2(v[0], v[1]); o.y = pk2(v[2], v[3]); o.z = pk2(v[4], v[5]); o.w = pk2(v[6], v[7]);
            *(v4u*)(KF + (size_t)g * T * 64 + kfrag_elem(t, d0)) = o;
        } else {
#pragma unroll
            for (int j = 0; j < 8; ++j) VF[(size_t)g * T * 64 + vfrag_elem(t, d0 + j)] = (bf16)f2bf(v[j]);
        }
    }
}

struct AttW { f32x4 o[4]; float m, l; };
__device__ __forceinline__ void attw_init(AttW& a) {
#pragma unroll
    for (int i = 0; i < 4; ++i) a.o[i] = (f32x4){0.f, 0.f, 0.f, 0.f};
    a.m = -INFINITY; a.l = 0.f;
}
__device__ __forceinline__ void qk_step(const bf16x8 (&kf)[2][2], const bf16x8 (&qf)[2], f32x4& s0, f32x4& s1) {
    const f32x4 z = {0.f, 0.f, 0.f, 0.f};
    s0 = MFMA16(kf[0][0], qf[0], z); s0 = MFMA16(kf[0][1], qf[1], s0);
    s1 = MFMA16(kf[1][0], qf[0], z); s1 = MFMA16(kf[1][1], qf[1], s1);
}
__device__ __forceinline__ bf16x8 pack_p(const f32x4& p0, const f32x4& p1) {
    union { v4u u; bf16x8 b; } c;
    c.u.x = pg8::cvt_pk_bf16(p0[0], p0[1]); c.u.y = pg8::cvt_pk_bf16(p0[2], p0[3]); c.u.z = pg8::cvt_pk_bf16(p1[0], p1[1]); c.u.w = pg8::cvt_pk_bf16(p1[2], p1[3]);
    return c.b;
}
__device__ __forceinline__ void att_update(AttW& a, const f32x4& s0, const f32x4& s1, const bf16x8 (&vf)[4]) {
    float mx = fmaxf(fmaxf(fmaxf(s0[0], s0[1]), fmaxf(s0[2], s0[3])), fmaxf(fmaxf(s1[0], s1[1]), fmaxf(s1[2], s1[3])));
    mx = fmaxf(mx, __shfl_xor(mx, 16)); mx = fmaxf(mx, __shfl_xor(mx, 32));
    const float mn = fmaxf(a.m, mx);
    const float ms = (mn == -INFINITY) ? 0.f : mn;
    const float alpha = __builtin_amdgcn_exp2f(a.m - ms);
    f32x4 p0, p1;
#pragma unroll
    for (int i = 0; i < 4; ++i) { p0[i] = __builtin_amdgcn_exp2f(s0[i] - ms); p1[i] = __builtin_amdgcn_exp2f(s1[i] - ms); }
    a.l = a.l * alpha + ((p0[0] + p0[1]) + (p0[2] + p0[3])) + ((p1[0] + p1[1]) + (p1[2] + p1[3]));
    a.m = mn;
    const bf16x8 pf = pack_p(p0, p1);
#pragma unroll
    for (int dt = 0; dt < 4; ++dt) { a.o[dt] = a.o[dt] * alpha; a.o[dt] = MFMA16(vf[dt], pf, a.o[dt]); }
}
__device__ __forceinline__ float grp_sum(float v) { v += __shfl_xor(v, 16); v += __shfl_xor(v, 32); return v; }

__device__ __forceinline__ void nsa_fast_unit(const KP& p, int unit, float* wl, int lane) {
    asm volatile("" : "+v"(lane));
    const int g = unit & 1, t0 = (unit >> 1) * 16;
    const int qi = lane & 15, grp = lane >> 4, t = t0 + qi;
    float* imp = wl; int* sel = (int*)(wl + 4096);
    const bf16* growb = p.H0B + (size_t)t * PAP + C_GATE + g * 4;
#define GROWF(i) __uint_as_float((unsigned)growb[i] << 16)
    bf16x8 qf[4][2];
#pragma unroll
    for (int h = 0; h < 4; ++h)
#pragma unroll
        for (int ks = 0; ks < 2; ++ks) qf[h][ks] = *(const bf16x8*)(p.QB + (size_t)t * 512 + (g * 4 + h) * 64 + 32 * ks + 8 * grp);
    AttW st[4];
    {
        const bf16* CKF = p.CKF + (size_t)g * 512 * 64; const bf16* CVF = p.CVF + (size_t)g * 512 * 64;
        const int nmax = (t0 + 16) >> 5; const int nsteps = (nmax + 31) >> 5;
        const int nval = (t + 1) >> 5;
        float m[4], l[4];
#pragma unroll
        for (int h = 0; h < 4; ++h) { m[h] = -INFINITY; l[h] = 0.f; }
        for (int s = 0; s < nsteps; ++s) {
            bf16x8 kf[2][2];
#pragma unroll
            for (int tl = 0; tl < 2; ++tl)
#pragma unroll
                for (int ks = 0; ks < 2; ++ks) kf[tl][ks] = *(const bf16x8*)(CKF + kfrag_off(2 * s + tl, ks, lane));
            const int cb = 32 * s + 4 * grp;
#pragma unroll
            for (int h = 0; h < 4; ++h) {
                f32x4 s0, s1; qk_step(kf, qf[h], s0, s1);
#pragma unroll
                for (int i = 0; i < 4; ++i) { if (cb + i >= nval) s0[i] = -INFINITY; if (cb + 16 + i >= nval) s1[i] = -INFINITY; }
                float mx = fmaxf(fmaxf(fmaxf(s0[0], s0[1]), fmaxf(s0[2], s0[3])), fmaxf(fmaxf(s1[0], s1[1]), fmaxf(s1[2], s1[3])));
                mx = fmaxf(mx, __shfl_xor(mx, 16)); mx = fmaxf(mx, __shfl_xor(mx, 32));
                const float mn = fmaxf(m[h], mx); const float ms = (mn == -INFINITY) ? 0.f : mn;
                float sum = 0.f;
#pragma unroll
                for (int i = 0; i < 4; ++i) sum += __builtin_amdgcn_exp2f(s0[i] - ms) + __builtin_amdgcn_exp2f(s1[i] - ms);
                l[h] = l[h] * __builtin_amdgcn_exp2f(m[h] - ms) + sum; m[h] = mn;
            }
        }
        float il[4];
#pragma unroll
        for (int h = 0; h < 4; ++h) { const float lt = grp_sum(l[h]); il[h] = lt > 0.f ? 1.f / lt : 0.f; if (m[h] == -INFINITY) m[h] = 0.f; attw_init(st[h]); }
        for (int s = 0; s < nsteps; ++s) {
            bf16x8 kf[2][2], vf[4];
#pragma unroll
            for (int tl = 0; tl < 2; ++tl)
#pragma unroll
                for (int ks = 0; ks < 2; ++ks) kf[tl][ks] = *(const bf16x8*)(CKF + kfrag_off(2 * s + tl, ks, lane));
#pragma unroll
            for (int dt = 0; dt < 4; ++dt) vf[dt] = *(const bf16x8*)(CVF + vfrag_off(s, dt, lane));
            const int cb = 32 * s + 4 * grp;
            float i4[4] = {0.f, 0.f, 0.f, 0.f};
#pragma unroll
            for (int h = 0; h < 4; ++h) {
                f32x4 s0, s1; qk_step(kf, qf[h], s0, s1);
                f32x4 p0, p1;
#pragma unroll
                for (int i = 0; i < 4; ++i) {
                    p0[i] = (cb + i < nval) ? __builtin_amdgcn_exp2f(s0[i] - m[h]) * il[h] : 0.f;
                    p1[i] = (cb + 16 + i < nval) ? __builtin_amdgcn_exp2f(s1[i] - m[h]) * il[h] : 0.f; }
                i4[0] += p0[0] + p0[1]; i4[1] += p0[2] + p0[3]; i4[2] += p1[0] + p1[1]; i4[3] += p1[2] + p1[3];
                const bf16x8 pf = pack_p(p0, p1);
#pragma unroll
                for (int dt = 0; dt < 4; ++dt) st[h].o[dt] = MFMA16(vf[dt], pf, st[h].o[dt]);
            }
            *(float2*)(imp + qi * 256 + 16 * s + 2 * grp) = make_float2(i4[0], i4[1]);
            *(float2*)(imp + qi * 256 + 16 * s + 8 + 2 * grp) = make_float2(i4[2], i4[3]);
        }
        wave_lds_sync();
    }
    const int cur = t0 >> 6;
    {
        if (cur + 1 <= 16) {
            for (int idx = lane; idx < 256; idx += 64) sel[idx] = ((idx & 15) <= cur) ? (idx & 15) : -1;
        } else {
            for (int q0 = 0; q0 < 16; q0 += 4) {
                unsigned key[4][4];
#pragma unroll
                for (int qq = 0; qq < 4; ++qq)
#pragma unroll
                    for (int j = 0; j < 4; ++j) { const int blk = lane + 64 * j; const float v = imp[(q0 + qq) * 256 + blk];
                        key[qq][j] = (blk >= 1 && blk <= cur - 2) ? ((__float_as_uint(v) & 0xFFFFFF00u) | (unsigned)(255 - blk)) : 0u; }
                if (lane < 4) { sel[(q0 + lane) * 16 + 0] = 0; sel[(q0 + lane) * 16 + 1] = cur; sel[(q0 + lane) * 16 + 2] = cur - 1; }
                for (int n = 3; n < 16; ++n) {
                    unsigned best[4];
#pragma unroll
                    for (int qq = 0; qq < 4; ++qq) best[qq] = max(max(key[qq][0], key[qq][1]), max(key[qq][2], key[qq][3]));
#pragma unroll
                    for (int o = 1; o < 64; o <<= 1) {
#pragma unroll
                        for (int qq = 0; qq < 4; ++qq) best[qq] = max(best[qq], (unsigned)__shfl_xor((int)best[qq], o));
                    }
#pragma unroll
                    for (int qq = 0; qq < 4; ++qq) {
                        const int blk = 255 - (int)(best[qq] & 255u);
#pragma unroll
                        for (int j = 0; j < 4; ++j) if (lane + 64 * j == blk) key[qq][j] = 0u;
                        if (lane == 0) sel[(q0 + qq) * 16 + n] = blk;
                    }
                }
            }
        }
        wave_lds_sync();
    }
    float* acc = wl;
    {
#pragma unroll
        for (int h = 0; h < 4; ++h) { const float gs = sigmoidf_(GROWF(h));
#pragma unroll
            for (int dt = 0; dt < 4; ++dt) *(f32x4*)(acc + (qi * 4 + h) * 64 + 16 * dt + 4 * grp) = st[h].o[dt] * gs; }
        wave_lds_sync();
    }
    {
        const bf16* KF = p.KWF + (size_t)g * T * 64; const bf16* VF = p.VWF + (size_t)g * T * 64;
        int kstart = t0 - 512; if (kstart < 0) kstart = 0; kstart &= ~31;
        const int nsteps = (t0 + 16 - kstart + 31) >> 5;
#pragma unroll
        for (int h = 0; h < 4; ++h) attw_init(st[h]);
        auto issue = [&](int s_, bf16x8 (&K)[2][2], bf16x8 (&V)[4]) {
            const int k0 = kstart + 32 * s_;
#pragma unroll
            for (int tl = 0; tl < 2; ++tl)
#pragma unroll
                for (int ks = 0; ks < 2; ++ks) K[tl][ks] = *(const bf16x8*)(KF + kfrag_off((k0 >> 4) + tl, ks, lane));
#pragma unroll
            for (int dt = 0; dt < 4; ++dt) V[dt] = *(const bf16x8*)(VF + vfrag_off(k0 >> 5, dt, lane));
        };
        auto compute = [&](int s_, const bf16x8 (&K)[2][2], const bf16x8 (&V)[4]) {
            const int k0 = kstart + 32 * s_;
            const bool need_mask = (k0 + 31 > t0) || (k0 < t0 + 15 - 512);
            const int pb = k0 + 4 * grp;
#pragma unroll
            for (int h = 0; h < 4; ++h) {
                f32x4 s0, s1; qk_step(K, qf[h], s0, s1);
                if (need_mask) {
#pragma unroll
                    for (int i = 0; i < 4; ++i) { const int p0 = pb + i, p1 = pb + 16 + i;
                        if (p0 > t || p0 < t - 512) s0[i] = -INFINITY; if (p1 > t || p1 < t - 512) s1[i] = -INFINITY; }
                }
                att_update(st[h], s0, s1, V);
            }
        };
        bf16x8 kA[2][2], vA[4], kB[2][2], vB[4];
        issue(0, kA, vA);
        for (int s = 0; s < nsteps; s += 2) {
            if (s + 1 < nsteps) issue(s + 1, kB, vB);
            compute(s, kA, vA);
            if (s + 1 < nsteps) { if (s + 2 < nsteps) issue(s + 2, kA, vA); compute(s + 1, kB, vB); }
        }
#pragma unroll
        for (int h = 0; h < 4; ++h) { const float lt = grp_sum(st[h].l); const float gs = sigmoidf_(GROWF(16 + h)) * (lt > 0.f ? 1.f / lt : 0.f);
#pragma unroll
            for (int dt = 0; dt < 4; ++dt) { f32x4* a = (f32x4*)(acc + (qi * 4 + h) * 64 + 16 * dt + 4 * grp); *a = *a + st[h].o[dt] * gs; } }
        wave_lds_sync();
    }
    *(int4*)(p.SEL + ((size_t)g * T + t0) * 16 + lane * 4) = *(const int4*)(sel + lane * 4);
#pragma unroll 4
    for (int q = 0; q < 16; ++q) *(f32x4*)(p.NSACC + (size_t)(t0 + q) * 512 + g * 256 + 4 * lane) = *(const f32x4*)(acc + q * 256 + 4 * lane);
    wave_lds_sync();
}

__device__ __forceinline__ void nsa_slc_item(const KP& p, int tq, int g, int lane) {
    asm volatile("" : "+v"(lane));
    const int l15 = lane & 15, grp = lane >> 4, hn = lane & 3;
    const bf16* KF = p.KSF + (size_t)g * T * 64; const bf16* VF = p.VSF + (size_t)g * T * 64;
    const int* selp = p.SEL + ((size_t)g * T + tq) * 16;
    int sb[16];
#pragma unroll
    for (int i = 0; i < 16; ++i) sb[i] = __builtin_amdgcn_readfirstlane(selp[i]);
    bf16x8 qs[2];
#pragma unroll
    for (int ks = 0; ks < 2; ++ks) qs[ks] = *(const bf16x8*)(p.QB + (size_t)tq * 512 + (g * 4 + hn) * 64 + 32 * ks + 8 * grp);
    AttW a; attw_init(a);
    bf16x8 kf[2][2][2], vf[2][4];
    auto issue = [&](int i, int buf) {
        const int blk = sb[i >> 1]; int k0 = blk * 64 + 32 * (i & 1); if (blk < 0 || k0 > tq) k0 = 0;
#pragma unroll
        for (int tl = 0; tl < 2; ++tl)
#pragma unroll
            for (int ks = 0; ks < 2; ++ks) kf[buf][tl][ks] = *(const bf16x8*)(KF + kfrag_off((k0 >> 4) + tl, ks, lane));
#pragma unroll
        for (int dt = 0; dt < 4; ++dt) vf[buf][dt] = *(const bf16x8*)(VF + vfrag_off(k0 >> 5, dt, lane));
    };
    issue(0, 0);
#pragma unroll
    for (int i = 0; i < 32; ++i) {
        const int buf = i & 1;
        if (i + 1 < 32) issue(i + 1, buf ^ 1);
        const int blk = sb[i >> 1]; const int k0 = blk * 64 + 32 * (i & 1);
        const bool dead = (blk < 0) || (k0 > tq);
        f32x4 s0, s1; qk_step(kf[buf], qs, s0, s1);
        const int pb = k0 + 4 * grp;
#pragma unroll
        for (int j = 0; j < 4; ++j) { if (dead || pb + j > tq) s0[j] = -INFINITY; if (dead || pb + 16 + j > tq) s1[j] = -INFINITY; }
        att_update(a, s0, s1, vf[buf]);
    }
    const float lt = grp_sum(a.l);
    if (l15 < 4) {
        const float gs = sigmoidf_(p.BIGF[(size_t)tq * PA + C_GATE + 8 + g * 4 + l15]) * (lt > 0.f ? 1.f / lt : 0.f);
#pragma unroll
        for (int dt = 0; dt < 4; ++dt) {
            const size_t o = (size_t)tq * 512 + g * 256 + l15 * 64 + 16 * dt + 4 * grp;
            const f32x4 base = *(const f32x4*)(p.NSACC + o); const f32x4 v = base + a.o[dt] * gs;
            uint2 w; w.x = pk2(v[0], v[1]); w.y = pk2(v[2], v[3]);
            *(uint2*)(p.MIXB + (size_t)tq * 1024 + g * 256 + l15 * 64 + 16 * dt + 4 * grp) = w;
        }
    }
}

__device__ __forceinline__ void ph_compress(const KP& p, const Fr& F) {
    float* flat = (float*)F.lds;
    float* hid = (float*)(F.lds + 32768);
    float* res = (float*)(F.lds + 32768 + 2048);
    const float* H0 = p.BIGF;
    const int tid = F.tid;
    for (int item = F.bid; item < 512; item += F.G) {
        const int c = item & 511, s = item >> 9;
        for (int e = tid; e < 8192; e += NTHR) {
            const int kv = e >> 12, g = (e >> 11) & 1, k = e & 2047, i = k >> 6, d = k & 63;
            const int row = c * 32 + i;
            float v;
            if (s == 0) v = H0[(size_t)row * PA + C_KC + kv * 128 + g * 64 + d];
            else { const int b = s - 1; const int page = p.page_table[b * NPAGES + (row >> 7)];
                   v = p.cache_cmp[((((size_t)page * 128 + (row & 127)) * 2 + kv) * 2 + g) * 64 + d]; }
            flat[e] = v + p.cpe[(kv * 32 + i) * 64 + d];
        }
        __syncthreads();
        {
            const int kv = tid >> 8, g = (tid >> 7) & 1, j = tid & 127;
            const float* w = p.cw1 + (size_t)kv * 2048 * 128 + j;
            const float* fl = flat + (kv * 2 + g) * 2048;
            float acc = p.cb1[kv * 128 + j];
            for (int k = 0; k < 2048; ++k) acc += fl[k] * w[(size_t)k * 128];
            hid[(kv * 2 + g) * 128 + j] = gelu_tanh(acc);
        }
        __syncthreads();
        if (tid < 256) {
            const int kv = tid >> 7, g = (tid >> 6) & 1, d = tid & 63;
            const float* w = p.cw2 + (size_t)kv * 128 * 64 + d;
            const float* hh = hid + (kv * 2 + g) * 128;
            float acc = 0.f;
            for (int j = 0; j < 128; ++j) acc += hh[j] * w[j * 64];
            res[(kv * 2 + g) * 64 + d] = acc;
        }
        __syncthreads();
        if (tid < 256) {
            const int kv = tid >> 7, g = (tid >> 6) & 1, d = tid & 63;
            const float* rr = res + (kv * 2 + g) * 64;
            float v = rr[d];
            if (kv == 0) {
                const int pos = (c + 1) * 32 - 1; const float2 cs = p.ROPE[pos * 32 + (d & 31)];
                const float x1 = rr[d & 31], x2 = rr[(d & 31) + 32];
                v = (d < 32) ? (x1 * cs.x - x2 * cs.y) : (x2 * cs.x + x1 * cs.y);
                p.CK[(((size_t)s * 512 + c) * 2 + g) * 64 + d] = v;
                if (s == 0) p.CKF[(size_t)g * 512 * 64 + kfrag_elem(c, d)] = (bf16)f2bf(v);
            } else { p.CV[(((size_t)s * 512 + c) * 2 + g) * 64 + d] = v; if (s == 0) p.CVF[(size_t)g * 512 * 64 + vfrag_elem(c, d)] = (bf16)f2bf(v); }
        }
        __syncthreads();
    }
}

__device__ __forceinline__ void ph_gdn_prep(const KP& p, const Fr& F) {
    const float* H0 = p.BIGF; const int lane = F.lane;
    for (int item = T * 8 + F.gw; item < TS * 8; item += F.NGW) {
        const int r = item >> 3, h = item & 7;
        const bool smp = r >= T; const int b = r - T;
        float cv[3];
#pragma unroll
        for (int part = 0; part < 3; ++part) {
            const int ch = part * 512 + h * 64 + lane;
            float acc = 0.f;
#pragma unroll
            for (int j = 0; j < 4; ++j) {
                float u;
                if (!smp) { const int t = r + j - 3; u = (t >= 0) ? H0[(size_t)t * PA + C_GQKV + ch] : 0.f; }
                else { u = (j < 3) ? p.st_gconv[((size_t)b * 3 + j) * 1536 + ch] : H0[(size_t)r * PA + C_GQKV + ch]; }
                acc += p.gconv_w[j * 1536 + ch] * u;
            }
            cv[part] = siluf_(acc);
        }
        const float qn = wave_sum(cv[0] * cv[0]), kn = wave_sum(cv[1] * cv[1]);
        const size_t o = ((size_t)r * 8 + h) * 64 + lane;
        p.GQ[o] = cv[0] * rsqrtf(qn + NORM_EPS) * 0.125f;
        p.GK[o] = cv[1] * rsqrtf(kn + NORM_EPS);
        p.GV[o] = cv[2];
        if (lane == 0) {
            const float av = H0[(size_t)r * PA + C_A + h], bt = H0[(size_t)r * PA + C_BT + h];
            p.Gg[(size_t)r * 8 + h] = -expf(p.gA[h]) * softplusf_(av + p.gdt[h]);
            p.Gb[(size_t)r * 8 + h] = sigmoidf_(bt);
        }
    }
    const size_t gt = (size_t)F.tgt, GT = (size_t)F.tGT;
    for (size_t idx = gt; idx < (size_t)3 * 1536; idx += GT) {
        const int j = (int)(idx / 1536), ch = (int)(idx % 1536);
        p.out[O_GCONV_P + idx] = h0f(p, T - 3 + j, C_GQKV + ch);
    }
    for (size_t idx = gt; idx < (size_t)NSMP * 3 * 1536; idx += GT) {
        const int b = (int)(idx / (3 * 1536)), j = (int)((idx / 1536) % 3), ch = (int)(idx % 1536);
        p.out[O_GCONV_S + idx] = (j < 2) ? p.st_gconv[((size_t)b * 3 + j + 1) * 1536 + ch] : H0[(size_t)(T + b) * PA + C_GQKV + ch];
    }
}

template <int NH, class KF>
__device__ __forceinline__ void wave_attend(const float* qs, float* sc, int scstride, int nkeys, KF kf, float (&outv)[NH], float (&den)[NH], int lane, float* mxout = nullptr) {
    float mx[NH];
#pragma unroll
    for (int h = 0; h < NH; ++h) mx[h] = -INFINITY;
    for (int j = lane; j < nkeys; j += 64) {
        const float *kp, *vp; const bool ok = kf(j, kp, vp);
        float s[NH];
#pragma unroll
        for (int h = 0; h < NH; ++h) s[h] = 0.f;
        if (ok) {
            for (int d4 = 0; d4 < 16; ++d4) {
                const float4 kvv = ((const float4*)kp)[d4];
#pragma unroll
                for (int h = 0; h < NH; ++h) { const float* q = qs + h * 64 + d4 * 4; s[h] += kvv.x * q[0] + kvv.y * q[1] + kvv.z * q[2] + kvv.w * q[3]; }
            }
        }
#pragma unroll
        for (int h = 0; h < NH; ++h) { const float v = ok ? s[h] * 0.125f : -INFINITY; sc[h * scstride + j] = v; mx[h] = fmaxf(mx[h], v); }
    }
#pragma unroll
    for (int h = 0; h < NH; ++h) { mx[h] = wave_max(mx[h]); if (!(mx[h] > -INFINITY)) mx[h] = 0.f; if (mxout) mxout[h] = mx[h]; }
    float sm[NH];
#pragma unroll
    for (int h = 0; h < NH; ++h) sm[h] = 0.f;
    for (int j = lane; j < nkeys; j += 64) {
#pragma unroll
        for (int h = 0; h < NH; ++h) { const float v = sc[h * scstride + j]; const float pp = (v == -INFINITY) ? 0.f : expf(v - mx[h]); sc[h * scstride + j] = pp; sm[h] += pp; }
    }
#pragma unroll
    for (int h = 0; h < NH; ++h) { sm[h] = wave_sum(sm[h]); den[h] = sm[h] > 0.f ? sm[h] : 1.f; }
    wave_lds_sync();
    {
        const int kq = lane >> 4, d4 = lane & 15;
        float4 acc[NH];
#pragma unroll
        for (int h = 0; h < NH; ++h) acc[h] = make_float4(0.f, 0.f, 0.f, 0.f);
        for (int j0 = 0; j0 < nkeys; j0 += 32) {
            float4 v[8];
#pragma unroll
            for (int u = 0; u < 8; ++u) { const int j = j0 + 4 * u + kq; const float *kp, *vp; const bool ok = (j < nkeys) && kf(j, kp, vp);
                v[u] = ok ? *(const float4*)(vp + 4 * d4) : make_float4(0.f, 0.f, 0.f, 0.f); }
#pragma unroll
            for (int u = 0; u < 8; ++u) { const int j = j0 + 4 * u + kq;
#pragma unroll
                for (int h = 0; h < NH; ++h) { const float pp = (j < nkeys) ? sc[h * scstride + j] : 0.f;
                    acc[h].x += pp * v[u].x; acc[h].y += pp * v[u].y; acc[h].z += pp * v[u].z; acc[h].w += pp * v[u].w; } }
        }
#pragma unroll
        for (int h = 0; h < NH; ++h) {
            float4 a = acc[h];
            a.x += __shfl_xor(a.x, 16); a.y += __shfl_xor(a.y, 16); a.z += __shfl_xor(a.z, 16); a.w += __shfl_xor(a.w, 16);
            a.x += __shfl_xor(a.x, 32); a.y += __shfl_xor(a.y, 32); a.z += __shfl_xor(a.z, 32); a.w += __shfl_xor(a.w, 32);
            const float x0 = __shfl(a.x, lane >> 2), x1 = __shfl(a.y, lane >> 2), x2 = __shfl(a.z, lane >> 2), x3 = __shfl(a.w, lane >> 2);
            const int cc = lane & 3; outv[h] = cc == 0 ? x0 : (cc == 1 ? x1 : (cc == 2 ? x2 : x3));
        }
    }
#pragma unroll
    for (int h = 0; h < NH; ++h) outv[h] /= den[h];
    wave_lds_sync();
}

__device__ __forceinline__ void nsa_smp_cs(const KP& p, int b, int g, float* wl, int lane) {
    float* qs = wl; float* sc = wl + 256; float* imp = wl + 256 + 4 * 1088; int* sel = (int*)(wl + 256 + 4 * 1088 + 320); long long* bb = (long long*)(wl + 256 + 4 * 1088 + 320 + 16);
    const int r = T + b; const int qpos = T;
    const float* grow = p.BIGF + (size_t)r * PA + C_GATE;
#pragma unroll
    for (int h = 0; h < 4; ++h) qs[h * 64 + lane] = p.QR[(size_t)r * 512 + (g * 4 + h) * 64 + lane];
    wave_lds_sync();
    float ocmp[4], oslc[4], den[4];
    {
        const float* CKp = p.CK + (size_t)(1 + b) * 512 * 128; const float* CVp = p.CV + (size_t)(1 + b) * 512 * 128;
        auto kf = [&](int j, const float*& kp, const float*& vp) -> bool { kp = CKp + (j * 2 + g) * 64; vp = CVp + (j * 2 + g) * 64; return true; };
        wave_attend<4>(qs, sc, 1088, 512, kf, ocmp, den, lane);
        for (int blk = lane; blk < 320; blk += 64) {
            float v = 0.f;
            if (blk < 256) {
#pragma unroll
                for (int h = 0; h < 4; ++h) v += (sc[h * 1088 + 2 * blk] + sc[h * 1088 + 2 * blk + 1]) / den[h];
            }
            imp[blk] = v;
        }
        wave_lds_sync();
    }
    {
        const int cur = qpos >> 6;
        float val[5];
#pragma unroll
        for (int j = 0; j < 5; ++j) { const int blk = lane + 64 * j; val[j] = (blk >= 1 && blk <= cur - 2) ? imp[blk] : -1.f; }
        if (lane == 0) { sel[0] = 0; sel[1] = cur; sel[2] = cur - 1; }
        for (int n = 3; n < 16; ++n) {
            float bv = -2.f; int bi = 0x7fffffff;
#pragma unroll
            for (int j = 0; j < 5; ++j) if (val[j] > bv) { bv = val[j]; bi = lane + 64 * j; }
#pragma unroll
            for (int o = 1; o < 64; o <<= 1) { const float ov = __shfl_xor(bv, o); const int oi = __shfl_xor(bi, o); if (ov > bv || (ov == bv && oi < bi)) { bv = ov; bi = oi; } }
#pragma unroll
            for (int j = 0; j < 5; ++j) if (lane + 64 * j == bi) val[j] = -3.f;
            if (lane == 0) sel[n] = bi;
        }
        wave_lds_sync();
        if (lane < 16) { const int blk = sel[lane]; long long o = 0;
            if (blk < 256) { const int page = p.page_table[b * NPAGES + (blk >> 1)]; o = ((long long)page * 128 + (blk & 1) * 64) * 256; }
            bb[lane] = o; }
        wave_lds_sync();
    }
    {
        auto kf = [&](int j, const float*& kp, const float*& vp) -> bool {
            const int blk = sel[j >> 6]; const int pos = blk * 64 + (j & 63); if (pos > qpos) return false;
            if (pos == T) { kp = p.KS + (size_t)r * 128 + g * 64; vp = p.VS + (size_t)r * 128 + g * 64; return true; }
            const float* base = p.cache_slc + bb[j >> 6] + (j & 63) * 256;
            kp = base + g * 64; vp = base + 128 + g * 64; return true; };
        wave_attend<4>(qs, sc, 1088, 1024, kf, oslc, den, lane);
    }
#pragma unroll
    for (int h = 0; h < 4; ++h) {
        const int hh = g * 4 + h;
        p.SMIXF[((size_t)b * 3 + 0) * 512 + hh * 64 + lane] = sigmoidf_(grow[hh]) * ocmp[h];
        p.SMIXF[((size_t)b * 3 + 1) * 512 + hh * 64 + lane] = sigmoidf_(grow[8 + hh]) * oslc[h];
    }
    wave_lds_sync();
}
__device__ __forceinline__ void nsa_smp_win(const KP& p, int b, int g, float* wl, int lane) {
    float* qs = wl; float* sc = wl + 256;
    const int r = T + b;
    const float* grow = p.BIGF + (size_t)r * PA + C_GATE;
#pragma unroll
    for (int h = 0; h < 4; ++h) qs[h * 64 + lane] = p.QR[(size_t)r * 512 + (g * 4 + h) * 64 + lane];
    wave_lds_sync();
    float owin[4], den[4];
    auto kf = [&](int j, const float*& kp, const float*& vp) -> bool {
        if (j == 512) { kp = p.KW + (size_t)r * 128 + g * 64; vp = p.VW + (size_t)r * 128 + g * 64; return true; }
        const float* base = p.st_win + ((size_t)b * 512 + j) * 256;
        kp = base + g * 64; vp = base + 128 + g * 64; return true; };
    wave_attend<4>(qs, sc, 528, 513, kf, owin, den, lane);
#pragma unroll
    for (int h = 0; h < 4; ++h) { const int hh = g * 4 + h; p.SMIXF[((size_t)b * 3 + 2) * 512 + hh * 64 + lane] = sigmoidf_(grow[16 + hh]) * owin[h]; }
    wave_lds_sync();
}

__device__ __forceinline__ void gdn_scan_item(const KP& p, int item, float* wl, int lane) {
    asm volatile("" : "+v"(lane));
    float* kq = wl;
    const int b = (item >> 3) - 1, h = item & 7;
    const int r = T + b; const size_t o = ((size_t)r * 8 + h) * 64;
    kq[lane] = p.GK[o + lane]; kq[64 + lane] = p.GQ[o + lane];
    wave_lds_sync();
    const float dec = expf(p.Gg[(size_t)r * 8 + h]), bt = p.Gb[(size_t)r * 8 + h];
    const float* Sp = p.st_gS + ((size_t)b * 8 + h) * 4096 + lane;
    float* so = p.out + O_GS_S + ((size_t)b * 8 + h) * 4096 + lane;
    float S[64]; float kv = 0.f;
#pragma unroll
    for (int i = 0; i < 64; ++i) { S[i] = Sp[i * 64] * dec; kv += kq[i] * S[i]; }
    const float vn = (p.GV[o + lane] - kv) * bt;
    float ov = 0.f;
#pragma unroll
    for (int i = 0; i < 64; ++i) { const float sn = S[i] + kq[i] * vn; ov += kq[64 + i] * sn; so[i * 64] = sn; }
    p.OG[o + lane] = ov;
    wave_lds_sync();
}

constexpr int GDN_WL = 34816;
__device__ __forceinline__ int kperm(int ks, int grp, int j) { return 32 * ks + 16 * (j >> 2) + 4 * grp + (j & 3); }

__device__ __forceinline__ void gdn_chunk_unit(const KP& p, int unit, unsigned char* ldsb, int woff, int lane) {
    asm volatile("" : "+v"(lane), "+s"(woff));
    unsigned char* wlb = ldsb + woff;
    const int n = unit >> 3, h = unit & 7, t0 = 64 * n;
    const int l15 = lane & 15, grp = lane >> 4;
    float* Af = (float*)wlb; bf16* kt = (bf16*)(wlb + 16384); bf16* qt = kt + 64 * 72; bf16* tmp = (bf16*)wlb;
    {
        const float* H0 = p.BIGF;
        float w[3][4], u1[3], u2[3], u3[3];
#pragma unroll
        for (int part = 0; part < 3; ++part) {
            const int ch = part * 512 + h * 64 + lane;
#pragma unroll
            for (int j = 0; j < 4; ++j) w[part][j] = p.gconv_w[j * 1536 + ch];
            u1[part] = (t0 >= 1) ? h0f(p, t0 - 1, C_GQKV + ch) : 0.f;
            u2[part] = (t0 >= 2) ? h0f(p, t0 - 2, C_GQKV + ch) : 0.f;
            u3[part] = (t0 >= 3) ? h0f(p, t0 - 3, C_GQKV + ch) : 0.f;
        }
        int roff = 0;
#pragma unroll 4
        for (int i = 0; i < 64; ++i) {
            float cv[3];
#pragma unroll
            for (int part = 0; part < 3; ++part) {
                const float u0 = __uint_as_float((unsigned)p.H0B[(size_t)t0 * PAP + C_GQKV + part * 512 + h * 64 + lane + roff] << 16);
                cv[part] = siluf_(w[part][0] * u3[part] + w[part][1] * u2[part] + w[part][2] * u1[part] + w[part][3] * u0);
                u3[part] = u2[part]; u2[part] = u1[part]; u1[part] = u0;
            }
            roff += PAP; asm volatile("" : "+s"(roff));
            const float qn = wave_sum(cv[0] * cv[0]), kn = wave_sum(cv[1] * cv[1]);
            qt[i * 72 + lane] = (bf16)f2bf(cv[0] * rsqrtf(qn + NORM_EPS) * 0.125f);
            kt[i * 72 + lane] = (bf16)f2bf(cv[1] * rsqrtf(kn + NORM_EPS));
            p.GV[((size_t)(t0 + i) * 8 + h) * 64 + lane] = cv[2];
        }
    }
    const float gl_ = -fexp_(p.gA[h]) * softplusf_(h0f(p, t0 + lane, C_A + h) + p.gdt[h]);
    const float beta = sigmoidf_(h0f(p, t0 + lane, C_BT + h));
    float gc = gl_;
#pragma unroll
    for (int o = 1; o < 64; o <<= 1) { const float tv = __shfl_up(gc, o); if (lane >= o) gc += tv; }
    const float gclast = __shfl(gc, 63);
#define GPAD(i) ((float*)(kt + (i) * 72 + 64))
    { float* pd = GPAD(lane); pd[0] = gc; pd[1] = beta; pd[2] = fexp_(gc); pd[3] = fexp_(gclast - gc); }
    wave_lds_sync();
    bf16* QKF = p.G_QKF + (size_t)unit * 4096;
#pragma unroll
    for (int it = 0; it < 4; ++it) {
        const int i = 16 * it + l15;
        const float gci = GPAD(i)[0], bi = GPAD(i)[1];
        bf16x8 bk[2], bq[2];
#pragma unroll
        for (int ks = 0; ks < 2; ++ks) { bk[ks] = *(const bf16x8*)(kt + i * 72 + 32 * ks + 8 * grp); bq[ks] = *(const bf16x8*)(qt + i * 72 + 32 * ks + 8 * grp); }
#pragma unroll
        for (int jt = 0; jt < 4; ++jt) {
            uint2 qkp = make_uint2(0u, 0u);
            if (jt <= it) {
                bf16x8 ak[2];
#pragma unroll
                for (int ks = 0; ks < 2; ++ks) ak[ks] = *(const bf16x8*)(kt + (16 * jt + l15) * 72 + 32 * ks + 8 * grp);
                f32x4 aa = {0.f, 0.f, 0.f, 0.f}, aq = {0.f, 0.f, 0.f, 0.f};
                aa = MFMA16(ak[0], bk[0], aa); aa = MFMA16(ak[1], bk[1], aa);
                aq = MFMA16(ak[0], bq[0], aq); aq = MFMA16(ak[1], bq[1], aq);
                f32x4 av, qv;
#pragma unroll
                for (int r = 0; r < 4; ++r) {
                    const int j = 16 * jt + 4 * grp + r; const float gcj = GPAD(j)[0];
                    const float e = (j <= i) ? fexp_(gci - gcj) : 0.f;
                    av[r] = (j < i) ? bi * aa[r] * e : 0.f; qv[r] = aq[r] * e;
                }
                *(f32x4*)(Af + i * 64 + 16 * jt + 4 * grp) = av;
                qkp.x = pk2(qv[0], qv[1]); qkp.y = pk2(qv[2], qv[3]);
            }
            *(uint2*)(QKF + ((size_t)(it * 2 + (jt >> 1)) * 64 + lane) * 8 + (jt & 1) * 4) = qkp;
        }
    }
    wave_lds_sync();
    {
        float* UF = p.G_UF + (size_t)unit * 4096;
        const int vq = lane >> 4;
#pragma unroll
        for (int pass = 0; pass < 2; ++pass) {
            float x[64];
            int goff = 0;
#pragma unroll
            for (int i = 0; i < 64; ++i) {
                const float bi = GPAD(i)[1];
                float acc;
                if (pass == 0) { acc = p.GV[((size_t)t0 * 8 + h) * 64 + lane + goff] * bi; goff += 512; asm volatile("" : "+s"(goff)); }
                else { const float ei = GPAD(i)[2];
                       acc = __uint_as_float((unsigned)kt[i * 72 + lane] << 16) * bi * ei; }
#pragma unroll
                for (int jj = 0; jj < (i + 3) / 4; ++jj) {
                    const float4 a4 = *(const float4*)(Af + i * 64 + 4 * jj);
                    acc -= a4.x * x[4 * jj + 0];
                    if (4 * jj + 1 < i) acc -= a4.y * x[4 * jj + 1];
                    if (4 * jj + 2 < i) acc -= a4.z * x[4 * jj + 2];
                    if (4 * jj + 3 < i) acc -= a4.w * x[4 * jj + 3];
                }
                x[i] = acc;
                if ((i & 3) == 3) asm volatile("" ::: "memory");
            }
            if (pass == 0) {
#pragma unroll
                for (int c4 = 0; c4 < 16; ++c4) {
                    const int mt = c4 >> 2, lp = l15 + 16 * (c4 & 3);
                    *(f32x4*)(UF + ((size_t)(vq * 4 + mt) * 64 + lp) * 4) = (f32x4){x[4 * c4], x[4 * c4 + 1], x[4 * c4 + 2], x[4 * c4 + 3]};
                }
            } else {
                wave_lds_sync();
#pragma unroll
                for (int c = 0; c < 64; ++c) tmp[c * 72 + lane] = (bf16)f2bf(-x[c]);
            }
            asm volatile("" ::: "memory");
        }
    }
    wave_lds_sync();
    {
        bf16* WF = p.G_WF + (size_t)unit * 4096; bf16* QGF = p.G_QGF + (size_t)unit * 4096; bf16* KDF = p.G_KDF + (size_t)unit * 4096;
#pragma unroll
        for (int mt = 0; mt < 4; ++mt) {
            const float egc = GPAD(16 * mt + l15)[2];
#pragma unroll
            for (int ks = 0; ks < 2; ++ks) {
                const int c = 16 * mt + l15, k0 = 32 * ks + 4 * grp;
                const uint2 w0 = *(const uint2*)(tmp + c * 72 + k0), w1 = *(const uint2*)(tmp + c * 72 + k0 + 16);
                v4u wv; wv.x = w0.x; wv.y = w0.y; wv.z = w1.x; wv.w = w1.y;
                *(v4u*)(WF + ((size_t)(mt * 2 + ks) * 64 + lane) * 8) = wv;
                const uint2 q0 = *(const uint2*)(qt + c * 72 + k0), q1 = *(const uint2*)(qt + c * 72 + k0 + 16);
                v4u qv;
                qv.x = pk2(__uint_as_float(q0.x << 16) * egc, __uint_as_float(q0.x & 0xffff0000u) * egc); qv.y = pk2(__uint_as_float(q0.y << 16) * egc, __uint_as_float(q0.y & 0xffff0000u) * egc);
                qv.z = pk2(__uint_as_float(q1.x << 16) * egc, __uint_as_float(q1.x & 0xffff0000u) * egc); qv.w = pk2(__uint_as_float(q1.y << 16) * egc, __uint_as_float(q1.y & 0xffff0000u) * egc);
                *(v4u*)(QGF + ((size_t)(mt * 2 + ks) * 64 + lane) * 8) = qv;
                float kd[8];
#pragma unroll
                for (int j = 0; j < 8; ++j) { const int cc = kperm(ks, grp, j); kd[j] = __uint_as_float((unsigned)kt[cc * 72 + 16 * mt + l15] << 16) * GPAD(cc)[3]; }
                v4u kv; kv.x = pk2(kd[0], kd[1]); kv.y = pk2(kd[2], kd[3]); kv.z = pk2(kd[4], kd[5]); kv.w = pk2(kd[6], kd[7]);
                *(v4u*)(KDF + ((size_t)(mt * 2 + ks) * 64 + lane) * 8) = kv;
            }
        }
        if (lane == 0) p.G_GL[unit] = fexp_(gclast);
    }
    wave_lds_sync();
#undef GPAD
}

constexpr int CH_SLOT = 32768;
__device__ __forceinline__ void gdn_chain_wg(const KP& p, int h, int wave, int lane, unsigned char* ldsb) {
    asm volatile("" : "+v"(lane));
    const int l15 = lane & 15, grp = lane >> 4;
    float* GLs = (float*)(ldsb + 4 * CH_SLOT);
    if (wave < 4) GLs[wave * 64 + lane] = p.G_GL[(size_t)(wave * 64 + lane) * 8 + h];
#define CH_BAR() do { asm volatile("s_waitcnt lgkmcnt(0)" ::: "memory"); __builtin_amdgcn_s_barrier(); asm volatile("" ::: "memory"); } while (0)
    if (wave >= 4) {
        const int lw = wave - 4;
        const unsigned char* gb = (lw == 0) ? (const unsigned char*)p.G_WF : (lw == 1) ? (const unsigned char*)p.G_KDF : (const unsigned char*)p.G_UF + (size_t)(lw - 2) * 8192;
        const size_t ustride = (lw < 2) ? 8192 : 16384;
        gb += (size_t)h * ustride + (size_t)lane * 16;
        auto src = [&](int n, int k) -> const v4u* { return (const v4u*)(gb + (size_t)n * 8 * ustride + k * 1024); };
        v4u rs[4][8];
#pragma unroll
        for (int j = 0; j < 4; ++j)
#pragma unroll
            for (int k = 0; k < 8; ++k) rs[j][k] = *src(j, k);
#pragma unroll
        for (int j = 0; j < 2; ++j) {
#pragma unroll
            for (int k = 0; k < 8; ++k) { *(v4u*)(ldsb + j * CH_SLOT + (lw * 512 + k * 64 + lane) * 16) = rs[j][k]; rs[j][k] = *src(4 + j, k); }
        }
        CH_BAR();
        for (int n0 = 0; n0 < 256; n0 += 4) {
#pragma unroll
            for (int j = 0; j < 4; ++j) {
                const int n = n0 + j, st = n + 2;
                if (st < 256) {
                    const int set = (j + 2) & 3;
#pragma unroll
                    for (int k = 0; k < 8; ++k) { *(v4u*)(ldsb + (st & 3) * CH_SLOT + (lw * 512 + k * 64 + lane) * 16) = rs[set][k]; if (st + 4 < 256) rs[set][k] = *src(st + 4, k); }
                }
                CH_BAR();
            }
        }
#undef CH_BAR
        return;
    }
    const int vq = wave;
    f32x4 S[4];
#pragma unroll
    for (int i = 0; i < 4; ++i) S[i] = (f32x4){0.f, 0.f, 0.f, 0.f};
    asm volatile("s_waitcnt lgkmcnt(0)" ::: "memory"); __builtin_amdgcn_s_barrier(); asm volatile("" ::: "memory");
    for (int n = 0; n < 256; ++n) {
        const unsigned char* sl = ldsb + (n & 3) * CH_SLOT;
        bf16x8 wf[4][2], kdf[4][2]; f32x4 uf[4];
#pragma unroll
        for (int mt = 0; mt < 4; ++mt) {
#pragma unroll
            for (int ks = 0; ks < 2; ++ks) { wf[mt][ks] = *(const bf16x8*)(sl + ((mt * 2 + ks) * 64 + lane) * 16); kdf[mt][ks] = *(const bf16x8*)(sl + 8192 + ((mt * 2 + ks) * 64 + lane) * 16); }
            uf[mt] = *(const f32x4*)(sl + 16384 + ((vq * 4 + mt) * 64 + lane) * 16);
        }
        const float gl = GLs[n];
        const size_t fo = ((size_t)((n * 8 + h) * 4 + vq) * 2) * 512;
        bf16x8 sB[2];
#pragma unroll
        for (int ks = 0; ks < 2; ++ks) { sB[ks] = pack_p(S[2 * ks], S[2 * ks + 1]); *(bf16x8*)(p.G_SPF + fo + ((size_t)ks * 64 + lane) * 8) = sB[ks]; }
        f32x4 v[4];
#pragma unroll
        for (int mt = 0; mt < 4; ++mt) { v[mt] = uf[mt]; v[mt] = MFMA16(wf[mt][0], sB[0], v[mt]); v[mt] = MFMA16(wf[mt][1], sB[1], v[mt]); }
        bf16x8 vB[2];
#pragma unroll
        for (int ks = 0; ks < 2; ++ks) { vB[ks] = pack_p(v[2 * ks], v[2 * ks + 1]); *(bf16x8*)(p.G_VNF + fo + ((size_t)ks * 64 + lane) * 8) = vB[ks]; }
#pragma unroll
        for (int mt = 0; mt < 4; ++mt) { S[mt] = S[mt] * gl; S[mt] = MFMA16(kdf[mt][0], vB[0], S[mt]); S[mt] = MFMA16(kdf[mt][1], vB[1], S[mt]); }
        asm volatile("s_waitcnt lgkmcnt(0)" ::: "memory"); __builtin_amdgcn_s_barrier(); asm volatile("" ::: "memory");
    }
    float* so = p.out + O_GS_P + (size_t)h * 4096;
#pragma unroll
    for (int mt = 0; mt < 4; ++mt)
#pragma unroll
        for (int r = 0; r < 4; ++r) so[(16 * mt + 4 * grp + r) * 64 + 16 * vq + l15] = S[mt][r];
}

__device__ __forceinline__ void gdn_out_unit(const KP& p, int unit, int lane) {
    asm volatile("" : "+v"(lane));
    const int n = unit >> 3, h = unit & 7, t0 = 64 * n; const int l15 = lane & 15, grp = lane >> 4;
    const bf16* QGF = p.G_QGF + (size_t)unit * 4096; const bf16* QKF = p.G_QKF + (size_t)unit * 4096;
    f32x4 o[4][4];
#pragma unroll
    for (int mt = 0; mt < 4; ++mt)
#pragma unroll
        for (int vq = 0; vq < 4; ++vq) o[mt][vq] = (f32x4){0.f, 0.f, 0.f, 0.f};
#pragma unroll
    for (int ks = 0; ks < 2; ++ks) {
        bf16x8 sp[4], vn[4];
#pragma unroll
        for (int vq = 0; vq < 4; ++vq) { const size_t fo = ((size_t)(unit * 4 + vq) * 2 + ks) * 512 + (size_t)lane * 8; sp[vq] = *(const bf16x8*)(p.G_SPF + fo); vn[vq] = *(const bf16x8*)(p.G_VNF + fo); }
#pragma unroll
        for (int mt = 0; mt < 4; ++mt) {
            const bf16x8 qg = *(const bf16x8*)(QGF + ((size_t)(mt * 2 + ks) * 64 + lane) * 8), qk = *(const bf16x8*)(QKF + ((size_t)(mt * 2 + ks) * 64 + lane) * 8);
#pragma unroll
            for (int vq = 0; vq < 4; ++vq) { o[mt][vq] = MFMA16(qg, sp[vq], o[mt][vq]); o[mt][vq] = MFMA16(qk, vn[vq], o[mt][vq]); }
        }
    }
    float nw[4];
#pragma unroll
    for (int vq = 0; vq < 4; ++vq) nw[vq] = p.gnw[16 * vq + l15];
#pragma unroll
    for (int mt = 0; mt < 4; ++mt)
#pragma unroll
        for (int r = 0; r < 4; ++r) {
            float ss = 0.f;
#pragma unroll
            for (int vq = 0; vq < 4; ++vq) ss += o[mt][vq][r] * o[mt][vq][r];
            ss += __shfl_xor(ss, 1); ss += __shfl_xor(ss, 2); ss += __shfl_xor(ss, 4); ss += __shfl_xor(ss, 8);
            const float rs = rsqrtf(ss * (1.f / 64.f) + NORM_EPS);
            const int t = t0 + 16 * mt + 4 * grp + r;
            const float* zr = p.ZF + (size_t)t * 512 + h * 64;
#pragma unroll
            for (int vq = 0; vq < 4; ++vq) p.MIXB[(size_t)t * 1024 + 512 + h * 64 + 16 * vq + l15] = (bf16)f2bf(o[mt][vq][r] * rs * nw[vq] * siluf_(zr[16 * vq + l15]));
        }
}

#define MFMA8(a, b, c) __builtin_amdgcn_mfma_f32_16x16x32_fp8_fp8((a), (b), (c), 0, 0, 0)
__device__ __forceinline__ long pack_fp8(const f32x4& a, const f32x4& b) {
    int w0 = 0, w1 = 0;
    w0 = __builtin_amdgcn_cvt_pk_fp8_f32(a[0], a[1], w0, false); w0 = __builtin_amdgcn_cvt_pk_fp8_f32(a[2], a[3], w0, true);
    w1 = __builtin_amdgcn_cvt_pk_fp8_f32(b[0], b[1], w1, false); w1 = __builtin_amdgcn_cvt_pk_fp8_f32(b[2], b[3], w1, true);
    return (long)(((unsigned long long)(unsigned)w1 << 32) | (unsigned long long)(unsigned)w0);
}
template <bool GEN>
__device__ __forceinline__ void nsa_slc_item8(const KP& p, int tq, int g, int lane) {
    asm volatile("" : "+v"(lane));
    const int l15 = lane & 15, grp = lane >> 4, hn = lane & 3;
    const unsigned char* KF = p.KS8 + (size_t)g * T * 64; const unsigned char* VF = p.VS8 + (size_t)g * T * 64;
    const int* selp = p.SEL + ((size_t)g * T + tq) * 16;
    int sb[16];
#pragma unroll
    for (int i = 0; i < 16; ++i) sb[i] = __builtin_amdgcn_readfirstlane(selp[i]);
    long qs[2];
#pragma unroll
    for (int ks = 0; ks < 2; ++ks) {
        const bf16x8 qb = *(const bf16x8*)(p.QB + (size_t)tq * 512 + (g * 4 + hn) * 64 + 32 * ks + 8 * grp);
        f32x4 a, b;
#pragma unroll
        for (int j = 0; j < 4; ++j) { a[j] = __uint_as_float((unsigned)(unsigned short)qb[j] << 16) * (1.f / QSCALE); b[j] = __uint_as_float((unsigned)(unsigned short)qb[4 + j] << 16) * (1.f / QSCALE); }
        qs[ks] = pack_fp8(a, b);
    }
    AttW a; attw_init(a);
    long kf[3][4][2], vf[3][2][4];
    auto issue = [&](int bi, int buf) {
        int blk = sb[bi]; if (GEN && (blk < 0 || blk * 64 > tq)) blk = 0;
        typedef long l2_t __attribute__((ext_vector_type(2)));
#pragma unroll
        for (int tl = 0; tl < 4; ++tl) { const l2_t x = *(const l2_t*)(KF + ((size_t)(blk * 4 + tl) * 64 + lane) * 16); kf[buf][tl][0] = x[0]; kf[buf][tl][1] = x[1]; }
#pragma unroll
        for (int dt = 0; dt < 4; ++dt) { const l2_t x = *(const l2_t*)(VF + ((size_t)(blk * 4 + dt) * 64 + lane) * 16); vf[buf][0][dt] = x[0]; vf[buf][1][dt] = x[1]; }
    };
    issue(0, 0); issue(1, 1);
#pragma unroll
    for (int bi = 0; bi < 16; ++bi) {
        const int buf = bi % 3;
        if (bi + 2 < 16) issue(bi + 2, (bi + 2) % 3);
        const int blk = sb[bi]; const int k0 = blk * 64;
        if (GEN && (blk < 0 || k0 > tq)) continue;
        const f32x4 z = {0.f, 0.f, 0.f, 0.f};
        f32x4 sc[4];
#pragma unroll
        for (int tl = 0; tl < 4; ++tl) { sc[tl] = MFMA8(kf[buf][tl][0], qs[0], z); sc[tl] = MFMA8(kf[buf][tl][1], qs[1], sc[tl]); }
        if (GEN ? (k0 + 63 > tq) : (bi == 1)) {
#pragma unroll
            for (int tl = 0; tl < 4; ++tl)
#pragma unroll
                for (int j = 0; j < 4; ++j) if (k0 + 16 * tl + 4 * grp + j > tq) sc[tl][j] = -INFINITY;
        }
        float mx = fmaxf(fmaxf(fmaxf(fmaxf(sc[0][0], sc[0][1]), fmaxf(sc[0][2], sc[0][3])), fmaxf(fmaxf(sc[1][0], sc[1][1]), fmaxf(sc[1][2], sc[1][3]))),
                         fmaxf(fmaxf(fmaxf(sc[2][0], sc[2][1]), fmaxf(sc[2][2], sc[2][3])), fmaxf(fmaxf(sc[3][0], sc[3][1]), fmaxf(sc[3][2], sc[3][3]))));
        mx = fmaxf(mx, __shfl_xor(mx, 16)); mx = fmaxf(mx, __shfl_xor(mx, 32));
        const float mn = fmaxf(a.m, mx * QSCALE);
        const float alpha = __builtin_amdgcn_exp2f(a.m - mn);
        const float mb = 7.f - mn;
        f32x4 pp[4]; float sum = 0.f;
#pragma unroll
        for (int tl = 0; tl < 4; ++tl) {
#pragma unroll
            for (int j = 0; j < 4; ++j) pp[tl][j] = __builtin_amdgcn_exp2f(fmaf(sc[tl][j], QSCALE, mb));
            sum += (pp[tl][0] + pp[tl][1]) + (pp[tl][2] + pp[tl][3]);
        }
        a.l = a.l * alpha + sum; a.m = mn;
        const long pf0 = pack_fp8(pp[0], pp[1]), pf1 = pack_fp8(pp[2], pp[3]);
#pragma unroll
        for (int dt = 0; dt < 4; ++dt) { a.o[dt] = a.o[dt] * alpha; a.o[dt] = MFMA8(vf[buf][0][dt], pf0, a.o[dt]); a.o[dt] = MFMA8(vf[buf][1][dt], pf1, a.o[dt]); }
    }
    const float lt = grp_sum(a.l);
    if (l15 < 4) {
        const float gs = sigmoidf_(h0f(p, tq, C_GATE + 8 + g * 4 + l15)) * (lt > 0.f ? 1.f / lt : 0.f);
#pragma unroll
        for (int dt = 0; dt < 4; ++dt) {
            const size_t o = (size_t)tq * 512 + g * 256 + l15 * 64 + 16 * dt + 4 * grp;
            const f32x4 base = *(const f32x4*)(p.NSACC + o); const f32x4 v = base + a.o[dt] * gs;
            uint2 w; w.x = pk2(v[0], v[1]); w.y = pk2(v[2], v[3]);
            *(uint2*)(p.MIXB + (size_t)tq * 1024 + g * 256 + l15 * 64 + 16 * dt + 4 * grp) = w;
        }
    }
}

__device__ __forceinline__ void ph_prep_chunks(const KP& p, const Fr& F) {
    if (F.wave < 4) { for (int unit = F.bid * 4 + F.wave; unit < 2048; unit += F.G * 4) gdn_chunk_unit(p, unit, F.lds, F.wave * GDN_WL, F.lane); }
    else {
        const int NP = F.G - 32;
        if (F.bid < NP) {
            Fr F2 = F; F2.tgt = F.bid * 256 + (F.tid - 256); F2.tGT = NP * 256; F2.gw = F.bid * 4 + (F.wave - 4); F2.NGW = NP * 4;
            ph_nsa_prep(p, F2); ph_nsa_prep_fast(p, F2); ph_gdn_prep(p, F2);
        } else { const int unit = (F.bid - NP) * 4 + (F.wave - 4); if (unit < 128) cmp_prompt_unit(p, unit, F.lane); }
    }
}
__device__ __forceinline__ void ph_mix_a(const KP& p, const Fr& F) {
    if (F.bid < 32) gdn_scan_item(p, (F.bid + 1) * 8 + F.wave, (float*)(F.lds + 8 * FAST_WL + 1024 + F.wave * 512), F.lane);
    float* wl = (float*)(F.lds + F.wave * FAST_WL);
    for (int unit = F.gw; unit < 2048; unit += F.NGW) nsa_fast_unit(p, unit, wl, F.lane);
}
__device__ __forceinline__ void ph_mix_b(const KP& p, const Fr& F) {
    if (F.bid < 8) { gdn_chain_wg(p, F.bid, F.wave, F.lane, F.lds); return; }
    if (F.bid < 24) {
        const int it = (F.bid - 8) * 4 + (F.wave & 3);
        if (F.wave < 4) nsa_smp_cs(p, it >> 1, it & 1, (float*)(F.lds + F.wave * 20480), F.lane);
        else nsa_smp_win(p, it >> 1, it & 1, (float*)(F.lds + 81920 + (F.wave - 4) * 12288), F.lane);
        return;
    }
    const int g = F.bid & 1, fr = (F.bid - 24) >> 1, NW = ((F.G - 24) >> 1) * 8;
    for (int tq = fr * 8 + F.wave; tq < T; tq += NW) { if (tq >= 1024) nsa_slc_item8<false>(p, tq, g, F.lane); else nsa_slc_item8<true>(p, tq, g, F.lane); }
}

__device__ __forceinline__ void ph_gdn_out(const KP& p, const Fr& F) {
    const float* H0 = p.BIGF; const int lane = F.lane;
    for (int unit = F.gw; unit < 2048; unit += F.NGW) gdn_out_unit(p, unit, lane);
    for (int idx = F.bid * NTHR + F.tid; idx < NSMP * 512; idx += F.G * NTHR) { const int b = idx >> 9, c = idx & 511; const float* sp = p.SMIXF + (size_t)b * 3 * 512 + c;
        p.MIXB[(size_t)(T + b) * 1024 + c] = (bf16)f2bf(sp[0] + sp[512] + sp[1024]); }
    for (int item = T * 8 + F.gw; item < TS * 8; item += F.NGW) {
        const int r = item >> 3, h = item & 7;
        const float o = p.OG[((size_t)r * 8 + h) * 64 + lane];
        const float ms = wave_sum(o * o) * (1.f / 64.f);
        const float z = H0[(size_t)r * PA + C_Z + h * 64 + lane];
        p.MIXB[(size_t)r * 1024 + 512 + h * 64 + lane] = (bf16)f2bf(o * rsqrtf(ms + NORM_EPS) * p.gnw[lane] * siluf_(z));
    }
}

__device__ __forceinline__ void ph_ln(const Fr& F, const float* Xp, const float* Xs, const float* Fm, const float* gam, const float* bet, float* outp, float* outs, bf16* ob) {
    const int lane = F.lane;
    for (int r = F.gw; r < TS; r += F.NGW) {
        const float4* xr = (const float4*)((r < T) ? Xp + (size_t)r * DM : Xs + (size_t)(r - T) * DM) + lane; const float4* fr = (const float4*)(Fm + (size_t)r * DM) + lane;
        f32x4 v[4]; float s = 0.f;
#pragma unroll
        for (int j = 0; j < 4; ++j) { const float4 x = xr[64 * j], f = fr[64 * j]; v[j] = (f32x4){DN_ALPHA * x.x + f.x, DN_ALPHA * x.y + f.y, DN_ALPHA * x.z + f.z, DN_ALPHA * x.w + f.w}; s += (v[j][0] + v[j][1]) + (v[j][2] + v[j][3]); }
        const float mean = wave_sum(s) * (1.f / DM); float q = 0.f;
#pragma unroll
        for (int j = 0; j < 4; ++j) { v[j] = v[j] - mean; q += (v[j][0] * v[j][0] + v[j][1] * v[j][1]) + (v[j][2] * v[j][2] + v[j][3] * v[j][3]); }
        const float rstd = rsqrtf(wave_sum(q) * (1.f / DM) + LN_EPS);
        float4* o = (float4*)((r < T) ? outp + (size_t)r * DM : outs + (size_t)(r - T) * DM) + lane;
#pragma unroll
        for (int j = 0; j < 4; ++j) { const float4 g4 = ((const float4*)gam)[lane + 64 * j], b4 = ((const float4*)bet)[lane + 64 * j];
            const float4 y = make_float4(v[j][0] * rstd * g4.x + b4.x, v[j][1] * rstd * g4.y + b4.y, v[j][2] * rstd * g4.z + b4.z, v[j][3] * rstd * g4.w + b4.w);
            o[64 * j] = y; if (ob) { uint2 w; w.x = pk2(y.x, y.y); w.y = pk2(y.z, y.w); *((uint2*)(ob + (size_t)r * DM) + lane + 64 * j) = w; } }
    }
}

__device__ __forceinline__ void ph_ffn_act(const KP& p, const Fr& F, int layer) {
    const float* U = p.BIGF; const float* cw = p.ffn_cw + (size_t)layer * 3 * DFF2; const float* cb = p.ffn_cb + (size_t)layer * DFF2;
    const size_t gt = (size_t)F.bid * NTHR + F.tid, GT = (size_t)F.G * NTHR;
    const size_t total = (size_t)TS * DFF;
    for (size_t idx = gt; idx < total; idx += GT) {
        const int r = (int)(idx / DFF), j = (int)(idx % DFF);
        const bool smp = r >= T; const int b = r - T;
        float c2[2];
#pragma unroll
        for (int half = 0; half < 2; ++half) {
            const int ch = half * DFF + j;
            float acc = cb[ch];
#pragma unroll
            for (int k = 0; k < 3; ++k) {
                float u;
                if (!smp) { const int t = r + k - 2; u = (t >= 0) ? U[(size_t)t * DFF2 + ch] : 0.f; }
                else u = (k < 2) ? p.st_ffn[(((size_t)b * 2 + layer) * 2 + k) * DFF2 + ch] : U[(size_t)r * DFF2 + ch];
                acc += cw[k * DFF2 + ch] * u;
            }
            c2[half] = acc;
        }
        p.HFFB[idx] = (bf16)f2bf(siluf_(c2[0]) * c2[1]);
    }
    for (size_t idx = gt; idx < (size_t)2 * DFF2; idx += GT) {
        const int k = (int)(idx / DFF2), ch = (int)(idx % DFF2);
        p.out[O_FFN_P + ((size_t)layer * 2 + k) * DFF2 + ch] = U[(size_t)(T - 2 + k) * DFF2 + ch];
    }
    for (size_t idx = gt; idx < (size_t)NSMP * 2 * DFF2; idx += GT) {
        const int b = (int)(idx / (2 * DFF2)), k = (int)((idx / DFF2) % 2), ch = (int)(idx % DFF2);
        p.out[O_FFN_S + (((size_t)b * 2 + layer) * 2 + k) * DFF2 + ch] =
            (k == 0) ? p.st_ffn[(((size_t)b * 2 + layer) * 2 + 1) * DFF2 + ch] : U[(size_t)(T + b) * DFF2 + ch];
    }
}

__device__ __forceinline__ void ph_dil_prep(const KP& p, const Fr& F) {
    const float* H1 = p.BIGF;
    const size_t gt = (size_t)F.bid * NTHR + F.tid, GT = (size_t)F.G * NTHR;
    const size_t total = (size_t)TS * 2048;
    for (size_t idx = gt + (size_t)T * 2048; idx < total; idx += GT) {
        const int r = (int)(idx >> 11), c = (int)(idx & 2047);
        const bool smp = r >= T; const int pos = smp ? T : r;
        const float* row = H1 + (size_t)r * 3072;
        const int i = c & 63; const float2 cs = p.ROPE[pos * 32 + (i & 31)];
        const float v = rope_val(row, c & ~63, i, cs);
        if (c < 1024) p.QD[(size_t)r * 1024 + c] = v; else p.KD[(size_t)r * 1024 + (c - 1024)] = v;
    }
}
__device__ __forceinline__ void ph_dil_cache(const KP& p, const Fr& F) {
    const float* H1 = p.BIGF;
    const size_t gt = (size_t)F.bid * NTHR + F.tid, GT = (size_t)F.G * NTHR;
    const size_t tots4 = (size_t)NSMP * 2048 * 512;
    for (size_t idx = gt; idx < tots4; idx += GT) {
        const int b = (int)(idx / (2048 * 512)); const int i = (int)((idx / 512) % 2048); const int c4 = (int)(idx % 512);
        float4 v;
        if (i < 2047) v = ((const float4*)p.st_dil)[((size_t)b * 2048 + i + 1) * 512 + c4];
        else { const int c = c4 * 4; const int r = T + b;
               v = (c < 1024) ? *(const float4*)(p.KD + (size_t)r * 1024 + c) : *(const float4*)(H1 + (size_t)r * 3072 + 2048 + (c - 1024)); }
        ((float4*)(p.out + O_DIL_S))[idx] = v;
    }
}
__device__ __forceinline__ void ph_dil_attn(const KP& p, const Fr& F) {
    const float* H1 = p.BIGF; const int lane = F.lane;
    float* qs = (float*)(F.lds + F.wave * 4096); float* sc = qs + 64;
    float* ex = (float*)(F.lds + 32768);
    const int il = F.wave / 3, gi = F.wave - 3 * il;
    const int item = F.bid * 2 + il; const int b = item >> 4, h = item & 15, r = T + b;
    if (F.wave < 6 && item < NSMP * 16) {
        qs[lane] = p.QD[(size_t)r * 1024 + h * 64 + lane];
        wave_lds_sync();
        const int dd = gi == 0 ? 1 : (gi == 1 ? 4 : 16);
        auto kf = [&](int j, const float*& kp, const float*& vp) -> bool {
            const int pos = T - j * dd;
            if (pos == T) { kp = p.KD + (size_t)r * 1024 + h * 64; vp = H1 + (size_t)r * 3072 + 2048 + h * 64; return true; }
            const float* base = p.st_dil + ((size_t)b * 2048 + (pos - (T - 2048))) * 2048;
            kp = base + h * 64; vp = base + 1024 + h * 64; return true; };
        float o[1], den[1], mx[1];
        wave_attend<1>(qs, sc, 448, 129, kf, o, den, lane, mx);
        float* e = ex + (il * 3 + gi) * 68;
        e[lane] = o[0] * den[0]; if (lane == 0) { e[64] = mx[0]; e[65] = den[0]; }
    }
    __syncthreads();
    if (F.wave < 6 && gi == 0 && item < NSMP * 16) {
        const float* e = ex + il * 3 * 68;
        const float m0 = e[64], m1 = e[68 + 64], m2 = e[136 + 64]; const float M = fmaxf(m0, fmaxf(m1, m2));
        const float w0 = expf(m0 - M), w1 = expf(m1 - M), w2 = expf(m2 - M);
        const float num = w0 * e[lane] + w1 * e[68 + lane] + w2 * e[136 + lane], dn = w0 * e[65] + w1 * e[68 + 65] + w2 * e[136 + 65];
        p.MIXB[(size_t)r * 1024 + h * 64 + lane] = (bf16)f2bf(num / dn);
    }
}

__device__ __forceinline__ void ph_dil_prep_fast(const KP& p, const Fr& F) {
    const float* H1 = p.BIGF;
    const size_t gt = (size_t)F.bid * NTHR + F.tid, GT = (size_t)F.G * NTHR;
    for (size_t idx = gt; idx < (size_t)T * 128; idx += GT) {
        const int t = (int)(idx >> 7), u = (int)(idx & 127);
        const int hq = u >> 2, d0 = (u & 3) * 8, c0 = hq * 64 + d0; const bf16* row = p.H1B + (size_t)t * 3072;
        const v4u ua = *(const v4u*)(row + c0), ub = *(const v4u*)(row + c0 + 32);
        const float4* rp = (const float4*)(p.ROPE + t * 32 + d0); const float4 r0 = rp[0], r1 = rp[1], r2 = rp[2], r3 = rp[3];
        float x1[8], x2[8];
#pragma unroll
        for (int e = 0; e < 4; ++e) { x1[2 * e] = __uint_as_float(ua[e] << 16); x1[2 * e + 1] = __uint_as_float(ua[e] & 0xffff0000u); x2[2 * e] = __uint_as_float(ub[e] << 16); x2[2 * e + 1] = __uint_as_float(ub[e] & 0xffff0000u); }
        const float cs[8] = {r0.x, r0.z, r1.x, r1.z, r2.x, r2.z, r3.x, r3.z}, sn[8] = {r0.y, r0.w, r1.y, r1.w, r2.y, r2.w, r3.y, r3.w};
        float lo[8], hi[8];
#pragma unroll
        for (int j = 0; j < 8; ++j) { lo[j] = x1[j] * cs[j] - x2[j] * sn[j]; hi[j] = x2[j] * cs[j] + x1[j] * sn[j]; }
        if (hq < 16) {
            v4u o; o.x = pk2(lo[0] * QSCALE, lo[1] * QSCALE); o.y = pk2(lo[2] * QSCALE, lo[3] * QSCALE); o.z = pk2(lo[4] * QSCALE, lo[5] * QSCALE); o.w = pk2(lo[6] * QSCALE, lo[7] * QSCALE);
            *(v4u*)(p.QDB + (size_t)t * 1024 + c0) = o;
            o.x = pk2(hi[0] * QSCALE, hi[1] * QSCALE); o.y = pk2(hi[2] * QSCALE, hi[3] * QSCALE); o.z = pk2(hi[4] * QSCALE, hi[5] * QSCALE); o.w = pk2(hi[6] * QSCALE, hi[7] * QSCALE);
            *(v4u*)(p.QDB + (size_t)t * 1024 + c0 + 32) = o;
        } else {
            const int h = hq - 16, kc = h * 64 + d0;
            v4u ol, oh; ol.x = pk2(lo[0], lo[1]); ol.y = pk2(lo[2], lo[3]); ol.z = pk2(lo[4], lo[5]); ol.w = pk2(lo[6], lo[7]);
            oh.x = pk2(hi[0], hi[1]); oh.y = pk2(hi[2], hi[3]); oh.z = pk2(hi[4], hi[5]); oh.w = pk2(hi[6], hi[7]);
#pragma unroll
            for (int pass = 0; pass < 3; ++pass) { const int sh = 2 * pass; const int pi = (t & ((1 << sh) - 1)) * (T >> sh) + (t >> sh);
                bf16* kb = (pass == 0 ? p.DKF[0] : pass == 1 ? p.DKF[1] : p.DKF[2]) + (size_t)h * T * 64;
                *(v4u*)(kb + kfrag_elem(pi, d0)) = ol; *(v4u*)(kb + kfrag_elem(pi, d0 + 32)) = oh; }
            if (t >= T - 2048) { float* op = p.out + O_DIL_P + (size_t)(t - (T - 2048)) * 2048 + kc;
                *(float4*)op = make_float4(lo[0], lo[1], lo[2], lo[3]); *(float4*)(op + 4) = make_float4(lo[4], lo[5], lo[6], lo[7]);
                *(float4*)(op + 32) = make_float4(hi[0], hi[1], hi[2], hi[3]); *(float4*)(op + 36) = make_float4(hi[4], hi[5], hi[6], hi[7]); }
        }
    }
    for (size_t idx = gt; idx < (size_t)2048 * 256; idx += GT) {
        const int i = (int)(idx >> 8), c4 = (int)(idx & 255);
        const uint2 uv = *(const uint2*)(p.H1B + (size_t)(T - 2048 + i) * 3072 + 2048 + c4 * 4);
        *(float4*)(p.out + O_DIL_P + (size_t)i * 2048 + 1024 + c4 * 4) = make_float4(__uint_as_float(uv.x << 16), __uint_as_float(uv.x & 0xffff0000u), __uint_as_float(uv.y << 16), __uint_as_float(uv.y & 0xffff0000u));
    }
    const int lane = F.lane, l15 = lane & 15, grp = lane >> 4;
    for (int unit = F.gw; unit < 3 * 16 * 512; unit += F.NGW) {
        const int st = unit & 511, h = (unit >> 9) & 15, pass = unit >> 13; const int sh = 2 * pass, Td = T >> sh;
        const int pi0 = 32 * st, r = pi0 / Td, s0 = pi0 - r * Td;
        bf16* dst = p.DVF[pass] + (size_t)h * T * 64;
#pragma unroll
        for (int dt = 0; dt < 4; ++dt) {
            unsigned v[8];
#pragma unroll
            for (int j = 0; j < 8; ++j) { const int s = s0 + 16 * (j >> 2) + 4 * grp + (j & 3); const int t = (s << sh) + r;
                v[j] = p.H1B[(size_t)t * 3072 + 2048 + h * 64 + 16 * dt + l15]; }
            v4u o; o.x = v[0] | (v[1] << 16); o.y = v[2] | (v[3] << 16); o.z = v[4] | (v[5] << 16); o.w = v[6] | (v[7] << 16);
            *(v4u*)(dst + vfrag_off(st, dt, lane)) = o;
        }
    }
}

__device__ __forceinline__ void dil_pass(const KP& p, int unit, int pass, unsigned char* ldsb, int w4, int lane) {
    asm volatile("" : "+v"(lane));
    const int h = unit & 15, P0 = (unit >> 4) * 256;
    const int l15 = lane & 15, grp = lane >> 4;
    float* stO = (float*)ldsb; float* stML = stO + 256 * 64;
    {
        const int sh = 2 * pass, Td = T >> sh;
        const bf16* KF = (pass == 0 ? p.DKF[0] : pass == 1 ? p.DKF[1] : p.DKF[2]) + (size_t)h * T * 64;
        const bf16* VF = (pass == 0 ? p.DVF[0] : pass == 1 ? p.DVF[1] : p.DVF[2]) + (size_t)h * T * 64;
        for (int tt = 0; tt < 4; ++tt) {
            const int tl = 4 * w4 + tt;
            const int r = tl >> (4 - sh), s0 = (P0 >> sh) + 16 * (tl & ((16 >> sh) - 1));
            const int sq = s0 + l15, tq = (sq << sh) + r, tloc = tq - P0;
            bf16x8 qf[2];
#pragma unroll
            for (int ks = 0; ks < 2; ++ks) qf[ks] = *(const bf16x8*)(p.QDB + (size_t)tq * 1024 + h * 64 + 32 * ks + 8 * grp);
            AttW a;
            if (pass == 0) attw_init(a);
            else {
#pragma unroll
                for (int dt = 0; dt < 4; ++dt) a.o[dt] = *(const f32x4*)(stO + tloc * 64 + 16 * dt + 4 * grp);
                a.m = stML[tloc * 2]; a.l = (grp == 0) ? stML[tloc * 2 + 1] : 0.f;
            }
            int kstart = s0 - 128; if (kstart < 0) kstart = 0; kstart &= ~31;
            const int nsteps = (s0 + 16 - kstart + 31) >> 5;
            const int base = r * Td;
            bf16x8 kf[3][2][2], vf[3][4];
            auto issue = [&](int s, int buf) {
                const int k0 = kstart + 32 * s;
#pragma unroll
                for (int tl2 = 0; tl2 < 2; ++tl2)
#pragma unroll
                    for (int ks = 0; ks < 2; ++ks) kf[buf][tl2][ks] = *(const bf16x8*)(KF + kfrag_off(((base + k0) >> 4) + tl2, ks, lane));
#pragma unroll
                for (int dt = 0; dt < 4; ++dt) vf[buf][dt] = *(const bf16x8*)(VF + vfrag_off((base + k0) >> 5, dt, lane));
            };
            issue(0, 0); if (nsteps > 1) issue(1, 1);
#pragma unroll
            for (int s = 0; s < 5; ++s) {
                if (s < nsteps) {
                    if (s + 2 < nsteps) issue(s + 2, (s + 2) % 3);
                    const int k0 = kstart + 32 * s;
                    f32x4 s0v, s1v; qk_step(kf[s % 3], qf, s0v, s1v);
                    if ((k0 + 31 > s0) || (k0 < s0 + 15 - 128)) {
                        const int pb = k0 + 4 * grp;
#pragma unroll
                        for (int i = 0; i < 4; ++i) { const int p0 = pb + i, p1 = pb + 16 + i;
                            if (p0 > sq || p0 < sq - 128) s0v[i] = -INFINITY; if (p1 > sq || p1 < sq - 128) s1v[i] = -INFINITY; }
                    }
                    att_update(a, s0v, s1v, vf[s % 3]);
                }
            }
            const float lt = grp_sum(a.l);
            if (pass < 2) {
#pragma unroll
                for (int dt = 0; dt < 4; ++dt) *(f32x4*)(stO + tloc * 64 + 16 * dt + 4 * grp) = a.o[dt];
                if (grp == 0) { stML[tloc * 2] = a.m; stML[tloc * 2 + 1] = lt; }
            } else {
                const float il = lt > 0.f ? 1.f / lt : 0.f;
#pragma unroll
                for (int dt = 0; dt < 4; ++dt) { uint2 o; o.x = pk2(a.o[dt][0] * il, a.o[dt][1] * il); o.y = pk2(a.o[dt][2] * il, a.o[dt][3] * il);
                    *(uint2*)(p.MIXB + (size_t)tq * 1024 + h * 64 + 16 * dt + 4 * grp) = o; }
            }
        }
    }
}
__device__ __forceinline__ void ph_dil_combo(const KP& p, const Fr& F) {
    const float* H1 = p.BIGF; const int lane = F.lane;
    const int cw = F.bid * 4 + F.wave;
#pragma unroll 1
    for (int u = 0; u < 4; ++u) {
#pragma unroll
        for (int pass = 0; pass < 3; ++pass) {
            if (F.wave >= 4) dil_pass(p, F.bid + u * F.G, pass, F.lds, F.wave - 4, lane);
            else {
                const int ci = u * 3 + pass;
                const int g0 = ci * 2 + (ci < 8 ? ci : 8), g1 = g0 + 2 + (ci < 8 ? 1 : 0);
                auto srcp = [&](int itn) -> const float4* {
                    const size_t idx = ((size_t)itn * 1024 + cw) * 64 + lane;
                    const int b = (int)(idx >> 20), i = (int)((idx >> 9) & 2047), c4 = (int)(idx & 511);
                    const int c = c4 * 4, r = T + b;
                    const float4* s_old = ((const float4*)p.st_dil) + ((size_t)b * 2048 + (i < 2047 ? i + 1 : 2047)) * 512 + c4;
                    const float4* s_new = (c < 1024) ? (const float4*)(p.KD + (size_t)r * 1024 + c) : (const float4*)(H1 + (size_t)r * 3072 + 2048 + (c - 1024));
                    return (i == 2047) ? s_new : s_old; };
                float4* dstp = (float4*)(p.out + O_DIL_S) + (size_t)cw * 64 + lane;
#pragma unroll 1
                for (int gi = g0; gi < g1; ++gi) {
                    const int i0 = gi * 16;
                    const float4 v0 = *srcp(i0), v1 = *srcp(i0 + 1), v2 = *srcp(i0 + 2), v3 = *srcp(i0 + 3), v4 = *srcp(i0 + 4), v5 = *srcp(i0 + 5), v6 = *srcp(i0 + 6), v7 = *srcp(i0 + 7);
                    const float4 v8 = *srcp(i0 + 8), v9 = *srcp(i0 + 9), v10 = *srcp(i0 + 10), v11 = *srcp(i0 + 11), v12 = *srcp(i0 + 12), v13 = *srcp(i0 + 13), v14 = *srcp(i0 + 14), v15 = *srcp(i0 + 15);
                    float4* d = dstp + (size_t)i0 * 65536;
                    d[0] = v0; d[65536] = v1; d[2 * 65536] = v2; d[3 * 65536] = v3; d[4 * 65536] = v4; d[5 * 65536] = v5; d[6 * 65536] = v6; d[7 * 65536] = v7;
                    d[8 * 65536] = v8; d[9 * 65536] = v9; d[10 * 65536] = v10; d[11 * 65536] = v11; d[12 * 65536] = v12; d[13 * 65536] = v13; d[14 * 65536] = v14; d[15 * 65536] = v15;
                }
            }
            __syncthreads();
        }
    }
}

constexpr int NPHASE = 21;
__global__ void __launch_bounds__(NTHR, 2) mega(KP p) {
    extern __shared__ __attribute__((aligned(16))) unsigned char lds[];
    Fr F; F.lds = lds; F.tid = threadIdx.x; F.lane = 0; F.wave = __builtin_amdgcn_readfirstlane(F.tid >> 6);
    F.bid = blockIdx.x; F.G = gridDim.x; F.gw = F.bid * NWAVES + F.wave; F.NGW = F.G * NWAVES; F.tgt = F.bid * NTHR + F.tid; F.tGT = F.G * NTHR;
    for (int u = F.tid; u < (LDS_BYTES - RING_BYTES) / 4; u += NTHR) ((unsigned*)(lds + RING_BYTES))[u] = 0u;
    __syncthreads();
    XcdBarrier bar; bar.bar = p.ctl + 4096; bar.x = 0; bar.st = nullptr;
    if (!MK_PER_PHASE) bar = xcd_barrier_post(p.ctl + 4096, (volatile LAS unsigned*)(lds + MISC_OFF + 32));
    const int lo = p.ph_lo, hi = p.ph_hi;
#define IN(k) (lo <= (k) && (k) < hi)

    int ph = 0;
#if PROBE_ON
#define PROBE_STAMP(k) do { if (blockIdx.x == 0 && threadIdx.x == 0) ((unsigned long long*)(p.ctl + 65536))[k] = __builtin_amdgcn_s_memrealtime(); } while (0)
#define PROBE_STAMPB(k, blk) do { if (blockIdx.x == (blk) && threadIdx.x == 0) ((unsigned long long*)(p.ctl + 65536))[k] = __builtin_amdgcn_s_memrealtime(); } while (0)
    PROBE_STAMP(0);
#else
#define PROBE_STAMP(k) do { } while (0)
#define PROBE_STAMPB(k, blk) do { } while (0)
#endif
#define PHASE(...) do { { unsigned t_ = threadIdx.x; asm volatile("" : "+v"(t_)); F.lane = (int)(t_ & 63u); } if (IN(ph)) { __VA_ARGS__ } if (IN(ph) && IN(ph + 1)) xcd_barrier(bar); ++ph; PROBE_STAMP(ph); } while (0)
    PHASE(ph_prologue(p, F););
    PHASE(if (F.bid >= F.G / 2) { ph_cmp_samples(p, F); ph_gemm_h0(p, F); } else { ph_gemm_h0(p, F); ph_cmp_samples(p, F); });
    PHASE(ph_prep_chunks(p, F););
    PHASE(ph_mix_a(p, F););
    PHASE(ph_mix_b(p, F););
    PHASE(ph_gdn_out(p, F););
    PHASE(ph_gemm_bf16(F, p.MIXB, p.WT_OA, DM, p.MOB););
    PHASE(ph_ln_b(F, p.ACTB, p.MOB, p.ln_mix_g, p.ln_mix_b, nullptr, nullptr););
    PHASE(ph_ffn_gemm(p, F, p.WT_FI0, 0););
    PHASE(ph_ffn_fix(p, F, 0););
    PHASE(ph_gemm_bf16(F, p.HFFB, p.WT_FO0, DFF, p.MOB););
    PHASE(ph_ln_b(F, p.ACTB, p.MOB, p.ln_ffn_g, p.ln_ffn_b, nullptr, nullptr););
    PHASE(ph_gemm_h1(p, F););
    PHASE(ph_dil_prep(p, F); ph_dil_prep_fast(p, F););
    PHASE(ph_dil_attn(p, F); __syncthreads(); ph_dil_combo(p, F););
    PHASE(ph_gemm_bf16(F, p.MIXB, p.WT_CO, DM, p.MOB););
    PHASE(ph_ln_b(F, p.ACTB, p.MOB, p.ln_mix_g + DM, p.ln_mix_b + DM, nullptr, nullptr););
    PHASE(ph_ffn_gemm(p, F, p.WT_FI1, 1););
    PHASE(ph_ffn_fix(p, F, 1););
    PHASE(ph_gemm_bf16(F, p.HFFB, p.WT_FO1, DFF, p.MOB););
    PHASE(ph_ln_b(F, p.ACTB, p.MOB, p.ln_ffn_g + DM, p.ln_ffn_b + DM, p.out + O_Y_P, p.out + O_Y_S););
#undef PHASE
#if PROBE_ON
    xcd_barrier(bar);
    if (blockIdx.x == 0) { __syncthreads(); const unsigned long long* pts = (const unsigned long long*)(p.ctl + 65536); const float x = (float)(pts[PROBE_B] - pts[PROBE_A]) * 1e-5f;
        for (int i = threadIdx.x; i < NSMP * DM; i += NTHR) p.out[O_Y_S + i] *= (1.f + x); }
#endif
#undef IN
}

static inline size_t align_up(size_t x) { return (x + 255) & ~(size_t)255; }

extern "C" void kernel_launch(void* const* d_in, const int* in_sizes, int n_in, void* d_out, int out_size, void* d_ws, size_t ws_size, hipStream_t stream) {
    static int grid = 0;
    if (grid == 0) {
        int dev = 0, cus = 0, per_cu = 0;
        if (hipGetDevice(&dev) != hipSuccess || hipDeviceGetAttribute(&cus, hipDeviceAttributeMultiprocessorCount, dev) != hipSuccess) { fprintf(stderr, "kernel_launch: device query failed\n"); grid = -1; return; }
        if (hipFuncSetAttribute((const void*)mega, hipFuncAttributeMaxDynamicSharedMemorySize, LDS_BYTES) != hipSuccess) { fprintf(stderr, "kernel_launch: hipFuncSetAttribute failed\n"); grid = -1; return; }
        if (hipOccupancyMaxActiveBlocksPerMultiprocessor(&per_cu, (const void*)mega, NTHR, LDS_BYTES) != hipSuccess || per_cu < 1) { fprintf(stderr, "kernel_launch: occupancy query says %d blocks per CU\n", per_cu); }
        (void)hipGetLastError();
        grid = cus;
    }
    if (grid < 0) return;
    if ((size_t)out_size != O_END) fprintf(stderr, "kernel_launch: out_size %d != expected %zu\n", out_size, (size_t)O_END);
    KP p{};
    p.x_prompt = (const float*)d_in[0]; p.x_sample = (const float*)d_in[1]; p.cache_cmp = (const float*)d_in[2]; p.cache_slc = (const float*)d_in[3];
    p.st_win = (const float*)d_in[4]; p.st_gconv = (const float*)d_in[5]; p.st_gS = (const float*)d_in[6]; p.st_dil = (const float*)d_in[7];
    p.st_ffn = (const float*)d_in[8]; p.page_table = (const int*)d_in[9]; p.w_in_a = (const float*)d_in[10]; p.cw1 = (const float*)d_in[11];
    p.cb1 = (const float*)d_in[12]; p.cw2 = (const float*)d_in[13]; p.cpe = (const float*)d_in[14]; p.gconv_w = (const float*)d_in[15];
    p.gA = (const float*)d_in[16]; p.gdt = (const float*)d_in[17]; p.gnw = (const float*)d_in[18]; p.w_out_a = (const float*)d_in[19];
    p.w_in_c = (const float*)d_in[20]; p.w_out_c = (const float*)d_in[21]; p.ln_mix_g = (const float*)d_in[22]; p.ln_mix_b = (const float*)d_in[23];
    p.ffn_w_in = (const float*)d_in[24]; p.ffn_cw = (const float*)d_in[25]; p.ffn_cb = (const float*)d_in[26]; p.ffn_w_out = (const float*)d_in[27];
    p.ln_ffn_g = (const float*)d_in[28]; p.ln_ffn_b = (const float*)d_in[29];
    p.out = (float*)d_out;
    char* ws = (char*)d_ws; size_t off = 0;
    auto alloc = [&](size_t bytes) { void* q = (void*)(ws + off); off = align_up(off + bytes); return q; };
    p.ctl = (unsigned*)alloc(1 << 20);
    p.WT_A = (bf16*)alloc((size_t)PAP * DM * 2); p.WT_OA = (bf16*)alloc((size_t)DM * DM * 2);
    p.WT_FI0 = (bf16*)alloc((size_t)DFF2 * DM * 2); p.WT_FI1 = (bf16*)alloc((size_t)DFF2 * DM * 2);
    p.WT_FO0 = (bf16*)alloc((size_t)DM * DFF * 2); p.WT_FO1 = (bf16*)alloc((size_t)DM * DFF * 2);
    p.WT_CI = (bf16*)alloc((size_t)3072 * DM * 2); p.WT_CO = (bf16*)alloc((size_t)DM * DM * 2);
    p.ROPE = (float2*)alloc((size_t)(T + 1) * 32 * 8);
    p.ACTB = (bf16*)alloc((size_t)TSP * DM * 2); p.MIXB = (bf16*)alloc((size_t)TSP * DM * 2); p.HFFB = (bf16*)alloc((size_t)TSP * DFF * 2);
    p.KS8 = (unsigned char*)alloc((size_t)2 * T * 64); p.VS8 = (unsigned char*)alloc((size_t)2 * T * 64);
    p.QB = (bf16*)alloc((size_t)T * 512 * 2); p.KSF = (bf16*)alloc((size_t)2 * T * 64 * 2); p.VSF = (bf16*)alloc((size_t)2 * T * 64 * 2);
    p.KWF = (bf16*)alloc((size_t)2 * T * 64 * 2); p.VWF = (bf16*)alloc((size_t)2 * T * 64 * 2); p.CKF = (bf16*)alloc((size_t)2 * 512 * 64 * 2); p.CVF = (bf16*)alloc((size_t)2 * 512 * 64 * 2);
    p.ACP = (bf16*)alloc((size_t)2048 * 2048 * 2);
    p.W2T = (bf16*)alloc((size_t)2 * 64 * 128 * 2);
    p.AC = nullptr; p.WT_C = (bf16*)alloc((size_t)256 * 2048 * 2); p.HID = nullptr; p.SMIXF = (float*)alloc((size_t)NSMP * 3 * 512 * 4);
    p.UB = (float*)alloc((size_t)256 * 4 * DFF2 * 4);
    p.NSACC = (float*)alloc((size_t)T * 512 * 4); p.SEL = (int*)alloc((size_t)2 * T * 16 * 4);
    p.QDB = (bf16*)alloc((size_t)T * 1024 * 2);
    for (int i = 0; i < 3; ++i) { p.DKF[i] = (bf16*)alloc((size_t)T * 1024 * 2); p.DVF[i] = (bf16*)alloc((size_t)T * 1024 * 2); }
    p.G_WF = (bf16*)alloc((size_t)2048 * 4096 * 2); p.G_KDF = (bf16*)alloc((size_t)2048 * 4096 * 2); p.G_QGF = (bf16*)alloc((size_t)2048 * 4096 * 2); p.G_QKF = (bf16*)alloc((size_t)2048 * 4096 * 2);
    p.G_SPF = (bf16*)alloc((size_t)2048 * 4096 * 2); p.G_VNF = (bf16*)alloc((size_t)2048 * 4096 * 2); p.G_UF = (float*)alloc((size_t)2048 * 4096 * 4); p.G_GL = (float*)alloc((size_t)2048 * 4);
    p.MOB = (bf16*)alloc((size_t)TSP * DM * 2); p.H1B = (bf16*)alloc((size_t)T * 3072 * 2); p.H0B = (bf16*)alloc((size_t)T * PAP * 2); p.ZF = (float*)alloc((size_t)T * 512 * 4);
    p.BIGF = (float*)alloc((size_t)TSP * DFF2 * 4); p.MO = (float*)alloc((size_t)TSP * DM * 4);
    p.X1 = (float*)alloc((size_t)TS * DM * 4); p.X2 = (float*)alloc((size_t)TS * DM * 4); p.X3 = (float*)alloc((size_t)TS * DM * 4);
    p.QR = (float*)alloc((size_t)TS * 512 * 4);
    p.KS = (float*)alloc((size_t)TS * 128 * 4); p.VS = (float*)alloc((size_t)TS * 128 * 4); p.KW = (float*)alloc((size_t)TS * 128 * 4); p.VW = (float*)alloc((size_t)TS * 128 * 4);
    p.CK = (float*)alloc((size_t)33 * 512 * 128 * 4); p.CV = (float*)alloc((size_t)33 * 512 * 128 * 4);
    p.GQ = (float*)alloc((size_t)TS * 512 * 4); p.GK = (float*)alloc((size_t)TS * 512 * 4); p.GV = (float*)alloc((size_t)TS * 512 * 4); p.OG = (float*)alloc((size_t)TS * 512 * 4);
    p.Gg = (float*)alloc((size_t)TS * 8 * 4); p.Gb = (float*)alloc((size_t)TS * 8 * 4);
    p.QD = (float*)alloc((size_t)TS * DM * 4); p.KD = (float*)alloc((size_t)TS * DM * 4);
    if (off > ws_size) { fprintf(stderr, "kernel_launch: workspace too small: need %zu have %zu\n", off, ws_size); return; }
    if (hipMemsetAsync(p.ctl, 0, 1 << 20, stream) != hipSuccess) { fprintf(stderr, "kernel_launch: memset failed\n"); return; }
#if MK_PER_PHASE
    for (int k = 0; k < NPHASE; ++k) { p.ph_lo = k; p.ph_hi = k + 1; hipLaunchKernelGGL(mega, dim3(grid), dim3(NTHR), LDS_BYTES, stream, p); }
#else
    p.ph_lo = 0; p.ph_hi = NPHASE;
    hipLaunchKernelGGL(mega, dim3(grid), dim3(NTHR), LDS_BYTES, stream, p);
#endif
    const hipError_t le = hipPeekAtLastError();
    if (le != hipSuccess) fprintf(stderr, "kernel_launch: launch failed: %s\n", hipGetErrorName(le));
}
```

```cpp
#include <hip/hip_runtime.h>
#include <cstdint>
#include <cstdio>
#include <cmath>

namespace pg8 {
#define PG8_LAS __attribute__((address_space(3)))
typedef unsigned short bf16_t;
typedef short bf16x8 __attribute__((ext_vector_type(8)));
typedef float f32x4 __attribute__((ext_vector_type(4)));
typedef unsigned u32x4 __attribute__((ext_vector_type(4)));
constexpr int BM = 256, BK = 64, HALF = 128, HTB = HALF * BK * 2  , STAGE_BYTES = 8 * HTB, NXCD = 8, WGM = 8;

__host__ __device__ __forceinline__ int lds_byte(int r, int c) { const int st = (r >> 4) * 2 + (c >> 5), rr = r & 15, cc = c & 31, ob = rr * 64 + cc * 2; return st * 1024 + (ob ^ (((ob >> 9) & 1) << 5)); }
__host__ __device__ __forceinline__ void stage_rc(int b, int& R, int& C) { const int st = b / 1024, sb = b % 1024, swz = sb ^ (((sb >> 9) & 1) << 5); R = (st >> 1) * 16 + swz / 64; C = (st & 1) * 32 + (swz % 64) / 2; }
__host__ __device__ __forceinline__ int perm32(int rho) { const int n = rho >> 4, i = rho & 15; return 8 * (i >> 2) + 4 * n + (i & 3); }

struct Unit { int pm, pn; };
struct Gemm { const bf16_t* A; const bf16_t* Bt; int M, N, K; };

struct StaticOrder {
    int nM, nN, nwg, G, c;
    __host__ __device__ void init(int M, int N, int G_, int c_) { nM = M / BM; nN = N / BM; nwg = nM * nN; G = G_; c = c_; }
    __host__ __device__ bool next(int i, Unit& u) const {
        const long L = (long)i * G + c; if (L >= nwg) return false;
        int wgid = (int)L; { const int q = nwg / NXCD, r = nwg % NXCD, xcd = wgid % NXCD, off = wgid / NXCD; wgid = (xcd < r ? xcd * (q + 1) : r * (q + 1) + (xcd - r) * q) + off; }
        const int nig = WGM * nN, gid = wgid / nig, fm = gid * WGM, gsz = (nM - fm) < WGM ? (nM - fm) : WGM;
        u.pm = fm + ((wgid % nig) % gsz); u.pn = (wgid % nig) / gsz; return true;
    }
    __device__ __forceinline__ void a_ready(const Unit&) const {}
    __device__ __forceinline__ void done(const Unit&) const {}
};

typedef __bf16 bf16x2_t __attribute__((ext_vector_type(2)));
typedef float f32x2_t __attribute__((ext_vector_type(2)));
__device__ __forceinline__ unsigned cvt_pk_bf16(float lo, float hi) { const f32x2_t v = {lo, hi}; return __builtin_bit_cast(unsigned, __builtin_convertvector(v, bf16x2_t)); }
typedef float f32x2 __attribute__((ext_vector_type(2)));
__device__ __forceinline__ f32x2 gelu_pk(f32x2 v) {
    const f32x2 av = __builtin_elementwise_abs(v), d = av * 0.2316418882f + 1.0f;
    f32x2 t; t.x = __builtin_amdgcn_rcpf(d.x); t.y = __builtin_amdgcn_rcpf(d.y);
    f32x2 q = t * 0.5307027145f + (-0.7265760135f); q = q * t + 0.7107068705f; q = q * t + (-0.142248368f); q = q * t + 0.127414796f; q = q * t;
    const f32x2 s = (v * v) * (-0.72134752044f);
    f32x2 e; e.x = __builtin_amdgcn_exp2f(s.x); e.y = __builtin_amdgcn_exp2f(s.y);
    const f32x2 m = v * (q * e), r = v - m;
    f32x2 o; o.x = v.x < 0.f ? m.x : r.x; o.y = v.y < 0.f ? m.y : r.y; return o;
}

template <int ACT  > struct EpiBf16 {
    static constexpr bool PERM = true, AFTER_DRAIN = false; static_assert(ACT == 0 || ACT == 1, "EpiBf16: ACT is 0 (none) or 1 (gelu_pk)");
    bf16_t* O; int ldc; const float* bias; int split_cols; size_t split_stride; float scale0;
    __device__ __forceinline__ void operator()(const f32x4 (&acc)[2][2][4][2], const Unit& u, int wr, int wc, int fr, int fq) const {
        const int row0 = u.pm * BM + wr * 64 + fr; int colt = u.pn * BM; bf16_t* base = O;
        float sc = 1.f; if (split_cols) { const int t = colt / split_cols; base += (size_t)t * split_stride; colt -= t * split_cols; if (t == 0) sc = scale0; }
        const int col0 = colt + wc * 32 + 8 * fq, bcol0 = u.pn * BM + wc * 32 + 8 * fq;
        f32x4 bv[2][2];
#pragma unroll
        for (int bj = 0; bj < 2; ++bj)
#pragma unroll
            for (int n = 0; n < 2; ++n) bv[bj][n] = bias ? *(const f32x4*)(bias + bcol0 + bj * HALF + 4 * n) : (f32x4){0.f, 0.f, 0.f, 0.f};
#pragma unroll
        for (int ai = 0; ai < 2; ++ai)
#pragma unroll
            for (int m = 0; m < 4; ++m) { bf16_t* rowp = base + (size_t)(row0 + ai * HALF + m * 16) * ldc + col0;
#pragma unroll
                for (int bj = 0; bj < 2; ++bj) { f32x4 v0 = acc[ai][bj][m][0] + bv[bj][0], v1 = acc[ai][bj][m][1] + bv[bj][1];
                    if (ACT == 1) { f32x2 a = gelu_pk((f32x2){v0[0], v0[1]}), b = gelu_pk((f32x2){v0[2], v0[3]}), c = gelu_pk((f32x2){v1[0], v1[1]}), d = gelu_pk((f32x2){v1[2], v1[3]});
                        v0 = (f32x4){a.x, a.y, b.x, b.y}; v1 = (f32x4){c.x, c.y, d.x, d.y}; }
                    v0 = v0 * sc; v1 = v1 * sc; u32x4 w; w.x = cvt_pk_bf16(v0[0], v0[1]); w.y = cvt_pk_bf16(v0[2], v0[3]); w.z = cvt_pk_bf16(v1[0], v1[1]); w.w = cvt_pk_bf16(v1[2], v1[3]);
                    *(u32x4*)(rowp + bj * HALF) = w; } }
    }
};

struct EpiF32 {
    static constexpr bool PERM = false, AFTER_DRAIN = false;
    float* O; int ldc; int ncols;
    __device__ __forceinline__ void operator()(const f32x4 (&acc)[2][2][4][2], const Unit& u, int wr, int wc, int fr, int fq) const {
        const int row0 = u.pm * BM + wr * 64 + fr; const int col0 = u.pn * BM + wc * 32 + 4 * fq;
#pragma unroll
        for (int ai = 0; ai < 2; ++ai)
#pragma unroll
            for (int m = 0; m < 4; ++m) { float* rowp = O + (size_t)(row0 + ai * HALF + m * 16) * ldc;
#pragma unroll
                for (int bj = 0; bj < 2; ++bj)
#pragma unroll
                    for (int n = 0; n < 2; ++n) { const int c = col0 + bj * HALF + n * 16; if (c < ncols) *(f32x4*)(rowp + c) = acc[ai][bj][m][n]; } }
    }
};
template <class Epi, class Sched, bool ALIGN_EPI = false, bool SP2 = false>
__device__ __forceinline__ void gemm_phase(PG8_LAS unsigned char* lds, const Gemm g, const Sched& S, const Epi& E) {
    const int tid = threadIdx.x, wid = __builtin_amdgcn_readfirstlane(tid >> 6), lane = tid & 63, wr = wid >> 2, wc = wid & 3, fr = lane & 15, fq = lane >> 4;
    const int K = g.K, nt = K / BK;
    unsigned voffA[2], voffB[2];
#pragma unroll
    for (int i = 0; i < 2; ++i) { int R, C; stage_rc(tid * 16 + i * 8192, R, C); const int Rb = Epi::PERM ? ((R & ~31) + perm32(R & 31)) : R;
        voffA[i] = (unsigned)(R * K + C) * 2u; voffB[i] = (unsigned)(Rb * K + C) * 2u; }
    const size_t kstep = (size_t)(BK * 2);
    const size_t hstep = (size_t)HALF * K * 2;
    const size_t tstep = 2 * hstep;
    const unsigned ldsw = (unsigned)wid * 1024u;
    const int aoff = lds_byte(wr * 64 + fr, fq * 8), boff = lds_byte(wc * 32 + fr, fq * 8);
#define PG8_SA(b, h) (((b) * 2 + (h)) * HTB)
#define PG8_SB(b, h) ((4 + (b) * 2 + (h)) * HTB)
#define PG8_STAGE(bufoff, gbase, voff) do { _Pragma("unroll") for (int _i = 0; _i < 2; ++_i) \
        __builtin_amdgcn_global_load_lds((const unsigned*)((const char*)(gbase) + (voff)[_i]), (PG8_LAS unsigned*)(lds + (bufoff) + ldsw + _i * 8192), 16, 0, 0); } while (0)
#define PG8_LDA(dst, b, h) do { _Pragma("unroll") for (int m = 0; m < 4; ++m) _Pragma("unroll") for (int k = 0; k < 2; ++k) dst[m][k] = *(const PG8_LAS bf16x8*)(lds + PG8_SA(b, h) + aoff + m * 2048 + k * 1024); } while (0)
#define PG8_LDB(dst, b, h) do { _Pragma("unroll") for (int n = 0; n < 2; ++n) _Pragma("unroll") for (int k = 0; k < 2; ++k) dst[n][k] = *(const PG8_LAS bf16x8*)(lds + PG8_SB(b, h) + boff + n * 2048 + k * 1024); } while (0)
#define PG8_MMA(ai, bj, At, Bt) do { __builtin_amdgcn_s_setprio(1); _Pragma("unroll") for (int m = 0; m < 4; ++m) _Pragma("unroll") for (int n = 0; n < 2; ++n) _Pragma("unroll") for (int k = 0; k < 2; ++k) \
        acc[ai][bj][m][n] = __builtin_amdgcn_mfma_f32_16x16x32_bf16(Bt[n][k], At[m][k], acc[ai][bj][m][n], 0, 0, 0); __builtin_amdgcn_s_setprio(0); } while (0)
#define PG8_WAIT_V(n) asm volatile("s_waitcnt vmcnt(" #n ")" ::: "memory")
#define PG8_WAIT_L(n) asm volatile("s_waitcnt lgkmcnt(" #n ")" ::: "memory")
#define PG8_BAR __builtin_amdgcn_s_barrier()
#define PG8_SCHED __builtin_amdgcn_sched_barrier(0)
    Unit cur, nxt; int ui = 0;
    if (!S.next(0, cur)) return;
    f32x4 acc[2][2][4][2];
#pragma unroll
    for (int a = 0; a < 2; ++a)
#pragma unroll
        for (int b = 0; b < 2; ++b)
#pragma unroll
            for (int m = 0; m < 4; ++m)
#pragma unroll
                for (int n = 0; n < 2; ++n) acc[a][b][m][n] = (f32x4){0.f, 0.f, 0.f, 0.f};
    bf16x8 At[4][2], B0[2][2], B1[2][2];
    const char* cA = (const char*)g.A + (size_t)cur.pm * tstep; const char* cB = (const char*)g.Bt + (size_t)cur.pn * tstep;
    S.a_ready(cur);
    if constexpr (SP2) {
        PG8_STAGE(PG8_SB(0, 0), cB, voffB); PG8_STAGE(PG8_SB(0, 1), cB + hstep, voffB); PG8_STAGE(PG8_SA(0, 0), cA, voffA); PG8_STAGE(PG8_SA(0, 1), cA + hstep, voffA);
        if (wr == 1) PG8_BAR;
        PG8_WAIT_V(2); PG8_BAR;
        PG8_STAGE(PG8_SB(1, 0), cB + kstep, voffB); PG8_STAGE(PG8_SA(1, 0), cA + kstep, voffA); PG8_STAGE(PG8_SB(1, 1), cB + hstep + kstep, voffB);
        PG8_WAIT_V(6); PG8_BAR;
    } else {
        PG8_STAGE(PG8_SB(0, 0), cB, voffB); PG8_STAGE(PG8_SA(0, 0), cA, voffA); PG8_STAGE(PG8_SB(0, 1), cB + hstep, voffB); PG8_STAGE(PG8_SA(0, 1), cA + hstep, voffA);
        if (wr == 1) PG8_BAR;
        PG8_WAIT_V(4); PG8_BAR;
        PG8_STAGE(PG8_SB(1, 0), cB + kstep, voffB); PG8_STAGE(PG8_SA(1, 0), cA + kstep, voffA); PG8_STAGE(PG8_SB(1, 1), cB + hstep + kstep, voffB);
        PG8_WAIT_V(6); PG8_BAR;
    }
    for (;;) {
        const bool has_next = S.next(ui + 1, nxt);
        const char* nA = has_next ? (const char*)g.A + (size_t)nxt.pm * tstep : cA; const char* nB = has_next ? (const char*)g.Bt + (size_t)nxt.pn * tstep : cB;
        for (int t = 0; t < nt; t += 2) {
            const bool last = (t == nt - 2);
            const char* a1 = cA + (size_t)(t + 1) * kstep;
            const char* a2 = last ? nA : cA + (size_t)(t + 2) * kstep; const char* b2 = last ? nB : cB + (size_t)(t + 2) * kstep;
            const char* a3 = a2 + kstep; const char* b3 = b2 + kstep;
            if (last && has_next) S.a_ready(nxt);
            if constexpr (SP2) {
            PG8_LDB(B0, 0, 0); PG8_LDB(B1, 0, 1); PG8_SCHED; PG8_LDA(At, 0, 0); PG8_STAGE(PG8_SA(1, 1), a1 + hstep, voffA);
            PG8_WAIT_V(8); PG8_WAIT_L(0); PG8_BAR; PG8_MMA(0, 0, At, B0); PG8_MMA(0, 1, At, B1); PG8_BAR; PG8_SCHED;
            PG8_LDA(At, 0, 1); PG8_STAGE(PG8_SB(0, 0), b2, voffB); PG8_STAGE(PG8_SB(0, 1), b2 + hstep, voffB); PG8_STAGE(PG8_SA(0, 0), a2, voffA);
            PG8_WAIT_V(8); PG8_WAIT_L(0); PG8_BAR; PG8_MMA(1, 0, At, B0); PG8_MMA(1, 1, At, B1); PG8_BAR; PG8_SCHED;
            PG8_LDB(B0, 1, 0); PG8_LDB(B1, 1, 1); PG8_SCHED; PG8_LDA(At, 1, 0); PG8_STAGE(PG8_SA(0, 1), a2 + hstep, voffA);
            PG8_WAIT_V(8); PG8_WAIT_L(0); PG8_BAR; PG8_MMA(0, 0, At, B0); PG8_MMA(0, 1, At, B1); PG8_BAR; PG8_SCHED;
            PG8_LDA(At, 1, 1); PG8_STAGE(PG8_SB(1, 0), b3, voffB); PG8_STAGE(PG8_SB(1, 1), b3 + hstep, voffB); PG8_STAGE(PG8_SA(1, 0), a3, voffA);
            PG8_WAIT_V(8); PG8_WAIT_L(0); PG8_BAR; PG8_MMA(1, 0, At, B0); PG8_MMA(1, 1, At, B1); PG8_BAR; PG8_SCHED;
            } else {
            PG8_LDB(B0, 0, 0); PG8_SCHED; PG8_LDA(At, 0, 0); PG8_STAGE(PG8_SA(1, 1), a1 + hstep, voffA);
            PG8_WAIT_L(8); PG8_BAR; PG8_WAIT_L(0); PG8_MMA(0, 0, At, B0); PG8_BAR; PG8_SCHED;
            PG8_LDB(B1, 0, 1); PG8_STAGE(PG8_SB(0, 0), b2, voffB);
            PG8_BAR; PG8_WAIT_L(0); PG8_MMA(0, 1, At, B1); PG8_BAR;
            PG8_LDA(At, 0, 1); PG8_STAGE(PG8_SA(0, 0), a2, voffA);
            PG8_BAR; PG8_WAIT_L(0); PG8_MMA(1, 0, At, B0); PG8_BAR; PG8_SCHED;
            PG8_STAGE(PG8_SB(0, 1), b2 + hstep, voffB);
            PG8_WAIT_V(6); PG8_BAR; PG8_MMA(1, 1, At, B1); PG8_BAR;
            PG8_LDB(B0, 1, 0); PG8_SCHED; PG8_LDA(At, 1, 0); PG8_STAGE(PG8_SA(0, 1), a2 + hstep, voffA);
            PG8_WAIT_L(8); PG8_BAR; PG8_WAIT_L(0); PG8_MMA(0, 0, At, B0); PG8_BAR; PG8_SCHED;
            PG8_LDB(B1, 1, 1); PG8_STAGE(PG8_SB(1, 0), b3, voffB);
            PG8_BAR; PG8_WAIT_L(0); PG8_MMA(0, 1, At, B1); PG8_BAR;
            PG8_LDA(At, 1, 1); PG8_STAGE(PG8_SA(1, 0), a3, voffA);
            PG8_BAR; PG8_WAIT_L(0); PG8_MMA(1, 0, At, B0); PG8_BAR; PG8_SCHED;
            PG8_STAGE(PG8_SB(1, 1), b3 + hstep, voffB);
            PG8_WAIT_V(6); PG8_BAR; PG8_MMA(1, 1, At, B1); PG8_BAR;
            }
        }
        if constexpr (ALIGN_EPI) { if (wr == 0) PG8_BAR; }
        if constexpr (!Epi::AFTER_DRAIN) { E(acc, cur, wr, wc, fr, fq); S.done(cur); }
        if (!has_next) break;
#pragma unroll
        for (int a = 0; a < 2; ++a)
#pragma unroll
            for (int b = 0; b < 2; ++b)
#pragma unroll
                for (int m = 0; m < 4; ++m)
#pragma unroll
                    for (int n = 0; n < 2; ++n) acc[a][b][m][n] = (f32x4){0.f, 0.f, 0.f, 0.f};
        cur = nxt; cA = nA; cB = nB; ++ui;
        if constexpr (ALIGN_EPI) { if (wr == 1) PG8_BAR; }
    }
    PG8_WAIT_V(0);
    if constexpr (!ALIGN_EPI) { if (wr == 0) PG8_BAR; }
    PG8_BAR;
    if constexpr (Epi::AFTER_DRAIN) { E.fused(acc, cur, wr, wc, fr, fq, lds, wid, lane); S.done(cur); }
#undef PG8_SA
#undef PG8_SB
#undef PG8_STAGE
#undef PG8_LDA
#undef PG8_LDB
#undef PG8_MMA
#undef PG8_WAIT_V
#undef PG8_WAIT_L
#undef PG8_BAR
#undef PG8_SCHED
}
}

#define LAS __attribute__((address_space(3)))
#define XB_TMO      128
#define XB_XCNT(j)  (256  + 64 * (j))
#define XB_XSUB(j)  (1280 + 64 * (j))
#define XB_XGEN(j)  (2304 + 64 * (j))
#define XB_TOP      3328
#define XB_TOPGEN   3392
#define XCD_BAR_WORDS 3456
#define XB_SPIN_CAP (1u << 26)

__device__ __forceinline__ unsigned xb_ld(unsigned* p)              { return __hip_atomic_load(p, __ATOMIC_RELAXED, __HIP_MEMORY_SCOPE_AGENT); }
__device__ __forceinline__ unsigned xb_add(unsigned* p, unsigned v) { return __hip_atomic_fetch_add(p, v, __ATOMIC_RELAXED, __HIP_MEMORY_SCOPE_AGENT); }
__device__ __forceinline__ unsigned xb_xcc_id() { return (unsigned)__builtin_amdgcn_s_getreg((3 << 11) | 20) & 0xFu; }
#define XB_SPIN(cond, bar) do { unsigned _sp = 0; while (cond) { __builtin_amdgcn_s_sleep(1); \
    if ((++_sp & 255u) == 0u) { if (xb_ld(&(bar)[XB_TMO])) break; if (_sp > XB_SPIN_CAP) { atomicAdd(&(bar)[XB_TMO], 1u); break; } } } } while (0)

struct XcdBarrier {
    unsigned* bar; unsigned x;
    volatile LAS unsigned* st;
};

__device__ __forceinline__ XcdBarrier xcd_barrier_post(unsigned* bar, volatile LAS unsigned* st) {
    XcdBarrier b; b.bar = bar; b.x = xb_xcc_id(); b.st = st;
    if (threadIdx.x == 0) (void)xb_add(&bar[XB_XCNT(b.x)], 1u);
    return b;
}
__device__ __forceinline__ void xcd_barrier_complete(unsigned* bar, unsigned x, unsigned& nloc, unsigned& nx) {
    const unsigned G = gridDim.x * gridDim.y * gridDim.z;
    unsigned sum, cnt, mine, sp = 0u;
    for (;;) {
        sum = 0u; cnt = 0u; mine = 0u;
#pragma unroll
        for (unsigned j = 0; j < 16; ++j) { const unsigned c = xb_ld(&bar[XB_XCNT(j)]); sum += c; cnt += (c > 0u) ? 1u : 0u; mine = (j == x) ? c : mine; }
        if (sum == G) break;
        __builtin_amdgcn_s_sleep(1);
        if ((++sp & 255u) == 0u) { if (xb_ld(&bar[XB_TMO])) break; if (sp > XB_SPIN_CAP) { atomicAdd(&bar[XB_TMO], 1u); break; } }
    }
    nloc = mine > 0u ? mine : 1u; nx = cnt > 0u ? cnt : 1u;
}

__device__ __forceinline__ void xcd_barrier(const XcdBarrier& b) {
    asm volatile("s_waitcnt vmcnt(0)" ::: "memory");
    __syncthreads();
    if (threadIdx.x == 0) {
        unsigned* bar = b.bar;
        __builtin_amdgcn_s_waitcnt(0);
        unsigned nloc = b.st[0], nx = b.st[1];
        if (nloc == 0u) { xcd_barrier_complete(bar, b.x, nloc, nx); b.st[0] = nloc; b.st[1] = nx; }
        const unsigned old = xb_add(&bar[XB_XSUB(b.x)], 1u);
        const unsigned gen = old / nloc;
        if (old + 1u == (gen + 1u) * nloc) {
            __builtin_amdgcn_fence(__ATOMIC_RELEASE, "agent");
            asm volatile("s_waitcnt vmcnt(0)" ::: "memory");
            const unsigned og = xb_add(&bar[XB_TOP], 1u);
            const unsigned tg = og / nx;
            if (og + 1u == (tg + 1u) * nx) xb_add(&bar[XB_TOPGEN], 1u);
            else XB_SPIN(xb_ld(&bar[XB_TOPGEN]) == tg, bar);
            __builtin_amdgcn_fence(__ATOMIC_ACQUIRE, "agent");
            xb_add(&bar[XB_XGEN(b.x)], 1u);
            asm volatile("s_waitcnt vmcnt(0)" ::: "memory");
        } else {
            XB_SPIN(xb_ld(&bar[XB_XGEN(b.x)]) == gen, bar);
            __builtin_amdgcn_fence(__ATOMIC_ACQUIRE, "agent");
            asm volatile("s_waitcnt vmcnt(0)" ::: "memory");
        }
    }
    __syncthreads();
}

#ifndef PG8_SP2
#define PG8_SP2 true
#endif
#ifndef PG8_ALIGN
#define PG8_ALIGN true
#endif
#ifndef PROBE_ON
#define PROBE_ON 0
#define PROBE_A 0
#define PROBE_B 1
#endif
#ifndef MK_PER_PHASE
#define MK_PER_PHASE 0
#endif

constexpr int T = 16384, NSMP = 32, TS = T + NSMP, TSP = T + 256, DM = 1024;
constexpr int PA = 3368, PAP = 3584;
constexpr int C_Q = 0, C_KC = 512, C_VC = 640, C_KS = 768, C_VS = 896, C_KW = 1024, C_VW = 1152, C_GATE = 1280,
              C_GQKV = 1304, C_A = 2840, C_BT = 2848, C_Z = 2856;
constexpr int DFF = 2816, DFF2 = 5632;
constexpr float DN_ALPHA = 1.4142135623730951f;
constexpr float LN_EPS = 1e-5f, NORM_EPS = 1e-6f;
constexpr int NPAGES = 128;
constexpr int NWAVES = 8, NTHR = 512;

constexpr size_t O_Y_P = 0;
constexpr size_t O_Y_S = O_Y_P + (size_t)T * DM;
constexpr size_t O_CMP_P = O_Y_S + (size_t)NSMP * DM;
constexpr size_t O_CMP_S = O_CMP_P + (size_t)T * 256;
constexpr size_t O_SLC_P = O_CMP_S + (size_t)NSMP * 256;
constexpr size_t O_SLC_S = O_SLC_P + (size_t)T * 256;
constexpr size_t O_WIN_P = O_SLC_S + (size_t)NSMP * 256;
constexpr size_t O_WIN_S = O_WIN_P + (size_t)512 * 256;
constexpr size_t O_GCONV_P = O_WIN_S + (size_t)NSMP * 512 * 256;
constexpr size_t O_GCONV_S = O_GCONV_P + (size_t)3 * 1536;
constexpr size_t O_GS_P = O_GCONV_S + (size_t)NSMP * 3 * 1536;
constexpr size_t O_GS_S = O_GS_P + (size_t)8 * 64 * 64;
constexpr size_t O_DIL_P = O_GS_S + (size_t)NSMP * 8 * 64 * 64;
constexpr size_t O_DIL_S = O_DIL_P + (size_t)2048 * 2048;
constexpr size_t O_FFN_P = O_DIL_S + (size_t)NSMP * 2048 * 2048;
constexpr size_t O_FFN_S = O_FFN_P + (size_t)2 * 2 * DFF2;
constexpr size_t O_END = O_FFN_S + (size_t)NSMP * 2 * 2 * DFF2;

constexpr int RING_BYTES = 131072;
constexpr int FAST_WL = 17408;
constexpr int MISC_OFF = 8 * FAST_WL + 64;
constexpr int LDS_BYTES = 147456;

typedef unsigned short bf16;
typedef unsigned v4u __attribute__((ext_vector_type(4)));

__device__ __forceinline__ unsigned f2bf(float f) { return (unsigned)__builtin_bit_cast(unsigned short, (__bf16)f); }
__device__ __forceinline__ unsigned pk2(float lo, float hi) { return pg8::cvt_pk_bf16(lo, hi); }
typedef short bf16x8 __attribute__((ext_vector_type(8)));
typedef float f32x4 __attribute__((ext_vector_type(4)));
#define MFMA16(a, b, c) __builtin_amdgcn_mfma_f32_16x16x32_bf16((a), (b), (c), 0, 0, 0)
__device__ __forceinline__ float wave_sum(float v) {
#pragma unroll
    for (int o = 1; o < 64; o <<= 1) v += __shfl_xor(v, o);
    return v;
}
__device__ __forceinline__ float wave_max(float v) {
#pragma unroll
    for (int o = 1; o < 64; o <<= 1) v = fmaxf(v, __shfl_xor(v, o));
    return v;
}
__device__ __forceinline__ void wave_lds_sync() { asm volatile("s_waitcnt lgkmcnt(0)" ::: "memory"); __builtin_amdgcn_wave_barrier(); asm volatile("" ::: "memory"); }
__device__ __forceinline__ float fexp_(float x) { return __builtin_amdgcn_exp2f(x * 1.4426950408889634f); }
__device__ __forceinline__ float fsilu_(float x) { return x * __builtin_amdgcn_rcpf(1.f + fexp_(-x)); }
__device__ __forceinline__ float sigmoidf_(float x) { return 1.f / (1.f + expf(-x)); }
__device__ __forceinline__ float siluf_(float x) { return x / (1.f + expf(-x)); }
__device__ __forceinline__ float gelu_tanh(float x) { const float c = 0.7978845608028654f; return 0.5f * x * (1.f + tanhf(c * (x + 0.044715f * x * x * x))); }
__device__ __forceinline__ float softplusf_(float x) { return x > 20.f ? x : log1pf(expf(x)); }

struct KP {
    const float *x_prompt, *x_sample, *cache_cmp, *cache_slc, *st_win, *st_gconv, *st_gS, *st_dil, *st_ffn;
    const int* page_table;
    const float *w_in_a, *cw1, *cb1, *cw2, *cpe, *gconv_w, *gA, *gdt, *gnw, *w_out_a, *w_in_c, *w_out_c, *ln_mix_g, *ln_mix_b,
                *ffn_w_in, *ffn_cw, *ffn_cb, *ffn_w_out, *ln_ffn_g, *ln_ffn_b;
    float* out;
    unsigned* ctl;
    bf16 *WT_A, *WT_OA, *WT_FI0, *WT_FI1, *WT_FO0, *WT_FO1, *WT_CI, *WT_CO;
    float2* ROPE;
    bf16 *ACTB, *MIXB, *HFFB, *MOB, *H1B, *H0B; float* ZF;
    bf16 *QB, *KSF, *VSF, *KWF, *VWF, *CKF, *CVF;
    unsigned char *KS8, *VS8;
    bf16 *QDB; bf16* DKF[3]; bf16* DVF[3];
    bf16 *AC, *WT_C, *HID, *W2T, *ACP; float* SMIXF; float* NSACC; int* SEL; float* UB;
    bf16 *G_WF, *G_KDF, *G_QGF, *G_QKF, *G_SPF, *G_VNF; float *G_UF, *G_GL;
    float *BIGF, *MO, *X1, *X2, *X3, *QR, *KS, *VS, *KW, *VW, *CK, *CV, *GQ, *GK, *GV, *OG, *Gg, *Gb, *QD, *KD;
    int ph_lo, ph_hi;
};

struct Fr { unsigned char* lds; int tid, lane, wave, gw, NGW, bid, G; int tgt, tGT; };
__device__ __forceinline__ float h0f(const KP& p, int t, int c) { return __uint_as_float((unsigned)p.H0B[(size_t)t * PAP + c] << 16); }

__device__ __forceinline__ int ffn_row(int u) { const int half = u >= DFF ? 1 : 0, jc = u - half * DFF; return 256 * (jc >> 7) + 128 * half + (jc & 127); }
__device__ __forceinline__ void transpose_item(const float* W, int K, int N, int NT, bf16* WT, float* scr, int item, int lane, int rowmap = 0) {
    const int nblk = NT / 32, kb = item / nblk, nb = item % nblk, k0 = 64 * kb, n0 = 32 * nb;
#pragma unroll 8
    for (int i = 0; i < 32; ++i) { const int kk = 2 * i + (lane >> 5); const int n = n0 + (lane & 31); scr[kk * 33 + (lane & 31)] = (n < N) ? W[(size_t)(k0 + kk) * N + n] : 0.f; }
    wave_lds_sync();
    const int c = lane & 7;
#pragma unroll
    for (int j = 0; j < 4; ++j) { const int n = (lane >> 3) + 8 * j; const float* s = scr + (8 * c) * 33 + n;
        v4u o; o.x = pk2(s[0 * 33], s[1 * 33]); o.y = pk2(s[2 * 33], s[3 * 33]); o.z = pk2(s[4 * 33], s[5 * 33]); o.w = pk2(s[6 * 33], s[7 * 33]);
        const int row = rowmap ? ffn_row(n0 + n) : n0 + n;
        *(v4u*)(WT + (size_t)row * K + k0 + 8 * c) = o; }
    wave_lds_sync();
}
__device__ __forceinline__ void ph_prologue(const KP& p, const Fr& F) {
    float* scr = (float*)(F.lds + F.wave * 16384);
    const int I_A = 16 * (PAP / 32), I_OA = 16 * 32, I_FI = 16 * (DFF2 / 32), I_FO = (DFF / 64) * 32, I_CI = 16 * (3072 / 32), I_CO = 16 * 32;
    const int NITEMS = I_A + I_OA + 2 * I_FI + 2 * I_FO + I_CI + I_CO + 256 + 8;
    for (int it = F.gw; it < NITEMS; it += F.NGW) {
        int r = it;
        if (r < I_A) { transpose_item(p.w_in_a, DM, PA, PAP, p.WT_A, scr, r, F.lane); continue; } r -= I_A;
        if (r < I_OA) { transpose_item(p.w_out_a, DM, DM, DM, p.WT_OA, scr, r, F.lane); continue; } r -= I_OA;
        if (r < I_FI) { transpose_item(p.ffn_w_in, DM, DFF2, DFF2, p.WT_FI0, scr, r, F.lane, 1); continue; } r -= I_FI;
        if (r < I_FI) { transpose_item(p.ffn_w_in + (size_t)DM * DFF2, DM, DFF2, DFF2, p.WT_FI1, scr, r, F.lane, 1); continue; } r -= I_FI;
        if (r < I_FO) { transpose_item(p.ffn_w_out, DFF, DM, DM, p.WT_FO0, scr, r, F.lane); continue; } r -= I_FO;
        if (r < I_FO) { transpose_item(p.ffn_w_out + (size_t)DFF * DM, DFF, DM, DM, p.WT_FO1, scr, r, F.lane); continue; } r -= I_FO;
        if (r < I_CI) { transpose_item(p.w_in_c, DM, 3072, 3072, p.WT_CI, scr, r, F.lane); continue; } r -= I_CI;
        if (r < I_CO) { transpose_item(p.w_out_c, DM, DM, DM, p.WT_CO, scr, r, F.lane); continue; } r -= I_CO;
        if (r < 256) { const int kv = r >> 7; transpose_item(p.cw1 + (size_t)kv * 2048 * 128, 2048, 128, 128, p.WT_C + (size_t)kv * 128 * 2048, scr, r & 127, F.lane); continue; } r -= 256;
        { const int kv = r >> 2; transpose_item(p.cw2 + (size_t)kv * 128 * 64, 128, 64, 64, p.W2T + (size_t)kv * 64 * 128, scr, r & 3, F.lane); }
    }
    const size_t gt = (size_t)F.bid * NTHR + F.tid, GT = (size_t)F.G * NTHR;
    for (size_t i4 = gt; i4 < (size_t)TSP * (DM / 4); i4 += GT) {
        const int r = (int)(i4 / (DM / 4)), c4 = (int)(i4 % (DM / 4));
        float4 v = make_float4(0.f, 0.f, 0.f, 0.f);
        if (r < T) v = ((const float4*)p.x_prompt)[(size_t)r * (DM / 4) + c4]; else if (r < TS) v = ((const float4*)p.x_sample)[(size_t)(r - T) * (DM / 4) + c4];
        uint2 o; o.x = pk2(v.x, v.y); o.y = pk2(v.z, v.w);
        ((uint2*)p.ACTB)[i4] = o;
    }
    for (size_t idx = gt; idx < (size_t)(T + 1) * 32; idx += GT) {
        const int pos = (int)(idx >> 5), i = (int)(idx & 31);
        const float inv = (float)pow(10000.0, -2.0 * (double)i / 64.0);
        const float ang = (float)pos * inv;
        p.ROPE[idx] = make_float2((float)cos((double)ang), (float)sin((double)ang));
    }
}

__device__ __forceinline__ size_t vfrag_elem(int key, int d);
__device__ __forceinline__ size_t kfrag_elem(int key, int d);
__device__ __forceinline__ bf16x8 pack_p(const f32x4& p0, const f32x4& p1);
template <bool FFNMAP = false, bool OUTBF = false>
__device__ __forceinline__ void skinny_gemm(const Fr& F, const bf16* A, const bf16* Bt, int K, int ncols, float* C, int ldc) {
    const int lane = F.lane, l15 = lane & 15, grp = lane >> 4;
    const int kper = K >> 3, k0 = F.wave * kper;
    const bf16* a0 = A + (size_t)(T + l15) * K + 8 * grp + k0; const bf16* a1 = a0 + (size_t)16 * K;
    f32x4* red = (f32x4*)F.lds;
    const int ntiles = (ncols + 15) >> 4;
    for (int nt = F.bid; nt < ntiles; nt += F.G) {
        const bf16* bp = Bt + (size_t)(nt * 16 + l15) * K + 8 * grp + k0;
        f32x4 c0 = {0.f, 0.f, 0.f, 0.f}, c1 = {0.f, 0.f, 0.f, 0.f};
#pragma unroll 4
        for (int k = 0; k < kper; k += 32) {
            const bf16x8 b = *(const bf16x8*)(bp + k), x0 = *(const bf16x8*)(a0 + k), x1 = *(const bf16x8*)(a1 + k);
            c0 = MFMA16(x0, b, c0); c1 = MFMA16(x1, b, c1);
        }
        red[(F.wave * 2 + 0) * 64 + lane] = c0; red[(F.wave * 2 + 1) * 64 + lane] = c1;
        __syncthreads();
        if (F.wave == 0) {
#pragma unroll
            for (int w = 1; w < 8; ++w) { c0 = c0 + red[(w * 2 + 0) * 64 + lane]; c1 = c1 + red[(w * 2 + 1) * 64 + lane]; }
            int n = nt * 16 + l15;
            if (FFNMAP) n = ((n >> 7) & 1) * DFF + (n >> 8) * 128 + (n & 127);
            if (n < ncols) {
#pragma unroll
                for (int r = 0; r < 4; ++r) {
                    if (OUTBF) { ((bf16*)C)[(size_t)(T + 4 * grp + r) * ldc + n] = (bf16)f2bf(c0[r]); ((bf16*)C)[(size_t)(T + 16 + 4 * grp + r) * ldc + n] = (bf16)f2bf(c1[r]); }
                    else { C[(size_t)(T + 4 * grp + r) * ldc + n] = c0[r]; C[(size_t)(T + 16 + 4 * grp + r) * ldc + n] = c1[r]; } }
            }
        }
        __syncthreads();
    }
}
__device__ __forceinline__ void ph_gemm_f32(const Fr& F, const bf16* A, const bf16* Bt, int N, int K, float* C, int ldc, int ncols) {
    skinny_gemm(F, A, Bt, K, ncols, C, ldc);
    pg8::Gemm g{A, Bt, T, N, K}; pg8::StaticOrder S; S.init(T, N, F.G, F.bid);
    pg8::EpiF32 E{C, ldc, ncols};
    pg8::gemm_phase<pg8::EpiF32, pg8::StaticOrder, PG8_ALIGN, PG8_SP2>((PG8_LAS unsigned char*)F.lds, g, S, E);
}
__device__ __forceinline__ void ph_gemm_h1(const KP& p, const Fr& F) {
    skinny_gemm(F, p.ACTB, p.WT_CI, DM, 3072, p.BIGF, 3072);
    pg8::Gemm g{p.ACTB, p.WT_CI, T, 3072, DM}; pg8::StaticOrder S; S.init(T, 3072, F.G, F.bid);
    pg8::EpiBf16<0> E{p.H1B, 3072, nullptr, 0, 0, 1.f};
    pg8::gemm_phase<pg8::EpiBf16<0>, pg8::StaticOrder, PG8_ALIGN, PG8_SP2>((PG8_LAS unsigned char*)F.lds, g, S, E);
}
__device__ __forceinline__ void ph_gemm_h0(const KP& p, const Fr& F) {
    skinny_gemm(F, p.ACTB, p.WT_A, DM, PA, p.BIGF, PA);
    pg8::Gemm g{p.ACTB, p.WT_A, T, PAP, DM}; pg8::StaticOrder S; S.init(T, PAP, F.G, F.bid);
    pg8::EpiBf16<0> E{p.H0B, PAP, nullptr, 0, 0, 1.f};
    pg8::gemm_phase<pg8::EpiBf16<0>, pg8::StaticOrder, PG8_ALIGN, PG8_SP2>((PG8_LAS unsigned char*)F.lds, g, S, E);
}
__device__ __forceinline__ void ph_gemm_bf16(const Fr& F, const bf16* A, const bf16* Bt, int K, bf16* C) {
    skinny_gemm<false, true>(F, A, Bt, K, DM, (float*)C, DM);
    pg8::Gemm g{A, Bt, T, DM, K}; pg8::StaticOrder S; S.init(T, DM, F.G, F.bid);
    pg8::EpiBf16<0> E{C, DM, nullptr, 0, 0, 1.f};
    pg8::gemm_phase<pg8::EpiBf16<0>, pg8::StaticOrder, PG8_ALIGN, PG8_SP2>((PG8_LAS unsigned char*)F.lds, g, S, E);
}
__device__ __forceinline__ void ph_ln_b(const Fr& F, bf16* XB, const bf16* FB, const float* gam, const float* bet, float* outp, float* outs) {
    const int lane = F.lane;
    for (int r = F.gw; r < TS; r += F.NGW) {
        float v[16]; float s = 0.f;
#pragma unroll
        for (int j = 0; j < 2; ++j) {
            const v4u x = *(const v4u*)(XB + (size_t)r * DM + 512 * j + 8 * lane), f = *(const v4u*)(FB + (size_t)r * DM + 512 * j + 8 * lane);
#pragma unroll
            for (int e = 0; e < 4; ++e) {
                v[8 * j + 2 * e] = DN_ALPHA * __uint_as_float(x[e] << 16) + __uint_as_float(f[e] << 16);
                v[8 * j + 2 * e + 1] = DN_ALPHA * __uint_as_float(x[e] & 0xffff0000u) + __uint_as_float(f[e] & 0xffff0000u);
            }
        }
#pragma unroll
        for (int i = 0; i < 16; ++i) s += v[i];
        const float mean = wave_sum(s) * (1.f / DM); float q = 0.f;
#pragma unroll
        for (int i = 0; i < 16; ++i) { v[i] -= mean; q += v[i] * v[i]; }
        const float rstd = rsqrtf(wave_sum(q) * (1.f / DM) + LN_EPS);
#pragma unroll
        for (int j = 0; j < 2; ++j) {
            const int c0 = 512 * j + 8 * lane;
            const float4 g0 = *(const float4*)(gam + c0), g1 = *(const float4*)(gam + c0 + 4), b0 = *(const float4*)(bet + c0), b1 = *(const float4*)(bet + c0 + 4);
            const float y0 = v[8 * j + 0] * rstd * g0.x + b0.x, y1 = v[8 * j + 1] * rstd * g0.y + b0.y, y2 = v[8 * j + 2] * rstd * g0.z + b0.z, y3 = v[8 * j + 3] * rstd * g0.w + b0.w;
            const float y4 = v[8 * j + 4] * rstd * g1.x + b1.x, y5 = v[8 * j + 5] * rstd * g1.y + b1.y, y6 = v[8 * j + 6] * rstd * g1.z + b1.z, y7 = v[8 * j + 7] * rstd * g1.w + b1.w;
            if (outp) { float* o = ((r < T) ? outp + (size_t)r * DM : outs + (size_t)(r - T) * DM) + c0;
                *(float4*)o = make_float4(y0, y1, y2, y3); *(float4*)(o + 4) = make_float4(y4, y5, y6, y7); }
            else { v4u w; w.x = pk2(y0, y1); w.y = pk2(y2, y3); w.z = pk2(y4, y5); w.w = pk2(y6, y7); *(v4u*)(XB + (size_t)r * DM + c0) = w; }
        }
    }
}
__device__ __forceinline__ float dpp_ror1(float x) { return __int_as_float(__builtin_amdgcn_update_dpp(0, __float_as_int(x), 0x121, 0xf, 0xf, false)); }
__device__ __forceinline__ float dpp_ror2(float x) { return __int_as_float(__builtin_amdgcn_update_dpp(0, __float_as_int(x), 0x122, 0xf, 0xf, false)); }
struct EpiFfn {
    static constexpr bool PERM = true, AFTER_DRAIN = false;
    bf16* H; float* UB; const float* cw; const float* cb;
    __device__ __forceinline__ void operator()(const pg8::f32x4 (&acc)[2][2][4][2], const pg8::Unit& u, int wr, int wc, int fr, int fq) const {
#pragma unroll
        for (int n = 0; n < 2; ++n) {
            const int jc = u.pn * 128 + wc * 32 + 8 * fq + 4 * n;
            pg8::f32x4 w0[2], w1[2], w2[2], bb[2];
#pragma unroll
            for (int bj = 0; bj < 2; ++bj) { const int uc = bj * DFF + jc;
                w0[bj] = *(const pg8::f32x4*)(cw + uc); w1[bj] = *(const pg8::f32x4*)(cw + DFF2 + uc); w2[bj] = *(const pg8::f32x4*)(cw + 2 * DFF2 + uc); bb[bj] = *(const pg8::f32x4*)(cb + uc); }
#pragma unroll
            for (int ai = 0; ai < 2; ++ai) {
                const int sl = u.pm * 4 + ai * 2 + wr;
                pg8::f32x4 pr1[2], pr2[2];
#pragma unroll
                for (int m = 0; m < 4; ++m) {
                    pg8::f32x4 c[2];
#pragma unroll
                    for (int bj = 0; bj < 2; ++bj) {
                        const pg8::f32x4 uu = acc[ai][bj][m][n]; pg8::f32x4 r1, r2;
#pragma unroll
                        for (int e = 0; e < 4; ++e) { r1[e] = dpp_ror1(uu[e]); r2[e] = dpp_ror2(uu[e]); }
                        pg8::f32x4 p1 = r1, p2 = r2;
                        if (m > 0) { if (fr == 0) p1 = pr1[bj]; if (fr < 2) p2 = pr2[bj]; }
                        c[bj] = bb[bj] + w0[bj] * p2 + w1[bj] * p1 + w2[bj] * uu;
                        pr1[bj] = r1; pr2[bj] = r2;
                        const int uc = bj * DFF + jc;
                        if (m == 0 && fr < 2) *(pg8::f32x4*)(UB + ((size_t)sl * 4 + fr) * DFF2 + uc) = uu;
                        if (m == 3 && fr >= 14) *(pg8::f32x4*)(UB + ((size_t)sl * 4 + 2 + (fr - 14)) * DFF2 + uc) = uu;
                    }
                    if (!(m == 0 && fr < 2)) {
                        const int t = u.pm * 256 + ai * 128 + wr * 64 + m * 16 + fr;
                        uint2 o; o.x = pk2(fsilu_(c[0][0]) * c[1][0], fsilu_(c[0][1]) * c[1][1]); o.y = pk2(fsilu_(c[0][2]) * c[1][2], fsilu_(c[0][3]) * c[1][3]);
                        *(uint2*)(H + (size_t)t * DFF + jc) = o;
                    }
                }
            }
        }
    }
};
__device__ __forceinline__ void ph_ffn_gemm(const KP& p, const Fr& F, const bf16* Bt, int layer) {
    skinny_gemm<true>(F, p.ACTB, Bt, DM, DFF2, p.BIGF, DFF2);
    pg8::Gemm g{p.ACTB, Bt, T, DFF2, DM}; pg8::StaticOrder S; S.init(T, DFF2, F.G, F.bid);
    EpiFfn E{p.HFFB, p.UB, p.ffn_cw + (size_t)layer * 3 * DFF2, p.ffn_cb + (size_t)layer * DFF2};
    pg8::gemm_phase<EpiFfn, pg8::StaticOrder, PG8_ALIGN, PG8_SP2>((PG8_LAS unsigned char*)F.lds, g, S, E);
}
__device__ __forceinline__ void ph_ffn_fix(const KP& p, const Fr& F, int layer) {
    const float* cw = p.ffn_cw + (size_t)layer * 3 * DFF2; const float* cb = p.ffn_cb + (size_t)layer * DFF2; const float* U = p.BIGF;
    const int gt = F.bid * NTHR + F.tid, GT = F.G * NTHR;
    for (int idx = gt; idx < 512 * DFF; idx += GT) {
        const int rr = idx / DFF, j = idx - rr * DFF; const int sl = rr >> 1, q = rr & 1;
        float c2[2];
#pragma unroll
        for (int half = 0; half < 2; ++half) { const int ch = half * DFF + j;
            const float u0 = p.UB[((size_t)sl * 4 + q) * DFF2 + ch];
            const float um1 = q ? p.UB[((size_t)sl * 4) * DFF2 + ch] : (sl ? p.UB[((size_t)(sl - 1) * 4 + 3) * DFF2 + ch] : 0.f);
            const float um2 = sl ? p.UB[((size_t)(sl - 1) * 4 + 2 + q) * DFF2 + ch] : 0.f;
            c2[half] = cb[ch] + cw[ch] * um2 + cw[DFF2 + ch] * um1 + cw[2 * DFF2 + ch] * u0; }
        p.HFFB[(size_t)(64 * sl + q) * DFF + j] = (bf16)f2bf(siluf_(c2[0]) * c2[1]);
    }
    for (int idx = gt; idx < NSMP * DFF; idx += GT) {
        const int b = idx / DFF, j = idx - b * DFF;
        float c2[2];
#pragma unroll
        for (int half = 0; half < 2; ++half) { const int ch = half * DFF + j;
            const float* hs = p.st_ffn + (((size_t)b * 2 + layer) * 2) * DFF2 + ch;
            c2[half] = cb[ch] + cw[ch] * hs[0] + cw[DFF2 + ch] * hs[DFF2] + cw[2 * DFF2 + ch] * U[(size_t)(T + b) * DFF2 + ch]; }
        p.HFFB[(size_t)(T + b) * DFF + j] = (bf16)f2bf(siluf_(c2[0]) * c2[1]);
    }
    for (int idx = gt; idx < 2 * DFF2; idx += GT) { const int k = idx / DFF2, ch = idx - k * DFF2;
        p.out[O_FFN_P + ((size_t)layer * 2 + k) * DFF2 + ch] = p.UB[((size_t)255 * 4 + 2 + k) * DFF2 + ch]; }
    for (int idx = gt; idx < NSMP * 2 * DFF2; idx += GT) { const int b = idx / (2 * DFF2), k = (idx / DFF2) & 1, ch = idx % DFF2;
        p.out[O_FFN_S + (((size_t)b * 2 + layer) * 2 + k) * DFF2 + ch] = (k == 0) ? p.st_ffn[(((size_t)b * 2 + layer) * 2 + 1) * DFF2 + ch] : U[(size_t)(T + b) * DFF2 + ch]; }
}
struct EpiCmp {
    static constexpr bool PERM = false, AFTER_DRAIN = false;
    bf16* HID; const float* b1;
    __device__ __forceinline__ void operator()(const pg8::f32x4 (&acc)[2][2][4][2], const pg8::Unit& u, int wr, int wc, int fr, int fq) const {
#pragma unroll
        for (int ai = 0; ai < 2; ++ai)
#pragma unroll
            for (int m = 0; m < 4; ++m) { const int combo = u.pm * 128 + wr * 64 + m * 16 + fr;
#pragma unroll
                for (int n = 0; n < 2; ++n) { const int j0 = wc * 32 + n * 16 + 4 * fq; const pg8::f32x4 v = acc[ai][ai][m][n]; const float* bb = b1 + ai * 128 + j0;
                    uint2 o; o.x = pk2(gelu_tanh(v[0] + bb[0]), gelu_tanh(v[1] + bb[1])); o.y = pk2(gelu_tanh(v[2] + bb[2]), gelu_tanh(v[3] + bb[3]));
                    *(uint2*)(HID + ((size_t)combo * 2 + ai) * 128 + j0) = o; } }
    }
};
__device__ __forceinline__ void ph_cmp_gemm(const KP& p, const Fr& F) {
    pg8::Gemm g{p.AC, p.WT_C, 65536, 256, 2048}; pg8::StaticOrder S; S.init(65536, 256, F.G, F.bid);
    EpiCmp E{p.HID, p.cb1};
    pg8::gemm_phase<EpiCmp, pg8::StaticOrder, PG8_ALIGN, PG8_SP2>((PG8_LAS unsigned char*)F.lds, g, S, E);
}
__device__ __forceinline__ void ph_cmp_stage2(const KP& p, const Fr& F) {
    const int lane = F.lane, l15 = lane & 15, grp = lane >> 4;
    for (int tile = F.gw; tile < 4096; tile += F.NGW) {
        const int kv = tile & 1, combo0 = (tile >> 1) * 16;
        const bf16* hid = p.HID + ((size_t)(combo0 + l15) * 2 + kv) * 128 + 8 * grp; const bf16* w2 = p.W2T + (size_t)kv * 64 * 128 + (size_t)l15 * 128 + 8 * grp;
        f32x4 acc[4];
#pragma unroll
        for (int nt = 0; nt < 4; ++nt) acc[nt] = (f32x4){0.f, 0.f, 0.f, 0.f};
#pragma unroll
        for (int ks = 0; ks < 4; ++ks) { const bf16x8 a = *(const bf16x8*)(hid + 32 * ks);
#pragma unroll
            for (int nt = 0; nt < 4; ++nt) acc[nt] = MFMA16(a, *(const bf16x8*)(w2 + (size_t)nt * 16 * 128 + 32 * ks), acc[nt]); }
#pragma unroll
        for (int r = 0; r < 4; ++r) {
            const int combo = combo0 + 4 * grp + r; const int g = combo & 1, c = (combo >> 1) & 511, b = combo >> 10;
            float* dst = ((kv == 0) ? p.CK : p.CV) + (((size_t)(1 + b) * 512 + c) * 2 + g) * 64;
            if (kv == 0) {
                const int pos = (c + 1) * 32 - 1;
#pragma unroll
                for (int nt = 0; nt < 2; ++nt) { const float2 cs = p.ROPE[pos * 32 + 16 * nt + l15]; const float x1 = acc[nt][r], x2 = acc[nt + 2][r];
                    dst[16 * nt + l15] = x1 * cs.x - x2 * cs.y; dst[16 * (nt + 2) + l15] = x2 * cs.x + x1 * cs.y; }
            } else {
#pragma unroll
                for (int nt = 0; nt < 4; ++nt) dst[16 * nt + l15] = acc[nt][r];
            }
        }
    }
}
__device__ __forceinline__ void cmp_prompt_unit(const KP& p, int unit, int lane) {
    asm volatile("" : "+v"(lane));
    const int l15 = lane & 15, grp = lane >> 4;
    const int kv = unit & 1, combo = (unit >> 1) * 16 + l15; const int g = combo & 1, c = combo >> 1;
    const bf16* w1 = p.WT_C + ((size_t)kv * 128 + l15) * 2048 + 8 * grp;
    f32x4 acc[8];
#pragma unroll
    for (int jt = 0; jt < 8; ++jt) acc[jt] = (f32x4){0.f, 0.f, 0.f, 0.f};
    const bf16* hsrc = p.H0B + (size_t)(c * 32) * PAP + C_KC + kv * 128 + g * 64 + 8 * grp; const float* pe = p.cpe + (size_t)kv * 32 * 64 + 8 * grp;
#pragma unroll 4
    for (int ks = 0; ks < 64; ++ks) {
        const int i = ks >> 1, dd = 32 * (ks & 1);
        const v4u hx = *(const v4u*)(hsrc + (size_t)i * PAP + dd); const float4 e0 = *(const float4*)(pe + i * 64 + dd), e1 = *(const float4*)(pe + i * 64 + dd + 4);
        union { v4u u; bf16x8 b; } fbu;
        fbu.u.x = pk2(__uint_as_float(hx[0] << 16) + e0.x, __uint_as_float(hx[0] & 0xffff0000u) + e0.y); fbu.u.y = pk2(__uint_as_float(hx[1] << 16) + e0.z, __uint_as_float(hx[1] & 0xffff0000u) + e0.w);
        fbu.u.z = pk2(__uint_as_float(hx[2] << 16) + e1.x, __uint_as_float(hx[2] & 0xffff0000u) + e1.y); fbu.u.w = pk2(__uint_as_float(hx[3] << 16) + e1.z, __uint_as_float(hx[3] & 0xffff0000u) + e1.w);
        const bf16x8 fb = fbu.b;
#pragma unroll
        for (int jt = 0; jt < 8; ++jt) acc[jt] = MFMA16(*(const bf16x8*)(w1 + (size_t)jt * 16 * 2048 + 32 * ks), fb, acc[jt]);
    }
    bf16x8 hb[4];
#pragma unroll
    for (int s2 = 0; s2 < 4; ++s2) {
        f32x4 h0, h1;
#pragma unroll
        for (int r = 0; r < 4; ++r) { h0[r] = gelu_tanh(acc[2 * s2][r] + p.cb1[kv * 128 + 32 * s2 + 4 * grp + r]); h1[r] = gelu_tanh(acc[2 * s2 + 1][r] + p.cb1[kv * 128 + 32 * s2 + 16 + 4 * grp + r]); }
        hb[s2] = pack_p(h0, h1);
    }
    f32x4 o[4];
#pragma unroll
    for (int dt = 0; dt < 4; ++dt) {
        o[dt] = (f32x4){0.f, 0.f, 0.f, 0.f};
        const bf16* w2 = p.W2T + (size_t)kv * 64 * 128 + (size_t)(16 * dt + l15) * 128 + 4 * grp;
#pragma unroll
        for (int s2 = 0; s2 < 4; ++s2) { const uint2 x0 = *(const uint2*)(w2 + 32 * s2), x1 = *(const uint2*)(w2 + 32 * s2 + 16);
            union { v4u u; bf16x8 b; } wa; wa.u.x = x0.x; wa.u.y = x0.y; wa.u.z = x1.x; wa.u.w = x1.y;
            o[dt] = MFMA16(wa.b, hb[s2], o[dt]); }
    }
    if (kv == 0) {
        const int pos = (c + 1) * 32 - 1;
#pragma unroll
        for (int dt = 0; dt < 2; ++dt)
#pragma unroll
            for (int r = 0; r < 4; ++r) { const float2 cs = p.ROPE[pos * 32 + 16 * dt + 4 * grp + r]; const float x1 = o[dt][r], x2 = o[dt + 2][r];
                o[dt][r] = x1 * cs.x - x2 * cs.y; o[dt + 2][r] = x2 * cs.x + x1 * cs.y; }
    }
#pragma unroll
    for (int dt = 0; dt < 4; ++dt)
#pragma unroll
        for (int r = 0; r < 4; ++r) { const int d = 16 * dt + 4 * grp + r;
            if (kv == 0) p.CKF[(size_t)g * 512 * 64 + kfrag_elem(c, d)] = (bf16)f2bf(o[dt][r]); else p.CVF[(size_t)g * 512 * 64 + vfrag_elem(c, d)] = (bf16)f2bf(o[dt][r]); }
}
__device__ __forceinline__ void cmp_sample_unit(const KP& p, int unit, int lane) {
    asm volatile("" : "+v"(lane));
    const int l15 = lane & 15, grp = lane >> 4;
    const int b = unit >> 6, kv = (unit >> 5) & 1, cb = unit & 31;
    const bf16* w1 = p.WT_C + ((size_t)kv * 128 + l15) * 2048 + 8 * grp;
    const float* src[2];
#pragma unroll
    for (int cg = 0; cg < 2; ++cg) { const int combo = cb * 32 + 16 * cg + l15; const int g = combo & 1, c = combo >> 1;
        const int page = p.page_table[b * NPAGES + (c >> 2)];
        src[cg] = p.cache_cmp + (((size_t)page * 128 + (c & 3) * 32) * 4 + kv * 2 + g) * 64 + 8 * grp; }
    const float* pe = p.cpe + (size_t)kv * 32 * 64 + 8 * grp;
    f32x4 acc[2][8];
#pragma unroll
    for (int cg = 0; cg < 2; ++cg)
#pragma unroll
        for (int jt = 0; jt < 8; ++jt) acc[cg][jt] = (f32x4){0.f, 0.f, 0.f, 0.f};
#pragma unroll 2
    for (int ks = 0; ks < 64; ++ks) {
        const int i = ks >> 1, dd = 32 * (ks & 1);
        const float4 e0 = *(const float4*)(pe + i * 64 + dd), e1 = *(const float4*)(pe + i * 64 + dd + 4);
        bf16x8 fb[2];
#pragma unroll
        for (int cg = 0; cg < 2; ++cg) { const float4 a0 = *(const float4*)(src[cg] + i * 256 + dd), a1 = *(const float4*)(src[cg] + i * 256 + dd + 4);
            union { v4u u; bf16x8 b; } t; t.u.x = pk2(a0.x + e0.x, a0.y + e0.y); t.u.y = pk2(a0.z + e0.z, a0.w + e0.w); t.u.z = pk2(a1.x + e1.x, a1.y + e1.y); t.u.w = pk2(a1.z + e1.z, a1.w + e1.w); fb[cg] = t.b; }
#pragma unroll
        for (int jt = 0; jt < 8; ++jt) { const bf16x8 wa = *(const bf16x8*)(w1 + (size_t)jt * 16 * 2048 + 32 * ks);
            acc[0][jt] = MFMA16(wa, fb[0], acc[0][jt]); acc[1][jt] = MFMA16(wa, fb[1], acc[1][jt]); }
    }
#pragma unroll
    for (int cg = 0; cg < 2; ++cg) {
        const int combo = cb * 32 + 16 * cg + l15; const int g = combo & 1, c = combo >> 1;
        bf16x8 hb[4];
#pragma unroll
        for (int s2 = 0; s2 < 4; ++s2) { f32x4 h0, h1;
#pragma unroll
            for (int r = 0; r < 4; ++r) { h0[r] = gelu_tanh(acc[cg][2 * s2][r] + p.cb1[kv * 128 + 32 * s2 + 4 * grp + r]); h1[r] = gelu_tanh(acc[cg][2 * s2 + 1][r] + p.cb1[kv * 128 + 32 * s2 + 16 + 4 * grp + r]); }
            hb[s2] = pack_p(h0, h1); }
        f32x4 o[4];
#pragma unroll
        for (int dt = 0; dt < 4; ++dt) {
            o[dt] = (f32x4){0.f, 0.f, 0.f, 0.f};
            const bf16* w2 = p.W2T + (size_t)kv * 64 * 128 + (size_t)(16 * dt + l15) * 128 + 4 * grp;
#pragma unroll
            for (int s2 = 0; s2 < 4; ++s2) { const uint2 x0 = *(const uint2*)(w2 + 32 * s2), x1 = *(const uint2*)(w2 + 32 * s2 + 16);
                union { v4u u; bf16x8 b; } wa; wa.u.x = x0.x; wa.u.y = x0.y; wa.u.z = x1.x; wa.u.w = x1.y;
                o[dt] = MFMA16(wa.b, hb[s2], o[dt]); }
        }
        if (kv == 0) {
            const int pos = (c + 1) * 32 - 1;
#pragma unroll
            for (int dt = 0; dt < 2; ++dt)
#pragma unroll
                for (int r = 0; r < 4; ++r) { const float2 cs = p.ROPE[pos * 32 + 16 * dt + 4 * grp + r]; const float x1 = o[dt][r], x2 = o[dt + 2][r];
                    o[dt][r] = x1 * cs.x - x2 * cs.y; o[dt + 2][r] = x2 * cs.x + x1 * cs.y; }
        }
        float* dst = ((kv == 0) ? p.CK : p.CV) + (((size_t)(1 + b) * 512 + c) * 2 + g) * 64 + 4 * grp;
#pragma unroll
        for (int dt = 0; dt < 4; ++dt) *(f32x4*)(dst + 16 * dt) = o[dt];
    }
}
constexpr int W1S_PITCH = 528;
constexpr int W1S_BYTES = 128 * W1S_PITCH;
__device__ __forceinline__ void cmp_sample_wg(const KP& p, int wu, const Fr& F) {
    int lane = F.lane; asm volatile("" : "+v"(lane));
    const int l15 = lane & 15, grp = lane >> 4, tid = F.tid;
    const int b = wu >> 3, kv = (wu >> 2) & 1, q4 = wu & 3;
    const float* src[2];
#pragma unroll
    for (int cg = 0; cg < 2; ++cg) { const int combo = q4 * 256 + F.wave * 32 + 16 * cg + l15; const int g = combo & 1, c = combo >> 1;
        const int page = p.page_table[b * NPAGES + (c >> 2)];
        src[cg] = p.cache_cmp + (((size_t)page * 128 + (c & 3) * 32) * 4 + kv * 2 + g) * 64 + 8 * grp; }
    const float* pe = p.cpe + (size_t)kv * 32 * 64 + 8 * grp;
    const bf16* wg = p.WT_C + (size_t)kv * 128 * 2048;
    f32x4 acc[2][8];
#pragma unroll
    for (int cg = 0; cg < 2; ++cg)
#pragma unroll
        for (int jt = 0; jt < 8; ++jt) acc[cg][jt] = (f32x4){0.f, 0.f, 0.f, 0.f};
    v4u wreg[8];
#pragma unroll
    for (int k = 0; k < 8; ++k) { const int c = tid + 512 * k; wreg[k] = *(const v4u*)(wg + (size_t)(c >> 5) * 2048 + (c & 31) * 8); }
#pragma unroll
    for (int k = 0; k < 8; ++k) { const int c = tid + 512 * k; *(v4u*)(F.lds + (c >> 5) * W1S_PITCH + (c & 31) * 16) = wreg[k]; }
    __syncthreads();
#pragma unroll 1
    for (int sl = 0; sl < 8; ++sl) {
        if (sl + 1 < 8) {
#pragma unroll
            for (int k = 0; k < 8; ++k) { const int c = tid + 512 * k; wreg[k] = *(const v4u*)(wg + (size_t)(c >> 5) * 2048 + (sl + 1) * 256 + (c & 31) * 8); }
        }
        const unsigned char* wl = F.lds + (sl & 1) * W1S_BYTES + l15 * W1S_PITCH + grp * 16;
#pragma unroll 4
        for (int kk = 0; kk < 8; ++kk) {
            const int ks = sl * 8 + kk, i = ks >> 1, dd = 32 * (ks & 1);
            const float4 e0 = *(const float4*)(pe + i * 64 + dd), e1 = *(const float4*)(pe + i * 64 + dd + 4);
            bf16x8 fb[2];
#pragma unroll
            for (int cg = 0; cg < 2; ++cg) { const float4 a0 = *(const float4*)(src[cg] + i * 256 + dd), a1 = *(const float4*)(src[cg] + i * 256 + dd + 4);
                union { v4u u; bf16x8 b; } t; t.u.x = pk2(a0.x + e0.x, a0.y + e0.y); t.u.y = pk2(a0.z + e0.z, a0.w + e0.w); t.u.z = pk2(a1.x + e1.x, a1.y + e1.y); t.u.w = pk2(a1.z + e1.z, a1.w + e1.w); fb[cg] = t.b; }
#pragma unroll
            for (int jt = 0; jt < 8; ++jt) { const bf16x8 wa = *(const bf16x8*)(wl + jt * 16 * W1S_PITCH + kk * 64);
                acc[0][jt] = MFMA16(wa, fb[0], acc[0][jt]); acc[1][jt] = MFMA16(wa, fb[1], acc[1][jt]); }
        }
        if (sl + 1 < 8) {
#pragma unroll
            for (int k = 0; k < 8; ++k) { const int c = tid + 512 * k; *(v4u*)(F.lds + ((sl + 1) & 1) * W1S_BYTES + (c >> 5) * W1S_PITCH + (c & 31) * 16) = wreg[k]; }
        }
        __syncthreads();
    }
#pragma unroll
    for (int cg = 0; cg < 2; ++cg) {
        const int combo = q4 * 256 + F.wave * 32 + 16 * cg + l15; const int g = combo & 1, c = combo >> 1;
        bf16x8 hb[4];
#pragma unroll
        for (int s2 = 0; s2 < 4; ++s2) { f32x4 h0, h1;
#pragma unroll
            for (int r = 0; r < 4; ++r) { h0[r] = gelu_tanh(acc[cg][2 * s2][r] + p.cb1[kv * 128 + 32 * s2 + 4 * grp + r]); h1[r] = gelu_tanh(acc[cg][2 * s2 + 1][r] + p.cb1[kv * 128 + 32 * s2 + 16 + 4 * grp + r]); }
            hb[s2] = pack_p(h0, h1); }
        f32x4 o[4];
#pragma unroll
        for (int dt = 0; dt < 4; ++dt) {
            o[dt] = (f32x4){0.f, 0.f, 0.f, 0.f};
            const bf16* w2 = p.W2T + (size_t)kv * 64 * 128 + (size_t)(16 * dt + l15) * 128 + 4 * grp;
#pragma unroll
            for (int s2 = 0; s2 < 4; ++s2) { const uint2 x0 = *(const uint2*)(w2 + 32 * s2), x1 = *(const uint2*)(w2 + 32 * s2 + 16);
                union { v4u u; bf16x8 b; } wa; wa.u.x = x0.x; wa.u.y = x0.y; wa.u.z = x1.x; wa.u.w = x1.y;
                o[dt] = MFMA16(wa.b, hb[s2], o[dt]); }
        }
        if (kv == 0) {
            const int pos = (c + 1) * 32 - 1;
#pragma unroll
            for (int dt = 0; dt < 2; ++dt)
#pragma unroll
                for (int r = 0; r < 4; ++r) { const float2 cs = p.ROPE[pos * 32 + 16 * dt + 4 * grp + r]; const float x1 = o[dt][r], x2 = o[dt + 2][r];
                    o[dt][r] = x1 * cs.x - x2 * cs.y; o[dt + 2][r] = x2 * cs.x + x1 * cs.y; }
        }
        float* dst = ((kv == 0) ? p.CK : p.CV) + (((size_t)(1 + b) * 512 + c) * 2 + g) * 64 + 4 * grp;
#pragma unroll
        for (int dt = 0; dt < 4; ++dt) *(f32x4*)(dst + 16 * dt) = o[dt];
    }
}
__device__ __forceinline__ void ph_cmp_samples(const KP& p, const Fr& F) {
    for (int wu = F.bid; wu < 256; wu += F.G) cmp_sample_wg(p, wu, F);
}
__device__ __forceinline__ void ph_cmp_prompt(const KP& p, const Fr& F) {
    for (int unit = F.gw; unit < 128; unit += F.NGW) cmp_prompt_unit(p, unit, F.lane);
}

__device__ __forceinline__ float rope_val(const float* row, int base, int i, float2 cs) {
    const int ii = i & 31;
    const float x1 = row[base + ii], x2 = row[base + ii + 32];
    return (i < 32) ? (x1 * cs.x - x2 * cs.y) : (x2 * cs.x + x1 * cs.y);
}
__device__ __forceinline__ void ph_nsa_prep(const KP& p, const Fr& F) {
    const float* H0 = p.BIGF; float* out = p.out;
    const size_t gt = (size_t)F.tgt, GT = (size_t)F.tGT;
    const size_t total = (size_t)TS * 1280;
    for (size_t idx = gt + (size_t)T * 1280; idx < total; idx += GT) {
        const int r = (int)(idx / 1280), c = (int)(idx % 1280);
        const bool smp = r >= T; const int b = r - T; const int pos = smp ? T : r;
        const float* row = H0 + (size_t)r * PA;
        const int i = c & 63;
        const float2 cs = p.ROPE[pos * 32 + (i & 31)];
        if (c < 512) { p.QR[(size_t)r * 512 + c] = rope_val(row, c & ~63, i, cs); continue; }
        const int sec = (c - 512) >> 7; const int gd = (c - 512) & 127; const int base = c & ~63;
        float v;
        if (sec == 2 || sec == 4) v = rope_val(row, base, i, cs); else v = row[c];
        const int kv = sec & 1;
        if (sec < 2) {
            if (!smp) out[O_CMP_P + (size_t)r * 256 + kv * 128 + gd] = v; else out[O_CMP_S + (size_t)b * 256 + kv * 128 + gd] = v;
        } else if (sec < 4) {
            if (!smp) out[O_SLC_P + (size_t)r * 256 + kv * 128 + gd] = v; else out[O_SLC_S + (size_t)b * 256 + kv * 128 + gd] = v;
            if (kv == 0) p.KS[(size_t)r * 128 + gd] = v; else p.VS[(size_t)r * 128 + gd] = v;
        } else {
            if (kv == 0) p.KW[(size_t)r * 128 + gd] = v; else p.VW[(size_t)r * 128 + gd] = v;
            if (!smp) { if (r >= T - 512) out[O_WIN_P + (size_t)(r - (T - 512)) * 256 + kv * 128 + gd] = v; }
            else out[O_WIN_S + ((size_t)b * 512 + 511) * 256 + kv * 128 + gd] = v;
        }
    }
    const size_t tot2 = (size_t)NSMP * 511 * 256;
    for (size_t idx = gt; idx < tot2; idx += GT) {
        const int b = (int)(idx / (511 * 256)); const int rem = (int)(idx % (511 * 256));
        out[O_WIN_S + (size_t)b * 512 * 256 + rem] = p.st_win[(size_t)b * 512 * 256 + 256 + rem];
    }
}

constexpr float QSCALE = 0.18033688011112042f;

__device__ __forceinline__ size_t kfrag_off(int kt, int ks, int lane) { return ((size_t)(kt * 2 + ks) * 64 + lane) * 8; }
__device__ __forceinline__ size_t vfrag_off(int st, int dt, int lane) { return ((size_t)(st * 4 + dt) * 64 + lane) * 8; }
__device__ __forceinline__ size_t vfrag_elem(int key, int d) {
    const int st = key >> 5, kk = key & 31, tile = kk >> 4, r16 = kk & 15, grp = r16 >> 2, reg = r16 & 3;
    return ((size_t)(st * 4 + (d >> 4)) * 64 + (d & 15) + 16 * grp) * 8 + tile * 4 + reg;
}
__device__ __forceinline__ size_t k8_off(int key, int d) { return ((size_t)(key >> 4) * 64 + (key & 15) + 16 * ((d & 31) >> 3)) * 16 + (d >> 5) * 8 + (d & 7); }
__device__ __forceinline__ size_t v8_off(int key, int d) {
    const int blk = key >> 6, st = (key >> 5) & 1, kk = key & 31, tile = kk >> 4, r16 = kk & 15, grp = r16 >> 2, reg = r16 & 3;
    return ((size_t)(blk * 4 + (d >> 4)) * 64 + (d & 15) + 16 * grp) * 16 + st * 8 + tile * 4 + reg;
}
__device__ __forceinline__ size_t kfrag_elem(int key, int d) {
    return ((size_t)((key >> 4) * 2 + (d >> 5)) * 64 + (key & 15) + 16 * ((d & 31) >> 3)) * 8 + (d & 7);
}

__device__ __forceinline__ void ph_nsa_prep_fast(const KP& p, const Fr& F) {
    const float* H0 = p.BIGF; float* out = p.out;
    const size_t gt = (size_t)F.tgt, GT = (size_t)F.tGT;
    for (size_t idx = gt; idx < (size_t)T * 64; idx += GT) {
        const int t = (int)(idx >> 6), u = (int)(idx & 63);
        const v4u uz = *(const v4u*)(p.H0B + (size_t)t * PAP + C_Z + 8 * u); float* zo = p.ZF + (size_t)t * 512 + 8 * u;
        *(float4*)zo = make_float4(__uint_as_float(uz[0] << 16), __uint_as_float(uz[0] & 0xffff0000u), __uint_as_float(uz[1] << 16), __uint_as_float(uz[1] & 0xffff0000u));
        *(float4*)(zo + 4) = make_float4(__uint_as_float(uz[2] << 16), __uint_as_float(uz[2] & 0xffff0000u), __uint_as_float(uz[3] << 16), __uint_as_float(uz[3] & 0xffff0000u));
    }
    for (size_t idx = gt; idx < (size_t)T * 160; idx += GT) {
        const int t = (int)(idx / 160), u = (int)(idx % 160);
        const int c0 = u * 8; const bf16* row = p.H0B + (size_t)t * PAP;
        const v4u ua = *(const v4u*)(row + c0);
        float v[8];
#pragma unroll
        for (int e = 0; e < 4; ++e) { v[2 * e] = __uint_as_float(ua[e] << 16); v[2 * e + 1] = __uint_as_float(ua[e] & 0xffff0000u); }
        const int sec = (u < 64) ? -1 : ((u - 64) >> 4);
        const bool roped = (sec == -1 || sec == 2 || sec == 4);
        if (roped) {
            const int d0 = c0 & 63; const int pc = (d0 < 32) ? c0 + 32 : c0 - 32;
            const v4u ub = *(const v4u*)(row + pc);
            float w[8];
#pragma unroll
            for (int e = 0; e < 4; ++e) { w[2 * e] = __uint_as_float(ub[e] << 16); w[2 * e + 1] = __uint_as_float(ub[e] & 0xffff0000u); }
            const float4* rp = (const float4*)(p.ROPE + t * 32 + (d0 & 31)); const float4 r0 = rp[0], r1 = rp[1], r2 = rp[2], r3 = rp[3];
            const float cs[8] = {r0.x, r0.z, r1.x, r1.z, r2.x, r2.z, r3.x, r3.z}, sn[8] = {r0.y, r0.w, r1.y, r1.w, r2.y, r2.w, r3.y, r3.w};
#pragma unroll
            for (int j = 0; j < 8; ++j) v[j] = (d0 < 32) ? (v[j] * cs[j] - w[j] * sn[j]) : (v[j] * cs[j] + w[j] * sn[j]);
        }
        if (sec == -1) {
            v4u o; o.x = pk2(v[0] * QSCALE, v[1] * QSCALE); o.y = pk2(v[2] * QSCALE, v[3] * QSCALE); o.z = pk2(v[4] * QSCALE, v[5] * QSCALE); o.w = pk2(v[6] * QSCALE, v[7] * QSCALE);
            *(v4u*)(p.QB + (size_t)t * 512 + c0) = o; continue;
        }
        const int gd = (c0 - 512) & 127, g = gd >> 6, d0 = gd & 63, kv = sec & 1;
        const float4 o0 = make_float4(v[0], v[1], v[2], v[3]), o1 = make_float4(v[4], v[5], v[6], v[7]);
        if (sec < 2) { float* o = out + O_CMP_P + (size_t)t * 256 + kv * 128 + gd; *(float4*)o = o0; *(float4*)(o + 4) = o1;
            continue; }
        if (sec < 4) { float* o = out + O_SLC_P + (size_t)t * 256 + kv * 128 + gd; *(float4*)o = o0; *(float4*)(o + 4) = o1; }
        else if (t >= T - 512) { float* o = out + O_WIN_P + (size_t)(t - (T - 512)) * 256 + kv * 128 + gd; *(float4*)o = o0; *(float4*)(o + 4) = o1; }
        if (sec < 4) {
            if (kv == 0) {
                int w0 = 0, w1 = 0;
                w0 = __builtin_amdgcn_cvt_pk_fp8_f32(v[0], v[1], w0, false); w0 = __builtin_amdgcn_cvt_pk_fp8_f32(v[2], v[3], w0, true);
                w1 = __builtin_amdgcn_cvt_pk_fp8_f32(v[4], v[5], w1, false); w1 = __builtin_amdgcn_cvt_pk_fp8_f32(v[6], v[7], w1, true);
                *(uint2*)(p.KS8 + (size_t)g * T * 64 + k8_off(t, d0)) = make_uint2((unsigned)w0, (unsigned)w1);
            } else {
#pragma unroll
                for (int j = 0; j < 8; ++j) p.VS8[(size_t)g * T * 64 + v8_off(t, d0 + j)] = (unsigned char)(__builtin_amdgcn_cvt_pk_fp8_f32(v[j], 0.f, 0, false) & 0xff);
            }
            continue;
        }
        bf16* KF = p.KWF; bf16* VF = p.VWF;
        if (kv == 0) {
            v4u o; o.x = pk2(v[0], v[1]); o.y = pk2(v[2], v[3]); o.z = pk2(v[4], v[5]); o.w = pk2(v[6], v[7]);
            *(v4u*)(KF + (size_t)g * T * 64 + kfrag_elem(t, d0)) = o;
        } else {
#pragma unroll
            for (int j = 0; j < 8; ++j) VF[(size_t)g * T * 64 + vfrag_elem(t, d0 + j)] = (bf16)f2bf(v[j]);
        }
    }
}

struct AttW { f32x4 o[4]; float m, l; };
__device__ __forceinline__ void attw_init(AttW& a) {
#pragma unroll
    for (int i = 0; i < 4; ++i) a.o[i] = (f32x4){0.f, 0.f, 0.f, 0.f};
    a.m = -INFINITY; a.l = 0.f;
}
__device__ __forceinline__ void qk_step(const bf16x8 (&kf)[2][2], const bf16x8 (&qf)[2], f32x4& s0, f32x4& s1) {
    const f32x4 z = {0.f, 0.f, 0.f, 0.f};
    s0 = MFMA16(kf[0][0], qf[0], z); s0 = MFMA16(kf[0][1], qf[1], s0);
    s1 = MFMA16(kf[1][0], qf[0], z); s1 = MFMA16(kf[1][1], qf[1], s1);
}
__device__ __forceinline__ bf16x8 pack_p(const f32x4& p0, const f32x4& p1) {
    union { v4u u; bf16x8 b; } c;
    c.u.x = pg8::cvt_pk_bf16(p0[0], p0[1]); c.u.y = pg8::cvt_pk_bf16(p0[2], p0[3]); c.u.z = pg8::cvt_pk_bf16(p1[0], p1[1]); c.u.w = pg8::cvt_pk_bf16(p1[2], p1[3]);
    return c.b;
}
__device__ __forceinline__ void att_update(AttW& a, const f32x4& s0, const f32x4& s1, const bf16x8 (&vf)[4]) {
    float mx = fmaxf(fmaxf(fmaxf(s0[0], s0[1]), fmaxf(s0[2], s0[3])), fmaxf(fmaxf(s1[0], s1[1]), fmaxf(s1[2], s1[3])));
    mx = fmaxf(mx, __shfl_xor(mx, 16)); mx = fmaxf(mx, __shfl_xor(mx, 32));
    const float mn = fmaxf(a.m, mx);
    const float ms = (mn == -INFINITY) ? 0.f : mn;
    const float alpha = __builtin_amdgcn_exp2f(a.m - ms);
    f32x4 p0, p1;
#pragma unroll
    for (int i = 0; i < 4; ++i) { p0[i] = __builtin_amdgcn_exp2f(s0[i] - ms); p1[i] = __builtin_amdgcn_exp2f(s1[i] - ms); }
    a.l = a.l * alpha + ((p0[0] + p0[1]) + (p0[2] + p0[3])) + ((p1[0] + p1[1]) + (p1[2] + p1[3]));
    a.m = mn;
    const bf16x8 pf = pack_p(p0, p1);
#pragma unroll
    for (int dt = 0; dt < 4; ++dt) { a.o[dt] = a.o[dt] * alpha; a.o[dt] = MFMA16(vf[dt], pf, a.o[dt]); }
}
__device__ __forceinline__ float grp_sum(float v) { v += __shfl_xor(v, 16); v += __shfl_xor(v, 32); return v; }

__device__ __forceinline__ void nsa_fast_unit(const KP& p, int unit, float* wl, int lane) {
    asm volatile("" : "+v"(lane));
    const int g = unit & 1, t0 = (unit >> 1) * 16;
    const int qi = lane & 15, grp = lane >> 4, t = t0 + qi;
    float* imp = wl; int* sel = (int*)(wl + 4096);
    const bf16* growb = p.H0B + (size_t)t * PAP + C_GATE + g * 4;
#define GROWF(i) __uint_as_float((unsigned)growb[i] << 16)
    bf16x8 qf[4][2];
#pragma unroll
    for (int h = 0; h < 4; ++h)
#pragma unroll
        for (int ks = 0; ks < 2; ++ks) qf[h][ks] = *(const bf16x8*)(p.QB + (size_t)t * 512 + (g * 4 + h) * 64 + 32 * ks + 8 * grp);
    AttW st[4];
    {
        const bf16* CKF = p.CKF + (size_t)g * 512 * 64; const bf16* CVF = p.CVF + (size_t)g * 512 * 64;
        const int nmax = (t0 + 16) >> 5; const int nsteps = (nmax + 31) >> 5;
        const int nval = (t + 1) >> 5;
        float m[4], l[4];
#pragma unroll
        for (int h = 0; h < 4; ++h) { m[h] = -INFINITY; l[h] = 0.f; }
        for (int s = 0; s < nsteps; ++s) {
            bf16x8 kf[2][2];
#pragma unroll
            for (int tl = 0; tl < 2; ++tl)
#pragma unroll
                for (int ks = 0; ks < 2; ++ks) kf[tl][ks] = *(const bf16x8*)(CKF + kfrag_off(2 * s + tl, ks, lane));
            const int cb = 32 * s + 4 * grp;
#pragma unroll
            for (int h = 0; h < 4; ++h) {
                f32x4 s0, s1; qk_step(kf, qf[h], s0, s1);
#pragma unroll
                for (int i = 0; i < 4; ++i) { if (cb + i >= nval) s0[i] = -INFINITY; if (cb + 16 + i >= nval) s1[i] = -INFINITY; }
                float mx = fmaxf(fmaxf(fmaxf(s0[0], s0[1]), fmaxf(s0[2], s0[3])), fmaxf(fmaxf(s1[0], s1[1]), fmaxf(s1[2], s1[3])));
                mx = fmaxf(mx, __shfl_xor(mx, 16)); mx = fmaxf(mx, __shfl_xor(mx, 32));
                const float mn = fmaxf(m[h], mx); const float ms = (mn == -INFINITY) ? 0.f : mn;
                float sum = 0.f;
#pragma unroll
                for (int i = 0; i < 4; ++i) sum += __builtin_amdgcn_exp2f(s0[i] - ms) + __builtin_amdgcn_exp2f(s1[i] - ms);
                l[h] = l[h] * __builtin_amdgcn_exp2f(m[h] - ms) + sum; m[h] = mn;
            }
        }
        float il[4];
#pragma unroll
        for (int h = 0; h < 4; ++h) { const float lt = grp_sum(l[h]); il[h] = lt > 0.f ? 1.f / lt : 0.f; if (m[h] == -INFINITY) m[h] = 0.f; attw_init(st[h]); }
        for (int s = 0; s < nsteps; ++s) {
            bf16x8 kf[2][2], vf[4];
#pragma unroll
            for (int tl = 0; tl < 2; ++tl)
#pragma unroll
                for (int ks = 0; ks < 2; ++ks) kf[tl][ks] = *(const bf16x8*)(CKF + kfrag_off(2 * s + tl, ks, lane));
#pragma unroll
            for (int dt = 0; dt < 4; ++dt) vf[dt] = *(const bf16x8*)(CVF + vfrag_off(s, dt, lane));
            const int cb = 32 * s + 4 * grp;
            float i4[4] = {0.f, 0.f, 0.f, 0.f};
#pragma unroll
            for (int h = 0; h < 4; ++h) {
                f32x4 s0, s1; qk_step(kf, qf[h], s0, s1);
                f32x4 p0, p1;
#pragma unroll
                for (int i = 0; i < 4; ++i) {
                    p0[i] = (cb + i < nval) ? __builtin_amdgcn_exp2f(s0[i] - m[h]) * il[h] : 0.f;
                    p1[i] = (cb + 16 + i < nval) ? __builtin_amdgcn_exp2f(s1[i] - m[h]) * il[h] : 0.f; }
                i4[0] += p0[0] + p0[1]; i4[1] += p0[2] + p0[3]; i4[2] += p1[0] + p1[1]; i4[3] += p1[2] + p1[3];
                const bf16x8 pf = pack_p(p0, p1);
#pragma unroll
                for (int dt = 0; dt < 4; ++dt) st[h].o[dt] = MFMA16(vf[dt], pf, st[h].o[dt]);
            }
            *(float2*)(imp + qi * 256 + 16 * s + 2 * grp) = make_float2(i4[0], i4[1]);
            *(float2*)(imp + qi * 256 + 16 * s + 8 + 2 * grp) = make_float2(i4[2], i4[3]);
        }
        wave_lds_sync();
    }
    const int cur = t0 >> 6;
    {
        if (cur + 1 <= 16) {
            for (int idx = lane; idx < 256; idx += 64) sel[idx] = ((idx & 15) <= cur) ? (idx & 15) : -1;
        } else {
            for (int q0 = 0; q0 < 16; q0 += 4) {
                unsigned key[4][4];
#pragma unroll
                for (int qq = 0; qq < 4; ++qq)
#pragma unroll
                    for (int j = 0; j < 4; ++j) { const int blk = lane + 64 * j; const float v = imp[(q0 + qq) * 256 + blk];
                        key[qq][j] = (blk >= 1 && blk <= cur - 2) ? ((__float_as_uint(v) & 0xFFFFFF00u) | (unsigned)(255 - blk)) : 0u; }
                if (lane < 4) { sel[(q0 + lane) * 16 + 0] = 0; sel[(q0 + lane) * 16 + 1] = cur; sel[(q0 + lane) * 16 + 2] = cur - 1; }
                for (int n = 3; n < 16; ++n) {
                    unsigned best[4];
#pragma unroll
                    for (int qq = 0; qq < 4; ++qq) best[qq] = max(max(key[qq][0], key[qq][1]), max(key[qq][2], key[qq][3]));
#pragma unroll
                    for (int o = 1; o < 64; o <<= 1) {
#pragma unroll
                        for (int qq = 0; qq < 4; ++qq) best[qq] = max(best[qq], (unsigned)__shfl_xor((int)best[qq], o));
                    }
#pragma unroll
                    for (int qq = 0; qq < 4; ++qq) {
                        const int blk = 255 - (int)(best[qq] & 255u);
#pragma unroll
                        for (int j = 0; j < 4; ++j) if (lane + 64 * j == blk) key[qq][j] = 0u;
                        if (lane == 0) sel[(q0 + qq) * 16 + n] = blk;
                    }
                }
            }
        }
        wave_lds_sync();
    }
    float* acc = wl;
    {
#pragma unroll
        for (int h = 0; h < 4; ++h) { const float gs = sigmoidf_(GROWF(h));
#pragma unroll
            for (int dt = 0; dt < 4; ++dt) *(f32x4*)(acc + (qi * 4 + h) * 64 + 16 * dt + 4 * grp) = st[h].o[dt] * gs; }
        wave_lds_sync();
    }
    {
        const bf16* KF = p.KWF + (size_t)g * T * 64; const bf16* VF = p.VWF + (size_t)g * T * 64;
        int kstart = t0 - 512; if (kstart < 0) kstart = 0; kstart &= ~31;
        const int nsteps = (t0 + 16 - kstart + 31) >> 5;
#pragma unroll
        for (int h = 0; h < 4; ++h) attw_init(st[h]);
        auto issue = [&](int s_, bf16x8 (&K)[2][2], bf16x8 (&V)[4]) {
            const int k0 = kstart + 32 * s_;
#pragma unroll
            for (int tl = 0; tl < 2; ++tl)
#pragma unroll
                for (int ks = 0; ks < 2; ++ks) K[tl][ks] = *(const bf16x8*)(KF + kfrag_off((k0 >> 4) + tl, ks, lane));
#pragma unroll
            for (int dt = 0; dt < 4; ++dt) V[dt] = *(const bf16x8*)(VF + vfrag_off(k0 >> 5, dt, lane));
        };
        auto compute = [&](int s_, const bf16x8 (&K)[2][2], const bf16x8 (&V)[4]) {
            const int k0 = kstart + 32 * s_;
            const bool need_mask = (k0 + 31 > t0) || (k0 < t0 + 15 - 512);
            const int pb = k0 + 4 * grp;
#pragma unroll
            for (int h = 0; h < 4; ++h) {
                f32x4 s0, s1; qk_step(K, qf[h], s0, s1);
                if (need_mask) {
#pragma unroll
                    for (int i = 0; i < 4; ++i) { const int p0 = pb + i, p1 = pb + 16 + i;
                        if (p0 > t || p0 < t - 512) s0[i] = -INFINITY; if (p1 > t || p1 < t - 512) s1[i] = -INFINITY; }
                }
                att_update(st[h], s0, s1, V);
            }
        };
        bf16x8 kA[2][2], vA[4], kB[2][2], vB[4];
        issue(0, kA, vA);
        for (int s = 0; s < nsteps; s += 2) {
            if (s + 1 < nsteps) issue(s + 1, kB, vB);
            compute(s, kA, vA);
            if (s + 1 < nsteps) { if (s + 2 < nsteps) issue(s + 2, kA, vA); compute(s + 1, kB, vB); }
        }
#pragma unroll
        for (int h = 0; h < 4; ++h) { const float lt = grp_sum(st[h].l); const float gs = sigmoidf_(GROWF(16 + h)) * (lt > 0.f ? 1.f / lt : 0.f);
#pragma unroll
            for (int dt = 0; dt < 4; ++dt) { f32x4* a = (f32x4*)(acc + (qi * 4 + h) * 64 + 16 * dt + 4 * grp); *a = *a + st[h].o[dt] * gs; } }
        wave_lds_sync();
    }
    *(int4*)(p.SEL + ((size_t)g * T + t0) * 16 + lane * 4) = *(const int4*)(sel + lane * 4);
#pragma unroll 4
    for (int q = 0; q < 16; ++q) *(f32x4*)(p.NSACC + (size_t)(t0 + q) * 512 + g * 256 + 4 * lane) = *(const f32x4*)(acc + q * 256 + 4 * lane);
    wave_lds_sync();
}

__device__ __forceinline__ void nsa_slc_item(const KP& p, int tq, int g, int lane) {
    asm volatile("" : "+v"(lane));
    const int l15 = lane & 15, grp = lane >> 4, hn = lane & 3;
    const bf16* KF = p.KSF + (size_t)g * T * 64; const bf16* VF = p.VSF + (size_t)g * T * 64;
    const int* selp = p.SEL + ((size_t)g * T + tq) * 16;
    int sb[16];
#pragma unroll
    for (int i = 0; i < 16; ++i) sb[i] = __builtin_amdgcn_readfirstlane(selp[i]);
    bf16x8 qs[2];
#pragma unroll
    for (int ks = 0; ks < 2; ++ks) qs[ks] = *(const bf16x8*)(p.QB + (size_t)tq * 512 + (g * 4 + hn) * 64 + 32 * ks + 8 * grp);
    AttW a; attw_init(a);
    bf16x8 kf[2][2][2], vf[2][4];
    auto issue = [&](int i, int buf) {
        const int blk = sb[i >> 1]; int k0 = blk * 64 + 32 * (i & 1); if (blk < 0 || k0 > tq) k0 = 0;
#pragma unroll
        for (int tl = 0; tl < 2; ++tl)
#pragma unroll
            for (int ks = 0; ks < 2; ++ks) kf[buf][tl][ks] = *(const bf16x8*)(KF + kfrag_off((k0 >> 4) + tl, ks, lane));
#pragma unroll
        for (int dt = 0; dt < 4; ++dt) vf[buf][dt] = *(const bf16x8*)(VF + vfrag_off(k0 >> 5, dt, lane));
    };
    issue(0, 0);
#pragma unroll
    for (int i = 0; i < 32; ++i) {
        const int buf = i & 1;
        if (i + 1 < 32) issue(i + 1, buf ^ 1);
        const int blk = sb[i >> 1]; const int k0 = blk * 64 + 32 * (i & 1);
        const bool dead = (blk < 0) || (k0 > tq);
        f32x4 s0, s1; qk_step(kf[buf], qs, s0, s1);
        const int pb = k0 + 4 * grp;
#pragma unroll
        for (int j = 0; j < 4; ++j) { if (dead || pb + j > tq) s0[j] = -INFINITY; if (dead || pb + 16 + j > tq) s1[j] = -INFINITY; }
        att_update(a, s0, s1, vf[buf]);
    }
    const float lt = grp_sum(a.l);
    if (l15 < 4) {
        const float gs = sigmoidf_(p.BIGF[(size_t)tq * PA + C_GATE + 8 + g * 4 + l15]) * (lt > 0.f ? 1.f / lt : 0.f);
#pragma unroll
        for (int dt = 0; dt < 4; ++dt) {
            const size_t o = (size_t)tq * 512 + g * 256 + l15 * 64 + 16 * dt + 4 * grp;
            const f32x4 base = *(const f32x4*)(p.NSACC + o); const f32x4 v = base + a.o[dt] * gs;
            uint2 w; w.x = pk2(v[0], v[1]); w.y = pk2(v[2], v[3]);
            *(uint2*)(p.MIXB + (size_t)tq * 1024 + g * 256 + l15 * 64 + 16 * dt + 4 * grp) = w;
        }
    }
}

__device__ __forceinline__ void ph_compress(const KP& p, const Fr& F) {
    float* flat = (float*)F.lds;
    float* hid = (float*)(F.lds + 32768);
    float* res = (float*)(F.lds + 32768 + 2048);
    const float* H0 = p.BIGF;
    const int tid = F.tid;
    for (int item = F.bid; item < 512; item += F.G) {
        const int c = item & 511, s = item >> 9;
        for (int e = tid; e < 8192; e += NTHR) {
            const int kv = e >> 12, g = (e >> 11) & 1, k = e & 2047, i = k >> 6, d = k & 63;
            const int row = c * 32 + i;
            float v;
            if (s == 0) v = H0[(size_t)row * PA + C_KC + kv * 128 + g * 64 + d];
            else { const int b = s - 1; const int page = p.page_table[b * NPAGES + (row >> 7)];
                   v = p.cache_cmp[((((size_t)page * 128 + (row & 127)) * 2 + kv) * 2 + g) * 64 + d]; }
            flat[e] = v + p.cpe[(kv * 32 + i) * 64 + d];
        }
        __syncthreads();
        {
            const int kv = tid >> 8, g = (tid >> 7) & 1, j = tid & 127;
            const float* w = p.cw1 + (size_t)kv * 2048 * 128 + j;
            const float* fl = flat + (kv * 2 + g) * 2048;
            float acc = p.cb1[kv * 128 + j];
            for (int k = 0; k < 2048; ++k) acc += fl[k] * w[(size_t)k * 128];
            hid[(kv * 2 + g) * 128 + j] = gelu_tanh(acc);
        }
        __syncthreads();
        if (tid < 256) {
            const int kv = tid >> 7, g = (tid >> 6) & 1, d = tid & 63;
            const float* w = p.cw2 + (size_t)kv * 128 * 64 + d;
            const float* hh = hid + (kv * 2 + g) * 128;
            float acc = 0.f;
            for (int j = 0; j < 128; ++j) acc += hh[j] * w[j * 64];
            res[(kv * 2 + g) * 64 + d] = acc;
        }
        __syncthreads();
        if (tid < 256) {
            const int kv = tid >> 7, g = (tid >> 6) & 1, d = tid & 63;
            const float* rr = res + (kv * 2 + g) * 64;
            float v = rr[d];
            if (kv == 0) {
                const int pos = (c + 1) * 32 - 1; const float2 cs = p.ROPE[pos * 32 + (d & 31)];
                const float x1 = rr[d & 31], x2 = rr[(d & 31) + 32];
                v = (d < 32) ? (x1 * cs.x - x2 * cs.y) : (x2 * cs.x + x1 * cs.y);
                p.CK[(((size_t)s * 512 + c) * 2 + g) * 64 + d] = v;
                if (s == 0) p.CKF[(size_t)g * 512 * 64 + kfrag_elem(c, d)] = (bf16)f2bf(v);
            } else { p.CV[(((size_t)s * 512 + c) * 2 + g) * 64 + d] = v; if (s == 0) p.CVF[(size_t)g * 512 * 64 + vfrag_elem(c, d)] = (bf16)f2bf(v); }
        }
        __syncthreads();
    }
}

__device__ __forceinline__ void ph_gdn_prep(const KP& p, const Fr& F) {
    const float* H0 = p.BIGF; const int lane = F.lane;
    for (int item = T * 8 + F.gw; item < TS * 8; item += F.NGW) {
        const int r = item >> 3, h = item & 7;
        const bool smp = r >= T; const int b = r - T;
        float cv[3];
#pragma unroll
        for (int part = 0; part < 3; ++part) {
            const int ch = part * 512 + h * 64 + lane;
            float acc = 0.f;
#pragma unroll
            for (int j = 0; j < 4; ++j) {
                float u;
                if (!smp) { const int t = r + j - 3; u = (t >= 0) ? H0[(size_t)t * PA + C_GQKV + ch] : 0.f; }
                else { u = (j < 3) ? p.st_gconv[((size_t)b * 3 + j) * 1536 + ch] : H0[(size_t)r * PA + C_GQKV + ch]; }
                acc += p.gconv_w[j * 1536 + ch] * u;
            }
            cv[part] = siluf_(acc);
        }
        const float qn = wave_sum(cv[0] * cv[0]), kn = wave_sum(cv[1] * cv[1]);
        const size_t o = ((size_t)r * 8 + h) * 64 + lane;
        p.GQ[o] = cv[0] * rsqrtf(qn + NORM_EPS) * 0.125f;
        p.GK[o] = cv[1] * rsqrtf(kn + NORM_EPS);
        p.GV[o] = cv[2];
        if (lane == 0) {
            const float av = H0[(size_t)r * PA + C_A + h], bt = H0[(size_t)r * PA + C_BT + h];
            p.Gg[(size_t)r * 8 + h] = -expf(p.gA[h]) * softplusf_(av + p.gdt[h]);
            p.Gb[(size_t)r * 8 + h] = sigmoidf_(bt);
        }
    }
    const size_t gt = (size_t)F.tgt, GT = (size_t)F.tGT;
    for (size_t idx = gt; idx < (size_t)3 * 1536; idx += GT) {
        const int j = (int)(idx / 1536), ch = (int)(idx % 1536);
        p.out[O_GCONV_P + idx] = h0f(p, T - 3 + j, C_GQKV + ch);
    }
    for (size_t idx = gt; idx < (size_t)NSMP * 3 * 1536; idx += GT) {
        const int b = (int)(idx / (3 * 1536)), j = (int)((idx / 1536) % 3), ch = (int)(idx % 1536);
        p.out[O_GCONV_S + idx] = (j < 2) ? p.st_gconv[((size_t)b * 3 + j + 1) * 1536 + ch] : H0[(size_t)(T + b) * PA + C_GQKV + ch];
    }
}

template <int NH, class KF>
__device__ __forceinline__ void wave_attend(const float* qs, float* sc, int scstride, int nkeys, KF kf, float (&outv)[NH], float (&den)[NH], int lane, float* mxout = nullptr) {
    float mx[NH];
#pragma unroll
    for (int h = 0; h < NH; ++h) mx[h] = -INFINITY;
    for (int j = lane; j < nkeys; j += 64) {
        const float *kp, *vp; const bool ok = kf(j, kp, vp);
        float s[NH];
#pragma unroll
        for (int h = 0; h < NH; ++h) s[h] = 0.f;
        if (ok) {
            for (int d4 = 0; d4 < 16; ++d4) {
                const float4 kvv = ((const float4*)kp)[d4];
#pragma unroll
                for (int h = 0; h < NH; ++h) { const float* q = qs + h * 64 + d4 * 4; s[h] += kvv.x * q[0] + kvv.y * q[1] + kvv.z * q[2] + kvv.w * q[3]; }
            }
        }
#pragma unroll
        for (int h = 0; h < NH; ++h) { const float v = ok ? s[h] * 0.125f : -INFINITY; sc[h * scstride + j] = v; mx[h] = fmaxf(mx[h], v); }
    }
#pragma unroll
    for (int h = 0; h < NH; ++h) { mx[h] = wave_max(mx[h]); if (!(mx[h] > -INFINITY)) mx[h] = 0.f; if (mxout) mxout[h] = mx[h]; }
    float sm[NH];
#pragma unroll
    for (int h = 0; h < NH; ++h) sm[h] = 0.f;
    for (int j = lane; j < nkeys; j += 64) {
#pragma unroll
        for (int h = 0; h < NH; ++h) { const float v = sc[h * scstride + j]; const float pp = (v == -INFINITY) ? 0.f : expf(v - mx[h]); sc[h * scstride + j] = pp; sm[h] += pp; }
    }
#pragma unroll
    for (int h = 0; h < NH; ++h) { sm[h] = wave_sum(sm[h]); den[h] = sm[h] > 0.f ? sm[h] : 1.f; }
    wave_lds_sync();
    {
        const int kq = lane >> 4, d4 = lane & 15;
        float4 acc[NH];
#pragma unroll
        for (int h = 0; h < NH; ++h) acc[h] = make_float4(0.f, 0.f, 0.f, 0.f);
        for (int j0 = 0; j0 < nkeys; j0 += 32) {
            float4 v[8];
#pragma unroll
            for (int u = 0; u < 8; ++u) { const int j = j0 + 4 * u + kq; const float *kp, *vp; const bool ok = (j < nkeys) && kf(j, kp, vp);
                v[u] = ok ? *(const float4*)(vp + 4 * d4) : make_float4(0.f, 0.f, 0.f, 0.f); }
#pragma unroll
            for (int u = 0; u < 8; ++u) { const int j = j0 + 4 * u + kq;
#pragma unroll
                for (int h = 0; h < NH; ++h) { const float pp = (j < nkeys) ? sc[h * scstride + j] : 0.f;
                    acc[h].x += pp * v[u].x; acc[h].y += pp * v[u].y; acc[h].z += pp * v[u].z; acc[h].w += pp * v[u].w; } }
        }
#pragma unroll
        for (int h = 0; h < NH; ++h) {
            float4 a = acc[h];
            a.x += __shfl_xor(a.x, 16); a.y += __shfl_xor(a.y, 16); a.z += __shfl_xor(a.z, 16); a.w += __shfl_xor(a.w, 16);
            a.x += __shfl_xor(a.x, 32); a.y += __shfl_xor(a.y, 32); a.z += __shfl_xor(a.z, 32); a.w += __shfl_xor(a.w, 32);
            const float x0 = __shfl(a.x, lane >> 2), x1 = __shfl(a.y, lane >> 2), x2 = __shfl(a.z, lane >> 2), x3 = __shfl(a.w, lane >> 2);
            const int cc = lane & 3; outv[h] = cc == 0 ? x0 : (cc == 1 ? x1 : (cc == 2 ? x2 : x3));
        }
    }
#pragma unroll
    for (int h = 0; h < NH; ++h) outv[h] /= den[h];
    wave_lds_sync();
}

__device__ __forceinline__ void nsa_smp_cs(const KP& p, int b, int g, float* wl, int lane) {
    float* qs = wl; float* sc = wl + 256; float* imp = wl + 256 + 4 * 1088; int* sel = (int*)(wl + 256 + 4 * 1088 + 320); long long* bb = (long long*)(wl + 256 + 4 * 1088 + 320 + 16);
    const int r = T + b; const int qpos = T;
    const float* grow = p.BIGF + (size_t)r * PA + C_GATE;
#pragma unroll
    for (int h = 0; h < 4; ++h) qs[h * 64 + lane] = p.QR[(size_t)r * 512 + (g * 4 + h) * 64 + lane];
    wave_lds_sync();
    float ocmp[4], oslc[4], den[4];
    {
        const float* CKp = p.CK + (size_t)(1 + b) * 512 * 128; const float* CVp = p.CV + (size_t)(1 + b) * 512 * 128;
        auto kf = [&](int j, const float*& kp, const float*& vp) -> bool { kp = CKp + (j * 2 + g) * 64; vp = CVp + (j * 2 + g) * 64; return true; };
        wave_attend<4>(qs, sc, 1088, 512, kf, ocmp, den, lane);
        for (int blk = lane; blk < 320; blk += 64) {
            float v = 0.f;
            if (blk < 256) {
#pragma unroll
                for (int h = 0; h < 4; ++h) v += (sc[h * 1088 + 2 * blk] + sc[h * 1088 + 2 * blk + 1]) / den[h];
            }
            imp[blk] = v;
        }
        wave_lds_sync();
    }
    {
        const int cur = qpos >> 6;
        float val[5];
#pragma unroll
        for (int j = 0; j < 5; ++j) { const int blk = lane + 64 * j; val[j] = (blk >= 1 && blk <= cur - 2) ? imp[blk] : -1.f; }
        if (lane == 0) { sel[0] = 0; sel[1] = cur; sel[2] = cur - 1; }
        for (int n = 3; n < 16; ++n) {
            float bv = -2.f; int bi = 0x7fffffff;
#pragma unroll
            for (int j = 0; j < 5; ++j) if (val[j] > bv) { bv = val[j]; bi = lane + 64 * j; }
#pragma unroll
            for (int o = 1; o < 64; o <<= 1) { const float ov = __shfl_xor(bv, o); const int oi = __shfl_xor(bi, o); if (ov > bv || (ov == bv && oi < bi)) { bv = ov; bi = oi; } }
#pragma unroll
            for (int j = 0; j < 5; ++j) if (lane + 64 * j == bi) val[j] = -3.f;
            if (lane == 0) sel[n] = bi;
        }
        wave_lds_sync();
        if (lane < 16) { const int blk = sel[lane]; long long o = 0;
            if (blk < 256) { const int page = p.page_table[b * NPAGES + (blk >> 1)]; o = ((long long)page * 128 + (blk & 1) * 64) * 256; }
            bb[lane] = o; }
        wave_lds_sync();
    }
    {
        auto kf = [&](int j, const float*& kp, const float*& vp) -> bool {
            const int blk = sel[j >> 6]; const int pos = blk * 64 + (j & 63); if (pos > qpos) return false;
            if (pos == T) { kp = p.KS + (size_t)r * 128 + g * 64; vp = p.VS + (size_t)r * 128 + g * 64; return true; }
            const float* base = p.cache_slc + bb[j >> 6] + (j & 63) * 256;
            kp = base + g * 64; vp = base + 128 + g * 64; return true; };
        wave_attend<4>(qs, sc, 1088, 1024, kf, oslc, den, lane);
    }
#pragma unroll
    for (int h = 0; h < 4; ++h) {
        const int hh = g * 4 + h;
        p.SMIXF[((size_t)b * 3 + 0) * 512 + hh * 64 + lane] = sigmoidf_(grow[hh]) * ocmp[h];
        p.SMIXF[((size_t)b * 3 + 1) * 512 + hh * 64 + lane] = sigmoidf_(grow[8 + hh]) * oslc[h];
    }
    wave_lds_sync();
}
__device__ __forceinline__ void nsa_smp_win(const KP& p, int b, int g, float* wl, int lane) {
    float* qs = wl; float* sc = wl + 256;
    const int r = T + b;
    const float* grow = p.BIGF + (size_t)r * PA + C_GATE;
#pragma unroll
    for (int h = 0; h < 4; ++h) qs[h * 64 + lane] = p.QR[(size_t)r * 512 + (g * 4 + h) * 64 + lane];
    wave_lds_sync();
    float owin[4], den[4];
    auto kf = [&](int j, const float*& kp, const float*& vp) -> bool {
        if (j == 512) { kp = p.KW + (size_t)r * 128 + g * 64; vp = p.VW + (size_t)r * 128 + g * 64; return true; }
        const float* base = p.st_win + ((size_t)b * 512 + j) * 256;
        kp = base + g * 64; vp = base + 128 + g * 64; return true; };
    wave_attend<4>(qs, sc, 528, 513, kf, owin, den, lane);
#pragma unroll
    for (int h = 0; h < 4; ++h) { const int hh = g * 4 + h; p.SMIXF[((size_t)b * 3 + 2) * 512 + hh * 64 + lane] = sigmoidf_(grow[16 + hh]) * owin[h]; }
    wave_lds_sync();
}

__device__ __forceinline__ void gdn_scan_item(const KP& p, int item, float* wl, int lane) {
    asm volatile("" : "+v"(lane));
    float* kq = wl;
    const int b = (item >> 3) - 1, h = item & 7;
    const int r = T + b; const size_t o = ((size_t)r * 8 + h) * 64;
    kq[lane] = p.GK[o + lane]; kq[64 + lane] = p.GQ[o + lane];
    wave_lds_sync();
    const float dec = expf(p.Gg[(size_t)r * 8 + h]), bt = p.Gb[(size_t)r * 8 + h];
    const float* Sp = p.st_gS + ((size_t)b * 8 + h) * 4096 + lane;
    float* so = p.out + O_GS_S + ((size_t)b * 8 + h) * 4096 + lane;
    float S[64]; float kv = 0.f;
#pragma unroll
    for (int i = 0; i < 64; ++i) { S[i] = Sp[i * 64] * dec; kv += kq[i] * S[i]; }
    const float vn = (p.GV[o + lane] - kv) * bt;
    float ov = 0.f;
#pragma unroll
    for (int i = 0; i < 64; ++i) { const float sn = S[i] + kq[i] * vn; ov += kq[64 + i] * sn; so[i * 64] = sn; }
    p.OG[o + lane] = ov;
    wave_lds_sync();
}

constexpr int GDN_WL = 34816;
__device__ __forceinline__ int kperm(int ks, int grp, int j) { return 32 * ks + 16 * (j >> 2) + 4 * grp + (j & 3); }

__device__ __forceinline__ void gdn_chunk_unit(const KP& p, int unit, unsigned char* ldsb, int woff, int lane) {
    asm volatile("" : "+v"(lane), "+s"(woff));
    unsigned char* wlb = ldsb + woff;
    const int n = unit >> 3, h = unit & 7, t0 = 64 * n;
    const int l15 = lane & 15, grp = lane >> 4;
    float* Af = (float*)wlb; bf16* kt = (bf16*)(wlb + 16384); bf16* qt = kt + 64 * 72; bf16* tmp = (bf16*)wlb;
    {
        const float* H0 = p.BIGF;
        float w[3][4], u1[3], u2[3], u3[3];
#pragma unroll
        for (int part = 0; part < 3; ++part) {
            const int ch = part * 512 + h * 64 + lane;
#pragma unroll
            for (int j = 0; j < 4; ++j) w[part][j] = p.gconv_w[j * 1536 + ch];
            u1[part] = (t0 >= 1) ? h0f(p, t0 - 1, C_GQKV + ch) : 0.f;
            u2[part] = (t0 >= 2) ? h0f(p, t0 - 2, C_GQKV + ch) : 0.f;
            u3[part] = (t0 >= 3) ? h0f(p, t0 - 3, C_GQKV + ch) : 0.f;
        }
        int roff = 0;
#pragma unroll 4
        for (int i = 0; i < 64; ++i) {
            float cv[3];
#pragma unroll
            for (int part = 0; part < 3; ++part) {
                const float u0 = __uint_as_float((unsigned)p.H0B[(size_t)t0 * PAP + C_GQKV + part * 512 + h * 64 + lane + roff] << 16);
                cv[part] = siluf_(w[part][0] * u3[part] + w[part][1] * u2[part] + w[part][2] * u1[part] + w[part][3] * u0);
                u3[part] = u2[part]; u2[part] = u1[part]; u1[part] = u0;
            }
            roff += PAP; asm volatile("" : "+s"(roff));
            const float qn = wave_sum(cv[0] * cv[0]), kn = wave_sum(cv[1] * cv[1]);
            qt[i * 72 + lane] = (bf16)f2bf(cv[0] * rsqrtf(qn + NORM_EPS) * 0.125f);
            kt[i * 72 + lane] = (bf16)f2bf(cv[1] * rsqrtf(kn + NORM_EPS));
            p.GV[((size_t)(t0 + i) * 8 + h) * 64 + lane] = cv[2];
        }
    }
    const float gl_ = -fexp_(p.gA[h]) * softplusf_(h0f(p, t0 + lane, C_A + h) + p.gdt[h]);
    const float beta = sigmoidf_(h0f(p, t0 + lane, C_BT + h));
    float gc = gl_;
#pragma unroll
    for (int o = 1; o < 64; o <<= 1) { const float tv = __shfl_up(gc, o); if (lane >= o) gc += tv; }
    const float gclast = __shfl(gc, 63);
#define GPAD(i) ((float*)(kt + (i) * 72 + 64))
    { float* pd = GPAD(lane); pd[0] = gc; pd[1] = beta; pd[2] = fexp_(gc); pd[3] = fexp_(gclast - gc); }
    wave_lds_sync();
    bf16* QKF = p.G_QKF + (size_t)unit * 4096;
#pragma unroll
    for (int it = 0; it < 4; ++it) {
        const int i = 16 * it + l15;
        const float gci = GPAD(i)[0], bi = GPAD(i)[1];
        bf16x8 bk[2], bq[2];
#pragma unroll
        for (int ks = 0; ks < 2; ++ks) { bk[ks] = *(const bf16x8*)(kt + i * 72 + 32 * ks + 8 * grp); bq[ks] = *(const bf16x8*)(qt + i * 72 + 32 * ks + 8 * grp); }
#pragma unroll
        for (int jt = 0; jt < 4; ++jt) {
            uint2 qkp = make_uint2(0u, 0u);
            if (jt <= it) {
                bf16x8 ak[2];
#pragma unroll
                for (int ks = 0; ks < 2; ++ks) ak[ks] = *(const bf16x8*)(kt + (16 * jt + l15) * 72 + 32 * ks + 8 * grp);
                f32x4 aa = {0.f, 0.f, 0.f, 0.f}, aq = {0.f, 0.f, 0.f, 0.f};
                aa = MFMA16(ak[0], bk[0], aa); aa = MFMA16(ak[1], bk[1], aa);
                aq = MFMA16(ak[0], bq[0], aq); aq = MFMA16(ak[1], bq[1], aq);
                f32x4 av, qv;
#pragma unroll
                for (int r = 0; r < 4; ++r) {
                    const int j = 16 * jt + 4 * grp + r; const float gcj = GPAD(j)[0];
                    const float e = (j <= i) ? fexp_(gci - gcj) : 0.f;
                    av[r] = (j < i) ? bi * aa[r] * e : 0.f; qv[r] = aq[r] * e;
                }
                *(f32x4*)(Af + i * 64 + 16 * jt + 4 * grp) = av;
                qkp.x = pk2(qv[0], qv[1]); qkp.y = pk2(qv[2], qv[3]);
            }
            *(uint2*)(QKF + ((size_t)(it * 2 + (jt >> 1)) * 64 + lane) * 8 + (jt & 1) * 4) = qkp;
        }
    }
    wave_lds_sync();
    {
        float* UF = p.G_UF + (size_t)unit * 4096;
        const int vq = lane >> 4;
#pragma unroll
        for (int pass = 0; pass < 2; ++pass) {
            float x[64];
            int goff = 0;
#pragma unroll
            for (int i = 0; i < 64; ++i) {
                const float bi = GPAD(i)[1];
                float acc;
                if (pass == 0) { acc = p.GV[((size_t)t0 * 8 + h) * 64 + lane + goff] * bi; goff += 512; asm volatile("" : "+s"(goff)); }
                else { const float ei = GPAD(i)[2];
                       acc = __uint_as_float((unsigned)kt[i * 72 + lane] << 16) * bi * ei; }
#pragma unroll
                for (int jj = 0; jj < (i + 3) / 4; ++jj) {
                    const float4 a4 = *(const float4*)(Af + i * 64 + 4 * jj);
                    acc -= a4.x * x[4 * jj + 0];
                    if (4 * jj + 1 < i) acc -= a4.y * x[4 * jj + 1];
                    if (4 * jj + 2 < i) acc -= a4.z * x[4 * jj + 2];
                    if (4 * jj + 3 < i) acc -= a4.w * x[4 * jj + 3];
                }
                x[i] = acc;
                if ((i & 3) == 3) asm volatile("" ::: "memory");
            }
            if (pass == 0) {
#pragma unroll
                for (int c4 = 0; c4 < 16; ++c4) {
                    const int mt = c4 >> 2, lp = l15 + 16 * (c4 & 3);
                    *(f32x4*)(UF + ((size_t)(vq * 4 + mt) * 64 + lp) * 4) = (f32x4){x[4 * c4], x[4 * c4 + 1], x[4 * c4 + 2], x[4 * c4 + 3]};
                }
            } else {
                wave_lds_sync();
#pragma unroll
                for (int c = 0; c < 64; ++c) tmp[c * 72 + lane] = (bf16)f2bf(-x[c]);
            }
            asm volatile("" ::: "memory");
        }
    }
    wave_lds_sync();
    {
        bf16* WF = p.G_WF + (size_t)unit * 4096; bf16* QGF = p.G_QGF + (size_t)unit * 4096; bf16* KDF = p.G_KDF + (size_t)unit * 4096;
#pragma unroll
        for (int mt = 0; mt < 4; ++mt) {
            const float egc = GPAD(16 * mt + l15)[2];
#pragma unroll
            for (int ks = 0; ks < 2; ++ks) {
                const int c = 16 * mt + l15, k0 = 32 * ks + 4 * grp;
                const uint2 w0 = *(const uint2*)(tmp + c * 72 + k0), w1 = *(const uint2*)(tmp + c * 72 + k0 + 16);
                v4u wv; wv.x = w0.x; wv.y = w0.y; wv.z = w1.x; wv.w = w1.y;
                *(v4u*)(WF + ((size_t)(mt * 2 + ks) * 64 + lane) * 8) = wv;
                const uint2 q0 = *(const uint2*)(qt + c * 72 + k0), q1 = *(const uint2*)(qt + c * 72 + k0 + 16);
                v4u qv;
                qv.x = pk2(__uint_as_float(q0.x << 16) * egc, __uint_as_float(q0.x & 0xffff0000u) * egc); qv.y = pk2(__uint_as_float(q0.y << 16) * egc, __uint_as_float(q0.y & 0xffff0000u) * egc);
                qv.z = pk2(__uint_as_float(q1.x << 16) * egc, __uint_as_float(q1.x & 0xffff0000u) * egc); qv.w = pk2(__uint_as_float(q1.y << 16) * egc, __uint_as_float(q1.y & 0xffff0000u) * egc);
                *(v4u*)(QGF + ((size_t)(mt * 2 + ks) * 64 + lane) * 8) = qv;
                float kd[8];
#pragma unroll
                for (int j = 0; j < 8; ++j) { const int cc = kperm(ks, grp, j); kd[j] = __uint_as_float((unsigned)kt[cc * 72 + 16 * mt + l15] << 16) * GPAD(cc)[3]; }
                v4u kv; kv.x = pk2(kd[0], kd[1]); kv.y = pk2(kd[2], kd[3]); kv.z = pk2(kd[4], kd[5]); kv.w = pk2(kd[6], kd[7]);
                *(v4u*)(KDF + ((size_t)(mt * 2 + ks) * 64 + lane) * 8) = kv;
            }
        }
        if (lane == 0) p.G_GL[unit] = fexp_(gclast);
    }
    wave_lds_sync();
#undef GPAD
}

constexpr int CH_SLOT = 32768;
__device__ __forceinline__ void gdn_chain_wg(const KP& p, int h, int wave, int lane, unsigned char* ldsb) {
    asm volatile("" : "+v"(lane));
    const int l15 = lane & 15, grp = lane >> 4;
    float* GLs = (float*)(ldsb + 4 * CH_SLOT);
    if (wave < 4) GLs[wave * 64 + lane] = p.G_GL[(size_t)(wave * 64 + lane) * 8 + h];
#define CH_BAR() do { asm volatile("s_waitcnt lgkmcnt(0)" ::: "memory"); __builtin_amdgcn_s_barrier(); asm volatile("" ::: "memory"); } while (0)
    if (wave >= 4) {
        const int lw = wave - 4;
        const unsigned char* gb = (lw == 0) ? (const unsigned char*)p.G_WF : (lw == 1) ? (const unsigned char*)p.G_KDF : (const unsigned char*)p.G_UF + (size_t)(lw - 2) * 8192;
        const size_t ustride = (lw < 2) ? 8192 : 16384;
        gb += (size_t)h * ustride + (size_t)lane * 16;
        auto src = [&](int n, int k) -> const v4u* { return (const v4u*)(gb + (size_t)n * 8 * ustride + k * 1024); };
        v4u rs[4][8];
#pragma unroll
        for (int j = 0; j < 4; ++j)
#pragma unroll
            for (int k = 0; k < 8; ++k) rs[j][k] = *src(j, k);
#pragma unroll
        for (int j = 0; j < 2; ++j) {
#pragma unroll
            for (int k = 0; k < 8; ++k) { *(v4u*)(ldsb + j * CH_SLOT + (lw * 512 + k * 64 + lane) * 16) = rs[j][k]; rs[j][k] = *src(4 + j, k); }
        }
        CH_BAR();
        for (int n0 = 0; n0 < 256; n0 += 4) {
#pragma unroll
            for (int j = 0; j < 4; ++j) {
                const int n = n0 + j, st = n + 2;
                if (st < 256) {
                    const int set = (j + 2) & 3;
#pragma unroll
                    for (int k = 0; k < 8; ++k) { *(v4u*)(ldsb + (st & 3) * CH_SLOT + (lw * 512 + k * 64 + lane) * 16) = rs[set][k]; if (st + 4 < 256) rs[set][k] = *src(st + 4, k); }
                }
                CH_BAR();
            }
        }
#undef CH_BAR
        return;
    }
    const int vq = wave;
    f32x4 S[4];
#pragma unroll
    for (int i = 0; i < 4; ++i) S[i] = (f32x4){0.f, 0.f, 0.f, 0.f};
    asm volatile("s_waitcnt lgkmcnt(0)" ::: "memory"); __builtin_amdgcn_s_barrier(); asm volatile("" ::: "memory");
    for (int n = 0; n < 256; ++n) {
        const unsigned char* sl = ldsb + (n & 3) * CH_SLOT;
        bf16x8 wf[4][2], kdf[4][2]; f32x4 uf[4];
#pragma unroll
        for (int mt = 0; mt < 4; ++mt) {
#pragma unroll
            for (int ks = 0; ks < 2; ++ks) { wf[mt][ks] = *(const bf16x8*)(sl + ((mt * 2 + ks) * 64 + lane) * 16); kdf[mt][ks] = *(const bf16x8*)(sl + 8192 + ((mt * 2 + ks) * 64 + lane) * 16); }
            uf[mt] = *(const f32x4*)(sl + 16384 + ((vq * 4 + mt) * 64 + lane) * 16);
        }
        const float gl = GLs[n];
        const size_t fo = ((size_t)((n * 8 + h) * 4 + vq) * 2) * 512;
        bf16x8 sB[2];
#pragma unroll
        for (int ks = 0; ks < 2; ++ks) { sB[ks] = pack_p(S[2 * ks], S[2 * ks + 1]); *(bf16x8*)(p.G_SPF + fo + ((size_t)ks * 64 + lane) * 8) = sB[ks]; }
        f32x4 v[4];
#pragma unroll
        for (int mt = 0; mt < 4; ++mt) { v[mt] = uf[mt]; v[mt] = MFMA16(wf[mt][0], sB[0], v[mt]); v[mt] = MFMA16(wf[mt][1], sB[1], v[mt]); }
        bf16x8 vB[2];
#pragma unroll
        for (int ks = 0; ks < 2; ++ks) { vB[ks] = pack_p(v[2 * ks], v[2 * ks + 1]); *(bf16x8*)(p.G_VNF + fo + ((size_t)ks * 64 + lane) * 8) = vB[ks]; }
#pragma unroll
        for (int mt = 0; mt < 4; ++mt) { S[mt] = S[mt] * gl; S[mt] = MFMA16(kdf[mt][0], vB[0], S[mt]); S[mt] = MFMA16(kdf[mt][1], vB[1], S[mt]); }
        asm volatile("s_waitcnt lgkmcnt(0)" ::: "memory"); __builtin_amdgcn_s_barrier(); asm volatile("" ::: "memory");
    }
    float* so = p.out + O_GS_P + (size_t)h * 4096;
#pragma unroll
    for (int mt = 0; mt < 4; ++mt)
#pragma unroll
        for (int r = 0; r < 4; ++r) so[(16 * mt + 4 * grp + r) * 64 + 16 * vq + l15] = S[mt][r];
}

__device__ __forceinline__ void gdn_out_unit(const KP& p, int unit, int lane) {
    asm volatile("" : "+v"(lane));
    const int n = unit >> 3, h = unit & 7, t0 = 64 * n; const int l15 = lane & 15, grp = lane >> 4;
    const bf16* QGF = p.G_QGF + (size_t)unit * 4096; const bf16* QKF = p.G_QKF + (size_t)unit * 4096;
    f32x4 o[4][4];
#pragma unroll
    for (int mt = 0; mt < 4; ++mt)
#pragma unroll
        for (int vq = 0; vq < 4; ++vq) o[mt][vq] = (f32x4){0.f, 0.f, 0.f, 0.f};
#pragma unroll
    for (int ks = 0; ks < 2; ++ks) {
        bf16x8 sp[4], vn[4];
#pragma unroll
        for (int vq = 0; vq < 4; ++vq) { const size_t fo = ((size_t)(unit * 4 + vq) * 2 + ks) * 512 + (size_t)lane * 8; sp[vq] = *(const bf16x8*)(p.G_SPF + fo); vn[vq] = *(const bf16x8*)(p.G_VNF + fo); }
#pragma unroll
        for (int mt = 0; mt < 4; ++mt) {
            const bf16x8 qg = *(const bf16x8*)(QGF + ((size_t)(mt * 2 + ks) * 64 + lane) * 8), qk = *(const bf16x8*)(QKF + ((size_t)(mt * 2 + ks) * 64 + lane) * 8);
#pragma unroll
            for (int vq = 0; vq < 4; ++vq) { o[mt][vq] = MFMA16(qg, sp[vq], o[mt][vq]); o[mt][vq] = MFMA16(qk, vn[vq], o[mt][vq]); }
        }
    }
    float nw[4];
#pragma unroll
    for (int vq = 0; vq < 4; ++vq) nw[vq] = p.gnw[16 * vq + l15];
#pragma unroll
    for (int mt = 0; mt < 4; ++mt)
#pragma unroll
        for (int r = 0; r < 4; ++r) {
            float ss = 0.f;
#pragma unroll
            for (int vq = 0; vq < 4; ++vq) ss += o[mt][vq][r] * o[mt][vq][r];
            ss += __shfl_xor(ss, 1); ss += __shfl_xor(ss, 2); ss += __shfl_xor(ss, 4); ss += __shfl_xor(ss, 8);
            const float rs = rsqrtf(ss * (1.f / 64.f) + NORM_EPS);
            const int t = t0 + 16 * mt + 4 * grp + r;
            const float* zr = p.ZF + (size_t)t * 512 + h * 64;
#pragma unroll
            for (int vq = 0; vq < 4; ++vq) p.MIXB[(size_t)t * 1024 + 512 + h * 64 + 16 * vq + l15] = (bf16)f2bf(o[mt][vq][r] * rs * nw[vq] * siluf_(zr[16 * vq + l15]));
        }
}

#define MFMA8(a, b, c) __builtin_amdgcn_mfma_f32_16x16x32_fp8_fp8((a), (b), (c), 0, 0, 0)
__device__ __forceinline__ long pack_fp8(const f32x4& a, const f32x4& b) {
    int w0 = 0, w1 = 0;
    w0 = __builtin_amdgcn_cvt_pk_fp8_f32(a[0], a[1], w0, false); w0 = __builtin_amdgcn_cvt_pk_fp8_f32(a[2], a[3], w0, true);
    w1 = __builtin_amdgcn_cvt_pk_fp8_f32(b[0], b[1], w1, false); w1 = __builtin_amdgcn_cvt_pk_fp8_f32(b[2], b[3], w1, true);
    return (long)(((unsigned long long)(unsigned)w1 << 32) | (unsigned long long)(unsigned)w0);
}
template <bool GEN>
__device__ __forceinline__ void nsa_slc_item8(const KP& p, int tq, int g, int lane) {
    asm volatile("" : "+v"(lane));
    const int l15 = lane & 15, grp = lane >> 4, hn = lane & 3;
    const unsigned char* KF = p.KS8 + (size_t)g * T * 64; const unsigned char* VF = p.VS8 + (size_t)g * T * 64;
    const int* selp = p.SEL + ((size_t)g * T + tq) * 16;
    int sb[16];
#pragma unroll
    for (int i = 0; i < 16; ++i) sb[i] = __builtin_amdgcn_readfirstlane(selp[i]);
    long qs[2];
#pragma unroll
    for (int ks = 0; ks < 2; ++ks) {
        const bf16x8 qb = *(const bf16x8*)(p.QB + (size_t)tq * 512 + (g * 4 + hn) * 64 + 32 * ks + 8 * grp);
        f32x4 a, b;
#pragma unroll
        for (int j = 0; j < 4; ++j) { a[j] = __uint_as_float((unsigned)(unsigned short)qb[j] << 16) * (1.f / QSCALE); b[j] = __uint_as_float((unsigned)(unsigned short)qb[4 + j] << 16) * (1.f / QSCALE); }
        qs[ks] = pack_fp8(a, b);
    }
    AttW a; attw_init(a);
    long kf[3][4][2], vf[3][2][4];
    auto issue = [&](int bi, int buf) {
        int blk = sb[bi]; if (GEN && (blk < 0 || blk * 64 > tq)) blk = 0;
        typedef long l2_t __attribute__((ext_vector_type(2)));
#pragma unroll
        for (int tl = 0; tl < 4; ++tl) { const l2_t x = *(const l2_t*)(KF + ((size_t)(blk * 4 + tl) * 64 + lane) * 16); kf[buf][tl][0] = x[0]; kf[buf][tl][1] = x[1]; }
#pragma unroll
        for (int dt = 0; dt < 4; ++dt) { const l2_t x = *(const l2_t*)(VF + ((size_t)(blk * 4 + dt) * 64 + lane) * 16); vf[buf][0][dt] = x[0]; vf[buf][1][dt] = x[1]; }
    };
    issue(0, 0); issue(1, 1);
#pragma unroll
    for (int bi = 0; bi < 16; ++bi) {
        const int buf = bi % 3;
        if (bi + 2 < 16) issue(bi + 2, (bi + 2) % 3);
        const int blk = sb[bi]; const int k0 = blk * 64;
        if (GEN && (blk < 0 || k0 > tq)) continue;
        const f32x4 z = {0.f, 0.f, 0.f, 0.f};
        f32x4 sc[4];
#pragma unroll
        for (int tl = 0; tl < 4; ++tl) { sc[tl] = MFMA8(kf[buf][tl][0], qs[0], z); sc[tl] = MFMA8(kf[buf][tl][1], qs[1], sc[tl]); }
        if (GEN ? (k0 + 63 > tq) : (bi == 1)) {
#pragma unroll
            for (int tl = 0; tl < 4; ++tl)
#pragma unroll
                for (int j = 0; j < 4; ++j) if (k0 + 16 * tl + 4 * grp + j > tq) sc[tl][j] = -INFINITY;
        }
        float mx = fmaxf(fmaxf(fmaxf(fmaxf(sc[0][0], sc[0][1]), fmaxf(sc[0][2], sc[0][3])), fmaxf(fmaxf(sc[1][0], sc[1][1]), fmaxf(sc[1][2], sc[1][3]))),
                         fmaxf(fmaxf(fmaxf(sc[2][0], sc[2][1]), fmaxf(sc[2][2], sc[2][3])), fmaxf(fmaxf(sc[3][0], sc[3][1]), fmaxf(sc[3][2], sc[3][3]))));
        mx = fmaxf(mx, __shfl_xor(mx, 16)); mx = fmaxf(mx, __shfl_xor(mx, 32));
        const float mn = fmaxf(a.m, mx * QSCALE);
        const float alpha = __builtin_amdgcn_exp2f(a.m - mn);
        const float mb = 7.f - mn;
        f32x4 pp[4]; float sum = 0.f;
#pragma unroll
        for (int tl = 0; tl < 4; ++tl) {
#pragma unroll
            for (int j = 0; j < 4; ++j) pp[tl][j] = __builtin_amdgcn_exp2f(fmaf(sc[tl][j], QSCALE, mb));
            sum += (pp[tl][0] + pp[tl][1]) + (pp[tl][2] + pp[tl][3]);
        }
        a.l = a.l * alpha + sum; a.m = mn;
        const long pf0 = pack_fp8(pp[0], pp[1]), pf1 = pack_fp8(pp[2], pp[3]);
#pragma unroll
        for (int dt = 0; dt < 4; ++dt) { a.o[dt] = a.o[dt] * alpha; a.o[dt] = MFMA8(vf[buf][0][dt], pf0, a.o[dt]); a.o[dt] = MFMA8(vf[buf][1][dt], pf1, a.o[dt]); }
    }
    const float lt = grp_sum(a.l);
    if (l15 < 4) {
        const float gs = sigmoidf_(h0f(p, tq, C_GATE + 8 + g * 4 + l15)) * (lt > 0.f ? 1.f / lt : 0.f);
#pragma unroll
        for (int dt = 0; dt < 4; ++dt) {
            const size_t o = (size_t)tq * 512 + g * 256 + l15 * 64 + 16 * dt + 4 * grp;
            const f32x4 base = *(const f32x4*)(p.NSACC + o); const f32x4 v = base + a.o[dt] * gs;
            uint2 w; w.x = pk2(v[0], v[1]); w.y = pk2(v[2], v[3]);
            *(uint2*)(p.MIXB + (size_t)tq * 1024 + g * 256 + l15 * 64 + 16 * dt + 4 * grp) = w;
        }
    }
}

__device__ __forceinline__ void ph_prep_chunks(const KP& p, const Fr& F) {
    if (F.wave < 4) { for (int unit = F.bid * 4 + F.wave; unit < 2048; unit += F.G * 4) gdn_chunk_unit(p, unit, F.lds, F.wave * GDN_WL, F.lane); }
    else {
        const int NP = F.G - 32;
        if (F.bid < NP) {
            Fr F2 = F; F2.tgt = F.bid * 256 + (F.tid - 256); F2.tGT = NP * 256; F2.gw = F.bid * 4 + (F.wave - 4); F2.NGW = NP * 4;
            ph_nsa_prep(p, F2); ph_nsa_prep_fast(p, F2); ph_gdn_prep(p, F2);
        } else { const int unit = (F.bid - NP) * 4 + (F.wave - 4); if (unit < 128) cmp_prompt_unit(p, unit, F.lane); }
    }
}
__device__ __forceinline__ void ph_mix_a(const KP& p, const Fr& F) {
    if (F.bid < 32) gdn_scan_item(p, (F.bid + 1) * 8 + F.wave, (float*)(F.lds + 8 * FAST_WL + 1024 + F.wave * 512), F.lane);
    float* wl = (float*)(F.lds + F.wave * FAST_WL);
    for (int unit = F.gw; unit < 2048; unit += F.NGW) nsa_fast_unit(p, unit, wl, F.lane);
}
__device__ __forceinline__ void ph_mix_b(const KP& p, const Fr& F) {
    if (F.bid < 8) { gdn_chain_wg(p, F.bid, F.wave, F.lane, F.lds); return; }
    if (F.bid < 24) {
        const int it = (F.bid - 8) * 4 + (F.wave & 3);
        if (F.wave < 4) nsa_smp_cs(p, it >> 1, it & 1, (float*)(F.lds + F.wave * 20480), F.lane);
        else nsa_smp_win(p, it >> 1, it & 1, (float*)(F.lds + 81920 + (F.wave - 4) * 12288), F.lane);
        return;
    }
    const int g = F.bid & 1, fr = (F.bid - 24) >> 1, NW = ((F.G - 24) >> 1) * 8;
    for (int tq = fr * 8 + F.wave; tq < T; tq += NW) { if (tq >= 1024) nsa_slc_item8<false>(p, tq, g, F.lane); else nsa_slc_item8<true>(p, tq, g, F.lane); }
}

__device__ __forceinline__ void ph_gdn_out(const KP& p, const Fr& F) {
    const float* H0 = p.BIGF; const int lane = F.lane;
    for (int unit = F.gw; unit < 2048; unit += F.NGW) gdn_out_unit(p, unit, lane);
    for (int idx = F.bid * NTHR + F.tid; idx < NSMP * 512; idx += F.G * NTHR) { const int b = idx >> 9, c = idx & 511; const float* sp = p.SMIXF + (size_t)b * 3 * 512 + c;
        p.MIXB[(size_t)(T + b) * 1024 + c] = (bf16)f2bf(sp[0] + sp[512] + sp[1024]); }
    for (int item = T * 8 + F.gw; item < TS * 8; item += F.NGW) {
        const int r = item >> 3, h = item & 7;
        const float o = p.OG[((size_t)r * 8 + h) * 64 + lane];
        const float ms = wave_sum(o * o) * (1.f / 64.f);
        const float z = H0[(size_t)r * PA + C_Z + h * 64 + lane];
        p.MIXB[(size_t)r * 1024 + 512 + h * 64 + lane] = (bf16)f2bf(o * rsqrtf(ms + NORM_EPS) * p.gnw[lane] * siluf_(z));
    }
}

__device__ __forceinline__ void ph_ln(const Fr& F, const float* Xp, const float* Xs, const float* Fm, const float* gam, const float* bet, float* outp, float* outs, bf16* ob) {
    const int lane = F.lane;
    for (int r = F.gw; r < TS; r += F.NGW) {
        const float4* xr = (const float4*)((r < T) ? Xp + (size_t)r * DM : Xs + (size_t)(r - T) * DM) + lane; const float4* fr = (const float4*)(Fm + (size_t)r * DM) + lane;
        f32x4 v[4]; float s = 0.f;
#pragma unroll
        for (int j = 0; j < 4; ++j) { const float4 x = xr[64 * j], f = fr[64 * j]; v[j] = (f32x4){DN_ALPHA * x.x + f.x, DN_ALPHA * x.y + f.y, DN_ALPHA * x.z + f.z, DN_ALPHA * x.w + f.w}; s += (v[j][0] + v[j][1]) + (v[j][2] + v[j][3]); }
        const float mean = wave_sum(s) * (1.f / DM); float q = 0.f;
#pragma unroll
        for (int j = 0; j < 4; ++j) { v[j] = v[j] - mean; q += (v[j][0] * v[j][0] + v[j][1] * v[j][1]) + (v[j][2] * v[j][2] + v[j][3] * v[j][3]); }
        const float rstd = rsqrtf(wave_sum(q) * (1.f / DM) + LN_EPS);
        float4* o = (float4*)((r < T) ? outp + (size_t)r * DM : outs + (size_t)(r - T) * DM) + lane;
#pragma unroll
        for (int j = 0; j < 4; ++j) { const float4 g4 = ((const float4*)gam)[lane + 64 * j], b4 = ((const float4*)bet)[lane + 64 * j];
            const float4 y = make_float4(v[j][0] * rstd * g4.x + b4.x, v[j][1] * rstd * g4.y + b4.y, v[j][2] * rstd * g4.z + b4.z, v[j][3] * rstd * g4.w + b4.w);
            o[64 * j] = y; if (ob) { uint2 w; w.x = pk2(y.x, y.y); w.y = pk2(y.z, y.w); *((uint2*)(ob + (size_t)r * DM) + lane + 64 * j) = w; } }
    }
}

__device__ __forceinline__ void ph_ffn_act(const KP& p, const Fr& F, int layer) {
    const float* U = p.BIGF; const float* cw = p.ffn_cw + (size_t)layer * 3 * DFF2; const float* cb = p.ffn_cb + (size_t)layer * DFF2;
    const size_t gt = (size_t)F.bid * NTHR + F.tid, GT = (size_t)F.G * NTHR;
    const size_t total = (size_t)TS * DFF;
    for (size_t idx = gt; idx < total; idx += GT) {
        const int r = (int)(idx / DFF), j = (int)(idx % DFF);
        const bool smp = r >= T; const int b = r - T;
        float c2[2];
#pragma unroll
        for (int half = 0; half < 2; ++half) {
            const int ch = half * DFF + j;
            float acc = cb[ch];
#pragma unroll
            for (int k = 0; k < 3; ++k) {
                float u;
                if (!smp) { const int t = r + k - 2; u = (t >= 0) ? U[(size_t)t * DFF2 + ch] : 0.f; }
                else u = (k < 2) ? p.st_ffn[(((size_t)b * 2 + layer) * 2 + k) * DFF2 + ch] : U[(size_t)r * DFF2 + ch];
                acc += cw[k * DFF2 + ch] * u;
            }
            c2[half] = acc;
        }
        p.HFFB[idx] = (bf16)f2bf(siluf_(c2[0]) * c2[1]);
    }
    for (size_t idx = gt; idx < (size_t)2 * DFF2; idx += GT) {
        const int k = (int)(idx / DFF2), ch = (int)(idx % DFF2);
        p.out[O_FFN_P + ((size_t)layer * 2 + k) * DFF2 + ch] = U[(size_t)(T - 2 + k) * DFF2 + ch];
    }
    for (size_t idx = gt; idx < (size_t)NSMP * 2 * DFF2; idx += GT) {
        const int b = (int)(idx / (2 * DFF2)), k = (int)((idx / DFF2) % 2), ch = (int)(idx % DFF2);
        p.out[O_FFN_S + (((size_t)b * 2 + layer) * 2 + k) * DFF2 + ch] =
            (k == 0) ? p.st_ffn[(((size_t)b * 2 + layer) * 2 + 1) * DFF2 + ch] : U[(size_t)(T + b) * DFF2 + ch];
    }
}

__device__ __forceinline__ void ph_dil_prep(const KP& p, const Fr& F) {
    const float* H1 = p.BIGF;
    const size_t gt = (size_t)F.bid * NTHR + F.tid, GT = (size_t)F.G * NTHR;
    const size_t total = (size_t)TS * 2048;
    for (size_t idx = gt + (size_t)T * 2048; idx < total; idx += GT) {
        const int r = (int)(idx >> 11), c = (int)(idx & 2047);
        const bool smp = r >= T; const int pos = smp ? T : r;
        const float* row = H1 + (size_t)r * 3072;
        const int i = c & 63; const float2 cs = p.ROPE[pos * 32 + (i & 31)];
        const float v = rope_val(row, c & ~63, i, cs);
        if (c < 1024) p.QD[(size_t)r * 1024 + c] = v; else p.KD[(size_t)r * 1024 + (c - 1024)] = v;
    }
}
__device__ __forceinline__ void ph_dil_cache(const KP& p, const Fr& F) {
    const float* H1 = p.BIGF;
    const size_t gt = (size_t)F.bid * NTHR + F.tid, GT = (size_t)F.G * NTHR;
    const size_t tots4 = (size_t)NSMP * 2048 * 512;
    for (size_t idx = gt; idx < tots4; idx += GT) {
        const int b = (int)(idx / (2048 * 512)); const int i = (int)((idx / 512) % 2048); const int c4 = (int)(idx % 512);
        float4 v;
        if (i < 2047) v = ((const float4*)p.st_dil)[((size_t)b * 2048 + i + 1) * 512 + c4];
        else { const int c = c4 * 4; const int r = T + b;
               v = (c < 1024) ? *(const float4*)(p.KD + (size_t)r * 1024 + c) : *(const float4*)(H1 + (size_t)r * 3072 + 2048 + (c - 1024)); }
        ((float4*)(p.out + O_DIL_S))[idx] = v;
    }
}
__device__ __forceinline__ void ph_dil_attn(const KP& p, const Fr& F) {
    const float* H1 = p.BIGF; const int lane = F.lane;
    float* qs = (float*)(F.lds + F.wave * 4096); float* sc = qs + 64;
    float* ex = (float*)(F.lds + 32768);
    const int il = F.wave / 3, gi = F.wave - 3 * il;
    const int item = F.bid * 2 + il; const int b = item >> 4, h = item & 15, r = T + b;
    if (F.wave < 6 && item < NSMP * 16) {
        qs[lane] = p.QD[(size_t)r * 1024 + h * 64 + lane];
        wave_lds_sync();
        const int dd = gi == 0 ? 1 : (gi == 1 ? 4 : 16);
        auto kf = [&](int j, const float*& kp, const float*& vp) -> bool {
            const int pos = T - j * dd;
            if (pos == T) { kp = p.KD + (size_t)r * 1024 + h * 64; vp = H1 + (size_t)r * 3072 + 2048 + h * 64; return true; }
            const float* base = p.st_dil + ((size_t)b * 2048 + (pos - (T - 2048))) * 2048;
            kp = base + h * 64; vp = base + 1024 + h * 64; return true; };
        float o[1], den[1], mx[1];
        wave_attend<1>(qs, sc, 448, 129, kf, o, den, lane, mx);
        float* e = ex + (il * 3 + gi) * 68;
        e[lane] = o[0] * den[0]; if (lane == 0) { e[64] = mx[0]; e[65] = den[0]; }
    }
    __syncthreads();
    if (F.wave < 6 && gi == 0 && item < NSMP * 16) {
        const float* e = ex + il * 3 * 68;
        const float m0 = e[64], m1 = e[68 + 64], m2 = e[136 + 64]; const float M = fmaxf(m0, fmaxf(m1, m2));
        const float w0 = expf(m0 - M), w1 = expf(m1 - M), w2 = expf(m2 - M);
        const float num = w0 * e[lane] + w1 * e[68 + lane] + w2 * e[136 + lane], dn = w0 * e[65] + w1 * e[68 + 65] + w2 * e[136 + 65];
        p.MIXB[(size_t)r * 1024 + h * 64 + lane] = (bf16)f2bf(num / dn);
    }
}

__device__ __forceinline__ void ph_dil_prep_fast(const KP& p, const Fr& F) {
    const float* H1 = p.BIGF;
    const size_t gt = (size_t)F.bid * NTHR + F.tid, GT = (size_t)F.G * NTHR;
    for (size_t idx = gt; idx < (size_t)T * 128; idx += GT) {
        const int t = (int)(idx >> 7), u = (int)(idx & 127);
        const int hq = u >> 2, d0 = (u & 3) * 8, c0 = hq * 64 + d0; const bf16* row = p.H1B + (size_t)t * 3072;
        const v4u ua = *(const v4u*)(row + c0), ub = *(const v4u*)(row + c0 + 32);
        const float4* rp = (const float4*)(p.ROPE + t * 32 + d0); const float4 r0 = rp[0], r1 = rp[1], r2 = rp[2], r3 = rp[3];
        float x1[8], x2[8];
#pragma unroll
        for (int e = 0; e < 4; ++e) { x1[2 * e] = __uint_as_float(ua[e] << 16); x1[2 * e + 1] = __uint_as_float(ua[e] & 0xffff0000u); x2[2 * e] = __uint_as_float(ub[e] << 16); x2[2 * e + 1] = __uint_as_float(ub[e] & 0xffff0000u); }
        const float cs[8] = {r0.x, r0.z, r1.x, r1.z, r2.x, r2.z, r3.x, r3.z}, sn[8] = {r0.y, r0.w, r1.y, r1.w, r2.y, r2.w, r3.y, r3.w};
        float lo[8], hi[8];
#pragma unroll
        for (int j = 0; j < 8; ++j) { lo[j] = x1[j] * cs[j] - x2[j] * sn[j]; hi[j] = x2[j] * cs[j] + x1[j] * sn[j]; }
        if (hq < 16) {
            v4u o; o.x = pk2(lo[0] * QSCALE, lo[1] * QSCALE); o.y = pk2(lo[2] * QSCALE, lo[3] * QSCALE); o.z = pk2(lo[4] * QSCALE, lo[5] * QSCALE); o.w = pk2(lo[6] * QSCALE, lo[7] * QSCALE);
            *(v4u*)(p.QDB + (size_t)t * 1024 + c0) = o;
            o.x = pk2(hi[0] * QSCALE, hi[1] * QSCALE); o.y = pk2(hi[2] * QSCALE, hi[3] * QSCALE); o.z = pk2(hi[4] * QSCALE, hi[5] * QSCALE); o.w = pk2(hi[6] * QSCALE, hi[7] * QSCALE);
            *(v4u*)(p.QDB + (size_t)t * 1024 + c0 + 32) = o;
        } else {
            const int h = hq - 16, kc = h * 64 + d0;
            v4u ol, oh; ol.x = pk2(lo[0], lo[1]); ol.y = pk2(lo[2], lo[3]); ol.z = pk2(lo[4], lo[5]); ol.w = pk2(lo[6], lo[7]);
            oh.x = pk2(hi[0], hi[1]); oh.y = pk2(hi[2], hi[3]); oh.z = pk2(hi[4], hi[5]); oh.w = pk2(hi[6], hi[7]);
#pragma unroll
            for (int pass = 0; pass < 3; ++pass) { const int sh = 2 * pass; const int pi = (t & ((1 << sh) - 1)) * (T >> sh) + (t >> sh);
                bf16* kb = (pass == 0 ? p.DKF[0] : pass == 1 ? p.DKF[1] : p.DKF[2]) + (size_t)h * T * 64;
                *(v4u*)(kb + kfrag_elem(pi, d0)) = ol; *(v4u*)(kb + kfrag_elem(pi, d0 + 32)) = oh; }
            if (t >= T - 2048) { float* op = p.out + O_DIL_P + (size_t)(t - (T - 2048)) * 2048 + kc;
                *(float4*)op = make_float4(lo[0], lo[1], lo[2], lo[3]); *(float4*)(op + 4) = make_float4(lo[4], lo[5], lo[6], lo[7]);
                *(float4*)(op + 32) = make_float4(hi[0], hi[1], hi[2], hi[3]); *(float4*)(op + 36) = make_float4(hi[4], hi[5], hi[6], hi[7]); }
        }
    }
    for (size_t idx = gt; idx < (size_t)2048 * 256; idx += GT) {
        const int i = (int)(idx >> 8), c4 = (int)(idx & 255);
        const uint2 uv = *(const uint2*)(p.H1B + (size_t)(T - 2048 + i) * 3072 + 2048 + c4 * 4);
        *(float4*)(p.out + O_DIL_P + (size_t)i * 2048 + 1024 + c4 * 4) = make_float4(__uint_as_float(uv.x << 16), __uint_as_float(uv.x & 0xffff0000u), __uint_as_float(uv.y << 16), __uint_as_float(uv.y & 0xffff0000u));
    }
    const int lane = F.lane, l15 = lane & 15, grp = lane >> 4;
    for (int unit = F.gw; unit < 3 * 16 * 512; unit += F.NGW) {
        const int st = unit & 511, h = (unit >> 9) & 15, pass = unit >> 13; const int sh = 2 * pass, Td = T >> sh;
        const int pi0 = 32 * st, r = pi0 / Td, s0 = pi0 - r * Td;
        bf16* dst = p.DVF[pass] + (size_t)h * T * 64;
#pragma unroll
        for (int dt = 0; dt < 4; ++dt) {
            unsigned v[8];
#pragma unroll
            for (int j = 0; j < 8; ++j) { const int s = s0 + 16 * (j >> 2) + 4 * grp + (j & 3); const int t = (s << sh) + r;
                v[j] = p.H1B[(size_t)t * 3072 + 2048 + h * 64 + 16 * dt + l15]; }
            v4u o; o.x = v[0] | (v[1] << 16); o.y = v[2] | (v[3] << 16); o.z = v[4] | (v[5] << 16); o.w = v[6] | (v[7] << 16);
            *(v4u*)(dst + vfrag_off(st, dt, lane)) = o;
        }
    }
}

__device__ __forceinline__ void dil_pass(const KP& p, int unit, int pass, unsigned char* ldsb, int w4, int lane) {
    asm volatile("" : "+v"(lane));
    const int h = unit & 15, P0 = (unit >> 4) * 256;
    const int l15 = lane & 15, grp = lane >> 4;
    float* stO = (float*)ldsb; float* stML = stO + 256 * 64;
    {
        const int sh = 2 * pass, Td = T >> sh;
        const bf16* KF = (pass == 0 ? p.DKF[0] : pass == 1 ? p.DKF[1] : p.DKF[2]) + (size_t)h * T * 64;
        const bf16* VF = (pass == 0 ? p.DVF[0] : pass == 1 ? p.DVF[1] : p.DVF[2]) + (size_t)h * T * 64;
        for (int tt = 0; tt < 4; ++tt) {
            const int tl = 4 * w4 + tt;
            const int r = tl >> (4 - sh), s0 = (P0 >> sh) + 16 * (tl & ((16 >> sh) - 1));
            const int sq = s0 + l15, tq = (sq << sh) + r, tloc = tq - P0;
            bf16x8 qf[2];
#pragma unroll
            for (int ks = 0; ks < 2; ++ks) qf[ks] = *(const bf16x8*)(p.QDB + (size_t)tq * 1024 + h * 64 + 32 * ks + 8 * grp);
            AttW a;
            if (pass == 0) attw_init(a);
            else {
#pragma unroll
                for (int dt = 0; dt < 4; ++dt) a.o[dt] = *(const f32x4*)(stO + tloc * 64 + 16 * dt + 4 * grp);
                a.m = stML[tloc * 2]; a.l = (grp == 0) ? stML[tloc * 2 + 1] : 0.f;
            }
            int kstart = s0 - 128; if (kstart < 0) kstart = 0; kstart &= ~31;
            const int nsteps = (s0 + 16 - kstart + 31) >> 5;
            const int base = r * Td;
            bf16x8 kf[3][2][2], vf[3][4];
            auto issue = [&](int s, int buf) {
                const int k0 = kstart + 32 * s;
#pragma unroll
                for (int tl2 = 0; tl2 < 2; ++tl2)
#pragma unroll
                    for (int ks = 0; ks < 2; ++ks) kf[buf][tl2][ks] = *(const bf16x8*)(KF + kfrag_off(((base + k0) >> 4) + tl2, ks, lane));
#pragma unroll
                for (int dt = 0; dt < 4; ++dt) vf[buf][dt] = *(const bf16x8*)(VF + vfrag_off((base + k0) >> 5, dt, lane));
            };
            issue(0, 0); if (nsteps > 1) issue(1, 1);
#pragma unroll
            for (int s = 0; s < 5; ++s) {
                if (s < nsteps) {
                    if (s + 2 < nsteps) issue(s + 2, (s + 2) % 3);
                    const int k0 = kstart + 32 * s;
                    f32x4 s0v, s1v; qk_step(kf[s % 3], qf, s0v, s1v);
                    if ((k0 + 31 > s0) || (k0 < s0 + 15 - 128)) {
                        const int pb = k0 + 4 * grp;
#pragma unroll
                        for (int i = 0; i < 4; ++i) { const int p0 = pb + i, p1 = pb + 16 + i;
                            if (p0 > sq || p0 < sq - 128) s0v[i] = -INFINITY; if (p1 > sq || p1 < sq - 128) s1v[i] = -INFINITY; }
                    }
                    att_update(a, s0v, s1v, vf[s % 3]);
                }
            }
            const float lt = grp_sum(a.l);
            if (pass < 2) {
#pragma unroll
                for (int dt = 0; dt < 4; ++dt) *(f32x4*)(stO + tloc * 64 + 16 * dt + 4 * grp) = a.o[dt];
                if (grp == 0) { stML[tloc * 2] = a.m; stML[tloc * 2 + 1] = lt; }
            } else {
                const float il = lt > 0.f ? 1.f / lt : 0.f;
#pragma unroll
                for (int dt = 0; dt < 4; ++dt) { uint2 o; o.x = pk2(a.o[dt][0] * il, a.o[dt][1] * il); o.y = pk2(a.o[dt][2] * il, a.o[dt][3] * il);
                    *(uint2*)(p.MIXB + (size_t)tq * 1024 + h * 64 + 16 * dt + 4 * grp) = o; }
            }
        }
    }
}
__device__ __forceinline__ void ph_dil_combo(const KP& p, const Fr& F) {
    const float* H1 = p.BIGF; const int lane = F.lane;
    const int cw = F.bid * 4 + F.wave;
#pragma unroll 1
    for (int u = 0; u < 4; ++u) {
#pragma unroll
        for (int pass = 0; pass < 3; ++pass) {
            if (F.wave >= 4) dil_pass(p, F.bid + u * F.G, pass, F.lds, F.wave - 4, lane);
            else {
                const int ci = u * 3 + pass;
                const int g0 = ci * 2 + (ci < 8 ? ci : 8), g1 = g0 + 2 + (ci < 8 ? 1 : 0);
                auto srcp = [&](int itn) -> const float4* {
                    const size_t idx = ((size_t)itn * 1024 + cw) * 64 + lane;
                    const int b = (int)(idx >> 20), i = (int)((idx >> 9) & 2047), c4 = (int)(idx & 511);
                    const int c = c4 * 4, r = T + b;
                    const float4* s_old = ((const float4*)p.st_dil) + ((size_t)b * 2048 + (i < 2047 ? i + 1 : 2047)) * 512 + c4;
                    const float4* s_new = (c < 1024) ? (const float4*)(p.KD + (size_t)r * 1024 + c) : (const float4*)(H1 + (size_t)r * 3072 + 2048 + (c - 1024));
                    return (i == 2047) ? s_new : s_old; };
                float4* dstp = (float4*)(p.out + O_DIL_S) + (size_t)cw * 64 + lane;
#pragma unroll 1
                for (int gi = g0; gi < g1; ++gi) {
                    const int i0 = gi * 16;
                    const float4 v0 = *srcp(i0), v1 = *srcp(i0 + 1), v2 = *srcp(i0 + 2), v3 = *srcp(i0 + 3), v4 = *srcp(i0 + 4), v5 = *srcp(i0 + 5), v6 = *srcp(i0 + 6), v7 = *srcp(i0 + 7);
                    const float4 v8 = *srcp(i0 + 8), v9 = *srcp(i0 + 9), v10 = *srcp(i0 + 10), v11 = *srcp(i0 + 11), v12 = *srcp(i0 + 12), v13 = *srcp(i0 + 13), v14 = *srcp(i0 + 14), v15 = *srcp(i0 + 15);
                    float4* d = dstp + (size_t)i0 * 65536;
                    d[0] = v0; d[65536] = v1; d[2 * 65536] = v2; d[3 * 65536] = v3; d[4 * 65536] = v4; d[5 * 65536] = v5; d[6 * 65536] = v6; d[7 * 65536] = v7;
                    d[8 * 65536] = v8; d[9 * 65536] = v9; d[10 * 65536] = v10; d[11 * 65536] = v11; d[12 * 65536] = v12; d[13 * 65536] = v13; d[14 * 65536] = v14; d[15 * 65536] = v15;
                }
            }
            __syncthreads();
        }
    }
}

constexpr int NPHASE = 21;
__global__ void __launch_bounds__(NTHR, 2) mega(KP p) {
    extern __shared__ __attribute__((aligned(16))) unsigned char lds[];
    Fr F; F.lds = lds; F.tid = threadIdx.x; F.lane = 0; F.wave = __builtin_amdgcn_readfirstlane(F.tid >> 6);
    F.bid = blockIdx.x; F.G = gridDim.x; F.gw = F.bid * NWAVES + F.wave; F.NGW = F.G * NWAVES; F.tgt = F.bid * NTHR + F.tid; F.tGT = F.G * NTHR;
    for (int u = F.tid; u < (LDS_BYTES - RING_BYTES) / 4; u += NTHR) ((unsigned*)(lds + RING_BYTES))[u] = 0u;
    __syncthreads();
    XcdBarrier bar; bar.bar = p.ctl + 4096; bar.x = 0; bar.st = nullptr;
    if (!MK_PER_PHASE) bar = xcd_barrier_post(p.ctl + 4096, (volatile LAS unsigned*)(lds + MISC_OFF + 32));
    const int lo = p.ph_lo, hi = p.ph_hi;
#define IN(k) (lo <= (k) && (k) < hi)

    int ph = 0;
#if PROBE_ON
#define PROBE_STAMP(k) do { if (blockIdx.x == 0 && threadIdx.x == 0) ((unsigned long long*)(p.ctl + 65536))[k] = __builtin_amdgcn_s_memrealtime(); } while (0)
#define PROBE_STAMPB(k, blk) do { if (blockIdx.x == (blk) && threadIdx.x == 0) ((unsigned long long*)(p.ctl + 65536))[k] = __builtin_amdgcn_s_memrealtime(); } while (0)
    PROBE_STAMP(0);
#else
#define PROBE_STAMP(k) do { } while (0)
#define PROBE_STAMPB(k, blk) do { } while (0)
#endif
#define PHASE(...) do { { unsigned t_ = threadIdx.x; asm volatile("" : "+v"(t_)); F.lane = (int)(t_ & 63u); } if (IN(ph)) { __VA_ARGS__ } if (IN(ph) && IN(ph + 1)) xcd_barrier(bar); ++ph; PROBE_STAMP(ph); } while (0)
    PHASE(ph_prologue(p, F););
    PHASE(if (F.bid >= F.G / 2) { ph_cmp_samples(p, F); ph_gemm_h0(p, F); } else { ph_gemm_h0(p, F); ph_cmp_samples(p, F); });
    PHASE(ph_prep_chunks(p, F););
    PHASE(ph_mix_a(p, F););
    PHASE(ph_mix_b(p, F););
    PHASE(ph_gdn_out(p, F););
    PHASE(ph_gemm_bf16(F, p.MIXB, p.WT_OA, DM, p.MOB););
    PHASE(ph_ln_b(F, p.ACTB, p.MOB, p.ln_mix_g, p.ln_mix_b, nullptr, nullptr););
    PHASE(ph_ffn_gemm(p, F, p.WT_FI0, 0););
    PHASE(ph_ffn_fix(p, F, 0););
    PHASE(ph_gemm_bf16(F, p.HFFB, p.WT_FO0, DFF, p.MOB););
    PHASE(ph_ln_b(F, p.ACTB, p.MOB, p.ln_ffn_g, p.ln_ffn_b, nullptr, nullptr););
    PHASE(ph_gemm_h1(p, F););
    PHASE(ph_dil_prep(p, F); ph_dil_prep_fast(p, F););
    PHASE(if (F.bid & 1) { ph_dil_combo(p, F); __syncthreads(); ph_dil_attn(p, F); } else { ph_dil_attn(p, F); __syncthreads(); ph_dil_combo(p, F); });
    PHASE(ph_gemm_bf16(F, p.MIXB, p.WT_CO, DM, p.MOB););
    PHASE(ph_ln_b(F, p.ACTB, p.MOB, p.ln_mix_g + DM, p.ln_mix_b + DM, nullptr, nullptr););
    PHASE(ph_ffn_gemm(p, F, p.WT_FI1, 1););
    PHASE(ph_ffn_fix(p, F, 1););
    PHASE(ph_gemm_bf16(F, p.HFFB, p.WT_FO1, DFF, p.MOB););
    PHASE(ph_ln_b(F, p.ACTB, p.MOB, p.ln_ffn_g + DM, p.ln_ffn_b + DM, p.out + O_Y_P, p.out + O_Y_S););
#undef PHASE
#if PROBE_ON
    xcd_barrier(bar);
    if (blockIdx.x == 0) { __syncthreads(); const unsigned long long* pts = (const unsigned long long*)(p.ctl + 65536); const float x = (float)(pts[PROBE_B] - pts[PROBE_A]) * 1e-5f;
        for (int i = threadIdx.x; i < NSMP * DM; i += NTHR) p.out[O_Y_S + i] *= (1.f + x); }
#endif
#undef IN
}

static inline size_t align_up(size_t x) { return (x + 255) & ~(size_t)255; }

extern "C" void kernel_launch(void* const* d_in, const int* in_sizes, int n_in, void* d_out, int out_size, void* d_ws, size_t ws_size, hipStream_t stream) {
    static int grid = 0;
    if (grid == 0) {
        int dev = 0, cus = 0, per_cu = 0;
        if (hipGetDevice(&dev) != hipSuccess || hipDeviceGetAttribute(&cus, hipDeviceAttributeMultiprocessorCount, dev) != hipSuccess) { fprintf(stderr, "kernel_launch: device query failed\n"); grid = -1; return; }
        if (hipFuncSetAttribute((const void*)mega, hipFuncAttributeMaxDynamicSharedMemorySize, LDS_BYTES) != hipSuccess) { fprintf(stderr, "kernel_launch: hipFuncSetAttribute failed\n"); grid = -1; return; }
        if (hipOccupancyMaxActiveBlocksPerMultiprocessor(&per_cu, (const void*)mega, NTHR, LDS_BYTES) != hipSuccess || per_cu < 1) { fprintf(stderr, "kernel_launch: occupancy query says %d blocks per CU\n", per_cu); }
        (void)hipGetLastError();
        grid = cus;
    }
    if (grid < 0) return;
    if ((size_t)out_size != O_END) fprintf(stderr, "kernel_launch: out_size %d != expected %zu\n", out_size, (size_t)O_END);
    KP p{};
    p.x_prompt = (const float*)d_in[0]; p.x_sample = (const float*)d_in[1]; p.cache_cmp = (const float*)d_in[2]; p.cache_slc = (const float*)d_in[3];
    p.st_win = (const float*)d_in[4]; p.st_gconv = (const float*)d_in[5]; p.st_gS = (const float*)d_in[6]; p.st_dil = (const float*)d_in[7];
    p.st_ffn = (const float*)d_in[8]; p.page_table = (const int*)d_in[9]; p.w_in_a = (const float*)d_in[10]; p.cw1 = (const float*)d_in[11];
    p.cb1 = (const float*)d_in[12]; p.cw2 = (const float*)d_in[13]; p.cpe = (const float*)d_in[14]; p.gconv_w = (const float*)d_in[15];
    p.gA = (const float*)d_in[16]; p.gdt = (const float*)d_in[17]; p.gnw = (const float*)d_in[18]; p.w_out_a = (const float*)d_in[19];
    p.w_in_c = (const float*)d_in[20]; p.w_out_c = (const float*)d_in[21]; p.ln_mix_g = (const float*)d_in[22]; p.ln_mix_b = (const float*)d_in[23];
    p.ffn_w_in = (const float*)d_in[24]; p.ffn_cw = (const float*)d_in[25]; p.ffn_cb = (const float*)d_in[26]; p.ffn_w_out = (const float*)d_in[27];
    p.ln_ffn_g = (const float*)d_in[28]; p.ln_ffn_b = (const float*)d_in[29];
    p.out = (float*)d_out;
    char* ws = (char*)d_ws; size_t off = 0;
    auto alloc = [&](size_t bytes) { void* q = (void*)(ws + off); off = align_up(off + bytes); return q; };
    p.ctl = (unsigned*)alloc(1 << 20);
    p.WT_A = (bf16*)alloc((size_t)PAP * DM * 2); p.WT_OA = (bf16*)alloc((size_t)DM * DM * 2);
    p.WT_FI0 = (bf16*)alloc((size_t)DFF2 * DM * 2); p.WT_FI1 = (bf16*)alloc((size_t)DFF2 * DM * 2);
    p.WT_FO0 = (bf16*)alloc((size_t)DM * DFF * 2); p.WT_FO1 = (bf16*)alloc((size_t)DM * DFF * 2);
    p.WT_CI = (bf16*)alloc((size_t)3072 * DM * 2); p.WT_CO = (bf16*)alloc((size_t)DM * DM * 2);
    p.ROPE = (float2*)alloc((size_t)(T + 1) * 32 * 8);
    p.ACTB = (bf16*)alloc((size_t)TSP * DM * 2); p.MIXB = (bf16*)alloc((size_t)TSP * DM * 2); p.HFFB = (bf16*)alloc((size_t)TSP * DFF * 2);
    p.KS8 = (unsigned char*)alloc((size_t)2 * T * 64); p.VS8 = (unsigned char*)alloc((size_t)2 * T * 64);
    p.QB = (bf16*)alloc((size_t)T * 512 * 2); p.KSF = (bf16*)alloc((size_t)2 * T * 64 * 2); p.VSF = (bf16*)alloc((size_t)2 * T * 64 * 2);
    p.KWF = (bf16*)alloc((size_t)2 * T * 64 * 2); p.VWF = (bf16*)alloc((size_t)2 * T * 64 * 2); p.CKF = (bf16*)alloc((size_t)2 * 512 * 64 * 2); p.CVF = (bf16*)alloc((size_t)2 * 512 * 64 * 2);
    p.ACP = (bf16*)alloc((size_t)2048 * 2048 * 2);
    p.W2T = (bf16*)alloc((size_t)2 * 64 * 128 * 2);
    p.AC = nullptr; p.WT_C = (bf16*)alloc((size_t)256 * 2048 * 2); p.HID = nullptr; p.SMIXF = (float*)alloc((size_t)NSMP * 3 * 512 * 4);
    p.UB = (float*)alloc((size_t)256 * 4 * DFF2 * 4);
    p.NSACC = (float*)alloc((size_t)T * 512 * 4); p.SEL = (int*)alloc((size_t)2 * T * 16 * 4);
    p.QDB = (bf16*)alloc((size_t)T * 1024 * 2);
    for (int i = 0; i < 3; ++i) { p.DKF[i] = (bf16*)alloc((size_t)T * 1024 * 2); p.DVF[i] = (bf16*)alloc((size_t)T * 1024 * 2); }
    p.G_WF = (bf16*)alloc((size_t)2048 * 4096 * 2); p.G_KDF = (bf16*)alloc((size_t)2048 * 4096 * 2); p.G_QGF = (bf16*)alloc((size_t)2048 * 4096 * 2); p.G_QKF = (bf16*)alloc((size_t)2048 * 4096 * 2);
    p.G_SPF = (bf16*)alloc((size_t)2048 * 4096 * 2); p.G_VNF = (bf16*)alloc((size_t)2048 * 4096 * 2); p.G_UF = (float*)alloc((size_t)2048 * 4096 * 4); p.G_GL = (float*)alloc((size_t)2048 * 4);
    p.MOB = (bf16*)alloc((size_t)TSP * DM * 2); p.H1B = (bf16*)alloc((size_t)T * 3072 * 2); p.H0B = (bf16*)alloc((size_t)T * PAP * 2); p.ZF = (float*)alloc((size_t)T * 512 * 4);
    p.BIGF = (float*)alloc((size_t)TSP * DFF2 * 4); p.MO = (float*)alloc((size_t)TSP * DM * 4);
    p.X1 = (float*)alloc((size_t)TS * DM * 4); p.X2 = (float*)alloc((size_t)TS * DM * 4); p.X3 = (float*)alloc((size_t)TS * DM * 4);
    p.QR = (float*)alloc((size_t)TS * 512 * 4);
    p.KS = (float*)alloc((size_t)TS * 128 * 4); p.VS = (float*)alloc((size_t)TS * 128 * 4); p.KW = (float*)alloc((size_t)TS * 128 * 4); p.VW = (float*)alloc((size_t)TS * 128 * 4);
    p.CK = (float*)alloc((size_t)33 * 512 * 128 * 4); p.CV = (float*)alloc((size_t)33 * 512 * 128 * 4);
    p.GQ = (float*)alloc((size_t)TS * 512 * 4); p.GK = (float*)alloc((size_t)TS * 512 * 4); p.GV = (float*)alloc((size_t)TS * 512 * 4); p.OG = (float*)alloc((size_t)TS * 512 * 4);
    p.Gg = (float*)alloc((size_t)TS * 8 * 4); p.Gb = (float*)alloc((size_t)TS * 8 * 4);
    p.QD = (float*)alloc((size_t)TS * DM * 4); p.KD = (float*)alloc((size_t)TS * DM * 4);
    if (off > ws_size) { fprintf(stderr, "kernel_launch: workspace too small: need %zu have %zu\n", off, ws_size); return; }
    if (hipMemsetAsync(p.ctl, 0, 1 << 20, stream) != hipSuccess) { fprintf(stderr, "kernel_launch: memset failed\n"); return; }
#if MK_PER_PHASE
    for (int k = 0; k < NPHASE; ++k) { p.ph_lo = k; p.ph_hi = k + 1; hipLaunchKernelGGL(mega, dim3(grid), dim3(NTHR), LDS_BYTES, stream, p); }
#else
    p.ph_lo = 0; p.ph_hi = NPHASE;
    hipLaunchKernelGGL(mega, dim3(grid), dim3(NTHR), LDS_BYTES, stream, p);
#endif
    const hipError_t le = hipPeekAtLastError();
    if (le != hipSuccess) fprintf(stderr, "kernel_launch: launch failed: %s\n", hipGetErrorName(le));
}
```
